# Optimizing an MI355X kernel written in HIP

```python
import math
import jax, jax.numpy as jnp
from jax import lax
import numpy as np

D_MODEL = 2048
BATCH = 4
SEQ = 2048
DEPTH = 2

GRID_W = 64
HEAD_DIM = 128
N_Q_HEADS = 12
N_KV_HEADS = 4
GQA_GROUP = N_Q_HEADS // N_KV_HEADS
ATTN_WIDTH = N_Q_HEADS * HEAD_DIM
KV_WIDTH = N_KV_HEADS * HEAD_DIM
Q_BLOCK = 128
ROPE_THETA = 10000.0
ROPE_AXIS_DIM = HEAD_DIM // 2
N_FOURIER_GROUPS = 4
FOURIER_GROUP = 128
FOURIER_WIDTH = N_FOURIER_GROUPS * FOURIER_GROUP
MIX_WIDTH = ATTN_WIDTH + FOURIER_WIDTH
IN_WIDTH = ATTN_WIDTH + 2 * KV_WIDTH + FOURIER_WIDTH
POOL_WINDOWS = (2, 4, 8, 16)
N_POOL_GROUPS = len(POOL_WINDOWS)
POOL_GROUP = D_MODEL // N_POOL_GROUPS
MEM_LEN = 256
N_MEM_HEADS = 4
MEM_HEAD_DIM = D_MODEL // N_MEM_HEADS
N_EXPERTS = 16
EXPERT_FF = D_MODEL // 2
EC_CAPACITY_FACTOR = 2
NORM_EPS = 1e-6
N_EVEN = (DEPTH + 1) // 2
N_ODD = DEPTH // 2

kernel_name = "hybrid_attn_fourier_pool_ec_moe_encoder"


def rms_norm(x, gain):
    xf = x.astype(jnp.float32)
    y = xf * lax.rsqrt(jnp.mean(xf * xf, axis=-1, keepdims=True) + NORM_EPS)
    return (y * gain.astype(jnp.float32)).astype(x.dtype)


def axial_rope_tables(seq_len):
    rows = seq_len // GRID_W
    row_idx = jnp.repeat(jnp.arange(rows), GRID_W).astype(jnp.float32)
    col_idx = jnp.tile(jnp.arange(GRID_W), rows).astype(jnp.float32)
    inv_freq = 1.0 / (ROPE_THETA ** (jnp.arange(0, ROPE_AXIS_DIM, 2, dtype=jnp.float32) / ROPE_AXIS_DIM))
    ang = jnp.concatenate([row_idx[:, None] * inv_freq[None, :],
                           col_idx[:, None] * inv_freq[None, :]], axis=-1)
    return jnp.cos(ang), jnp.sin(ang)


def apply_axial_rope(x, cos, sin):
    xf = x.astype(jnp.float32)
    x1 = xf[..., 0::2]
    x2 = xf[..., 1::2]
    c = cos[None, :, None, :]
    s = sin[None, :, None, :]
    out = jnp.stack([x1 * c - x2 * s, x1 * s + x2 * c], axis=-1).reshape(x.shape)
    return out.astype(x.dtype)


def blocked_bidirectional_gqa(q, k, v):
    b, s = q.shape[0], q.shape[1]
    n_blocks = s // Q_BLOCK
    scale = HEAD_DIM ** -0.5
    qb = q.reshape(b, n_blocks, Q_BLOCK, N_KV_HEADS, GQA_GROUP, HEAD_DIM).transpose(1, 0, 2, 3, 4, 5)

    def one_block(q_blk):
        scores = jnp.einsum('bqkgd,bskd->bkgqs', q_blk, k,
                            preferred_element_type=jnp.float32) * scale
        probs = jax.nn.softmax(scores, axis=-1).astype(v.dtype)
        return jnp.einsum('bkgqs,bskd->bqkgd', probs, v)

    o = lax.map(one_block, qb)
    return o.transpose(1, 0, 2, 3, 4, 5).reshape(b, s, ATTN_WIDTH)


def fourier_groups(u, w_fourier):
    z = jnp.fft.fft2(u.astype(jnp.float32), axes=(1, 3), norm='ortho').real
    return jnp.einsum('bsgc,gcd->bsgd', z.astype(u.dtype), w_fourier)


def attn_fourier_mixer(h, cos, sin, w_in, q_gain, k_gain, w_fourier, w_out):
    b, s, _ = h.shape
    proj = h @ w_in
    q, k, v, f = jnp.split(proj, [ATTN_WIDTH, ATTN_WIDTH + KV_WIDTH,
                                  ATTN_WIDTH + 2 * KV_WIDTH], axis=-1)
    q = apply_axial_rope(rms_norm(q.reshape(b, s, N_Q_HEADS, HEAD_DIM), q_gain), cos, sin)
    k = apply_axial_rope(rms_norm(k.reshape(b, s, N_KV_HEADS, HEAD_DIM), k_gain), cos, sin)
    q = q.reshape(b, s, N_KV_HEADS, GQA_GROUP, HEAD_DIM)
    v = v.reshape(b, s, N_KV_HEADS, HEAD_DIM)
    o_attn = blocked_bidirectional_gqa(q, k, v)
    o_four = fourier_groups(f.reshape(b, s, N_FOURIER_GROUPS, FOURIER_GROUP),
                            w_fourier).reshape(b, s, FOURIER_WIDTH)
    return jnp.concatenate([o_attn, o_four], axis=-1) @ w_out


def centred_mean_minus_self(u, window):
    b, s, c = u.shape
    t = jnp.arange(s)
    lo = jnp.clip(t - window // 2, 0, s)
    hi = jnp.clip(t + window - window // 2, 0, s)
    uf = u.astype(jnp.float32)
    cs = jnp.concatenate([jnp.zeros((b, 1, c), jnp.float32), jnp.cumsum(uf, axis=1)], axis=1)
    total = cs[:, hi] - cs[:, lo]
    count = (hi - lo).astype(jnp.float32)[None, :, None]
    return (total / count - uf).astype(u.dtype)


def pool_mixer(h, w_pool, pool_scale):
    b, s, _ = h.shape
    groups = h.reshape(b, s, N_POOL_GROUPS, POOL_GROUP)
    pooled = jnp.stack([centred_mean_minus_self(groups[:, :, g], w)
                        for g, w in enumerate(POOL_WINDOWS)], axis=2)
    mixed = jnp.einsum('bsgc,gcd->bsgd', pooled, w_pool).reshape(b, s, D_MODEL)
    return mixed * pool_scale


def memory_cross_attention(h, mem_n, w_q, w_k, w_v, w_o):
    b, s, _ = h.shape
    m = mem_n.shape[1]
    q = (h @ w_q).reshape(b, s, N_MEM_HEADS, MEM_HEAD_DIM)
    k = (mem_n @ w_k).reshape(b, m, N_MEM_HEADS, MEM_HEAD_DIM)
    v = (mem_n @ w_v).reshape(b, m, N_MEM_HEADS, MEM_HEAD_DIM)
    scores = jnp.einsum('bqhd,bmhd->bhqm', q, k,
                        preferred_element_type=jnp.float32) * (MEM_HEAD_DIM ** -0.5)
    probs = jax.nn.softmax(scores, axis=-1).astype(v.dtype)
    o = jnp.einsum('bhqm,bmhd->bqhd', probs, v).reshape(b, s, D_MODEL)
    return o @ w_o


def expert_choice_moe(h, w_router, w_gate, w_up, w_down):
    b, s, d = h.shape
    capacity = EC_CAPACITY_FACTOR * s // N_EXPERTS
    logits = jnp.einsum('bsd,de->bse', h, w_router, preferred_element_type=jnp.float32)
    affinity = jax.nn.softmax(logits, axis=-1)
    gate, idx = lax.top_k(affinity.transpose(0, 2, 1), capacity)
    xs = jax.vmap(lambda hb, ib: hb[ib])(h, idx)
    a = jnp.einsum('becd,edf->becf', xs, w_gate)
    u = jnp.einsum('becd,edf->becf', xs, w_up)
    y = jnp.einsum('becf,efd->becd', jax.nn.silu(a) * u, w_down)
    y = y * gate[..., None].astype(y.dtype)
    return jax.vmap(lambda yb, ib: jnp.zeros((s, d), yb.dtype)
                    .at[ib.reshape(-1)].add(yb.reshape(-1, d)))(y, idx)


def setup_inputs(seed: int = 0) -> dict:
    key = jax.random.key(seed)
    ks = jax.random.split(key, 24)
    f32 = jnp.float32

    def w(k, shape, fan_in):
        return jax.random.normal(k, shape, f32) * (fan_in ** -0.5)

    def gain(k, shape):
        return 1.0 + 0.02 * jax.random.normal(k, shape, f32)

    return {
        "x": jax.random.normal(ks[0], (BATCH, SEQ, D_MODEL), f32),
        "mem": jax.random.normal(ks[1], (BATCH, MEM_LEN, D_MODEL), f32),
        "mix_norm": gain(ks[2], (DEPTH, D_MODEL)),
        "attn_w_in": w(ks[3], (N_EVEN, D_MODEL, IN_WIDTH), D_MODEL),
        "q_gain": gain(ks[4], (N_EVEN, HEAD_DIM)),
        "k_gain": gain(ks[5], (N_EVEN, HEAD_DIM)),
        "fourier_w": w(ks[6], (N_EVEN, N_FOURIER_GROUPS, FOURIER_GROUP, FOURIER_GROUP), FOURIER_GROUP),
        "attn_w_out": w(ks[7], (N_EVEN, MIX_WIDTH, D_MODEL), MIX_WIDTH),
        "pool_w": w(ks[8], (N_ODD, N_POOL_GROUPS, POOL_GROUP, POOL_GROUP), POOL_GROUP),
        "pool_scale": gain(ks[9], (N_ODD, D_MODEL)),
        "cross_norm": gain(ks[10], (DEPTH, D_MODEL)),
        "mem_norm": gain(ks[11], (DEPTH, D_MODEL)),
        "cross_w_q": w(ks[12], (DEPTH, D_MODEL, D_MODEL), D_MODEL),
        "cross_w_k": w(ks[13], (DEPTH, D_MODEL, D_MODEL), D_MODEL),
        "cross_w_v": w(ks[14], (DEPTH, D_MODEL, D_MODEL), D_MODEL),
        "cross_w_o": w(ks[15], (DEPTH, D_MODEL, D_MODEL), D_MODEL),
        "ffn_norm": gain(ks[16], (DEPTH, D_MODEL)),
        "router_w": w(ks[17], (DEPTH, D_MODEL, N_EXPERTS), D_MODEL),
        "expert_w_gate": w(ks[18], (DEPTH, N_EXPERTS, D_MODEL, EXPERT_FF), D_MODEL),
        "expert_w_up": w(ks[19], (DEPTH, N_EXPERTS, D_MODEL, EXPERT_FF), D_MODEL),
        "expert_w_down": w(ks[20], (DEPTH, N_EXPERTS, EXPERT_FF, D_MODEL), EXPERT_FF),
        "final_norm": gain(ks[21], (D_MODEL,)),
    }


def reference(x, mem, mix_norm, attn_w_in, q_gain, k_gain, fourier_w, attn_w_out,
              pool_w, pool_scale, cross_norm, mem_norm, cross_w_q, cross_w_k,
              cross_w_v, cross_w_o, ffn_norm, router_w, expert_w_gate, expert_w_up,
              expert_w_down, final_norm):
    seq_len = x.shape[1]
    cos, sin = axial_rope_tables(seq_len)
    for layer in range(DEPTH):
        h = rms_norm(x, mix_norm[layer])
        i = layer // 2
        if layer % 2 == 0:
            x = x + attn_fourier_mixer(h, cos, sin, attn_w_in[i], q_gain[i], k_gain[i],
                                       fourier_w[i], attn_w_out[i])
        else:
            x = x + pool_mixer(h, pool_w[i], pool_scale[i])
        x = x + memory_cross_attention(rms_norm(x, cross_norm[layer]),
                                       rms_norm(mem, mem_norm[layer]),
                                       cross_w_q[layer], cross_w_k[layer],
                                       cross_w_v[layer], cross_w_o[layer])
        x = x + expert_choice_moe(rms_norm(x, ffn_norm[layer]), router_w[layer],
                                  expert_w_gate[layer], expert_w_up[layer],
                                  expert_w_down[layer])
    return rms_norm(x, final_norm)
```

```cpp
#include <hip/hip_runtime.h>
#include <cstdio>
#include <cstdint>

constexpr int DM = 2048, NB = 4, SEQ = 2048, NTOK = NB * SEQ;
constexpr int HD = 128, NQH = 12, NKVH = 4, AW = NQH * HD, KVW = NKVH * HD, FW = 512, INW = 3072;
constexpr int MEML = 256, NMH = 4, MHD = 512;
constexpr int NE = 16, EFF = 1024, CAP = 256;
constexpr float EPS = 1e-6f;

__global__ void __launch_bounds__(256) rmsnorm_k(const float* __restrict__ x, const float* __restrict__ g, float* __restrict__ y, int C) {
    __shared__ float red[4];
    const long row = blockIdx.x; const float* xr = x + row * C; float* yr = y + row * C;
    float v[8]; float s = 0.f;
    for (int i = 0; i < 8; ++i) { v[i] = xr[threadIdx.x + 256 * i]; s += v[i] * v[i]; }
    for (int o = 32; o > 0; o >>= 1) s += __shfl_xor(s, o);
    if ((threadIdx.x & 63) == 0) red[threadIdx.x >> 6] = s;
    __syncthreads();
    s = red[0] + red[1] + red[2] + red[3];
    const float r = rsqrtf(s / (float)C + EPS);
    for (int i = 0; i < 8; ++i) yr[threadIdx.x + 256 * i] = v[i] * r * g[threadIdx.x + 256 * i];
}

struct GemmP {
    const float* A; const float* B; float* C; const float* R; const float* cs;
    int M, N, K, nz2;
    long lda, sbk, sbn, ldc;
    long sA1, sA2, sB1, sB2, sC1, sC2, sCS2;
    float alpha; int accumulate;
};
__global__ void __launch_bounds__(256) sgemm_k(GemmP p) {
    __shared__ float As[16][68];
    __shared__ float Bs[16][68];
    const int z = blockIdx.z, z1 = z / p.nz2, z2 = z % p.nz2;
    const float* A = p.A + z1 * p.sA1 + z2 * p.sA2;
    const float* B = p.B + z1 * p.sB1 + z2 * p.sB2;
    const long coff = z1 * p.sC1 + z2 * p.sC2;
    float* C = p.C + coff; const float* R = p.R ? p.R + coff : nullptr;
    const float* cs = p.cs ? p.cs + z2 * p.sCS2 : nullptr;
    const int m0 = blockIdx.y * 64, n0 = blockIdx.x * 64, t = threadIdx.x, ty = t >> 4, tx = t & 15;
    float acc[4][4] = {};
    for (int k0 = 0; k0 < p.K; k0 += 16) {
#pragma unroll
        for (int i = 0; i < 4; ++i) { const int e = t + 256 * i, r = e >> 4, kk = e & 15; As[kk][r] = A[(long)(m0 + r) * p.lda + k0 + kk]; }
        if (p.sbn == 1) {
#pragma unroll
            for (int i = 0; i < 4; ++i) { const int e = t + 256 * i, kk = e >> 6, n = e & 63; Bs[kk][n] = B[(long)(k0 + kk) * p.sbk + (n0 + n)]; }
        } else {
#pragma unroll
            for (int i = 0; i < 4; ++i) { const int e = t + 256 * i, n = e >> 4, kk = e & 15; Bs[kk][n] = B[(long)(k0 + kk) * p.sbk + (long)(n0 + n) * p.sbn]; }
        }
        __syncthreads();
#pragma unroll
        for (int kk = 0; kk < 16; ++kk) {
            const float4 a = *(const float4*)&As[kk][ty * 4]; const float4 b = *(const float4*)&Bs[kk][tx * 4];
            const float av[4] = {a.x, a.y, a.z, a.w}, bv[4] = {b.x, b.y, b.z, b.w};
#pragma unroll
            for (int i = 0; i < 4; ++i)
#pragma unroll
                for (int j = 0; j < 4; ++j) acc[i][j] += av[i] * bv[j];
        }
        __syncthreads();
    }
#pragma unroll
    for (int i = 0; i < 4; ++i) {
        const long off = (long)(m0 + ty * 4 + i) * p.ldc + n0 + tx * 4;
#pragma unroll
        for (int j = 0; j < 4; ++j) {
            float v = acc[i][j] * p.alpha;
            if (cs) v *= cs[n0 + tx * 4 + j];
            if (R) v += R[off + j];
            if (p.accumulate) v += C[off + j];
            C[off + j] = v;
        }
    }
}

__global__ void __launch_bounds__(64) qknorm_rope_k(float* proj, const float* __restrict__ gain, int col0, int nheads) {
    const int tok = blockIdx.x / nheads, h = blockIdx.x % nheads, lane = threadIdx.x;
    float* p = proj + (long)tok * INW + col0 + h * HD;
    float a = p[2 * lane], b = p[2 * lane + 1];
    float s = a * a + b * b;
    for (int o = 32; o > 0; o >>= 1) s += __shfl_xor(s, o);
    const float r = rsqrtf(s / (float)HD + EPS);
    a = a * r * gain[2 * lane]; b = b * r * gain[2 * lane + 1];
    const int t = tok % SEQ; const int pos = (lane < 32) ? (t / 64) : (t % 64); const int j = lane & 31;
    const float inv = 1.0f / powf(10000.0f, (float)(2 * j) / 64.0f);
    const float ang = (float)pos * inv;
    const float c = cosf(ang), sn = sinf(ang);
    p[2 * lane] = a * c - b * sn; p[2 * lane + 1] = a * sn + b * c;
}

__global__ void __launch_bounds__(256) softmax_k(float* S, int C, float scale) {
    __shared__ float red[4];
    float* r = S + (long)blockIdx.x * C; const int n = C / 256;
    float v[8]; float m = -3.0e38f;
    for (int i = 0; i < n; ++i) { v[i] = r[threadIdx.x + 256 * i] * scale; m = fmaxf(m, v[i]); }
    for (int o = 32; o > 0; o >>= 1) m = fmaxf(m, __shfl_xor(m, o));
    if ((threadIdx.x & 63) == 0) red[threadIdx.x >> 6] = m;
    __syncthreads();
    m = fmaxf(fmaxf(red[0], red[1]), fmaxf(red[2], red[3]));
    __syncthreads();
    float s = 0.f;
    for (int i = 0; i < n; ++i) { v[i] = expf(v[i] - m); s += v[i]; }
    for (int o = 32; o > 0; o >>= 1) s += __shfl_xor(s, o);
    if ((threadIdx.x & 63) == 0) red[threadIdx.x >> 6] = s;
    __syncthreads();
    s = red[0] + red[1] + red[2] + red[3];
    const float inv = 1.0f / s;
    for (int i = 0; i < n; ++i) r[threadIdx.x + 256 * i] = v[i] * inv;
}

__global__ void dft_tab_k(float* Cm, float* Sm, int N) {
    const long i = (long)blockIdx.x * blockDim.x + threadIdx.x; if (i >= (long)N * N) return;
    const int k = (int)(i / N), s = (int)(i % N); const int m = (int)(((long)k * s) % N);
    const double ang = 6.283185307179586476925286766559 * (double)m / (double)N;
    Cm[i] = (float)cos(ang); Sm[i] = (float)sin(ang);
}

__global__ void __launch_bounds__(256) pool_k(const float* __restrict__ h, float* __restrict__ out) {
    const long row = blockIdx.x; const int t = (int)(row % SEQ);
    for (int c = threadIdx.x; c < DM; c += 256) {
        const int g = c / 512, w = 2 << g; int lo = t - w / 2, hi = t + w - w / 2; if (lo < 0) lo = 0; if (hi > SEQ) hi = SEQ;
        float s = 0.f; for (int j = lo; j < hi; ++j) s += h[(row - t + j) * DM + c];
        out[row * DM + c] = s / (float)(hi - lo) - h[row * DM + c];
    }
}

__global__ void __launch_bounds__(64) router_k(const float* __restrict__ h, const float* __restrict__ Wr, float* __restrict__ aff) {
    const int tok = blockIdx.x, lane = threadIdx.x; const float* hr = h + (long)tok * DM;
    float acc[NE]; for (int e = 0; e < NE; ++e) acc[e] = 0.f;
    for (int k = lane; k < DM; k += 64) { const float hv = hr[k]; const float* w = Wr + (long)k * NE; for (int e = 0; e < NE; ++e) acc[e] += hv * w[e]; }
    for (int e = 0; e < NE; ++e) for (int o = 32; o > 0; o >>= 1) acc[e] += __shfl_xor(acc[e], o);
    float m = acc[0]; for (int e = 1; e < NE; ++e) m = fmaxf(m, acc[e]);
    float s = 0.f; for (int e = 0; e < NE; ++e) { acc[e] = expf(acc[e] - m); s += acc[e]; }
    if (lane < NE) { float v = 0.f; for (int e = 0; e < NE; ++e) if (e == lane) v = acc[e]; const int b = tok / SEQ, t = tok % SEQ; aff[((long)b * NE + lane) * SEQ + t] = v / s; }
}

__global__ void __launch_bounds__(256) rank_k(const float* __restrict__ aff, int* __restrict__ rank, int* __restrict__ idx, float* __restrict__ gate) {
    __shared__ float a[SEQ];
    const int be = blockIdx.x, chunk = blockIdx.y; const float* ar = aff + (long)be * SEQ;
    for (int i = threadIdx.x; i < SEQ; i += 256) a[i] = ar[i];
    __syncthreads();
    const int t = chunk * 256 + threadIdx.x; const float v = a[t]; int cnt = 0;
    for (int j = 0; j < SEQ; ++j) { const float w = a[j]; cnt += (w > v || (w == v && j < t)) ? 1 : 0; }
    rank[(long)be * SEQ + t] = cnt;
    if (cnt < CAP) { idx[be * CAP + cnt] = t; gate[be * CAP + cnt] = v; }
}

__global__ void __launch_bounds__(256) gather_k(const float* __restrict__ h, const int* __restrict__ idx, float* __restrict__ xs, int b) {
    const int ec = blockIdx.x; const int t = idx[b * NE * CAP + ec];
    const float* src = h + ((long)b * SEQ + t) * DM; float* dst = xs + (long)ec * DM;
    for (int c = threadIdx.x; c < DM; c += 256) dst[c] = src[c];
}
__global__ void silu_mul_k(float* a, const float* __restrict__ u, long n) {
    const long i = (long)blockIdx.x * blockDim.x + threadIdx.x; if (i >= n) return;
    const float x = a[i]; a[i] = x / (1.0f + expf(-x)) * u[i];
}
__global__ void __launch_bounds__(256) combine_k(float* x, const float* __restrict__ y, const int* __restrict__ rank, const float* __restrict__ gate, int b) {
    const int t = blockIdx.x; float* xr = x + ((long)b * SEQ + t) * DM;
    float acc[8]; for (int i = 0; i < 8; ++i) acc[i] = xr[threadIdx.x + 256 * i];
    for (int e = 0; e < NE; ++e) {
        const int r = rank[((long)b * NE + e) * SEQ + t];
        if (r < CAP) { const float gt = gate[(b * NE + e) * CAP + r]; const float* yr = y + ((long)e * CAP + r) * DM;
            for (int i = 0; i < 8; ++i) acc[i] += gt * yr[threadIdx.x + 256 * i]; }
    }
    for (int i = 0; i < 8; ++i) xr[threadIdx.x + 256 * i] = acc[i];
}

static void gemm(hipStream_t st, const float* A, long lda, const float* B, long sbk, long sbn, float* C, long ldc, int M, int N, int K,
                 float alpha = 1.f, const float* R = nullptr, int accumulate = 0, int nz1 = 1, int nz2 = 1,
                 long sA1 = 0, long sA2 = 0, long sB1 = 0, long sB2 = 0, long sC1 = 0, long sC2 = 0, const float* cs = nullptr, long sCS2 = 0) {
    GemmP p{}; p.A = A; p.B = B; p.C = C; p.R = R; p.cs = cs; p.M = M; p.N = N; p.K = K; p.nz2 = nz2; p.lda = lda; p.sbk = sbk; p.sbn = sbn; p.ldc = ldc;
    p.sA1 = sA1; p.sA2 = sA2; p.sB1 = sB1; p.sB2 = sB2; p.sC1 = sC1; p.sC2 = sC2; p.sCS2 = sCS2; p.alpha = alpha; p.accumulate = accumulate;
    hipLaunchKernelGGL(sgemm_k, dim3(N / 64, M / 64, nz1 * nz2), dim3(256), 0, st, p);
}

extern "C" void kernel_launch(void* const* d_in, const int* in_sizes, int n_in, void* d_out, int out_size, void* d_ws, size_t ws_size, hipStream_t stream) {
    const float* x_in = (const float*)d_in[0]; const float* mem = (const float*)d_in[1]; const float* mix_norm = (const float*)d_in[2];
    const float* w_in = (const float*)d_in[3]; const float* q_gain = (const float*)d_in[4]; const float* k_gain = (const float*)d_in[5];
    const float* w_four = (const float*)d_in[6]; const float* w_out = (const float*)d_in[7]; const float* pool_w = (const float*)d_in[8];
    const float* pool_scale = (const float*)d_in[9]; const float* cross_norm = (const float*)d_in[10]; const float* mem_norm = (const float*)d_in[11];
    const float* cw_q = (const float*)d_in[12]; const float* cw_k = (const float*)d_in[13]; const float* cw_v = (const float*)d_in[14]; const float* cw_o = (const float*)d_in[15];
    const float* ffn_norm = (const float*)d_in[16]; const float* router_w = (const float*)d_in[17];
    const float* ew_gate = (const float*)d_in[18]; const float* ew_up = (const float*)d_in[19]; const float* ew_down = (const float*)d_in[20];
    const float* final_norm = (const float*)d_in[21];
    float* xc = (float*)d_out;
    float* ws = (float*)d_ws; size_t o = 0;
    auto take = [&](size_t n) { float* p = ws + o; o += (n + 63) / 64 * 64; return p; };
    float* HN = take((size_t)NTOK * DM);
    float* PROJ = take((size_t)NTOK * INW);
    float* MIX = take((size_t)NTOK * DM);
    float* SC = take((size_t)NQH * SEQ * SEQ);
    float* T1 = take((size_t)NTOK * FW); float* T2 = take((size_t)NTOK * FW); float* ZB = take((size_t)NTOK * FW);
    float* CS = take((size_t)SEQ * SEQ); float* SS = take((size_t)SEQ * SEQ); float* CC = take(HD * HD); float* SCc = take(HD * HD);
    float* MEMN = take((size_t)NB * MEML * DM); float* KC = take((size_t)NB * MEML * DM); float* VC = take((size_t)NB * MEML * DM);
    float* AFF = take((size_t)NB * NE * SEQ); int* RANK = (int*)take((size_t)NB * NE * SEQ); int* IDX = (int*)take((size_t)NB * NE * CAP); float* GATE = take((size_t)NB * NE * CAP);
    if (o * 4 > ws_size) { fprintf(stderr, "ws too small: need %zu have %zu\n", o * 4, ws_size); return; }
    float* QC = PROJ; float* OC = MIX;
    float* XS = SC; float* AB = XS + (size_t)NE * CAP * DM; float* UB = AB + (size_t)NE * CAP * EFF; float* YB = UB + (size_t)NE * CAP * EFF;

    hipLaunchKernelGGL(dft_tab_k, dim3((SEQ * SEQ + 255) / 256), dim3(256), 0, stream, CS, SS, SEQ);
    hipLaunchKernelGGL(dft_tab_k, dim3((HD * HD + 255) / 256), dim3(256), 0, stream, CC, SCc, HD);

    for (int layer = 0; layer < 2; ++layer) {
        const float* xr = (layer == 0) ? x_in : xc;
        hipLaunchKernelGGL(rmsnorm_k, dim3(NTOK), dim3(256), 0, stream, xr, mix_norm + layer * DM, HN, DM);
        if (layer == 0) {
            gemm(stream, HN, DM, w_in, INW, 1, PROJ, INW, NTOK, INW, DM);
            hipLaunchKernelGGL(qknorm_rope_k, dim3(NTOK * NQH), dim3(64), 0, stream, PROJ, q_gain, 0, NQH);
            hipLaunchKernelGGL(qknorm_rope_k, dim3(NTOK * NKVH), dim3(64), 0, stream, PROJ, k_gain, AW, NKVH);
            for (int b = 0; b < NB; ++b) {
                const float* pb = PROJ + (size_t)b * SEQ * INW;
                gemm(stream, pb, INW, pb + AW, 1, INW, SC, SEQ, SEQ, SEQ, HD, 1.f, nullptr, 0, NKVH, 3, 3 * HD, HD, HD, 0, 3L * SEQ * SEQ, (long)SEQ * SEQ);
                hipLaunchKernelGGL(softmax_k, dim3(NQH * SEQ), dim3(256), 0, stream, SC, SEQ, 0.08838834764831845f);
                gemm(stream, SC, SEQ, pb + AW + KVW, INW, 1, MIX + (size_t)b * SEQ * DM, DM, SEQ, HD, SEQ, 1.f, nullptr, 0, NKVH, 3,
                     3L * SEQ * SEQ, (long)SEQ * SEQ, HD, 0, 3 * HD, HD);
            }
            gemm(stream, PROJ + AW + 2 * KVW, INW, CC, HD, 1, T1, FW, NTOK, HD, HD, 1.f, nullptr, 0, 1, 4, 0, HD, 0, 0, 0, HD);
            gemm(stream, PROJ + AW + 2 * KVW, INW, SCc, HD, 1, T2, FW, NTOK, HD, HD, 1.f, nullptr, 0, 1, 4, 0, HD, 0, 0, 0, HD);
            gemm(stream, CS, SEQ, T1, FW, 1, ZB, FW, SEQ, FW, SEQ, 1.0f / 512.0f, nullptr, 0, NB, 1, 0, 0, (long)SEQ * FW, 0, (long)SEQ * FW, 0);
            gemm(stream, SS, SEQ, T2, FW, 1, ZB, FW, SEQ, FW, SEQ, -1.0f / 512.0f, nullptr, 1, NB, 1, 0, 0, (long)SEQ * FW, 0, (long)SEQ * FW, 0);
            gemm(stream, ZB, FW, w_four, HD, 1, MIX + AW, DM, NTOK, HD, HD, 1.f, nullptr, 0, 1, 4, 0, HD, 0, (long)HD * HD, 0, HD);
            gemm(stream, MIX, DM, w_out, DM, 1, xc, DM, NTOK, DM, DM, 1.f, xr);
        } else {
            hipLaunchKernelGGL(pool_k, dim3(NTOK), dim3(256), 0, stream, HN, MIX);
            gemm(stream, MIX, DM, pool_w, 512, 1, xc, DM, NTOK, 512, 512, 1.f, xr, 0, 1, 4, 0, 512, 0, 512L * 512, 0, 512, pool_scale, 512);
        }
        hipLaunchKernelGGL(rmsnorm_k, dim3(NTOK), dim3(256), 0, stream, xc, cross_norm + layer * DM, HN, DM);
        hipLaunchKernelGGL(rmsnorm_k, dim3(NB * MEML), dim3(256), 0, stream, mem, mem_norm + layer * DM, MEMN, DM);
        const size_t wl = (size_t)layer * DM * DM;
        gemm(stream, HN, DM, cw_q + wl, DM, 1, QC, DM, NTOK, DM, DM);
        gemm(stream, MEMN, DM, cw_k + wl, DM, 1, KC, DM, NB * MEML, DM, DM);
        gemm(stream, MEMN, DM, cw_v + wl, DM, 1, VC, DM, NB * MEML, DM, DM);
        gemm(stream, QC, DM, KC, 1, DM, SC, MEML, SEQ, MEML, MHD, 1.f, nullptr, 0, NB, NMH, (long)SEQ * DM, MHD, (long)MEML * DM, MHD, (long)NMH * SEQ * MEML, (long)SEQ * MEML);
        hipLaunchKernelGGL(softmax_k, dim3(NB * NMH * SEQ), dim3(256), 0, stream, SC, MEML, 0.04419417382415922f);
        gemm(stream, SC, MEML, VC, DM, 1, OC, DM, SEQ, MHD, MEML, 1.f, nullptr, 0, NB, NMH, (long)NMH * SEQ * MEML, (long)SEQ * MEML, (long)MEML * DM, MHD, (long)SEQ * DM, MHD);
        gemm(stream, OC, DM, cw_o + wl, DM, 1, xc, DM, NTOK, DM, DM, 1.f, xc);
        hipLaunchKernelGGL(rmsnorm_k, dim3(NTOK), dim3(256), 0, stream, xc, ffn_norm + layer * DM, HN, DM);
        hipLaunchKernelGGL(router_k, dim3(NTOK), dim3(64), 0, stream, HN, router_w + (size_t)layer * DM * NE, AFF);
        hipLaunchKernelGGL(rank_k, dim3(NB * NE, SEQ / 256), dim3(256), 0, stream, AFF, RANK, IDX, GATE);
        const size_t el = (size_t)layer * NE * DM * EFF;
        for (int b = 0; b < NB; ++b) {
            hipLaunchKernelGGL(gather_k, dim3(NE * CAP), dim3(256), 0, stream, HN, IDX, XS, b);
            gemm(stream, XS, DM, ew_gate + el, EFF, 1, AB, EFF, CAP, EFF, DM, 1.f, nullptr, 0, 1, NE, 0, (long)CAP * DM, 0, (long)DM * EFF, 0, (long)CAP * EFF);
            gemm(stream, XS, DM, ew_up + el, EFF, 1, UB, EFF, CAP, EFF, DM, 1.f, nullptr, 0, 1, NE, 0, (long)CAP * DM, 0, (long)DM * EFF, 0, (long)CAP * EFF);
            hipLaunchKernelGGL(silu_mul_k, dim3((NE * CAP * EFF + 255) / 256), dim3(256), 0, stream, AB, UB, (long)NE * CAP * EFF);
            gemm(stream, AB, EFF, ew_down + el, DM, 1, YB, DM, CAP, DM, EFF, 1.f, nullptr, 0, 1, NE, 0, (long)CAP * EFF, 0, (long)EFF * DM, 0, (long)CAP * DM);
            hipLaunchKernelGGL(combine_k, dim3(SEQ), dim3(256), 0, stream, xc, YB, RANK, GATE, b);
        }
    }
    hipLaunchKernelGGL(rmsnorm_k, dim3(NTOK), dim3(256), 0, stream, xc, final_norm, xc, DM);
}
```

```cpp
#include <hip/hip_runtime.h>
#include <cstdio>
#include <cstdint>

constexpr int DM = 2048, NB = 4, SEQ = 2048, NTOK = NB * SEQ;
constexpr int HD = 128, NQH = 12, NKVH = 4, AW = NQH * HD, KVW = NKVH * HD, FW = 512, INW = 3072;
constexpr int MEML = 256, NMH = 4, MHD = 512;
constexpr int NE = 16, EFF = 1024, CAP = 256;
constexpr float EPS = 1e-6f;

#define LAS __attribute__((address_space(3)))
#define GAS __attribute__((address_space(1)))
typedef unsigned short bf16_t;
typedef short bf16x8 __attribute__((ext_vector_type(8)));
typedef float f32x4 __attribute__((ext_vector_type(4)));
typedef float f32x2 __attribute__((ext_vector_type(2)));
typedef unsigned u32x4 __attribute__((ext_vector_type(4)));
typedef unsigned u32x2 __attribute__((ext_vector_type(2)));
typedef __bf16 bf16x2_t __attribute__((ext_vector_type(2)));
__device__ __forceinline__ unsigned cvtpk(float lo, float hi) { f32x2 v = {lo, hi}; bf16x2_t b = __builtin_convertvector(v, bf16x2_t); return __builtin_bit_cast(unsigned, b); }
__device__ __forceinline__ float bf2f(unsigned short h) { return __uint_as_float(((unsigned)h) << 16); }
template <class T> __device__ __forceinline__ T* uptr(T* p) { const unsigned long long v = (unsigned long long)p; const unsigned lo = __builtin_amdgcn_readfirstlane((unsigned)v), hi = __builtin_amdgcn_readfirstlane((unsigned)(v >> 32)); return (T*)(((unsigned long long)hi << 32) | lo); }
__device__ __forceinline__ int lane_id() { int l = (int)__builtin_amdgcn_mbcnt_hi(~0u, __builtin_amdgcn_mbcnt_lo(~0u, 0u)); asm volatile("" : "+v"(l)); return l; }
#define LDS_WAIT() asm volatile("s_waitcnt lgkmcnt(0)" ::: "memory")
#define VM_WAIT() asm volatile("s_waitcnt vmcnt(0)" ::: "memory")
#define WG_BAR() do { asm volatile("s_waitcnt lgkmcnt(0)" ::: "memory"); __builtin_amdgcn_s_barrier(); asm volatile("" ::: "memory"); } while (0)

namespace pg8 {
constexpr int BM = 256, BK = 64, HALF = 128, HTB = HALF * BK * 2, STAGE_BYTES = 8 * HTB, NXCD = 8, WGM = 8;
__host__ __device__ __forceinline__ int lds_byte(int r, int c) { const int st = (r >> 4) * 2 + (c >> 5), rr = r & 15, cc = c & 31, ob = rr * 64 + cc * 2; return st * 1024 + (ob ^ (((ob >> 9) & 1) << 5)); }
__host__ __device__ __forceinline__ void stage_rc(int b, int& R, int& C) { const int st = b / 1024, sb = b % 1024, swz = sb ^ (((sb >> 9) & 1) << 5); R = (st >> 1) * 16 + swz / 64; C = (st & 1) * 32 + (swz % 64) / 2; }
__host__ __device__ __forceinline__ int perm32(int rho) { const int n = rho >> 4, i = rho & 15; return 8 * (i >> 2) + 4 * n + (i & 3); }

struct Unit { int pm, pn; const char* a; const char* b; };
struct EpiCtx { int wr, wc, wid; LAS unsigned char* xl; };

template <class Map> struct Sched {
    int nM, nN, nwg, G, c; Map map;
    __device__ __forceinline__ void init(int nM_, int nN_, int G_, int c_, const Map& m) { nM = nM_; nN = nN_; nwg = nM * nN; G = G_; c = c_; map = m; }
    __device__ __forceinline__ bool next(int i, Unit& u) const {
        const long L = (long)i * G + c; if (L >= nwg) return false;
        int wgid = (int)L; { const int q = nwg / NXCD, r = nwg % NXCD, xcd = wgid % NXCD, off = wgid / NXCD; wgid = (xcd < r ? xcd * (q + 1) : r * (q + 1) + (xcd - r) * q) + off; }
        const int nig = WGM * nN, gid = wgid / nig, fm = gid * WGM, gsz = (nM - fm) < WGM ? (nM - fm) : WGM;
        u.pm = fm + ((wgid % nig) % gsz); u.pn = (wgid % nig) / gsz; map(u); return true;
    }
};

template <class Epi, class SchedT, bool SP2>
__device__ __forceinline__ void gemm_phase(const int wave_, LAS unsigned char* lds, LAS unsigned char* xl, const int K, const int lda, const int ldb, const SchedT& S, const Epi& E) {
    constexpr bool ALIGN_EPI = true;
    const int lane = lane_id(), wid = wave_, tid = wid * 64 + lane, wr = wid >> 2, wc = wid & 3, fr = lane & 15, fq = lane >> 4;
    const int nt = K / BK;
    unsigned voffA[2], voffB[2];
#pragma unroll
    for (int i = 0; i < 2; ++i) { int R, C; stage_rc(tid * 16 + i * 8192, R, C); const int Rb = Epi::PERM ? ((R & ~31) + perm32(R & 31)) : R;
        voffA[i] = (unsigned)(R * lda + C * 2); voffB[i] = (unsigned)(Rb * ldb + C * 2); }
    const size_t kstep = (size_t)(BK * 2);
    const size_t hstepA = (size_t)HALF * lda, hstepB = (size_t)HALF * ldb;
    const unsigned ldsw = (unsigned)wid * 1024u;
    const int aoff = lds_byte(wr * 64 + fr, fq * 8), boff = lds_byte(wc * 32 + fr, fq * 8);
#define PG8_SA(b, h) (((b) * 2 + (h)) * HTB)
#define PG8_SB(b, h) ((4 + (b) * 2 + (h)) * HTB)
#define PG8_STAGE(bufoff, gbase, voff) do { _Pragma("unroll") for (int _i = 0; _i < 2; ++_i) \
        __builtin_amdgcn_global_load_lds((const unsigned*)((const char*)(gbase) + (voff)[_i]), (LAS unsigned*)(lds + (bufoff) + ldsw + _i * 8192), 16, 0, 0); } while (0)
#define PG8_LDA(dst, b, h) do { _Pragma("unroll") for (int m = 0; m < 4; ++m) _Pragma("unroll") for (int k = 0; k < 2; ++k) dst[m][k] = *(const LAS bf16x8*)(lds + PG8_SA(b, h) + aoff + m * 2048 + k * 1024); } while (0)
#define PG8_LDB(dst, b, h) do { _Pragma("unroll") for (int n = 0; n < 2; ++n) _Pragma("unroll") for (int k = 0; k < 2; ++k) dst[n][k] = *(const LAS bf16x8*)(lds + PG8_SB(b, h) + boff + n * 2048 + k * 1024); } while (0)
#define PG8_MMA(ai, bj, At, Bt) do { __builtin_amdgcn_s_setprio(1); _Pragma("unroll") for (int m = 0; m < 4; ++m) _Pragma("unroll") for (int n = 0; n < 2; ++n) _Pragma("unroll") for (int k = 0; k < 2; ++k) \
        acc[ai][bj][m][n] = __builtin_amdgcn_mfma_f32_16x16x32_bf16(Bt[n][k], At[m][k], acc[ai][bj][m][n], 0, 0, 0); __builtin_amdgcn_s_setprio(0); } while (0)
#define PG8_WAIT_V(n) asm volatile("s_waitcnt vmcnt(" #n ")" ::: "memory")
#define PG8_WAIT_L(n) asm volatile("s_waitcnt lgkmcnt(" #n ")" ::: "memory")
#define PG8_BAR __builtin_amdgcn_s_barrier()
#define PG8_SCHED __builtin_amdgcn_sched_barrier(0)
    Unit cur, nxt; int ui = 0;
    if (!S.next(0, cur)) return;
    EpiCtx ctx; ctx.wr = wr; ctx.wc = wc; ctx.wid = wid; ctx.xl = xl;
    f32x4 acc[2][2][4][2];
#pragma unroll
    for (int a = 0; a < 2; ++a)
#pragma unroll
        for (int b = 0; b < 2; ++b)
#pragma unroll
            for (int m = 0; m < 4; ++m)
#pragma unroll
                for (int n = 0; n < 2; ++n) acc[a][b][m][n] = (f32x4){0.f, 0.f, 0.f, 0.f};
    bf16x8 At[4][2], B0[2][2], B1[2][2];
    const char* cA = cur.a; const char* cB = cur.b;
    if constexpr (SP2) {
        PG8_STAGE(PG8_SB(0, 0), cB, voffB); PG8_STAGE(PG8_SB(0, 1), cB + hstepB, voffB); PG8_STAGE(PG8_SA(0, 0), cA, voffA); PG8_STAGE(PG8_SA(0, 1), cA + hstepA, voffA);
        if (wr == 1) PG8_BAR;
        PG8_WAIT_V(2); PG8_BAR;
        PG8_STAGE(PG8_SB(1, 0), cB + kstep, voffB); PG8_STAGE(PG8_SA(1, 0), cA + kstep, voffA); PG8_STAGE(PG8_SB(1, 1), cB + hstepB + kstep, voffB);
        PG8_WAIT_V(6); PG8_BAR;
    } else {
        PG8_STAGE(PG8_SB(0, 0), cB, voffB); PG8_STAGE(PG8_SA(0, 0), cA, voffA); PG8_STAGE(PG8_SB(0, 1), cB + hstepB, voffB); PG8_STAGE(PG8_SA(0, 1), cA + hstepA, voffA);
        if (wr == 1) PG8_BAR;
        PG8_WAIT_V(4); PG8_BAR;
        PG8_STAGE(PG8_SB(1, 0), cB + kstep, voffB); PG8_STAGE(PG8_SA(1, 0), cA + kstep, voffA); PG8_STAGE(PG8_SB(1, 1), cB + hstepB + kstep, voffB);
        PG8_WAIT_V(6); PG8_BAR;
    }
    for (;;) {
        const bool has_next = S.next(ui + 1, nxt);
        const char* nA = has_next ? nxt.a : cA; const char* nB = has_next ? nxt.b : cB;
        for (int t = 0; t < nt; t += 2) {
            const bool last = (t == nt - 2);
            const char* a1 = cA + (size_t)(t + 1) * kstep;
            const char* a2 = last ? nA : cA + (size_t)(t + 2) * kstep; const char* b2 = last ? nB : cB + (size_t)(t + 2) * kstep;
            const char* a3 = a2 + kstep; const char* b3 = b2 + kstep;
            if constexpr (SP2) {
            PG8_LDB(B0, 0, 0); PG8_LDB(B1, 0, 1); PG8_SCHED; PG8_LDA(At, 0, 0); PG8_STAGE(PG8_SA(1, 1), a1 + hstepA, voffA);
            PG8_WAIT_V(8); PG8_WAIT_L(0); PG8_BAR; PG8_MMA(0, 0, At, B0); PG8_MMA(0, 1, At, B1); PG8_BAR; PG8_SCHED;
            PG8_LDA(At, 0, 1); PG8_STAGE(PG8_SB(0, 0), b2, voffB); PG8_STAGE(PG8_SB(0, 1), b2 + hstepB, voffB); PG8_STAGE(PG8_SA(0, 0), a2, voffA);
            PG8_WAIT_V(8); PG8_WAIT_L(0); PG8_BAR; PG8_MMA(1, 0, At, B0); PG8_MMA(1, 1, At, B1); PG8_BAR; PG8_SCHED;
            PG8_LDB(B0, 1, 0); PG8_LDB(B1, 1, 1); PG8_SCHED; PG8_LDA(At, 1, 0); PG8_STAGE(PG8_SA(0, 1), a2 + hstepA, voffA);
            PG8_WAIT_V(8); PG8_WAIT_L(0); PG8_BAR; PG8_MMA(0, 0, At, B0); PG8_MMA(0, 1, At, B1); PG8_BAR; PG8_SCHED;
            PG8_LDA(At, 1, 1); PG8_STAGE(PG8_SB(1, 0), b3, voffB); PG8_STAGE(PG8_SB(1, 1), b3 + hstepB, voffB); PG8_STAGE(PG8_SA(1, 0), a3, voffA);
            PG8_WAIT_V(8); PG8_WAIT_L(0); PG8_BAR; PG8_MMA(1, 0, At, B0); PG8_MMA(1, 1, At, B1); PG8_BAR; PG8_SCHED;
            } else {
            PG8_LDB(B0, 0, 0); PG8_SCHED; PG8_LDA(At, 0, 0); PG8_STAGE(PG8_SA(1, 1), a1 + hstepA, voffA);
            PG8_WAIT_L(8); PG8_BAR; PG8_WAIT_L(0); PG8_MMA(0, 0, At, B0); PG8_BAR; PG8_SCHED;
            PG8_LDB(B1, 0, 1); PG8_STAGE(PG8_SB(0, 0), b2, voffB);
            PG8_BAR; PG8_WAIT_L(0); PG8_MMA(0, 1, At, B1); PG8_BAR;
            PG8_LDA(At, 0, 1); PG8_STAGE(PG8_SA(0, 0), a2, voffA);
            PG8_BAR; PG8_WAIT_L(0); PG8_MMA(1, 0, At, B0); PG8_BAR; PG8_SCHED;
            PG8_STAGE(PG8_SB(0, 1), b2 + hstepB, voffB);
            PG8_WAIT_V(6); PG8_BAR; PG8_MMA(1, 1, At, B1); PG8_BAR;
            PG8_LDB(B0, 1, 0); PG8_SCHED; PG8_LDA(At, 1, 0); PG8_STAGE(PG8_SA(0, 1), a2 + hstepA, voffA);
            PG8_WAIT_L(8); PG8_BAR; PG8_WAIT_L(0); PG8_MMA(0, 0, At, B0); PG8_BAR; PG8_SCHED;
            PG8_LDB(B1, 1, 1); PG8_STAGE(PG8_SB(1, 0), b3, voffB);
            PG8_BAR; PG8_WAIT_L(0); PG8_MMA(0, 1, At, B1); PG8_BAR;
            PG8_LDA(At, 1, 1); PG8_STAGE(PG8_SA(1, 0), a3, voffA);
            PG8_BAR; PG8_WAIT_L(0); PG8_MMA(1, 0, At, B0); PG8_BAR; PG8_SCHED;
            PG8_STAGE(PG8_SB(1, 1), b3 + hstepB, voffB);
            PG8_WAIT_V(6); PG8_BAR; PG8_MMA(1, 1, At, B1); PG8_BAR;
            }
        }
        if constexpr (ALIGN_EPI) { if (wr == 0) PG8_BAR; }
        E(acc, cur, ctx);
        if (!has_next) break;
#pragma unroll
        for (int a = 0; a < 2; ++a)
#pragma unroll
            for (int b = 0; b < 2; ++b)
#pragma unroll
                for (int m = 0; m < 4; ++m)
#pragma unroll
                    for (int n = 0; n < 2; ++n) acc[a][b][m][n] = (f32x4){0.f, 0.f, 0.f, 0.f};
        cur = nxt; cA = nA; cB = nB; ++ui;
        if constexpr (ALIGN_EPI) { if (wr == 1) PG8_BAR; }
    }
    PG8_WAIT_V(0);
    if constexpr (!ALIGN_EPI) { if (wr == 0) PG8_BAR; }
    PG8_BAR;
#undef PG8_SA
#undef PG8_SB
#undef PG8_STAGE
#undef PG8_LDA
#undef PG8_LDB
#undef PG8_MMA
#undef PG8_WAIT_V
#undef PG8_WAIT_L
#undef PG8_BAR
#undef PG8_SCHED
}
}

constexpr size_t MiB = 1u << 20;
constexpr size_t WS_CTL = 0, CTL_ZERO_BYTES = 1 * MiB;
constexpr size_t WS_WIN_T = 1 * MiB, WS_WF_T = 11 * MiB, WS_WOUT_T = 15 * MiB, WS_WCQ_T = 23 * MiB, WS_WCK_T = 39 * MiB, WS_WCV_T = 55 * MiB, WS_WCO_T = 71 * MiB;
constexpr size_t WS_WP_T = 87 * MiB, WS_DFT = 89 * MiB, WS_ROPE = 105 * MiB, WS_WGU_T = 106 * MiB, WS_WD_T = 234 * MiB;
constexpr size_t WS_HN = 298 * MiB, WS_XB = 330 * MiB, WS_QB = 362 * MiB, WS_KB = 386 * MiB, WS_VB = 394 * MiB, WS_FPQ = 402 * MiB, WS_MIXB = 418 * MiB, WS_QCB = 450 * MiB;
constexpr size_t WS_KCB = 482 * MiB, WS_VTB = 490 * MiB, WS_MEMNB = 498 * MiB, WS_PB = 506 * MiB, WS_XSB = 522 * MiB, WS_ACTB = 586 * MiB, WS_YB = 618 * MiB;
constexpr size_t WS_SSP = 682 * MiB, WS_AFF = 683 * MiB, WS_RANK = 684 * MiB, WS_GATE = 685 * MiB, WS_FAST_END = 686 * MiB;
constexpr int CW_TMO = 0, CW_CODE = 1, CW_BAR = 4096;
constexpr int RING_OFF = 0, RING_BYTES = 131072, XL_OFF = 131072, XL_BYTES = 14336, LDSCTL_OFF = XL_OFF + XL_BYTES, MISC_OFF = LDSCTL_OFF + 320, LDS_BYTES = 147456;
static_assert(MISC_OFF + 128 <= LDS_BYTES, "LDS map");
constexpr int NWAVES = 8;

typedef GAS unsigned gu32;
#define RLX_AGENT __ATOMIC_RELAXED, __HIP_MEMORY_SCOPE_AGENT

#define XB_TMO      128
#define XB_XCNT(j)  (256  + 64 * (j))
#define XB_XSUB(j)  (1280 + 64 * (j))
#define XB_XGEN(j)  (2304 + 64 * (j))
#define XB_TOP      3328
#define XB_TOPGEN   3392
#define XCD_BAR_WORDS 3456
#define XB_SPIN_CAP (1u << 18)
__device__ __forceinline__ unsigned xb_ld(unsigned* p)              { return __hip_atomic_load(p, __ATOMIC_RELAXED, __HIP_MEMORY_SCOPE_AGENT); }
__device__ __forceinline__ unsigned xb_add(unsigned* p, unsigned v) { return __hip_atomic_fetch_add(p, v, __ATOMIC_RELAXED, __HIP_MEMORY_SCOPE_AGENT); }
__device__ __forceinline__ unsigned xb_xcc_id() { return (unsigned)__builtin_amdgcn_s_getreg((3 << 11) | 20) & 0xFu; }
#define XB_SPIN(cond, bar) do { unsigned _sp = 0; while (cond) { __builtin_amdgcn_s_sleep(1); \
    if ((++_sp & 255u) == 0u) { if (xb_ld(&(bar)[XB_TMO])) break; if (_sp > XB_SPIN_CAP) { atomicAdd(&(bar)[XB_TMO], 1u); break; } } } } while (0)
struct XcdBarrier { unsigned* bar; unsigned x; volatile LAS unsigned* st; int wave; };
__device__ __forceinline__ XcdBarrier xcd_barrier_post(unsigned* bar, volatile LAS unsigned* st, int wave) {
    XcdBarrier b; b.bar = bar; b.x = xb_xcc_id(); b.st = st; b.wave = wave;
    if (wave == 0 && lane_id() == 0) (void)xb_add(&bar[XB_XCNT(b.x)], 1u);
    return b;
}
__device__ __forceinline__ void xcd_barrier_complete(unsigned* bar, unsigned x, unsigned& nloc, unsigned& nx) {
    const unsigned G = gridDim.x * gridDim.y * gridDim.z;
    unsigned sum, cnt, mine, sp = 0u;
    for (;;) {
        sum = 0u; cnt = 0u; mine = 0u;
#pragma unroll
        for (unsigned j = 0; j < 16; ++j) { const unsigned c = xb_ld(&bar[XB_XCNT(j)]); sum += c; cnt += (c > 0u) ? 1u : 0u; mine = (j == x) ? c : mine; }
        if (sum == G) break;
        __builtin_amdgcn_s_sleep(1);
        if ((++sp & 255u) == 0u) { if (xb_ld(&bar[XB_TMO])) break; if (sp > XB_SPIN_CAP) { atomicAdd(&bar[XB_TMO], 1u); break; } }
    }
    nloc = mine > 0u ? mine : 1u; nx = cnt > 0u ? cnt : 1u;
}
__device__ __forceinline__ void xcd_barrier(const XcdBarrier& b) {
    asm volatile("s_waitcnt vmcnt(0)" ::: "memory");
    __syncthreads();
    if (b.wave == 0 && lane_id() == 0) {
        unsigned* bar = b.bar;
        __builtin_amdgcn_s_waitcnt(0);
        unsigned nloc = b.st[0], nx = b.st[1];
        if (nloc == 0u) { xcd_barrier_complete(bar, b.x, nloc, nx); b.st[0] = nloc; b.st[1] = nx; }
        const unsigned old = xb_add(&bar[XB_XSUB(b.x)], 1u);
        const unsigned gen = old / nloc;
        if (old + 1u == (gen + 1u) * nloc) {
            __builtin_amdgcn_fence(__ATOMIC_RELEASE, "agent");
            asm volatile("s_waitcnt vmcnt(0)" ::: "memory");
            const unsigned og = xb_add(&bar[XB_TOP], 1u);
            const unsigned tg = og / nx;
            if (og + 1u == (tg + 1u) * nx) xb_add(&bar[XB_TOPGEN], 1u);
            else XB_SPIN(xb_ld(&bar[XB_TOPGEN]) == tg, bar);
            __builtin_amdgcn_fence(__ATOMIC_ACQUIRE, "agent");
            xb_add(&bar[XB_XGEN(b.x)], 1u);
            asm volatile("s_waitcnt vmcnt(0)" ::: "memory");
        } else {
            XB_SPIN(xb_ld(&bar[XB_XGEN(b.x)]) == gen, bar);
            __builtin_amdgcn_fence(__ATOMIC_ACQUIRE, "agent");
            asm volatile("s_waitcnt vmcnt(0)" ::: "memory");
        }
    }
    __syncthreads();
}

struct Args { const float* in[22]; float* out; unsigned char* ws; int ph_lo, ph_hi, li, pad; };
struct Frame {
    LAS unsigned char* lds; volatile LAS unsigned* MISC; gu32* ctl;
    int wave, vcu, G;
    unsigned char* ws;
};
__device__ __forceinline__ float wave_sum(float v) {
#pragma unroll
    for (int o = 1; o < 64; o <<= 1) v += __shfl_xor(v, o);
    return v;
}
__device__ __forceinline__ void tr_item(const float* __restrict__ W, int ldw, const float* __restrict__ gain, bf16_t* WT, int ldt, int k0, int n0, long drow0, LAS float* scr, int lane) {
#pragma unroll 8
    for (int i = 0; i < 32; ++i) { const int kk = 2 * i + (lane >> 5); float v = W[(size_t)(k0 + kk) * ldw + n0 + (lane & 31)]; if (gain) v *= gain[k0 + kk]; scr[kk * 33 + (lane & 31)] = v; }
    LDS_WAIT(); asm volatile("" ::: "memory");
    const int c = lane & 7;
#pragma unroll
    for (int j = 0; j < 4; ++j) { const int n = (lane >> 3) + 8 * j; const LAS float* s = scr + (8 * c) * 33 + n;
        u32x4 o; o.x = cvtpk(s[0 * 33], s[1 * 33]); o.y = cvtpk(s[2 * 33], s[3 * 33]); o.z = cvtpk(s[4 * 33], s[5 * 33]); o.w = cvtpk(s[6 * 33], s[7 * 33]);
        *(GAS u32x4*)(WT + (size_t)(drow0 + n) * ldt + k0 + 8 * c) = o; }
    LDS_WAIT(); asm volatile("" ::: "memory");
}
__device__ __forceinline__ void rms_row_to_bf16(const float* xrow, const float* __restrict__ gain, bf16_t* orow, int lane) {
    const GAS f32x4* xr = (const GAS f32x4*)xrow + lane; const f32x4* gr = (const f32x4*)gain + lane;
    f32x4 v[8]; float s = 0.f;
#pragma unroll
    for (int j = 0; j < 8; ++j) { v[j] = xr[64 * j]; s += (v[j].x * v[j].x + v[j].y * v[j].y) + (v[j].z * v[j].z + v[j].w * v[j].w); }
    const float r = rsqrtf(wave_sum(s) * (1.f / DM) + EPS);
    GAS u32x2* o8 = (GAS u32x2*)orow + lane;
#pragma unroll
    for (int j = 0; j < 8; ++j) { const f32x4 g = gr[64 * j]; u32x2 w; w.x = cvtpk(v[j].x * r * g.x, v[j].y * r * g.y); w.y = cvtpk(v[j].z * r * g.z, v[j].w * r * g.w); o8[64 * j] = w; }
}

__device__ __forceinline__ void expert_tr_items(const Frame& F, const float* eg, const float* eu, const float* ed, int layer, LAS float* scr) {
    const int e_lane = lane_id();
    const int gw = F.vcu * NWAVES + F.wave, NGW = F.G * NWAVES;
    bf16_t* WGU = (bf16_t*)(F.ws + WS_WGU_T); bf16_t* WD = (bf16_t*)(F.ws + WS_WD_T);
    for (int it = gw; it < NE * 3072; it += NGW) {
        const int e = it / 3072, r = it % 3072; const size_t eo = (size_t)(layer * NE + e);
        if (r < 2048) { const int up = r >> 10, q = r & 1023, kb = q >> 5, nb = q & 31, n0 = nb * 32;
            const float* W = (up ? eu : eg) + eo * DM * EFF; const long drow0 = (long)(n0 >> 7) * 256 + up * 128 + (n0 & 127);
            tr_item(W, EFF, nullptr, WGU + (size_t)e * 2048 * 2048, 2048, kb * 64, n0, drow0, scr, e_lane);
        } else { const int q = r - 2048, kb = q >> 6, nb = q & 63;
            tr_item(ed + eo * EFF * DM, DM, nullptr, WD + (size_t)e * 2048 * 1024, 1024, kb * 64, nb * 32, nb * 32, scr, e_lane); }
    }
}

__device__ __forceinline__ void p0_prologue(Frame& F, const Args& args) {
    const float* x = args.in[0]; const float* mem = args.in[1]; const float* mix_norm = args.in[2]; const float* w_in = args.in[3];
    const float* w_four = args.in[6]; const float* w_out = args.in[7]; const float* pool_w = args.in[8]; const float* cross_norm = args.in[10]; const float* mem_norm = args.in[11];
    const int gw = F.vcu * NWAVES + F.wave, NGW = F.G * NWAVES;
    const int p_lane = lane_id(), p_tid = F.wave * 64 + p_lane;
    { LAS float* tab = (LAS float*)(F.lds + RING_OFF);
      for (int m = p_tid; m < 2048; m += 512) tab[m] = cosf(6.283185307179586f * (float)m * (1.0f / 2048.0f));
      __syncthreads();
      bf16_t* DFT = (bf16_t*)(F.ws + WS_DFT);
      for (int row = F.vcu * 8; row < 2048; row += F.G * 8)
          for (int rr = 0; rr < 8; ++rr) { const int k1 = row + rr; if (k1 >= 2048) break;
              { const int c0 = p_tid * 8; const int which = c0 >> 11, s0 = c0 & 2047; unsigned w[4];
#pragma unroll
                for (int j = 0; j < 4; ++j) { const int ma = (k1 * (s0 + 2 * j)) & 2047, mb = (k1 * (s0 + 2 * j + 1)) & 2047;
                    w[j] = cvtpk(tab[(ma - which * 512) & 2047], tab[(mb - which * 512) & 2047]); }
                *(GAS u32x4*)(DFT + (size_t)k1 * 4096 + c0) = (u32x4){w[0], w[1], w[2], w[3]}; } }
      __syncthreads(); }
    { float* RC = (float*)(F.ws + WS_ROPE); float* RS = RC + SEQ * 64;
      for (int i = F.vcu * 512 + p_tid; i < SEQ * 64; i += F.G * 512) { const int t = i >> 6, p = i & 63; const int pos = (p < 32) ? (t >> 6) : (t & 63); const int j = p & 31;
          const float inv = 1.0f / powf(10000.0f, (float)(2 * j) / 64.0f); const float ang = (float)pos * inv; RC[i] = cosf(ang); RS[i] = sinf(ang); } }
    { LAS float* Mw = (LAS float*)(F.lds + RING_OFF); LAS float* t128 = Mw + 128 * 32;
      bf16_t* WF = (bf16_t*)(F.ws + WS_WF_T);
      for (int it = F.vcu; it < 256; it += F.G) {
          const int which = it >> 7, g = (it >> 5) & 3, d0 = ((it >> 3) & 3) * 32, k0 = (it & 7) * 256;
          if (p_tid < 128) t128[p_tid] = cosf(6.283185307179586f * (float)p_tid * (1.0f / 128.0f));
          __syncthreads();
          { const int c = p_tid >> 2, dd = (p_tid & 3) * 8; float o[8] = {0.f, 0.f, 0.f, 0.f, 0.f, 0.f, 0.f, 0.f};
            for (int k2 = 0; k2 < 128; ++k2) { const int m = (c * k2) & 127; const float tv = which ? -t128[(m - 32) & 127] : t128[m];
                const float* wr_ = w_four + ((size_t)g * 128 + k2) * 128 + d0 + dd; const f32x4 w0 = *(const f32x4*)wr_, w1 = *(const f32x4*)(wr_ + 4);
                o[0] += tv * w0.x; o[1] += tv * w0.y; o[2] += tv * w0.z; o[3] += tv * w0.w; o[4] += tv * w1.x; o[5] += tv * w1.y; o[6] += tv * w1.z; o[7] += tv * w1.w; }
#pragma unroll
            for (int j = 0; j < 8; ++j) Mw[c * 32 + dd + j] = o[j] * (1.0f / 512.0f); }
          __syncthreads();
          { const int kp = p_tid & 127, dq = p_tid >> 7, k = k0 + 2 * kp; float o0[8] = {0.f, 0.f, 0.f, 0.f, 0.f, 0.f, 0.f, 0.f}, o1[8] = {0.f, 0.f, 0.f, 0.f, 0.f, 0.f, 0.f, 0.f};
            const float* r0 = w_in + (size_t)k * INW + 2560 + g * 128; const float* r1 = r0 + INW;
            for (int c4 = 0; c4 < 32; ++c4) { const f32x4 a = *(const f32x4*)(r0 + 4 * c4), b = *(const f32x4*)(r1 + 4 * c4); const float av[4] = {a.x, a.y, a.z, a.w}, bv[4] = {b.x, b.y, b.z, b.w};
#pragma unroll
                for (int cc = 0; cc < 4; ++cc) { const LAS float* mr = Mw + (4 * c4 + cc) * 32 + dq * 8;
#pragma unroll
                    for (int j = 0; j < 8; ++j) { o0[j] += av[cc] * mr[j]; o1[j] += bv[cc] * mr[j]; } } }
#pragma unroll
            for (int j = 0; j < 8; ++j) *(GAS unsigned*)(WF + (size_t)(which * 512 + g * 128 + d0 + dq * 8 + j) * DM + k) = cvtpk(o0[j], o1[j]); }
          __syncthreads(); } }
    { LAS float* scr = (LAS float*)(F.lds + RING_OFF + F.wave * 16384);
      constexpr int I_IN = 32 * 80, I_SQ = 32 * 64, I_P = 32 * 16;
      constexpr int NIT = I_IN + 9 * I_SQ + I_P;
      for (int it = gw; it < NIT; it += NGW) {
          int r = it;
          if (r < I_IN) { tr_item(w_in, INW, nullptr, (bf16_t*)(F.ws + WS_WIN_T), DM, (r / 80) * 64, (r % 80) * 32, (r % 80) * 32, scr, p_lane); continue; } r -= I_IN;
          if (r < I_SQ) { tr_item(w_out, DM, nullptr, (bf16_t*)(F.ws + WS_WOUT_T), DM, (r / 64) * 64, (r % 64) * 32, (r % 64) * 32, scr, p_lane); continue; } r -= I_SQ;
          { const int j = r / I_SQ; if (j < 8) { const int q = r % I_SQ, wsel = j >> 1, layer = j & 1;
              const float* W = args.in[12 + wsel] + (size_t)layer * DM * DM; const size_t wso = (wsel == 0 ? WS_WCQ_T : wsel == 1 ? WS_WCK_T : wsel == 2 ? WS_WCV_T : WS_WCO_T) + (size_t)layer * DM * DM * 2;
              tr_item(W, DM, wsel == 0 ? cross_norm + layer * DM : nullptr, (bf16_t*)(F.ws + wso), DM, (q / 64) * 64, (q % 64) * 32, (q % 64) * 32, scr, p_lane); continue; } r -= 8 * I_SQ; }
          tr_item(pool_w, 512, nullptr, (bf16_t*)(F.ws + WS_WP_T), DM, (r / 16) * 64, (r % 16) * 32, (r % 16) * 32, scr, p_lane);
      }
      expert_tr_items(F, args.in[18], args.in[19], args.in[20], 0, scr); }
    for (int m = gw; m < NTOK; m += NGW) rms_row_to_bf16(x + (size_t)m * DM, mix_norm, (bf16_t*)(F.ws + WS_HN) + (size_t)m * DM, p_lane);
    for (int m = gw; m < 2 * NB * MEML; m += NGW) { const int l = m / (NB * MEML), r = m % (NB * MEML);
        rms_row_to_bf16(mem + (size_t)r * DM, mem_norm + l * DM, (bf16_t*)(F.ws + WS_MEMNB) + (size_t)m * DM, p_lane); }
}

struct MapLin { const char* A; const char* B; size_t as, bs; __device__ __forceinline__ void operator()(pg8::Unit& u) const { u.a = A + (size_t)u.pm * as; u.b = B + (size_t)u.pn * bs; } };

struct EpiQKV {
    static constexpr bool PERM = true;
    bf16_t* Q; bf16_t* K; bf16_t* V; const float* qg; const float* kg; const float* RC; const float* RS;
    __device__ __forceinline__ void operator()(f32x4 (&acc)[2][2][4][2], const pg8::Unit& u, const pg8::EpiCtx& c) const { const int e_lane = lane_id(), e_fr = e_lane & 15, e_fq = e_lane >> 4;
        const int pn = u.pn, hc = c.wc * 32 + e_fq * 8, rl0 = c.wr * 64 + e_fr;
        if (pn >= 8) {
            bf16_t* base = V + (size_t)(u.pm * 256 + rl0) * KVW + (pn - 8) * 256 + hc;
#pragma unroll
            for (int ai = 0; ai < 2; ++ai)
#pragma unroll
                for (int m = 0; m < 4; ++m) { bf16_t* rowp = base + (size_t)(ai * 128 + m * 16) * KVW;
#pragma unroll
                    for (int bj = 0; bj < 2; ++bj) { const f32x4 v0 = acc[ai][bj][m][0], v1 = acc[ai][bj][m][1];
                        *(u32x4*)(rowp + bj * 128) = (u32x4){cvtpk(v0.x, v0.y), cvtpk(v0.z, v0.w), cvtpk(v1.x, v1.y), cvtpk(v1.z, v1.w)}; } }
            return;
        }
        LAS float* part = (LAS float*)c.xl;
#pragma unroll
        for (int ai = 0; ai < 2; ++ai)
#pragma unroll
            for (int m = 0; m < 4; ++m)
#pragma unroll
                for (int bj = 0; bj < 2; ++bj) { const f32x4 v0 = acc[ai][bj][m][0], v1 = acc[ai][bj][m][1];
                    float s = (v0.x * v0.x + v0.y * v0.y) + (v0.z * v0.z + v0.w * v0.w) + (v1.x * v1.x + v1.y * v1.y) + (v1.z * v1.z + v1.w * v1.w);
                    s += __shfl_xor(s, 16); s += __shfl_xor(s, 32);
                    if (e_fq == 0) part[((ai * 128 + rl0 + m * 16) * 2 + bj) * 4 + c.wc] = s; }
        WG_BAR();
        const float* gain = pn < 6 ? qg : kg;
        const f32x4 g0 = *(const f32x4*)(gain + hc), g1 = *(const f32x4*)(gain + hc + 4);
        bf16_t* O = pn < 6 ? Q : K; const int ld = pn < 6 ? AW : KVW; const int colbase = (pn < 6 ? pn : pn - 6) * 256 + hc;
#pragma unroll
        for (int ai = 0; ai < 2; ++ai)
#pragma unroll
            for (int m = 0; m < 4; ++m) { const int rl = ai * 128 + rl0 + m * 16, row = u.pm * 256 + rl, sp = row & (SEQ - 1);
                const f32x4 cs = *(const f32x4*)(RC + sp * 64 + (hc >> 1)), sn = *(const f32x4*)(RS + sp * 64 + (hc >> 1));
#pragma unroll
                for (int bj = 0; bj < 2; ++bj) { const f32x4 p4 = *(const LAS f32x4*)(part + (rl * 2 + bj) * 4);
                    const float r = rsqrtf(((p4.x + p4.y) + (p4.z + p4.w)) * (1.0f / 128.0f) + EPS);
                    const f32x4 v0 = acc[ai][bj][m][0] * r * g0, v1 = acc[ai][bj][m][1] * r * g1;
                    u32x4 w; w.x = cvtpk(v0.x * cs.x - v0.y * sn.x, v0.x * sn.x + v0.y * cs.x); w.y = cvtpk(v0.z * cs.y - v0.w * sn.y, v0.z * sn.y + v0.w * cs.y);
                    w.z = cvtpk(v1.x * cs.z - v1.y * sn.z, v1.x * sn.z + v1.y * cs.z); w.w = cvtpk(v1.z * cs.w - v1.w * sn.w, v1.z * sn.w + v1.w * cs.w);
                    *(u32x4*)(O + (size_t)row * ld + colbase + bj * 128) = w; } }
    }
};


template <class AddrF> struct EpiStore {
    static constexpr bool PERM = true; AddrF f;
    __device__ __forceinline__ void operator()(f32x4 (&acc)[2][2][4][2], const pg8::Unit& u, const pg8::EpiCtx& c) const { const int e_lane = lane_id(), e_fr = e_lane & 15, e_fq = e_lane >> 4;
        const int hc = c.wc * 32 + e_fq * 8, rl0 = c.wr * 64 + e_fr;
#pragma unroll
        for (int ai = 0; ai < 2; ++ai)
#pragma unroll
            for (int m = 0; m < 4; ++m)
#pragma unroll
                for (int bj = 0; bj < 2; ++bj) { const f32x4 v0 = acc[ai][bj][m][0], v1 = acc[ai][bj][m][1];
                    *(u32x4*)f(u, ai * 128 + rl0 + m * 16, bj * 128 + hc) = (u32x4){cvtpk(v0.x, v0.y), cvtpk(v0.z, v0.w), cvtpk(v1.x, v1.y), cvtpk(v1.z, v1.w)}; }
    }
};
struct AddrF1 { bf16_t* FPQ; __device__ __forceinline__ bf16_t* operator()(const pg8::Unit& u, int rl, int tc) const {
    const int r = u.pm * 256 + rl, which = r >> 9, n = r & 511, cidx = u.pn * 256 + tc, b = cidx >> 11, s = cidx & 2047; return FPQ + (((size_t)(b * 512 + n) * 2 + which) * 2048 + s); } };
struct AddrF2 { bf16_t* MIX; __device__ __forceinline__ bf16_t* operator()(const pg8::Unit& u, int rl, int tc) const {
    const int row = (u.pn >> 1) * 2048 + u.pm * 256 + rl, col = AW + (u.pn & 1) * 256 + tc; return MIX + (size_t)row * DM + col; } };

struct EpiRes {
    static constexpr bool PERM = false;
    const float* base; float* out; bf16_t* xb; float* ssp; const float* cscale; int npn;
    __device__ __forceinline__ void operator()(f32x4 (&acc)[2][2][4][2], const pg8::Unit& u, const pg8::EpiCtx& c) const { const int e_lane = lane_id(), e_fr = e_lane & 15, e_fq = e_lane >> 4;
        const int col0 = u.pn * 256 + c.wc * 32 + 4 * e_fq, rl0 = c.wr * 64 + e_fr;
        LAS float* part = (LAS float*)c.xl;
#pragma unroll
        for (int ai = 0; ai < 2; ++ai)
#pragma unroll
            for (int m = 0; m < 4; ++m) { const int rl = ai * 128 + rl0 + m * 16; const size_t off = (size_t)(u.pm * 256 + rl) * DM + col0; float s = 0.f;
#pragma unroll
                for (int bj = 0; bj < 2; ++bj)
#pragma unroll
                    for (int n = 0; n < 2; ++n) { const size_t o2 = off + bj * 128 + n * 16; f32x4 v = acc[ai][bj][m][n];
                        if (cscale) v = v * *(const f32x4*)(cscale + col0 + bj * 128 + n * 16);
                        v = v + *(const f32x4*)(base + o2);
                        *(f32x4*)(out + o2) = v;
                        if (xb) { *(u32x2*)(xb + o2) = (u32x2){cvtpk(v.x, v.y), cvtpk(v.z, v.w)}; s += (v.x * v.x + v.y * v.y) + (v.z * v.z + v.w * v.w); } }
                if (xb) { s += __shfl_xor(s, 16); s += __shfl_xor(s, 32); if (e_fq == 0) part[rl * 4 + c.wc] = s; }
                asm volatile("" ::: "memory"); }
        if (xb) { WG_BAR();
            if (e_lane < 32) { const int row = c.wid * 32 + e_lane; const f32x4 p4 = *(const LAS f32x4*)(part + row * 4);
                ssp[(size_t)(u.pm * 256 + row) * npn + u.pn] = (p4.x + p4.y) + (p4.z + p4.w); }
            WG_BAR(); }
    }
};

namespace attn {
using s16x4 = __attribute__((ext_vector_type(4))) short;
using f32x16 = __attribute__((ext_vector_type(16))) float;
constexpr int D = 128, NW = 8, QBLK = 32, KVBLK = 64;
constexpr float SCALE = 0.088388347648318440f;
constexpr float THR = 0.f;
#ifndef ATT_SDEPTH
#define ATT_SDEPTH 1
#endif
constexpr int LDQ = AW, LDK = KVW, LDO = DM;
constexpr size_t SHM_V = KVBLK * D * 2, SHM_K = KVBLK * D * 2, SHM_ATTN = 2 * SHM_V + 2 * SHM_K + NW * 64 * 4;
#define KSWZ(row, colB) ((row) * 256 + ((colB) ^ (((row) & 7) << 4)))
#define SBAR() __builtin_amdgcn_sched_barrier(0)
__device__ __forceinline__ int crow(int r, int hi) { return (r & 3) + 8 * (r >> 2) + 4 * hi; }
__device__ __forceinline__ unsigned cvtpk_a(float lo, float hi) { unsigned r; asm volatile("v_cvt_pk_bf16_f32 %0, %1, %2" : "=v"(r) : "v"(lo), "v"(hi)); return r; }
__device__ __forceinline__ void partialSM(f32x16& p0, f32x16& p1, float& m_reg, float& mn, float& alpha) {
  constexpr float C = SCALE * 1.4426950408889634f;
  float pmax = p0[0]; for (int r = 1; r < 16; ++r) pmax = fmaxf(pmax, p0[r]); for (int r = 0; r < 16; ++r) pmax = fmaxf(pmax, p1[r]);
  { auto rr = __builtin_amdgcn_permlane32_swap(__float_as_uint(pmax), __float_as_uint(pmax), false, false);
    pmax = fmaxf(__uint_as_float(rr[0]), __uint_as_float(rr[1])); }
  if (__builtin_expect(__all(pmax - m_reg <= THR / SCALE), 1)) { mn = m_reg; alpha = 1.f; }
  else { mn = fmaxf(m_reg, pmax); alpha = __builtin_amdgcn_exp2f((m_reg - mn) * C); m_reg = mn; }
  float mnC = -mn * C;
  for (int r = 0; r < 16; ++r) p0[r] = fmaf(p0[r], C, mnC); for (int r = 0; r < 16; ++r) p1[r] = fmaf(p1[r], C, mnC);
  for (int r = 0; r < 16; ++r) p0[r] = __builtin_amdgcn_exp2f(p0[r]);
}
__device__ __forceinline__ void finishSM(f32x16& p0, f32x16& p1, float alpha, float& l_reg, bf16x8& pa0, bf16x8& pa1, bf16x8& pa2, bf16x8& pa3) {
  for (int r = 0; r < 16; ++r) p1[r] = __builtin_amdgcn_exp2f(p1[r]);
  float ps = 0; for (int r = 0; r < 16; ++r) ps += p0[r]; for (int r = 0; r < 16; ++r) ps += p1[r];
  { auto rr = __builtin_amdgcn_permlane32_swap(__float_as_uint(ps), __float_as_uint(ps), false, false);
    ps = __uint_as_float(rr[0]) + __uint_as_float(rr[1]); }
  l_reg = l_reg * alpha + ps;
#define PK4(P, BASE, OUT) do { unsigned a0 = cvtpk_a(P[BASE + 0], P[BASE + 1]), a1 = cvtpk_a(P[BASE + 2], P[BASE + 3]);   \
    unsigned b0 = cvtpk_a(P[BASE + 4], P[BASE + 5]), b1 = cvtpk_a(P[BASE + 6], P[BASE + 7]);                              \
    auto r0 = __builtin_amdgcn_permlane32_swap(a0, b0, false, false); auto r1 = __builtin_amdgcn_permlane32_swap(a1, b1, false, false); \
    u32x4 w = {r0[0], r1[0], r0[1], r1[1]}; OUT = *reinterpret_cast<bf16x8*>(&w); } while (0)
  PK4(p0, 0, pa0); PK4(p0, 8, pa1); PK4(p1, 0, pa2); PK4(p1, 8, pa3);
#undef PK4
}
__device__ __forceinline__ void qkt(f32x16& p0, f32x16& p1, const bf16_t* Ks, const bf16x8* qr, int r32, int hi) {
  p0 = f32x16{}; p1 = f32x16{};
  for (int d0 = 0; d0 < 8; ++d0) { int cb = (d0 * 16 + hi * 8) * 2;
    bf16x8 b0 = *reinterpret_cast<const bf16x8*>((const char*)Ks + KSWZ(r32, cb));
    bf16x8 b1 = *reinterpret_cast<const bf16x8*>((const char*)Ks + KSWZ(32 + r32, cb));
    p0 = __builtin_amdgcn_mfma_f32_32x32x16_bf16(b0, qr[d0], p0, 0, 0, 0);
    p1 = __builtin_amdgcn_mfma_f32_32x32x16_bf16(b1, qr[d0], p1, 0, 0, 0); }
}
__device__ __forceinline__ int v_st(int k, int c) { const int kk = (k & ~0xC) | ((k & 4) << 1) | ((k & 8) >> 1); return ((kk >> 3) * 4 + (c >> 5)) * 512 + ((kk & 7) * 32 + (c & 31)) * 2; }
__device__ __forceinline__ int v_rd_base(int lane) { return ((lane & 3) << 3) | (((lane >> 2) & 3) << 6) | (((lane >> 4) & 1) << 5) | (((lane >> 5) & 1) << 8); }
constexpr int v_rd_off(int d0, int ks, int half) { return d0 * 512 + ks * 4096 + half * 2048; }
template <int OFF> __device__ __forceinline__ s16x4 tr_read(int vb) {
  s16x4 r; asm volatile("ds_read_b64_tr_b16 %0, %1 offset:%2" : "=&v"(r) : "v"(vb), "i"(OFF) : "memory"); return r;
}
template <int D0> __device__ __forceinline__ void pv_one(f32x16& od, int vb, bf16x8 pa0, bf16x8 pa1, bf16x8 pa2, bf16x8 pa3) {
  const s16x4 l0 = tr_read<v_rd_off(D0, 0, 0)>(vb), h0 = tr_read<v_rd_off(D0, 0, 1)>(vb), l1 = tr_read<v_rd_off(D0, 1, 0)>(vb), h1 = tr_read<v_rd_off(D0, 1, 1)>(vb);
  const s16x4 l2 = tr_read<v_rd_off(D0, 2, 0)>(vb), h2 = tr_read<v_rd_off(D0, 2, 1)>(vb), l3 = tr_read<v_rd_off(D0, 3, 0)>(vb), h3 = tr_read<v_rd_off(D0, 3, 1)>(vb);
  asm volatile("s_waitcnt lgkmcnt(0)" ::: "memory"); SBAR();
#define PK(L, H) (bf16x8){L[0], L[1], L[2], L[3], H[0], H[1], H[2], H[3]}
  od = __builtin_amdgcn_mfma_f32_32x32x16_bf16(pa0, PK(l0, h0), od, 0, 0, 0);
  od = __builtin_amdgcn_mfma_f32_32x32x16_bf16(pa1, PK(l1, h1), od, 0, 0, 0);
  od = __builtin_amdgcn_mfma_f32_32x32x16_bf16(pa2, PK(l2, h2), od, 0, 0, 0);
  od = __builtin_amdgcn_mfma_f32_32x32x16_bf16(pa3, PK(l3, h3), od, 0, 0, 0);
#undef PK
}
__device__ __forceinline__ void pv_d0(f32x16* o, int vb, bf16x8 pa0, bf16x8 pa1, bf16x8 pa2, bf16x8 pa3) {
  pv_one<0>(o[0], vb, pa0, pa1, pa2, pa3); pv_one<1>(o[1], vb, pa0, pa1, pa2, pa3); pv_one<2>(o[2], vb, pa0, pa1, pa2, pa3); pv_one<3>(o[3], vb, pa0, pa1, pa2, pa3);
}
__device__ __forceinline__ void attn_dense_body(const bf16_t* __restrict__ Qb, const bf16_t* __restrict__ Kh, const bf16_t* __restrict__ Vh,
                                                bf16_t* __restrict__ Ob, int seq, char* lds, const int wave_) {
  constexpr int SDEPTH = ATT_SDEPTH;
  const int lane = lane_id(), wid = wave_, tid = wid * 64 + lane, r32 = lane & 31, hi = lane >> 5;
  bf16_t* V_lds = (bf16_t*)lds; bf16_t* K_lds = (bf16_t*)(lds + 2 * SHM_V);
  float* ws = (float*)(lds + 2 * SHM_V + 2 * SHM_K) + wid * 64; float* li_l = ws; float* al_l = ws + 32;
  float m_reg = -1e30f, l_reg = 0; f32x16 o[4] = {}; bf16x8 qr[8];
  const bf16_t* Qw = Qb + (long)(wid * QBLK + r32) * LDQ + hi * 8;
#pragma unroll
  for (int d0 = 0; d0 < 8; ++d0) qr[d0] = *reinterpret_cast<const bf16x8*>(Qw + d0 * 16);
  const int sr = tid >> 4, sc = (tid & 15) * 8, vst0 = v_st(sr, sc), vst1 = v_st(32 + sr, sc);
  const int vb0 = (int)(uintptr_t)V_lds + v_rd_base(lane);
  struct { bf16x8 vs0, vs1, ks0, ks1; } sr_[SDEPTH];
#define SLOAD(i, k0) do { sr_[i].vs0 = *reinterpret_cast<const bf16x8*>(&Vh[(long)((k0) + sr) * LDK + sc]); sr_[i].vs1 = *reinterpret_cast<const bf16x8*>(&Vh[(long)((k0) + 32 + sr) * LDK + sc]); \
    sr_[i].ks0 = *reinterpret_cast<const bf16x8*>(&Kh[(long)((k0) + sr) * LDK + sc]); sr_[i].ks1 = *reinterpret_cast<const bf16x8*>(&Kh[(long)((k0) + 32 + sr) * LDK + sc]); } while (0)
#define SWRITE(b, i) do { *(bf16x8*)((char*)V_lds + (b) * SHM_V + vst0) = sr_[i].vs0;          \
    *(bf16x8*)((char*)V_lds + (b) * SHM_V + vst1) = sr_[i].vs1; int kc = sc * 2;               \
    *(bf16x8*)((char*)K_lds + (b) * SHM_K + KSWZ(sr, kc)) = sr_[i].ks0;                       \
    *(bf16x8*)((char*)K_lds + (b) * SHM_K + KSWZ(32 + sr, kc)) = sr_[i].ks1; } while (0)
#define SWAIT() do { if constexpr (SDEPTH == 2) asm volatile("s_waitcnt vmcnt(4)" ::: "memory"); else asm volatile("s_waitcnt vmcnt(0)" ::: "memory"); } while (0)
#define RESC(a) do { if (__any((a) < 1.f)) { if (hi == 0) al_l[r32] = (a); asm volatile("s_waitcnt lgkmcnt(0)" ::: "memory"); \
    for (int d = 0; d < 4; ++d) for (int r = 0; r < 16; ++r) o[d][r] *= al_l[crow(r, hi)]; } } while (0)
  f32x16 pA0, pA1, pB0, pB1; float mnA, mnB, alA, alB; bf16x8 pa0, pa1, pa2, pa3; const int NT = seq / KVBLK;
  constexpr int SE = 0, SO = SDEPTH - 1;
  SLOAD(SE, 0); asm volatile("s_waitcnt vmcnt(0)" ::: "memory"); SWRITE(0, SE); __syncthreads();
  qkt(pA0, pA1, K_lds, qr, r32, hi); partialSM(pA0, pA1, m_reg, mnA, alA);
  SLOAD(SO, KVBLK); if constexpr (SDEPTH == 2) { if (2 < NT) SLOAD(SE, 2 * KVBLK); }
  SWAIT(); SWRITE(1, SO); __syncthreads();
  for (int j = 1; j + 1 < NT; j += 2) {
    SBAR(); qkt(pB0, pB1, (bf16_t*)((char*)K_lds + SHM_K), qr, r32, hi);
    finishSM(pA0, pA1, alA, l_reg, pa0, pa1, pa2, pa3); SBAR();
    SLOAD(SO, (j + SDEPTH) * KVBLK); SBAR();
    pv_d0(o, vb0, pa0, pa1, pa2, pa3); partialSM(pB0, pB1, m_reg, mnB, alB);
    __syncthreads(); SWAIT(); SWRITE(0, SE);
    RESC(alB); __syncthreads();
    SBAR(); qkt(pA0, pA1, K_lds, qr, r32, hi);
    finishSM(pB0, pB1, alB, l_reg, pa0, pa1, pa2, pa3); SBAR();
    if (SDEPTH == 1 || j + 3 < NT) SLOAD(SE, (j + 1 + SDEPTH) * KVBLK); SBAR();
    pv_d0(o, vb0 + (int)SHM_V, pa0, pa1, pa2, pa3); partialSM(pA0, pA1, m_reg, mnA, alA);
    __syncthreads(); SWAIT(); SWRITE(1, SO);
    RESC(alA); __syncthreads();
  }
  SBAR(); qkt(pB0, pB1, (bf16_t*)((char*)K_lds + SHM_K), qr, r32, hi);
  finishSM(pA0, pA1, alA, l_reg, pa0, pa1, pa2, pa3); SBAR();
  pv_d0(o, vb0, pa0, pa1, pa2, pa3); partialSM(pB0, pB1, m_reg, mnB, alB);
  __syncthreads(); RESC(alB);
  finishSM(pB0, pB1, alB, l_reg, pa0, pa1, pa2, pa3); SBAR();
  pv_d0(o, vb0 + (int)SHM_V, pa0, pa1, pa2, pa3);
  if (hi == 0) li_l[r32] = l_reg; asm volatile("s_waitcnt lgkmcnt(0)" ::: "memory");
  float rli[16];
#pragma unroll
  for (int r = 0; r < 16; ++r) rli[r] = __builtin_amdgcn_rcpf(li_l[crow(r, hi)]);
  bf16_t* Ow = Ob + (long)(wid * QBLK) * LDO;
#pragma unroll
  for (int r = 0; r < 16; ++r) { int orow = crow(r, hi);
    for (int d0 = 0; d0 < 4; ++d0) Ow[(long)orow * LDO + d0 * 32 + r32] = (bf16_t)(cvtpk(o[d0][r] * rli[r], 0.f) & 0xffffu); }
#undef SLOAD
#undef SWRITE
#undef SWAIT
#undef RESC
  __syncthreads();
}
#undef KSWZ
#undef SBAR
}

struct AddrLin { bf16_t* O; int ld; __device__ __forceinline__ bf16_t* operator()(const pg8::Unit& u, int rl, int tc) const { return O + (size_t)(u.pm * 256 + rl) * ld + u.pn * 256 + tc; } };
struct EpiRowScale {
    static constexpr bool PERM = true; bf16_t* O; int ld; const float* ssp; float cscale;
    __device__ __forceinline__ void operator()(f32x4 (&acc)[2][2][4][2], const pg8::Unit& u, const pg8::EpiCtx& c) const { const int e_lane = lane_id(), e_fr = e_lane & 15, e_fq = e_lane >> 4;
        const int hc = c.wc * 32 + e_fq * 8, rl0 = c.wr * 64 + e_fr;
#pragma unroll
        for (int ai = 0; ai < 2; ++ai)
#pragma unroll
            for (int m = 0; m < 4; ++m) { const int row = u.pm * 256 + ai * 128 + rl0 + m * 16; const f32x4 p0 = *(const f32x4*)(ssp + (size_t)row * 8), p1 = *(const f32x4*)(ssp + (size_t)row * 8 + 4);
                const float r = rsqrtf((((p0.x + p0.y) + (p0.z + p0.w)) + ((p1.x + p1.y) + (p1.z + p1.w))) * (1.0f / DM) + EPS) * cscale;
#pragma unroll
                for (int bj = 0; bj < 2; ++bj) { const f32x4 v0 = acc[ai][bj][m][0] * r, v1 = acc[ai][bj][m][1] * r;
                    *(u32x4*)(O + (size_t)row * ld + u.pn * 256 + bj * 128 + hc) = (u32x4){cvtpk(v0.x, v0.y), cvtpk(v0.z, v0.w), cvtpk(v1.x, v1.y), cvtpk(v1.z, v1.w)}; } }
    }
};
struct EpiSoftmax {
    static constexpr bool PERM = true; bf16_t* P; int ld;
    __device__ __forceinline__ void operator()(f32x4 (&acc)[2][2][4][2], const pg8::Unit& u, const pg8::EpiCtx& c) const { const int e_lane = lane_id(), e_fr = e_lane & 15, e_fq = e_lane >> 4;
        const int hc = c.wc * 32 + e_fq * 8, rl0 = c.wr * 64 + e_fr;
        LAS float* pmx = (LAS float*)c.xl; LAS float* psm = pmx + 1024;
#pragma unroll
        for (int ai = 0; ai < 2; ++ai)
#pragma unroll
            for (int m = 0; m < 4; ++m) { float mx = -3.0e38f;
#pragma unroll
                for (int bj = 0; bj < 2; ++bj)
#pragma unroll
                    for (int n = 0; n < 2; ++n) { const f32x4 v = acc[ai][bj][m][n]; mx = fmaxf(fmaxf(mx, fmaxf(v.x, v.y)), fmaxf(v.z, v.w)); }
                mx = fmaxf(mx, __shfl_xor(mx, 16)); mx = fmaxf(mx, __shfl_xor(mx, 32));
                if (e_fq == 0) pmx[(ai * 128 + rl0 + m * 16) * 4 + c.wc] = mx; }
        WG_BAR();
#pragma unroll
        for (int ai = 0; ai < 2; ++ai)
#pragma unroll
            for (int m = 0; m < 4; ++m) { const int rl = ai * 128 + rl0 + m * 16; const f32x4 p4 = *(const LAS f32x4*)(pmx + rl * 4);
                const float mx = fmaxf(fmaxf(p4.x, p4.y), fmaxf(p4.z, p4.w)) * 1.4426950408889634f; float s = 0.f;
#pragma unroll
                for (int bj = 0; bj < 2; ++bj)
#pragma unroll
                    for (int n = 0; n < 2; ++n) { f32x4 v = acc[ai][bj][m][n];
                        v.x = __builtin_amdgcn_exp2f(fmaf(v.x, 1.4426950408889634f, -mx)); v.y = __builtin_amdgcn_exp2f(fmaf(v.y, 1.4426950408889634f, -mx));
                        v.z = __builtin_amdgcn_exp2f(fmaf(v.z, 1.4426950408889634f, -mx)); v.w = __builtin_amdgcn_exp2f(fmaf(v.w, 1.4426950408889634f, -mx));
                        s += (v.x + v.y) + (v.z + v.w); acc[ai][bj][m][n] = v; }
                s += __shfl_xor(s, 16); s += __shfl_xor(s, 32);
                if (e_fq == 0) psm[rl * 4 + c.wc] = s; }
        WG_BAR();
#pragma unroll
        for (int ai = 0; ai < 2; ++ai)
#pragma unroll
            for (int m = 0; m < 4; ++m) { const int rl = ai * 128 + rl0 + m * 16; const f32x4 p4 = *(const LAS f32x4*)(psm + rl * 4);
                const float inv = 1.0f / ((p4.x + p4.y) + (p4.z + p4.w));
#pragma unroll
                for (int bj = 0; bj < 2; ++bj) { const f32x4 v0 = acc[ai][bj][m][0] * inv, v1 = acc[ai][bj][m][1] * inv;
                    *(u32x4*)(P + (size_t)(u.pm * 256 + rl) * ld + u.pn * 256 + bj * 128 + hc) = (u32x4){cvtpk(v0.x, v0.y), cvtpk(v0.z, v0.w), cvtpk(v1.x, v1.y), cvtpk(v1.z, v1.w)}; } }
        WG_BAR();
    }
};
struct MapXS { const char* Q; const char* K; __device__ __forceinline__ void operator()(pg8::Unit& u) const {
    u.a = Q + ((size_t)u.pm * 256 * DM + (size_t)u.pn * MHD) * 2; u.b = K + ((size_t)(u.pm >> 3) * MEML * DM + (size_t)u.pn * MHD) * 2; } };
struct MapXPV { const char* P; const char* VT; __device__ __forceinline__ void operator()(pg8::Unit& u) const {
    u.a = P + ((size_t)u.pm * 256 * 1024 + (size_t)(u.pn >> 1) * MEML) * 2; u.b = VT + ((size_t)u.pn * 256 * 1024 + (size_t)(u.pm >> 3) * MEML) * 2; } };

struct MapMoE { const char* A; const char* W; size_t as, es, ws_; __device__ __forceinline__ void operator()(pg8::Unit& u) const {
    u.a = A + (size_t)u.pm * as; u.b = W + (size_t)(u.pm >> 2) * es + (size_t)u.pn * ws_; } };
struct EpiSwiGLU {
    static constexpr bool PERM = true; bf16_t* ACT;
    __device__ __forceinline__ void operator()(f32x4 (&acc)[2][2][4][2], const pg8::Unit& u, const pg8::EpiCtx& c) const { const int e_lane = lane_id(), e_fr = e_lane & 15, e_fq = e_lane >> 4;
        const int hc = c.wc * 32 + e_fq * 8, rl0 = c.wr * 64 + e_fr;
#pragma unroll
        for (int ai = 0; ai < 2; ++ai)
#pragma unroll
            for (int m = 0; m < 4; ++m) { f32x4 o[2];
#pragma unroll
                for (int n = 0; n < 2; ++n) { const f32x4 g = acc[ai][0][m][n], up = acc[ai][1][m][n]; f32x4 r;
                    r.x = g.x * __builtin_amdgcn_rcpf(1.0f + __builtin_amdgcn_exp2f(-1.4426950408889634f * g.x)) * up.x; r.y = g.y * __builtin_amdgcn_rcpf(1.0f + __builtin_amdgcn_exp2f(-1.4426950408889634f * g.y)) * up.y;
                    r.z = g.z * __builtin_amdgcn_rcpf(1.0f + __builtin_amdgcn_exp2f(-1.4426950408889634f * g.z)) * up.z; r.w = g.w * __builtin_amdgcn_rcpf(1.0f + __builtin_amdgcn_exp2f(-1.4426950408889634f * g.w)) * up.w; o[n] = r; }
                *(u32x4*)(ACT + (size_t)(u.pm * 256 + ai * 128 + rl0 + m * 16) * EFF + u.pn * 128 + hc) = (u32x4){cvtpk(o[0].x, o[0].y), cvtpk(o[0].z, o[0].w), cvtpk(o[1].x, o[1].y), cvtpk(o[1].z, o[1].w)}; }
    }
};
struct EpiRowGate {
    static constexpr bool PERM = true; bf16_t* Y; const float* gate;
    __device__ __forceinline__ void operator()(f32x4 (&acc)[2][2][4][2], const pg8::Unit& u, const pg8::EpiCtx& c) const { const int e_lane = lane_id(), e_fr = e_lane & 15, e_fq = e_lane >> 4;
        const int hc = c.wc * 32 + e_fq * 8, rl0 = c.wr * 64 + e_fr;
#pragma unroll
        for (int ai = 0; ai < 2; ++ai)
#pragma unroll
            for (int m = 0; m < 4; ++m) { const int row = u.pm * 256 + ai * 128 + rl0 + m * 16; const float gt = gate[row];
#pragma unroll
                for (int bj = 0; bj < 2; ++bj) { const f32x4 v0 = acc[ai][bj][m][0] * gt, v1 = acc[ai][bj][m][1] * gt;
                    *(u32x4*)(Y + (size_t)row * DM + u.pn * 256 + bj * 128 + hc) = (u32x4){cvtpk(v0.x, v0.y), cvtpk(v0.z, v0.w), cvtpk(v1.x, v1.y), cvtpk(v1.z, v1.w)}; } }
    }
};
__device__ __forceinline__ float rms_row_to_bf16_r(const float* xrow, const float* __restrict__ gain, bf16_t* orow, int lane) {
    const GAS f32x4* xr = (const GAS f32x4*)xrow + lane; const f32x4* gr = (const f32x4*)gain + lane;
    f32x4 v[8]; float s = 0.f;
#pragma unroll
    for (int j = 0; j < 8; ++j) { v[j] = xr[64 * j]; s += (v[j].x * v[j].x + v[j].y * v[j].y) + (v[j].z * v[j].z + v[j].w * v[j].w); }
    const float r = rsqrtf(wave_sum(s) * (1.f / DM) + EPS);
    GAS u32x2* o8 = (GAS u32x2*)orow + lane;
#pragma unroll
    for (int j = 0; j < 8; ++j) { const f32x4 g = gr[64 * j]; u32x2 w; w.x = cvtpk(v[j].x * r * g.x, v[j].y * r * g.y); w.y = cvtpk(v[j].z * r * g.z, v[j].w * r * g.w); o8[64 * j] = w; }
    return r;
}
__device__ __forceinline__ void router_phase(const Frame& F, const float* x, const float* __restrict__ gain, const float* __restrict__ Wr, bf16_t* HNo, float* aff) {
    const int lane = lane_id(), tid = F.wave * 64 + lane;
    LAS f32x4* Wl = (LAS f32x4*)(F.lds + RING_OFF);
    for (int i = tid; i < DM * 4; i += 512) { const int kk = i >> 2, q = i & 3; Wl[q * DM + kk] = *(const f32x4*)(Wr + (size_t)kk * NE + 4 * q); }
    __syncthreads();
    const int gw = (int)blockIdx.x * NWAVES + F.wave, NGW = F.G * NWAVES;
    for (int rb = gw * 4; rb < NTOK; rb += NGW * 4) {
        float rr[4];
#pragma unroll
        for (int j = 0; j < 4; ++j) rr[j] = rms_row_to_bf16_r(x + (size_t)(rb + j) * DM, gain, HNo + (size_t)(rb + j) * DM, lane);
        float a[64];
#pragma unroll
        for (int i = 0; i < 64; ++i) a[i] = 0.f;
        for (int i = 0; i < 32; ++i) { const int kk = lane + 64 * i; const float g = gain[kk]; float hv[4];
#pragma unroll
            for (int j = 0; j < 4; ++j) hv[j] = x[(size_t)(rb + j) * DM + kk] * rr[j] * g;
#pragma unroll
            for (int q = 0; q < 4; ++q) { const f32x4 w = Wl[q * DM + kk];
#pragma unroll
                for (int j = 0; j < 4; ++j) { a[j * 16 + 4 * q + 0] += hv[j] * w.x; a[j * 16 + 4 * q + 1] += hv[j] * w.y; a[j * 16 + 4 * q + 2] += hv[j] * w.z; a[j * 16 + 4 * q + 3] += hv[j] * w.w; } } }
#define RS_STEP(N, MASK) { const bool up_ = (lane & MASK) != 0; _Pragma("unroll") for (int i = 0; i < N; ++i) { const float keep = up_ ? a[i + N] : a[i], send = up_ ? a[i] : a[i + N]; a[i] = keep + __shfl_xor(send, MASK); } }
        RS_STEP(32, 32) RS_STEP(16, 16) RS_STEP(8, 8) RS_STEP(4, 4) RS_STEP(2, 2) RS_STEP(1, 1)
#undef RS_STEP
        float lg = a[0], mx = lg;
        mx = fmaxf(mx, __shfl_xor(mx, 8)); mx = fmaxf(mx, __shfl_xor(mx, 4)); mx = fmaxf(mx, __shfl_xor(mx, 2)); mx = fmaxf(mx, __shfl_xor(mx, 1));
        const float ex = expf(lg - mx); float sm = ex;
        sm += __shfl_xor(sm, 8); sm += __shfl_xor(sm, 4); sm += __shfl_xor(sm, 2); sm += __shfl_xor(sm, 1);
        const int row = rb + (lane >> 4), e = lane & 15, b = row / SEQ, t = row % SEQ;
        aff[((size_t)b * NE + e) * SEQ + t] = ex / sm;
    }
    __syncthreads();
}
__device__ __forceinline__ void rank_phase(const Frame& F, const float* aff, int* rank, float* gate, const bf16_t* HNi, bf16_t* XS) {
    const int lane = lane_id(), tid = F.wave * 64 + lane;
    LAS float* a = (LAS float*)(F.lds + RING_OFF);
    LAS int* list = (LAS int*)(F.lds + RING_OFF + 8192);
    LAS int* cntp = (LAS int*)(F.lds + RING_OFF + 8192 + 1024);
    for (int it = (int)blockIdx.x; it < NB * NE * 8; it += F.G) {
        const int be = it >> 3, chunk = it & 7, b = be >> 4, e = be & 15;
        for (int i = tid; i < SEQ / 4; i += 512) ((LAS f32x4*)a)[i] = *(const f32x4*)(aff + (size_t)be * SEQ + 4 * i);
        if (tid == 0) cntp[0] = 0;
        __syncthreads();
        const int tl = tid >> 1, half = tid & 1, t = chunk * 256 + tl; const float v = a[t]; int cnt = 0;
        for (int j4 = half * 256; j4 < half * 256 + 256; ++j4) { const f32x4 w = ((LAS f32x4*)a)[j4]; const int j = 4 * j4;
            cnt += (w.x > v || (w.x == v && j < t)) ? 1 : 0; cnt += (w.y > v || (w.y == v && j + 1 < t)) ? 1 : 0;
            cnt += (w.z > v || (w.z == v && j + 2 < t)) ? 1 : 0; cnt += (w.w > v || (w.w == v && j + 3 < t)) ? 1 : 0; }
        cnt += __shfl_xor(cnt, 1);
        if (half == 0) { rank[(size_t)be * SEQ + t] = cnt;
            if (cnt < CAP) { gate[(e * 4 + b) * CAP + cnt] = v; const int slot = atomicAdd((int*)cntp, 1); list[slot] = (t << 16) | cnt; } }
        __syncthreads();
        const int n = cntp[0];
        for (int li = F.wave; li < n; li += NWAVES) { const int pk = list[li], tt = pk >> 16, rk = pk & 0xffff;
            const u32x4* src = (const u32x4*)(HNi + ((size_t)b * SEQ + tt) * DM); u32x4* dst = (u32x4*)(XS + ((size_t)(e * 4 + b) * CAP + rk) * DM);
#pragma unroll
            for (int j = 0; j < 4; ++j) dst[lane + 64 * j] = src[lane + 64 * j]; }
        __syncthreads();
    }
}
__device__ __forceinline__ void combine_phase(const Frame& F, float* x, const bf16_t* Y, const int* rank, const float* __restrict__ gain, bf16_t* HNo, bool final_) {
    const int lane = lane_id();
    const int gw = (int)blockIdx.x * NWAVES + F.wave, NGW = F.G * NWAVES;
    for (int row = gw; row < NTOK; row += NGW) {
        const int b = row / SEQ, t = row % SEQ;
        int rk = CAP; if (lane < NE) rk = rank[((size_t)b * NE + lane) * SEQ + t];
        GAS f32x4* xr = (GAS f32x4*)(x + (size_t)row * DM) + lane; f32x4 v[8];
#pragma unroll
        for (int j = 0; j < 8; ++j) v[j] = xr[64 * j];
#pragma unroll
        for (int e = 0; e < NE; ++e) { const int r = __builtin_amdgcn_readlane(rk, e);
            if (r < CAP) { const u32x2* yr = (const u32x2*)(Y + ((size_t)(e * 4 + b) * CAP + r) * DM) + lane;
#pragma unroll
                for (int j = 0; j < 8; ++j) { const u32x2 w = yr[64 * j]; v[j].x += __uint_as_float(w.x << 16); v[j].y += __uint_as_float(w.x & 0xffff0000u); v[j].z += __uint_as_float(w.y << 16); v[j].w += __uint_as_float(w.y & 0xffff0000u); } } }
        float s = 0.f;
#pragma unroll
        for (int j = 0; j < 8; ++j) s += (v[j].x * v[j].x + v[j].y * v[j].y) + (v[j].z * v[j].z + v[j].w * v[j].w);
        const float r = rsqrtf(wave_sum(s) * (1.f / DM) + EPS); const f32x4* gr = (const f32x4*)gain + lane;
        if (final_) {
#pragma unroll
            for (int j = 0; j < 8; ++j) { const f32x4 g = gr[64 * j]; xr[64 * j] = (f32x4){v[j].x * r * g.x, v[j].y * r * g.y, v[j].z * r * g.z, v[j].w * r * g.w}; }
        } else { GAS u32x2* o8 = (GAS u32x2*)(HNo + (size_t)row * DM) + lane;
#pragma unroll
            for (int j = 0; j < 8; ++j) { const f32x4 g = gr[64 * j]; xr[64 * j] = v[j]; o8[64 * j] = (u32x2){cvtpk(v[j].x * r * g.x, v[j].y * r * g.y), cvtpk(v[j].z * r * g.z, v[j].w * r * g.w)}; } }
    }
}

struct MapPool { const char* A; const char* W; __device__ __forceinline__ void operator()(pg8::Unit& u) const {
    u.a = A + ((size_t)u.pm * 256 * DM + (size_t)(u.pn >> 1) * 512) * 2; u.b = W + ((size_t)(u.pn & 1) * 256 * DM + (size_t)(u.pn >> 1) * 512) * 2; } };
__device__ __forceinline__ void pool_phase(const Frame& F, const bf16_t* H, bf16_t* P) {
    const int lane = lane_id(); const int gt = ((int)blockIdx.x * NWAVES + F.wave) * 64 + lane, NT = F.G * NWAVES * 64;
    for (int idx = gt; idx < NTOK * (DM / 8); idx += NT) {
        const int row = idx >> 8, c8 = idx & 255, t = row & (SEQ - 1), g = c8 >> 6, w = 2 << g;
        int lo = t - (w >> 1), hi = t + (w >> 1); if (lo < 0) lo = 0; if (hi > SEQ) hi = SEQ;
        float s[8] = {0.f, 0.f, 0.f, 0.f, 0.f, 0.f, 0.f, 0.f}; float self[8];
        const bf16_t* base = H + (size_t)(row - t) * DM + c8 * 8;
        for (int j = lo; j < hi; ++j) { const u32x4 v = *(const u32x4*)(base + (size_t)j * DM);
            const float f[8] = {__uint_as_float(v.x << 16), __uint_as_float(v.x & 0xffff0000u), __uint_as_float(v.y << 16), __uint_as_float(v.y & 0xffff0000u),
                                __uint_as_float(v.z << 16), __uint_as_float(v.z & 0xffff0000u), __uint_as_float(v.w << 16), __uint_as_float(v.w & 0xffff0000u)};
#pragma unroll
            for (int i = 0; i < 8; ++i) { s[i] += f[i]; if (j == t) self[i] = f[i]; } }
        const float inv = 1.0f / (float)(hi - lo);
        *(u32x4*)(P + (size_t)row * DM + c8 * 8) = (u32x4){cvtpk(s[0] * inv - self[0], s[1] * inv - self[1]), cvtpk(s[2] * inv - self[2], s[3] * inv - self[3]),
                                                          cvtpk(s[4] * inv - self[4], s[5] * inv - self[5]), cvtpk(s[6] * inv - self[6], s[7] * inv - self[7])};
    }
}

constexpr int N_PHASES = 24;
__global__ void __launch_bounds__(NWAVES * 64, 2) skel_fwd(Args args) {
    extern __shared__ __attribute__((aligned(16))) unsigned char lds_raw[];
    Frame F;
    F.lds = (LAS unsigned char*)lds_raw; F.MISC = (volatile LAS unsigned*)(F.lds + MISC_OFF);
    F.wave = __builtin_amdgcn_readfirstlane(threadIdx.x >> 6);
    F.G = gridDim.x; { const int bx = blockIdx.x; F.vcu = (F.G % 8 == 0) ? (bx % 8) * (F.G / 8) + bx / 8 : bx; }
    unsigned char* const ws = uptr(args.ws);
    F.ws = ws; F.ctl = (gu32*)(ws + WS_CTL);
    for (int u = threadIdx.x; u < (LDS_BYTES - LDSCTL_OFF) / 4; u += NWAVES * 64) ((LAS unsigned*)(F.lds + LDSCTL_OFF))[u] = 0u;
    __syncthreads();
    const bool multi = (args.ph_hi - args.ph_lo) > 1;
    XcdBarrier bar; bar.bar = (unsigned*)(F.ctl + CW_BAR); bar.x = 0; bar.st = nullptr; bar.wave = F.wave;
    if (multi) bar = xcd_barrier_post((unsigned*)(F.ctl + CW_BAR), F.MISC + 8, F.wave);
    const int lo = args.ph_lo, hi = args.ph_hi;
#define IN(k) (lo <= (k) && (k) < hi)
#define SEAM(k) do { if (IN(k) && IN((k) + 1)) xcd_barrier(bar); } while (0)
    LAS unsigned char* ring = F.lds + RING_OFF; LAS unsigned char* xl = F.lds + XL_OFF;
    const int bx = (int)blockIdx.x, G = F.G;

    if (IN(0)) { p0_prologue(F, args); SEAM(0); }
    if (IN(1)) {
        {
            MapLin mp{(const char*)(ws + WS_HN), (const char*)(ws + WS_WIN_T), (size_t)256 * DM * 2, (size_t)256 * DM * 2};
            pg8::Sched<MapLin> S; S.init(NTOK / 256, 2560 / 256, G, bx, mp);
            EpiQKV E{(bf16_t*)(ws + WS_QB), (bf16_t*)(ws + WS_KB), (bf16_t*)(ws + WS_VB), args.in[4], args.in[5], (const float*)(ws + WS_ROPE), (const float*)(ws + WS_ROPE) + SEQ * 64};
            pg8::gemm_phase<EpiQKV, pg8::Sched<MapLin>, true>(F.wave, ring, xl, DM, DM * 2, DM * 2, S, E); }
        {
            MapLin mp{(const char*)(ws + WS_WF_T), (const char*)(ws + WS_HN), (size_t)256 * DM * 2, (size_t)256 * DM * 2};
            pg8::Sched<MapLin> S; S.init(1024 / 256, NTOK / 256, G, (bx + G - (320 % G)) % G, mp);
            EpiStore<AddrF1> E{AddrF1{(bf16_t*)(ws + WS_FPQ)}};
            pg8::gemm_phase<EpiStore<AddrF1>, pg8::Sched<MapLin>, true>(F.wave, ring, xl, DM, DM * 2, DM * 2, S, E); }
        for (int l = 0; l < 2; ++l) {
            { MapLin mp{(const char*)(ws + WS_MEMNB + (size_t)l * NB * MEML * DM * 2), (const char*)(ws + WS_WCK_T + (size_t)l * DM * DM * 2), (size_t)256 * DM * 2, (size_t)256 * DM * 2};
              pg8::Sched<MapLin> S; S.init(NB * MEML / 256, DM / 256, G, (bx + G - ((448 + 64 * l) % G)) % G, mp);
              EpiStore<AddrLin> E{AddrLin{(bf16_t*)(ws + WS_KCB + (size_t)l * NB * MEML * DM * 2), DM}};
              pg8::gemm_phase<EpiStore<AddrLin>, pg8::Sched<MapLin>, true>(F.wave, ring, xl, DM, DM * 2, DM * 2, S, E); }
            { MapLin mp{(const char*)(ws + WS_WCV_T + (size_t)l * DM * DM * 2), (const char*)(ws + WS_MEMNB + (size_t)l * NB * MEML * DM * 2), (size_t)256 * DM * 2, (size_t)256 * DM * 2};
              pg8::Sched<MapLin> S; S.init(DM / 256, NB * MEML / 256, G, (bx + G - ((480 + 64 * l) % G)) % G, mp);
              EpiStore<AddrLin> E{AddrLin{(bf16_t*)(ws + WS_VTB + (size_t)l * NB * MEML * DM * 2), NB * MEML}};
              pg8::gemm_phase<EpiStore<AddrLin>, pg8::Sched<MapLin>, true>(F.wave, ring, xl, DM, DM * 2, DM * 2, S, E); }
        }
        SEAM(1);
    }
    if (IN(2)) {
        const int nF2 = (G > 64) ? 64 : 0;
        if (bx < nF2 || nF2 == 0) {
            MapLin mp{(const char*)(ws + WS_DFT), (const char*)(ws + WS_FPQ), (size_t)256 * 4096 * 2, (size_t)256 * 4096 * 2};
            pg8::Sched<MapLin> S; S.init(8, 8, nF2 ? nF2 : G, bx, mp);
            EpiStore<AddrF2> E{AddrF2{(bf16_t*)(ws + WS_MIXB)}};
            pg8::gemm_phase<EpiStore<AddrF2>, pg8::Sched<MapLin>, true>(F.wave, ring, xl, 4096, 4096 * 2, 4096 * 2, S, E);
        }
        if (bx >= nF2) {
            const int a = bx - nF2, cnt = G - nF2, per = (384 + cnt - 1) / cnt;
            for (int uid = a * per; uid < (a + 1) * per && uid < 384; ++uid) {
                const int qb = uid & 7, hq = (uid >> 3) % NQH, b = uid / (8 * NQH), kvh = hq / 3;
                const bf16_t* Qb = (const bf16_t*)(ws + WS_QB) + ((size_t)b * SEQ + qb * 256) * AW + hq * HD;
                const bf16_t* Kh = (const bf16_t*)(ws + WS_KB) + (size_t)b * SEQ * KVW + kvh * HD;
                const bf16_t* Vh = (const bf16_t*)(ws + WS_VB) + (size_t)b * SEQ * KVW + kvh * HD;
                bf16_t* Ob = (bf16_t*)(ws + WS_MIXB) + ((size_t)b * SEQ + qb * 256) * DM + hq * HD;
                attn::attn_dense_body(Qb, Kh, Vh, Ob, SEQ, (char*)lds_raw + RING_OFF, F.wave);
            }
        }
        SEAM(2);
    }
    if (IN(3)) {
        MapLin mp{(const char*)(ws + WS_MIXB), (const char*)(ws + WS_WOUT_T), (size_t)256 * DM * 2, (size_t)256 * DM * 2};
        pg8::Sched<MapLin> S; S.init(NTOK / 256, DM / 256, G, bx, mp);
        EpiRes E{args.in[0], args.out, (bf16_t*)(ws + WS_XB), (float*)(ws + WS_SSP), nullptr, 8};
        pg8::gemm_phase<EpiRes, pg8::Sched<MapLin>, true>(F.wave, ring, xl, DM, DM * 2, DM * 2, S, E);
        SEAM(3);
    }
    for (int l = 0; l < 2; ++l) {
        const int pb = l ? 15 : 4;
        if (l == 1) {
            if (IN(13)) {
                pool_phase(F, (const bf16_t*)(ws + WS_HN), (bf16_t*)(ws + WS_QCB));
                expert_tr_items(F, args.in[18], args.in[19], args.in[20], 1, (LAS float*)(F.lds + RING_OFF + F.wave * 16384));
                SEAM(13);
            }
            if (IN(14)) {
                MapPool mp{(const char*)(ws + WS_QCB), (const char*)(ws + WS_WP_T)};
                pg8::Sched<MapPool> S; S.init(NTOK / 256, DM / 256, G, bx, mp);
                EpiRes E{args.out, args.out, (bf16_t*)(ws + WS_XB), (float*)(ws + WS_SSP), args.in[9], 8};
                pg8::gemm_phase<EpiRes, pg8::Sched<MapPool>, true>(F.wave, ring, xl, 512, DM * 2, DM * 2, S, E);
                SEAM(14);
            }
        }
        if (IN(pb + 0)) {
            MapLin mp{(const char*)(ws + WS_XB), (const char*)(ws + WS_WCQ_T + (size_t)l * DM * DM * 2), (size_t)256 * DM * 2, (size_t)256 * DM * 2};
            pg8::Sched<MapLin> S; S.init(NTOK / 256, DM / 256, G, bx, mp);
            EpiRowScale E{(bf16_t*)(ws + WS_QCB), DM, (const float*)(ws + WS_SSP), 0.04419417382415922f};
            pg8::gemm_phase<EpiRowScale, pg8::Sched<MapLin>, true>(F.wave, ring, xl, DM, DM * 2, DM * 2, S, E);
            SEAM(pb + 0);
        }
        if (IN(pb + 1)) {
            MapXS mp{(const char*)(ws + WS_QCB), (const char*)(ws + WS_KCB + (size_t)l * NB * MEML * DM * 2)};
            pg8::Sched<MapXS> S; S.init(NTOK / 256, NMH, G, bx, mp);
            EpiSoftmax E{(bf16_t*)(ws + WS_PB), NMH * MEML};
            pg8::gemm_phase<EpiSoftmax, pg8::Sched<MapXS>, true>(F.wave, ring, xl, MHD, DM * 2, DM * 2, S, E);
            SEAM(pb + 1);
        }
        if (IN(pb + 2)) {
            MapXPV mp{(const char*)(ws + WS_PB), (const char*)(ws + WS_VTB + (size_t)l * NB * MEML * DM * 2)};
            pg8::Sched<MapXPV> S; S.init(NTOK / 256, DM / 256, G, bx, mp);
            EpiStore<AddrLin> E{AddrLin{(bf16_t*)(ws + WS_MIXB), DM}};
            pg8::gemm_phase<EpiStore<AddrLin>, pg8::Sched<MapXPV>, true>(F.wave, ring, xl, MEML, NMH * MEML * 2, NB * MEML * 2, S, E);
            SEAM(pb + 2);
        }
        if (IN(pb + 3)) {
            MapLin mp{(const char*)(ws + WS_MIXB), (const char*)(ws + WS_WCO_T + (size_t)l * DM * DM * 2), (size_t)256 * DM * 2, (size_t)256 * DM * 2};
            pg8::Sched<MapLin> S; S.init(NTOK / 256, DM / 256, G, bx, mp);
            EpiRes E{args.out, args.out, nullptr, nullptr, nullptr, 8};
            pg8::gemm_phase<EpiRes, pg8::Sched<MapLin>, true>(F.wave, ring, xl, DM, DM * 2, DM * 2, S, E);
            SEAM(pb + 3);
        }
        if (IN(pb + 4)) {
            router_phase(F, args.out, args.in[16] + l * DM, args.in[17] + (size_t)l * DM * NE, (bf16_t*)(ws + WS_HN), (float*)(ws + WS_AFF));
            SEAM(pb + 4);
        }
        if (IN(pb + 5)) {
            rank_phase(F, (const float*)(ws + WS_AFF), (int*)(ws + WS_RANK), (float*)(ws + WS_GATE), (const bf16_t*)(ws + WS_HN), (bf16_t*)(ws + WS_XSB));
            SEAM(pb + 5);
        }
        if (IN(pb + 6)) {
            MapMoE mp{(const char*)(ws + WS_XSB), (const char*)(ws + WS_WGU_T), (size_t)256 * DM * 2, (size_t)2048 * DM * 2, (size_t)256 * DM * 2};
            pg8::Sched<MapMoE> S; S.init(NB * NE, 8, G, bx, mp);
            EpiSwiGLU E{(bf16_t*)(ws + WS_ACTB)};
            pg8::gemm_phase<EpiSwiGLU, pg8::Sched<MapMoE>, true>(F.wave, ring, xl, DM, DM * 2, DM * 2, S, E);
            SEAM(pb + 6);
        }
        if (IN(pb + 7)) {
            MapMoE mp{(const char*)(ws + WS_ACTB), (const char*)(ws + WS_WD_T), (size_t)256 * EFF * 2, (size_t)2048 * EFF * 2, (size_t)256 * EFF * 2};
            pg8::Sched<MapMoE> S; S.init(NB * NE, 8, G, bx, mp);
            EpiRowGate E{(bf16_t*)(ws + WS_YB), (const float*)(ws + WS_GATE)};
            pg8::gemm_phase<EpiRowGate, pg8::Sched<MapMoE>, true>(F.wave, ring, xl, EFF, EFF * 2, EFF * 2, S, E);
            SEAM(pb + 7);
        }
        if (IN(pb + 8)) {
            combine_phase(F, args.out, (const bf16_t*)(ws + WS_YB), (const int*)(ws + WS_RANK), l == 0 ? args.in[2] + DM : args.in[21], (bf16_t*)(ws + WS_HN), l == 1);
            SEAM(pb + 8);
        }
    }
#undef IN
#undef SEAM
}


#ifndef MK_N_LAUNCHES
#define MK_N_LAUNCHES 24
#endif
extern "C" void kernel_launch(void* const* d_in, const int* in_sizes, int n_in, void* d_out, int out_size, void* d_ws, size_t ws_size, hipStream_t stream) {
    static int grid = 0;
    if (grid == 0) {
        int dev = 0, cus = 0;
        if (n_in != 22 || out_size != NTOK * DM || ws_size < WS_FAST_END) { fprintf(stderr, "kernel_launch: unexpected shapes (n_in %d out %d ws %zu)\n", n_in, out_size, ws_size); grid = -1; return; }
        if (hipGetDevice(&dev) != hipSuccess || hipDeviceGetAttribute(&cus, hipDeviceAttributeMultiprocessorCount, dev) != hipSuccess) { fprintf(stderr, "device query failed\n"); grid = -1; return; }
        if (hipFuncSetAttribute((const void*)skel_fwd, hipFuncAttributeMaxDynamicSharedMemorySize, LDS_BYTES) != hipSuccess) { fprintf(stderr, "hipFuncSetAttribute failed\n"); grid = -1; return; }
        (void)hipGetLastError();
        grid = cus;
    }
    if (grid < 0) return;
    hipMemsetAsync((char*)d_ws + WS_CTL, 0, CTL_ZERO_BYTES, stream);
    Args a{};
    for (int i = 0; i < 22; ++i) a.in[i] = (const float*)d_in[i];
    a.out = (float*)d_out; a.ws = (unsigned char*)d_ws;
    constexpr int NL = MK_N_LAUNCHES;
    for (int li = 0; li < NL; ++li) {
        a.ph_lo = (N_PHASES * li) / NL; a.ph_hi = (N_PHASES * (li + 1)) / NL; a.li = li;
        hipLaunchKernelGGL(skel_fwd, dim3(grid), dim3(NWAVES * 64), LDS_BYTES, stream, a);
    }
}
```

```cpp
#include <hip/hip_runtime.h>
#include <cstdio>
#include <cstdint>

constexpr int DM = 2048, NB = 4, SEQ = 2048, NTOK = NB * SEQ;
constexpr int HD = 128, NQH = 12, NKVH = 4, AW = NQH * HD, KVW = NKVH * HD, FW = 512, INW = 3072;
constexpr int MEML = 256, NMH = 4, MHD = 512;
constexpr int NE = 16, EFF = 1024, CAP = 256;
constexpr float EPS = 1e-6f;

#define LAS __attribute__((address_space(3)))
#define GAS __attribute__((address_space(1)))
typedef unsigned short bf16_t;
typedef short bf16x8 __attribute__((ext_vector_type(8)));
typedef float f32x4 __attribute__((ext_vector_type(4)));
typedef float f32x2 __attribute__((ext_vector_type(2)));
typedef unsigned u32x4 __attribute__((ext_vector_type(4)));
typedef unsigned u32x2 __attribute__((ext_vector_type(2)));
typedef __bf16 bf16x2_t __attribute__((ext_vector_type(2)));
__device__ __forceinline__ unsigned cvtpk(float lo, float hi) { f32x2 v = {lo, hi}; bf16x2_t b = __builtin_convertvector(v, bf16x2_t); return __builtin_bit_cast(unsigned, b); }
__device__ __forceinline__ float bf2f(unsigned short h) { return __uint_as_float(((unsigned)h) << 16); }
template <class T> __device__ __forceinline__ T* uptr(T* p) { const unsigned long long v = (unsigned long long)p; const unsigned lo = __builtin_amdgcn_readfirstlane((unsigned)v), hi = __builtin_amdgcn_readfirstlane((unsigned)(v >> 32)); return (T*)(((unsigned long long)hi << 32) | lo); }
__device__ __forceinline__ int lane_id() { int l = (int)__builtin_amdgcn_mbcnt_hi(~0u, __builtin_amdgcn_mbcnt_lo(~0u, 0u)); asm volatile("" : "+v"(l)); return l; }
#define LDS_WAIT() asm volatile("s_waitcnt lgkmcnt(0)" ::: "memory")
#define VM_WAIT() asm volatile("s_waitcnt vmcnt(0)" ::: "memory")
#define WG_BAR() do { asm volatile("s_waitcnt lgkmcnt(0)" ::: "memory"); __builtin_amdgcn_s_barrier(); asm volatile("" ::: "memory"); } while (0)

namespace pg8 {
constexpr int BM = 256, BK = 64, HALF = 128, HTB = HALF * BK * 2, STAGE_BYTES = 8 * HTB, NXCD = 8, WGM = 8;
__host__ __device__ __forceinline__ int lds_byte(int r, int c) { const int st = (r >> 4) * 2 + (c >> 5), rr = r & 15, cc = c & 31, ob = rr * 64 + cc * 2; return st * 1024 + (ob ^ (((ob >> 9) & 1) << 5)); }
__host__ __device__ __forceinline__ void stage_rc(int b, int& R, int& C) { const int st = b / 1024, sb = b % 1024, swz = sb ^ (((sb >> 9) & 1) << 5); R = (st >> 1) * 16 + swz / 64; C = (st & 1) * 32 + (swz % 64) / 2; }
__host__ __device__ __forceinline__ int perm32(int rho) { const int n = rho >> 4, i = rho & 15; return 8 * (i >> 2) + 4 * n + (i & 3); }

struct Unit { int pm, pn; const char* a; const char* b; };
struct EpiCtx { int wr, wc, wid; LAS unsigned char* xl; };

template <class Map> struct Sched {
    int nM, nN, nwg, G, c; Map map;
    __device__ __forceinline__ void init(int nM_, int nN_, int G_, int c_, const Map& m) { nM = nM_; nN = nN_; nwg = nM * nN; G = G_; c = c_; map = m; }
    __device__ __forceinline__ bool next(int i, Unit& u) const {
        const long L = (long)i * G + c; if (L >= nwg) return false;
        int wgid = (int)L; { const int q = nwg / NXCD, r = nwg % NXCD, xcd = wgid % NXCD, off = wgid / NXCD; wgid = (xcd < r ? xcd * (q + 1) : r * (q + 1) + (xcd - r) * q) + off; }
        const int nig = WGM * nN, gid = wgid / nig, fm = gid * WGM, gsz = (nM - fm) < WGM ? (nM - fm) : WGM;
        u.pm = fm + ((wgid % nig) % gsz); u.pn = (wgid % nig) / gsz; map(u); return true;
    }
};

template <class Epi, class SchedT, bool SP2>
__device__ __forceinline__ void gemm_phase(const int wave_, LAS unsigned char* lds, LAS unsigned char* xl, const int K, const int lda, const int ldb, const SchedT& S, const Epi& E) {
    constexpr bool ALIGN_EPI = true;
    const int lane = lane_id(), wid = wave_, tid = wid * 64 + lane, wr = wid >> 2, wc = wid & 3, fr = lane & 15, fq = lane >> 4;
    const int nt = K / BK;
    unsigned voffA[2], voffB[2];
#pragma unroll
    for (int i = 0; i < 2; ++i) { int R, C; stage_rc(tid * 16 + i * 8192, R, C); const int Rb = Epi::PERM ? ((R & ~31) + perm32(R & 31)) : R;
        voffA[i] = (unsigned)(R * lda + C * 2); voffB[i] = (unsigned)(Rb * ldb + C * 2); }
    const size_t kstep = (size_t)(BK * 2);
    const size_t hstepA = (size_t)HALF * lda, hstepB = (size_t)HALF * ldb;
    const unsigned ldsw = (unsigned)wid * 1024u;
    const int aoff = lds_byte(wr * 64 + fr, fq * 8), boff = lds_byte(wc * 32 + fr, fq * 8);
#define PG8_SA(b, h) (((b) * 2 + (h)) * HTB)
#define PG8_SB(b, h) ((4 + (b) * 2 + (h)) * HTB)
#define PG8_STAGE(bufoff, gbase, voff) do { _Pragma("unroll") for (int _i = 0; _i < 2; ++_i) \
        __builtin_amdgcn_global_load_lds((const unsigned*)((const char*)(gbase) + (voff)[_i]), (LAS unsigned*)(lds + (bufoff) + ldsw + _i * 8192), 16, 0, 0); } while (0)
#define PG8_LDA(dst, b, h) do { _Pragma("unroll") for (int m = 0; m < 4; ++m) _Pragma("unroll") for (int k = 0; k < 2; ++k) dst[m][k] = *(const LAS bf16x8*)(lds + PG8_SA(b, h) + aoff + m * 2048 + k * 1024); } while (0)
#define PG8_LDB(dst, b, h) do { _Pragma("unroll") for (int n = 0; n < 2; ++n) _Pragma("unroll") for (int k = 0; k < 2; ++k) dst[n][k] = *(const LAS bf16x8*)(lds + PG8_SB(b, h) + boff + n * 2048 + k * 1024); } while (0)
#define PG8_MMA(ai, bj, At, Bt) do { __builtin_amdgcn_s_setprio(1); _Pragma("unroll") for (int m = 0; m < 4; ++m) _Pragma("unroll") for (int n = 0; n < 2; ++n) _Pragma("unroll") for (int k = 0; k < 2; ++k) \
        acc[ai][bj][m][n] = __builtin_amdgcn_mfma_f32_16x16x32_bf16(Bt[n][k], At[m][k], acc[ai][bj][m][n], 0, 0, 0); __builtin_amdgcn_s_setprio(0); } while (0)
#define PG8_WAIT_V(n) asm volatile("s_waitcnt vmcnt(" #n ")" ::: "memory")
#define PG8_WAIT_L(n) asm volatile("s_waitcnt lgkmcnt(" #n ")" ::: "memory")
#define PG8_BAR __builtin_amdgcn_s_barrier()
#define PG8_SCHED __builtin_amdgcn_sched_barrier(0)
    Unit cur, nxt; int ui = 0;
    if (!S.next(0, cur)) return;
    EpiCtx ctx; ctx.wr = wr; ctx.wc = wc; ctx.wid = wid; ctx.xl = xl;
    f32x4 acc[2][2][4][2];
#pragma unroll
    for (int a = 0; a < 2; ++a)
#pragma unroll
        for (int b = 0; b < 2; ++b)
#pragma unroll
            for (int m = 0; m < 4; ++m)
#pragma unroll
                for (int n = 0; n < 2; ++n) acc[a][b][m][n] = (f32x4){0.f, 0.f, 0.f, 0.f};
    bf16x8 At[4][2], B0[2][2], B1[2][2];
    const char* cA = cur.a; const char* cB = cur.b;
    if constexpr (SP2) {
        PG8_STAGE(PG8_SB(0, 0), cB, voffB); PG8_STAGE(PG8_SB(0, 1), cB + hstepB, voffB); PG8_STAGE(PG8_SA(0, 0), cA, voffA); PG8_STAGE(PG8_SA(0, 1), cA + hstepA, voffA);
        if (wr == 1) PG8_BAR;
        PG8_WAIT_V(2); PG8_BAR;
        PG8_STAGE(PG8_SB(1, 0), cB + kstep, voffB); PG8_STAGE(PG8_SA(1, 0), cA + kstep, voffA); PG8_STAGE(PG8_SB(1, 1), cB + hstepB + kstep, voffB);
        PG8_WAIT_V(6); PG8_BAR;
    } else {
        PG8_STAGE(PG8_SB(0, 0), cB, voffB); PG8_STAGE(PG8_SA(0, 0), cA, voffA); PG8_STAGE(PG8_SB(0, 1), cB + hstepB, voffB); PG8_STAGE(PG8_SA(0, 1), cA + hstepA, voffA);
        if (wr == 1) PG8_BAR;
        PG8_WAIT_V(4); PG8_BAR;
        PG8_STAGE(PG8_SB(1, 0), cB + kstep, voffB); PG8_STAGE(PG8_SA(1, 0), cA + kstep, voffA); PG8_STAGE(PG8_SB(1, 1), cB + hstepB + kstep, voffB);
        PG8_WAIT_V(6); PG8_BAR;
    }
    for (;;) {
        const bool has_next = S.next(ui + 1, nxt);
        const char* nA = has_next ? nxt.a : cA; const char* nB = has_next ? nxt.b : cB;
        for (int t = 0; t < nt; t += 2) {
            const bool last = (t == nt - 2);
            const char* a1 = cA + (size_t)(t + 1) * kstep;
            const char* a2 = last ? nA : cA + (size_t)(t + 2) * kstep; const char* b2 = last ? nB : cB + (size_t)(t + 2) * kstep;
            const char* a3 = a2 + kstep; const char* b3 = b2 + kstep;
            if constexpr (SP2) {
            PG8_LDB(B0, 0, 0); PG8_LDB(B1, 0, 1); PG8_SCHED; PG8_LDA(At, 0, 0); PG8_STAGE(PG8_SA(1, 1), a1 + hstepA, voffA);
            PG8_WAIT_V(8); PG8_WAIT_L(0); PG8_BAR; PG8_MMA(0, 0, At, B0); PG8_MMA(0, 1, At, B1); PG8_BAR; PG8_SCHED;
            PG8_LDA(At, 0, 1); PG8_STAGE(PG8_SB(0, 0), b2, voffB); PG8_STAGE(PG8_SB(0, 1), b2 + hstepB, voffB); PG8_STAGE(PG8_SA(0, 0), a2, voffA);
            PG8_WAIT_V(8); PG8_WAIT_L(0); PG8_BAR; PG8_MMA(1, 0, At, B0); PG8_MMA(1, 1, At, B1); PG8_BAR; PG8_SCHED;
            PG8_LDB(B0, 1, 0); PG8_LDB(B1, 1, 1); PG8_SCHED; PG8_LDA(At, 1, 0); PG8_STAGE(PG8_SA(0, 1), a2 + hstepA, voffA);
            PG8_WAIT_V(8); PG8_WAIT_L(0); PG8_BAR; PG8_MMA(0, 0, At, B0); PG8_MMA(0, 1, At, B1); PG8_BAR; PG8_SCHED;
            PG8_LDA(At, 1, 1); PG8_STAGE(PG8_SB(1, 0), b3, voffB); PG8_STAGE(PG8_SB(1, 1), b3 + hstepB, voffB); PG8_STAGE(PG8_SA(1, 0), a3, voffA);
            PG8_WAIT_V(8); PG8_WAIT_L(0); PG8_BAR; PG8_MMA(1, 0, At, B0); PG8_MMA(1, 1, At, B1); PG8_BAR; PG8_SCHED;
            } else {
            PG8_LDB(B0, 0, 0); PG8_SCHED; PG8_LDA(At, 0, 0); PG8_STAGE(PG8_SA(1, 1), a1 + hstepA, voffA);
            PG8_WAIT_L(8); PG8_BAR; PG8_WAIT_L(0); PG8_MMA(0, 0, At, B0); PG8_BAR; PG8_SCHED;
            PG8_LDB(B1, 0, 1); PG8_STAGE(PG8_SB(0, 0), b2, voffB);
            PG8_BAR; PG8_WAIT_L(0); PG8_MMA(0, 1, At, B1); PG8_BAR;
            PG8_LDA(At, 0, 1); PG8_STAGE(PG8_SA(0, 0), a2, voffA);
            PG8_BAR; PG8_WAIT_L(0); PG8_MMA(1, 0, At, B0); PG8_BAR; PG8_SCHED;
            PG8_STAGE(PG8_SB(0, 1), b2 + hstepB, voffB);
            PG8_WAIT_V(6); PG8_BAR; PG8_MMA(1, 1, At, B1); PG8_BAR;
            PG8_LDB(B0, 1, 0); PG8_SCHED; PG8_LDA(At, 1, 0); PG8_STAGE(PG8_SA(0, 1), a2 + hstepA, voffA);
            PG8_WAIT_L(8); PG8_BAR; PG8_WAIT_L(0); PG8_MMA(0, 0, At, B0); PG8_BAR; PG8_SCHED;
            PG8_LDB(B1, 1, 1); PG8_STAGE(PG8_SB(1, 0), b3, voffB);
            PG8_BAR; PG8_WAIT_L(0); PG8_MMA(0, 1, At, B1); PG8_BAR;
            PG8_LDA(At, 1, 1); PG8_STAGE(PG8_SA(1, 0), a3, voffA);
            PG8_BAR; PG8_WAIT_L(0); PG8_MMA(1, 0, At, B0); PG8_BAR; PG8_SCHED;
            PG8_STAGE(PG8_SB(1, 1), b3 + hstepB, voffB);
            PG8_WAIT_V(6); PG8_BAR; PG8_MMA(1, 1, At, B1); PG8_BAR;
            }
        }
        if constexpr (ALIGN_EPI) { if (wr == 0) PG8_BAR; }
        E(acc, cur, ctx);
        if (!has_next) break;
#pragma unroll
        for (int a = 0; a < 2; ++a)
#pragma unroll
            for (int b = 0; b < 2; ++b)
#pragma unroll
                for (int m = 0; m < 4; ++m)
#pragma unroll
                    for (int n = 0; n < 2; ++n) acc[a][b][m][n] = (f32x4){0.f, 0.f, 0.f, 0.f};
        cur = nxt; cA = nA; cB = nB; ++ui;
        if constexpr (ALIGN_EPI) { if (wr == 1) PG8_BAR; }
    }
    PG8_WAIT_V(0);
    if constexpr (!ALIGN_EPI) { if (wr == 0) PG8_BAR; }
    PG8_BAR;
#undef PG8_SA
#undef PG8_SB
#undef PG8_STAGE
#undef PG8_LDA
#undef PG8_LDB
#undef PG8_MMA
#undef PG8_WAIT_V
#undef PG8_WAIT_L
#undef PG8_BAR
#undef PG8_SCHED
}
}

constexpr size_t MiB = 1u << 20;
constexpr size_t WS_CTL = 0, CTL_ZERO_BYTES = 1 * MiB;
constexpr size_t WS_WIN_T = 1 * MiB, WS_WF_T = 11 * MiB, WS_WOUT_T = 15 * MiB, WS_WCQ_T = 23 * MiB, WS_WCK_T = 39 * MiB, WS_WCV_T = 55 * MiB, WS_WCO_T = 71 * MiB;
constexpr size_t WS_WP_T = 87 * MiB, WS_DFT = 89 * MiB, WS_ROPE = 105 * MiB, WS_WGU_T = 106 * MiB, WS_WD_T = 234 * MiB;
constexpr size_t WS_HN = 298 * MiB, WS_XB = 330 * MiB, WS_QB = 362 * MiB, WS_KB = 386 * MiB, WS_VB = 394 * MiB, WS_FPQ = 402 * MiB, WS_MIXB = 418 * MiB, WS_QCB = 450 * MiB;
constexpr size_t WS_KCB = 482 * MiB, WS_VTB = 490 * MiB, WS_MEMNB = 498 * MiB, WS_PB = 506 * MiB, WS_XSB = 522 * MiB, WS_ACTB = 586 * MiB, WS_YB = 618 * MiB;
constexpr size_t WS_SSP = 682 * MiB, WS_AFF = 683 * MiB, WS_RANK = 684 * MiB, WS_GATE = 685 * MiB, WS_FAST_END = 686 * MiB;
constexpr int CW_TMO = 0, CW_CODE = 1, CW_BAR = 4096;
constexpr int RING_OFF = 0, RING_BYTES = 131072, XL_OFF = 131072, XL_BYTES = 14336, LDSCTL_OFF = XL_OFF + XL_BYTES, MISC_OFF = LDSCTL_OFF + 320, LDS_BYTES = 147456;
static_assert(MISC_OFF + 128 <= LDS_BYTES, "LDS map");
constexpr int NWAVES = 8;

typedef GAS unsigned gu32;
#define RLX_AGENT __ATOMIC_RELAXED, __HIP_MEMORY_SCOPE_AGENT

#define XB_TMO      128
#define XB_XCNT(j)  (256  + 64 * (j))
#define XB_XSUB(j)  (1280 + 64 * (j))
#define XB_XGEN(j)  (2304 + 64 * (j))
#define XB_TOP      3328
#define XB_TOPGEN   3392
#define XCD_BAR_WORDS 3456
#define XB_SPIN_CAP (1u << 18)
__device__ __forceinline__ unsigned xb_ld(unsigned* p)              { return __hip_atomic_load(p, __ATOMIC_RELAXED, __HIP_MEMORY_SCOPE_AGENT); }
__device__ __forceinline__ unsigned xb_add(unsigned* p, unsigned v) { return __hip_atomic_fetch_add(p, v, __ATOMIC_RELAXED, __HIP_MEMORY_SCOPE_AGENT); }
__device__ __forceinline__ unsigned xb_xcc_id() { return (unsigned)__builtin_amdgcn_s_getreg((3 << 11) | 20) & 0xFu; }
#define XB_SPIN(cond, bar) do { unsigned _sp = 0; while (cond) { __builtin_amdgcn_s_sleep(1); \
    if ((++_sp & 255u) == 0u) { if (xb_ld(&(bar)[XB_TMO])) break; if (_sp > XB_SPIN_CAP) { atomicAdd(&(bar)[XB_TMO], 1u); break; } } } } while (0)
struct XcdBarrier { unsigned* bar; unsigned x; volatile LAS unsigned* st; int wave; };
__device__ __forceinline__ XcdBarrier xcd_barrier_post(unsigned* bar, volatile LAS unsigned* st, int wave) {
    XcdBarrier b; b.bar = bar; b.x = xb_xcc_id(); b.st = st; b.wave = wave;
    if (wave == 0 && lane_id() == 0) (void)xb_add(&bar[XB_XCNT(b.x)], 1u);
    return b;
}
__device__ __forceinline__ void xcd_barrier_complete(unsigned* bar, unsigned x, unsigned& nloc, unsigned& nx) {
    const unsigned G = gridDim.x * gridDim.y * gridDim.z;
    unsigned sum, cnt, mine, sp = 0u;
    for (;;) {
        sum = 0u; cnt = 0u; mine = 0u;
#pragma unroll
        for (unsigned j = 0; j < 16; ++j) { const unsigned c = xb_ld(&bar[XB_XCNT(j)]); sum += c; cnt += (c > 0u) ? 1u : 0u; mine = (j == x) ? c : mine; }
        if (sum == G) break;
        __builtin_amdgcn_s_sleep(1);
        if ((++sp & 255u) == 0u) { if (xb_ld(&bar[XB_TMO])) break; if (sp > XB_SPIN_CAP) { atomicAdd(&bar[XB_TMO], 1u); break; } }
    }
    nloc = mine > 0u ? mine : 1u; nx = cnt > 0u ? cnt : 1u;
}
__device__ __forceinline__ void xcd_barrier(const XcdBarrier& b) {
    asm volatile("s_waitcnt vmcnt(0)" ::: "memory");
    __syncthreads();
    if (b.wave == 0 && lane_id() == 0) {
        unsigned* bar = b.bar;
        __builtin_amdgcn_s_waitcnt(0);
        unsigned nloc = b.st[0], nx = b.st[1];
        if (nloc == 0u) { xcd_barrier_complete(bar, b.x, nloc, nx); b.st[0] = nloc; b.st[1] = nx; }
        const unsigned old = xb_add(&bar[XB_XSUB(b.x)], 1u);
        const unsigned gen = old / nloc;
        if (old + 1u == (gen + 1u) * nloc) {
            __builtin_amdgcn_fence(__ATOMIC_RELEASE, "agent");
            asm volatile("s_waitcnt vmcnt(0)" ::: "memory");
            const unsigned og = xb_add(&bar[XB_TOP], 1u);
            const unsigned tg = og / nx;
            if (og + 1u == (tg + 1u) * nx) xb_add(&bar[XB_TOPGEN], 1u);
            else XB_SPIN(xb_ld(&bar[XB_TOPGEN]) == tg, bar);
            __builtin_amdgcn_fence(__ATOMIC_ACQUIRE, "agent");
            xb_add(&bar[XB_XGEN(b.x)], 1u);
            asm volatile("s_waitcnt vmcnt(0)" ::: "memory");
        } else {
            XB_SPIN(xb_ld(&bar[XB_XGEN(b.x)]) == gen, bar);
            __builtin_amdgcn_fence(__ATOMIC_ACQUIRE, "agent");
            asm volatile("s_waitcnt vmcnt(0)" ::: "memory");
        }
    }
    __syncthreads();
}

struct Args { const float* in[22]; float* out; unsigned char* ws; int ph_lo, ph_hi, li, pad; };
struct Frame {
    LAS unsigned char* lds; volatile LAS unsigned* MISC; gu32* ctl;
    int wave, vcu, G;
    unsigned char* ws;
};
__device__ __forceinline__ float wave_sum(float v) {
#pragma unroll
    for (int o = 1; o < 64; o <<= 1) v += __shfl_xor(v, o);
    return v;
}
__device__ __forceinline__ void tr_item(const float* __restrict__ W, int ldw, const float* __restrict__ gain, bf16_t* WT, int ldt, int k0, int n0, long drow0, LAS float* scr, int lane) {
#pragma unroll 8
    for (int i = 0; i < 32; ++i) { const int kk = 2 * i + (lane >> 5); float v = W[(size_t)(k0 + kk) * ldw + n0 + (lane & 31)]; if (gain) v *= gain[k0 + kk]; scr[kk * 33 + (lane & 31)] = v; }
    LDS_WAIT(); asm volatile("" ::: "memory");
    const int c = lane & 7;
#pragma unroll
    for (int j = 0; j < 4; ++j) { const int n = (lane >> 3) + 8 * j; const LAS float* s = scr + (8 * c) * 33 + n;
        u32x4 o; o.x = cvtpk(s[0 * 33], s[1 * 33]); o.y = cvtpk(s[2 * 33], s[3 * 33]); o.z = cvtpk(s[4 * 33], s[5 * 33]); o.w = cvtpk(s[6 * 33], s[7 * 33]);
        *(GAS u32x4*)(WT + (size_t)(drow0 + n) * ldt + k0 + 8 * c) = o; }
    LDS_WAIT(); asm volatile("" ::: "memory");
}
__device__ __forceinline__ void rms_row_to_bf16(const float* xrow, const float* __restrict__ gain, bf16_t* orow, int lane) {
    const GAS f32x4* xr = (const GAS f32x4*)xrow + lane; const f32x4* gr = (const f32x4*)gain + lane;
    f32x4 v[8]; float s = 0.f;
#pragma unroll
    for (int j = 0; j < 8; ++j) { v[j] = xr[64 * j]; s += (v[j].x * v[j].x + v[j].y * v[j].y) + (v[j].z * v[j].z + v[j].w * v[j].w); }
    const float r = rsqrtf(wave_sum(s) * (1.f / DM) + EPS);
    GAS u32x2* o8 = (GAS u32x2*)orow + lane;
#pragma unroll
    for (int j = 0; j < 8; ++j) { const f32x4 g = gr[64 * j]; u32x2 w; w.x = cvtpk(v[j].x * r * g.x, v[j].y * r * g.y); w.y = cvtpk(v[j].z * r * g.z, v[j].w * r * g.w); o8[64 * j] = w; }
}

__device__ __forceinline__ void expert_tr_items(const Frame& F, const float* eg, const float* eu, const float* ed, int layer, LAS float* scr) {
    const int e_lane = lane_id();
    const int gw = F.vcu * NWAVES + F.wave, NGW = F.G * NWAVES;
    bf16_t* WGU = (bf16_t*)(F.ws + WS_WGU_T); bf16_t* WD = (bf16_t*)(F.ws + WS_WD_T);
    for (int it = gw; it < NE * 3072; it += NGW) {
        const int e = it / 3072, r = it % 3072; const size_t eo = (size_t)(layer * NE + e);
        if (r < 2048) { const int up = r >> 10, q = r & 1023, kb = q >> 5, nb = q & 31, n0 = nb * 32;
            const float* W = (up ? eu : eg) + eo * DM * EFF; const long drow0 = (long)(n0 >> 7) * 256 + up * 128 + (n0 & 127);
            tr_item(W, EFF, nullptr, WGU + (size_t)e * 2048 * 2048, 2048, kb * 64, n0, drow0, scr, e_lane);
        } else { const int q = r - 2048, kb = q >> 6, nb = q & 63;
            tr_item(ed + eo * EFF * DM, DM, nullptr, WD + (size_t)e * 2048 * 1024, 1024, kb * 64, nb * 32, nb * 32, scr, e_lane); }
    }
}

__device__ __forceinline__ void p0_prologue(Frame& F, const Args& args) {
    const float* x = args.in[0]; const float* mem = args.in[1]; const float* mix_norm = args.in[2]; const float* w_in = args.in[3];
    const float* w_four = args.in[6]; const float* w_out = args.in[7]; const float* pool_w = args.in[8]; const float* cross_norm = args.in[10]; const float* mem_norm = args.in[11];
    const int gw = F.vcu * NWAVES + F.wave, NGW = F.G * NWAVES;
    const int p_lane = lane_id(), p_tid = F.wave * 64 + p_lane;
    { LAS float* tab = (LAS float*)(F.lds + RING_OFF);
      for (int m = p_tid; m < 2048; m += 512) tab[m] = cosf(6.283185307179586f * (float)m * (1.0f / 2048.0f));
      __syncthreads();
      bf16_t* DFT = (bf16_t*)(F.ws + WS_DFT);
      for (int row = F.vcu * 8; row < 2048; row += F.G * 8)
          for (int rr = 0; rr < 8; ++rr) { const int k1 = row + rr; if (k1 >= 2048) break;
              { const int c0 = p_tid * 8; const int which = c0 >> 11, s0 = c0 & 2047; unsigned w[4];
#pragma unroll
                for (int j = 0; j < 4; ++j) { const int ma = (k1 * (s0 + 2 * j)) & 2047, mb = (k1 * (s0 + 2 * j + 1)) & 2047;
                    w[j] = cvtpk(tab[(ma - which * 512) & 2047], tab[(mb - which * 512) & 2047]); }
                *(GAS u32x4*)(DFT + (size_t)k1 * 4096 + c0) = (u32x4){w[0], w[1], w[2], w[3]}; } }
      __syncthreads(); }
    { float* RC = (float*)(F.ws + WS_ROPE); float* RS = RC + SEQ * 64;
      for (int i = F.vcu * 512 + p_tid; i < SEQ * 64; i += F.G * 512) { const int t = i >> 6, p = i & 63; const int pos = (p < 32) ? (t >> 6) : (t & 63); const int j = p & 31;
          const float inv = 1.0f / powf(10000.0f, (float)(2 * j) / 64.0f); const float ang = (float)pos * inv; RC[i] = cosf(ang); RS[i] = sinf(ang); } }
    { LAS float* Mw = (LAS float*)(F.lds + RING_OFF); LAS float* t128 = Mw + 128 * 32;
      bf16_t* WF = (bf16_t*)(F.ws + WS_WF_T);
      for (int it = F.vcu; it < 256; it += F.G) {
          const int which = it >> 7, g = (it >> 5) & 3, d0 = ((it >> 3) & 3) * 32, k0 = (it & 7) * 256;
          if (p_tid < 128) t128[p_tid] = cosf(6.283185307179586f * (float)p_tid * (1.0f / 128.0f));
          __syncthreads();
          { const int c = p_tid >> 2, dd = (p_tid & 3) * 8; float o[8] = {0.f, 0.f, 0.f, 0.f, 0.f, 0.f, 0.f, 0.f};
            for (int k2 = 0; k2 < 128; ++k2) { const int m = (c * k2) & 127; const float tv = which ? -t128[(m - 32) & 127] : t128[m];
                const float* wr_ = w_four + ((size_t)g * 128 + k2) * 128 + d0 + dd; const f32x4 w0 = *(const f32x4*)wr_, w1 = *(const f32x4*)(wr_ + 4);
                o[0] += tv * w0.x; o[1] += tv * w0.y; o[2] += tv * w0.z; o[3] += tv * w0.w; o[4] += tv * w1.x; o[5] += tv * w1.y; o[6] += tv * w1.z; o[7] += tv * w1.w; }
#pragma unroll
            for (int j = 0; j < 8; ++j) Mw[c * 32 + dd + j] = o[j] * (1.0f / 512.0f); }
          __syncthreads();
          { const int kp = p_tid & 127, dq = p_tid >> 7, k = k0 + 2 * kp; float o0[8] = {0.f, 0.f, 0.f, 0.f, 0.f, 0.f, 0.f, 0.f}, o1[8] = {0.f, 0.f, 0.f, 0.f, 0.f, 0.f, 0.f, 0.f};
            const float* r0 = w_in + (size_t)k * INW + 2560 + g * 128; const float* r1 = r0 + INW;
            for (int c4 = 0; c4 < 32; ++c4) { const f32x4 a = *(const f32x4*)(r0 + 4 * c4), b = *(const f32x4*)(r1 + 4 * c4); const float av[4] = {a.x, a.y, a.z, a.w}, bv[4] = {b.x, b.y, b.z, b.w};
#pragma unroll
                for (int cc = 0; cc < 4; ++cc) { const LAS float* mr = Mw + (4 * c4 + cc) * 32 + dq * 8;
#pragma unroll
                    for (int j = 0; j < 8; ++j) { o0[j] += av[cc] * mr[j]; o1[j] += bv[cc] * mr[j]; } } }
#pragma unroll
            for (int j = 0; j < 8; ++j) *(GAS unsigned*)(WF + (size_t)(which * 512 + g * 128 + d0 + dq * 8 + j) * DM + k) = cvtpk(o0[j], o1[j]); }
          __syncthreads(); } }
    { LAS float* scr = (LAS float*)(F.lds + RING_OFF + F.wave * 16384);
      constexpr int I_IN = 32 * 80, I_SQ = 32 * 64, I_P = 32 * 16;
      constexpr int NIT = I_IN + 9 * I_SQ + I_P;
      for (int it = gw; it < NIT; it += NGW) {
          int r = it;
          if (r < I_IN) { tr_item(w_in, INW, nullptr, (bf16_t*)(F.ws + WS_WIN_T), DM, (r / 80) * 64, (r % 80) * 32, (r % 80) * 32, scr, p_lane); continue; } r -= I_IN;
          if (r < I_SQ) { tr_item(w_out, DM, nullptr, (bf16_t*)(F.ws + WS_WOUT_T), DM, (r / 64) * 64, (r % 64) * 32, (r % 64) * 32, scr, p_lane); continue; } r -= I_SQ;
          { const int j = r / I_SQ; if (j < 8) { const int q = r % I_SQ, wsel = j >> 1, layer = j & 1;
              const float* W = args.in[12 + wsel] + (size_t)layer * DM * DM; const size_t wso = (wsel == 0 ? WS_WCQ_T : wsel == 1 ? WS_WCK_T : wsel == 2 ? WS_WCV_T : WS_WCO_T) + (size_t)layer * DM * DM * 2;
              tr_item(W, DM, wsel == 0 ? cross_norm + layer * DM : nullptr, (bf16_t*)(F.ws + wso), DM, (q / 64) * 64, (q % 64) * 32, (q % 64) * 32, scr, p_lane); continue; } r -= 8 * I_SQ; }
          tr_item(pool_w, 512, nullptr, (bf16_t*)(F.ws + WS_WP_T), DM, (r / 16) * 64, (r % 16) * 32, (r % 16) * 32, scr, p_lane);
      }
      expert_tr_items(F, args.in[18], args.in[19], args.in[20], 0, scr); }
    for (int m = gw; m < NTOK; m += NGW) rms_row_to_bf16(x + (size_t)m * DM, mix_norm, (bf16_t*)(F.ws + WS_HN) + (size_t)m * DM, p_lane);
    for (int m = gw; m < 2 * NB * MEML; m += NGW) { const int l = m / (NB * MEML), r = m % (NB * MEML);
        rms_row_to_bf16(mem + (size_t)r * DM, mem_norm + l * DM, (bf16_t*)(F.ws + WS_MEMNB) + (size_t)m * DM, p_lane); }
}

struct MapLin { const char* A; const char* B; size_t as, bs; __device__ __forceinline__ void operator()(pg8::Unit& u) const { u.a = A + (size_t)u.pm * as; u.b = B + (size_t)u.pn * bs; } };

struct EpiQKV {
    static constexpr bool PERM = true;
    bf16_t* Q; bf16_t* K; bf16_t* V; const float* qg; const float* kg; const float* RC; const float* RS;
    __device__ __forceinline__ void operator()(f32x4 (&acc)[2][2][4][2], const pg8::Unit& u, const pg8::EpiCtx& c) const { const int e_lane = lane_id(), e_fr = e_lane & 15, e_fq = e_lane >> 4;
        const int pn = u.pn, hc = c.wc * 32 + e_fq * 8, rl0 = c.wr * 64 + e_fr;
        if (pn >= 8) {
            bf16_t* base = V + (size_t)(u.pm * 256 + rl0) * KVW + (pn - 8) * 256 + hc;
#pragma unroll
            for (int ai = 0; ai < 2; ++ai)
#pragma unroll
                for (int m = 0; m < 4; ++m) { bf16_t* rowp = base + (size_t)(ai * 128 + m * 16) * KVW;
#pragma unroll
                    for (int bj = 0; bj < 2; ++bj) { const f32x4 v0 = acc[ai][bj][m][0], v1 = acc[ai][bj][m][1];
                        *(u32x4*)(rowp + bj * 128) = (u32x4){cvtpk(v0.x, v0.y), cvtpk(v0.z, v0.w), cvtpk(v1.x, v1.y), cvtpk(v1.z, v1.w)}; } }
            return;
        }
        LAS float* part = (LAS float*)c.xl;
#pragma unroll
        for (int ai = 0; ai < 2; ++ai)
#pragma unroll
            for (int m = 0; m < 4; ++m)
#pragma unroll
                for (int bj = 0; bj < 2; ++bj) { const f32x4 v0 = acc[ai][bj][m][0], v1 = acc[ai][bj][m][1];
                    float s = (v0.x * v0.x + v0.y * v0.y) + (v0.z * v0.z + v0.w * v0.w) + (v1.x * v1.x + v1.y * v1.y) + (v1.z * v1.z + v1.w * v1.w);
                    s += __shfl_xor(s, 16); s += __shfl_xor(s, 32);
                    if (e_fq == 0) part[((ai * 128 + rl0 + m * 16) * 2 + bj) * 4 + c.wc] = s; }
        WG_BAR();
        const float* gain = pn < 6 ? qg : kg;
        const f32x4 g0 = *(const f32x4*)(gain + hc), g1 = *(const f32x4*)(gain + hc + 4);
        bf16_t* O = pn < 6 ? Q : K; const int ld = pn < 6 ? AW : KVW; const int colbase = (pn < 6 ? pn : pn - 6) * 256 + hc;
#pragma unroll
        for (int ai = 0; ai < 2; ++ai)
#pragma unroll
            for (int m = 0; m < 4; ++m) { const int rl = ai * 128 + rl0 + m * 16, row = u.pm * 256 + rl, sp = row & (SEQ - 1);
                const f32x4 cs = *(const f32x4*)(RC + sp * 64 + (hc >> 1)), sn = *(const f32x4*)(RS + sp * 64 + (hc >> 1));
#pragma unroll
                for (int bj = 0; bj < 2; ++bj) { const f32x4 p4 = *(const LAS f32x4*)(part + (rl * 2 + bj) * 4);
                    const float r = rsqrtf(((p4.x + p4.y) + (p4.z + p4.w)) * (1.0f / 128.0f) + EPS);
                    const f32x4 v0 = acc[ai][bj][m][0] * r * g0, v1 = acc[ai][bj][m][1] * r * g1;
                    u32x4 w; w.x = cvtpk(v0.x * cs.x - v0.y * sn.x, v0.x * sn.x + v0.y * cs.x); w.y = cvtpk(v0.z * cs.y - v0.w * sn.y, v0.z * sn.y + v0.w * cs.y);
                    w.z = cvtpk(v1.x * cs.z - v1.y * sn.z, v1.x * sn.z + v1.y * cs.z); w.w = cvtpk(v1.z * cs.w - v1.w * sn.w, v1.z * sn.w + v1.w * cs.w);
                    *(u32x4*)(O + (size_t)row * ld + colbase + bj * 128) = w; } }
    }
};


template <class AddrF> struct EpiStore {
    static constexpr bool PERM = true; AddrF f;
    __device__ __forceinline__ void operator()(f32x4 (&acc)[2][2][4][2], const pg8::Unit& u, const pg8::EpiCtx& c) const { const int e_lane = lane_id(), e_fr = e_lane & 15, e_fq = e_lane >> 4;
        const int hc = c.wc * 32 + e_fq * 8, rl0 = c.wr * 64 + e_fr;
#pragma unroll
        for (int ai = 0; ai < 2; ++ai)
#pragma unroll
            for (int m = 0; m < 4; ++m)
#pragma unroll
                for (int bj = 0; bj < 2; ++bj) { const f32x4 v0 = acc[ai][bj][m][0], v1 = acc[ai][bj][m][1];
                    *(u32x4*)f(u, ai * 128 + rl0 + m * 16, bj * 128 + hc) = (u32x4){cvtpk(v0.x, v0.y), cvtpk(v0.z, v0.w), cvtpk(v1.x, v1.y), cvtpk(v1.z, v1.w)}; }
    }
};
struct AddrF1 { bf16_t* FPQ; __device__ __forceinline__ bf16_t* operator()(const pg8::Unit& u, int rl, int tc) const {
    const int r = u.pm * 256 + rl, which = r >> 9, n = r & 511, cidx = u.pn * 256 + tc, b = cidx >> 11, s = cidx & 2047; return FPQ + (((size_t)(b * 512 + n) * 2 + which) * 2048 + s); } };
struct AddrF2 { bf16_t* MIX; __device__ __forceinline__ bf16_t* operator()(const pg8::Unit& u, int rl, int tc) const {
    const int row = (u.pn >> 1) * 2048 + u.pm * 256 + rl, col = AW + (u.pn & 1) * 256 + tc; return MIX + (size_t)row * DM + col; } };

struct EpiRes {
    static constexpr bool PERM = false;
    const float* base; float* out; bf16_t* xb; float* ssp; const float* cscale; int npn;
    __device__ __forceinline__ void operator()(f32x4 (&acc)[2][2][4][2], const pg8::Unit& u, const pg8::EpiCtx& c) const { const int e_lane = lane_id(), e_fr = e_lane & 15, e_fq = e_lane >> 4;
        const int col0 = u.pn * 256 + c.wc * 32 + 4 * e_fq, rl0 = c.wr * 64 + e_fr;
        LAS float* part = (LAS float*)c.xl;
#pragma unroll
        for (int ai = 0; ai < 2; ++ai)
#pragma unroll
            for (int m = 0; m < 4; ++m) { const int rl = ai * 128 + rl0 + m * 16; const size_t off = (size_t)(u.pm * 256 + rl) * DM + col0; float s = 0.f;
#pragma unroll
                for (int bj = 0; bj < 2; ++bj)
#pragma unroll
                    for (int n = 0; n < 2; ++n) { const size_t o2 = off + bj * 128 + n * 16; f32x4 v = acc[ai][bj][m][n];
                        if (cscale) v = v * *(const f32x4*)(cscale + col0 + bj * 128 + n * 16);
                        v = v + *(const f32x4*)(base + o2);
                        *(f32x4*)(out + o2) = v;
                        if (xb) { *(u32x2*)(xb + o2) = (u32x2){cvtpk(v.x, v.y), cvtpk(v.z, v.w)}; s += (v.x * v.x + v.y * v.y) + (v.z * v.z + v.w * v.w); } }
                if (xb) { s += __shfl_xor(s, 16); s += __shfl_xor(s, 32); if (e_fq == 0) part[rl * 4 + c.wc] = s; }
                asm volatile("" ::: "memory"); }
        if (xb) { WG_BAR();
            if (e_lane < 32) { const int row = c.wid * 32 + e_lane; const f32x4 p4 = *(const LAS f32x4*)(part + row * 4);
                ssp[(size_t)(u.pm * 256 + row) * npn + u.pn] = (p4.x + p4.y) + (p4.z + p4.w); }
            WG_BAR(); }
    }
};

namespace attn {
using s16x4 = __attribute__((ext_vector_type(4))) short;
using f32x16 = __attribute__((ext_vector_type(16))) float;
constexpr int D = 128, NW = 8, QBLK = 32, KVBLK = 64;
constexpr float SCALE = 0.088388347648318440f;
constexpr float THR = 0.f;
#ifndef ATT_SDEPTH
#define ATT_SDEPTH 1
#endif
constexpr int LDQ = AW, LDK = KVW, LDO = DM;
constexpr size_t SHM_V = KVBLK * D * 2, SHM_K = KVBLK * D * 2, SHM_ATTN = 2 * SHM_V + 2 * SHM_K + NW * 64 * 4;
#define KSWZ(row, colB) ((row) * 256 + ((colB) ^ (((row) & 7) << 4)))
#define SBAR() __builtin_amdgcn_sched_barrier(0)
__device__ __forceinline__ int crow(int r, int hi) { return (r & 3) + 8 * (r >> 2) + 4 * hi; }
__device__ __forceinline__ unsigned cvtpk_a(float lo, float hi) { unsigned r; asm volatile("v_cvt_pk_bf16_f32 %0, %1, %2" : "=v"(r) : "v"(lo), "v"(hi)); return r; }
__device__ __forceinline__ void partialSM(f32x16& p0, f32x16& p1, float& m_reg, float& mn, float& alpha) {
  constexpr float C = SCALE * 1.4426950408889634f;
  float pmax = p0[0]; for (int r = 1; r < 16; ++r) pmax = fmaxf(pmax, p0[r]); for (int r = 0; r < 16; ++r) pmax = fmaxf(pmax, p1[r]);
  { auto rr = __builtin_amdgcn_permlane32_swap(__float_as_uint(pmax), __float_as_uint(pmax), false, false);
    pmax = fmaxf(__uint_as_float(rr[0]), __uint_as_float(rr[1])); }
  if (__builtin_expect(__all(pmax - m_reg <= THR / SCALE), 1)) { mn = m_reg; alpha = 1.f; }
  else { mn = fmaxf(m_reg, pmax); alpha = __builtin_amdgcn_exp2f((m_reg - mn) * C); m_reg = mn; }
  float mnC = -mn * C;
  for (int r = 0; r < 16; ++r) p0[r] = fmaf(p0[r], C, mnC); for (int r = 0; r < 16; ++r) p1[r] = fmaf(p1[r], C, mnC);
  for (int r = 0; r < 16; ++r) p0[r] = __builtin_amdgcn_exp2f(p0[r]);
}
__device__ __forceinline__ void finishSM(f32x16& p0, f32x16& p1, float alpha, float& l_reg, bf16x8& pa0, bf16x8& pa1, bf16x8& pa2, bf16x8& pa3) {
  for (int r = 0; r < 16; ++r) p1[r] = __builtin_amdgcn_exp2f(p1[r]);
  float ps = 0; for (int r = 0; r < 16; ++r) ps += p0[r]; for (int r = 0; r < 16; ++r) ps += p1[r];
  { auto rr = __builtin_amdgcn_permlane32_swap(__float_as_uint(ps), __float_as_uint(ps), false, false);
    ps = __uint_as_float(rr[0]) + __uint_as_float(rr[1]); }
  l_reg = l_reg * alpha + ps;
#define PK4(P, BASE, OUT) do { unsigned a0 = cvtpk_a(P[BASE + 0], P[BASE + 1]), a1 = cvtpk_a(P[BASE + 2], P[BASE + 3]);   \
    unsigned b0 = cvtpk_a(P[BASE + 4], P[BASE + 5]), b1 = cvtpk_a(P[BASE + 6], P[BASE + 7]);                              \
    auto r0 = __builtin_amdgcn_permlane32_swap(a0, b0, false, false); auto r1 = __builtin_amdgcn_permlane32_swap(a1, b1, false, false); \
    u32x4 w = {r0[0], r1[0], r0[1], r1[1]}; OUT = *reinterpret_cast<bf16x8*>(&w); } while (0)
  PK4(p0, 0, pa0); PK4(p0, 8, pa1); PK4(p1, 0, pa2); PK4(p1, 8, pa3);
#undef PK4
}
__device__ __forceinline__ void qkt(f32x16& p0, f32x16& p1, const bf16_t* Ks, const bf16x8* qr, int r32, int hi) {
  p0 = f32x16{}; p1 = f32x16{};
  for (int d0 = 0; d0 < 8; ++d0) { int cb = (d0 * 16 + hi * 8) * 2;
    bf16x8 b0 = *reinterpret_cast<const bf16x8*>((const char*)Ks + KSWZ(r32, cb));
    bf16x8 b1 = *reinterpret_cast<const bf16x8*>((const char*)Ks + KSWZ(32 + r32, cb));
    p0 = __builtin_amdgcn_mfma_f32_32x32x16_bf16(b0, qr[d0], p0, 0, 0, 0);
    p1 = __builtin_amdgcn_mfma_f32_32x32x16_bf16(b1, qr[d0], p1, 0, 0, 0); }
}
__device__ __forceinline__ int v_st(int k, int c) { const int kk = (k & ~0xC) | ((k & 4) << 1) | ((k & 8) >> 1); return ((kk >> 3) * 4 + (c >> 5)) * 512 + ((kk & 7) * 32 + (c & 31)) * 2; }
__device__ __forceinline__ int v_rd_base(int lane) { return ((lane & 3) << 3) | (((lane >> 2) & 3) << 6) | (((lane >> 4) & 1) << 5) | (((lane >> 5) & 1) << 8); }
constexpr int v_rd_off(int d0, int ks, int half) { return d0 * 512 + ks * 4096 + half * 2048; }
template <int OFF> __device__ __forceinline__ s16x4 tr_read(int vb) {
  s16x4 r; asm volatile("ds_read_b64_tr_b16 %0, %1 offset:%2" : "=&v"(r) : "v"(vb), "i"(OFF) : "memory"); return r;
}
template <int D0> __device__ __forceinline__ void pv_one(f32x16& od, int vb, bf16x8 pa0, bf16x8 pa1, bf16x8 pa2, bf16x8 pa3) {
  const s16x4 l0 = tr_read<v_rd_off(D0, 0, 0)>(vb), h0 = tr_read<v_rd_off(D0, 0, 1)>(vb), l1 = tr_read<v_rd_off(D0, 1, 0)>(vb), h1 = tr_read<v_rd_off(D0, 1, 1)>(vb);
  const s16x4 l2 = tr_read<v_rd_off(D0, 2, 0)>(vb), h2 = tr_read<v_rd_off(D0, 2, 1)>(vb), l3 = tr_read<v_rd_off(D0, 3, 0)>(vb), h3 = tr_read<v_rd_off(D0, 3, 1)>(vb);
  asm volatile("s_waitcnt lgkmcnt(0)" ::: "memory"); SBAR();
#define PK(L, H) (bf16x8){L[0], L[1], L[2], L[3], H[0], H[1], H[2], H[3]}
  od = __builtin_amdgcn_mfma_f32_32x32x16_bf16(pa0, PK(l0, h0), od, 0, 0, 0);
  od = __builtin_amdgcn_mfma_f32_32x32x16_bf16(pa1, PK(l1, h1), od, 0, 0, 0);
  od = __builtin_amdgcn_mfma_f32_32x32x16_bf16(pa2, PK(l2, h2), od, 0, 0, 0);
  od = __builtin_amdgcn_mfma_f32_32x32x16_bf16(pa3, PK(l3, h3), od, 0, 0, 0);
#undef PK
}
__device__ __forceinline__ void pv_d0(f32x16* o, int vb, bf16x8 pa0, bf16x8 pa1, bf16x8 pa2, bf16x8 pa3) {
  pv_one<0>(o[0], vb, pa0, pa1, pa2, pa3); pv_one<1>(o[1], vb, pa0, pa1, pa2, pa3); pv_one<2>(o[2], vb, pa0, pa1, pa2, pa3); pv_one<3>(o[3], vb, pa0, pa1, pa2, pa3);
}
__device__ __forceinline__ void attn_dense_body(const bf16_t* __restrict__ Qb, const bf16_t* __restrict__ Kh, const bf16_t* __restrict__ Vh,
                                                bf16_t* __restrict__ Ob, int seq, char* lds, const int wave_) {
  constexpr int SDEPTH = ATT_SDEPTH;
  const int lane = lane_id(), wid = wave_, tid = wid * 64 + lane, r32 = lane & 31, hi = lane >> 5;
  bf16_t* V_lds = (bf16_t*)lds; bf16_t* K_lds = (bf16_t*)(lds + 2 * SHM_V);
  float* ws = (float*)(lds + 2 * SHM_V + 2 * SHM_K) + wid * 64; float* li_l = ws; float* al_l = ws + 32;
  float m_reg = -1e30f, l_reg = 0; f32x16 o[4] = {}; bf16x8 qr[8];
  const bf16_t* Qw = Qb + (long)(wid * QBLK + r32) * LDQ + hi * 8;
#pragma unroll
  for (int d0 = 0; d0 < 8; ++d0) qr[d0] = *reinterpret_cast<const bf16x8*>(Qw + d0 * 16);
  const int sr = tid >> 4, sc = (tid & 15) * 8, vst0 = v_st(sr, sc), vst1 = v_st(32 + sr, sc);
  const int vb0 = (int)(uintptr_t)V_lds + v_rd_base(lane);
  struct { bf16x8 vs0, vs1, ks0, ks1; } sr_[SDEPTH];
#define SLOAD(i, k0) do { sr_[i].vs0 = *reinterpret_cast<const bf16x8*>(&Vh[(long)((k0) + sr) * LDK + sc]); sr_[i].vs1 = *reinterpret_cast<const bf16x8*>(&Vh[(long)((k0) + 32 + sr) * LDK + sc]); \
    sr_[i].ks0 = *reinterpret_cast<const bf16x8*>(&Kh[(long)((k0) + sr) * LDK + sc]); sr_[i].ks1 = *reinterpret_cast<const bf16x8*>(&Kh[(long)((k0) + 32 + sr) * LDK + sc]); } while (0)
#define SWRITE(b, i) do { *(bf16x8*)((char*)V_lds + (b) * SHM_V + vst0) = sr_[i].vs0;          \
    *(bf16x8*)((char*)V_lds + (b) * SHM_V + vst1) = sr_[i].vs1; int kc = sc * 2;               \
    *(bf16x8*)((char*)K_lds + (b) * SHM_K + KSWZ(sr, kc)) = sr_[i].ks0;                       \
    *(bf16x8*)((char*)K_lds + (b) * SHM_K + KSWZ(32 + sr, kc)) = sr_[i].ks1; } while (0)
#define SWAIT() do { if constexpr (SDEPTH == 2) asm volatile("s_waitcnt vmcnt(4)" ::: "memory"); else asm volatile("s_waitcnt vmcnt(0)" ::: "memory"); } while (0)
#define RESC(a) do { if (__any((a) < 1.f)) { if (hi == 0) al_l[r32] = (a); asm volatile("s_waitcnt lgkmcnt(0)" ::: "memory"); \
    for (int d = 0; d < 4; ++d) for (int r = 0; r < 16; ++r) o[d][r] *= al_l[crow(r, hi)]; } } while (0)
  f32x16 pA0, pA1, pB0, pB1; float mnA, mnB, alA, alB; bf16x8 pa0, pa1, pa2, pa3; const int NT = seq / KVBLK;
  constexpr int SE = 0, SO = SDEPTH - 1;
  SLOAD(SE, 0); asm volatile("s_waitcnt vmcnt(0)" ::: "memory"); SWRITE(0, SE); __syncthreads();
  qkt(pA0, pA1, K_lds, qr, r32, hi); partialSM(pA0, pA1, m_reg, mnA, alA);
  SLOAD(SO, KVBLK); if constexpr (SDEPTH == 2) { if (2 < NT) SLOAD(SE, 2 * KVBLK); }
  SWAIT(); SWRITE(1, SO); __syncthreads();
  for (int j = 1; j + 1 < NT; j += 2) {
    SBAR(); qkt(pB0, pB1, (bf16_t*)((char*)K_lds + SHM_K), qr, r32, hi);
    finishSM(pA0, pA1, alA, l_reg, pa0, pa1, pa2, pa3); SBAR();
    SLOAD(SO, (j + SDEPTH) * KVBLK); SBAR();
    pv_d0(o, vb0, pa0, pa1, pa2, pa3); partialSM(pB0, pB1, m_reg, mnB, alB);
    __syncthreads(); SWAIT(); SWRITE(0, SE);
    RESC(alB); __syncthreads();
    SBAR(); qkt(pA0, pA1, K_lds, qr, r32, hi);
    finishSM(pB0, pB1, alB, l_reg, pa0, pa1, pa2, pa3); SBAR();
    if (SDEPTH == 1 || j + 3 < NT) SLOAD(SE, (j + 1 + SDEPTH) * KVBLK); SBAR();
    pv_d0(o, vb0 + (int)SHM_V, pa0, pa1, pa2, pa3); partialSM(pA0, pA1, m_reg, mnA, alA);
    __syncthreads(); SWAIT(); SWRITE(1, SO);
    RESC(alA); __syncthreads();
  }
  SBAR(); qkt(pB0, pB1, (bf16_t*)((char*)K_lds + SHM_K), qr, r32, hi);
  finishSM(pA0, pA1, alA, l_reg, pa0, pa1, pa2, pa3); SBAR();
  pv_d0(o, vb0, pa0, pa1, pa2, pa3); partialSM(pB0, pB1, m_reg, mnB, alB);
  __syncthreads(); RESC(alB);
  finishSM(pB0, pB1, alB, l_reg, pa0, pa1, pa2, pa3); SBAR();
  pv_d0(o, vb0 + (int)SHM_V, pa0, pa1, pa2, pa3);
  if (hi == 0) li_l[r32] = l_reg; asm volatile("s_waitcnt lgkmcnt(0)" ::: "memory");
  float rli[16];
#pragma unroll
  for (int r = 0; r < 16; ++r) rli[r] = __builtin_amdgcn_rcpf(li_l[crow(r, hi)]);
  bf16_t* Ow = Ob + (long)(wid * QBLK) * LDO;
#pragma unroll
  for (int r = 0; r < 16; ++r) { int orow = crow(r, hi);
    for (int d0 = 0; d0 < 4; ++d0) Ow[(long)orow * LDO + d0 * 32 + r32] = (bf16_t)(cvtpk(o[d0][r] * rli[r], 0.f) & 0xffffu); }
#undef SLOAD
#undef SWRITE
#undef SWAIT
#undef RESC
  __syncthreads();
}
#undef KSWZ
#undef SBAR
}

struct AddrLin { bf16_t* O; int ld; __device__ __forceinline__ bf16_t* operator()(const pg8::Unit& u, int rl, int tc) const { return O + (size_t)(u.pm * 256 + rl) * ld + u.pn * 256 + tc; } };
struct EpiRowScale {
    static constexpr bool PERM = true; bf16_t* O; int ld; const float* ssp; float cscale;
    __device__ __forceinline__ void operator()(f32x4 (&acc)[2][2][4][2], const pg8::Unit& u, const pg8::EpiCtx& c) const { const int e_lane = lane_id(), e_fr = e_lane & 15, e_fq = e_lane >> 4;
        const int hc = c.wc * 32 + e_fq * 8, rl0 = c.wr * 64 + e_fr;
#pragma unroll
        for (int ai = 0; ai < 2; ++ai)
#pragma unroll
            for (int m = 0; m < 4; ++m) { const int row = u.pm * 256 + ai * 128 + rl0 + m * 16; const f32x4 p0 = *(const f32x4*)(ssp + (size_t)row * 8), p1 = *(const f32x4*)(ssp + (size_t)row * 8 + 4);
                const float r = rsqrtf((((p0.x + p0.y) + (p0.z + p0.w)) + ((p1.x + p1.y) + (p1.z + p1.w))) * (1.0f / DM) + EPS) * cscale;
#pragma unroll
                for (int bj = 0; bj < 2; ++bj) { const f32x4 v0 = acc[ai][bj][m][0] * r, v1 = acc[ai][bj][m][1] * r;
                    *(u32x4*)(O + (size_t)row * ld + u.pn * 256 + bj * 128 + hc) = (u32x4){cvtpk(v0.x, v0.y), cvtpk(v0.z, v0.w), cvtpk(v1.x, v1.y), cvtpk(v1.z, v1.w)}; } }
    }
};
struct EpiSoftmax {
    static constexpr bool PERM = true; bf16_t* P; int ld;
    __device__ __forceinline__ void operator()(f32x4 (&acc)[2][2][4][2], const pg8::Unit& u, const pg8::EpiCtx& c) const { const int e_lane = lane_id(), e_fr = e_lane & 15, e_fq = e_lane >> 4;
        const int hc = c.wc * 32 + e_fq * 8, rl0 = c.wr * 64 + e_fr;
        LAS float* pmx = (LAS float*)c.xl; LAS float* psm = pmx + 1024;
#pragma unroll
        for (int ai = 0; ai < 2; ++ai)
#pragma unroll
            for (int m = 0; m < 4; ++m) { float mx = -3.0e38f;
#pragma unroll
                for (int bj = 0; bj < 2; ++bj)
#pragma unroll
                    for (int n = 0; n < 2; ++n) { const f32x4 v = acc[ai][bj][m][n]; mx = fmaxf(fmaxf(mx, fmaxf(v.x, v.y)), fmaxf(v.z, v.w)); }
                mx = fmaxf(mx, __shfl_xor(mx, 16)); mx = fmaxf(mx, __shfl_xor(mx, 32));
                if (e_fq == 0) pmx[(ai * 128 + rl0 + m * 16) * 4 + c.wc] = mx; }
        WG_BAR();
#pragma unroll
        for (int ai = 0; ai < 2; ++ai)
#pragma unroll
            for (int m = 0; m < 4; ++m) { const int rl = ai * 128 + rl0 + m * 16; const f32x4 p4 = *(const LAS f32x4*)(pmx + rl * 4);
                const float mx = fmaxf(fmaxf(p4.x, p4.y), fmaxf(p4.z, p4.w)) * 1.4426950408889634f; float s = 0.f;
#pragma unroll
                for (int bj = 0; bj < 2; ++bj)
#pragma unroll
                    for (int n = 0; n < 2; ++n) { f32x4 v = acc[ai][bj][m][n];
                        v.x = __builtin_amdgcn_exp2f(fmaf(v.x, 1.4426950408889634f, -mx)); v.y = __builtin_amdgcn_exp2f(fmaf(v.y, 1.4426950408889634f, -mx));
                        v.z = __builtin_amdgcn_exp2f(fmaf(v.z, 1.4426950408889634f, -mx)); v.w = __builtin_amdgcn_exp2f(fmaf(v.w, 1.4426950408889634f, -mx));
                        s += (v.x + v.y) + (v.z + v.w); acc[ai][bj][m][n] = v; }
                s += __shfl_xor(s, 16); s += __shfl_xor(s, 32);
                if (e_fq == 0) psm[rl * 4 + c.wc] = s; }
        WG_BAR();
#pragma unroll
        for (int ai = 0; ai < 2; ++ai)
#pragma unroll
            for (int m = 0; m < 4; ++m) { const int rl = ai * 128 + rl0 + m * 16; const f32x4 p4 = *(const LAS f32x4*)(psm + rl * 4);
                const float inv = 1.0f / ((p4.x + p4.y) + (p4.z + p4.w));
#pragma unroll
                for (int bj = 0; bj < 2; ++bj) { const f32x4 v0 = acc[ai][bj][m][0] * inv, v1 = acc[ai][bj][m][1] * inv;
                    *(u32x4*)(P + (size_t)(u.pm * 256 + rl) * ld + u.pn * 256 + bj * 128 + hc) = (u32x4){cvtpk(v0.x, v0.y), cvtpk(v0.z, v0.w), cvtpk(v1.x, v1.y), cvtpk(v1.z, v1.w)}; } }
        WG_BAR();
    }
};
struct MapXS { const char* Q; const char* K; __device__ __forceinline__ void operator()(pg8::Unit& u) const {
    u.a = Q + ((size_t)u.pm * 256 * DM + (size_t)u.pn * MHD) * 2; u.b = K + ((size_t)(u.pm >> 3) * MEML * DM + (size_t)u.pn * MHD) * 2; } };
struct MapXPV { const char* P; const char* VT; __device__ __forceinline__ void operator()(pg8::Unit& u) const {
    u.a = P + ((size_t)u.pm * 256 * 1024 + (size_t)(u.pn >> 1) * MEML) * 2; u.b = VT + ((size_t)u.pn * 256 * 1024 + (size_t)(u.pm >> 3) * MEML) * 2; } };

struct MapMoE { const char* A; const char* W; size_t as, es, ws_; __device__ __forceinline__ void operator()(pg8::Unit& u) const {
    u.a = A + (size_t)u.pm * as; u.b = W + (size_t)(u.pm >> 2) * es + (size_t)u.pn * ws_; } };
struct EpiSwiGLU {
    static constexpr bool PERM = true; bf16_t* ACT;
    __device__ __forceinline__ void operator()(f32x4 (&acc)[2][2][4][2], const pg8::Unit& u, const pg8::EpiCtx& c) const { const int e_lane = lane_id(), e_fr = e_lane & 15, e_fq = e_lane >> 4;
        const int hc = c.wc * 32 + e_fq * 8, rl0 = c.wr * 64 + e_fr;
#pragma unroll
        for (int ai = 0; ai < 2; ++ai)
#pragma unroll
            for (int m = 0; m < 4; ++m) { f32x4 o[2];
#pragma unroll
                for (int n = 0; n < 2; ++n) { const f32x4 g = acc[ai][0][m][n], up = acc[ai][1][m][n]; f32x4 r;
                    r.x = g.x * __builtin_amdgcn_rcpf(1.0f + __builtin_amdgcn_exp2f(-1.4426950408889634f * g.x)) * up.x; r.y = g.y * __builtin_amdgcn_rcpf(1.0f + __builtin_amdgcn_exp2f(-1.4426950408889634f * g.y)) * up.y;
                    r.z = g.z * __builtin_amdgcn_rcpf(1.0f + __builtin_amdgcn_exp2f(-1.4426950408889634f * g.z)) * up.z; r.w = g.w * __builtin_amdgcn_rcpf(1.0f + __builtin_amdgcn_exp2f(-1.4426950408889634f * g.w)) * up.w; o[n] = r; }
                *(u32x4*)(ACT + (size_t)(u.pm * 256 + ai * 128 + rl0 + m * 16) * EFF + u.pn * 128 + hc) = (u32x4){cvtpk(o[0].x, o[0].y), cvtpk(o[0].z, o[0].w), cvtpk(o[1].x, o[1].y), cvtpk(o[1].z, o[1].w)}; }
    }
};
struct EpiRowGate {
    static constexpr bool PERM = true; bf16_t* Y; const float* gate;
    __device__ __forceinline__ void operator()(f32x4 (&acc)[2][2][4][2], const pg8::Unit& u, const pg8::EpiCtx& c) const { const int e_lane = lane_id(), e_fr = e_lane & 15, e_fq = e_lane >> 4;
        const int hc = c.wc * 32 + e_fq * 8, rl0 = c.wr * 64 + e_fr;
#pragma unroll
        for (int ai = 0; ai < 2; ++ai)
#pragma unroll
            for (int m = 0; m < 4; ++m) { const int row = u.pm * 256 + ai * 128 + rl0 + m * 16; const float gt = gate[row];
#pragma unroll
                for (int bj = 0; bj < 2; ++bj) { const f32x4 v0 = acc[ai][bj][m][0] * gt, v1 = acc[ai][bj][m][1] * gt;
                    *(u32x4*)(Y + (size_t)row * DM + u.pn * 256 + bj * 128 + hc) = (u32x4){cvtpk(v0.x, v0.y), cvtpk(v0.z, v0.w), cvtpk(v1.x, v1.y), cvtpk(v1.z, v1.w)}; } }
    }
};
__device__ __forceinline__ float rms_row_to_bf16_r(const float* xrow, const float* __restrict__ gain, bf16_t* orow, int lane) {
    const GAS f32x4* xr = (const GAS f32x4*)xrow + lane; const f32x4* gr = (const f32x4*)gain + lane;
    f32x4 v[8]; float s = 0.f;
#pragma unroll
    for (int j = 0; j < 8; ++j) { v[j] = xr[64 * j]; s += (v[j].x * v[j].x + v[j].y * v[j].y) + (v[j].z * v[j].z + v[j].w * v[j].w); }
    const float r = rsqrtf(wave_sum(s) * (1.f / DM) + EPS);
    GAS u32x2* o8 = (GAS u32x2*)orow + lane;
#pragma unroll
    for (int j = 0; j < 8; ++j) { const f32x4 g = gr[64 * j]; u32x2 w; w.x = cvtpk(v[j].x * r * g.x, v[j].y * r * g.y); w.y = cvtpk(v[j].z * r * g.z, v[j].w * r * g.w); o8[64 * j] = w; }
    return r;
}
__device__ __forceinline__ void router_phase(const Frame& F, const float* x, const float* __restrict__ gain, const float* __restrict__ Wr, bf16_t* HNo, float* aff) {
    const int lane = lane_id(), tid = F.wave * 64 + lane;
    LAS f32x4* Wl = (LAS f32x4*)(F.lds + RING_OFF);
    for (int i = tid; i < DM * 4; i += 512) { const int kk = i >> 2, q = i & 3; Wl[q * DM + kk] = *(const f32x4*)(Wr + (size_t)kk * NE + 4 * q); }
    __syncthreads();
    const int gw = (int)blockIdx.x * NWAVES + F.wave, NGW = F.G * NWAVES;
    for (int rb = gw * 4; rb < NTOK; rb += NGW * 4) {
        float rr[4];
#pragma unroll
        for (int j = 0; j < 4; ++j) rr[j] = rms_row_to_bf16_r(x + (size_t)(rb + j) * DM, gain, HNo + (size_t)(rb + j) * DM, lane);
        float a[64];
#pragma unroll
        for (int i = 0; i < 64; ++i) a[i] = 0.f;
        for (int i = 0; i < 32; ++i) { const int kk = lane + 64 * i; const float g = gain[kk]; float hv[4];
#pragma unroll
            for (int j = 0; j < 4; ++j) hv[j] = x[(size_t)(rb + j) * DM + kk] * rr[j] * g;
#pragma unroll
            for (int q = 0; q < 4; ++q) { const f32x4 w = Wl[q * DM + kk];
#pragma unroll
                for (int j = 0; j < 4; ++j) { a[j * 16 + 4 * q + 0] += hv[j] * w.x; a[j * 16 + 4 * q + 1] += hv[j] * w.y; a[j * 16 + 4 * q + 2] += hv[j] * w.z; a[j * 16 + 4 * q + 3] += hv[j] * w.w; } } }
#define RS_STEP(N, MASK) { const bool up_ = (lane & MASK) != 0; _Pragma("unroll") for (int i = 0; i < N; ++i) { const float keep = up_ ? a[i + N] : a[i], send = up_ ? a[i] : a[i + N]; a[i] = keep + __shfl_xor(send, MASK); } }
        RS_STEP(32, 32) RS_STEP(16, 16) RS_STEP(8, 8) RS_STEP(4, 4) RS_STEP(2, 2) RS_STEP(1, 1)
#undef RS_STEP
        float lg = a[0], mx = lg;
        mx = fmaxf(mx, __shfl_xor(mx, 8)); mx = fmaxf(mx, __shfl_xor(mx, 4)); mx = fmaxf(mx, __shfl_xor(mx, 2)); mx = fmaxf(mx, __shfl_xor(mx, 1));
        const float ex = expf(lg - mx); float sm = ex;
        sm += __shfl_xor(sm, 8); sm += __shfl_xor(sm, 4); sm += __shfl_xor(sm, 2); sm += __shfl_xor(sm, 1);
        const int row = rb + (lane >> 4), e = lane & 15, b = row / SEQ, t = row % SEQ;
        aff[((size_t)b * NE + e) * SEQ + t] = ex / sm;
    }
    __syncthreads();
}
__device__ __forceinline__ void rank_phase(const Frame& F, const float* aff, int* rank, float* gate, const bf16_t* HNi, bf16_t* XS) {
    const int lane = lane_id(), tid = F.wave * 64 + lane;
    LAS float* a = (LAS float*)(F.lds + RING_OFF);
    LAS int* list = (LAS int*)(F.lds + RING_OFF + 8192);
    LAS int* cntp = (LAS int*)(F.lds + RING_OFF + 8192 + 1024);
    for (int it = (int)blockIdx.x; it < NB * NE * 8; it += F.G) {
        const int be = it >> 3, chunk = it & 7, b = be >> 4, e = be & 15;
        for (int i = tid; i < SEQ / 4; i += 512) ((LAS f32x4*)a)[i] = *(const f32x4*)(aff + (size_t)be * SEQ + 4 * i);
        if (tid == 0) cntp[0] = 0;
        __syncthreads();
        const int tl = tid >> 1, half = tid & 1, t = chunk * 256 + tl; const float v = a[t]; int cnt = 0;
        for (int j4 = half * 256; j4 < half * 256 + 256; ++j4) { const f32x4 w = ((LAS f32x4*)a)[j4]; const int j = 4 * j4;
            cnt += (w.x > v || (w.x == v && j < t)) ? 1 : 0; cnt += (w.y > v || (w.y == v && j + 1 < t)) ? 1 : 0;
            cnt += (w.z > v || (w.z == v && j + 2 < t)) ? 1 : 0; cnt += (w.w > v || (w.w == v && j + 3 < t)) ? 1 : 0; }
        cnt += __shfl_xor(cnt, 1);
        if (half == 0) { rank[(size_t)be * SEQ + t] = cnt;
            if (cnt < CAP) { gate[(e * 4 + b) * CAP + cnt] = v; const int slot = atomicAdd((int*)cntp, 1); list[slot] = (t << 16) | cnt; } }
        __syncthreads();
        const int n = cntp[0];
        for (int li = F.wave; li < n; li += NWAVES) { const int pk = list[li], tt = pk >> 16, rk = pk & 0xffff;
            const u32x4* src = (const u32x4*)(HNi + ((size_t)b * SEQ + tt) * DM); u32x4* dst = (u32x4*)(XS + ((size_t)(e * 4 + b) * CAP + rk) * DM);
#pragma unroll
            for (int j = 0; j < 4; ++j) dst[lane + 64 * j] = src[lane + 64 * j]; }
        __syncthreads();
    }
}
__device__ __forceinline__ void combine_phase(const Frame& F, float* x, const bf16_t* Y, const int* rank, const float* __restrict__ gain, bf16_t* HNo, bool final_) {
    const int lane = lane_id();
    const int gw = (int)blockIdx.x * NWAVES + F.wave, NGW = F.G * NWAVES;
    for (int row = gw; row < NTOK; row += NGW) {
        const int b = row / SEQ, t = row % SEQ;
        int rk = CAP; if (lane < NE) rk = rank[((size_t)b * NE + lane) * SEQ + t];
        GAS f32x4* xr = (GAS f32x4*)(x + (size_t)row * DM) + lane; f32x4 v[8];
#pragma unroll
        for (int j = 0; j < 8; ++j) v[j] = xr[64 * j];
#pragma unroll
        for (int e = 0; e < NE; ++e) { const int r = __builtin_amdgcn_readlane(rk, e);
            if (r < CAP) { const u32x2* yr = (const u32x2*)(Y + ((size_t)(e * 4 + b) * CAP + r) * DM) + lane;
#pragma unroll
                for (int j = 0; j < 8; ++j) { const u32x2 w = yr[64 * j]; v[j].x += __uint_as_float(w.x << 16); v[j].y += __uint_as_float(w.x & 0xffff0000u); v[j].z += __uint_as_float(w.y << 16); v[j].w += __uint_as_float(w.y & 0xffff0000u); } } }
        float s = 0.f;
#pragma unroll
        for (int j = 0; j < 8; ++j) s += (v[j].x * v[j].x + v[j].y * v[j].y) + (v[j].z * v[j].z + v[j].w * v[j].w);
        const float r = rsqrtf(wave_sum(s) * (1.f / DM) + EPS); const f32x4* gr = (const f32x4*)gain + lane;
        if (final_) {
#pragma unroll
            for (int j = 0; j < 8; ++j) { const f32x4 g = gr[64 * j]; xr[64 * j] = (f32x4){v[j].x * r * g.x, v[j].y * r * g.y, v[j].z * r * g.z, v[j].w * r * g.w}; }
        } else { GAS u32x2* o8 = (GAS u32x2*)(HNo + (size_t)row * DM) + lane;
#pragma unroll
            for (int j = 0; j < 8; ++j) { const f32x4 g = gr[64 * j]; xr[64 * j] = v[j]; o8[64 * j] = (u32x2){cvtpk(v[j].x * r * g.x, v[j].y * r * g.y), cvtpk(v[j].z * r * g.z, v[j].w * r * g.w)}; } }
    }
}

struct MapPool { const char* A; const char* W; __device__ __forceinline__ void operator()(pg8::Unit& u) const {
    u.a = A + ((size_t)u.pm * 256 * DM + (size_t)(u.pn >> 1) * 512) * 2; u.b = W + ((size_t)(u.pn & 1) * 256 * DM + (size_t)(u.pn >> 1) * 512) * 2; } };
__device__ __forceinline__ void pool_phase(const Frame& F, const bf16_t* H, bf16_t* P) {
    const int lane = lane_id(); const int gt = ((int)blockIdx.x * NWAVES + F.wave) * 64 + lane, NT = F.G * NWAVES * 64;
    for (int idx = gt; idx < NTOK * (DM / 8); idx += NT) {
        const int row = idx >> 8, c8 = idx & 255, t = row & (SEQ - 1), g = c8 >> 6, w = 2 << g;
        int lo = t - (w >> 1), hi = t + (w >> 1); if (lo < 0) lo = 0; if (hi > SEQ) hi = SEQ;
        float s[8] = {0.f, 0.f, 0.f, 0.f, 0.f, 0.f, 0.f, 0.f}; float self[8];
        const bf16_t* base = H + (size_t)(row - t) * DM + c8 * 8;
        for (int j = lo; j < hi; ++j) { const u32x4 v = *(const u32x4*)(base + (size_t)j * DM);
            const float f[8] = {__uint_as_float(v.x << 16), __uint_as_float(v.x & 0xffff0000u), __uint_as_float(v.y << 16), __uint_as_float(v.y & 0xffff0000u),
                                __uint_as_float(v.z << 16), __uint_as_float(v.z & 0xffff0000u), __uint_as_float(v.w << 16), __uint_as_float(v.w & 0xffff0000u)};
#pragma unroll
            for (int i = 0; i < 8; ++i) { s[i] += f[i]; if (j == t) self[i] = f[i]; } }
        const float inv = 1.0f / (float)(hi - lo);
        *(u32x4*)(P + (size_t)row * DM + c8 * 8) = (u32x4){cvtpk(s[0] * inv - self[0], s[1] * inv - self[1]), cvtpk(s[2] * inv - self[2], s[3] * inv - self[3]),
                                                          cvtpk(s[4] * inv - self[4], s[5] * inv - self[5]), cvtpk(s[6] * inv - self[6], s[7] * inv - self[7])};
    }
}

constexpr int N_PHASES = 24;
__global__ void __launch_bounds__(NWAVES * 64, 2) skel_fwd(Args args) {
    extern __shared__ __attribute__((aligned(16))) unsigned char lds_raw[];
    Frame F;
    F.lds = (LAS unsigned char*)lds_raw; F.MISC = (volatile LAS unsigned*)(F.lds + MISC_OFF);
    F.wave = __builtin_amdgcn_readfirstlane(threadIdx.x >> 6);
    F.G = gridDim.x; { const int bx = blockIdx.x; F.vcu = (F.G % 8 == 0) ? (bx % 8) * (F.G / 8) + bx / 8 : bx; }
    unsigned char* const ws = uptr(args.ws);
    F.ws = ws; F.ctl = (gu32*)(ws + WS_CTL);
    for (int u = threadIdx.x; u < (LDS_BYTES - LDSCTL_OFF) / 4; u += NWAVES * 64) ((LAS unsigned*)(F.lds + LDSCTL_OFF))[u] = 0u;
    __syncthreads();
    const bool multi = (args.ph_hi - args.ph_lo) > 1;
    XcdBarrier bar; bar.bar = (unsigned*)(F.ctl + CW_BAR); bar.x = 0; bar.st = nullptr; bar.wave = F.wave;
    if (multi) bar = xcd_barrier_post((unsigned*)(F.ctl + CW_BAR), F.MISC + 8, F.wave);
    const int lo = args.ph_lo, hi = args.ph_hi;
#define IN(k) (lo <= (k) && (k) < hi)
#define SEAM(k) do { if (IN(k) && IN((k) + 1)) xcd_barrier(bar); } while (0)
    LAS unsigned char* ring = F.lds + RING_OFF; LAS unsigned char* xl = F.lds + XL_OFF;
    const int bx = (int)blockIdx.x, G = F.G;

    if (IN(0)) { p0_prologue(F, args); SEAM(0); }
    if (IN(1)) {
        {
            MapLin mp{(const char*)(ws + WS_HN), (const char*)(ws + WS_WIN_T), (size_t)256 * DM * 2, (size_t)256 * DM * 2};
            pg8::Sched<MapLin> S; S.init(NTOK / 256, 2560 / 256, G, bx, mp);
            EpiQKV E{(bf16_t*)(ws + WS_QB), (bf16_t*)(ws + WS_KB), (bf16_t*)(ws + WS_VB), args.in[4], args.in[5], (const float*)(ws + WS_ROPE), (const float*)(ws + WS_ROPE) + SEQ * 64};
            pg8::gemm_phase<EpiQKV, pg8::Sched<MapLin>, true>(F.wave, ring, xl, DM, DM * 2, DM * 2, S, E); }
        {
            MapLin mp{(const char*)(ws + WS_WF_T), (const char*)(ws + WS_HN), (size_t)256 * DM * 2, (size_t)256 * DM * 2};
            pg8::Sched<MapLin> S; S.init(1024 / 256, NTOK / 256, G, (bx + G - (320 % G)) % G, mp);
            EpiStore<AddrF1> E{AddrF1{(bf16_t*)(ws + WS_FPQ)}};
            pg8::gemm_phase<EpiStore<AddrF1>, pg8::Sched<MapLin>, true>(F.wave, ring, xl, DM, DM * 2, DM * 2, S, E); }
        for (int l = 0; l < 2; ++l) {
            { MapLin mp{(const char*)(ws + WS_MEMNB + (size_t)l * NB * MEML * DM * 2), (const char*)(ws + WS_WCK_T + (size_t)l * DM * DM * 2), (size_t)256 * DM * 2, (size_t)256 * DM * 2};
              pg8::Sched<MapLin> S; S.init(NB * MEML / 256, DM / 256, G, (bx + G - ((448 + 64 * l) % G)) % G, mp);
              EpiStore<AddrLin> E{AddrLin{(bf16_t*)(ws + WS_KCB + (size_t)l * NB * MEML * DM * 2), DM}};
              pg8::gemm_phase<EpiStore<AddrLin>, pg8::Sched<MapLin>, true>(F.wave, ring, xl, DM, DM * 2, DM * 2, S, E); }
            { MapLin mp{(const char*)(ws + WS_WCV_T + (size_t)l * DM * DM * 2), (const char*)(ws + WS_MEMNB + (size_t)l * NB * MEML * DM * 2), (size_t)256 * DM * 2, (size_t)256 * DM * 2};
              pg8::Sched<MapLin> S; S.init(DM / 256, NB * MEML / 256, G, (bx + G - ((480 + 64 * l) % G)) % G, mp);
              EpiStore<AddrLin> E{AddrLin{(bf16_t*)(ws + WS_VTB + (size_t)l * NB * MEML * DM * 2), NB * MEML}};
              pg8::gemm_phase<EpiStore<AddrLin>, pg8::Sched<MapLin>, true>(F.wave, ring, xl, DM, DM * 2, DM * 2, S, E); }
        }
        SEAM(1);
    }
    if (IN(2)) {
        const int nF2 = (G > 64) ? 64 : 0;
        if (bx < nF2 || nF2 == 0) {
            MapLin mp{(const char*)(ws + WS_DFT), (const char*)(ws + WS_FPQ), (size_t)256 * 4096 * 2, (size_t)256 * 4096 * 2};
            pg8::Sched<MapLin> S; S.init(8, 8, nF2 ? nF2 : G, bx, mp);
            EpiStore<AddrF2> E{AddrF2{(bf16_t*)(ws + WS_MIXB)}};
            pg8::gemm_phase<EpiStore<AddrF2>, pg8::Sched<MapLin>, true>(F.wave, ring, xl, 4096, 4096 * 2, 4096 * 2, S, E);
        }
        if (bx >= nF2) {
            const int a = bx - nF2, cnt = G - nF2, per = (384 + cnt - 1) / cnt;
            for (int uid = a * per; uid < (a + 1) * per && uid < 384; ++uid) {
                const int qb = uid & 7, hq = (uid >> 3) % NQH, b = uid / (8 * NQH), kvh = hq / 3;
                const bf16_t* Qb = (const bf16_t*)(ws + WS_QB) + ((size_t)b * SEQ + qb * 256) * AW + hq * HD;
                const bf16_t* Kh = (const bf16_t*)(ws + WS_KB) + (size_t)b * SEQ * KVW + kvh * HD;
                const bf16_t* Vh = (const bf16_t*)(ws + WS_VB) + (size_t)b * SEQ * KVW + kvh * HD;
                bf16_t* Ob = (bf16_t*)(ws + WS_MIXB) + ((size_t)b * SEQ + qb * 256) * DM + hq * HD;
                attn::attn_dense_body(Qb, Kh, Vh, Ob, SEQ, (char*)lds_raw + RING_OFF, F.wave);
            }
        }
        SEAM(2);
    }
    if (IN(3)) {
        MapLin mp{(const char*)(ws + WS_MIXB), (const char*)(ws + WS_WOUT_T), (size_t)256 * DM * 2, (size_t)256 * DM * 2};
        pg8::Sched<MapLin> S; S.init(NTOK / 256, DM / 256, G, bx, mp);
        EpiRes E{args.in[0], args.out, (bf16_t*)(ws + WS_XB), (float*)(ws + WS_SSP), nullptr, 8};
        pg8::gemm_phase<EpiRes, pg8::Sched<MapLin>, true>(F.wave, ring, xl, DM, DM * 2, DM * 2, S, E);
        SEAM(3);
    }
    for (int l = 0; l < 2; ++l) {
        const int pb = l ? 15 : 4;
        if (l == 1) {
            if (IN(13)) {
                pool_phase(F, (const bf16_t*)(ws + WS_HN), (bf16_t*)(ws + WS_QCB));
                expert_tr_items(F, args.in[18], args.in[19], args.in[20], 1, (LAS float*)(F.lds + RING_OFF + F.wave * 16384));
                SEAM(13);
            }
            if (IN(14)) {
                MapPool mp{(const char*)(ws + WS_QCB), (const char*)(ws + WS_WP_T)};
                pg8::Sched<MapPool> S; S.init(NTOK / 256, DM / 256, G, bx, mp);
                EpiRes E{args.out, args.out, (bf16_t*)(ws + WS_XB), (float*)(ws + WS_SSP), args.in[9], 8};
                pg8::gemm_phase<EpiRes, pg8::Sched<MapPool>, true>(F.wave, ring, xl, 512, DM * 2, DM * 2, S, E);
                SEAM(14);
            }
        }
        if (IN(pb + 0)) {
            MapLin mp{(const char*)(ws + WS_XB), (const char*)(ws + WS_WCQ_T + (size_t)l * DM * DM * 2), (size_t)256 * DM * 2, (size_t)256 * DM * 2};
            pg8::Sched<MapLin> S; S.init(NTOK / 256, DM / 256, G, bx, mp);
            EpiRowScale E{(bf16_t*)(ws + WS_QCB), DM, (const float*)(ws + WS_SSP), 0.04419417382415922f};
            pg8::gemm_phase<EpiRowScale, pg8::Sched<MapLin>, true>(F.wave, ring, xl, DM, DM * 2, DM * 2, S, E);
            SEAM(pb + 0);
        }
        if (IN(pb + 1)) {
            MapXS mp{(const char*)(ws + WS_QCB), (const char*)(ws + WS_KCB + (size_t)l * NB * MEML * DM * 2)};
            pg8::Sched<MapXS> S; S.init(NTOK / 256, NMH, G, bx, mp);
            EpiSoftmax E{(bf16_t*)(ws + WS_PB), NMH * MEML};
            pg8::gemm_phase<EpiSoftmax, pg8::Sched<MapXS>, true>(F.wave, ring, xl, MHD, DM * 2, DM * 2, S, E);
            SEAM(pb + 1);
        }
        if (IN(pb + 2)) {
            MapXPV mp{(const char*)(ws + WS_PB), (const char*)(ws + WS_VTB + (size_t)l * NB * MEML * DM * 2)};
            pg8::Sched<MapXPV> S; S.init(NTOK / 256, DM / 256, G, bx, mp);
            EpiStore<AddrLin> E{AddrLin{(bf16_t*)(ws + WS_MIXB), DM}};
            pg8::gemm_phase<EpiStore<AddrLin>, pg8::Sched<MapXPV>, true>(F.wave, ring, xl, MEML, NMH * MEML * 2, NB * MEML * 2, S, E);
            SEAM(pb + 2);
        }
        if (IN(pb + 3)) {
            MapLin mp{(const char*)(ws + WS_MIXB), (const char*)(ws + WS_WCO_T + (size_t)l * DM * DM * 2), (size_t)256 * DM * 2, (size_t)256 * DM * 2};
            pg8::Sched<MapLin> S; S.init(NTOK / 256, DM / 256, G, bx, mp);
            EpiRes E{args.out, args.out, nullptr, nullptr, nullptr, 8};
            pg8::gemm_phase<EpiRes, pg8::Sched<MapLin>, true>(F.wave, ring, xl, DM, DM * 2, DM * 2, S, E);
            SEAM(pb + 3);
        }
        if (IN(pb + 4)) {
            router_phase(F, args.out, args.in[16] + l * DM, args.in[17] + (size_t)l * DM * NE, (bf16_t*)(ws + WS_HN), (float*)(ws + WS_AFF));
            SEAM(pb + 4);
        }
        if (IN(pb + 5)) {
            rank_phase(F, (const float*)(ws + WS_AFF), (int*)(ws + WS_RANK), (float*)(ws + WS_GATE), (const bf16_t*)(ws + WS_HN), (bf16_t*)(ws + WS_XSB));
            SEAM(pb + 5);
        }
        if (IN(pb + 6)) {
            MapMoE mp{(const char*)(ws + WS_XSB), (const char*)(ws + WS_WGU_T), (size_t)256 * DM * 2, (size_t)2048 * DM * 2, (size_t)256 * DM * 2};
            pg8::Sched<MapMoE> S; S.init(NB * NE, 8, G, bx, mp);
            EpiSwiGLU E{(bf16_t*)(ws + WS_ACTB)};
            pg8::gemm_phase<EpiSwiGLU, pg8::Sched<MapMoE>, true>(F.wave, ring, xl, DM, DM * 2, DM * 2, S, E);
            SEAM(pb + 6);
        }
        if (IN(pb + 7)) {
            MapMoE mp{(const char*)(ws + WS_ACTB), (const char*)(ws + WS_WD_T), (size_t)256 * EFF * 2, (size_t)2048 * EFF * 2, (size_t)256 * EFF * 2};
            pg8::Sched<MapMoE> S; S.init(NB * NE, 8, G, bx, mp);
            EpiRowGate E{(bf16_t*)(ws + WS_YB), (const float*)(ws + WS_GATE)};
            pg8::gemm_phase<EpiRowGate, pg8::Sched<MapMoE>, true>(F.wave, ring, xl, EFF, EFF * 2, EFF * 2, S, E);
            SEAM(pb + 7);
        }
        if (IN(pb + 8)) {
            combine_phase(F, args.out, (const bf16_t*)(ws + WS_YB), (const int*)(ws + WS_RANK), l == 0 ? args.in[2] + DM : args.in[21], (bf16_t*)(ws + WS_HN), l == 1);
            SEAM(pb + 8);
        }
    }
#undef IN
#undef SEAM
}


#ifndef MK_N_LAUNCHES
#define MK_N_LAUNCHES 1
#endif
extern "C" void kernel_launch(void* const* d_in, const int* in_sizes, int n_in, void* d_out, int out_size, void* d_ws, size_t ws_size, hipStream_t stream) {
    static int grid = 0;
    if (grid == 0) {
        int dev = 0, cus = 0;
        if (n_in != 22 || out_size != NTOK * DM || ws_size < WS_FAST_END) { fprintf(stderr, "kernel_launch: unexpected shapes (n_in %d out %d ws %zu)\n", n_in, out_size, ws_size); grid = -1; return; }
        if (hipGetDevice(&dev) != hipSuccess || hipDeviceGetAttribute(&cus, hipDeviceAttributeMultiprocessorCount, dev) != hipSuccess) { fprintf(stderr, "device query failed\n"); grid = -1; return; }
        if (hipFuncSetAttribute((const void*)skel_fwd, hipFuncAttributeMaxDynamicSharedMemorySize, LDS_BYTES) != hipSuccess) { fprintf(stderr, "hipFuncSetAttribute failed\n"); grid = -1; return; }
        (void)hipGetLastError();
        grid = cus;
    }
    if (grid < 0) return;
    hipMemsetAsync((char*)d_ws + WS_CTL, 0, CTL_ZERO_BYTES, stream);
    Args a{};
    for (int i = 0; i < 22; ++i) a.in[i] = (const float*)d_in[i];
    a.out = (float*)d_out; a.ws = (unsigned char*)d_ws;
    constexpr int NL = MK_N_LAUNCHES;
    for (int li = 0; li < NL; ++li) {
        a.ph_lo = (N_PHASES * li) / NL; a.ph_hi = (N_PHASES * (li + 1)) / NL; a.li = li;
        hipLaunchKernelGGL(skel_fwd, dim3(grid), dim3(NWAVES * 64), LDS_BYTES, stream, a);
    }
}
```

```cpp
#include <hip/hip_runtime.h>
#include <cstdio>
#include <cstdint>

constexpr int DM = 2048, NB = 4, SEQ = 2048, NTOK = NB * SEQ;
constexpr int HD = 128, NQH = 12, NKVH = 4, AW = NQH * HD, KVW = NKVH * HD, FW = 512, INW = 3072;
constexpr int MEML = 256, NMH = 4, MHD = 512;
constexpr int NE = 16, EFF = 1024, CAP = 256;
constexpr float EPS = 1e-6f;

#define LAS __attribute__((address_space(3)))
#define GAS __attribute__((address_space(1)))
typedef unsigned short bf16_t;
typedef short bf16x8 __attribute__((ext_vector_type(8)));
typedef float f32x4 __attribute__((ext_vector_type(4)));
typedef float f32x2 __attribute__((ext_vector_type(2)));
typedef unsigned u32x4 __attribute__((ext_vector_type(4)));
typedef unsigned u32x2 __attribute__((ext_vector_type(2)));
typedef __bf16 bf16x2_t __attribute__((ext_vector_type(2)));
__device__ __forceinline__ unsigned cvtpk(float lo, float hi) { f32x2 v = {lo, hi}; bf16x2_t b = __builtin_convertvector(v, bf16x2_t); return __builtin_bit_cast(unsigned, b); }
__device__ __forceinline__ float bf2f(unsigned short h) { return __uint_as_float(((unsigned)h) << 16); }
template <class T> __device__ __forceinline__ T* uptr(T* p) { const unsigned long long v = (unsigned long long)p; const unsigned lo = __builtin_amdgcn_readfirstlane((unsigned)v), hi = __builtin_amdgcn_readfirstlane((unsigned)(v >> 32)); return (T*)(((unsigned long long)hi << 32) | lo); }
__device__ __forceinline__ int lane_id() { int l = (int)__builtin_amdgcn_mbcnt_hi(~0u, __builtin_amdgcn_mbcnt_lo(~0u, 0u)); asm volatile("" : "+v"(l)); return l; }
#define LDS_WAIT() asm volatile("s_waitcnt lgkmcnt(0)" ::: "memory")
#define VM_WAIT() asm volatile("s_waitcnt vmcnt(0)" ::: "memory")
#define WG_BAR() do { asm volatile("s_waitcnt lgkmcnt(0)" ::: "memory"); __builtin_amdgcn_s_barrier(); asm volatile("" ::: "memory"); } while (0)

namespace pg8 {
constexpr int BM = 256, BK = 64, HALF = 128, HTB = HALF * BK * 2, STAGE_BYTES = 8 * HTB, NXCD = 8, WGM = 8;
__host__ __device__ __forceinline__ int lds_byte(int r, int c) { const int st = (r >> 4) * 2 + (c >> 5), rr = r & 15, cc = c & 31, ob = rr * 64 + cc * 2; return st * 1024 + (ob ^ (((ob >> 9) & 1) << 5)); }
__host__ __device__ __forceinline__ void stage_rc(int b, int& R, int& C) { const int st = b / 1024, sb = b % 1024, swz = sb ^ (((sb >> 9) & 1) << 5); R = (st >> 1) * 16 + swz / 64; C = (st & 1) * 32 + (swz % 64) / 2; }
__host__ __device__ __forceinline__ int perm32(int rho) { const int n = rho >> 4, i = rho & 15; return 8 * (i >> 2) + 4 * n + (i & 3); }

struct Unit { int pm, pn; const char* a; const char* b; };
struct EpiCtx { int wr, wc, wid; LAS unsigned char* xl; };

template <class Map> struct Sched {
    int nM, nN, nwg, G, c; Map map;
    __device__ __forceinline__ void init(int nM_, int nN_, int G_, int c_, const Map& m) { nM = nM_; nN = nN_; nwg = nM * nN; G = G_; c = c_; map = m; }
    __device__ __forceinline__ bool next(int i, Unit& u) const {
        const long L = (long)i * G + c; if (L >= nwg) return false;
        int wgid = (int)L; { const int q = nwg / NXCD, r = nwg % NXCD, xcd = wgid % NXCD, off = wgid / NXCD; wgid = (xcd < r ? xcd * (q + 1) : r * (q + 1) + (xcd - r) * q) + off; }
        const int nig = WGM * nN, gid = wgid / nig, fm = gid * WGM, gsz = (nM - fm) < WGM ? (nM - fm) : WGM;
        u.pm = fm + ((wgid % nig) % gsz); u.pn = (wgid % nig) / gsz; map(u); return true;
    }
};

template <class Epi, class SchedT, bool SP2>
__device__ __forceinline__ void gemm_phase(const int wave_, LAS unsigned char* lds, LAS unsigned char* xl, const int K, const int lda, const int ldb, const SchedT& S, const Epi& E) {
    constexpr bool ALIGN_EPI = true;
    const int lane = lane_id(), wid = wave_, tid = wid * 64 + lane, wr = wid >> 2, wc = wid & 3, fr = lane & 15, fq = lane >> 4;
    const int nt = K / BK;
    unsigned voffA[2], voffB[2];
#pragma unroll
    for (int i = 0; i < 2; ++i) { int R, C; stage_rc(tid * 16 + i * 8192, R, C); const int Rb = Epi::PERM ? ((R & ~31) + perm32(R & 31)) : R;
        voffA[i] = (unsigned)(R * lda + C * 2); voffB[i] = (unsigned)(Rb * ldb + C * 2); }
    const size_t kstep = (size_t)(BK * 2);
    const size_t hstepA = (size_t)HALF * lda, hstepB = (size_t)HALF * ldb;
    const unsigned ldsw = (unsigned)wid * 1024u;
    const int aoff = lds_byte(wr * 64 + fr, fq * 8), boff = lds_byte(wc * 32 + fr, fq * 8);
#define PG8_SA(b, h) (((b) * 2 + (h)) * HTB)
#define PG8_SB(b, h) ((4 + (b) * 2 + (h)) * HTB)
#define PG8_STAGE(bufoff, gbase, voff) do { _Pragma("unroll") for (int _i = 0; _i < 2; ++_i) \
        __builtin_amdgcn_global_load_lds((const unsigned*)((const char*)(gbase) + (voff)[_i]), (LAS unsigned*)(lds + (bufoff) + ldsw + _i * 8192), 16, 0, 0); } while (0)
#define PG8_LDA(dst, b, h) do { _Pragma("unroll") for (int m = 0; m < 4; ++m) _Pragma("unroll") for (int k = 0; k < 2; ++k) dst[m][k] = *(const LAS bf16x8*)(lds + PG8_SA(b, h) + aoff + m * 2048 + k * 1024); } while (0)
#define PG8_LDB(dst, b, h) do { _Pragma("unroll") for (int n = 0; n < 2; ++n) _Pragma("unroll") for (int k = 0; k < 2; ++k) dst[n][k] = *(const LAS bf16x8*)(lds + PG8_SB(b, h) + boff + n * 2048 + k * 1024); } while (0)
#define PG8_MMA(ai, bj, At, Bt) do { __builtin_amdgcn_s_setprio(1); _Pragma("unroll") for (int m = 0; m < 4; ++m) _Pragma("unroll") for (int n = 0; n < 2; ++n) _Pragma("unroll") for (int k = 0; k < 2; ++k) \
        acc[ai][bj][m][n] = __builtin_amdgcn_mfma_f32_16x16x32_bf16(Bt[n][k], At[m][k], acc[ai][bj][m][n], 0, 0, 0); __builtin_amdgcn_s_setprio(0); } while (0)
#define PG8_WAIT_V(n) asm volatile("s_waitcnt vmcnt(" #n ")" ::: "memory")
#define PG8_WAIT_L(n) asm volatile("s_waitcnt lgkmcnt(" #n ")" ::: "memory")
#define PG8_BAR __builtin_amdgcn_s_barrier()
#define PG8_SCHED __builtin_amdgcn_sched_barrier(0)
    Unit cur, nxt; int ui = 0;
    if (!S.next(0, cur)) return;
    EpiCtx ctx; ctx.wr = wr; ctx.wc = wc; ctx.wid = wid; ctx.xl = xl;
    f32x4 acc[2][2][4][2];
#pragma unroll
    for (int a = 0; a < 2; ++a)
#pragma unroll
        for (int b = 0; b < 2; ++b)
#pragma unroll
            for (int m = 0; m < 4; ++m)
#pragma unroll
                for (int n = 0; n < 2; ++n) acc[a][b][m][n] = (f32x4){0.f, 0.f, 0.f, 0.f};
    bf16x8 At[4][2], B0[2][2], B1[2][2];
    const char* cA = cur.a; const char* cB = cur.b;
    if constexpr (SP2) {
        PG8_STAGE(PG8_SB(0, 0), cB, voffB); PG8_STAGE(PG8_SB(0, 1), cB + hstepB, voffB); PG8_STAGE(PG8_SA(0, 0), cA, voffA); PG8_STAGE(PG8_SA(0, 1), cA + hstepA, voffA);
        if (wr == 1) PG8_BAR;
        PG8_WAIT_V(2); PG8_BAR;
        PG8_STAGE(PG8_SB(1, 0), cB + kstep, voffB); PG8_STAGE(PG8_SA(1, 0), cA + kstep, voffA); PG8_STAGE(PG8_SB(1, 1), cB + hstepB + kstep, voffB);
        PG8_WAIT_V(6); PG8_BAR;
    } else {
        PG8_STAGE(PG8_SB(0, 0), cB, voffB); PG8_STAGE(PG8_SA(0, 0), cA, voffA); PG8_STAGE(PG8_SB(0, 1), cB + hstepB, voffB); PG8_STAGE(PG8_SA(0, 1), cA + hstepA, voffA);
        if (wr == 1) PG8_BAR;
        PG8_WAIT_V(4); PG8_BAR;
        PG8_STAGE(PG8_SB(1, 0), cB + kstep, voffB); PG8_STAGE(PG8_SA(1, 0), cA + kstep, voffA); PG8_STAGE(PG8_SB(1, 1), cB + hstepB + kstep, voffB);
        PG8_WAIT_V(6); PG8_BAR;
    }
    for (;;) {
        const bool has_next = S.next(ui + 1, nxt);
        const char* nA = has_next ? nxt.a : cA; const char* nB = has_next ? nxt.b : cB;
        for (int t = 0; t < nt; t += 2) {
            const bool last = (t == nt - 2);
            const char* a1 = cA + (size_t)(t + 1) * kstep;
            const char* a2 = last ? nA : cA + (size_t)(t + 2) * kstep; const char* b2 = last ? nB : cB + (size_t)(t + 2) * kstep;
            const char* a3 = a2 + kstep; const char* b3 = b2 + kstep;
            if constexpr (SP2) {
            PG8_LDB(B0, 0, 0); PG8_LDB(B1, 0, 1); PG8_SCHED; PG8_LDA(At, 0, 0); PG8_STAGE(PG8_SA(1, 1), a1 + hstepA, voffA);
            PG8_WAIT_V(8); PG8_WAIT_L(0); PG8_BAR; PG8_MMA(0, 0, At, B0); PG8_MMA(0, 1, At, B1); PG8_BAR; PG8_SCHED;
            PG8_LDA(At, 0, 1); PG8_STAGE(PG8_SB(0, 0), b2, voffB); PG8_STAGE(PG8_SB(0, 1), b2 + hstepB, voffB); PG8_STAGE(PG8_SA(0, 0), a2, voffA);
            PG8_WAIT_V(8); PG8_WAIT_L(0); PG8_BAR; PG8_MMA(1, 0, At, B0); PG8_MMA(1, 1, At, B1); PG8_BAR; PG8_SCHED;
            PG8_LDB(B0, 1, 0); PG8_LDB(B1, 1, 1); PG8_SCHED; PG8_LDA(At, 1, 0); PG8_STAGE(PG8_SA(0, 1), a2 + hstepA, voffA);
            PG8_WAIT_V(8); PG8_WAIT_L(0); PG8_BAR; PG8_MMA(0, 0, At, B0); PG8_MMA(0, 1, At, B1); PG8_BAR; PG8_SCHED;
            PG8_LDA(At, 1, 1); PG8_STAGE(PG8_SB(1, 0), b3, voffB); PG8_STAGE(PG8_SB(1, 1), b3 + hstepB, voffB); PG8_STAGE(PG8_SA(1, 0), a3, voffA);
            PG8_WAIT_V(8); PG8_WAIT_L(0); PG8_BAR; PG8_MMA(1, 0, At, B0); PG8_MMA(1, 1, At, B1); PG8_BAR; PG8_SCHED;
            } else {
            PG8_LDB(B0, 0, 0); PG8_SCHED; PG8_LDA(At, 0, 0); PG8_STAGE(PG8_SA(1, 1), a1 + hstepA, voffA);
            PG8_WAIT_L(8); PG8_BAR; PG8_WAIT_L(0); PG8_MMA(0, 0, At, B0); PG8_BAR; PG8_SCHED;
            PG8_LDB(B1, 0, 1); PG8_STAGE(PG8_SB(0, 0), b2, voffB);
            PG8_BAR; PG8_WAIT_L(0); PG8_MMA(0, 1, At, B1); PG8_BAR;
            PG8_LDA(At, 0, 1); PG8_STAGE(PG8_SA(0, 0), a2, voffA);
            PG8_BAR; PG8_WAIT_L(0); PG8_MMA(1, 0, At, B0); PG8_BAR; PG8_SCHED;
            PG8_STAGE(PG8_SB(0, 1), b2 + hstepB, voffB);
            PG8_WAIT_V(6); PG8_BAR; PG8_MMA(1, 1, At, B1); PG8_BAR;
            PG8_LDB(B0, 1, 0); PG8_SCHED; PG8_LDA(At, 1, 0); PG8_STAGE(PG8_SA(0, 1), a2 + hstepA, voffA);
            PG8_WAIT_L(8); PG8_BAR; PG8_WAIT_L(0); PG8_MMA(0, 0, At, B0); PG8_BAR; PG8_SCHED;
            PG8_LDB(B1, 1, 1); PG8_STAGE(PG8_SB(1, 0), b3, voffB);
            PG8_BAR; PG8_WAIT_L(0); PG8_MMA(0, 1, At, B1); PG8_BAR;
            PG8_LDA(At, 1, 1); PG8_STAGE(PG8_SA(1, 0), a3, voffA);
            PG8_BAR; PG8_WAIT_L(0); PG8_MMA(1, 0, At, B0); PG8_BAR; PG8_SCHED;
            PG8_STAGE(PG8_SB(1, 1), b3 + hstepB, voffB);
            PG8_WAIT_V(6); PG8_BAR; PG8_MMA(1, 1, At, B1); PG8_BAR;
            }
        }
        if constexpr (ALIGN_EPI) { if (wr == 0) PG8_BAR; }
        E(acc, cur, ctx);
        if (!has_next) break;
#pragma unroll
        for (int a = 0; a < 2; ++a)
#pragma unroll
            for (int b = 0; b < 2; ++b)
#pragma unroll
                for (int m = 0; m < 4; ++m)
#pragma unroll
                    for (int n = 0; n < 2; ++n) acc[a][b][m][n] = (f32x4){0.f, 0.f, 0.f, 0.f};
        cur = nxt; cA = nA; cB = nB; ++ui;
        if constexpr (ALIGN_EPI) { if (wr == 1) PG8_BAR; }
    }
    PG8_WAIT_V(0);
    if constexpr (!ALIGN_EPI) { if (wr == 0) PG8_BAR; }
    PG8_BAR;
#undef PG8_SA
#undef PG8_SB
#undef PG8_STAGE
#undef PG8_LDA
#undef PG8_LDB
#undef PG8_MMA
#undef PG8_WAIT_V
#undef PG8_WAIT_L
#undef PG8_BAR
#undef PG8_SCHED
}
}

constexpr size_t MiB = 1u << 20;
constexpr size_t WS_CTL = 0, CTL_ZERO_BYTES = 1 * MiB;
constexpr size_t WS_WIN_T = 1 * MiB, WS_WF_T = 11 * MiB, WS_WOUT_T = 15 * MiB, WS_WCQ_T = 23 * MiB, WS_WCK_T = 39 * MiB, WS_WCV_T = 55 * MiB, WS_WCO_T = 71 * MiB;
constexpr size_t WS_WP_T = 87 * MiB, WS_DFT = 89 * MiB, WS_ROPE = 105 * MiB, WS_WGU_T = 106 * MiB, WS_WD_T = 234 * MiB;
constexpr size_t WS_HN = 298 * MiB, WS_XB = 330 * MiB, WS_QB = 362 * MiB, WS_KB = 386 * MiB, WS_VB = 394 * MiB, WS_FPQ = 402 * MiB, WS_MIXB = 418 * MiB, WS_QCB = 450 * MiB;
constexpr size_t WS_KCB = 482 * MiB, WS_VTB = 490 * MiB, WS_MEMNB = 498 * MiB, WS_PB = 506 * MiB, WS_XSB = 522 * MiB, WS_ACTB = 586 * MiB, WS_YB = 618 * MiB;
constexpr size_t WS_SSP = 682 * MiB, WS_AFF = 683 * MiB, WS_RANK = 684 * MiB, WS_GATE = 685 * MiB, WS_FAST_END = 686 * MiB;
constexpr int CW_TMO = 0, CW_CODE = 1, CW_BAR = 4096;
constexpr int RING_OFF = 0, RING_BYTES = 131072, XL_OFF = 131072, XL_BYTES = 14336, LDSCTL_OFF = XL_OFF + XL_BYTES, MISC_OFF = LDSCTL_OFF + 320, LDS_BYTES = 147456;
static_assert(MISC_OFF + 128 <= LDS_BYTES, "LDS map");
constexpr int NWAVES = 8;

typedef GAS unsigned gu32;
#define RLX_AGENT __ATOMIC_RELAXED, __HIP_MEMORY_SCOPE_AGENT

#define XB_TMO      128
#define XB_XCNT(j)  (256  + 64 * (j))
#define XB_XSUB(j)  (1280 + 64 * (j))
#define XB_XGEN(j)  (2304 + 64 * (j))
#define XB_TOP      3328
#define XB_TOPGEN   3392
#define XCD_BAR_WORDS 3456
#define XB_SPIN_CAP (1u << 18)
__device__ __forceinline__ unsigned xb_ld(unsigned* p)              { return __hip_atomic_load(p, __ATOMIC_RELAXED, __HIP_MEMORY_SCOPE_AGENT); }
__device__ __forceinline__ unsigned xb_add(unsigned* p, unsigned v) { return __hip_atomic_fetch_add(p, v, __ATOMIC_RELAXED, __HIP_MEMORY_SCOPE_AGENT); }
__device__ __forceinline__ unsigned xb_xcc_id() { return (unsigned)__builtin_amdgcn_s_getreg((3 << 11) | 20) & 0xFu; }
#define XB_SPIN(cond, bar) do { unsigned _sp = 0; while (cond) { __builtin_amdgcn_s_sleep(1); \
    if ((++_sp & 255u) == 0u) { if (xb_ld(&(bar)[XB_TMO])) break; if (_sp > XB_SPIN_CAP) { atomicAdd(&(bar)[XB_TMO], 1u); break; } } } } while (0)
struct XcdBarrier { unsigned* bar; unsigned x; volatile LAS unsigned* st; int wave; };
__device__ __forceinline__ XcdBarrier xcd_barrier_post(unsigned* bar, volatile LAS unsigned* st, int wave) {
    XcdBarrier b; b.bar = bar; b.x = xb_xcc_id(); b.st = st; b.wave = wave;
    if (wave == 0 && lane_id() == 0) (void)xb_add(&bar[XB_XCNT(b.x)], 1u);
    return b;
}
__device__ __forceinline__ void xcd_barrier_complete(unsigned* bar, unsigned x, unsigned& nloc, unsigned& nx) {
    const unsigned G = gridDim.x * gridDim.y * gridDim.z;
    unsigned sum, cnt, mine, sp = 0u;
    for (;;) {
        sum = 0u; cnt = 0u; mine = 0u;
#pragma unroll
        for (unsigned j = 0; j < 16; ++j) { const unsigned c = xb_ld(&bar[XB_XCNT(j)]); sum += c; cnt += (c > 0u) ? 1u : 0u; mine = (j == x) ? c : mine; }
        if (sum == G) break;
        __builtin_amdgcn_s_sleep(1);
        if ((++sp & 255u) == 0u) { if (xb_ld(&bar[XB_TMO])) break; if (sp > XB_SPIN_CAP) { atomicAdd(&bar[XB_TMO], 1u); break; } }
    }
    nloc = mine > 0u ? mine : 1u; nx = cnt > 0u ? cnt : 1u;
}
__device__ __forceinline__ void xcd_barrier(const XcdBarrier& b) {
    asm volatile("s_waitcnt vmcnt(0)" ::: "memory");
    __syncthreads();
    if (b.wave == 0 && lane_id() == 0) {
        unsigned* bar = b.bar;
        __builtin_amdgcn_s_waitcnt(0);
        unsigned nloc = b.st[0], nx = b.st[1];
        if (nloc == 0u) { xcd_barrier_complete(bar, b.x, nloc, nx); b.st[0] = nloc; b.st[1] = nx; }
        const unsigned old = xb_add(&bar[XB_XSUB(b.x)], 1u);
        const unsigned gen = old / nloc;
        if (old + 1u == (gen + 1u) * nloc) {
            __builtin_amdgcn_fence(__ATOMIC_RELEASE, "agent");
            asm volatile("s_waitcnt vmcnt(0)" ::: "memory");
            const unsigned og = xb_add(&bar[XB_TOP], 1u);
            const unsigned tg = og / nx;
            if (og + 1u == (tg + 1u) * nx) xb_add(&bar[XB_TOPGEN], 1u);
            else XB_SPIN(xb_ld(&bar[XB_TOPGEN]) == tg, bar);
            __builtin_amdgcn_fence(__ATOMIC_ACQUIRE, "agent");
            xb_add(&bar[XB_XGEN(b.x)], 1u);
            asm volatile("s_waitcnt vmcnt(0)" ::: "memory");
        } else {
            XB_SPIN(xb_ld(&bar[XB_XGEN(b.x)]) == gen, bar);
            __builtin_amdgcn_fence(__ATOMIC_ACQUIRE, "agent");
            asm volatile("s_waitcnt vmcnt(0)" ::: "memory");
        }
    }
    __syncthreads();
}

struct Args { const float* in[22]; float* out; unsigned char* ws; int ph_lo, ph_hi, li, pad; };
struct Frame {
    LAS unsigned char* lds; volatile LAS unsigned* MISC; gu32* ctl;
    int wave, vcu, G;
    unsigned char* ws;
};
__device__ __forceinline__ float wave_sum(float v) {
#pragma unroll
    for (int o = 1; o < 64; o <<= 1) v += __shfl_xor(v, o);
    return v;
}
__device__ __forceinline__ void tr_item(const float* __restrict__ W, int ldw, const float* __restrict__ gain, bf16_t* WT, int ldt, int k0, int n0, long drow0, LAS float* scr, int lane) {
    const int lr = lane >> 4, lc = (lane & 15) * 4;
    f32x4 v[16];
#pragma unroll
    for (int i = 0; i < 16; ++i) v[i] = *(const GAS f32x4*)(W + (size_t)(k0 + 4 * i + lr) * ldw + n0 + lc);
#pragma unroll
    for (int i = 0; i < 16; ++i) { const int kk = 4 * i + lr; f32x4 x = v[i]; if (gain) x = x * gain[k0 + kk];
        LAS float* s = scr + kk * 65 + lc; s[0] = x.x; s[1] = x.y; s[2] = x.z; s[3] = x.w; }
    LDS_WAIT(); asm volatile("" ::: "memory");
    const int c = lane & 7;
#pragma unroll
    for (int j = 0; j < 8; ++j) { const int n = (lane >> 3) + 8 * j; const LAS float* s = scr + (8 * c) * 65 + n;
        u32x4 o; o.x = cvtpk(s[0 * 65], s[1 * 65]); o.y = cvtpk(s[2 * 65], s[3 * 65]); o.z = cvtpk(s[4 * 65], s[5 * 65]); o.w = cvtpk(s[6 * 65], s[7 * 65]);
        *(GAS u32x4*)(WT + (size_t)(drow0 + n) * ldt + k0 + 8 * c) = o; }
    LDS_WAIT(); asm volatile("" ::: "memory");
}
__device__ __forceinline__ void rms_row_to_bf16(const float* xrow, const float* __restrict__ gain, bf16_t* orow, int lane) {
    const GAS f32x4* xr = (const GAS f32x4*)xrow + lane; const f32x4* gr = (const f32x4*)gain + lane;
    f32x4 v[8]; float s = 0.f;
#pragma unroll
    for (int j = 0; j < 8; ++j) { v[j] = xr[64 * j]; s += (v[j].x * v[j].x + v[j].y * v[j].y) + (v[j].z * v[j].z + v[j].w * v[j].w); }
    const float r = rsqrtf(wave_sum(s) * (1.f / DM) + EPS);
    GAS u32x2* o8 = (GAS u32x2*)orow + lane;
#pragma unroll
    for (int j = 0; j < 8; ++j) { const f32x4 g = gr[64 * j]; u32x2 w; w.x = cvtpk(v[j].x * r * g.x, v[j].y * r * g.y); w.y = cvtpk(v[j].z * r * g.z, v[j].w * r * g.w); o8[64 * j] = w; }
}

__device__ __forceinline__ void expert_tr_items(const Frame& F, const float* eg, const float* eu, const float* ed, int layer, LAS float* scr) {
    const int e_lane = lane_id();
    const int gw = F.vcu * NWAVES + F.wave, NGW = F.G * NWAVES;
    bf16_t* WGU = (bf16_t*)(F.ws + WS_WGU_T); bf16_t* WD = (bf16_t*)(F.ws + WS_WD_T);
    for (int it = gw; it < NE * 1536; it += NGW) {
        const int e = it / 1536, r = it % 1536; const size_t eo = (size_t)(layer * NE + e);
        if (r < 1024) { const int up = r >> 9, q = r & 511, kb = q >> 4, nb = q & 15, n0 = nb * 64;
            const float* W = (up ? eu : eg) + eo * DM * EFF; const long drow0 = (long)(n0 >> 7) * 256 + up * 128 + (n0 & 127);
            tr_item(W, EFF, nullptr, WGU + (size_t)e * 2048 * 2048, 2048, kb * 64, n0, drow0, scr, e_lane);
        } else { const int q = r - 1024, kb = q >> 5, nb = q & 31;
            tr_item(ed + eo * EFF * DM, DM, nullptr, WD + (size_t)e * 2048 * 1024, 1024, kb * 64, nb * 64, nb * 64, scr, e_lane); }
    }
}

__device__ __forceinline__ void p0_prologue(Frame& F, const Args& args) {
    const float* x = args.in[0]; const float* mem = args.in[1]; const float* mix_norm = args.in[2]; const float* w_in = args.in[3];
    const float* w_four = args.in[6]; const float* w_out = args.in[7]; const float* pool_w = args.in[8]; const float* cross_norm = args.in[10]; const float* mem_norm = args.in[11];
    const int gw = F.vcu * NWAVES + F.wave, NGW = F.G * NWAVES;
    const int p_lane = lane_id(), p_tid = F.wave * 64 + p_lane;
    { LAS float* tab = (LAS float*)(F.lds + RING_OFF);
      for (int m = p_tid; m < 2048; m += 512) tab[m] = cosf(6.283185307179586f * (float)m * (1.0f / 2048.0f));
      __syncthreads();
      bf16_t* DFT = (bf16_t*)(F.ws + WS_DFT);
      for (int row = F.vcu * 8; row < 2048; row += F.G * 8)
          for (int rr = 0; rr < 8; ++rr) { const int k1 = row + rr; if (k1 >= 2048) break;
              { const int c0 = p_tid * 8; const int which = c0 >> 11, s0 = c0 & 2047; unsigned w[4];
#pragma unroll
                for (int j = 0; j < 4; ++j) { const int ma = (k1 * (s0 + 2 * j)) & 2047, mb = (k1 * (s0 + 2 * j + 1)) & 2047;
                    w[j] = cvtpk(tab[(ma - which * 512) & 2047], tab[(mb - which * 512) & 2047]); }
                *(GAS u32x4*)(DFT + (size_t)k1 * 4096 + c0) = (u32x4){w[0], w[1], w[2], w[3]}; } }
      __syncthreads(); }
    { float* RC = (float*)(F.ws + WS_ROPE); float* RS = RC + SEQ * 64;
      for (int i = F.vcu * 512 + p_tid; i < SEQ * 64; i += F.G * 512) { const int t = i >> 6, p = i & 63; const int pos = (p < 32) ? (t >> 6) : (t & 63); const int j = p & 31;
          const float inv = 1.0f / powf(10000.0f, (float)(2 * j) / 64.0f); const float ang = (float)pos * inv; RC[i] = cosf(ang); RS[i] = sinf(ang); } }
    { LAS float* Mw = (LAS float*)(F.lds + RING_OFF); LAS float* t128 = Mw + 128 * 32;
      bf16_t* WF = (bf16_t*)(F.ws + WS_WF_T);
      for (int it = F.vcu; it < 256; it += F.G) {
          const int which = it >> 7, g = (it >> 5) & 3, d0 = ((it >> 3) & 3) * 32, k0 = (it & 7) * 256;
          if (p_tid < 128) t128[p_tid] = cosf(6.283185307179586f * (float)p_tid * (1.0f / 128.0f));
          __syncthreads();
          { const int c = p_tid >> 2, dd = (p_tid & 3) * 8; float o[8] = {0.f, 0.f, 0.f, 0.f, 0.f, 0.f, 0.f, 0.f};
            for (int k2 = 0; k2 < 128; ++k2) { const int m = (c * k2) & 127; const float tv = which ? -t128[(m - 32) & 127] : t128[m];
                const float* wr_ = w_four + ((size_t)g * 128 + k2) * 128 + d0 + dd; const f32x4 w0 = *(const f32x4*)wr_, w1 = *(const f32x4*)(wr_ + 4);
                o[0] += tv * w0.x; o[1] += tv * w0.y; o[2] += tv * w0.z; o[3] += tv * w0.w; o[4] += tv * w1.x; o[5] += tv * w1.y; o[6] += tv * w1.z; o[7] += tv * w1.w; }
#pragma unroll
            for (int j = 0; j < 8; ++j) Mw[c * 32 + dd + j] = o[j] * (1.0f / 512.0f); }
          __syncthreads();
          { const int kp = p_tid & 127, dq = p_tid >> 7, k = k0 + 2 * kp; float o0[8] = {0.f, 0.f, 0.f, 0.f, 0.f, 0.f, 0.f, 0.f}, o1[8] = {0.f, 0.f, 0.f, 0.f, 0.f, 0.f, 0.f, 0.f};
            const float* r0 = w_in + (size_t)k * INW + 2560 + g * 128; const float* r1 = r0 + INW;
            for (int c4 = 0; c4 < 32; ++c4) { const f32x4 a = *(const f32x4*)(r0 + 4 * c4), b = *(const f32x4*)(r1 + 4 * c4); const float av[4] = {a.x, a.y, a.z, a.w}, bv[4] = {b.x, b.y, b.z, b.w};
#pragma unroll
                for (int cc = 0; cc < 4; ++cc) { const LAS float* mr = Mw + (4 * c4 + cc) * 32 + dq * 8;
#pragma unroll
                    for (int j = 0; j < 8; ++j) { o0[j] += av[cc] * mr[j]; o1[j] += bv[cc] * mr[j]; } } }
#pragma unroll
            for (int j = 0; j < 8; ++j) *(GAS unsigned*)(WF + (size_t)(which * 512 + g * 128 + d0 + dq * 8 + j) * DM + k) = cvtpk(o0[j], o1[j]); }
          __syncthreads(); } }
    { LAS float* scr = (LAS float*)(F.lds + RING_OFF + F.wave * 16640);
      constexpr int I_IN = 32 * 40, I_SQ = 32 * 32, I_P = 32 * 8;
      constexpr int NIT = I_IN + 9 * I_SQ + I_P;
      for (int it = gw; it < NIT; it += NGW) {
          int r = it;
          if (r < I_IN) { tr_item(w_in, INW, nullptr, (bf16_t*)(F.ws + WS_WIN_T), DM, (r / 40) * 64, (r % 40) * 64, (r % 40) * 64, scr, p_lane); continue; } r -= I_IN;
          if (r < I_SQ) { tr_item(w_out, DM, nullptr, (bf16_t*)(F.ws + WS_WOUT_T), DM, (r / 32) * 64, (r % 32) * 64, (r % 32) * 64, scr, p_lane); continue; } r -= I_SQ;
          { const int j = r / I_SQ; if (j < 8) { const int q = r % I_SQ, wsel = j >> 1, layer = j & 1;
              const float* W = args.in[12 + wsel] + (size_t)layer * DM * DM; const size_t wso = (wsel == 0 ? WS_WCQ_T : wsel == 1 ? WS_WCK_T : wsel == 2 ? WS_WCV_T : WS_WCO_T) + (size_t)layer * DM * DM * 2;
              tr_item(W, DM, wsel == 0 ? cross_norm + layer * DM : nullptr, (bf16_t*)(F.ws + wso), DM, (q / 32) * 64, (q % 32) * 64, (q % 32) * 64, scr, p_lane); continue; } r -= 8 * I_SQ; }
          tr_item(pool_w, 512, nullptr, (bf16_t*)(F.ws + WS_WP_T), DM, (r / 8) * 64, (r % 8) * 64, (r % 8) * 64, scr, p_lane);
      }
      expert_tr_items(F, args.in[18], args.in[19], args.in[20], 0, scr); }
    for (int m = gw; m < NTOK; m += NGW) rms_row_to_bf16(x + (size_t)m * DM, mix_norm, (bf16_t*)(F.ws + WS_HN) + (size_t)m * DM, p_lane);
    for (int m = gw; m < 2 * NB * MEML; m += NGW) { const int l = m / (NB * MEML), r = m % (NB * MEML);
        rms_row_to_bf16(mem + (size_t)r * DM, mem_norm + l * DM, (bf16_t*)(F.ws + WS_MEMNB) + (size_t)m * DM, p_lane); }
}

struct MapLin { const char* A; const char* B; size_t as, bs; __device__ __forceinline__ void operator()(pg8::Unit& u) const { u.a = A + (size_t)u.pm * as; u.b = B + (size_t)u.pn * bs; } };

struct EpiQKV {
    static constexpr bool PERM = true;
    bf16_t* Q; bf16_t* K; bf16_t* V; const float* qg; const float* kg; const float* RC; const float* RS;
    __device__ __forceinline__ void operator()(f32x4 (&acc)[2][2][4][2], const pg8::Unit& u, const pg8::EpiCtx& c) const { const int e_lane = lane_id(), e_fr = e_lane & 15, e_fq = e_lane >> 4;
        const int pn = u.pn, hc = c.wc * 32 + e_fq * 8, rl0 = c.wr * 64 + e_fr;
        if (pn >= 8) {
            bf16_t* base = V + (size_t)(u.pm * 256 + rl0) * KVW + (pn - 8) * 256 + hc;
#pragma unroll
            for (int ai = 0; ai < 2; ++ai)
#pragma unroll
                for (int m = 0; m < 4; ++m) { bf16_t* rowp = base + (size_t)(ai * 128 + m * 16) * KVW;
#pragma unroll
                    for (int bj = 0; bj < 2; ++bj) { const f32x4 v0 = acc[ai][bj][m][0], v1 = acc[ai][bj][m][1];
                        *(u32x4*)(rowp + bj * 128) = (u32x4){cvtpk(v0.x, v0.y), cvtpk(v0.z, v0.w), cvtpk(v1.x, v1.y), cvtpk(v1.z, v1.w)}; } }
            return;
        }
        LAS float* part = (LAS float*)c.xl;
#pragma unroll
        for (int ai = 0; ai < 2; ++ai)
#pragma unroll
            for (int m = 0; m < 4; ++m)
#pragma unroll
                for (int bj = 0; bj < 2; ++bj) { const f32x4 v0 = acc[ai][bj][m][0], v1 = acc[ai][bj][m][1];
                    float s = (v0.x * v0.x + v0.y * v0.y) + (v0.z * v0.z + v0.w * v0.w) + (v1.x * v1.x + v1.y * v1.y) + (v1.z * v1.z + v1.w * v1.w);
                    s += __shfl_xor(s, 16); s += __shfl_xor(s, 32);
                    if (e_fq == 0) part[((ai * 128 + rl0 + m * 16) * 2 + bj) * 4 + c.wc] = s; }
        WG_BAR();
        const float* gain = pn < 6 ? qg : kg;
        const f32x4 g0 = *(const f32x4*)(gain + hc), g1 = *(const f32x4*)(gain + hc + 4);
        bf16_t* O = pn < 6 ? Q : K; const int ld = pn < 6 ? AW : KVW; const int colbase = (pn < 6 ? pn : pn - 6) * 256 + hc;
#pragma unroll
        for (int ai = 0; ai < 2; ++ai)
#pragma unroll
            for (int m = 0; m < 4; ++m) { const int rl = ai * 128 + rl0 + m * 16, row = u.pm * 256 + rl, sp = row & (SEQ - 1);
                const f32x4 cs = *(const f32x4*)(RC + sp * 64 + (hc >> 1)), sn = *(const f32x4*)(RS + sp * 64 + (hc >> 1));
#pragma unroll
                for (int bj = 0; bj < 2; ++bj) { const f32x4 p4 = *(const LAS f32x4*)(part + (rl * 2 + bj) * 4);
                    const float r = rsqrtf(((p4.x + p4.y) + (p4.z + p4.w)) * (1.0f / 128.0f) + EPS);
                    const f32x4 v0 = acc[ai][bj][m][0] * r * g0, v1 = acc[ai][bj][m][1] * r * g1;
                    u32x4 w; w.x = cvtpk(v0.x * cs.x - v0.y * sn.x, v0.x * sn.x + v0.y * cs.x); w.y = cvtpk(v0.z * cs.y - v0.w * sn.y, v0.z * sn.y + v0.w * cs.y);
                    w.z = cvtpk(v1.x * cs.z - v1.y * sn.z, v1.x * sn.z + v1.y * cs.z); w.w = cvtpk(v1.z * cs.w - v1.w * sn.w, v1.z * sn.w + v1.w * cs.w);
                    *(u32x4*)(O + (size_t)row * ld + colbase + bj * 128) = w; } }
    }
};


template <class AddrF> struct EpiStore {
    static constexpr bool PERM = true; AddrF f;
    __device__ __forceinline__ void operator()(f32x4 (&acc)[2][2][4][2], const pg8::Unit& u, const pg8::EpiCtx& c) const { const int e_lane = lane_id(), e_fr = e_lane & 15, e_fq = e_lane >> 4;
        const int hc = c.wc * 32 + e_fq * 8, rl0 = c.wr * 64 + e_fr;
#pragma unroll
        for (int ai = 0; ai < 2; ++ai)
#pragma unroll
            for (int m = 0; m < 4; ++m)
#pragma unroll
                for (int bj = 0; bj < 2; ++bj) { const f32x4 v0 = acc[ai][bj][m][0], v1 = acc[ai][bj][m][1];
                    *(u32x4*)f(u, ai * 128 + rl0 + m * 16, bj * 128 + hc) = (u32x4){cvtpk(v0.x, v0.y), cvtpk(v0.z, v0.w), cvtpk(v1.x, v1.y), cvtpk(v1.z, v1.w)}; }
    }
};
struct AddrF1 { bf16_t* FPQ; __device__ __forceinline__ bf16_t* operator()(const pg8::Unit& u, int rl, int tc) const {
    const int r = u.pm * 256 + rl, which = r >> 9, n = r & 511, cidx = u.pn * 256 + tc, b = cidx >> 11, s = cidx & 2047; return FPQ + (((size_t)(b * 512 + n) * 2 + which) * 2048 + s); } };
struct AddrF2 { bf16_t* MIX; __device__ __forceinline__ bf16_t* operator()(const pg8::Unit& u, int rl, int tc) const {
    const int row = (u.pn >> 1) * 2048 + u.pm * 256 + rl, col = AW + (u.pn & 1) * 256 + tc; return MIX + (size_t)row * DM + col; } };

struct EpiRes {
    static constexpr bool PERM = false;
    const float* base; float* out; bf16_t* xb; float* ssp; const float* cscale; int npn;
    __device__ __forceinline__ void operator()(f32x4 (&acc)[2][2][4][2], const pg8::Unit& u, const pg8::EpiCtx& c) const { const int e_lane = lane_id(), e_fr = e_lane & 15, e_fq = e_lane >> 4;
        const int col0 = u.pn * 256 + c.wc * 32 + 4 * e_fq, rl0 = c.wr * 64 + e_fr;
        LAS float* part = (LAS float*)c.xl;
#pragma unroll
        for (int ai = 0; ai < 2; ++ai)
#pragma unroll
            for (int m = 0; m < 4; ++m) { const int rl = ai * 128 + rl0 + m * 16; const size_t off = (size_t)(u.pm * 256 + rl) * DM + col0; float s = 0.f;
#pragma unroll
                for (int bj = 0; bj < 2; ++bj)
#pragma unroll
                    for (int n = 0; n < 2; ++n) { const size_t o2 = off + bj * 128 + n * 16; f32x4 v = acc[ai][bj][m][n];
                        if (cscale) v = v * *(const f32x4*)(cscale + col0 + bj * 128 + n * 16);
                        v = v + *(const f32x4*)(base + o2);
                        *(f32x4*)(out + o2) = v;
                        if (xb) { *(u32x2*)(xb + o2) = (u32x2){cvtpk(v.x, v.y), cvtpk(v.z, v.w)}; s += (v.x * v.x + v.y * v.y) + (v.z * v.z + v.w * v.w); } }
                if (xb) { s += __shfl_xor(s, 16); s += __shfl_xor(s, 32); if (e_fq == 0) part[rl * 4 + c.wc] = s; }
                asm volatile("" ::: "memory"); }
        if (xb) { WG_BAR();
            if (e_lane < 32) { const int row = c.wid * 32 + e_lane; const f32x4 p4 = *(const LAS f32x4*)(part + row * 4);
                ssp[(size_t)(u.pm * 256 + row) * npn + u.pn] = (p4.x + p4.y) + (p4.z + p4.w); }
            WG_BAR(); }
    }
};

namespace attn {
using s16x4 = __attribute__((ext_vector_type(4))) short;
using f32x16 = __attribute__((ext_vector_type(16))) float;
constexpr int D = 128, NW = 8, QBLK = 32, KVBLK = 64;
constexpr float SCALE = 0.088388347648318440f;
constexpr float THR = 0.f;
#ifndef ATT_SDEPTH
#define ATT_SDEPTH 1
#endif
constexpr int LDQ = AW, LDK = KVW, LDO = DM;
constexpr size_t SHM_V = KVBLK * D * 2, SHM_K = KVBLK * D * 2, SHM_ATTN = 2 * SHM_V + 2 * SHM_K + NW * 64 * 4;
#define KSWZ(row, colB) ((row) * 256 + ((colB) ^ (((row) & 7) << 4)))
#define SBAR() __builtin_amdgcn_sched_barrier(0)
__device__ __forceinline__ int crow(int r, int hi) { return (r & 3) + 8 * (r >> 2) + 4 * hi; }
__device__ __forceinline__ unsigned cvtpk_a(float lo, float hi) { unsigned r; asm volatile("v_cvt_pk_bf16_f32 %0, %1, %2" : "=v"(r) : "v"(lo), "v"(hi)); return r; }
__device__ __forceinline__ void partialSM(f32x16& p0, f32x16& p1, float& m_reg, float& mn, float& alpha) {
  constexpr float C = SCALE * 1.4426950408889634f;
  float pmax = p0[0]; for (int r = 1; r < 16; ++r) pmax = fmaxf(pmax, p0[r]); for (int r = 0; r < 16; ++r) pmax = fmaxf(pmax, p1[r]);
  { auto rr = __builtin_amdgcn_permlane32_swap(__float_as_uint(pmax), __float_as_uint(pmax), false, false);
    pmax = fmaxf(__uint_as_float(rr[0]), __uint_as_float(rr[1])); }
  if (__builtin_expect(__all(pmax - m_reg <= THR / SCALE), 1)) { mn = m_reg; alpha = 1.f; }
  else { mn = fmaxf(m_reg, pmax); alpha = __builtin_amdgcn_exp2f((m_reg - mn) * C); m_reg = mn; }
  float mnC = -mn * C;
  for (int r = 0; r < 16; ++r) p0[r] = fmaf(p0[r], C, mnC); for (int r = 0; r < 16; ++r) p1[r] = fmaf(p1[r], C, mnC);
  for (int r = 0; r < 16; ++r) p0[r] = __builtin_amdgcn_exp2f(p0[r]);
}
__device__ __forceinline__ void finishSM(f32x16& p0, f32x16& p1, float alpha, float& l_reg, bf16x8& pa0, bf16x8& pa1, bf16x8& pa2, bf16x8& pa3) {
  for (int r = 0; r < 16; ++r) p1[r] = __builtin_amdgcn_exp2f(p1[r]);
  float ps = 0; for (int r = 0; r < 16; ++r) ps += p0[r]; for (int r = 0; r < 16; ++r) ps += p1[r];
  { auto rr = __builtin_amdgcn_permlane32_swap(__float_as_uint(ps), __float_as_uint(ps), false, false);
    ps = __uint_as_float(rr[0]) + __uint_as_float(rr[1]); }
  l_reg = l_reg * alpha + ps;
#define PK4(P, BASE, OUT) do { unsigned a0 = cvtpk_a(P[BASE + 0], P[BASE + 1]), a1 = cvtpk_a(P[BASE + 2], P[BASE + 3]);   \
    unsigned b0 = cvtpk_a(P[BASE + 4], P[BASE + 5]), b1 = cvtpk_a(P[BASE + 6], P[BASE + 7]);                              \
    auto r0 = __builtin_amdgcn_permlane32_swap(a0, b0, false, false); auto r1 = __builtin_amdgcn_permlane32_swap(a1, b1, false, false); \
    u32x4 w = {r0[0], r1[0], r0[1], r1[1]}; OUT = *reinterpret_cast<bf16x8*>(&w); } while (0)
  PK4(p0, 0, pa0); PK4(p0, 8, pa1); PK4(p1, 0, pa2); PK4(p1, 8, pa3);
#undef PK4
}
__device__ __forceinline__ void qkt(f32x16& p0, f32x16& p1, const bf16_t* Ks, const bf16x8* qr, int r32, int hi) {
  p0 = f32x16{}; p1 = f32x16{};
  for (int d0 = 0; d0 < 8; ++d0) { int cb = (d0 * 16 + hi * 8) * 2;
    bf16x8 b0 = *reinterpret_cast<const bf16x8*>((const char*)Ks + KSWZ(r32, cb));
    bf16x8 b1 = *reinterpret_cast<const bf16x8*>((const char*)Ks + KSWZ(32 + r32, cb));
    p0 = __builtin_amdgcn_mfma_f32_32x32x16_bf16(b0, qr[d0], p0, 0, 0, 0);
    p1 = __builtin_amdgcn_mfma_f32_32x32x16_bf16(b1, qr[d0], p1, 0, 0, 0); }
}
__device__ __forceinline__ int v_st(int k, int c) { const int kk = (k & ~0xC) | ((k & 4) << 1) | ((k & 8) >> 1); return ((kk >> 3) * 4 + (c >> 5)) * 512 + ((kk & 7) * 32 + (c & 31)) * 2; }
__device__ __forceinline__ int v_rd_base(int lane) { return ((lane & 3) << 3) | (((lane >> 2) & 3) << 6) | (((lane >> 4) & 1) << 5) | (((lane >> 5) & 1) << 8); }
constexpr int v_rd_off(int d0, int ks, int half) { return d0 * 512 + ks * 4096 + half * 2048; }
template <int OFF> __device__ __forceinline__ s16x4 tr_read(int vb) {
  s16x4 r; asm volatile("ds_read_b64_tr_b16 %0, %1 offset:%2" : "=&v"(r) : "v"(vb), "i"(OFF) : "memory"); return r;
}
template <int D0> __device__ __forceinline__ void pv_one(f32x16& od, int vb, bf16x8 pa0, bf16x8 pa1, bf16x8 pa2, bf16x8 pa3) {
  const s16x4 l0 = tr_read<v_rd_off(D0, 0, 0)>(vb), h0 = tr_read<v_rd_off(D0, 0, 1)>(vb), l1 = tr_read<v_rd_off(D0, 1, 0)>(vb), h1 = tr_read<v_rd_off(D0, 1, 1)>(vb);
  const s16x4 l2 = tr_read<v_rd_off(D0, 2, 0)>(vb), h2 = tr_read<v_rd_off(D0, 2, 1)>(vb), l3 = tr_read<v_rd_off(D0, 3, 0)>(vb), h3 = tr_read<v_rd_off(D0, 3, 1)>(vb);
  asm volatile("s_waitcnt lgkmcnt(0)" ::: "memory"); SBAR();
#define PK(L, H) (bf16x8){L[0], L[1], L[2], L[3], H[0], H[1], H[2], H[3]}
  od = __builtin_amdgcn_mfma_f32_32x32x16_bf16(pa0, PK(l0, h0), od, 0, 0, 0);
  od = __builtin_amdgcn_mfma_f32_32x32x16_bf16(pa1, PK(l1, h1), od, 0, 0, 0);
  od = __builtin_amdgcn_mfma_f32_32x32x16_bf16(pa2, PK(l2, h2), od, 0, 0, 0);
  od = __builtin_amdgcn_mfma_f32_32x32x16_bf16(pa3, PK(l3, h3), od, 0, 0, 0);
#undef PK
}
__device__ __forceinline__ void pv_d0(f32x16* o, int vb, bf16x8 pa0, bf16x8 pa1, bf16x8 pa2, bf16x8 pa3) {
  pv_one<0>(o[0], vb, pa0, pa1, pa2, pa3); pv_one<1>(o[1], vb, pa0, pa1, pa2, pa3); pv_one<2>(o[2], vb, pa0, pa1, pa2, pa3); pv_one<3>(o[3], vb, pa0, pa1, pa2, pa3);
}
__device__ __forceinline__ void attn_dense_body(const bf16_t* __restrict__ Qb, const bf16_t* __restrict__ Kh, const bf16_t* __restrict__ Vh,
                                                bf16_t* __restrict__ Ob, int seq, char* lds, const int wave_) {
  constexpr int SDEPTH = ATT_SDEPTH;
  const int lane = lane_id(), wid = wave_, tid = wid * 64 + lane, r32 = lane & 31, hi = lane >> 5;
  bf16_t* V_lds = (bf16_t*)lds; bf16_t* K_lds = (bf16_t*)(lds + 2 * SHM_V);
  float* ws = (float*)(lds + 2 * SHM_V + 2 * SHM_K) + wid * 64; float* li_l = ws; float* al_l = ws + 32;
  float m_reg = -1e30f, l_reg = 0; f32x16 o[4] = {}; bf16x8 qr[8];
  const bf16_t* Qw = Qb + (long)(wid * QBLK + r32) * LDQ + hi * 8;
#pragma unroll
  for (int d0 = 0; d0 < 8; ++d0) qr[d0] = *reinterpret_cast<const bf16x8*>(Qw + d0 * 16);
  const int sr = tid >> 4, sc = (tid & 15) * 8, vst0 = v_st(sr, sc), vst1 = v_st(32 + sr, sc);
  const int vb0 = (int)(uintptr_t)V_lds + v_rd_base(lane);
  struct { bf16x8 vs0, vs1, ks0, ks1; } sr_[SDEPTH];
#define SLOAD(i, k0) do { sr_[i].vs0 = *reinterpret_cast<const bf16x8*>(&Vh[(long)((k0) + sr) * LDK + sc]); sr_[i].vs1 = *reinterpret_cast<const bf16x8*>(&Vh[(long)((k0) + 32 + sr) * LDK + sc]); \
    sr_[i].ks0 = *reinterpret_cast<const bf16x8*>(&Kh[(long)((k0) + sr) * LDK + sc]); sr_[i].ks1 = *reinterpret_cast<const bf16x8*>(&Kh[(long)((k0) + 32 + sr) * LDK + sc]); } while (0)
#define SWRITE(b, i) do { *(bf16x8*)((char*)V_lds + (b) * SHM_V + vst0) = sr_[i].vs0;          \
    *(bf16x8*)((char*)V_lds + (b) * SHM_V + vst1) = sr_[i].vs1; int kc = sc * 2;               \
    *(bf16x8*)((char*)K_lds + (b) * SHM_K + KSWZ(sr, kc)) = sr_[i].ks0;                       \
    *(bf16x8*)((char*)K_lds + (b) * SHM_K + KSWZ(32 + sr, kc)) = sr_[i].ks1; } while (0)
#define SWAIT() do { if constexpr (SDEPTH == 2) asm volatile("s_waitcnt vmcnt(4)" ::: "memory"); else asm volatile("s_waitcnt vmcnt(0)" ::: "memory"); } while (0)
#define RESC(a) do { if (__any((a) < 1.f)) { if (hi == 0) al_l[r32] = (a); asm volatile("s_waitcnt lgkmcnt(0)" ::: "memory"); \
    for (int d = 0; d < 4; ++d) for (int r = 0; r < 16; ++r) o[d][r] *= al_l[crow(r, hi)]; } } while (0)
  f32x16 pA0, pA1, pB0, pB1; float mnA, mnB, alA, alB; bf16x8 pa0, pa1, pa2, pa3; const int NT = seq / KVBLK;
  constexpr int SE = 0, SO = SDEPTH - 1;
  SLOAD(SE, 0); asm volatile("s_waitcnt vmcnt(0)" ::: "memory"); SWRITE(0, SE); __syncthreads();
  qkt(pA0, pA1, K_lds, qr, r32, hi); partialSM(pA0, pA1, m_reg, mnA, alA);
  SLOAD(SO, KVBLK); if constexpr (SDEPTH == 2) { if (2 < NT) SLOAD(SE, 2 * KVBLK); }
  SWAIT(); SWRITE(1, SO); __syncthreads();
  for (int j = 1; j + 1 < NT; j += 2) {
    SBAR(); qkt(pB0, pB1, (bf16_t*)((char*)K_lds + SHM_K), qr, r32, hi);
    finishSM(pA0, pA1, alA, l_reg, pa0, pa1, pa2, pa3); SBAR();
    SLOAD(SO, (j + SDEPTH) * KVBLK); SBAR();
    pv_d0(o, vb0, pa0, pa1, pa2, pa3); partialSM(pB0, pB1, m_reg, mnB, alB);
    __syncthreads(); SWAIT(); SWRITE(0, SE);
    RESC(alB); __syncthreads();
    SBAR(); qkt(pA0, pA1, K_lds, qr, r32, hi);
    finishSM(pB0, pB1, alB, l_reg, pa0, pa1, pa2, pa3); SBAR();
    if (SDEPTH == 1 || j + 3 < NT) SLOAD(SE, (j + 1 + SDEPTH) * KVBLK); SBAR();
    pv_d0(o, vb0 + (int)SHM_V, pa0, pa1, pa2, pa3); partialSM(pA0, pA1, m_reg, mnA, alA);
    __syncthreads(); SWAIT(); SWRITE(1, SO);
    RESC(alA); __syncthreads();
  }
  SBAR(); qkt(pB0, pB1, (bf16_t*)((char*)K_lds + SHM_K), qr, r32, hi);
  finishSM(pA0, pA1, alA, l_reg, pa0, pa1, pa2, pa3); SBAR();
  pv_d0(o, vb0, pa0, pa1, pa2, pa3); partialSM(pB0, pB1, m_reg, mnB, alB);
  __syncthreads(); RESC(alB);
  finishSM(pB0, pB1, alB, l_reg, pa0, pa1, pa2, pa3); SBAR();
  pv_d0(o, vb0 + (int)SHM_V, pa0, pa1, pa2, pa3);
  if (hi == 0) li_l[r32] = l_reg; asm volatile("s_waitcnt lgkmcnt(0)" ::: "memory");
  float rli[16];
#pragma unroll
  for (int r = 0; r < 16; ++r) rli[r] = __builtin_amdgcn_rcpf(li_l[crow(r, hi)]);
  bf16_t* Ow = Ob + (long)(wid * QBLK) * LDO;
#pragma unroll
  for (int r = 0; r < 16; ++r) { int orow = crow(r, hi);
    for (int d0 = 0; d0 < 4; ++d0) Ow[(long)orow * LDO + d0 * 32 + r32] = (bf16_t)(cvtpk(o[d0][r] * rli[r], 0.f) & 0xffffu); }
#undef SLOAD
#undef SWRITE
#undef SWAIT
#undef RESC
  __syncthreads();
}
#undef KSWZ
#undef SBAR
}

struct AddrLin { bf16_t* O; int ld; __device__ __forceinline__ bf16_t* operator()(const pg8::Unit& u, int rl, int tc) const { return O + (size_t)(u.pm * 256 + rl) * ld + u.pn * 256 + tc; } };
struct EpiRowScale {
    static constexpr bool PERM = true; bf16_t* O; int ld; const float* ssp; float cscale;
    __device__ __forceinline__ void operator()(f32x4 (&acc)[2][2][4][2], const pg8::Unit& u, const pg8::EpiCtx& c) const { const int e_lane = lane_id(), e_fr = e_lane & 15, e_fq = e_lane >> 4;
        const int hc = c.wc * 32 + e_fq * 8, rl0 = c.wr * 64 + e_fr;
#pragma unroll
        for (int ai = 0; ai < 2; ++ai)
#pragma unroll
            for (int m = 0; m < 4; ++m) { const int row = u.pm * 256 + ai * 128 + rl0 + m * 16; const f32x4 p0 = *(const f32x4*)(ssp + (size_t)row * 8), p1 = *(const f32x4*)(ssp + (size_t)row * 8 + 4);
                const float r = rsqrtf((((p0.x + p0.y) + (p0.z + p0.w)) + ((p1.x + p1.y) + (p1.z + p1.w))) * (1.0f / DM) + EPS) * cscale;
#pragma unroll
                for (int bj = 0; bj < 2; ++bj) { const f32x4 v0 = acc[ai][bj][m][0] * r, v1 = acc[ai][bj][m][1] * r;
                    *(u32x4*)(O + (size_t)row * ld + u.pn * 256 + bj * 128 + hc) = (u32x4){cvtpk(v0.x, v0.y), cvtpk(v0.z, v0.w), cvtpk(v1.x, v1.y), cvtpk(v1.z, v1.w)}; } }
    }
};
struct EpiSoftmax {
    static constexpr bool PERM = true; bf16_t* P; int ld;
    __device__ __forceinline__ void operator()(f32x4 (&acc)[2][2][4][2], const pg8::Unit& u, const pg8::EpiCtx& c) const { const int e_lane = lane_id(), e_fr = e_lane & 15, e_fq = e_lane >> 4;
        const int hc = c.wc * 32 + e_fq * 8, rl0 = c.wr * 64 + e_fr;
        LAS float* pmx = (LAS float*)c.xl; LAS float* psm = pmx + 1024;
#pragma unroll
        for (int ai = 0; ai < 2; ++ai)
#pragma unroll
            for (int m = 0; m < 4; ++m) { float mx = -3.0e38f;
#pragma unroll
                for (int bj = 0; bj < 2; ++bj)
#pragma unroll
                    for (int n = 0; n < 2; ++n) { const f32x4 v = acc[ai][bj][m][n]; mx = fmaxf(fmaxf(mx, fmaxf(v.x, v.y)), fmaxf(v.z, v.w)); }
                mx = fmaxf(mx, __shfl_xor(mx, 16)); mx = fmaxf(mx, __shfl_xor(mx, 32));
                if (e_fq == 0) pmx[(ai * 128 + rl0 + m * 16) * 4 + c.wc] = mx; }
        WG_BAR();
#pragma unroll
        for (int ai = 0; ai < 2; ++ai)
#pragma unroll
            for (int m = 0; m < 4; ++m) { const int rl = ai * 128 + rl0 + m * 16; const f32x4 p4 = *(const LAS f32x4*)(pmx + rl * 4);
                const float mx = fmaxf(fmaxf(p4.x, p4.y), fmaxf(p4.z, p4.w)) * 1.4426950408889634f; float s = 0.f;
#pragma unroll
                for (int bj = 0; bj < 2; ++bj)
#pragma unroll
                    for (int n = 0; n < 2; ++n) { f32x4 v = acc[ai][bj][m][n];
                        v.x = __builtin_amdgcn_exp2f(fmaf(v.x, 1.4426950408889634f, -mx)); v.y = __builtin_amdgcn_exp2f(fmaf(v.y, 1.4426950408889634f, -mx));
                        v.z = __builtin_amdgcn_exp2f(fmaf(v.z, 1.4426950408889634f, -mx)); v.w = __builtin_amdgcn_exp2f(fmaf(v.w, 1.4426950408889634f, -mx));
                        s += (v.x + v.y) + (v.z + v.w); acc[ai][bj][m][n] = v; }
                s += __shfl_xor(s, 16); s += __shfl_xor(s, 32);
                if (e_fq == 0) psm[rl * 4 + c.wc] = s; }
        WG_BAR();
#pragma unroll
        for (int ai = 0; ai < 2; ++ai)
#pragma unroll
            for (int m = 0; m < 4; ++m) { const int rl = ai * 128 + rl0 + m * 16; const f32x4 p4 = *(const LAS f32x4*)(psm + rl * 4);
                const float inv = 1.0f / ((p4.x + p4.y) + (p4.z + p4.w));
#pragma unroll
                for (int bj = 0; bj < 2; ++bj) { const f32x4 v0 = acc[ai][bj][m][0] * inv, v1 = acc[ai][bj][m][1] * inv;
                    *(u32x4*)(P + (size_t)(u.pm * 256 + rl) * ld + u.pn * 256 + bj * 128 + hc) = (u32x4){cvtpk(v0.x, v0.y), cvtpk(v0.z, v0.w), cvtpk(v1.x, v1.y), cvtpk(v1.z, v1.w)}; } }
        WG_BAR();
    }
};
struct MapXS { const char* Q; const char* K; __device__ __forceinline__ void operator()(pg8::Unit& u) const {
    u.a = Q + ((size_t)u.pm * 256 * DM + (size_t)u.pn * MHD) * 2; u.b = K + ((size_t)(u.pm >> 3) * MEML * DM + (size_t)u.pn * MHD) * 2; } };
struct MapXPV { const char* P; const char* VT; __device__ __forceinline__ void operator()(pg8::Unit& u) const {
    u.a = P + ((size_t)u.pm * 256 * 1024 + (size_t)(u.pn >> 1) * MEML) * 2; u.b = VT + ((size_t)u.pn * 256 * 1024 + (size_t)(u.pm >> 3) * MEML) * 2; } };

struct MapMoE { const char* A; const char* W; size_t as, es, ws_; __device__ __forceinline__ void operator()(pg8::Unit& u) const {
    u.a = A + (size_t)u.pm * as; u.b = W + (size_t)(u.pm >> 2) * es + (size_t)u.pn * ws_; } };
struct EpiSwiGLU {
    static constexpr bool PERM = true; bf16_t* ACT;
    __device__ __forceinline__ void operator()(f32x4 (&acc)[2][2][4][2], const pg8::Unit& u, const pg8::EpiCtx& c) const { const int e_lane = lane_id(), e_fr = e_lane & 15, e_fq = e_lane >> 4;
        const int hc = c.wc * 32 + e_fq * 8, rl0 = c.wr * 64 + e_fr;
#pragma unroll
        for (int ai = 0; ai < 2; ++ai)
#pragma unroll
            for (int m = 0; m < 4; ++m) { f32x4 o[2];
#pragma unroll
                for (int n = 0; n < 2; ++n) { const f32x4 g = acc[ai][0][m][n], up = acc[ai][1][m][n]; f32x4 r;
                    r.x = g.x * __builtin_amdgcn_rcpf(1.0f + __builtin_amdgcn_exp2f(-1.4426950408889634f * g.x)) * up.x; r.y = g.y * __builtin_amdgcn_rcpf(1.0f + __builtin_amdgcn_exp2f(-1.4426950408889634f * g.y)) * up.y;
                    r.z = g.z * __builtin_amdgcn_rcpf(1.0f + __builtin_amdgcn_exp2f(-1.4426950408889634f * g.z)) * up.z; r.w = g.w * __builtin_amdgcn_rcpf(1.0f + __builtin_amdgcn_exp2f(-1.4426950408889634f * g.w)) * up.w; o[n] = r; }
                *(u32x4*)(ACT + (size_t)(u.pm * 256 + ai * 128 + rl0 + m * 16) * EFF + u.pn * 128 + hc) = (u32x4){cvtpk(o[0].x, o[0].y), cvtpk(o[0].z, o[0].w), cvtpk(o[1].x, o[1].y), cvtpk(o[1].z, o[1].w)}; }
    }
};
struct EpiRowGate {
    static constexpr bool PERM = true; bf16_t* Y; const float* gate;
    __device__ __forceinline__ void operator()(f32x4 (&acc)[2][2][4][2], const pg8::Unit& u, const pg8::EpiCtx& c) const { const int e_lane = lane_id(), e_fr = e_lane & 15, e_fq = e_lane >> 4;
        const int hc = c.wc * 32 + e_fq * 8, rl0 = c.wr * 64 + e_fr;
#pragma unroll
        for (int ai = 0; ai < 2; ++ai)
#pragma unroll
            for (int m = 0; m < 4; ++m) { const int row = u.pm * 256 + ai * 128 + rl0 + m * 16; const float gt = gate[row];
#pragma unroll
                for (int bj = 0; bj < 2; ++bj) { const f32x4 v0 = acc[ai][bj][m][0] * gt, v1 = acc[ai][bj][m][1] * gt;
                    *(u32x4*)(Y + (size_t)row * DM + u.pn * 256 + bj * 128 + hc) = (u32x4){cvtpk(v0.x, v0.y), cvtpk(v0.z, v0.w), cvtpk(v1.x, v1.y), cvtpk(v1.z, v1.w)}; } }
    }
};
__device__ __forceinline__ float rms_row_to_bf16_r(const float* xrow, const float* __restrict__ gain, bf16_t* orow, int lane) {
    const GAS f32x4* xr = (const GAS f32x4*)xrow + lane; const f32x4* gr = (const f32x4*)gain + lane;
    f32x4 v[8]; float s = 0.f;
#pragma unroll
    for (int j = 0; j < 8; ++j) { v[j] = xr[64 * j]; s += (v[j].x * v[j].x + v[j].y * v[j].y) + (v[j].z * v[j].z + v[j].w * v[j].w); }
    const float r = rsqrtf(wave_sum(s) * (1.f / DM) + EPS);
    GAS u32x2* o8 = (GAS u32x2*)orow + lane;
#pragma unroll
    for (int j = 0; j < 8; ++j) { const f32x4 g = gr[64 * j]; u32x2 w; w.x = cvtpk(v[j].x * r * g.x, v[j].y * r * g.y); w.y = cvtpk(v[j].z * r * g.z, v[j].w * r * g.w); o8[64 * j] = w; }
    return r;
}
__device__ __forceinline__ void router_phase(const Frame& F, const float* x, const float* __restrict__ gain, const float* __restrict__ Wr, bf16_t* HNo, float* aff) {
    const int lane = lane_id(), tid = F.wave * 64 + lane;
    LAS f32x4* Wl = (LAS f32x4*)(F.lds + RING_OFF);
    for (int i = tid; i < DM * 4; i += 512) { const int kk = i >> 2, q = i & 3; Wl[q * DM + kk] = *(const f32x4*)(Wr + (size_t)kk * NE + 4 * q); }
    __syncthreads();
    const int gw = (int)blockIdx.x * NWAVES + F.wave, NGW = F.G * NWAVES;
    for (int rb = gw * 4; rb < NTOK; rb += NGW * 4) {
        float rr[4];
#pragma unroll
        for (int j = 0; j < 4; ++j) rr[j] = rms_row_to_bf16_r(x + (size_t)(rb + j) * DM, gain, HNo + (size_t)(rb + j) * DM, lane);
        float a[64];
#pragma unroll
        for (int i = 0; i < 64; ++i) a[i] = 0.f;
        for (int i = 0; i < 32; ++i) { const int kk = lane + 64 * i; const float g = gain[kk]; float hv[4];
#pragma unroll
            for (int j = 0; j < 4; ++j) hv[j] = x[(size_t)(rb + j) * DM + kk] * rr[j] * g;
#pragma unroll
            for (int q = 0; q < 4; ++q) { const f32x4 w = Wl[q * DM + kk];
#pragma unroll
                for (int j = 0; j < 4; ++j) { a[j * 16 + 4 * q + 0] += hv[j] * w.x; a[j * 16 + 4 * q + 1] += hv[j] * w.y; a[j * 16 + 4 * q + 2] += hv[j] * w.z; a[j * 16 + 4 * q + 3] += hv[j] * w.w; } } }
#define RS_STEP(N, MASK) { const bool up_ = (lane & MASK) != 0; _Pragma("unroll") for (int i = 0; i < N; ++i) { const float keep = up_ ? a[i + N] : a[i], send = up_ ? a[i] : a[i + N]; a[i] = keep + __shfl_xor(send, MASK); } }
        RS_STEP(32, 32) RS_STEP(16, 16) RS_STEP(8, 8) RS_STEP(4, 4) RS_STEP(2, 2) RS_STEP(1, 1)
#undef RS_STEP
        float lg = a[0], mx = lg;
        mx = fmaxf(mx, __shfl_xor(mx, 8)); mx = fmaxf(mx, __shfl_xor(mx, 4)); mx = fmaxf(mx, __shfl_xor(mx, 2)); mx = fmaxf(mx, __shfl_xor(mx, 1));
        const float ex = expf(lg - mx); float sm = ex;
        sm += __shfl_xor(sm, 8); sm += __shfl_xor(sm, 4); sm += __shfl_xor(sm, 2); sm += __shfl_xor(sm, 1);
        const int row = rb + (lane >> 4), e = lane & 15, b = row / SEQ, t = row % SEQ;
        aff[((size_t)b * NE + e) * SEQ + t] = ex / sm;
    }
    __syncthreads();
}
__device__ __forceinline__ void rank_phase(const Frame& F, const float* aff, int* rank, float* gate, const bf16_t* HNi, bf16_t* XS) {
    const int lane = lane_id(), tid = F.wave * 64 + lane;
    LAS float* a = (LAS float*)(F.lds + RING_OFF);
    LAS int* list = (LAS int*)(F.lds + RING_OFF + 8192);
    LAS int* cntp = (LAS int*)(F.lds + RING_OFF + 8192 + 1024);
    for (int it = (int)blockIdx.x; it < NB * NE * 8; it += F.G) {
        const int be = it >> 3, chunk = it & 7, b = be >> 4, e = be & 15;
        for (int i = tid; i < SEQ / 4; i += 512) ((LAS f32x4*)a)[i] = *(const f32x4*)(aff + (size_t)be * SEQ + 4 * i);
        if (tid == 0) cntp[0] = 0;
        __syncthreads();
        const int tl = tid >> 1, half = tid & 1, t = chunk * 256 + tl; const float v = a[t]; int cnt = 0;
        for (int j4 = half * 256; j4 < half * 256 + 256; ++j4) { const f32x4 w = ((LAS f32x4*)a)[j4]; const int j = 4 * j4;
            cnt += (w.x > v || (w.x == v && j < t)) ? 1 : 0; cnt += (w.y > v || (w.y == v && j + 1 < t)) ? 1 : 0;
            cnt += (w.z > v || (w.z == v && j + 2 < t)) ? 1 : 0; cnt += (w.w > v || (w.w == v && j + 3 < t)) ? 1 : 0; }
        cnt += __shfl_xor(cnt, 1);
        if (half == 0) { rank[(size_t)be * SEQ + t] = cnt;
            if (cnt < CAP) { gate[(e * 4 + b) * CAP + cnt] = v; const int slot = atomicAdd((int*)cntp, 1); list[slot] = (t << 16) | cnt; } }
        __syncthreads();
        const int n = cntp[0];
        for (int li = F.wave; li < n; li += NWAVES) { const int pk = list[li], tt = pk >> 16, rk = pk & 0xffff;
            const u32x4* src = (const u32x4*)(HNi + ((size_t)b * SEQ + tt) * DM); u32x4* dst = (u32x4*)(XS + ((size_t)(e * 4 + b) * CAP + rk) * DM);
#pragma unroll
            for (int j = 0; j < 4; ++j) dst[lane + 64 * j] = src[lane + 64 * j]; }
        __syncthreads();
    }
}
__device__ __forceinline__ void combine_phase(const Frame& F, float* x, const bf16_t* Y, const int* rank, const float* __restrict__ gain, bf16_t* HNo, bool final_) {
    const int lane = lane_id();
    const int gw = (int)blockIdx.x * NWAVES + F.wave, NGW = F.G * NWAVES;
    for (int row = gw; row < NTOK; row += NGW) {
        const int b = row / SEQ, t = row % SEQ;
        int rk = CAP; if (lane < NE) rk = rank[((size_t)b * NE + lane) * SEQ + t];
        GAS f32x4* xr = (GAS f32x4*)(x + (size_t)row * DM) + lane; f32x4 v[8];
#pragma unroll
        for (int j = 0; j < 8; ++j) v[j] = xr[64 * j];
#pragma unroll
        for (int e = 0; e < NE; ++e) { const int r = __builtin_amdgcn_readlane(rk, e);
            if (r < CAP) { const u32x2* yr = (const u32x2*)(Y + ((size_t)(e * 4 + b) * CAP + r) * DM) + lane;
#pragma unroll
                for (int j = 0; j < 8; ++j) { const u32x2 w = yr[64 * j]; v[j].x += __uint_as_float(w.x << 16); v[j].y += __uint_as_float(w.x & 0xffff0000u); v[j].z += __uint_as_float(w.y << 16); v[j].w += __uint_as_float(w.y & 0xffff0000u); } } }
        float s = 0.f;
#pragma unroll
        for (int j = 0; j < 8; ++j) s += (v[j].x * v[j].x + v[j].y * v[j].y) + (v[j].z * v[j].z + v[j].w * v[j].w);
        const float r = rsqrtf(wave_sum(s) * (1.f / DM) + EPS); const f32x4* gr = (const f32x4*)gain + lane;
        if (final_) {
#pragma unroll
            for (int j = 0; j < 8; ++j) { const f32x4 g = gr[64 * j]; xr[64 * j] = (f32x4){v[j].x * r * g.x, v[j].y * r * g.y, v[j].z * r * g.z, v[j].w * r * g.w}; }
        } else { GAS u32x2* o8 = (GAS u32x2*)(HNo + (size_t)row * DM) + lane;
#pragma unroll
            for (int j = 0; j < 8; ++j) { const f32x4 g = gr[64 * j]; xr[64 * j] = v[j]; o8[64 * j] = (u32x2){cvtpk(v[j].x * r * g.x, v[j].y * r * g.y), cvtpk(v[j].z * r * g.z, v[j].w * r * g.w)}; } }
    }
}

struct MapPool { const char* A; const char* W; __device__ __forceinline__ void operator()(pg8::Unit& u) const {
    u.a = A + ((size_t)u.pm * 256 * DM + (size_t)(u.pn >> 1) * 512) * 2; u.b = W + ((size_t)(u.pn & 1) * 256 * DM + (size_t)(u.pn >> 1) * 512) * 2; } };
__device__ __forceinline__ void pool_phase(const Frame& F, const bf16_t* H, bf16_t* P) {
    const int lane = lane_id(); const int gt = ((int)blockIdx.x * NWAVES + F.wave) * 64 + lane, NT = F.G * NWAVES * 64;
    for (int idx = gt; idx < NTOK * (DM / 8); idx += NT) {
        const int row = idx >> 8, c8 = idx & 255, t = row & (SEQ - 1), g = c8 >> 6, w = 2 << g;
        int lo = t - (w >> 1), hi = t + (w >> 1); if (lo < 0) lo = 0; if (hi > SEQ) hi = SEQ;
        float s[8] = {0.f, 0.f, 0.f, 0.f, 0.f, 0.f, 0.f, 0.f}; float self[8];
        const bf16_t* base = H + (size_t)(row - t) * DM + c8 * 8;
        for (int j = lo; j < hi; ++j) { const u32x4 v = *(const u32x4*)(base + (size_t)j * DM);
            const float f[8] = {__uint_as_float(v.x << 16), __uint_as_float(v.x & 0xffff0000u), __uint_as_float(v.y << 16), __uint_as_float(v.y & 0xffff0000u),
                                __uint_as_float(v.z << 16), __uint_as_float(v.z & 0xffff0000u), __uint_as_float(v.w << 16), __uint_as_float(v.w & 0xffff0000u)};
#pragma unroll
            for (int i = 0; i < 8; ++i) { s[i] += f[i]; if (j == t) self[i] = f[i]; } }
        const float inv = 1.0f / (float)(hi - lo);
        *(u32x4*)(P + (size_t)row * DM + c8 * 8) = (u32x4){cvtpk(s[0] * inv - self[0], s[1] * inv - self[1]), cvtpk(s[2] * inv - self[2], s[3] * inv - self[3]),
                                                          cvtpk(s[4] * inv - self[4], s[5] * inv - self[5]), cvtpk(s[6] * inv - self[6], s[7] * inv - self[7])};
    }
}

constexpr int N_PHASES = 24;
#ifndef REP_MASK
#define REP_MASK 0
#endif
__global__ void __launch_bounds__(NWAVES * 64, 2) skel_fwd(Args args) {
    extern __shared__ __attribute__((aligned(16))) unsigned char lds_raw[];
    Frame F;
    F.lds = (LAS unsigned char*)lds_raw; F.MISC = (volatile LAS unsigned*)(F.lds + MISC_OFF);
    F.wave = __builtin_amdgcn_readfirstlane(threadIdx.x >> 6);
    F.G = gridDim.x; { const int bx = blockIdx.x; F.vcu = (F.G % 8 == 0) ? (bx % 8) * (F.G / 8) + bx / 8 : bx; }
    unsigned char* const ws = uptr(args.ws);
    F.ws = ws; F.ctl = (gu32*)(ws + WS_CTL);
    for (int u = threadIdx.x; u < (LDS_BYTES - LDSCTL_OFF) / 4; u += NWAVES * 64) ((LAS unsigned*)(F.lds + LDSCTL_OFF))[u] = 0u;
    __syncthreads();
    const bool multi = (args.ph_hi - args.ph_lo) > 1 || REP_MASK != 0;
    XcdBarrier bar; bar.bar = (unsigned*)(F.ctl + CW_BAR); bar.x = 0; bar.st = nullptr; bar.wave = F.wave;
    if (multi) bar = xcd_barrier_post((unsigned*)(F.ctl + CW_BAR), F.MISC + 8, F.wave);
    const int lo = args.ph_lo, hi = args.ph_hi;
#define IN(k) (lo <= (k) && (k) < hi)
#define PHASE(k) for (int rep_ = 0; rep_ < 1 + (int)((((unsigned)REP_MASK) >> (k)) & 1u); ++rep_)
#define SEAM(k) do { if ((IN(k) && IN((k) + 1)) || rep_ + 1 < 1 + (int)((((unsigned)REP_MASK) >> (k)) & 1u)) xcd_barrier(bar); } while (0)
    LAS unsigned char* ring = F.lds + RING_OFF; LAS unsigned char* xl = F.lds + XL_OFF;
    const int bx = (int)blockIdx.x, G = F.G;

    if (IN(0)) PHASE(0) { p0_prologue(F, args); SEAM(0); }
    if (IN(1)) PHASE(1) {
        {
            MapLin mp{(const char*)(ws + WS_HN), (const char*)(ws + WS_WIN_T), (size_t)256 * DM * 2, (size_t)256 * DM * 2};
            pg8::Sched<MapLin> S; S.init(NTOK / 256, 2560 / 256, G, bx, mp);
            EpiQKV E{(bf16_t*)(ws + WS_QB), (bf16_t*)(ws + WS_KB), (bf16_t*)(ws + WS_VB), args.in[4], args.in[5], (const float*)(ws + WS_ROPE), (const float*)(ws + WS_ROPE) + SEQ * 64};
            pg8::gemm_phase<EpiQKV, pg8::Sched<MapLin>, true>(F.wave, ring, xl, DM, DM * 2, DM * 2, S, E); }
        {
            MapLin mp{(const char*)(ws + WS_WF_T), (const char*)(ws + WS_HN), (size_t)256 * DM * 2, (size_t)256 * DM * 2};
            pg8::Sched<MapLin> S; S.init(1024 / 256, NTOK / 256, G, (bx + G - (320 % G)) % G, mp);
            EpiStore<AddrF1> E{AddrF1{(bf16_t*)(ws + WS_FPQ)}};
            pg8::gemm_phase<EpiStore<AddrF1>, pg8::Sched<MapLin>, true>(F.wave, ring, xl, DM, DM * 2, DM * 2, S, E); }
        for (int l = 0; l < 2; ++l) {
            { MapLin mp{(const char*)(ws + WS_MEMNB + (size_t)l * NB * MEML * DM * 2), (const char*)(ws + WS_WCK_T + (size_t)l * DM * DM * 2), (size_t)256 * DM * 2, (size_t)256 * DM * 2};
              pg8::Sched<MapLin> S; S.init(NB * MEML / 256, DM / 256, G, (bx + G - ((448 + 64 * l) % G)) % G, mp);
              EpiStore<AddrLin> E{AddrLin{(bf16_t*)(ws + WS_KCB + (size_t)l * NB * MEML * DM * 2), DM}};
              pg8::gemm_phase<EpiStore<AddrLin>, pg8::Sched<MapLin>, true>(F.wave, ring, xl, DM, DM * 2, DM * 2, S, E); }
            { MapLin mp{(const char*)(ws + WS_WCV_T + (size_t)l * DM * DM * 2), (const char*)(ws + WS_MEMNB + (size_t)l * NB * MEML * DM * 2), (size_t)256 * DM * 2, (size_t)256 * DM * 2};
              pg8::Sched<MapLin> S; S.init(DM / 256, NB * MEML / 256, G, (bx + G - ((480 + 64 * l) % G)) % G, mp);
              EpiStore<AddrLin> E{AddrLin{(bf16_t*)(ws + WS_VTB + (size_t)l * NB * MEML * DM * 2), NB * MEML}};
              pg8::gemm_phase<EpiStore<AddrLin>, pg8::Sched<MapLin>, true>(F.wave, ring, xl, DM, DM * 2, DM * 2, S, E); }
        }
        SEAM(1);
    }
    if (IN(2)) PHASE(2) {
        const int nF2 = (G > 64) ? 64 : 0;
        if (bx < nF2 || nF2 == 0) {
            MapLin mp{(const char*)(ws + WS_DFT), (const char*)(ws + WS_FPQ), (size_t)256 * 4096 * 2, (size_t)256 * 4096 * 2};
            pg8::Sched<MapLin> S; S.init(8, 8, nF2 ? nF2 : G, bx, mp);
            EpiStore<AddrF2> E{AddrF2{(bf16_t*)(ws + WS_MIXB)}};
            pg8::gemm_phase<EpiStore<AddrF2>, pg8::Sched<MapLin>, true>(F.wave, ring, xl, 4096, 4096 * 2, 4096 * 2, S, E);
        }
        if (bx >= nF2) {
            const int a = bx - nF2, cnt = G - nF2, per = (384 + cnt - 1) / cnt;
            for (int uid = a * per; uid < (a + 1) * per && uid < 384; ++uid) {
                const int qb = uid & 7, hq = (uid >> 3) % NQH, b = uid / (8 * NQH), kvh = hq / 3;
                const bf16_t* Qb = (const bf16_t*)(ws + WS_QB) + ((size_t)b * SEQ + qb * 256) * AW + hq * HD;
                const bf16_t* Kh = (const bf16_t*)(ws + WS_KB) + (size_t)b * SEQ * KVW + kvh * HD;
                const bf16_t* Vh = (const bf16_t*)(ws + WS_VB) + (size_t)b * SEQ * KVW + kvh * HD;
                bf16_t* Ob = (bf16_t*)(ws + WS_MIXB) + ((size_t)b * SEQ + qb * 256) * DM + hq * HD;
                attn::attn_dense_body(Qb, Kh, Vh, Ob, SEQ, (char*)lds_raw + RING_OFF, F.wave);
            }
        }
        SEAM(2);
    }
    if (IN(3)) PHASE(3) {
        MapLin mp{(const char*)(ws + WS_MIXB), (const char*)(ws + WS_WOUT_T), (size_t)256 * DM * 2, (size_t)256 * DM * 2};
        pg8::Sched<MapLin> S; S.init(NTOK / 256, DM / 256, G, bx, mp);
        EpiRes E{args.in[0], args.out, (bf16_t*)(ws + WS_XB), (float*)(ws + WS_SSP), nullptr, 8};
        pg8::gemm_phase<EpiRes, pg8::Sched<MapLin>, true>(F.wave, ring, xl, DM, DM * 2, DM * 2, S, E);
        SEAM(3);
    }
    for (int l = 0; l < 2; ++l) {
        const int pb = l ? 15 : 4;
        if (l == 1) {
            if (IN(13)) PHASE(13) {
                pool_phase(F, (const bf16_t*)(ws + WS_HN), (bf16_t*)(ws + WS_QCB));
                expert_tr_items(F, args.in[18], args.in[19], args.in[20], 1, (LAS float*)(F.lds + RING_OFF + F.wave * 16640));
                SEAM(13);
            }
            if (IN(14)) PHASE(14) {
                MapPool mp{(const char*)(ws + WS_QCB), (const char*)(ws + WS_WP_T)};
                pg8::Sched<MapPool> S; S.init(NTOK / 256, DM / 256, G, bx, mp);
                EpiRes E{args.out, args.out, (bf16_t*)(ws + WS_XB), (float*)(ws + WS_SSP), args.in[9], 8};
                pg8::gemm_phase<EpiRes, pg8::Sched<MapPool>, true>(F.wave, ring, xl, 512, DM * 2, DM * 2, S, E);
                SEAM(14);
            }
        }
        if (IN(pb + 0)) PHASE(pb + 0) {
            MapLin mp{(const char*)(ws + WS_XB), (const char*)(ws + WS_WCQ_T + (size_t)l * DM * DM * 2), (size_t)256 * DM * 2, (size_t)256 * DM * 2};
            pg8::Sched<MapLin> S; S.init(NTOK / 256, DM / 256, G, bx, mp);
            EpiRowScale E{(bf16_t*)(ws + WS_QCB), DM, (const float*)(ws + WS_SSP), 0.04419417382415922f};
            pg8::gemm_phase<EpiRowScale, pg8::Sched<MapLin>, true>(F.wave, ring, xl, DM, DM * 2, DM * 2, S, E);
            SEAM(pb + 0);
        }
        if (IN(pb + 1)) PHASE(pb + 1) {
            MapXS mp{(const char*)(ws + WS_QCB), (const char*)(ws + WS_KCB + (size_t)l * NB * MEML * DM * 2)};
            pg8::Sched<MapXS> S; S.init(NTOK / 256, NMH, G, bx, mp);
            EpiSoftmax E{(bf16_t*)(ws + WS_PB), NMH * MEML};
            pg8::gemm_phase<EpiSoftmax, pg8::Sched<MapXS>, true>(F.wave, ring, xl, MHD, DM * 2, DM * 2, S, E);
            SEAM(pb + 1);
        }
        if (IN(pb + 2)) PHASE(pb + 2) {
            MapXPV mp{(const char*)(ws + WS_PB), (const char*)(ws + WS_VTB + (size_t)l * NB * MEML * DM * 2)};
            pg8::Sched<MapXPV> S; S.init(NTOK / 256, DM / 256, G, bx, mp);
            EpiStore<AddrLin> E{AddrLin{(bf16_t*)(ws + WS_MIXB), DM}};
            pg8::gemm_phase<EpiStore<AddrLin>, pg8::Sched<MapXPV>, true>(F.wave, ring, xl, MEML, NMH * MEML * 2, NB * MEML * 2, S, E);
            SEAM(pb + 2);
        }
        if (IN(pb + 3)) PHASE(pb + 3) {
            MapLin mp{(const char*)(ws + WS_MIXB), (const char*)(ws + WS_WCO_T + (size_t)l * DM * DM * 2), (size_t)256 * DM * 2, (size_t)256 * DM * 2};
            pg8::Sched<MapLin> S; S.init(NTOK / 256, DM / 256, G, bx, mp);
            EpiRes E{args.out, args.out, nullptr, nullptr, nullptr, 8};
            pg8::gemm_phase<EpiRes, pg8::Sched<MapLin>, true>(F.wave, ring, xl, DM, DM * 2, DM * 2, S, E);
            SEAM(pb + 3);
        }
        if (IN(pb + 4)) PHASE(pb + 4) {
            router_phase(F, args.out, args.in[16] + l * DM, args.in[17] + (size_t)l * DM * NE, (bf16_t*)(ws + WS_HN), (float*)(ws + WS_AFF));
            SEAM(pb + 4);
        }
        if (IN(pb + 5)) PHASE(pb + 5) {
            rank_phase(F, (const float*)(ws + WS_AFF), (int*)(ws + WS_RANK), (float*)(ws + WS_GATE), (const bf16_t*)(ws + WS_HN), (bf16_t*)(ws + WS_XSB));
            SEAM(pb + 5);
        }
        if (IN(pb + 6)) PHASE(pb + 6) {
            MapMoE mp{(const char*)(ws + WS_XSB), (const char*)(ws + WS_WGU_T), (size_t)256 * DM * 2, (size_t)2048 * DM * 2, (size_t)256 * DM * 2};
            pg8::Sched<MapMoE> S; S.init(NB * NE, 8, G, bx, mp);
            EpiSwiGLU E{(bf16_t*)(ws + WS_ACTB)};
            pg8::gemm_phase<EpiSwiGLU, pg8::Sched<MapMoE>, true>(F.wave, ring, xl, DM, DM * 2, DM * 2, S, E);
            SEAM(pb + 6);
        }
        if (IN(pb + 7)) PHASE(pb + 7) {
            MapMoE mp{(const char*)(ws + WS_ACTB), (const char*)(ws + WS_WD_T), (size_t)256 * EFF * 2, (size_t)2048 * EFF * 2, (size_t)256 * EFF * 2};
            pg8::Sched<MapMoE> S; S.init(NB * NE, 8, G, bx, mp);
            EpiRowGate E{(bf16_t*)(ws + WS_YB), (const float*)(ws + WS_GATE)};
            pg8::gemm_phase<EpiRowGate, pg8::Sched<MapMoE>, true>(F.wave, ring, xl, EFF, EFF * 2, EFF * 2, S, E);
            SEAM(pb + 7);
        }
        if (IN(pb + 8)) PHASE(pb + 8) {
            combine_phase(F, args.out, (const bf16_t*)(ws + WS_YB), (const int*)(ws + WS_RANK), l == 0 ? args.in[2] + DM : args.in[21], (bf16_t*)(ws + WS_HN), l == 1);
            SEAM(pb + 8);
        }
    }
#undef IN
#undef SEAM
#undef PHASE
}


#ifndef MK_N_LAUNCHES
#define MK_N_LAUNCHES 1
#endif
extern "C" void kernel_launch(void* const* d_in, const int* in_sizes, int n_in, void* d_out, int out_size, void* d_ws, size_t ws_size, hipStream_t stream) {
    static int grid = 0;
    if (grid == 0) {
        int dev = 0, cus = 0;
        if (n_in != 22 || out_size != NTOK * DM || ws_size < WS_FAST_END) { fprintf(stderr, "kernel_launch: unexpected shapes (n_in %d out %d ws %zu)\n", n_in, out_size, ws_size); grid = -1; return; }
        if (hipGetDevice(&dev) != hipSuccess || hipDeviceGetAttribute(&cus, hipDeviceAttributeMultiprocessorCount, dev) != hipSuccess) { fprintf(stderr, "device query failed\n"); grid = -1; return; }
        if (hipFuncSetAttribute((const void*)skel_fwd, hipFuncAttributeMaxDynamicSharedMemorySize, LDS_BYTES) != hipSuccess) { fprintf(stderr, "hipFuncSetAttribute failed\n"); grid = -1; return; }
        (void)hipGetLastError();
        grid = cus;
    }
    if (grid < 0) return;
    hipMemsetAsync((char*)d_ws + WS_CTL, 0, CTL_ZERO_BYTES, stream);
    Args a{};
    for (int i = 0; i < 22; ++i) a.in[i] = (const float*)d_in[i];
    a.out = (float*)d_out; a.ws = (unsigned char*)d_ws;
    constexpr int NL = MK_N_LAUNCHES;
    for (int li = 0; li < NL; ++li) {
        a.ph_lo = (N_PHASES * li) / NL; a.ph_hi = (N_PHASES * (li + 1)) / NL; a.li = li;
        hipLaunchKernelGGL(skel_fwd, dim3(grid), dim3(NWAVES * 64), LDS_BYTES, stream, a);
    }
}
```

```cpp
#include <hip/hip_runtime.h>
#include <cstdio>
#include <cstdint>

constexpr int DM = 2048, NB = 4, SEQ = 2048, NTOK = NB * SEQ;
constexpr int HD = 128, NQH = 12, NKVH = 4, AW = NQH * HD, KVW = NKVH * HD, FW = 512, INW = 3072;
constexpr int MEML = 256, NMH = 4, MHD = 512;
constexpr int NE = 16, EFF = 1024, CAP = 256;
constexpr float EPS = 1e-6f;

#define LAS __attribute__((address_space(3)))
#define GAS __attribute__((address_space(1)))
typedef unsigned short bf16_t;
typedef short bf16x8 __attribute__((ext_vector_type(8)));
typedef float f32x4 __attribute__((ext_vector_type(4)));
typedef float f32x2 __attribute__((ext_vector_type(2)));
typedef unsigned u32x4 __attribute__((ext_vector_type(4)));
typedef unsigned u32x2 __attribute__((ext_vector_type(2)));
typedef __bf16 bf16x2_t __attribute__((ext_vector_type(2)));
__device__ __forceinline__ unsigned cvtpk(float lo, float hi) { f32x2 v = {lo, hi}; bf16x2_t b = __builtin_convertvector(v, bf16x2_t); return __builtin_bit_cast(unsigned, b); }
__device__ __forceinline__ float bf2f(unsigned short h) { return __uint_as_float(((unsigned)h) << 16); }
template <class T> __device__ __forceinline__ T* uptr(T* p) { const unsigned long long v = (unsigned long long)p; const unsigned lo = __builtin_amdgcn_readfirstlane((unsigned)v), hi = __builtin_amdgcn_readfirstlane((unsigned)(v >> 32)); return (T*)(((unsigned long long)hi << 32) | lo); }
__device__ __forceinline__ int lane_id() { int l = (int)__builtin_amdgcn_mbcnt_hi(~0u, __builtin_amdgcn_mbcnt_lo(~0u, 0u)); asm volatile("" : "+v"(l)); return l; }
typedef __attribute__((address_space(4))) const unsigned char* karg_t;
__device__ __forceinline__ karg_t kargs() { karg_t p = (karg_t)__builtin_amdgcn_kernarg_segment_ptr(); asm volatile("" : "+s"(p)); return p; }
#define KIN(ka, i) (*(const float* const __attribute__((address_space(4)))*)((ka) + 8 * (i)))
#define KOUT(ka) (*(float* const __attribute__((address_space(4)))*)((ka) + 176))
#define KWS(ka) (*(unsigned char* const __attribute__((address_space(4)))*)((ka) + 184))
#define LDS_WAIT() asm volatile("s_waitcnt lgkmcnt(0)" ::: "memory")
#define VM_WAIT() asm volatile("s_waitcnt vmcnt(0)" ::: "memory")
#define WG_BAR() do { asm volatile("s_waitcnt lgkmcnt(0)" ::: "memory"); __builtin_amdgcn_s_barrier(); asm volatile("" ::: "memory"); } while (0)

namespace pg8 {
constexpr int BM = 256, BK = 64, HALF = 128, HTB = HALF * BK * 2, STAGE_BYTES = 8 * HTB, NXCD = 8, WGM = 8;
__host__ __device__ __forceinline__ int lds_byte(int r, int c) { const int st = (r >> 4) * 2 + (c >> 5), rr = r & 15, cc = c & 31, ob = rr * 64 + cc * 2; return st * 1024 + (ob ^ (((ob >> 9) & 1) << 5)); }
__host__ __device__ __forceinline__ void stage_rc(int b, int& R, int& C) { const int st = b / 1024, sb = b % 1024, swz = sb ^ (((sb >> 9) & 1) << 5); R = (st >> 1) * 16 + swz / 64; C = (st & 1) * 32 + (swz % 64) / 2; }
__host__ __device__ __forceinline__ int perm32(int rho) { const int n = rho >> 4, i = rho & 15; return 8 * (i >> 2) + 4 * n + (i & 3); }

struct Unit { int pm, pn; const char* a; const char* b; };
struct EpiCtx { int wr, wc, wid; LAS unsigned char* xl; };

template <class Map> struct Sched {
    int nM, nN, nwg, G, c; Map map;
    __device__ __forceinline__ void init(int nM_, int nN_, int G_, int c_, const Map& m) { nM = nM_; nN = nN_; nwg = nM * nN; G = G_; c = c_; map = m; }
    __device__ __forceinline__ bool next(int i, Unit& u) const {
        const long L = (long)i * G + c; if (L >= nwg) return false;
        int wgid = (int)L; { const int q = nwg / NXCD, r = nwg % NXCD, xcd = wgid % NXCD, off = wgid / NXCD; wgid = (xcd < r ? xcd * (q + 1) : r * (q + 1) + (xcd - r) * q) + off; }
        const int nig = WGM * nN, gid = wgid / nig, fm = gid * WGM, gsz = (nM - fm) < WGM ? (nM - fm) : WGM;
        u.pm = fm + ((wgid % nig) % gsz); u.pn = (wgid % nig) / gsz; map(u); return true;
    }
};

template <class Epi, class SchedT, bool SP2>
__device__ __forceinline__ void gemm_phase(const int wave_, LAS unsigned char* lds, LAS unsigned char* xl, const int K, const int lda, const int ldb, const SchedT& S, const Epi& E) {
    constexpr bool ALIGN_EPI = true;
    const int lane = lane_id(), wid = wave_, tid = wid * 64 + lane, wr = wid >> 2, wc = wid & 3, fr = lane & 15, fq = lane >> 4;
    const int nt = K / BK;
    unsigned voffA[2], voffB[2];
#pragma unroll
    for (int i = 0; i < 2; ++i) { int R, C; stage_rc(tid * 16 + i * 8192, R, C); const int Rb = Epi::PERM ? ((R & ~31) + perm32(R & 31)) : R;
        voffA[i] = (unsigned)(R * lda + C * 2); voffB[i] = (unsigned)(Rb * ldb + C * 2); }
    const size_t kstep = (size_t)(BK * 2);
    const size_t hstepA = (size_t)HALF * lda, hstepB = (size_t)HALF * ldb;
    const unsigned ldsw = (unsigned)wid * 1024u;
    const int aoff = lds_byte(wr * 64 + fr, fq * 8), boff = lds_byte(wc * 32 + fr, fq * 8);
#define PG8_SA(b, h) (((b) * 2 + (h)) * HTB)
#define PG8_SB(b, h) ((4 + (b) * 2 + (h)) * HTB)
#define PG8_STAGE(bufoff, gbase, voff) do { _Pragma("unroll") for (int _i = 0; _i < 2; ++_i) \
        __builtin_amdgcn_global_load_lds((const unsigned*)((const char*)(gbase) + (voff)[_i]), (LAS unsigned*)(lds + (bufoff) + ldsw + _i * 8192), 16, 0, 0); } while (0)
#define PG8_LDA(dst, b, h) do { _Pragma("unroll") for (int m = 0; m < 4; ++m) _Pragma("unroll") for (int k = 0; k < 2; ++k) dst[m][k] = *(const LAS bf16x8*)(lds + PG8_SA(b, h) + aoff + m * 2048 + k * 1024); } while (0)
#define PG8_LDB(dst, b, h) do { _Pragma("unroll") for (int n = 0; n < 2; ++n) _Pragma("unroll") for (int k = 0; k < 2; ++k) dst[n][k] = *(const LAS bf16x8*)(lds + PG8_SB(b, h) + boff + n * 2048 + k * 1024); } while (0)
#define PG8_MMA(ai, bj, At, Bt) do { __builtin_amdgcn_s_setprio(1); _Pragma("unroll") for (int m = 0; m < 4; ++m) _Pragma("unroll") for (int n = 0; n < 2; ++n) _Pragma("unroll") for (int k = 0; k < 2; ++k) \
        acc[ai][bj][m][n] = __builtin_amdgcn_mfma_f32_16x16x32_bf16(Bt[n][k], At[m][k], acc[ai][bj][m][n], 0, 0, 0); __builtin_amdgcn_s_setprio(0); } while (0)
#define PG8_WAIT_V(n) asm volatile("s_waitcnt vmcnt(" #n ")" ::: "memory")
#define PG8_WAIT_L(n) asm volatile("s_waitcnt lgkmcnt(" #n ")" ::: "memory")
#define PG8_BAR __builtin_amdgcn_s_barrier()
#define PG8_SCHED __builtin_amdgcn_sched_barrier(0)
    Unit cur, nxt; int ui = 0;
    if (!S.next(0, cur)) return;
    EpiCtx ctx; ctx.wr = wr; ctx.wc = wc; ctx.wid = wid; ctx.xl = xl;
    f32x4 acc[2][2][4][2];
#pragma unroll
    for (int a = 0; a < 2; ++a)
#pragma unroll
        for (int b = 0; b < 2; ++b)
#pragma unroll
            for (int m = 0; m < 4; ++m)
#pragma unroll
                for (int n = 0; n < 2; ++n) acc[a][b][m][n] = (f32x4){0.f, 0.f, 0.f, 0.f};
    bf16x8 At[4][2], B0[2][2], B1[2][2];
    const char* cA = cur.a; const char* cB = cur.b;
    if constexpr (SP2) {
        PG8_STAGE(PG8_SB(0, 0), cB, voffB); PG8_STAGE(PG8_SB(0, 1), cB + hstepB, voffB); PG8_STAGE(PG8_SA(0, 0), cA, voffA); PG8_STAGE(PG8_SA(0, 1), cA + hstepA, voffA);
        if (wr == 1) PG8_BAR;
        PG8_WAIT_V(2); PG8_BAR;
        PG8_STAGE(PG8_SB(1, 0), cB + kstep, voffB); PG8_STAGE(PG8_SA(1, 0), cA + kstep, voffA); PG8_STAGE(PG8_SB(1, 1), cB + hstepB + kstep, voffB);
        PG8_WAIT_V(6); PG8_BAR;
    } else {
        PG8_STAGE(PG8_SB(0, 0), cB, voffB); PG8_STAGE(PG8_SA(0, 0), cA, voffA); PG8_STAGE(PG8_SB(0, 1), cB + hstepB, voffB); PG8_STAGE(PG8_SA(0, 1), cA + hstepA, voffA);
        if (wr == 1) PG8_BAR;
        PG8_WAIT_V(4); PG8_BAR;
        PG8_STAGE(PG8_SB(1, 0), cB + kstep, voffB); PG8_STAGE(PG8_SA(1, 0), cA + kstep, voffA); PG8_STAGE(PG8_SB(1, 1), cB + hstepB + kstep, voffB);
        PG8_WAIT_V(6); PG8_BAR;
    }
    for (;;) {
        const bool has_next = S.next(ui + 1, nxt);
        const char* nA = has_next ? nxt.a : cA; const char* nB = has_next ? nxt.b : cB;
        for (int t = 0; t < nt; t += 2) {
            const bool last = (t == nt - 2);
            const char* a1 = cA + (size_t)(t + 1) * kstep;
            const char* a2 = last ? nA : cA + (size_t)(t + 2) * kstep; const char* b2 = last ? nB : cB + (size_t)(t + 2) * kstep;
            const char* a3 = a2 + kstep; const char* b3 = b2 + kstep;
            if constexpr (SP2) {
            PG8_LDB(B0, 0, 0); PG8_LDB(B1, 0, 1); PG8_SCHED; PG8_LDA(At, 0, 0); PG8_STAGE(PG8_SA(1, 1), a1 + hstepA, voffA);
            PG8_WAIT_V(8); PG8_WAIT_L(0); PG8_BAR; PG8_MMA(0, 0, At, B0); PG8_MMA(0, 1, At, B1); PG8_BAR; PG8_SCHED;
            PG8_LDA(At, 0, 1); PG8_STAGE(PG8_SB(0, 0), b2, voffB); PG8_STAGE(PG8_SB(0, 1), b2 + hstepB, voffB); PG8_STAGE(PG8_SA(0, 0), a2, voffA);
            PG8_WAIT_V(8); PG8_WAIT_L(0); PG8_BAR; PG8_MMA(1, 0, At, B0); PG8_MMA(1, 1, At, B1); PG8_BAR; PG8_SCHED;
            PG8_LDB(B0, 1, 0); PG8_LDB(B1, 1, 1); PG8_SCHED; PG8_LDA(At, 1, 0); PG8_STAGE(PG8_SA(0, 1), a2 + hstepA, voffA);
            PG8_WAIT_V(8); PG8_WAIT_L(0); PG8_BAR; PG8_MMA(0, 0, At, B0); PG8_MMA(0, 1, At, B1); PG8_BAR; PG8_SCHED;
            PG8_LDA(At, 1, 1); PG8_STAGE(PG8_SB(1, 0), b3, voffB); PG8_STAGE(PG8_SB(1, 1), b3 + hstepB, voffB); PG8_STAGE(PG8_SA(1, 0), a3, voffA);
            PG8_WAIT_V(8); PG8_WAIT_L(0); PG8_BAR; PG8_MMA(1, 0, At, B0); PG8_MMA(1, 1, At, B1); PG8_BAR; PG8_SCHED;
            } else {
            PG8_LDB(B0, 0, 0); PG8_SCHED; PG8_LDA(At, 0, 0); PG8_STAGE(PG8_SA(1, 1), a1 + hstepA, voffA);
            PG8_WAIT_L(8); PG8_BAR; PG8_WAIT_L(0); PG8_MMA(0, 0, At, B0); PG8_BAR; PG8_SCHED;
            PG8_LDB(B1, 0, 1); PG8_STAGE(PG8_SB(0, 0), b2, voffB);
            PG8_BAR; PG8_WAIT_L(0); PG8_MMA(0, 1, At, B1); PG8_BAR;
            PG8_LDA(At, 0, 1); PG8_STAGE(PG8_SA(0, 0), a2, voffA);
            PG8_BAR; PG8_WAIT_L(0); PG8_MMA(1, 0, At, B0); PG8_BAR; PG8_SCHED;
            PG8_STAGE(PG8_SB(0, 1), b2 + hstepB, voffB);
            PG8_WAIT_V(6); PG8_BAR; PG8_MMA(1, 1, At, B1); PG8_BAR;
            PG8_LDB(B0, 1, 0); PG8_SCHED; PG8_LDA(At, 1, 0); PG8_STAGE(PG8_SA(0, 1), a2 + hstepA, voffA);
            PG8_WAIT_L(8); PG8_BAR; PG8_WAIT_L(0); PG8_MMA(0, 0, At, B0); PG8_BAR; PG8_SCHED;
            PG8_LDB(B1, 1, 1); PG8_STAGE(PG8_SB(1, 0), b3, voffB);
            PG8_BAR; PG8_WAIT_L(0); PG8_MMA(0, 1, At, B1); PG8_BAR;
            PG8_LDA(At, 1, 1); PG8_STAGE(PG8_SA(1, 0), a3, voffA);
            PG8_BAR; PG8_WAIT_L(0); PG8_MMA(1, 0, At, B0); PG8_BAR; PG8_SCHED;
            PG8_STAGE(PG8_SB(1, 1), b3 + hstepB, voffB);
            PG8_WAIT_V(6); PG8_BAR; PG8_MMA(1, 1, At, B1); PG8_BAR;
            }
        }
        if constexpr (ALIGN_EPI) { if (wr == 0) PG8_BAR; }
        E(acc, cur, ctx);
        if (!has_next) break;
#pragma unroll
        for (int a = 0; a < 2; ++a)
#pragma unroll
            for (int b = 0; b < 2; ++b)
#pragma unroll
                for (int m = 0; m < 4; ++m)
#pragma unroll
                    for (int n = 0; n < 2; ++n) acc[a][b][m][n] = (f32x4){0.f, 0.f, 0.f, 0.f};
        cur = nxt; cA = nA; cB = nB; ++ui;
        if constexpr (ALIGN_EPI) { if (wr == 1) PG8_BAR; }
    }
    PG8_WAIT_V(0);
    if constexpr (!ALIGN_EPI) { if (wr == 0) PG8_BAR; }
    PG8_BAR;
#undef PG8_SA
#undef PG8_SB
#undef PG8_STAGE
#undef PG8_LDA
#undef PG8_LDB
#undef PG8_MMA
#undef PG8_WAIT_V
#undef PG8_WAIT_L
#undef PG8_BAR
#undef PG8_SCHED
}
}

constexpr size_t MiB = 1u << 20;
constexpr size_t WS_CTL = 0, CTL_ZERO_BYTES = 1 * MiB;
constexpr size_t WS_WIN_T = 1 * MiB, WS_WF_T = 11 * MiB, WS_WOUT_T = 15 * MiB, WS_WCQ_T = 23 * MiB, WS_WCK_T = 39 * MiB, WS_WCV_T = 55 * MiB, WS_WCO_T = 71 * MiB;
constexpr size_t WS_WP_T = 87 * MiB, WS_DFT = 89 * MiB, WS_ROPE = 105 * MiB, WS_WGU_T = 106 * MiB, WS_WD_T = 234 * MiB;
constexpr size_t WS_HN = 298 * MiB, WS_XB = 330 * MiB, WS_QB = 362 * MiB, WS_KB = 386 * MiB, WS_VB = 394 * MiB, WS_FPQ = 402 * MiB, WS_MIXB = 418 * MiB, WS_QCB = 450 * MiB;
constexpr size_t WS_KCB = 482 * MiB, WS_VTB = 490 * MiB, WS_MEMNB = 498 * MiB, WS_PB = 506 * MiB, WS_XSB = 522 * MiB, WS_ACTB = 586 * MiB, WS_YB = 618 * MiB;
constexpr size_t WS_SSP = 682 * MiB, WS_AFF = 683 * MiB, WS_RANK = 684 * MiB, WS_GATE = 685 * MiB, WS_XALT = 686 * MiB, WS_WGU_T2 = 750 * MiB, WS_WD_T2 = 878 * MiB, WS_FAST_END = 942 * MiB;
constexpr int CW_TMO = 0, CW_CODE = 1, CW_BAR = 4096;
constexpr int RING_OFF = 0, RING_BYTES = 131072, XL_OFF = 131072, XL_BYTES = 14336, LDSCTL_OFF = XL_OFF + XL_BYTES, MISC_OFF = LDSCTL_OFF + 320, LDS_BYTES = 147456;
static_assert(MISC_OFF + 128 <= LDS_BYTES, "LDS map");
constexpr int NWAVES = 8;

typedef GAS unsigned gu32;
#define RLX_AGENT __ATOMIC_RELAXED, __HIP_MEMORY_SCOPE_AGENT

#define XB_TMO      128
#define XB_XCNT(j)  (256  + 64 * (j))
#define XB_XSUB(j)  (1280 + 64 * (j))
#define XB_XGEN(j)  (2304 + 64 * (j))
#define XB_TOP      3328
#define XB_TOPGEN   3392
#define XCD_BAR_WORDS 3456
#define XB_SPIN_CAP (1u << 18)
__device__ __forceinline__ unsigned xb_ld(unsigned* p)              { return __hip_atomic_load(p, __ATOMIC_RELAXED, __HIP_MEMORY_SCOPE_AGENT); }
__device__ __forceinline__ unsigned xb_add(unsigned* p, unsigned v) { return __hip_atomic_fetch_add(p, v, __ATOMIC_RELAXED, __HIP_MEMORY_SCOPE_AGENT); }
__device__ __forceinline__ unsigned xb_xcc_id() { return (unsigned)__builtin_amdgcn_s_getreg((3 << 11) | 20) & 0xFu; }
#define XB_SPIN(cond, bar) do { unsigned _sp = 0; while (cond) { __builtin_amdgcn_s_sleep(1); \
    if ((++_sp & 255u) == 0u) { if (xb_ld(&(bar)[XB_TMO])) break; if (_sp > XB_SPIN_CAP) { atomicAdd(&(bar)[XB_TMO], 1u); break; } } } } while (0)
struct XcdBarrier { unsigned* bar; unsigned x; volatile LAS unsigned* st; int wave; };
__device__ __forceinline__ XcdBarrier xcd_barrier_post(unsigned* bar, volatile LAS unsigned* st, int wave) {
    XcdBarrier b; b.bar = bar; b.x = xb_xcc_id(); b.st = st; b.wave = wave;
    if (wave == 0 && lane_id() == 0) (void)xb_add(&bar[XB_XCNT(b.x)], 1u);
    return b;
}
__device__ __forceinline__ void xcd_barrier_complete(unsigned* bar, unsigned x, unsigned& nloc, unsigned& nx) {
    const unsigned G = gridDim.x * gridDim.y * gridDim.z;
    unsigned sum, cnt, mine, sp = 0u;
    for (;;) {
        sum = 0u; cnt = 0u; mine = 0u;
#pragma unroll
        for (unsigned j = 0; j < 16; ++j) { const unsigned c = xb_ld(&bar[XB_XCNT(j)]); sum += c; cnt += (c > 0u) ? 1u : 0u; mine = (j == x) ? c : mine; }
        if (sum == G) break;
        __builtin_amdgcn_s_sleep(1);
        if ((++sp & 255u) == 0u) { if (xb_ld(&bar[XB_TMO])) break; if (sp > XB_SPIN_CAP) { atomicAdd(&bar[XB_TMO], 1u); break; } }
    }
    nloc = mine > 0u ? mine : 1u; nx = cnt > 0u ? cnt : 1u;
}
__device__ __forceinline__ void xcd_barrier(const XcdBarrier& b) {
    asm volatile("s_waitcnt vmcnt(0)" ::: "memory");
    __syncthreads();
    if (b.wave == 0 && lane_id() == 0) {
        unsigned* bar = b.bar;
        __builtin_amdgcn_s_waitcnt(0);
        unsigned nloc = b.st[0], nx = b.st[1];
        if (nloc == 0u) { xcd_barrier_complete(bar, b.x, nloc, nx); b.st[0] = nloc; b.st[1] = nx; }
        const unsigned old = xb_add(&bar[XB_XSUB(b.x)], 1u);
        const unsigned gen = old / nloc;
        if (old + 1u == (gen + 1u) * nloc) {
            __builtin_amdgcn_fence(__ATOMIC_RELEASE, "agent");
            asm volatile("s_waitcnt vmcnt(0)" ::: "memory");
            const unsigned og = xb_add(&bar[XB_TOP], 1u);
            const unsigned tg = og / nx;
            if (og + 1u == (tg + 1u) * nx) xb_add(&bar[XB_TOPGEN], 1u);
            else XB_SPIN(xb_ld(&bar[XB_TOPGEN]) == tg, bar);
            __builtin_amdgcn_fence(__ATOMIC_ACQUIRE, "agent");
            xb_add(&bar[XB_XGEN(b.x)], 1u);
            asm volatile("s_waitcnt vmcnt(0)" ::: "memory");
        } else {
            XB_SPIN(xb_ld(&bar[XB_XGEN(b.x)]) == gen, bar);
            __builtin_amdgcn_fence(__ATOMIC_ACQUIRE, "agent");
            asm volatile("s_waitcnt vmcnt(0)" ::: "memory");
        }
    }
    __syncthreads();
}

struct Args { const float* in[22]; float* out; unsigned char* ws; int ph_lo, ph_hi, li, pad; };
struct Frame {
    LAS unsigned char* lds; volatile LAS unsigned* MISC; gu32* ctl;
    int wave, vcu, G;
    unsigned char* ws;
};
__device__ __forceinline__ float wave_sum(float v) {
#pragma unroll
    for (int o = 1; o < 64; o <<= 1) v += __shfl_xor(v, o);
    return v;
}
struct TrDesc { const float* W; const float* gain; bf16_t* WT; int ldw, ldt, k0, n0; long drow0; };
__device__ __forceinline__ void tr_load(const TrDesc& d, f32x4 (&v)[16], int lane) {
    const int lr = lane >> 4, lc = (lane & 15) * 4;
#pragma unroll
    for (int i = 0; i < 16; ++i) v[i] = *(const GAS f32x4*)(d.W + (size_t)(d.k0 + 4 * i + lr) * d.ldw + d.n0 + lc);
}
#ifndef TRV
#define TRV 0
#endif
template <int V> __device__ __forceinline__ void tr_finish(const TrDesc& d, const f32x4 (&v)[16], LAS float* scr, int lane) {
    const int lr = lane >> 4, lc = (lane & 15) * 4;
    if (V == 1) { f32x4 s = v[0]; for (int i = 1; i < 16; ++i) s = s + v[i]; if (s.x == 1.2345e30f) *(GAS f32x4*)(d.WT) = s; return; }
#pragma unroll
    for (int i = 0; i < 16; ++i) { const int kk = 4 * i + lr; f32x4 x = v[i]; if (d.gain) x = x * d.gain[d.k0 + kk];
        LAS float* s = scr + kk * 65 + lc; s[0] = x.x; s[1] = x.y; s[2] = x.z; s[3] = x.w; }
    LDS_WAIT(); asm volatile("" ::: "memory");
    const int c = lane & 7;
#pragma unroll
    for (int j = 0; j < 8; ++j) { const int n = (lane >> 3) + 8 * j; const LAS float* s = scr + (8 * c) * 65 + n;
        u32x4 o; o.x = cvtpk(s[0 * 65], s[1 * 65]); o.y = cvtpk(s[2 * 65], s[3 * 65]); o.z = cvtpk(s[4 * 65], s[5 * 65]); o.w = cvtpk(s[6 * 65], s[7 * 65]);
        if (V == 0 || o.x == 0x12345678u) *(GAS u32x4*)(d.WT + (size_t)(d.drow0 + n) * d.ldt + d.k0 + 8 * c) = o; }
    LDS_WAIT(); asm volatile("" ::: "memory");
}
#ifndef TR_PIPE
#define TR_PIPE 0
#endif
constexpr int TR_DENSE = 32 * 20 + 9 * 32 * 16 + 32 * 4, TR_EXPERT = NE * 768;
__device__ __forceinline__ TrDesc tr_desc(karg_t ka, unsigned char* ws, int it, int mode) {
    TrDesc d; d.gain = nullptr;
    constexpr int I_IN = 32 * 20, I_SQ = 32 * 16;
    if (mode == 0) {
        int r = it;
        if (r < I_IN) { d.W = KIN(ka, 3); d.ldw = INW; d.WT = (bf16_t*)(ws + WS_WIN_T); d.ldt = DM; d.k0 = (r / 20) * 64; d.n0 = (r % 20) * 128; d.drow0 = d.n0; return d; } r -= I_IN;
        if (r < I_SQ) { d.W = KIN(ka, 7); d.ldw = DM; d.WT = (bf16_t*)(ws + WS_WOUT_T); d.ldt = DM; d.k0 = (r / 16) * 64; d.n0 = (r % 16) * 128; d.drow0 = d.n0; return d; } r -= I_SQ;
        if (r < 8 * I_SQ) { const int j = r / I_SQ, q = r % I_SQ, wsel = j >> 1, layer = j & 1;
            d.W = KIN(ka, 12 + wsel) + (size_t)layer * DM * DM; d.ldw = DM; if (wsel == 0) d.gain = KIN(ka, 10) + layer * DM;
            d.WT = (bf16_t*)(ws + (wsel == 0 ? WS_WCQ_T : wsel == 1 ? WS_WCK_T : wsel == 2 ? WS_WCV_T : WS_WCO_T) + (size_t)layer * DM * DM * 2); d.ldt = DM;
            d.k0 = (q / 16) * 64; d.n0 = (q % 16) * 128; d.drow0 = d.n0; return d; } r -= 8 * I_SQ;
        d.W = KIN(ka, 8); d.ldw = 512; d.WT = (bf16_t*)(ws + WS_WP_T); d.ldt = DM; d.k0 = (r / 4) * 64; d.n0 = (r % 4) * 128; d.drow0 = d.n0; return d;
    }
    const int layer = mode - 1;
    const int e = it / 768, r = it % 768; const size_t eo = (size_t)(layer * NE + e);
    if (r < 512) { const int up = r >> 8, q = r & 255, kb = q >> 3, nb = q & 7, n0 = nb * 128;
        d.W = (up ? KIN(ka, 19) : KIN(ka, 18)) + eo * DM * EFF; d.ldw = EFF; d.WT = (bf16_t*)(ws + (layer ? WS_WGU_T2 : WS_WGU_T)) + (size_t)e * 2048 * 2048; d.ldt = 2048;
        d.k0 = kb * 64; d.n0 = n0; d.drow0 = (long)(n0 >> 7) * 256 + up * 128;
    } else { const int q = r - 512, kb = q >> 4, nb = q & 15;
        d.W = KIN(ka, 20) + eo * EFF * DM; d.ldw = DM; d.WT = (bf16_t*)(ws + (layer ? WS_WD_T2 : WS_WD_T)) + (size_t)e * 2048 * 1024; d.ldt = 1024; d.k0 = kb * 64; d.n0 = nb * 128; d.drow0 = nb * 128; }
    return d;
}
template <int V = 0> __device__ __forceinline__ void tr_span(const Frame& F, karg_t ka, unsigned char* ws, int mode, int first, int stride, int cnt) {
    const int lane = lane_id(); LAS float* scr = (LAS float*)(F.lds + RING_OFF + F.wave * 16640);
    for (int j = 0; j < cnt; ++j) { f32x4 va[16], vb[16]; TrDesc da = tr_desc(ka, ws, first + stride * j, mode), db = da; db.n0 += 64; db.drow0 += 64;
        tr_load(da, va, lane); tr_load(db, vb, lane); tr_finish<V>(da, va, scr, lane); tr_finish<V>(db, vb, scr, lane); }
}
__device__ __forceinline__ void rms_row_to_bf16(const float* xrow, const float* __restrict__ gain, bf16_t* orow, int lane) {
    const GAS f32x4* xr = (const GAS f32x4*)xrow + lane; const f32x4* gr = (const f32x4*)gain + lane;
    f32x4 v[8]; float s = 0.f;
#pragma unroll
    for (int j = 0; j < 8; ++j) { v[j] = xr[64 * j]; s += (v[j].x * v[j].x + v[j].y * v[j].y) + (v[j].z * v[j].z + v[j].w * v[j].w); }
    const float r = rsqrtf(wave_sum(s) * (1.f / DM) + EPS);
    GAS u32x2* o8 = (GAS u32x2*)orow + lane;
#pragma unroll
    for (int j = 0; j < 8; ++j) { const f32x4 g = gr[64 * j]; u32x2 w; w.x = cvtpk(v[j].x * r * g.x, v[j].y * r * g.y); w.y = cvtpk(v[j].z * r * g.z, v[j].w * r * g.w); o8[64 * j] = w; }
}

__device__ __forceinline__ void p0_prologue(Frame& F, karg_t ka, unsigned char* ws) {
    const float* x = KIN(ka, 0); const float* mem = KIN(ka, 1); const float* mix_norm = KIN(ka, 2); const float* w_in = KIN(ka, 3);
    const float* w_four = KIN(ka, 6); const float* w_out = KIN(ka, 7); const float* pool_w = KIN(ka, 8); const float* cross_norm = KIN(ka, 10); const float* mem_norm = KIN(ka, 11);
    const int gw = F.vcu * NWAVES + F.wave, NGW = F.G * NWAVES;
    const int p_lane = lane_id(), p_tid = F.wave * 64 + p_lane;
    { LAS float* tab = (LAS float*)(F.lds + RING_OFF);
      for (int m = p_tid; m < 2048; m += 512) tab[m] = cosf(6.283185307179586f * (float)m * (1.0f / 2048.0f));
      __syncthreads();
      bf16_t* DFT = (bf16_t*)(ws + WS_DFT);
      for (int row = F.vcu * 8; row < 2048; row += F.G * 8)
          for (int rr = 0; rr < 8; ++rr) { const int k1 = row + rr; if (k1 >= 2048) break;
              { const int c0 = p_tid * 8; const int which = c0 >> 11, s0 = c0 & 2047; unsigned w[4];
#pragma unroll
                for (int j = 0; j < 4; ++j) { const int ma = (k1 * (s0 + 2 * j)) & 2047, mb = (k1 * (s0 + 2 * j + 1)) & 2047;
                    w[j] = cvtpk(tab[(ma - which * 512) & 2047], tab[(mb - which * 512) & 2047]); }
                *(GAS u32x4*)(DFT + (size_t)k1 * 4096 + c0) = (u32x4){w[0], w[1], w[2], w[3]}; } }
      __syncthreads(); }
    { float* RC = (float*)(ws + WS_ROPE); float* RS = RC + SEQ * 64;
      for (int i = F.vcu * 512 + p_tid; i < SEQ * 64; i += F.G * 512) { const int t = i >> 6, p = i & 63; const int pos = (p < 32) ? (t >> 6) : (t & 63); const int j = p & 31;
          const float inv = 1.0f / powf(10000.0f, (float)(2 * j) / 64.0f); const float ang = (float)pos * inv; RC[i] = cosf(ang); RS[i] = sinf(ang); } }
    { LAS float* Mw = (LAS float*)(F.lds + RING_OFF); LAS float* t128 = Mw + 128 * 32;
      bf16_t* WF = (bf16_t*)(ws + WS_WF_T);
      for (int it = F.vcu; it < 256; it += F.G) {
          const int which = it >> 7, g = (it >> 5) & 3, d0 = ((it >> 3) & 3) * 32, k0 = (it & 7) * 256;
          if (p_tid < 128) t128[p_tid] = cosf(6.283185307179586f * (float)p_tid * (1.0f / 128.0f));
          __syncthreads();
          { const int c = p_tid >> 2, dd = (p_tid & 3) * 8; float o[8] = {0.f, 0.f, 0.f, 0.f, 0.f, 0.f, 0.f, 0.f};
            for (int k2 = 0; k2 < 128; ++k2) { const int m = (c * k2) & 127; const float tv = which ? -t128[(m - 32) & 127] : t128[m];
                const float* wr_ = w_four + ((size_t)g * 128 + k2) * 128 + d0 + dd; const f32x4 w0 = *(const f32x4*)wr_, w1 = *(const f32x4*)(wr_ + 4);
                o[0] += tv * w0.x; o[1] += tv * w0.y; o[2] += tv * w0.z; o[3] += tv * w0.w; o[4] += tv * w1.x; o[5] += tv * w1.y; o[6] += tv * w1.z; o[7] += tv * w1.w; }
#pragma unroll
            for (int j = 0; j < 8; ++j) Mw[c * 32 + dd + j] = o[j] * (1.0f / 512.0f); }
          __syncthreads();
          { const int kp = p_tid & 127, dq = p_tid >> 7, k = k0 + 2 * kp; float o0[8] = {0.f, 0.f, 0.f, 0.f, 0.f, 0.f, 0.f, 0.f}, o1[8] = {0.f, 0.f, 0.f, 0.f, 0.f, 0.f, 0.f, 0.f};
            const float* r0 = w_in + (size_t)k * INW + 2560 + g * 128; const float* r1 = r0 + INW;
            for (int c4 = 0; c4 < 32; ++c4) { const f32x4 a = *(const f32x4*)(r0 + 4 * c4), b = *(const f32x4*)(r1 + 4 * c4); const float av[4] = {a.x, a.y, a.z, a.w}, bv[4] = {b.x, b.y, b.z, b.w};
#pragma unroll
                for (int cc = 0; cc < 4; ++cc) { const LAS float* mr = Mw + (4 * c4 + cc) * 32 + dq * 8;
#pragma unroll
                    for (int j = 0; j < 8; ++j) { o0[j] += av[cc] * mr[j]; o1[j] += bv[cc] * mr[j]; } } }
#pragma unroll
            for (int j = 0; j < 8; ++j) *(GAS unsigned*)(WF + (size_t)(which * 512 + g * 128 + d0 + dq * 8 + j) * DM + k) = cvtpk(o0[j], o1[j]); }
          __syncthreads(); } }
    { const int n = (TR_DENSE - gw + NGW - 1) / NGW; tr_span(F, ka, ws, 0, gw, NGW, n > 0 ? n : 0); }
    __syncthreads();
    for (int m = gw; m < NTOK; m += NGW) rms_row_to_bf16(x + (size_t)m * DM, mix_norm, (bf16_t*)(ws + WS_HN) + (size_t)m * DM, p_lane);
    for (int m = gw; m < 2 * NB * MEML; m += NGW) { const int l = m / (NB * MEML), r = m % (NB * MEML);
        rms_row_to_bf16(mem + (size_t)r * DM, mem_norm + l * DM, (bf16_t*)(ws + WS_MEMNB) + (size_t)m * DM, p_lane); }
}

struct MapLin { const char* A; const char* B; size_t as, bs; __device__ __forceinline__ void operator()(pg8::Unit& u) const { u.a = A + (size_t)u.pm * as; u.b = B + (size_t)u.pn * bs; } };

struct EpiQKV {
    static constexpr bool PERM = true;
    bf16_t* Q; bf16_t* K; bf16_t* V; const float* qg; const float* kg; const float* RC; const float* RS;
    __device__ __forceinline__ void operator()(f32x4 (&acc)[2][2][4][2], const pg8::Unit& u, const pg8::EpiCtx& c) const { const int e_lane = lane_id(), e_fr = e_lane & 15, e_fq = e_lane >> 4;
        const int pn = u.pn, hc = c.wc * 32 + e_fq * 8, rl0 = c.wr * 64 + e_fr;
        if (pn >= 8) {
            bf16_t* base = V + (size_t)(u.pm * 256 + rl0) * KVW + (pn - 8) * 256 + hc;
#pragma unroll
            for (int ai = 0; ai < 2; ++ai)
#pragma unroll
                for (int m = 0; m < 4; ++m) { bf16_t* rowp = base + (size_t)(ai * 128 + m * 16) * KVW;
#pragma unroll
                    for (int bj = 0; bj < 2; ++bj) { const f32x4 v0 = acc[ai][bj][m][0], v1 = acc[ai][bj][m][1];
                        *(u32x4*)(rowp + bj * 128) = (u32x4){cvtpk(v0.x, v0.y), cvtpk(v0.z, v0.w), cvtpk(v1.x, v1.y), cvtpk(v1.z, v1.w)}; } }
            return;
        }
        LAS float* part = (LAS float*)c.xl;
#pragma unroll
        for (int ai = 0; ai < 2; ++ai)
#pragma unroll
            for (int m = 0; m < 4; ++m)
#pragma unroll
                for (int bj = 0; bj < 2; ++bj) { const f32x4 v0 = acc[ai][bj][m][0], v1 = acc[ai][bj][m][1];
                    float s = (v0.x * v0.x + v0.y * v0.y) + (v0.z * v0.z + v0.w * v0.w) + (v1.x * v1.x + v1.y * v1.y) + (v1.z * v1.z + v1.w * v1.w);
                    s += __shfl_xor(s, 16); s += __shfl_xor(s, 32);
                    if (e_fq == 0) part[((ai * 128 + rl0 + m * 16) * 2 + bj) * 4 + c.wc] = s; }
        WG_BAR();
        const float* gain = pn < 6 ? qg : kg;
        const f32x4 g0 = *(const f32x4*)(gain + hc), g1 = *(const f32x4*)(gain + hc + 4);
        bf16_t* O = pn < 6 ? Q : K; const int ld = pn < 6 ? AW : KVW; const int colbase = (pn < 6 ? pn : pn - 6) * 256 + hc;
#pragma unroll
        for (int ai = 0; ai < 2; ++ai)
#pragma unroll
            for (int m = 0; m < 4; ++m) { const int rl = ai * 128 + rl0 + m * 16, row = u.pm * 256 + rl, sp = row & (SEQ - 1);
                const f32x4 cs = *(const f32x4*)(RC + sp * 64 + (hc >> 1)), sn = *(const f32x4*)(RS + sp * 64 + (hc >> 1));
#pragma unroll
                for (int bj = 0; bj < 2; ++bj) { const f32x4 p4 = *(const LAS f32x4*)(part + (rl * 2 + bj) * 4);
                    const float r = rsqrtf(((p4.x + p4.y) + (p4.z + p4.w)) * (1.0f / 128.0f) + EPS);
                    const f32x4 v0 = acc[ai][bj][m][0] * r * g0, v1 = acc[ai][bj][m][1] * r * g1;
                    u32x4 w; w.x = cvtpk(v0.x * cs.x - v0.y * sn.x, v0.x * sn.x + v0.y * cs.x); w.y = cvtpk(v0.z * cs.y - v0.w * sn.y, v0.z * sn.y + v0.w * cs.y);
                    w.z = cvtpk(v1.x * cs.z - v1.y * sn.z, v1.x * sn.z + v1.y * cs.z); w.w = cvtpk(v1.z * cs.w - v1.w * sn.w, v1.z * sn.w + v1.w * cs.w);
                    *(u32x4*)(O + (size_t)row * ld + colbase + bj * 128) = w; } }
    }
};


template <class AddrF> struct EpiStore {
    static constexpr bool PERM = true; AddrF f;
    __device__ __forceinline__ void operator()(f32x4 (&acc)[2][2][4][2], const pg8::Unit& u, const pg8::EpiCtx& c) const { const int e_lane = lane_id(), e_fr = e_lane & 15, e_fq = e_lane >> 4;
        const int hc = c.wc * 32 + e_fq * 8, rl0 = c.wr * 64 + e_fr;
#pragma unroll
        for (int ai = 0; ai < 2; ++ai)
#pragma unroll
            for (int m = 0; m < 4; ++m)
#pragma unroll
                for (int bj = 0; bj < 2; ++bj) { const f32x4 v0 = acc[ai][bj][m][0], v1 = acc[ai][bj][m][1];
                    *(u32x4*)f(u, ai * 128 + rl0 + m * 16, bj * 128 + hc) = (u32x4){cvtpk(v0.x, v0.y), cvtpk(v0.z, v0.w), cvtpk(v1.x, v1.y), cvtpk(v1.z, v1.w)}; }
    }
};
struct AddrF1 { bf16_t* FPQ; __device__ __forceinline__ bf16_t* operator()(const pg8::Unit& u, int rl, int tc) const {
    const int r = u.pm * 256 + rl, which = r >> 9, n = r & 511, cidx = u.pn * 256 + tc, b = cidx >> 11, s = cidx & 2047; return FPQ + (((size_t)(b * 512 + n) * 2 + which) * 2048 + s); } };
struct AddrF2 { bf16_t* MIX; __device__ __forceinline__ bf16_t* operator()(const pg8::Unit& u, int rl, int tc) const {
    const int row = (u.pn >> 1) * 2048 + u.pm * 256 + rl, col = AW + (u.pn & 1) * 256 + tc; return MIX + (size_t)row * DM + col; } };

struct EpiRes {
    static constexpr bool PERM = false;
    const float* base; float* out; bf16_t* xb; float* ssp; const float* cscale; int npn;
    __device__ __forceinline__ void operator()(f32x4 (&acc)[2][2][4][2], const pg8::Unit& u, const pg8::EpiCtx& c) const { const int e_lane = lane_id(), e_fr = e_lane & 15, e_fq = e_lane >> 4;
        const int col0 = u.pn * 256 + c.wc * 32 + 4 * e_fq, rl0 = c.wr * 64 + e_fr;
        LAS float* part = (LAS float*)c.xl;
#pragma unroll
        for (int ai = 0; ai < 2; ++ai)
#pragma unroll
            for (int m = 0; m < 4; ++m) { const int rl = ai * 128 + rl0 + m * 16; const size_t off = (size_t)(u.pm * 256 + rl) * DM + col0; float s = 0.f;
#pragma unroll
                for (int bj = 0; bj < 2; ++bj)
#pragma unroll
                    for (int n = 0; n < 2; ++n) { const size_t o2 = off + bj * 128 + n * 16; f32x4 v = acc[ai][bj][m][n];
                        if (cscale) v = v * *(const f32x4*)(cscale + col0 + bj * 128 + n * 16);
                        v = v + *(const f32x4*)(base + o2);
                        *(f32x4*)(out + o2) = v;
                        if (xb) { *(u32x2*)(xb + o2) = (u32x2){cvtpk(v.x, v.y), cvtpk(v.z, v.w)}; s += (v.x * v.x + v.y * v.y) + (v.z * v.z + v.w * v.w); } }
                if (xb) { s += __shfl_xor(s, 16); s += __shfl_xor(s, 32); if (e_fq == 0) part[rl * 4 + c.wc] = s; }
                asm volatile("" ::: "memory"); }
        if (xb) { WG_BAR();
            if (e_lane < 32) { const int row = c.wid * 32 + e_lane; const f32x4 p4 = *(const LAS f32x4*)(part + row * 4);
                ssp[(size_t)(u.pm * 256 + row) * npn + u.pn] = (p4.x + p4.y) + (p4.z + p4.w); }
            WG_BAR(); }
    }
};

namespace attn {
using s16x4 = __attribute__((ext_vector_type(4))) short;
using f32x16 = __attribute__((ext_vector_type(16))) float;
constexpr int D = 128, NW = 8, QBLK = 32, KVBLK = 64;
constexpr float SCALE = 0.088388347648318440f;
constexpr float THR = 0.f;
#ifndef ATT_SDEPTH
#define ATT_SDEPTH 1
#endif
constexpr int LDQ = AW, LDK = KVW, LDO = DM;
constexpr size_t SHM_V = KVBLK * D * 2, SHM_K = KVBLK * D * 2, SHM_ATTN = 2 * SHM_V + 2 * SHM_K + NW * 64 * 4;
#define KSWZ(row, colB) ((row) * 256 + ((colB) ^ (((row) & 7) << 4)))
#define SBAR() __builtin_amdgcn_sched_barrier(0)
__device__ __forceinline__ int crow(int r, int hi) { return (r & 3) + 8 * (r >> 2) + 4 * hi; }
__device__ __forceinline__ unsigned cvtpk_a(float lo, float hi) { unsigned r; asm volatile("v_cvt_pk_bf16_f32 %0, %1, %2" : "=v"(r) : "v"(lo), "v"(hi)); return r; }
__device__ __forceinline__ void partialSM(f32x16& p0, f32x16& p1, float& m_reg, float& mn, float& alpha) {
  constexpr float C = SCALE * 1.4426950408889634f;
  float pmax = p0[0]; for (int r = 1; r < 16; ++r) pmax = fmaxf(pmax, p0[r]); for (int r = 0; r < 16; ++r) pmax = fmaxf(pmax, p1[r]);
  { auto rr = __builtin_amdgcn_permlane32_swap(__float_as_uint(pmax), __float_as_uint(pmax), false, false);
    pmax = fmaxf(__uint_as_float(rr[0]), __uint_as_float(rr[1])); }
  if (__builtin_expect(__all(pmax - m_reg <= THR / SCALE), 1)) { mn = m_reg; alpha = 1.f; }
  else { mn = fmaxf(m_reg, pmax); alpha = __builtin_amdgcn_exp2f((m_reg - mn) * C); m_reg = mn; }
  float mnC = -mn * C;
  for (int r = 0; r < 16; ++r) p0[r] = fmaf(p0[r], C, mnC); for (int r = 0; r < 16; ++r) p1[r] = fmaf(p1[r], C, mnC);
  for (int r = 0; r < 16; ++r) p0[r] = __builtin_amdgcn_exp2f(p0[r]);
}
__device__ __forceinline__ void finishSM(f32x16& p0, f32x16& p1, float alpha, float& l_reg, bf16x8& pa0, bf16x8& pa1, bf16x8& pa2, bf16x8& pa3) {
  for (int r = 0; r < 16; ++r) p1[r] = __builtin_amdgcn_exp2f(p1[r]);
  float ps = 0; for (int r = 0; r < 16; ++r) ps += p0[r]; for (int r = 0; r < 16; ++r) ps += p1[r];
  { auto rr = __builtin_amdgcn_permlane32_swap(__float_as_uint(ps), __float_as_uint(ps), false, false);
    ps = __uint_as_float(rr[0]) + __uint_as_float(rr[1]); }
  l_reg = l_reg * alpha + ps;
#define PK4(P, BASE, OUT) do { unsigned a0 = cvtpk_a(P[BASE + 0], P[BASE + 1]), a1 = cvtpk_a(P[BASE + 2], P[BASE + 3]);   \
    unsigned b0 = cvtpk_a(P[BASE + 4], P[BASE + 5]), b1 = cvtpk_a(P[BASE + 6], P[BASE + 7]);                              \
    auto r0 = __builtin_amdgcn_permlane32_swap(a0, b0, false, false); auto r1 = __builtin_amdgcn_permlane32_swap(a1, b1, false, false); \
    u32x4 w = {r0[0], r1[0], r0[1], r1[1]}; OUT = *reinterpret_cast<bf16x8*>(&w); } while (0)
  PK4(p0, 0, pa0); PK4(p0, 8, pa1); PK4(p1, 0, pa2); PK4(p1, 8, pa3);
#undef PK4
}
__device__ __forceinline__ void qkt(f32x16& p0, f32x16& p1, const bf16_t* Ks, const bf16x8* qr, int r32, int hi) {
  p0 = f32x16{}; p1 = f32x16{};
  for (int d0 = 0; d0 < 8; ++d0) { int cb = (d0 * 16 + hi * 8) * 2;
    bf16x8 b0 = *reinterpret_cast<const bf16x8*>((const char*)Ks + KSWZ(r32, cb));
    bf16x8 b1 = *reinterpret_cast<const bf16x8*>((const char*)Ks + KSWZ(32 + r32, cb));
    p0 = __builtin_amdgcn_mfma_f32_32x32x16_bf16(b0, qr[d0], p0, 0, 0, 0);
    p1 = __builtin_amdgcn_mfma_f32_32x32x16_bf16(b1, qr[d0], p1, 0, 0, 0); }
}
__device__ __forceinline__ int v_st(int k, int c) { const int kk = (k & ~0xC) | ((k & 4) << 1) | ((k & 8) >> 1); return ((kk >> 3) * 4 + (c >> 5)) * 512 + ((kk & 7) * 32 + (c & 31)) * 2; }
__device__ __forceinline__ int v_rd_base(int lane) { return ((lane & 3) << 3) | (((lane >> 2) & 3) << 6) | (((lane >> 4) & 1) << 5) | (((lane >> 5) & 1) << 8); }
constexpr int v_rd_off(int d0, int ks, int half) { return d0 * 512 + ks * 4096 + half * 2048; }
template <int OFF> __device__ __forceinline__ s16x4 tr_read(int vb) {
  s16x4 r; asm volatile("ds_read_b64_tr_b16 %0, %1 offset:%2" : "=&v"(r) : "v"(vb), "i"(OFF) : "memory"); return r;
}
template <int D0> __device__ __forceinline__ void pv_one(f32x16& od, int vb, bf16x8 pa0, bf16x8 pa1, bf16x8 pa2, bf16x8 pa3) {
  const s16x4 l0 = tr_read<v_rd_off(D0, 0, 0)>(vb), h0 = tr_read<v_rd_off(D0, 0, 1)>(vb), l1 = tr_read<v_rd_off(D0, 1, 0)>(vb), h1 = tr_read<v_rd_off(D0, 1, 1)>(vb);
  const s16x4 l2 = tr_read<v_rd_off(D0, 2, 0)>(vb), h2 = tr_read<v_rd_off(D0, 2, 1)>(vb), l3 = tr_read<v_rd_off(D0, 3, 0)>(vb), h3 = tr_read<v_rd_off(D0, 3, 1)>(vb);
  asm volatile("s_waitcnt lgkmcnt(0)" ::: "memory"); SBAR();
#define PK(L, H) (bf16x8){L[0], L[1], L[2], L[3], H[0], H[1], H[2], H[3]}
  od = __builtin_amdgcn_mfma_f32_32x32x16_bf16(pa0, PK(l0, h0), od, 0, 0, 0);
  od = __builtin_amdgcn_mfma_f32_32x32x16_bf16(pa1, PK(l1, h1), od, 0, 0, 0);
  od = __builtin_amdgcn_mfma_f32_32x32x16_bf16(pa2, PK(l2, h2), od, 0, 0, 0);
  od = __builtin_amdgcn_mfma_f32_32x32x16_bf16(pa3, PK(l3, h3), od, 0, 0, 0);
#undef PK
}
__device__ __forceinline__ void pv_d0(f32x16* o, int vb, bf16x8 pa0, bf16x8 pa1, bf16x8 pa2, bf16x8 pa3) {
  pv_one<0>(o[0], vb, pa0, pa1, pa2, pa3); pv_one<1>(o[1], vb, pa0, pa1, pa2, pa3); pv_one<2>(o[2], vb, pa0, pa1, pa2, pa3); pv_one<3>(o[3], vb, pa0, pa1, pa2, pa3);
}
__device__ __forceinline__ void attn_dense_body(const bf16_t* __restrict__ Qb, const bf16_t* __restrict__ Kh, const bf16_t* __restrict__ Vh,
                                                bf16_t* __restrict__ Ob, int seq, char* lds, const int wave_) {
  constexpr int SDEPTH = ATT_SDEPTH;
  const int lane = lane_id(), wid = wave_, tid = wid * 64 + lane, r32 = lane & 31, hi = lane >> 5;
  bf16_t* V_lds = (bf16_t*)lds; bf16_t* K_lds = (bf16_t*)(lds + 2 * SHM_V);
  float* ws = (float*)(lds + 2 * SHM_V + 2 * SHM_K) + wid * 64; float* li_l = ws; float* al_l = ws + 32;
  float m_reg = -1e30f, l_reg = 0; f32x16 o[4] = {}; bf16x8 qr[8];
  const bf16_t* Qw = Qb + (long)(wid * QBLK + r32) * LDQ + hi * 8;
#pragma unroll
  for (int d0 = 0; d0 < 8; ++d0) qr[d0] = *reinterpret_cast<const bf16x8*>(Qw + d0 * 16);
  const int sr = tid >> 4, sc = (tid & 15) * 8, vst0 = v_st(sr, sc), vst1 = v_st(32 + sr, sc);
  const int vb0 = (int)(uintptr_t)V_lds + v_rd_base(lane);
  struct { bf16x8 vs0, vs1, ks0, ks1; } sr_[SDEPTH];
#define SLOAD(i, k0) do { sr_[i].vs0 = *reinterpret_cast<const bf16x8*>(&Vh[(long)((k0) + sr) * LDK + sc]); sr_[i].vs1 = *reinterpret_cast<const bf16x8*>(&Vh[(long)((k0) + 32 + sr) * LDK + sc]); \
    sr_[i].ks0 = *reinterpret_cast<const bf16x8*>(&Kh[(long)((k0) + sr) * LDK + sc]); sr_[i].ks1 = *reinterpret_cast<const bf16x8*>(&Kh[(long)((k0) + 32 + sr) * LDK + sc]); } while (0)
#define SWRITE(b, i) do { *(bf16x8*)((char*)V_lds + (b) * SHM_V + vst0) = sr_[i].vs0;          \
    *(bf16x8*)((char*)V_lds + (b) * SHM_V + vst1) = sr_[i].vs1; int kc = sc * 2;               \
    *(bf16x8*)((char*)K_lds + (b) * SHM_K + KSWZ(sr, kc)) = sr_[i].ks0;                       \
    *(bf16x8*)((char*)K_lds + (b) * SHM_K + KSWZ(32 + sr, kc)) = sr_[i].ks1; } while (0)
#define SWAIT() do { if constexpr (SDEPTH == 2) asm volatile("s_waitcnt vmcnt(4)" ::: "memory"); else asm volatile("s_waitcnt vmcnt(0)" ::: "memory"); } while (0)
#define RESC(a) do { if (__any((a) < 1.f)) { if (hi == 0) al_l[r32] = (a); asm volatile("s_waitcnt lgkmcnt(0)" ::: "memory"); \
    for (int d = 0; d < 4; ++d) for (int r = 0; r < 16; ++r) o[d][r] *= al_l[crow(r, hi)]; } } while (0)
  f32x16 pA0, pA1, pB0, pB1; float mnA, mnB, alA, alB; bf16x8 pa0, pa1, pa2, pa3; const int NT = seq / KVBLK;
  constexpr int SE = 0, SO = SDEPTH - 1;
  SLOAD(SE, 0); asm volatile("s_waitcnt vmcnt(0)" ::: "memory"); SWRITE(0, SE); __syncthreads();
  qkt(pA0, pA1, K_lds, qr, r32, hi); partialSM(pA0, pA1, m_reg, mnA, alA);
  SLOAD(SO, KVBLK); if constexpr (SDEPTH == 2) { if (2 < NT) SLOAD(SE, 2 * KVBLK); }
  SWAIT(); SWRITE(1, SO); __syncthreads();
  for (int j = 1; j + 1 < NT; j += 2) {
    SBAR(); qkt(pB0, pB1, (bf16_t*)((char*)K_lds + SHM_K), qr, r32, hi);
    finishSM(pA0, pA1, alA, l_reg, pa0, pa1, pa2, pa3); SBAR();
    SLOAD(SO, (j + SDEPTH) * KVBLK); SBAR();
    pv_d0(o, vb0, pa0, pa1, pa2, pa3); partialSM(pB0, pB1, m_reg, mnB, alB);
    __syncthreads(); SWAIT(); SWRITE(0, SE);
    RESC(alB); __syncthreads();
    SBAR(); qkt(pA0, pA1, K_lds, qr, r32, hi);
    finishSM(pB0, pB1, alB, l_reg, pa0, pa1, pa2, pa3); SBAR();
    if (SDEPTH == 1 || j + 3 < NT) SLOAD(SE, (j + 1 + SDEPTH) * KVBLK); SBAR();
    pv_d0(o, vb0 + (int)SHM_V, pa0, pa1, pa2, pa3); partialSM(pA0, pA1, m_reg, mnA, alA);
    __syncthreads(); SWAIT(); SWRITE(1, SO);
    RESC(alA); __syncthreads();
  }
  SBAR(); qkt(pB0, pB1, (bf16_t*)((char*)K_lds + SHM_K), qr, r32, hi);
  finishSM(pA0, pA1, alA, l_reg, pa0, pa1, pa2, pa3); SBAR();
  pv_d0(o, vb0, pa0, pa1, pa2, pa3); partialSM(pB0, pB1, m_reg, mnB, alB);
  __syncthreads(); RESC(alB);
  finishSM(pB0, pB1, alB, l_reg, pa0, pa1, pa2, pa3); SBAR();
  pv_d0(o, vb0 + (int)SHM_V, pa0, pa1, pa2, pa3);
  if (hi == 0) li_l[r32] = l_reg; asm volatile("s_waitcnt lgkmcnt(0)" ::: "memory");
  float rli[16];
#pragma unroll
  for (int r = 0; r < 16; ++r) rli[r] = __builtin_amdgcn_rcpf(li_l[crow(r, hi)]);
  bf16_t* Ow = Ob + (long)(wid * QBLK) * LDO;
#pragma unroll
  for (int r = 0; r < 16; ++r) { int orow = crow(r, hi);
    for (int d0 = 0; d0 < 4; ++d0) Ow[(long)orow * LDO + d0 * 32 + r32] = (bf16_t)(cvtpk(o[d0][r] * rli[r], 0.f) & 0xffffu); }
#undef SLOAD
#undef SWRITE
#undef SWAIT
#undef RESC
  __syncthreads();
}
#undef KSWZ
#undef SBAR
}

struct AddrLin { bf16_t* O; int ld; __device__ __forceinline__ bf16_t* operator()(const pg8::Unit& u, int rl, int tc) const { return O + (size_t)(u.pm * 256 + rl) * ld + u.pn * 256 + tc; } };
struct EpiRowScale {
    static constexpr bool PERM = true; bf16_t* O; int ld; const float* ssp; float cscale;
    __device__ __forceinline__ void operator()(f32x4 (&acc)[2][2][4][2], const pg8::Unit& u, const pg8::EpiCtx& c) const { const int e_lane = lane_id(), e_fr = e_lane & 15, e_fq = e_lane >> 4;
        const int hc = c.wc * 32 + e_fq * 8, rl0 = c.wr * 64 + e_fr;
#pragma unroll
        for (int ai = 0; ai < 2; ++ai)
#pragma unroll
            for (int m = 0; m < 4; ++m) { const int row = u.pm * 256 + ai * 128 + rl0 + m * 16; const f32x4 p0 = *(const f32x4*)(ssp + (size_t)row * 8), p1 = *(const f32x4*)(ssp + (size_t)row * 8 + 4);
                const float r = rsqrtf((((p0.x + p0.y) + (p0.z + p0.w)) + ((p1.x + p1.y) + (p1.z + p1.w))) * (1.0f / DM) + EPS) * cscale;
#pragma unroll
                for (int bj = 0; bj < 2; ++bj) { const f32x4 v0 = acc[ai][bj][m][0] * r, v1 = acc[ai][bj][m][1] * r;
                    *(u32x4*)(O + (size_t)row * ld + u.pn * 256 + bj * 128 + hc) = (u32x4){cvtpk(v0.x, v0.y), cvtpk(v0.z, v0.w), cvtpk(v1.x, v1.y), cvtpk(v1.z, v1.w)}; } }
    }
};
struct EpiSoftmax {
    static constexpr bool PERM = true; bf16_t* P; int ld;
    __device__ __forceinline__ void operator()(f32x4 (&acc)[2][2][4][2], const pg8::Unit& u, const pg8::EpiCtx& c) const { const int e_lane = lane_id(), e_fr = e_lane & 15, e_fq = e_lane >> 4;
        const int hc = c.wc * 32 + e_fq * 8, rl0 = c.wr * 64 + e_fr;
        LAS float* pmx = (LAS float*)c.xl; LAS float* psm = pmx + 1024;
#pragma unroll
        for (int ai = 0; ai < 2; ++ai)
#pragma unroll
            for (int m = 0; m < 4; ++m) { float mx = -3.0e38f;
#pragma unroll
                for (int bj = 0; bj < 2; ++bj)
#pragma unroll
                    for (int n = 0; n < 2; ++n) { const f32x4 v = acc[ai][bj][m][n]; mx = fmaxf(fmaxf(mx, fmaxf(v.x, v.y)), fmaxf(v.z, v.w)); }
                mx = fmaxf(mx, __shfl_xor(mx, 16)); mx = fmaxf(mx, __shfl_xor(mx, 32));
                if (e_fq == 0) pmx[(ai * 128 + rl0 + m * 16) * 4 + c.wc] = mx; }
        WG_BAR();
#pragma unroll
        for (int ai = 0; ai < 2; ++ai)
#pragma unroll
            for (int m = 0; m < 4; ++m) { const int rl = ai * 128 + rl0 + m * 16; const f32x4 p4 = *(const LAS f32x4*)(pmx + rl * 4);
                const float mx = fmaxf(fmaxf(p4.x, p4.y), fmaxf(p4.z, p4.w)) * 1.4426950408889634f; float s = 0.f;
#pragma unroll
                for (int bj = 0; bj < 2; ++bj)
#pragma unroll
                    for (int n = 0; n < 2; ++n) { f32x4 v = acc[ai][bj][m][n];
                        v.x = __builtin_amdgcn_exp2f(fmaf(v.x, 1.4426950408889634f, -mx)); v.y = __builtin_amdgcn_exp2f(fmaf(v.y, 1.4426950408889634f, -mx));
                        v.z = __builtin_amdgcn_exp2f(fmaf(v.z, 1.4426950408889634f, -mx)); v.w = __builtin_amdgcn_exp2f(fmaf(v.w, 1.4426950408889634f, -mx));
                        s += (v.x + v.y) + (v.z + v.w); acc[ai][bj][m][n] = v; }
                s += __shfl_xor(s, 16); s += __shfl_xor(s, 32);
                if (e_fq == 0) psm[rl * 4 + c.wc] = s; }
        WG_BAR();
#pragma unroll
        for (int ai = 0; ai < 2; ++ai)
#pragma unroll
            for (int m = 0; m < 4; ++m) { const int rl = ai * 128 + rl0 + m * 16; const f32x4 p4 = *(const LAS f32x4*)(psm + rl * 4);
                const float inv = 1.0f / ((p4.x + p4.y) + (p4.z + p4.w));
#pragma unroll
                for (int bj = 0; bj < 2; ++bj) { const f32x4 v0 = acc[ai][bj][m][0] * inv, v1 = acc[ai][bj][m][1] * inv;
                    *(u32x4*)(P + (size_t)(u.pm * 256 + rl) * ld + u.pn * 256 + bj * 128 + hc) = (u32x4){cvtpk(v0.x, v0.y), cvtpk(v0.z, v0.w), cvtpk(v1.x, v1.y), cvtpk(v1.z, v1.w)}; } }
        WG_BAR();
    }
};
struct MapXS { const char* Q; const char* K; __device__ __forceinline__ void operator()(pg8::Unit& u) const {
    u.a = Q + ((size_t)u.pm * 256 * DM + (size_t)u.pn * MHD) * 2; u.b = K + ((size_t)(u.pm >> 3) * MEML * DM + (size_t)u.pn * MHD) * 2; } };
struct MapXPV { const char* P; const char* VT; __device__ __forceinline__ void operator()(pg8::Unit& u) const {
    u.a = P + ((size_t)u.pm * 256 * 1024 + (size_t)(u.pn >> 1) * MEML) * 2; u.b = VT + ((size_t)u.pn * 256 * 1024 + (size_t)(u.pm >> 3) * MEML) * 2; } };

struct MapMoE { const char* A; const char* W; size_t as, es, ws_; __device__ __forceinline__ void operator()(pg8::Unit& u) const {
    u.a = A + (size_t)u.pm * as; u.b = W + (size_t)(u.pm >> 2) * es + (size_t)u.pn * ws_; } };
struct EpiSwiGLU {
    static constexpr bool PERM = true; bf16_t* ACT;
    __device__ __forceinline__ void operator()(f32x4 (&acc)[2][2][4][2], const pg8::Unit& u, const pg8::EpiCtx& c) const { const int e_lane = lane_id(), e_fr = e_lane & 15, e_fq = e_lane >> 4;
        const int hc = c.wc * 32 + e_fq * 8, rl0 = c.wr * 64 + e_fr;
#pragma unroll
        for (int ai = 0; ai < 2; ++ai)
#pragma unroll
            for (int m = 0; m < 4; ++m) { f32x4 o[2];
#pragma unroll
                for (int n = 0; n < 2; ++n) { const f32x4 g = acc[ai][0][m][n], up = acc[ai][1][m][n]; f32x4 r;
                    r.x = g.x * __builtin_amdgcn_rcpf(1.0f + __builtin_amdgcn_exp2f(-1.4426950408889634f * g.x)) * up.x; r.y = g.y * __builtin_amdgcn_rcpf(1.0f + __builtin_amdgcn_exp2f(-1.4426950408889634f * g.y)) * up.y;
                    r.z = g.z * __builtin_amdgcn_rcpf(1.0f + __builtin_amdgcn_exp2f(-1.4426950408889634f * g.z)) * up.z; r.w = g.w * __builtin_amdgcn_rcpf(1.0f + __builtin_amdgcn_exp2f(-1.4426950408889634f * g.w)) * up.w; o[n] = r; }
                *(u32x4*)(ACT + (size_t)(u.pm * 256 + ai * 128 + rl0 + m * 16) * EFF + u.pn * 128 + hc) = (u32x4){cvtpk(o[0].x, o[0].y), cvtpk(o[0].z, o[0].w), cvtpk(o[1].x, o[1].y), cvtpk(o[1].z, o[1].w)}; }
    }
};
struct EpiRowGate {
    static constexpr bool PERM = true; bf16_t* Y; const float* gate;
    __device__ __forceinline__ void operator()(f32x4 (&acc)[2][2][4][2], const pg8::Unit& u, const pg8::EpiCtx& c) const { const int e_lane = lane_id(), e_fr = e_lane & 15, e_fq = e_lane >> 4;
        const int hc = c.wc * 32 + e_fq * 8, rl0 = c.wr * 64 + e_fr;
#pragma unroll
        for (int ai = 0; ai < 2; ++ai)
#pragma unroll
            for (int m = 0; m < 4; ++m) { const int row = u.pm * 256 + ai * 128 + rl0 + m * 16; const float gt = gate[row];
#pragma unroll
                for (int bj = 0; bj < 2; ++bj) { const f32x4 v0 = acc[ai][bj][m][0] * gt, v1 = acc[ai][bj][m][1] * gt;
                    *(u32x4*)(Y + (size_t)row * DM + u.pn * 256 + bj * 128 + hc) = (u32x4){cvtpk(v0.x, v0.y), cvtpk(v0.z, v0.w), cvtpk(v1.x, v1.y), cvtpk(v1.z, v1.w)}; } }
    }
};
__device__ __forceinline__ float rms_row_to_bf16_r(const float* xrow, const float* __restrict__ gain, bf16_t* orow, int lane) {
    const GAS f32x4* xr = (const GAS f32x4*)xrow + lane; const f32x4* gr = (const f32x4*)gain + lane;
    f32x4 v[8]; float s = 0.f;
#pragma unroll
    for (int j = 0; j < 8; ++j) { v[j] = xr[64 * j]; s += (v[j].x * v[j].x + v[j].y * v[j].y) + (v[j].z * v[j].z + v[j].w * v[j].w); }
    const float r = rsqrtf(wave_sum(s) * (1.f / DM) + EPS);
    GAS u32x2* o8 = (GAS u32x2*)orow + lane;
#pragma unroll
    for (int j = 0; j < 8; ++j) { const f32x4 g = gr[64 * j]; u32x2 w; w.x = cvtpk(v[j].x * r * g.x, v[j].y * r * g.y); w.y = cvtpk(v[j].z * r * g.z, v[j].w * r * g.w); o8[64 * j] = w; }
    return r;
}
__device__ __forceinline__ void router_phase(const Frame& F, const float* x, const float* __restrict__ gain, const float* __restrict__ Wr, bf16_t* HNo, float* aff) {
    const int lane = lane_id(), tid = F.wave * 64 + lane;
    LAS f32x4* Wl = (LAS f32x4*)(F.lds + RING_OFF);
    for (int i = tid; i < DM * 4; i += 512) { const int kk = i >> 2, q = i & 3; Wl[q * DM + (kk & 3) * 512 + (kk >> 2)] = *(const f32x4*)(Wr + (size_t)kk * NE + 4 * q); }
    __syncthreads();
    const int gw = (int)blockIdx.x * NWAVES + F.wave, NGW = F.G * NWAVES;
    const f32x4* gr = (const f32x4*)gain + lane;
    for (int rb = gw * 2; rb < NTOK; rb += NGW * 2) {
        f32x4 v0[8], v1[8]; float s0 = 0.f, s1 = 0.f;
        const GAS f32x4* x0 = (const GAS f32x4*)(x + (size_t)rb * DM) + lane; const GAS f32x4* x1 = x0 + DM / 4;
#pragma unroll
        for (int j = 0; j < 8; ++j) { v0[j] = x0[64 * j]; v1[j] = x1[64 * j]; }
#pragma unroll
        for (int j = 0; j < 8; ++j) { s0 += (v0[j].x * v0[j].x + v0[j].y * v0[j].y) + (v0[j].z * v0[j].z + v0[j].w * v0[j].w); s1 += (v1[j].x * v1[j].x + v1[j].y * v1[j].y) + (v1[j].z * v1[j].z + v1[j].w * v1[j].w); }
        const float r0 = rsqrtf(wave_sum(s0) * (1.f / DM) + EPS), r1 = rsqrtf(wave_sum(s1) * (1.f / DM) + EPS);
        GAS u32x2* o0 = (GAS u32x2*)(HNo + (size_t)rb * DM) + lane; GAS u32x2* o1 = o0 + DM / 4;
        float a[32];
#pragma unroll
        for (int i = 0; i < 32; ++i) a[i] = 0.f;
#pragma unroll
        for (int j = 0; j < 8; ++j) { const f32x4 g = gr[64 * j];
            v0[j] = (f32x4){v0[j].x * r0 * g.x, v0[j].y * r0 * g.y, v0[j].z * r0 * g.z, v0[j].w * r0 * g.w}; v1[j] = (f32x4){v1[j].x * r1 * g.x, v1[j].y * r1 * g.y, v1[j].z * r1 * g.z, v1[j].w * r1 * g.w};
            o0[64 * j] = (u32x2){cvtpk(v0[j].x, v0[j].y), cvtpk(v0[j].z, v0[j].w)}; o1[64 * j] = (u32x2){cvtpk(v1[j].x, v1[j].y), cvtpk(v1[j].z, v1[j].w)};
            const float h0[4] = {v0[j].x, v0[j].y, v0[j].z, v0[j].w}, h1[4] = {v1[j].x, v1[j].y, v1[j].z, v1[j].w};
#pragma unroll
            for (int c = 0; c < 4; ++c)
#pragma unroll
                for (int q = 0; q < 4; ++q) { const f32x4 w = Wl[q * DM + c * 512 + lane + 64 * j];
                    a[4 * q + 0] += h0[c] * w.x; a[4 * q + 1] += h0[c] * w.y; a[4 * q + 2] += h0[c] * w.z; a[4 * q + 3] += h0[c] * w.w;
                    a[16 + 4 * q + 0] += h1[c] * w.x; a[16 + 4 * q + 1] += h1[c] * w.y; a[16 + 4 * q + 2] += h1[c] * w.z; a[16 + 4 * q + 3] += h1[c] * w.w; } }
#define RS_STEP(N, MASK) { const bool up_ = (lane & MASK) != 0; _Pragma("unroll") for (int i = 0; i < N; ++i) { const float keep = up_ ? a[i + N] : a[i], send = up_ ? a[i] : a[i + N]; a[i] = keep + __shfl_xor(send, MASK); } }
        RS_STEP(16, 32) RS_STEP(8, 16) RS_STEP(4, 8) RS_STEP(2, 4) RS_STEP(1, 2)
#undef RS_STEP
        const float lg = a[0] + __shfl_xor(a[0], 1); float mx = lg;
        mx = fmaxf(mx, __shfl_xor(mx, 16)); mx = fmaxf(mx, __shfl_xor(mx, 8)); mx = fmaxf(mx, __shfl_xor(mx, 4)); mx = fmaxf(mx, __shfl_xor(mx, 2));
        const float ex = expf(lg - mx); float sm = ex;
        sm += __shfl_xor(sm, 16); sm += __shfl_xor(sm, 8); sm += __shfl_xor(sm, 4); sm += __shfl_xor(sm, 2);
        const int el = lane >> 1, row = rb + (el >> 4), e = el & 15, b = row / SEQ, t = row % SEQ;
        if ((lane & 1) == 0) aff[((size_t)b * NE + e) * SEQ + t] = ex / sm;
    }
    __syncthreads();
}
__device__ __forceinline__ void rank_phase(const Frame& F, const float* aff, int* rank, float* gate, const bf16_t* HNi, bf16_t* XS) {
    const int lane = lane_id(), tid = F.wave * 64 + lane;
    LAS float* a = (LAS float*)(F.lds + RING_OFF);
    LAS int* list = (LAS int*)(F.lds + RING_OFF + 8192);
    LAS int* cntp = (LAS int*)(F.lds + RING_OFF + 8192 + 1024);
    for (int it = (int)blockIdx.x; it < NB * NE * 8; it += F.G) {
        const int be = it >> 3, chunk = it & 7, b = be >> 4, e = be & 15;
        for (int i = tid; i < SEQ / 4; i += 512) ((LAS f32x4*)a)[i] = *(const f32x4*)(aff + (size_t)be * SEQ + 4 * i);
        if (tid == 0) cntp[0] = 0;
        __syncthreads();
        const int tl = tid >> 1, half = tid & 1, t = chunk * 256 + tl; const float v = a[t]; int cnt = 0;
        const int jb = half * 256, je = jb + 256, tq = t >> 2;
        const int e1 = tq < je ? (tq > jb ? tq : jb) : je;
        for (int j4 = jb; j4 < e1; ++j4) { const f32x4 w = ((LAS f32x4*)a)[j4]; cnt += (w.x >= v) + (w.y >= v) + (w.z >= v) + (w.w >= v); }
        if (tq >= jb && tq < je) { const f32x4 w = ((LAS f32x4*)a)[tq]; const int j = 4 * tq;
            cnt += (w.x > v || (w.x == v && j < t)) + (w.y > v || (w.y == v && j + 1 < t)) + (w.z > v || (w.z == v && j + 2 < t)) + (w.w > v || (w.w == v && j + 3 < t)); }
        const int b2 = tq >= jb ? (tq + 1 < je ? tq + 1 : je) : jb;
        for (int j4 = b2; j4 < je; ++j4) { const f32x4 w = ((LAS f32x4*)a)[j4]; cnt += (w.x > v) + (w.y > v) + (w.z > v) + (w.w > v); }
        cnt += __shfl_xor(cnt, 1);
        if (half == 0) { rank[(size_t)be * SEQ + t] = cnt;
            if (cnt < CAP) { gate[(e * 4 + b) * CAP + cnt] = v; const int slot = atomicAdd((int*)cntp, 1); list[slot] = (t << 16) | cnt; } }
        __syncthreads();
        const int n = cntp[0];
        for (int l0 = F.wave; l0 < n; l0 += 4 * NWAVES) {
            u32x4 cv[4][4]; u32x4* dstp[4];
#pragma unroll
            for (int q = 0; q < 4; ++q) { const int li = l0 + q * NWAVES; const int pk = list[li < n ? li : l0], tt = pk >> 16, rk = pk & 0xffff;
                const u32x4* src = (const u32x4*)(HNi + ((size_t)b * SEQ + tt) * DM); dstp[q] = (u32x4*)(XS + ((size_t)(e * 4 + b) * CAP + rk) * DM);
#pragma unroll
                for (int j = 0; j < 4; ++j) cv[q][j] = src[lane + 64 * j]; }
#pragma unroll
            for (int q = 0; q < 4; ++q) if (l0 + q * NWAVES < n) {
#pragma unroll
                for (int j = 0; j < 4; ++j) dstp[q][lane + 64 * j] = cv[q][j]; }
        }
        __syncthreads();
    }
}
__device__ __forceinline__ void combine_phase(const Frame& F, const float* xin, float* x, const bf16_t* Y, const int* rank, const float* __restrict__ gain, bf16_t* HNo, bool final_) {
    const int lane = lane_id();
    const int gw = (int)blockIdx.x * NWAVES + F.wave, NGW = F.G * NWAVES;
    for (int row = gw; row < NTOK; row += NGW) {
        const int b = row / SEQ, t = row % SEQ;
        int rk = CAP; if (lane < NE) rk = rank[((size_t)b * NE + lane) * SEQ + t];
        GAS f32x4* xr = (GAS f32x4*)(x + (size_t)row * DM) + lane; const GAS f32x4* xi = (const GAS f32x4*)(xin + (size_t)row * DM) + lane; f32x4 v[8];
#pragma unroll
        for (int j = 0; j < 8; ++j) v[j] = xi[64 * j];
#pragma unroll
        for (int e = 0; e < NE; ++e) { const int r = __builtin_amdgcn_readlane(rk, e);
            if (r < CAP) { const u32x2* yr = (const u32x2*)(Y + ((size_t)(e * 4 + b) * CAP + r) * DM) + lane;
#pragma unroll
                for (int j = 0; j < 8; ++j) { const u32x2 w = yr[64 * j]; v[j].x += __uint_as_float(w.x << 16); v[j].y += __uint_as_float(w.x & 0xffff0000u); v[j].z += __uint_as_float(w.y << 16); v[j].w += __uint_as_float(w.y & 0xffff0000u); } } }
        float s = 0.f;
#pragma unroll
        for (int j = 0; j < 8; ++j) s += (v[j].x * v[j].x + v[j].y * v[j].y) + (v[j].z * v[j].z + v[j].w * v[j].w);
        const float r = rsqrtf(wave_sum(s) * (1.f / DM) + EPS); const f32x4* gr = (const f32x4*)gain + lane;
        if (final_) {
#pragma unroll
            for (int j = 0; j < 8; ++j) { const f32x4 g = gr[64 * j]; xr[64 * j] = (f32x4){v[j].x * r * g.x, v[j].y * r * g.y, v[j].z * r * g.z, v[j].w * r * g.w}; }
        } else { GAS u32x2* o8 = (GAS u32x2*)(HNo + (size_t)row * DM) + lane;
#pragma unroll
            for (int j = 0; j < 8; ++j) { const f32x4 g = gr[64 * j]; xr[64 * j] = v[j]; o8[64 * j] = (u32x2){cvtpk(v[j].x * r * g.x, v[j].y * r * g.y), cvtpk(v[j].z * r * g.z, v[j].w * r * g.w)}; } }
    }
}

struct MapPool { const char* A; const char* W; __device__ __forceinline__ void operator()(pg8::Unit& u) const {
    u.a = A + ((size_t)u.pm * 256 * DM + (size_t)(u.pn >> 1) * 512) * 2; u.b = W + ((size_t)(u.pn & 1) * 256 * DM + (size_t)(u.pn >> 1) * 512) * 2; } };
template <int W> __device__ __forceinline__ void pool_item(const bf16_t* H, bf16_t* P, int row, int c8) {
    const int t = row & (SEQ - 1); const bf16_t* base = H + (size_t)(row - t) * DM + c8 * 8;
    u32x4 v[W];
#pragma unroll
    for (int i = 0; i < W; ++i) { int j = t - W / 2 + i; j = j < 0 ? 0 : (j > SEQ - 1 ? SEQ - 1 : j); v[i] = *(const u32x4*)(base + (size_t)j * DM); }
    float s[8] = {0.f, 0.f, 0.f, 0.f, 0.f, 0.f, 0.f, 0.f};
#pragma unroll
    for (int i = 0; i < W; ++i) { const int j = t - W / 2 + i; const float m = (j >= 0 && j < SEQ) ? 1.f : 0.f;
        s[0] += m * __uint_as_float(v[i].x << 16); s[1] += m * __uint_as_float(v[i].x & 0xffff0000u); s[2] += m * __uint_as_float(v[i].y << 16); s[3] += m * __uint_as_float(v[i].y & 0xffff0000u);
        s[4] += m * __uint_as_float(v[i].z << 16); s[5] += m * __uint_as_float(v[i].z & 0xffff0000u); s[6] += m * __uint_as_float(v[i].w << 16); s[7] += m * __uint_as_float(v[i].w & 0xffff0000u); }
    int lo = t - W / 2, hi = t + W / 2; if (lo < 0) lo = 0; if (hi > SEQ) hi = SEQ;
    const float inv = 1.0f / (float)(hi - lo); const u32x4 sv = v[W / 2];
    const float e0 = __uint_as_float(sv.x << 16), e1 = __uint_as_float(sv.x & 0xffff0000u), e2 = __uint_as_float(sv.y << 16), e3 = __uint_as_float(sv.y & 0xffff0000u);
    const float e4 = __uint_as_float(sv.z << 16), e5 = __uint_as_float(sv.z & 0xffff0000u), e6 = __uint_as_float(sv.w << 16), e7 = __uint_as_float(sv.w & 0xffff0000u);
    *(u32x4*)(P + (size_t)row * DM + c8 * 8) = (u32x4){cvtpk(s[0] * inv - e0, s[1] * inv - e1), cvtpk(s[2] * inv - e2, s[3] * inv - e3), cvtpk(s[4] * inv - e4, s[5] * inv - e5), cvtpk(s[6] * inv - e6, s[7] * inv - e7)};
}
__device__ __forceinline__ void pool_phase(const Frame& F, const bf16_t* H, bf16_t* P) {
    const int lane = lane_id(); const int gwv = (int)blockIdx.x * NWAVES + F.wave, NWV = F.G * NWAVES;
    for (int wi = gwv; wi < NTOK * 4; wi += NWV) {
        const int row = wi >> 2, g = wi & 3, c8 = g * 64 + lane;
        if (g == 0) pool_item<2>(H, P, row, c8); else if (g == 1) pool_item<4>(H, P, row, c8); else if (g == 2) pool_item<8>(H, P, row, c8); else pool_item<16>(H, P, row, c8);
    }
}

constexpr int N_PHASES = 24;
#ifndef MK_N_LAUNCHES
#define MK_N_LAUNCHES 1
#endif
#ifndef REP_MASK
#define REP_MASK 0
#endif
__global__ void __launch_bounds__(NWAVES * 64, 2) skel_fwd(Args args) {
    extern __shared__ __attribute__((aligned(16))) unsigned char lds_raw[];
    Frame F;
    F.lds = (LAS unsigned char*)lds_raw; F.MISC = (volatile LAS unsigned*)(F.lds + MISC_OFF);
    F.wave = __builtin_amdgcn_readfirstlane(threadIdx.x >> 6);
    F.G = gridDim.x; { const int bx = blockIdx.x; F.vcu = (F.G % 8 == 0) ? (bx % 8) * (F.G / 8) + bx / 8 : bx; }
    F.ws = nullptr; F.ctl = (gu32*)(uptr(args.ws) + WS_CTL);
    for (int u = threadIdx.x; u < (LDS_BYTES - LDSCTL_OFF) / 4; u += NWAVES * 64) ((LAS unsigned*)(F.lds + LDSCTL_OFF))[u] = 0u;
    __syncthreads();
    const bool multi = (MK_N_LAUNCHES == 1) || (args.ph_hi - args.ph_lo) > 1 || REP_MASK != 0;
    XcdBarrier bar; bar.bar = (unsigned*)(F.ctl + CW_BAR); bar.x = 0; bar.st = nullptr; bar.wave = F.wave;
    if (multi) bar = xcd_barrier_post((unsigned*)(F.ctl + CW_BAR), F.MISC + 8, F.wave);
    const int lo = args.ph_lo, hi = args.ph_hi;
#define IN(k) ((MK_N_LAUNCHES == 1) ? ((k) < N_PHASES) : (lo <= (k) && (k) < hi))
#define PHASE(k) for (int rep_ = 0; rep_ < 1 + (int)((((unsigned)REP_MASK) >> (k)) & 1u); ++rep_)
#define SEAM(k) do { if ((IN(k) && IN((k) + 1)) || rep_ + 1 < 1 + (int)((((unsigned)REP_MASK) >> (k)) & 1u)) xcd_barrier(bar); } while (0)
    LAS unsigned char* ring = F.lds + RING_OFF; LAS unsigned char* xl = F.lds + XL_OFF;
    const int bx = (int)blockIdx.x, G = F.G;

#define KV_PROJ(l, rotK, rotV) do {   \
            { MapLin mp{(const char*)(ws + WS_MEMNB + (size_t)(l) * NB * MEML * DM * 2), (const char*)(ws + WS_WCK_T + (size_t)(l) * DM * DM * 2), (size_t)256 * DM * 2, (size_t)256 * DM * 2}; \
              pg8::Sched<MapLin> S; S.init(NB * MEML / 256, DM / 256, G, (bx + G - ((rotK) % G)) % G, mp); \
              EpiStore<AddrLin> E{AddrLin{(bf16_t*)(ws + WS_KCB + (size_t)(l) * NB * MEML * DM * 2), DM}}; \
              pg8::gemm_phase<EpiStore<AddrLin>, pg8::Sched<MapLin>, true>(F.wave, ring, xl, DM, DM * 2, DM * 2, S, E); } \
            { MapLin mp{(const char*)(ws + WS_WCV_T + (size_t)(l) * DM * DM * 2), (const char*)(ws + WS_MEMNB + (size_t)(l) * NB * MEML * DM * 2), (size_t)256 * DM * 2, (size_t)256 * DM * 2}; \
              pg8::Sched<MapLin> S; S.init(DM / 256, NB * MEML / 256, G, (bx + G - ((rotV) % G)) % G, mp); \
              EpiStore<AddrLin> E{AddrLin{(bf16_t*)(ws + WS_VTB + (size_t)(l) * NB * MEML * DM * 2), NB * MEML}}; \
              pg8::gemm_phase<EpiStore<AddrLin>, pg8::Sched<MapLin>, true>(F.wave, ring, xl, DM, DM * 2, DM * 2, S, E); } } while (0)
#ifdef EXTRA_BARS
    for (int eb = 0; eb < EXTRA_BARS; ++eb) xcd_barrier(bar);
#endif
    if (IN(0)) PHASE(0) { const karg_t ka = kargs(); unsigned char* const ws = uptr(KWS(ka)); p0_prologue(F, ka, ws); SEAM(0); }
    if (IN(1)) PHASE(1) { const karg_t ka = kargs(); unsigned char* const ws = uptr(KWS(ka));
        {
            MapLin mp{(const char*)(ws + WS_HN), (const char*)(ws + WS_WIN_T), (size_t)256 * DM * 2, (size_t)256 * DM * 2};
            pg8::Sched<MapLin> S; S.init(NTOK / 256, 2560 / 256, G, bx, mp);
            EpiQKV E{(bf16_t*)(ws + WS_QB), (bf16_t*)(ws + WS_KB), (bf16_t*)(ws + WS_VB), KIN(ka, 4), KIN(ka, 5), (const float*)(ws + WS_ROPE), (const float*)(ws + WS_ROPE) + SEQ * 64};
            pg8::gemm_phase<EpiQKV, pg8::Sched<MapLin>, true>(F.wave, ring, xl, DM, DM * 2, DM * 2, S, E); }
        {
            MapLin mp{(const char*)(ws + WS_WF_T), (const char*)(ws + WS_HN), (size_t)256 * DM * 2, (size_t)256 * DM * 2};
            pg8::Sched<MapLin> S; S.init(1024 / 256, NTOK / 256, G, (bx + G - (320 % G)) % G, mp);
            EpiStore<AddrF1> E{AddrF1{(bf16_t*)(ws + WS_FPQ)}};
            pg8::gemm_phase<EpiStore<AddrF1>, pg8::Sched<MapLin>, true>(F.wave, ring, xl, DM, DM * 2, DM * 2, S, E); }
        KV_PROJ(0, 448, 480);
        SEAM(1);
    }
    if (IN(2)) PHASE(2) { const karg_t ka = kargs(); unsigned char* const ws = uptr(KWS(ka));
        const int nF2 = (G > 64) ? 64 : 0;
        if (bx < nF2 || nF2 == 0) {
            MapLin mp{(const char*)(ws + WS_DFT), (const char*)(ws + WS_FPQ), (size_t)256 * 4096 * 2, (size_t)256 * 4096 * 2};
            pg8::Sched<MapLin> S; S.init(8, 8, nF2 ? nF2 : G, bx, mp);
            EpiStore<AddrF2> E{AddrF2{(bf16_t*)(ws + WS_MIXB)}};
            pg8::gemm_phase<EpiStore<AddrF2>, pg8::Sched<MapLin>, true>(F.wave, ring, xl, 4096, 4096 * 2, 4096 * 2, S, E);
        }
        if (bx < nF2) { __syncthreads(); tr_span(F, ka, ws, 1, 7680 + bx * 8 + F.wave, 512, 9); __syncthreads(); }
        if (bx >= nF2) {
            const int a = bx - nF2, cnt = G - nF2, per = (384 + cnt - 1) / cnt, slot = a % 3; int ui = 0;
            for (int uid = a * per; uid < (a + 1) * per && uid < 384; ++uid, ++ui) {
                if (ui == slot) { __syncthreads(); tr_span(F, ka, ws, 1, a * 8 + F.wave, 1536, 5); __syncthreads(); }
                const int qb = uid & 7, hq = (uid >> 3) % NQH, b = uid / (8 * NQH), kvh = hq / 3;
                const bf16_t* Qb = (const bf16_t*)(ws + WS_QB) + ((size_t)b * SEQ + qb * 256) * AW + hq * HD;
                const bf16_t* Kh = (const bf16_t*)(ws + WS_KB) + (size_t)b * SEQ * KVW + kvh * HD;
                const bf16_t* Vh = (const bf16_t*)(ws + WS_VB) + (size_t)b * SEQ * KVW + kvh * HD;
                bf16_t* Ob = (bf16_t*)(ws + WS_MIXB) + ((size_t)b * SEQ + qb * 256) * DM + hq * HD;
                attn::attn_dense_body(Qb, Kh, Vh, Ob, SEQ, (char*)lds_raw + RING_OFF, F.wave);
            }
            if (slot >= ui) { __syncthreads(); tr_span(F, ka, ws, 1, a * 8 + F.wave, 1536, 5); __syncthreads(); }
        }
        SEAM(2);
    }
    if (IN(3)) PHASE(3) { const karg_t ka = kargs(); unsigned char* const ws = uptr(KWS(ka));
        MapLin mp{(const char*)(ws + WS_MIXB), (const char*)(ws + WS_WOUT_T), (size_t)256 * DM * 2, (size_t)256 * DM * 2};
        pg8::Sched<MapLin> S; S.init(NTOK / 256, DM / 256, G, bx, mp);
        EpiRes E{KIN(ka, 0), (float*)(ws + WS_XALT), (bf16_t*)(ws + WS_XB), (float*)(ws + WS_SSP), nullptr, 8};
        pg8::gemm_phase<EpiRes, pg8::Sched<MapLin>, true>(F.wave, ring, xl, DM, DM * 2, DM * 2, S, E);
        SEAM(3);
    }
    {
        constexpr int l = 0; constexpr int pb = l ? 15 : 4;
        if (l == 1) {
            if (IN(13)) PHASE(13) { const karg_t ka = kargs(); unsigned char* const ws = uptr(KWS(ka));
                pool_phase(F, (const bf16_t*)(ws + WS_HN), (bf16_t*)(ws + WS_QCB));
#ifdef PROBE_CONV
                tr_span<TRV>(F, ka, ws, 1, bx * 8 + F.wave, 2048, 6);
#endif
                SEAM(13);
            }
            if (IN(14)) PHASE(14) { const karg_t ka = kargs(); unsigned char* const ws = uptr(KWS(ka));
                MapPool mp{(const char*)(ws + WS_QCB), (const char*)(ws + WS_WP_T)};
                pg8::Sched<MapPool> S; S.init(NTOK / 256, DM / 256, G, bx, mp);
                EpiRes E{(const float*)(ws + WS_XALT), KOUT(ka), (bf16_t*)(ws + WS_XB), (float*)(ws + WS_SSP), KIN(ka, 9), 8};
                pg8::gemm_phase<EpiRes, pg8::Sched<MapPool>, true>(F.wave, ring, xl, 512, DM * 2, DM * 2, S, E);
                SEAM(14);
            }
        }
        if (IN(pb + 0)) PHASE(pb + 0) { const karg_t ka = kargs(); unsigned char* const ws = uptr(KWS(ka));
            MapLin mp{(const char*)(ws + WS_XB), (const char*)(ws + WS_WCQ_T + (size_t)l * DM * DM * 2), (size_t)256 * DM * 2, (size_t)256 * DM * 2};
            pg8::Sched<MapLin> S; S.init(NTOK / 256, DM / 256, G, bx, mp);
            EpiRowScale E{(bf16_t*)(ws + WS_QCB), DM, (const float*)(ws + WS_SSP), 0.04419417382415922f};
            pg8::gemm_phase<EpiRowScale, pg8::Sched<MapLin>, true>(F.wave, ring, xl, DM, DM * 2, DM * 2, S, E);
            SEAM(pb + 0);
        }
        if (IN(pb + 1)) PHASE(pb + 1) { const karg_t ka = kargs(); unsigned char* const ws = uptr(KWS(ka));
            MapXS mp{(const char*)(ws + WS_QCB), (const char*)(ws + WS_KCB + (size_t)l * NB * MEML * DM * 2)};
            pg8::Sched<MapXS> S; S.init(NTOK / 256, NMH, G, bx, mp);
            EpiSoftmax E{(bf16_t*)(ws + WS_PB), NMH * MEML};
            pg8::gemm_phase<EpiSoftmax, pg8::Sched<MapXS>, true>(F.wave, ring, xl, MHD, DM * 2, DM * 2, S, E);
            if (l == 0) KV_PROJ(1, 128, 160);
            SEAM(pb + 1);
        }
        if (IN(pb + 2)) PHASE(pb + 2) { const karg_t ka = kargs(); unsigned char* const ws = uptr(KWS(ka));
            MapXPV mp{(const char*)(ws + WS_PB), (const char*)(ws + WS_VTB + (size_t)l * NB * MEML * DM * 2)};
            pg8::Sched<MapXPV> S; S.init(NTOK / 256, DM / 256, G, bx, mp);
            EpiStore<AddrLin> E{AddrLin{(bf16_t*)(ws + WS_MIXB), DM}};
            pg8::gemm_phase<EpiStore<AddrLin>, pg8::Sched<MapXPV>, true>(F.wave, ring, xl, MEML, NMH * MEML * 2, NB * MEML * 2, S, E);
            SEAM(pb + 2);
        }
        if (IN(pb + 3)) PHASE(pb + 3) { const karg_t ka = kargs(); unsigned char* const ws = uptr(KWS(ka));
            MapLin mp{(const char*)(ws + WS_MIXB), (const char*)(ws + WS_WCO_T + (size_t)l * DM * DM * 2), (size_t)256 * DM * 2, (size_t)256 * DM * 2};
            pg8::Sched<MapLin> S; S.init(NTOK / 256, DM / 256, G, bx, mp);
            EpiRes E{l == 0 ? (const float*)(ws + WS_XALT) : (const float*)KOUT(ka), l == 0 ? KOUT(ka) : (float*)(ws + WS_XALT), nullptr, nullptr, nullptr, 8};
            pg8::gemm_phase<EpiRes, pg8::Sched<MapLin>, true>(F.wave, ring, xl, DM, DM * 2, DM * 2, S, E);
            SEAM(pb + 3);
        }
        if (IN(pb + 4)) PHASE(pb + 4) { const karg_t ka = kargs(); unsigned char* const ws = uptr(KWS(ka));
            router_phase(F, l == 0 ? (const float*)KOUT(ka) : (const float*)(ws + WS_XALT), KIN(ka, 16) + l * DM, KIN(ka, 17) + (size_t)l * DM * NE, (bf16_t*)(ws + WS_HN), (float*)(ws + WS_AFF));
            SEAM(pb + 4);
        }
        if (IN(pb + 5)) PHASE(pb + 5) { const karg_t ka = kargs(); unsigned char* const ws = uptr(KWS(ka));
            rank_phase(F, (const float*)(ws + WS_AFF), (int*)(ws + WS_RANK), (float*)(ws + WS_GATE), (const bf16_t*)(ws + WS_HN), (bf16_t*)(ws + WS_XSB));
            SEAM(pb + 5);
        }
        if (IN(pb + 6)) PHASE(pb + 6) { const karg_t ka = kargs(); unsigned char* const ws = uptr(KWS(ka));
            MapMoE mp{(const char*)(ws + WS_XSB), (const char*)(ws + (l ? WS_WGU_T2 : WS_WGU_T)), (size_t)256 * DM * 2, (size_t)2048 * DM * 2, (size_t)256 * DM * 2};
            pg8::Sched<MapMoE> S; S.init(NB * NE, 8, G, bx, mp);
            EpiSwiGLU E{(bf16_t*)(ws + WS_ACTB)};
            const bool cfirst = ((bx >> 3) & 1) != 0;
            if (l == 0 && cfirst) { tr_span(F, ka, ws, 2, bx * 8 + F.wave, 2048, 3); __syncthreads(); }
            pg8::gemm_phase<EpiSwiGLU, pg8::Sched<MapMoE>, true>(F.wave, ring, xl, DM, DM * 2, DM * 2, S, E);
            if (l == 0 && !cfirst) { __syncthreads(); tr_span(F, ka, ws, 2, bx * 8 + F.wave, 2048, 3); }
            SEAM(pb + 6);
        }
        if (IN(pb + 7)) PHASE(pb + 7) { const karg_t ka = kargs(); unsigned char* const ws = uptr(KWS(ka));
            MapMoE mp{(const char*)(ws + WS_ACTB), (const char*)(ws + (l ? WS_WD_T2 : WS_WD_T)), (size_t)256 * EFF * 2, (size_t)2048 * EFF * 2, (size_t)256 * EFF * 2};
            pg8::Sched<MapMoE> S; S.init(NB * NE, 8, G, bx, mp);
            EpiRowGate E{(bf16_t*)(ws + WS_YB), (const float*)(ws + WS_GATE)};
            const bool cfirst = ((bx >> 3) & 1) == 0;
            if (l == 0 && cfirst) { tr_span(F, ka, ws, 2, 6144 + bx * 8 + F.wave, 2048, 3); __syncthreads(); }
            pg8::gemm_phase<EpiRowGate, pg8::Sched<MapMoE>, true>(F.wave, ring, xl, EFF, EFF * 2, EFF * 2, S, E);
            if (l == 0 && !cfirst) { __syncthreads(); tr_span(F, ka, ws, 2, 6144 + bx * 8 + F.wave, 2048, 3); }
            SEAM(pb + 7);
        }
        if (IN(pb + 8)) PHASE(pb + 8) { const karg_t ka = kargs(); unsigned char* const ws = uptr(KWS(ka));
            combine_phase(F, l == 0 ? (const float*)KOUT(ka) : (const float*)(ws + WS_XALT), l == 0 ? (float*)(ws + WS_XALT) : KOUT(ka), (const bf16_t*)(ws + WS_YB), (const int*)(ws + WS_RANK), l == 0 ? KIN(ka, 2) + DM : KIN(ka, 21), (bf16_t*)(ws + WS_HN), l == 1);
            SEAM(pb + 8);
        }
    }
    {
        constexpr int l = 1; constexpr int pb = l ? 15 : 4;
        if (l == 1) {
            if (IN(13)) PHASE(13) { const karg_t ka = kargs(); unsigned char* const ws = uptr(KWS(ka));
                pool_phase(F, (const bf16_t*)(ws + WS_HN), (bf16_t*)(ws + WS_QCB));
#ifdef PROBE_CONV
                tr_span<TRV>(F, ka, ws, 1, bx * 8 + F.wave, 2048, 6);
#endif
                SEAM(13);
            }
            if (IN(14)) PHASE(14) { const karg_t ka = kargs(); unsigned char* const ws = uptr(KWS(ka));
                MapPool mp{(const char*)(ws + WS_QCB), (const char*)(ws + WS_WP_T)};
                pg8::Sched<MapPool> S; S.init(NTOK / 256, DM / 256, G, bx, mp);
                EpiRes E{(const float*)(ws + WS_XALT), KOUT(ka), (bf16_t*)(ws + WS_XB), (float*)(ws + WS_SSP), KIN(ka, 9), 8};
                pg8::gemm_phase<EpiRes, pg8::Sched<MapPool>, true>(F.wave, ring, xl, 512, DM * 2, DM * 2, S, E);
                SEAM(14);
            }
        }
        if (IN(pb + 0)) PHASE(pb + 0) { const karg_t ka = kargs(); unsigned char* const ws = uptr(KWS(ka));
            MapLin mp{(const char*)(ws + WS_XB), (const char*)(ws + WS_WCQ_T + (size_t)l * DM * DM * 2), (size_t)256 * DM * 2, (size_t)256 * DM * 2};
            pg8::Sched<MapLin> S; S.init(NTOK / 256, DM / 256, G, bx, mp);
            EpiRowScale E{(bf16_t*)(ws + WS_QCB), DM, (const float*)(ws + WS_SSP), 0.04419417382415922f};
            pg8::gemm_phase<EpiRowScale, pg8::Sched<MapLin>, true>(F.wave, ring, xl, DM, DM * 2, DM * 2, S, E);
            SEAM(pb + 0);
        }
        if (IN(pb + 1)) PHASE(pb + 1) { const karg_t ka = kargs(); unsigned char* const ws = uptr(KWS(ka));
            MapXS mp{(const char*)(ws + WS_QCB), (const char*)(ws + WS_KCB + (size_t)l * NB * MEML * DM * 2)};
            pg8::Sched<MapXS> S; S.init(NTOK / 256, NMH, G, bx, mp);
            EpiSoftmax E{(bf16_t*)(ws + WS_PB), NMH * MEML};
            pg8::gemm_phase<EpiSoftmax, pg8::Sched<MapXS>, true>(F.wave, ring, xl, MHD, DM * 2, DM * 2, S, E);
            if (l == 0) KV_PROJ(1, 128, 160);
            SEAM(pb + 1);
        }
        if (IN(pb + 2)) PHASE(pb + 2) { const karg_t ka = kargs(); unsigned char* const ws = uptr(KWS(ka));
            MapXPV mp{(const char*)(ws + WS_PB), (const char*)(ws + WS_VTB + (size_t)l * NB * MEML * DM * 2)};
            pg8::Sched<MapXPV> S; S.init(NTOK / 256, DM / 256, G, bx, mp);
            EpiStore<AddrLin> E{AddrLin{(bf16_t*)(ws + WS_MIXB), DM}};
            pg8::gemm_phase<EpiStore<AddrLin>, pg8::Sched<MapXPV>, true>(F.wave, ring, xl, MEML, NMH * MEML * 2, NB * MEML * 2, S, E);
            SEAM(pb + 2);
        }
        if (IN(pb + 3)) PHASE(pb + 3) { const karg_t ka = kargs(); unsigned char* const ws = uptr(KWS(ka));
            MapLin mp{(const char*)(ws + WS_MIXB), (const char*)(ws + WS_WCO_T + (size_t)l * DM * DM * 2), (size_t)256 * DM * 2, (size_t)256 * DM * 2};
            pg8::Sched<MapLin> S; S.init(NTOK / 256, DM / 256, G, bx, mp);
            EpiRes E{l == 0 ? (const float*)(ws + WS_XALT) : (const float*)KOUT(ka), l == 0 ? KOUT(ka) : (float*)(ws + WS_XALT), nullptr, nullptr, nullptr, 8};
            pg8::gemm_phase<EpiRes, pg8::Sched<MapLin>, true>(F.wave, ring, xl, DM, DM * 2, DM * 2, S, E);
            SEAM(pb + 3);
        }
        if (IN(pb + 4)) PHASE(pb + 4) { const karg_t ka = kargs(); unsigned char* const ws = uptr(KWS(ka));
            router_phase(F, l == 0 ? (const float*)KOUT(ka) : (const float*)(ws + WS_XALT), KIN(ka, 16) + l * DM, KIN(ka, 17) + (size_t)l * DM * NE, (bf16_t*)(ws + WS_HN), (float*)(ws + WS_AFF));
            SEAM(pb + 4);
        }
        if (IN(pb + 5)) PHASE(pb + 5) { const karg_t ka = kargs(); unsigned char* const ws = uptr(KWS(ka));
            rank_phase(F, (const float*)(ws + WS_AFF), (int*)(ws + WS_RANK), (float*)(ws + WS_GATE), (const bf16_t*)(ws + WS_HN), (bf16_t*)(ws + WS_XSB));
            SEAM(pb + 5);
        }
        if (IN(pb + 6)) PHASE(pb + 6) { const karg_t ka = kargs(); unsigned char* const ws = uptr(KWS(ka));
            MapMoE mp{(const char*)(ws + WS_XSB), (const char*)(ws + (l ? WS_WGU_T2 : WS_WGU_T)), (size_t)256 * DM * 2, (size_t)2048 * DM * 2, (size_t)256 * DM * 2};
            pg8::Sched<MapMoE> S; S.init(NB * NE, 8, G, bx, mp);
            EpiSwiGLU E{(bf16_t*)(ws + WS_ACTB)};
            const bool cfirst = ((bx >> 3) & 1) != 0;
            if (l == 0 && cfirst) { tr_span(F, ka, ws, 2, bx * 8 + F.wave, 2048, 3); __syncthreads(); }
            pg8::gemm_phase<EpiSwiGLU, pg8::Sched<MapMoE>, true>(F.wave, ring, xl, DM, DM * 2, DM * 2, S, E);
            if (l == 0 && !cfirst) { __syncthreads(); tr_span(F, ka, ws, 2, bx * 8 + F.wave, 2048, 3); }
            SEAM(pb + 6);
        }
        if (IN(pb + 7)) PHASE(pb + 7) { const karg_t ka = kargs(); unsigned char* const ws = uptr(KWS(ka));
            MapMoE mp{(const char*)(ws + WS_ACTB), (const char*)(ws + (l ? WS_WD_T2 : WS_WD_T)), (size_t)256 * EFF * 2, (size_t)2048 * EFF * 2, (size_t)256 * EFF * 2};
            pg8::Sched<MapMoE> S; S.init(NB * NE, 8, G, bx, mp);
            EpiRowGate E{(bf16_t*)(ws + WS_YB), (const float*)(ws + WS_GATE)};
            const bool cfirst = ((bx >> 3) & 1) == 0;
            if (l == 0 && cfirst) { tr_span(F, ka, ws, 2, 6144 + bx * 8 + F.wave, 2048, 3); __syncthreads(); }
            pg8::gemm_phase<EpiRowGate, pg8::Sched<MapMoE>, true>(F.wave, ring, xl, EFF, EFF * 2, EFF * 2, S, E);
            if (l == 0 && !cfirst) { __syncthreads(); tr_span(F, ka, ws, 2, 6144 + bx * 8 + F.wave, 2048, 3); }
            SEAM(pb + 7);
        }
        if (IN(pb + 8)) PHASE(pb + 8) { const karg_t ka = kargs(); unsigned char* const ws = uptr(KWS(ka));
            combine_phase(F, l == 0 ? (const float*)KOUT(ka) : (const float*)(ws + WS_XALT), l == 0 ? (float*)(ws + WS_XALT) : KOUT(ka), (const bf16_t*)(ws + WS_YB), (const int*)(ws + WS_RANK), l == 0 ? KIN(ka, 2) + DM : KIN(ka, 21), (bf16_t*)(ws + WS_HN), l == 1);
            SEAM(pb + 8);
        }
    }
#undef IN
#undef SEAM
#undef PHASE
#undef KV_PROJ
}


extern "C" void kernel_launch(void* const* d_in, const int* in_sizes, int n_in, void* d_out, int out_size, void* d_ws, size_t ws_size, hipStream_t stream) {
    static int grid = 0;
    if (grid == 0) {
        int dev = 0, cus = 0;
        if (n_in != 22 || out_size != NTOK * DM || ws_size < WS_FAST_END) { fprintf(stderr, "kernel_launch: unexpected shapes (n_in %d out %d ws %zu)\n", n_in, out_size, ws_size); grid = -1; return; }
        if (hipGetDevice(&dev) != hipSuccess || hipDeviceGetAttribute(&cus, hipDeviceAttributeMultiprocessorCount, dev) != hipSuccess) { fprintf(stderr, "device query failed\n"); grid = -1; return; }
        if (hipFuncSetAttribute((const void*)skel_fwd, hipFuncAttributeMaxDynamicSharedMemorySize, LDS_BYTES) != hipSuccess) { fprintf(stderr, "hipFuncSetAttribute failed\n"); grid = -1; return; }
        (void)hipGetLastError();
        grid = cus;
        if (grid != 256) { fprintf(stderr, "kernel_launch: this kernel is laid out for 256 CUs (found %d)\n", cus); grid = -1; return; }
    }
    if (grid < 0) return;
    hipMemsetAsync((char*)d_ws + WS_CTL, 0, CTL_ZERO_BYTES, stream);
    Args a{};
    for (int i = 0; i < 22; ++i) a.in[i] = (const float*)d_in[i];
    a.out = (float*)d_out; a.ws = (unsigned char*)d_ws;
    constexpr int NL = MK_N_LAUNCHES;
    for (int li = 0; li < NL; ++li) {
        a.ph_lo = (N_PHASES * li) / NL; a.ph_hi = (N_PHASES * (li + 1)) / NL; a.li = li;
        hipLaunchKernelGGL(skel_fwd, dim3(grid), dim3(NWAVES * 64), LDS_BYTES, stream, a);
    }
}
```

```cpp
#include <hip/hip_runtime.h>
#include <cstdio>
#include <cstdint>

constexpr int DM = 2048, NB = 4, SEQ = 2048, NTOK = NB * SEQ;
constexpr int HD = 128, NQH = 12, NKVH = 4, AW = NQH * HD, KVW = NKVH * HD, FW = 512, INW = 3072;
constexpr int MEML = 256, NMH = 4, MHD = 512;
constexpr int NE = 16, EFF = 1024, CAP = 256;
constexpr float EPS = 1e-6f;

#define LAS __attribute__((address_space(3)))
#define GAS __attribute__((address_space(1)))
typedef unsigned short bf16_t;
typedef short bf16x8 __attribute__((ext_vector_type(8)));
typedef float f32x4 __attribute__((ext_vector_type(4)));
typedef float f32x2 __attribute__((ext_vector_type(2)));
typedef unsigned u32x4 __attribute__((ext_vector_type(4)));
typedef unsigned u32x2 __attribute__((ext_vector_type(2)));
typedef __bf16 bf16x2_t __attribute__((ext_vector_type(2)));
__device__ __forceinline__ unsigned cvtpk(float lo, float hi) { f32x2 v = {lo, hi}; bf16x2_t b = __builtin_convertvector(v, bf16x2_t); return __builtin_bit_cast(unsigned, b); }
__device__ __forceinline__ float bf2f(unsigned short h) { return __uint_as_float(((unsigned)h) << 16); }
template <class T> __device__ __forceinline__ T* uptr(T* p) { const unsigned long long v = (unsigned long long)p; const unsigned lo = __builtin_amdgcn_readfirstlane((unsigned)v), hi = __builtin_amdgcn_readfirstlane((unsigned)(v >> 32)); return (T*)(((unsigned long long)hi << 32) | lo); }
__device__ __forceinline__ int lane_id() { int l = (int)__builtin_amdgcn_mbcnt_hi(~0u, __builtin_amdgcn_mbcnt_lo(~0u, 0u)); asm volatile("" : "+v"(l)); return l; }
typedef __attribute__((address_space(4))) const unsigned char* karg_t;
__device__ __forceinline__ karg_t kargs() { karg_t p = (karg_t)__builtin_amdgcn_kernarg_segment_ptr(); asm volatile("" : "+s"(p)); return p; }
#define KIN(ka, i) (*(const float* const __attribute__((address_space(4)))*)((ka) + 8 * (i)))
#define KOUT(ka) (*(float* const __attribute__((address_space(4)))*)((ka) + 176))
#define KWS(ka) (*(unsigned char* const __attribute__((address_space(4)))*)((ka) + 184))
#define LDS_WAIT() asm volatile("s_waitcnt lgkmcnt(0)" ::: "memory")
#define VM_WAIT() asm volatile("s_waitcnt vmcnt(0)" ::: "memory")
#define WG_BAR() do { asm volatile("s_waitcnt lgkmcnt(0)" ::: "memory"); __builtin_amdgcn_s_barrier(); asm volatile("" ::: "memory"); } while (0)

namespace pg8 {
constexpr int BM = 256, BK = 64, HALF = 128, HTB = HALF * BK * 2, STAGE_BYTES = 8 * HTB, NXCD = 8, WGM = 8;
__host__ __device__ __forceinline__ int lds_byte(int r, int c) { const int st = (r >> 4) * 2 + (c >> 5), rr = r & 15, cc = c & 31, ob = rr * 64 + cc * 2; return st * 1024 + (ob ^ (((ob >> 9) & 1) << 5)); }
__host__ __device__ __forceinline__ void stage_rc(int b, int& R, int& C) { const int st = b / 1024, sb = b % 1024, swz = sb ^ (((sb >> 9) & 1) << 5); R = (st >> 1) * 16 + swz / 64; C = (st & 1) * 32 + (swz % 64) / 2; }
__host__ __device__ __forceinline__ int perm32(int rho) { const int n = rho >> 4, i = rho & 15; return 8 * (i >> 2) + 4 * n + (i & 3); }

struct Unit { int pm, pn; const char* a; const char* b; };
struct EpiCtx { int wr, wc, wid; LAS unsigned char* xl; };

template <class Map> struct Sched {
    int nM, nN, nwg, G, c; Map map;
    __device__ __forceinline__ void init(int nM_, int nN_, int G_, int c_, const Map& m) { nM = nM_; nN = nN_; nwg = nM * nN; G = G_; c = c_; map = m; }
    __device__ __forceinline__ bool next(int i, Unit& u) const {
        const long L = (long)i * G + c; if (L >= nwg) return false;
        int wgid = (int)L; { const int q = nwg / NXCD, r = nwg % NXCD, xcd = wgid % NXCD, off = wgid / NXCD; wgid = (xcd < r ? xcd * (q + 1) : r * (q + 1) + (xcd - r) * q) + off; }
        const int nig = WGM * nN, gid = wgid / nig, fm = gid * WGM, gsz = (nM - fm) < WGM ? (nM - fm) : WGM;
        u.pm = fm + ((wgid % nig) % gsz); u.pn = (wgid % nig) / gsz; map(u); return true;
    }
};

template <class Epi, class SchedT, bool SP2>
__device__ __forceinline__ void gemm_phase(const int wave_, LAS unsigned char* lds, LAS unsigned char* xl, const int K, const int lda, const int ldb, const SchedT& S, const Epi& E) {
    constexpr bool ALIGN_EPI = true;
    const int lane = lane_id(), wid = wave_, tid = wid * 64 + lane, wr = wid >> 2, wc = wid & 3, fr = lane & 15, fq = lane >> 4;
    const int nt = K / BK;
    unsigned voffA[2], voffB[2];
#pragma unroll
    for (int i = 0; i < 2; ++i) { int R, C; stage_rc(tid * 16 + i * 8192, R, C); const int Rb = Epi::PERM ? ((R & ~31) + perm32(R & 31)) : R;
        voffA[i] = (unsigned)(R * lda + C * 2); voffB[i] = (unsigned)(Rb * ldb + C * 2); }
    const size_t kstep = (size_t)(BK * 2);
    const size_t hstepA = (size_t)HALF * lda, hstepB = (size_t)HALF * ldb;
    const unsigned ldsw = (unsigned)wid * 1024u;
    const int aoff = lds_byte(wr * 64 + fr, fq * 8), boff = lds_byte(wc * 32 + fr, fq * 8);
#define PG8_SA(b, h) (((b) * 2 + (h)) * HTB)
#define PG8_SB(b, h) ((4 + (b) * 2 + (h)) * HTB)
#define PG8_STAGE(bufoff, gbase, voff) do { _Pragma("unroll") for (int _i = 0; _i < 2; ++_i) \
        __builtin_amdgcn_global_load_lds((const unsigned*)((const char*)(gbase) + (voff)[_i]), (LAS unsigned*)(lds + (bufoff) + ldsw + _i * 8192), 16, 0, 0); } while (0)
#define PG8_LDA(dst, b, h) do { _Pragma("unroll") for (int m = 0; m < 4; ++m) _Pragma("unroll") for (int k = 0; k < 2; ++k) dst[m][k] = *(const LAS bf16x8*)(lds + PG8_SA(b, h) + aoff + m * 2048 + k * 1024); } while (0)
#define PG8_LDB(dst, b, h) do { _Pragma("unroll") for (int n = 0; n < 2; ++n) _Pragma("unroll") for (int k = 0; k < 2; ++k) dst[n][k] = *(const LAS bf16x8*)(lds + PG8_SB(b, h) + boff + n * 2048 + k * 1024); } while (0)
#define PG8_MMA(ai, bj, At, Bt) do { __builtin_amdgcn_s_setprio(1); _Pragma("unroll") for (int m = 0; m < 4; ++m) _Pragma("unroll") for (int n = 0; n < 2; ++n) _Pragma("unroll") for (int k = 0; k < 2; ++k) \
        acc[ai][bj][m][n] = __builtin_amdgcn_mfma_f32_16x16x32_bf16(Bt[n][k], At[m][k], acc[ai][bj][m][n], 0, 0, 0); __builtin_amdgcn_s_setprio(0); } while (0)
#define PG8_WAIT_V(n) asm volatile("s_waitcnt vmcnt(" #n ")" ::: "memory")
#define PG8_WAIT_L(n) asm volatile("s_waitcnt lgkmcnt(" #n ")" ::: "memory")
#define PG8_BAR __builtin_amdgcn_s_barrier()
#define PG8_SCHED __builtin_amdgcn_sched_barrier(0)
    Unit cur, nxt; int ui = 0;
    if (!S.next(0, cur)) return;
    EpiCtx ctx; ctx.wr = wr; ctx.wc = wc; ctx.wid = wid; ctx.xl = xl;
    f32x4 acc[2][2][4][2];
#pragma unroll
    for (int a = 0; a < 2; ++a)
#pragma unroll
        for (int b = 0; b < 2; ++b)
#pragma unroll
            for (int m = 0; m < 4; ++m)
#pragma unroll
                for (int n = 0; n < 2; ++n) acc[a][b][m][n] = (f32x4){0.f, 0.f, 0.f, 0.f};
    bf16x8 At[4][2], B0[2][2], B1[2][2];
    const char* cA = cur.a; const char* cB = cur.b;
    if constexpr (SP2) {
        PG8_STAGE(PG8_SB(0, 0), cB, voffB); PG8_STAGE(PG8_SB(0, 1), cB + hstepB, voffB); PG8_STAGE(PG8_SA(0, 0), cA, voffA); PG8_STAGE(PG8_SA(0, 1), cA + hstepA, voffA);
        if (wr == 1) PG8_BAR;
        PG8_WAIT_V(2); PG8_BAR;
        PG8_STAGE(PG8_SB(1, 0), cB + kstep, voffB); PG8_STAGE(PG8_SA(1, 0), cA + kstep, voffA); PG8_STAGE(PG8_SB(1, 1), cB + hstepB + kstep, voffB);
        PG8_WAIT_V(6); PG8_BAR;
    } else {
        PG8_STAGE(PG8_SB(0, 0), cB, voffB); PG8_STAGE(PG8_SA(0, 0), cA, voffA); PG8_STAGE(PG8_SB(0, 1), cB + hstepB, voffB); PG8_STAGE(PG8_SA(0, 1), cA + hstepA, voffA);
        if (wr == 1) PG8_BAR;
        PG8_WAIT_V(4); PG8_BAR;
        PG8_STAGE(PG8_SB(1, 0), cB + kstep, voffB); PG8_STAGE(PG8_SA(1, 0), cA + kstep, voffA); PG8_STAGE(PG8_SB(1, 1), cB + hstepB + kstep, voffB);
        PG8_WAIT_V(6); PG8_BAR;
    }
    for (;;) {
        const bool has_next = S.next(ui + 1, nxt);
        const char* nA = has_next ? nxt.a : cA; const char* nB = has_next ? nxt.b : cB;
        for (int t = 0; t < nt; t += 2) {
            const bool last = (t == nt - 2);
            const char* a1 = cA + (size_t)(t + 1) * kstep;
            const char* a2 = last ? nA : cA + (size_t)(t + 2) * kstep; const char* b2 = last ? nB : cB + (size_t)(t + 2) * kstep;
            const char* a3 = a2 + kstep; const char* b3 = b2 + kstep;
            if constexpr (SP2) {
            PG8_LDB(B0, 0, 0); PG8_LDB(B1, 0, 1); PG8_SCHED; PG8_LDA(At, 0, 0); PG8_STAGE(PG8_SA(1, 1), a1 + hstepA, voffA);
            PG8_WAIT_V(8); PG8_WAIT_L(0); PG8_BAR; PG8_MMA(0, 0, At, B0); PG8_MMA(0, 1, At, B1); PG8_BAR; PG8_SCHED;
            PG8_LDA(At, 0, 1); PG8_STAGE(PG8_SB(0, 0), b2, voffB); PG8_STAGE(PG8_SB(0, 1), b2 + hstepB, voffB); PG8_STAGE(PG8_SA(0, 0), a2, voffA);
            PG8_WAIT_V(8); PG8_WAIT_L(0); PG8_BAR; PG8_MMA(1, 0, At, B0); PG8_MMA(1, 1, At, B1); PG8_BAR; PG8_SCHED;
            PG8_LDB(B0, 1, 0); PG8_LDB(B1, 1, 1); PG8_SCHED; PG8_LDA(At, 1, 0); PG8_STAGE(PG8_SA(0, 1), a2 + hstepA, voffA);
            PG8_WAIT_V(8); PG8_WAIT_L(0); PG8_BAR; PG8_MMA(0, 0, At, B0); PG8_MMA(0, 1, At, B1); PG8_BAR; PG8_SCHED;
            PG8_LDA(At, 1, 1); PG8_STAGE(PG8_SB(1, 0), b3, voffB); PG8_STAGE(PG8_SB(1, 1), b3 + hstepB, voffB); PG8_STAGE(PG8_SA(1, 0), a3, voffA);
            PG8_WAIT_V(8); PG8_WAIT_L(0); PG8_BAR; PG8_MMA(1, 0, At, B0); PG8_MMA(1, 1, At, B1); PG8_BAR; PG8_SCHED;
            } else {
            PG8_LDB(B0, 0, 0); PG8_SCHED; PG8_LDA(At, 0, 0); PG8_STAGE(PG8_SA(1, 1), a1 + hstepA, voffA);
            PG8_WAIT_L(8); PG8_BAR; PG8_WAIT_L(0); PG8_MMA(0, 0, At, B0); PG8_BAR; PG8_SCHED;
            PG8_LDB(B1, 0, 1); PG8_STAGE(PG8_SB(0, 0), b2, voffB);
            PG8_BAR; PG8_WAIT_L(0); PG8_MMA(0, 1, At, B1); PG8_BAR;
            PG8_LDA(At, 0, 1); PG8_STAGE(PG8_SA(0, 0), a2, voffA);
            PG8_BAR; PG8_WAIT_L(0); PG8_MMA(1, 0, At, B0); PG8_BAR; PG8_SCHED;
            PG8_STAGE(PG8_SB(0, 1), b2 + hstepB, voffB);
            PG8_WAIT_V(6); PG8_BAR; PG8_MMA(1, 1, At, B1); PG8_BAR;
            PG8_LDB(B0, 1, 0); PG8_SCHED; PG8_LDA(At, 1, 0); PG8_STAGE(PG8_SA(0, 1), a2 + hstepA, voffA);
            PG8_WAIT_L(8); PG8_BAR; PG8_WAIT_L(0); PG8_MMA(0, 0, At, B0); PG8_BAR; PG8_SCHED;
            PG8_LDB(B1, 1, 1); PG8_STAGE(PG8_SB(1, 0), b3, voffB);
            PG8_BAR; PG8_WAIT_L(0); PG8_MMA(0, 1, At, B1); PG8_BAR;
            PG8_LDA(At, 1, 1); PG8_STAGE(PG8_SA(1, 0), a3, voffA);
            PG8_BAR; PG8_WAIT_L(0); PG8_MMA(1, 0, At, B0); PG8_BAR; PG8_SCHED;
            PG8_STAGE(PG8_SB(1, 1), b3 + hstepB, voffB);
            PG8_WAIT_V(6); PG8_BAR; PG8_MMA(1, 1, At, B1); PG8_BAR;
            }
        }
        if constexpr (ALIGN_EPI) { if (wr == 0) PG8_BAR; }
        E(acc, cur, ctx);
        if (!has_next) break;
#pragma unroll
        for (int a = 0; a < 2; ++a)
#pragma unroll
            for (int b = 0; b < 2; ++b)
#pragma unroll
                for (int m = 0; m < 4; ++m)
#pragma unroll
                    for (int n = 0; n < 2; ++n) acc[a][b][m][n] = (f32x4){0.f, 0.f, 0.f, 0.f};
        cur = nxt; cA = nA; cB = nB; ++ui;
        if constexpr (ALIGN_EPI) { if (wr == 1) PG8_BAR; }
    }
    PG8_WAIT_V(0);
    if constexpr (!ALIGN_EPI) { if (wr == 0) PG8_BAR; }
    PG8_BAR;
#undef PG8_SA
#undef PG8_SB
#undef PG8_STAGE
#undef PG8_LDA
#undef PG8_LDB
#undef PG8_MMA
#undef PG8_WAIT_V
#undef PG8_WAIT_L
#undef PG8_BAR
#undef PG8_SCHED
}
}

constexpr size_t MiB = 1u << 20;
constexpr size_t WS_CTL = 0, CTL_ZERO_BYTES = 1 * MiB;
constexpr size_t WS_WIN_T = 1 * MiB, WS_WF_T = 11 * MiB, WS_WOUT_T = 15 * MiB, WS_WCQ_T = 23 * MiB, WS_WCK_T = 39 * MiB, WS_WCV_T = 55 * MiB, WS_WCO_T = 71 * MiB;
constexpr size_t WS_WP_T = 87 * MiB, WS_DFT = 89 * MiB, WS_ROPE = 105 * MiB, WS_WGU_T = 106 * MiB, WS_WD_T = 234 * MiB;
constexpr size_t WS_HN = 298 * MiB, WS_XB = 330 * MiB, WS_QB = 362 * MiB, WS_KB = 386 * MiB, WS_VB = 394 * MiB, WS_FPQ = 402 * MiB, WS_MIXB = 418 * MiB, WS_QCB = 450 * MiB;
constexpr size_t WS_KCB = 482 * MiB, WS_VTB = 490 * MiB, WS_MEMNB = 498 * MiB, WS_PB = 506 * MiB, WS_XSB = 522 * MiB, WS_ACTB = 586 * MiB, WS_YB = 618 * MiB;
constexpr size_t WS_SSP = 682 * MiB, WS_AFF = 683 * MiB, WS_RANK = 684 * MiB, WS_GATE = 685 * MiB, WS_XALT = 686 * MiB, WS_WGU_T2 = 750 * MiB, WS_WD_T2 = 878 * MiB, WS_FAST_END = 942 * MiB;
constexpr int CW_TMO = 0, CW_CODE = 1, CW_BAR = 4096;
constexpr int RING_OFF = 0, RING_BYTES = 131072, XL_OFF = 131072, XL_BYTES = 14336, LDSCTL_OFF = XL_OFF + XL_BYTES, MISC_OFF = LDSCTL_OFF + 320, LDS_BYTES = 147456;
static_assert(MISC_OFF + 128 <= LDS_BYTES, "LDS map");
constexpr int NWAVES = 8;

typedef GAS unsigned gu32;
#define RLX_AGENT __ATOMIC_RELAXED, __HIP_MEMORY_SCOPE_AGENT

#define XB_TMO      128
#define XB_XCNT(j)  (256  + 64 * (j))
#define XB_XSUB(j)  (1280 + 64 * (j))
#define XB_XGEN(j)  (2304 + 64 * (j))
#define XB_TOP      3328
#define XB_TOPGEN   3392
#define XCD_BAR_WORDS 3456
#define XB_SPIN_CAP (1u << 18)
__device__ __forceinline__ unsigned xb_ld(unsigned* p)              { return __hip_atomic_load(p, __ATOMIC_RELAXED, __HIP_MEMORY_SCOPE_AGENT); }
__device__ __forceinline__ unsigned xb_add(unsigned* p, unsigned v) { return __hip_atomic_fetch_add(p, v, __ATOMIC_RELAXED, __HIP_MEMORY_SCOPE_AGENT); }
__device__ __forceinline__ unsigned xb_xcc_id() { return (unsigned)__builtin_amdgcn_s_getreg((3 << 11) | 20) & 0xFu; }
#define XB_SPIN(cond, bar) do { unsigned _sp = 0; while (cond) { __builtin_amdgcn_s_sleep(1); \
    if ((++_sp & 255u) == 0u) { if (xb_ld(&(bar)[XB_TMO])) break; if (_sp > XB_SPIN_CAP) { atomicAdd(&(bar)[XB_TMO], 1u); break; } } } } while (0)
struct XcdBarrier { unsigned* bar; unsigned x; volatile LAS unsigned* st; int wave; };
__device__ __forceinline__ XcdBarrier xcd_barrier_post(unsigned* bar, volatile LAS unsigned* st, int wave) {
    XcdBarrier b; b.bar = bar; b.x = xb_xcc_id(); b.st = st; b.wave = wave;
    if (wave == 0 && lane_id() == 0) (void)xb_add(&bar[XB_XCNT(b.x)], 1u);
    return b;
}
__device__ __forceinline__ void xcd_barrier_complete(unsigned* bar, unsigned x, unsigned& nloc, unsigned& nx) {
    const unsigned G = gridDim.x * gridDim.y * gridDim.z;
    unsigned sum, cnt, mine, sp = 0u;
    for (;;) {
        sum = 0u; cnt = 0u; mine = 0u;
#pragma unroll
        for (unsigned j = 0; j < 16; ++j) { const unsigned c = xb_ld(&bar[XB_XCNT(j)]); sum += c; cnt += (c > 0u) ? 1u : 0u; mine = (j == x) ? c : mine; }
        if (sum == G) break;
        __builtin_amdgcn_s_sleep(1);
        if ((++sp & 255u) == 0u) { if (xb_ld(&bar[XB_TMO])) break; if (sp > XB_SPIN_CAP) { atomicAdd(&bar[XB_TMO], 1u); break; } }
    }
    nloc = mine > 0u ? mine : 1u; nx = cnt > 0u ? cnt : 1u;
}
__device__ __forceinline__ void xcd_barrier(const XcdBarrier& b) {
    asm volatile("s_waitcnt vmcnt(0)" ::: "memory");
    __syncthreads();
    if (b.wave == 0 && lane_id() == 0) {
        unsigned* bar = b.bar;
        __builtin_amdgcn_s_waitcnt(0);
        unsigned nloc = b.st[0], nx = b.st[1];
        if (nloc == 0u) { xcd_barrier_complete(bar, b.x, nloc, nx); b.st[0] = nloc; b.st[1] = nx; }
        const unsigned old = xb_add(&bar[XB_XSUB(b.x)], 1u);
        const unsigned gen = old / nloc;
        if (old + 1u == (gen + 1u) * nloc) {
            __builtin_amdgcn_fence(__ATOMIC_RELEASE, "agent");
            asm volatile("s_waitcnt vmcnt(0)" ::: "memory");
            const unsigned og = xb_add(&bar[XB_TOP], 1u);
            const unsigned tg = og / nx;
            if (og + 1u == (tg + 1u) * nx) xb_add(&bar[XB_TOPGEN], 1u);
            else XB_SPIN(xb_ld(&bar[XB_TOPGEN]) == tg, bar);
            __builtin_amdgcn_fence(__ATOMIC_ACQUIRE, "agent");
            xb_add(&bar[XB_XGEN(b.x)], 1u);
            asm volatile("s_waitcnt vmcnt(0)" ::: "memory");
        } else {
            XB_SPIN(xb_ld(&bar[XB_XGEN(b.x)]) == gen, bar);
            __builtin_amdgcn_fence(__ATOMIC_ACQUIRE, "agent");
            asm volatile("s_waitcnt vmcnt(0)" ::: "memory");
        }
    }
    __syncthreads();
}

struct Args { const float* in[22]; float* out; unsigned char* ws; int ph_lo, ph_hi, li, pad; };
struct Frame {
    LAS unsigned char* lds; volatile LAS unsigned* MISC; gu32* ctl;
    int wave, vcu, G;
    unsigned char* ws;
};
__device__ __forceinline__ float wave_sum(float v) {
#pragma unroll
    for (int o = 1; o < 64; o <<= 1) v += __shfl_xor(v, o);
    return v;
}
struct TrDesc { const float* W; const float* gain; bf16_t* WT; int ldw, ldt, k0, n0; long drow0; };
__device__ __forceinline__ void tr_load(const TrDesc& d, f32x4 (&v)[16], int lane) {
    const int lr = lane >> 4, lc = (lane & 15) * 4;
#pragma unroll
    for (int i = 0; i < 16; ++i) v[i] = *(const GAS f32x4*)(d.W + (size_t)(d.k0 + 4 * i + lr) * d.ldw + d.n0 + lc);
}
#ifndef TRV
#define TRV 0
#endif
template <int V> __device__ __forceinline__ void tr_finish(const TrDesc& d, const f32x4 (&v)[16], LAS float* scr, int lane) {
    const int lr = lane >> 4, lc = (lane & 15) * 4;
    if (V == 1) { f32x4 s = v[0]; for (int i = 1; i < 16; ++i) s = s + v[i]; if (s.x == 1.2345e30f) *(GAS f32x4*)(d.WT) = s; return; }
#pragma unroll
    for (int i = 0; i < 16; ++i) { const int kk = 4 * i + lr; f32x4 x = v[i]; if (d.gain) x = x * d.gain[d.k0 + kk];
        LAS float* s = scr + kk * 65 + lc; s[0] = x.x; s[1] = x.y; s[2] = x.z; s[3] = x.w; }
    LDS_WAIT(); asm volatile("" ::: "memory");
    const int c = lane & 7;
#pragma unroll
    for (int j = 0; j < 8; ++j) { const int n = (lane >> 3) + 8 * j; const LAS float* s = scr + (8 * c) * 65 + n;
        u32x4 o; o.x = cvtpk(s[0 * 65], s[1 * 65]); o.y = cvtpk(s[2 * 65], s[3 * 65]); o.z = cvtpk(s[4 * 65], s[5 * 65]); o.w = cvtpk(s[6 * 65], s[7 * 65]);
        if (V == 0 || o.x == 0x12345678u) *(GAS u32x4*)(d.WT + (size_t)(d.drow0 + n) * d.ldt + d.k0 + 8 * c) = o; }
    LDS_WAIT(); asm volatile("" ::: "memory");
}
#ifndef TR_PIPE
#define TR_PIPE 0
#endif
constexpr int TR_DENSE = 32 * 20 + 9 * 32 * 16 + 32 * 4, TR_EXPERT = NE * 768;
__device__ __forceinline__ TrDesc tr_desc(karg_t ka, unsigned char* ws, int it, int mode) {
    TrDesc d; d.gain = nullptr;
    constexpr int I_IN = 32 * 20, I_SQ = 32 * 16;
    if (mode == 0) {
        int r = it;
        if (r < I_IN) { d.W = KIN(ka, 3); d.ldw = INW; d.WT = (bf16_t*)(ws + WS_WIN_T); d.ldt = DM; d.k0 = (r / 20) * 64; d.n0 = (r % 20) * 128; d.drow0 = d.n0; return d; } r -= I_IN;
        if (r < I_SQ) { d.W = KIN(ka, 7); d.ldw = DM; d.WT = (bf16_t*)(ws + WS_WOUT_T); d.ldt = DM; d.k0 = (r / 16) * 64; d.n0 = (r % 16) * 128; d.drow0 = d.n0; return d; } r -= I_SQ;
        if (r < 8 * I_SQ) { const int j = r / I_SQ, q = r % I_SQ, wsel = j >> 1, layer = j & 1;
            d.W = KIN(ka, 12 + wsel) + (size_t)layer * DM * DM; d.ldw = DM; if (wsel == 0) d.gain = KIN(ka, 10) + layer * DM;
            d.WT = (bf16_t*)(ws + (wsel == 0 ? WS_WCQ_T : wsel == 1 ? WS_WCK_T : wsel == 2 ? WS_WCV_T : WS_WCO_T) + (size_t)layer * DM * DM * 2); d.ldt = DM;
            d.k0 = (q / 16) * 64; d.n0 = (q % 16) * 128; d.drow0 = d.n0; return d; } r -= 8 * I_SQ;
        d.W = KIN(ka, 8); d.ldw = 512; d.WT = (bf16_t*)(ws + WS_WP_T); d.ldt = DM; d.k0 = (r / 4) * 64; d.n0 = (r % 4) * 128; d.drow0 = d.n0; return d;
    }
    const int layer = mode - 1;
    const int e = it / 768, r = it % 768; const size_t eo = (size_t)(layer * NE + e);
    if (r < 512) { const int up = r >> 8, q = r & 255, kb = q >> 3, nb = q & 7, n0 = nb * 128;
        d.W = (up ? KIN(ka, 19) : KIN(ka, 18)) + eo * DM * EFF; d.ldw = EFF; d.WT = (bf16_t*)(ws + (layer ? WS_WGU_T2 : WS_WGU_T)) + (size_t)e * 2048 * 2048; d.ldt = 2048;
        d.k0 = kb * 64; d.n0 = n0; d.drow0 = (long)(n0 >> 7) * 256 + up * 128;
    } else { const int q = r - 512, kb = q >> 4, nb = q & 15;
        d.W = KIN(ka, 20) + eo * EFF * DM; d.ldw = DM; d.WT = (bf16_t*)(ws + (layer ? WS_WD_T2 : WS_WD_T)) + (size_t)e * 2048 * 1024; d.ldt = 1024; d.k0 = kb * 64; d.n0 = nb * 128; d.drow0 = nb * 128; }
    return d;
}
template <int V = 0> __device__ __forceinline__ void tr_span(const Frame& F, karg_t ka, unsigned char* ws, int mode, int first, int stride, int cnt) {
    const int lane = lane_id(); LAS float* scr = (LAS float*)(F.lds + RING_OFF + F.wave * 16640);
    if (cnt <= 0) return;
    f32x4 va[16], vb[16];
    TrDesc da = tr_desc(ka, ws, first, mode), db = da; db.n0 += 64; db.drow0 += 64;
    tr_load(da, va, lane); tr_load(db, vb, lane);
    for (int j = 0; j < cnt; ++j) {
        const bool more = j + 1 < cnt; TrDesc na = da, nb = db;
        if (more) { na = tr_desc(ka, ws, first + stride * (j + 1), mode); nb = na; nb.n0 += 64; nb.drow0 += 64; }
        tr_finish<V>(da, va, scr, lane); if (more) tr_load(na, va, lane);
        tr_finish<V>(db, vb, scr, lane); if (more) tr_load(nb, vb, lane);
        da = na; db = nb;
    }
}
__device__ __forceinline__ void rms_row_to_bf16(const float* xrow, const float* __restrict__ gain, bf16_t* orow, int lane) {
    const GAS f32x4* xr = (const GAS f32x4*)xrow + lane; const f32x4* gr = (const f32x4*)gain + lane;
    f32x4 v[8]; float s = 0.f;
#pragma unroll
    for (int j = 0; j < 8; ++j) { v[j] = xr[64 * j]; s += (v[j].x * v[j].x + v[j].y * v[j].y) + (v[j].z * v[j].z + v[j].w * v[j].w); }
    const float r = rsqrtf(wave_sum(s) * (1.f / DM) + EPS);
    GAS u32x2* o8 = (GAS u32x2*)orow + lane;
#pragma unroll
    for (int j = 0; j < 8; ++j) { const f32x4 g = gr[64 * j]; u32x2 w; w.x = cvtpk(v[j].x * r * g.x, v[j].y * r * g.y); w.y = cvtpk(v[j].z * r * g.z, v[j].w * r * g.w); o8[64 * j] = w; }
}

__device__ __forceinline__ void p0_prologue(Frame& F, karg_t ka, unsigned char* ws) {
    const float* x = KIN(ka, 0); const float* mem = KIN(ka, 1); const float* mix_norm = KIN(ka, 2); const float* w_in = KIN(ka, 3);
    const float* w_four = KIN(ka, 6); const float* w_out = KIN(ka, 7); const float* pool_w = KIN(ka, 8); const float* cross_norm = KIN(ka, 10); const float* mem_norm = KIN(ka, 11);
    const int gw = F.vcu * NWAVES + F.wave, NGW = F.G * NWAVES;
    const int p_lane = lane_id(), p_tid = F.wave * 64 + p_lane;
    { LAS float* tab = (LAS float*)(F.lds + RING_OFF);
      for (int m = p_tid; m < 2048; m += 512) tab[m] = cosf(6.283185307179586f * (float)m * (1.0f / 2048.0f));
      __syncthreads();
      bf16_t* DFT = (bf16_t*)(ws + WS_DFT);
      for (int row = F.vcu * 8; row < 2048; row += F.G * 8)
          for (int rr = 0; rr < 8; ++rr) { const int k1 = row + rr; if (k1 >= 2048) break;
              { const int c0 = p_tid * 8; const int which = c0 >> 11, s0 = c0 & 2047; unsigned w[4];
#pragma unroll
                for (int j = 0; j < 4; ++j) { const int ma = (k1 * (s0 + 2 * j)) & 2047, mb = (k1 * (s0 + 2 * j + 1)) & 2047;
                    w[j] = cvtpk(tab[(ma - which * 512) & 2047], tab[(mb - which * 512) & 2047]); }
                *(GAS u32x4*)(DFT + (size_t)k1 * 4096 + c0) = (u32x4){w[0], w[1], w[2], w[3]}; } }
      __syncthreads(); }
    { float* RC = (float*)(ws + WS_ROPE); float* RS = RC + SEQ * 64;
      for (int i = F.vcu * 512 + p_tid; i < SEQ * 64; i += F.G * 512) { const int t = i >> 6, p = i & 63; const int pos = (p < 32) ? (t >> 6) : (t & 63); const int j = p & 31;
          const float inv = 1.0f / powf(10000.0f, (float)(2 * j) / 64.0f); const float ang = (float)pos * inv; RC[i] = cosf(ang); RS[i] = sinf(ang); } }
    { LAS float* Mw = (LAS float*)(F.lds + RING_OFF); LAS float* t128 = Mw + 128 * 32;
      bf16_t* WF = (bf16_t*)(ws + WS_WF_T);
      for (int it = F.vcu; it < 256; it += F.G) {
          const int which = it >> 7, g = (it >> 5) & 3, d0 = ((it >> 3) & 3) * 32, k0 = (it & 7) * 256;
          if (p_tid < 128) t128[p_tid] = cosf(6.283185307179586f * (float)p_tid * (1.0f / 128.0f));
          __syncthreads();
          { const int c = p_tid >> 2, dd = (p_tid & 3) * 8; float o[8] = {0.f, 0.f, 0.f, 0.f, 0.f, 0.f, 0.f, 0.f};
            for (int k2 = 0; k2 < 128; ++k2) { const int m = (c * k2) & 127; const float tv = which ? -t128[(m - 32) & 127] : t128[m];
                const float* wr_ = w_four + ((size_t)g * 128 + k2) * 128 + d0 + dd; const f32x4 w0 = *(const f32x4*)wr_, w1 = *(const f32x4*)(wr_ + 4);
                o[0] += tv * w0.x; o[1] += tv * w0.y; o[2] += tv * w0.z; o[3] += tv * w0.w; o[4] += tv * w1.x; o[5] += tv * w1.y; o[6] += tv * w1.z; o[7] += tv * w1.w; }
#pragma unroll
            for (int j = 0; j < 8; ++j) Mw[c * 32 + dd + j] = o[j] * (1.0f / 512.0f); }
          __syncthreads();
          { const int kp = p_tid & 127, dq = p_tid >> 7, k = k0 + 2 * kp; float o0[8] = {0.f, 0.f, 0.f, 0.f, 0.f, 0.f, 0.f, 0.f}, o1[8] = {0.f, 0.f, 0.f, 0.f, 0.f, 0.f, 0.f, 0.f};
            const float* r0 = w_in + (size_t)k * INW + 2560 + g * 128; const float* r1 = r0 + INW;
            for (int c4 = 0; c4 < 32; ++c4) { const f32x4 a = *(const f32x4*)(r0 + 4 * c4), b = *(const f32x4*)(r1 + 4 * c4); const float av[4] = {a.x, a.y, a.z, a.w}, bv[4] = {b.x, b.y, b.z, b.w};
#pragma unroll
                for (int cc = 0; cc < 4; ++cc) { const LAS float* mr = Mw + (4 * c4 + cc) * 32 + dq * 8;
#pragma unroll
                    for (int j = 0; j < 8; ++j) { o0[j] += av[cc] * mr[j]; o1[j] += bv[cc] * mr[j]; } } }
#pragma unroll
            for (int j = 0; j < 8; ++j) *(GAS unsigned*)(WF + (size_t)(which * 512 + g * 128 + d0 + dq * 8 + j) * DM + k) = cvtpk(o0[j], o1[j]); }
          __syncthreads(); } }
    { const int n = (TR_DENSE - gw + NGW - 1) / NGW; tr_span(F, ka, ws, 0, gw, NGW, n > 0 ? n : 0); }
    __syncthreads();
    for (int m = gw; m < NTOK; m += NGW) rms_row_to_bf16(x + (size_t)m * DM, mix_norm, (bf16_t*)(ws + WS_HN) + (size_t)m * DM, p_lane);
    for (int m = gw; m < 2 * NB * MEML; m += NGW) { const int l = m / (NB * MEML), r = m % (NB * MEML);
        rms_row_to_bf16(mem + (size_t)r * DM, mem_norm + l * DM, (bf16_t*)(ws + WS_MEMNB) + (size_t)m * DM, p_lane); }
}

struct MapLin { const char* A; const char* B; size_t as, bs; __device__ __forceinline__ void operator()(pg8::Unit& u) const { u.a = A + (size_t)u.pm * as; u.b = B + (size_t)u.pn * bs; } };

struct EpiQKV {
    static constexpr bool PERM = true;
    bf16_t* Q; bf16_t* K; bf16_t* V; const float* qg; const float* kg; const float* RC; const float* RS;
    __device__ __forceinline__ void operator()(f32x4 (&acc)[2][2][4][2], const pg8::Unit& u, const pg8::EpiCtx& c) const { const int e_lane = lane_id(), e_fr = e_lane & 15, e_fq = e_lane >> 4;
        const int pn = u.pn, hc = c.wc * 32 + e_fq * 8, rl0 = c.wr * 64 + e_fr;
        if (pn >= 8) {
            bf16_t* base = V + (size_t)(u.pm * 256 + rl0) * KVW + (pn - 8) * 256 + hc;
#pragma unroll
            for (int ai = 0; ai < 2; ++ai)
#pragma unroll
                for (int m = 0; m < 4; ++m) { bf16_t* rowp = base + (size_t)(ai * 128 + m * 16) * KVW;
#pragma unroll
                    for (int bj = 0; bj < 2; ++bj) { const f32x4 v0 = acc[ai][bj][m][0], v1 = acc[ai][bj][m][1];
                        *(u32x4*)(rowp + bj * 128) = (u32x4){cvtpk(v0.x, v0.y), cvtpk(v0.z, v0.w), cvtpk(v1.x, v1.y), cvtpk(v1.z, v1.w)}; } }
            return;
        }
        LAS float* part = (LAS float*)c.xl;
#pragma unroll
        for (int ai = 0; ai < 2; ++ai)
#pragma unroll
            for (int m = 0; m < 4; ++m)
#pragma unroll
                for (int bj = 0; bj < 2; ++bj) { const f32x4 v0 = acc[ai][bj][m][0], v1 = acc[ai][bj][m][1];
                    float s = (v0.x * v0.x + v0.y * v0.y) + (v0.z * v0.z + v0.w * v0.w) + (v1.x * v1.x + v1.y * v1.y) + (v1.z * v1.z + v1.w * v1.w);
                    s += __shfl_xor(s, 16); s += __shfl_xor(s, 32);
                    if (e_fq == 0) part[((ai * 128 + rl0 + m * 16) * 2 + bj) * 4 + c.wc] = s; }
        WG_BAR();
        const float* gain = pn < 6 ? qg : kg;
        const f32x4 g0 = *(const f32x4*)(gain + hc), g1 = *(const f32x4*)(gain + hc + 4);
        bf16_t* O = pn < 6 ? Q : K; const int ld = pn < 6 ? AW : KVW; const int colbase = (pn < 6 ? pn : pn - 6) * 256 + hc;
#pragma unroll
        for (int ai = 0; ai < 2; ++ai)
#pragma unroll
            for (int m = 0; m < 4; ++m) { const int rl = ai * 128 + rl0 + m * 16, row = u.pm * 256 + rl, sp = row & (SEQ - 1);
                const f32x4 cs = *(const f32x4*)(RC + sp * 64 + (hc >> 1)), sn = *(const f32x4*)(RS + sp * 64 + (hc >> 1));
#pragma unroll
                for (int bj = 0; bj < 2; ++bj) { const f32x4 p4 = *(const LAS f32x4*)(part + (rl * 2 + bj) * 4);
                    const float r = rsqrtf(((p4.x + p4.y) + (p4.z + p4.w)) * (1.0f / 128.0f) + EPS);
                    const f32x4 v0 = acc[ai][bj][m][0] * r * g0, v1 = acc[ai][bj][m][1] * r * g1;
                    u32x4 w; w.x = cvtpk(v0.x * cs.x - v0.y * sn.x, v0.x * sn.x + v0.y * cs.x); w.y = cvtpk(v0.z * cs.y - v0.w * sn.y, v0.z * sn.y + v0.w * cs.y);
                    w.z = cvtpk(v1.x * cs.z - v1.y * sn.z, v1.x * sn.z + v1.y * cs.z); w.w = cvtpk(v1.z * cs.w - v1.w * sn.w, v1.z * sn.w + v1.w * cs.w);
                    *(u32x4*)(O + (size_t)row * ld + colbase + bj * 128) = w; } }
    }
};


template <class AddrF> struct EpiStore {
    static constexpr bool PERM = true; AddrF f;
    __device__ __forceinline__ void operator()(f32x4 (&acc)[2][2][4][2], const pg8::Unit& u, const pg8::EpiCtx& c) const { const int e_lane = lane_id(), e_fr = e_lane & 15, e_fq = e_lane >> 4;
        const int hc = c.wc * 32 + e_fq * 8, rl0 = c.wr * 64 + e_fr;
#pragma unroll
        for (int ai = 0; ai < 2; ++ai)
#pragma unroll
            for (int m = 0; m < 4; ++m)
#pragma unroll
                for (int bj = 0; bj < 2; ++bj) { const f32x4 v0 = acc[ai][bj][m][0], v1 = acc[ai][bj][m][1];
                    *(u32x4*)f(u, ai * 128 + rl0 + m * 16, bj * 128 + hc) = (u32x4){cvtpk(v0.x, v0.y), cvtpk(v0.z, v0.w), cvtpk(v1.x, v1.y), cvtpk(v1.z, v1.w)}; }
    }
};
struct AddrF1 { bf16_t* FPQ; __device__ __forceinline__ bf16_t* operator()(const pg8::Unit& u, int rl, int tc) const {
    const int r = u.pm * 256 + rl, which = r >> 9, n = r & 511, cidx = u.pn * 256 + tc, b = cidx >> 11, s = cidx & 2047; return FPQ + (((size_t)(b * 512 + n) * 2 + which) * 2048 + s); } };
struct AddrF2 { bf16_t* MIX; __device__ __forceinline__ bf16_t* operator()(const pg8::Unit& u, int rl, int tc) const {
    const int row = (u.pn >> 1) * 2048 + u.pm * 256 + rl, col = AW + (u.pn & 1) * 256 + tc; return MIX + (size_t)row * DM + col; } };

struct EpiRes {
    static constexpr bool PERM = false;
    const float* base; float* out; bf16_t* xb; float* ssp; const float* cscale; int npn;
    __device__ __forceinline__ void operator()(f32x4 (&acc)[2][2][4][2], const pg8::Unit& u, const pg8::EpiCtx& c) const { const int e_lane = lane_id(), e_fr = e_lane & 15, e_fq = e_lane >> 4;
        const int col0 = u.pn * 256 + c.wc * 32 + 4 * e_fq, rl0 = c.wr * 64 + e_fr;
        LAS float* part = (LAS float*)c.xl;
#pragma unroll
        for (int ai = 0; ai < 2; ++ai)
#pragma unroll
            for (int m = 0; m < 4; ++m) { const int rl = ai * 128 + rl0 + m * 16; const size_t off = (size_t)(u.pm * 256 + rl) * DM + col0; float s = 0.f;
#pragma unroll
                for (int bj = 0; bj < 2; ++bj)
#pragma unroll
                    for (int n = 0; n < 2; ++n) { const size_t o2 = off + bj * 128 + n * 16; f32x4 v = acc[ai][bj][m][n];
                        if (cscale) v = v * *(const f32x4*)(cscale + col0 + bj * 128 + n * 16);
                        v = v + *(const f32x4*)(base + o2);
                        *(f32x4*)(out + o2) = v;
                        if (xb) { *(u32x2*)(xb + o2) = (u32x2){cvtpk(v.x, v.y), cvtpk(v.z, v.w)}; s += (v.x * v.x + v.y * v.y) + (v.z * v.z + v.w * v.w); } }
                if (xb) { s += __shfl_xor(s, 16); s += __shfl_xor(s, 32); if (e_fq == 0) part[rl * 4 + c.wc] = s; }
                asm volatile("" ::: "memory"); }
        if (xb) { WG_BAR();
            if (e_lane < 32) { const int row = c.wid * 32 + e_lane; const f32x4 p4 = *(const LAS f32x4*)(part + row * 4);
                ssp[(size_t)(u.pm * 256 + row) * npn + u.pn] = (p4.x + p4.y) + (p4.z + p4.w); }
            WG_BAR(); }
    }
};

namespace attn {
using s16x4 = __attribute__((ext_vector_type(4))) short;
using f32x16 = __attribute__((ext_vector_type(16))) float;
constexpr int D = 128, NW = 8, QBLK = 32, KVBLK = 64;
constexpr float SCALE = 0.088388347648318440f;
constexpr float THR = 0.f;
#ifndef ATT_SDEPTH
#define ATT_SDEPTH 1
#endif
constexpr int LDQ = AW, LDK = KVW, LDO = DM;
constexpr size_t SHM_V = KVBLK * D * 2, SHM_K = KVBLK * D * 2, SHM_ATTN = 2 * SHM_V + 2 * SHM_K + NW * 64 * 4;
#define KSWZ(row, colB) ((row) * 256 + ((colB) ^ (((row) & 7) << 4)))
#define SBAR() __builtin_amdgcn_sched_barrier(0)
__device__ __forceinline__ int crow(int r, int hi) { return (r & 3) + 8 * (r >> 2) + 4 * hi; }
__device__ __forceinline__ unsigned cvtpk_a(float lo, float hi) { unsigned r; asm volatile("v_cvt_pk_bf16_f32 %0, %1, %2" : "=v"(r) : "v"(lo), "v"(hi)); return r; }
__device__ __forceinline__ void partialSM(f32x16& p0, f32x16& p1, float& m_reg, float& mn, float& alpha) {
  constexpr float C = SCALE * 1.4426950408889634f;
  float pmax = p0[0]; for (int r = 1; r < 16; ++r) pmax = fmaxf(pmax, p0[r]); for (int r = 0; r < 16; ++r) pmax = fmaxf(pmax, p1[r]);
  { auto rr = __builtin_amdgcn_permlane32_swap(__float_as_uint(pmax), __float_as_uint(pmax), false, false);
    pmax = fmaxf(__uint_as_float(rr[0]), __uint_as_float(rr[1])); }
  if (__builtin_expect(__all(pmax - m_reg <= THR / SCALE), 1)) { mn = m_reg; alpha = 1.f; }
  else { mn = fmaxf(m_reg, pmax); alpha = __builtin_amdgcn_exp2f((m_reg - mn) * C); m_reg = mn; }
  float mnC = -mn * C;
  for (int r = 0; r < 16; ++r) p0[r] = fmaf(p0[r], C, mnC); for (int r = 0; r < 16; ++r) p1[r] = fmaf(p1[r], C, mnC);
  for (int r = 0; r < 16; ++r) p0[r] = __builtin_amdgcn_exp2f(p0[r]);
}
__device__ __forceinline__ void finishSM(f32x16& p0, f32x16& p1, float alpha, float& l_reg, bf16x8& pa0, bf16x8& pa1, bf16x8& pa2, bf16x8& pa3) {
  for (int r = 0; r < 16; ++r) p1[r] = __builtin_amdgcn_exp2f(p1[r]);
  float ps = 0; for (int r = 0; r < 16; ++r) ps += p0[r]; for (int r = 0; r < 16; ++r) ps += p1[r];
  { auto rr = __builtin_amdgcn_permlane32_swap(__float_as_uint(ps), __float_as_uint(ps), false, false);
    ps = __uint_as_float(rr[0]) + __uint_as_float(rr[1]); }
  l_reg = l_reg * alpha + ps;
#define PK4(P, BASE, OUT) do { unsigned a0 = cvtpk_a(P[BASE + 0], P[BASE + 1]), a1 = cvtpk_a(P[BASE + 2], P[BASE + 3]);   \
    unsigned b0 = cvtpk_a(P[BASE + 4], P[BASE + 5]), b1 = cvtpk_a(P[BASE + 6], P[BASE + 7]);                              \
    auto r0 = __builtin_amdgcn_permlane32_swap(a0, b0, false, false); auto r1 = __builtin_amdgcn_permlane32_swap(a1, b1, false, false); \
    u32x4 w = {r0[0], r1[0], r0[1], r1[1]}; OUT = *reinterpret_cast<bf16x8*>(&w); } while (0)
  PK4(p0, 0, pa0); PK4(p0, 8, pa1); PK4(p1, 0, pa2); PK4(p1, 8, pa3);
#undef PK4
}
__device__ __forceinline__ void qkt(f32x16& p0, f32x16& p1, const bf16_t* Ks, const bf16x8* qr, int r32, int hi) {
  p0 = f32x16{}; p1 = f32x16{};
  for (int d0 = 0; d0 < 8; ++d0) { int cb = (d0 * 16 + hi * 8) * 2;
    bf16x8 b0 = *reinterpret_cast<const bf16x8*>((const char*)Ks + KSWZ(r32, cb));
    bf16x8 b1 = *reinterpret_cast<const bf16x8*>((const char*)Ks + KSWZ(32 + r32, cb));
    p0 = __builtin_amdgcn_mfma_f32_32x32x16_bf16(b0, qr[d0], p0, 0, 0, 0);
    p1 = __builtin_amdgcn_mfma_f32_32x32x16_bf16(b1, qr[d0], p1, 0, 0, 0); }
}
__device__ __forceinline__ int v_st(int k, int c) { const int kk = (k & ~0xC) | ((k & 4) << 1) | ((k & 8) >> 1); return ((kk >> 3) * 4 + (c >> 5)) * 512 + ((kk & 7) * 32 + (c & 31)) * 2; }
__device__ __forceinline__ int v_rd_base(int lane) { return ((lane & 3) << 3) | (((lane >> 2) & 3) << 6) | (((lane >> 4) & 1) << 5) | (((lane >> 5) & 1) << 8); }
constexpr int v_rd_off(int d0, int ks, int half) { return d0 * 512 + ks * 4096 + half * 2048; }
template <int OFF> __device__ __forceinline__ s16x4 tr_read(int vb) {
  s16x4 r; asm volatile("ds_read_b64_tr_b16 %0, %1 offset:%2" : "=&v"(r) : "v"(vb), "i"(OFF) : "memory"); return r;
}
template <int D0> __device__ __forceinline__ void pv_one(f32x16& od, int vb, bf16x8 pa0, bf16x8 pa1, bf16x8 pa2, bf16x8 pa3) {
  const s16x4 l0 = tr_read<v_rd_off(D0, 0, 0)>(vb), h0 = tr_read<v_rd_off(D0, 0, 1)>(vb), l1 = tr_read<v_rd_off(D0, 1, 0)>(vb), h1 = tr_read<v_rd_off(D0, 1, 1)>(vb);
  const s16x4 l2 = tr_read<v_rd_off(D0, 2, 0)>(vb), h2 = tr_read<v_rd_off(D0, 2, 1)>(vb), l3 = tr_read<v_rd_off(D0, 3, 0)>(vb), h3 = tr_read<v_rd_off(D0, 3, 1)>(vb);
  asm volatile("s_waitcnt lgkmcnt(0)" ::: "memory"); SBAR();
#define PK(L, H) (bf16x8){L[0], L[1], L[2], L[3], H[0], H[1], H[2], H[3]}
  od = __builtin_amdgcn_mfma_f32_32x32x16_bf16(pa0, PK(l0, h0), od, 0, 0, 0);
  od = __builtin_amdgcn_mfma_f32_32x32x16_bf16(pa1, PK(l1, h1), od, 0, 0, 0);
  od = __builtin_amdgcn_mfma_f32_32x32x16_bf16(pa2, PK(l2, h2), od, 0, 0, 0);
  od = __builtin_amdgcn_mfma_f32_32x32x16_bf16(pa3, PK(l3, h3), od, 0, 0, 0);
#undef PK
}
__device__ __forceinline__ void pv_d0(f32x16* o, int vb, bf16x8 pa0, bf16x8 pa1, bf16x8 pa2, bf16x8 pa3) {
  pv_one<0>(o[0], vb, pa0, pa1, pa2, pa3); pv_one<1>(o[1], vb, pa0, pa1, pa2, pa3); pv_one<2>(o[2], vb, pa0, pa1, pa2, pa3); pv_one<3>(o[3], vb, pa0, pa1, pa2, pa3);
}
__device__ __forceinline__ void attn_dense_body(const bf16_t* __restrict__ Qb, const bf16_t* __restrict__ Kh, const bf16_t* __restrict__ Vh,
                                                bf16_t* __restrict__ Ob, int seq, char* lds, const int wave_) {
  constexpr int SDEPTH = ATT_SDEPTH;
  const int lane = lane_id(), wid = wave_, tid = wid * 64 + lane, r32 = lane & 31, hi = lane >> 5;
  bf16_t* V_lds = (bf16_t*)lds; bf16_t* K_lds = (bf16_t*)(lds + 2 * SHM_V);
  float* ws = (float*)(lds + 2 * SHM_V + 2 * SHM_K) + wid * 64; float* li_l = ws; float* al_l = ws + 32;
  float m_reg = -1e30f, l_reg = 0; f32x16 o[4] = {}; bf16x8 qr[8];
  const bf16_t* Qw = Qb + (long)(wid * QBLK + r32) * LDQ + hi * 8;
#pragma unroll
  for (int d0 = 0; d0 < 8; ++d0) qr[d0] = *reinterpret_cast<const bf16x8*>(Qw + d0 * 16);
  const int sr = tid >> 4, sc = (tid & 15) * 8, vst0 = v_st(sr, sc), vst1 = v_st(32 + sr, sc);
  const int vb0 = (int)(uintptr_t)V_lds + v_rd_base(lane);
  struct { bf16x8 vs0, vs1, ks0, ks1; } sr_[SDEPTH];
#define SLOAD(i, k0) do { sr_[i].vs0 = *reinterpret_cast<const bf16x8*>(&Vh[(long)((k0) + sr) * LDK + sc]); sr_[i].vs1 = *reinterpret_cast<const bf16x8*>(&Vh[(long)((k0) + 32 + sr) * LDK + sc]); \
    sr_[i].ks0 = *reinterpret_cast<const bf16x8*>(&Kh[(long)((k0) + sr) * LDK + sc]); sr_[i].ks1 = *reinterpret_cast<const bf16x8*>(&Kh[(long)((k0) + 32 + sr) * LDK + sc]); } while (0)
#define SWRITE(b, i) do { *(bf16x8*)((char*)V_lds + (b) * SHM_V + vst0) = sr_[i].vs0;          \
    *(bf16x8*)((char*)V_lds + (b) * SHM_V + vst1) = sr_[i].vs1; int kc = sc * 2;               \
    *(bf16x8*)((char*)K_lds + (b) * SHM_K + KSWZ(sr, kc)) = sr_[i].ks0;                       \
    *(bf16x8*)((char*)K_lds + (b) * SHM_K + KSWZ(32 + sr, kc)) = sr_[i].ks1; } while (0)
#define SWAIT() do { if constexpr (SDEPTH == 2) asm volatile("s_waitcnt vmcnt(4)" ::: "memory"); else asm volatile("s_waitcnt vmcnt(0)" ::: "memory"); } while (0)
#define RESC(a) do { if (__any((a) < 1.f)) { if (hi == 0) al_l[r32] = (a); asm volatile("s_waitcnt lgkmcnt(0)" ::: "memory"); \
    for (int d = 0; d < 4; ++d) for (int r = 0; r < 16; ++r) o[d][r] *= al_l[crow(r, hi)]; } } while (0)
  f32x16 pA0, pA1, pB0, pB1; float mnA, mnB, alA, alB; bf16x8 pa0, pa1, pa2, pa3; const int NT = seq / KVBLK;
  constexpr int SE = 0, SO = SDEPTH - 1;
  SLOAD(SE, 0); asm volatile("s_waitcnt vmcnt(0)" ::: "memory"); SWRITE(0, SE); __syncthreads();
  qkt(pA0, pA1, K_lds, qr, r32, hi); partialSM(pA0, pA1, m_reg, mnA, alA);
  SLOAD(SO, KVBLK); if constexpr (SDEPTH == 2) { if (2 < NT) SLOAD(SE, 2 * KVBLK); }
  SWAIT(); SWRITE(1, SO); __syncthreads();
  for (int j = 1; j + 1 < NT; j += 2) {
    SBAR(); qkt(pB0, pB1, (bf16_t*)((char*)K_lds + SHM_K), qr, r32, hi);
    finishSM(pA0, pA1, alA, l_reg, pa0, pa1, pa2, pa3); SBAR();
    SLOAD(SO, (j + SDEPTH) * KVBLK); SBAR();
    pv_d0(o, vb0, pa0, pa1, pa2, pa3); partialSM(pB0, pB1, m_reg, mnB, alB);
    __syncthreads(); SWAIT(); SWRITE(0, SE);
    RESC(alB); __syncthreads();
    SBAR(); qkt(pA0, pA1, K_lds, qr, r32, hi);
    finishSM(pB0, pB1, alB, l_reg, pa0, pa1, pa2, pa3); SBAR();
    if (SDEPTH == 1 || j + 3 < NT) SLOAD(SE, (j + 1 + SDEPTH) * KVBLK); SBAR();
    pv_d0(o, vb0 + (int)SHM_V, pa0, pa1, pa2, pa3); partialSM(pA0, pA1, m_reg, mnA, alA);
    __syncthreads(); SWAIT(); SWRITE(1, SO);
    RESC(alA); __syncthreads();
  }
  SBAR(); qkt(pB0, pB1, (bf16_t*)((char*)K_lds + SHM_K), qr, r32, hi);
  finishSM(pA0, pA1, alA, l_reg, pa0, pa1, pa2, pa3); SBAR();
  pv_d0(o, vb0, pa0, pa1, pa2, pa3); partialSM(pB0, pB1, m_reg, mnB, alB);
  __syncthreads(); RESC(alB);
  finishSM(pB0, pB1, alB, l_reg, pa0, pa1, pa2, pa3); SBAR();
  pv_d0(o, vb0 + (int)SHM_V, pa0, pa1, pa2, pa3);
  if (hi == 0) li_l[r32] = l_reg; asm volatile("s_waitcnt lgkmcnt(0)" ::: "memory");
  float rli[16];
#pragma unroll
  for (int r = 0; r < 16; ++r) rli[r] = __builtin_amdgcn_rcpf(li_l[crow(r, hi)]);
  bf16_t* Ow = Ob + (long)(wid * QBLK) * LDO;
#pragma unroll
  for (int r = 0; r < 16; ++r) { int orow = crow(r, hi);
    for (int d0 = 0; d0 < 4; ++d0) Ow[(long)orow * LDO + d0 * 32 + r32] = (bf16_t)(cvtpk(o[d0][r] * rli[r], 0.f) & 0xffffu); }
#undef SLOAD
#undef SWRITE
#undef SWAIT
#undef RESC
  __syncthreads();
}
#undef KSWZ
#undef SBAR
}

struct AddrLin { bf16_t* O; int ld; __device__ __forceinline__ bf16_t* operator()(const pg8::Unit& u, int rl, int tc) const { return O + (size_t)(u.pm * 256 + rl) * ld + u.pn * 256 + tc; } };
struct EpiRowScale {
    static constexpr bool PERM = true; bf16_t* O; int ld; const float* ssp; float cscale;
    __device__ __forceinline__ void operator()(f32x4 (&acc)[2][2][4][2], const pg8::Unit& u, const pg8::EpiCtx& c) const { const int e_lane = lane_id(), e_fr = e_lane & 15, e_fq = e_lane >> 4;
        const int hc = c.wc * 32 + e_fq * 8, rl0 = c.wr * 64 + e_fr;
#pragma unroll
        for (int ai = 0; ai < 2; ++ai)
#pragma unroll
            for (int m = 0; m < 4; ++m) { const int row = u.pm * 256 + ai * 128 + rl0 + m * 16; const f32x4 p0 = *(const f32x4*)(ssp + (size_t)row * 8), p1 = *(const f32x4*)(ssp + (size_t)row * 8 + 4);
                const float r = rsqrtf((((p0.x + p0.y) + (p0.z + p0.w)) + ((p1.x + p1.y) + (p1.z + p1.w))) * (1.0f / DM) + EPS) * cscale;
#pragma unroll
                for (int bj = 0; bj < 2; ++bj) { const f32x4 v0 = acc[ai][bj][m][0] * r, v1 = acc[ai][bj][m][1] * r;
                    *(u32x4*)(O + (size_t)row * ld + u.pn * 256 + bj * 128 + hc) = (u32x4){cvtpk(v0.x, v0.y), cvtpk(v0.z, v0.w), cvtpk(v1.x, v1.y), cvtpk(v1.z, v1.w)}; } }
    }
};
struct EpiSoftmax {
    static constexpr bool PERM = true; bf16_t* P; int ld;
    __device__ __forceinline__ void operator()(f32x4 (&acc)[2][2][4][2], const pg8::Unit& u, const pg8::EpiCtx& c) const { const int e_lane = lane_id(), e_fr = e_lane & 15, e_fq = e_lane >> 4;
        const int hc = c.wc * 32 + e_fq * 8, rl0 = c.wr * 64 + e_fr;
        LAS float* pmx = (LAS float*)c.xl; LAS float* psm = pmx + 1024;
#pragma unroll
        for (int ai = 0; ai < 2; ++ai)
#pragma unroll
            for (int m = 0; m < 4; ++m) { float mx = -3.0e38f;
#pragma unroll
                for (int bj = 0; bj < 2; ++bj)
#pragma unroll
                    for (int n = 0; n < 2; ++n) { const f32x4 v = acc[ai][bj][m][n]; mx = fmaxf(fmaxf(mx, fmaxf(v.x, v.y)), fmaxf(v.z, v.w)); }
                mx = fmaxf(mx, __shfl_xor(mx, 16)); mx = fmaxf(mx, __shfl_xor(mx, 32));
                if (e_fq == 0) pmx[(ai * 128 + rl0 + m * 16) * 4 + c.wc] = mx; }
        WG_BAR();
#pragma unroll
        for (int ai = 0; ai < 2; ++ai)
#pragma unroll
            for (int m = 0; m < 4; ++m) { const int rl = ai * 128 + rl0 + m * 16; const f32x4 p4 = *(const LAS f32x4*)(pmx + rl * 4);
                const float mx = fmaxf(fmaxf(p4.x, p4.y), fmaxf(p4.z, p4.w)) * 1.4426950408889634f; float s = 0.f;
#pragma unroll
                for (int bj = 0; bj < 2; ++bj)
#pragma unroll
                    for (int n = 0; n < 2; ++n) { f32x4 v = acc[ai][bj][m][n];
                        v.x = __builtin_amdgcn_exp2f(fmaf(v.x, 1.4426950408889634f, -mx)); v.y = __builtin_amdgcn_exp2f(fmaf(v.y, 1.4426950408889634f, -mx));
                        v.z = __builtin_amdgcn_exp2f(fmaf(v.z, 1.4426950408889634f, -mx)); v.w = __builtin_amdgcn_exp2f(fmaf(v.w, 1.4426950408889634f, -mx));
                        s += (v.x + v.y) + (v.z + v.w); acc[ai][bj][m][n] = v; }
                s += __shfl_xor(s, 16); s += __shfl_xor(s, 32);
                if (e_fq == 0) psm[rl * 4 + c.wc] = s; }
        WG_BAR();
#pragma unroll
        for (int ai = 0; ai < 2; ++ai)
#pragma unroll
            for (int m = 0; m < 4; ++m) { const int rl = ai * 128 + rl0 + m * 16; const f32x4 p4 = *(const LAS f32x4*)(psm + rl * 4);
                const float inv = 1.0f / ((p4.x + p4.y) + (p4.z + p4.w));
#pragma unroll
                for (int bj = 0; bj < 2; ++bj) { const f32x4 v0 = acc[ai][bj][m][0] * inv, v1 = acc[ai][bj][m][1] * inv;
                    *(u32x4*)(P + (size_t)(u.pm * 256 + rl) * ld + u.pn * 256 + bj * 128 + hc) = (u32x4){cvtpk(v0.x, v0.y), cvtpk(v0.z, v0.w), cvtpk(v1.x, v1.y), cvtpk(v1.z, v1.w)}; } }
        WG_BAR();
    }
};
struct MapXS { const char* Q; const char* K; __device__ __forceinline__ void operator()(pg8::Unit& u) const {
    u.a = Q + ((size_t)u.pm * 256 * DM + (size_t)u.pn * MHD) * 2; u.b = K + ((size_t)(u.pm >> 3) * MEML * DM + (size_t)u.pn * MHD) * 2; } };
struct MapXPV { const char* P; const char* VT; __device__ __forceinline__ void operator()(pg8::Unit& u) const {
    u.a = P + ((size_t)u.pm * 256 * 1024 + (size_t)(u.pn >> 1) * MEML) * 2; u.b = VT + ((size_t)u.pn * 256 * 1024 + (size_t)(u.pm >> 3) * MEML) * 2; } };

struct MapMoE { const char* A; const char* W; size_t as, es, ws_; __device__ __forceinline__ void operator()(pg8::Unit& u) const {
    u.a = A + (size_t)u.pm * as; u.b = W + (size_t)(u.pm >> 2) * es + (size_t)u.pn * ws_; } };
struct EpiSwiGLU {
    static constexpr bool PERM = true; bf16_t* ACT;
    __device__ __forceinline__ void operator()(f32x4 (&acc)[2][2][4][2], const pg8::Unit& u, const pg8::EpiCtx& c) const { const int e_lane = lane_id(), e_fr = e_lane & 15, e_fq = e_lane >> 4;
        const int hc = c.wc * 32 + e_fq * 8, rl0 = c.wr * 64 + e_fr;
#pragma unroll
        for (int ai = 0; ai < 2; ++ai)
#pragma unroll
            for (int m = 0; m < 4; ++m) { f32x4 o[2];
#pragma unroll
                for (int n = 0; n < 2; ++n) { const f32x4 g = acc[ai][0][m][n], up = acc[ai][1][m][n]; f32x4 r;
                    r.x = g.x * __builtin_amdgcn_rcpf(1.0f + __builtin_amdgcn_exp2f(-1.4426950408889634f * g.x)) * up.x; r.y = g.y * __builtin_amdgcn_rcpf(1.0f + __builtin_amdgcn_exp2f(-1.4426950408889634f * g.y)) * up.y;
                    r.z = g.z * __builtin_amdgcn_rcpf(1.0f + __builtin_amdgcn_exp2f(-1.4426950408889634f * g.z)) * up.z; r.w = g.w * __builtin_amdgcn_rcpf(1.0f + __builtin_amdgcn_exp2f(-1.4426950408889634f * g.w)) * up.w; o[n] = r; }
                *(u32x4*)(ACT + (size_t)(u.pm * 256 + ai * 128 + rl0 + m * 16) * EFF + u.pn * 128 + hc) = (u32x4){cvtpk(o[0].x, o[0].y), cvtpk(o[0].z, o[0].w), cvtpk(o[1].x, o[1].y), cvtpk(o[1].z, o[1].w)}; }
    }
};
struct EpiRowGate {
    static constexpr bool PERM = true; bf16_t* Y; const float* gate;
    __device__ __forceinline__ void operator()(f32x4 (&acc)[2][2][4][2], const pg8::Unit& u, const pg8::EpiCtx& c) const { const int e_lane = lane_id(), e_fr = e_lane & 15, e_fq = e_lane >> 4;
        const int hc = c.wc * 32 + e_fq * 8, rl0 = c.wr * 64 + e_fr;
#pragma unroll
        for (int ai = 0; ai < 2; ++ai)
#pragma unroll
            for (int m = 0; m < 4; ++m) { const int row = u.pm * 256 + ai * 128 + rl0 + m * 16; const float gt = gate[row];
#pragma unroll
                for (int bj = 0; bj < 2; ++bj) { const f32x4 v0 = acc[ai][bj][m][0] * gt, v1 = acc[ai][bj][m][1] * gt;
                    *(u32x4*)(Y + (size_t)row * DM + u.pn * 256 + bj * 128 + hc) = (u32x4){cvtpk(v0.x, v0.y), cvtpk(v0.z, v0.w), cvtpk(v1.x, v1.y), cvtpk(v1.z, v1.w)}; } }
    }
};
__device__ __forceinline__ float rms_row_to_bf16_r(const float* xrow, const float* __restrict__ gain, bf16_t* orow, int lane) {
    const GAS f32x4* xr = (const GAS f32x4*)xrow + lane; const f32x4* gr = (const f32x4*)gain + lane;
    f32x4 v[8]; float s = 0.f;
#pragma unroll
    for (int j = 0; j < 8; ++j) { v[j] = xr[64 * j]; s += (v[j].x * v[j].x + v[j].y * v[j].y) + (v[j].z * v[j].z + v[j].w * v[j].w); }
    const float r = rsqrtf(wave_sum(s) * (1.f / DM) + EPS);
    GAS u32x2* o8 = (GAS u32x2*)orow + lane;
#pragma unroll
    for (int j = 0; j < 8; ++j) { const f32x4 g = gr[64 * j]; u32x2 w; w.x = cvtpk(v[j].x * r * g.x, v[j].y * r * g.y); w.y = cvtpk(v[j].z * r * g.z, v[j].w * r * g.w); o8[64 * j] = w; }
    return r;
}
__device__ __forceinline__ void router_phase(const Frame& F, const float* x, const float* __restrict__ gain, const float* __restrict__ Wr, bf16_t* HNo, float* aff) {
    const int lane = lane_id(), tid = F.wave * 64 + lane;
    LAS f32x4* Wl = (LAS f32x4*)(F.lds + RING_OFF);
    for (int i = tid; i < DM * 4; i += 512) { const int kk = i >> 2, q = i & 3; Wl[q * DM + (kk & 3) * 512 + (kk >> 2)] = *(const f32x4*)(Wr + (size_t)kk * NE + 4 * q); }
    __syncthreads();
    const int gw = (int)blockIdx.x * NWAVES + F.wave, NGW = F.G * NWAVES;
    const f32x4* gr = (const f32x4*)gain + lane;
    for (int rb = gw * 2; rb < NTOK; rb += NGW * 2) {
        f32x4 v0[8], v1[8]; float s0 = 0.f, s1 = 0.f;
        const GAS f32x4* x0 = (const GAS f32x4*)(x + (size_t)rb * DM) + lane; const GAS f32x4* x1 = x0 + DM / 4;
#pragma unroll
        for (int j = 0; j < 8; ++j) { v0[j] = x0[64 * j]; v1[j] = x1[64 * j]; }
#pragma unroll
        for (int j = 0; j < 8; ++j) { s0 += (v0[j].x * v0[j].x + v0[j].y * v0[j].y) + (v0[j].z * v0[j].z + v0[j].w * v0[j].w); s1 += (v1[j].x * v1[j].x + v1[j].y * v1[j].y) + (v1[j].z * v1[j].z + v1[j].w * v1[j].w); }
        const float r0 = rsqrtf(wave_sum(s0) * (1.f / DM) + EPS), r1 = rsqrtf(wave_sum(s1) * (1.f / DM) + EPS);
        GAS u32x2* o0 = (GAS u32x2*)(HNo + (size_t)rb * DM) + lane; GAS u32x2* o1 = o0 + DM / 4;
        float a[32];
#pragma unroll
        for (int i = 0; i < 32; ++i) a[i] = 0.f;
#pragma unroll
        for (int j = 0; j < 8; ++j) { const f32x4 g = gr[64 * j];
            v0[j] = (f32x4){v0[j].x * r0 * g.x, v0[j].y * r0 * g.y, v0[j].z * r0 * g.z, v0[j].w * r0 * g.w}; v1[j] = (f32x4){v1[j].x * r1 * g.x, v1[j].y * r1 * g.y, v1[j].z * r1 * g.z, v1[j].w * r1 * g.w};
            o0[64 * j] = (u32x2){cvtpk(v0[j].x, v0[j].y), cvtpk(v0[j].z, v0[j].w)}; o1[64 * j] = (u32x2){cvtpk(v1[j].x, v1[j].y), cvtpk(v1[j].z, v1[j].w)};
            const float h0[4] = {v0[j].x, v0[j].y, v0[j].z, v0[j].w}, h1[4] = {v1[j].x, v1[j].y, v1[j].z, v1[j].w};
#pragma unroll
            for (int c = 0; c < 4; ++c)
#pragma unroll
                for (int q = 0; q < 4; ++q) { const f32x4 w = Wl[q * DM + c * 512 + lane + 64 * j];
                    a[4 * q + 0] += h0[c] * w.x; a[4 * q + 1] += h0[c] * w.y; a[4 * q + 2] += h0[c] * w.z; a[4 * q + 3] += h0[c] * w.w;
                    a[16 + 4 * q + 0] += h1[c] * w.x; a[16 + 4 * q + 1] += h1[c] * w.y; a[16 + 4 * q + 2] += h1[c] * w.z; a[16 + 4 * q + 3] += h1[c] * w.w; } }
#define RS_STEP(N, MASK) { const bool up_ = (lane & MASK) != 0; _Pragma("unroll") for (int i = 0; i < N; ++i) { const float keep = up_ ? a[i + N] : a[i], send = up_ ? a[i] : a[i + N]; a[i] = keep + __shfl_xor(send, MASK); } }
        RS_STEP(16, 32) RS_STEP(8, 16) RS_STEP(4, 8) RS_STEP(2, 4) RS_STEP(1, 2)
#undef RS_STEP
        const float lg = a[0] + __shfl_xor(a[0], 1); float mx = lg;
        mx = fmaxf(mx, __shfl_xor(mx, 16)); mx = fmaxf(mx, __shfl_xor(mx, 8)); mx = fmaxf(mx, __shfl_xor(mx, 4)); mx = fmaxf(mx, __shfl_xor(mx, 2));
        const float ex = expf(lg - mx); float sm = ex;
        sm += __shfl_xor(sm, 16); sm += __shfl_xor(sm, 8); sm += __shfl_xor(sm, 4); sm += __shfl_xor(sm, 2);
        const int el = lane >> 1, row = rb + (el >> 4), e = el & 15, b = row / SEQ, t = row % SEQ;
        if ((lane & 1) == 0) aff[((size_t)b * NE + e) * SEQ + t] = ex / sm;
    }
    __syncthreads();
}
__device__ __forceinline__ void rank_phase(const Frame& F, const float* aff, int* rank, float* gate, const bf16_t* HNi, bf16_t* XS) {
    const int lane = lane_id(), tid = F.wave * 64 + lane;
    LAS float* a = (LAS float*)(F.lds + RING_OFF);
    LAS int* list = (LAS int*)(F.lds + RING_OFF + 8192);
    LAS int* cntp = (LAS int*)(F.lds + RING_OFF + 8192 + 1024);
    for (int it = (int)blockIdx.x; it < NB * NE * 8; it += F.G) {
        const int be = it >> 3, chunk = it & 7, b = be >> 4, e = be & 15;
        for (int i = tid; i < SEQ / 4; i += 512) ((LAS f32x4*)a)[i] = *(const f32x4*)(aff + (size_t)be * SEQ + 4 * i);
        if (tid == 0) cntp[0] = 0;
        __syncthreads();
        const int tl = tid >> 1, half = tid & 1, t = chunk * 256 + tl; const float v = a[t]; int cnt = 0;
        const float vn = __uint_as_float(__float_as_uint(v) + 1u);
        const int jb = half * 256, je = jb + 256, t0q = (chunk * 256 + F.wave * 32) >> 2;
        const int eA = t0q < jb ? jb : (t0q > je ? je : t0q), bC = (t0q + 9 < jb) ? jb : (t0q + 9 > je ? je : t0q + 9);
        const LAS f32x4* a4 = (const LAS f32x4*)a;
#pragma unroll 8
        for (int j4 = jb; j4 < eA; ++j4) { const f32x4 w = a4[j4]; cnt += (w.x >= v) + (w.y >= v) + (w.z >= v) + (w.w >= v); }
        for (int j4 = eA; j4 < bC; ++j4) { const f32x4 w = a4[j4]; const int j = 4 * j4;
            cnt += (w.x >= (j < t ? v : vn)) + (w.y >= (j + 1 < t ? v : vn)) + (w.z >= (j + 2 < t ? v : vn)) + (w.w >= (j + 3 < t ? v : vn)); }
#pragma unroll 8
        for (int j4 = bC; j4 < je; ++j4) { const f32x4 w = a4[j4]; cnt += (w.x >= vn) + (w.y >= vn) + (w.z >= vn) + (w.w >= vn); }
        cnt += __shfl_xor(cnt, 1);
        if (half == 0) { rank[(size_t)be * SEQ + t] = cnt;
            if (cnt < CAP) { gate[(e * 4 + b) * CAP + cnt] = v; const int slot = atomicAdd((int*)cntp, 1); list[slot] = (t << 16) | cnt; } }
        __syncthreads();
        const int n = cntp[0];
        for (int l0 = F.wave; l0 < n; l0 += 4 * NWAVES) {
            u32x4 cv[4][4]; u32x4* dstp[4];
#pragma unroll
            for (int q = 0; q < 4; ++q) { const int li = l0 + q * NWAVES; const int pk = list[li < n ? li : l0], tt = pk >> 16, rk = pk & 0xffff;
                const u32x4* src = (const u32x4*)(HNi + ((size_t)b * SEQ + tt) * DM); dstp[q] = (u32x4*)(XS + ((size_t)(e * 4 + b) * CAP + rk) * DM);
#pragma unroll
                for (int j = 0; j < 4; ++j) cv[q][j] = src[lane + 64 * j]; }
#pragma unroll
            for (int q = 0; q < 4; ++q) if (l0 + q * NWAVES < n) {
#pragma unroll
                for (int j = 0; j < 4; ++j) dstp[q][lane + 64 * j] = cv[q][j]; }
        }
        __syncthreads();
    }
}
__device__ __forceinline__ void combine_phase(const Frame& F, const float* xin, float* x, const bf16_t* Y, const int* rank, const float* __restrict__ gain, bf16_t* HNo, bool final_) {
    const int lane = lane_id();
    const int gw = (int)blockIdx.x * NWAVES + F.wave, NGW = F.G * NWAVES;
    for (int row = gw; row < NTOK; row += NGW) {
        const int b = row / SEQ, t = row % SEQ;
        int rk = CAP; if (lane < NE) rk = rank[((size_t)b * NE + lane) * SEQ + t];
        GAS f32x4* xr = (GAS f32x4*)(x + (size_t)row * DM) + lane; const GAS f32x4* xi = (const GAS f32x4*)(xin + (size_t)row * DM) + lane; f32x4 v[8];
#pragma unroll
        for (int j = 0; j < 8; ++j) v[j] = xi[64 * j];
#pragma unroll
        for (int e = 0; e < NE; ++e) { const int r = __builtin_amdgcn_readlane(rk, e);
            if (r < CAP) { const u32x2* yr = (const u32x2*)(Y + ((size_t)(e * 4 + b) * CAP + r) * DM) + lane;
#pragma unroll
                for (int j = 0; j < 8; ++j) { const u32x2 w = yr[64 * j]; v[j].x += __uint_as_float(w.x << 16); v[j].y += __uint_as_float(w.x & 0xffff0000u); v[j].z += __uint_as_float(w.y << 16); v[j].w += __uint_as_float(w.y & 0xffff0000u); } } }
        float s = 0.f;
#pragma unroll
        for (int j = 0; j < 8; ++j) s += (v[j].x * v[j].x + v[j].y * v[j].y) + (v[j].z * v[j].z + v[j].w * v[j].w);
        const float r = rsqrtf(wave_sum(s) * (1.f / DM) + EPS); const f32x4* gr = (const f32x4*)gain + lane;
        if (final_) {
#pragma unroll
            for (int j = 0; j < 8; ++j) { const f32x4 g = gr[64 * j]; xr[64 * j] = (f32x4){v[j].x * r * g.x, v[j].y * r * g.y, v[j].z * r * g.z, v[j].w * r * g.w}; }
        } else { GAS u32x2* o8 = (GAS u32x2*)(HNo + (size_t)row * DM) + lane;
#pragma unroll
            for (int j = 0; j < 8; ++j) { const f32x4 g = gr[64 * j]; xr[64 * j] = v[j]; o8[64 * j] = (u32x2){cvtpk(v[j].x * r * g.x, v[j].y * r * g.y), cvtpk(v[j].z * r * g.z, v[j].w * r * g.w)}; } }
    }
}

struct MapPool { const char* A; const char* W; __device__ __forceinline__ void operator()(pg8::Unit& u) const {
    u.a = A + ((size_t)u.pm * 256 * DM + (size_t)(u.pn >> 1) * 512) * 2; u.b = W + ((size_t)(u.pn & 1) * 256 * DM + (size_t)(u.pn >> 1) * 512) * 2; } };
template <int W> __device__ __forceinline__ void pool_item(const bf16_t* H, bf16_t* P, int row, int c8) {
    const int t = row & (SEQ - 1); const bf16_t* base = H + (size_t)(row - t) * DM + c8 * 8;
    u32x4 v[W];
#pragma unroll
    for (int i = 0; i < W; ++i) { int j = t - W / 2 + i; j = j < 0 ? 0 : (j > SEQ - 1 ? SEQ - 1 : j); v[i] = *(const u32x4*)(base + (size_t)j * DM); }
    float s[8] = {0.f, 0.f, 0.f, 0.f, 0.f, 0.f, 0.f, 0.f};
#pragma unroll
    for (int i = 0; i < W; ++i) { const int j = t - W / 2 + i; const float m = (j >= 0 && j < SEQ) ? 1.f : 0.f;
        s[0] += m * __uint_as_float(v[i].x << 16); s[1] += m * __uint_as_float(v[i].x & 0xffff0000u); s[2] += m * __uint_as_float(v[i].y << 16); s[3] += m * __uint_as_float(v[i].y & 0xffff0000u);
        s[4] += m * __uint_as_float(v[i].z << 16); s[5] += m * __uint_as_float(v[i].z & 0xffff0000u); s[6] += m * __uint_as_float(v[i].w << 16); s[7] += m * __uint_as_float(v[i].w & 0xffff0000u); }
    int lo = t - W / 2, hi = t + W / 2; if (lo < 0) lo = 0; if (hi > SEQ) hi = SEQ;
    const float inv = 1.0f / (float)(hi - lo); const u32x4 sv = v[W / 2];
    const float e0 = __uint_as_float(sv.x << 16), e1 = __uint_as_float(sv.x & 0xffff0000u), e2 = __uint_as_float(sv.y << 16), e3 = __uint_as_float(sv.y & 0xffff0000u);
    const float e4 = __uint_as_float(sv.z << 16), e5 = __uint_as_float(sv.z & 0xffff0000u), e6 = __uint_as_float(sv.w << 16), e7 = __uint_as_float(sv.w & 0xffff0000u);
    *(u32x4*)(P + (size_t)row * DM + c8 * 8) = (u32x4){cvtpk(s[0] * inv - e0, s[1] * inv - e1), cvtpk(s[2] * inv - e2, s[3] * inv - e3), cvtpk(s[4] * inv - e4, s[5] * inv - e5), cvtpk(s[6] * inv - e6, s[7] * inv - e7)};
}
__device__ __forceinline__ void pool_phase(const Frame& F, const bf16_t* H, bf16_t* P) {
    const int lane = lane_id(); const int gwv = (int)blockIdx.x * NWAVES + F.wave, NWV = F.G * NWAVES;
    for (int wi = gwv; wi < NTOK * 4; wi += NWV) {
        const int row = wi >> 2, g = wi & 3, c8 = g * 64 + lane;
        if (g == 0) pool_item<2>(H, P, row, c8); else if (g == 1) pool_item<4>(H, P, row, c8); else if (g == 2) pool_item<8>(H, P, row, c8); else pool_item<16>(H, P, row, c8);
    }
}

constexpr int N_PHASES = 24;
#ifndef MK_N_LAUNCHES
#define MK_N_LAUNCHES 1
#endif
#ifndef REP_MASK
#define REP_MASK 0
#endif
__global__ void __launch_bounds__(NWAVES * 64, 2) skel_fwd(Args args) {
    extern __shared__ __attribute__((aligned(16))) unsigned char lds_raw[];
    Frame F;
    F.lds = (LAS unsigned char*)lds_raw; F.MISC = (volatile LAS unsigned*)(F.lds + MISC_OFF);
    F.wave = __builtin_amdgcn_readfirstlane(threadIdx.x >> 6);
    F.G = gridDim.x; { const int bx = blockIdx.x; F.vcu = (F.G % 8 == 0) ? (bx % 8) * (F.G / 8) + bx / 8 : bx; }
    F.ws = nullptr; F.ctl = (gu32*)(uptr(args.ws) + WS_CTL);
    for (int u = threadIdx.x; u < (LDS_BYTES - LDSCTL_OFF) / 4; u += NWAVES * 64) ((LAS unsigned*)(F.lds + LDSCTL_OFF))[u] = 0u;
    __syncthreads();
    const bool multi = (MK_N_LAUNCHES == 1) || (args.ph_hi - args.ph_lo) > 1 || REP_MASK != 0;
    XcdBarrier bar; bar.bar = (unsigned*)(F.ctl + CW_BAR); bar.x = 0; bar.st = nullptr; bar.wave = F.wave;
    if (multi) bar = xcd_barrier_post((unsigned*)(F.ctl + CW_BAR), F.MISC + 8, F.wave);
    const int lo = args.ph_lo, hi = args.ph_hi;
#ifdef REP_RT
    const unsigned rep_mask_ = (unsigned)__builtin_amdgcn_readfirstlane(args.pad);
#endif
#define IN(k) ((MK_N_LAUNCHES == 1) ? ((k) < N_PHASES) : (lo <= (k) && (k) < hi))
#ifdef REP_RT
#define REPBIT(k) ((int)((rep_mask_ >> (k)) & 1u))
#else
#define REPBIT(k) ((int)((((unsigned)REP_MASK) >> (k)) & 1u))
#endif
#define PHASE(k) _Pragma("unroll") for (int rep_ = 0; rep_ < 1 + REPBIT(k); ++rep_)
#define SEAM(k) do { if ((IN(k) && IN((k) + 1)) || rep_ + 1 < 1 + REPBIT(k)) xcd_barrier(bar); } while (0)
    LAS unsigned char* ring = F.lds + RING_OFF; LAS unsigned char* xl = F.lds + XL_OFF;
    const int bx = (int)blockIdx.x, G = F.G;

#define KV_PROJ(l, rotK, rotV) do {   \
            { MapLin mp{(const char*)(ws + WS_MEMNB + (size_t)(l) * NB * MEML * DM * 2), (const char*)(ws + WS_WCK_T + (size_t)(l) * DM * DM * 2), (size_t)256 * DM * 2, (size_t)256 * DM * 2}; \
              pg8::Sched<MapLin> S; S.init(NB * MEML / 256, DM / 256, G, (bx + G - ((rotK) % G)) % G, mp); \
              EpiStore<AddrLin> E{AddrLin{(bf16_t*)(ws + WS_KCB + (size_t)(l) * NB * MEML * DM * 2), DM}}; \
              pg8::gemm_phase<EpiStore<AddrLin>, pg8::Sched<MapLin>, true>(F.wave, ring, xl, DM, DM * 2, DM * 2, S, E); } \
            { MapLin mp{(const char*)(ws + WS_WCV_T + (size_t)(l) * DM * DM * 2), (const char*)(ws + WS_MEMNB + (size_t)(l) * NB * MEML * DM * 2), (size_t)256 * DM * 2, (size_t)256 * DM * 2}; \
              pg8::Sched<MapLin> S; S.init(DM / 256, NB * MEML / 256, G, (bx + G - ((rotV) % G)) % G, mp); \
              EpiStore<AddrLin> E{AddrLin{(bf16_t*)(ws + WS_VTB + (size_t)(l) * NB * MEML * DM * 2), NB * MEML}}; \
              pg8::gemm_phase<EpiStore<AddrLin>, pg8::Sched<MapLin>, true>(F.wave, ring, xl, DM, DM * 2, DM * 2, S, E); } } while (0)
#ifdef EXTRA_BARS
    for (int eb = 0; eb < EXTRA_BARS; ++eb) xcd_barrier(bar);
#endif
    if (IN(0)) PHASE(0) { const karg_t ka = kargs(); unsigned char* const ws = uptr(KWS(ka)); p0_prologue(F, ka, ws); SEAM(0); }
    if (IN(1)) PHASE(1) { const karg_t ka = kargs(); unsigned char* const ws = uptr(KWS(ka));
        {
            MapLin mp{(const char*)(ws + WS_HN), (const char*)(ws + WS_WIN_T), (size_t)256 * DM * 2, (size_t)256 * DM * 2};
            pg8::Sched<MapLin> S; S.init(NTOK / 256, 2560 / 256, G, bx, mp);
            EpiQKV E{(bf16_t*)(ws + WS_QB), (bf16_t*)(ws + WS_KB), (bf16_t*)(ws + WS_VB), KIN(ka, 4), KIN(ka, 5), (const float*)(ws + WS_ROPE), (const float*)(ws + WS_ROPE) + SEQ * 64};
            pg8::gemm_phase<EpiQKV, pg8::Sched<MapLin>, true>(F.wave, ring, xl, DM, DM * 2, DM * 2, S, E); }
        {
            MapLin mp{(const char*)(ws + WS_WF_T), (const char*)(ws + WS_HN), (size_t)256 * DM * 2, (size_t)256 * DM * 2};
            pg8::Sched<MapLin> S; S.init(1024 / 256, NTOK / 256, G, (bx + G - (320 % G)) % G, mp);
            EpiStore<AddrF1> E{AddrF1{(bf16_t*)(ws + WS_FPQ)}};
            pg8::gemm_phase<EpiStore<AddrF1>, pg8::Sched<MapLin>, true>(F.wave, ring, xl, DM, DM * 2, DM * 2, S, E); }
        KV_PROJ(0, 448, 480);
        SEAM(1);
    }
    if (IN(2)) PHASE(2) { const karg_t ka = kargs(); unsigned char* const ws = uptr(KWS(ka));
        const int nF2 = (G > 64) ? 64 : 0;
        if (bx < nF2 || nF2 == 0) {
            MapLin mp{(const char*)(ws + WS_DFT), (const char*)(ws + WS_FPQ), (size_t)256 * 4096 * 2, (size_t)256 * 4096 * 2};
            pg8::Sched<MapLin> S; S.init(8, 8, nF2 ? nF2 : G, bx, mp);
            EpiStore<AddrF2> E{AddrF2{(bf16_t*)(ws + WS_MIXB)}};
            pg8::gemm_phase<EpiStore<AddrF2>, pg8::Sched<MapLin>, true>(F.wave, ring, xl, 4096, 4096 * 2, 4096 * 2, S, E);
        }
        if (bx < nF2) { __syncthreads(); tr_span(F, ka, ws, 1, 7680 + bx * 8 + F.wave, 512, 9); __syncthreads(); }
        if (bx >= nF2) {
            const int a = bx - nF2, cnt = G - nF2, per = (384 + cnt - 1) / cnt, slot = a % 3; int ui = 0;
            for (int uid = a * per; uid < (a + 1) * per && uid < 384; ++uid, ++ui) {
                if (ui == slot) { __syncthreads(); tr_span(F, ka, ws, 1, a * 8 + F.wave, 1536, 5); __syncthreads(); }
                const int qb = uid & 7, hq = (uid >> 3) % NQH, b = uid / (8 * NQH), kvh = hq / 3;
                const bf16_t* Qb = (const bf16_t*)(ws + WS_QB) + ((size_t)b * SEQ + qb * 256) * AW + hq * HD;
                const bf16_t* Kh = (const bf16_t*)(ws + WS_KB) + (size_t)b * SEQ * KVW + kvh * HD;
                const bf16_t* Vh = (const bf16_t*)(ws + WS_VB) + (size_t)b * SEQ * KVW + kvh * HD;
                bf16_t* Ob = (bf16_t*)(ws + WS_MIXB) + ((size_t)b * SEQ + qb * 256) * DM + hq * HD;
                attn::attn_dense_body(Qb, Kh, Vh, Ob, SEQ, (char*)lds_raw + RING_OFF, F.wave);
            }
            if (slot >= ui) { __syncthreads(); tr_span(F, ka, ws, 1, a * 8 + F.wave, 1536, 5); __syncthreads(); }
        }
        SEAM(2);
    }
    if (IN(3)) PHASE(3) { const karg_t ka = kargs(); unsigned char* const ws = uptr(KWS(ka));
        MapLin mp{(const char*)(ws + WS_MIXB), (const char*)(ws + WS_WOUT_T), (size_t)256 * DM * 2, (size_t)256 * DM * 2};
        pg8::Sched<MapLin> S; S.init(NTOK / 256, DM / 256, G, bx, mp);
        EpiRes E{KIN(ka, 0), (float*)(ws + WS_XALT), (bf16_t*)(ws + WS_XB), (float*)(ws + WS_SSP), nullptr, 8};
        pg8::gemm_phase<EpiRes, pg8::Sched<MapLin>, true>(F.wave, ring, xl, DM, DM * 2, DM * 2, S, E);
        SEAM(3);
    }
    {
        constexpr int l = 0; constexpr int pb = l ? 15 : 4;
        if (l == 1) {
            if (IN(13)) PHASE(13) { const karg_t ka = kargs(); unsigned char* const ws = uptr(KWS(ka));
                pool_phase(F, (const bf16_t*)(ws + WS_HN), (bf16_t*)(ws + WS_QCB));
#ifdef PROBE_CONV
                tr_span<TRV>(F, ka, ws, 1, bx * 8 + F.wave, 2048, 6);
#endif
                SEAM(13);
            }
            if (IN(14)) PHASE(14) { const karg_t ka = kargs(); unsigned char* const ws = uptr(KWS(ka));
                MapPool mp{(const char*)(ws + WS_QCB), (const char*)(ws + WS_WP_T)};
                pg8::Sched<MapPool> S; S.init(NTOK / 256, DM / 256, G, bx, mp);
                EpiRes E{(const float*)(ws + WS_XALT), KOUT(ka), (bf16_t*)(ws + WS_XB), (float*)(ws + WS_SSP), KIN(ka, 9), 8};
                pg8::gemm_phase<EpiRes, pg8::Sched<MapPool>, true>(F.wave, ring, xl, 512, DM * 2, DM * 2, S, E);
                SEAM(14);
            }
        }
        if (IN(pb + 0)) PHASE(pb + 0) { const karg_t ka = kargs(); unsigned char* const ws = uptr(KWS(ka));
            MapLin mp{(const char*)(ws + WS_XB), (const char*)(ws + WS_WCQ_T + (size_t)l * DM * DM * 2), (size_t)256 * DM * 2, (size_t)256 * DM * 2};
            pg8::Sched<MapLin> S; S.init(NTOK / 256, DM / 256, G, bx, mp);
            EpiRowScale E{(bf16_t*)(ws + WS_QCB), DM, (const float*)(ws + WS_SSP), 0.04419417382415922f};
            pg8::gemm_phase<EpiRowScale, pg8::Sched<MapLin>, true>(F.wave, ring, xl, DM, DM * 2, DM * 2, S, E);
            SEAM(pb + 0);
        }
        if (IN(pb + 1)) PHASE(pb + 1) { const karg_t ka = kargs(); unsigned char* const ws = uptr(KWS(ka));
            MapXS mp{(const char*)(ws + WS_QCB), (const char*)(ws + WS_KCB + (size_t)l * NB * MEML * DM * 2)};
            pg8::Sched<MapXS> S; S.init(NTOK / 256, NMH, G, bx, mp);
            EpiSoftmax E{(bf16_t*)(ws + WS_PB), NMH * MEML};
            pg8::gemm_phase<EpiSoftmax, pg8::Sched<MapXS>, true>(F.wave, ring, xl, MHD, DM * 2, DM * 2, S, E);
            if (l == 0) KV_PROJ(1, 128, 160);
            SEAM(pb + 1);
        }
        if (IN(pb + 2)) PHASE(pb + 2) { const karg_t ka = kargs(); unsigned char* const ws = uptr(KWS(ka));
            MapXPV mp{(const char*)(ws + WS_PB), (const char*)(ws + WS_VTB + (size_t)l * NB * MEML * DM * 2)};
            pg8::Sched<MapXPV> S; S.init(NTOK / 256, DM / 256, G, bx, mp);
            EpiStore<AddrLin> E{AddrLin{(bf16_t*)(ws + WS_MIXB), DM}};
            pg8::gemm_phase<EpiStore<AddrLin>, pg8::Sched<MapXPV>, true>(F.wave, ring, xl, MEML, NMH * MEML * 2, NB * MEML * 2, S, E);
            SEAM(pb + 2);
        }
        if (IN(pb + 3)) PHASE(pb + 3) { const karg_t ka = kargs(); unsigned char* const ws = uptr(KWS(ka));
            MapLin mp{(const char*)(ws + WS_MIXB), (const char*)(ws + WS_WCO_T + (size_t)l * DM * DM * 2), (size_t)256 * DM * 2, (size_t)256 * DM * 2};
            pg8::Sched<MapLin> S; S.init(NTOK / 256, DM / 256, G, bx, mp);
            EpiRes E{l == 0 ? (const float*)(ws + WS_XALT) : (const float*)KOUT(ka), l == 0 ? KOUT(ka) : (float*)(ws + WS_XALT), nullptr, nullptr, nullptr, 8};
            pg8::gemm_phase<EpiRes, pg8::Sched<MapLin>, true>(F.wave, ring, xl, DM, DM * 2, DM * 2, S, E);
            SEAM(pb + 3);
        }
        if (IN(pb + 4)) PHASE(pb + 4) { const karg_t ka = kargs(); unsigned char* const ws = uptr(KWS(ka));
            router_phase(F, l == 0 ? (const float*)KOUT(ka) : (const float*)(ws + WS_XALT), KIN(ka, 16) + l * DM, KIN(ka, 17) + (size_t)l * DM * NE, (bf16_t*)(ws + WS_HN), (float*)(ws + WS_AFF));
            SEAM(pb + 4);
        }
        if (IN(pb + 5)) PHASE(pb + 5) { const karg_t ka = kargs(); unsigned char* const ws = uptr(KWS(ka));
            rank_phase(F, (const float*)(ws + WS_AFF), (int*)(ws + WS_RANK), (float*)(ws + WS_GATE), (const bf16_t*)(ws + WS_HN), (bf16_t*)(ws + WS_XSB));
            SEAM(pb + 5);
        }
        if (IN(pb + 6)) PHASE(pb + 6) { const karg_t ka = kargs(); unsigned char* const ws = uptr(KWS(ka));
            MapMoE mp{(const char*)(ws + WS_XSB), (const char*)(ws + (l ? WS_WGU_T2 : WS_WGU_T)), (size_t)256 * DM * 2, (size_t)2048 * DM * 2, (size_t)256 * DM * 2};
            pg8::Sched<MapMoE> S; S.init(NB * NE, 8, G, bx, mp);
            EpiSwiGLU E{(bf16_t*)(ws + WS_ACTB)};
            const bool cfirst = ((bx >> 3) & 1) != 0;
            if (l == 0 && cfirst) { tr_span(F, ka, ws, 2, bx * 8 + F.wave, 2048, 3); __syncthreads(); }
            pg8::gemm_phase<EpiSwiGLU, pg8::Sched<MapMoE>, true>(F.wave, ring, xl, DM, DM * 2, DM * 2, S, E);
            if (l == 0 && !cfirst) { __syncthreads(); tr_span(F, ka, ws, 2, bx * 8 + F.wave, 2048, 3); }
            SEAM(pb + 6);
        }
        if (IN(pb + 7)) PHASE(pb + 7) { const karg_t ka = kargs(); unsigned char* const ws = uptr(KWS(ka));
            MapMoE mp{(const char*)(ws + WS_ACTB), (const char*)(ws + (l ? WS_WD_T2 : WS_WD_T)), (size_t)256 * EFF * 2, (size_t)2048 * EFF * 2, (size_t)256 * EFF * 2};
            pg8::Sched<MapMoE> S; S.init(NB * NE, 8, G, bx, mp);
            EpiRowGate E{(bf16_t*)(ws + WS_YB), (const float*)(ws + WS_GATE)};
            const bool cfirst = ((bx >> 3) & 1) == 0;
            if (l == 0 && cfirst) { tr_span(F, ka, ws, 2, 6144 + bx * 8 + F.wave, 2048, 3); __syncthreads(); }
            pg8::gemm_phase<EpiRowGate, pg8::Sched<MapMoE>, true>(F.wave, ring, xl, EFF, EFF * 2, EFF * 2, S, E);
            if (l == 0 && !cfirst) { __syncthreads(); tr_span(F, ka, ws, 2, 6144 + bx * 8 + F.wave, 2048, 3); }
            SEAM(pb + 7);
        }
        if (IN(pb + 8)) PHASE(pb + 8) { const karg_t ka = kargs(); unsigned char* const ws = uptr(KWS(ka));
            combine_phase(F, l == 0 ? (const float*)KOUT(ka) : (const float*)(ws + WS_XALT), l == 0 ? (float*)(ws + WS_XALT) : KOUT(ka), (const bf16_t*)(ws + WS_YB), (const int*)(ws + WS_RANK), l == 0 ? KIN(ka, 2) + DM : KIN(ka, 21), (bf16_t*)(ws + WS_HN), l == 1);
            SEAM(pb + 8);
        }
    }
    {
        constexpr int l = 1; constexpr int pb = l ? 15 : 4;
        if (l == 1) {
            if (IN(13)) PHASE(13) { const karg_t ka = kargs(); unsigned char* const ws = uptr(KWS(ka));
                pool_phase(F, (const bf16_t*)(ws + WS_HN), (bf16_t*)(ws + WS_QCB));
#ifdef PROBE_CONV
                tr_span<TRV>(F, ka, ws, 1, bx * 8 + F.wave, 2048, 6);
#endif
                SEAM(13);
            }
            if (IN(14)) PHASE(14) { const karg_t ka = kargs(); unsigned char* const ws = uptr(KWS(ka));
                MapPool mp{(const char*)(ws + WS_QCB), (const char*)(ws + WS_WP_T)};
                pg8::Sched<MapPool> S; S.init(NTOK / 256, DM / 256, G, bx, mp);
                EpiRes E{(const float*)(ws + WS_XALT), KOUT(ka), (bf16_t*)(ws + WS_XB), (float*)(ws + WS_SSP), KIN(ka, 9), 8};
                pg8::gemm_phase<EpiRes, pg8::Sched<MapPool>, true>(F.wave, ring, xl, 512, DM * 2, DM * 2, S, E);
                SEAM(14);
            }
        }
        if (IN(pb + 0)) PHASE(pb + 0) { const karg_t ka = kargs(); unsigned char* const ws = uptr(KWS(ka));
            MapLin mp{(const char*)(ws + WS_XB), (const char*)(ws + WS_WCQ_T + (size_t)l * DM * DM * 2), (size_t)256 * DM * 2, (size_t)256 * DM * 2};
            pg8::Sched<MapLin> S; S.init(NTOK / 256, DM / 256, G, bx, mp);
            EpiRowScale E{(bf16_t*)(ws + WS_QCB), DM, (const float*)(ws + WS_SSP), 0.04419417382415922f};
            pg8::gemm_phase<EpiRowScale, pg8::Sched<MapLin>, true>(F.wave, ring, xl, DM, DM * 2, DM * 2, S, E);
            SEAM(pb + 0);
        }
        if (IN(pb + 1)) PHASE(pb + 1) { const karg_t ka = kargs(); unsigned char* const ws = uptr(KWS(ka));
            MapXS mp{(const char*)(ws + WS_QCB), (const char*)(ws + WS_KCB + (size_t)l * NB * MEML * DM * 2)};
            pg8::Sched<MapXS> S; S.init(NTOK / 256, NMH, G, bx, mp);
            EpiSoftmax E{(bf16_t*)(ws + WS_PB), NMH * MEML};
            pg8::gemm_phase<EpiSoftmax, pg8::Sched<MapXS>, true>(F.wave, ring, xl, MHD, DM * 2, DM * 2, S, E);
            if (l == 0) KV_PROJ(1, 128, 160);
            SEAM(pb + 1);
        }
        if (IN(pb + 2)) PHASE(pb + 2) { const karg_t ka = kargs(); unsigned char* const ws = uptr(KWS(ka));
            MapXPV mp{(const char*)(ws + WS_PB), (const char*)(ws + WS_VTB + (size_t)l * NB * MEML * DM * 2)};
            pg8::Sched<MapXPV> S; S.init(NTOK / 256, DM / 256, G, bx, mp);
            EpiStore<AddrLin> E{AddrLin{(bf16_t*)(ws + WS_MIXB), DM}};
            pg8::gemm_phase<EpiStore<AddrLin>, pg8::Sched<MapXPV>, true>(F.wave, ring, xl, MEML, NMH * MEML * 2, NB * MEML * 2, S, E);
            SEAM(pb + 2);
        }
        if (IN(pb + 3)) PHASE(pb + 3) { const karg_t ka = kargs(); unsigned char* const ws = uptr(KWS(ka));
            MapLin mp{(const char*)(ws + WS_MIXB), (const char*)(ws + WS_WCO_T + (size_t)l * DM * DM * 2), (size_t)256 * DM * 2, (size_t)256 * DM * 2};
            pg8::Sched<MapLin> S; S.init(NTOK / 256, DM / 256, G, bx, mp);
            EpiRes E{l == 0 ? (const float*)(ws + WS_XALT) : (const float*)KOUT(ka), l == 0 ? KOUT(ka) : (float*)(ws + WS_XALT), nullptr, nullptr, nullptr, 8};
            pg8::gemm_phase<EpiRes, pg8::Sched<MapLin>, true>(F.wave, ring, xl, DM, DM * 2, DM * 2, S, E);
            SEAM(pb + 3);
        }
        if (IN(pb + 4)) PHASE(pb + 4) { const karg_t ka = kargs(); unsigned char* const ws = uptr(KWS(ka));
            router_phase(F, l == 0 ? (const float*)KOUT(ka) : (const float*)(ws + WS_XALT), KIN(ka, 16) + l * DM, KIN(ka, 17) + (size_t)l * DM * NE, (bf16_t*)(ws + WS_HN), (float*)(ws + WS_AFF));
            SEAM(pb + 4);
        }
        if (IN(pb + 5)) PHASE(pb + 5) { const karg_t ka = kargs(); unsigned char* const ws = uptr(KWS(ka));
            rank_phase(F, (const float*)(ws + WS_AFF), (int*)(ws + WS_RANK), (float*)(ws + WS_GATE), (const bf16_t*)(ws + WS_HN), (bf16_t*)(ws + WS_XSB));
            SEAM(pb + 5);
        }
        if (IN(pb + 6)) PHASE(pb + 6) { const karg_t ka = kargs(); unsigned char* const ws = uptr(KWS(ka));
            MapMoE mp{(const char*)(ws + WS_XSB), (const char*)(ws + (l ? WS_WGU_T2 : WS_WGU_T)), (size_t)256 * DM * 2, (size_t)2048 * DM * 2, (size_t)256 * DM * 2};
            pg8::Sched<MapMoE> S; S.init(NB * NE, 8, G, bx, mp);
            EpiSwiGLU E{(bf16_t*)(ws + WS_ACTB)};
            const bool cfirst = ((bx >> 3) & 1) != 0;
            if (l == 0 && cfirst) { tr_span(F, ka, ws, 2, bx * 8 + F.wave, 2048, 3); __syncthreads(); }
            pg8::gemm_phase<EpiSwiGLU, pg8::Sched<MapMoE>, true>(F.wave, ring, xl, DM, DM * 2, DM * 2, S, E);
            if (l == 0 && !cfirst) { __syncthreads(); tr_span(F, ka, ws, 2, bx * 8 + F.wave, 2048, 3); }
            SEAM(pb + 6);
        }
        if (IN(pb + 7)) PHASE(pb + 7) { const karg_t ka = kargs(); unsigned char* const ws = uptr(KWS(ka));
            MapMoE mp{(const char*)(ws + WS_ACTB), (const char*)(ws + (l ? WS_WD_T2 : WS_WD_T)), (size_t)256 * EFF * 2, (size_t)2048 * EFF * 2, (size_t)256 * EFF * 2};
            pg8::Sched<MapMoE> S; S.init(NB * NE, 8, G, bx, mp);
            EpiRowGate E{(bf16_t*)(ws + WS_YB), (const float*)(ws + WS_GATE)};
            const bool cfirst = ((bx >> 3) & 1) == 0;
            if (l == 0 && cfirst) { tr_span(F, ka, ws, 2, 6144 + bx * 8 + F.wave, 2048, 3); __syncthreads(); }
            pg8::gemm_phase<EpiRowGate, pg8::Sched<MapMoE>, true>(F.wave, ring, xl, EFF, EFF * 2, EFF * 2, S, E);
            if (l == 0 && !cfirst) { __syncthreads(); tr_span(F, ka, ws, 2, 6144 + bx * 8 + F.wave, 2048, 3); }
            SEAM(pb + 7);
        }
        if (IN(pb + 8)) PHASE(pb + 8) { const karg_t ka = kargs(); unsigned char* const ws = uptr(KWS(ka));
            combine_phase(F, l == 0 ? (const float*)KOUT(ka) : (const float*)(ws + WS_XALT), l == 0 ? (float*)(ws + WS_XALT) : KOUT(ka), (const bf16_t*)(ws + WS_YB), (const int*)(ws + WS_RANK), l == 0 ? KIN(ka, 2) + DM : KIN(ka, 21), (bf16_t*)(ws + WS_HN), l == 1);
            SEAM(pb + 8);
        }
    }
#undef IN
#undef SEAM
#undef PHASE
#undef KV_PROJ
}


extern "C" void kernel_launch(void* const* d_in, const int* in_sizes, int n_in, void* d_out, int out_size, void* d_ws, size_t ws_size, hipStream_t stream) {
    static int grid = 0;
    if (grid == 0) {
        int dev = 0, cus = 0;
        if (n_in != 22 || out_size != NTOK * DM || ws_size < WS_FAST_END) { fprintf(stderr, "kernel_launch: unexpected shapes (n_in %d out %d ws %zu)\n", n_in, out_size, ws_size); grid = -1; return; }
        if (hipGetDevice(&dev) != hipSuccess || hipDeviceGetAttribute(&cus, hipDeviceAttributeMultiprocessorCount, dev) != hipSuccess) { fprintf(stderr, "device query failed\n"); grid = -1; return; }
        if (hipFuncSetAttribute((const void*)skel_fwd, hipFuncAttributeMaxDynamicSharedMemorySize, LDS_BYTES) != hipSuccess) { fprintf(stderr, "hipFuncSetAttribute failed\n"); grid = -1; return; }
        (void)hipGetLastError();
        grid = cus;
        if (grid != 256) { fprintf(stderr, "kernel_launch: this kernel is laid out for 256 CUs (found %d)\n", cus); grid = -1; return; }
    }
    if (grid < 0) return;
    hipMemsetAsync((char*)d_ws + WS_CTL, 0, CTL_ZERO_BYTES, stream);
    Args a{};
    for (int i = 0; i < 22; ++i) a.in[i] = (const float*)d_in[i];
    a.out = (float*)d_out; a.ws = (unsigned char*)d_ws;
#ifdef REP_RT
    a.pad = REP_RT;
#endif
    constexpr int NL = MK_N_LAUNCHES;
    for (int li = 0; li < NL; ++li) {
        a.ph_lo = (N_PHASES * li) / NL; a.ph_hi = (N_PHASES * (li + 1)) / NL; a.li = li;
        hipLaunchKernelGGL(skel_fwd, dim3(grid), dim3(NWAVES * 64), LDS_BYTES, stream, a);
    }
}
```

```cpp
#include <hip/hip_runtime.h>
#include <cstdio>
#include <cstdint>

constexpr int DM = 2048, NB = 4, SEQ = 2048, NTOK = NB * SEQ;
constexpr int HD = 128, NQH = 12, NKVH = 4, AW = NQH * HD, KVW = NKVH * HD, FW = 512, INW = 3072;
constexpr int MEML = 256, NMH = 4, MHD = 512;
constexpr int NE = 16, EFF = 1024, CAP = 256;
constexpr float EPS = 1e-6f;

#define LAS __attribute__((address_space(3)))
#define GAS __attribute__((address_space(1)))
typedef unsigned short bf16_t;
typedef short bf16x8 __attribute__((ext_vector_type(8)));
typedef float f32x4 __attribute__((ext_vector_type(4)));
typedef float f32x2 __attribute__((ext_vector_type(2)));
typedef unsigned u32x4 __attribute__((ext_vector_type(4)));
typedef unsigned u32x2 __attribute__((ext_vector_type(2)));
typedef __bf16 bf16x2_t __attribute__((ext_vector_type(2)));
__device__ __forceinline__ unsigned cvtpk(float lo, float hi) { f32x2 v = {lo, hi}; bf16x2_t b = __builtin_convertvector(v, bf16x2_t); return __builtin_bit_cast(unsigned, b); }
__device__ __forceinline__ float bf2f(unsigned short h) { return __uint_as_float(((unsigned)h) << 16); }
template <class T> __device__ __forceinline__ T* uptr(T* p) { const unsigned long long v = (unsigned long long)p; const unsigned lo = __builtin_amdgcn_readfirstlane((unsigned)v), hi = __builtin_amdgcn_readfirstlane((unsigned)(v >> 32)); return (T*)(((unsigned long long)hi << 32) | lo); }
__device__ __forceinline__ int lane_id() { int l = (int)__builtin_amdgcn_mbcnt_hi(~0u, __builtin_amdgcn_mbcnt_lo(~0u, 0u)); asm volatile("" : "+v"(l)); return l; }
typedef __attribute__((address_space(4))) const unsigned char* karg_t;
__device__ __forceinline__ karg_t kargs() { karg_t p = (karg_t)__builtin_amdgcn_kernarg_segment_ptr(); asm volatile("" : "+s"(p)); return p; }
#define KIN(ka, i) (*(const float* const __attribute__((address_space(4)))*)((ka) + 8 * (i)))
#define KOUT(ka) (*(float* const __attribute__((address_space(4)))*)((ka) + 176))
#define KWS(ka) (*(unsigned char* const __attribute__((address_space(4)))*)((ka) + 184))
#define LDS_WAIT() asm volatile("s_waitcnt lgkmcnt(0)" ::: "memory")
#define VM_WAIT() asm volatile("s_waitcnt vmcnt(0)" ::: "memory")
#define WG_BAR() do { asm volatile("s_waitcnt lgkmcnt(0)" ::: "memory"); __builtin_amdgcn_s_barrier(); asm volatile("" ::: "memory"); } while (0)

namespace pg8 {
constexpr int BM = 256, BK = 64, HALF = 128, HTB = HALF * BK * 2, STAGE_BYTES = 8 * HTB, NXCD = 8, WGM = 8;
__host__ __device__ __forceinline__ int lds_byte(int r, int c) { const int st = (r >> 4) * 2 + (c >> 5), rr = r & 15, cc = c & 31, ob = rr * 64 + cc * 2; return st * 1024 + (ob ^ (((ob >> 9) & 1) << 5)); }
__host__ __device__ __forceinline__ void stage_rc(int b, int& R, int& C) { const int st = b / 1024, sb = b % 1024, swz = sb ^ (((sb >> 9) & 1) << 5); R = (st >> 1) * 16 + swz / 64; C = (st & 1) * 32 + (swz % 64) / 2; }
__host__ __device__ __forceinline__ int perm32(int rho) { const int n = rho >> 4, i = rho & 15; return 8 * (i >> 2) + 4 * n + (i & 3); }

struct Unit { int pm, pn; const char* a; const char* b; };
struct EpiCtx { int wr, wc, wid; LAS unsigned char* xl; };

template <class Map> struct Sched {
    int nM, nN, nwg, G, c; Map map;
    __device__ __forceinline__ void init(int nM_, int nN_, int G_, int c_, const Map& m) { nM = nM_; nN = nN_; nwg = nM * nN; G = G_; c = c_; map = m; }
    __device__ __forceinline__ bool next(int i, Unit& u) const {
        const long L = (long)i * G + c; if (L >= nwg) return false;
        int wgid = (int)L; { const int q = nwg / NXCD, r = nwg % NXCD, xcd = wgid % NXCD, off = wgid / NXCD; wgid = (xcd < r ? xcd * (q + 1) : r * (q + 1) + (xcd - r) * q) + off; }
        const int nig = WGM * nN, gid = wgid / nig, fm = gid * WGM, gsz = (nM - fm) < WGM ? (nM - fm) : WGM;
        u.pm = fm + ((wgid % nig) % gsz); u.pn = (wgid % nig) / gsz; map(u); return true;
    }
};

template <class Epi, class SchedT, bool SP2>
__device__ __forceinline__ void gemm_phase(const int wave_, LAS unsigned char* lds, LAS unsigned char* xl, const int K, const int lda, const int ldb, const SchedT& S, const Epi& E) {
    constexpr bool ALIGN_EPI = true;
    const int lane = lane_id(), wid = wave_, tid = wid * 64 + lane, wr = wid >> 2, wc = wid & 3, fr = lane & 15, fq = lane >> 4;
    const int nt = K / BK;
    unsigned voffA[2], voffB[2];
#pragma unroll
    for (int i = 0; i < 2; ++i) { int R, C; stage_rc(tid * 16 + i * 8192, R, C); const int Rb = Epi::PERM ? ((R & ~31) + perm32(R & 31)) : R;
        voffA[i] = (unsigned)(R * lda + C * 2); voffB[i] = (unsigned)(Rb * ldb + C * 2); }
    const size_t kstep = (size_t)(BK * 2);
    const size_t hstepA = (size_t)HALF * lda, hstepB = (size_t)HALF * ldb;
    const unsigned ldsw = (unsigned)wid * 1024u;
    const int aoff = lds_byte(wr * 64 + fr, fq * 8), boff = lds_byte(wc * 32 + fr, fq * 8);
#define PG8_SA(b, h) (((b) * 2 + (h)) * HTB)
#define PG8_SB(b, h) ((4 + (b) * 2 + (h)) * HTB)
#define PG8_STAGE(bufoff, gbase, voff) do { _Pragma("unroll") for (int _i = 0; _i < 2; ++_i) \
        __builtin_amdgcn_global_load_lds((const unsigned*)((const char*)(gbase) + (voff)[_i]), (LAS unsigned*)(lds + (bufoff) + ldsw + _i * 8192), 16, 0, 0); } while (0)
#define PG8_LDA(dst, b, h) do { _Pragma("unroll") for (int m = 0; m < 4; ++m) _Pragma("unroll") for (int k = 0; k < 2; ++k) dst[m][k] = *(const LAS bf16x8*)(lds + PG8_SA(b, h) + aoff + m * 2048 + k * 1024); } while (0)
#define PG8_LDB(dst, b, h) do { _Pragma("unroll") for (int n = 0; n < 2; ++n) _Pragma("unroll") for (int k = 0; k < 2; ++k) dst[n][k] = *(const LAS bf16x8*)(lds + PG8_SB(b, h) + boff + n * 2048 + k * 1024); } while (0)
#define PG8_MMA(ai, bj, At, Bt) do { __builtin_amdgcn_s_setprio(1); _Pragma("unroll") for (int m = 0; m < 4; ++m) _Pragma("unroll") for (int n = 0; n < 2; ++n) _Pragma("unroll") for (int k = 0; k < 2; ++k) \
        acc[ai][bj][m][n] = __builtin_amdgcn_mfma_f32_16x16x32_bf16(Bt[n][k], At[m][k], acc[ai][bj][m][n], 0, 0, 0); __builtin_amdgcn_s_setprio(0); } while (0)
#define PG8_WAIT_V(n) asm volatile("s_waitcnt vmcnt(" #n ")" ::: "memory")
#define PG8_WAIT_L(n) asm volatile("s_waitcnt lgkmcnt(" #n ")" ::: "memory")
#define PG8_BAR __builtin_amdgcn_s_barrier()
#define PG8_SCHED __builtin_amdgcn_sched_barrier(0)
    Unit cur, nxt; int ui = 0;
    if (!S.next(0, cur)) return;
    EpiCtx ctx; ctx.wr = wr; ctx.wc = wc; ctx.wid = wid; ctx.xl = xl;
    f32x4 acc[2][2][4][2];
#pragma unroll
    for (int a = 0; a < 2; ++a)
#pragma unroll
        for (int b = 0; b < 2; ++b)
#pragma unroll
            for (int m = 0; m < 4; ++m)
#pragma unroll
                for (int n = 0; n < 2; ++n) acc[a][b][m][n] = (f32x4){0.f, 0.f, 0.f, 0.f};
    bf16x8 At[4][2], B0[2][2], B1[2][2];
    const char* cA = cur.a; const char* cB = cur.b;
    if constexpr (SP2) {
        PG8_STAGE(PG8_SB(0, 0), cB, voffB); PG8_STAGE(PG8_SB(0, 1), cB + hstepB, voffB); PG8_STAGE(PG8_SA(0, 0), cA, voffA); PG8_STAGE(PG8_SA(0, 1), cA + hstepA, voffA);
        if (wr == 1) PG8_BAR;
        PG8_WAIT_V(2); PG8_BAR;
        PG8_STAGE(PG8_SB(1, 0), cB + kstep, voffB); PG8_STAGE(PG8_SA(1, 0), cA + kstep, voffA); PG8_STAGE(PG8_SB(1, 1), cB + hstepB + kstep, voffB);
        PG8_WAIT_V(6); PG8_BAR;
    } else {
        PG8_STAGE(PG8_SB(0, 0), cB, voffB); PG8_STAGE(PG8_SA(0, 0), cA, voffA); PG8_STAGE(PG8_SB(0, 1), cB + hstepB, voffB); PG8_STAGE(PG8_SA(0, 1), cA + hstepA, voffA);
        if (wr == 1) PG8_BAR;
        PG8_WAIT_V(4); PG8_BAR;
        PG8_STAGE(PG8_SB(1, 0), cB + kstep, voffB); PG8_STAGE(PG8_SA(1, 0), cA + kstep, voffA); PG8_STAGE(PG8_SB(1, 1), cB + hstepB + kstep, voffB);
        PG8_WAIT_V(6); PG8_BAR;
    }
    for (;;) {
        const bool has_next = S.next(ui + 1, nxt);
        const char* nA = has_next ? nxt.a : cA; const char* nB = has_next ? nxt.b : cB;
        for (int t = 0; t < nt; t += 2) {
            const bool last = (t == nt - 2);
            const char* a1 = cA + (size_t)(t + 1) * kstep;
            const char* a2 = last ? nA : cA + (size_t)(t + 2) * kstep; const char* b2 = last ? nB : cB + (size_t)(t + 2) * kstep;
            const char* a3 = a2 + kstep; const char* b3 = b2 + kstep;
            if constexpr (SP2) {
            PG8_LDB(B0, 0, 0); PG8_LDB(B1, 0, 1); PG8_SCHED; PG8_LDA(At, 0, 0); PG8_STAGE(PG8_SA(1, 1), a1 + hstepA, voffA);
            PG8_WAIT_V(8); PG8_WAIT_L(0); PG8_BAR; PG8_MMA(0, 0, At, B0); PG8_MMA(0, 1, At, B1); PG8_BAR; PG8_SCHED;
            PG8_LDA(At, 0, 1); PG8_STAGE(PG8_SB(0, 0), b2, voffB); PG8_STAGE(PG8_SB(0, 1), b2 + hstepB, voffB); PG8_STAGE(PG8_SA(0, 0), a2, voffA);
            PG8_WAIT_V(8); PG8_WAIT_L(0); PG8_BAR; PG8_MMA(1, 0, At, B0); PG8_MMA(1, 1, At, B1); PG8_BAR; PG8_SCHED;
            PG8_LDB(B0, 1, 0); PG8_LDB(B1, 1, 1); PG8_SCHED; PG8_LDA(At, 1, 0); PG8_STAGE(PG8_SA(0, 1), a2 + hstepA, voffA);
            PG8_WAIT_V(8); PG8_WAIT_L(0); PG8_BAR; PG8_MMA(0, 0, At, B0); PG8_MMA(0, 1, At, B1); PG8_BAR; PG8_SCHED;
            PG8_LDA(At, 1, 1); PG8_STAGE(PG8_SB(1, 0), b3, voffB); PG8_STAGE(PG8_SB(1, 1), b3 + hstepB, voffB); PG8_STAGE(PG8_SA(1, 0), a3, voffA);
            PG8_WAIT_V(8); PG8_WAIT_L(0); PG8_BAR; PG8_MMA(1, 0, At, B0); PG8_MMA(1, 1, At, B1); PG8_BAR; PG8_SCHED;
            } else {
            PG8_LDB(B0, 0, 0); PG8_SCHED; PG8_LDA(At, 0, 0); PG8_STAGE(PG8_SA(1, 1), a1 + hstepA, voffA);
            PG8_WAIT_L(8); PG8_BAR; PG8_WAIT_L(0); PG8_MMA(0, 0, At, B0); PG8_BAR; PG8_SCHED;
            PG8_LDB(B1, 0, 1); PG8_STAGE(PG8_SB(0, 0), b2, voffB);
            PG8_BAR; PG8_WAIT_L(0); PG8_MMA(0, 1, At, B1); PG8_BAR;
            PG8_LDA(At, 0, 1); PG8_STAGE(PG8_SA(0, 0), a2, voffA);
            PG8_BAR; PG8_WAIT_L(0); PG8_MMA(1, 0, At, B0); PG8_BAR; PG8_SCHED;
            PG8_STAGE(PG8_SB(0, 1), b2 + hstepB, voffB);
            PG8_WAIT_V(6); PG8_BAR; PG8_MMA(1, 1, At, B1); PG8_BAR;
            PG8_LDB(B0, 1, 0); PG8_SCHED; PG8_LDA(At, 1, 0); PG8_STAGE(PG8_SA(0, 1), a2 + hstepA, voffA);
            PG8_WAIT_L(8); PG8_BAR; PG8_WAIT_L(0); PG8_MMA(0, 0, At, B0); PG8_BAR; PG8_SCHED;
            PG8_LDB(B1, 1, 1); PG8_STAGE(PG8_SB(1, 0), b3, voffB);
            PG8_BAR; PG8_WAIT_L(0); PG8_MMA(0, 1, At, B1); PG8_BAR;
            PG8_LDA(At, 1, 1); PG8_STAGE(PG8_SA(1, 0), a3, voffA);
            PG8_BAR; PG8_WAIT_L(0); PG8_MMA(1, 0, At, B0); PG8_BAR; PG8_SCHED;
            PG8_STAGE(PG8_SB(1, 1), b3 + hstepB, voffB);
            PG8_WAIT_V(6); PG8_BAR; PG8_MMA(1, 1, At, B1); PG8_BAR;
            }
        }
        if constexpr (ALIGN_EPI) { if (wr == 0) PG8_BAR; }
        E(acc, cur, ctx);
        if (!has_next) break;
#pragma unroll
        for (int a = 0; a < 2; ++a)
#pragma unroll
            for (int b = 0; b < 2; ++b)
#pragma unroll
                for (int m = 0; m < 4; ++m)
#pragma unroll
                    for (int n = 0; n < 2; ++n) acc[a][b][m][n] = (f32x4){0.f, 0.f, 0.f, 0.f};
        cur = nxt; cA = nA; cB = nB; ++ui;
        if constexpr (ALIGN_EPI) { if (wr == 1) PG8_BAR; }
    }
    PG8_WAIT_V(0);
    if constexpr (!ALIGN_EPI) { if (wr == 0) PG8_BAR; }
    PG8_BAR;
#undef PG8_SA
#undef PG8_SB
#undef PG8_STAGE
#undef PG8_LDA
#undef PG8_LDB
#undef PG8_MMA
#undef PG8_WAIT_V
#undef PG8_WAIT_L
#undef PG8_BAR
#undef PG8_SCHED
}
}

constexpr size_t MiB = 1u << 20;
constexpr size_t WS_CTL = 0, CTL_ZERO_BYTES = 1 * MiB;
constexpr size_t WS_WIN_T = 1 * MiB, WS_WF_T = 11 * MiB, WS_WOUT_T = 15 * MiB, WS_WCQ_T = 23 * MiB, WS_WCK_T = 39 * MiB, WS_WCV_T = 55 * MiB, WS_WCO_T = 71 * MiB;
constexpr size_t WS_WP_T = 87 * MiB, WS_DFT = 89 * MiB, WS_ROPE = 105 * MiB, WS_WGU_T = 106 * MiB, WS_WD_T = 234 * MiB;
constexpr size_t WS_HN = 298 * MiB, WS_XB = 330 * MiB, WS_QB = 362 * MiB, WS_KB = 386 * MiB, WS_VB = 394 * MiB, WS_FPQ = 402 * MiB, WS_MIXB = 418 * MiB, WS_QCB = 450 * MiB;
constexpr size_t WS_KCB = 482 * MiB, WS_VTB = 490 * MiB, WS_MEMNB = 498 * MiB, WS_PB = 506 * MiB, WS_XSB = 522 * MiB, WS_ACTB = 586 * MiB, WS_YB = 618 * MiB;
constexpr size_t WS_SSP = 682 * MiB, WS_AFF = 683 * MiB, WS_RANK = 684 * MiB, WS_GATE = 685 * MiB, WS_XALT = 686 * MiB, WS_WGU_T2 = 750 * MiB, WS_WD_T2 = 878 * MiB, WS_FAST_END = 942 * MiB;
constexpr int CW_TMO = 0, CW_CODE = 1, CW_BAR = 4096;
constexpr int RING_OFF = 0, RING_BYTES = 131072, XL_OFF = 131072, XL_BYTES = 14336, LDSCTL_OFF = XL_OFF + XL_BYTES, MISC_OFF = LDSCTL_OFF + 320, LDS_BYTES = 147456;
static_assert(MISC_OFF + 128 <= LDS_BYTES, "LDS map");
constexpr int NWAVES = 8;

typedef GAS unsigned gu32;
#define RLX_AGENT __ATOMIC_RELAXED, __HIP_MEMORY_SCOPE_AGENT

#define XB_TMO      128
#define XB_XCNT(j)  (256  + 64 * (j))
#define XB_XSUB(j)  (1280 + 64 * (j))
#define XB_XGEN(j)  (2304 + 64 * (j))
#define XB_TOP      3328
#define XB_TOPGEN   3392
#define XCD_BAR_WORDS 3456
#define XB_SPIN_CAP (1u << 18)
__device__ __forceinline__ unsigned xb_ld(unsigned* p)              { return __hip_atomic_load(p, __ATOMIC_RELAXED, __HIP_MEMORY_SCOPE_AGENT); }
__device__ __forceinline__ unsigned xb_add(unsigned* p, unsigned v) { return __hip_atomic_fetch_add(p, v, __ATOMIC_RELAXED, __HIP_MEMORY_SCOPE_AGENT); }
__device__ __forceinline__ unsigned xb_xcc_id() { return (unsigned)__builtin_amdgcn_s_getreg((3 << 11) | 20) & 0xFu; }
#define XB_SPIN(cond, bar) do { unsigned _sp = 0; while (cond) { __builtin_amdgcn_s_sleep(1); \
    if ((++_sp & 255u) == 0u) { if (xb_ld(&(bar)[XB_TMO])) break; if (_sp > XB_SPIN_CAP) { atomicAdd(&(bar)[XB_TMO], 1u); break; } } } } while (0)
struct XcdBarrier { unsigned* bar; unsigned x; volatile LAS unsigned* st; int wave; };
__device__ __forceinline__ XcdBarrier xcd_barrier_post(unsigned* bar, volatile LAS unsigned* st, int wave) {
    XcdBarrier b; b.bar = bar; b.x = xb_xcc_id(); b.st = st; b.wave = wave;
    if (wave == 0 && lane_id() == 0) (void)xb_add(&bar[XB_XCNT(b.x)], 1u);
    return b;
}
__device__ __forceinline__ void xcd_barrier_complete(unsigned* bar, unsigned x, unsigned& nloc, unsigned& nx) {
    const unsigned G = gridDim.x * gridDim.y * gridDim.z;
    unsigned sum, cnt, mine, sp = 0u;
    for (;;) {
        sum = 0u; cnt = 0u; mine = 0u;
#pragma unroll
        for (unsigned j = 0; j < 16; ++j) { const unsigned c = xb_ld(&bar[XB_XCNT(j)]); sum += c; cnt += (c > 0u) ? 1u : 0u; mine = (j == x) ? c : mine; }
        if (sum == G) break;
        __builtin_amdgcn_s_sleep(1);
        if ((++sp & 255u) == 0u) { if (xb_ld(&bar[XB_TMO])) break; if (sp > XB_SPIN_CAP) { atomicAdd(&bar[XB_TMO], 1u); break; } }
    }
    nloc = mine > 0u ? mine : 1u; nx = cnt > 0u ? cnt : 1u;
}
__device__ __forceinline__ void xcd_barrier(const XcdBarrier& b) {
    asm volatile("s_waitcnt vmcnt(0)" ::: "memory");
    __syncthreads();
    if (b.wave == 0 && lane_id() == 0) {
        unsigned* bar = b.bar;
        __builtin_amdgcn_s_waitcnt(0);
        unsigned nloc = b.st[0], nx = b.st[1];
        if (nloc == 0u) { xcd_barrier_complete(bar, b.x, nloc, nx); b.st[0] = nloc; b.st[1] = nx; }
        const unsigned old = xb_add(&bar[XB_XSUB(b.x)], 1u);
        const unsigned gen = old / nloc;
        if (old + 1u == (gen + 1u) * nloc) {
            __builtin_amdgcn_fence(__ATOMIC_RELEASE, "agent");
            asm volatile("s_waitcnt vmcnt(0)" ::: "memory");
            const unsigned og = xb_add(&bar[XB_TOP], 1u);
            const unsigned tg = og / nx;
            if (og + 1u == (tg + 1u) * nx) xb_add(&bar[XB_TOPGEN], 1u);
            else XB_SPIN(xb_ld(&bar[XB_TOPGEN]) == tg, bar);
            __builtin_amdgcn_fence(__ATOMIC_ACQUIRE, "agent");
            xb_add(&bar[XB_XGEN(b.x)], 1u);
            asm volatile("s_waitcnt vmcnt(0)" ::: "memory");
        } else {
            XB_SPIN(xb_ld(&bar[XB_XGEN(b.x)]) == gen, bar);
            __builtin_amdgcn_fence(__ATOMIC_ACQUIRE, "agent");
            asm volatile("s_waitcnt vmcnt(0)" ::: "memory");
        }
    }
    __syncthreads();
}

struct Args { const float* in[22]; float* out; unsigned char* ws; int ph_lo, ph_hi, li, pad; };
struct Frame {
    LAS unsigned char* lds; volatile LAS unsigned* MISC; gu32* ctl;
    int wave, vcu, G;
    unsigned char* ws;
};
__device__ __forceinline__ float wave_sum(float v) {
#pragma unroll
    for (int o = 1; o < 64; o <<= 1) v += __shfl_xor(v, o);
    return v;
}
struct TrDesc { const float* W; const float* gain; bf16_t* WT; int ldw, ldt, k0, n0; long drow0; };
__device__ __forceinline__ void tr_load(const TrDesc& d, f32x4 (&v)[16], int lane) {
    const int lr = lane >> 4, lc = (lane & 15) * 4;
#pragma unroll
    for (int i = 0; i < 16; ++i) v[i] = __builtin_nontemporal_load((const GAS f32x4*)(d.W + (size_t)(d.k0 + 4 * i + lr) * d.ldw + d.n0 + lc));
}
#ifndef TRV
#define TRV 0
#endif
template <int V> __device__ __forceinline__ void tr_finish(const TrDesc& d, const f32x4 (&v)[16], LAS float* scr, int lane) {
    const int lr = lane >> 4, lc = (lane & 15) * 4;
    if (V == 1) { f32x4 s = v[0]; for (int i = 1; i < 16; ++i) s = s + v[i]; if (s.x == 1.2345e30f) *(GAS f32x4*)(d.WT) = s; return; }
#pragma unroll
    for (int i = 0; i < 16; ++i) { const int kk = 4 * i + lr; f32x4 x = v[i]; if (d.gain) x = x * d.gain[d.k0 + kk];
        LAS float* s = scr + kk * 65 + lc; s[0] = x.x; s[1] = x.y; s[2] = x.z; s[3] = x.w; }
    LDS_WAIT(); asm volatile("" ::: "memory");
    const int c = lane & 7;
#pragma unroll
    for (int j = 0; j < 8; ++j) { const int n = (lane >> 3) + 8 * j; const LAS float* s = scr + (8 * c) * 65 + n;
        u32x4 o; o.x = cvtpk(s[0 * 65], s[1 * 65]); o.y = cvtpk(s[2 * 65], s[3 * 65]); o.z = cvtpk(s[4 * 65], s[5 * 65]); o.w = cvtpk(s[6 * 65], s[7 * 65]);
        if (V == 0 || o.x == 0x12345678u) *(GAS u32x4*)(d.WT + (size_t)(d.drow0 + n) * d.ldt + d.k0 + 8 * c) = o; }
    LDS_WAIT(); asm volatile("" ::: "memory");
}
#ifndef TR_PIPE
#define TR_PIPE 0
#endif
constexpr int TR_DENSE = 32 * 20 + 9 * 32 * 16 + 32 * 4, TR_EXPERT = NE * 768;
__device__ __forceinline__ TrDesc tr_desc(karg_t ka, unsigned char* ws, int it, int mode) {
    TrDesc d; d.gain = nullptr;
    constexpr int I_IN = 32 * 20, I_SQ = 32 * 16;
    if (mode == 0) {
        int r = it;
        if (r < I_IN) { d.W = KIN(ka, 3); d.ldw = INW; d.WT = (bf16_t*)(ws + WS_WIN_T); d.ldt = DM; d.k0 = (r / 20) * 64; d.n0 = (r % 20) * 128; d.drow0 = d.n0; return d; } r -= I_IN;
        if (r < I_SQ) { d.W = KIN(ka, 7); d.ldw = DM; d.WT = (bf16_t*)(ws + WS_WOUT_T); d.ldt = DM; d.k0 = (r / 16) * 64; d.n0 = (r % 16) * 128; d.drow0 = d.n0; return d; } r -= I_SQ;
        if (r < 8 * I_SQ) { const int j = r / I_SQ, q = r % I_SQ, wsel = j >> 1, layer = j & 1;
            d.W = KIN(ka, 12 + wsel) + (size_t)layer * DM * DM; d.ldw = DM; if (wsel == 0) d.gain = KIN(ka, 10) + layer * DM;
            d.WT = (bf16_t*)(ws + (wsel == 0 ? WS_WCQ_T : wsel == 1 ? WS_WCK_T : wsel == 2 ? WS_WCV_T : WS_WCO_T) + (size_t)layer * DM * DM * 2); d.ldt = DM;
            d.k0 = (q / 16) * 64; d.n0 = (q % 16) * 128; d.drow0 = d.n0; return d; } r -= 8 * I_SQ;
        d.W = KIN(ka, 8); d.ldw = 512; d.WT = (bf16_t*)(ws + WS_WP_T); d.ldt = DM; d.k0 = (r / 4) * 64; d.n0 = (r % 4) * 128; d.drow0 = d.n0; return d;
    }
    const int layer = mode - 1;
    const int e = it / 768, r = it % 768; const size_t eo = (size_t)(layer * NE + e);
    if (r < 512) { const int up = r >> 8, q = r & 255, kb = q >> 3, nb = q & 7, n0 = nb * 128;
        d.W = (up ? KIN(ka, 19) : KIN(ka, 18)) + eo * DM * EFF; d.ldw = EFF; d.WT = (bf16_t*)(ws + (layer ? WS_WGU_T2 : WS_WGU_T)) + (size_t)e * 2048 * 2048; d.ldt = 2048;
        d.k0 = kb * 64; d.n0 = n0; d.drow0 = (long)(n0 >> 7) * 256 + up * 128;
    } else { const int q = r - 512, kb = q >> 4, nb = q & 15;
        d.W = KIN(ka, 20) + eo * EFF * DM; d.ldw = DM; d.WT = (bf16_t*)(ws + (layer ? WS_WD_T2 : WS_WD_T)) + (size_t)e * 2048 * 1024; d.ldt = 1024; d.k0 = kb * 64; d.n0 = nb * 128; d.drow0 = nb * 128; }
    return d;
}
template <int V = 0> __device__ __forceinline__ void tr_span(const Frame& F, karg_t ka, unsigned char* ws, int mode, int first, int stride, int cnt) {
    const int lane = lane_id(); LAS float* scr = (LAS float*)(F.lds + RING_OFF + F.wave * 16640);
    if (cnt <= 0) return;
    f32x4 va[16], vb[16];
    TrDesc da = tr_desc(ka, ws, first, mode), db = da; db.n0 += 64; db.drow0 += 64;
    tr_load(da, va, lane); tr_load(db, vb, lane);
    for (int j = 0; j < cnt; ++j) {
        const bool more = j + 1 < cnt; TrDesc na = da, nb = db;
        if (more) { na = tr_desc(ka, ws, first + stride * (j + 1), mode); nb = na; nb.n0 += 64; nb.drow0 += 64; }
        tr_finish<V>(da, va, scr, lane); if (more) tr_load(na, va, lane);
        tr_finish<V>(db, vb, scr, lane); if (more) tr_load(nb, vb, lane);
        da = na; db = nb;
    }
}
__device__ __forceinline__ void rms_row_to_bf16(const float* xrow, const float* __restrict__ gain, bf16_t* orow, int lane) {
    const GAS f32x4* xr = (const GAS f32x4*)xrow + lane; const f32x4* gr = (const f32x4*)gain + lane;
    f32x4 v[8]; float s = 0.f;
#pragma unroll
    for (int j = 0; j < 8; ++j) { v[j] = xr[64 * j]; s += (v[j].x * v[j].x + v[j].y * v[j].y) + (v[j].z * v[j].z + v[j].w * v[j].w); }
    const float r = rsqrtf(wave_sum(s) * (1.f / DM) + EPS);
    GAS u32x2* o8 = (GAS u32x2*)orow + lane;
#pragma unroll
    for (int j = 0; j < 8; ++j) { const f32x4 g = gr[64 * j]; u32x2 w; w.x = cvtpk(v[j].x * r * g.x, v[j].y * r * g.y); w.y = cvtpk(v[j].z * r * g.z, v[j].w * r * g.w); o8[64 * j] = w; }
}

__device__ __forceinline__ void p0_prologue(Frame& F, karg_t ka, unsigned char* ws) {
    const float* x = KIN(ka, 0); const float* mem = KIN(ka, 1); const float* mix_norm = KIN(ka, 2); const float* w_in = KIN(ka, 3);
    const float* w_four = KIN(ka, 6); const float* w_out = KIN(ka, 7); const float* pool_w = KIN(ka, 8); const float* cross_norm = KIN(ka, 10); const float* mem_norm = KIN(ka, 11);
    const int gw = F.vcu * NWAVES + F.wave, NGW = F.G * NWAVES;
    const int p_lane = lane_id(), p_tid = F.wave * 64 + p_lane;
    { LAS float* tab = (LAS float*)(F.lds + RING_OFF);
      for (int m = p_tid; m < 2048; m += 512) tab[m] = cosf(6.283185307179586f * (float)m * (1.0f / 2048.0f));
      __syncthreads();
      bf16_t* DFT = (bf16_t*)(ws + WS_DFT);
      for (int row = F.vcu * 8; row < 2048; row += F.G * 8)
          for (int rr = 0; rr < 8; ++rr) { const int k1 = row + rr; if (k1 >= 2048) break;
              { const int c0 = p_tid * 8; const int which = c0 >> 11, s0 = c0 & 2047; unsigned w[4];
#pragma unroll
                for (int j = 0; j < 4; ++j) { const int ma = (k1 * (s0 + 2 * j)) & 2047, mb = (k1 * (s0 + 2 * j + 1)) & 2047;
                    w[j] = cvtpk(tab[(ma - which * 512) & 2047], tab[(mb - which * 512) & 2047]); }
                *(GAS u32x4*)(DFT + (size_t)k1 * 4096 + c0) = (u32x4){w[0], w[1], w[2], w[3]}; } }
      __syncthreads(); }
    { float* RC = (float*)(ws + WS_ROPE); float* RS = RC + SEQ * 64;
      for (int i = F.vcu * 512 + p_tid; i < SEQ * 64; i += F.G * 512) { const int t = i >> 6, p = i & 63; const int pos = (p < 32) ? (t >> 6) : (t & 63); const int j = p & 31;
          const float inv = 1.0f / powf(10000.0f, (float)(2 * j) / 64.0f); const float ang = (float)pos * inv; RC[i] = cosf(ang); RS[i] = sinf(ang); } }
    { LAS float* Mw = (LAS float*)(F.lds + RING_OFF); LAS float* t128 = Mw + 128 * 32;
      bf16_t* WF = (bf16_t*)(ws + WS_WF_T);
      for (int it = F.vcu; it < 256; it += F.G) {
          const int which = it >> 7, g = (it >> 5) & 3, d0 = ((it >> 3) & 3) * 32, k0 = (it & 7) * 256;
          if (p_tid < 128) t128[p_tid] = cosf(6.283185307179586f * (float)p_tid * (1.0f / 128.0f));
          __syncthreads();
          { const int c = p_tid >> 2, dd = (p_tid & 3) * 8; float o[8] = {0.f, 0.f, 0.f, 0.f, 0.f, 0.f, 0.f, 0.f};
            for (int k2 = 0; k2 < 128; ++k2) { const int m = (c * k2) & 127; const float tv = which ? -t128[(m - 32) & 127] : t128[m];
                const float* wr_ = w_four + ((size_t)g * 128 + k2) * 128 + d0 + dd; const f32x4 w0 = *(const f32x4*)wr_, w1 = *(const f32x4*)(wr_ + 4);
                o[0] += tv * w0.x; o[1] += tv * w0.y; o[2] += tv * w0.z; o[3] += tv * w0.w; o[4] += tv * w1.x; o[5] += tv * w1.y; o[6] += tv * w1.z; o[7] += tv * w1.w; }
#pragma unroll
            for (int j = 0; j < 8; ++j) Mw[c * 32 + dd + j] = o[j] * (1.0f / 512.0f); }
          __syncthreads();
          { const int kp = p_tid & 127, dq = p_tid >> 7, k = k0 + 2 * kp; float o0[8] = {0.f, 0.f, 0.f, 0.f, 0.f, 0.f, 0.f, 0.f}, o1[8] = {0.f, 0.f, 0.f, 0.f, 0.f, 0.f, 0.f, 0.f};
            const float* r0 = w_in + (size_t)k * INW + 2560 + g * 128; const float* r1 = r0 + INW;
            for (int c4 = 0; c4 < 32; ++c4) { const f32x4 a = *(const f32x4*)(r0 + 4 * c4), b = *(const f32x4*)(r1 + 4 * c4); const float av[4] = {a.x, a.y, a.z, a.w}, bv[4] = {b.x, b.y, b.z, b.w};
#pragma unroll
                for (int cc = 0; cc < 4; ++cc) { const LAS float* mr = Mw + (4 * c4 + cc) * 32 + dq * 8;
#pragma unroll
                    for (int j = 0; j < 8; ++j) { o0[j] += av[cc] * mr[j]; o1[j] += bv[cc] * mr[j]; } } }
#pragma unroll
            for (int j = 0; j < 8; ++j) *(GAS unsigned*)(WF + (size_t)(which * 512 + g * 128 + d0 + dq * 8 + j) * DM + k) = cvtpk(o0[j], o1[j]); }
          __syncthreads(); } }
    { const int n = (TR_DENSE - gw + NGW - 1) / NGW; tr_span(F, ka, ws, 0, gw, NGW, n > 0 ? n : 0); }
    __syncthreads();
    for (int m = gw; m < NTOK; m += NGW) rms_row_to_bf16(x + (size_t)m * DM, mix_norm, (bf16_t*)(ws + WS_HN) + (size_t)m * DM, p_lane);
    for (int m = gw; m < 2 * NB * MEML; m += NGW) { const int l = m / (NB * MEML), r = m % (NB * MEML);
        rms_row_to_bf16(mem + (size_t)r * DM, mem_norm + l * DM, (bf16_t*)(ws + WS_MEMNB) + (size_t)m * DM, p_lane); }
}

struct MapLin { const char* A; const char* B; size_t as, bs; __device__ __forceinline__ void operator()(pg8::Unit& u) const { u.a = A + (size_t)u.pm * as; u.b = B + (size_t)u.pn * bs; } };

struct EpiQKV {
    static constexpr bool PERM = true;
    bf16_t* Q; bf16_t* K; bf16_t* V; const float* qg; const float* kg; const float* RC; const float* RS;
    __device__ __forceinline__ void operator()(f32x4 (&acc)[2][2][4][2], const pg8::Unit& u, const pg8::EpiCtx& c) const { const int e_lane = lane_id(), e_fr = e_lane & 15, e_fq = e_lane >> 4;
        const int pn = u.pn, hc = c.wc * 32 + e_fq * 8, rl0 = c.wr * 64 + e_fr;
        if (pn >= 8) {
            bf16_t* base = V + (size_t)(u.pm * 256 + rl0) * KVW + (pn - 8) * 256 + hc;
#pragma unroll
            for (int ai = 0; ai < 2; ++ai)
#pragma unroll
                for (int m = 0; m < 4; ++m) { bf16_t* rowp = base + (size_t)(ai * 128 + m * 16) * KVW;
#pragma unroll
                    for (int bj = 0; bj < 2; ++bj) { const f32x4 v0 = acc[ai][bj][m][0], v1 = acc[ai][bj][m][1];
                        *(u32x4*)(rowp + bj * 128) = (u32x4){cvtpk(v0.x, v0.y), cvtpk(v0.z, v0.w), cvtpk(v1.x, v1.y), cvtpk(v1.z, v1.w)}; } }
            return;
        }
        LAS float* part = (LAS float*)c.xl;
#pragma unroll
        for (int ai = 0; ai < 2; ++ai)
#pragma unroll
            for (int m = 0; m < 4; ++m)
#pragma unroll
                for (int bj = 0; bj < 2; ++bj) { const f32x4 v0 = acc[ai][bj][m][0], v1 = acc[ai][bj][m][1];
                    float s = (v0.x * v0.x + v0.y * v0.y) + (v0.z * v0.z + v0.w * v0.w) + (v1.x * v1.x + v1.y * v1.y) + (v1.z * v1.z + v1.w * v1.w);
                    s += __shfl_xor(s, 16); s += __shfl_xor(s, 32);
                    if (e_fq == 0) part[((ai * 128 + rl0 + m * 16) * 2 + bj) * 4 + c.wc] = s; }
        WG_BAR();
        const float* gain = pn < 6 ? qg : kg;
        const f32x4 g0 = *(const f32x4*)(gain + hc), g1 = *(const f32x4*)(gain + hc + 4);
        bf16_t* O = pn < 6 ? Q : K; const int ld = pn < 6 ? AW : KVW; const int colbase = (pn < 6 ? pn : pn - 6) * 256 + hc;
#pragma unroll
        for (int ai = 0; ai < 2; ++ai)
#pragma unroll
            for (int m = 0; m < 4; ++m) { const int rl = ai * 128 + rl0 + m * 16, row = u.pm * 256 + rl, sp = row & (SEQ - 1);
                const f32x4 cs = *(const f32x4*)(RC + sp * 64 + (hc >> 1)), sn = *(const f32x4*)(RS + sp * 64 + (hc >> 1));
#pragma unroll
                for (int bj = 0; bj < 2; ++bj) { const f32x4 p4 = *(const LAS f32x4*)(part + (rl * 2 + bj) * 4);
                    const float r = rsqrtf(((p4.x + p4.y) + (p4.z + p4.w)) * (1.0f / 128.0f) + EPS);
                    const f32x4 v0 = acc[ai][bj][m][0] * r * g0, v1 = acc[ai][bj][m][1] * r * g1;
                    u32x4 w; w.x = cvtpk(v0.x * cs.x - v0.y * sn.x, v0.x * sn.x + v0.y * cs.x); w.y = cvtpk(v0.z * cs.y - v0.w * sn.y, v0.z * sn.y + v0.w * cs.y);
                    w.z = cvtpk(v1.x * cs.z - v1.y * sn.z, v1.x * sn.z + v1.y * cs.z); w.w = cvtpk(v1.z * cs.w - v1.w * sn.w, v1.z * sn.w + v1.w * cs.w);
                    *(u32x4*)(O + (size_t)row * ld + colbase + bj * 128) = w; } }
    }
};


template <class AddrF> struct EpiStore {
    static constexpr bool PERM = true; AddrF f;
    __device__ __forceinline__ void operator()(f32x4 (&acc)[2][2][4][2], const pg8::Unit& u, const pg8::EpiCtx& c) const { const int e_lane = lane_id(), e_fr = e_lane & 15, e_fq = e_lane >> 4;
        const int hc = c.wc * 32 + e_fq * 8, rl0 = c.wr * 64 + e_fr;
#pragma unroll
        for (int ai = 0; ai < 2; ++ai)
#pragma unroll
            for (int m = 0; m < 4; ++m)
#pragma unroll
                for (int bj = 0; bj < 2; ++bj) { const f32x4 v0 = acc[ai][bj][m][0], v1 = acc[ai][bj][m][1];
                    *(u32x4*)f(u, ai * 128 + rl0 + m * 16, bj * 128 + hc) = (u32x4){cvtpk(v0.x, v0.y), cvtpk(v0.z, v0.w), cvtpk(v1.x, v1.y), cvtpk(v1.z, v1.w)}; }
    }
};
struct AddrF1 { bf16_t* FPQ; __device__ __forceinline__ bf16_t* operator()(const pg8::Unit& u, int rl, int tc) const {
    const int r = u.pm * 256 + rl, which = r >> 9, n = r & 511, cidx = u.pn * 256 + tc, b = cidx >> 11, s = cidx & 2047; return FPQ + (((size_t)(b * 512 + n) * 2 + which) * 2048 + s); } };
struct AddrF2 { bf16_t* MIX; __device__ __forceinline__ bf16_t* operator()(const pg8::Unit& u, int rl, int tc) const {
    const int row = (u.pn >> 1) * 2048 + u.pm * 256 + rl, col = AW + (u.pn & 1) * 256 + tc; return MIX + (size_t)row * DM + col; } };

template <bool BF32> struct EpiResB {
    static constexpr bool PERM = true;
    const void* base; bf16_t* xo; float* ssp; const float* cscale;
    __device__ __forceinline__ void operator()(f32x4 (&acc)[2][2][4][2], const pg8::Unit& u, const pg8::EpiCtx& c) const { const int e_lane = lane_id(), e_fr = e_lane & 15, e_fq = e_lane >> 4;
        const int hc = c.wc * 32 + e_fq * 8, rl0 = c.wr * 64 + e_fr;
        LAS float* part = (LAS float*)c.xl;
#pragma unroll
        for (int ai = 0; ai < 2; ++ai)
#pragma unroll
            for (int m = 0; m < 4; ++m) { const int rl = ai * 128 + rl0 + m * 16; float s = 0.f;
#pragma unroll
                for (int bj = 0; bj < 2; ++bj) { const int col = u.pn * 256 + bj * 128 + hc; const size_t off = (size_t)(u.pm * 256 + rl) * DM + col;
                    f32x4 v0 = acc[ai][bj][m][0], v1 = acc[ai][bj][m][1];
                    if (cscale) { v0 = v0 * *(const f32x4*)(cscale + col); v1 = v1 * *(const f32x4*)(cscale + col + 4); }
                    if (BF32) { v0 = v0 + *(const f32x4*)((const float*)base + off); v1 = v1 + *(const f32x4*)((const float*)base + off + 4); }
                    else { const u32x4 b = *(const u32x4*)((const bf16_t*)base + off);
                        v0.x += __uint_as_float(b.x << 16); v0.y += __uint_as_float(b.x & 0xffff0000u); v0.z += __uint_as_float(b.y << 16); v0.w += __uint_as_float(b.y & 0xffff0000u);
                        v1.x += __uint_as_float(b.z << 16); v1.y += __uint_as_float(b.z & 0xffff0000u); v1.z += __uint_as_float(b.w << 16); v1.w += __uint_as_float(b.w & 0xffff0000u); }
                    *(u32x4*)(xo + off) = (u32x4){cvtpk(v0.x, v0.y), cvtpk(v0.z, v0.w), cvtpk(v1.x, v1.y), cvtpk(v1.z, v1.w)};
                    if (ssp) s += ((v0.x * v0.x + v0.y * v0.y) + (v0.z * v0.z + v0.w * v0.w)) + ((v1.x * v1.x + v1.y * v1.y) + (v1.z * v1.z + v1.w * v1.w)); }
                if (ssp) { s += __shfl_xor(s, 16); s += __shfl_xor(s, 32); if (e_fq == 0) part[rl * 4 + c.wc] = s; }
                asm volatile("" ::: "memory"); }
        if (ssp) { WG_BAR();
            if (e_lane < 32) { const int row = c.wid * 32 + e_lane; const f32x4 p4 = *(const LAS f32x4*)(part + row * 4);
                ssp[(size_t)(u.pm * 256 + row) * 8 + u.pn] = (p4.x + p4.y) + (p4.z + p4.w); }
            WG_BAR(); }
    }
};

namespace attn {
using s16x4 = __attribute__((ext_vector_type(4))) short;
using f32x16 = __attribute__((ext_vector_type(16))) float;
constexpr int D = 128, NW = 8, QBLK = 32, KVBLK = 64;
constexpr float SCALE = 0.088388347648318440f;
constexpr float THR = 0.f;
#ifndef ATT_SDEPTH
#define ATT_SDEPTH 1
#endif
constexpr int LDQ = AW, LDK = KVW, LDO = DM;
constexpr size_t SHM_V = KVBLK * D * 2, SHM_K = KVBLK * D * 2, SHM_ATTN = 2 * SHM_V + 2 * SHM_K + NW * 64 * 4;
#define KSWZ(row, colB) ((row) * 256 + ((colB) ^ (((row) & 7) << 4)))
#define SBAR() __builtin_amdgcn_sched_barrier(0)
__device__ __forceinline__ int crow(int r, int hi) { return (r & 3) + 8 * (r >> 2) + 4 * hi; }
__device__ __forceinline__ unsigned cvtpk_a(float lo, float hi) { unsigned r; asm volatile("v_cvt_pk_bf16_f32 %0, %1, %2" : "=v"(r) : "v"(lo), "v"(hi)); return r; }
__device__ __forceinline__ void partialSM(f32x16& p0, f32x16& p1, float& m_reg, float& mn, float& alpha) {
  constexpr float C = SCALE * 1.4426950408889634f;
  float pmax = p0[0]; for (int r = 1; r < 16; ++r) pmax = fmaxf(pmax, p0[r]); for (int r = 0; r < 16; ++r) pmax = fmaxf(pmax, p1[r]);
  { auto rr = __builtin_amdgcn_permlane32_swap(__float_as_uint(pmax), __float_as_uint(pmax), false, false);
    pmax = fmaxf(__uint_as_float(rr[0]), __uint_as_float(rr[1])); }
  if (__builtin_expect(__all(pmax - m_reg <= THR / SCALE), 1)) { mn = m_reg; alpha = 1.f; }
  else { mn = fmaxf(m_reg, pmax); alpha = __builtin_amdgcn_exp2f((m_reg - mn) * C); m_reg = mn; }
  float mnC = -mn * C;
  for (int r = 0; r < 16; ++r) p0[r] = fmaf(p0[r], C, mnC); for (int r = 0; r < 16; ++r) p1[r] = fmaf(p1[r], C, mnC);
  for (int r = 0; r < 16; ++r) p0[r] = __builtin_amdgcn_exp2f(p0[r]);
}
__device__ __forceinline__ void finishSM(f32x16& p0, f32x16& p1, float alpha, float& l_reg, bf16x8& pa0, bf16x8& pa1, bf16x8& pa2, bf16x8& pa3) {
  for (int r = 0; r < 16; ++r) p1[r] = __builtin_amdgcn_exp2f(p1[r]);
  float ps = 0; for (int r = 0; r < 16; ++r) ps += p0[r]; for (int r = 0; r < 16; ++r) ps += p1[r];
  { auto rr = __builtin_amdgcn_permlane32_swap(__float_as_uint(ps), __float_as_uint(ps), false, false);
    ps = __uint_as_float(rr[0]) + __uint_as_float(rr[1]); }
  l_reg = l_reg * alpha + ps;
#define PK4(P, BASE, OUT) do { unsigned a0 = cvtpk_a(P[BASE + 0], P[BASE + 1]), a1 = cvtpk_a(P[BASE + 2], P[BASE + 3]);   \
    unsigned b0 = cvtpk_a(P[BASE + 4], P[BASE + 5]), b1 = cvtpk_a(P[BASE + 6], P[BASE + 7]);                              \
    auto r0 = __builtin_amdgcn_permlane32_swap(a0, b0, false, false); auto r1 = __builtin_amdgcn_permlane32_swap(a1, b1, false, false); \
    u32x4 w = {r0[0], r1[0], r0[1], r1[1]}; OUT = *reinterpret_cast<bf16x8*>(&w); } while (0)
  PK4(p0, 0, pa0); PK4(p0, 8, pa1); PK4(p1, 0, pa2); PK4(p1, 8, pa3);
#undef PK4
}
__device__ __forceinline__ void qkt(f32x16& p0, f32x16& p1, const bf16_t* Ks, const bf16x8* qr, int r32, int hi) {
  p0 = f32x16{}; p1 = f32x16{};
  for (int d0 = 0; d0 < 8; ++d0) { int cb = (d0 * 16 + hi * 8) * 2;
    bf16x8 b0 = *reinterpret_cast<const bf16x8*>((const char*)Ks + KSWZ(r32, cb));
    bf16x8 b1 = *reinterpret_cast<const bf16x8*>((const char*)Ks + KSWZ(32 + r32, cb));
    p0 = __builtin_amdgcn_mfma_f32_32x32x16_bf16(b0, qr[d0], p0, 0, 0, 0);
    p1 = __builtin_amdgcn_mfma_f32_32x32x16_bf16(b1, qr[d0], p1, 0, 0, 0); }
}
__device__ __forceinline__ int v_st(int k, int c) { const int kk = (k & ~0xC) | ((k & 4) << 1) | ((k & 8) >> 1); return ((kk >> 3) * 4 + (c >> 5)) * 512 + ((kk & 7) * 32 + (c & 31)) * 2; }
__device__ __forceinline__ int v_rd_base(int lane) { return ((lane & 3) << 3) | (((lane >> 2) & 3) << 6) | (((lane >> 4) & 1) << 5) | (((lane >> 5) & 1) << 8); }
constexpr int v_rd_off(int d0, int ks, int half) { return d0 * 512 + ks * 4096 + half * 2048; }
template <int OFF> __device__ __forceinline__ s16x4 tr_read(int vb) {
  s16x4 r; asm volatile("ds_read_b64_tr_b16 %0, %1 offset:%2" : "=&v"(r) : "v"(vb), "i"(OFF) : "memory"); return r;
}
template <int D0> __device__ __forceinline__ void pv_one(f32x16& od, int vb, bf16x8 pa0, bf16x8 pa1, bf16x8 pa2, bf16x8 pa3) {
  const s16x4 l0 = tr_read<v_rd_off(D0, 0, 0)>(vb), h0 = tr_read<v_rd_off(D0, 0, 1)>(vb), l1 = tr_read<v_rd_off(D0, 1, 0)>(vb), h1 = tr_read<v_rd_off(D0, 1, 1)>(vb);
  const s16x4 l2 = tr_read<v_rd_off(D0, 2, 0)>(vb), h2 = tr_read<v_rd_off(D0, 2, 1)>(vb), l3 = tr_read<v_rd_off(D0, 3, 0)>(vb), h3 = tr_read<v_rd_off(D0, 3, 1)>(vb);
  asm volatile("s_waitcnt lgkmcnt(0)" ::: "memory"); SBAR();
#define PK(L, H) (bf16x8){L[0], L[1], L[2], L[3], H[0], H[1], H[2], H[3]}
  od = __builtin_amdgcn_mfma_f32_32x32x16_bf16(pa0, PK(l0, h0), od, 0, 0, 0);
  od = __builtin_amdgcn_mfma_f32_32x32x16_bf16(pa1, PK(l1, h1), od, 0, 0, 0);
  od = __builtin_amdgcn_mfma_f32_32x32x16_bf16(pa2, PK(l2, h2), od, 0, 0, 0);
  od = __builtin_amdgcn_mfma_f32_32x32x16_bf16(pa3, PK(l3, h3), od, 0, 0, 0);
#undef PK
}
__device__ __forceinline__ void pv_d0(f32x16* o, int vb, bf16x8 pa0, bf16x8 pa1, bf16x8 pa2, bf16x8 pa3) {
  pv_one<0>(o[0], vb, pa0, pa1, pa2, pa3); pv_one<1>(o[1], vb, pa0, pa1, pa2, pa3); pv_one<2>(o[2], vb, pa0, pa1, pa2, pa3); pv_one<3>(o[3], vb, pa0, pa1, pa2, pa3);
}
__device__ __forceinline__ void attn_dense_body(const bf16_t* __restrict__ Qb, const bf16_t* __restrict__ Kh, const bf16_t* __restrict__ Vh,
                                                bf16_t* __restrict__ Ob, int seq, char* lds, const int wave_) {
  constexpr int SDEPTH = ATT_SDEPTH;
  const int lane = lane_id(), wid = wave_, tid = wid * 64 + lane, r32 = lane & 31, hi = lane >> 5;
  bf16_t* V_lds = (bf16_t*)lds; bf16_t* K_lds = (bf16_t*)(lds + 2 * SHM_V);
  float* ws = (float*)(lds + 2 * SHM_V + 2 * SHM_K) + wid * 64; float* li_l = ws; float* al_l = ws + 32;
  float m_reg = -1e30f, l_reg = 0; f32x16 o[4] = {}; bf16x8 qr[8];
  const bf16_t* Qw = Qb + (long)(wid * QBLK + r32) * LDQ + hi * 8;
#pragma unroll
  for (int d0 = 0; d0 < 8; ++d0) qr[d0] = *reinterpret_cast<const bf16x8*>(Qw + d0 * 16);
  const int sr = tid >> 4, sc = (tid & 15) * 8, vst0 = v_st(sr, sc), vst1 = v_st(32 + sr, sc);
  const int vb0 = (int)(uintptr_t)V_lds + v_rd_base(lane);
  struct { bf16x8 vs0, vs1, ks0, ks1; } sr_[SDEPTH];
#define SLOAD(i, k0) do { sr_[i].vs0 = *reinterpret_cast<const bf16x8*>(&Vh[(long)((k0) + sr) * LDK + sc]); sr_[i].vs1 = *reinterpret_cast<const bf16x8*>(&Vh[(long)((k0) + 32 + sr) * LDK + sc]); \
    sr_[i].ks0 = *reinterpret_cast<const bf16x8*>(&Kh[(long)((k0) + sr) * LDK + sc]); sr_[i].ks1 = *reinterpret_cast<const bf16x8*>(&Kh[(long)((k0) + 32 + sr) * LDK + sc]); } while (0)
#define SWRITE(b, i) do { *(bf16x8*)((char*)V_lds + (b) * SHM_V + vst0) = sr_[i].vs0;          \
    *(bf16x8*)((char*)V_lds + (b) * SHM_V + vst1) = sr_[i].vs1; int kc = sc * 2;               \
    *(bf16x8*)((char*)K_lds + (b) * SHM_K + KSWZ(sr, kc)) = sr_[i].ks0;                       \
    *(bf16x8*)((char*)K_lds + (b) * SHM_K + KSWZ(32 + sr, kc)) = sr_[i].ks1; } while (0)
#define SWAIT() do { if constexpr (SDEPTH == 2) asm volatile("s_waitcnt vmcnt(4)" ::: "memory"); else asm volatile("s_waitcnt vmcnt(0)" ::: "memory"); } while (0)
#define RESC(a) do { if (__any((a) < 1.f)) { if (hi == 0) al_l[r32] = (a); asm volatile("s_waitcnt lgkmcnt(0)" ::: "memory"); \
    for (int d = 0; d < 4; ++d) for (int r = 0; r < 16; ++r) o[d][r] *= al_l[crow(r, hi)]; } } while (0)
  f32x16 pA0, pA1, pB0, pB1; float mnA, mnB, alA, alB; bf16x8 pa0, pa1, pa2, pa3; const int NT = seq / KVBLK;
  constexpr int SE = 0, SO = SDEPTH - 1;
  SLOAD(SE, 0); asm volatile("s_waitcnt vmcnt(0)" ::: "memory"); SWRITE(0, SE); __syncthreads();
  qkt(pA0, pA1, K_lds, qr, r32, hi); partialSM(pA0, pA1, m_reg, mnA, alA);
  SLOAD(SO, KVBLK); if constexpr (SDEPTH == 2) { if (2 < NT) SLOAD(SE, 2 * KVBLK); }
  SWAIT(); SWRITE(1, SO); __syncthreads();
  for (int j = 1; j + 1 < NT; j += 2) {
    SBAR(); qkt(pB0, pB1, (bf16_t*)((char*)K_lds + SHM_K), qr, r32, hi);
    finishSM(pA0, pA1, alA, l_reg, pa0, pa1, pa2, pa3); SBAR();
    SLOAD(SO, (j + SDEPTH) * KVBLK); SBAR();
    pv_d0(o, vb0, pa0, pa1, pa2, pa3); partialSM(pB0, pB1, m_reg, mnB, alB);
    __syncthreads(); SWAIT(); SWRITE(0, SE);
    RESC(alB); __syncthreads();
    SBAR(); qkt(pA0, pA1, K_lds, qr, r32, hi);
    finishSM(pB0, pB1, alB, l_reg, pa0, pa1, pa2, pa3); SBAR();
    if (SDEPTH == 1 || j + 3 < NT) SLOAD(SE, (j + 1 + SDEPTH) * KVBLK); SBAR();
    pv_d0(o, vb0 + (int)SHM_V, pa0, pa1, pa2, pa3); partialSM(pA0, pA1, m_reg, mnA, alA);
    __syncthreads(); SWAIT(); SWRITE(1, SO);
    RESC(alA); __syncthreads();
  }
  SBAR(); qkt(pB0, pB1, (bf16_t*)((char*)K_lds + SHM_K), qr, r32, hi);
  finishSM(pA0, pA1, alA, l_reg, pa0, pa1, pa2, pa3); SBAR();
  pv_d0(o, vb0, pa0, pa1, pa2, pa3); partialSM(pB0, pB1, m_reg, mnB, alB);
  __syncthreads(); RESC(alB);
  finishSM(pB0, pB1, alB, l_reg, pa0, pa1, pa2, pa3); SBAR();
  pv_d0(o, vb0 + (int)SHM_V, pa0, pa1, pa2, pa3);
  if (hi == 0) li_l[r32] = l_reg; asm volatile("s_waitcnt lgkmcnt(0)" ::: "memory");
  float rli[16];
#pragma unroll
  for (int r = 0; r < 16; ++r) rli[r] = __builtin_amdgcn_rcpf(li_l[crow(r, hi)]);
  bf16_t* Ow = Ob + (long)(wid * QBLK) * LDO;
#pragma unroll
  for (int r = 0; r < 16; ++r) { int orow = crow(r, hi);
    for (int d0 = 0; d0 < 4; ++d0) Ow[(long)orow * LDO + d0 * 32 + r32] = (bf16_t)(cvtpk(o[d0][r] * rli[r], 0.f) & 0xffffu); }
#undef SLOAD
#undef SWRITE
#undef SWAIT
#undef RESC
  __syncthreads();
}
#undef KSWZ
#undef SBAR
}

struct AddrLin { bf16_t* O; int ld; __device__ __forceinline__ bf16_t* operator()(const pg8::Unit& u, int rl, int tc) const { return O + (size_t)(u.pm * 256 + rl) * ld + u.pn * 256 + tc; } };
struct EpiRowScale {
    static constexpr bool PERM = true; bf16_t* O; int ld; const float* ssp; float cscale;
    __device__ __forceinline__ void operator()(f32x4 (&acc)[2][2][4][2], const pg8::Unit& u, const pg8::EpiCtx& c) const { const int e_lane = lane_id(), e_fr = e_lane & 15, e_fq = e_lane >> 4;
        const int hc = c.wc * 32 + e_fq * 8, rl0 = c.wr * 64 + e_fr;
#pragma unroll
        for (int ai = 0; ai < 2; ++ai)
#pragma unroll
            for (int m = 0; m < 4; ++m) { const int row = u.pm * 256 + ai * 128 + rl0 + m * 16; const f32x4 p0 = *(const f32x4*)(ssp + (size_t)row * 8), p1 = *(const f32x4*)(ssp + (size_t)row * 8 + 4);
                const float r = rsqrtf((((p0.x + p0.y) + (p0.z + p0.w)) + ((p1.x + p1.y) + (p1.z + p1.w))) * (1.0f / DM) + EPS) * cscale;
#pragma unroll
                for (int bj = 0; bj < 2; ++bj) { const f32x4 v0 = acc[ai][bj][m][0] * r, v1 = acc[ai][bj][m][1] * r;
                    *(u32x4*)(O + (size_t)row * ld + u.pn * 256 + bj * 128 + hc) = (u32x4){cvtpk(v0.x, v0.y), cvtpk(v0.z, v0.w), cvtpk(v1.x, v1.y), cvtpk(v1.z, v1.w)}; } }
    }
};
struct EpiSoftmax {
    static constexpr bool PERM = true; bf16_t* P; int ld;
    __device__ __forceinline__ void operator()(f32x4 (&acc)[2][2][4][2], const pg8::Unit& u, const pg8::EpiCtx& c) const { const int e_lane = lane_id(), e_fr = e_lane & 15, e_fq = e_lane >> 4;
        const int hc = c.wc * 32 + e_fq * 8, rl0 = c.wr * 64 + e_fr;
        LAS float* pmx = (LAS float*)c.xl; LAS float* psm = pmx + 1024;
#pragma unroll
        for (int ai = 0; ai < 2; ++ai)
#pragma unroll
            for (int m = 0; m < 4; ++m) { float mx = -3.0e38f;
#pragma unroll
                for (int bj = 0; bj < 2; ++bj)
#pragma unroll
                    for (int n = 0; n < 2; ++n) { const f32x4 v = acc[ai][bj][m][n]; mx = fmaxf(fmaxf(mx, fmaxf(v.x, v.y)), fmaxf(v.z, v.w)); }
                mx = fmaxf(mx, __shfl_xor(mx, 16)); mx = fmaxf(mx, __shfl_xor(mx, 32));
                if (e_fq == 0) pmx[(ai * 128 + rl0 + m * 16) * 4 + c.wc] = mx; }
        WG_BAR();
#pragma unroll
        for (int ai = 0; ai < 2; ++ai)
#pragma unroll
            for (int m = 0; m < 4; ++m) { const int rl = ai * 128 + rl0 + m * 16; const f32x4 p4 = *(const LAS f32x4*)(pmx + rl * 4);
                const float mx = fmaxf(fmaxf(p4.x, p4.y), fmaxf(p4.z, p4.w)) * 1.4426950408889634f; float s = 0.f;
#pragma unroll
                for (int bj = 0; bj < 2; ++bj)
#pragma unroll
                    for (int n = 0; n < 2; ++n) { f32x4 v = acc[ai][bj][m][n];
                        v.x = __builtin_amdgcn_exp2f(fmaf(v.x, 1.4426950408889634f, -mx)); v.y = __builtin_amdgcn_exp2f(fmaf(v.y, 1.4426950408889634f, -mx));
                        v.z = __builtin_amdgcn_exp2f(fmaf(v.z, 1.4426950408889634f, -mx)); v.w = __builtin_amdgcn_exp2f(fmaf(v.w, 1.4426950408889634f, -mx));
                        s += (v.x + v.y) + (v.z + v.w); acc[ai][bj][m][n] = v; }
                s += __shfl_xor(s, 16); s += __shfl_xor(s, 32);
                if (e_fq == 0) psm[rl * 4 + c.wc] = s; }
        WG_BAR();
#pragma unroll
        for (int ai = 0; ai < 2; ++ai)
#pragma unroll
            for (int m = 0; m < 4; ++m) { const int rl = ai * 128 + rl0 + m * 16; const f32x4 p4 = *(const LAS f32x4*)(psm + rl * 4);
                const float inv = 1.0f / ((p4.x + p4.y) + (p4.z + p4.w));
#pragma unroll
                for (int bj = 0; bj < 2; ++bj) { const f32x4 v0 = acc[ai][bj][m][0] * inv, v1 = acc[ai][bj][m][1] * inv;
                    *(u32x4*)(P + (size_t)(u.pm * 256 + rl) * ld + u.pn * 256 + bj * 128 + hc) = (u32x4){cvtpk(v0.x, v0.y), cvtpk(v0.z, v0.w), cvtpk(v1.x, v1.y), cvtpk(v1.z, v1.w)}; } }
        WG_BAR();
    }
};
struct MapXS { const char* Q; const char* K; __device__ __forceinline__ void operator()(pg8::Unit& u) const {
    u.a = Q + ((size_t)u.pm * 256 * DM + (size_t)u.pn * MHD) * 2; u.b = K + ((size_t)(u.pm >> 3) * MEML * DM + (size_t)u.pn * MHD) * 2; } };
struct MapXPV { const char* P; const char* VT; __device__ __forceinline__ void operator()(pg8::Unit& u) const {
    u.a = P + ((size_t)u.pm * 256 * 1024 + (size_t)(u.pn >> 1) * MEML) * 2; u.b = VT + ((size_t)u.pn * 256 * 1024 + (size_t)(u.pm >> 3) * MEML) * 2; } };

struct MapMoE { const char* A; const char* W; size_t as, es, ws_; __device__ __forceinline__ void operator()(pg8::Unit& u) const {
    u.a = A + (size_t)u.pm * as; u.b = W + (size_t)(u.pm >> 2) * es + (size_t)u.pn * ws_; } };
struct EpiSwiGLU {
    static constexpr bool PERM = true; bf16_t* ACT;
    __device__ __forceinline__ void operator()(f32x4 (&acc)[2][2][4][2], const pg8::Unit& u, const pg8::EpiCtx& c) const { const int e_lane = lane_id(), e_fr = e_lane & 15, e_fq = e_lane >> 4;
        const int hc = c.wc * 32 + e_fq * 8, rl0 = c.wr * 64 + e_fr;
#pragma unroll
        for (int ai = 0; ai < 2; ++ai)
#pragma unroll
            for (int m = 0; m < 4; ++m) { f32x4 o[2];
#pragma unroll
                for (int n = 0; n < 2; ++n) { const f32x4 g = acc[ai][0][m][n], up = acc[ai][1][m][n]; f32x4 r;
                    r.x = g.x * __builtin_amdgcn_rcpf(1.0f + __builtin_amdgcn_exp2f(-1.4426950408889634f * g.x)) * up.x; r.y = g.y * __builtin_amdgcn_rcpf(1.0f + __builtin_amdgcn_exp2f(-1.4426950408889634f * g.y)) * up.y;
                    r.z = g.z * __builtin_amdgcn_rcpf(1.0f + __builtin_amdgcn_exp2f(-1.4426950408889634f * g.z)) * up.z; r.w = g.w * __builtin_amdgcn_rcpf(1.0f + __builtin_amdgcn_exp2f(-1.4426950408889634f * g.w)) * up.w; o[n] = r; }
                *(u32x4*)(ACT + (size_t)(u.pm * 256 + ai * 128 + rl0 + m * 16) * EFF + u.pn * 128 + hc) = (u32x4){cvtpk(o[0].x, o[0].y), cvtpk(o[0].z, o[0].w), cvtpk(o[1].x, o[1].y), cvtpk(o[1].z, o[1].w)}; }
    }
};
struct EpiRowGate {
    static constexpr bool PERM = true; bf16_t* Y; const float* gate;
    __device__ __forceinline__ void operator()(f32x4 (&acc)[2][2][4][2], const pg8::Unit& u, const pg8::EpiCtx& c) const { const int e_lane = lane_id(), e_fr = e_lane & 15, e_fq = e_lane >> 4;
        const int hc = c.wc * 32 + e_fq * 8, rl0 = c.wr * 64 + e_fr;
#pragma unroll
        for (int ai = 0; ai < 2; ++ai)
#pragma unroll
            for (int m = 0; m < 4; ++m) { const int row = u.pm * 256 + ai * 128 + rl0 + m * 16; const float gt = gate[row];
#pragma unroll
                for (int bj = 0; bj < 2; ++bj) { const f32x4 v0 = acc[ai][bj][m][0] * gt, v1 = acc[ai][bj][m][1] * gt;
                    *(u32x4*)(Y + (size_t)row * DM + u.pn * 256 + bj * 128 + hc) = (u32x4){cvtpk(v0.x, v0.y), cvtpk(v0.z, v0.w), cvtpk(v1.x, v1.y), cvtpk(v1.z, v1.w)}; } }
    }
};
__device__ __forceinline__ float rms_row_to_bf16_r(const float* xrow, const float* __restrict__ gain, bf16_t* orow, int lane) {
    const GAS f32x4* xr = (const GAS f32x4*)xrow + lane; const f32x4* gr = (const f32x4*)gain + lane;
    f32x4 v[8]; float s = 0.f;
#pragma unroll
    for (int j = 0; j < 8; ++j) { v[j] = xr[64 * j]; s += (v[j].x * v[j].x + v[j].y * v[j].y) + (v[j].z * v[j].z + v[j].w * v[j].w); }
    const float r = rsqrtf(wave_sum(s) * (1.f / DM) + EPS);
    GAS u32x2* o8 = (GAS u32x2*)orow + lane;
#pragma unroll
    for (int j = 0; j < 8; ++j) { const f32x4 g = gr[64 * j]; u32x2 w; w.x = cvtpk(v[j].x * r * g.x, v[j].y * r * g.y); w.y = cvtpk(v[j].z * r * g.z, v[j].w * r * g.w); o8[64 * j] = w; }
    return r;
}
__device__ __forceinline__ void router_phase(const Frame& F, const bf16_t* x, const float* __restrict__ gain, const float* __restrict__ Wr, bf16_t* HNo, float* aff) {
    const int lane = lane_id(), tid = F.wave * 64 + lane;
    LAS f32x4* Wl = (LAS f32x4*)(F.lds + RING_OFF);
    for (int i = tid; i < DM * 4; i += 512) { const int kk = i >> 2, q = i & 3; Wl[q * DM + (kk & 3) * 512 + (kk >> 2)] = *(const f32x4*)(Wr + (size_t)kk * NE + 4 * q); }
    __syncthreads();
    const int gw = (int)blockIdx.x * NWAVES + F.wave, NGW = F.G * NWAVES;
    const f32x4* gr = (const f32x4*)gain + lane;
    for (int rb = gw * 2; rb < NTOK; rb += NGW * 2) {
        f32x4 v0[8], v1[8]; float s0 = 0.f, s1 = 0.f;
        const GAS u32x2* x0 = (const GAS u32x2*)(x + (size_t)rb * DM) + lane; const GAS u32x2* x1 = x0 + DM / 4;
#pragma unroll
        for (int j = 0; j < 8; ++j) { const u32x2 p = x0[64 * j], q = x1[64 * j];
            v0[j] = (f32x4){__uint_as_float(p.x << 16), __uint_as_float(p.x & 0xffff0000u), __uint_as_float(p.y << 16), __uint_as_float(p.y & 0xffff0000u)};
            v1[j] = (f32x4){__uint_as_float(q.x << 16), __uint_as_float(q.x & 0xffff0000u), __uint_as_float(q.y << 16), __uint_as_float(q.y & 0xffff0000u)}; }
#pragma unroll
        for (int j = 0; j < 8; ++j) { s0 += (v0[j].x * v0[j].x + v0[j].y * v0[j].y) + (v0[j].z * v0[j].z + v0[j].w * v0[j].w); s1 += (v1[j].x * v1[j].x + v1[j].y * v1[j].y) + (v1[j].z * v1[j].z + v1[j].w * v1[j].w); }
        const float r0 = rsqrtf(wave_sum(s0) * (1.f / DM) + EPS), r1 = rsqrtf(wave_sum(s1) * (1.f / DM) + EPS);
        GAS u32x2* o0 = (GAS u32x2*)(HNo + (size_t)rb * DM) + lane; GAS u32x2* o1 = o0 + DM / 4;
        float a[32];
#pragma unroll
        for (int i = 0; i < 32; ++i) a[i] = 0.f;
#pragma unroll
        for (int j = 0; j < 8; ++j) { const f32x4 g = gr[64 * j];
            v0[j] = (f32x4){v0[j].x * r0 * g.x, v0[j].y * r0 * g.y, v0[j].z * r0 * g.z, v0[j].w * r0 * g.w}; v1[j] = (f32x4){v1[j].x * r1 * g.x, v1[j].y * r1 * g.y, v1[j].z * r1 * g.z, v1[j].w * r1 * g.w};
            o0[64 * j] = (u32x2){cvtpk(v0[j].x, v0[j].y), cvtpk(v0[j].z, v0[j].w)}; o1[64 * j] = (u32x2){cvtpk(v1[j].x, v1[j].y), cvtpk(v1[j].z, v1[j].w)};
            const float h0[4] = {v0[j].x, v0[j].y, v0[j].z, v0[j].w}, h1[4] = {v1[j].x, v1[j].y, v1[j].z, v1[j].w};
#pragma unroll
            for (int c = 0; c < 4; ++c)
#pragma unroll
                for (int q = 0; q < 4; ++q) { const f32x4 w = Wl[q * DM + c * 512 + lane + 64 * j];
                    a[4 * q + 0] += h0[c] * w.x; a[4 * q + 1] += h0[c] * w.y; a[4 * q + 2] += h0[c] * w.z; a[4 * q + 3] += h0[c] * w.w;
                    a[16 + 4 * q + 0] += h1[c] * w.x; a[16 + 4 * q + 1] += h1[c] * w.y; a[16 + 4 * q + 2] += h1[c] * w.z; a[16 + 4 * q + 3] += h1[c] * w.w; } }
#define RS_STEP(N, MASK) { const bool up_ = (lane & MASK) != 0; _Pragma("unroll") for (int i = 0; i < N; ++i) { const float keep = up_ ? a[i + N] : a[i], send = up_ ? a[i] : a[i + N]; a[i] = keep + __shfl_xor(send, MASK); } }
        RS_STEP(16, 32) RS_STEP(8, 16) RS_STEP(4, 8) RS_STEP(2, 4) RS_STEP(1, 2)
#undef RS_STEP
        const float lg = a[0] + __shfl_xor(a[0], 1); float mx = lg;
        mx = fmaxf(mx, __shfl_xor(mx, 16)); mx = fmaxf(mx, __shfl_xor(mx, 8)); mx = fmaxf(mx, __shfl_xor(mx, 4)); mx = fmaxf(mx, __shfl_xor(mx, 2));
        const float ex = expf(lg - mx); float sm = ex;
        sm += __shfl_xor(sm, 16); sm += __shfl_xor(sm, 8); sm += __shfl_xor(sm, 4); sm += __shfl_xor(sm, 2);
        const int el = lane >> 1, row = rb + (el >> 4), e = el & 15, b = row / SEQ, t = row % SEQ;
        if ((lane & 1) == 0) aff[((size_t)b * NE + e) * SEQ + t] = ex / sm;
    }
    __syncthreads();
}
__device__ __forceinline__ void rank_phase(const Frame& F, const float* aff, int* rank, float* gate, const bf16_t* HNi, bf16_t* XS) {
    const int lane = lane_id(), tid = F.wave * 64 + lane;
    LAS float* a = (LAS float*)(F.lds + RING_OFF);
    LAS int* list = (LAS int*)(F.lds + RING_OFF + 8192);
    LAS int* cntp = (LAS int*)(F.lds + RING_OFF + 8192 + 1024);
    for (int it = (int)blockIdx.x; it < NB * NE * 8; it += F.G) {
        const int be = it >> 3, chunk = it & 7, b = be >> 4, e = be & 15;
        for (int i = tid; i < SEQ / 4; i += 512) ((LAS f32x4*)a)[i] = *(const f32x4*)(aff + (size_t)be * SEQ + 4 * i);
        if (tid == 0) cntp[0] = 0;
        __syncthreads();
        const int tl = tid >> 1, half = tid & 1, t = chunk * 256 + tl; const float v = a[t]; int cnt = 0;
        const float vn = __uint_as_float(__float_as_uint(v) + 1u);
        const int jb = half * 256, je = jb + 256, t0q = (chunk * 256 + F.wave * 32) >> 2;
        const int eA = t0q < jb ? jb : (t0q > je ? je : t0q), bC = (t0q + 9 < jb) ? jb : (t0q + 9 > je ? je : t0q + 9);
        const LAS f32x4* a4 = (const LAS f32x4*)a;
#pragma unroll 8
        for (int j4 = jb; j4 < eA; ++j4) { const f32x4 w = a4[j4]; cnt += (w.x >= v) + (w.y >= v) + (w.z >= v) + (w.w >= v); }
        for (int j4 = eA; j4 < bC; ++j4) { const f32x4 w = a4[j4]; const int j = 4 * j4;
            cnt += (w.x >= (j < t ? v : vn)) + (w.y >= (j + 1 < t ? v : vn)) + (w.z >= (j + 2 < t ? v : vn)) + (w.w >= (j + 3 < t ? v : vn)); }
#pragma unroll 8
        for (int j4 = bC; j4 < je; ++j4) { const f32x4 w = a4[j4]; cnt += (w.x >= vn) + (w.y >= vn) + (w.z >= vn) + (w.w >= vn); }
        cnt += __shfl_xor(cnt, 1);
        if (half == 0) { rank[(size_t)be * SEQ + t] = cnt;
            if (cnt < CAP) { gate[(e * 4 + b) * CAP + cnt] = v; const int slot = atomicAdd((int*)cntp, 1); list[slot] = (t << 16) | cnt; } }
        __syncthreads();
        const int n = cntp[0];
        for (int l0 = F.wave; l0 < n; l0 += 4 * NWAVES) {
            u32x4 cv[4][4]; u32x4* dstp[4];
#pragma unroll
            for (int q = 0; q < 4; ++q) { const int li = l0 + q * NWAVES; const int pk = list[li < n ? li : l0], tt = pk >> 16, rk = pk & 0xffff;
                const u32x4* src = (const u32x4*)(HNi + ((size_t)b * SEQ + tt) * DM); dstp[q] = (u32x4*)(XS + ((size_t)(e * 4 + b) * CAP + rk) * DM);
#pragma unroll
                for (int j = 0; j < 4; ++j) cv[q][j] = src[lane + 64 * j]; }
#pragma unroll
            for (int q = 0; q < 4; ++q) if (l0 + q * NWAVES < n) {
#pragma unroll
                for (int j = 0; j < 4; ++j) dstp[q][lane + 64 * j] = cv[q][j]; }
        }
        __syncthreads();
    }
}
__device__ __forceinline__ void combine_phase(const Frame& F, const bf16_t* xin, bf16_t* xo, float* fout, const bf16_t* Y, const int* rank, const float* __restrict__ gain, bf16_t* HNo, bool final_) {
    const int lane = lane_id();
    const int gw = (int)blockIdx.x * NWAVES + F.wave, NGW = F.G * NWAVES;
    for (int row = gw; row < NTOK; row += NGW) {
        const int b = row / SEQ, t = row % SEQ;
        int rk = CAP; if (lane < NE) rk = rank[((size_t)b * NE + lane) * SEQ + t];
        const GAS u32x2* xi = (const GAS u32x2*)(xin + (size_t)row * DM) + lane; f32x4 v[8];
#pragma unroll
        for (int j = 0; j < 8; ++j) { const u32x2 p = xi[64 * j]; v[j] = (f32x4){__uint_as_float(p.x << 16), __uint_as_float(p.x & 0xffff0000u), __uint_as_float(p.y << 16), __uint_as_float(p.y & 0xffff0000u)}; }
#pragma unroll
        for (int e = 0; e < NE; ++e) { const int r = __builtin_amdgcn_readlane(rk, e);
            if (r < CAP) { const u32x2* yr = (const u32x2*)(Y + ((size_t)(e * 4 + b) * CAP + r) * DM) + lane;
#pragma unroll
                for (int j = 0; j < 8; ++j) { const u32x2 w = yr[64 * j]; v[j].x += __uint_as_float(w.x << 16); v[j].y += __uint_as_float(w.x & 0xffff0000u); v[j].z += __uint_as_float(w.y << 16); v[j].w += __uint_as_float(w.y & 0xffff0000u); } } }
        float s = 0.f;
#pragma unroll
        for (int j = 0; j < 8; ++j) s += (v[j].x * v[j].x + v[j].y * v[j].y) + (v[j].z * v[j].z + v[j].w * v[j].w);
        const float r = rsqrtf(wave_sum(s) * (1.f / DM) + EPS); const f32x4* gr = (const f32x4*)gain + lane;
        if (final_) { GAS f32x4* fo = (GAS f32x4*)(fout + (size_t)row * DM) + lane;
#pragma unroll
            for (int j = 0; j < 8; ++j) { const f32x4 g = gr[64 * j]; fo[64 * j] = (f32x4){v[j].x * r * g.x, v[j].y * r * g.y, v[j].z * r * g.z, v[j].w * r * g.w}; }
        } else { GAS u32x2* o8 = (GAS u32x2*)(HNo + (size_t)row * DM) + lane; GAS u32x2* x8 = (GAS u32x2*)(xo + (size_t)row * DM) + lane;
#pragma unroll
            for (int j = 0; j < 8; ++j) { const f32x4 g = gr[64 * j]; x8[64 * j] = (u32x2){cvtpk(v[j].x, v[j].y), cvtpk(v[j].z, v[j].w)}; o8[64 * j] = (u32x2){cvtpk(v[j].x * r * g.x, v[j].y * r * g.y), cvtpk(v[j].z * r * g.z, v[j].w * r * g.w)}; } }
    }
}
struct MapPool { const char* A; const char* W; __device__ __forceinline__ void operator()(pg8::Unit& u) const {
    u.a = A + ((size_t)u.pm * 256 * DM + (size_t)(u.pn >> 1) * 512) * 2; u.b = W + ((size_t)(u.pn & 1) * 256 * DM + (size_t)(u.pn >> 1) * 512) * 2; } };
template <int W> __device__ __forceinline__ void pool_item(const bf16_t* H, bf16_t* P, int row, int c8) {
    const int t = row & (SEQ - 1); const bf16_t* base = H + (size_t)(row - t) * DM + c8 * 8;
    u32x4 v[W];
#pragma unroll
    for (int i = 0; i < W; ++i) { int j = t - W / 2 + i; j = j < 0 ? 0 : (j > SEQ - 1 ? SEQ - 1 : j); v[i] = *(const u32x4*)(base + (size_t)j * DM); }
    float s[8] = {0.f, 0.f, 0.f, 0.f, 0.f, 0.f, 0.f, 0.f};
#pragma unroll
    for (int i = 0; i < W; ++i) { const int j = t - W / 2 + i; const float m = (j >= 0 && j < SEQ) ? 1.f : 0.f;
        s[0] += m * __uint_as_float(v[i].x << 16); s[1] += m * __uint_as_float(v[i].x & 0xffff0000u); s[2] += m * __uint_as_float(v[i].y << 16); s[3] += m * __uint_as_float(v[i].y & 0xffff0000u);
        s[4] += m * __uint_as_float(v[i].z << 16); s[5] += m * __uint_as_float(v[i].z & 0xffff0000u); s[6] += m * __uint_as_float(v[i].w << 16); s[7] += m * __uint_as_float(v[i].w & 0xffff0000u); }
    int lo = t - W / 2, hi = t + W / 2; if (lo < 0) lo = 0; if (hi > SEQ) hi = SEQ;
    const float inv = 1.0f / (float)(hi - lo); const u32x4 sv = v[W / 2];
    const float e0 = __uint_as_float(sv.x << 16), e1 = __uint_as_float(sv.x & 0xffff0000u), e2 = __uint_as_float(sv.y << 16), e3 = __uint_as_float(sv.y & 0xffff0000u);
    const float e4 = __uint_as_float(sv.z << 16), e5 = __uint_as_float(sv.z & 0xffff0000u), e6 = __uint_as_float(sv.w << 16), e7 = __uint_as_float(sv.w & 0xffff0000u);
    *(u32x4*)(P + (size_t)row * DM + c8 * 8) = (u32x4){cvtpk(s[0] * inv - e0, s[1] * inv - e1), cvtpk(s[2] * inv - e2, s[3] * inv - e3), cvtpk(s[4] * inv - e4, s[5] * inv - e5), cvtpk(s[6] * inv - e6, s[7] * inv - e7)};
}
__device__ __forceinline__ void pool_phase(const Frame& F, const bf16_t* H, bf16_t* P) {
    const int lane = lane_id(); const int gwv = (int)blockIdx.x * NWAVES + F.wave, NWV = F.G * NWAVES;
    for (int wi = gwv; wi < NTOK * 4; wi += NWV) {
        const int row = wi >> 2, g = wi & 3, c8 = g * 64 + lane;
        if (g == 0) pool_item<2>(H, P, row, c8); else if (g == 1) pool_item<4>(H, P, row, c8); else if (g == 2) pool_item<8>(H, P, row, c8); else pool_item<16>(H, P, row, c8);
    }
}

constexpr int N_PHASES = 24;
#ifndef MK_N_LAUNCHES
#define MK_N_LAUNCHES 1
#endif
#ifndef REP_MASK
#define REP_MASK 0
#endif
__global__ void __launch_bounds__(NWAVES * 64, 2) skel_fwd(Args args) {
    extern __shared__ __attribute__((aligned(16))) unsigned char lds_raw[];
    Frame F;
    F.lds = (LAS unsigned char*)lds_raw; F.MISC = (volatile LAS unsigned*)(F.lds + MISC_OFF);
    F.wave = __builtin_amdgcn_readfirstlane(threadIdx.x >> 6);
    F.G = gridDim.x; { const int bx = blockIdx.x; F.vcu = (F.G % 8 == 0) ? (bx % 8) * (F.G / 8) + bx / 8 : bx; }
    F.ws = nullptr; F.ctl = (gu32*)(uptr(args.ws) + WS_CTL);
    for (int u = threadIdx.x; u < (LDS_BYTES - LDSCTL_OFF) / 4; u += NWAVES * 64) ((LAS unsigned*)(F.lds + LDSCTL_OFF))[u] = 0u;
    __syncthreads();
    const bool multi = (MK_N_LAUNCHES == 1) || (args.ph_hi - args.ph_lo) > 1 || REP_MASK != 0;
    XcdBarrier bar; bar.bar = (unsigned*)(F.ctl + CW_BAR); bar.x = 0; bar.st = nullptr; bar.wave = F.wave;
    if (multi) bar = xcd_barrier_post((unsigned*)(F.ctl + CW_BAR), F.MISC + 8, F.wave);
    const int lo = args.ph_lo, hi = args.ph_hi;
#ifdef REP_RT
    const unsigned rep_mask_ = (unsigned)__builtin_amdgcn_readfirstlane(args.pad);
#endif
#define IN(k) ((MK_N_LAUNCHES == 1) ? ((k) < N_PHASES) : (lo <= (k) && (k) < hi))
#ifdef REP_RT
#define REPBIT(k) ((int)((rep_mask_ >> (k)) & 1u))
#else
#define REPBIT(k) ((int)((((unsigned)REP_MASK) >> (k)) & 1u))
#endif
#define PHASE(k) _Pragma("unroll") for (int rep_ = 0; rep_ < 1 + REPBIT(k); ++rep_)
#define SEAM(k) do { if ((IN(k) && IN((k) + 1)) || rep_ + 1 < 1 + REPBIT(k)) xcd_barrier(bar); } while (0)
    LAS unsigned char* ring = F.lds + RING_OFF; LAS unsigned char* xl = F.lds + XL_OFF;
    const int bx = (int)blockIdx.x, G = F.G;

#define KV_PROJ(l, rotK, rotV) do {   \
            { MapLin mp{(const char*)(ws + WS_MEMNB + (size_t)(l) * NB * MEML * DM * 2), (const char*)(ws + WS_WCK_T + (size_t)(l) * DM * DM * 2), (size_t)256 * DM * 2, (size_t)256 * DM * 2}; \
              pg8::Sched<MapLin> S; S.init(NB * MEML / 256, DM / 256, G, (bx + G - ((rotK) % G)) % G, mp); \
              EpiStore<AddrLin> E{AddrLin{(bf16_t*)(ws + WS_KCB + (size_t)(l) * NB * MEML * DM * 2), DM}}; \
              pg8::gemm_phase<EpiStore<AddrLin>, pg8::Sched<MapLin>, true>(F.wave, ring, xl, DM, DM * 2, DM * 2, S, E); } \
            { MapLin mp{(const char*)(ws + WS_WCV_T + (size_t)(l) * DM * DM * 2), (const char*)(ws + WS_MEMNB + (size_t)(l) * NB * MEML * DM * 2), (size_t)256 * DM * 2, (size_t)256 * DM * 2}; \
              pg8::Sched<MapLin> S; S.init(DM / 256, NB * MEML / 256, G, (bx + G - ((rotV) % G)) % G, mp); \
              EpiStore<AddrLin> E{AddrLin{(bf16_t*)(ws + WS_VTB + (size_t)(l) * NB * MEML * DM * 2), NB * MEML}}; \
              pg8::gemm_phase<EpiStore<AddrLin>, pg8::Sched<MapLin>, true>(F.wave, ring, xl, DM, DM * 2, DM * 2, S, E); } } while (0)
#ifdef EXTRA_BARS
    for (int eb = 0; eb < EXTRA_BARS; ++eb) xcd_barrier(bar);
#endif
    if (IN(0)) PHASE(0) { const karg_t ka = kargs(); unsigned char* const ws = uptr(KWS(ka)); p0_prologue(F, ka, ws); SEAM(0); }
    if (IN(1)) PHASE(1) { const karg_t ka = kargs(); unsigned char* const ws = uptr(KWS(ka));
        {
            MapLin mp{(const char*)(ws + WS_HN), (const char*)(ws + WS_WIN_T), (size_t)256 * DM * 2, (size_t)256 * DM * 2};
            pg8::Sched<MapLin> S; S.init(NTOK / 256, 2560 / 256, G, bx, mp);
            EpiQKV E{(bf16_t*)(ws + WS_QB), (bf16_t*)(ws + WS_KB), (bf16_t*)(ws + WS_VB), KIN(ka, 4), KIN(ka, 5), (const float*)(ws + WS_ROPE), (const float*)(ws + WS_ROPE) + SEQ * 64};
            pg8::gemm_phase<EpiQKV, pg8::Sched<MapLin>, true>(F.wave, ring, xl, DM, DM * 2, DM * 2, S, E); }
        {
            MapLin mp{(const char*)(ws + WS_WF_T), (const char*)(ws + WS_HN), (size_t)256 * DM * 2, (size_t)256 * DM * 2};
            pg8::Sched<MapLin> S; S.init(1024 / 256, NTOK / 256, G, (bx + G - (320 % G)) % G, mp);
            EpiStore<AddrF1> E{AddrF1{(bf16_t*)(ws + WS_FPQ)}};
            pg8::gemm_phase<EpiStore<AddrF1>, pg8::Sched<MapLin>, true>(F.wave, ring, xl, DM, DM * 2, DM * 2, S, E); }
        KV_PROJ(0, 448, 480);
        SEAM(1);
    }
    if (IN(2)) PHASE(2) { const karg_t ka = kargs(); unsigned char* const ws = uptr(KWS(ka));
        const int nF2 = (G > 64) ? 64 : 0;
        if (bx < nF2 || nF2 == 0) {
            MapLin mp{(const char*)(ws + WS_DFT), (const char*)(ws + WS_FPQ), (size_t)256 * 4096 * 2, (size_t)256 * 4096 * 2};
            pg8::Sched<MapLin> S; S.init(8, 8, nF2 ? nF2 : G, bx, mp);
            EpiStore<AddrF2> E{AddrF2{(bf16_t*)(ws + WS_MIXB)}};
            pg8::gemm_phase<EpiStore<AddrF2>, pg8::Sched<MapLin>, true>(F.wave, ring, xl, 4096, 4096 * 2, 4096 * 2, S, E);
        }
        if (bx < nF2) { __syncthreads(); tr_span(F, ka, ws, 1, 7680 + bx * 8 + F.wave, 512, 9); __syncthreads(); }
        if (bx >= nF2) {
            const int a = bx - nF2, cnt = G - nF2, per = (384 + cnt - 1) / cnt, slot = a % 3; int ui = 0;
            for (int uid = a * per; uid < (a + 1) * per && uid < 384; ++uid, ++ui) {
                if (ui == slot) { __syncthreads(); tr_span(F, ka, ws, 1, a * 8 + F.wave, 1536, 5); __syncthreads(); }
                const int qb = uid & 7, hq = (uid >> 3) % NQH, b = uid / (8 * NQH), kvh = hq / 3;
                const bf16_t* Qb = (const bf16_t*)(ws + WS_QB) + ((size_t)b * SEQ + qb * 256) * AW + hq * HD;
                const bf16_t* Kh = (const bf16_t*)(ws + WS_KB) + (size_t)b * SEQ * KVW + kvh * HD;
                const bf16_t* Vh = (const bf16_t*)(ws + WS_VB) + (size_t)b * SEQ * KVW + kvh * HD;
                bf16_t* Ob = (bf16_t*)(ws + WS_MIXB) + ((size_t)b * SEQ + qb * 256) * DM + hq * HD;
                attn::attn_dense_body(Qb, Kh, Vh, Ob, SEQ, (char*)lds_raw + RING_OFF, F.wave);
            }
            if (slot >= ui) { __syncthreads(); tr_span(F, ka, ws, 1, a * 8 + F.wave, 1536, 5); __syncthreads(); }
        }
        SEAM(2);
    }
    if (IN(3)) PHASE(3) { const karg_t ka = kargs(); unsigned char* const ws = uptr(KWS(ka));
        MapLin mp{(const char*)(ws + WS_MIXB), (const char*)(ws + WS_WOUT_T), (size_t)256 * DM * 2, (size_t)256 * DM * 2};
        pg8::Sched<MapLin> S; S.init(NTOK / 256, DM / 256, G, bx, mp);
        EpiResB<true> E{KIN(ka, 0), (bf16_t*)(ws + WS_XB), (float*)(ws + WS_SSP), nullptr};
        pg8::gemm_phase<EpiResB<true>, pg8::Sched<MapLin>, true>(F.wave, ring, xl, DM, DM * 2, DM * 2, S, E);
        SEAM(3);
    }
    {
        constexpr int l = 0; constexpr int pb = l ? 15 : 4;
        if (l == 1) {
            if (IN(13)) PHASE(13) { const karg_t ka = kargs(); unsigned char* const ws = uptr(KWS(ka));
                pool_phase(F, (const bf16_t*)(ws + WS_HN), (bf16_t*)(ws + WS_QCB));
#ifdef PROBE_CONV
                tr_span<TRV>(F, ka, ws, 1, bx * 8 + F.wave, 2048, 6);
#endif
                SEAM(13);
            }
            if (IN(14)) PHASE(14) { const karg_t ka = kargs(); unsigned char* const ws = uptr(KWS(ka));
                MapPool mp{(const char*)(ws + WS_QCB), (const char*)(ws + WS_WP_T)};
                pg8::Sched<MapPool> S; S.init(NTOK / 256, DM / 256, G, bx, mp);
                EpiResB<false> E{(const bf16_t*)(ws + WS_XB), (bf16_t*)(ws + WS_XALT), (float*)(ws + WS_SSP), KIN(ka, 9)};
                pg8::gemm_phase<EpiResB<false>, pg8::Sched<MapPool>, true>(F.wave, ring, xl, 512, DM * 2, DM * 2, S, E);
                SEAM(14);
            }
        }
        if (IN(pb + 0)) PHASE(pb + 0) { const karg_t ka = kargs(); unsigned char* const ws = uptr(KWS(ka));
            MapLin mp{(const char*)(ws + (l == 0 ? WS_XB : WS_XALT)), (const char*)(ws + WS_WCQ_T + (size_t)l * DM * DM * 2), (size_t)256 * DM * 2, (size_t)256 * DM * 2};
            pg8::Sched<MapLin> S; S.init(NTOK / 256, DM / 256, G, bx, mp);
            EpiRowScale E{(bf16_t*)(ws + WS_QCB), DM, (const float*)(ws + WS_SSP), 0.04419417382415922f};
            pg8::gemm_phase<EpiRowScale, pg8::Sched<MapLin>, true>(F.wave, ring, xl, DM, DM * 2, DM * 2, S, E);
            SEAM(pb + 0);
        }
        if (IN(pb + 1)) PHASE(pb + 1) { const karg_t ka = kargs(); unsigned char* const ws = uptr(KWS(ka));
            MapXS mp{(const char*)(ws + WS_QCB), (const char*)(ws + WS_KCB + (size_t)l * NB * MEML * DM * 2)};
            pg8::Sched<MapXS> S; S.init(NTOK / 256, NMH, G, bx, mp);
            EpiSoftmax E{(bf16_t*)(ws + WS_PB), NMH * MEML};
            pg8::gemm_phase<EpiSoftmax, pg8::Sched<MapXS>, true>(F.wave, ring, xl, MHD, DM * 2, DM * 2, S, E);
            if (l == 0) KV_PROJ(1, 128, 160);
            SEAM(pb + 1);
        }
        if (IN(pb + 2)) PHASE(pb + 2) { const karg_t ka = kargs(); unsigned char* const ws = uptr(KWS(ka));
            MapXPV mp{(const char*)(ws + WS_PB), (const char*)(ws + WS_VTB + (size_t)l * NB * MEML * DM * 2)};
            pg8::Sched<MapXPV> S; S.init(NTOK / 256, DM / 256, G, bx, mp);
            EpiStore<AddrLin> E{AddrLin{(bf16_t*)(ws + WS_MIXB), DM}};
            pg8::gemm_phase<EpiStore<AddrLin>, pg8::Sched<MapXPV>, true>(F.wave, ring, xl, MEML, NMH * MEML * 2, NB * MEML * 2, S, E);
            SEAM(pb + 2);
        }
        if (IN(pb + 3)) PHASE(pb + 3) { const karg_t ka = kargs(); unsigned char* const ws = uptr(KWS(ka));
            MapLin mp{(const char*)(ws + WS_MIXB), (const char*)(ws + WS_WCO_T + (size_t)l * DM * DM * 2), (size_t)256 * DM * 2, (size_t)256 * DM * 2};
            pg8::Sched<MapLin> S; S.init(NTOK / 256, DM / 256, G, bx, mp);
            EpiResB<false> E{(const bf16_t*)(ws + (l == 0 ? WS_XB : WS_XALT)), (bf16_t*)(ws + (l == 0 ? WS_XALT : WS_XB)), nullptr, nullptr};
            pg8::gemm_phase<EpiResB<false>, pg8::Sched<MapLin>, true>(F.wave, ring, xl, DM, DM * 2, DM * 2, S, E);
            SEAM(pb + 3);
        }
        if (IN(pb + 4)) PHASE(pb + 4) { const karg_t ka = kargs(); unsigned char* const ws = uptr(KWS(ka));
            router_phase(F, (const bf16_t*)(ws + (l == 0 ? WS_XALT : WS_XB)), KIN(ka, 16) + l * DM, KIN(ka, 17) + (size_t)l * DM * NE, (bf16_t*)(ws + WS_HN), (float*)(ws + WS_AFF));
            SEAM(pb + 4);
        }
        if (IN(pb + 5)) PHASE(pb + 5) { const karg_t ka = kargs(); unsigned char* const ws = uptr(KWS(ka));
            rank_phase(F, (const float*)(ws + WS_AFF), (int*)(ws + WS_RANK), (float*)(ws + WS_GATE), (const bf16_t*)(ws + WS_HN), (bf16_t*)(ws + WS_XSB));
            SEAM(pb + 5);
        }
        if (IN(pb + 6)) PHASE(pb + 6) { const karg_t ka = kargs(); unsigned char* const ws = uptr(KWS(ka));
            MapMoE mp{(const char*)(ws + WS_XSB), (const char*)(ws + (l ? WS_WGU_T2 : WS_WGU_T)), (size_t)256 * DM * 2, (size_t)2048 * DM * 2, (size_t)256 * DM * 2};
            pg8::Sched<MapMoE> S; S.init(NB * NE, 8, G, bx, mp);
            EpiSwiGLU E{(bf16_t*)(ws + WS_ACTB)};
            const bool cfirst = ((bx >> 3) & 1) != 0;
            if (l == 0 && cfirst) { tr_span(F, ka, ws, 2, bx * 8 + F.wave, 2048, 3); __syncthreads(); }
            pg8::gemm_phase<EpiSwiGLU, pg8::Sched<MapMoE>, true>(F.wave, ring, xl, DM, DM * 2, DM * 2, S, E);
            if (l == 0 && !cfirst) { __syncthreads(); tr_span(F, ka, ws, 2, bx * 8 + F.wave, 2048, 3); }
            SEAM(pb + 6);
        }
        if (IN(pb + 7)) PHASE(pb + 7) { const karg_t ka = kargs(); unsigned char* const ws = uptr(KWS(ka));
            MapMoE mp{(const char*)(ws + WS_ACTB), (const char*)(ws + (l ? WS_WD_T2 : WS_WD_T)), (size_t)256 * EFF * 2, (size_t)2048 * EFF * 2, (size_t)256 * EFF * 2};
            pg8::Sched<MapMoE> S; S.init(NB * NE, 8, G, bx, mp);
            EpiRowGate E{(bf16_t*)(ws + WS_YB), (const float*)(ws + WS_GATE)};
            const bool cfirst = ((bx >> 3) & 1) == 0;
            if (l == 0 && cfirst) { tr_span(F, ka, ws, 2, 6144 + bx * 8 + F.wave, 2048, 3); __syncthreads(); }
            pg8::gemm_phase<EpiRowGate, pg8::Sched<MapMoE>, true>(F.wave, ring, xl, EFF, EFF * 2, EFF * 2, S, E);
            if (l == 0 && !cfirst) { __syncthreads(); tr_span(F, ka, ws, 2, 6144 + bx * 8 + F.wave, 2048, 3); }
            SEAM(pb + 7);
        }
        if (IN(pb + 8)) PHASE(pb + 8) { const karg_t ka = kargs(); unsigned char* const ws = uptr(KWS(ka));
            combine_phase(F, (const bf16_t*)(ws + (l == 0 ? WS_XALT : WS_XB)), (bf16_t*)(ws + WS_XB), KOUT(ka), (const bf16_t*)(ws + WS_YB), (const int*)(ws + WS_RANK), l == 0 ? KIN(ka, 2) + DM : KIN(ka, 21), (bf16_t*)(ws + WS_HN), l == 1);
            SEAM(pb + 8);
        }
    }
    {
        constexpr int l = 1; constexpr int pb = l ? 15 : 4;
        if (l == 1) {
            if (IN(13)) PHASE(13) { const karg_t ka = kargs(); unsigned char* const ws = uptr(KWS(ka));
                pool_phase(F, (const bf16_t*)(ws + WS_HN), (bf16_t*)(ws + WS_QCB));
#ifdef PROBE_CONV
                tr_span<TRV>(F, ka, ws, 1, bx * 8 + F.wave, 2048, 6);
#endif
                SEAM(13);
            }
            if (IN(14)) PHASE(14) { const karg_t ka = kargs(); unsigned char* const ws = uptr(KWS(ka));
                MapPool mp{(const char*)(ws + WS_QCB), (const char*)(ws + WS_WP_T)};
                pg8::Sched<MapPool> S; S.init(NTOK / 256, DM / 256, G, bx, mp);
                EpiResB<false> E{(const bf16_t*)(ws + WS_XB), (bf16_t*)(ws + WS_XALT), (float*)(ws + WS_SSP), KIN(ka, 9)};
                pg8::gemm_phase<EpiResB<false>, pg8::Sched<MapPool>, true>(F.wave, ring, xl, 512, DM * 2, DM * 2, S, E);
                SEAM(14);
            }
        }
        if (IN(pb + 0)) PHASE(pb + 0) { const karg_t ka = kargs(); unsigned char* const ws = uptr(KWS(ka));
            MapLin mp{(const char*)(ws + (l == 0 ? WS_XB : WS_XALT)), (const char*)(ws + WS_WCQ_T + (size_t)l * DM * DM * 2), (size_t)256 * DM * 2, (size_t)256 * DM * 2};
            pg8::Sched<MapLin> S; S.init(NTOK / 256, DM / 256, G, bx, mp);
            EpiRowScale E{(bf16_t*)(ws + WS_QCB), DM, (const float*)(ws + WS_SSP), 0.04419417382415922f};
            pg8::gemm_phase<EpiRowScale, pg8::Sched<MapLin>, true>(F.wave, ring, xl, DM, DM * 2, DM * 2, S, E);
            SEAM(pb + 0);
        }
        if (IN(pb + 1)) PHASE(pb + 1) { const karg_t ka = kargs(); unsigned char* const ws = uptr(KWS(ka));
            MapXS mp{(const char*)(ws + WS_QCB), (const char*)(ws + WS_KCB + (size_t)l * NB * MEML * DM * 2)};
            pg8::Sched<MapXS> S; S.init(NTOK / 256, NMH, G, bx, mp);
            EpiSoftmax E{(bf16_t*)(ws + WS_PB), NMH * MEML};
            pg8::gemm_phase<EpiSoftmax, pg8::Sched<MapXS>, true>(F.wave, ring, xl, MHD, DM * 2, DM * 2, S, E);
            if (l == 0) KV_PROJ(1, 128, 160);
            SEAM(pb + 1);
        }
        if (IN(pb + 2)) PHASE(pb + 2) { const karg_t ka = kargs(); unsigned char* const ws = uptr(KWS(ka));
            MapXPV mp{(const char*)(ws + WS_PB), (const char*)(ws + WS_VTB + (size_t)l * NB * MEML * DM * 2)};
            pg8::Sched<MapXPV> S; S.init(NTOK / 256, DM / 256, G, bx, mp);
            EpiStore<AddrLin> E{AddrLin{(bf16_t*)(ws + WS_MIXB), DM}};
            pg8::gemm_phase<EpiStore<AddrLin>, pg8::Sched<MapXPV>, true>(F.wave, ring, xl, MEML, NMH * MEML * 2, NB * MEML * 2, S, E);
            SEAM(pb + 2);
        }
        if (IN(pb + 3)) PHASE(pb + 3) { const karg_t ka = kargs(); unsigned char* const ws = uptr(KWS(ka));
            MapLin mp{(const char*)(ws + WS_MIXB), (const char*)(ws + WS_WCO_T + (size_t)l * DM * DM * 2), (size_t)256 * DM * 2, (size_t)256 * DM * 2};
            pg8::Sched<MapLin> S; S.init(NTOK / 256, DM / 256, G, bx, mp);
            EpiResB<false> E{(const bf16_t*)(ws + (l == 0 ? WS_XB : WS_XALT)), (bf16_t*)(ws + (l == 0 ? WS_XALT : WS_XB)), nullptr, nullptr};
            pg8::gemm_phase<EpiResB<false>, pg8::Sched<MapLin>, true>(F.wave, ring, xl, DM, DM * 2, DM * 2, S, E);
            SEAM(pb + 3);
        }
        if (IN(pb + 4)) PHASE(pb + 4) { const karg_t ka = kargs(); unsigned char* const ws = uptr(KWS(ka));
            router_phase(F, (const bf16_t*)(ws + (l == 0 ? WS_XALT : WS_XB)), KIN(ka, 16) + l * DM, KIN(ka, 17) + (size_t)l * DM * NE, (bf16_t*)(ws + WS_HN), (float*)(ws + WS_AFF));
            SEAM(pb + 4);
        }
        if (IN(pb + 5)) PHASE(pb + 5) { const karg_t ka = kargs(); unsigned char* const ws = uptr(KWS(ka));
            rank_phase(F, (const float*)(ws + WS_AFF), (int*)(ws + WS_RANK), (float*)(ws + WS_GATE), (const bf16_t*)(ws + WS_HN), (bf16_t*)(ws + WS_XSB));
            SEAM(pb + 5);
        }
        if (IN(pb + 6)) PHASE(pb + 6) { const karg_t ka = kargs(); unsigned char* const ws = uptr(KWS(ka));
            MapMoE mp{(const char*)(ws + WS_XSB), (const char*)(ws + (l ? WS_WGU_T2 : WS_WGU_T)), (size_t)256 * DM * 2, (size_t)2048 * DM * 2, (size_t)256 * DM * 2};
            pg8::Sched<MapMoE> S; S.init(NB * NE, 8, G, bx, mp);
            EpiSwiGLU E{(bf16_t*)(ws + WS_ACTB)};
            const bool cfirst = ((bx >> 3) & 1) != 0;
            if (l == 0 && cfirst) { tr_span(F, ka, ws, 2, bx * 8 + F.wave, 2048, 3); __syncthreads(); }
            pg8::gemm_phase<EpiSwiGLU, pg8::Sched<MapMoE>, true>(F.wave, ring, xl, DM, DM * 2, DM * 2, S, E);
            if (l == 0 && !cfirst) { __syncthreads(); tr_span(F, ka, ws, 2, bx * 8 + F.wave, 2048, 3); }
            SEAM(pb + 6);
        }
        if (IN(pb + 7)) PHASE(pb + 7) { const karg_t ka = kargs(); unsigned char* const ws = uptr(KWS(ka));
            MapMoE mp{(const char*)(ws + WS_ACTB), (const char*)(ws + (l ? WS_WD_T2 : WS_WD_T)), (size_t)256 * EFF * 2, (size_t)2048 * EFF * 2, (size_t)256 * EFF * 2};
            pg8::Sched<MapMoE> S; S.init(NB * NE, 8, G, bx, mp);
            EpiRowGate E{(bf16_t*)(ws + WS_YB), (const float*)(ws + WS_GATE)};
            const bool cfirst = ((bx >> 3) & 1) == 0;
            if (l == 0 && cfirst) { tr_span(F, ka, ws, 2, 6144 + bx * 8 + F.wave, 2048, 3); __syncthreads(); }
            pg8::gemm_phase<EpiRowGate, pg8::Sched<MapMoE>, true>(F.wave, ring, xl, EFF, EFF * 2, EFF * 2, S, E);
            if (l == 0 && !cfirst) { __syncthreads(); tr_span(F, ka, ws, 2, 6144 + bx * 8 + F.wave, 2048, 3); }
            SEAM(pb + 7);
        }
        if (IN(pb + 8)) PHASE(pb + 8) { const karg_t ka = kargs(); unsigned char* const ws = uptr(KWS(ka));
            combine_phase(F, (const bf16_t*)(ws + (l == 0 ? WS_XALT : WS_XB)), (bf16_t*)(ws + WS_XB), KOUT(ka), (const bf16_t*)(ws + WS_YB), (const int*)(ws + WS_RANK), l == 0 ? KIN(ka, 2) + DM : KIN(ka, 21), (bf16_t*)(ws + WS_HN), l == 1);
            SEAM(pb + 8);
        }
    }
#undef IN
#undef SEAM
#undef PHASE
#undef KV_PROJ
}


extern "C" void kernel_launch(void* const* d_in, const int* in_sizes, int n_in, void* d_out, int out_size, void* d_ws, size_t ws_size, hipStream_t stream) {
    static int grid = 0;
    if (grid == 0) {
        int dev = 0, cus = 0;
        if (n_in != 22 || out_size != NTOK * DM || ws_size < WS_FAST_END) { fprintf(stderr, "kernel_launch: unexpected shapes (n_in %d out %d ws %zu)\n", n_in, out_size, ws_size); grid = -1; return; }
        if (hipGetDevice(&dev) != hipSuccess || hipDeviceGetAttribute(&cus, hipDeviceAttributeMultiprocessorCount, dev) != hipSuccess) { fprintf(stderr, "device query failed\n"); grid = -1; return; }
        if (hipFuncSetAttribute((const void*)skel_fwd, hipFuncAttributeMaxDynamicSharedMemorySize, LDS_BYTES) != hipSuccess) { fprintf(stderr, "hipFuncSetAttribute failed\n"); grid = -1; return; }
        (void)hipGetLastError();
        grid = cus;
        if (grid != 256) { fprintf(stderr, "kernel_launch: this kernel is laid out for 256 CUs (found %d)\n", cus); grid = -1; return; }
    }
    if (grid < 0) return;
    (void)hipMemsetAsync((char*)d_ws + WS_CTL, 0, 32768, stream);
    Args a{};
    for (int i = 0; i < 22; ++i) a.in[i] = (const float*)d_in[i];
    a.out = (float*)d_out; a.ws = (unsigned char*)d_ws;
#ifdef REP_RT
    a.pad = REP_RT;
#endif
    constexpr int NL = MK_N_LAUNCHES;
    for (int li = 0; li < NL; ++li) {
        a.ph_lo = (N_PHASES * li) / NL; a.ph_hi = (N_PHASES * (li + 1)) / NL; a.li = li;
        hipLaunchKernelGGL(skel_fwd, dim3(grid), dim3(NWAVES * 64), LDS_BYTES, stream, a);
    }
}
```

```cpp
#include <hip/hip_runtime.h>
#include <cstdio>
#include <cstdint>

constexpr int DM = 2048, NB = 4, SEQ = 2048, NTOK = NB * SEQ;
constexpr int HD = 128, NQH = 12, NKVH = 4, AW = NQH * HD, KVW = NKVH * HD, FW = 512, INW = 3072;
constexpr int MEML = 256, NMH = 4, MHD = 512;
constexpr int NE = 16, EFF = 1024, CAP = 256;
constexpr float EPS = 1e-6f;

#define LAS __attribute__((address_space(3)))
#define GAS __attribute__((address_space(1)))
typedef unsigned short bf16_t;
typedef short bf16x8 __attribute__((ext_vector_type(8)));
typedef float f32x4 __attribute__((ext_vector_type(4)));
typedef float f32x2 __attribute__((ext_vector_type(2)));
typedef unsigned u32x4 __attribute__((ext_vector_type(4)));
typedef unsigned u32x2 __attribute__((ext_vector_type(2)));
typedef __bf16 bf16x2_t __attribute__((ext_vector_type(2)));
__device__ __forceinline__ unsigned cvtpk(float lo, float hi) { f32x2 v = {lo, hi}; bf16x2_t b = __builtin_convertvector(v, bf16x2_t); return __builtin_bit_cast(unsigned, b); }
__device__ __forceinline__ float bf2f(unsigned short h) { return __uint_as_float(((unsigned)h) << 16); }
template <class T> __device__ __forceinline__ T* uptr(T* p) { const unsigned long long v = (unsigned long long)p; const unsigned lo = __builtin_amdgcn_readfirstlane((unsigned)v), hi = __builtin_amdgcn_readfirstlane((unsigned)(v >> 32)); return (T*)(((unsigned long long)hi << 32) | lo); }
__device__ __forceinline__ int lane_id() { int l = (int)__builtin_amdgcn_mbcnt_hi(~0u, __builtin_amdgcn_mbcnt_lo(~0u, 0u)); asm volatile("" : "+v"(l)); return l; }
typedef __attribute__((address_space(4))) const unsigned char* karg_t;
__device__ __forceinline__ karg_t kargs() { karg_t p = (karg_t)__builtin_amdgcn_kernarg_segment_ptr(); asm volatile("" : "+s"(p)); return p; }
#define KIN(ka, i) (*(const float* const __attribute__((address_space(4)))*)((ka) + 8 * (i)))
#define KOUT(ka) (*(float* const __attribute__((address_space(4)))*)((ka) + 176))
#define KWS(ka) (*(unsigned char* const __attribute__((address_space(4)))*)((ka) + 184))
#ifndef EPI_WT
#define EPI_WT 0
#endif
__device__ __forceinline__ void st16(void* p, u32x4 v) {
#if EPI_WT
    asm volatile("global_store_dwordx4 %0, %1, off sc1\n\ts_nop 1" :: "v"(p), "v"(v) : "memory");
#else
    *(u32x4*)p = v;
#endif
}
#define LDS_WAIT() asm volatile("s_waitcnt lgkmcnt(0)" ::: "memory")
#define VM_WAIT() asm volatile("s_waitcnt vmcnt(0)" ::: "memory")
#define WG_BAR() do { asm volatile("s_waitcnt lgkmcnt(0)" ::: "memory"); __builtin_amdgcn_s_barrier(); asm volatile("" ::: "memory"); } while (0)

namespace pg8 {
constexpr int BM = 256, BK = 64, HALF = 128, HTB = HALF * BK * 2, STAGE_BYTES = 8 * HTB, NXCD = 8, WGM = 8;
__host__ __device__ __forceinline__ int lds_byte(int r, int c) { const int st = (r >> 4) * 2 + (c >> 5), rr = r & 15, cc = c & 31, ob = rr * 64 + cc * 2; return st * 1024 + (ob ^ (((ob >> 9) & 1) << 5)); }
__host__ __device__ __forceinline__ void stage_rc(int b, int& R, int& C) { const int st = b / 1024, sb = b % 1024, swz = sb ^ (((sb >> 9) & 1) << 5); R = (st >> 1) * 16 + swz / 64; C = (st & 1) * 32 + (swz % 64) / 2; }
__host__ __device__ __forceinline__ int perm32(int rho) { const int n = rho >> 4, i = rho & 15; return 8 * (i >> 2) + 4 * n + (i & 3); }

struct Unit { int pm, pn; const char* a; const char* b; };
struct EpiCtx { int wr, wc, wid; LAS unsigned char* xl; };

template <class Map> struct Sched {
    int nM, nN, nwg, G, c; Map map;
    __device__ __forceinline__ void init(int nM_, int nN_, int G_, int c_, const Map& m) { nM = nM_; nN = nN_; nwg = nM * nN; G = G_; c = c_; map = m; }
    __device__ __forceinline__ bool next(int i, Unit& u) const {
        const long L = (long)i * G + c; if (L >= nwg) return false;
        int wgid = (int)L; { const int q = nwg / NXCD, r = nwg % NXCD, xcd = wgid % NXCD, off = wgid / NXCD; wgid = (xcd < r ? xcd * (q + 1) : r * (q + 1) + (xcd - r) * q) + off; }
        const int nig = WGM * nN, gid = wgid / nig, fm = gid * WGM, gsz = (nM - fm) < WGM ? (nM - fm) : WGM;
        u.pm = fm + ((wgid % nig) % gsz); u.pn = (wgid % nig) / gsz; map(u); return true;
    }
};

template <class Epi, class SchedT, bool SP2, bool GATHER = false>
__device__ __forceinline__ void gemm_phase(const int wave_, LAS unsigned char* lds, LAS unsigned char* xl, const int K, const int lda, const int ldb, const SchedT& S, const Epi& E, const int* gidx = nullptr) {
    constexpr bool ALIGN_EPI = true; static_assert(SP2 || !GATHER, "GATHER needs the SP2 loop");
    const int lane = lane_id(), wid = wave_, tid = wid * 64 + lane, wr = wid >> 2, wc = wid & 3, fr = lane & 15, fq = lane >> 4;
    const int nt = K / BK;
    unsigned voffA[2], voffB[2];
#pragma unroll
    for (int i = 0; i < 2; ++i) { int R, C; stage_rc(tid * 16 + i * 8192, R, C); const int Rb = Epi::PERM ? ((R & ~31) + perm32(R & 31)) : R;
        voffA[i] = (unsigned)(R * lda + C * 2); voffB[i] = (unsigned)(Rb * ldb + C * 2); }
    const size_t kstep = (size_t)(BK * 2);
    const size_t hstepA = (size_t)HALF * lda, hstepB = (size_t)HALF * ldb;
    const unsigned ldsw = (unsigned)wid * 1024u;
    const int aoff = lds_byte(wr * 64 + fr, fq * 8), boff = lds_byte(wc * 32 + fr, fq * 8);
    const unsigned xoffA = (unsigned)tid * 16u;
    int gset = 0;
#define PG8_GSETUP(set, pm_) do { if constexpr (GATHER) { int R0_, C0_, R1_, C1_; stage_rc(tid * 16, R0_, C0_); stage_rc(tid * 16 + 8192, R1_, C1_); \
        const GAS int* gi_ = (const GAS int*)gidx + (pm_) * 256; const int r00_ = gi_[R0_], r01_ = gi_[R1_], r10_ = gi_[128 + R0_], r11_ = gi_[128 + R1_];     \
        *(LAS u32x4*)(xl + (set) * 8192 + xoffA) = (u32x4){(unsigned)(r00_ * lda + C0_ * 2), (unsigned)(r01_ * lda + C1_ * 2), (unsigned)(r10_ * lda + C0_ * 2), (unsigned)(r11_ * lda + C1_ * 2)}; } } while (0)
#define PG8_SA(b, h) (((b) * 2 + (h)) * HTB)
#define PG8_SB(b, h) ((4 + (b) * 2 + (h)) * HTB)
#define PG8_STAGE(bufoff, gbase, voff) do { _Pragma("unroll") for (int _i = 0; _i < 2; ++_i) \
        __builtin_amdgcn_global_load_lds((const unsigned*)((const char*)(gbase) + (voff)[_i]), (LAS unsigned*)(lds + (bufoff) + ldsw + _i * 8192), 16, 0, 0); } while (0)
#define PG8_GOFF(h_, set_) u32x2 go_ = {0u, 0u}; if constexpr (GATHER) go_ = *(const LAS u32x2*)(xl + (set_) * 8192 + xoffA + (h_) * 8)
#define PG8_STAGE_A(bufoff, gbase, h_, set_) do { if constexpr (GATHER) { \
        __builtin_amdgcn_global_load_lds((const unsigned*)((const char*)(gbase) + go_.x), (LAS unsigned*)(lds + (bufoff) + ldsw), 16, 0, 0); \
        __builtin_amdgcn_global_load_lds((const unsigned*)((const char*)(gbase) + go_.y), (LAS unsigned*)(lds + (bufoff) + ldsw + 8192), 16, 0, 0); } \
      else { PG8_STAGE(bufoff, (const char*)(gbase) + (h_) * hstepA, voffA); } } while (0)
#define PG8_LDA(dst, b, h) do { _Pragma("unroll") for (int m = 0; m < 4; ++m) _Pragma("unroll") for (int k = 0; k < 2; ++k) dst[m][k] = *(const LAS bf16x8*)(lds + PG8_SA(b, h) + aoff + m * 2048 + k * 1024); } while (0)
#define PG8_LDB(dst, b, h) do { _Pragma("unroll") for (int n = 0; n < 2; ++n) _Pragma("unroll") for (int k = 0; k < 2; ++k) dst[n][k] = *(const LAS bf16x8*)(lds + PG8_SB(b, h) + boff + n * 2048 + k * 1024); } while (0)
#define PG8_MMA(ai, bj, At, Bt) do { __builtin_amdgcn_s_setprio(1); _Pragma("unroll") for (int m = 0; m < 4; ++m) _Pragma("unroll") for (int n = 0; n < 2; ++n) _Pragma("unroll") for (int k = 0; k < 2; ++k) \
        acc[ai][bj][m][n] = __builtin_amdgcn_mfma_f32_16x16x32_bf16(Bt[n][k], At[m][k], acc[ai][bj][m][n], 0, 0, 0); __builtin_amdgcn_s_setprio(0); } while (0)
#define PG8_WAIT_V(n) asm volatile("s_waitcnt vmcnt(" #n ")" ::: "memory")
#define PG8_WAIT_L(n) asm volatile("s_waitcnt lgkmcnt(" #n ")" ::: "memory")
#define PG8_BAR __builtin_amdgcn_s_barrier()
#define PG8_SCHED __builtin_amdgcn_sched_barrier(0)
    Unit cur, nxt; int ui = 0;
    if (!S.next(0, cur)) return;
    EpiCtx ctx; ctx.wr = wr; ctx.wc = wc; ctx.wid = wid; ctx.xl = xl;
    f32x4 acc[2][2][4][2];
#pragma unroll
    for (int a = 0; a < 2; ++a)
#pragma unroll
        for (int b = 0; b < 2; ++b)
#pragma unroll
            for (int m = 0; m < 4; ++m)
#pragma unroll
                for (int n = 0; n < 2; ++n) acc[a][b][m][n] = (f32x4){0.f, 0.f, 0.f, 0.f};
    bf16x8 At[4][2], B0[2][2], B1[2][2];
    const char* cA = cur.a; const char* cB = cur.b;
    PG8_GSETUP(0, cur.pm);
    if constexpr (SP2) {
        PG8_STAGE(PG8_SB(0, 0), cB, voffB); PG8_STAGE(PG8_SB(0, 1), cB + hstepB, voffB); { PG8_GOFF(0, 0); PG8_STAGE_A(PG8_SA(0, 0), cA, 0, 0); } { PG8_GOFF(1, 0); PG8_STAGE_A(PG8_SA(0, 1), cA, 1, 0); }
        if (wr == 1) PG8_BAR;
        PG8_WAIT_V(2); PG8_BAR;
        PG8_STAGE(PG8_SB(1, 0), cB + kstep, voffB); { PG8_GOFF(0, 0); PG8_STAGE_A(PG8_SA(1, 0), cA + kstep, 0, 0); } PG8_STAGE(PG8_SB(1, 1), cB + hstepB + kstep, voffB);
        PG8_WAIT_V(6); PG8_BAR;
    } else {
        PG8_STAGE(PG8_SB(0, 0), cB, voffB); PG8_STAGE(PG8_SA(0, 0), cA, voffA); PG8_STAGE(PG8_SB(0, 1), cB + hstepB, voffB); PG8_STAGE(PG8_SA(0, 1), cA + hstepA, voffA);
        if (wr == 1) PG8_BAR;
        PG8_WAIT_V(4); PG8_BAR;
        PG8_STAGE(PG8_SB(1, 0), cB + kstep, voffB); PG8_STAGE(PG8_SA(1, 0), cA + kstep, voffA); PG8_STAGE(PG8_SB(1, 1), cB + hstepB + kstep, voffB);
        PG8_WAIT_V(6); PG8_BAR;
    }
    for (;;) {
        const bool has_next = S.next(ui + 1, nxt);
        const char* nA = has_next ? nxt.a : cA; const char* nB = has_next ? nxt.b : cB;
        if (has_next) PG8_GSETUP(gset ^ 1, nxt.pm);
        for (int t = 0; t < nt; t += 2) {
            const bool last = (t == nt - 2);
            const char* a1 = cA + (size_t)(t + 1) * kstep;
            const char* a2 = last ? nA : cA + (size_t)(t + 2) * kstep; const char* b2 = last ? nB : cB + (size_t)(t + 2) * kstep;
            const char* a3 = a2 + kstep; const char* b3 = b2 + kstep;
            const int set2 = (last && has_next) ? (gset ^ 1) : gset;
            if constexpr (SP2) {
            { PG8_GOFF(1, gset); PG8_LDB(B0, 0, 0); PG8_LDB(B1, 0, 1); PG8_SCHED; PG8_LDA(At, 0, 0); PG8_STAGE_A(PG8_SA(1, 1), a1, 1, gset); }
            PG8_WAIT_V(8); PG8_WAIT_L(0); PG8_BAR; PG8_MMA(0, 0, At, B0); PG8_MMA(0, 1, At, B1); PG8_BAR; PG8_SCHED;
            { PG8_GOFF(0, set2); PG8_LDA(At, 0, 1); PG8_STAGE(PG8_SB(0, 0), b2, voffB); PG8_STAGE(PG8_SB(0, 1), b2 + hstepB, voffB); PG8_STAGE_A(PG8_SA(0, 0), a2, 0, set2); }
            PG8_WAIT_V(8); PG8_WAIT_L(0); PG8_BAR; PG8_MMA(1, 0, At, B0); PG8_MMA(1, 1, At, B1); PG8_BAR; PG8_SCHED;
            { PG8_GOFF(1, set2); PG8_LDB(B0, 1, 0); PG8_LDB(B1, 1, 1); PG8_SCHED; PG8_LDA(At, 1, 0); PG8_STAGE_A(PG8_SA(0, 1), a2, 1, set2); }
            PG8_WAIT_V(8); PG8_WAIT_L(0); PG8_BAR; PG8_MMA(0, 0, At, B0); PG8_MMA(0, 1, At, B1); PG8_BAR; PG8_SCHED;
            { PG8_GOFF(0, set2); PG8_LDA(At, 1, 1); PG8_STAGE(PG8_SB(1, 0), b3, voffB); PG8_STAGE(PG8_SB(1, 1), b3 + hstepB, voffB); PG8_STAGE_A(PG8_SA(1, 0), a3, 0, set2); }
            PG8_WAIT_V(8); PG8_WAIT_L(0); PG8_BAR; PG8_MMA(1, 0, At, B0); PG8_MMA(1, 1, At, B1); PG8_BAR; PG8_SCHED;
            } else {
            PG8_LDB(B0, 0, 0); PG8_SCHED; PG8_LDA(At, 0, 0); PG8_STAGE(PG8_SA(1, 1), a1 + hstepA, voffA);
            PG8_WAIT_L(8); PG8_BAR; PG8_WAIT_L(0); PG8_MMA(0, 0, At, B0); PG8_BAR; PG8_SCHED;
            PG8_LDB(B1, 0, 1); PG8_STAGE(PG8_SB(0, 0), b2, voffB);
            PG8_BAR; PG8_WAIT_L(0); PG8_MMA(0, 1, At, B1); PG8_BAR;
            PG8_LDA(At, 0, 1); PG8_STAGE(PG8_SA(0, 0), a2, voffA);
            PG8_BAR; PG8_WAIT_L(0); PG8_MMA(1, 0, At, B0); PG8_BAR; PG8_SCHED;
            PG8_STAGE(PG8_SB(0, 1), b2 + hstepB, voffB);
            PG8_WAIT_V(6); PG8_BAR; PG8_MMA(1, 1, At, B1); PG8_BAR;
            PG8_LDB(B0, 1, 0); PG8_SCHED; PG8_LDA(At, 1, 0); PG8_STAGE(PG8_SA(0, 1), a2 + hstepA, voffA);
            PG8_WAIT_L(8); PG8_BAR; PG8_WAIT_L(0); PG8_MMA(0, 0, At, B0); PG8_BAR; PG8_SCHED;
            PG8_LDB(B1, 1, 1); PG8_STAGE(PG8_SB(1, 0), b3, voffB);
            PG8_BAR; PG8_WAIT_L(0); PG8_MMA(0, 1, At, B1); PG8_BAR;
            PG8_LDA(At, 1, 1); PG8_STAGE(PG8_SA(1, 0), a3, voffA);
            PG8_BAR; PG8_WAIT_L(0); PG8_MMA(1, 0, At, B0); PG8_BAR; PG8_SCHED;
            PG8_STAGE(PG8_SB(1, 1), b3 + hstepB, voffB);
            PG8_WAIT_V(6); PG8_BAR; PG8_MMA(1, 1, At, B1); PG8_BAR;
            }
        }
        if constexpr (ALIGN_EPI) { if (wr == 0) PG8_BAR; }
        E(acc, cur, ctx);
        if (!has_next) break;
#pragma unroll
        for (int a = 0; a < 2; ++a)
#pragma unroll
            for (int b = 0; b < 2; ++b)
#pragma unroll
                for (int m = 0; m < 4; ++m)
#pragma unroll
                    for (int n = 0; n < 2; ++n) acc[a][b][m][n] = (f32x4){0.f, 0.f, 0.f, 0.f};
        cur = nxt; cA = nA; cB = nB; ++ui; gset ^= 1;
        if constexpr (ALIGN_EPI) { if (wr == 1) PG8_BAR; }
    }
    PG8_WAIT_V(0);
    if constexpr (!ALIGN_EPI) { if (wr == 0) PG8_BAR; }
    PG8_BAR;
#undef PG8_SA
#undef PG8_SB
#undef PG8_STAGE
#undef PG8_STAGE_A
#undef PG8_GOFF
#undef PG8_GSETUP
#undef PG8_LDA
#undef PG8_LDB
#undef PG8_MMA
#undef PG8_WAIT_V
#undef PG8_WAIT_L
#undef PG8_BAR
#undef PG8_SCHED
}
}

constexpr size_t MiB = 1u << 20;
constexpr size_t WS_CTL = 0, CTL_ZERO_BYTES = 1 * MiB;
constexpr size_t WS_WIN_T = 1 * MiB, WS_WF_T = 11 * MiB, WS_WOUT_T = 15 * MiB, WS_WCQ_T = 23 * MiB, WS_WCK_T = 39 * MiB, WS_WCV_T = 55 * MiB, WS_WCO_T = 71 * MiB;
constexpr size_t WS_WP_T = 87 * MiB, WS_DFT = 89 * MiB, WS_ROPE = 105 * MiB, WS_WGU_T = 106 * MiB, WS_WD_T = 234 * MiB;
constexpr size_t WS_HN = 298 * MiB, WS_XB = 330 * MiB, WS_QB = 362 * MiB, WS_KB = 386 * MiB, WS_VB = 394 * MiB, WS_FPQ = 402 * MiB, WS_MIXB = 418 * MiB, WS_QCB = 450 * MiB;
constexpr size_t WS_KCB = 482 * MiB, WS_VTB = 490 * MiB, WS_MEMNB = 498 * MiB, WS_PB = 506 * MiB, WS_XSB = 522 * MiB, WS_ACTB = 586 * MiB, WS_YB = 618 * MiB;
constexpr size_t WS_SSP = 682 * MiB, WS_AFF = 683 * MiB, WS_RANK = 684 * MiB, WS_GATE = 685 * MiB, WS_XALT = 686 * MiB, WS_WGU_T2 = 750 * MiB, WS_WD_T2 = 878 * MiB, WS_FAST_END = 942 * MiB;
constexpr int CW_TMO = 0, CW_CODE = 1, CW_BAR = 4096;
constexpr int RING_OFF = 0, RING_BYTES = 131072, XL_OFF = 131072, XL_BYTES = 16384, LDSCTL_OFF = XL_OFF + XL_BYTES, MISC_OFF = LDSCTL_OFF + 320, LDS_BYTES = 149504;
static_assert(MISC_OFF + 128 <= LDS_BYTES, "LDS map");
constexpr int NWAVES = 8;

typedef GAS unsigned gu32;
#define RLX_AGENT __ATOMIC_RELAXED, __HIP_MEMORY_SCOPE_AGENT

#define XB_TMO      128
#define XB_XCNT(j)  (256  + 64 * (j))
#define XB_XSUB(j)  (1280 + 64 * (j))
#define XB_XGEN(j)  (2304 + 64 * (j))
#define XB_TOP      3328
#define XB_TOPGEN   3392
#define XCD_BAR_WORDS 3456
#define XB_SPIN_CAP (1u << 18)
__device__ __forceinline__ unsigned xb_ld(unsigned* p)              { return __hip_atomic_load(p, __ATOMIC_RELAXED, __HIP_MEMORY_SCOPE_AGENT); }
__device__ __forceinline__ unsigned xb_add(unsigned* p, unsigned v) { return __hip_atomic_fetch_add(p, v, __ATOMIC_RELAXED, __HIP_MEMORY_SCOPE_AGENT); }
__device__ __forceinline__ unsigned xb_xcc_id() { return (unsigned)__builtin_amdgcn_s_getreg((3 << 11) | 20) & 0xFu; }
#define XB_SPIN(cond, bar) do { unsigned _sp = 0; while (cond) { __builtin_amdgcn_s_sleep(1); \
    if ((++_sp & 255u) == 0u) { if (xb_ld(&(bar)[XB_TMO])) break; if (_sp > XB_SPIN_CAP) { atomicAdd(&(bar)[XB_TMO], 1u); break; } } } } while (0)
struct XcdBarrier { unsigned* bar; unsigned x; volatile LAS unsigned* st; int wave; };
__device__ __forceinline__ XcdBarrier xcd_barrier_post(unsigned* bar, volatile LAS unsigned* st, int wave) {
    XcdBarrier b; b.bar = bar; b.x = xb_xcc_id(); b.st = st; b.wave = wave;
    if (wave == 0 && lane_id() == 0) (void)xb_add(&bar[XB_XCNT(b.x)], 1u);
    return b;
}
__device__ __forceinline__ void xcd_barrier_complete(unsigned* bar, unsigned x, unsigned& nloc, unsigned& nx) {
    const unsigned G = gridDim.x * gridDim.y * gridDim.z;
    unsigned sum, cnt, mine, sp = 0u;
    for (;;) {
        sum = 0u; cnt = 0u; mine = 0u;
#pragma unroll
        for (unsigned j = 0; j < 16; ++j) { const unsigned c = xb_ld(&bar[XB_XCNT(j)]); sum += c; cnt += (c > 0u) ? 1u : 0u; mine = (j == x) ? c : mine; }
        if (sum == G) break;
        __builtin_amdgcn_s_sleep(1);
        if ((++sp & 255u) == 0u) { if (xb_ld(&bar[XB_TMO])) break; if (sp > XB_SPIN_CAP) { atomicAdd(&bar[XB_TMO], 1u); break; } }
    }
    nloc = mine > 0u ? mine : 1u; nx = cnt > 0u ? cnt : 1u;
}
__device__ __forceinline__ void xcd_barrier(const XcdBarrier& b) {
    asm volatile("s_waitcnt vmcnt(0)" ::: "memory");
    __syncthreads();
    if (b.wave == 0 && lane_id() == 0) {
        unsigned* bar = b.bar;
        __builtin_amdgcn_s_waitcnt(0);
        unsigned nloc = b.st[0], nx = b.st[1];
        if (nloc == 0u) { xcd_barrier_complete(bar, b.x, nloc, nx); b.st[0] = nloc; b.st[1] = nx; }
        const unsigned old = xb_add(&bar[XB_XSUB(b.x)], 1u);
        const unsigned gen = old / nloc;
        if (old + 1u == (gen + 1u) * nloc) {
            __builtin_amdgcn_fence(__ATOMIC_RELEASE, "agent");
            asm volatile("s_waitcnt vmcnt(0)" ::: "memory");
            const unsigned og = xb_add(&bar[XB_TOP], 1u);
            const unsigned tg = og / nx;
            if (og + 1u == (tg + 1u) * nx) xb_add(&bar[XB_TOPGEN], 1u);
            else XB_SPIN(xb_ld(&bar[XB_TOPGEN]) == tg, bar);
            __builtin_amdgcn_fence(__ATOMIC_ACQUIRE, "agent");
            xb_add(&bar[XB_XGEN(b.x)], 1u);
            asm volatile("s_waitcnt vmcnt(0)" ::: "memory");
        } else {
            XB_SPIN(xb_ld(&bar[XB_XGEN(b.x)]) == gen, bar);
            __builtin_amdgcn_fence(__ATOMIC_ACQUIRE, "agent");
            asm volatile("s_waitcnt vmcnt(0)" ::: "memory");
        }
    }
    __syncthreads();
}

struct Args { const float* in[22]; float* out; unsigned char* ws; int ph_lo, ph_hi, li, pad; };
struct Frame {
    LAS unsigned char* lds; volatile LAS unsigned* MISC; gu32* ctl;
    int wave, vcu, G;
    unsigned char* ws;
};
__device__ __forceinline__ float wave_sum(float v) {
#pragma unroll
    for (int o = 1; o < 64; o <<= 1) v += __shfl_xor(v, o);
    return v;
}
struct TrDesc { const float* W; const float* gain; bf16_t* WT; int ldw, ldt, k0, n0; long drow0; };
__device__ __forceinline__ void tr_load(const TrDesc& d, f32x4 (&v)[16], int lane) {
    const int lr = lane >> 4, lc = (lane & 15) * 4;
#pragma unroll
    for (int i = 0; i < 16; ++i) v[i] = __builtin_nontemporal_load((const GAS f32x4*)(d.W + (size_t)(d.k0 + 4 * i + lr) * d.ldw + d.n0 + lc));
}
#ifndef TRV
#define TRV 0
#endif
template <int V> __device__ __forceinline__ void tr_finish(const TrDesc& d, const f32x4 (&v)[16], LAS float* scr, int lane) {
    const int lr = lane >> 4, lc = (lane & 15) * 4;
    if (V == 1) { f32x4 s = v[0]; for (int i = 1; i < 16; ++i) s = s + v[i]; if (s.x == 1.2345e30f) *(GAS f32x4*)(d.WT) = s; return; }
#pragma unroll
    for (int i = 0; i < 16; ++i) { const int kk = 4 * i + lr; f32x4 x = v[i]; if (d.gain) x = x * d.gain[d.k0 + kk];
        LAS float* s = scr + kk * 65 + lc; s[0] = x.x; s[1] = x.y; s[2] = x.z; s[3] = x.w; }
    LDS_WAIT(); asm volatile("" ::: "memory");
    const int c = lane & 7;
#pragma unroll
    for (int j = 0; j < 8; ++j) { const int n = (lane >> 3) + 8 * j; const LAS float* s = scr + (8 * c) * 65 + n;
        u32x4 o; o.x = cvtpk(s[0 * 65], s[1 * 65]); o.y = cvtpk(s[2 * 65], s[3 * 65]); o.z = cvtpk(s[4 * 65], s[5 * 65]); o.w = cvtpk(s[6 * 65], s[7 * 65]);
        if (V == 0 || o.x == 0x12345678u) *(GAS u32x4*)(d.WT + (size_t)(d.drow0 + n) * d.ldt + d.k0 + 8 * c) = o; }
    LDS_WAIT(); asm volatile("" ::: "memory");
}
#ifndef TR_PIPE
#define TR_PIPE 0
#endif
constexpr int TR_DENSE = 32 * 20 + 9 * 32 * 16 + 32 * 4, TR_EXPERT = NE * 768;
__device__ __forceinline__ TrDesc tr_desc(karg_t ka, unsigned char* ws, int it, int mode) {
    TrDesc d; d.gain = nullptr;
    constexpr int I_IN = 32 * 20, I_SQ = 32 * 16;
    if (mode == 0) {
        int r = it;
        if (r < I_IN) { d.W = KIN(ka, 3); d.ldw = INW; d.WT = (bf16_t*)(ws + WS_WIN_T); d.ldt = DM; d.k0 = (r / 20) * 64; d.n0 = (r % 20) * 128; d.drow0 = d.n0; return d; } r -= I_IN;
        if (r < I_SQ) { d.W = KIN(ka, 7); d.ldw = DM; d.WT = (bf16_t*)(ws + WS_WOUT_T); d.ldt = DM; d.k0 = (r / 16) * 64; d.n0 = (r % 16) * 128; d.drow0 = d.n0; return d; } r -= I_SQ;
        if (r < 8 * I_SQ) { const int j = r / I_SQ, q = r % I_SQ, wsel = j >> 1, layer = j & 1;
            d.W = KIN(ka, 12 + wsel) + (size_t)layer * DM * DM; d.ldw = DM; if (wsel == 0) d.gain = KIN(ka, 10) + layer * DM;
            d.WT = (bf16_t*)(ws + (wsel == 0 ? WS_WCQ_T : wsel == 1 ? WS_WCK_T : wsel == 2 ? WS_WCV_T : WS_WCO_T) + (size_t)layer * DM * DM * 2); d.ldt = DM;
            d.k0 = (q / 16) * 64; d.n0 = (q % 16) * 128; d.drow0 = d.n0; return d; } r -= 8 * I_SQ;
        d.W = KIN(ka, 8); d.ldw = 512; d.WT = (bf16_t*)(ws + WS_WP_T); d.ldt = DM; d.k0 = (r / 4) * 64; d.n0 = (r % 4) * 128; d.drow0 = d.n0; return d;
    }
    const int layer = mode - 1;
    const int e = it / 768, r = it % 768; const size_t eo = (size_t)(layer * NE + e);
    if (r < 512) { const int up = r >> 8, q = r & 255, kb = q >> 3, nb = q & 7, n0 = nb * 128;
        d.W = (up ? KIN(ka, 19) : KIN(ka, 18)) + eo * DM * EFF; d.ldw = EFF; d.gain = KIN(ka, 16) + layer * DM;   d.WT = (bf16_t*)(ws + (layer ? WS_WGU_T2 : WS_WGU_T)) + (size_t)e * 2048 * 2048; d.ldt = 2048;
        d.k0 = kb * 64; d.n0 = n0; d.drow0 = (long)(n0 >> 7) * 256 + up * 128;
    } else { const int q = r - 512, kb = q >> 4, nb = q & 15;
        d.W = KIN(ka, 20) + eo * EFF * DM; d.ldw = DM; d.WT = (bf16_t*)(ws + (layer ? WS_WD_T2 : WS_WD_T)) + (size_t)e * 2048 * 1024; d.ldt = 1024; d.k0 = kb * 64; d.n0 = nb * 128; d.drow0 = nb * 128; }
    return d;
}
template <int V = 0> __device__ __forceinline__ void tr_span(const Frame& F, karg_t ka, unsigned char* ws, int mode, int first, int stride, int cnt) {
    const int lane = lane_id(); LAS float* scr = (LAS float*)(F.lds + RING_OFF + F.wave * 16640);
    if (cnt <= 0) return;
    f32x4 va[16], vb[16];
    TrDesc da = tr_desc(ka, ws, first, mode), db = da; db.n0 += 64; db.drow0 += 64;
    tr_load(da, va, lane); tr_load(db, vb, lane);
    for (int j = 0; j < cnt; ++j) {
        const bool more = j + 1 < cnt; TrDesc na = da, nb = db;
        if (more) { na = tr_desc(ka, ws, first + stride * (j + 1), mode); nb = na; nb.n0 += 64; nb.drow0 += 64; }
        tr_finish<V>(da, va, scr, lane); if (more) tr_load(na, va, lane);
        tr_finish<V>(db, vb, scr, lane); if (more) tr_load(nb, vb, lane);
        da = na; db = nb;
    }
}
__device__ __forceinline__ void rms_row_to_bf16(const float* xrow, const float* __restrict__ gain, bf16_t* orow, int lane) {
    const GAS f32x4* xr = (const GAS f32x4*)xrow + lane; const f32x4* gr = (const f32x4*)gain + lane;
    f32x4 v[8]; float s = 0.f;
#pragma unroll
    for (int j = 0; j < 8; ++j) { v[j] = xr[64 * j]; s += (v[j].x * v[j].x + v[j].y * v[j].y) + (v[j].z * v[j].z + v[j].w * v[j].w); }
    const float r = rsqrtf(wave_sum(s) * (1.f / DM) + EPS);
    GAS u32x2* o8 = (GAS u32x2*)orow + lane;
#pragma unroll
    for (int j = 0; j < 8; ++j) { const f32x4 g = gr[64 * j]; u32x2 w; w.x = cvtpk(v[j].x * r * g.x, v[j].y * r * g.y); w.y = cvtpk(v[j].z * r * g.z, v[j].w * r * g.w); o8[64 * j] = w; }
}

__device__ __forceinline__ void p0_prologue(Frame& F, karg_t ka, unsigned char* ws) {
    const float* x = KIN(ka, 0); const float* mem = KIN(ka, 1); const float* mix_norm = KIN(ka, 2); const float* w_in = KIN(ka, 3);
    const float* w_four = KIN(ka, 6); const float* w_out = KIN(ka, 7); const float* pool_w = KIN(ka, 8); const float* cross_norm = KIN(ka, 10); const float* mem_norm = KIN(ka, 11);
    const int gw = F.vcu * NWAVES + F.wave, NGW = F.G * NWAVES;
    const int p_lane = lane_id(), p_tid = F.wave * 64 + p_lane;
    { LAS float* tab = (LAS float*)(F.lds + RING_OFF);
      for (int m = p_tid; m < 2048; m += 512) tab[m] = cosf(6.283185307179586f * (float)m * (1.0f / 2048.0f));
      __syncthreads();
      bf16_t* DFT = (bf16_t*)(ws + WS_DFT);
      for (int row = F.vcu * 8; row < 2048; row += F.G * 8)
          for (int rr = 0; rr < 8; ++rr) { const int k1 = row + rr; if (k1 >= 2048) break;
              { const int c0 = p_tid * 8; const int which = c0 >> 11, s0 = c0 & 2047; unsigned w[4];
#pragma unroll
                for (int j = 0; j < 4; ++j) { const int ma = (k1 * (s0 + 2 * j)) & 2047, mb = (k1 * (s0 + 2 * j + 1)) & 2047;
                    w[j] = cvtpk(tab[(ma - which * 512) & 2047], tab[(mb - which * 512) & 2047]); }
                *(GAS u32x4*)(DFT + (size_t)k1 * 4096 + c0) = (u32x4){w[0], w[1], w[2], w[3]}; } }
      __syncthreads(); }
    { float* RC = (float*)(ws + WS_ROPE); float* RS = RC + SEQ * 64;
      for (int i = F.vcu * 512 + p_tid; i < SEQ * 64; i += F.G * 512) { const int t = i >> 6, p = i & 63; const int pos = (p < 32) ? (t >> 6) : (t & 63); const int j = p & 31;
          const float inv = 1.0f / powf(10000.0f, (float)(2 * j) / 64.0f); const float ang = (float)pos * inv; RC[i] = cosf(ang); RS[i] = sinf(ang); } }
    { LAS float* Mw = (LAS float*)(F.lds + RING_OFF); LAS float* t128 = Mw + 128 * 32;
      bf16_t* WF = (bf16_t*)(ws + WS_WF_T);
      for (int it = F.vcu; it < 256; it += F.G) {
          const int which = it >> 7, g = (it >> 5) & 3, d0 = ((it >> 3) & 3) * 32, k0 = (it & 7) * 256;
          if (p_tid < 128) t128[p_tid] = cosf(6.283185307179586f * (float)p_tid * (1.0f / 128.0f));
          __syncthreads();
          { const int c = p_tid >> 2, dd = (p_tid & 3) * 8; float o[8] = {0.f, 0.f, 0.f, 0.f, 0.f, 0.f, 0.f, 0.f};
            for (int k2 = 0; k2 < 128; ++k2) { const int m = (c * k2) & 127; const float tv = which ? -t128[(m - 32) & 127] : t128[m];
                const float* wr_ = w_four + ((size_t)g * 128 + k2) * 128 + d0 + dd; const f32x4 w0 = *(const f32x4*)wr_, w1 = *(const f32x4*)(wr_ + 4);
                o[0] += tv * w0.x; o[1] += tv * w0.y; o[2] += tv * w0.z; o[3] += tv * w0.w; o[4] += tv * w1.x; o[5] += tv * w1.y; o[6] += tv * w1.z; o[7] += tv * w1.w; }
#pragma unroll
            for (int j = 0; j < 8; ++j) Mw[c * 32 + dd + j] = o[j] * (1.0f / 512.0f); }
          __syncthreads();
          { const int kp = p_tid & 127, dq = p_tid >> 7, k = k0 + 2 * kp; float o0[8] = {0.f, 0.f, 0.f, 0.f, 0.f, 0.f, 0.f, 0.f}, o1[8] = {0.f, 0.f, 0.f, 0.f, 0.f, 0.f, 0.f, 0.f};
            const float* r0 = w_in + (size_t)k * INW + 2560 + g * 128; const float* r1 = r0 + INW;
            for (int c4 = 0; c4 < 32; ++c4) { const f32x4 a = *(const f32x4*)(r0 + 4 * c4), b = *(const f32x4*)(r1 + 4 * c4); const float av[4] = {a.x, a.y, a.z, a.w}, bv[4] = {b.x, b.y, b.z, b.w};
#pragma unroll
                for (int cc = 0; cc < 4; ++cc) { const LAS float* mr = Mw + (4 * c4 + cc) * 32 + dq * 8;
#pragma unroll
                    for (int j = 0; j < 8; ++j) { o0[j] += av[cc] * mr[j]; o1[j] += bv[cc] * mr[j]; } } }
#pragma unroll
            for (int j = 0; j < 8; ++j) *(GAS unsigned*)(WF + (size_t)(which * 512 + g * 128 + d0 + dq * 8 + j) * DM + k) = cvtpk(o0[j], o1[j]); }
          __syncthreads(); } }
    { const int n = (TR_DENSE - gw + NGW - 1) / NGW; tr_span(F, ka, ws, 0, gw, NGW, n > 0 ? n : 0); }
    __syncthreads();
    for (int m = gw; m < NTOK; m += NGW) rms_row_to_bf16(x + (size_t)m * DM, mix_norm, (bf16_t*)(ws + WS_HN) + (size_t)m * DM, p_lane);
    for (int m = gw; m < 2 * NB * MEML; m += NGW) { const int l = m / (NB * MEML), r = m % (NB * MEML);
        rms_row_to_bf16(mem + (size_t)r * DM, mem_norm + l * DM, (bf16_t*)(ws + WS_MEMNB) + (size_t)m * DM, p_lane); }
}

struct MapLin { const char* A; const char* B; size_t as, bs; __device__ __forceinline__ void operator()(pg8::Unit& u) const { u.a = A + (size_t)u.pm * as; u.b = B + (size_t)u.pn * bs; } };

struct EpiQKV {
    static constexpr bool PERM = true;
    bf16_t* Q; bf16_t* K; bf16_t* V; const float* qg; const float* kg; const float* RC; const float* RS;
    __device__ __forceinline__ void operator()(f32x4 (&acc)[2][2][4][2], const pg8::Unit& u, const pg8::EpiCtx& c) const { const int e_lane = lane_id(), e_fr = e_lane & 15, e_fq = e_lane >> 4;
        const int pn = u.pn, hc = c.wc * 32 + e_fq * 8, rl0 = c.wr * 64 + e_fr;
        if (pn >= 8) {
            bf16_t* base = V + (size_t)(u.pm * 256 + rl0) * KVW + (pn - 8) * 256 + hc;
#pragma unroll
            for (int ai = 0; ai < 2; ++ai)
#pragma unroll
                for (int m = 0; m < 4; ++m) { bf16_t* rowp = base + (size_t)(ai * 128 + m * 16) * KVW;
#pragma unroll
                    for (int bj = 0; bj < 2; ++bj) { const f32x4 v0 = acc[ai][bj][m][0], v1 = acc[ai][bj][m][1];
                        st16((rowp + bj * 128), (u32x4){cvtpk(v0.x, v0.y), cvtpk(v0.z, v0.w), cvtpk(v1.x, v1.y), cvtpk(v1.z, v1.w)}); } }
            return;
        }
        LAS float* part = (LAS float*)c.xl;
#pragma unroll
        for (int ai = 0; ai < 2; ++ai)
#pragma unroll
            for (int m = 0; m < 4; ++m)
#pragma unroll
                for (int bj = 0; bj < 2; ++bj) { const f32x4 v0 = acc[ai][bj][m][0], v1 = acc[ai][bj][m][1];
                    float s = (v0.x * v0.x + v0.y * v0.y) + (v0.z * v0.z + v0.w * v0.w) + (v1.x * v1.x + v1.y * v1.y) + (v1.z * v1.z + v1.w * v1.w);
                    s += __shfl_xor(s, 16); s += __shfl_xor(s, 32);
                    if (e_fq == 0) part[((ai * 128 + rl0 + m * 16) * 2 + bj) * 4 + c.wc] = s; }
        WG_BAR();
        const float* gain = pn < 6 ? qg : kg;
        const f32x4 g0 = *(const f32x4*)(gain + hc), g1 = *(const f32x4*)(gain + hc + 4);
        bf16_t* O = pn < 6 ? Q : K; const int ld = pn < 6 ? AW : KVW; const int colbase = (pn < 6 ? pn : pn - 6) * 256 + hc;
#pragma unroll
        for (int ai = 0; ai < 2; ++ai)
#pragma unroll
            for (int m = 0; m < 4; ++m) { const int rl = ai * 128 + rl0 + m * 16, row = u.pm * 256 + rl, sp = row & (SEQ - 1);
                const f32x4 cs = *(const f32x4*)(RC + sp * 64 + (hc >> 1)), sn = *(const f32x4*)(RS + sp * 64 + (hc >> 1));
#pragma unroll
                for (int bj = 0; bj < 2; ++bj) { const f32x4 p4 = *(const LAS f32x4*)(part + (rl * 2 + bj) * 4);
                    const float r = rsqrtf(((p4.x + p4.y) + (p4.z + p4.w)) * (1.0f / 128.0f) + EPS);
                    const f32x4 v0 = acc[ai][bj][m][0] * r * g0, v1 = acc[ai][bj][m][1] * r * g1;
                    u32x4 w; w.x = cvtpk(v0.x * cs.x - v0.y * sn.x, v0.x * sn.x + v0.y * cs.x); w.y = cvtpk(v0.z * cs.y - v0.w * sn.y, v0.z * sn.y + v0.w * cs.y);
                    w.z = cvtpk(v1.x * cs.z - v1.y * sn.z, v1.x * sn.z + v1.y * cs.z); w.w = cvtpk(v1.z * cs.w - v1.w * sn.w, v1.z * sn.w + v1.w * cs.w);
                    st16((O + (size_t)row * ld + colbase + bj * 128), w); } }
    }
};


template <class AddrF> struct EpiStore {
    static constexpr bool PERM = true; AddrF f;
    __device__ __forceinline__ void operator()(f32x4 (&acc)[2][2][4][2], const pg8::Unit& u, const pg8::EpiCtx& c) const { const int e_lane = lane_id(), e_fr = e_lane & 15, e_fq = e_lane >> 4;
        const int hc = c.wc * 32 + e_fq * 8, rl0 = c.wr * 64 + e_fr;
#pragma unroll
        for (int ai = 0; ai < 2; ++ai)
#pragma unroll
            for (int m = 0; m < 4; ++m)
#pragma unroll
                for (int bj = 0; bj < 2; ++bj) { const f32x4 v0 = acc[ai][bj][m][0], v1 = acc[ai][bj][m][1];
                    st16(f(u, ai * 128 + rl0 + m * 16, bj * 128 + hc), (u32x4){cvtpk(v0.x, v0.y), cvtpk(v0.z, v0.w), cvtpk(v1.x, v1.y), cvtpk(v1.z, v1.w)}); }
    }
};
struct AddrF1 { bf16_t* FPQ; __device__ __forceinline__ bf16_t* operator()(const pg8::Unit& u, int rl, int tc) const {
    const int r = u.pm * 256 + rl, which = r >> 9, n = r & 511, cidx = u.pn * 256 + tc, b = cidx >> 11, s = cidx & 2047; return FPQ + (((size_t)(b * 512 + n) * 2 + which) * 2048 + s); } };
struct AddrF2 { bf16_t* MIX; __device__ __forceinline__ bf16_t* operator()(const pg8::Unit& u, int rl, int tc) const {
    const int row = (u.pn >> 1) * 2048 + u.pm * 256 + rl, col = AW + (u.pn & 1) * 256 + tc; return MIX + (size_t)row * DM + col; } };

template <bool BF32> struct EpiResB {
    static constexpr bool PERM = true;
    const void* base; bf16_t* xo; float* ssp; const float* cscale;
    __device__ __forceinline__ void operator()(f32x4 (&acc)[2][2][4][2], const pg8::Unit& u, const pg8::EpiCtx& c) const { const int e_lane = lane_id(), e_fr = e_lane & 15, e_fq = e_lane >> 4;
        const int hc = c.wc * 32 + e_fq * 8, rl0 = c.wr * 64 + e_fr;
        LAS float* part = (LAS float*)c.xl;
#pragma unroll
        for (int ai = 0; ai < 2; ++ai)
#pragma unroll
            for (int m = 0; m < 4; ++m) { const int rl = ai * 128 + rl0 + m * 16; float s = 0.f;
#pragma unroll
                for (int bj = 0; bj < 2; ++bj) { const int col = u.pn * 256 + bj * 128 + hc; const size_t off = (size_t)(u.pm * 256 + rl) * DM + col;
                    f32x4 v0 = acc[ai][bj][m][0], v1 = acc[ai][bj][m][1];
                    if (cscale) { v0 = v0 * *(const f32x4*)(cscale + col); v1 = v1 * *(const f32x4*)(cscale + col + 4); }
                    if (BF32) { v0 = v0 + *(const f32x4*)((const float*)base + off); v1 = v1 + *(const f32x4*)((const float*)base + off + 4); }
                    else { const u32x4 b = *(const u32x4*)((const bf16_t*)base + off);
                        v0.x += __uint_as_float(b.x << 16); v0.y += __uint_as_float(b.x & 0xffff0000u); v0.z += __uint_as_float(b.y << 16); v0.w += __uint_as_float(b.y & 0xffff0000u);
                        v1.x += __uint_as_float(b.z << 16); v1.y += __uint_as_float(b.z & 0xffff0000u); v1.z += __uint_as_float(b.w << 16); v1.w += __uint_as_float(b.w & 0xffff0000u); }
                    st16((xo + off), (u32x4){cvtpk(v0.x, v0.y), cvtpk(v0.z, v0.w), cvtpk(v1.x, v1.y), cvtpk(v1.z, v1.w)});
                    if (ssp) s += ((v0.x * v0.x + v0.y * v0.y) + (v0.z * v0.z + v0.w * v0.w)) + ((v1.x * v1.x + v1.y * v1.y) + (v1.z * v1.z + v1.w * v1.w)); }
                if (ssp) { s += __shfl_xor(s, 16); s += __shfl_xor(s, 32); if (e_fq == 0) part[rl * 4 + c.wc] = s; }
                asm volatile("" ::: "memory"); }
        if (ssp) { WG_BAR();
            if (e_lane < 32) { const int row = c.wid * 32 + e_lane; const f32x4 p4 = *(const LAS f32x4*)(part + row * 4);
                ssp[(size_t)(u.pm * 256 + row) * 8 + u.pn] = (p4.x + p4.y) + (p4.z + p4.w); }
            WG_BAR(); }
    }
};

namespace attn {
using s16x4 = __attribute__((ext_vector_type(4))) short;
using f32x16 = __attribute__((ext_vector_type(16))) float;
constexpr int D = 128, NW = 8, QBLK = 32, KVBLK = 64;
constexpr float SCALE = 0.088388347648318440f;
constexpr float THR = 0.f;
#ifndef ATT_SDEPTH
#define ATT_SDEPTH 1
#endif
constexpr int LDQ = AW, LDK = KVW, LDO = DM;
constexpr size_t SHM_V = KVBLK * D * 2, SHM_K = KVBLK * D * 2, SHM_ATTN = 2 * SHM_V + 2 * SHM_K + NW * 64 * 4;
#define KSWZ(row, colB) ((row) * 256 + ((colB) ^ (((row) & 7) << 4)))
#define SBAR() __builtin_amdgcn_sched_barrier(0)
__device__ __forceinline__ int crow(int r, int hi) { return (r & 3) + 8 * (r >> 2) + 4 * hi; }
__device__ __forceinline__ unsigned cvtpk_a(float lo, float hi) { unsigned r; asm volatile("v_cvt_pk_bf16_f32 %0, %1, %2" : "=v"(r) : "v"(lo), "v"(hi)); return r; }
__device__ __forceinline__ void partialSM(f32x16& p0, f32x16& p1, float& m_reg, float& mn, float& alpha) {
  constexpr float C = SCALE * 1.4426950408889634f;
  float pmax = p0[0]; for (int r = 1; r < 16; ++r) pmax = fmaxf(pmax, p0[r]); for (int r = 0; r < 16; ++r) pmax = fmaxf(pmax, p1[r]);
  { auto rr = __builtin_amdgcn_permlane32_swap(__float_as_uint(pmax), __float_as_uint(pmax), false, false);
    pmax = fmaxf(__uint_as_float(rr[0]), __uint_as_float(rr[1])); }
  if (__builtin_expect(__all(pmax - m_reg <= THR / SCALE), 1)) { mn = m_reg; alpha = 1.f; }
  else { mn = fmaxf(m_reg, pmax); alpha = __builtin_amdgcn_exp2f((m_reg - mn) * C); m_reg = mn; }
  float mnC = -mn * C;
  for (int r = 0; r < 16; ++r) p0[r] = fmaf(p0[r], C, mnC); for (int r = 0; r < 16; ++r) p1[r] = fmaf(p1[r], C, mnC);
  for (int r = 0; r < 16; ++r) p0[r] = __builtin_amdgcn_exp2f(p0[r]);
}
__device__ __forceinline__ void finishSM(f32x16& p0, f32x16& p1, float alpha, float& l_reg, bf16x8& pa0, bf16x8& pa1, bf16x8& pa2, bf16x8& pa3) {
  for (int r = 0; r < 16; ++r) p1[r] = __builtin_amdgcn_exp2f(p1[r]);
  float ps = 0; for (int r = 0; r < 16; ++r) ps += p0[r]; for (int r = 0; r < 16; ++r) ps += p1[r];
  { auto rr = __builtin_amdgcn_permlane32_swap(__float_as_uint(ps), __float_as_uint(ps), false, false);
    ps = __uint_as_float(rr[0]) + __uint_as_float(rr[1]); }
  l_reg = l_reg * alpha + ps;
#define PK4(P, BASE, OUT) do { unsigned a0 = cvtpk_a(P[BASE + 0], P[BASE + 1]), a1 = cvtpk_a(P[BASE + 2], P[BASE + 3]);   \
    unsigned b0 = cvtpk_a(P[BASE + 4], P[BASE + 5]), b1 = cvtpk_a(P[BASE + 6], P[BASE + 7]);                              \
    auto r0 = __builtin_amdgcn_permlane32_swap(a0, b0, false, false); auto r1 = __builtin_amdgcn_permlane32_swap(a1, b1, false, false); \
    u32x4 w = {r0[0], r1[0], r0[1], r1[1]}; OUT = *reinterpret_cast<bf16x8*>(&w); } while (0)
  PK4(p0, 0, pa0); PK4(p0, 8, pa1); PK4(p1, 0, pa2); PK4(p1, 8, pa3);
#undef PK4
}
__device__ __forceinline__ void qkt(f32x16& p0, f32x16& p1, const bf16_t* Ks, const bf16x8* qr, int r32, int hi) {
  p0 = f32x16{}; p1 = f32x16{};
  for (int d0 = 0; d0 < 8; ++d0) { int cb = (d0 * 16 + hi * 8) * 2;
    bf16x8 b0 = *reinterpret_cast<const bf16x8*>((const char*)Ks + KSWZ(r32, cb));
    bf16x8 b1 = *reinterpret_cast<const bf16x8*>((const char*)Ks + KSWZ(32 + r32, cb));
    p0 = __builtin_amdgcn_mfma_f32_32x32x16_bf16(b0, qr[d0], p0, 0, 0, 0);
    p1 = __builtin_amdgcn_mfma_f32_32x32x16_bf16(b1, qr[d0], p1, 0, 0, 0); }
}
__device__ __forceinline__ int v_st(int k, int c) { const int kk = (k & ~0xC) | ((k & 4) << 1) | ((k & 8) >> 1); return ((kk >> 3) * 4 + (c >> 5)) * 512 + ((kk & 7) * 32 + (c & 31)) * 2; }
__device__ __forceinline__ int v_rd_base(int lane) { return ((lane & 3) << 3) | (((lane >> 2) & 3) << 6) | (((lane >> 4) & 1) << 5) | (((lane >> 5) & 1) << 8); }
constexpr int v_rd_off(int d0, int ks, int half) { return d0 * 512 + ks * 4096 + half * 2048; }
template <int OFF> __device__ __forceinline__ s16x4 tr_read(int vb) {
  s16x4 r; asm volatile("ds_read_b64_tr_b16 %0, %1 offset:%2" : "=&v"(r) : "v"(vb), "i"(OFF) : "memory"); return r;
}
template <int D0> __device__ __forceinline__ void pv_one(f32x16& od, int vb, bf16x8 pa0, bf16x8 pa1, bf16x8 pa2, bf16x8 pa3) {
  const s16x4 l0 = tr_read<v_rd_off(D0, 0, 0)>(vb), h0 = tr_read<v_rd_off(D0, 0, 1)>(vb), l1 = tr_read<v_rd_off(D0, 1, 0)>(vb), h1 = tr_read<v_rd_off(D0, 1, 1)>(vb);
  const s16x4 l2 = tr_read<v_rd_off(D0, 2, 0)>(vb), h2 = tr_read<v_rd_off(D0, 2, 1)>(vb), l3 = tr_read<v_rd_off(D0, 3, 0)>(vb), h3 = tr_read<v_rd_off(D0, 3, 1)>(vb);
  asm volatile("s_waitcnt lgkmcnt(0)" ::: "memory"); SBAR();
#define PK(L, H) (bf16x8){L[0], L[1], L[2], L[3], H[0], H[1], H[2], H[3]}
  od = __builtin_amdgcn_mfma_f32_32x32x16_bf16(pa0, PK(l0, h0), od, 0, 0, 0);
  od = __builtin_amdgcn_mfma_f32_32x32x16_bf16(pa1, PK(l1, h1), od, 0, 0, 0);
  od = __builtin_amdgcn_mfma_f32_32x32x16_bf16(pa2, PK(l2, h2), od, 0, 0, 0);
  od = __builtin_amdgcn_mfma_f32_32x32x16_bf16(pa3, PK(l3, h3), od, 0, 0, 0);
#undef PK
}
__device__ __forceinline__ void pv_d0(f32x16* o, int vb, bf16x8 pa0, bf16x8 pa1, bf16x8 pa2, bf16x8 pa3) {
  pv_one<0>(o[0], vb, pa0, pa1, pa2, pa3); pv_one<1>(o[1], vb, pa0, pa1, pa2, pa3); pv_one<2>(o[2], vb, pa0, pa1, pa2, pa3); pv_one<3>(o[3], vb, pa0, pa1, pa2, pa3);
}
__device__ __forceinline__ void attn_dense_body(const bf16_t* __restrict__ Qb, const bf16_t* __restrict__ Kh, const bf16_t* __restrict__ Vh,
                                                bf16_t* __restrict__ Ob, int seq, char* lds, const int wave_) {
  constexpr int SDEPTH = ATT_SDEPTH;
  const int lane = lane_id(), wid = wave_, tid = wid * 64 + lane, r32 = lane & 31, hi = lane >> 5;
  bf16_t* V_lds = (bf16_t*)lds; bf16_t* K_lds = (bf16_t*)(lds + 2 * SHM_V);
  float* ws = (float*)(lds + 2 * SHM_V + 2 * SHM_K) + wid * 64; float* li_l = ws; float* al_l = ws + 32;
  float m_reg = -1e30f, l_reg = 0; f32x16 o[4] = {}; bf16x8 qr[8];
  const bf16_t* Qw = Qb + (long)(wid * QBLK + r32) * LDQ + hi * 8;
#pragma unroll
  for (int d0 = 0; d0 < 8; ++d0) qr[d0] = *reinterpret_cast<const bf16x8*>(Qw + d0 * 16);
  const int sr = tid >> 4, sc = (tid & 15) * 8, vst0 = v_st(sr, sc), vst1 = v_st(32 + sr, sc);
  const int vb0 = (int)(uintptr_t)V_lds + v_rd_base(lane);
  struct { bf16x8 vs0, vs1, ks0, ks1; } sr_[SDEPTH];
#define SLOAD(i, k0) do { sr_[i].vs0 = *reinterpret_cast<const bf16x8*>(&Vh[(long)((k0) + sr) * LDK + sc]); sr_[i].vs1 = *reinterpret_cast<const bf16x8*>(&Vh[(long)((k0) + 32 + sr) * LDK + sc]); \
    sr_[i].ks0 = *reinterpret_cast<const bf16x8*>(&Kh[(long)((k0) + sr) * LDK + sc]); sr_[i].ks1 = *reinterpret_cast<const bf16x8*>(&Kh[(long)((k0) + 32 + sr) * LDK + sc]); } while (0)
#define SWRITE(b, i) do { *(bf16x8*)((char*)V_lds + (b) * SHM_V + vst0) = sr_[i].vs0;          \
    *(bf16x8*)((char*)V_lds + (b) * SHM_V + vst1) = sr_[i].vs1; int kc = sc * 2;               \
    *(bf16x8*)((char*)K_lds + (b) * SHM_K + KSWZ(sr, kc)) = sr_[i].ks0;                       \
    *(bf16x8*)((char*)K_lds + (b) * SHM_K + KSWZ(32 + sr, kc)) = sr_[i].ks1; } while (0)
#define SWAIT() do { if constexpr (SDEPTH == 2) asm volatile("s_waitcnt vmcnt(4)" ::: "memory"); else asm volatile("s_waitcnt vmcnt(0)" ::: "memory"); } while (0)
#define RESC(a) do { if (__any((a) < 1.f)) { if (hi == 0) al_l[r32] = (a); asm volatile("s_waitcnt lgkmcnt(0)" ::: "memory"); \
    for (int d = 0; d < 4; ++d) for (int r = 0; r < 16; ++r) o[d][r] *= al_l[crow(r, hi)]; } } while (0)
  f32x16 pA0, pA1, pB0, pB1; float mnA, mnB, alA, alB; bf16x8 pa0, pa1, pa2, pa3; const int NT = seq / KVBLK;
  constexpr int SE = 0, SO = SDEPTH - 1;
  SLOAD(SE, 0); asm volatile("s_waitcnt vmcnt(0)" ::: "memory"); SWRITE(0, SE); __syncthreads();
  qkt(pA0, pA1, K_lds, qr, r32, hi); partialSM(pA0, pA1, m_reg, mnA, alA);
  SLOAD(SO, KVBLK); if constexpr (SDEPTH == 2) { if (2 < NT) SLOAD(SE, 2 * KVBLK); }
  SWAIT(); SWRITE(1, SO); __syncthreads();
  for (int j = 1; j + 1 < NT; j += 2) {
    SBAR(); qkt(pB0, pB1, (bf16_t*)((char*)K_lds + SHM_K), qr, r32, hi);
    finishSM(pA0, pA1, alA, l_reg, pa0, pa1, pa2, pa3); SBAR();
    SLOAD(SO, (j + SDEPTH) * KVBLK); SBAR();
    pv_d0(o, vb0, pa0, pa1, pa2, pa3); partialSM(pB0, pB1, m_reg, mnB, alB);
    __syncthreads(); SWAIT(); SWRITE(0, SE);
    RESC(alB); __syncthreads();
    SBAR(); qkt(pA0, pA1, K_lds, qr, r32, hi);
    finishSM(pB0, pB1, alB, l_reg, pa0, pa1, pa2, pa3); SBAR();
    if (SDEPTH == 1 || j + 3 < NT) SLOAD(SE, (j + 1 + SDEPTH) * KVBLK); SBAR();
    pv_d0(o, vb0 + (int)SHM_V, pa0, pa1, pa2, pa3); partialSM(pA0, pA1, m_reg, mnA, alA);
    __syncthreads(); SWAIT(); SWRITE(1, SO);
    RESC(alA); __syncthreads();
  }
  SBAR(); qkt(pB0, pB1, (bf16_t*)((char*)K_lds + SHM_K), qr, r32, hi);
  finishSM(pA0, pA1, alA, l_reg, pa0, pa1, pa2, pa3); SBAR();
  pv_d0(o, vb0, pa0, pa1, pa2, pa3); partialSM(pB0, pB1, m_reg, mnB, alB);
  __syncthreads(); RESC(alB);
  finishSM(pB0, pB1, alB, l_reg, pa0, pa1, pa2, pa3); SBAR();
  pv_d0(o, vb0 + (int)SHM_V, pa0, pa1, pa2, pa3);
  if (hi == 0) li_l[r32] = l_reg; asm volatile("s_waitcnt lgkmcnt(0)" ::: "memory");
  float rli[16];
#pragma unroll
  for (int r = 0; r < 16; ++r) rli[r] = __builtin_amdgcn_rcpf(li_l[crow(r, hi)]);
  bf16_t* Ow = Ob + (long)(wid * QBLK) * LDO;
#pragma unroll
  for (int r = 0; r < 16; ++r) { int orow = crow(r, hi);
    for (int d0 = 0; d0 < 4; ++d0) Ow[(long)orow * LDO + d0 * 32 + r32] = (bf16_t)(cvtpk(o[d0][r] * rli[r], 0.f) & 0xffffu); }
#undef SLOAD
#undef SWRITE
#undef SWAIT
#undef RESC
  __syncthreads();
}
#undef KSWZ
#undef SBAR
}

struct AddrLin { bf16_t* O; int ld; __device__ __forceinline__ bf16_t* operator()(const pg8::Unit& u, int rl, int tc) const { return O + (size_t)(u.pm * 256 + rl) * ld + u.pn * 256 + tc; } };
struct EpiRowScale {
    static constexpr bool PERM = true; bf16_t* O; int ld; const float* ssp; float cscale;
    __device__ __forceinline__ void operator()(f32x4 (&acc)[2][2][4][2], const pg8::Unit& u, const pg8::EpiCtx& c) const { const int e_lane = lane_id(), e_fr = e_lane & 15, e_fq = e_lane >> 4;
        const int hc = c.wc * 32 + e_fq * 8, rl0 = c.wr * 64 + e_fr;
#pragma unroll
        for (int ai = 0; ai < 2; ++ai)
#pragma unroll
            for (int m = 0; m < 4; ++m) { const int row = u.pm * 256 + ai * 128 + rl0 + m * 16; const f32x4 p0 = *(const f32x4*)(ssp + (size_t)row * 8), p1 = *(const f32x4*)(ssp + (size_t)row * 8 + 4);
                const float r = rsqrtf((((p0.x + p0.y) + (p0.z + p0.w)) + ((p1.x + p1.y) + (p1.z + p1.w))) * (1.0f / DM) + EPS) * cscale;
#pragma unroll
                for (int bj = 0; bj < 2; ++bj) { const f32x4 v0 = acc[ai][bj][m][0] * r, v1 = acc[ai][bj][m][1] * r;
                    st16((O + (size_t)row * ld + u.pn * 256 + bj * 128 + hc), (u32x4){cvtpk(v0.x, v0.y), cvtpk(v0.z, v0.w), cvtpk(v1.x, v1.y), cvtpk(v1.z, v1.w)}); } }
    }
};
struct EpiSoftmax {
    static constexpr bool PERM = true; bf16_t* P; int ld;
    __device__ __forceinline__ void operator()(f32x4 (&acc)[2][2][4][2], const pg8::Unit& u, const pg8::EpiCtx& c) const { const int e_lane = lane_id(), e_fr = e_lane & 15, e_fq = e_lane >> 4;
        const int hc = c.wc * 32 + e_fq * 8, rl0 = c.wr * 64 + e_fr;
        LAS float* pmx = (LAS float*)c.xl; LAS float* psm = pmx + 1024;
#pragma unroll
        for (int ai = 0; ai < 2; ++ai)
#pragma unroll
            for (int m = 0; m < 4; ++m) { float mx = -3.0e38f;
#pragma unroll
                for (int bj = 0; bj < 2; ++bj)
#pragma unroll
                    for (int n = 0; n < 2; ++n) { const f32x4 v = acc[ai][bj][m][n]; mx = fmaxf(fmaxf(mx, fmaxf(v.x, v.y)), fmaxf(v.z, v.w)); }
                mx = fmaxf(mx, __shfl_xor(mx, 16)); mx = fmaxf(mx, __shfl_xor(mx, 32));
                if (e_fq == 0) pmx[(ai * 128 + rl0 + m * 16) * 4 + c.wc] = mx; }
        WG_BAR();
#pragma unroll
        for (int ai = 0; ai < 2; ++ai)
#pragma unroll
            for (int m = 0; m < 4; ++m) { const int rl = ai * 128 + rl0 + m * 16; const f32x4 p4 = *(const LAS f32x4*)(pmx + rl * 4);
                const float mx = fmaxf(fmaxf(p4.x, p4.y), fmaxf(p4.z, p4.w)) * 1.4426950408889634f; float s = 0.f;
#pragma unroll
                for (int bj = 0; bj < 2; ++bj)
#pragma unroll
                    for (int n = 0; n < 2; ++n) { f32x4 v = acc[ai][bj][m][n];
                        v.x = __builtin_amdgcn_exp2f(fmaf(v.x, 1.4426950408889634f, -mx)); v.y = __builtin_amdgcn_exp2f(fmaf(v.y, 1.4426950408889634f, -mx));
                        v.z = __builtin_amdgcn_exp2f(fmaf(v.z, 1.4426950408889634f, -mx)); v.w = __builtin_amdgcn_exp2f(fmaf(v.w, 1.4426950408889634f, -mx));
                        s += (v.x + v.y) + (v.z + v.w); acc[ai][bj][m][n] = v; }
                s += __shfl_xor(s, 16); s += __shfl_xor(s, 32);
                if (e_fq == 0) psm[rl * 4 + c.wc] = s; }
        WG_BAR();
#pragma unroll
        for (int ai = 0; ai < 2; ++ai)
#pragma unroll
            for (int m = 0; m < 4; ++m) { const int rl = ai * 128 + rl0 + m * 16; const f32x4 p4 = *(const LAS f32x4*)(psm + rl * 4);
                const float inv = 1.0f / ((p4.x + p4.y) + (p4.z + p4.w));
#pragma unroll
                for (int bj = 0; bj < 2; ++bj) { const f32x4 v0 = acc[ai][bj][m][0] * inv, v1 = acc[ai][bj][m][1] * inv;
                    st16((P + (size_t)(u.pm * 256 + rl) * ld + u.pn * 256 + bj * 128 + hc), (u32x4){cvtpk(v0.x, v0.y), cvtpk(v0.z, v0.w), cvtpk(v1.x, v1.y), cvtpk(v1.z, v1.w)}); } }
        WG_BAR();
    }
};
struct MapXS { const char* Q; const char* K; __device__ __forceinline__ void operator()(pg8::Unit& u) const {
    u.a = Q + ((size_t)u.pm * 256 * DM + (size_t)u.pn * MHD) * 2; u.b = K + ((size_t)(u.pm >> 3) * MEML * DM + (size_t)u.pn * MHD) * 2; } };
struct MapXPV { const char* P; const char* VT; __device__ __forceinline__ void operator()(pg8::Unit& u) const {
    u.a = P + ((size_t)u.pm * 256 * 1024 + (size_t)(u.pn >> 1) * MEML) * 2; u.b = VT + ((size_t)u.pn * 256 * 1024 + (size_t)(u.pm >> 3) * MEML) * 2; } };

struct MapMoE { const char* A; const char* W; size_t as, es, ws_; __device__ __forceinline__ void operator()(pg8::Unit& u) const {
    u.a = A + (size_t)u.pm * as; u.b = W + (size_t)(u.pm >> 2) * es + (size_t)u.pn * ws_; } };
struct EpiSwiGLU {
    static constexpr bool PERM = true; bf16_t* ACT; const float* rs;
    __device__ __forceinline__ void operator()(f32x4 (&acc)[2][2][4][2], const pg8::Unit& u, const pg8::EpiCtx& c) const { const int e_lane = lane_id(), e_fr = e_lane & 15, e_fq = e_lane >> 4;
        const int hc = c.wc * 32 + e_fq * 8, rl0 = c.wr * 64 + e_fr;
#pragma unroll
        for (int ai = 0; ai < 2; ++ai)
#pragma unroll
            for (int m = 0; m < 4; ++m) { f32x4 o[2]; const float rf = rs[u.pm * 256 + ai * 128 + rl0 + m * 16];
#pragma unroll
                for (int n = 0; n < 2; ++n) { const f32x4 g = acc[ai][0][m][n] * rf, up = acc[ai][1][m][n] * rf; f32x4 r;
                    r.x = g.x * __builtin_amdgcn_rcpf(1.0f + __builtin_amdgcn_exp2f(-1.4426950408889634f * g.x)) * up.x; r.y = g.y * __builtin_amdgcn_rcpf(1.0f + __builtin_amdgcn_exp2f(-1.4426950408889634f * g.y)) * up.y;
                    r.z = g.z * __builtin_amdgcn_rcpf(1.0f + __builtin_amdgcn_exp2f(-1.4426950408889634f * g.z)) * up.z; r.w = g.w * __builtin_amdgcn_rcpf(1.0f + __builtin_amdgcn_exp2f(-1.4426950408889634f * g.w)) * up.w; o[n] = r; }
                st16((ACT + (size_t)(u.pm * 256 + ai * 128 + rl0 + m * 16) * EFF + u.pn * 128 + hc), (u32x4){cvtpk(o[0].x, o[0].y), cvtpk(o[0].z, o[0].w), cvtpk(o[1].x, o[1].y), cvtpk(o[1].z, o[1].w)}); }
    }
};
struct EpiRowGate {
    static constexpr bool PERM = true; bf16_t* Y; const float* gate;
    __device__ __forceinline__ void operator()(f32x4 (&acc)[2][2][4][2], const pg8::Unit& u, const pg8::EpiCtx& c) const { const int e_lane = lane_id(), e_fr = e_lane & 15, e_fq = e_lane >> 4;
        const int hc = c.wc * 32 + e_fq * 8, rl0 = c.wr * 64 + e_fr;
#pragma unroll
        for (int ai = 0; ai < 2; ++ai)
#pragma unroll
            for (int m = 0; m < 4; ++m) { const int row = u.pm * 256 + ai * 128 + rl0 + m * 16; const float gt = gate[row];
#pragma unroll
                for (int bj = 0; bj < 2; ++bj) { const f32x4 v0 = acc[ai][bj][m][0] * gt, v1 = acc[ai][bj][m][1] * gt;
                    st16((Y + (size_t)row * DM + u.pn * 256 + bj * 128 + hc), (u32x4){cvtpk(v0.x, v0.y), cvtpk(v0.z, v0.w), cvtpk(v1.x, v1.y), cvtpk(v1.z, v1.w)}); } }
    }
};
__device__ __forceinline__ float rms_row_to_bf16_r(const float* xrow, const float* __restrict__ gain, bf16_t* orow, int lane) {
    const GAS f32x4* xr = (const GAS f32x4*)xrow + lane; const f32x4* gr = (const f32x4*)gain + lane;
    f32x4 v[8]; float s = 0.f;
#pragma unroll
    for (int j = 0; j < 8; ++j) { v[j] = xr[64 * j]; s += (v[j].x * v[j].x + v[j].y * v[j].y) + (v[j].z * v[j].z + v[j].w * v[j].w); }
    const float r = rsqrtf(wave_sum(s) * (1.f / DM) + EPS);
    GAS u32x2* o8 = (GAS u32x2*)orow + lane;
#pragma unroll
    for (int j = 0; j < 8; ++j) { const f32x4 g = gr[64 * j]; u32x2 w; w.x = cvtpk(v[j].x * r * g.x, v[j].y * r * g.y); w.y = cvtpk(v[j].z * r * g.z, v[j].w * r * g.w); o8[64 * j] = w; }
    return r;
}
__device__ __forceinline__ void router_phase(const Frame& F, const bf16_t* x, const float* __restrict__ gain, const float* __restrict__ Wr, float* rrow, float* aff) {
    const int lane = lane_id(), tid = F.wave * 64 + lane;
    LAS f32x4* Wl = (LAS f32x4*)(F.lds + RING_OFF);
    for (int i = tid; i < DM * 4; i += 512) { const int kk = i >> 2, q = i & 3; Wl[q * DM + (kk & 3) * 512 + (kk >> 2)] = *(const f32x4*)(Wr + (size_t)kk * NE + 4 * q); }
    __syncthreads();
    const int gw = (int)blockIdx.x * NWAVES + F.wave, NGW = F.G * NWAVES;
    const f32x4* gr = (const f32x4*)gain + lane;
    for (int rb = gw * 2; rb < NTOK; rb += NGW * 2) {
        f32x4 v0[8], v1[8]; float s0 = 0.f, s1 = 0.f;
        const GAS u32x2* x0 = (const GAS u32x2*)(x + (size_t)rb * DM) + lane; const GAS u32x2* x1 = x0 + DM / 4;
#pragma unroll
        for (int j = 0; j < 8; ++j) { const u32x2 p = x0[64 * j], q = x1[64 * j];
            v0[j] = (f32x4){__uint_as_float(p.x << 16), __uint_as_float(p.x & 0xffff0000u), __uint_as_float(p.y << 16), __uint_as_float(p.y & 0xffff0000u)};
            v1[j] = (f32x4){__uint_as_float(q.x << 16), __uint_as_float(q.x & 0xffff0000u), __uint_as_float(q.y << 16), __uint_as_float(q.y & 0xffff0000u)}; }
#pragma unroll
        for (int j = 0; j < 8; ++j) { s0 += (v0[j].x * v0[j].x + v0[j].y * v0[j].y) + (v0[j].z * v0[j].z + v0[j].w * v0[j].w); s1 += (v1[j].x * v1[j].x + v1[j].y * v1[j].y) + (v1[j].z * v1[j].z + v1[j].w * v1[j].w); }
        const float r0 = rsqrtf(wave_sum(s0) * (1.f / DM) + EPS), r1 = rsqrtf(wave_sum(s1) * (1.f / DM) + EPS);
        if (lane == 0) { rrow[rb] = r0; rrow[rb + 1] = r1; }
        float a[32];
#pragma unroll
        for (int i = 0; i < 32; ++i) a[i] = 0.f;
#pragma unroll
        for (int j = 0; j < 8; ++j) { const f32x4 g = gr[64 * j];
            v0[j] = (f32x4){v0[j].x * r0 * g.x, v0[j].y * r0 * g.y, v0[j].z * r0 * g.z, v0[j].w * r0 * g.w}; v1[j] = (f32x4){v1[j].x * r1 * g.x, v1[j].y * r1 * g.y, v1[j].z * r1 * g.z, v1[j].w * r1 * g.w};
            const float h0[4] = {v0[j].x, v0[j].y, v0[j].z, v0[j].w}, h1[4] = {v1[j].x, v1[j].y, v1[j].z, v1[j].w};
#pragma unroll
            for (int c = 0; c < 4; ++c)
#pragma unroll
                for (int q = 0; q < 4; ++q) { const f32x4 w = Wl[q * DM + c * 512 + lane + 64 * j];
                    a[4 * q + 0] += h0[c] * w.x; a[4 * q + 1] += h0[c] * w.y; a[4 * q + 2] += h0[c] * w.z; a[4 * q + 3] += h0[c] * w.w;
                    a[16 + 4 * q + 0] += h1[c] * w.x; a[16 + 4 * q + 1] += h1[c] * w.y; a[16 + 4 * q + 2] += h1[c] * w.z; a[16 + 4 * q + 3] += h1[c] * w.w; } }
#define RS_STEP(N, MASK) { const bool up_ = (lane & MASK) != 0; _Pragma("unroll") for (int i = 0; i < N; ++i) { const float keep = up_ ? a[i + N] : a[i], send = up_ ? a[i] : a[i + N]; a[i] = keep + __shfl_xor(send, MASK); } }
        RS_STEP(16, 32) RS_STEP(8, 16) RS_STEP(4, 8) RS_STEP(2, 4) RS_STEP(1, 2)
#undef RS_STEP
        const float lg = a[0] + __shfl_xor(a[0], 1); float mx = lg;
        mx = fmaxf(mx, __shfl_xor(mx, 16)); mx = fmaxf(mx, __shfl_xor(mx, 8)); mx = fmaxf(mx, __shfl_xor(mx, 4)); mx = fmaxf(mx, __shfl_xor(mx, 2));
        const float ex = expf(lg - mx); float sm = ex;
        sm += __shfl_xor(sm, 16); sm += __shfl_xor(sm, 8); sm += __shfl_xor(sm, 4); sm += __shfl_xor(sm, 2);
        const int el = lane >> 1, row = rb + (el >> 4), e = el & 15, b = row / SEQ, t = row % SEQ;
        if ((lane & 1) == 0) aff[((size_t)b * NE + e) * SEQ + t] = ex / sm;
    }
    __syncthreads();
}
__device__ __forceinline__ void rank_phase(const Frame& F, const float* aff, int* rank, float* gate, const float* rrow, float* rs, int* gidx) {
    const int lane = lane_id(), tid = F.wave * 64 + lane;
    LAS unsigned* wc = (LAS unsigned*)(F.lds + RING_OFF);
    LAS unsigned* ck = (LAS unsigned*)(F.lds + RING_OFF + 256);
    LAS unsigned* ci = ck + SEQ + 4;
    LAS unsigned* ncp = ci + SEQ + 4;
    for (int be = (int)blockIdx.x; be < NB * NE; be += F.G) {
        const int b = be >> 4, e = be & 15;
        unsigned k[4];
#pragma unroll
        for (int j = 0; j < 4; ++j) k[j] = __float_as_uint(aff[(size_t)be * SEQ + tid + 512 * j]);
        unsigned lo = 0u, hi = 0x3F800001u;
        if (tid == 0) ncp[0] = 0u;
        for (int it = 0; it < 40; ++it) {
            const unsigned mid = lo + ((hi - lo) >> 1); if (mid == lo) break;
            const int ws_ = __popcll(__ballot(k[0] >= mid)) + __popcll(__ballot(k[1] >= mid)) + __popcll(__ballot(k[2] >= mid)) + __popcll(__ballot(k[3] >= mid));
            if (lane == 0) wc[(it & 1) * 8 + F.wave] = (unsigned)ws_;
            __syncthreads();
            const u32x4 c0 = *(const LAS u32x4*)(wc + (it & 1) * 8), c1 = *(const LAS u32x4*)(wc + (it & 1) * 8 + 4);
            const int c = (int)(((c0.x + c0.y) + (c0.z + c0.w)) + ((c1.x + c1.y) + (c1.z + c1.w)));
            if (c < CAP) hi = mid; else { lo = mid; if (c <= 448) break; }
        }
        const unsigned T = lo;
        __syncthreads();
#pragma unroll
        for (int j = 0; j < 4; ++j) { const bool pred = k[j] >= T; const unsigned long long bal = __ballot(pred);
            const int wcount = __popcll(bal), pre = __popcll(bal & ((1ull << lane) - 1ull));
            unsigned base = 0u; if (lane == 0 && wcount) base = __hip_atomic_fetch_add(ncp, (unsigned)wcount, __ATOMIC_RELAXED, __HIP_MEMORY_SCOPE_WORKGROUP);
            base = (unsigned)__builtin_amdgcn_readfirstlane((int)base);
            if (pred) { ck[base + pre] = k[j]; ci[base + pre] = (unsigned)(tid + 512 * j); } else rank[(size_t)be * SEQ + tid + 512 * j] = CAP; }
        __syncthreads();
        const int nc = (int)ncp[0];
        if (tid < 4) { ck[nc + tid] = 0u; ci[nc + tid] = 0x7fffffffu; }
        __syncthreads();
        const int nc4 = (nc + 3) >> 2;
        for (int i = tid; i < nc; i += 512) { const unsigned kk = ck[i]; const int tt = (int)ci[i]; int cnt = 0;
#pragma unroll 4
            for (int m = 0; m < nc4; ++m) { const u32x4 km = ((const LAS u32x4*)ck)[m]; const u32x4 tm = ((const LAS u32x4*)ci)[m];
                cnt += ((km.x > kk || (km.x == kk && (int)tm.x < tt)) ? 1 : 0) + ((km.y > kk || (km.y == kk && (int)tm.y < tt)) ? 1 : 0)
                     + ((km.z > kk || (km.z == kk && (int)tm.z < tt)) ? 1 : 0) + ((km.w > kk || (km.w == kk && (int)tm.w < tt)) ? 1 : 0); }
            const int r = cnt < CAP ? cnt : CAP; rank[(size_t)be * SEQ + tt] = r;
            if (r < CAP) { const int sl = (e * 4 + b) * CAP + r; gate[sl] = __uint_as_float(kk); gidx[sl] = b * SEQ + tt; rs[sl] = rrow[b * SEQ + tt]; } }
        __syncthreads();
    }
}
__device__ __forceinline__ void combine_phase(const Frame& F, const bf16_t* xin, bf16_t* xo, float* fout, const bf16_t* Y, const int* rank, const float* __restrict__ gain, bf16_t* HNo, bool final_) {
    const int lane = lane_id();
    const int gw = (int)blockIdx.x * NWAVES + F.wave, NGW = F.G * NWAVES;
    for (int row = gw; row < NTOK; row += NGW) {
        const int b = row / SEQ, t = row % SEQ;
        int rk = CAP; if (lane < NE) rk = rank[((size_t)b * NE + lane) * SEQ + t];
        const GAS u32x2* xi = (const GAS u32x2*)(xin + (size_t)row * DM) + lane; f32x4 v[8];
#pragma unroll
        for (int j = 0; j < 8; ++j) { const u32x2 p = xi[64 * j]; v[j] = (f32x4){__uint_as_float(p.x << 16), __uint_as_float(p.x & 0xffff0000u), __uint_as_float(p.y << 16), __uint_as_float(p.y & 0xffff0000u)}; }
#pragma unroll
        for (int e = 0; e < NE; ++e) { const int r = __builtin_amdgcn_readlane(rk, e);
            if (r < CAP) { const u32x2* yr = (const u32x2*)(Y + ((size_t)(e * 4 + b) * CAP + r) * DM) + lane;
#pragma unroll
                for (int j = 0; j < 8; ++j) { const u32x2 w = yr[64 * j]; v[j].x += __uint_as_float(w.x << 16); v[j].y += __uint_as_float(w.x & 0xffff0000u); v[j].z += __uint_as_float(w.y << 16); v[j].w += __uint_as_float(w.y & 0xffff0000u); } } }
        float s = 0.f;
#pragma unroll
        for (int j = 0; j < 8; ++j) s += (v[j].x * v[j].x + v[j].y * v[j].y) + (v[j].z * v[j].z + v[j].w * v[j].w);
        const float r = rsqrtf(wave_sum(s) * (1.f / DM) + EPS); const f32x4* gr = (const f32x4*)gain + lane;
        if (final_) { GAS f32x4* fo = (GAS f32x4*)(fout + (size_t)row * DM) + lane;
#pragma unroll
            for (int j = 0; j < 8; ++j) { const f32x4 g = gr[64 * j]; fo[64 * j] = (f32x4){v[j].x * r * g.x, v[j].y * r * g.y, v[j].z * r * g.z, v[j].w * r * g.w}; }
        } else { GAS u32x2* o8 = (GAS u32x2*)(HNo + (size_t)row * DM) + lane; GAS u32x2* x8 = (GAS u32x2*)(xo + (size_t)row * DM) + lane;
#pragma unroll
            for (int j = 0; j < 8; ++j) { const f32x4 g = gr[64 * j]; x8[64 * j] = (u32x2){cvtpk(v[j].x, v[j].y), cvtpk(v[j].z, v[j].w)}; o8[64 * j] = (u32x2){cvtpk(v[j].x * r * g.x, v[j].y * r * g.y), cvtpk(v[j].z * r * g.z, v[j].w * r * g.w)}; } }
    }
}
struct MapPool { const char* A; const char* W; __device__ __forceinline__ void operator()(pg8::Unit& u) const {
    u.a = A + ((size_t)u.pm * 256 * DM + (size_t)(u.pn >> 1) * 512) * 2; u.b = W + ((size_t)(u.pn & 1) * 256 * DM + (size_t)(u.pn >> 1) * 512) * 2; } };
template <int W> __device__ __forceinline__ void pool_item(const bf16_t* H, bf16_t* P, int row, int c8) {
    const int t = row & (SEQ - 1); const bf16_t* base = H + (size_t)(row - t) * DM + c8 * 8;
    u32x4 v[W];
#pragma unroll
    for (int i = 0; i < W; ++i) { int j = t - W / 2 + i; j = j < 0 ? 0 : (j > SEQ - 1 ? SEQ - 1 : j); v[i] = *(const u32x4*)(base + (size_t)j * DM); }
    float s[8] = {0.f, 0.f, 0.f, 0.f, 0.f, 0.f, 0.f, 0.f};
#pragma unroll
    for (int i = 0; i < W; ++i) { const int j = t - W / 2 + i; const float m = (j >= 0 && j < SEQ) ? 1.f : 0.f;
        s[0] += m * __uint_as_float(v[i].x << 16); s[1] += m * __uint_as_float(v[i].x & 0xffff0000u); s[2] += m * __uint_as_float(v[i].y << 16); s[3] += m * __uint_as_float(v[i].y & 0xffff0000u);
        s[4] += m * __uint_as_float(v[i].z << 16); s[5] += m * __uint_as_float(v[i].z & 0xffff0000u); s[6] += m * __uint_as_float(v[i].w << 16); s[7] += m * __uint_as_float(v[i].w & 0xffff0000u); }
    int lo = t - W / 2, hi = t + W / 2; if (lo < 0) lo = 0; if (hi > SEQ) hi = SEQ;
    const float inv = 1.0f / (float)(hi - lo); const u32x4 sv = v[W / 2];
    const float e0 = __uint_as_float(sv.x << 16), e1 = __uint_as_float(sv.x & 0xffff0000u), e2 = __uint_as_float(sv.y << 16), e3 = __uint_as_float(sv.y & 0xffff0000u);
    const float e4 = __uint_as_float(sv.z << 16), e5 = __uint_as_float(sv.z & 0xffff0000u), e6 = __uint_as_float(sv.w << 16), e7 = __uint_as_float(sv.w & 0xffff0000u);
    *(u32x4*)(P + (size_t)row * DM + c8 * 8) = (u32x4){cvtpk(s[0] * inv - e0, s[1] * inv - e1), cvtpk(s[2] * inv - e2, s[3] * inv - e3), cvtpk(s[4] * inv - e4, s[5] * inv - e5), cvtpk(s[6] * inv - e6, s[7] * inv - e7)};
}
__device__ __forceinline__ void pool_phase(const Frame& F, const bf16_t* H, bf16_t* P) {
    const int lane = lane_id(); const int gwv = (int)blockIdx.x * NWAVES + F.wave, NWV = F.G * NWAVES;
    for (int wi = gwv; wi < NTOK * 4; wi += NWV) {
        const int row = wi >> 2, g = wi & 3, c8 = g * 64 + lane;
        if (g == 0) pool_item<2>(H, P, row, c8); else if (g == 1) pool_item<4>(H, P, row, c8); else if (g == 2) pool_item<8>(H, P, row, c8); else pool_item<16>(H, P, row, c8);
    }
}

constexpr int N_PHASES = 24;
#ifndef MK_N_LAUNCHES
#define MK_N_LAUNCHES 1
#endif
#ifndef REP_MASK
#define REP_MASK 0
#endif
__global__ void __launch_bounds__(NWAVES * 64, 2) skel_fwd(Args args) {
    extern __shared__ __attribute__((aligned(16))) unsigned char lds_raw[];
    Frame F;
    F.lds = (LAS unsigned char*)lds_raw; F.MISC = (volatile LAS unsigned*)(F.lds + MISC_OFF);
    F.wave = __builtin_amdgcn_readfirstlane(threadIdx.x >> 6);
    F.G = gridDim.x; { const int bx = blockIdx.x; F.vcu = (F.G % 8 == 0) ? (bx % 8) * (F.G / 8) + bx / 8 : bx; }
    F.ws = nullptr; F.ctl = (gu32*)(uptr(args.ws) + WS_CTL);
    for (int u = threadIdx.x; u < (LDS_BYTES - LDSCTL_OFF) / 4; u += NWAVES * 64) ((LAS unsigned*)(F.lds + LDSCTL_OFF))[u] = 0u;
    __syncthreads();
    const bool multi = (MK_N_LAUNCHES == 1) || (args.ph_hi - args.ph_lo) > 1 || REP_MASK != 0;
    XcdBarrier bar; bar.bar = (unsigned*)(F.ctl + CW_BAR); bar.x = 0; bar.st = nullptr; bar.wave = F.wave;
    if (multi) bar = xcd_barrier_post((unsigned*)(F.ctl + CW_BAR), F.MISC + 8, F.wave);
    const int lo = args.ph_lo, hi = args.ph_hi;
#ifdef REP_RT
    const unsigned rep_mask_ = (unsigned)__builtin_amdgcn_readfirstlane(args.pad);
#endif
#define IN(k) ((MK_N_LAUNCHES == 1) ? ((k) < N_PHASES) : (lo <= (k) && (k) < hi))
#ifdef REP_RT
#define REPBIT(k) ((int)((rep_mask_ >> (k)) & 1u))
#else
#define REPBIT(k) ((int)((((unsigned)REP_MASK) >> (k)) & 1u))
#endif
#define PHASE(k) _Pragma("unroll") for (int rep_ = 0; rep_ < 1 + REPBIT(k); ++rep_)
#define SEAM(k) do { if ((IN(k) && IN((k) + 1)) || rep_ + 1 < 1 + REPBIT(k)) xcd_barrier(bar); } while (0)
    LAS unsigned char* ring = F.lds + RING_OFF; LAS unsigned char* xl = F.lds + XL_OFF;
    const int bx = (int)blockIdx.x, G = F.G;

#define KV_PROJ(l, rotK, rotV) do {   \
            { MapLin mp{(const char*)(ws + WS_MEMNB + (size_t)(l) * NB * MEML * DM * 2), (const char*)(ws + WS_WCK_T + (size_t)(l) * DM * DM * 2), (size_t)256 * DM * 2, (size_t)256 * DM * 2}; \
              pg8::Sched<MapLin> S; S.init(NB * MEML / 256, DM / 256, G, (bx + G - ((rotK) % G)) % G, mp); \
              EpiStore<AddrLin> E{AddrLin{(bf16_t*)(ws + WS_KCB + (size_t)(l) * NB * MEML * DM * 2), DM}}; \
              pg8::gemm_phase<EpiStore<AddrLin>, pg8::Sched<MapLin>, true>(F.wave, ring, xl, DM, DM * 2, DM * 2, S, E); } \
            { MapLin mp{(const char*)(ws + WS_WCV_T + (size_t)(l) * DM * DM * 2), (const char*)(ws + WS_MEMNB + (size_t)(l) * NB * MEML * DM * 2), (size_t)256 * DM * 2, (size_t)256 * DM * 2}; \
              pg8::Sched<MapLin> S; S.init(DM / 256, NB * MEML / 256, G, (bx + G - ((rotV) % G)) % G, mp); \
              EpiStore<AddrLin> E{AddrLin{(bf16_t*)(ws + WS_VTB + (size_t)(l) * NB * MEML * DM * 2), NB * MEML}}; \
              pg8::gemm_phase<EpiStore<AddrLin>, pg8::Sched<MapLin>, true>(F.wave, ring, xl, DM, DM * 2, DM * 2, S, E); } } while (0)
#ifdef EXTRA_BARS
    for (int eb = 0; eb < EXTRA_BARS; ++eb) xcd_barrier(bar);
#endif
    if (IN(0)) PHASE(0) { const karg_t ka = kargs(); unsigned char* const ws = uptr(KWS(ka)); p0_prologue(F, ka, ws); SEAM(0); }
    if (IN(1)) PHASE(1) { const karg_t ka = kargs(); unsigned char* const ws = uptr(KWS(ka));
        {
            MapLin mp{(const char*)(ws + WS_HN), (const char*)(ws + WS_WIN_T), (size_t)256 * DM * 2, (size_t)256 * DM * 2};
            pg8::Sched<MapLin> S; S.init(NTOK / 256, 2560 / 256, G, bx, mp);
            EpiQKV E{(bf16_t*)(ws + WS_QB), (bf16_t*)(ws + WS_KB), (bf16_t*)(ws + WS_VB), KIN(ka, 4), KIN(ka, 5), (const float*)(ws + WS_ROPE), (const float*)(ws + WS_ROPE) + SEQ * 64};
            pg8::gemm_phase<EpiQKV, pg8::Sched<MapLin>, true>(F.wave, ring, xl, DM, DM * 2, DM * 2, S, E); }
        {
            MapLin mp{(const char*)(ws + WS_WF_T), (const char*)(ws + WS_HN), (size_t)256 * DM * 2, (size_t)256 * DM * 2};
            pg8::Sched<MapLin> S; S.init(1024 / 256, NTOK / 256, G, (bx + G - (320 % G)) % G, mp);
            EpiStore<AddrF1> E{AddrF1{(bf16_t*)(ws + WS_FPQ)}};
            pg8::gemm_phase<EpiStore<AddrF1>, pg8::Sched<MapLin>, true>(F.wave, ring, xl, DM, DM * 2, DM * 2, S, E); }
        KV_PROJ(0, 448, 480);
        SEAM(1);
    }
    if (IN(2)) PHASE(2) { const karg_t ka = kargs(); unsigned char* const ws = uptr(KWS(ka));
        const int nF2 = (G > 64) ? 64 : 0;
        if (bx < nF2 || nF2 == 0) {
            MapLin mp{(const char*)(ws + WS_DFT), (const char*)(ws + WS_FPQ), (size_t)256 * 4096 * 2, (size_t)256 * 4096 * 2};
            pg8::Sched<MapLin> S; S.init(8, 8, nF2 ? nF2 : G, bx, mp);
            EpiStore<AddrF2> E{AddrF2{(bf16_t*)(ws + WS_MIXB)}};
            pg8::gemm_phase<EpiStore<AddrF2>, pg8::Sched<MapLin>, true>(F.wave, ring, xl, 4096, 4096 * 2, 4096 * 2, S, E);
        }
        if (bx < nF2) { __syncthreads(); tr_span(F, ka, ws, 1, 7680 + bx * 8 + F.wave, 512, 9); __syncthreads(); }
        if (bx >= nF2) {
            const int a = bx - nF2, cnt = G - nF2, per = (384 + cnt - 1) / cnt, slot = a % 3; int ui = 0;
            for (int uid = a * per; uid < (a + 1) * per && uid < 384; ++uid, ++ui) {
                if (ui == slot) { __syncthreads(); tr_span(F, ka, ws, 1, a * 8 + F.wave, 1536, 5); __syncthreads(); }
                const int qb = uid & 7, hq = (uid >> 3) % NQH, b = uid / (8 * NQH), kvh = hq / 3;
                const bf16_t* Qb = (const bf16_t*)(ws + WS_QB) + ((size_t)b * SEQ + qb * 256) * AW + hq * HD;
                const bf16_t* Kh = (const bf16_t*)(ws + WS_KB) + (size_t)b * SEQ * KVW + kvh * HD;
                const bf16_t* Vh = (const bf16_t*)(ws + WS_VB) + (size_t)b * SEQ * KVW + kvh * HD;
                bf16_t* Ob = (bf16_t*)(ws + WS_MIXB) + ((size_t)b * SEQ + qb * 256) * DM + hq * HD;
                attn::attn_dense_body(Qb, Kh, Vh, Ob, SEQ, (char*)lds_raw + RING_OFF, F.wave);
            }
            if (slot >= ui) { __syncthreads(); tr_span(F, ka, ws, 1, a * 8 + F.wave, 1536, 5); __syncthreads(); }
        }
        SEAM(2);
    }
    if (IN(3)) PHASE(3) { const karg_t ka = kargs(); unsigned char* const ws = uptr(KWS(ka));
        MapLin mp{(const char*)(ws + WS_MIXB), (const char*)(ws + WS_WOUT_T), (size_t)256 * DM * 2, (size_t)256 * DM * 2};
        pg8::Sched<MapLin> S; S.init(NTOK / 256, DM / 256, G, bx, mp);
        EpiResB<true> E{KIN(ka, 0), (bf16_t*)(ws + WS_XB), (float*)(ws + WS_SSP), nullptr};
        pg8::gemm_phase<EpiResB<true>, pg8::Sched<MapLin>, true>(F.wave, ring, xl, DM, DM * 2, DM * 2, S, E);
        SEAM(3);
    }
    {
        constexpr int l = 0; constexpr int pb = l ? 15 : 4;
        if (l == 1) {
            if (IN(13)) PHASE(13) { const karg_t ka = kargs(); unsigned char* const ws = uptr(KWS(ka));
                pool_phase(F, (const bf16_t*)(ws + WS_HN), (bf16_t*)(ws + WS_QCB));
#ifdef PROBE_CONV
                tr_span<TRV>(F, ka, ws, 1, bx * 8 + F.wave, 2048, 6);
#endif
                SEAM(13);
            }
            if (IN(14)) PHASE(14) { const karg_t ka = kargs(); unsigned char* const ws = uptr(KWS(ka));
                MapPool mp{(const char*)(ws + WS_QCB), (const char*)(ws + WS_WP_T)};
                pg8::Sched<MapPool> S; S.init(NTOK / 256, DM / 256, G, bx, mp);
                EpiResB<false> E{(const bf16_t*)(ws + WS_XB), (bf16_t*)(ws + WS_XALT), (float*)(ws + WS_SSP), KIN(ka, 9)};
                pg8::gemm_phase<EpiResB<false>, pg8::Sched<MapPool>, true>(F.wave, ring, xl, 512, DM * 2, DM * 2, S, E);
                SEAM(14);
            }
        }
        if (IN(pb + 0)) PHASE(pb + 0) { const karg_t ka = kargs(); unsigned char* const ws = uptr(KWS(ka));
            MapLin mp{(const char*)(ws + (l == 0 ? WS_XB : WS_XALT)), (const char*)(ws + WS_WCQ_T + (size_t)l * DM * DM * 2), (size_t)256 * DM * 2, (size_t)256 * DM * 2};
            pg8::Sched<MapLin> S; S.init(NTOK / 256, DM / 256, G, bx, mp);
            EpiRowScale E{(bf16_t*)(ws + WS_QCB), DM, (const float*)(ws + WS_SSP), 0.04419417382415922f};
            pg8::gemm_phase<EpiRowScale, pg8::Sched<MapLin>, true>(F.wave, ring, xl, DM, DM * 2, DM * 2, S, E);
            SEAM(pb + 0);
        }
        if (IN(pb + 1)) PHASE(pb + 1) { const karg_t ka = kargs(); unsigned char* const ws = uptr(KWS(ka));
            MapXS mp{(const char*)(ws + WS_QCB), (const char*)(ws + WS_KCB + (size_t)l * NB * MEML * DM * 2)};
            pg8::Sched<MapXS> S; S.init(NTOK / 256, NMH, G, bx, mp);
            EpiSoftmax E{(bf16_t*)(ws + WS_PB), NMH * MEML};
            pg8::gemm_phase<EpiSoftmax, pg8::Sched<MapXS>, true>(F.wave, ring, xl, MHD, DM * 2, DM * 2, S, E);
            if (l == 0) { KV_PROJ(1, 128, 160);
                if (bx < 128) { __syncthreads(); tr_span(F, ka, ws, 2, bx * 8 + F.wave, 1024, 2); }
                else if (bx >= 192) { tr_span(F, ka, ws, 2, 2048 + (bx - 192) * 8 + F.wave, 512, 4); } }
            SEAM(pb + 1);
        }
        if (IN(pb + 2)) PHASE(pb + 2) { const karg_t ka = kargs(); unsigned char* const ws = uptr(KWS(ka));
            MapXPV mp{(const char*)(ws + WS_PB), (const char*)(ws + WS_VTB + (size_t)l * NB * MEML * DM * 2)};
            pg8::Sched<MapXPV> S; S.init(NTOK / 256, DM / 256, G, bx, mp);
            EpiStore<AddrLin> E{AddrLin{(bf16_t*)(ws + WS_MIXB), DM}};
            pg8::gemm_phase<EpiStore<AddrLin>, pg8::Sched<MapXPV>, true>(F.wave, ring, xl, MEML, NMH * MEML * 2, NB * MEML * 2, S, E);
            SEAM(pb + 2);
        }
        if (IN(pb + 3)) PHASE(pb + 3) { const karg_t ka = kargs(); unsigned char* const ws = uptr(KWS(ka));
            MapLin mp{(const char*)(ws + WS_MIXB), (const char*)(ws + WS_WCO_T + (size_t)l * DM * DM * 2), (size_t)256 * DM * 2, (size_t)256 * DM * 2};
            pg8::Sched<MapLin> S; S.init(NTOK / 256, DM / 256, G, bx, mp);
            EpiResB<false> E{(const bf16_t*)(ws + (l == 0 ? WS_XB : WS_XALT)), (bf16_t*)(ws + (l == 0 ? WS_XALT : WS_XB)), nullptr, nullptr};
            pg8::gemm_phase<EpiResB<false>, pg8::Sched<MapLin>, true>(F.wave, ring, xl, DM, DM * 2, DM * 2, S, E);
            SEAM(pb + 3);
        }
        if (IN(pb + 4)) PHASE(pb + 4) { const karg_t ka = kargs(); unsigned char* const ws = uptr(KWS(ka));
            router_phase(F, (const bf16_t*)(ws + (l == 0 ? WS_XALT : WS_XB)), KIN(ka, 16) + l * DM, KIN(ka, 17) + (size_t)l * DM * NE, (float*)(ws + WS_SSP + 512 * 1024), (float*)(ws + WS_AFF));
            SEAM(pb + 4);
        }
        if (IN(pb + 5)) PHASE(pb + 5) { const karg_t ka = kargs(); unsigned char* const ws = uptr(KWS(ka));
            rank_phase(F, (const float*)(ws + WS_AFF), (int*)(ws + WS_RANK), (float*)(ws + WS_GATE), (const float*)(ws + WS_SSP + 512 * 1024), (float*)(ws + WS_SSP + 768 * 1024), (int*)(ws + WS_GATE + 512 * 1024));
            SEAM(pb + 5);
        }
        if (IN(pb + 6)) PHASE(pb + 6) { const karg_t ka = kargs(); unsigned char* const ws = uptr(KWS(ka));
            MapMoE mp{(const char*)(ws + (l == 0 ? WS_XALT : WS_XB)), (const char*)(ws + (l ? WS_WGU_T2 : WS_WGU_T)), (size_t)0, (size_t)2048 * DM * 2, (size_t)256 * DM * 2};
            pg8::Sched<MapMoE> S; S.init(NB * NE, 8, G, bx, mp);
            EpiSwiGLU E{(bf16_t*)(ws + WS_ACTB), (const float*)(ws + WS_SSP + 768 * 1024)};
            const bool cfirst = ((bx >> 3) & 1) != 0;
            if (l == 0 && cfirst) { tr_span(F, ka, ws, 2, 4096 + bx * 8 + F.wave, 2048, 2); __syncthreads(); }
            pg8::gemm_phase<EpiSwiGLU, pg8::Sched<MapMoE>, true, true>(F.wave, ring, xl, DM, DM * 2, DM * 2, S, E, (const int*)(ws + WS_GATE + 512 * 1024));
            if (l == 0 && !cfirst) { __syncthreads(); tr_span(F, ka, ws, 2, 4096 + bx * 8 + F.wave, 2048, 2); }
            SEAM(pb + 6);
        }
        if (IN(pb + 7)) PHASE(pb + 7) { const karg_t ka = kargs(); unsigned char* const ws = uptr(KWS(ka));
            MapMoE mp{(const char*)(ws + WS_ACTB), (const char*)(ws + (l ? WS_WD_T2 : WS_WD_T)), (size_t)256 * EFF * 2, (size_t)2048 * EFF * 2, (size_t)256 * EFF * 2};
            pg8::Sched<MapMoE> S; S.init(NB * NE, 8, G, bx, mp);
            EpiRowGate E{(bf16_t*)(ws + WS_YB), (const float*)(ws + WS_GATE)};
            const bool cfirst = ((bx >> 3) & 1) == 0;
            if (l == 0 && cfirst) { tr_span(F, ka, ws, 2, 8192 + bx * 8 + F.wave, 2048, 2); __syncthreads(); }
            pg8::gemm_phase<EpiRowGate, pg8::Sched<MapMoE>, true>(F.wave, ring, xl, EFF, EFF * 2, EFF * 2, S, E);
            if (l == 0 && !cfirst) { __syncthreads(); tr_span(F, ka, ws, 2, 8192 + bx * 8 + F.wave, 2048, 2); }
            SEAM(pb + 7);
        }
        if (IN(pb + 8)) PHASE(pb + 8) { const karg_t ka = kargs(); unsigned char* const ws = uptr(KWS(ka));
            combine_phase(F, (const bf16_t*)(ws + (l == 0 ? WS_XALT : WS_XB)), (bf16_t*)(ws + WS_XB), KOUT(ka), (const bf16_t*)(ws + WS_YB), (const int*)(ws + WS_RANK), l == 0 ? KIN(ka, 2) + DM : KIN(ka, 21), (bf16_t*)(ws + WS_HN), l == 1);
            SEAM(pb + 8);
        }
    }
    {
        constexpr int l = 1; constexpr int pb = l ? 15 : 4;
        if (l == 1) {
            if (IN(13)) PHASE(13) { const karg_t ka = kargs(); unsigned char* const ws = uptr(KWS(ka));
                pool_phase(F, (const bf16_t*)(ws + WS_HN), (bf16_t*)(ws + WS_QCB));
#ifdef PROBE_CONV
                tr_span<TRV>(F, ka, ws, 1, bx * 8 + F.wave, 2048, 6);
#endif
                SEAM(13);
            }
            if (IN(14)) PHASE(14) { const karg_t ka = kargs(); unsigned char* const ws = uptr(KWS(ka));
                MapPool mp{(const char*)(ws + WS_QCB), (const char*)(ws + WS_WP_T)};
                pg8::Sched<MapPool> S; S.init(NTOK / 256, DM / 256, G, bx, mp);
                EpiResB<false> E{(const bf16_t*)(ws + WS_XB), (bf16_t*)(ws + WS_XALT), (float*)(ws + WS_SSP), KIN(ka, 9)};
                pg8::gemm_phase<EpiResB<false>, pg8::Sched<MapPool>, true>(F.wave, ring, xl, 512, DM * 2, DM * 2, S, E);
                SEAM(14);
            }
        }
        if (IN(pb + 0)) PHASE(pb + 0) { const karg_t ka = kargs(); unsigned char* const ws = uptr(KWS(ka));
            MapLin mp{(const char*)(ws + (l == 0 ? WS_XB : WS_XALT)), (const char*)(ws + WS_WCQ_T + (size_t)l * DM * DM * 2), (size_t)256 * DM * 2, (size_t)256 * DM * 2};
            pg8::Sched<MapLin> S; S.init(NTOK / 256, DM / 256, G, bx, mp);
            EpiRowScale E{(bf16_t*)(ws + WS_QCB), DM, (const float*)(ws + WS_SSP), 0.04419417382415922f};
            pg8::gemm_phase<EpiRowScale, pg8::Sched<MapLin>, true>(F.wave, ring, xl, DM, DM * 2, DM * 2, S, E);
            SEAM(pb + 0);
        }
        if (IN(pb + 1)) PHASE(pb + 1) { const karg_t ka = kargs(); unsigned char* const ws = uptr(KWS(ka));
            MapXS mp{(const char*)(ws + WS_QCB), (const char*)(ws + WS_KCB + (size_t)l * NB * MEML * DM * 2)};
            pg8::Sched<MapXS> S; S.init(NTOK / 256, NMH, G, bx, mp);
            EpiSoftmax E{(bf16_t*)(ws + WS_PB), NMH * MEML};
            pg8::gemm_phase<EpiSoftmax, pg8::Sched<MapXS>, true>(F.wave, ring, xl, MHD, DM * 2, DM * 2, S, E);
            if (l == 0) { KV_PROJ(1, 128, 160);
                if (bx < 128) { __syncthreads(); tr_span(F, ka, ws, 2, bx * 8 + F.wave, 1024, 2); }
                else if (bx >= 192) { tr_span(F, ka, ws, 2, 2048 + (bx - 192) * 8 + F.wave, 512, 4); } }
            SEAM(pb + 1);
        }
        if (IN(pb + 2)) PHASE(pb + 2) { const karg_t ka = kargs(); unsigned char* const ws = uptr(KWS(ka));
            MapXPV mp{(const char*)(ws + WS_PB), (const char*)(ws + WS_VTB + (size_t)l * NB * MEML * DM * 2)};
            pg8::Sched<MapXPV> S; S.init(NTOK / 256, DM / 256, G, bx, mp);
            EpiStore<AddrLin> E{AddrLin{(bf16_t*)(ws + WS_MIXB), DM}};
            pg8::gemm_phase<EpiStore<AddrLin>, pg8::Sched<MapXPV>, true>(F.wave, ring, xl, MEML, NMH * MEML * 2, NB * MEML * 2, S, E);
            SEAM(pb + 2);
        }
        if (IN(pb + 3)) PHASE(pb + 3) { const karg_t ka = kargs(); unsigned char* const ws = uptr(KWS(ka));
            MapLin mp{(const char*)(ws + WS_MIXB), (const char*)(ws + WS_WCO_T + (size_t)l * DM * DM * 2), (size_t)256 * DM * 2, (size_t)256 * DM * 2};
            pg8::Sched<MapLin> S; S.init(NTOK / 256, DM / 256, G, bx, mp);
            EpiResB<false> E{(const bf16_t*)(ws + (l == 0 ? WS_XB : WS_XALT)), (bf16_t*)(ws + (l == 0 ? WS_XALT : WS_XB)), nullptr, nullptr};
            pg8::gemm_phase<EpiResB<false>, pg8::Sched<MapLin>, true>(F.wave, ring, xl, DM, DM * 2, DM * 2, S, E);
            SEAM(pb + 3);
        }
        if (IN(pb + 4)) PHASE(pb + 4) { const karg_t ka = kargs(); unsigned char* const ws = uptr(KWS(ka));
            router_phase(F, (const bf16_t*)(ws + (l == 0 ? WS_XALT : WS_XB)), KIN(ka, 16) + l * DM, KIN(ka, 17) + (size_t)l * DM * NE, (float*)(ws + WS_SSP + 512 * 1024), (float*)(ws + WS_AFF));
            SEAM(pb + 4);
        }
        if (IN(pb + 5)) PHASE(pb + 5) { const karg_t ka = kargs(); unsigned char* const ws = uptr(KWS(ka));
            rank_phase(F, (const float*)(ws + WS_AFF), (int*)(ws + WS_RANK), (float*)(ws + WS_GATE), (const float*)(ws + WS_SSP + 512 * 1024), (float*)(ws + WS_SSP + 768 * 1024), (int*)(ws + WS_GATE + 512 * 1024));
            SEAM(pb + 5);
        }
        if (IN(pb + 6)) PHASE(pb + 6) { const karg_t ka = kargs(); unsigned char* const ws = uptr(KWS(ka));
            MapMoE mp{(const char*)(ws + (l == 0 ? WS_XALT : WS_XB)), (const char*)(ws + (l ? WS_WGU_T2 : WS_WGU_T)), (size_t)0, (size_t)2048 * DM * 2, (size_t)256 * DM * 2};
            pg8::Sched<MapMoE> S; S.init(NB * NE, 8, G, bx, mp);
            EpiSwiGLU E{(bf16_t*)(ws + WS_ACTB), (const float*)(ws + WS_SSP + 768 * 1024)};
            const bool cfirst = ((bx >> 3) & 1) != 0;
            if (l == 0 && cfirst) { tr_span(F, ka, ws, 2, 4096 + bx * 8 + F.wave, 2048, 2); __syncthreads(); }
            pg8::gemm_phase<EpiSwiGLU, pg8::Sched<MapMoE>, true, true>(F.wave, ring, xl, DM, DM * 2, DM * 2, S, E, (const int*)(ws + WS_GATE + 512 * 1024));
            if (l == 0 && !cfirst) { __syncthreads(); tr_span(F, ka, ws, 2, 4096 + bx * 8 + F.wave, 2048, 2); }
            SEAM(pb + 6);
        }
        if (IN(pb + 7)) PHASE(pb + 7) { const karg_t ka = kargs(); unsigned char* const ws = uptr(KWS(ka));
            MapMoE mp{(const char*)(ws + WS_ACTB), (const char*)(ws + (l ? WS_WD_T2 : WS_WD_T)), (size_t)256 * EFF * 2, (size_t)2048 * EFF * 2, (size_t)256 * EFF * 2};
            pg8::Sched<MapMoE> S; S.init(NB * NE, 8, G, bx, mp);
            EpiRowGate E{(bf16_t*)(ws + WS_YB), (const float*)(ws + WS_GATE)};
            const bool cfirst = ((bx >> 3) & 1) == 0;
            if (l == 0 && cfirst) { tr_span(F, ka, ws, 2, 8192 + bx * 8 + F.wave, 2048, 2); __syncthreads(); }
            pg8::gemm_phase<EpiRowGate, pg8::Sched<MapMoE>, true>(F.wave, ring, xl, EFF, EFF * 2, EFF * 2, S, E);
            if (l == 0 && !cfirst) { __syncthreads(); tr_span(F, ka, ws, 2, 8192 + bx * 8 + F.wave, 2048, 2); }
            SEAM(pb + 7);
        }
        if (IN(pb + 8)) PHASE(pb + 8) { const karg_t ka = kargs(); unsigned char* const ws = uptr(KWS(ka));
            combine_phase(F, (const bf16_t*)(ws + (l == 0 ? WS_XALT : WS_XB)), (bf16_t*)(ws + WS_XB), KOUT(ka), (const bf16_t*)(ws + WS_YB), (const int*)(ws + WS_RANK), l == 0 ? KIN(ka, 2) + DM : KIN(ka, 21), (bf16_t*)(ws + WS_HN), l == 1);
            SEAM(pb + 8);
        }
    }
#undef IN
#undef SEAM
#undef PHASE
#undef KV_PROJ
}


extern "C" void kernel_launch(void* const* d_in, const int* in_sizes, int n_in, void* d_out, int out_size, void* d_ws, size_t ws_size, hipStream_t stream) {
    static int grid = 0;
    if (grid == 0) {
        int dev = 0, cus = 0;
        if (n_in != 22 || out_size != NTOK * DM || ws_size < WS_FAST_END) { fprintf(stderr, "kernel_launch: unexpected shapes (n_in %d out %d ws %zu)\n", n_in, out_size, ws_size); grid = -1; return; }
        if (hipGetDevice(&dev) != hipSuccess || hipDeviceGetAttribute(&cus, hipDeviceAttributeMultiprocessorCount, dev) != hipSuccess) { fprintf(stderr, "device query failed\n"); grid = -1; return; }
        if (hipFuncSetAttribute((const void*)skel_fwd, hipFuncAttributeMaxDynamicSharedMemorySize, LDS_BYTES) != hipSuccess) { fprintf(stderr, "hipFuncSetAttribute failed\n"); grid = -1; return; }
        (void)hipGetLastError();
        grid = cus;
        if (grid != 256) { fprintf(stderr, "kernel_launch: this kernel is laid out for 256 CUs (found %d)\n", cus); grid = -1; return; }
    }
    if (grid < 0) return;
    (void)hipMemsetAsync((char*)d_ws + WS_CTL, 0, 32768, stream);
    Args a{};
    for (int i = 0; i < 22; ++i) a.in[i] = (const float*)d_in[i];
    a.out = (float*)d_out; a.ws = (unsigned char*)d_ws;
#ifdef REP_RT
    a.pad = REP_RT;
#endif
    constexpr int NL = MK_N_LAUNCHES;
    for (int li = 0; li < NL; ++li) {
        a.ph_lo = (N_PHASES * li) / NL; a.ph_hi = (N_PHASES * (li + 1)) / NL; a.li = li;
        hipLaunchKernelGGL(skel_fwd, dim3(grid), dim3(NWAVES * 64), LDS_BYTES, stream, a);
    }
}
```

```cpp
#include <hip/hip_runtime.h>
#include <cstdio>
#include <cstdint>

constexpr int DM = 2048, NB = 4, SEQ = 2048, NTOK = NB * SEQ;
constexpr int HD = 128, NQH = 12, NKVH = 4, AW = NQH * HD, KVW = NKVH * HD, FW = 512, INW = 3072;
constexpr int MEML = 256, NMH = 4, MHD = 512;
constexpr int NE = 16, EFF = 1024, CAP = 256;
constexpr float EPS = 1e-6f;

#define LAS __attribute__((address_space(3)))
#define GAS __attribute__((address_space(1)))
typedef unsigned short bf16_t;
typedef short bf16x8 __attribute__((ext_vector_type(8)));
typedef float f32x4 __attribute__((ext_vector_type(4)));
typedef float f32x2 __attribute__((ext_vector_type(2)));
typedef unsigned u32x4 __attribute__((ext_vector_type(4)));
typedef unsigned u32x2 __attribute__((ext_vector_type(2)));
typedef __bf16 bf16x2_t __attribute__((ext_vector_type(2)));
__device__ __forceinline__ unsigned cvtpk(float lo, float hi) { f32x2 v = {lo, hi}; bf16x2_t b = __builtin_convertvector(v, bf16x2_t); return __builtin_bit_cast(unsigned, b); }
__device__ __forceinline__ float bf2f(unsigned short h) { return __uint_as_float(((unsigned)h) << 16); }
template <class T> __device__ __forceinline__ T* uptr(T* p) { const unsigned long long v = (unsigned long long)p; const unsigned lo = __builtin_amdgcn_readfirstlane((unsigned)v), hi = __builtin_amdgcn_readfirstlane((unsigned)(v >> 32)); return (T*)(((unsigned long long)hi << 32) | lo); }
__device__ __forceinline__ int lane_id() { int l = (int)__builtin_amdgcn_mbcnt_hi(~0u, __builtin_amdgcn_mbcnt_lo(~0u, 0u)); asm volatile("" : "+v"(l)); return l; }
typedef __attribute__((address_space(4))) const unsigned char* karg_t;
__device__ __forceinline__ karg_t kargs() { karg_t p = (karg_t)__builtin_amdgcn_kernarg_segment_ptr(); asm volatile("" : "+s"(p)); return p; }
#define KIN(ka, i) (*(const float* const __attribute__((address_space(4)))*)((ka) + 8 * (i)))
#define KOUT(ka) (*(float* const __attribute__((address_space(4)))*)((ka) + 176))
#define KWS(ka) (*(unsigned char* const __attribute__((address_space(4)))*)((ka) + 184))
#ifndef EPI_WT
#define EPI_WT 0
#endif
__device__ __forceinline__ void st16(void* p, u32x4 v) {
#if EPI_WT
    asm volatile("global_store_dwordx4 %0, %1, off sc1\n\ts_nop 1" :: "v"(p), "v"(v) : "memory");
#else
    *(u32x4*)p = v;
#endif
}
#define LDS_WAIT() asm volatile("s_waitcnt lgkmcnt(0)" ::: "memory")
#define VM_WAIT() asm volatile("s_waitcnt vmcnt(0)" ::: "memory")
#define WG_BAR() do { asm volatile("s_waitcnt lgkmcnt(0)" ::: "memory"); __builtin_amdgcn_s_barrier(); asm volatile("" ::: "memory"); } while (0)

namespace pg8 {
constexpr int BM = 256, BK = 64, HALF = 128, HTB = HALF * BK * 2, STAGE_BYTES = 8 * HTB, NXCD = 8, WGM = 8;
__host__ __device__ __forceinline__ int lds_byte(int r, int c) { const int st = (r >> 4) * 2 + (c >> 5), rr = r & 15, cc = c & 31, ob = rr * 64 + cc * 2; return st * 1024 + (ob ^ (((ob >> 9) & 1) << 5)); }
__host__ __device__ __forceinline__ void stage_rc(int b, int& R, int& C) { const int st = b / 1024, sb = b % 1024, swz = sb ^ (((sb >> 9) & 1) << 5); R = (st >> 1) * 16 + swz / 64; C = (st & 1) * 32 + (swz % 64) / 2; }
__host__ __device__ __forceinline__ int perm32(int rho) { const int n = rho >> 4, i = rho & 15; return 8 * (i >> 2) + 4 * n + (i & 3); }

struct Unit { int pm, pn; const char* a; const char* b; };
struct EpiCtx { int wr, wc, wid; LAS unsigned char* xl; };

template <class Map> struct Sched {
    int nM, nN, nwg, G, c; Map map;
    __device__ __forceinline__ void init(int nM_, int nN_, int G_, int c_, const Map& m) { nM = nM_; nN = nN_; nwg = nM * nN; G = G_; c = c_; map = m; }
    __device__ __forceinline__ bool next(int i, Unit& u) const {
        const long L = (long)i * G + c; if (L >= nwg) return false;
        int wgid = (int)L; { const int q = nwg / NXCD, r = nwg % NXCD, xcd = wgid % NXCD, off = wgid / NXCD; wgid = (xcd < r ? xcd * (q + 1) : r * (q + 1) + (xcd - r) * q) + off; }
        const int nig = WGM * nN, gid = wgid / nig, fm = gid * WGM, gsz = (nM - fm) < WGM ? (nM - fm) : WGM;
        u.pm = fm + ((wgid % nig) % gsz); u.pn = (wgid % nig) / gsz; map(u); return true;
    }
};

template <class Epi, class SchedT, bool SP2, bool GATHER = false>
__device__ __forceinline__ void gemm_phase(const int wave_, LAS unsigned char* lds, LAS unsigned char* xl, const int K, const int lda, const int ldb, const SchedT& S, const Epi& E, const int* gidx = nullptr) {
    constexpr bool ALIGN_EPI = true; static_assert(SP2 || !GATHER, "GATHER needs the SP2 loop");
    const int lane = lane_id(), wid = wave_, tid = wid * 64 + lane, wr = wid >> 2, wc = wid & 3, fr = lane & 15, fq = lane >> 4;
    const int nt = K / BK;
    unsigned voffA[2], voffB[2];
#pragma unroll
    for (int i = 0; i < 2; ++i) { int R, C; stage_rc(tid * 16 + i * 8192, R, C); const int Rb = Epi::PERM ? ((R & ~31) + perm32(R & 31)) : R;
        voffA[i] = (unsigned)(R * lda + C * 2); voffB[i] = (unsigned)(Rb * ldb + C * 2); }
    const size_t kstep = (size_t)(BK * 2);
    const size_t hstepA = (size_t)HALF * lda, hstepB = (size_t)HALF * ldb;
    const unsigned ldsw = (unsigned)wid * 1024u;
    const int aoff = lds_byte(wr * 64 + fr, fq * 8), boff = lds_byte(wc * 32 + fr, fq * 8);
    const unsigned xoffA = (unsigned)tid * 16u;
    int gset = 0;
#define PG8_GSETUP(set, pm_) do { if constexpr (GATHER) { int R0_, C0_, R1_, C1_; stage_rc(tid * 16, R0_, C0_); stage_rc(tid * 16 + 8192, R1_, C1_); \
        const GAS int* gi_ = (const GAS int*)gidx + (pm_) * 256; const int r00_ = gi_[R0_], r01_ = gi_[R1_], r10_ = gi_[128 + R0_], r11_ = gi_[128 + R1_];     \
        *(LAS u32x4*)(xl + (set) * 8192 + xoffA) = (u32x4){(unsigned)(r00_ * lda + C0_ * 2), (unsigned)(r01_ * lda + C1_ * 2), (unsigned)(r10_ * lda + C0_ * 2), (unsigned)(r11_ * lda + C1_ * 2)}; } } while (0)
#define PG8_SA(b, h) (((b) * 2 + (h)) * HTB)
#define PG8_SB(b, h) ((4 + (b) * 2 + (h)) * HTB)
#define PG8_STAGE(bufoff, gbase, voff) do { _Pragma("unroll") for (int _i = 0; _i < 2; ++_i) \
        __builtin_amdgcn_global_load_lds((const unsigned*)((const char*)(gbase) + (voff)[_i]), (LAS unsigned*)(lds + (bufoff) + ldsw + _i * 8192), 16, 0, 0); } while (0)
#define PG8_GOFF(h_, set_) u32x2 go_ = {0u, 0u}; if constexpr (GATHER) go_ = *(const LAS u32x2*)(xl + (set_) * 8192 + xoffA + (h_) * 8)
#define PG8_STAGE_A(bufoff, gbase, h_, set_) do { if constexpr (GATHER) { \
        __builtin_amdgcn_global_load_lds((const unsigned*)((const char*)(gbase) + go_.x), (LAS unsigned*)(lds + (bufoff) + ldsw), 16, 0, 0); \
        __builtin_amdgcn_global_load_lds((const unsigned*)((const char*)(gbase) + go_.y), (LAS unsigned*)(lds + (bufoff) + ldsw + 8192), 16, 0, 0); } \
      else { PG8_STAGE(bufoff, (const char*)(gbase) + (h_) * hstepA, voffA); } } while (0)
#define PG8_LDA(dst, b, h) do { _Pragma("unroll") for (int m = 0; m < 4; ++m) _Pragma("unroll") for (int k = 0; k < 2; ++k) dst[m][k] = *(const LAS bf16x8*)(lds + PG8_SA(b, h) + aoff + m * 2048 + k * 1024); } while (0)
#define PG8_LDB(dst, b, h) do { _Pragma("unroll") for (int n = 0; n < 2; ++n) _Pragma("unroll") for (int k = 0; k < 2; ++k) dst[n][k] = *(const LAS bf16x8*)(lds + PG8_SB(b, h) + boff + n * 2048 + k * 1024); } while (0)
#define PG8_MMA(ai, bj, At, Bt) do { __builtin_amdgcn_s_setprio(1); _Pragma("unroll") for (int m = 0; m < 4; ++m) _Pragma("unroll") for (int n = 0; n < 2; ++n) _Pragma("unroll") for (int k = 0; k < 2; ++k) \
        acc[ai][bj][m][n] = __builtin_amdgcn_mfma_f32_16x16x32_bf16(Bt[n][k], At[m][k], acc[ai][bj][m][n], 0, 0, 0); __builtin_amdgcn_s_setprio(0); } while (0)
#define PG8_WAIT_V(n) asm volatile("s_waitcnt vmcnt(" #n ")" ::: "memory")
#define PG8_WAIT_L(n) asm volatile("s_waitcnt lgkmcnt(" #n ")" ::: "memory")
#define PG8_BAR __builtin_amdgcn_s_barrier()
#define PG8_SCHED __builtin_amdgcn_sched_barrier(0)
    Unit cur, nxt; int ui = 0;
    if (!S.next(0, cur)) return;
    EpiCtx ctx; ctx.wr = wr; ctx.wc = wc; ctx.wid = wid; ctx.xl = xl;
    f32x4 acc[2][2][4][2];
#pragma unroll
    for (int a = 0; a < 2; ++a)
#pragma unroll
        for (int b = 0; b < 2; ++b)
#pragma unroll
            for (int m = 0; m < 4; ++m)
#pragma unroll
                for (int n = 0; n < 2; ++n) acc[a][b][m][n] = (f32x4){0.f, 0.f, 0.f, 0.f};
    bf16x8 At[4][2], B0[2][2], B1[2][2];
    const char* cA = cur.a; const char* cB = cur.b;
    PG8_GSETUP(0, cur.pm);
    if constexpr (SP2) {
        PG8_STAGE(PG8_SB(0, 0), cB, voffB); PG8_STAGE(PG8_SB(0, 1), cB + hstepB, voffB); { PG8_GOFF(0, 0); PG8_STAGE_A(PG8_SA(0, 0), cA, 0, 0); } { PG8_GOFF(1, 0); PG8_STAGE_A(PG8_SA(0, 1), cA, 1, 0); }
        if (wr == 1) PG8_BAR;
        PG8_WAIT_V(2); PG8_BAR;
        PG8_STAGE(PG8_SB(1, 0), cB + kstep, voffB); { PG8_GOFF(0, 0); PG8_STAGE_A(PG8_SA(1, 0), cA + kstep, 0, 0); } PG8_STAGE(PG8_SB(1, 1), cB + hstepB + kstep, voffB);
        PG8_WAIT_V(6); PG8_BAR;
    } else {
        PG8_STAGE(PG8_SB(0, 0), cB, voffB); PG8_STAGE(PG8_SA(0, 0), cA, voffA); PG8_STAGE(PG8_SB(0, 1), cB + hstepB, voffB); PG8_STAGE(PG8_SA(0, 1), cA + hstepA, voffA);
        if (wr == 1) PG8_BAR;
        PG8_WAIT_V(4); PG8_BAR;
        PG8_STAGE(PG8_SB(1, 0), cB + kstep, voffB); PG8_STAGE(PG8_SA(1, 0), cA + kstep, voffA); PG8_STAGE(PG8_SB(1, 1), cB + hstepB + kstep, voffB);
        PG8_WAIT_V(6); PG8_BAR;
    }
    for (;;) {
        const bool has_next = S.next(ui + 1, nxt);
        const char* nA = has_next ? nxt.a : cA; const char* nB = has_next ? nxt.b : cB;
        if (has_next) PG8_GSETUP(gset ^ 1, nxt.pm);
        for (int t = 0; t < nt; t += 2) {
            const bool last = (t == nt - 2);
            const char* a1 = cA + (size_t)(t + 1) * kstep;
            const char* a2 = last ? nA : cA + (size_t)(t + 2) * kstep; const char* b2 = last ? nB : cB + (size_t)(t + 2) * kstep;
            const char* a3 = a2 + kstep; const char* b3 = b2 + kstep;
            const int set2 = (last && has_next) ? (gset ^ 1) : gset;
            if constexpr (SP2) {
            { PG8_GOFF(1, gset); PG8_LDB(B0, 0, 0); PG8_LDB(B1, 0, 1); PG8_SCHED; PG8_LDA(At, 0, 0); PG8_STAGE_A(PG8_SA(1, 1), a1, 1, gset); }
            PG8_WAIT_V(8); PG8_WAIT_L(0); PG8_BAR; PG8_MMA(0, 0, At, B0); PG8_MMA(0, 1, At, B1); PG8_BAR; PG8_SCHED;
            { PG8_GOFF(0, set2); PG8_LDA(At, 0, 1); PG8_STAGE(PG8_SB(0, 0), b2, voffB); PG8_STAGE(PG8_SB(0, 1), b2 + hstepB, voffB); PG8_STAGE_A(PG8_SA(0, 0), a2, 0, set2); }
            PG8_WAIT_V(8); PG8_WAIT_L(0); PG8_BAR; PG8_MMA(1, 0, At, B0); PG8_MMA(1, 1, At, B1); PG8_BAR; PG8_SCHED;
            { PG8_GOFF(1, set2); PG8_LDB(B0, 1, 0); PG8_LDB(B1, 1, 1); PG8_SCHED; PG8_LDA(At, 1, 0); PG8_STAGE_A(PG8_SA(0, 1), a2, 1, set2); }
            PG8_WAIT_V(8); PG8_WAIT_L(0); PG8_BAR; PG8_MMA(0, 0, At, B0); PG8_MMA(0, 1, At, B1); PG8_BAR; PG8_SCHED;
            { PG8_GOFF(0, set2); PG8_LDA(At, 1, 1); PG8_STAGE(PG8_SB(1, 0), b3, voffB); PG8_STAGE(PG8_SB(1, 1), b3 + hstepB, voffB); PG8_STAGE_A(PG8_SA(1, 0), a3, 0, set2); }
            PG8_WAIT_V(8); PG8_WAIT_L(0); PG8_BAR; PG8_MMA(1, 0, At, B0); PG8_MMA(1, 1, At, B1); PG8_BAR; PG8_SCHED;
            } else {
            PG8_LDB(B0, 0, 0); PG8_SCHED; PG8_LDA(At, 0, 0); PG8_STAGE(PG8_SA(1, 1), a1 + hstepA, voffA);
            PG8_WAIT_L(8); PG8_BAR; PG8_WAIT_L(0); PG8_MMA(0, 0, At, B0); PG8_BAR; PG8_SCHED;
            PG8_LDB(B1, 0, 1); PG8_STAGE(PG8_SB(0, 0), b2, voffB);
            PG8_BAR; PG8_WAIT_L(0); PG8_MMA(0, 1, At, B1); PG8_BAR;
            PG8_LDA(At, 0, 1); PG8_STAGE(PG8_SA(0, 0), a2, voffA);
            PG8_BAR; PG8_WAIT_L(0); PG8_MMA(1, 0, At, B0); PG8_BAR; PG8_SCHED;
            PG8_STAGE(PG8_SB(0, 1), b2 + hstepB, voffB);
            PG8_WAIT_V(6); PG8_BAR; PG8_MMA(1, 1, At, B1); PG8_BAR;
            PG8_LDB(B0, 1, 0); PG8_SCHED; PG8_LDA(At, 1, 0); PG8_STAGE(PG8_SA(0, 1), a2 + hstepA, voffA);
            PG8_WAIT_L(8); PG8_BAR; PG8_WAIT_L(0); PG8_MMA(0, 0, At, B0); PG8_BAR; PG8_SCHED;
            PG8_LDB(B1, 1, 1); PG8_STAGE(PG8_SB(1, 0), b3, voffB);
            PG8_BAR; PG8_WAIT_L(0); PG8_MMA(0, 1, At, B1); PG8_BAR;
            PG8_LDA(At, 1, 1); PG8_STAGE(PG8_SA(1, 0), a3, voffA);
            PG8_BAR; PG8_WAIT_L(0); PG8_MMA(1, 0, At, B0); PG8_BAR; PG8_SCHED;
            PG8_STAGE(PG8_SB(1, 1), b3 + hstepB, voffB);
            PG8_WAIT_V(6); PG8_BAR; PG8_MMA(1, 1, At, B1); PG8_BAR;
            }
        }
        if constexpr (ALIGN_EPI) { if (wr == 0) PG8_BAR; }
        E(acc, cur, ctx);
        if (!has_next) break;
#pragma unroll
        for (int a = 0; a < 2; ++a)
#pragma unroll
            for (int b = 0; b < 2; ++b)
#pragma unroll
                for (int m = 0; m < 4; ++m)
#pragma unroll
                    for (int n = 0; n < 2; ++n) acc[a][b][m][n] = (f32x4){0.f, 0.f, 0.f, 0.f};
        cur = nxt; cA = nA; cB = nB; ++ui; gset ^= 1;
        if constexpr (ALIGN_EPI) { if (wr == 1) PG8_BAR; }
    }
    PG8_WAIT_V(0);
    if constexpr (!ALIGN_EPI) { if (wr == 0) PG8_BAR; }
    PG8_BAR;
#undef PG8_SA
#undef PG8_SB
#undef PG8_STAGE
#undef PG8_STAGE_A
#undef PG8_GOFF
#undef PG8_GSETUP
#undef PG8_LDA
#undef PG8_LDB
#undef PG8_MMA
#undef PG8_WAIT_V
#undef PG8_WAIT_L
#undef PG8_BAR
#undef PG8_SCHED
}
}

constexpr size_t MiB = 1u << 20;
constexpr size_t WS_CTL = 0, CTL_ZERO_BYTES = 1 * MiB;
constexpr size_t WS_WIN_T = 1 * MiB, WS_WF_T = 11 * MiB, WS_WOUT_T = 15 * MiB, WS_WCQ_T = 23 * MiB, WS_WCK_T = 39 * MiB, WS_WCV_T = 55 * MiB, WS_WCO_T = 71 * MiB;
constexpr size_t WS_WP_T = 87 * MiB, WS_DFT = 89 * MiB, WS_ROPE = 105 * MiB, WS_WGU_T = 106 * MiB, WS_WD_T = 234 * MiB;
constexpr size_t WS_HN = 298 * MiB, WS_XB = 330 * MiB, WS_QB = 362 * MiB, WS_KB = 386 * MiB, WS_VB = 394 * MiB, WS_FPQ = 402 * MiB, WS_MIXB = 418 * MiB, WS_QCB = 450 * MiB;
constexpr size_t WS_KCB = 482 * MiB, WS_VTB = 490 * MiB, WS_MEMNB = 498 * MiB, WS_PB = 506 * MiB, WS_XSB = 522 * MiB, WS_ACTB = 586 * MiB, WS_YB = 618 * MiB;
constexpr size_t WS_SSP = 682 * MiB, WS_AFF = 683 * MiB, WS_RANK = 684 * MiB, WS_GATE = 685 * MiB, WS_XALT = 686 * MiB, WS_WGU_T2 = 750 * MiB, WS_WD_T2 = 878 * MiB, WS_FAST_END = 942 * MiB;
constexpr int CW_TMO = 0, CW_CODE = 1, CW_BAR = 4096;
constexpr int RING_OFF = 0, RING_BYTES = 131072, XL_OFF = 131072, XL_BYTES = 16384, LDSCTL_OFF = XL_OFF + XL_BYTES, MISC_OFF = LDSCTL_OFF + 320, LDS_BYTES = 149504;
static_assert(MISC_OFF + 128 <= LDS_BYTES, "LDS map");
constexpr int NWAVES = 8;

typedef GAS unsigned gu32;
#define RLX_AGENT __ATOMIC_RELAXED, __HIP_MEMORY_SCOPE_AGENT

#define XB_TMO      128
#define XB_XCNT(j)  (256  + 64 * (j))
#define XB_XSUB(j)  (1280 + 64 * (j))
#define XB_XGEN(j)  (2304 + 64 * (j))
#define XB_TOP      3328
#define XB_TOPGEN   3392
#define XCD_BAR_WORDS 3456
#define XB_SPIN_CAP (1u << 18)
__device__ __forceinline__ unsigned xb_ld(unsigned* p)              { return __hip_atomic_load(p, __ATOMIC_RELAXED, __HIP_MEMORY_SCOPE_AGENT); }
__device__ __forceinline__ unsigned xb_add(unsigned* p, unsigned v) { return __hip_atomic_fetch_add(p, v, __ATOMIC_RELAXED, __HIP_MEMORY_SCOPE_AGENT); }
__device__ __forceinline__ unsigned xb_xcc_id() { return (unsigned)__builtin_amdgcn_s_getreg((3 << 11) | 20) & 0xFu; }
#define XB_SPIN(cond, bar) do { unsigned _sp = 0; while (cond) { __builtin_amdgcn_s_sleep(1); \
    if ((++_sp & 255u) == 0u) { if (xb_ld(&(bar)[XB_TMO])) break; if (_sp > XB_SPIN_CAP) { atomicAdd(&(bar)[XB_TMO], 1u); break; } } } } while (0)
struct XcdBarrier { unsigned* bar; unsigned x; volatile LAS unsigned* st; int wave; };
__device__ __forceinline__ XcdBarrier xcd_barrier_post(unsigned* bar, volatile LAS unsigned* st, int wave) {
    XcdBarrier b; b.bar = bar; b.x = xb_xcc_id(); b.st = st; b.wave = wave;
    if (wave == 0 && lane_id() == 0) (void)xb_add(&bar[XB_XCNT(b.x)], 1u);
    return b;
}
__device__ __forceinline__ void xcd_barrier_complete(unsigned* bar, unsigned x, unsigned& nloc, unsigned& nx) {
    const unsigned G = gridDim.x * gridDim.y * gridDim.z;
    unsigned sum, cnt, mine, sp = 0u;
    for (;;) {
        sum = 0u; cnt = 0u; mine = 0u;
#pragma unroll
        for (unsigned j = 0; j < 16; ++j) { const unsigned c = xb_ld(&bar[XB_XCNT(j)]); sum += c; cnt += (c > 0u) ? 1u : 0u; mine = (j == x) ? c : mine; }
        if (sum == G) break;
        __builtin_amdgcn_s_sleep(1);
        if ((++sp & 255u) == 0u) { if (xb_ld(&bar[XB_TMO])) break; if (sp > XB_SPIN_CAP) { atomicAdd(&bar[XB_TMO], 1u); break; } }
    }
    nloc = mine > 0u ? mine : 1u; nx = cnt > 0u ? cnt : 1u;
}
__device__ __forceinline__ void xcd_barrier(const XcdBarrier& b) {
    asm volatile("s_waitcnt vmcnt(0)" ::: "memory");
    __syncthreads();
    if (b.wave == 0 && lane_id() == 0) {
        unsigned* bar = b.bar;
        __builtin_amdgcn_s_waitcnt(0);
        unsigned nloc = b.st[0], nx = b.st[1];
        if (nloc == 0u) { xcd_barrier_complete(bar, b.x, nloc, nx); b.st[0] = nloc; b.st[1] = nx; }
        const unsigned old = xb_add(&bar[XB_XSUB(b.x)], 1u);
        const unsigned gen = old / nloc;
        if (old + 1u == (gen + 1u) * nloc) {
            __builtin_amdgcn_fence(__ATOMIC_RELEASE, "agent");
            asm volatile("s_waitcnt vmcnt(0)" ::: "memory");
            const unsigned og = xb_add(&bar[XB_TOP], 1u);
            const unsigned tg = og / nx;
            if (og + 1u == (tg + 1u) * nx) xb_add(&bar[XB_TOPGEN], 1u);
            else XB_SPIN(xb_ld(&bar[XB_TOPGEN]) == tg, bar);
            __builtin_amdgcn_fence(__ATOMIC_ACQUIRE, "agent");
            xb_add(&bar[XB_XGEN(b.x)], 1u);
            asm volatile("s_waitcnt vmcnt(0)" ::: "memory");
        } else {
            XB_SPIN(xb_ld(&bar[XB_XGEN(b.x)]) == gen, bar);
            __builtin_amdgcn_fence(__ATOMIC_ACQUIRE, "agent");
            asm volatile("s_waitcnt vmcnt(0)" ::: "memory");
        }
    }
    __syncthreads();
}

struct Args { const float* in[22]; float* out; unsigned char* ws; int ph_lo, ph_hi, li, pad; };
struct Frame {
    LAS unsigned char* lds; volatile LAS unsigned* MISC; gu32* ctl;
    int wave, vcu, G;
    unsigned char* ws;
};
__device__ __forceinline__ float wave_sum(float v) {
#pragma unroll
    for (int o = 1; o < 64; o <<= 1) v += __shfl_xor(v, o);
    return v;
}
struct TrDesc { const float* W; const float* gain; bf16_t* WT; int ldw, ldt, k0, n0; long drow0; };
__device__ __forceinline__ void tr_load(const TrDesc& d, f32x4 (&v)[16], int lane) {
    const int lr = lane >> 4, lc = (lane & 15) * 4;
#pragma unroll
    for (int i = 0; i < 16; ++i) v[i] = __builtin_nontemporal_load((const GAS f32x4*)(d.W + (size_t)(d.k0 + 4 * i + lr) * d.ldw + d.n0 + lc));
}
#ifndef TRV
#define TRV 0
#endif
template <int V> __device__ __forceinline__ void tr_finish(const TrDesc& d, const f32x4 (&v)[16], LAS float* scr, int lane) {
    const int lr = lane >> 4, lc = (lane & 15) * 4;
    if (V == 1) { f32x4 s = v[0]; for (int i = 1; i < 16; ++i) s = s + v[i]; if (s.x == 1.2345e30f) *(GAS f32x4*)(d.WT) = s; return; }
#pragma unroll
    for (int i = 0; i < 16; ++i) { const int kk = 4 * i + lr; f32x4 x = v[i]; if (d.gain) x = x * d.gain[d.k0 + kk];
        LAS float* s = scr + kk * 65 + lc; s[0] = x.x; s[1] = x.y; s[2] = x.z; s[3] = x.w; }
    LDS_WAIT(); asm volatile("" ::: "memory");
    const int c = lane & 7;
#pragma unroll
    for (int j = 0; j < 8; ++j) { const int n = (lane >> 3) + 8 * j; const LAS float* s = scr + (8 * c) * 65 + n;
        u32x4 o; o.x = cvtpk(s[0 * 65], s[1 * 65]); o.y = cvtpk(s[2 * 65], s[3 * 65]); o.z = cvtpk(s[4 * 65], s[5 * 65]); o.w = cvtpk(s[6 * 65], s[7 * 65]);
        if (V == 0 || o.x == 0x12345678u) *(GAS u32x4*)(d.WT + (size_t)(d.drow0 + n) * d.ldt + d.k0 + 8 * c) = o; }
    LDS_WAIT(); asm volatile("" ::: "memory");
}
#ifndef TR_PIPE
#define TR_PIPE 0
#endif
constexpr int TR_DENSE = 32 * 20 + 9 * 32 * 16 + 32 * 4, TR_EXPERT = NE * 768;
__device__ __forceinline__ TrDesc tr_desc(karg_t ka, unsigned char* ws, int it, int mode) {
    TrDesc d; d.gain = nullptr;
    constexpr int I_IN = 32 * 20, I_SQ = 32 * 16;
    if (mode == 0) {
        int r = it;
        if (r < I_IN) { d.W = KIN(ka, 3); d.ldw = INW; d.WT = (bf16_t*)(ws + WS_WIN_T); d.ldt = DM; d.k0 = (r / 20) * 64; d.n0 = (r % 20) * 128; d.drow0 = d.n0; return d; } r -= I_IN;
        if (r < I_SQ) { d.W = KIN(ka, 7); d.ldw = DM; d.WT = (bf16_t*)(ws + WS_WOUT_T); d.ldt = DM; d.k0 = (r / 16) * 64; d.n0 = (r % 16) * 128; d.drow0 = d.n0; return d; } r -= I_SQ;
        if (r < 8 * I_SQ) { const int j = r / I_SQ, q = r % I_SQ, wsel = j >> 1, layer = j & 1;
            d.W = KIN(ka, 12 + wsel) + (size_t)layer * DM * DM; d.ldw = DM; if (wsel == 0) d.gain = KIN(ka, 10) + layer * DM;
            d.WT = (bf16_t*)(ws + (wsel == 0 ? WS_WCQ_T : wsel == 1 ? WS_WCK_T : wsel == 2 ? WS_WCV_T : WS_WCO_T) + (size_t)layer * DM * DM * 2); d.ldt = DM;
            d.k0 = (q / 16) * 64; d.n0 = (q % 16) * 128; d.drow0 = d.n0; return d; } r -= 8 * I_SQ;
        d.W = KIN(ka, 8); d.ldw = 512; d.WT = (bf16_t*)(ws + WS_WP_T); d.ldt = DM; d.k0 = (r / 4) * 64; d.n0 = (r % 4) * 128; d.drow0 = d.n0; return d;
    }
    const int layer = mode - 1;
    const int e = it / 768, r = it % 768; const size_t eo = (size_t)(layer * NE + e);
    if (r < 512) { const int up = r >> 8, q = r & 255, kb = q >> 3, nb = q & 7, n0 = nb * 128;
        d.W = (up ? KIN(ka, 19) : KIN(ka, 18)) + eo * DM * EFF; d.ldw = EFF; d.gain = KIN(ka, 16) + layer * DM;   d.WT = (bf16_t*)(ws + (layer ? WS_WGU_T2 : WS_WGU_T)) + (size_t)e * 2048 * 2048; d.ldt = 2048;
        d.k0 = kb * 64; d.n0 = n0; d.drow0 = (long)(n0 >> 7) * 256 + up * 128;
    } else { const int q = r - 512, kb = q >> 4, nb = q & 15;
        d.W = KIN(ka, 20) + eo * EFF * DM; d.ldw = DM; d.WT = (bf16_t*)(ws + (layer ? WS_WD_T2 : WS_WD_T)) + (size_t)e * 2048 * 1024; d.ldt = 1024; d.k0 = kb * 64; d.n0 = nb * 128; d.drow0 = nb * 128; }
    return d;
}
template <int V = 0> __device__ __forceinline__ void tr_span(const Frame& F, karg_t ka, unsigned char* ws, int mode, int first, int stride, int cnt) {
    const int lane = lane_id(); LAS float* scr = (LAS float*)(F.lds + RING_OFF + F.wave * 16640);
    if (cnt <= 0) return;
    f32x4 va[16], vb[16];
    TrDesc da = tr_desc(ka, ws, first, mode), db = da; db.n0 += 64; db.drow0 += 64;
    tr_load(da, va, lane); tr_load(db, vb, lane);
    for (int j = 0; j < cnt; ++j) {
        const bool more = j + 1 < cnt; TrDesc na = da, nb = db;
        if (more) { na = tr_desc(ka, ws, first + stride * (j + 1), mode); nb = na; nb.n0 += 64; nb.drow0 += 64; }
        tr_finish<V>(da, va, scr, lane); if (more) tr_load(na, va, lane);
        tr_finish<V>(db, vb, scr, lane); if (more) tr_load(nb, vb, lane);
        da = na; db = nb;
    }
}
__device__ __forceinline__ void rms_row_to_bf16(const float* xrow, const float* __restrict__ gain, bf16_t* orow, int lane) {
    const GAS f32x4* xr = (const GAS f32x4*)xrow + lane; const f32x4* gr = (const f32x4*)gain + lane;
    f32x4 v[8]; float s = 0.f;
#pragma unroll
    for (int j = 0; j < 8; ++j) { v[j] = xr[64 * j]; s += (v[j].x * v[j].x + v[j].y * v[j].y) + (v[j].z * v[j].z + v[j].w * v[j].w); }
    const float r = rsqrtf(wave_sum(s) * (1.f / DM) + EPS);
    GAS u32x2* o8 = (GAS u32x2*)orow + lane;
#pragma unroll
    for (int j = 0; j < 8; ++j) { const f32x4 g = gr[64 * j]; u32x2 w; w.x = cvtpk(v[j].x * r * g.x, v[j].y * r * g.y); w.y = cvtpk(v[j].z * r * g.z, v[j].w * r * g.w); o8[64 * j] = w; }
}

__device__ __forceinline__ void p0_prologue(Frame& F, karg_t ka, unsigned char* ws) {
    const float* x = KIN(ka, 0); const float* mem = KIN(ka, 1); const float* mix_norm = KIN(ka, 2); const float* w_in = KIN(ka, 3);
    const float* w_four = KIN(ka, 6); const float* w_out = KIN(ka, 7); const float* pool_w = KIN(ka, 8); const float* cross_norm = KIN(ka, 10); const float* mem_norm = KIN(ka, 11);
    const int gw = F.vcu * NWAVES + F.wave, NGW = F.G * NWAVES;
    const int p_lane = lane_id(), p_tid = F.wave * 64 + p_lane;
    { LAS float* tab = (LAS float*)(F.lds + RING_OFF);
      for (int m = p_tid; m < 2048; m += 512) tab[m] = cosf(6.283185307179586f * (float)m * (1.0f / 2048.0f));
      __syncthreads();
      bf16_t* DFT = (bf16_t*)(ws + WS_DFT);
      for (int row = F.vcu * 8; row < 2048; row += F.G * 8)
          for (int rr = 0; rr < 8; ++rr) { const int k1 = row + rr; if (k1 >= 2048) break;
              { const int c0 = p_tid * 8; const int which = c0 >> 11, s0 = c0 & 2047; unsigned w[4];
#pragma unroll
                for (int j = 0; j < 4; ++j) { const int ma = (k1 * (s0 + 2 * j)) & 2047, mb = (k1 * (s0 + 2 * j + 1)) & 2047;
                    w[j] = cvtpk(tab[(ma - which * 512) & 2047], tab[(mb - which * 512) & 2047]); }
                *(GAS u32x4*)(DFT + (size_t)k1 * 4096 + c0) = (u32x4){w[0], w[1], w[2], w[3]}; } }
      __syncthreads(); }
    { float* RC = (float*)(ws + WS_ROPE); float* RS = RC + SEQ * 64;
      for (int i = F.vcu * 512 + p_tid; i < SEQ * 64; i += F.G * 512) { const int t = i >> 6, p = i & 63; const int pos = (p < 32) ? (t >> 6) : (t & 63); const int j = p & 31;
          const float inv = 1.0f / powf(10000.0f, (float)(2 * j) / 64.0f); const float ang = (float)pos * inv; RC[i] = cosf(ang); RS[i] = sinf(ang); } }
    { LAS float* Mw = (LAS float*)(F.lds + RING_OFF); LAS float* t128 = Mw + 128 * 32;
      bf16_t* WF = (bf16_t*)(ws + WS_WF_T);
      for (int it = F.vcu; it < 256; it += F.G) {
          const int which = it >> 7, g = (it >> 5) & 3, d0 = ((it >> 3) & 3) * 32, k0 = (it & 7) * 256;
          if (p_tid < 128) t128[p_tid] = cosf(6.283185307179586f * (float)p_tid * (1.0f / 128.0f));
          __syncthreads();
          { const int c = p_tid >> 2, dd = (p_tid & 3) * 8; float o[8] = {0.f, 0.f, 0.f, 0.f, 0.f, 0.f, 0.f, 0.f};
#pragma unroll 16
            for (int k2 = 0; k2 < 128; ++k2) { const int m = (c * k2) & 127; const float tv = which ? -t128[(m - 32) & 127] : t128[m];
                const float* wr_ = w_four + ((size_t)g * 128 + k2) * 128 + d0 + dd; const f32x4 w0 = *(const f32x4*)wr_, w1 = *(const f32x4*)(wr_ + 4);
                o[0] += tv * w0.x; o[1] += tv * w0.y; o[2] += tv * w0.z; o[3] += tv * w0.w; o[4] += tv * w1.x; o[5] += tv * w1.y; o[6] += tv * w1.z; o[7] += tv * w1.w; }
#pragma unroll
            for (int j = 0; j < 8; ++j) Mw[c * 32 + dd + j] = o[j] * (1.0f / 512.0f); }
          __syncthreads();
          { const int kp = p_tid & 127, dq = p_tid >> 7, k = k0 + 2 * kp; float o0[8] = {0.f, 0.f, 0.f, 0.f, 0.f, 0.f, 0.f, 0.f}, o1[8] = {0.f, 0.f, 0.f, 0.f, 0.f, 0.f, 0.f, 0.f};
            const float* r0 = w_in + (size_t)k * INW + 2560 + g * 128; const float* r1 = r0 + INW;
#pragma unroll 8
            for (int c4 = 0; c4 < 32; ++c4) { const f32x4 a = *(const f32x4*)(r0 + 4 * c4), b = *(const f32x4*)(r1 + 4 * c4); const float av[4] = {a.x, a.y, a.z, a.w}, bv[4] = {b.x, b.y, b.z, b.w};
#pragma unroll
                for (int cc = 0; cc < 4; ++cc) { const LAS float* mr = Mw + (4 * c4 + cc) * 32 + dq * 8;
#pragma unroll
                    for (int j = 0; j < 8; ++j) { o0[j] += av[cc] * mr[j]; o1[j] += bv[cc] * mr[j]; } } }
#pragma unroll
            for (int j = 0; j < 8; ++j) *(GAS unsigned*)(WF + (size_t)(which * 512 + g * 128 + d0 + dq * 8 + j) * DM + k) = cvtpk(o0[j], o1[j]); }
          __syncthreads(); } }
    { const int n = (TR_DENSE - gw + NGW - 1) / NGW; tr_span(F, ka, ws, 0, gw, NGW, n > 0 ? n : 0); }
    __syncthreads();
    for (int m = gw; m < NTOK; m += NGW) rms_row_to_bf16(x + (size_t)m * DM, mix_norm, (bf16_t*)(ws + WS_HN) + (size_t)m * DM, p_lane);
    for (int m = gw; m < 2 * NB * MEML; m += NGW) { const int l = m / (NB * MEML), r = m % (NB * MEML);
        rms_row_to_bf16(mem + (size_t)r * DM, mem_norm + l * DM, (bf16_t*)(ws + WS_MEMNB) + (size_t)m * DM, p_lane); }
}

struct MapLin { const char* A; const char* B; size_t as, bs; __device__ __forceinline__ void operator()(pg8::Unit& u) const { u.a = A + (size_t)u.pm * as; u.b = B + (size_t)u.pn * bs; } };

struct EpiQKV {
    static constexpr bool PERM = true;
    bf16_t* Q; bf16_t* K; bf16_t* V; const float* qg; const float* kg; const float* RC; const float* RS;
    __device__ __forceinline__ void operator()(f32x4 (&acc)[2][2][4][2], const pg8::Unit& u, const pg8::EpiCtx& c) const { const int e_lane = lane_id(), e_fr = e_lane & 15, e_fq = e_lane >> 4;
        const int pn = u.pn, hc = c.wc * 32 + e_fq * 8, rl0 = c.wr * 64 + e_fr;
        if (pn >= 8) {
            bf16_t* base = V + (size_t)(u.pm * 256 + rl0) * KVW + (pn - 8) * 256 + hc;
#pragma unroll
            for (int ai = 0; ai < 2; ++ai)
#pragma unroll
                for (int m = 0; m < 4; ++m) { bf16_t* rowp = base + (size_t)(ai * 128 + m * 16) * KVW;
#pragma unroll
                    for (int bj = 0; bj < 2; ++bj) { const f32x4 v0 = acc[ai][bj][m][0], v1 = acc[ai][bj][m][1];
                        st16((rowp + bj * 128), (u32x4){cvtpk(v0.x, v0.y), cvtpk(v0.z, v0.w), cvtpk(v1.x, v1.y), cvtpk(v1.z, v1.w)}); } }
            return;
        }
        LAS float* part = (LAS float*)c.xl;
#pragma unroll
        for (int ai = 0; ai < 2; ++ai)
#pragma unroll
            for (int m = 0; m < 4; ++m)
#pragma unroll
                for (int bj = 0; bj < 2; ++bj) { const f32x4 v0 = acc[ai][bj][m][0], v1 = acc[ai][bj][m][1];
                    float s = (v0.x * v0.x + v0.y * v0.y) + (v0.z * v0.z + v0.w * v0.w) + (v1.x * v1.x + v1.y * v1.y) + (v1.z * v1.z + v1.w * v1.w);
                    s += __shfl_xor(s, 16); s += __shfl_xor(s, 32);
                    if (e_fq == 0) part[((ai * 128 + rl0 + m * 16) * 2 + bj) * 4 + c.wc] = s; }
        WG_BAR();
        const float* gain = pn < 6 ? qg : kg;
        const f32x4 g0 = *(const f32x4*)(gain + hc), g1 = *(const f32x4*)(gain + hc + 4);
        bf16_t* O = pn < 6 ? Q : K; const int ld = pn < 6 ? AW : KVW; const int colbase = (pn < 6 ? pn : pn - 6) * 256 + hc;
#pragma unroll
        for (int ai = 0; ai < 2; ++ai)
#pragma unroll
            for (int m = 0; m < 4; ++m) { const int rl = ai * 128 + rl0 + m * 16, row = u.pm * 256 + rl, sp = row & (SEQ - 1);
                const f32x4 cs = *(const f32x4*)(RC + sp * 64 + (hc >> 1)), sn = *(const f32x4*)(RS + sp * 64 + (hc >> 1));
#pragma unroll
                for (int bj = 0; bj < 2; ++bj) { const f32x4 p4 = *(const LAS f32x4*)(part + (rl * 2 + bj) * 4);
                    const float r = rsqrtf(((p4.x + p4.y) + (p4.z + p4.w)) * (1.0f / 128.0f) + EPS);
                    const f32x4 v0 = acc[ai][bj][m][0] * r * g0, v1 = acc[ai][bj][m][1] * r * g1;
                    u32x4 w; w.x = cvtpk(v0.x * cs.x - v0.y * sn.x, v0.x * sn.x + v0.y * cs.x); w.y = cvtpk(v0.z * cs.y - v0.w * sn.y, v0.z * sn.y + v0.w * cs.y);
                    w.z = cvtpk(v1.x * cs.z - v1.y * sn.z, v1.x * sn.z + v1.y * cs.z); w.w = cvtpk(v1.z * cs.w - v1.w * sn.w, v1.z * sn.w + v1.w * cs.w);
                    st16((O + (size_t)row * ld + colbase + bj * 128), w); } }
    }
};


template <class AddrF> struct EpiStore {
    static constexpr bool PERM = true; AddrF f;
    __device__ __forceinline__ void operator()(f32x4 (&acc)[2][2][4][2], const pg8::Unit& u, const pg8::EpiCtx& c) const { const int e_lane = lane_id(), e_fr = e_lane & 15, e_fq = e_lane >> 4;
        const int hc = c.wc * 32 + e_fq * 8, rl0 = c.wr * 64 + e_fr;
#pragma unroll
        for (int ai = 0; ai < 2; ++ai)
#pragma unroll
            for (int m = 0; m < 4; ++m)
#pragma unroll
                for (int bj = 0; bj < 2; ++bj) { const f32x4 v0 = acc[ai][bj][m][0], v1 = acc[ai][bj][m][1];
                    st16(f(u, ai * 128 + rl0 + m * 16, bj * 128 + hc), (u32x4){cvtpk(v0.x, v0.y), cvtpk(v0.z, v0.w), cvtpk(v1.x, v1.y), cvtpk(v1.z, v1.w)}); }
    }
};
struct AddrF1 { bf16_t* FPQ; __device__ __forceinline__ bf16_t* operator()(const pg8::Unit& u, int rl, int tc) const {
    const int r = u.pm * 256 + rl, which = r >> 9, n = r & 511, cidx = u.pn * 256 + tc, b = cidx >> 11, s = cidx & 2047; return FPQ + (((size_t)(b * 512 + n) * 2 + which) * 2048 + s); } };
struct AddrF2 { bf16_t* MIX; __device__ __forceinline__ bf16_t* operator()(const pg8::Unit& u, int rl, int tc) const {
    const int row = (u.pn >> 1) * 2048 + u.pm * 256 + rl, col = AW + (u.pn & 1) * 256 + tc; return MIX + (size_t)row * DM + col; } };

template <bool BF32> struct EpiResB {
    static constexpr bool PERM = true;
    const void* base; bf16_t* xo; float* ssp; const float* cscale;
    __device__ __forceinline__ void operator()(f32x4 (&acc)[2][2][4][2], const pg8::Unit& u, const pg8::EpiCtx& c) const { const int e_lane = lane_id(), e_fr = e_lane & 15, e_fq = e_lane >> 4;
        const int hc = c.wc * 32 + e_fq * 8, rl0 = c.wr * 64 + e_fr;
        LAS float* part = (LAS float*)c.xl;
#pragma unroll
        for (int ai = 0; ai < 2; ++ai)
#pragma unroll
            for (int m = 0; m < 4; ++m) { const int rl = ai * 128 + rl0 + m * 16; float s = 0.f;
#pragma unroll
                for (int bj = 0; bj < 2; ++bj) { const int col = u.pn * 256 + bj * 128 + hc; const size_t off = (size_t)(u.pm * 256 + rl) * DM + col;
                    f32x4 v0 = acc[ai][bj][m][0], v1 = acc[ai][bj][m][1];
                    if (cscale) { v0 = v0 * *(const f32x4*)(cscale + col); v1 = v1 * *(const f32x4*)(cscale + col + 4); }
                    if (BF32) { v0 = v0 + *(const f32x4*)((const float*)base + off); v1 = v1 + *(const f32x4*)((const float*)base + off + 4); }
                    else { const u32x4 b = *(const u32x4*)((const bf16_t*)base + off);
                        v0.x += __uint_as_float(b.x << 16); v0.y += __uint_as_float(b.x & 0xffff0000u); v0.z += __uint_as_float(b.y << 16); v0.w += __uint_as_float(b.y & 0xffff0000u);
                        v1.x += __uint_as_float(b.z << 16); v1.y += __uint_as_float(b.z & 0xffff0000u); v1.z += __uint_as_float(b.w << 16); v1.w += __uint_as_float(b.w & 0xffff0000u); }
                    st16((xo + off), (u32x4){cvtpk(v0.x, v0.y), cvtpk(v0.z, v0.w), cvtpk(v1.x, v1.y), cvtpk(v1.z, v1.w)});
                    if (ssp) s += ((v0.x * v0.x + v0.y * v0.y) + (v0.z * v0.z + v0.w * v0.w)) + ((v1.x * v1.x + v1.y * v1.y) + (v1.z * v1.z + v1.w * v1.w)); }
                if (ssp) { s += __shfl_xor(s, 16); s += __shfl_xor(s, 32); if (e_fq == 0) part[rl * 4 + c.wc] = s; }
                asm volatile("" ::: "memory"); }
        if (ssp) { WG_BAR();
            if (e_lane < 32) { const int row = c.wid * 32 + e_lane; const f32x4 p4 = *(const LAS f32x4*)(part + row * 4);
                ssp[(size_t)(u.pm * 256 + row) * 8 + u.pn] = (p4.x + p4.y) + (p4.z + p4.w); }
            WG_BAR(); }
    }
};

namespace attn {
using s16x4 = __attribute__((ext_vector_type(4))) short;
using f32x16 = __attribute__((ext_vector_type(16))) float;
constexpr int D = 128, NW = 8, QBLK = 32, KVBLK = 64;
constexpr float SCALE = 0.088388347648318440f;
constexpr float THR = 0.f;
#ifndef ATT_SDEPTH
#define ATT_SDEPTH 1
#endif
constexpr int LDQ = AW, LDK = KVW, LDO = DM;
constexpr size_t SHM_V = KVBLK * D * 2, SHM_K = KVBLK * D * 2, SHM_ATTN = 2 * SHM_V + 2 * SHM_K + NW * 64 * 4;
#define KSWZ(row, colB) ((row) * 256 + ((colB) ^ (((row) & 7) << 4)))
#define SBAR() __builtin_amdgcn_sched_barrier(0)
__device__ __forceinline__ int crow(int r, int hi) { return (r & 3) + 8 * (r >> 2) + 4 * hi; }
__device__ __forceinline__ unsigned cvtpk_a(float lo, float hi) { unsigned r; asm volatile("v_cvt_pk_bf16_f32 %0, %1, %2" : "=v"(r) : "v"(lo), "v"(hi)); return r; }
__device__ __forceinline__ void partialSM(f32x16& p0, f32x16& p1, float& m_reg, float& mn, float& alpha) {
  constexpr float C = SCALE * 1.4426950408889634f;
  float pmax = p0[0]; for (int r = 1; r < 16; ++r) pmax = fmaxf(pmax, p0[r]); for (int r = 0; r < 16; ++r) pmax = fmaxf(pmax, p1[r]);
  { auto rr = __builtin_amdgcn_permlane32_swap(__float_as_uint(pmax), __float_as_uint(pmax), false, false);
    pmax = fmaxf(__uint_as_float(rr[0]), __uint_as_float(rr[1])); }
  if (__builtin_expect(__all(pmax - m_reg <= THR / SCALE), 1)) { mn = m_reg; alpha = 1.f; }
  else { mn = fmaxf(m_reg, pmax); alpha = __builtin_amdgcn_exp2f((m_reg - mn) * C); m_reg = mn; }
  float mnC = -mn * C;
  for (int r = 0; r < 16; ++r) p0[r] = fmaf(p0[r], C, mnC); for (int r = 0; r < 16; ++r) p1[r] = fmaf(p1[r], C, mnC);
  for (int r = 0; r < 16; ++r) p0[r] = __builtin_amdgcn_exp2f(p0[r]);
}
__device__ __forceinline__ void finishSM(f32x16& p0, f32x16& p1, float alpha, float& l_reg, bf16x8& pa0, bf16x8& pa1, bf16x8& pa2, bf16x8& pa3) {
  for (int r = 0; r < 16; ++r) p1[r] = __builtin_amdgcn_exp2f(p1[r]);
  float ps = 0; for (int r = 0; r < 16; ++r) ps += p0[r]; for (int r = 0; r < 16; ++r) ps += p1[r];
  { auto rr = __builtin_amdgcn_permlane32_swap(__float_as_uint(ps), __float_as_uint(ps), false, false);
    ps = __uint_as_float(rr[0]) + __uint_as_float(rr[1]); }
  l_reg = l_reg * alpha + ps;
#define PK4(P, BASE, OUT) do { unsigned a0 = cvtpk_a(P[BASE + 0], P[BASE + 1]), a1 = cvtpk_a(P[BASE + 2], P[BASE + 3]);   \
    unsigned b0 = cvtpk_a(P[BASE + 4], P[BASE + 5]), b1 = cvtpk_a(P[BASE + 6], P[BASE + 7]);                              \
    auto r0 = __builtin_amdgcn_permlane32_swap(a0, b0, false, false); auto r1 = __builtin_amdgcn_permlane32_swap(a1, b1, false, false); \
    u32x4 w = {r0[0], r1[0], r0[1], r1[1]}; OUT = *reinterpret_cast<bf16x8*>(&w); } while (0)
  PK4(p0, 0, pa0); PK4(p0, 8, pa1); PK4(p1, 0, pa2); PK4(p1, 8, pa3);
#undef PK4
}
__device__ __forceinline__ void qkt(f32x16& p0, f32x16& p1, const bf16_t* Ks, const bf16x8* qr, int r32, int hi) {
  p0 = f32x16{}; p1 = f32x16{};
  for (int d0 = 0; d0 < 8; ++d0) { int cb = (d0 * 16 + hi * 8) * 2;
    bf16x8 b0 = *reinterpret_cast<const bf16x8*>((const char*)Ks + KSWZ(r32, cb));
    bf16x8 b1 = *reinterpret_cast<const bf16x8*>((const char*)Ks + KSWZ(32 + r32, cb));
    p0 = __builtin_amdgcn_mfma_f32_32x32x16_bf16(b0, qr[d0], p0, 0, 0, 0);
    p1 = __builtin_amdgcn_mfma_f32_32x32x16_bf16(b1, qr[d0], p1, 0, 0, 0); }
}
__device__ __forceinline__ int v_st(int k, int c) { const int kk = (k & ~0xC) | ((k & 4) << 1) | ((k & 8) >> 1); return ((kk >> 3) * 4 + (c >> 5)) * 512 + ((kk & 7) * 32 + (c & 31)) * 2; }
__device__ __forceinline__ int v_rd_base(int lane) { return ((lane & 3) << 3) | (((lane >> 2) & 3) << 6) | (((lane >> 4) & 1) << 5) | (((lane >> 5) & 1) << 8); }
constexpr int v_rd_off(int d0, int ks, int half) { return d0 * 512 + ks * 4096 + half * 2048; }
template <int OFF> __device__ __forceinline__ s16x4 tr_read(int vb) {
  s16x4 r; asm volatile("ds_read_b64_tr_b16 %0, %1 offset:%2" : "=&v"(r) : "v"(vb), "i"(OFF) : "memory"); return r;
}
template <int D0> __device__ __forceinline__ void pv_one(f32x16& od, int vb, bf16x8 pa0, bf16x8 pa1, bf16x8 pa2, bf16x8 pa3) {
  const s16x4 l0 = tr_read<v_rd_off(D0, 0, 0)>(vb), h0 = tr_read<v_rd_off(D0, 0, 1)>(vb), l1 = tr_read<v_rd_off(D0, 1, 0)>(vb), h1 = tr_read<v_rd_off(D0, 1, 1)>(vb);
  const s16x4 l2 = tr_read<v_rd_off(D0, 2, 0)>(vb), h2 = tr_read<v_rd_off(D0, 2, 1)>(vb), l3 = tr_read<v_rd_off(D0, 3, 0)>(vb), h3 = tr_read<v_rd_off(D0, 3, 1)>(vb);
  asm volatile("s_waitcnt lgkmcnt(0)" ::: "memory"); SBAR();
#define PK(L, H) (bf16x8){L[0], L[1], L[2], L[3], H[0], H[1], H[2], H[3]}
  od = __builtin_amdgcn_mfma_f32_32x32x16_bf16(pa0, PK(l0, h0), od, 0, 0, 0);
  od = __builtin_amdgcn_mfma_f32_32x32x16_bf16(pa1, PK(l1, h1), od, 0, 0, 0);
  od = __builtin_amdgcn_mfma_f32_32x32x16_bf16(pa2, PK(l2, h2), od, 0, 0, 0);
  od = __builtin_amdgcn_mfma_f32_32x32x16_bf16(pa3, PK(l3, h3), od, 0, 0, 0);
#undef PK
}
__device__ __forceinline__ void pv_d0(f32x16* o, int vb, bf16x8 pa0, bf16x8 pa1, bf16x8 pa2, bf16x8 pa3) {
  pv_one<0>(o[0], vb, pa0, pa1, pa2, pa3); pv_one<1>(o[1], vb, pa0, pa1, pa2, pa3); pv_one<2>(o[2], vb, pa0, pa1, pa2, pa3); pv_one<3>(o[3], vb, pa0, pa1, pa2, pa3);
}
__device__ __forceinline__ void attn_dense_body(const bf16_t* __restrict__ Qb, const bf16_t* __restrict__ Kh, const bf16_t* __restrict__ Vh,
                                                bf16_t* __restrict__ Ob, int seq, char* lds, const int wave_) {
  constexpr int SDEPTH = ATT_SDEPTH;
  const int lane = lane_id(), wid = wave_, tid = wid * 64 + lane, r32 = lane & 31, hi = lane >> 5;
  bf16_t* V_lds = (bf16_t*)lds; bf16_t* K_lds = (bf16_t*)(lds + 2 * SHM_V);
  float* ws = (float*)(lds + 2 * SHM_V + 2 * SHM_K) + wid * 64; float* li_l = ws; float* al_l = ws + 32;
  float m_reg = -1e30f, l_reg = 0; f32x16 o[4] = {}; bf16x8 qr[8];
  const bf16_t* Qw = Qb + (long)(wid * QBLK + r32) * LDQ + hi * 8;
#pragma unroll
  for (int d0 = 0; d0 < 8; ++d0) qr[d0] = *reinterpret_cast<const bf16x8*>(Qw + d0 * 16);
  const int sr = tid >> 4, sc = (tid & 15) * 8, vst0 = v_st(sr, sc), vst1 = v_st(32 + sr, sc);
  const int vb0 = (int)(uintptr_t)V_lds + v_rd_base(lane);
  struct { bf16x8 vs0, vs1, ks0, ks1; } sr_[SDEPTH];
#define SLOAD(i, k0) do { sr_[i].vs0 = *reinterpret_cast<const bf16x8*>(&Vh[(long)((k0) + sr) * LDK + sc]); sr_[i].vs1 = *reinterpret_cast<const bf16x8*>(&Vh[(long)((k0) + 32 + sr) * LDK + sc]); \
    sr_[i].ks0 = *reinterpret_cast<const bf16x8*>(&Kh[(long)((k0) + sr) * LDK + sc]); sr_[i].ks1 = *reinterpret_cast<const bf16x8*>(&Kh[(long)((k0) + 32 + sr) * LDK + sc]); } while (0)
#define SWRITE(b, i) do { *(bf16x8*)((char*)V_lds + (b) * SHM_V + vst0) = sr_[i].vs0;          \
    *(bf16x8*)((char*)V_lds + (b) * SHM_V + vst1) = sr_[i].vs1; int kc = sc * 2;               \
    *(bf16x8*)((char*)K_lds + (b) * SHM_K + KSWZ(sr, kc)) = sr_[i].ks0;                       \
    *(bf16x8*)((char*)K_lds + (b) * SHM_K + KSWZ(32 + sr, kc)) = sr_[i].ks1; } while (0)
#define SWAIT() do { if constexpr (SDEPTH == 2) asm volatile("s_waitcnt vmcnt(4)" ::: "memory"); else asm volatile("s_waitcnt vmcnt(0)" ::: "memory"); } while (0)
#define RESC(a) do { if (__any((a) < 1.f)) { if (hi == 0) al_l[r32] = (a); asm volatile("s_waitcnt lgkmcnt(0)" ::: "memory"); \
    for (int d = 0; d < 4; ++d) for (int r = 0; r < 16; ++r) o[d][r] *= al_l[crow(r, hi)]; } } while (0)
  f32x16 pA0, pA1, pB0, pB1; float mnA, mnB, alA, alB; bf16x8 pa0, pa1, pa2, pa3; const int NT = seq / KVBLK;
  constexpr int SE = 0, SO = SDEPTH - 1;
  SLOAD(SE, 0); asm volatile("s_waitcnt vmcnt(0)" ::: "memory"); SWRITE(0, SE); __syncthreads();
  qkt(pA0, pA1, K_lds, qr, r32, hi); partialSM(pA0, pA1, m_reg, mnA, alA);
  SLOAD(SO, KVBLK); if constexpr (SDEPTH == 2) { if (2 < NT) SLOAD(SE, 2 * KVBLK); }
  SWAIT(); SWRITE(1, SO); __syncthreads();
  for (int j = 1; j + 1 < NT; j += 2) {
    SBAR(); qkt(pB0, pB1, (bf16_t*)((char*)K_lds + SHM_K), qr, r32, hi);
    finishSM(pA0, pA1, alA, l_reg, pa0, pa1, pa2, pa3); SBAR();
    SLOAD(SO, (j + SDEPTH) * KVBLK); SBAR();
    pv_d0(o, vb0, pa0, pa1, pa2, pa3); partialSM(pB0, pB1, m_reg, mnB, alB);
    __syncthreads(); SWAIT(); SWRITE(0, SE);
    RESC(alB); __syncthreads();
    SBAR(); qkt(pA0, pA1, K_lds, qr, r32, hi);
    finishSM(pB0, pB1, alB, l_reg, pa0, pa1, pa2, pa3); SBAR();
    if (SDEPTH == 1 || j + 3 < NT) SLOAD(SE, (j + 1 + SDEPTH) * KVBLK); SBAR();
    pv_d0(o, vb0 + (int)SHM_V, pa0, pa1, pa2, pa3); partialSM(pA0, pA1, m_reg, mnA, alA);
    __syncthreads(); SWAIT(); SWRITE(1, SO);
    RESC(alA); __syncthreads();
  }
  SBAR(); qkt(pB0, pB1, (bf16_t*)((char*)K_lds + SHM_K), qr, r32, hi);
  finishSM(pA0, pA1, alA, l_reg, pa0, pa1, pa2, pa3); SBAR();
  pv_d0(o, vb0, pa0, pa1, pa2, pa3); partialSM(pB0, pB1, m_reg, mnB, alB);
  __syncthreads(); RESC(alB);
  finishSM(pB0, pB1, alB, l_reg, pa0, pa1, pa2, pa3); SBAR();
  pv_d0(o, vb0 + (int)SHM_V, pa0, pa1, pa2, pa3);
  if (hi == 0) li_l[r32] = l_reg; asm volatile("s_waitcnt lgkmcnt(0)" ::: "memory");
  float rli[16];
#pragma unroll
  for (int r = 0; r < 16; ++r) rli[r] = __builtin_amdgcn_rcpf(li_l[crow(r, hi)]);
  bf16_t* Ow = Ob + (long)(wid * QBLK) * LDO;
#pragma unroll
  for (int r = 0; r < 16; ++r) { int orow = crow(r, hi);
    for (int d0 = 0; d0 < 4; ++d0) Ow[(long)orow * LDO + d0 * 32 + r32] = (bf16_t)(cvtpk(o[d0][r] * rli[r], 0.f) & 0xffffu); }
#undef SLOAD
#undef SWRITE
#undef SWAIT
#undef RESC
  __syncthreads();
}
#undef KSWZ
#undef SBAR
}

struct AddrLin { bf16_t* O; int ld; __device__ __forceinline__ bf16_t* operator()(const pg8::Unit& u, int rl, int tc) const { return O + (size_t)(u.pm * 256 + rl) * ld + u.pn * 256 + tc; } };
struct EpiRowScale {
    static constexpr bool PERM = true; bf16_t* O; int ld; const float* ssp; float cscale;
    __device__ __forceinline__ void operator()(f32x4 (&acc)[2][2][4][2], const pg8::Unit& u, const pg8::EpiCtx& c) const { const int e_lane = lane_id(), e_fr = e_lane & 15, e_fq = e_lane >> 4;
        const int hc = c.wc * 32 + e_fq * 8, rl0 = c.wr * 64 + e_fr;
#pragma unroll
        for (int ai = 0; ai < 2; ++ai)
#pragma unroll
            for (int m = 0; m < 4; ++m) { const int row = u.pm * 256 + ai * 128 + rl0 + m * 16; const f32x4 p0 = *(const f32x4*)(ssp + (size_t)row * 8), p1 = *(const f32x4*)(ssp + (size_t)row * 8 + 4);
                const float r = rsqrtf((((p0.x + p0.y) + (p0.z + p0.w)) + ((p1.x + p1.y) + (p1.z + p1.w))) * (1.0f / DM) + EPS) * cscale;
#pragma unroll
                for (int bj = 0; bj < 2; ++bj) { const f32x4 v0 = acc[ai][bj][m][0] * r, v1 = acc[ai][bj][m][1] * r;
                    st16((O + (size_t)row * ld + u.pn * 256 + bj * 128 + hc), (u32x4){cvtpk(v0.x, v0.y), cvtpk(v0.z, v0.w), cvtpk(v1.x, v1.y), cvtpk(v1.z, v1.w)}); } }
    }
};
struct EpiSoftmax {
    static constexpr bool PERM = true; bf16_t* P; int ld;
    __device__ __forceinline__ void operator()(f32x4 (&acc)[2][2][4][2], const pg8::Unit& u, const pg8::EpiCtx& c) const { const int e_lane = lane_id(), e_fr = e_lane & 15, e_fq = e_lane >> 4;
        const int hc = c.wc * 32 + e_fq * 8, rl0 = c.wr * 64 + e_fr;
        LAS float* pmx = (LAS float*)c.xl; LAS float* psm = pmx + 1024;
#pragma unroll
        for (int ai = 0; ai < 2; ++ai)
#pragma unroll
            for (int m = 0; m < 4; ++m) { float mx = -3.0e38f;
#pragma unroll
                for (int bj = 0; bj < 2; ++bj)
#pragma unroll
                    for (int n = 0; n < 2; ++n) { const f32x4 v = acc[ai][bj][m][n]; mx = fmaxf(fmaxf(mx, fmaxf(v.x, v.y)), fmaxf(v.z, v.w)); }
                mx = fmaxf(mx, __shfl_xor(mx, 16)); mx = fmaxf(mx, __shfl_xor(mx, 32));
                if (e_fq == 0) pmx[(ai * 128 + rl0 + m * 16) * 4 + c.wc] = mx; }
        WG_BAR();
#pragma unroll
        for (int ai = 0; ai < 2; ++ai)
#pragma unroll
            for (int m = 0; m < 4; ++m) { const int rl = ai * 128 + rl0 + m * 16; const f32x4 p4 = *(const LAS f32x4*)(pmx + rl * 4);
                const float mx = fmaxf(fmaxf(p4.x, p4.y), fmaxf(p4.z, p4.w)) * 1.4426950408889634f; float s = 0.f;
#pragma unroll
                for (int bj = 0; bj < 2; ++bj)
#pragma unroll
                    for (int n = 0; n < 2; ++n) { f32x4 v = acc[ai][bj][m][n];
                        v.x = __builtin_amdgcn_exp2f(fmaf(v.x, 1.4426950408889634f, -mx)); v.y = __builtin_amdgcn_exp2f(fmaf(v.y, 1.4426950408889634f, -mx));
                        v.z = __builtin_amdgcn_exp2f(fmaf(v.z, 1.4426950408889634f, -mx)); v.w = __builtin_amdgcn_exp2f(fmaf(v.w, 1.4426950408889634f, -mx));
                        s += (v.x + v.y) + (v.z + v.w); acc[ai][bj][m][n] = v; }
                s += __shfl_xor(s, 16); s += __shfl_xor(s, 32);
                if (e_fq == 0) psm[rl * 4 + c.wc] = s; }
        WG_BAR();
#pragma unroll
        for (int ai = 0; ai < 2; ++ai)
#pragma unroll
            for (int m = 0; m < 4; ++m) { const int rl = ai * 128 + rl0 + m * 16; const f32x4 p4 = *(const LAS f32x4*)(psm + rl * 4);
                const float inv = 1.0f / ((p4.x + p4.y) + (p4.z + p4.w));
#pragma unroll
                for (int bj = 0; bj < 2; ++bj) { const f32x4 v0 = acc[ai][bj][m][0] * inv, v1 = acc[ai][bj][m][1] * inv;
                    st16((P + (size_t)(u.pm * 256 + rl) * ld + u.pn * 256 + bj * 128 + hc), (u32x4){cvtpk(v0.x, v0.y), cvtpk(v0.z, v0.w), cvtpk(v1.x, v1.y), cvtpk(v1.z, v1.w)}); } }
        WG_BAR();
    }
};
struct MapXS { const char* Q; const char* K; __device__ __forceinline__ void operator()(pg8::Unit& u) const {
    u.a = Q + ((size_t)u.pm * 256 * DM + (size_t)u.pn * MHD) * 2; u.b = K + ((size_t)(u.pm >> 3) * MEML * DM + (size_t)u.pn * MHD) * 2; } };
struct MapXPV { const char* P; const char* VT; __device__ __forceinline__ void operator()(pg8::Unit& u) const {
    u.a = P + ((size_t)u.pm * 256 * 1024 + (size_t)(u.pn >> 1) * MEML) * 2; u.b = VT + ((size_t)u.pn * 256 * 1024 + (size_t)(u.pm >> 3) * MEML) * 2; } };

struct MapMoE { const char* A; const char* W; size_t as, es, ws_; __device__ __forceinline__ void operator()(pg8::Unit& u) const {
    u.a = A + (size_t)u.pm * as; u.b = W + (size_t)(u.pm >> 2) * es + (size_t)u.pn * ws_; } };
struct EpiSwiGLU {
    static constexpr bool PERM = true; bf16_t* ACT; const float* rs;
    __device__ __forceinline__ void operator()(f32x4 (&acc)[2][2][4][2], const pg8::Unit& u, const pg8::EpiCtx& c) const { const int e_lane = lane_id(), e_fr = e_lane & 15, e_fq = e_lane >> 4;
        const int hc = c.wc * 32 + e_fq * 8, rl0 = c.wr * 64 + e_fr;
#pragma unroll
        for (int ai = 0; ai < 2; ++ai)
#pragma unroll
            for (int m = 0; m < 4; ++m) { f32x4 o[2]; const float rf = rs[u.pm * 256 + ai * 128 + rl0 + m * 16];
#pragma unroll
                for (int n = 0; n < 2; ++n) { const f32x4 g = acc[ai][0][m][n] * rf, up = acc[ai][1][m][n] * rf; f32x4 r;
                    r.x = g.x * __builtin_amdgcn_rcpf(1.0f + __builtin_amdgcn_exp2f(-1.4426950408889634f * g.x)) * up.x; r.y = g.y * __builtin_amdgcn_rcpf(1.0f + __builtin_amdgcn_exp2f(-1.4426950408889634f * g.y)) * up.y;
                    r.z = g.z * __builtin_amdgcn_rcpf(1.0f + __builtin_amdgcn_exp2f(-1.4426950408889634f * g.z)) * up.z; r.w = g.w * __builtin_amdgcn_rcpf(1.0f + __builtin_amdgcn_exp2f(-1.4426950408889634f * g.w)) * up.w; o[n] = r; }
                st16((ACT + (size_t)(u.pm * 256 + ai * 128 + rl0 + m * 16) * EFF + u.pn * 128 + hc), (u32x4){cvtpk(o[0].x, o[0].y), cvtpk(o[0].z, o[0].w), cvtpk(o[1].x, o[1].y), cvtpk(o[1].z, o[1].w)}); }
    }
};
struct EpiRowGate {
    static constexpr bool PERM = true; bf16_t* Y; const float* gate;
    __device__ __forceinline__ void operator()(f32x4 (&acc)[2][2][4][2], const pg8::Unit& u, const pg8::EpiCtx& c) const { const int e_lane = lane_id(), e_fr = e_lane & 15, e_fq = e_lane >> 4;
        const int hc = c.wc * 32 + e_fq * 8, rl0 = c.wr * 64 + e_fr;
#pragma unroll
        for (int ai = 0; ai < 2; ++ai)
#pragma unroll
            for (int m = 0; m < 4; ++m) { const int row = u.pm * 256 + ai * 128 + rl0 + m * 16; const float gt = gate[row];
#pragma unroll
                for (int bj = 0; bj < 2; ++bj) { const f32x4 v0 = acc[ai][bj][m][0] * gt, v1 = acc[ai][bj][m][1] * gt;
                    st16((Y + (size_t)row * DM + u.pn * 256 + bj * 128 + hc), (u32x4){cvtpk(v0.x, v0.y), cvtpk(v0.z, v0.w), cvtpk(v1.x, v1.y), cvtpk(v1.z, v1.w)}); } }
    }
};
__device__ __forceinline__ float rms_row_to_bf16_r(const float* xrow, const float* __restrict__ gain, bf16_t* orow, int lane) {
    const GAS f32x4* xr = (const GAS f32x4*)xrow + lane; const f32x4* gr = (const f32x4*)gain + lane;
    f32x4 v[8]; float s = 0.f;
#pragma unroll
    for (int j = 0; j < 8; ++j) { v[j] = xr[64 * j]; s += (v[j].x * v[j].x + v[j].y * v[j].y) + (v[j].z * v[j].z + v[j].w * v[j].w); }
    const float r = rsqrtf(wave_sum(s) * (1.f / DM) + EPS);
    GAS u32x2* o8 = (GAS u32x2*)orow + lane;
#pragma unroll
    for (int j = 0; j < 8; ++j) { const f32x4 g = gr[64 * j]; u32x2 w; w.x = cvtpk(v[j].x * r * g.x, v[j].y * r * g.y); w.y = cvtpk(v[j].z * r * g.z, v[j].w * r * g.w); o8[64 * j] = w; }
    return r;
}
__device__ __forceinline__ void router_phase(const Frame& F, const bf16_t* x, const float* __restrict__ gain, const float* __restrict__ Wr, float* rrow, float* aff) {
    const int lane = lane_id(), tid = F.wave * 64 + lane;
    LAS f32x4* Wl = (LAS f32x4*)(F.lds + RING_OFF);
    for (int i = tid; i < DM * 4; i += 512) { const int kk = i >> 2, q = i & 3; Wl[q * DM + (kk & 3) * 512 + (kk >> 2)] = *(const f32x4*)(Wr + (size_t)kk * NE + 4 * q); }
    __syncthreads();
    const int gw = (int)blockIdx.x * NWAVES + F.wave, NGW = F.G * NWAVES;
    const f32x4* gr = (const f32x4*)gain + lane;
    for (int rb = gw * 2; rb < NTOK; rb += NGW * 2) {
        f32x4 v0[8], v1[8]; float s0 = 0.f, s1 = 0.f;
        const GAS u32x2* x0 = (const GAS u32x2*)(x + (size_t)rb * DM) + lane; const GAS u32x2* x1 = x0 + DM / 4;
#pragma unroll
        for (int j = 0; j < 8; ++j) { const u32x2 p = x0[64 * j], q = x1[64 * j];
            v0[j] = (f32x4){__uint_as_float(p.x << 16), __uint_as_float(p.x & 0xffff0000u), __uint_as_float(p.y << 16), __uint_as_float(p.y & 0xffff0000u)};
            v1[j] = (f32x4){__uint_as_float(q.x << 16), __uint_as_float(q.x & 0xffff0000u), __uint_as_float(q.y << 16), __uint_as_float(q.y & 0xffff0000u)}; }
#pragma unroll
        for (int j = 0; j < 8; ++j) { s0 += (v0[j].x * v0[j].x + v0[j].y * v0[j].y) + (v0[j].z * v0[j].z + v0[j].w * v0[j].w); s1 += (v1[j].x * v1[j].x + v1[j].y * v1[j].y) + (v1[j].z * v1[j].z + v1[j].w * v1[j].w); }
        const float r0 = rsqrtf(wave_sum(s0) * (1.f / DM) + EPS), r1 = rsqrtf(wave_sum(s1) * (1.f / DM) + EPS);
        if (lane == 0) { rrow[rb] = r0; rrow[rb + 1] = r1; }
        float a[32];
#pragma unroll
        for (int i = 0; i < 32; ++i) a[i] = 0.f;
#pragma unroll
        for (int j = 0; j < 8; ++j) { const f32x4 g = gr[64 * j];
            v0[j] = (f32x4){v0[j].x * r0 * g.x, v0[j].y * r0 * g.y, v0[j].z * r0 * g.z, v0[j].w * r0 * g.w}; v1[j] = (f32x4){v1[j].x * r1 * g.x, v1[j].y * r1 * g.y, v1[j].z * r1 * g.z, v1[j].w * r1 * g.w};
            const float h0[4] = {v0[j].x, v0[j].y, v0[j].z, v0[j].w}, h1[4] = {v1[j].x, v1[j].y, v1[j].z, v1[j].w};
#pragma unroll
            for (int c = 0; c < 4; ++c)
#pragma unroll
                for (int q = 0; q < 4; ++q) { const f32x4 w = Wl[q * DM + c * 512 + lane + 64 * j];
                    a[4 * q + 0] += h0[c] * w.x; a[4 * q + 1] += h0[c] * w.y; a[4 * q + 2] += h0[c] * w.z; a[4 * q + 3] += h0[c] * w.w;
                    a[16 + 4 * q + 0] += h1[c] * w.x; a[16 + 4 * q + 1] += h1[c] * w.y; a[16 + 4 * q + 2] += h1[c] * w.z; a[16 + 4 * q + 3] += h1[c] * w.w; } }
#define RS_STEP(N, MASK) { const bool up_ = (lane & MASK) != 0; _Pragma("unroll") for (int i = 0; i < N; ++i) { const float keep = up_ ? a[i + N] : a[i], send = up_ ? a[i] : a[i + N]; a[i] = keep + __shfl_xor(send, MASK); } }
        RS_STEP(16, 32) RS_STEP(8, 16) RS_STEP(4, 8) RS_STEP(2, 4) RS_STEP(1, 2)
#undef RS_STEP
        const float lg = a[0] + __shfl_xor(a[0], 1); float mx = lg;
        mx = fmaxf(mx, __shfl_xor(mx, 16)); mx = fmaxf(mx, __shfl_xor(mx, 8)); mx = fmaxf(mx, __shfl_xor(mx, 4)); mx = fmaxf(mx, __shfl_xor(mx, 2));
        const float ex = expf(lg - mx); float sm = ex;
        sm += __shfl_xor(sm, 16); sm += __shfl_xor(sm, 8); sm += __shfl_xor(sm, 4); sm += __shfl_xor(sm, 2);
        const int el = lane >> 1, row = rb + (el >> 4), e = el & 15, b = row / SEQ, t = row % SEQ;
        if ((lane & 1) == 0) aff[((size_t)b * NE + e) * SEQ + t] = ex / sm;
    }
    __syncthreads();
}
__device__ __forceinline__ void rank_phase(const Frame& F, const float* aff, int* rank, float* gate, const float* rrow, float* rs, int* gidx) {
    const int lane = lane_id(), tid = F.wave * 64 + lane;
    LAS unsigned* wc = (LAS unsigned*)(F.lds + RING_OFF);
    LAS unsigned* ck = (LAS unsigned*)(F.lds + RING_OFF + 256);
    LAS unsigned* ci = ck + SEQ + 4;
    LAS unsigned* ncp = ci + SEQ + 4;
    for (int be = (int)blockIdx.x; be < NB * NE; be += F.G) {
        const int b = be >> 4, e = be & 15;
        unsigned k[4];
#pragma unroll
        for (int j = 0; j < 4; ++j) k[j] = __float_as_uint(aff[(size_t)be * SEQ + tid + 512 * j]);
        unsigned lo = 0u, hi = 0x3F800001u;
        if (tid == 0) ncp[0] = 0u;
        for (int it = 0; it < 40; ++it) {
            const unsigned mid = lo + ((hi - lo) >> 1); if (mid == lo) break;
            const int ws_ = __popcll(__ballot(k[0] >= mid)) + __popcll(__ballot(k[1] >= mid)) + __popcll(__ballot(k[2] >= mid)) + __popcll(__ballot(k[3] >= mid));
            if (lane == 0) wc[(it & 1) * 8 + F.wave] = (unsigned)ws_;
            __syncthreads();
            const u32x4 c0 = *(const LAS u32x4*)(wc + (it & 1) * 8), c1 = *(const LAS u32x4*)(wc + (it & 1) * 8 + 4);
            const int c = (int)(((c0.x + c0.y) + (c0.z + c0.w)) + ((c1.x + c1.y) + (c1.z + c1.w)));
            if (c < CAP) hi = mid; else { lo = mid; if (c <= 448) break; }
        }
        const unsigned T = lo;
        __syncthreads();
#pragma unroll
        for (int j = 0; j < 4; ++j) { const bool pred = k[j] >= T; const unsigned long long bal = __ballot(pred);
            const int wcount = __popcll(bal), pre = __popcll(bal & ((1ull << lane) - 1ull));
            unsigned base = 0u; if (lane == 0 && wcount) base = __hip_atomic_fetch_add(ncp, (unsigned)wcount, __ATOMIC_RELAXED, __HIP_MEMORY_SCOPE_WORKGROUP);
            base = (unsigned)__builtin_amdgcn_readfirstlane((int)base);
            if (pred) { ck[base + pre] = k[j]; ci[base + pre] = (unsigned)(tid + 512 * j); } else rank[(size_t)be * SEQ + tid + 512 * j] = CAP; }
        __syncthreads();
        const int nc = (int)ncp[0];
        if (tid < 4) { ck[nc + tid] = 0u; ci[nc + tid] = 0x7fffffffu; }
        __syncthreads();
        const int nc4 = (nc + 3) >> 2;
        for (int i = tid; i < nc; i += 512) { const unsigned kk = ck[i]; const int tt = (int)ci[i]; int cnt = 0;
#pragma unroll 4
            for (int m = 0; m < nc4; ++m) { const u32x4 km = ((const LAS u32x4*)ck)[m]; const u32x4 tm = ((const LAS u32x4*)ci)[m];
                cnt += ((km.x > kk || (km.x == kk && (int)tm.x < tt)) ? 1 : 0) + ((km.y > kk || (km.y == kk && (int)tm.y < tt)) ? 1 : 0)
                     + ((km.z > kk || (km.z == kk && (int)tm.z < tt)) ? 1 : 0) + ((km.w > kk || (km.w == kk && (int)tm.w < tt)) ? 1 : 0); }
            const int r = cnt < CAP ? cnt : CAP; rank[(size_t)be * SEQ + tt] = r;
            if (r < CAP) { const int sl = (e * 4 + b) * CAP + r; gate[sl] = __uint_as_float(kk); gidx[sl] = b * SEQ + tt; rs[sl] = rrow[b * SEQ + tt]; } }
        __syncthreads();
    }
}
__device__ __forceinline__ void combine_phase(const Frame& F, const bf16_t* xin, bf16_t* xo, float* fout, const bf16_t* Y, const int* rank, const float* __restrict__ gain, bf16_t* HNo, bool final_) {
    const int lane = lane_id();
    const int gw = (int)blockIdx.x * NWAVES + F.wave, NGW = F.G * NWAVES;
    for (int row = gw; row < NTOK; row += NGW) {
        const int b = row / SEQ, t = row % SEQ;
        int rk = CAP; if (lane < NE) rk = rank[((size_t)b * NE + lane) * SEQ + t];
        const GAS u32x2* xi = (const GAS u32x2*)(xin + (size_t)row * DM) + lane; f32x4 v[8];
#pragma unroll
        for (int j = 0; j < 8; ++j) { const u32x2 p = xi[64 * j]; v[j] = (f32x4){__uint_as_float(p.x << 16), __uint_as_float(p.x & 0xffff0000u), __uint_as_float(p.y << 16), __uint_as_float(p.y & 0xffff0000u)}; }
#pragma unroll
        for (int e = 0; e < NE; ++e) { const int r = __builtin_amdgcn_readlane(rk, e);
            if (r < CAP) { const u32x2* yr = (const u32x2*)(Y + ((size_t)(e * 4 + b) * CAP + r) * DM) + lane;
#pragma unroll
                for (int j = 0; j < 8; ++j) { const u32x2 w = yr[64 * j]; v[j].x += __uint_as_float(w.x << 16); v[j].y += __uint_as_float(w.x & 0xffff0000u); v[j].z += __uint_as_float(w.y << 16); v[j].w += __uint_as_float(w.y & 0xffff0000u); } } }
        float s = 0.f;
#pragma unroll
        for (int j = 0; j < 8; ++j) s += (v[j].x * v[j].x + v[j].y * v[j].y) + (v[j].z * v[j].z + v[j].w * v[j].w);
        const float r = rsqrtf(wave_sum(s) * (1.f / DM) + EPS); const f32x4* gr = (const f32x4*)gain + lane;
        if (final_) { GAS f32x4* fo = (GAS f32x4*)(fout + (size_t)row * DM) + lane;
#pragma unroll
            for (int j = 0; j < 8; ++j) { const f32x4 g = gr[64 * j]; fo[64 * j] = (f32x4){v[j].x * r * g.x, v[j].y * r * g.y, v[j].z * r * g.z, v[j].w * r * g.w}; }
        } else { GAS u32x2* o8 = (GAS u32x2*)(HNo + (size_t)row * DM) + lane; GAS u32x2* x8 = (GAS u32x2*)(xo + (size_t)row * DM) + lane;
#pragma unroll
            for (int j = 0; j < 8; ++j) { const f32x4 g = gr[64 * j]; x8[64 * j] = (u32x2){cvtpk(v[j].x, v[j].y), cvtpk(v[j].z, v[j].w)}; o8[64 * j] = (u32x2){cvtpk(v[j].x * r * g.x, v[j].y * r * g.y), cvtpk(v[j].z * r * g.z, v[j].w * r * g.w)}; } }
    }
}
struct MapPool { const char* A; const char* W; __device__ __forceinline__ void operator()(pg8::Unit& u) const {
    u.a = A + ((size_t)u.pm * 256 * DM + (size_t)(u.pn >> 1) * 512) * 2; u.b = W + ((size_t)(u.pn & 1) * 256 * DM + (size_t)(u.pn >> 1) * 512) * 2; } };
template <int W> __device__ __forceinline__ void pool_item4(const bf16_t* H, bf16_t* P, int row0, int c8) {
    const int t0 = row0 & (SEQ - 1); const bf16_t* base = H + (size_t)(row0 - t0) * DM + c8 * 8;
    u32x4 v[W + 3];
#pragma unroll
    for (int i = 0; i < W + 3; ++i) { int j = t0 - W / 2 + i; j = j < 0 ? 0 : (j > SEQ - 1 ? SEQ - 1 : j); v[i] = *(const u32x4*)(base + (size_t)j * DM); }
    float f[W + 3][8];
#pragma unroll
    for (int i = 0; i < W + 3; ++i) { const int j = t0 - W / 2 + i; const float m = (j >= 0 && j < SEQ) ? 1.f : 0.f;
        f[i][0] = m * __uint_as_float(v[i].x << 16); f[i][1] = m * __uint_as_float(v[i].x & 0xffff0000u); f[i][2] = m * __uint_as_float(v[i].y << 16); f[i][3] = m * __uint_as_float(v[i].y & 0xffff0000u);
        f[i][4] = m * __uint_as_float(v[i].z << 16); f[i][5] = m * __uint_as_float(v[i].z & 0xffff0000u); f[i][6] = m * __uint_as_float(v[i].w << 16); f[i][7] = m * __uint_as_float(v[i].w & 0xffff0000u); }
    float s[8];
#pragma unroll
    for (int c = 0; c < 8; ++c) { s[c] = 0.f;
#pragma unroll
        for (int i = 0; i < W; ++i) s[c] += f[i][c]; }
#pragma unroll
    for (int q = 0; q < 4; ++q) { const int t = t0 + q; int lo = t - W / 2, hi = t + W / 2; if (lo < 0) lo = 0; if (hi > SEQ) hi = SEQ; const float inv = 1.0f / (float)(hi - lo);
        if (q > 0) {
#pragma unroll
            for (int c = 0; c < 8; ++c) s[c] += f[q + W - 1][c] - f[q - 1][c]; }
        const float* e = f[q + W / 2];
        *(u32x4*)(P + (size_t)(row0 + q) * DM + c8 * 8) = (u32x4){cvtpk(s[0] * inv - e[0], s[1] * inv - e[1]), cvtpk(s[2] * inv - e[2], s[3] * inv - e[3]), cvtpk(s[4] * inv - e[4], s[5] * inv - e[5]), cvtpk(s[6] * inv - e[6], s[7] * inv - e[7])}; }
}
__device__ __forceinline__ void pool_phase(const Frame& F, const bf16_t* H, bf16_t* P) {
    const int lane = lane_id(); const int gwv = (int)blockIdx.x * NWAVES + F.wave, NWV = F.G * NWAVES;
    for (int wi = gwv; wi < NTOK; wi += NWV) {
        const int row0 = (wi >> 2) * 4, g = wi & 3, c8 = g * 64 + lane;
        if (g == 0) pool_item4<2>(H, P, row0, c8); else if (g == 1) pool_item4<4>(H, P, row0, c8); else if (g == 2) pool_item4<8>(H, P, row0, c8); else pool_item4<16>(H, P, row0, c8);
    }
}

constexpr int N_PHASES = 24;
#ifndef MK_N_LAUNCHES
#define MK_N_LAUNCHES 1
#endif
#ifndef REP_MASK
#define REP_MASK 0
#endif
__global__ void __launch_bounds__(NWAVES * 64, 2) skel_fwd(Args args) {
    extern __shared__ __attribute__((aligned(16))) unsigned char lds_raw[];
    Frame F;
    F.lds = (LAS unsigned char*)lds_raw; F.MISC = (volatile LAS unsigned*)(F.lds + MISC_OFF);
    F.wave = __builtin_amdgcn_readfirstlane(threadIdx.x >> 6);
    F.G = gridDim.x; { const int bx = blockIdx.x; F.vcu = (F.G % 8 == 0) ? (bx % 8) * (F.G / 8) + bx / 8 : bx; }
    F.ws = nullptr; F.ctl = (gu32*)(uptr(args.ws) + WS_CTL);
    for (int u = threadIdx.x; u < (LDS_BYTES - LDSCTL_OFF) / 4; u += NWAVES * 64) ((LAS unsigned*)(F.lds + LDSCTL_OFF))[u] = 0u;
    __syncthreads();
    const bool multi = (MK_N_LAUNCHES == 1) || (args.ph_hi - args.ph_lo) > 1 || REP_MASK != 0;
    XcdBarrier bar; bar.bar = (unsigned*)(F.ctl + CW_BAR); bar.x = 0; bar.st = nullptr; bar.wave = F.wave;
    if (multi) bar = xcd_barrier_post((unsigned*)(F.ctl + CW_BAR), F.MISC + 8, F.wave);
    const int lo = args.ph_lo, hi = args.ph_hi;
#ifdef REP_RT
    const unsigned rep_mask_ = (unsigned)__builtin_amdgcn_readfirstlane(args.pad);
#endif
#define IN(k) ((MK_N_LAUNCHES == 1) ? ((k) < N_PHASES) : (lo <= (k) && (k) < hi))
#ifdef REP_RT
#define REPBIT(k) ((int)((rep_mask_ >> (k)) & 1u))
#else
#define REPBIT(k) ((int)((((unsigned)REP_MASK) >> (k)) & 1u))
#endif
#define PHASE(k) _Pragma("unroll") for (int rep_ = 0; rep_ < 1 + REPBIT(k); ++rep_)
#define SEAM(k) do { if ((IN(k) && IN((k) + 1)) || rep_ + 1 < 1 + REPBIT(k)) xcd_barrier(bar); } while (0)
    LAS unsigned char* ring = F.lds + RING_OFF; LAS unsigned char* xl = F.lds + XL_OFF;
    const int bx = (int)blockIdx.x, G = F.G;

#define KV_PROJ(l, rotK, rotV) do {   \
            { MapLin mp{(const char*)(ws + WS_MEMNB + (size_t)(l) * NB * MEML * DM * 2), (const char*)(ws + WS_WCK_T + (size_t)(l) * DM * DM * 2), (size_t)256 * DM * 2, (size_t)256 * DM * 2}; \
              pg8::Sched<MapLin> S; S.init(NB * MEML / 256, DM / 256, G, (bx + G - ((rotK) % G)) % G, mp); \
              EpiStore<AddrLin> E{AddrLin{(bf16_t*)(ws + WS_KCB + (size_t)(l) * NB * MEML * DM * 2), DM}}; \
              pg8::gemm_phase<EpiStore<AddrLin>, pg8::Sched<MapLin>, true>(F.wave, ring, xl, DM, DM * 2, DM * 2, S, E); } \
            { MapLin mp{(const char*)(ws + WS_WCV_T + (size_t)(l) * DM * DM * 2), (const char*)(ws + WS_MEMNB + (size_t)(l) * NB * MEML * DM * 2), (size_t)256 * DM * 2, (size_t)256 * DM * 2}; \
              pg8::Sched<MapLin> S; S.init(DM / 256, NB * MEML / 256, G, (bx + G - ((rotV) % G)) % G, mp); \
              EpiStore<AddrLin> E{AddrLin{(bf16_t*)(ws + WS_VTB + (size_t)(l) * NB * MEML * DM * 2), NB * MEML}}; \
              pg8::gemm_phase<EpiStore<AddrLin>, pg8::Sched<MapLin>, true>(F.wave, ring, xl, DM, DM * 2, DM * 2, S, E); } } while (0)
#ifdef EXTRA_BARS
    for (int eb = 0; eb < EXTRA_BARS; ++eb) xcd_barrier(bar);
#endif
    if (IN(0)) PHASE(0) { const karg_t ka = kargs(); unsigned char* const ws = uptr(KWS(ka)); p0_prologue(F, ka, ws); SEAM(0); }
    if (IN(1)) PHASE(1) { const karg_t ka = kargs(); unsigned char* const ws = uptr(KWS(ka));
        {
            MapLin mp{(const char*)(ws + WS_HN), (const char*)(ws + WS_WIN_T), (size_t)256 * DM * 2, (size_t)256 * DM * 2};
            pg8::Sched<MapLin> S; S.init(NTOK / 256, 2560 / 256, G, bx, mp);
            EpiQKV E{(bf16_t*)(ws + WS_QB), (bf16_t*)(ws + WS_KB), (bf16_t*)(ws + WS_VB), KIN(ka, 4), KIN(ka, 5), (const float*)(ws + WS_ROPE), (const float*)(ws + WS_ROPE) + SEQ * 64};
            pg8::gemm_phase<EpiQKV, pg8::Sched<MapLin>, true>(F.wave, ring, xl, DM, DM * 2, DM * 2, S, E); }
        {
            MapLin mp{(const char*)(ws + WS_WF_T), (const char*)(ws + WS_HN), (size_t)256 * DM * 2, (size_t)256 * DM * 2};
            pg8::Sched<MapLin> S; S.init(1024 / 256, NTOK / 256, G, (bx + G - (320 % G)) % G, mp);
            EpiStore<AddrF1> E{AddrF1{(bf16_t*)(ws + WS_FPQ)}};
            pg8::gemm_phase<EpiStore<AddrF1>, pg8::Sched<MapLin>, true>(F.wave, ring, xl, DM, DM * 2, DM * 2, S, E); }
        KV_PROJ(0, 448, 480);
        SEAM(1);
    }
    if (IN(2)) PHASE(2) { const karg_t ka = kargs(); unsigned char* const ws = uptr(KWS(ka));
        const int nF2 = (G > 64) ? 64 : 0;
        if (bx < nF2 || nF2 == 0) {
            MapLin mp{(const char*)(ws + WS_DFT), (const char*)(ws + WS_FPQ), (size_t)256 * 4096 * 2, (size_t)256 * 4096 * 2};
            pg8::Sched<MapLin> S; S.init(8, 8, nF2 ? nF2 : G, bx, mp);
            EpiStore<AddrF2> E{AddrF2{(bf16_t*)(ws + WS_MIXB)}};
            pg8::gemm_phase<EpiStore<AddrF2>, pg8::Sched<MapLin>, true>(F.wave, ring, xl, 4096, 4096 * 2, 4096 * 2, S, E);
        }
        if (bx < nF2) { __syncthreads(); tr_span(F, ka, ws, 1, 7680 + bx * 8 + F.wave, 512, 9); __syncthreads(); }
        if (bx >= nF2) {
            const int a = bx - nF2, cnt = G - nF2, per = (384 + cnt - 1) / cnt, slot = a % 3; int ui = 0;
            for (int uid = a * per; uid < (a + 1) * per && uid < 384; ++uid, ++ui) {
                if (ui == slot) { __syncthreads(); tr_span(F, ka, ws, 1, a * 8 + F.wave, 1536, 5); __syncthreads(); }
                const int qb = uid & 7, hq = (uid >> 3) % NQH, b = uid / (8 * NQH), kvh = hq / 3;
                const bf16_t* Qb = (const bf16_t*)(ws + WS_QB) + ((size_t)b * SEQ + qb * 256) * AW + hq * HD;
                const bf16_t* Kh = (const bf16_t*)(ws + WS_KB) + (size_t)b * SEQ * KVW + kvh * HD;
                const bf16_t* Vh = (const bf16_t*)(ws + WS_VB) + (size_t)b * SEQ * KVW + kvh * HD;
                bf16_t* Ob = (bf16_t*)(ws + WS_MIXB) + ((size_t)b * SEQ + qb * 256) * DM + hq * HD;
                attn::attn_dense_body(Qb, Kh, Vh, Ob, SEQ, (char*)lds_raw + RING_OFF, F.wave);
            }
            if (slot >= ui) { __syncthreads(); tr_span(F, ka, ws, 1, a * 8 + F.wave, 1536, 5); __syncthreads(); }
        }
        SEAM(2);
    }
    if (IN(3)) PHASE(3) { const karg_t ka = kargs(); unsigned char* const ws = uptr(KWS(ka));
        MapLin mp{(const char*)(ws + WS_MIXB), (const char*)(ws + WS_WOUT_T), (size_t)256 * DM * 2, (size_t)256 * DM * 2};
        pg8::Sched<MapLin> S; S.init(NTOK / 256, DM / 256, G, bx, mp);
        EpiResB<true> E{KIN(ka, 0), (bf16_t*)(ws + WS_XB), (float*)(ws + WS_SSP), nullptr};
        pg8::gemm_phase<EpiResB<true>, pg8::Sched<MapLin>, true>(F.wave, ring, xl, DM, DM * 2, DM * 2, S, E);
        SEAM(3);
    }
    {
        constexpr int l = 0; constexpr int pb = l ? 15 : 4;
        if (l == 1) {
            if (IN(13)) PHASE(13) { const karg_t ka = kargs(); unsigned char* const ws = uptr(KWS(ka));
                pool_phase(F, (const bf16_t*)(ws + WS_HN), (bf16_t*)(ws + WS_QCB));
#ifdef PROBE_CONV
                tr_span<TRV>(F, ka, ws, 1, bx * 8 + F.wave, 2048, 6);
#endif
                SEAM(13);
            }
            if (IN(14)) PHASE(14) { const karg_t ka = kargs(); unsigned char* const ws = uptr(KWS(ka));
                MapPool mp{(const char*)(ws + WS_QCB), (const char*)(ws + WS_WP_T)};
                pg8::Sched<MapPool> S; S.init(NTOK / 256, DM / 256, G, bx, mp);
                EpiResB<false> E{(const bf16_t*)(ws + WS_XB), (bf16_t*)(ws + WS_XALT), (float*)(ws + WS_SSP), KIN(ka, 9)};
                pg8::gemm_phase<EpiResB<false>, pg8::Sched<MapPool>, true>(F.wave, ring, xl, 512, DM * 2, DM * 2, S, E);
                SEAM(14);
            }
        }
        if (IN(pb + 0)) PHASE(pb + 0) { const karg_t ka = kargs(); unsigned char* const ws = uptr(KWS(ka));
            MapLin mp{(const char*)(ws + (l == 0 ? WS_XB : WS_XALT)), (const char*)(ws + WS_WCQ_T + (size_t)l * DM * DM * 2), (size_t)256 * DM * 2, (size_t)256 * DM * 2};
            pg8::Sched<MapLin> S; S.init(NTOK / 256, DM / 256, G, bx, mp);
            EpiRowScale E{(bf16_t*)(ws + WS_QCB), DM, (const float*)(ws + WS_SSP), 0.04419417382415922f};
            pg8::gemm_phase<EpiRowScale, pg8::Sched<MapLin>, true>(F.wave, ring, xl, DM, DM * 2, DM * 2, S, E);
            SEAM(pb + 0);
        }
        if (IN(pb + 1)) PHASE(pb + 1) { const karg_t ka = kargs(); unsigned char* const ws = uptr(KWS(ka));
            MapXS mp{(const char*)(ws + WS_QCB), (const char*)(ws + WS_KCB + (size_t)l * NB * MEML * DM * 2)};
            pg8::Sched<MapXS> S; S.init(NTOK / 256, NMH, G, bx, mp);
            EpiSoftmax E{(bf16_t*)(ws + WS_PB), NMH * MEML};
            pg8::gemm_phase<EpiSoftmax, pg8::Sched<MapXS>, true>(F.wave, ring, xl, MHD, DM * 2, DM * 2, S, E);
            if (l == 0) { KV_PROJ(1, 128, 160);
                if (bx < 128) { __syncthreads(); tr_span(F, ka, ws, 2, bx * 8 + F.wave, 1024, 2); }
                else if (bx >= 192) { tr_span(F, ka, ws, 2, 2048 + (bx - 192) * 8 + F.wave, 512, 1); } }
            SEAM(pb + 1);
        }
        if (IN(pb + 2)) PHASE(pb + 2) { const karg_t ka = kargs(); unsigned char* const ws = uptr(KWS(ka));
            MapXPV mp{(const char*)(ws + WS_PB), (const char*)(ws + WS_VTB + (size_t)l * NB * MEML * DM * 2)};
            pg8::Sched<MapXPV> S; S.init(NTOK / 256, DM / 256, G, bx, mp);
            EpiStore<AddrLin> E{AddrLin{(bf16_t*)(ws + WS_MIXB), DM}};
            pg8::gemm_phase<EpiStore<AddrLin>, pg8::Sched<MapXPV>, true>(F.wave, ring, xl, MEML, NMH * MEML * 2, NB * MEML * 2, S, E);
            SEAM(pb + 2);
        }
        if (IN(pb + 3)) PHASE(pb + 3) { const karg_t ka = kargs(); unsigned char* const ws = uptr(KWS(ka));
            MapLin mp{(const char*)(ws + WS_MIXB), (const char*)(ws + WS_WCO_T + (size_t)l * DM * DM * 2), (size_t)256 * DM * 2, (size_t)256 * DM * 2};
            pg8::Sched<MapLin> S; S.init(NTOK / 256, DM / 256, G, bx, mp);
            EpiResB<false> E{(const bf16_t*)(ws + (l == 0 ? WS_XB : WS_XALT)), (bf16_t*)(ws + (l == 0 ? WS_XALT : WS_XB)), nullptr, nullptr};
            pg8::gemm_phase<EpiResB<false>, pg8::Sched<MapLin>, true>(F.wave, ring, xl, DM, DM * 2, DM * 2, S, E);
            SEAM(pb + 3);
        }
        if (IN(pb + 4)) PHASE(pb + 4) { const karg_t ka = kargs(); unsigned char* const ws = uptr(KWS(ka));
            router_phase(F, (const bf16_t*)(ws + (l == 0 ? WS_XALT : WS_XB)), KIN(ka, 16) + l * DM, KIN(ka, 17) + (size_t)l * DM * NE, (float*)(ws + WS_SSP + 512 * 1024), (float*)(ws + WS_AFF));
            SEAM(pb + 4);
        }
        if (IN(pb + 5)) PHASE(pb + 5) { const karg_t ka = kargs(); unsigned char* const ws = uptr(KWS(ka));
            rank_phase(F, (const float*)(ws + WS_AFF), (int*)(ws + WS_RANK), (float*)(ws + WS_GATE), (const float*)(ws + WS_SSP + 512 * 1024), (float*)(ws + WS_SSP + 768 * 1024), (int*)(ws + WS_GATE + 512 * 1024));
            if (l == 0 && bx >= NB * NE) tr_span(F, ka, ws, 2, 2560 + (bx - NB * NE) * 8 + F.wave, 1536, 1);
            SEAM(pb + 5);
        }
        if (IN(pb + 6)) PHASE(pb + 6) { const karg_t ka = kargs(); unsigned char* const ws = uptr(KWS(ka));
            MapMoE mp{(const char*)(ws + (l == 0 ? WS_XALT : WS_XB)), (const char*)(ws + (l ? WS_WGU_T2 : WS_WGU_T)), (size_t)0, (size_t)2048 * DM * 2, (size_t)256 * DM * 2};
            pg8::Sched<MapMoE> S; S.init(NB * NE, 8, G, bx, mp);
            EpiSwiGLU E{(bf16_t*)(ws + WS_ACTB), (const float*)(ws + WS_SSP + 768 * 1024)};
            const bool cfirst = ((bx >> 3) & 1) != 0;
            if (l == 0 && cfirst) { tr_span(F, ka, ws, 2, 4096 + bx * 8 + F.wave, 2048, 2); __syncthreads(); }
            pg8::gemm_phase<EpiSwiGLU, pg8::Sched<MapMoE>, true, true>(F.wave, ring, xl, DM, DM * 2, DM * 2, S, E, (const int*)(ws + WS_GATE + 512 * 1024));
            if (l == 0 && !cfirst) { __syncthreads(); tr_span(F, ka, ws, 2, 4096 + bx * 8 + F.wave, 2048, 2); }
            SEAM(pb + 6);
        }
        if (IN(pb + 7)) PHASE(pb + 7) { const karg_t ka = kargs(); unsigned char* const ws = uptr(KWS(ka));
            MapMoE mp{(const char*)(ws + WS_ACTB), (const char*)(ws + (l ? WS_WD_T2 : WS_WD_T)), (size_t)256 * EFF * 2, (size_t)2048 * EFF * 2, (size_t)256 * EFF * 2};
            pg8::Sched<MapMoE> S; S.init(NB * NE, 8, G, bx, mp);
            EpiRowGate E{(bf16_t*)(ws + WS_YB), (const float*)(ws + WS_GATE)};
            const bool cfirst = ((bx >> 3) & 1) == 0;
            if (l == 0 && cfirst) { tr_span(F, ka, ws, 2, 8192 + bx * 8 + F.wave, 2048, 2); __syncthreads(); }
            pg8::gemm_phase<EpiRowGate, pg8::Sched<MapMoE>, true>(F.wave, ring, xl, EFF, EFF * 2, EFF * 2, S, E);
            if (l == 0 && !cfirst) { __syncthreads(); tr_span(F, ka, ws, 2, 8192 + bx * 8 + F.wave, 2048, 2); }
            SEAM(pb + 7);
        }
        if (IN(pb + 8)) PHASE(pb + 8) { const karg_t ka = kargs(); unsigned char* const ws = uptr(KWS(ka));
            combine_phase(F, (const bf16_t*)(ws + (l == 0 ? WS_XALT : WS_XB)), (bf16_t*)(ws + WS_XB), KOUT(ka), (const bf16_t*)(ws + WS_YB), (const int*)(ws + WS_RANK), l == 0 ? KIN(ka, 2) + DM : KIN(ka, 21), (bf16_t*)(ws + WS_HN), l == 1);
            SEAM(pb + 8);
        }
    }
    {
        constexpr int l = 1; constexpr int pb = l ? 15 : 4;
        if (l == 1) {
            if (IN(13)) PHASE(13) { const karg_t ka = kargs(); unsigned char* const ws = uptr(KWS(ka));
                pool_phase(F, (const bf16_t*)(ws + WS_HN), (bf16_t*)(ws + WS_QCB));
#ifdef PROBE_CONV
                tr_span<TRV>(F, ka, ws, 1, bx * 8 + F.wave, 2048, 6);
#endif
                SEAM(13);
            }
            if (IN(14)) PHASE(14) { const karg_t ka = kargs(); unsigned char* const ws = uptr(KWS(ka));
                MapPool mp{(const char*)(ws + WS_QCB), (const char*)(ws + WS_WP_T)};
                pg8::Sched<MapPool> S; S.init(NTOK / 256, DM / 256, G, bx, mp);
                EpiResB<false> E{(const bf16_t*)(ws + WS_XB), (bf16_t*)(ws + WS_XALT), (float*)(ws + WS_SSP), KIN(ka, 9)};
                pg8::gemm_phase<EpiResB<false>, pg8::Sched<MapPool>, true>(F.wave, ring, xl, 512, DM * 2, DM * 2, S, E);
                SEAM(14);
            }
        }
        if (IN(pb + 0)) PHASE(pb + 0) { const karg_t ka = kargs(); unsigned char* const ws = uptr(KWS(ka));
            MapLin mp{(const char*)(ws + (l == 0 ? WS_XB : WS_XALT)), (const char*)(ws + WS_WCQ_T + (size_t)l * DM * DM * 2), (size_t)256 * DM * 2, (size_t)256 * DM * 2};
            pg8::Sched<MapLin> S; S.init(NTOK / 256, DM / 256, G, bx, mp);
            EpiRowScale E{(bf16_t*)(ws + WS_QCB), DM, (const float*)(ws + WS_SSP), 0.04419417382415922f};
            pg8::gemm_phase<EpiRowScale, pg8::Sched<MapLin>, true>(F.wave, ring, xl, DM, DM * 2, DM * 2, S, E);
            SEAM(pb + 0);
        }
        if (IN(pb + 1)) PHASE(pb + 1) { const karg_t ka = kargs(); unsigned char* const ws = uptr(KWS(ka));
            MapXS mp{(const char*)(ws + WS_QCB), (const char*)(ws + WS_KCB + (size_t)l * NB * MEML * DM * 2)};
            pg8::Sched<MapXS> S; S.init(NTOK / 256, NMH, G, bx, mp);
            EpiSoftmax E{(bf16_t*)(ws + WS_PB), NMH * MEML};
            pg8::gemm_phase<EpiSoftmax, pg8::Sched<MapXS>, true>(F.wave, ring, xl, MHD, DM * 2, DM * 2, S, E);
            if (l == 0) { KV_PROJ(1, 128, 160);
                if (bx < 128) { __syncthreads(); tr_span(F, ka, ws, 2, bx * 8 + F.wave, 1024, 2); }
                else if (bx >= 192) { tr_span(F, ka, ws, 2, 2048 + (bx - 192) * 8 + F.wave, 512, 1); } }
            SEAM(pb + 1);
        }
        if (IN(pb + 2)) PHASE(pb + 2) { const karg_t ka = kargs(); unsigned char* const ws = uptr(KWS(ka));
            MapXPV mp{(const char*)(ws + WS_PB), (const char*)(ws + WS_VTB + (size_t)l * NB * MEML * DM * 2)};
            pg8::Sched<MapXPV> S; S.init(NTOK / 256, DM / 256, G, bx, mp);
            EpiStore<AddrLin> E{AddrLin{(bf16_t*)(ws + WS_MIXB), DM}};
            pg8::gemm_phase<EpiStore<AddrLin>, pg8::Sched<MapXPV>, true>(F.wave, ring, xl, MEML, NMH * MEML * 2, NB * MEML * 2, S, E);
            SEAM(pb + 2);
        }
        if (IN(pb + 3)) PHASE(pb + 3) { const karg_t ka = kargs(); unsigned char* const ws = uptr(KWS(ka));
            MapLin mp{(const char*)(ws + WS_MIXB), (const char*)(ws + WS_WCO_T + (size_t)l * DM * DM * 2), (size_t)256 * DM * 2, (size_t)256 * DM * 2};
            pg8::Sched<MapLin> S; S.init(NTOK / 256, DM / 256, G, bx, mp);
            EpiResB<false> E{(const bf16_t*)(ws + (l == 0 ? WS_XB : WS_XALT)), (bf16_t*)(ws + (l == 0 ? WS_XALT : WS_XB)), nullptr, nullptr};
            pg8::gemm_phase<EpiResB<false>, pg8::Sched<MapLin>, true>(F.wave, ring, xl, DM, DM * 2, DM * 2, S, E);
            SEAM(pb + 3);
        }
        if (IN(pb + 4)) PHASE(pb + 4) { const karg_t ka = kargs(); unsigned char* const ws = uptr(KWS(ka));
            router_phase(F, (const bf16_t*)(ws + (l == 0 ? WS_XALT : WS_XB)), KIN(ka, 16) + l * DM, KIN(ka, 17) + (size_t)l * DM * NE, (float*)(ws + WS_SSP + 512 * 1024), (float*)(ws + WS_AFF));
            SEAM(pb + 4);
        }
        if (IN(pb + 5)) PHASE(pb + 5) { const karg_t ka = kargs(); unsigned char* const ws = uptr(KWS(ka));
            rank_phase(F, (const float*)(ws + WS_AFF), (int*)(ws + WS_RANK), (float*)(ws + WS_GATE), (const float*)(ws + WS_SSP + 512 * 1024), (float*)(ws + WS_SSP + 768 * 1024), (int*)(ws + WS_GATE + 512 * 1024));
            if (l == 0 && bx >= NB * NE) tr_span(F, ka, ws, 2, 2560 + (bx - NB * NE) * 8 + F.wave, 1536, 1);
            SEAM(pb + 5);
        }
        if (IN(pb + 6)) PHASE(pb + 6) { const karg_t ka = kargs(); unsigned char* const ws = uptr(KWS(ka));
            MapMoE mp{(const char*)(ws + (l == 0 ? WS_XALT : WS_XB)), (const char*)(ws + (l ? WS_WGU_T2 : WS_WGU_T)), (size_t)0, (size_t)2048 * DM * 2, (size_t)256 * DM * 2};
            pg8::Sched<MapMoE> S; S.init(NB * NE, 8, G, bx, mp);
            EpiSwiGLU E{(bf16_t*)(ws + WS_ACTB), (const float*)(ws + WS_SSP + 768 * 1024)};
            const bool cfirst = ((bx >> 3) & 1) != 0;
            if (l == 0 && cfirst) { tr_span(F, ka, ws, 2, 4096 + bx * 8 + F.wave, 2048, 2); __syncthreads(); }
            pg8::gemm_phase<EpiSwiGLU, pg8::Sched<MapMoE>, true, true>(F.wave, ring, xl, DM, DM * 2, DM * 2, S, E, (const int*)(ws + WS_GATE + 512 * 1024));
            if (l == 0 && !cfirst) { __syncthreads(); tr_span(F, ka, ws, 2, 4096 + bx * 8 + F.wave, 2048, 2); }
            SEAM(pb + 6);
        }
        if (IN(pb + 7)) PHASE(pb + 7) { const karg_t ka = kargs(); unsigned char* const ws = uptr(KWS(ka));
            MapMoE mp{(const char*)(ws + WS_ACTB), (const char*)(ws + (l ? WS_WD_T2 : WS_WD_T)), (size_t)256 * EFF * 2, (size_t)2048 * EFF * 2, (size_t)256 * EFF * 2};
            pg8::Sched<MapMoE> S; S.init(NB * NE, 8, G, bx, mp);
            EpiRowGate E{(bf16_t*)(ws + WS_YB), (const float*)(ws + WS_GATE)};
            const bool cfirst = ((bx >> 3) & 1) == 0;
            if (l == 0 && cfirst) { tr_span(F, ka, ws, 2, 8192 + bx * 8 + F.wave, 2048, 2); __syncthreads(); }
            pg8::gemm_phase<EpiRowGate, pg8::Sched<MapMoE>, true>(F.wave, ring, xl, EFF, EFF * 2, EFF * 2, S, E);
            if (l == 0 && !cfirst) { __syncthreads(); tr_span(F, ka, ws, 2, 8192 + bx * 8 + F.wave, 2048, 2); }
            SEAM(pb + 7);
        }
        if (IN(pb + 8)) PHASE(pb + 8) { const karg_t ka = kargs(); unsigned char* const ws = uptr(KWS(ka));
            combine_phase(F, (const bf16_t*)(ws + (l == 0 ? WS_XALT : WS_XB)), (bf16_t*)(ws + WS_XB), KOUT(ka), (const bf16_t*)(ws + WS_YB), (const int*)(ws + WS_RANK), l == 0 ? KIN(ka, 2) + DM : KIN(ka, 21), (bf16_t*)(ws + WS_HN), l == 1);
            SEAM(pb + 8);
        }
    }
#undef IN
#undef SEAM
#undef PHASE
#undef KV_PROJ
}


extern "C" void kernel_launch(void* const* d_in, const int* in_sizes, int n_in, void* d_out, int out_size, void* d_ws, size_t ws_size, hipStream_t stream) {
    static int grid = 0;
    if (grid == 0) {
        int dev = 0, cus = 0;
        if (n_in != 22 || out_size != NTOK * DM || ws_size < WS_FAST_END) { fprintf(stderr, "kernel_launch: unexpected shapes (n_in %d out %d ws %zu)\n", n_in, out_size, ws_size); grid = -1; return; }
        if (hipGetDevice(&dev) != hipSuccess || hipDeviceGetAttribute(&cus, hipDeviceAttributeMultiprocessorCount, dev) != hipSuccess) { fprintf(stderr, "device query failed\n"); grid = -1; return; }
        if (hipFuncSetAttribute((const void*)skel_fwd, hipFuncAttributeMaxDynamicSharedMemorySize, LDS_BYTES) != hipSuccess) { fprintf(stderr, "hipFuncSetAttribute failed\n"); grid = -1; return; }
        (void)hipGetLastError();
        grid = cus;
        if (grid != 256) { fprintf(stderr, "kernel_launch: this kernel is laid out for 256 CUs (found %d)\n", cus); grid = -1; return; }
    }
    if (grid < 0) return;
    (void)hipMemsetAsync((char*)d_ws + WS_CTL, 0, 32768, stream);
    Args a{};
    for (int i = 0; i < 22; ++i) a.in[i] = (const float*)d_in[i];
    a.out = (float*)d_out; a.ws = (unsigned char*)d_ws;
#ifdef REP_RT
    a.pad = REP_RT;
#endif
    constexpr int NL = MK_N_LAUNCHES;
    for (int li = 0; li < NL; ++li) {
        a.ph_lo = (N_PHASES * li) / NL; a.ph_hi = (N_PHASES * (li + 1)) / NL; a.li = li;
        hipLaunchKernelGGL(skel_fwd, dim3(grid), dim3(NWAVES * 64), LDS_BYTES, stream, a);
    }
}
```

```cpp
#include <hip/hip_runtime.h>
#include <cstdio>
#include <cstdint>

constexpr int DM = 2048, NB = 4, SEQ = 2048, NTOK = NB * SEQ;
constexpr int HD = 128, NQH = 12, NKVH = 4, AW = NQH * HD, KVW = NKVH * HD, FW = 512, INW = 3072;
constexpr int MEML = 256, NMH = 4, MHD = 512;
constexpr int NE = 16, EFF = 1024, CAP = 256;
constexpr float EPS = 1e-6f;

#define LAS __attribute__((address_space(3)))
#define GAS __attribute__((address_space(1)))
typedef unsigned short bf16_t;
typedef short bf16x8 __attribute__((ext_vector_type(8)));
typedef float f32x4 __attribute__((ext_vector_type(4)));
typedef float f32x2 __attribute__((ext_vector_type(2)));
typedef unsigned u32x4 __attribute__((ext_vector_type(4)));
typedef unsigned u32x2 __attribute__((ext_vector_type(2)));
typedef __bf16 bf16x2_t __attribute__((ext_vector_type(2)));
__device__ __forceinline__ unsigned cvtpk(float lo, float hi) { f32x2 v = {lo, hi}; bf16x2_t b = __builtin_convertvector(v, bf16x2_t); return __builtin_bit_cast(unsigned, b); }
__device__ __forceinline__ float bf2f(unsigned short h) { return __uint_as_float(((unsigned)h) << 16); }
template <class T> __device__ __forceinline__ T* uptr(T* p) { const unsigned long long v = (unsigned long long)p; const unsigned lo = __builtin_amdgcn_readfirstlane((unsigned)v), hi = __builtin_amdgcn_readfirstlane((unsigned)(v >> 32)); return (T*)(((unsigned long long)hi << 32) | lo); }
__device__ __forceinline__ int lane_id() { int l = (int)__builtin_amdgcn_mbcnt_hi(~0u, __builtin_amdgcn_mbcnt_lo(~0u, 0u)); asm volatile("" : "+v"(l)); return l; }
typedef __attribute__((address_space(4))) const unsigned char* karg_t;
__device__ __forceinline__ karg_t kargs() { karg_t p = (karg_t)__builtin_amdgcn_kernarg_segment_ptr(); asm volatile("" : "+s"(p)); return p; }
#define KIN(ka, i) (*(const float* const __attribute__((address_space(4)))*)((ka) + 8 * (i)))
#define KOUT(ka) (*(float* const __attribute__((address_space(4)))*)((ka) + 176))
#define KWS(ka) (*(unsigned char* const __attribute__((address_space(4)))*)((ka) + 184))
#ifndef EPI_WT
#define EPI_WT 0
#endif
__device__ __forceinline__ void st16(void* p, u32x4 v) {
#if EPI_WT
    asm volatile("global_store_dwordx4 %0, %1, off sc1\n\ts_nop 1" :: "v"(p), "v"(v) : "memory");
#else
    *(u32x4*)p = v;
#endif
}
#define LDS_WAIT() asm volatile("s_waitcnt lgkmcnt(0)" ::: "memory")
#define VM_WAIT() asm volatile("s_waitcnt vmcnt(0)" ::: "memory")
#define WG_BAR() do { asm volatile("s_waitcnt lgkmcnt(0)" ::: "memory"); __builtin_amdgcn_s_barrier(); asm volatile("" ::: "memory"); } while (0)

namespace pg8 {
constexpr int BM = 256, BK = 64, HALF = 128, HTB = HALF * BK * 2, STAGE_BYTES = 8 * HTB, NXCD = 8, WGM = 8;
__host__ __device__ __forceinline__ int lds_byte(int r, int c) { const int st = (r >> 4) * 2 + (c >> 5), rr = r & 15, cc = c & 31, ob = rr * 64 + cc * 2; return st * 1024 + (ob ^ (((ob >> 9) & 1) << 5)); }
__host__ __device__ __forceinline__ void stage_rc(int b, int& R, int& C) { const int st = b / 1024, sb = b % 1024, swz = sb ^ (((sb >> 9) & 1) << 5); R = (st >> 1) * 16 + swz / 64; C = (st & 1) * 32 + (swz % 64) / 2; }
__host__ __device__ __forceinline__ int perm32(int rho) { const int n = rho >> 4, i = rho & 15; return 8 * (i >> 2) + 4 * n + (i & 3); }

struct Unit { int pm, pn; const char* a; const char* b; };
struct EpiCtx { int wr, wc, wid; LAS unsigned char* xl; };

template <class Map> struct Sched {
    int nM, nN, nwg, G, c; Map map;
    __device__ __forceinline__ void init(int nM_, int nN_, int G_, int c_, const Map& m) { nM = nM_; nN = nN_; nwg = nM * nN; G = G_; c = c_; map = m; }
    __device__ __forceinline__ bool next(int i, Unit& u) const {
        const long L = (long)i * G + c; if (L >= nwg) return false;
        int wgid = (int)L; { const int q = nwg / NXCD, r = nwg % NXCD, xcd = wgid % NXCD, off = wgid / NXCD; wgid = (xcd < r ? xcd * (q + 1) : r * (q + 1) + (xcd - r) * q) + off; }
        const int nig = WGM * nN, gid = wgid / nig, fm = gid * WGM, gsz = (nM - fm) < WGM ? (nM - fm) : WGM;
        u.pm = fm + ((wgid % nig) % gsz); u.pn = (wgid % nig) / gsz; map(u); return true;
    }
};

template <class Epi, class SchedT, bool SP2, bool GATHER = false>
__device__ __forceinline__ void gemm_phase(const int wave_, LAS unsigned char* lds, LAS unsigned char* xl, const int K, const int lda, const int ldb, const SchedT& S, const Epi& E, const int* gidx = nullptr) {
    constexpr bool ALIGN_EPI = true; static_assert(SP2 || !GATHER, "GATHER needs the SP2 loop");
    const int lane = lane_id(), wid = wave_, tid = wid * 64 + lane, wr = wid >> 2, wc = wid & 3, fr = lane & 15, fq = lane >> 4;
    const int nt = K / BK;
    unsigned voffA[2], voffB[2];
#pragma unroll
    for (int i = 0; i < 2; ++i) { int R, C; stage_rc(tid * 16 + i * 8192, R, C); const int Rb = Epi::PERM ? ((R & ~31) + perm32(R & 31)) : R;
        voffA[i] = (unsigned)(R * lda + C * 2); voffB[i] = (unsigned)(Rb * ldb + C * 2); }
    const size_t kstep = (size_t)(BK * 2);
    const size_t hstepA = (size_t)HALF * lda, hstepB = (size_t)HALF * ldb;
    const unsigned ldsw = (unsigned)wid * 1024u;
    const int aoff = lds_byte(wr * 64 + fr, fq * 8), boff = lds_byte(wc * 32 + fr, fq * 8);
    const unsigned xoffA = (unsigned)tid * 16u;
    int gset = 0;
#define PG8_GSETUP(set, pm_) do { if constexpr (GATHER) { int R0_, C0_, R1_, C1_; stage_rc(tid * 16, R0_, C0_); stage_rc(tid * 16 + 8192, R1_, C1_); \
        const GAS int* gi_ = (const GAS int*)gidx + (pm_) * 256; const int r00_ = gi_[R0_], r01_ = gi_[R1_], r10_ = gi_[128 + R0_], r11_ = gi_[128 + R1_];     \
        *(LAS u32x4*)(xl + (set) * 8192 + xoffA) = (u32x4){(unsigned)(r00_ * lda + C0_ * 2), (unsigned)(r01_ * lda + C1_ * 2), (unsigned)(r10_ * lda + C0_ * 2), (unsigned)(r11_ * lda + C1_ * 2)}; } } while (0)
#define PG8_SA(b, h) (((b) * 2 + (h)) * HTB)
#define PG8_SB(b, h) ((4 + (b) * 2 + (h)) * HTB)
#define PG8_STAGE(bufoff, gbase, voff) do { _Pragma("unroll") for (int _i = 0; _i < 2; ++_i) \
        __builtin_amdgcn_global_load_lds((const unsigned*)((const char*)(gbase) + (voff)[_i]), (LAS unsigned*)(lds + (bufoff) + ldsw + _i * 8192), 16, 0, 0); } while (0)
#define PG8_GOFF(h_, set_) u32x2 go_ = {0u, 0u}; if constexpr (GATHER) go_ = *(const LAS u32x2*)(xl + (set_) * 8192 + xoffA + (h_) * 8)
#define PG8_STAGE_A(bufoff, gbase, h_, set_) do { if constexpr (GATHER) { \
        __builtin_amdgcn_global_load_lds((const unsigned*)((const char*)(gbase) + go_.x), (LAS unsigned*)(lds + (bufoff) + ldsw), 16, 0, 0); \
        __builtin_amdgcn_global_load_lds((const unsigned*)((const char*)(gbase) + go_.y), (LAS unsigned*)(lds + (bufoff) + ldsw + 8192), 16, 0, 0); } \
      else { PG8_STAGE(bufoff, (const char*)(gbase) + (h_) * hstepA, voffA); } } while (0)
#define PG8_LDA(dst, b, h) do { _Pragma("unroll") for (int m = 0; m < 4; ++m) _Pragma("unroll") for (int k = 0; k < 2; ++k) dst[m][k] = *(const LAS bf16x8*)(lds + PG8_SA(b, h) + aoff + m * 2048 + k * 1024); } while (0)
#define PG8_LDB(dst, b, h) do { _Pragma("unroll") for (int n = 0; n < 2; ++n) _Pragma("unroll") for (int k = 0; k < 2; ++k) dst[n][k] = *(const LAS bf16x8*)(lds + PG8_SB(b, h) + boff + n * 2048 + k * 1024); } while (0)
#define PG8_MMA(ai, bj, At, Bt) do { __builtin_amdgcn_s_setprio(1); _Pragma("unroll") for (int m = 0; m < 4; ++m) _Pragma("unroll") for (int n = 0; n < 2; ++n) _Pragma("unroll") for (int k = 0; k < 2; ++k) \
        acc[ai][bj][m][n] = __builtin_amdgcn_mfma_f32_16x16x32_bf16(Bt[n][k], At[m][k], acc[ai][bj][m][n], 0, 0, 0); __builtin_amdgcn_s_setprio(0); } while (0)
#define PG8_WAIT_V(n) asm volatile("s_waitcnt vmcnt(" #n ")" ::: "memory")
#define PG8_WAIT_L(n) asm volatile("s_waitcnt lgkmcnt(" #n ")" ::: "memory")
#define PG8_BAR __builtin_amdgcn_s_barrier()
#define PG8_SCHED __builtin_amdgcn_sched_barrier(0)
    Unit cur, nxt; int ui = 0;
    if (!S.next(0, cur)) return;
    EpiCtx ctx; ctx.wr = wr; ctx.wc = wc; ctx.wid = wid; ctx.xl = xl;
    f32x4 acc[2][2][4][2];
#pragma unroll
    for (int a = 0; a < 2; ++a)
#pragma unroll
        for (int b = 0; b < 2; ++b)
#pragma unroll
            for (int m = 0; m < 4; ++m)
#pragma unroll
                for (int n = 0; n < 2; ++n) acc[a][b][m][n] = (f32x4){0.f, 0.f, 0.f, 0.f};
    bf16x8 At[4][2], B0[2][2], B1[2][2];
    const char* cA = cur.a; const char* cB = cur.b;
    PG8_GSETUP(0, cur.pm);
    if constexpr (SP2) {
        PG8_STAGE(PG8_SB(0, 0), cB, voffB); PG8_STAGE(PG8_SB(0, 1), cB + hstepB, voffB); { PG8_GOFF(0, 0); PG8_STAGE_A(PG8_SA(0, 0), cA, 0, 0); } { PG8_GOFF(1, 0); PG8_STAGE_A(PG8_SA(0, 1), cA, 1, 0); }
        if (wr == 1) PG8_BAR;
        PG8_WAIT_V(2); PG8_BAR;
        PG8_STAGE(PG8_SB(1, 0), cB + kstep, voffB); { PG8_GOFF(0, 0); PG8_STAGE_A(PG8_SA(1, 0), cA + kstep, 0, 0); } PG8_STAGE(PG8_SB(1, 1), cB + hstepB + kstep, voffB);
        PG8_WAIT_V(6); PG8_BAR;
    } else {
        PG8_STAGE(PG8_SB(0, 0), cB, voffB); PG8_STAGE(PG8_SA(0, 0), cA, voffA); PG8_STAGE(PG8_SB(0, 1), cB + hstepB, voffB); PG8_STAGE(PG8_SA(0, 1), cA + hstepA, voffA);
        if (wr == 1) PG8_BAR;
        PG8_WAIT_V(4); PG8_BAR;
        PG8_STAGE(PG8_SB(1, 0), cB + kstep, voffB); PG8_STAGE(PG8_SA(1, 0), cA + kstep, voffA); PG8_STAGE(PG8_SB(1, 1), cB + hstepB + kstep, voffB);
        PG8_WAIT_V(6); PG8_BAR;
    }
    for (;;) {
        const bool has_next = S.next(ui + 1, nxt);
        const char* nA = has_next ? nxt.a : cA; const char* nB = has_next ? nxt.b : cB;
        if (has_next) PG8_GSETUP(gset ^ 1, nxt.pm);
        for (int t = 0; t < nt; t += 2) {
            const bool last = (t == nt - 2);
            const char* a1 = cA + (size_t)(t + 1) * kstep;
            const char* a2 = last ? nA : cA + (size_t)(t + 2) * kstep; const char* b2 = last ? nB : cB + (size_t)(t + 2) * kstep;
            const char* a3 = a2 + kstep; const char* b3 = b2 + kstep;
            const int set2 = (last && has_next) ? (gset ^ 1) : gset;
            if constexpr (SP2) {
            { PG8_GOFF(1, gset); PG8_LDB(B0, 0, 0); PG8_LDB(B1, 0, 1); PG8_SCHED; PG8_LDA(At, 0, 0); PG8_STAGE_A(PG8_SA(1, 1), a1, 1, gset); }
            PG8_WAIT_V(8); PG8_WAIT_L(0); PG8_BAR; PG8_MMA(0, 0, At, B0); PG8_MMA(0, 1, At, B1); PG8_BAR; PG8_SCHED;
            { PG8_GOFF(0, set2); PG8_LDA(At, 0, 1); PG8_STAGE(PG8_SB(0, 0), b2, voffB); PG8_STAGE(PG8_SB(0, 1), b2 + hstepB, voffB); PG8_STAGE_A(PG8_SA(0, 0), a2, 0, set2); }
            PG8_WAIT_V(8); PG8_WAIT_L(0); PG8_BAR; PG8_MMA(1, 0, At, B0); PG8_MMA(1, 1, At, B1); PG8_BAR; PG8_SCHED;
            { PG8_GOFF(1, set2); PG8_LDB(B0, 1, 0); PG8_LDB(B1, 1, 1); PG8_SCHED; PG8_LDA(At, 1, 0); PG8_STAGE_A(PG8_SA(0, 1), a2, 1, set2); }
            PG8_WAIT_V(8); PG8_WAIT_L(0); PG8_BAR; PG8_MMA(0, 0, At, B0); PG8_MMA(0, 1, At, B1); PG8_BAR; PG8_SCHED;
            { PG8_GOFF(0, set2); PG8_LDA(At, 1, 1); PG8_STAGE(PG8_SB(1, 0), b3, voffB); PG8_STAGE(PG8_SB(1, 1), b3 + hstepB, voffB); PG8_STAGE_A(PG8_SA(1, 0), a3, 0, set2); }
            PG8_WAIT_V(8); PG8_WAIT_L(0); PG8_BAR; PG8_MMA(1, 0, At, B0); PG8_MMA(1, 1, At, B1); PG8_BAR; PG8_SCHED;
            } else {
            PG8_LDB(B0, 0, 0); PG8_SCHED; PG8_LDA(At, 0, 0); PG8_STAGE(PG8_SA(1, 1), a1 + hstepA, voffA);
            PG8_WAIT_L(8); PG8_BAR; PG8_WAIT_L(0); PG8_MMA(0, 0, At, B0); PG8_BAR; PG8_SCHED;
            PG8_LDB(B1, 0, 1); PG8_STAGE(PG8_SB(0, 0), b2, voffB);
            PG8_BAR; PG8_WAIT_L(0); PG8_MMA(0, 1, At, B1); PG8_BAR;
            PG8_LDA(At, 0, 1); PG8_STAGE(PG8_SA(0, 0), a2, voffA);
            PG8_BAR; PG8_WAIT_L(0); PG8_MMA(1, 0, At, B0); PG8_BAR; PG8_SCHED;
            PG8_STAGE(PG8_SB(0, 1), b2 + hstepB, voffB);
            PG8_WAIT_V(6); PG8_BAR; PG8_MMA(1, 1, At, B1); PG8_BAR;
            PG8_LDB(B0, 1, 0); PG8_SCHED; PG8_LDA(At, 1, 0); PG8_STAGE(PG8_SA(0, 1), a2 + hstepA, voffA);
            PG8_WAIT_L(8); PG8_BAR; PG8_WAIT_L(0); PG8_MMA(0, 0, At, B0); PG8_BAR; PG8_SCHED;
            PG8_LDB(B1, 1, 1); PG8_STAGE(PG8_SB(1, 0), b3, voffB);
            PG8_BAR; PG8_WAIT_L(0); PG8_MMA(0, 1, At, B1); PG8_BAR;
            PG8_LDA(At, 1, 1); PG8_STAGE(PG8_SA(1, 0), a3, voffA);
            PG8_BAR; PG8_WAIT_L(0); PG8_MMA(1, 0, At, B0); PG8_BAR; PG8_SCHED;
            PG8_STAGE(PG8_SB(1, 1), b3 + hstepB, voffB);
            PG8_WAIT_V(6); PG8_BAR; PG8_MMA(1, 1, At, B1); PG8_BAR;
            }
        }
        if constexpr (ALIGN_EPI) { if (wr == 0) PG8_BAR; }
        E(acc, cur, ctx);
        if (!has_next) break;
#pragma unroll
        for (int a = 0; a < 2; ++a)
#pragma unroll
            for (int b = 0; b < 2; ++b)
#pragma unroll
                for (int m = 0; m < 4; ++m)
#pragma unroll
                    for (int n = 0; n < 2; ++n) acc[a][b][m][n] = (f32x4){0.f, 0.f, 0.f, 0.f};
        cur = nxt; cA = nA; cB = nB; ++ui; gset ^= 1;
        if constexpr (ALIGN_EPI) { if (wr == 1) PG8_BAR; }
    }
    PG8_WAIT_V(0);
    if constexpr (!ALIGN_EPI) { if (wr == 0) PG8_BAR; }
    PG8_BAR;
#undef PG8_SA
#undef PG8_SB
#undef PG8_STAGE
#undef PG8_STAGE_A
#undef PG8_GOFF
#undef PG8_GSETUP
#undef PG8_LDA
#undef PG8_LDB
#undef PG8_MMA
#undef PG8_WAIT_V
#undef PG8_WAIT_L
#undef PG8_BAR
#undef PG8_SCHED
}
}

constexpr size_t MiB = 1u << 20;
constexpr size_t WS_CTL = 0, CTL_ZERO_BYTES = 1 * MiB;
constexpr size_t WS_WIN_T = 1 * MiB, WS_WF_T = 11 * MiB, WS_WOUT_T = 15 * MiB, WS_WCQ_T = 23 * MiB, WS_WCK_T = 39 * MiB, WS_WCV_T = 55 * MiB, WS_WCO_T = 71 * MiB;
constexpr size_t WS_WP_T = 87 * MiB, WS_DFT = 89 * MiB, WS_ROPE = 105 * MiB, WS_WGU_T = 106 * MiB, WS_WD_T = 234 * MiB;
constexpr size_t WS_HN = 298 * MiB, WS_XB = 330 * MiB, WS_QB = 362 * MiB, WS_KB = 386 * MiB, WS_VB = 394 * MiB, WS_FPQ = 402 * MiB, WS_MIXB = 418 * MiB, WS_QCB = 450 * MiB;
constexpr size_t WS_KCB = 482 * MiB, WS_VTB = 490 * MiB, WS_MEMNB = 498 * MiB, WS_PB = 506 * MiB, WS_XSB = 522 * MiB, WS_ACTB = 586 * MiB, WS_YB = 618 * MiB;
constexpr size_t WS_SSP = 682 * MiB, WS_AFF = 683 * MiB, WS_RANK = 684 * MiB, WS_GATE = 685 * MiB, WS_XALT = 686 * MiB, WS_WGU_T2 = 750 * MiB, WS_WD_T2 = 878 * MiB, WS_FAST_END = 942 * MiB;
constexpr int CW_TMO = 0, CW_CODE = 1, CW_BAR = 4096;
constexpr int RING_OFF = 0, RING_BYTES = 131072, XL_OFF = 131072, XL_BYTES = 16384, LDSCTL_OFF = XL_OFF + XL_BYTES, MISC_OFF = LDSCTL_OFF + 320, LDS_BYTES = 149504;
static_assert(MISC_OFF + 128 <= LDS_BYTES, "LDS map");
constexpr int NWAVES = 8;

typedef GAS unsigned gu32;
#define RLX_AGENT __ATOMIC_RELAXED, __HIP_MEMORY_SCOPE_AGENT

#define XB_TMO      128
#define XB_XCNT(j)  (256  + 64 * (j))
#define XB_XSUB(j)  (1280 + 64 * (j))
#define XB_XGEN(j)  (2304 + 64 * (j))
#define XB_TOP      3328
#define XB_TOPGEN   3392
#define XCD_BAR_WORDS 3456
#define XB_SPIN_CAP (1u << 18)
__device__ __forceinline__ unsigned xb_ld(unsigned* p)              { return __hip_atomic_load(p, __ATOMIC_RELAXED, __HIP_MEMORY_SCOPE_AGENT); }
__device__ __forceinline__ unsigned xb_add(unsigned* p, unsigned v) { return __hip_atomic_fetch_add(p, v, __ATOMIC_RELAXED, __HIP_MEMORY_SCOPE_AGENT); }
__device__ __forceinline__ unsigned xb_xcc_id() { return (unsigned)__builtin_amdgcn_s_getreg((3 << 11) | 20) & 0xFu; }
#define XB_SPIN(cond, bar) do { unsigned _sp = 0; while (cond) { __builtin_amdgcn_s_sleep(1); \
    if ((++_sp & 255u) == 0u) { if (xb_ld(&(bar)[XB_TMO])) break; if (_sp > XB_SPIN_CAP) { atomicAdd(&(bar)[XB_TMO], 1u); break; } } } } while (0)
struct XcdBarrier { unsigned* bar; unsigned x; volatile LAS unsigned* st; int wave; };
__device__ __forceinline__ XcdBarrier xcd_barrier_post(unsigned* bar, volatile LAS unsigned* st, int wave) {
    XcdBarrier b; b.bar = bar; b.x = xb_xcc_id(); b.st = st; b.wave = wave;
    if (wave == 0 && lane_id() == 0) (void)xb_add(&bar[XB_XCNT(b.x)], 1u);
    return b;
}
__device__ __forceinline__ void xcd_barrier_complete(unsigned* bar, unsigned x, unsigned& nloc, unsigned& nx) {
    const unsigned G = gridDim.x * gridDim.y * gridDim.z;
    unsigned sum, cnt, mine, sp = 0u;
    for (;;) {
        sum = 0u; cnt = 0u; mine = 0u;
#pragma unroll
        for (unsigned j = 0; j < 16; ++j) { const unsigned c = xb_ld(&bar[XB_XCNT(j)]); sum += c; cnt += (c > 0u) ? 1u : 0u; mine = (j == x) ? c : mine; }
        if (sum == G) break;
        __builtin_amdgcn_s_sleep(1);
        if ((++sp & 255u) == 0u) { if (xb_ld(&bar[XB_TMO])) break; if (sp > XB_SPIN_CAP) { atomicAdd(&bar[XB_TMO], 1u); break; } }
    }
    nloc = mine > 0u ? mine : 1u; nx = cnt > 0u ? cnt : 1u;
}
__device__ __forceinline__ void xcd_barrier(const XcdBarrier& b) {
    asm volatile("s_waitcnt vmcnt(0)" ::: "memory");
    __syncthreads();
    if (b.wave == 0 && lane_id() == 0) {
        unsigned* bar = b.bar;
        __builtin_amdgcn_s_waitcnt(0);
        unsigned nloc = b.st[0], nx = b.st[1];
        if (nloc == 0u) { xcd_barrier_complete(bar, b.x, nloc, nx); b.st[0] = nloc; b.st[1] = nx; }
        const unsigned old = xb_add(&bar[XB_XSUB(b.x)], 1u);
        const unsigned gen = old / nloc;
        if (old + 1u == (gen + 1u) * nloc) {
            __builtin_amdgcn_fence(__ATOMIC_RELEASE, "agent");
            asm volatile("s_waitcnt vmcnt(0)" ::: "memory");
            const unsigned og = xb_add(&bar[XB_TOP], 1u);
            const unsigned tg = og / nx;
            if (og + 1u == (tg + 1u) * nx) xb_add(&bar[XB_TOPGEN], 1u);
            else XB_SPIN(xb_ld(&bar[XB_TOPGEN]) == tg, bar);
            __builtin_amdgcn_fence(__ATOMIC_ACQUIRE, "agent");
            xb_add(&bar[XB_XGEN(b.x)], 1u);
            asm volatile("s_waitcnt vmcnt(0)" ::: "memory");
        } else {
            XB_SPIN(xb_ld(&bar[XB_XGEN(b.x)]) == gen, bar);
            __builtin_amdgcn_fence(__ATOMIC_ACQUIRE, "agent");
            asm volatile("s_waitcnt vmcnt(0)" ::: "memory");
        }
    }
    __syncthreads();
}

struct Args { const float* in[22]; float* out; unsigned char* ws; int ph_lo, ph_hi, li, pad; };
struct Frame {
    LAS unsigned char* lds; volatile LAS unsigned* MISC; gu32* ctl;
    int wave, vcu, G;
    unsigned char* ws;
};
__device__ __forceinline__ float wave_sum(float v) {
#pragma unroll
    for (int o = 1; o < 64; o <<= 1) v += __shfl_xor(v, o);
    return v;
}
struct TrDesc { const float* W; const float* gain; bf16_t* WT; int ldw, ldt, k0, n0; long drow0; };
__device__ __forceinline__ void tr_load(const TrDesc& d, f32x4 (&v)[16], int lane) {
    const int lr = lane >> 4, lc = (lane & 15) * 4;
#pragma unroll
    for (int i = 0; i < 16; ++i) v[i] = __builtin_nontemporal_load((const GAS f32x4*)(d.W + (size_t)(d.k0 + 4 * i + lr) * d.ldw + d.n0 + lc));
}
#ifndef TRV
#define TRV 0
#endif
template <int V> __device__ __forceinline__ void tr_finish(const TrDesc& d, const f32x4 (&v)[16], LAS float* scr, int lane) {
    const int lr = lane >> 4, lc = (lane & 15) * 4;
    if (V == 1) { f32x4 s = v[0]; for (int i = 1; i < 16; ++i) s = s + v[i]; if (s.x == 1.2345e30f) *(GAS f32x4*)(d.WT) = s; return; }
#pragma unroll
    for (int i = 0; i < 16; ++i) { const int kk = 4 * i + lr; f32x4 x = v[i]; if (d.gain) x = x * d.gain[d.k0 + kk];
        LAS float* s = scr + kk * 65 + lc; s[0] = x.x; s[1] = x.y; s[2] = x.z; s[3] = x.w; }
    LDS_WAIT(); asm volatile("" ::: "memory");
    const int c = lane & 7;
#pragma unroll
    for (int j = 0; j < 8; ++j) { const int n = (lane >> 3) + 8 * j; const LAS float* s = scr + (8 * c) * 65 + n;
        u32x4 o; o.x = cvtpk(s[0 * 65], s[1 * 65]); o.y = cvtpk(s[2 * 65], s[3 * 65]); o.z = cvtpk(s[4 * 65], s[5 * 65]); o.w = cvtpk(s[6 * 65], s[7 * 65]);
        if (V == 0 || o.x == 0x12345678u) *(GAS u32x4*)(d.WT + (size_t)(d.drow0 + n) * d.ldt + d.k0 + 8 * c) = o; }
    LDS_WAIT(); asm volatile("" ::: "memory");
}
#ifndef TR_PIPE
#define TR_PIPE 0
#endif
constexpr int TR_DENSE = 32 * 20 + 9 * 32 * 16 + 32 * 4, TR_EXPERT = NE * 768;
__device__ __forceinline__ TrDesc tr_desc(karg_t ka, unsigned char* ws, int it, int mode) {
    TrDesc d; d.gain = nullptr;
    constexpr int I_IN = 32 * 20, I_SQ = 32 * 16;
    if (mode == 0) {
        int r = it;
        if (r < I_IN) { d.W = KIN(ka, 3); d.ldw = INW; d.WT = (bf16_t*)(ws + WS_WIN_T); d.ldt = DM; d.k0 = (r / 20) * 64; d.n0 = (r % 20) * 128; d.drow0 = d.n0; return d; } r -= I_IN;
        if (r < I_SQ) { d.W = KIN(ka, 7); d.ldw = DM; d.WT = (bf16_t*)(ws + WS_WOUT_T); d.ldt = DM; d.k0 = (r / 16) * 64; d.n0 = (r % 16) * 128; d.drow0 = d.n0; return d; } r -= I_SQ;
        if (r < 8 * I_SQ) { const int j = r / I_SQ, q = r % I_SQ, wsel = j >> 1, layer = j & 1;
            d.W = KIN(ka, 12 + wsel) + (size_t)layer * DM * DM; d.ldw = DM; if (wsel == 0) d.gain = KIN(ka, 10) + layer * DM;
            d.WT = (bf16_t*)(ws + (wsel == 0 ? WS_WCQ_T : wsel == 1 ? WS_WCK_T : wsel == 2 ? WS_WCV_T : WS_WCO_T) + (size_t)layer * DM * DM * 2); d.ldt = DM;
            d.k0 = (q / 16) * 64; d.n0 = (q % 16) * 128; d.drow0 = d.n0; return d; } r -= 8 * I_SQ;
        d.W = KIN(ka, 8); d.ldw = 512; d.WT = (bf16_t*)(ws + WS_WP_T); d.ldt = DM; d.k0 = (r / 4) * 64; d.n0 = (r % 4) * 128; d.drow0 = d.n0; return d;
    }
    const int layer = mode - 1;
    const int e = it / 768, r = it % 768; const size_t eo = (size_t)(layer * NE + e);
    if (r < 512) { const int up = r >> 8, q = r & 255, kb = q >> 3, nb = q & 7, n0 = nb * 128;
        d.W = (up ? KIN(ka, 19) : KIN(ka, 18)) + eo * DM * EFF; d.ldw = EFF; d.gain = KIN(ka, 16) + layer * DM;   d.WT = (bf16_t*)(ws + (layer ? WS_WGU_T2 : WS_WGU_T)) + (size_t)e * 2048 * 2048; d.ldt = 2048;
        d.k0 = kb * 64; d.n0 = n0; d.drow0 = (long)(n0 >> 7) * 256 + up * 128;
    } else { const int q = r - 512, kb = q >> 4, nb = q & 15;
        d.W = KIN(ka, 20) + eo * EFF * DM; d.ldw = DM; d.WT = (bf16_t*)(ws + (layer ? WS_WD_T2 : WS_WD_T)) + (size_t)e * 2048 * 1024; d.ldt = 1024; d.k0 = kb * 64; d.n0 = nb * 128; d.drow0 = nb * 128; }
    return d;
}
template <int V = 0> __device__ __forceinline__ void tr_span(const Frame& F, karg_t ka, unsigned char* ws, int mode, int first, int stride, int cnt) {
    const int lane = lane_id(); LAS float* scr = (LAS float*)(F.lds + RING_OFF + F.wave * 16640);
    if (cnt <= 0) return;
    f32x4 va[16], vb[16];
    TrDesc da = tr_desc(ka, ws, first, mode), db = da; db.n0 += 64; db.drow0 += 64;
    tr_load(da, va, lane); tr_load(db, vb, lane);
    for (int j = 0; j < cnt; ++j) {
        const bool more = j + 1 < cnt; TrDesc na = da, nb = db;
        if (more) { na = tr_desc(ka, ws, first + stride * (j + 1), mode); nb = na; nb.n0 += 64; nb.drow0 += 64; }
        tr_finish<V>(da, va, scr, lane); if (more) tr_load(na, va, lane);
        tr_finish<V>(db, vb, scr, lane); if (more) tr_load(nb, vb, lane);
        da = na; db = nb;
    }
}
__device__ __forceinline__ void rms_row_to_bf16(const float* xrow, const float* __restrict__ gain, bf16_t* orow, int lane) {
    const GAS f32x4* xr = (const GAS f32x4*)xrow + lane; const f32x4* gr = (const f32x4*)gain + lane;
    f32x4 v[8]; float s = 0.f;
#pragma unroll
    for (int j = 0; j < 8; ++j) { v[j] = xr[64 * j]; s += (v[j].x * v[j].x + v[j].y * v[j].y) + (v[j].z * v[j].z + v[j].w * v[j].w); }
    const float r = rsqrtf(wave_sum(s) * (1.f / DM) + EPS);
    GAS u32x2* o8 = (GAS u32x2*)orow + lane;
#pragma unroll
    for (int j = 0; j < 8; ++j) { const f32x4 g = gr[64 * j]; u32x2 w; w.x = cvtpk(v[j].x * r * g.x, v[j].y * r * g.y); w.y = cvtpk(v[j].z * r * g.z, v[j].w * r * g.w); o8[64 * j] = w; }
}

__device__ __forceinline__ void p0_prologue(Frame& F, karg_t ka, unsigned char* ws) {
    const float* x = KIN(ka, 0); const float* mem = KIN(ka, 1); const float* mix_norm = KIN(ka, 2); const float* w_in = KIN(ka, 3);
    const float* w_four = KIN(ka, 6); const float* w_out = KIN(ka, 7); const float* pool_w = KIN(ka, 8); const float* cross_norm = KIN(ka, 10); const float* mem_norm = KIN(ka, 11);
    const int gw = F.vcu * NWAVES + F.wave, NGW = F.G * NWAVES;
    const int p_lane = lane_id(), p_tid = F.wave * 64 + p_lane;
    { LAS float* tab = (LAS float*)(F.lds + RING_OFF);
      for (int m = p_tid; m < 2048; m += 512) tab[m] = cosf(6.283185307179586f * (float)m * (1.0f / 2048.0f));
      __syncthreads();
      bf16_t* DFT = (bf16_t*)(ws + WS_DFT);
      for (int row = F.vcu * 8; row < 2048; row += F.G * 8)
          for (int rr = 0; rr < 8; ++rr) { const int k1 = row + rr; if (k1 >= 2048) break;
              { const int c0 = p_tid * 8; const int which = c0 >> 11, s0 = c0 & 2047; unsigned w[4];
#pragma unroll
                for (int j = 0; j < 4; ++j) { const int ma = (k1 * (s0 + 2 * j)) & 2047, mb = (k1 * (s0 + 2 * j + 1)) & 2047;
                    w[j] = cvtpk(tab[(ma - which * 512) & 2047], tab[(mb - which * 512) & 2047]); }
                *(GAS u32x4*)(DFT + (size_t)k1 * 4096 + c0) = (u32x4){w[0], w[1], w[2], w[3]}; } }
      __syncthreads(); }
    { float* RC = (float*)(ws + WS_ROPE); float* RS = RC + SEQ * 64;
      for (int i = F.vcu * 512 + p_tid; i < SEQ * 64; i += F.G * 512) { const int t = i >> 6, p = i & 63; const int pos = (p < 32) ? (t >> 6) : (t & 63); const int j = p & 31;
          const float inv = 1.0f / powf(10000.0f, (float)(2 * j) / 64.0f); const float ang = (float)pos * inv; RC[i] = cosf(ang); RS[i] = sinf(ang); } }
    { u32x4* RB = (u32x4*)(ws + WS_AFF + 512 * 1024);
      for (int i = F.vcu * 512 + p_tid; i < 2 * 64 * 64; i += F.G * 512) { const int layer = i >> 12, ks = (i >> 6) & 63, ln = i & 63, e = ln & 15, k0 = 32 * ks + 8 * (ln >> 4);
          const float* Wr = KIN(ka, 17) + (size_t)layer * DM * NE; const float* gn = KIN(ka, 16) + layer * DM; float w[8], lo[8];
#pragma unroll
          for (int j = 0; j < 8; ++j) { w[j] = gn[k0 + j] * Wr[(size_t)(k0 + j) * NE + e]; }
          u32x4 hi4 = {cvtpk(w[0], w[1]), cvtpk(w[2], w[3]), cvtpk(w[4], w[5]), cvtpk(w[6], w[7])};
          const unsigned hh[4] = {hi4.x, hi4.y, hi4.z, hi4.w};
#pragma unroll
          for (int j = 0; j < 4; ++j) { lo[2 * j] = w[2 * j] - __uint_as_float(hh[j] << 16); lo[2 * j + 1] = w[2 * j + 1] - __uint_as_float(hh[j] & 0xffff0000u); }
          RB[(size_t)(layer * 2 + 0) * 4096 + ks * 64 + ln] = hi4;
          RB[(size_t)(layer * 2 + 1) * 4096 + ks * 64 + ln] = (u32x4){cvtpk(lo[0], lo[1]), cvtpk(lo[2], lo[3]), cvtpk(lo[4], lo[5]), cvtpk(lo[6], lo[7])}; } }
    { LAS float* Mw = (LAS float*)(F.lds + RING_OFF); LAS float* t128 = Mw + 128 * 32;
      bf16_t* WF = (bf16_t*)(ws + WS_WF_T);
      for (int it = F.vcu; it < 256; it += F.G) {
          const int which = it >> 7, g = (it >> 5) & 3, d0 = ((it >> 3) & 3) * 32, k0 = (it & 7) * 256;
          if (p_tid < 128) t128[p_tid] = cosf(6.283185307179586f * (float)p_tid * (1.0f / 128.0f));
          __syncthreads();
          { const int c = p_tid >> 2, dd = (p_tid & 3) * 8; float o[8] = {0.f, 0.f, 0.f, 0.f, 0.f, 0.f, 0.f, 0.f};
#pragma unroll 16
            for (int k2 = 0; k2 < 128; ++k2) { const int m = (c * k2) & 127; const float tv = which ? -t128[(m - 32) & 127] : t128[m];
                const float* wr_ = w_four + ((size_t)g * 128 + k2) * 128 + d0 + dd; const f32x4 w0 = *(const f32x4*)wr_, w1 = *(const f32x4*)(wr_ + 4);
                o[0] += tv * w0.x; o[1] += tv * w0.y; o[2] += tv * w0.z; o[3] += tv * w0.w; o[4] += tv * w1.x; o[5] += tv * w1.y; o[6] += tv * w1.z; o[7] += tv * w1.w; }
#pragma unroll
            for (int j = 0; j < 8; ++j) Mw[c * 32 + dd + j] = o[j] * (1.0f / 512.0f); }
          __syncthreads();
          { const int kp = p_tid & 127, dq = p_tid >> 7, k = k0 + 2 * kp; float o0[8] = {0.f, 0.f, 0.f, 0.f, 0.f, 0.f, 0.f, 0.f}, o1[8] = {0.f, 0.f, 0.f, 0.f, 0.f, 0.f, 0.f, 0.f};
            const float* r0 = w_in + (size_t)k * INW + 2560 + g * 128; const float* r1 = r0 + INW;
#pragma unroll 8
            for (int c4 = 0; c4 < 32; ++c4) { const f32x4 a = *(const f32x4*)(r0 + 4 * c4), b = *(const f32x4*)(r1 + 4 * c4); const float av[4] = {a.x, a.y, a.z, a.w}, bv[4] = {b.x, b.y, b.z, b.w};
#pragma unroll
                for (int cc = 0; cc < 4; ++cc) { const LAS float* mr = Mw + (4 * c4 + cc) * 32 + dq * 8;
#pragma unroll
                    for (int j = 0; j < 8; ++j) { o0[j] += av[cc] * mr[j]; o1[j] += bv[cc] * mr[j]; } } }
#pragma unroll
            for (int j = 0; j < 8; ++j) *(GAS unsigned*)(WF + (size_t)(which * 512 + g * 128 + d0 + dq * 8 + j) * DM + k) = cvtpk(o0[j], o1[j]); }
          __syncthreads(); } }
    { const int n = (TR_DENSE - gw + NGW - 1) / NGW; tr_span(F, ka, ws, 0, gw, NGW, n > 0 ? n : 0); }
    __syncthreads();
    for (int m = gw; m < NTOK; m += NGW) rms_row_to_bf16(x + (size_t)m * DM, mix_norm, (bf16_t*)(ws + WS_HN) + (size_t)m * DM, p_lane);
    for (int m = gw; m < 2 * NB * MEML; m += NGW) { const int l = m / (NB * MEML), r = m % (NB * MEML);
        rms_row_to_bf16(mem + (size_t)r * DM, mem_norm + l * DM, (bf16_t*)(ws + WS_MEMNB) + (size_t)m * DM, p_lane); }
}

struct MapLin { const char* A; const char* B; size_t as, bs; __device__ __forceinline__ void operator()(pg8::Unit& u) const { u.a = A + (size_t)u.pm * as; u.b = B + (size_t)u.pn * bs; } };

struct EpiQKV {
    static constexpr bool PERM = true;
    bf16_t* Q; bf16_t* K; bf16_t* V; const float* qg; const float* kg; const float* RC; const float* RS;
    __device__ __forceinline__ void operator()(f32x4 (&acc)[2][2][4][2], const pg8::Unit& u, const pg8::EpiCtx& c) const { const int e_lane = lane_id(), e_fr = e_lane & 15, e_fq = e_lane >> 4;
        const int pn = u.pn, hc = c.wc * 32 + e_fq * 8, rl0 = c.wr * 64 + e_fr;
        if (pn >= 8) {
            bf16_t* base = V + (size_t)(u.pm * 256 + rl0) * KVW + (pn - 8) * 256 + hc;
#pragma unroll
            for (int ai = 0; ai < 2; ++ai)
#pragma unroll
                for (int m = 0; m < 4; ++m) { bf16_t* rowp = base + (size_t)(ai * 128 + m * 16) * KVW;
#pragma unroll
                    for (int bj = 0; bj < 2; ++bj) { const f32x4 v0 = acc[ai][bj][m][0], v1 = acc[ai][bj][m][1];
                        st16((rowp + bj * 128), (u32x4){cvtpk(v0.x, v0.y), cvtpk(v0.z, v0.w), cvtpk(v1.x, v1.y), cvtpk(v1.z, v1.w)}); } }
            return;
        }
        LAS float* part = (LAS float*)c.xl;
#pragma unroll
        for (int ai = 0; ai < 2; ++ai)
#pragma unroll
            for (int m = 0; m < 4; ++m)
#pragma unroll
                for (int bj = 0; bj < 2; ++bj) { const f32x4 v0 = acc[ai][bj][m][0], v1 = acc[ai][bj][m][1];
                    float s = (v0.x * v0.x + v0.y * v0.y) + (v0.z * v0.z + v0.w * v0.w) + (v1.x * v1.x + v1.y * v1.y) + (v1.z * v1.z + v1.w * v1.w);
                    s += __shfl_xor(s, 16); s += __shfl_xor(s, 32);
                    if (e_fq == 0) part[((ai * 128 + rl0 + m * 16) * 2 + bj) * 4 + c.wc] = s; }
        WG_BAR();
        const float* gain = pn < 6 ? qg : kg;
        const f32x4 g0 = *(const f32x4*)(gain + hc), g1 = *(const f32x4*)(gain + hc + 4);
        bf16_t* O = pn < 6 ? Q : K; const int ld = pn < 6 ? AW : KVW; const int colbase = (pn < 6 ? pn : pn - 6) * 256 + hc;
#pragma unroll
        for (int ai = 0; ai < 2; ++ai)
#pragma unroll
            for (int m = 0; m < 4; ++m) { const int rl = ai * 128 + rl0 + m * 16, row = u.pm * 256 + rl, sp = row & (SEQ - 1);
                const f32x4 cs = *(const f32x4*)(RC + sp * 64 + (hc >> 1)), sn = *(const f32x4*)(RS + sp * 64 + (hc >> 1));
#pragma unroll
                for (int bj = 0; bj < 2; ++bj) { const f32x4 p4 = *(const LAS f32x4*)(part + (rl * 2 + bj) * 4);
                    const float r = rsqrtf(((p4.x + p4.y) + (p4.z + p4.w)) * (1.0f / 128.0f) + EPS);
                    const f32x4 v0 = acc[ai][bj][m][0] * r * g0, v1 = acc[ai][bj][m][1] * r * g1;
                    u32x4 w; w.x = cvtpk(v0.x * cs.x - v0.y * sn.x, v0.x * sn.x + v0.y * cs.x); w.y = cvtpk(v0.z * cs.y - v0.w * sn.y, v0.z * sn.y + v0.w * cs.y);
                    w.z = cvtpk(v1.x * cs.z - v1.y * sn.z, v1.x * sn.z + v1.y * cs.z); w.w = cvtpk(v1.z * cs.w - v1.w * sn.w, v1.z * sn.w + v1.w * cs.w);
                    st16((O + (size_t)row * ld + colbase + bj * 128), w); } }
    }
};


template <class AddrF> struct EpiStore {
    static constexpr bool PERM = true; AddrF f;
    __device__ __forceinline__ void operator()(f32x4 (&acc)[2][2][4][2], const pg8::Unit& u, const pg8::EpiCtx& c) const { const int e_lane = lane_id(), e_fr = e_lane & 15, e_fq = e_lane >> 4;
        const int hc = c.wc * 32 + e_fq * 8, rl0 = c.wr * 64 + e_fr;
#pragma unroll
        for (int ai = 0; ai < 2; ++ai)
#pragma unroll
            for (int m = 0; m < 4; ++m)
#pragma unroll
                for (int bj = 0; bj < 2; ++bj) { const f32x4 v0 = acc[ai][bj][m][0], v1 = acc[ai][bj][m][1];
                    st16(f(u, ai * 128 + rl0 + m * 16, bj * 128 + hc), (u32x4){cvtpk(v0.x, v0.y), cvtpk(v0.z, v0.w), cvtpk(v1.x, v1.y), cvtpk(v1.z, v1.w)}); }
    }
};
struct AddrF1 { bf16_t* FPQ; __device__ __forceinline__ bf16_t* operator()(const pg8::Unit& u, int rl, int tc) const {
    const int r = u.pm * 256 + rl, which = r >> 9, n = r & 511, cidx = u.pn * 256 + tc, b = cidx >> 11, s = cidx & 2047; return FPQ + (((size_t)(b * 512 + n) * 2 + which) * 2048 + s); } };
struct AddrF2 { bf16_t* MIX; __device__ __forceinline__ bf16_t* operator()(const pg8::Unit& u, int rl, int tc) const {
    const int row = (u.pn >> 1) * 2048 + u.pm * 256 + rl, col = AW + (u.pn & 1) * 256 + tc; return MIX + (size_t)row * DM + col; } };

template <bool BF32> struct EpiResB {
    static constexpr bool PERM = true;
    const void* base; bf16_t* xo; float* ssp; const float* cscale;
    __device__ __forceinline__ void operator()(f32x4 (&acc)[2][2][4][2], const pg8::Unit& u, const pg8::EpiCtx& c) const { const int e_lane = lane_id(), e_fr = e_lane & 15, e_fq = e_lane >> 4;
        const int hc = c.wc * 32 + e_fq * 8, rl0 = c.wr * 64 + e_fr;
        LAS float* part = (LAS float*)c.xl;
#pragma unroll
        for (int ai = 0; ai < 2; ++ai)
#pragma unroll
            for (int m = 0; m < 4; ++m) { const int rl = ai * 128 + rl0 + m * 16; float s = 0.f;
#pragma unroll
                for (int bj = 0; bj < 2; ++bj) { const int col = u.pn * 256 + bj * 128 + hc; const size_t off = (size_t)(u.pm * 256 + rl) * DM + col;
                    f32x4 v0 = acc[ai][bj][m][0], v1 = acc[ai][bj][m][1];
                    if (cscale) { v0 = v0 * *(const f32x4*)(cscale + col); v1 = v1 * *(const f32x4*)(cscale + col + 4); }
                    if (BF32) { v0 = v0 + *(const f32x4*)((const float*)base + off); v1 = v1 + *(const f32x4*)((const float*)base + off + 4); }
                    else { const u32x4 b = *(const u32x4*)((const bf16_t*)base + off);
                        v0.x += __uint_as_float(b.x << 16); v0.y += __uint_as_float(b.x & 0xffff0000u); v0.z += __uint_as_float(b.y << 16); v0.w += __uint_as_float(b.y & 0xffff0000u);
                        v1.x += __uint_as_float(b.z << 16); v1.y += __uint_as_float(b.z & 0xffff0000u); v1.z += __uint_as_float(b.w << 16); v1.w += __uint_as_float(b.w & 0xffff0000u); }
                    st16((xo + off), (u32x4){cvtpk(v0.x, v0.y), cvtpk(v0.z, v0.w), cvtpk(v1.x, v1.y), cvtpk(v1.z, v1.w)});
                    if (ssp) s += ((v0.x * v0.x + v0.y * v0.y) + (v0.z * v0.z + v0.w * v0.w)) + ((v1.x * v1.x + v1.y * v1.y) + (v1.z * v1.z + v1.w * v1.w)); }
                if (ssp) { s += __shfl_xor(s, 16); s += __shfl_xor(s, 32); if (e_fq == 0) part[rl * 4 + c.wc] = s; }
                asm volatile("" ::: "memory"); }
        if (ssp) { WG_BAR();
            if (e_lane < 32) { const int row = c.wid * 32 + e_lane; const f32x4 p4 = *(const LAS f32x4*)(part + row * 4);
                ssp[(size_t)(u.pm * 256 + row) * 8 + u.pn] = (p4.x + p4.y) + (p4.z + p4.w); }
            WG_BAR(); }
    }
};

namespace attn {
using s16x4 = __attribute__((ext_vector_type(4))) short;
using f32x16 = __attribute__((ext_vector_type(16))) float;
constexpr int D = 128, NW = 8, QBLK = 32, KVBLK = 64;
constexpr float SCALE = 0.088388347648318440f;
constexpr float THR = 0.f;
#ifndef ATT_SDEPTH
#define ATT_SDEPTH 1
#endif
constexpr int LDQ = AW, LDK = KVW, LDO = DM;
constexpr size_t SHM_V = KVBLK * D * 2, SHM_K = KVBLK * D * 2, SHM_ATTN = 2 * SHM_V + 2 * SHM_K + NW * 64 * 4;
#define KSWZ(row, colB) ((row) * 256 + ((colB) ^ (((row) & 7) << 4)))
#define SBAR() __builtin_amdgcn_sched_barrier(0)
__device__ __forceinline__ int crow(int r, int hi) { return (r & 3) + 8 * (r >> 2) + 4 * hi; }
__device__ __forceinline__ unsigned cvtpk_a(float lo, float hi) { unsigned r; asm volatile("v_cvt_pk_bf16_f32 %0, %1, %2" : "=v"(r) : "v"(lo), "v"(hi)); return r; }
__device__ __forceinline__ void partialSM(f32x16& p0, f32x16& p1, float& m_reg, float& mn, float& alpha) {
  constexpr float C = SCALE * 1.4426950408889634f;
  float pmax = p0[0]; for (int r = 1; r < 16; ++r) pmax = fmaxf(pmax, p0[r]); for (int r = 0; r < 16; ++r) pmax = fmaxf(pmax, p1[r]);
  { auto rr = __builtin_amdgcn_permlane32_swap(__float_as_uint(pmax), __float_as_uint(pmax), false, false);
    pmax = fmaxf(__uint_as_float(rr[0]), __uint_as_float(rr[1])); }
  if (__builtin_expect(__all(pmax - m_reg <= THR / SCALE), 1)) { mn = m_reg; alpha = 1.f; }
  else { mn = fmaxf(m_reg, pmax); alpha = __builtin_amdgcn_exp2f((m_reg - mn) * C); m_reg = mn; }
  float mnC = -mn * C;
  for (int r = 0; r < 16; ++r) p0[r] = fmaf(p0[r], C, mnC); for (int r = 0; r < 16; ++r) p1[r] = fmaf(p1[r], C, mnC);
  for (int r = 0; r < 16; ++r) p0[r] = __builtin_amdgcn_exp2f(p0[r]);
}
__device__ __forceinline__ void finishSM(f32x16& p0, f32x16& p1, float alpha, float& l_reg, bf16x8& pa0, bf16x8& pa1, bf16x8& pa2, bf16x8& pa3) {
  for (int r = 0; r < 16; ++r) p1[r] = __builtin_amdgcn_exp2f(p1[r]);
  float ps = 0; for (int r = 0; r < 16; ++r) ps += p0[r]; for (int r = 0; r < 16; ++r) ps += p1[r];
  { auto rr = __builtin_amdgcn_permlane32_swap(__float_as_uint(ps), __float_as_uint(ps), false, false);
    ps = __uint_as_float(rr[0]) + __uint_as_float(rr[1]); }
  l_reg = l_reg * alpha + ps;
#define PK4(P, BASE, OUT) do { unsigned a0 = cvtpk_a(P[BASE + 0], P[BASE + 1]), a1 = cvtpk_a(P[BASE + 2], P[BASE + 3]);   \
    unsigned b0 = cvtpk_a(P[BASE + 4], P[BASE + 5]), b1 = cvtpk_a(P[BASE + 6], P[BASE + 7]);                              \
    auto r0 = __builtin_amdgcn_permlane32_swap(a0, b0, false, false); auto r1 = __builtin_amdgcn_permlane32_swap(a1, b1, false, false); \
    u32x4 w = {r0[0], r1[0], r0[1], r1[1]}; OUT = *reinterpret_cast<bf16x8*>(&w); } while (0)
  PK4(p0, 0, pa0); PK4(p0, 8, pa1); PK4(p1, 0, pa2); PK4(p1, 8, pa3);
#undef PK4
}
__device__ __forceinline__ void qkt(f32x16& p0, f32x16& p1, const bf16_t* Ks, const bf16x8* qr, int r32, int hi) {
  p0 = f32x16{}; p1 = f32x16{};
  for (int d0 = 0; d0 < 8; ++d0) { int cb = (d0 * 16 + hi * 8) * 2;
    bf16x8 b0 = *reinterpret_cast<const bf16x8*>((const char*)Ks + KSWZ(r32, cb));
    bf16x8 b1 = *reinterpret_cast<const bf16x8*>((const char*)Ks + KSWZ(32 + r32, cb));
    p0 = __builtin_amdgcn_mfma_f32_32x32x16_bf16(b0, qr[d0], p0, 0, 0, 0);
    p1 = __builtin_amdgcn_mfma_f32_32x32x16_bf16(b1, qr[d0], p1, 0, 0, 0); }
}
__device__ __forceinline__ int v_st(int k, int c) { const int kk = (k & ~0xC) | ((k & 4) << 1) | ((k & 8) >> 1); return ((kk >> 3) * 4 + (c >> 5)) * 512 + ((kk & 7) * 32 + (c & 31)) * 2; }
__device__ __forceinline__ int v_rd_base(int lane) { return ((lane & 3) << 3) | (((lane >> 2) & 3) << 6) | (((lane >> 4) & 1) << 5) | (((lane >> 5) & 1) << 8); }
constexpr int v_rd_off(int d0, int ks, int half) { return d0 * 512 + ks * 4096 + half * 2048; }
template <int OFF> __device__ __forceinline__ s16x4 tr_read(int vb) {
  s16x4 r; asm volatile("ds_read_b64_tr_b16 %0, %1 offset:%2" : "=&v"(r) : "v"(vb), "i"(OFF) : "memory"); return r;
}
template <int D0> __device__ __forceinline__ void pv_one(f32x16& od, int vb, bf16x8 pa0, bf16x8 pa1, bf16x8 pa2, bf16x8 pa3) {
  const s16x4 l0 = tr_read<v_rd_off(D0, 0, 0)>(vb), h0 = tr_read<v_rd_off(D0, 0, 1)>(vb), l1 = tr_read<v_rd_off(D0, 1, 0)>(vb), h1 = tr_read<v_rd_off(D0, 1, 1)>(vb);
  const s16x4 l2 = tr_read<v_rd_off(D0, 2, 0)>(vb), h2 = tr_read<v_rd_off(D0, 2, 1)>(vb), l3 = tr_read<v_rd_off(D0, 3, 0)>(vb), h3 = tr_read<v_rd_off(D0, 3, 1)>(vb);
  asm volatile("s_waitcnt lgkmcnt(0)" ::: "memory"); SBAR();
#define PK(L, H) (bf16x8){L[0], L[1], L[2], L[3], H[0], H[1], H[2], H[3]}
  od = __builtin_amdgcn_mfma_f32_32x32x16_bf16(pa0, PK(l0, h0), od, 0, 0, 0);
  od = __builtin_amdgcn_mfma_f32_32x32x16_bf16(pa1, PK(l1, h1), od, 0, 0, 0);
  od = __builtin_amdgcn_mfma_f32_32x32x16_bf16(pa2, PK(l2, h2), od, 0, 0, 0);
  od = __builtin_amdgcn_mfma_f32_32x32x16_bf16(pa3, PK(l3, h3), od, 0, 0, 0);
#undef PK
}
__device__ __forceinline__ void pv_d0(f32x16* o, int vb, bf16x8 pa0, bf16x8 pa1, bf16x8 pa2, bf16x8 pa3) {
  pv_one<0>(o[0], vb, pa0, pa1, pa2, pa3); pv_one<1>(o[1], vb, pa0, pa1, pa2, pa3); pv_one<2>(o[2], vb, pa0, pa1, pa2, pa3); pv_one<3>(o[3], vb, pa0, pa1, pa2, pa3);
}
__device__ __forceinline__ void attn_dense_body(const bf16_t* __restrict__ Qb, const bf16_t* __restrict__ Kh, const bf16_t* __restrict__ Vh,
                                                bf16_t* __restrict__ Ob, int seq, char* lds, const int wave_) {
  constexpr int SDEPTH = ATT_SDEPTH;
  const int lane = lane_id(), wid = wave_, tid = wid * 64 + lane, r32 = lane & 31, hi = lane >> 5;
  bf16_t* V_lds = (bf16_t*)lds; bf16_t* K_lds = (bf16_t*)(lds + 2 * SHM_V);
  float* ws = (float*)(lds + 2 * SHM_V + 2 * SHM_K) + wid * 64; float* li_l = ws; float* al_l = ws + 32;
  float m_reg = -1e30f, l_reg = 0; f32x16 o[4] = {}; bf16x8 qr[8];
  const bf16_t* Qw = Qb + (long)(wid * QBLK + r32) * LDQ + hi * 8;
#pragma unroll
  for (int d0 = 0; d0 < 8; ++d0) qr[d0] = *reinterpret_cast<const bf16x8*>(Qw + d0 * 16);
  const int sr = tid >> 4, sc = (tid & 15) * 8, vst0 = v_st(sr, sc), vst1 = v_st(32 + sr, sc);
  const int vb0 = (int)(uintptr_t)V_lds + v_rd_base(lane);
  struct { bf16x8 vs0, vs1, ks0, ks1; } sr_[SDEPTH];
#define SLOAD(i, k0) do { sr_[i].vs0 = *reinterpret_cast<const bf16x8*>(&Vh[(long)((k0) + sr) * LDK + sc]); sr_[i].vs1 = *reinterpret_cast<const bf16x8*>(&Vh[(long)((k0) + 32 + sr) * LDK + sc]); \
    sr_[i].ks0 = *reinterpret_cast<const bf16x8*>(&Kh[(long)((k0) + sr) * LDK + sc]); sr_[i].ks1 = *reinterpret_cast<const bf16x8*>(&Kh[(long)((k0) + 32 + sr) * LDK + sc]); } while (0)
#define SWRITE(b, i) do { *(bf16x8*)((char*)V_lds + (b) * SHM_V + vst0) = sr_[i].vs0;          \
    *(bf16x8*)((char*)V_lds + (b) * SHM_V + vst1) = sr_[i].vs1; int kc = sc * 2;               \
    *(bf16x8*)((char*)K_lds + (b) * SHM_K + KSWZ(sr, kc)) = sr_[i].ks0;                       \
    *(bf16x8*)((char*)K_lds + (b) * SHM_K + KSWZ(32 + sr, kc)) = sr_[i].ks1; } while (0)
#define SWAIT() do { if constexpr (SDEPTH == 2) asm volatile("s_waitcnt vmcnt(4)" ::: "memory"); else asm volatile("s_waitcnt vmcnt(0)" ::: "memory"); } while (0)
#define RESC(a) do { if (__any((a) < 1.f)) { if (hi == 0) al_l[r32] = (a); asm volatile("s_waitcnt lgkmcnt(0)" ::: "memory"); \
    for (int d = 0; d < 4; ++d) for (int r = 0; r < 16; ++r) o[d][r] *= al_l[crow(r, hi)]; } } while (0)
  f32x16 pA0, pA1, pB0, pB1; float mnA, mnB, alA, alB; bf16x8 pa0, pa1, pa2, pa3; const int NT = seq / KVBLK;
  constexpr int SE = 0, SO = SDEPTH - 1;
  SLOAD(SE, 0); asm volatile("s_waitcnt vmcnt(0)" ::: "memory"); SWRITE(0, SE); __syncthreads();
  qkt(pA0, pA1, K_lds, qr, r32, hi); partialSM(pA0, pA1, m_reg, mnA, alA);
  SLOAD(SO, KVBLK); if constexpr (SDEPTH == 2) { if (2 < NT) SLOAD(SE, 2 * KVBLK); }
  SWAIT(); SWRITE(1, SO); __syncthreads();
  for (int j = 1; j + 1 < NT; j += 2) {
    SBAR(); qkt(pB0, pB1, (bf16_t*)((char*)K_lds + SHM_K), qr, r32, hi);
    finishSM(pA0, pA1, alA, l_reg, pa0, pa1, pa2, pa3); SBAR();
    SLOAD(SO, (j + SDEPTH) * KVBLK); SBAR();
    pv_d0(o, vb0, pa0, pa1, pa2, pa3); partialSM(pB0, pB1, m_reg, mnB, alB);
    __syncthreads(); SWAIT(); SWRITE(0, SE);
    RESC(alB); __syncthreads();
    SBAR(); qkt(pA0, pA1, K_lds, qr, r32, hi);
    finishSM(pB0, pB1, alB, l_reg, pa0, pa1, pa2, pa3); SBAR();
    if (SDEPTH == 1 || j + 3 < NT) SLOAD(SE, (j + 1 + SDEPTH) * KVBLK); SBAR();
    pv_d0(o, vb0 + (int)SHM_V, pa0, pa1, pa2, pa3); partialSM(pA0, pA1, m_reg, mnA, alA);
    __syncthreads(); SWAIT(); SWRITE(1, SO);
    RESC(alA); __syncthreads();
  }
  SBAR(); qkt(pB0, pB1, (bf16_t*)((char*)K_lds + SHM_K), qr, r32, hi);
  finishSM(pA0, pA1, alA, l_reg, pa0, pa1, pa2, pa3); SBAR();
  pv_d0(o, vb0, pa0, pa1, pa2, pa3); partialSM(pB0, pB1, m_reg, mnB, alB);
  __syncthreads(); RESC(alB);
  finishSM(pB0, pB1, alB, l_reg, pa0, pa1, pa2, pa3); SBAR();
  pv_d0(o, vb0 + (int)SHM_V, pa0, pa1, pa2, pa3);
  if (hi == 0) li_l[r32] = l_reg; asm volatile("s_waitcnt lgkmcnt(0)" ::: "memory");
  float rli[16];
#pragma unroll
  for (int r = 0; r < 16; ++r) rli[r] = __builtin_amdgcn_rcpf(li_l[crow(r, hi)]);
  bf16_t* Ow = Ob + (long)(wid * QBLK) * LDO;
#pragma unroll
  for (int r = 0; r < 16; ++r) { int orow = crow(r, hi);
    for (int d0 = 0; d0 < 4; ++d0) Ow[(long)orow * LDO + d0 * 32 + r32] = (bf16_t)(cvtpk(o[d0][r] * rli[r], 0.f) & 0xffffu); }
#undef SLOAD
#undef SWRITE
#undef SWAIT
#undef RESC
  __syncthreads();
}
#undef KSWZ
#undef SBAR
}

struct AddrLin { bf16_t* O; int ld; __device__ __forceinline__ bf16_t* operator()(const pg8::Unit& u, int rl, int tc) const { return O + (size_t)(u.pm * 256 + rl) * ld + u.pn * 256 + tc; } };
struct EpiRowScale {
    static constexpr bool PERM = true; bf16_t* O; int ld; const float* ssp; float cscale;
    __device__ __forceinline__ void operator()(f32x4 (&acc)[2][2][4][2], const pg8::Unit& u, const pg8::EpiCtx& c) const { const int e_lane = lane_id(), e_fr = e_lane & 15, e_fq = e_lane >> 4;
        const int hc = c.wc * 32 + e_fq * 8, rl0 = c.wr * 64 + e_fr;
#pragma unroll
        for (int ai = 0; ai < 2; ++ai)
#pragma unroll
            for (int m = 0; m < 4; ++m) { const int row = u.pm * 256 + ai * 128 + rl0 + m * 16; const f32x4 p0 = *(const f32x4*)(ssp + (size_t)row * 8), p1 = *(const f32x4*)(ssp + (size_t)row * 8 + 4);
                const float r = rsqrtf((((p0.x + p0.y) + (p0.z + p0.w)) + ((p1.x + p1.y) + (p1.z + p1.w))) * (1.0f / DM) + EPS) * cscale;
#pragma unroll
                for (int bj = 0; bj < 2; ++bj) { const f32x4 v0 = acc[ai][bj][m][0] * r, v1 = acc[ai][bj][m][1] * r;
                    st16((O + (size_t)row * ld + u.pn * 256 + bj * 128 + hc), (u32x4){cvtpk(v0.x, v0.y), cvtpk(v0.z, v0.w), cvtpk(v1.x, v1.y), cvtpk(v1.z, v1.w)}); } }
    }
};
struct EpiSoftmax {
    static constexpr bool PERM = true; bf16_t* P; int ld;
    __device__ __forceinline__ void operator()(f32x4 (&acc)[2][2][4][2], const pg8::Unit& u, const pg8::EpiCtx& c) const { const int e_lane = lane_id(), e_fr = e_lane & 15, e_fq = e_lane >> 4;
        const int hc = c.wc * 32 + e_fq * 8, rl0 = c.wr * 64 + e_fr;
        LAS float* pmx = (LAS float*)c.xl; LAS float* psm = pmx + 1024;
#pragma unroll
        for (int ai = 0; ai < 2; ++ai)
#pragma unroll
            for (int m = 0; m < 4; ++m) { float mx = -3.0e38f;
#pragma unroll
                for (int bj = 0; bj < 2; ++bj)
#pragma unroll
                    for (int n = 0; n < 2; ++n) { const f32x4 v = acc[ai][bj][m][n]; mx = fmaxf(fmaxf(mx, fmaxf(v.x, v.y)), fmaxf(v.z, v.w)); }
                mx = fmaxf(mx, __shfl_xor(mx, 16)); mx = fmaxf(mx, __shfl_xor(mx, 32));
                if (e_fq == 0) pmx[(ai * 128 + rl0 + m * 16) * 4 + c.wc] = mx; }
        WG_BAR();
#pragma unroll
        for (int ai = 0; ai < 2; ++ai)
#pragma unroll
            for (int m = 0; m < 4; ++m) { const int rl = ai * 128 + rl0 + m * 16; const f32x4 p4 = *(const LAS f32x4*)(pmx + rl * 4);
                const float mx = fmaxf(fmaxf(p4.x, p4.y), fmaxf(p4.z, p4.w)) * 1.4426950408889634f; float s = 0.f;
#pragma unroll
                for (int bj = 0; bj < 2; ++bj)
#pragma unroll
                    for (int n = 0; n < 2; ++n) { f32x4 v = acc[ai][bj][m][n];
                        v.x = __builtin_amdgcn_exp2f(fmaf(v.x, 1.4426950408889634f, -mx)); v.y = __builtin_amdgcn_exp2f(fmaf(v.y, 1.4426950408889634f, -mx));
                        v.z = __builtin_amdgcn_exp2f(fmaf(v.z, 1.4426950408889634f, -mx)); v.w = __builtin_amdgcn_exp2f(fmaf(v.w, 1.4426950408889634f, -mx));
                        s += (v.x + v.y) + (v.z + v.w); acc[ai][bj][m][n] = v; }
                s += __shfl_xor(s, 16); s += __shfl_xor(s, 32);
                if (e_fq == 0) psm[rl * 4 + c.wc] = s; }
        WG_BAR();
#pragma unroll
        for (int ai = 0; ai < 2; ++ai)
#pragma unroll
            for (int m = 0; m < 4; ++m) { const int rl = ai * 128 + rl0 + m * 16; const f32x4 p4 = *(const LAS f32x4*)(psm + rl * 4);
                const float inv = 1.0f / ((p4.x + p4.y) + (p4.z + p4.w));
#pragma unroll
                for (int bj = 0; bj < 2; ++bj) { const f32x4 v0 = acc[ai][bj][m][0] * inv, v1 = acc[ai][bj][m][1] * inv;
                    st16((P + (size_t)(u.pm * 256 + rl) * ld + u.pn * 256 + bj * 128 + hc), (u32x4){cvtpk(v0.x, v0.y), cvtpk(v0.z, v0.w), cvtpk(v1.x, v1.y), cvtpk(v1.z, v1.w)}); } }
        WG_BAR();
    }
};
struct MapXS { const char* Q; const char* K; __device__ __forceinline__ void operator()(pg8::Unit& u) const {
    u.a = Q + ((size_t)u.pm * 256 * DM + (size_t)u.pn * MHD) * 2; u.b = K + ((size_t)(u.pm >> 3) * MEML * DM + (size_t)u.pn * MHD) * 2; } };
struct MapXPV { const char* P; const char* VT; __device__ __forceinline__ void operator()(pg8::Unit& u) const {
    u.a = P + ((size_t)u.pm * 256 * 1024 + (size_t)(u.pn >> 1) * MEML) * 2; u.b = VT + ((size_t)u.pn * 256 * 1024 + (size_t)(u.pm >> 3) * MEML) * 2; } };

struct MapMoE { const char* A; const char* W; size_t as, es, ws_; __device__ __forceinline__ void operator()(pg8::Unit& u) const {
    u.a = A + (size_t)u.pm * as; u.b = W + (size_t)(u.pm >> 2) * es + (size_t)u.pn * ws_; } };
struct EpiSwiGLU {
    static constexpr bool PERM = true; bf16_t* ACT; const float* rs;
    __device__ __forceinline__ void operator()(f32x4 (&acc)[2][2][4][2], const pg8::Unit& u, const pg8::EpiCtx& c) const { const int e_lane = lane_id(), e_fr = e_lane & 15, e_fq = e_lane >> 4;
        const int hc = c.wc * 32 + e_fq * 8, rl0 = c.wr * 64 + e_fr;
#pragma unroll
        for (int ai = 0; ai < 2; ++ai)
#pragma unroll
            for (int m = 0; m < 4; ++m) { f32x4 o[2]; const float rf = rs[u.pm * 256 + ai * 128 + rl0 + m * 16];
#pragma unroll
                for (int n = 0; n < 2; ++n) { const f32x4 g = acc[ai][0][m][n] * rf, up = acc[ai][1][m][n] * rf; f32x4 r;
                    r.x = g.x * __builtin_amdgcn_rcpf(1.0f + __builtin_amdgcn_exp2f(-1.4426950408889634f * g.x)) * up.x; r.y = g.y * __builtin_amdgcn_rcpf(1.0f + __builtin_amdgcn_exp2f(-1.4426950408889634f * g.y)) * up.y;
                    r.z = g.z * __builtin_amdgcn_rcpf(1.0f + __builtin_amdgcn_exp2f(-1.4426950408889634f * g.z)) * up.z; r.w = g.w * __builtin_amdgcn_rcpf(1.0f + __builtin_amdgcn_exp2f(-1.4426950408889634f * g.w)) * up.w; o[n] = r; }
                st16((ACT + (size_t)(u.pm * 256 + ai * 128 + rl0 + m * 16) * EFF + u.pn * 128 + hc), (u32x4){cvtpk(o[0].x, o[0].y), cvtpk(o[0].z, o[0].w), cvtpk(o[1].x, o[1].y), cvtpk(o[1].z, o[1].w)}); }
    }
};
struct EpiRowGate {
    static constexpr bool PERM = true; bf16_t* Y; const float* gate;
    __device__ __forceinline__ void operator()(f32x4 (&acc)[2][2][4][2], const pg8::Unit& u, const pg8::EpiCtx& c) const { const int e_lane = lane_id(), e_fr = e_lane & 15, e_fq = e_lane >> 4;
        const int hc = c.wc * 32 + e_fq * 8, rl0 = c.wr * 64 + e_fr;
#pragma unroll
        for (int ai = 0; ai < 2; ++ai)
#pragma unroll
            for (int m = 0; m < 4; ++m) { const int row = u.pm * 256 + ai * 128 + rl0 + m * 16; const float gt = gate[row];
#pragma unroll
                for (int bj = 0; bj < 2; ++bj) { const f32x4 v0 = acc[ai][bj][m][0] * gt, v1 = acc[ai][bj][m][1] * gt;
                    st16((Y + (size_t)row * DM + u.pn * 256 + bj * 128 + hc), (u32x4){cvtpk(v0.x, v0.y), cvtpk(v0.z, v0.w), cvtpk(v1.x, v1.y), cvtpk(v1.z, v1.w)}); } }
    }
};
__device__ __forceinline__ float rms_row_to_bf16_r(const float* xrow, const float* __restrict__ gain, bf16_t* orow, int lane) {
    const GAS f32x4* xr = (const GAS f32x4*)xrow + lane; const f32x4* gr = (const f32x4*)gain + lane;
    f32x4 v[8]; float s = 0.f;
#pragma unroll
    for (int j = 0; j < 8; ++j) { v[j] = xr[64 * j]; s += (v[j].x * v[j].x + v[j].y * v[j].y) + (v[j].z * v[j].z + v[j].w * v[j].w); }
    const float r = rsqrtf(wave_sum(s) * (1.f / DM) + EPS);
    GAS u32x2* o8 = (GAS u32x2*)orow + lane;
#pragma unroll
    for (int j = 0; j < 8; ++j) { const f32x4 g = gr[64 * j]; u32x2 w; w.x = cvtpk(v[j].x * r * g.x, v[j].y * r * g.y); w.y = cvtpk(v[j].z * r * g.z, v[j].w * r * g.w); o8[64 * j] = w; }
    return r;
}
__device__ __forceinline__ void router_phase(const Frame& F, const bf16_t* x, const u32x4* RBl, float* rrow, float* aff, LAS unsigned char* xl) {
    const int lane = lane_id(), tid = F.wave * 64 + lane;
    LAS u32x4* Bl = (LAS u32x4*)(F.lds + RING_OFF);
    for (int i = tid; i < 2 * 4096; i += 512) Bl[i] = RBl[i];
    __syncthreads();
    LAS float* red = (LAS float*)xl;
    LAS float* ssq = (LAS float*)(xl + 8192);
    const int rg = F.wave >> 2, kq = F.wave & 3, r16 = lane & 15, kg = lane >> 4;
    for (int rb = (int)blockIdx.x * 32; rb < NTOK; rb += F.G * 32) {
        const bf16_t* xr = x + (size_t)(rb + rg * 16 + r16) * DM + kq * 512 + kg * 8;
        bf16x8 a[16];
#pragma unroll
        for (int s = 0; s < 16; ++s) a[s] = *(const GAS bf16x8*)(xr + 32 * s);
        f32x4 acc = {0.f, 0.f, 0.f, 0.f}; float sq = 0.f;
#pragma unroll
        for (int s = 0; s < 16; ++s) { const int ks = kq * 16 + s;
            const bf16x8 bh = __builtin_bit_cast(bf16x8, Bl[ks * 64 + lane]), bl = __builtin_bit_cast(bf16x8, Bl[4096 + ks * 64 + lane]);
            acc = __builtin_amdgcn_mfma_f32_16x16x32_bf16(a[s], bh, acc, 0, 0, 0);
            acc = __builtin_amdgcn_mfma_f32_16x16x32_bf16(a[s], bl, acc, 0, 0, 0);
            const u32x4 av = __builtin_bit_cast(u32x4, a[s]);
            const float f0 = __uint_as_float(av.x << 16), f1 = __uint_as_float(av.x & 0xffff0000u), f2 = __uint_as_float(av.y << 16), f3 = __uint_as_float(av.y & 0xffff0000u);
            const float f4 = __uint_as_float(av.z << 16), f5 = __uint_as_float(av.z & 0xffff0000u), f6 = __uint_as_float(av.w << 16), f7 = __uint_as_float(av.w & 0xffff0000u);
            sq += ((f0 * f0 + f1 * f1) + (f2 * f2 + f3 * f3)) + ((f4 * f4 + f5 * f5) + (f6 * f6 + f7 * f7)); }
        sq += __shfl_xor(sq, 16); sq += __shfl_xor(sq, 32);
        *(LAS f32x4*)(red + ((rg * 4 + kq) * 64 + lane) * 4) = acc;
        if (kg == 0) ssq[(rg * 4 + kq) * 16 + r16] = sq;
        __syncthreads();
        if (kq == 0) {
            f32x4 t = *(const LAS f32x4*)(red + ((rg * 4 + 0) * 64 + lane) * 4);
#pragma unroll
            for (int q = 1; q < 4; ++q) t = t + *(const LAS f32x4*)(red + ((rg * 4 + q) * 64 + lane) * 4);
            const float lg[4] = {t.x, t.y, t.z, t.w};
#pragma unroll
            for (int i = 0; i < 4; ++i) { const int rr = 4 * kg + i; const float ss = (ssq[(rg * 4 + 0) * 16 + rr] + ssq[(rg * 4 + 1) * 16 + rr]) + (ssq[(rg * 4 + 2) * 16 + rr] + ssq[(rg * 4 + 3) * 16 + rr]);
                const float r = rsqrtf(ss * (1.f / DM) + EPS); const int row = rb + rg * 16 + rr;
                const float v = lg[i] * r; float mx = v;
                mx = fmaxf(mx, __shfl_xor(mx, 8)); mx = fmaxf(mx, __shfl_xor(mx, 4)); mx = fmaxf(mx, __shfl_xor(mx, 2)); mx = fmaxf(mx, __shfl_xor(mx, 1));
                const float ex = expf(v - mx); float sm = ex;
                sm += __shfl_xor(sm, 8); sm += __shfl_xor(sm, 4); sm += __shfl_xor(sm, 2); sm += __shfl_xor(sm, 1);
                const int b = row / SEQ, tt = row % SEQ; aff[((size_t)b * NE + r16) * SEQ + tt] = ex / sm;
                if (r16 == 0) rrow[row] = r; }
        }
        __syncthreads();
    }
}
__device__ __forceinline__ void rank_phase(const Frame& F, const float* aff, int* rank, float* gate, const float* rrow, float* rs, int* gidx) {
    const int lane = lane_id(), tid = F.wave * 64 + lane;
    LAS unsigned* wc = (LAS unsigned*)(F.lds + RING_OFF);
    LAS unsigned* ck = (LAS unsigned*)(F.lds + RING_OFF + 256);
    LAS unsigned* ci = ck + SEQ + 4;
    LAS unsigned* ncp = ci + SEQ + 4;
    for (int be = (int)blockIdx.x; be < NB * NE; be += F.G) {
        const int b = be >> 4, e = be & 15;
        unsigned k[4];
#pragma unroll
        for (int j = 0; j < 4; ++j) k[j] = __float_as_uint(aff[(size_t)be * SEQ + tid + 512 * j]);
        unsigned lo = 0u, hi = 0x3F800001u;
        if (tid == 0) ncp[0] = 0u;
        for (int it = 0; it < 40; ++it) {
            const unsigned mid = lo + ((hi - lo) >> 1); if (mid == lo) break;
            const int ws_ = __popcll(__ballot(k[0] >= mid)) + __popcll(__ballot(k[1] >= mid)) + __popcll(__ballot(k[2] >= mid)) + __popcll(__ballot(k[3] >= mid));
            if (lane == 0) wc[(it & 1) * 8 + F.wave] = (unsigned)ws_;
            __syncthreads();
            const u32x4 c0 = *(const LAS u32x4*)(wc + (it & 1) * 8), c1 = *(const LAS u32x4*)(wc + (it & 1) * 8 + 4);
            const int c = (int)(((c0.x + c0.y) + (c0.z + c0.w)) + ((c1.x + c1.y) + (c1.z + c1.w)));
            if (c < CAP) hi = mid; else { lo = mid; if (c <= 448) break; }
        }
        const unsigned T = lo;
        __syncthreads();
#pragma unroll
        for (int j = 0; j < 4; ++j) { const bool pred = k[j] >= T; const unsigned long long bal = __ballot(pred);
            const int wcount = __popcll(bal), pre = __popcll(bal & ((1ull << lane) - 1ull));
            unsigned base = 0u; if (lane == 0 && wcount) base = __hip_atomic_fetch_add(ncp, (unsigned)wcount, __ATOMIC_RELAXED, __HIP_MEMORY_SCOPE_WORKGROUP);
            base = (unsigned)__builtin_amdgcn_readfirstlane((int)base);
            if (pred) { ck[base + pre] = k[j]; ci[base + pre] = (unsigned)(tid + 512 * j); } else rank[(size_t)be * SEQ + tid + 512 * j] = CAP; }
        __syncthreads();
        const int nc = (int)ncp[0];
        if (tid < 4) { ck[nc + tid] = 0u; ci[nc + tid] = 0x7fffffffu; }
        __syncthreads();
        const int nc4 = (nc + 3) >> 2;
        for (int i = tid; i < nc; i += 512) { const unsigned kk = ck[i]; const int tt = (int)ci[i]; int cnt = 0;
#pragma unroll 4
            for (int m = 0; m < nc4; ++m) { const u32x4 km = ((const LAS u32x4*)ck)[m]; const u32x4 tm = ((const LAS u32x4*)ci)[m];
                cnt += ((km.x > kk || (km.x == kk && (int)tm.x < tt)) ? 1 : 0) + ((km.y > kk || (km.y == kk && (int)tm.y < tt)) ? 1 : 0)
                     + ((km.z > kk || (km.z == kk && (int)tm.z < tt)) ? 1 : 0) + ((km.w > kk || (km.w == kk && (int)tm.w < tt)) ? 1 : 0); }
            const int r = cnt < CAP ? cnt : CAP; rank[(size_t)be * SEQ + tt] = r;
            if (r < CAP) { const int sl = (e * 4 + b) * CAP + r; gate[sl] = __uint_as_float(kk); gidx[sl] = b * SEQ + tt; rs[sl] = rrow[b * SEQ + tt]; } }
        __syncthreads();
    }
}
__device__ __forceinline__ void combine_phase(const Frame& F, const bf16_t* xin, bf16_t* xo, float* fout, const bf16_t* Y, const int* rank, const float* __restrict__ gain, bf16_t* HNo, bool final_) {
    const int lane = lane_id();
    const int gw = (int)blockIdx.x * NWAVES + F.wave, NGW = F.G * NWAVES;
    for (int row = gw; row < NTOK; row += NGW) {
        const int b = row / SEQ, t = row % SEQ;
        int rk = CAP; if (lane < NE) rk = rank[((size_t)b * NE + lane) * SEQ + t];
        const GAS u32x2* xi = (const GAS u32x2*)(xin + (size_t)row * DM) + lane; f32x4 v[8];
#pragma unroll
        for (int j = 0; j < 8; ++j) { const u32x2 p = xi[64 * j]; v[j] = (f32x4){__uint_as_float(p.x << 16), __uint_as_float(p.x & 0xffff0000u), __uint_as_float(p.y << 16), __uint_as_float(p.y & 0xffff0000u)}; }
#pragma unroll
        for (int e = 0; e < NE; ++e) { const int r = __builtin_amdgcn_readlane(rk, e);
            if (r < CAP) { const u32x2* yr = (const u32x2*)(Y + ((size_t)(e * 4 + b) * CAP + r) * DM) + lane;
#pragma unroll
                for (int j = 0; j < 8; ++j) { const u32x2 w = yr[64 * j]; v[j].x += __uint_as_float(w.x << 16); v[j].y += __uint_as_float(w.x & 0xffff0000u); v[j].z += __uint_as_float(w.y << 16); v[j].w += __uint_as_float(w.y & 0xffff0000u); } } }
        float s = 0.f;
#pragma unroll
        for (int j = 0; j < 8; ++j) s += (v[j].x * v[j].x + v[j].y * v[j].y) + (v[j].z * v[j].z + v[j].w * v[j].w);
        const float r = rsqrtf(wave_sum(s) * (1.f / DM) + EPS); const f32x4* gr = (const f32x4*)gain + lane;
        if (final_) { GAS f32x4* fo = (GAS f32x4*)(fout + (size_t)row * DM) + lane;
#pragma unroll
            for (int j = 0; j < 8; ++j) { const f32x4 g = gr[64 * j]; fo[64 * j] = (f32x4){v[j].x * r * g.x, v[j].y * r * g.y, v[j].z * r * g.z, v[j].w * r * g.w}; }
        } else { GAS u32x2* o8 = (GAS u32x2*)(HNo + (size_t)row * DM) + lane; GAS u32x2* x8 = (GAS u32x2*)(xo + (size_t)row * DM) + lane;
#pragma unroll
            for (int j = 0; j < 8; ++j) { const f32x4 g = gr[64 * j]; x8[64 * j] = (u32x2){cvtpk(v[j].x, v[j].y), cvtpk(v[j].z, v[j].w)}; o8[64 * j] = (u32x2){cvtpk(v[j].x * r * g.x, v[j].y * r * g.y), cvtpk(v[j].z * r * g.z, v[j].w * r * g.w)}; } }
    }
}
struct MapPool { const char* A; const char* W; __device__ __forceinline__ void operator()(pg8::Unit& u) const {
    u.a = A + ((size_t)u.pm * 256 * DM + (size_t)(u.pn >> 1) * 512) * 2; u.b = W + ((size_t)(u.pn & 1) * 256 * DM + (size_t)(u.pn >> 1) * 512) * 2; } };
template <int W> __device__ __forceinline__ void pool_item4(const bf16_t* H, bf16_t* P, int row0, int c8) {
    const int t0 = row0 & (SEQ - 1); const bf16_t* base = H + (size_t)(row0 - t0) * DM + c8 * 8;
    u32x4 v[W + 3];
#pragma unroll
    for (int i = 0; i < W + 3; ++i) { int j = t0 - W / 2 + i; j = j < 0 ? 0 : (j > SEQ - 1 ? SEQ - 1 : j); v[i] = *(const u32x4*)(base + (size_t)j * DM); }
    float f[W + 3][8];
#pragma unroll
    for (int i = 0; i < W + 3; ++i) { const int j = t0 - W / 2 + i; const float m = (j >= 0 && j < SEQ) ? 1.f : 0.f;
        f[i][0] = m * __uint_as_float(v[i].x << 16); f[i][1] = m * __uint_as_float(v[i].x & 0xffff0000u); f[i][2] = m * __uint_as_float(v[i].y << 16); f[i][3] = m * __uint_as_float(v[i].y & 0xffff0000u);
        f[i][4] = m * __uint_as_float(v[i].z << 16); f[i][5] = m * __uint_as_float(v[i].z & 0xffff0000u); f[i][6] = m * __uint_as_float(v[i].w << 16); f[i][7] = m * __uint_as_float(v[i].w & 0xffff0000u); }
    float s[8];
#pragma unroll
    for (int c = 0; c < 8; ++c) { s[c] = 0.f;
#pragma unroll
        for (int i = 0; i < W; ++i) s[c] += f[i][c]; }
#pragma unroll
    for (int q = 0; q < 4; ++q) { const int t = t0 + q; int lo = t - W / 2, hi = t + W / 2; if (lo < 0) lo = 0; if (hi > SEQ) hi = SEQ; const float inv = 1.0f / (float)(hi - lo);
        if (q > 0) {
#pragma unroll
            for (int c = 0; c < 8; ++c) s[c] += f[q + W - 1][c] - f[q - 1][c]; }
        const float* e = f[q + W / 2];
        *(u32x4*)(P + (size_t)(row0 + q) * DM + c8 * 8) = (u32x4){cvtpk(s[0] * inv - e[0], s[1] * inv - e[1]), cvtpk(s[2] * inv - e[2], s[3] * inv - e[3]), cvtpk(s[4] * inv - e[4], s[5] * inv - e[5]), cvtpk(s[6] * inv - e[6], s[7] * inv - e[7])}; }
}
__device__ __forceinline__ void pool_phase(const Frame& F, const bf16_t* H, bf16_t* P) {
    const int lane = lane_id(); const int gwv = (int)blockIdx.x * NWAVES + F.wave, NWV = F.G * NWAVES;
    for (int wi = gwv; wi < NTOK; wi += NWV) {
        const int row0 = (wi >> 2) * 4, g = wi & 3, c8 = g * 64 + lane;
        if (g == 0) pool_item4<2>(H, P, row0, c8); else if (g == 1) pool_item4<4>(H, P, row0, c8); else if (g == 2) pool_item4<8>(H, P, row0, c8); else pool_item4<16>(H, P, row0, c8);
    }
}

constexpr int N_PHASES = 24;
#ifndef MK_N_LAUNCHES
#define MK_N_LAUNCHES 1
#endif
#ifndef REP_MASK
#define REP_MASK 0
#endif
__global__ void __launch_bounds__(NWAVES * 64, 2) skel_fwd(Args args) {
    extern __shared__ __attribute__((aligned(16))) unsigned char lds_raw[];
    Frame F;
    F.lds = (LAS unsigned char*)lds_raw; F.MISC = (volatile LAS unsigned*)(F.lds + MISC_OFF);
    F.wave = __builtin_amdgcn_readfirstlane(threadIdx.x >> 6);
    F.G = gridDim.x; { const int bx = blockIdx.x; F.vcu = (F.G % 8 == 0) ? (bx % 8) * (F.G / 8) + bx / 8 : bx; }
    F.ws = nullptr; F.ctl = (gu32*)(uptr(args.ws) + WS_CTL);
    for (int u = threadIdx.x; u < (LDS_BYTES - LDSCTL_OFF) / 4; u += NWAVES * 64) ((LAS unsigned*)(F.lds + LDSCTL_OFF))[u] = 0u;
    __syncthreads();
    const bool multi = (MK_N_LAUNCHES == 1) || (args.ph_hi - args.ph_lo) > 1 || REP_MASK != 0;
    XcdBarrier bar; bar.bar = (unsigned*)(F.ctl + CW_BAR); bar.x = 0; bar.st = nullptr; bar.wave = F.wave;
    if (multi) bar = xcd_barrier_post((unsigned*)(F.ctl + CW_BAR), F.MISC + 8, F.wave);
    const int lo = args.ph_lo, hi = args.ph_hi;
#ifdef REP_RT
    const unsigned rep_mask_ = (unsigned)__builtin_amdgcn_readfirstlane(args.pad);
#endif
#define IN(k) ((MK_N_LAUNCHES == 1) ? ((k) < N_PHASES) : (lo <= (k) && (k) < hi))
#ifdef REP_RT
#define REPBIT(k) ((int)((rep_mask_ >> (k)) & 1u))
#else
#define REPBIT(k) ((int)((((unsigned)REP_MASK) >> (k)) & 1u))
#endif
#define PHASE(k) _Pragma("unroll") for (int rep_ = 0; rep_ < 1 + REPBIT(k); ++rep_)
#define SEAM(k) do { if ((IN(k) && IN((k) + 1)) || rep_ + 1 < 1 + REPBIT(k)) xcd_barrier(bar); } while (0)
    LAS unsigned char* ring = F.lds + RING_OFF; LAS unsigned char* xl = F.lds + XL_OFF;
    const int bx = (int)blockIdx.x, G = F.G;

#define KV_PROJ(l, rotK, rotV) do {   \
            { MapLin mp{(const char*)(ws + WS_MEMNB + (size_t)(l) * NB * MEML * DM * 2), (const char*)(ws + WS_WCK_T + (size_t)(l) * DM * DM * 2), (size_t)256 * DM * 2, (size_t)256 * DM * 2}; \
              pg8::Sched<MapLin> S; S.init(NB * MEML / 256, DM / 256, G, (bx + G - ((rotK) % G)) % G, mp); \
              EpiStore<AddrLin> E{AddrLin{(bf16_t*)(ws + WS_KCB + (size_t)(l) * NB * MEML * DM * 2), DM}}; \
              pg8::gemm_phase<EpiStore<AddrLin>, pg8::Sched<MapLin>, true>(F.wave, ring, xl, DM, DM * 2, DM * 2, S, E); } \
            { MapLin mp{(const char*)(ws + WS_WCV_T + (size_t)(l) * DM * DM * 2), (const char*)(ws + WS_MEMNB + (size_t)(l) * NB * MEML * DM * 2), (size_t)256 * DM * 2, (size_t)256 * DM * 2}; \
              pg8::Sched<MapLin> S; S.init(DM / 256, NB * MEML / 256, G, (bx + G - ((rotV) % G)) % G, mp); \
              EpiStore<AddrLin> E{AddrLin{(bf16_t*)(ws + WS_VTB + (size_t)(l) * NB * MEML * DM * 2), NB * MEML}}; \
              pg8::gemm_phase<EpiStore<AddrLin>, pg8::Sched<MapLin>, true>(F.wave, ring, xl, DM, DM * 2, DM * 2, S, E); } } while (0)
#ifdef EXTRA_BARS
    for (int eb = 0; eb < EXTRA_BARS; ++eb) xcd_barrier(bar);
#endif
    if (IN(0)) PHASE(0) { const karg_t ka = kargs(); unsigned char* const ws = uptr(KWS(ka)); p0_prologue(F, ka, ws); SEAM(0); }
    if (IN(1)) PHASE(1) { const karg_t ka = kargs(); unsigned char* const ws = uptr(KWS(ka));
        {
            MapLin mp{(const char*)(ws + WS_HN), (const char*)(ws + WS_WIN_T), (size_t)256 * DM * 2, (size_t)256 * DM * 2};
            pg8::Sched<MapLin> S; S.init(NTOK / 256, 2560 / 256, G, bx, mp);
            EpiQKV E{(bf16_t*)(ws + WS_QB), (bf16_t*)(ws + WS_KB), (bf16_t*)(ws + WS_VB), KIN(ka, 4), KIN(ka, 5), (const float*)(ws + WS_ROPE), (const float*)(ws + WS_ROPE) + SEQ * 64};
            pg8::gemm_phase<EpiQKV, pg8::Sched<MapLin>, true>(F.wave, ring, xl, DM, DM * 2, DM * 2, S, E); }
        {
            MapLin mp{(const char*)(ws + WS_WF_T), (const char*)(ws + WS_HN), (size_t)256 * DM * 2, (size_t)256 * DM * 2};
            pg8::Sched<MapLin> S; S.init(1024 / 256, NTOK / 256, G, (bx + G - (320 % G)) % G, mp);
            EpiStore<AddrF1> E{AddrF1{(bf16_t*)(ws + WS_FPQ)}};
            pg8::gemm_phase<EpiStore<AddrF1>, pg8::Sched<MapLin>, true>(F.wave, ring, xl, DM, DM * 2, DM * 2, S, E); }
        KV_PROJ(0, 448, 480);
        SEAM(1);
    }
    if (IN(2)) PHASE(2) { const karg_t ka = kargs(); unsigned char* const ws = uptr(KWS(ka));
        const int nF2 = (G > 64) ? 64 : 0;
        if (bx < nF2 || nF2 == 0) {
            MapLin mp{(const char*)(ws + WS_DFT), (const char*)(ws + WS_FPQ), (size_t)256 * 4096 * 2, (size_t)256 * 4096 * 2};
            pg8::Sched<MapLin> S; S.init(8, 8, nF2 ? nF2 : G, bx, mp);
            EpiStore<AddrF2> E{AddrF2{(bf16_t*)(ws + WS_MIXB)}};
            pg8::gemm_phase<EpiStore<AddrF2>, pg8::Sched<MapLin>, true>(F.wave, ring, xl, 4096, 4096 * 2, 4096 * 2, S, E);
        }
        if (bx < nF2) { __syncthreads(); tr_span(F, ka, ws, 1, 7680 + bx * 8 + F.wave, 512, 9); __syncthreads(); }
        if (bx >= nF2) {
            const int a = bx - nF2, cnt = G - nF2, per = (384 + cnt - 1) / cnt, slot = a % 3; int ui = 0;
            for (int uid = a * per; uid < (a + 1) * per && uid < 384; ++uid, ++ui) {
                if (ui == slot) { __syncthreads(); tr_span(F, ka, ws, 1, a * 8 + F.wave, 1536, 5); __syncthreads(); }
                const int qb = uid & 7, hq = (uid >> 3) % NQH, b = uid / (8 * NQH), kvh = hq / 3;
                const bf16_t* Qb = (const bf16_t*)(ws + WS_QB) + ((size_t)b * SEQ + qb * 256) * AW + hq * HD;
                const bf16_t* Kh = (const bf16_t*)(ws + WS_KB) + (size_t)b * SEQ * KVW + kvh * HD;
                const bf16_t* Vh = (const bf16_t*)(ws + WS_VB) + (size_t)b * SEQ * KVW + kvh * HD;
                bf16_t* Ob = (bf16_t*)(ws + WS_MIXB) + ((size_t)b * SEQ + qb * 256) * DM + hq * HD;
                attn::attn_dense_body(Qb, Kh, Vh, Ob, SEQ, (char*)lds_raw + RING_OFF, F.wave);
            }
            if (slot >= ui) { __syncthreads(); tr_span(F, ka, ws, 1, a * 8 + F.wave, 1536, 5); __syncthreads(); }
        }
        SEAM(2);
    }
    if (IN(3)) PHASE(3) { const karg_t ka = kargs(); unsigned char* const ws = uptr(KWS(ka));
        MapLin mp{(const char*)(ws + WS_MIXB), (const char*)(ws + WS_WOUT_T), (size_t)256 * DM * 2, (size_t)256 * DM * 2};
        pg8::Sched<MapLin> S; S.init(NTOK / 256, DM / 256, G, bx, mp);
        EpiResB<true> E{KIN(ka, 0), (bf16_t*)(ws + WS_XB), (float*)(ws + WS_SSP), nullptr};
        pg8::gemm_phase<EpiResB<true>, pg8::Sched<MapLin>, true>(F.wave, ring, xl, DM, DM * 2, DM * 2, S, E);
        SEAM(3);
    }
    {
        constexpr int l = 0; constexpr int pb = l ? 15 : 4;
        if (l == 1) {
            if (IN(13)) PHASE(13) { const karg_t ka = kargs(); unsigned char* const ws = uptr(KWS(ka));
                pool_phase(F, (const bf16_t*)(ws + WS_HN), (bf16_t*)(ws + WS_QCB));
#ifdef PROBE_CONV
                tr_span<TRV>(F, ka, ws, 1, bx * 8 + F.wave, 2048, 6);
#endif
                SEAM(13);
            }
            if (IN(14)) PHASE(14) { const karg_t ka = kargs(); unsigned char* const ws = uptr(KWS(ka));
                MapPool mp{(const char*)(ws + WS_QCB), (const char*)(ws + WS_WP_T)};
                pg8::Sched<MapPool> S; S.init(NTOK / 256, DM / 256, G, bx, mp);
                EpiResB<false> E{(const bf16_t*)(ws + WS_XB), (bf16_t*)(ws + WS_XALT), (float*)(ws + WS_SSP), KIN(ka, 9)};
                pg8::gemm_phase<EpiResB<false>, pg8::Sched<MapPool>, true>(F.wave, ring, xl, 512, DM * 2, DM * 2, S, E);
                SEAM(14);
            }
        }
        if (IN(pb + 0)) PHASE(pb + 0) { const karg_t ka = kargs(); unsigned char* const ws = uptr(KWS(ka));
            MapLin mp{(const char*)(ws + (l == 0 ? WS_XB : WS_XALT)), (const char*)(ws + WS_WCQ_T + (size_t)l * DM * DM * 2), (size_t)256 * DM * 2, (size_t)256 * DM * 2};
            pg8::Sched<MapLin> S; S.init(NTOK / 256, DM / 256, G, bx, mp);
            EpiRowScale E{(bf16_t*)(ws + WS_QCB), DM, (const float*)(ws + WS_SSP), 0.04419417382415922f};
            pg8::gemm_phase<EpiRowScale, pg8::Sched<MapLin>, true>(F.wave, ring, xl, DM, DM * 2, DM * 2, S, E);
            SEAM(pb + 0);
        }
        if (IN(pb + 1)) PHASE(pb + 1) { const karg_t ka = kargs(); unsigned char* const ws = uptr(KWS(ka));
            MapXS mp{(const char*)(ws + WS_QCB), (const char*)(ws + WS_KCB + (size_t)l * NB * MEML * DM * 2)};
            pg8::Sched<MapXS> S; S.init(NTOK / 256, NMH, G, bx, mp);
            EpiSoftmax E{(bf16_t*)(ws + WS_PB), NMH * MEML};
            pg8::gemm_phase<EpiSoftmax, pg8::Sched<MapXS>, true>(F.wave, ring, xl, MHD, DM * 2, DM * 2, S, E);
            if (l == 0) { KV_PROJ(1, 128, 160);
                if (bx < 128) { __syncthreads(); tr_span(F, ka, ws, 2, bx * 8 + F.wave, 1024, 2); }
                else if (bx >= 192) { tr_span(F, ka, ws, 2, 2048 + (bx - 192) * 8 + F.wave, 512, 1); } }
            SEAM(pb + 1);
        }
        if (IN(pb + 2)) PHASE(pb + 2) { const karg_t ka = kargs(); unsigned char* const ws = uptr(KWS(ka));
            MapXPV mp{(const char*)(ws + WS_PB), (const char*)(ws + WS_VTB + (size_t)l * NB * MEML * DM * 2)};
            pg8::Sched<MapXPV> S; S.init(NTOK / 256, DM / 256, G, bx, mp);
            EpiStore<AddrLin> E{AddrLin{(bf16_t*)(ws + WS_MIXB), DM}};
            pg8::gemm_phase<EpiStore<AddrLin>, pg8::Sched<MapXPV>, true>(F.wave, ring, xl, MEML, NMH * MEML * 2, NB * MEML * 2, S, E);
            SEAM(pb + 2);
        }
        if (IN(pb + 3)) PHASE(pb + 3) { const karg_t ka = kargs(); unsigned char* const ws = uptr(KWS(ka));
            MapLin mp{(const char*)(ws + WS_MIXB), (const char*)(ws + WS_WCO_T + (size_t)l * DM * DM * 2), (size_t)256 * DM * 2, (size_t)256 * DM * 2};
            pg8::Sched<MapLin> S; S.init(NTOK / 256, DM / 256, G, bx, mp);
            EpiResB<false> E{(const bf16_t*)(ws + (l == 0 ? WS_XB : WS_XALT)), (bf16_t*)(ws + (l == 0 ? WS_XALT : WS_XB)), nullptr, nullptr};
            pg8::gemm_phase<EpiResB<false>, pg8::Sched<MapLin>, true>(F.wave, ring, xl, DM, DM * 2, DM * 2, S, E);
            SEAM(pb + 3);
        }
        if (IN(pb + 4)) PHASE(pb + 4) { const karg_t ka = kargs(); unsigned char* const ws = uptr(KWS(ka));
            router_phase(F, (const bf16_t*)(ws + (l == 0 ? WS_XALT : WS_XB)), (const u32x4*)(ws + WS_AFF + 512 * 1024) + (size_t)l * 8192, (float*)(ws + WS_SSP + 512 * 1024), (float*)(ws + WS_AFF), xl);
            SEAM(pb + 4);
        }
        if (IN(pb + 5)) PHASE(pb + 5) { const karg_t ka = kargs(); unsigned char* const ws = uptr(KWS(ka));
            rank_phase(F, (const float*)(ws + WS_AFF), (int*)(ws + WS_RANK), (float*)(ws + WS_GATE), (const float*)(ws + WS_SSP + 512 * 1024), (float*)(ws + WS_SSP + 768 * 1024), (int*)(ws + WS_GATE + 512 * 1024));
            if (l == 0 && bx >= NB * NE) tr_span(F, ka, ws, 2, 2560 + (bx - NB * NE) * 8 + F.wave, 1536, 1);
            SEAM(pb + 5);
        }
        if (IN(pb + 6)) PHASE(pb + 6) { const karg_t ka = kargs(); unsigned char* const ws = uptr(KWS(ka));
            MapMoE mp{(const char*)(ws + (l == 0 ? WS_XALT : WS_XB)), (const char*)(ws + (l ? WS_WGU_T2 : WS_WGU_T)), (size_t)0, (size_t)2048 * DM * 2, (size_t)256 * DM * 2};
            pg8::Sched<MapMoE> S; S.init(NB * NE, 8, G, bx, mp);
            EpiSwiGLU E{(bf16_t*)(ws + WS_ACTB), (const float*)(ws + WS_SSP + 768 * 1024)};
            const bool cfirst = ((bx >> 3) & 1) != 0;
            if (l == 0 && cfirst) { tr_span(F, ka, ws, 2, 4096 + bx * 8 + F.wave, 2048, 2); __syncthreads(); }
            pg8::gemm_phase<EpiSwiGLU, pg8::Sched<MapMoE>, true, true>(F.wave, ring, xl, DM, DM * 2, DM * 2, S, E, (const int*)(ws + WS_GATE + 512 * 1024));
            if (l == 0 && !cfirst) { __syncthreads(); tr_span(F, ka, ws, 2, 4096 + bx * 8 + F.wave, 2048, 2); }
            SEAM(pb + 6);
        }
        if (IN(pb + 7)) PHASE(pb + 7) { const karg_t ka = kargs(); unsigned char* const ws = uptr(KWS(ka));
            MapMoE mp{(const char*)(ws + WS_ACTB), (const char*)(ws + (l ? WS_WD_T2 : WS_WD_T)), (size_t)256 * EFF * 2, (size_t)2048 * EFF * 2, (size_t)256 * EFF * 2};
            pg8::Sched<MapMoE> S; S.init(NB * NE, 8, G, bx, mp);
            EpiRowGate E{(bf16_t*)(ws + WS_YB), (const float*)(ws + WS_GATE)};
            const bool cfirst = ((bx >> 3) & 1) == 0;
            if (l == 0 && cfirst) { tr_span(F, ka, ws, 2, 8192 + bx * 8 + F.wave, 2048, 2); __syncthreads(); }
            pg8::gemm_phase<EpiRowGate, pg8::Sched<MapMoE>, true>(F.wave, ring, xl, EFF, EFF * 2, EFF * 2, S, E);
            if (l == 0 && !cfirst) { __syncthreads(); tr_span(F, ka, ws, 2, 8192 + bx * 8 + F.wave, 2048, 2); }
            SEAM(pb + 7);
        }
        if (IN(pb + 8)) PHASE(pb + 8) { const karg_t ka = kargs(); unsigned char* const ws = uptr(KWS(ka));
            combine_phase(F, (const bf16_t*)(ws + (l == 0 ? WS_XALT : WS_XB)), (bf16_t*)(ws + WS_XB), KOUT(ka), (const bf16_t*)(ws + WS_YB), (const int*)(ws + WS_RANK), l == 0 ? KIN(ka, 2) + DM : KIN(ka, 21), (bf16_t*)(ws + WS_HN), l == 1);
            SEAM(pb + 8);
        }
    }
    {
        constexpr int l = 1; constexpr int pb = l ? 15 : 4;
        if (l == 1) {
            if (IN(13)) PHASE(13) { const karg_t ka = kargs(); unsigned char* const ws = uptr(KWS(ka));
                pool_phase(F, (const bf16_t*)(ws + WS_HN), (bf16_t*)(ws + WS_QCB));
#ifdef PROBE_CONV
                tr_span<TRV>(F, ka, ws, 1, bx * 8 + F.wave, 2048, 6);
#endif
                SEAM(13);
            }
            if (IN(14)) PHASE(14) { const karg_t ka = kargs(); unsigned char* const ws = uptr(KWS(ka));
                MapPool mp{(const char*)(ws + WS_QCB), (const char*)(ws + WS_WP_T)};
                pg8::Sched<MapPool> S; S.init(NTOK / 256, DM / 256, G, bx, mp);
                EpiResB<false> E{(const bf16_t*)(ws + WS_XB), (bf16_t*)(ws + WS_XALT), (float*)(ws + WS_SSP), KIN(ka, 9)};
                pg8::gemm_phase<EpiResB<false>, pg8::Sched<MapPool>, true>(F.wave, ring, xl, 512, DM * 2, DM * 2, S, E);
                SEAM(14);
            }
        }
        if (IN(pb + 0)) PHASE(pb + 0) { const karg_t ka = kargs(); unsigned char* const ws = uptr(KWS(ka));
            MapLin mp{(const char*)(ws + (l == 0 ? WS_XB : WS_XALT)), (const char*)(ws + WS_WCQ_T + (size_t)l * DM * DM * 2), (size_t)256 * DM * 2, (size_t)256 * DM * 2};
            pg8::Sched<MapLin> S; S.init(NTOK / 256, DM / 256, G, bx, mp);
            EpiRowScale E{(bf16_t*)(ws + WS_QCB), DM, (const float*)(ws + WS_SSP), 0.04419417382415922f};
            pg8::gemm_phase<EpiRowScale, pg8::Sched<MapLin>, true>(F.wave, ring, xl, DM, DM * 2, DM * 2, S, E);
            SEAM(pb + 0);
        }
        if (IN(pb + 1)) PHASE(pb + 1) { const karg_t ka = kargs(); unsigned char* const ws = uptr(KWS(ka));
            MapXS mp{(const char*)(ws + WS_QCB), (const char*)(ws + WS_KCB + (size_t)l * NB * MEML * DM * 2)};
            pg8::Sched<MapXS> S; S.init(NTOK / 256, NMH, G, bx, mp);
            EpiSoftmax E{(bf16_t*)(ws + WS_PB), NMH * MEML};
            pg8::gemm_phase<EpiSoftmax, pg8::Sched<MapXS>, true>(F.wave, ring, xl, MHD, DM * 2, DM * 2, S, E);
            if (l == 0) { KV_PROJ(1, 128, 160);
                if (bx < 128) { __syncthreads(); tr_span(F, ka, ws, 2, bx * 8 + F.wave, 1024, 2); }
                else if (bx >= 192) { tr_span(F, ka, ws, 2, 2048 + (bx - 192) * 8 + F.wave, 512, 1); } }
            SEAM(pb + 1);
        }
        if (IN(pb + 2)) PHASE(pb + 2) { const karg_t ka = kargs(); unsigned char* const ws = uptr(KWS(ka));
            MapXPV mp{(const char*)(ws + WS_PB), (const char*)(ws + WS_VTB + (size_t)l * NB * MEML * DM * 2)};
            pg8::Sched<MapXPV> S; S.init(NTOK / 256, DM / 256, G, bx, mp);
            EpiStore<AddrLin> E{AddrLin{(bf16_t*)(ws + WS_MIXB), DM}};
            pg8::gemm_phase<EpiStore<AddrLin>, pg8::Sched<MapXPV>, true>(F.wave, ring, xl, MEML, NMH * MEML * 2, NB * MEML * 2, S, E);
            SEAM(pb + 2);
        }
        if (IN(pb + 3)) PHASE(pb + 3) { const karg_t ka = kargs(); unsigned char* const ws = uptr(KWS(ka));
            MapLin mp{(const char*)(ws + WS_MIXB), (const char*)(ws + WS_WCO_T + (size_t)l * DM * DM * 2), (size_t)256 * DM * 2, (size_t)256 * DM * 2};
            pg8::Sched<MapLin> S; S.init(NTOK / 256, DM / 256, G, bx, mp);
            EpiResB<false> E{(const bf16_t*)(ws + (l == 0 ? WS_XB : WS_XALT)), (bf16_t*)(ws + (l == 0 ? WS_XALT : WS_XB)), nullptr, nullptr};
            pg8::gemm_phase<EpiResB<false>, pg8::Sched<MapLin>, true>(F.wave, ring, xl, DM, DM * 2, DM * 2, S, E);
            SEAM(pb + 3);
        }
        if (IN(pb + 4)) PHASE(pb + 4) { const karg_t ka = kargs(); unsigned char* const ws = uptr(KWS(ka));
            router_phase(F, (const bf16_t*)(ws + (l == 0 ? WS_XALT : WS_XB)), (const u32x4*)(ws + WS_AFF + 512 * 1024) + (size_t)l * 8192, (float*)(ws + WS_SSP + 512 * 1024), (float*)(ws + WS_AFF), xl);
            SEAM(pb + 4);
        }
        if (IN(pb + 5)) PHASE(pb + 5) { const karg_t ka = kargs(); unsigned char* const ws = uptr(KWS(ka));
            rank_phase(F, (const float*)(ws + WS_AFF), (int*)(ws + WS_RANK), (float*)(ws + WS_GATE), (const float*)(ws + WS_SSP + 512 * 1024), (float*)(ws + WS_SSP + 768 * 1024), (int*)(ws + WS_GATE + 512 * 1024));
            if (l == 0 && bx >= NB * NE) tr_span(F, ka, ws, 2, 2560 + (bx - NB * NE) * 8 + F.wave, 1536, 1);
            SEAM(pb + 5);
        }
        if (IN(pb + 6)) PHASE(pb + 6) { const karg_t ka = kargs(); unsigned char* const ws = uptr(KWS(ka));
            MapMoE mp{(const char*)(ws + (l == 0 ? WS_XALT : WS_XB)), (const char*)(ws + (l ? WS_WGU_T2 : WS_WGU_T)), (size_t)0, (size_t)2048 * DM * 2, (size_t)256 * DM * 2};
            pg8::Sched<MapMoE> S; S.init(NB * NE, 8, G, bx, mp);
            EpiSwiGLU E{(bf16_t*)(ws + WS_ACTB), (const float*)(ws + WS_SSP + 768 * 1024)};
            const bool cfirst = ((bx >> 3) & 1) != 0;
            if (l == 0 && cfirst) { tr_span(F, ka, ws, 2, 4096 + bx * 8 + F.wave, 2048, 2); __syncthreads(); }
            pg8::gemm_phase<EpiSwiGLU, pg8::Sched<MapMoE>, true, true>(F.wave, ring, xl, DM, DM * 2, DM * 2, S, E, (const int*)(ws + WS_GATE + 512 * 1024));
            if (l == 0 && !cfirst) { __syncthreads(); tr_span(F, ka, ws, 2, 4096 + bx * 8 + F.wave, 2048, 2); }
            SEAM(pb + 6);
        }
        if (IN(pb + 7)) PHASE(pb + 7) { const karg_t ka = kargs(); unsigned char* const ws = uptr(KWS(ka));
            MapMoE mp{(const char*)(ws + WS_ACTB), (const char*)(ws + (l ? WS_WD_T2 : WS_WD_T)), (size_t)256 * EFF * 2, (size_t)2048 * EFF * 2, (size_t)256 * EFF * 2};
            pg8::Sched<MapMoE> S; S.init(NB * NE, 8, G, bx, mp);
            EpiRowGate E{(bf16_t*)(ws + WS_YB), (const float*)(ws + WS_GATE)};
            const bool cfirst = ((bx >> 3) & 1) == 0;
            if (l == 0 && cfirst) { tr_span(F, ka, ws, 2, 8192 + bx * 8 + F.wave, 2048, 2); __syncthreads(); }
            pg8::gemm_phase<EpiRowGate, pg8::Sched<MapMoE>, true>(F.wave, ring, xl, EFF, EFF * 2, EFF * 2, S, E);
            if (l == 0 && !cfirst) { __syncthreads(); tr_span(F, ka, ws, 2, 8192 + bx * 8 + F.wave, 2048, 2); }
            SEAM(pb + 7);
        }
        if (IN(pb + 8)) PHASE(pb + 8) { const karg_t ka = kargs(); unsigned char* const ws = uptr(KWS(ka));
            combine_phase(F, (const bf16_t*)(ws + (l == 0 ? WS_XALT : WS_XB)), (bf16_t*)(ws + WS_XB), KOUT(ka), (const bf16_t*)(ws + WS_YB), (const int*)(ws + WS_RANK), l == 0 ? KIN(ka, 2) + DM : KIN(ka, 21), (bf16_t*)(ws + WS_HN), l == 1);
            SEAM(pb + 8);
        }
    }
#undef IN
#undef SEAM
#undef PHASE
#undef KV_PROJ
}


extern "C" void kernel_launch(void* const* d_in, const int* in_sizes, int n_in, void* d_out, int out_size, void* d_ws, size_t ws_size, hipStream_t stream) {
    static int grid = 0;
    if (grid == 0) {
        int dev = 0, cus = 0;
        if (n_in != 22 || out_size != NTOK * DM || ws_size < WS_FAST_END) { fprintf(stderr, "kernel_launch: unexpected shapes (n_in %d out %d ws %zu)\n", n_in, out_size, ws_size); grid = -1; return; }
        if (hipGetDevice(&dev) != hipSuccess || hipDeviceGetAttribute(&cus, hipDeviceAttributeMultiprocessorCount, dev) != hipSuccess) { fprintf(stderr, "device query failed\n"); grid = -1; return; }
        if (hipFuncSetAttribute((const void*)skel_fwd, hipFuncAttributeMaxDynamicSharedMemorySize, LDS_BYTES) != hipSuccess) { fprintf(stderr, "hipFuncSetAttribute failed\n"); grid = -1; return; }
        (void)hipGetLastError();
        grid = cus;
        if (grid != 256) { fprintf(stderr, "kernel_launch: this kernel is laid out for 256 CUs (found %d)\n", cus); grid = -1; return; }
    }
    if (grid < 0) return;
    (void)hipMemsetAsync((char*)d_ws + WS_CTL, 0, 32768, stream);
    Args a{};
    for (int i = 0; i < 22; ++i) a.in[i] = (const float*)d_in[i];
    a.out = (float*)d_out; a.ws = (unsigned char*)d_ws;
#ifdef REP_RT
    a.pad = REP_RT;
#endif
    constexpr int NL = MK_N_LAUNCHES;
    for (int li = 0; li < NL; ++li) {
        a.ph_lo = (N_PHASES * li) / NL; a.ph_hi = (N_PHASES * (li + 1)) / NL; a.li = li;
        hipLaunchKernelGGL(skel_fwd, dim3(grid), dim3(NWAVES * 64), LDS_BYTES, stream, a);
    }
}
```

```cpp
#include <hip/hip_runtime.h>
#include <cstdio>
#include <cstdint>

constexpr int DM = 2048, NB = 4, SEQ = 2048, NTOK = NB * SEQ;
constexpr int HD = 128, NQH = 12, NKVH = 4, AW = NQH * HD, KVW = NKVH * HD, FW = 512, INW = 3072;
constexpr int MEML = 256, NMH = 4, MHD = 512;
constexpr int NE = 16, EFF = 1024, CAP = 256;
constexpr float EPS = 1e-6f;

#define LAS __attribute__((address_space(3)))
#define GAS __attribute__((address_space(1)))
typedef unsigned short bf16_t;
typedef short bf16x8 __attribute__((ext_vector_type(8)));
typedef float f32x4 __attribute__((ext_vector_type(4)));
typedef float f32x2 __attribute__((ext_vector_type(2)));
typedef unsigned u32x4 __attribute__((ext_vector_type(4)));
typedef unsigned u32x2 __attribute__((ext_vector_type(2)));
typedef __bf16 bf16x2_t __attribute__((ext_vector_type(2)));
__device__ __forceinline__ unsigned cvtpk(float lo, float hi) { f32x2 v = {lo, hi}; bf16x2_t b = __builtin_convertvector(v, bf16x2_t); return __builtin_bit_cast(unsigned, b); }
__device__ __forceinline__ float bf2f(unsigned short h) { return __uint_as_float(((unsigned)h) << 16); }
template <class T> __device__ __forceinline__ T* uptr(T* p) { const unsigned long long v = (unsigned long long)p; const unsigned lo = __builtin_amdgcn_readfirstlane((unsigned)v), hi = __builtin_amdgcn_readfirstlane((unsigned)(v >> 32)); return (T*)(((unsigned long long)hi << 32) | lo); }
__device__ __forceinline__ int lane_id() { int l = (int)__builtin_amdgcn_mbcnt_hi(~0u, __builtin_amdgcn_mbcnt_lo(~0u, 0u)); asm volatile("" : "+v"(l)); return l; }
typedef __attribute__((address_space(4))) const unsigned char* karg_t;
__device__ __forceinline__ karg_t kargs() { karg_t p = (karg_t)__builtin_amdgcn_kernarg_segment_ptr(); asm volatile("" : "+s"(p)); return p; }
#define KIN(ka, i) (*(const float* const __attribute__((address_space(4)))*)((ka) + 8 * (i)))
#define KOUT(ka) (*(float* const __attribute__((address_space(4)))*)((ka) + 176))
#define KWS(ka) (*(unsigned char* const __attribute__((address_space(4)))*)((ka) + 184))
#ifndef EPI_WT
#define EPI_WT 0
#endif
__device__ __forceinline__ void st16(void* p, u32x4 v) {
#if EPI_WT
    asm volatile("global_store_dwordx4 %0, %1, off sc1\n\ts_nop 1" :: "v"(p), "v"(v) : "memory");
#else
    *(u32x4*)p = v;
#endif
}
#define LDS_WAIT() asm volatile("s_waitcnt lgkmcnt(0)" ::: "memory")
#define VM_WAIT() asm volatile("s_waitcnt vmcnt(0)" ::: "memory")
#define WG_BAR() do { asm volatile("s_waitcnt lgkmcnt(0)" ::: "memory"); __builtin_amdgcn_s_barrier(); asm volatile("" ::: "memory"); } while (0)

namespace pg8 {
constexpr int BM = 256, BK = 64, HALF = 128, HTB = HALF * BK * 2, STAGE_BYTES = 8 * HTB, NXCD = 8, WGM = 8;
__host__ __device__ __forceinline__ int lds_byte(int r, int c) { const int st = (r >> 4) * 2 + (c >> 5), rr = r & 15, cc = c & 31, ob = rr * 64 + cc * 2; return st * 1024 + (ob ^ (((ob >> 9) & 1) << 5)); }
__host__ __device__ __forceinline__ void stage_rc(int b, int& R, int& C) { const int st = b / 1024, sb = b % 1024, swz = sb ^ (((sb >> 9) & 1) << 5); R = (st >> 1) * 16 + swz / 64; C = (st & 1) * 32 + (swz % 64) / 2; }
__host__ __device__ __forceinline__ int perm32(int rho) { const int n = rho >> 4, i = rho & 15; return 8 * (i >> 2) + 4 * n + (i & 3); }

struct Unit { int pm, pn; const char* a; const char* b; };
struct EpiCtx { int wr, wc, wid; LAS unsigned char* xl; };

template <class Map> struct Sched {
    int nM, nN, nwg, G, c; Map map;
    __device__ __forceinline__ void init(int nM_, int nN_, int G_, int c_, const Map& m) { nM = nM_; nN = nN_; nwg = nM * nN; G = G_; c = c_; map = m; }
    __device__ __forceinline__ bool next(int i, Unit& u) const {
        const long L = (long)i * G + c; if (L >= nwg) return false;
        int wgid = (int)L; { const int q = nwg / NXCD, r = nwg % NXCD, xcd = wgid % NXCD, off = wgid / NXCD; wgid = (xcd < r ? xcd * (q + 1) : r * (q + 1) + (xcd - r) * q) + off; }
        const int nig = WGM * nN, gid = wgid / nig, fm = gid * WGM, gsz = (nM - fm) < WGM ? (nM - fm) : WGM;
        u.pm = fm + ((wgid % nig) % gsz); u.pn = (wgid % nig) / gsz; map(u); return true;
    }
};

template <class Epi, class SchedT, bool SP2, bool GATHER = false>
__device__ __forceinline__ void gemm_phase(const int wave_, LAS unsigned char* lds, LAS unsigned char* xl, const int K, const int lda, const int ldb, const SchedT& S, const Epi& E, const int* gidx = nullptr) {
    constexpr bool ALIGN_EPI = true; static_assert(SP2 || !GATHER, "GATHER needs the SP2 loop");
    const int lane = lane_id(), wid = wave_, tid = wid * 64 + lane, wr = wid >> 2, wc = wid & 3, fr = lane & 15, fq = lane >> 4;
    const int nt = K / BK;
    unsigned voffA[2], voffB[2];
#pragma unroll
    for (int i = 0; i < 2; ++i) { int R, C; stage_rc(tid * 16 + i * 8192, R, C); const int Rb = Epi::PERM ? ((R & ~31) + perm32(R & 31)) : R;
        voffA[i] = (unsigned)(R * lda + C * 2); voffB[i] = (unsigned)(Rb * ldb + C * 2); }
    const size_t kstep = (size_t)(BK * 2);
    const size_t hstepA = (size_t)HALF * lda, hstepB = (size_t)HALF * ldb;
    const unsigned ldsw = (unsigned)wid * 1024u;
    const int aoff = lds_byte(wr * 64 + fr, fq * 8), boff = lds_byte(wc * 32 + fr, fq * 8);
    const unsigned xoffA = (unsigned)tid * 16u;
    int gset = 0;
#define PG8_GSETUP(set, pm_) do { if constexpr (GATHER) { int R0_, C0_, R1_, C1_; stage_rc(tid * 16, R0_, C0_); stage_rc(tid * 16 + 8192, R1_, C1_); \
        const GAS int* gi_ = (const GAS int*)gidx + (pm_) * 256; const int r00_ = gi_[R0_], r01_ = gi_[R1_], r10_ = gi_[128 + R0_], r11_ = gi_[128 + R1_];     \
        *(LAS u32x4*)(xl + (set) * 8192 + xoffA) = (u32x4){(unsigned)(r00_ * lda + C0_ * 2), (unsigned)(r01_ * lda + C1_ * 2), (unsigned)(r10_ * lda + C0_ * 2), (unsigned)(r11_ * lda + C1_ * 2)}; } } while (0)
#define PG8_SA(b, h) (((b) * 2 + (h)) * HTB)
#define PG8_SB(b, h) ((4 + (b) * 2 + (h)) * HTB)
#define PG8_STAGE(bufoff, gbase, voff) do { _Pragma("unroll") for (int _i = 0; _i < 2; ++_i) \
        __builtin_amdgcn_global_load_lds((const unsigned*)((const char*)(gbase) + (voff)[_i]), (LAS unsigned*)(lds + (bufoff) + ldsw + _i * 8192), 16, 0, 0); } while (0)
#define PG8_GOFF(h_, set_) u32x2 go_ = {0u, 0u}; if constexpr (GATHER) go_ = *(const LAS u32x2*)(xl + (set_) * 8192 + xoffA + (h_) * 8)
#define PG8_STAGE_A(bufoff, gbase, h_, set_) do { if constexpr (GATHER) { \
        __builtin_amdgcn_global_load_lds((const unsigned*)((const char*)(gbase) + go_.x), (LAS unsigned*)(lds + (bufoff) + ldsw), 16, 0, 0); \
        __builtin_amdgcn_global_load_lds((const unsigned*)((const char*)(gbase) + go_.y), (LAS unsigned*)(lds + (bufoff) + ldsw + 8192), 16, 0, 0); } \
      else { PG8_STAGE(bufoff, (const char*)(gbase) + (h_) * hstepA, voffA); } } while (0)
#define PG8_LDA(dst, b, h) do { _Pragma("unroll") for (int m = 0; m < 4; ++m) _Pragma("unroll") for (int k = 0; k < 2; ++k) dst[m][k] = *(const LAS bf16x8*)(lds + PG8_SA(b, h) + aoff + m * 2048 + k * 1024); } while (0)
#define PG8_LDB(dst, b, h) do { _Pragma("unroll") for (int n = 0; n < 2; ++n) _Pragma("unroll") for (int k = 0; k < 2; ++k) dst[n][k] = *(const LAS bf16x8*)(lds + PG8_SB(b, h) + boff + n * 2048 + k * 1024); } while (0)
#define PG8_MMA(ai, bj, At, Bt) do { __builtin_amdgcn_s_setprio(1); _Pragma("unroll") for (int m = 0; m < 4; ++m) _Pragma("unroll") for (int n = 0; n < 2; ++n) _Pragma("unroll") for (int k = 0; k < 2; ++k) \
        acc[ai][bj][m][n] = __builtin_amdgcn_mfma_f32_16x16x32_bf16(Bt[n][k], At[m][k], acc[ai][bj][m][n], 0, 0, 0); __builtin_amdgcn_s_setprio(0); } while (0)
#define PG8_WAIT_V(n) asm volatile("s_waitcnt vmcnt(" #n ")" ::: "memory")
#define PG8_WAIT_L(n) asm volatile("s_waitcnt lgkmcnt(" #n ")" ::: "memory")
#define PG8_BAR __builtin_amdgcn_s_barrier()
#define PG8_SCHED __builtin_amdgcn_sched_barrier(0)
    Unit cur, nxt; int ui = 0;
    if (!S.next(0, cur)) return;
    EpiCtx ctx; ctx.wr = wr; ctx.wc = wc; ctx.wid = wid; ctx.xl = xl;
    f32x4 acc[2][2][4][2];
#pragma unroll
    for (int a = 0; a < 2; ++a)
#pragma unroll
        for (int b = 0; b < 2; ++b)
#pragma unroll
            for (int m = 0; m < 4; ++m)
#pragma unroll
                for (int n = 0; n < 2; ++n) acc[a][b][m][n] = (f32x4){0.f, 0.f, 0.f, 0.f};
    bf16x8 At[4][2], B0[2][2], B1[2][2];
    const char* cA = cur.a; const char* cB = cur.b;
    PG8_GSETUP(0, cur.pm);
    if constexpr (SP2) {
        PG8_STAGE(PG8_SB(0, 0), cB, voffB); PG8_STAGE(PG8_SB(0, 1), cB + hstepB, voffB); { PG8_GOFF(0, 0); PG8_STAGE_A(PG8_SA(0, 0), cA, 0, 0); } { PG8_GOFF(1, 0); PG8_STAGE_A(PG8_SA(0, 1), cA, 1, 0); }
        if (wr == 1) PG8_BAR;
        PG8_WAIT_V(2); PG8_BAR;
        PG8_STAGE(PG8_SB(1, 0), cB + kstep, voffB); { PG8_GOFF(0, 0); PG8_STAGE_A(PG8_SA(1, 0), cA + kstep, 0, 0); } PG8_STAGE(PG8_SB(1, 1), cB + hstepB + kstep, voffB);
        PG8_WAIT_V(6); PG8_BAR;
    } else {
        PG8_STAGE(PG8_SB(0, 0), cB, voffB); PG8_STAGE(PG8_SA(0, 0), cA, voffA); PG8_STAGE(PG8_SB(0, 1), cB + hstepB, voffB); PG8_STAGE(PG8_SA(0, 1), cA + hstepA, voffA);
        if (wr == 1) PG8_BAR;
        PG8_WAIT_V(4); PG8_BAR;
        PG8_STAGE(PG8_SB(1, 0), cB + kstep, voffB); PG8_STAGE(PG8_SA(1, 0), cA + kstep, voffA); PG8_STAGE(PG8_SB(1, 1), cB + hstepB + kstep, voffB);
        PG8_WAIT_V(6); PG8_BAR;
    }
    for (;;) {
        const bool has_next = S.next(ui + 1, nxt);
        const char* nA = has_next ? nxt.a : cA; const char* nB = has_next ? nxt.b : cB;
        if (has_next) PG8_GSETUP(gset ^ 1, nxt.pm);
        for (int t = 0; t < nt; t += 2) {
            const bool last = (t == nt - 2);
            const char* a1 = cA + (size_t)(t + 1) * kstep;
            const char* a2 = last ? nA : cA + (size_t)(t + 2) * kstep; const char* b2 = last ? nB : cB + (size_t)(t + 2) * kstep;
            const char* a3 = a2 + kstep; const char* b3 = b2 + kstep;
            const int set2 = (last && has_next) ? (gset ^ 1) : gset;
            if constexpr (SP2) {
            { PG8_GOFF(1, gset); PG8_LDB(B0, 0, 0); PG8_LDB(B1, 0, 1); PG8_SCHED; PG8_LDA(At, 0, 0); PG8_STAGE_A(PG8_SA(1, 1), a1, 1, gset); }
            PG8_WAIT_V(8); PG8_WAIT_L(0); PG8_BAR; PG8_MMA(0, 0, At, B0); PG8_MMA(0, 1, At, B1); PG8_BAR; PG8_SCHED;
            { PG8_GOFF(0, set2); PG8_LDA(At, 0, 1); PG8_STAGE(PG8_SB(0, 0), b2, voffB); PG8_STAGE(PG8_SB(0, 1), b2 + hstepB, voffB); PG8_STAGE_A(PG8_SA(0, 0), a2, 0, set2); }
            PG8_WAIT_V(8); PG8_WAIT_L(0); PG8_BAR; PG8_MMA(1, 0, At, B0); PG8_MMA(1, 1, At, B1); PG8_BAR; PG8_SCHED;
            { PG8_GOFF(1, set2); PG8_LDB(B0, 1, 0); PG8_LDB(B1, 1, 1); PG8_SCHED; PG8_LDA(At, 1, 0); PG8_STAGE_A(PG8_SA(0, 1), a2, 1, set2); }
            PG8_WAIT_V(8); PG8_WAIT_L(0); PG8_BAR; PG8_MMA(0, 0, At, B0); PG8_MMA(0, 1, At, B1); PG8_BAR; PG8_SCHED;
            { PG8_GOFF(0, set2); PG8_LDA(At, 1, 1); PG8_STAGE(PG8_SB(1, 0), b3, voffB); PG8_STAGE(PG8_SB(1, 1), b3 + hstepB, voffB); PG8_STAGE_A(PG8_SA(1, 0), a3, 0, set2); }
            PG8_WAIT_V(8); PG8_WAIT_L(0); PG8_BAR; PG8_MMA(1, 0, At, B0); PG8_MMA(1, 1, At, B1); PG8_BAR; PG8_SCHED;
            } else {
            PG8_LDB(B0, 0, 0); PG8_SCHED; PG8_LDA(At, 0, 0); PG8_STAGE(PG8_SA(1, 1), a1 + hstepA, voffA);
            PG8_WAIT_L(8); PG8_BAR; PG8_WAIT_L(0); PG8_MMA(0, 0, At, B0); PG8_BAR; PG8_SCHED;
            PG8_LDB(B1, 0, 1); PG8_STAGE(PG8_SB(0, 0), b2, voffB);
            PG8_BAR; PG8_WAIT_L(0); PG8_MMA(0, 1, At, B1); PG8_BAR;
            PG8_LDA(At, 0, 1); PG8_STAGE(PG8_SA(0, 0), a2, voffA);
            PG8_BAR; PG8_WAIT_L(0); PG8_MMA(1, 0, At, B0); PG8_BAR; PG8_SCHED;
            PG8_STAGE(PG8_SB(0, 1), b2 + hstepB, voffB);
            PG8_WAIT_V(6); PG8_BAR; PG8_MMA(1, 1, At, B1); PG8_BAR;
            PG8_LDB(B0, 1, 0); PG8_SCHED; PG8_LDA(At, 1, 0); PG8_STAGE(PG8_SA(0, 1), a2 + hstepA, voffA);
            PG8_WAIT_L(8); PG8_BAR; PG8_WAIT_L(0); PG8_MMA(0, 0, At, B0); PG8_BAR; PG8_SCHED;
            PG8_LDB(B1, 1, 1); PG8_STAGE(PG8_SB(1, 0), b3, voffB);
            PG8_BAR; PG8_WAIT_L(0); PG8_MMA(0, 1, At, B1); PG8_BAR;
            PG8_LDA(At, 1, 1); PG8_STAGE(PG8_SA(1, 0), a3, voffA);
            PG8_BAR; PG8_WAIT_L(0); PG8_MMA(1, 0, At, B0); PG8_BAR; PG8_SCHED;
            PG8_STAGE(PG8_SB(1, 1), b3 + hstepB, voffB);
            PG8_WAIT_V(6); PG8_BAR; PG8_MMA(1, 1, At, B1); PG8_BAR;
            }
        }
        if constexpr (ALIGN_EPI) { if (wr == 0) PG8_BAR; }
        E(acc, cur, ctx);
        if (!has_next) break;
#pragma unroll
        for (int a = 0; a < 2; ++a)
#pragma unroll
            for (int b = 0; b < 2; ++b)
#pragma unroll
                for (int m = 0; m < 4; ++m)
#pragma unroll
                    for (int n = 0; n < 2; ++n) acc[a][b][m][n] = (f32x4){0.f, 0.f, 0.f, 0.f};
        cur = nxt; cA = nA; cB = nB; ++ui; gset ^= 1;
        if constexpr (ALIGN_EPI) { if (wr == 1) PG8_BAR; }
    }
    PG8_WAIT_V(0);
    if constexpr (!ALIGN_EPI) { if (wr == 0) PG8_BAR; }
    PG8_BAR;
#undef PG8_SA
#undef PG8_SB
#undef PG8_STAGE
#undef PG8_STAGE_A
#undef PG8_GOFF
#undef PG8_GSETUP
#undef PG8_LDA
#undef PG8_LDB
#undef PG8_MMA
#undef PG8_WAIT_V
#undef PG8_WAIT_L
#undef PG8_BAR
#undef PG8_SCHED
}
}

constexpr size_t MiB = 1u << 20;
constexpr size_t WS_CTL = 0, CTL_ZERO_BYTES = 1 * MiB;
constexpr size_t WS_WIN_T = 1 * MiB, WS_WF_T = 11 * MiB, WS_WOUT_T = 15 * MiB, WS_WCQ_T = 23 * MiB, WS_WCK_T = 39 * MiB, WS_WCV_T = 55 * MiB, WS_WCO_T = 71 * MiB;
constexpr size_t WS_WP_T = 87 * MiB, WS_DFT = 89 * MiB, WS_ROPE = 105 * MiB, WS_WGU_T = 106 * MiB, WS_WD_T = 234 * MiB;
constexpr size_t WS_HN = 298 * MiB, WS_XB = 330 * MiB, WS_QB = 362 * MiB, WS_KB = 386 * MiB, WS_VB = 394 * MiB, WS_FPQ = 402 * MiB, WS_MIXB = 418 * MiB, WS_QCB = 450 * MiB;
constexpr size_t WS_KCB = 482 * MiB, WS_VTB = 490 * MiB, WS_MEMNB = 498 * MiB, WS_PB = 506 * MiB, WS_XSB = 522 * MiB, WS_ACTB = 586 * MiB, WS_YB = 618 * MiB;
constexpr size_t WS_SSP = 682 * MiB, WS_AFF = 683 * MiB, WS_RANK = 684 * MiB, WS_GATE = 685 * MiB, WS_XALT = 686 * MiB, WS_WGU_T2 = 750 * MiB, WS_WD_T2 = 878 * MiB, WS_FAST_END = 942 * MiB;
constexpr int CW_TMO = 0, CW_CODE = 1, CW_BAR = 4096;
constexpr int RING_OFF = 0, RING_BYTES = 131072, XL_OFF = 131072, XL_BYTES = 16384, LDSCTL_OFF = XL_OFF + XL_BYTES, MISC_OFF = LDSCTL_OFF + 320, LDS_BYTES = 149504;
static_assert(MISC_OFF + 128 <= LDS_BYTES, "LDS map");
constexpr int NWAVES = 8;

typedef GAS unsigned gu32;
#define RLX_AGENT __ATOMIC_RELAXED, __HIP_MEMORY_SCOPE_AGENT

#define XB_TMO      128
#define XB_XCNT(j)  (256  + 64 * (j))
#define XB_XSUB(j)  (1280 + 64 * (j))
#define XB_XGEN(j)  (2304 + 64 * (j))
#define XB_TOP      3328
#define XB_TOPGEN   3392
#define XCD_BAR_WORDS 3456
#define XB_SPIN_CAP (1u << 18)
__device__ __forceinline__ unsigned xb_ld(unsigned* p)              { return __hip_atomic_load(p, __ATOMIC_RELAXED, __HIP_MEMORY_SCOPE_AGENT); }
__device__ __forceinline__ unsigned xb_add(unsigned* p, unsigned v) { return __hip_atomic_fetch_add(p, v, __ATOMIC_RELAXED, __HIP_MEMORY_SCOPE_AGENT); }
__device__ __forceinline__ unsigned xb_xcc_id() { return (unsigned)__builtin_amdgcn_s_getreg((3 << 11) | 20) & 0xFu; }
#define XB_SPIN(cond, bar) do { unsigned _sp = 0; while (cond) { __builtin_amdgcn_s_sleep(1); \
    if ((++_sp & 255u) == 0u) { if (xb_ld(&(bar)[XB_TMO])) break; if (_sp > XB_SPIN_CAP) { atomicAdd(&(bar)[XB_TMO], 1u); break; } } } } while (0)
struct XcdBarrier { unsigned* bar; unsigned x; volatile LAS unsigned* st; int wave; };
__device__ __forceinline__ XcdBarrier xcd_barrier_post(unsigned* bar, volatile LAS unsigned* st, int wave) {
    XcdBarrier b; b.bar = bar; b.x = xb_xcc_id(); b.st = st; b.wave = wave;
    if (wave == 0 && lane_id() == 0) (void)xb_add(&bar[XB_XCNT(b.x)], 1u);
    return b;
}
__device__ __forceinline__ void xcd_barrier_complete(unsigned* bar, unsigned x, unsigned& nloc, unsigned& nx) {
    const unsigned G = gridDim.x * gridDim.y * gridDim.z;
    unsigned sum, cnt, mine, sp = 0u;
    for (;;) {
        sum = 0u; cnt = 0u; mine = 0u;
#pragma unroll
        for (unsigned j = 0; j < 16; ++j) { const unsigned c = xb_ld(&bar[XB_XCNT(j)]); sum += c; cnt += (c > 0u) ? 1u : 0u; mine = (j == x) ? c : mine; }
        if (sum == G) break;
        __builtin_amdgcn_s_sleep(1);
        if ((++sp & 255u) == 0u) { if (xb_ld(&bar[XB_TMO])) break; if (sp > XB_SPIN_CAP) { atomicAdd(&bar[XB_TMO], 1u); break; } }
    }
    nloc = mine > 0u ? mine : 1u; nx = cnt > 0u ? cnt : 1u;
}
__device__ __forceinline__ void xcd_barrier(const XcdBarrier& b) {
    asm volatile("s_waitcnt vmcnt(0)" ::: "memory");
    __syncthreads();
    if (b.wave == 0 && lane_id() == 0) {
        unsigned* bar = b.bar;
        __builtin_amdgcn_s_waitcnt(0);
        unsigned nloc = b.st[0], nx = b.st[1];
        if (nloc == 0u) { xcd_barrier_complete(bar, b.x, nloc, nx); b.st[0] = nloc; b.st[1] = nx; }
        const unsigned old = xb_add(&bar[XB_XSUB(b.x)], 1u);
        const unsigned gen = old / nloc;
        if (old + 1u == (gen + 1u) * nloc) {
            __builtin_amdgcn_fence(__ATOMIC_RELEASE, "agent");
            asm volatile("s_waitcnt vmcnt(0)" ::: "memory");
            const unsigned og = xb_add(&bar[XB_TOP], 1u);
            const unsigned tg = og / nx;
            if (og + 1u == (tg + 1u) * nx) xb_add(&bar[XB_TOPGEN], 1u);
            else XB_SPIN(xb_ld(&bar[XB_TOPGEN]) == tg, bar);
            __builtin_amdgcn_fence(__ATOMIC_ACQUIRE, "agent");
            xb_add(&bar[XB_XGEN(b.x)], 1u);
            asm volatile("s_waitcnt vmcnt(0)" ::: "memory");
        } else {
            XB_SPIN(xb_ld(&bar[XB_XGEN(b.x)]) == gen, bar);
            __builtin_amdgcn_fence(__ATOMIC_ACQUIRE, "agent");
            asm volatile("s_waitcnt vmcnt(0)" ::: "memory");
        }
    }
    __syncthreads();
}

struct Args { const float* in[22]; float* out; unsigned char* ws; int ph_lo, ph_hi, li, pad; };
struct Frame {
    LAS unsigned char* lds; volatile LAS unsigned* MISC; gu32* ctl;
    int wave, vcu, G;
    unsigned char* ws;
};
__device__ __forceinline__ float wave_sum(float v) {
#pragma unroll
    for (int o = 1; o < 64; o <<= 1) v += __shfl_xor(v, o);
    return v;
}
struct TrDesc { const float* W; const float* gain; bf16_t* WT; int ldw, ldt, k0, n0; long drow0; };
__device__ __forceinline__ void tr_load(const TrDesc& d, f32x4 (&v)[16], int lane) {
    const int lr = lane >> 4, lc = (lane & 15) * 4;
#pragma unroll
    for (int i = 0; i < 16; ++i) v[i] = __builtin_nontemporal_load((const GAS f32x4*)(d.W + (size_t)(d.k0 + 4 * i + lr) * d.ldw + d.n0 + lc));
}
#ifndef TRV
#define TRV 0
#endif
template <int V> __device__ __forceinline__ void tr_finish(const TrDesc& d, const f32x4 (&v)[16], LAS float* scr, int lane) {
    const int lr = lane >> 4, lc = (lane & 15) * 4;
    if (V == 1) { f32x4 s = v[0]; for (int i = 1; i < 16; ++i) s = s + v[i]; if (s.x == 1.2345e30f) *(GAS f32x4*)(d.WT) = s; return; }
#pragma unroll
    for (int i = 0; i < 16; ++i) { const int kk = 4 * i + lr; f32x4 x = v[i]; if (d.gain) x = x * d.gain[d.k0 + kk];
        LAS float* s = scr + kk * 65 + lc; s[0] = x.x; s[1] = x.y; s[2] = x.z; s[3] = x.w; }
    LDS_WAIT(); asm volatile("" ::: "memory");
    const int c = lane & 7;
#pragma unroll
    for (int j = 0; j < 8; ++j) { const int n = (lane >> 3) + 8 * j; const LAS float* s = scr + (8 * c) * 65 + n;
        u32x4 o; o.x = cvtpk(s[0 * 65], s[1 * 65]); o.y = cvtpk(s[2 * 65], s[3 * 65]); o.z = cvtpk(s[4 * 65], s[5 * 65]); o.w = cvtpk(s[6 * 65], s[7 * 65]);
        if (V == 0 || o.x == 0x12345678u) *(GAS u32x4*)(d.WT + (size_t)(d.drow0 + n) * d.ldt + d.k0 + 8 * c) = o; }
    LDS_WAIT(); asm volatile("" ::: "memory");
}
#ifndef TR_PIPE
#define TR_PIPE 0
#endif
constexpr int TR_DENSE = 32 * 20 + 9 * 32 * 16 + 32 * 4, TR_EXPERT = NE * 768;
__device__ __forceinline__ TrDesc tr_desc(karg_t ka, unsigned char* ws, int it, int mode) {
    TrDesc d; d.gain = nullptr;
    constexpr int I_IN = 32 * 20, I_SQ = 32 * 16;
    if (mode == 0) {
        int r = it;
        if (r < I_IN) { d.W = KIN(ka, 3); d.ldw = INW; d.WT = (bf16_t*)(ws + WS_WIN_T); d.ldt = DM; d.k0 = (r / 20) * 64; d.n0 = (r % 20) * 128; d.drow0 = d.n0; return d; } r -= I_IN;
        if (r < I_SQ) { d.W = KIN(ka, 7); d.ldw = DM; d.WT = (bf16_t*)(ws + WS_WOUT_T); d.ldt = DM; d.k0 = (r / 16) * 64; d.n0 = (r % 16) * 128; d.drow0 = d.n0; return d; } r -= I_SQ;
        if (r < 8 * I_SQ) { const int j = r / I_SQ, q = r % I_SQ, wsel = j >> 1, layer = j & 1;
            d.W = KIN(ka, 12 + wsel) + (size_t)layer * DM * DM; d.ldw = DM; if (wsel == 0) d.gain = KIN(ka, 10) + layer * DM;
            d.WT = (bf16_t*)(ws + (wsel == 0 ? WS_WCQ_T : wsel == 1 ? WS_WCK_T : wsel == 2 ? WS_WCV_T : WS_WCO_T) + (size_t)layer * DM * DM * 2); d.ldt = DM;
            d.k0 = (q / 16) * 64; d.n0 = (q % 16) * 128; d.drow0 = d.n0; return d; } r -= 8 * I_SQ;
        d.W = KIN(ka, 8); d.ldw = 512; d.WT = (bf16_t*)(ws + WS_WP_T); d.ldt = DM; d.k0 = (r / 4) * 64; d.n0 = (r % 4) * 128; d.drow0 = d.n0; return d;
    }
    const int layer = mode - 1;
    const int e = it / 768, r = it % 768; const size_t eo = (size_t)(layer * NE + e);
    if (r < 512) { const int up = r >> 8, q = r & 255, kb = q >> 3, nb = q & 7, n0 = nb * 128;
        d.W = (up ? KIN(ka, 19) : KIN(ka, 18)) + eo * DM * EFF; d.ldw = EFF; d.gain = KIN(ka, 16) + layer * DM;   d.WT = (bf16_t*)(ws + (layer ? WS_WGU_T2 : WS_WGU_T)) + (size_t)e * 2048 * 2048; d.ldt = 2048;
        d.k0 = kb * 64; d.n0 = n0; d.drow0 = (long)(n0 >> 7) * 256 + up * 128;
    } else { const int q = r - 512, kb = q >> 4, nb = q & 15;
        d.W = KIN(ka, 20) + eo * EFF * DM; d.ldw = DM; d.WT = (bf16_t*)(ws + (layer ? WS_WD_T2 : WS_WD_T)) + (size_t)e * 2048 * 1024; d.ldt = 1024; d.k0 = kb * 64; d.n0 = nb * 128; d.drow0 = nb * 128; }
    return d;
}
template <int V = 0> __device__ __forceinline__ void tr_span(const Frame& F, karg_t ka, unsigned char* ws, int mode, int first, int stride, int cnt) {
    const int lane = lane_id(); LAS float* scr = (LAS float*)(F.lds + RING_OFF + F.wave * 16640);
    if (cnt <= 0) return;
    f32x4 va[16], vb[16];
    TrDesc da = tr_desc(ka, ws, first, mode), db = da; db.n0 += 64; db.drow0 += 64;
    tr_load(da, va, lane); tr_load(db, vb, lane);
    for (int j = 0; j < cnt; ++j) {
        const bool more = j + 1 < cnt; TrDesc na = da, nb = db;
        if (more) { na = tr_desc(ka, ws, first + stride * (j + 1), mode); nb = na; nb.n0 += 64; nb.drow0 += 64; }
        tr_finish<V>(da, va, scr, lane); if (more) tr_load(na, va, lane);
        tr_finish<V>(db, vb, scr, lane); if (more) tr_load(nb, vb, lane);
        da = na; db = nb;
    }
}
__device__ __forceinline__ void rms_row_to_bf16(const float* xrow, const float* __restrict__ gain, bf16_t* orow, int lane) {
    const GAS f32x4* xr = (const GAS f32x4*)xrow + lane; const f32x4* gr = (const f32x4*)gain + lane;
    f32x4 v[8]; float s = 0.f;
#pragma unroll
    for (int j = 0; j < 8; ++j) { v[j] = xr[64 * j]; s += (v[j].x * v[j].x + v[j].y * v[j].y) + (v[j].z * v[j].z + v[j].w * v[j].w); }
    const float r = rsqrtf(wave_sum(s) * (1.f / DM) + EPS);
    GAS u32x2* o8 = (GAS u32x2*)orow + lane;
#pragma unroll
    for (int j = 0; j < 8; ++j) { const f32x4 g = gr[64 * j]; u32x2 w; w.x = cvtpk(v[j].x * r * g.x, v[j].y * r * g.y); w.y = cvtpk(v[j].z * r * g.z, v[j].w * r * g.w); o8[64 * j] = w; }
}

__device__ __forceinline__ void p0_prologue(Frame& F, karg_t ka, unsigned char* ws) {
    const float* x = KIN(ka, 0); const float* mem = KIN(ka, 1); const float* mix_norm = KIN(ka, 2); const float* w_in = KIN(ka, 3);
    const float* w_four = KIN(ka, 6); const float* w_out = KIN(ka, 7); const float* pool_w = KIN(ka, 8); const float* cross_norm = KIN(ka, 10); const float* mem_norm = KIN(ka, 11);
    const int gw = F.vcu * NWAVES + F.wave, NGW = F.G * NWAVES;
    const int p_lane = lane_id(), p_tid = F.wave * 64 + p_lane;
    { LAS float* tab = (LAS float*)(F.lds + RING_OFF);
      for (int m = p_tid; m < 2048; m += 512) tab[m] = cosf(6.283185307179586f * (float)m * (1.0f / 2048.0f));
      __syncthreads();
      bf16_t* DFT = (bf16_t*)(ws + WS_DFT);
      for (int row = F.vcu * 8; row < 2048; row += F.G * 8)
          for (int rr = 0; rr < 8; ++rr) { const int k1 = row + rr; if (k1 >= 2048) break;
              { const int c0 = p_tid * 8; const int which = c0 >> 11, s0 = c0 & 2047; unsigned w[4];
#pragma unroll
                for (int j = 0; j < 4; ++j) { const int ma = (k1 * (s0 + 2 * j)) & 2047, mb = (k1 * (s0 + 2 * j + 1)) & 2047;
                    w[j] = cvtpk(tab[(ma - which * 512) & 2047], tab[(mb - which * 512) & 2047]); }
                *(GAS u32x4*)(DFT + (size_t)k1 * 4096 + c0) = (u32x4){w[0], w[1], w[2], w[3]}; } }
      __syncthreads(); }
    { float* RC = (float*)(ws + WS_ROPE); float* RS = RC + SEQ * 64;
      for (int i = F.vcu * 512 + p_tid; i < SEQ * 64; i += F.G * 512) { const int t = i >> 6, p = i & 63; const int pos = (p < 32) ? (t >> 6) : (t & 63); const int j = p & 31;
          const float inv = 1.0f / powf(10000.0f, (float)(2 * j) / 64.0f); const float ang = (float)pos * inv; RC[i] = cosf(ang); RS[i] = sinf(ang); } }
    { u32x4* RB = (u32x4*)(ws + WS_AFF + 512 * 1024);
      for (int i = F.vcu * 512 + p_tid; i < 2 * 64 * 64; i += F.G * 512) { const int layer = i >> 12, ks = (i >> 6) & 63, ln = i & 63, e = ln & 15, k0 = 32 * ks + 8 * (ln >> 4);
          const float* Wr = KIN(ka, 17) + (size_t)layer * DM * NE; const float* gn = KIN(ka, 16) + layer * DM; float w[8], lo[8];
#pragma unroll
          for (int j = 0; j < 8; ++j) { w[j] = gn[k0 + j] * Wr[(size_t)(k0 + j) * NE + e]; }
          u32x4 hi4 = {cvtpk(w[0], w[1]), cvtpk(w[2], w[3]), cvtpk(w[4], w[5]), cvtpk(w[6], w[7])};
          const unsigned hh[4] = {hi4.x, hi4.y, hi4.z, hi4.w};
#pragma unroll
          for (int j = 0; j < 4; ++j) { lo[2 * j] = w[2 * j] - __uint_as_float(hh[j] << 16); lo[2 * j + 1] = w[2 * j + 1] - __uint_as_float(hh[j] & 0xffff0000u); }
          RB[(size_t)(layer * 2 + 0) * 4096 + ks * 64 + ln] = hi4;
          RB[(size_t)(layer * 2 + 1) * 4096 + ks * 64 + ln] = (u32x4){cvtpk(lo[0], lo[1]), cvtpk(lo[2], lo[3]), cvtpk(lo[4], lo[5]), cvtpk(lo[6], lo[7])}; } }
    { LAS float* Mw = (LAS float*)(F.lds + RING_OFF); LAS float* t128 = Mw + 128 * 32;
      bf16_t* WF = (bf16_t*)(ws + WS_WF_T);
      for (int it = F.vcu; it < 256; it += F.G) {
          const int which = it >> 7, g = (it >> 5) & 3, d0 = ((it >> 3) & 3) * 32, k0 = (it & 7) * 256;
          if (p_tid < 128) t128[p_tid] = cosf(6.283185307179586f * (float)p_tid * (1.0f / 128.0f));
          __syncthreads();
          { const int c = p_tid >> 2, dd = (p_tid & 3) * 8; float o[8] = {0.f, 0.f, 0.f, 0.f, 0.f, 0.f, 0.f, 0.f};
#pragma unroll 16
            for (int k2 = 0; k2 < 128; ++k2) { const int m = (c * k2) & 127; const float tv = which ? -t128[(m - 32) & 127] : t128[m];
                const float* wr_ = w_four + ((size_t)g * 128 + k2) * 128 + d0 + dd; const f32x4 w0 = *(const f32x4*)wr_, w1 = *(const f32x4*)(wr_ + 4);
                o[0] += tv * w0.x; o[1] += tv * w0.y; o[2] += tv * w0.z; o[3] += tv * w0.w; o[4] += tv * w1.x; o[5] += tv * w1.y; o[6] += tv * w1.z; o[7] += tv * w1.w; }
#pragma unroll
            for (int j = 0; j < 8; ++j) Mw[c * 32 + dd + j] = o[j] * (1.0f / 512.0f); }
          __syncthreads();
          { const int kp = p_tid & 127, dq = p_tid >> 7, k = k0 + 2 * kp; float o0[8] = {0.f, 0.f, 0.f, 0.f, 0.f, 0.f, 0.f, 0.f}, o1[8] = {0.f, 0.f, 0.f, 0.f, 0.f, 0.f, 0.f, 0.f};
            const float* r0 = w_in + (size_t)k * INW + 2560 + g * 128; const float* r1 = r0 + INW;
#pragma unroll 8
            for (int c4 = 0; c4 < 32; ++c4) { const f32x4 a = *(const f32x4*)(r0 + 4 * c4), b = *(const f32x4*)(r1 + 4 * c4); const float av[4] = {a.x, a.y, a.z, a.w}, bv[4] = {b.x, b.y, b.z, b.w};
#pragma unroll
                for (int cc = 0; cc < 4; ++cc) { const LAS float* mr = Mw + (4 * c4 + cc) * 32 + dq * 8;
#pragma unroll
                    for (int j = 0; j < 8; ++j) { o0[j] += av[cc] * mr[j]; o1[j] += bv[cc] * mr[j]; } } }
#pragma unroll
            for (int j = 0; j < 8; ++j) *(GAS unsigned*)(WF + (size_t)(which * 512 + g * 128 + d0 + dq * 8 + j) * DM + k) = cvtpk(o0[j], o1[j]); }
          __syncthreads(); } }
    { const int n = (TR_DENSE - gw + NGW - 1) / NGW; tr_span(F, ka, ws, 0, gw, NGW, n > 0 ? n : 0); }
    __syncthreads();
    for (int m = gw; m < NTOK; m += NGW) rms_row_to_bf16(x + (size_t)m * DM, mix_norm, (bf16_t*)(ws + WS_HN) + (size_t)m * DM, p_lane);
    for (int m = gw; m < 2 * NB * MEML; m += NGW) { const int l = m / (NB * MEML), r = m % (NB * MEML);
        rms_row_to_bf16(mem + (size_t)r * DM, mem_norm + l * DM, (bf16_t*)(ws + WS_MEMNB) + (size_t)m * DM, p_lane); }
}

struct MapLin { const char* A; const char* B; size_t as, bs; __device__ __forceinline__ void operator()(pg8::Unit& u) const { u.a = A + (size_t)u.pm * as; u.b = B + (size_t)u.pn * bs; } };

struct EpiQKV {
    static constexpr bool PERM = true;
    bf16_t* Q; bf16_t* K; bf16_t* V; const float* qg; const float* kg; const float* RC; const float* RS;
    __device__ __forceinline__ void operator()(f32x4 (&acc)[2][2][4][2], const pg8::Unit& u, const pg8::EpiCtx& c) const { const int e_lane = lane_id(), e_fr = e_lane & 15, e_fq = e_lane >> 4;
        const int pn = u.pn, hc = c.wc * 32 + e_fq * 8, rl0 = c.wr * 64 + e_fr;
        if (pn >= 8) {
            bf16_t* base = V + (size_t)(u.pm * 256 + rl0) * KVW + (pn - 8) * 256 + hc;
#pragma unroll
            for (int ai = 0; ai < 2; ++ai)
#pragma unroll
                for (int m = 0; m < 4; ++m) { bf16_t* rowp = base + (size_t)(ai * 128 + m * 16) * KVW;
#pragma unroll
                    for (int bj = 0; bj < 2; ++bj) { const f32x4 v0 = acc[ai][bj][m][0], v1 = acc[ai][bj][m][1];
                        st16((rowp + bj * 128), (u32x4){cvtpk(v0.x, v0.y), cvtpk(v0.z, v0.w), cvtpk(v1.x, v1.y), cvtpk(v1.z, v1.w)}); } }
            return;
        }
        LAS float* part = (LAS float*)c.xl;
#pragma unroll
        for (int ai = 0; ai < 2; ++ai)
#pragma unroll
            for (int m = 0; m < 4; ++m)
#pragma unroll
                for (int bj = 0; bj < 2; ++bj) { const f32x4 v0 = acc[ai][bj][m][0], v1 = acc[ai][bj][m][1];
                    float s = (v0.x * v0.x + v0.y * v0.y) + (v0.z * v0.z + v0.w * v0.w) + (v1.x * v1.x + v1.y * v1.y) + (v1.z * v1.z + v1.w * v1.w);
                    s += __shfl_xor(s, 16); s += __shfl_xor(s, 32);
                    if (e_fq == 0) part[((ai * 128 + rl0 + m * 16) * 2 + bj) * 4 + c.wc] = s; }
        WG_BAR();
        const float* gain = pn < 6 ? qg : kg;
        const f32x4 g0 = *(const f32x4*)(gain + hc), g1 = *(const f32x4*)(gain + hc + 4);
        bf16_t* O = pn < 6 ? Q : K; const int ld = pn < 6 ? AW : KVW; const int colbase = (pn < 6 ? pn : pn - 6) * 256 + hc;
#pragma unroll
        for (int ai = 0; ai < 2; ++ai)
#pragma unroll
            for (int m = 0; m < 4; ++m) { const int rl = ai * 128 + rl0 + m * 16, row = u.pm * 256 + rl, sp = row & (SEQ - 1);
                const f32x4 cs = *(const f32x4*)(RC + sp * 64 + (hc >> 1)), sn = *(const f32x4*)(RS + sp * 64 + (hc >> 1));
#pragma unroll
                for (int bj = 0; bj < 2; ++bj) { const f32x4 p4 = *(const LAS f32x4*)(part + (rl * 2 + bj) * 4);
                    const float r = rsqrtf(((p4.x + p4.y) + (p4.z + p4.w)) * (1.0f / 128.0f) + EPS);
                    const f32x4 v0 = acc[ai][bj][m][0] * r * g0, v1 = acc[ai][bj][m][1] * r * g1;
                    u32x4 w; w.x = cvtpk(v0.x * cs.x - v0.y * sn.x, v0.x * sn.x + v0.y * cs.x); w.y = cvtpk(v0.z * cs.y - v0.w * sn.y, v0.z * sn.y + v0.w * cs.y);
                    w.z = cvtpk(v1.x * cs.z - v1.y * sn.z, v1.x * sn.z + v1.y * cs.z); w.w = cvtpk(v1.z * cs.w - v1.w * sn.w, v1.z * sn.w + v1.w * cs.w);
                    st16((O + (size_t)row * ld + colbase + bj * 128), w); } }
    }
};


template <class AddrF> struct EpiStore {
    static constexpr bool PERM = true; AddrF f;
    __device__ __forceinline__ void operator()(f32x4 (&acc)[2][2][4][2], const pg8::Unit& u, const pg8::EpiCtx& c) const { const int e_lane = lane_id(), e_fr = e_lane & 15, e_fq = e_lane >> 4;
        const int hc = c.wc * 32 + e_fq * 8, rl0 = c.wr * 64 + e_fr;
#pragma unroll
        for (int ai = 0; ai < 2; ++ai)
#pragma unroll
            for (int m = 0; m < 4; ++m)
#pragma unroll
                for (int bj = 0; bj < 2; ++bj) { const f32x4 v0 = acc[ai][bj][m][0], v1 = acc[ai][bj][m][1];
                    st16(f(u, ai * 128 + rl0 + m * 16, bj * 128 + hc), (u32x4){cvtpk(v0.x, v0.y), cvtpk(v0.z, v0.w), cvtpk(v1.x, v1.y), cvtpk(v1.z, v1.w)}); }
    }
};
struct AddrF1 { bf16_t* FPQ; __device__ __forceinline__ bf16_t* operator()(const pg8::Unit& u, int rl, int tc) const {
    const int r = u.pm * 256 + rl, which = r >> 9, n = r & 511, cidx = u.pn * 256 + tc, b = cidx >> 11, s = cidx & 2047; return FPQ + (((size_t)(b * 512 + n) * 2 + which) * 2048 + s); } };
struct AddrF2 { bf16_t* MIX; __device__ __forceinline__ bf16_t* operator()(const pg8::Unit& u, int rl, int tc) const {
    const int row = (u.pn >> 1) * 2048 + u.pm * 256 + rl, col = AW + (u.pn & 1) * 256 + tc; return MIX + (size_t)row * DM + col; } };

template <bool BF32> struct EpiResB {
    static constexpr bool PERM = true;
    const void* base; bf16_t* xo; float* ssp; const float* cscale;
    __device__ __forceinline__ void operator()(f32x4 (&acc)[2][2][4][2], const pg8::Unit& u, const pg8::EpiCtx& c) const { const int e_lane = lane_id(), e_fr = e_lane & 15, e_fq = e_lane >> 4;
        const int hc = c.wc * 32 + e_fq * 8, rl0 = c.wr * 64 + e_fr;
        LAS float* part = (LAS float*)c.xl;
#pragma unroll
        for (int ai = 0; ai < 2; ++ai) {
            f32x4 bf0[4][2], bf1[4][2]; u32x4 bb[4][2];
#pragma unroll
            for (int m = 0; m < 4; ++m)
#pragma unroll
                for (int bj = 0; bj < 2; ++bj) { const size_t off = (size_t)(u.pm * 256 + ai * 128 + rl0 + m * 16) * DM + u.pn * 256 + bj * 128 + hc;
                    if (BF32) { bf0[m][bj] = *(const f32x4*)((const float*)base + off); bf1[m][bj] = *(const f32x4*)((const float*)base + off + 4); }
                    else bb[m][bj] = *(const u32x4*)((const bf16_t*)base + off); }
#pragma unroll
            for (int m = 0; m < 4; ++m) { const int rl = ai * 128 + rl0 + m * 16; float s = 0.f;
#pragma unroll
                for (int bj = 0; bj < 2; ++bj) { const int col = u.pn * 256 + bj * 128 + hc; const size_t off = (size_t)(u.pm * 256 + rl) * DM + col;
                    f32x4 v0 = acc[ai][bj][m][0], v1 = acc[ai][bj][m][1];
                    if (cscale) { v0 = v0 * *(const f32x4*)(cscale + col); v1 = v1 * *(const f32x4*)(cscale + col + 4); }
                    if (BF32) { v0 = v0 + bf0[m][bj]; v1 = v1 + bf1[m][bj]; }
                    else { const u32x4 b = bb[m][bj];
                        v0.x += __uint_as_float(b.x << 16); v0.y += __uint_as_float(b.x & 0xffff0000u); v0.z += __uint_as_float(b.y << 16); v0.w += __uint_as_float(b.y & 0xffff0000u);
                        v1.x += __uint_as_float(b.z << 16); v1.y += __uint_as_float(b.z & 0xffff0000u); v1.z += __uint_as_float(b.w << 16); v1.w += __uint_as_float(b.w & 0xffff0000u); }
                    st16((xo + off), (u32x4){cvtpk(v0.x, v0.y), cvtpk(v0.z, v0.w), cvtpk(v1.x, v1.y), cvtpk(v1.z, v1.w)});
                    if (ssp) s += ((v0.x * v0.x + v0.y * v0.y) + (v0.z * v0.z + v0.w * v0.w)) + ((v1.x * v1.x + v1.y * v1.y) + (v1.z * v1.z + v1.w * v1.w)); }
                if (ssp) { s += __shfl_xor(s, 16); s += __shfl_xor(s, 32); if (e_fq == 0) part[rl * 4 + c.wc] = s; } }
            asm volatile("" ::: "memory"); }
        if (ssp) { WG_BAR();
            if (e_lane < 32) { const int row = c.wid * 32 + e_lane; const f32x4 p4 = *(const LAS f32x4*)(part + row * 4);
                ssp[(size_t)(u.pm * 256 + row) * 8 + u.pn] = (p4.x + p4.y) + (p4.z + p4.w); }
            WG_BAR(); }
    }
};

namespace attn {
using s16x4 = __attribute__((ext_vector_type(4))) short;
using f32x16 = __attribute__((ext_vector_type(16))) float;
constexpr int D = 128, NW = 8, QBLK = 32, KVBLK = 64;
constexpr float SCALE = 0.088388347648318440f;
constexpr float THR = 0.f;
#ifndef ATT_SDEPTH
#define ATT_SDEPTH 1
#endif
constexpr int LDQ = AW, LDK = KVW, LDO = DM;
constexpr size_t SHM_V = KVBLK * D * 2, SHM_K = KVBLK * D * 2, SHM_ATTN = 2 * SHM_V + 2 * SHM_K + NW * 64 * 4;
#define KSWZ(row, colB) ((row) * 256 + ((colB) ^ (((row) & 7) << 4)))
#define SBAR() __builtin_amdgcn_sched_barrier(0)
__device__ __forceinline__ int crow(int r, int hi) { return (r & 3) + 8 * (r >> 2) + 4 * hi; }
__device__ __forceinline__ unsigned cvtpk_a(float lo, float hi) { unsigned r; asm volatile("v_cvt_pk_bf16_f32 %0, %1, %2" : "=v"(r) : "v"(lo), "v"(hi)); return r; }
__device__ __forceinline__ void partialSM(f32x16& p0, f32x16& p1, float& m_reg, float& mn, float& alpha) {
  constexpr float C = SCALE * 1.4426950408889634f;
  float pmax = p0[0]; for (int r = 1; r < 16; ++r) pmax = fmaxf(pmax, p0[r]); for (int r = 0; r < 16; ++r) pmax = fmaxf(pmax, p1[r]);
  { auto rr = __builtin_amdgcn_permlane32_swap(__float_as_uint(pmax), __float_as_uint(pmax), false, false);
    pmax = fmaxf(__uint_as_float(rr[0]), __uint_as_float(rr[1])); }
  if (__builtin_expect(__all(pmax - m_reg <= THR / SCALE), 1)) { mn = m_reg; alpha = 1.f; }
  else { mn = fmaxf(m_reg, pmax); alpha = __builtin_amdgcn_exp2f((m_reg - mn) * C); m_reg = mn; }
  float mnC = -mn * C;
  for (int r = 0; r < 16; ++r) p0[r] = fmaf(p0[r], C, mnC); for (int r = 0; r < 16; ++r) p1[r] = fmaf(p1[r], C, mnC);
  for (int r = 0; r < 16; ++r) p0[r] = __builtin_amdgcn_exp2f(p0[r]);
}
__device__ __forceinline__ void finishSM(f32x16& p0, f32x16& p1, float alpha, float& l_reg, bf16x8& pa0, bf16x8& pa1, bf16x8& pa2, bf16x8& pa3) {
  for (int r = 0; r < 16; ++r) p1[r] = __builtin_amdgcn_exp2f(p1[r]);
  float ps = 0; for (int r = 0; r < 16; ++r) ps += p0[r]; for (int r = 0; r < 16; ++r) ps += p1[r];
  { auto rr = __builtin_amdgcn_permlane32_swap(__float_as_uint(ps), __float_as_uint(ps), false, false);
    ps = __uint_as_float(rr[0]) + __uint_as_float(rr[1]); }
  l_reg = l_reg * alpha + ps;
#define PK4(P, BASE, OUT) do { unsigned a0 = cvtpk_a(P[BASE + 0], P[BASE + 1]), a1 = cvtpk_a(P[BASE + 2], P[BASE + 3]);   \
    unsigned b0 = cvtpk_a(P[BASE + 4], P[BASE + 5]), b1 = cvtpk_a(P[BASE + 6], P[BASE + 7]);                              \
    auto r0 = __builtin_amdgcn_permlane32_swap(a0, b0, false, false); auto r1 = __builtin_amdgcn_permlane32_swap(a1, b1, false, false); \
    u32x4 w = {r0[0], r1[0], r0[1], r1[1]}; OUT = *reinterpret_cast<bf16x8*>(&w); } while (0)
  PK4(p0, 0, pa0); PK4(p0, 8, pa1); PK4(p1, 0, pa2); PK4(p1, 8, pa3);
#undef PK4
}
__device__ __forceinline__ void qkt(f32x16& p0, f32x16& p1, const bf16_t* Ks, const bf16x8* qr, int r32, int hi) {
  p0 = f32x16{}; p1 = f32x16{};
  for (int d0 = 0; d0 < 8; ++d0) { int cb = (d0 * 16 + hi * 8) * 2;
    bf16x8 b0 = *reinterpret_cast<const bf16x8*>((const char*)Ks + KSWZ(r32, cb));
    bf16x8 b1 = *reinterpret_cast<const bf16x8*>((const char*)Ks + KSWZ(32 + r32, cb));
    p0 = __builtin_amdgcn_mfma_f32_32x32x16_bf16(b0, qr[d0], p0, 0, 0, 0);
    p1 = __builtin_amdgcn_mfma_f32_32x32x16_bf16(b1, qr[d0], p1, 0, 0, 0); }
}
__device__ __forceinline__ int v_st(int k, int c) { const int kk = (k & ~0xC) | ((k & 4) << 1) | ((k & 8) >> 1); return ((kk >> 3) * 4 + (c >> 5)) * 512 + ((kk & 7) * 32 + (c & 31)) * 2; }
__device__ __forceinline__ int v_rd_base(int lane) { return ((lane & 3) << 3) | (((lane >> 2) & 3) << 6) | (((lane >> 4) & 1) << 5) | (((lane >> 5) & 1) << 8); }
constexpr int v_rd_off(int d0, int ks, int half) { return d0 * 512 + ks * 4096 + half * 2048; }
template <int OFF> __device__ __forceinline__ s16x4 tr_read(int vb) {
  s16x4 r; asm volatile("ds_read_b64_tr_b16 %0, %1 offset:%2" : "=&v"(r) : "v"(vb), "i"(OFF) : "memory"); return r;
}
template <int D0> __device__ __forceinline__ void pv_one(f32x16& od, int vb, bf16x8 pa0, bf16x8 pa1, bf16x8 pa2, bf16x8 pa3) {
  const s16x4 l0 = tr_read<v_rd_off(D0, 0, 0)>(vb), h0 = tr_read<v_rd_off(D0, 0, 1)>(vb), l1 = tr_read<v_rd_off(D0, 1, 0)>(vb), h1 = tr_read<v_rd_off(D0, 1, 1)>(vb);
  const s16x4 l2 = tr_read<v_rd_off(D0, 2, 0)>(vb), h2 = tr_read<v_rd_off(D0, 2, 1)>(vb), l3 = tr_read<v_rd_off(D0, 3, 0)>(vb), h3 = tr_read<v_rd_off(D0, 3, 1)>(vb);
  asm volatile("s_waitcnt lgkmcnt(0)" ::: "memory"); SBAR();
#define PK(L, H) (bf16x8){L[0], L[1], L[2], L[3], H[0], H[1], H[2], H[3]}
  od = __builtin_amdgcn_mfma_f32_32x32x16_bf16(pa0, PK(l0, h0), od, 0, 0, 0);
  od = __builtin_amdgcn_mfma_f32_32x32x16_bf16(pa1, PK(l1, h1), od, 0, 0, 0);
  od = __builtin_amdgcn_mfma_f32_32x32x16_bf16(pa2, PK(l2, h2), od, 0, 0, 0);
  od = __builtin_amdgcn_mfma_f32_32x32x16_bf16(pa3, PK(l3, h3), od, 0, 0, 0);
#undef PK
}
__device__ __forceinline__ void pv_d0(f32x16* o, int vb, bf16x8 pa0, bf16x8 pa1, bf16x8 pa2, bf16x8 pa3) {
  pv_one<0>(o[0], vb, pa0, pa1, pa2, pa3); pv_one<1>(o[1], vb, pa0, pa1, pa2, pa3); pv_one<2>(o[2], vb, pa0, pa1, pa2, pa3); pv_one<3>(o[3], vb, pa0, pa1, pa2, pa3);
}
__device__ __forceinline__ void attn_dense_body(const bf16_t* __restrict__ Qb, const bf16_t* __restrict__ Kh, const bf16_t* __restrict__ Vh,
                                                bf16_t* __restrict__ Ob, int seq, char* lds, const int wave_) {
  constexpr int SDEPTH = ATT_SDEPTH;
  const int lane = lane_id(), wid = wave_, tid = wid * 64 + lane, r32 = lane & 31, hi = lane >> 5;
  bf16_t* V_lds = (bf16_t*)lds; bf16_t* K_lds = (bf16_t*)(lds + 2 * SHM_V);
  float* ws = (float*)(lds + 2 * SHM_V + 2 * SHM_K) + wid * 64; float* li_l = ws; float* al_l = ws + 32;
  float m_reg = -1e30f, l_reg = 0; f32x16 o[4] = {}; bf16x8 qr[8];
  const bf16_t* Qw = Qb + (long)(wid * QBLK + r32) * LDQ + hi * 8;
#pragma unroll
  for (int d0 = 0; d0 < 8; ++d0) qr[d0] = *reinterpret_cast<const bf16x8*>(Qw + d0 * 16);
  const int sr = tid >> 4, sc = (tid & 15) * 8, vst0 = v_st(sr, sc), vst1 = v_st(32 + sr, sc);
  const int vb0 = (int)(uintptr_t)V_lds + v_rd_base(lane);
  struct { bf16x8 vs0, vs1, ks0, ks1; } sr_[SDEPTH];
#define SLOAD(i, k0) do { sr_[i].vs0 = *reinterpret_cast<const bf16x8*>(&Vh[(long)((k0) + sr) * LDK + sc]); sr_[i].vs1 = *reinterpret_cast<const bf16x8*>(&Vh[(long)((k0) + 32 + sr) * LDK + sc]); \
    sr_[i].ks0 = *reinterpret_cast<const bf16x8*>(&Kh[(long)((k0) + sr) * LDK + sc]); sr_[i].ks1 = *reinterpret_cast<const bf16x8*>(&Kh[(long)((k0) + 32 + sr) * LDK + sc]); } while (0)
#define SWRITE(b, i) do { *(bf16x8*)((char*)V_lds + (b) * SHM_V + vst0) = sr_[i].vs0;          \
    *(bf16x8*)((char*)V_lds + (b) * SHM_V + vst1) = sr_[i].vs1; int kc = sc * 2;               \
    *(bf16x8*)((char*)K_lds + (b) * SHM_K + KSWZ(sr, kc)) = sr_[i].ks0;                       \
    *(bf16x8*)((char*)K_lds + (b) * SHM_K + KSWZ(32 + sr, kc)) = sr_[i].ks1; } while (0)
#define SWAIT() do { if constexpr (SDEPTH == 2) asm volatile("s_waitcnt vmcnt(4)" ::: "memory"); else asm volatile("s_waitcnt vmcnt(0)" ::: "memory"); } while (0)
#define RESC(a) do { if (__any((a) < 1.f)) { if (hi == 0) al_l[r32] = (a); asm volatile("s_waitcnt lgkmcnt(0)" ::: "memory"); \
    for (int d = 0; d < 4; ++d) for (int r = 0; r < 16; ++r) o[d][r] *= al_l[crow(r, hi)]; } } while (0)
  f32x16 pA0, pA1, pB0, pB1; float mnA, mnB, alA, alB; bf16x8 pa0, pa1, pa2, pa3; const int NT = seq / KVBLK;
  constexpr int SE = 0, SO = SDEPTH - 1;
  SLOAD(SE, 0); asm volatile("s_waitcnt vmcnt(0)" ::: "memory"); SWRITE(0, SE); __syncthreads();
  qkt(pA0, pA1, K_lds, qr, r32, hi); partialSM(pA0, pA1, m_reg, mnA, alA);
  SLOAD(SO, KVBLK); if constexpr (SDEPTH == 2) { if (2 < NT) SLOAD(SE, 2 * KVBLK); }
  SWAIT(); SWRITE(1, SO); __syncthreads();
  for (int j = 1; j + 1 < NT; j += 2) {
    SBAR(); qkt(pB0, pB1, (bf16_t*)((char*)K_lds + SHM_K), qr, r32, hi);
    finishSM(pA0, pA1, alA, l_reg, pa0, pa1, pa2, pa3); SBAR();
    SLOAD(SO, (j + SDEPTH) * KVBLK); SBAR();
    pv_d0(o, vb0, pa0, pa1, pa2, pa3); partialSM(pB0, pB1, m_reg, mnB, alB);
    __syncthreads(); SWAIT(); SWRITE(0, SE);
    RESC(alB); __syncthreads();
    SBAR(); qkt(pA0, pA1, K_lds, qr, r32, hi);
    finishSM(pB0, pB1, alB, l_reg, pa0, pa1, pa2, pa3); SBAR();
    if (SDEPTH == 1 || j + 3 < NT) SLOAD(SE, (j + 1 + SDEPTH) * KVBLK); SBAR();
    pv_d0(o, vb0 + (int)SHM_V, pa0, pa1, pa2, pa3); partialSM(pA0, pA1, m_reg, mnA, alA);
    __syncthreads(); SWAIT(); SWRITE(1, SO);
    RESC(alA); __syncthreads();
  }
  SBAR(); qkt(pB0, pB1, (bf16_t*)((char*)K_lds + SHM_K), qr, r32, hi);
  finishSM(pA0, pA1, alA, l_reg, pa0, pa1, pa2, pa3); SBAR();
  pv_d0(o, vb0, pa0, pa1, pa2, pa3); partialSM(pB0, pB1, m_reg, mnB, alB);
  __syncthreads(); RESC(alB);
  finishSM(pB0, pB1, alB, l_reg, pa0, pa1, pa2, pa3); SBAR();
  pv_d0(o, vb0 + (int)SHM_V, pa0, pa1, pa2, pa3);
  if (hi == 0) li_l[r32] = l_reg; asm volatile("s_waitcnt lgkmcnt(0)" ::: "memory");
  float rli[16];
#pragma unroll
  for (int r = 0; r < 16; ++r) rli[r] = __builtin_amdgcn_rcpf(li_l[crow(r, hi)]);
  bf16_t* Ow = Ob + (long)(wid * QBLK) * LDO;
#pragma unroll
  for (int r = 0; r < 16; ++r) { int orow = crow(r, hi);
    for (int d0 = 0; d0 < 4; ++d0) Ow[(long)orow * LDO + d0 * 32 + r32] = (bf16_t)(cvtpk(o[d0][r] * rli[r], 0.f) & 0xffffu); }
#undef SLOAD
#undef SWRITE
#undef SWAIT
#undef RESC
  __syncthreads();
}
#undef KSWZ
#undef SBAR
}

struct AddrLin { bf16_t* O; int ld; __device__ __forceinline__ bf16_t* operator()(const pg8::Unit& u, int rl, int tc) const { return O + (size_t)(u.pm * 256 + rl) * ld + u.pn * 256 + tc; } };
struct EpiRowScale {
    static constexpr bool PERM = true; bf16_t* O; int ld; const float* ssp; float cscale;
    __device__ __forceinline__ void operator()(f32x4 (&acc)[2][2][4][2], const pg8::Unit& u, const pg8::EpiCtx& c) const { const int e_lane = lane_id(), e_fr = e_lane & 15, e_fq = e_lane >> 4;
        const int hc = c.wc * 32 + e_fq * 8, rl0 = c.wr * 64 + e_fr;
#pragma unroll
        for (int ai = 0; ai < 2; ++ai)
#pragma unroll
            for (int m = 0; m < 4; ++m) { const int row = u.pm * 256 + ai * 128 + rl0 + m * 16; const f32x4 p0 = *(const f32x4*)(ssp + (size_t)row * 8), p1 = *(const f32x4*)(ssp + (size_t)row * 8 + 4);
                const float r = rsqrtf((((p0.x + p0.y) + (p0.z + p0.w)) + ((p1.x + p1.y) + (p1.z + p1.w))) * (1.0f / DM) + EPS) * cscale;
#pragma unroll
                for (int bj = 0; bj < 2; ++bj) { const f32x4 v0 = acc[ai][bj][m][0] * r, v1 = acc[ai][bj][m][1] * r;
                    st16((O + (size_t)row * ld + u.pn * 256 + bj * 128 + hc), (u32x4){cvtpk(v0.x, v0.y), cvtpk(v0.z, v0.w), cvtpk(v1.x, v1.y), cvtpk(v1.z, v1.w)}); } }
    }
};
struct EpiSoftmax {
    static constexpr bool PERM = true; bf16_t* P; int ld;
    __device__ __forceinline__ void operator()(f32x4 (&acc)[2][2][4][2], const pg8::Unit& u, const pg8::EpiCtx& c) const { const int e_lane = lane_id(), e_fr = e_lane & 15, e_fq = e_lane >> 4;
        const int hc = c.wc * 32 + e_fq * 8, rl0 = c.wr * 64 + e_fr;
        LAS float* pmx = (LAS float*)c.xl; LAS float* psm = pmx + 1024;
#pragma unroll
        for (int ai = 0; ai < 2; ++ai)
#pragma unroll
            for (int m = 0; m < 4; ++m) { float mx = -3.0e38f;
#pragma unroll
                for (int bj = 0; bj < 2; ++bj)
#pragma unroll
                    for (int n = 0; n < 2; ++n) { const f32x4 v = acc[ai][bj][m][n]; mx = fmaxf(fmaxf(mx, fmaxf(v.x, v.y)), fmaxf(v.z, v.w)); }
                mx = fmaxf(mx, __shfl_xor(mx, 16)); mx = fmaxf(mx, __shfl_xor(mx, 32));
                if (e_fq == 0) pmx[(ai * 128 + rl0 + m * 16) * 4 + c.wc] = mx; }
        WG_BAR();
#pragma unroll
        for (int ai = 0; ai < 2; ++ai)
#pragma unroll
            for (int m = 0; m < 4; ++m) { const int rl = ai * 128 + rl0 + m * 16; const f32x4 p4 = *(const LAS f32x4*)(pmx + rl * 4);
                const float mx = fmaxf(fmaxf(p4.x, p4.y), fmaxf(p4.z, p4.w)) * 1.4426950408889634f; float s = 0.f;
#pragma unroll
                for (int bj = 0; bj < 2; ++bj)
#pragma unroll
                    for (int n = 0; n < 2; ++n) { f32x4 v = acc[ai][bj][m][n];
                        v.x = __builtin_amdgcn_exp2f(fmaf(v.x, 1.4426950408889634f, -mx)); v.y = __builtin_amdgcn_exp2f(fmaf(v.y, 1.4426950408889634f, -mx));
                        v.z = __builtin_amdgcn_exp2f(fmaf(v.z, 1.4426950408889634f, -mx)); v.w = __builtin_amdgcn_exp2f(fmaf(v.w, 1.4426950408889634f, -mx));
                        s += (v.x + v.y) + (v.z + v.w); acc[ai][bj][m][n] = v; }
                s += __shfl_xor(s, 16); s += __shfl_xor(s, 32);
                if (e_fq == 0) psm[rl * 4 + c.wc] = s; }
        WG_BAR();
#pragma unroll
        for (int ai = 0; ai < 2; ++ai)
#pragma unroll
            for (int m = 0; m < 4; ++m) { const int rl = ai * 128 + rl0 + m * 16; const f32x4 p4 = *(const LAS f32x4*)(psm + rl * 4);
                const float inv = 1.0f / ((p4.x + p4.y) + (p4.z + p4.w));
#pragma unroll
                for (int bj = 0; bj < 2; ++bj) { const f32x4 v0 = acc[ai][bj][m][0] * inv, v1 = acc[ai][bj][m][1] * inv;
                    st16((P + (size_t)(u.pm * 256 + rl) * ld + u.pn * 256 + bj * 128 + hc), (u32x4){cvtpk(v0.x, v0.y), cvtpk(v0.z, v0.w), cvtpk(v1.x, v1.y), cvtpk(v1.z, v1.w)}); } }
        WG_BAR();
    }
};
struct MapXS { const char* Q; const char* K; __device__ __forceinline__ void operator()(pg8::Unit& u) const {
    u.a = Q + ((size_t)u.pm * 256 * DM + (size_t)u.pn * MHD) * 2; u.b = K + ((size_t)(u.pm >> 3) * MEML * DM + (size_t)u.pn * MHD) * 2; } };
struct SchedPair { pg8::Unit ua, ub; __device__ __forceinline__ bool next(int i, pg8::Unit& o) const { if (i >= 2) return false; o.pm = i ? ub.pm : ua.pm; o.pn = i ? ub.pn : ua.pn; o.a = i ? ub.a : ua.a; o.b = i ? ub.b : ua.b; asm volatile("" : "+s"(o.a), "+s"(o.b));     return true; } };
struct MapXPV { const char* P; const char* VT; __device__ __forceinline__ void operator()(pg8::Unit& u) const {
    u.a = P + ((size_t)u.pm * 256 * 1024 + (size_t)(u.pn >> 1) * MEML) * 2; u.b = VT + ((size_t)u.pn * 256 * 1024 + (size_t)(u.pm >> 3) * MEML) * 2; } };

struct MapMoE { const char* A; const char* W; size_t as, es, ws_; __device__ __forceinline__ void operator()(pg8::Unit& u) const {
    u.a = A + (size_t)u.pm * as; u.b = W + (size_t)(u.pm >> 2) * es + (size_t)u.pn * ws_; } };
struct EpiSwiGLU {
    static constexpr bool PERM = true; bf16_t* ACT; const float* rs;
    __device__ __forceinline__ void operator()(f32x4 (&acc)[2][2][4][2], const pg8::Unit& u, const pg8::EpiCtx& c) const { const int e_lane = lane_id(), e_fr = e_lane & 15, e_fq = e_lane >> 4;
        const int hc = c.wc * 32 + e_fq * 8, rl0 = c.wr * 64 + e_fr;
#pragma unroll
        for (int ai = 0; ai < 2; ++ai)
#pragma unroll
            for (int m = 0; m < 4; ++m) { f32x4 o[2]; const float rf = rs[u.pm * 256 + ai * 128 + rl0 + m * 16];
#pragma unroll
                for (int n = 0; n < 2; ++n) { const f32x4 g = acc[ai][0][m][n] * rf, up = acc[ai][1][m][n] * rf; f32x4 r;
                    r.x = g.x * __builtin_amdgcn_rcpf(1.0f + __builtin_amdgcn_exp2f(-1.4426950408889634f * g.x)) * up.x; r.y = g.y * __builtin_amdgcn_rcpf(1.0f + __builtin_amdgcn_exp2f(-1.4426950408889634f * g.y)) * up.y;
                    r.z = g.z * __builtin_amdgcn_rcpf(1.0f + __builtin_amdgcn_exp2f(-1.4426950408889634f * g.z)) * up.z; r.w = g.w * __builtin_amdgcn_rcpf(1.0f + __builtin_amdgcn_exp2f(-1.4426950408889634f * g.w)) * up.w; o[n] = r; }
                st16((ACT + (size_t)(u.pm * 256 + ai * 128 + rl0 + m * 16) * EFF + u.pn * 128 + hc), (u32x4){cvtpk(o[0].x, o[0].y), cvtpk(o[0].z, o[0].w), cvtpk(o[1].x, o[1].y), cvtpk(o[1].z, o[1].w)}); }
    }
};
struct EpiRowGate {
    static constexpr bool PERM = true; bf16_t* Y; const float* gate;
    __device__ __forceinline__ void operator()(f32x4 (&acc)[2][2][4][2], const pg8::Unit& u, const pg8::EpiCtx& c) const { const int e_lane = lane_id(), e_fr = e_lane & 15, e_fq = e_lane >> 4;
        const int hc = c.wc * 32 + e_fq * 8, rl0 = c.wr * 64 + e_fr;
#pragma unroll
        for (int ai = 0; ai < 2; ++ai)
#pragma unroll
            for (int m = 0; m < 4; ++m) { const int row = u.pm * 256 + ai * 128 + rl0 + m * 16; const float gt = gate[row];
#pragma unroll
                for (int bj = 0; bj < 2; ++bj) { const f32x4 v0 = acc[ai][bj][m][0] * gt, v1 = acc[ai][bj][m][1] * gt;
                    st16((Y + (size_t)row * DM + u.pn * 256 + bj * 128 + hc), (u32x4){cvtpk(v0.x, v0.y), cvtpk(v0.z, v0.w), cvtpk(v1.x, v1.y), cvtpk(v1.z, v1.w)}); } }
    }
};
__device__ __forceinline__ float rms_row_to_bf16_r(const float* xrow, const float* __restrict__ gain, bf16_t* orow, int lane) {
    const GAS f32x4* xr = (const GAS f32x4*)xrow + lane; const f32x4* gr = (const f32x4*)gain + lane;
    f32x4 v[8]; float s = 0.f;
#pragma unroll
    for (int j = 0; j < 8; ++j) { v[j] = xr[64 * j]; s += (v[j].x * v[j].x + v[j].y * v[j].y) + (v[j].z * v[j].z + v[j].w * v[j].w); }
    const float r = rsqrtf(wave_sum(s) * (1.f / DM) + EPS);
    GAS u32x2* o8 = (GAS u32x2*)orow + lane;
#pragma unroll
    for (int j = 0; j < 8; ++j) { const f32x4 g = gr[64 * j]; u32x2 w; w.x = cvtpk(v[j].x * r * g.x, v[j].y * r * g.y); w.y = cvtpk(v[j].z * r * g.z, v[j].w * r * g.w); o8[64 * j] = w; }
    return r;
}
__device__ __forceinline__ void router_phase(const Frame& F, const bf16_t* x, const u32x4* RBl, float* rrow, float* aff, LAS unsigned char* xl) {
    const int lane = lane_id(), tid = F.wave * 64 + lane;
    LAS u32x4* Bl = (LAS u32x4*)(F.lds + RING_OFF);
    for (int i = tid; i < 2 * 4096; i += 512) Bl[i] = RBl[i];
    __syncthreads();
    LAS float* red = (LAS float*)xl;
    LAS float* ssq = (LAS float*)(xl + 8192);
    const int rg = F.wave >> 2, kq = F.wave & 3, r16 = lane & 15, kg = lane >> 4;
    for (int rb = (int)blockIdx.x * 32; rb < NTOK; rb += F.G * 32) {
        const bf16_t* xr = x + (size_t)(rb + rg * 16 + r16) * DM + kq * 512 + kg * 8;
        bf16x8 a[16];
#pragma unroll
        for (int s = 0; s < 16; ++s) a[s] = *(const GAS bf16x8*)(xr + 32 * s);
        f32x4 acc = {0.f, 0.f, 0.f, 0.f}; float sq = 0.f;
#pragma unroll
        for (int s = 0; s < 16; ++s) { const int ks = kq * 16 + s;
            const bf16x8 bh = __builtin_bit_cast(bf16x8, Bl[ks * 64 + lane]), bl = __builtin_bit_cast(bf16x8, Bl[4096 + ks * 64 + lane]);
            acc = __builtin_amdgcn_mfma_f32_16x16x32_bf16(a[s], bh, acc, 0, 0, 0);
            acc = __builtin_amdgcn_mfma_f32_16x16x32_bf16(a[s], bl, acc, 0, 0, 0);
            const u32x4 av = __builtin_bit_cast(u32x4, a[s]);
            const float f0 = __uint_as_float(av.x << 16), f1 = __uint_as_float(av.x & 0xffff0000u), f2 = __uint_as_float(av.y << 16), f3 = __uint_as_float(av.y & 0xffff0000u);
            const float f4 = __uint_as_float(av.z << 16), f5 = __uint_as_float(av.z & 0xffff0000u), f6 = __uint_as_float(av.w << 16), f7 = __uint_as_float(av.w & 0xffff0000u);
            sq += ((f0 * f0 + f1 * f1) + (f2 * f2 + f3 * f3)) + ((f4 * f4 + f5 * f5) + (f6 * f6 + f7 * f7)); }
        sq += __shfl_xor(sq, 16); sq += __shfl_xor(sq, 32);
        *(LAS f32x4*)(red + ((rg * 4 + kq) * 64 + lane) * 4) = acc;
        if (kg == 0) ssq[(rg * 4 + kq) * 16 + r16] = sq;
        __syncthreads();
        if (kq == 0) {
            f32x4 t = *(const LAS f32x4*)(red + ((rg * 4 + 0) * 64 + lane) * 4);
#pragma unroll
            for (int q = 1; q < 4; ++q) t = t + *(const LAS f32x4*)(red + ((rg * 4 + q) * 64 + lane) * 4);
            const float lg[4] = {t.x, t.y, t.z, t.w};
#pragma unroll
            for (int i = 0; i < 4; ++i) { const int rr = 4 * kg + i; const float ss = (ssq[(rg * 4 + 0) * 16 + rr] + ssq[(rg * 4 + 1) * 16 + rr]) + (ssq[(rg * 4 + 2) * 16 + rr] + ssq[(rg * 4 + 3) * 16 + rr]);
                const float r = rsqrtf(ss * (1.f / DM) + EPS); const int row = rb + rg * 16 + rr;
                const float v = lg[i] * r; float mx = v;
                mx = fmaxf(mx, __shfl_xor(mx, 8)); mx = fmaxf(mx, __shfl_xor(mx, 4)); mx = fmaxf(mx, __shfl_xor(mx, 2)); mx = fmaxf(mx, __shfl_xor(mx, 1));
                const float ex = expf(v - mx); float sm = ex;
                sm += __shfl_xor(sm, 8); sm += __shfl_xor(sm, 4); sm += __shfl_xor(sm, 2); sm += __shfl_xor(sm, 1);
                const int b = row / SEQ, tt = row % SEQ; aff[((size_t)b * NE + r16) * SEQ + tt] = ex / sm;
                if (r16 == 0) rrow[row] = r; }
        }
        __syncthreads();
    }
}
__device__ __forceinline__ void rank_phase(const Frame& F, const float* aff, int* rank, float* gate, const float* rrow, float* rs, int* gidx) {
    const int lane = lane_id(), tid = F.wave * 64 + lane;
    LAS unsigned* wc = (LAS unsigned*)(F.lds + RING_OFF);
    LAS unsigned* ck = (LAS unsigned*)(F.lds + RING_OFF + 256);
    LAS unsigned* ci = ck + SEQ + 4;
    LAS unsigned* ncp = ci + SEQ + 4;
    for (int be = (int)blockIdx.x; be < NB * NE; be += F.G) {
        const int b = be >> 4, e = be & 15;
        unsigned k[4];
#pragma unroll
        for (int j = 0; j < 4; ++j) k[j] = __float_as_uint(aff[(size_t)be * SEQ + tid + 512 * j]);
        unsigned lo = 0u, hi = 0x3F800001u;
        if (tid == 0) ncp[0] = 0u;
        for (int it = 0; it < 40; ++it) {
            const unsigned mid = lo + ((hi - lo) >> 1); if (mid == lo) break;
            const int ws_ = __popcll(__ballot(k[0] >= mid)) + __popcll(__ballot(k[1] >= mid)) + __popcll(__ballot(k[2] >= mid)) + __popcll(__ballot(k[3] >= mid));
            if (lane == 0) wc[(it & 1) * 8 + F.wave] = (unsigned)ws_;
            __syncthreads();
            const u32x4 c0 = *(const LAS u32x4*)(wc + (it & 1) * 8), c1 = *(const LAS u32x4*)(wc + (it & 1) * 8 + 4);
            const int c = (int)(((c0.x + c0.y) + (c0.z + c0.w)) + ((c1.x + c1.y) + (c1.z + c1.w)));
            if (c < CAP) hi = mid; else { lo = mid; if (c <= 448) break; }
        }
        const unsigned T = lo;
        __syncthreads();
#pragma unroll
        for (int j = 0; j < 4; ++j) { const bool pred = k[j] >= T; const unsigned long long bal = __ballot(pred);
            const int wcount = __popcll(bal), pre = __popcll(bal & ((1ull << lane) - 1ull));
            unsigned base = 0u; if (lane == 0 && wcount) base = __hip_atomic_fetch_add(ncp, (unsigned)wcount, __ATOMIC_RELAXED, __HIP_MEMORY_SCOPE_WORKGROUP);
            base = (unsigned)__builtin_amdgcn_readfirstlane((int)base);
            if (pred) { ck[base + pre] = k[j]; ci[base + pre] = (unsigned)(tid + 512 * j); } else rank[(size_t)be * SEQ + tid + 512 * j] = CAP; }
        __syncthreads();
        const int nc = (int)ncp[0];
        if (tid < 4) { ck[nc + tid] = 0u; ci[nc + tid] = 0x7fffffffu; }
        __syncthreads();
        const int nc4 = (nc + 3) >> 2;
        for (int i = tid; i < nc; i += 512) { const unsigned kk = ck[i]; const int tt = (int)ci[i]; int cnt = 0;
#pragma unroll 4
            for (int m = 0; m < nc4; ++m) { const u32x4 km = ((const LAS u32x4*)ck)[m]; const u32x4 tm = ((const LAS u32x4*)ci)[m];
                cnt += ((km.x > kk || (km.x == kk && (int)tm.x < tt)) ? 1 : 0) + ((km.y > kk || (km.y == kk && (int)tm.y < tt)) ? 1 : 0)
                     + ((km.z > kk || (km.z == kk && (int)tm.z < tt)) ? 1 : 0) + ((km.w > kk || (km.w == kk && (int)tm.w < tt)) ? 1 : 0); }
            const int r = cnt < CAP ? cnt : CAP; rank[(size_t)be * SEQ + tt] = r;
            if (r < CAP) { const int sl = (e * 4 + b) * CAP + r; gate[sl] = __uint_as_float(kk); gidx[sl] = b * SEQ + tt; rs[sl] = rrow[b * SEQ + tt]; } }
        __syncthreads();
    }
}
__device__ __forceinline__ void combine_phase(const Frame& F, const bf16_t* xin, bf16_t* xo, float* fout, const bf16_t* Y, const int* rank, const float* __restrict__ gain, bf16_t* HNo, bool final_) {
    const int lane = lane_id();
    const int gw = (int)blockIdx.x * NWAVES + F.wave, NGW = F.G * NWAVES;
    for (int row = gw; row < NTOK; row += NGW) {
        const int b = row / SEQ, t = row % SEQ;
        int rk = CAP; if (lane < NE) rk = rank[((size_t)b * NE + lane) * SEQ + t];
        const GAS u32x2* xi = (const GAS u32x2*)(xin + (size_t)row * DM) + lane; f32x4 v[8];
#pragma unroll
        for (int j = 0; j < 8; ++j) { const u32x2 p = xi[64 * j]; v[j] = (f32x4){__uint_as_float(p.x << 16), __uint_as_float(p.x & 0xffff0000u), __uint_as_float(p.y << 16), __uint_as_float(p.y & 0xffff0000u)}; }
#pragma unroll
        for (int e = 0; e < NE; ++e) { const int r = __builtin_amdgcn_readlane(rk, e);
            if (r < CAP) { const u32x2* yr = (const u32x2*)(Y + ((size_t)(e * 4 + b) * CAP + r) * DM) + lane;
#pragma unroll
                for (int j = 0; j < 8; ++j) { const u32x2 w = yr[64 * j]; v[j].x += __uint_as_float(w.x << 16); v[j].y += __uint_as_float(w.x & 0xffff0000u); v[j].z += __uint_as_float(w.y << 16); v[j].w += __uint_as_float(w.y & 0xffff0000u); } } }
        float s = 0.f;
#pragma unroll
        for (int j = 0; j < 8; ++j) s += (v[j].x * v[j].x + v[j].y * v[j].y) + (v[j].z * v[j].z + v[j].w * v[j].w);
        const float r = rsqrtf(wave_sum(s) * (1.f / DM) + EPS); const f32x4* gr = (const f32x4*)gain + lane;
        if (final_) { GAS f32x4* fo = (GAS f32x4*)(fout + (size_t)row * DM) + lane;
#pragma unroll
            for (int j = 0; j < 8; ++j) { const f32x4 g = gr[64 * j]; fo[64 * j] = (f32x4){v[j].x * r * g.x, v[j].y * r * g.y, v[j].z * r * g.z, v[j].w * r * g.w}; }
        } else { GAS u32x2* o8 = (GAS u32x2*)(HNo + (size_t)row * DM) + lane; GAS u32x2* x8 = (GAS u32x2*)(xo + (size_t)row * DM) + lane;
#pragma unroll
            for (int j = 0; j < 8; ++j) { const f32x4 g = gr[64 * j]; x8[64 * j] = (u32x2){cvtpk(v[j].x, v[j].y), cvtpk(v[j].z, v[j].w)}; o8[64 * j] = (u32x2){cvtpk(v[j].x * r * g.x, v[j].y * r * g.y), cvtpk(v[j].z * r * g.z, v[j].w * r * g.w)}; } }
    }
}
struct MapPool { const char* A; const char* W; __device__ __forceinline__ void operator()(pg8::Unit& u) const {
    u.a = A + ((size_t)u.pm * 256 * DM + (size_t)(u.pn >> 1) * 512) * 2; u.b = W + ((size_t)(u.pn & 1) * 256 * DM + (size_t)(u.pn >> 1) * 512) * 2; } };
template <int W> __device__ __forceinline__ void pool_item4(const bf16_t* H, bf16_t* P, int row0, int c8) {
    const int t0 = row0 & (SEQ - 1); const bf16_t* base = H + (size_t)(row0 - t0) * DM + c8 * 8;
    u32x4 v[W + 3];
#pragma unroll
    for (int i = 0; i < W + 3; ++i) { int j = t0 - W / 2 + i; j = j < 0 ? 0 : (j > SEQ - 1 ? SEQ - 1 : j); v[i] = *(const u32x4*)(base + (size_t)j * DM); }
    float f[W + 3][8];
#pragma unroll
    for (int i = 0; i < W + 3; ++i) { const int j = t0 - W / 2 + i; const float m = (j >= 0 && j < SEQ) ? 1.f : 0.f;
        f[i][0] = m * __uint_as_float(v[i].x << 16); f[i][1] = m * __uint_as_float(v[i].x & 0xffff0000u); f[i][2] = m * __uint_as_float(v[i].y << 16); f[i][3] = m * __uint_as_float(v[i].y & 0xffff0000u);
        f[i][4] = m * __uint_as_float(v[i].z << 16); f[i][5] = m * __uint_as_float(v[i].z & 0xffff0000u); f[i][6] = m * __uint_as_float(v[i].w << 16); f[i][7] = m * __uint_as_float(v[i].w & 0xffff0000u); }
    float s[8];
#pragma unroll
    for (int c = 0; c < 8; ++c) { s[c] = 0.f;
#pragma unroll
        for (int i = 0; i < W; ++i) s[c] += f[i][c]; }
#pragma unroll
    for (int q = 0; q < 4; ++q) { const int t = t0 + q; int lo = t - W / 2, hi = t + W / 2; if (lo < 0) lo = 0; if (hi > SEQ) hi = SEQ; const float inv = 1.0f / (float)(hi - lo);
        if (q > 0) {
#pragma unroll
            for (int c = 0; c < 8; ++c) s[c] += f[q + W - 1][c] - f[q - 1][c]; }
        const float* e = f[q + W / 2];
        *(u32x4*)(P + (size_t)(row0 + q) * DM + c8 * 8) = (u32x4){cvtpk(s[0] * inv - e[0], s[1] * inv - e[1]), cvtpk(s[2] * inv - e[2], s[3] * inv - e[3]), cvtpk(s[4] * inv - e[4], s[5] * inv - e[5]), cvtpk(s[6] * inv - e[6], s[7] * inv - e[7])}; }
}
__device__ __forceinline__ void pool_phase(const Frame& F, const bf16_t* H, bf16_t* P) {
    const int lane = lane_id(); const int gwv = (int)blockIdx.x * NWAVES + F.wave, NWV = F.G * NWAVES;
    for (int wi = gwv; wi < NTOK; wi += NWV) {
        const int row0 = (wi >> 2) * 4, g = wi & 3, c8 = g * 64 + lane;
        if (g == 0) pool_item4<2>(H, P, row0, c8); else if (g == 1) pool_item4<4>(H, P, row0, c8); else if (g == 2) pool_item4<8>(H, P, row0, c8); else pool_item4<16>(H, P, row0, c8);
    }
}

constexpr int N_PHASES = 24;
#ifndef MK_N_LAUNCHES
#define MK_N_LAUNCHES 1
#endif
#ifndef REP_MASK
#define REP_MASK 0
#endif
__global__ void __launch_bounds__(NWAVES * 64, 2) skel_fwd(Args args) {
    extern __shared__ __attribute__((aligned(16))) unsigned char lds_raw[];
    Frame F;
    F.lds = (LAS unsigned char*)lds_raw; F.MISC = (volatile LAS unsigned*)(F.lds + MISC_OFF);
    F.wave = __builtin_amdgcn_readfirstlane(threadIdx.x >> 6);
    F.G = gridDim.x; { const int bx = blockIdx.x; F.vcu = (F.G % 8 == 0) ? (bx % 8) * (F.G / 8) + bx / 8 : bx; }
    F.ws = nullptr; F.ctl = (gu32*)(uptr(args.ws) + WS_CTL);
    for (int u = threadIdx.x; u < (LDS_BYTES - LDSCTL_OFF) / 4; u += NWAVES * 64) ((LAS unsigned*)(F.lds + LDSCTL_OFF))[u] = 0u;
    __syncthreads();
    const bool multi = (MK_N_LAUNCHES == 1) || (args.ph_hi - args.ph_lo) > 1 || REP_MASK != 0;
    XcdBarrier bar; bar.bar = (unsigned*)(F.ctl + CW_BAR); bar.x = 0; bar.st = nullptr; bar.wave = F.wave;
    if (multi) bar = xcd_barrier_post((unsigned*)(F.ctl + CW_BAR), F.MISC + 8, F.wave);
    const int lo = args.ph_lo, hi = args.ph_hi;
#ifdef REP_RT
    const unsigned rep_mask_ = (unsigned)__builtin_amdgcn_readfirstlane(args.pad);
#endif
#define IN(k) ((MK_N_LAUNCHES == 1) ? ((k) < N_PHASES) : (lo <= (k) && (k) < hi))
#ifdef REP_RT
#define REPBIT(k) ((int)((rep_mask_ >> (k)) & 1u))
#else
#define REPBIT(k) ((int)((((unsigned)REP_MASK) >> (k)) & 1u))
#endif
#define PHASE(k) _Pragma("unroll") for (int rep_ = 0; rep_ < 1 + REPBIT(k); ++rep_)
#define SEAM(k) do { if ((IN(k) && IN((k) + 1)) || rep_ + 1 < 1 + REPBIT(k)) xcd_barrier(bar); } while (0)
    LAS unsigned char* ring = F.lds + RING_OFF; LAS unsigned char* xl = F.lds + XL_OFF;
    const int bx = (int)blockIdx.x, G = F.G;

#define KV_PROJ(l, rotK, rotV) do {   \
            { MapLin mp{(const char*)(ws + WS_MEMNB + (size_t)(l) * NB * MEML * DM * 2), (const char*)(ws + WS_WCK_T + (size_t)(l) * DM * DM * 2), (size_t)256 * DM * 2, (size_t)256 * DM * 2}; \
              pg8::Sched<MapLin> S; S.init(NB * MEML / 256, DM / 256, G, (bx + G - ((rotK) % G)) % G, mp); \
              EpiStore<AddrLin> E{AddrLin{(bf16_t*)(ws + WS_KCB + (size_t)(l) * NB * MEML * DM * 2), DM}}; \
              pg8::gemm_phase<EpiStore<AddrLin>, pg8::Sched<MapLin>, true>(F.wave, ring, xl, DM, DM * 2, DM * 2, S, E); } \
            { MapLin mp{(const char*)(ws + WS_WCV_T + (size_t)(l) * DM * DM * 2), (const char*)(ws + WS_MEMNB + (size_t)(l) * NB * MEML * DM * 2), (size_t)256 * DM * 2, (size_t)256 * DM * 2}; \
              pg8::Sched<MapLin> S; S.init(DM / 256, NB * MEML / 256, G, (bx + G - ((rotV) % G)) % G, mp); \
              EpiStore<AddrLin> E{AddrLin{(bf16_t*)(ws + WS_VTB + (size_t)(l) * NB * MEML * DM * 2), NB * MEML}}; \
              pg8::gemm_phase<EpiStore<AddrLin>, pg8::Sched<MapLin>, true>(F.wave, ring, xl, DM, DM * 2, DM * 2, S, E); } } while (0)
#ifdef EXTRA_BARS
    for (int eb = 0; eb < EXTRA_BARS; ++eb) xcd_barrier(bar);
#endif
    if (IN(0)) PHASE(0) { const karg_t ka = kargs(); unsigned char* const ws = uptr(KWS(ka)); p0_prologue(F, ka, ws); SEAM(0); }
    if (IN(1)) PHASE(1) { const karg_t ka = kargs(); unsigned char* const ws = uptr(KWS(ka));
        {
            MapLin mp{(const char*)(ws + WS_HN), (const char*)(ws + WS_WIN_T), (size_t)256 * DM * 2, (size_t)256 * DM * 2};
            pg8::Sched<MapLin> S; S.init(NTOK / 256, 2560 / 256, G, bx, mp);
            EpiQKV E{(bf16_t*)(ws + WS_QB), (bf16_t*)(ws + WS_KB), (bf16_t*)(ws + WS_VB), KIN(ka, 4), KIN(ka, 5), (const float*)(ws + WS_ROPE), (const float*)(ws + WS_ROPE) + SEQ * 64};
            pg8::gemm_phase<EpiQKV, pg8::Sched<MapLin>, true>(F.wave, ring, xl, DM, DM * 2, DM * 2, S, E); }
        {
            MapLin mp{(const char*)(ws + WS_WF_T), (const char*)(ws + WS_HN), (size_t)256 * DM * 2, (size_t)256 * DM * 2};
            pg8::Sched<MapLin> S; S.init(1024 / 256, NTOK / 256, G, (bx + G - (320 % G)) % G, mp);
            EpiStore<AddrF1> E{AddrF1{(bf16_t*)(ws + WS_FPQ)}};
            pg8::gemm_phase<EpiStore<AddrF1>, pg8::Sched<MapLin>, true>(F.wave, ring, xl, DM, DM * 2, DM * 2, S, E); }
        KV_PROJ(0, 448, 480);
        SEAM(1);
    }
    if (IN(2)) PHASE(2) { const karg_t ka = kargs(); unsigned char* const ws = uptr(KWS(ka));
        const int nF2 = (G > 64) ? 64 : 0;
        if (bx < nF2 || nF2 == 0) {
            MapLin mp{(const char*)(ws + WS_DFT), (const char*)(ws + WS_FPQ), (size_t)256 * 4096 * 2, (size_t)256 * 4096 * 2};
            pg8::Sched<MapLin> S; S.init(8, 8, nF2 ? nF2 : G, bx, mp);
            EpiStore<AddrF2> E{AddrF2{(bf16_t*)(ws + WS_MIXB)}};
            pg8::gemm_phase<EpiStore<AddrF2>, pg8::Sched<MapLin>, true>(F.wave, ring, xl, 4096, 4096 * 2, 4096 * 2, S, E);
        }
        if (bx < nF2) { __syncthreads(); tr_span(F, ka, ws, 1, 7680 + bx * 8 + F.wave, 512, 9); __syncthreads(); }
        if (bx >= nF2) {
            const int a = bx - nF2, cnt = G - nF2, per = (384 + cnt - 1) / cnt, slot = a % 3; int ui = 0;
            for (int uid = a * per; uid < (a + 1) * per && uid < 384; ++uid, ++ui) {
                if (ui == slot) { __syncthreads(); tr_span(F, ka, ws, 1, a * 8 + F.wave, 1536, 5); __syncthreads(); }
                const int qb = uid & 7, hq = (uid >> 3) % NQH, b = uid / (8 * NQH), kvh = hq / 3;
                const bf16_t* Qb = (const bf16_t*)(ws + WS_QB) + ((size_t)b * SEQ + qb * 256) * AW + hq * HD;
                const bf16_t* Kh = (const bf16_t*)(ws + WS_KB) + (size_t)b * SEQ * KVW + kvh * HD;
                const bf16_t* Vh = (const bf16_t*)(ws + WS_VB) + (size_t)b * SEQ * KVW + kvh * HD;
                bf16_t* Ob = (bf16_t*)(ws + WS_MIXB) + ((size_t)b * SEQ + qb * 256) * DM + hq * HD;
                attn::attn_dense_body(Qb, Kh, Vh, Ob, SEQ, (char*)lds_raw + RING_OFF, F.wave);
            }
            if (slot >= ui) { __syncthreads(); tr_span(F, ka, ws, 1, a * 8 + F.wave, 1536, 5); __syncthreads(); }
        }
        SEAM(2);
    }
    if (IN(3)) PHASE(3) { const karg_t ka = kargs(); unsigned char* const ws = uptr(KWS(ka));
        MapLin mp{(const char*)(ws + WS_MIXB), (const char*)(ws + WS_WOUT_T), (size_t)256 * DM * 2, (size_t)256 * DM * 2};
        pg8::Sched<MapLin> S; S.init(NTOK / 256, DM / 256, G, bx, mp);
        EpiResB<true> E{KIN(ka, 0), (bf16_t*)(ws + WS_XB), (float*)(ws + WS_SSP), nullptr};
        pg8::gemm_phase<EpiResB<true>, pg8::Sched<MapLin>, true>(F.wave, ring, xl, DM, DM * 2, DM * 2, S, E);
        SEAM(3);
    }
    {
        constexpr int l = 0; constexpr int pb = l ? 15 : 4;
        if (l == 1) {
            if (IN(13)) PHASE(13) { const karg_t ka = kargs(); unsigned char* const ws = uptr(KWS(ka));
                pool_phase(F, (const bf16_t*)(ws + WS_HN), (bf16_t*)(ws + WS_QCB));
#ifdef PROBE_CONV
                tr_span<TRV>(F, ka, ws, 1, bx * 8 + F.wave, 2048, 6);
#endif
                SEAM(13);
            }
            if (IN(14)) PHASE(14) { const karg_t ka = kargs(); unsigned char* const ws = uptr(KWS(ka));
                MapPool mp{(const char*)(ws + WS_QCB), (const char*)(ws + WS_WP_T)};
                pg8::Sched<MapPool> S; S.init(NTOK / 256, DM / 256, G, bx, mp);
                EpiResB<false> E{(const bf16_t*)(ws + WS_XB), (bf16_t*)(ws + WS_XALT), (float*)(ws + WS_SSP), KIN(ka, 9)};
                pg8::gemm_phase<EpiResB<false>, pg8::Sched<MapPool>, true>(F.wave, ring, xl, 512, DM * 2, DM * 2, S, E);
                SEAM(14);
            }
        }
        if (IN(pb + 0)) PHASE(pb + 0) { const karg_t ka = kargs(); unsigned char* const ws = uptr(KWS(ka));
            MapLin mp{(const char*)(ws + (l == 0 ? WS_XB : WS_XALT)), (const char*)(ws + WS_WCQ_T + (size_t)l * DM * DM * 2), (size_t)256 * DM * 2, (size_t)256 * DM * 2};
            pg8::Sched<MapLin> S; S.init(NTOK / 256, DM / 256, G, bx, mp);
            EpiRowScale E{(bf16_t*)(ws + WS_QCB), DM, (const float*)(ws + WS_SSP), 0.04419417382415922f};
            pg8::gemm_phase<EpiRowScale, pg8::Sched<MapLin>, true>(F.wave, ring, xl, DM, DM * 2, DM * 2, S, E);
            SEAM(pb + 0);
        }
        if (IN(pb + 1)) PHASE(pb + 1) { const karg_t ka = kargs(); unsigned char* const ws = uptr(KWS(ka));
            MapXS mp{(const char*)(ws + WS_QCB), (const char*)(ws + WS_KCB + (size_t)l * NB * MEML * DM * 2)};
            pg8::Sched<MapXS> S; S.init(NTOK / 256, NMH, G, bx, mp);
            EpiSoftmax E{(bf16_t*)(ws + WS_PB), NMH * MEML};
            pg8::gemm_phase<EpiSoftmax, pg8::Sched<MapXS>, true>(F.wave, ring, xl, MHD, DM * 2, DM * 2, S, E);
            { pg8::Unit su; if (S.next(0, su)) {
                VM_WAIT(); __syncthreads(); if (F.wave == 0 && lane_id() == 0) { __builtin_amdgcn_fence(__ATOMIC_ACQUIRE, "agent"); VM_WAIT(); } __syncthreads();
                MapXPV mp2{(const char*)(ws + WS_PB), (const char*)(ws + WS_VTB + (size_t)l * NB * MEML * DM * 2)};
                SchedPair S2; S2.ua.pm = su.pm; S2.ua.pn = 2 * su.pn; S2.ub.pm = su.pm; S2.ub.pn = 2 * su.pn + 1; mp2(S2.ua); mp2(S2.ub);
                EpiStore<AddrLin> E2{AddrLin{(bf16_t*)(ws + WS_MIXB), DM}};
                pg8::gemm_phase<EpiStore<AddrLin>, SchedPair, true>(F.wave, ring, xl, MEML, NMH * MEML * 2, NB * MEML * 2, S2, E2); } }
            if (l == 0) { KV_PROJ(1, 128, 160);
                if (bx < 128) { __syncthreads(); tr_span(F, ka, ws, 2, bx * 8 + F.wave, 1024, 2); }
                else if (bx >= 192) { tr_span(F, ka, ws, 2, 2048 + (bx - 192) * 8 + F.wave, 512, 1); } }
            SEAM(pb + 1);
        }
        if (IN(pb + 3)) PHASE(pb + 3) { const karg_t ka = kargs(); unsigned char* const ws = uptr(KWS(ka));
            MapLin mp{(const char*)(ws + WS_MIXB), (const char*)(ws + WS_WCO_T + (size_t)l * DM * DM * 2), (size_t)256 * DM * 2, (size_t)256 * DM * 2};
            pg8::Sched<MapLin> S; S.init(NTOK / 256, DM / 256, G, bx, mp);
            EpiResB<false> E{(const bf16_t*)(ws + (l == 0 ? WS_XB : WS_XALT)), (bf16_t*)(ws + (l == 0 ? WS_XALT : WS_XB)), nullptr, nullptr};
            pg8::gemm_phase<EpiResB<false>, pg8::Sched<MapLin>, true>(F.wave, ring, xl, DM, DM * 2, DM * 2, S, E);
            SEAM(pb + 3);
        }
        if (IN(pb + 4)) PHASE(pb + 4) { const karg_t ka = kargs(); unsigned char* const ws = uptr(KWS(ka));
            router_phase(F, (const bf16_t*)(ws + (l == 0 ? WS_XALT : WS_XB)), (const u32x4*)(ws + WS_AFF + 512 * 1024) + (size_t)l * 8192, (float*)(ws + WS_SSP + 512 * 1024), (float*)(ws + WS_AFF), xl);
            SEAM(pb + 4);
        }
        if (IN(pb + 5)) PHASE(pb + 5) { const karg_t ka = kargs(); unsigned char* const ws = uptr(KWS(ka));
            rank_phase(F, (const float*)(ws + WS_AFF), (int*)(ws + WS_RANK), (float*)(ws + WS_GATE), (const float*)(ws + WS_SSP + 512 * 1024), (float*)(ws + WS_SSP + 768 * 1024), (int*)(ws + WS_GATE + 512 * 1024));
            if (l == 0 && bx >= NB * NE) tr_span(F, ka, ws, 2, 2560 + (bx - NB * NE) * 8 + F.wave, 1536, 1);
            SEAM(pb + 5);
        }
        if (IN(pb + 6)) PHASE(pb + 6) { const karg_t ka = kargs(); unsigned char* const ws = uptr(KWS(ka));
            MapMoE mp{(const char*)(ws + (l == 0 ? WS_XALT : WS_XB)), (const char*)(ws + (l ? WS_WGU_T2 : WS_WGU_T)), (size_t)0, (size_t)2048 * DM * 2, (size_t)256 * DM * 2};
            pg8::Sched<MapMoE> S; S.init(NB * NE, 8, G, bx, mp);
            EpiSwiGLU E{(bf16_t*)(ws + WS_ACTB), (const float*)(ws + WS_SSP + 768 * 1024)};
            const bool cfirst = ((bx >> 3) & 1) != 0;
            if (l == 0 && cfirst) { tr_span(F, ka, ws, 2, 4096 + bx * 8 + F.wave, 2048, 2); __syncthreads(); }
            pg8::gemm_phase<EpiSwiGLU, pg8::Sched<MapMoE>, true, true>(F.wave, ring, xl, DM, DM * 2, DM * 2, S, E, (const int*)(ws + WS_GATE + 512 * 1024));
            if (l == 0 && !cfirst) { __syncthreads(); tr_span(F, ka, ws, 2, 4096 + bx * 8 + F.wave, 2048, 2); }
            SEAM(pb + 6);
        }
        if (IN(pb + 7)) PHASE(pb + 7) { const karg_t ka = kargs(); unsigned char* const ws = uptr(KWS(ka));
            MapMoE mp{(const char*)(ws + WS_ACTB), (const char*)(ws + (l ? WS_WD_T2 : WS_WD_T)), (size_t)256 * EFF * 2, (size_t)2048 * EFF * 2, (size_t)256 * EFF * 2};
            pg8::Sched<MapMoE> S; S.init(NB * NE, 8, G, bx, mp);
            EpiRowGate E{(bf16_t*)(ws + WS_YB), (const float*)(ws + WS_GATE)};
            const bool cfirst = ((bx >> 3) & 1) == 0;
            if (l == 0 && cfirst) { tr_span(F, ka, ws, 2, 8192 + bx * 8 + F.wave, 2048, 2); __syncthreads(); }
            pg8::gemm_phase<EpiRowGate, pg8::Sched<MapMoE>, true>(F.wave, ring, xl, EFF, EFF * 2, EFF * 2, S, E);
            if (l == 0 && !cfirst) { __syncthreads(); tr_span(F, ka, ws, 2, 8192 + bx * 8 + F.wave, 2048, 2); }
            SEAM(pb + 7);
        }
        if (IN(pb + 8)) PHASE(pb + 8) { const karg_t ka = kargs(); unsigned char* const ws = uptr(KWS(ka));
            combine_phase(F, (const bf16_t*)(ws + (l == 0 ? WS_XALT : WS_XB)), (bf16_t*)(ws + WS_XB), KOUT(ka), (const bf16_t*)(ws + WS_YB), (const int*)(ws + WS_RANK), l == 0 ? KIN(ka, 2) + DM : KIN(ka, 21), (bf16_t*)(ws + WS_HN), l == 1);
            SEAM(pb + 8);
        }
    }
    {
        constexpr int l = 1; constexpr int pb = l ? 15 : 4;
        if (l == 1) {
            if (IN(13)) PHASE(13) { const karg_t ka = kargs(); unsigned char* const ws = uptr(KWS(ka));
                pool_phase(F, (const bf16_t*)(ws + WS_HN), (bf16_t*)(ws + WS_QCB));
#ifdef PROBE_CONV
                tr_span<TRV>(F, ka, ws, 1, bx * 8 + F.wave, 2048, 6);
#endif
                SEAM(13);
            }
            if (IN(14)) PHASE(14) { const karg_t ka = kargs(); unsigned char* const ws = uptr(KWS(ka));
                MapPool mp{(const char*)(ws + WS_QCB), (const char*)(ws + WS_WP_T)};
                pg8::Sched<MapPool> S; S.init(NTOK / 256, DM / 256, G, bx, mp);
                EpiResB<false> E{(const bf16_t*)(ws + WS_XB), (bf16_t*)(ws + WS_XALT), (float*)(ws + WS_SSP), KIN(ka, 9)};
                pg8::gemm_phase<EpiResB<false>, pg8::Sched<MapPool>, true>(F.wave, ring, xl, 512, DM * 2, DM * 2, S, E);
                SEAM(14);
            }
        }
        if (IN(pb + 0)) PHASE(pb + 0) { const karg_t ka = kargs(); unsigned char* const ws = uptr(KWS(ka));
            MapLin mp{(const char*)(ws + (l == 0 ? WS_XB : WS_XALT)), (const char*)(ws + WS_WCQ_T + (size_t)l * DM * DM * 2), (size_t)256 * DM * 2, (size_t)256 * DM * 2};
            pg8::Sched<MapLin> S; S.init(NTOK / 256, DM / 256, G, bx, mp);
            EpiRowScale E{(bf16_t*)(ws + WS_QCB), DM, (const float*)(ws + WS_SSP), 0.04419417382415922f};
            pg8::gemm_phase<EpiRowScale, pg8::Sched<MapLin>, true>(F.wave, ring, xl, DM, DM * 2, DM * 2, S, E);
            SEAM(pb + 0);
        }
        if (IN(pb + 1)) PHASE(pb + 1) { const karg_t ka = kargs(); unsigned char* const ws = uptr(KWS(ka));
            MapXS mp{(const char*)(ws + WS_QCB), (const char*)(ws + WS_KCB + (size_t)l * NB * MEML * DM * 2)};
            pg8::Sched<MapXS> S; S.init(NTOK / 256, NMH, G, bx, mp);
            EpiSoftmax E{(bf16_t*)(ws + WS_PB), NMH * MEML};
            pg8::gemm_phase<EpiSoftmax, pg8::Sched<MapXS>, true>(F.wave, ring, xl, MHD, DM * 2, DM * 2, S, E);
            { pg8::Unit su; if (S.next(0, su)) {
                VM_WAIT(); __syncthreads(); if (F.wave == 0 && lane_id() == 0) { __builtin_amdgcn_fence(__ATOMIC_ACQUIRE, "agent"); VM_WAIT(); } __syncthreads();
                MapXPV mp2{(const char*)(ws + WS_PB), (const char*)(ws + WS_VTB + (size_t)l * NB * MEML * DM * 2)};
                SchedPair S2; S2.ua.pm = su.pm; S2.ua.pn = 2 * su.pn; S2.ub.pm = su.pm; S2.ub.pn = 2 * su.pn + 1; mp2(S2.ua); mp2(S2.ub);
                EpiStore<AddrLin> E2{AddrLin{(bf16_t*)(ws + WS_MIXB), DM}};
                pg8::gemm_phase<EpiStore<AddrLin>, SchedPair, true>(F.wave, ring, xl, MEML, NMH * MEML * 2, NB * MEML * 2, S2, E2); } }
            if (l == 0) { KV_PROJ(1, 128, 160);
                if (bx < 128) { __syncthreads(); tr_span(F, ka, ws, 2, bx * 8 + F.wave, 1024, 2); }
                else if (bx >= 192) { tr_span(F, ka, ws, 2, 2048 + (bx - 192) * 8 + F.wave, 512, 1); } }
            SEAM(pb + 1);
        }
        if (IN(pb + 3)) PHASE(pb + 3) { const karg_t ka = kargs(); unsigned char* const ws = uptr(KWS(ka));
            MapLin mp{(const char*)(ws + WS_MIXB), (const char*)(ws + WS_WCO_T + (size_t)l * DM * DM * 2), (size_t)256 * DM * 2, (size_t)256 * DM * 2};
            pg8::Sched<MapLin> S; S.init(NTOK / 256, DM / 256, G, bx, mp);
            EpiResB<false> E{(const bf16_t*)(ws + (l == 0 ? WS_XB : WS_XALT)), (bf16_t*)(ws + (l == 0 ? WS_XALT : WS_XB)), nullptr, nullptr};
            pg8::gemm_phase<EpiResB<false>, pg8::Sched<MapLin>, true>(F.wave, ring, xl, DM, DM * 2, DM * 2, S, E);
            SEAM(pb + 3);
        }
        if (IN(pb + 4)) PHASE(pb + 4) { const karg_t ka = kargs(); unsigned char* const ws = uptr(KWS(ka));
            router_phase(F, (const bf16_t*)(ws + (l == 0 ? WS_XALT : WS_XB)), (const u32x4*)(ws + WS_AFF + 512 * 1024) + (size_t)l * 8192, (float*)(ws + WS_SSP + 512 * 1024), (float*)(ws + WS_AFF), xl);
            SEAM(pb + 4);
        }
        if (IN(pb + 5)) PHASE(pb + 5) { const karg_t ka = kargs(); unsigned char* const ws = uptr(KWS(ka));
            rank_phase(F, (const float*)(ws + WS_AFF), (int*)(ws + WS_RANK), (float*)(ws + WS_GATE), (const float*)(ws + WS_SSP + 512 * 1024), (float*)(ws + WS_SSP + 768 * 1024), (int*)(ws + WS_GATE + 512 * 1024));
            if (l == 0 && bx >= NB * NE) tr_span(F, ka, ws, 2, 2560 + (bx - NB * NE) * 8 + F.wave, 1536, 1);
            SEAM(pb + 5);
        }
        if (IN(pb + 6)) PHASE(pb + 6) { const karg_t ka = kargs(); unsigned char* const ws = uptr(KWS(ka));
            MapMoE mp{(const char*)(ws + (l == 0 ? WS_XALT : WS_XB)), (const char*)(ws + (l ? WS_WGU_T2 : WS_WGU_T)), (size_t)0, (size_t)2048 * DM * 2, (size_t)256 * DM * 2};
            pg8::Sched<MapMoE> S; S.init(NB * NE, 8, G, bx, mp);
            EpiSwiGLU E{(bf16_t*)(ws + WS_ACTB), (const float*)(ws + WS_SSP + 768 * 1024)};
            const bool cfirst = ((bx >> 3) & 1) != 0;
            if (l == 0 && cfirst) { tr_span(F, ka, ws, 2, 4096 + bx * 8 + F.wave, 2048, 2); __syncthreads(); }
            pg8::gemm_phase<EpiSwiGLU, pg8::Sched<MapMoE>, true, true>(F.wave, ring, xl, DM, DM * 2, DM * 2, S, E, (const int*)(ws + WS_GATE + 512 * 1024));
            if (l == 0 && !cfirst) { __syncthreads(); tr_span(F, ka, ws, 2, 4096 + bx * 8 + F.wave, 2048, 2); }
            SEAM(pb + 6);
        }
        if (IN(pb + 7)) PHASE(pb + 7) { const karg_t ka = kargs(); unsigned char* const ws = uptr(KWS(ka));
            MapMoE mp{(const char*)(ws + WS_ACTB), (const char*)(ws + (l ? WS_WD_T2 : WS_WD_T)), (size_t)256 * EFF * 2, (size_t)2048 * EFF * 2, (size_t)256 * EFF * 2};
            pg8::Sched<MapMoE> S; S.init(NB * NE, 8, G, bx, mp);
            EpiRowGate E{(bf16_t*)(ws + WS_YB), (const float*)(ws + WS_GATE)};
            const bool cfirst = ((bx >> 3) & 1) == 0;
            if (l == 0 && cfirst) { tr_span(F, ka, ws, 2, 8192 + bx * 8 + F.wave, 2048, 2); __syncthreads(); }
            pg8::gemm_phase<EpiRowGate, pg8::Sched<MapMoE>, true>(F.wave, ring, xl, EFF, EFF * 2, EFF * 2, S, E);
            if (l == 0 && !cfirst) { __syncthreads(); tr_span(F, ka, ws, 2, 8192 + bx * 8 + F.wave, 2048, 2); }
            SEAM(pb + 7);
        }
        if (IN(pb + 8)) PHASE(pb + 8) { const karg_t ka = kargs(); unsigned char* const ws = uptr(KWS(ka));
            combine_phase(F, (const bf16_t*)(ws + (l == 0 ? WS_XALT : WS_XB)), (bf16_t*)(ws + WS_XB), KOUT(ka), (const bf16_t*)(ws + WS_YB), (const int*)(ws + WS_RANK), l == 0 ? KIN(ka, 2) + DM : KIN(ka, 21), (bf16_t*)(ws + WS_HN), l == 1);
            SEAM(pb + 8);
        }
    }
#undef IN
#undef SEAM
#undef PHASE
#undef KV_PROJ
}


extern "C" void kernel_launch(void* const* d_in, const int* in_sizes, int n_in, void* d_out, int out_size, void* d_ws, size_t ws_size, hipStream_t stream) {
    static int grid = 0;
    if (grid == 0) {
        int dev = 0, cus = 0;
        if (n_in != 22 || out_size != NTOK * DM || ws_size < WS_FAST_END) { fprintf(stderr, "kernel_launch: unexpected shapes (n_in %d out %d ws %zu)\n", n_in, out_size, ws_size); grid = -1; return; }
        if (hipGetDevice(&dev) != hipSuccess || hipDeviceGetAttribute(&cus, hipDeviceAttributeMultiprocessorCount, dev) != hipSuccess) { fprintf(stderr, "device query failed\n"); grid = -1; return; }
        if (hipFuncSetAttribute((const void*)skel_fwd, hipFuncAttributeMaxDynamicSharedMemorySize, LDS_BYTES) != hipSuccess) { fprintf(stderr, "hipFuncSetAttribute failed\n"); grid = -1; return; }
        (void)hipGetLastError();
        grid = cus;
        if (grid != 256) { fprintf(stderr, "kernel_launch: this kernel is laid out for 256 CUs (found %d)\n", cus); grid = -1; return; }
    }
    if (grid < 0) return;
    (void)hipMemsetAsync((char*)d_ws + WS_CTL, 0, 32768, stream);
    Args a{};
    for (int i = 0; i < 22; ++i) a.in[i] = (const float*)d_in[i];
    a.out = (float*)d_out; a.ws = (unsigned char*)d_ws;
#ifdef REP_RT
    a.pad = REP_RT;
#endif
    constexpr int NL = MK_N_LAUNCHES;
    for (int li = 0; li < NL; ++li) {
        a.ph_lo = (N_PHASES * li) / NL; a.ph_hi = (N_PHASES * (li + 1)) / NL; a.li = li;
        hipLaunchKernelGGL(skel_fwd, dim3(grid), dim3(NWAVES * 64), LDS_BYTES, stream, a);
    }
}
```

```cpp
#include <hip/hip_runtime.h>
#include <cstdio>
#include <cstdint>

constexpr int DM = 2048, NB = 4, SEQ = 2048, NTOK = NB * SEQ;
constexpr int HD = 128, NQH = 12, NKVH = 4, AW = NQH * HD, KVW = NKVH * HD, FW = 512, INW = 3072;
constexpr int MEML = 256, NMH = 4, MHD = 512;
constexpr int NE = 16, EFF = 1024, CAP = 256;
constexpr float EPS = 1e-6f;

#define LAS __attribute__((address_space(3)))
#define GAS __attribute__((address_space(1)))
typedef unsigned short bf16_t;
typedef short bf16x8 __attribute__((ext_vector_type(8)));
typedef float f32x4 __attribute__((ext_vector_type(4)));
typedef float f32x2 __attribute__((ext_vector_type(2)));
typedef unsigned u32x4 __attribute__((ext_vector_type(4)));
typedef unsigned u32x2 __attribute__((ext_vector_type(2)));
typedef __bf16 bf16x2_t __attribute__((ext_vector_type(2)));
__device__ __forceinline__ unsigned cvtpk(float lo, float hi) { f32x2 v = {lo, hi}; bf16x2_t b = __builtin_convertvector(v, bf16x2_t); return __builtin_bit_cast(unsigned, b); }
__device__ __forceinline__ float bf2f(unsigned short h) { return __uint_as_float(((unsigned)h) << 16); }
template <class T> __device__ __forceinline__ T* uptr(T* p) { const unsigned long long v = (unsigned long long)p; const unsigned lo = __builtin_amdgcn_readfirstlane((unsigned)v), hi = __builtin_amdgcn_readfirstlane((unsigned)(v >> 32)); return (T*)(((unsigned long long)hi << 32) | lo); }
__device__ __forceinline__ int lane_id() { int l = (int)__builtin_amdgcn_mbcnt_hi(~0u, __builtin_amdgcn_mbcnt_lo(~0u, 0u)); asm volatile("" : "+v"(l)); return l; }
typedef __attribute__((address_space(4))) const unsigned char* karg_t;
__device__ __forceinline__ karg_t kargs() { karg_t p = (karg_t)__builtin_amdgcn_kernarg_segment_ptr(); asm volatile("" : "+s"(p)); return p; }
#define KIN(ka, i) (*(const float* const __attribute__((address_space(4)))*)((ka) + 8 * (i)))
#define KOUT(ka) (*(float* const __attribute__((address_space(4)))*)((ka) + 176))
#define KWS(ka) (*(unsigned char* const __attribute__((address_space(4)))*)((ka) + 184))
#ifndef EPI_WT
#define EPI_WT 0
#endif
__device__ __forceinline__ void st16(void* p, u32x4 v) {
#if EPI_WT
    asm volatile("global_store_dwordx4 %0, %1, off sc1\n\ts_nop 1" :: "v"(p), "v"(v) : "memory");
#else
    *(u32x4*)p = v;
#endif
}
#define LDS_WAIT() asm volatile("s_waitcnt lgkmcnt(0)" ::: "memory")
#define VM_WAIT() asm volatile("s_waitcnt vmcnt(0)" ::: "memory")
#define WG_BAR() do { asm volatile("s_waitcnt lgkmcnt(0)" ::: "memory"); __builtin_amdgcn_s_barrier(); asm volatile("" ::: "memory"); } while (0)

namespace pg8 {
constexpr int BM = 256, BK = 64, HALF = 128, HTB = HALF * BK * 2, STAGE_BYTES = 8 * HTB, NXCD = 8, WGM = 8;
__host__ __device__ __forceinline__ int lds_byte(int r, int c) { const int st = (r >> 4) * 2 + (c >> 5), rr = r & 15, cc = c & 31, ob = rr * 64 + cc * 2; return st * 1024 + (ob ^ (((ob >> 9) & 1) << 5)); }
__host__ __device__ __forceinline__ void stage_rc(int b, int& R, int& C) { const int st = b / 1024, sb = b % 1024, swz = sb ^ (((sb >> 9) & 1) << 5); R = (st >> 1) * 16 + swz / 64; C = (st & 1) * 32 + (swz % 64) / 2; }
__host__ __device__ __forceinline__ int perm32(int rho) { const int n = rho >> 4, i = rho & 15; return 8 * (i >> 2) + 4 * n + (i & 3); }

struct Unit { int pm, pn; const char* a; const char* b; };
struct EpiCtx { int wr, wc, wid; LAS unsigned char* xl; };

template <class Map> struct Sched {
    int nM, nN, nwg, G, c; Map map;
    __device__ __forceinline__ void init(int nM_, int nN_, int G_, int c_, const Map& m) { nM = nM_; nN = nN_; nwg = nM * nN; G = G_; c = c_; map = m; }
    __device__ __forceinline__ bool next(int i, Unit& u) const {
        const long L = (long)i * G + c; if (L >= nwg) return false;
        int wgid = (int)L; { const int q = nwg / NXCD, r = nwg % NXCD, xcd = wgid % NXCD, off = wgid / NXCD; wgid = (xcd < r ? xcd * (q + 1) : r * (q + 1) + (xcd - r) * q) + off; }
        const int nig = WGM * nN, gid = wgid / nig, fm = gid * WGM, gsz = (nM - fm) < WGM ? (nM - fm) : WGM;
        u.pm = fm + ((wgid % nig) % gsz); u.pn = (wgid % nig) / gsz; map(u); return true;
    }
};

template <class Epi, class SchedT, bool SP2, bool GATHER = false>
__device__ __forceinline__ void gemm_phase(const int wave_, LAS unsigned char* lds, LAS unsigned char* xl, const int K, const int lda, const int ldb, const SchedT& S, const Epi& E, const int* gidx = nullptr) {
    constexpr bool ALIGN_EPI = true; static_assert(SP2 || !GATHER, "GATHER needs the SP2 loop");
    const int lane = lane_id(), wid = wave_, tid = wid * 64 + lane, wr = wid >> 2, wc = wid & 3, fr = lane & 15, fq = lane >> 4;
    const int nt = K / BK;
    unsigned voffA[2], voffB[2];
#pragma unroll
    for (int i = 0; i < 2; ++i) { int R, C; stage_rc(tid * 16 + i * 8192, R, C); const int Rb = Epi::PERM ? ((R & ~31) + perm32(R & 31)) : R;
        voffA[i] = (unsigned)(R * lda + C * 2); voffB[i] = (unsigned)(Rb * ldb + C * 2); }
    const size_t kstep = (size_t)(BK * 2);
    const size_t hstepA = (size_t)HALF * lda, hstepB = (size_t)HALF * ldb;
    const unsigned ldsw = (unsigned)wid * 1024u;
    const int aoff = lds_byte(wr * 64 + fr, fq * 8), boff = lds_byte(wc * 32 + fr, fq * 8);
    const unsigned xoffA = (unsigned)tid * 16u;
    int gset = 0;
#define PG8_GSETUP(set, pm_) do { if constexpr (GATHER) { int R0_, C0_, R1_, C1_; stage_rc(tid * 16, R0_, C0_); stage_rc(tid * 16 + 8192, R1_, C1_); \
        const GAS int* gi_ = (const GAS int*)gidx + (pm_) * 256; const int r00_ = gi_[R0_], r01_ = gi_[R1_], r10_ = gi_[128 + R0_], r11_ = gi_[128 + R1_];     \
        *(LAS u32x4*)(xl + (set) * 8192 + xoffA) = (u32x4){(unsigned)(r00_ * lda + C0_ * 2), (unsigned)(r01_ * lda + C1_ * 2), (unsigned)(r10_ * lda + C0_ * 2), (unsigned)(r11_ * lda + C1_ * 2)}; } } while (0)
#define PG8_SA(b, h) (((b) * 2 + (h)) * HTB)
#define PG8_SB(b, h) ((4 + (b) * 2 + (h)) * HTB)
#define PG8_STAGE(bufoff, gbase, voff) do { _Pragma("unroll") for (int _i = 0; _i < 2; ++_i) \
        __builtin_amdgcn_global_load_lds((const unsigned*)((const char*)(gbase) + (voff)[_i]), (LAS unsigned*)(lds + (bufoff) + ldsw + _i * 8192), 16, 0, 0); } while (0)
#define PG8_GOFF(h_, set_) u32x2 go_ = {0u, 0u}; if constexpr (GATHER) go_ = *(const LAS u32x2*)(xl + (set_) * 8192 + xoffA + (h_) * 8)
#define PG8_STAGE_A(bufoff, gbase, h_, set_) do { if constexpr (GATHER) { \
        __builtin_amdgcn_global_load_lds((const unsigned*)((const char*)(gbase) + go_.x), (LAS unsigned*)(lds + (bufoff) + ldsw), 16, 0, 0); \
        __builtin_amdgcn_global_load_lds((const unsigned*)((const char*)(gbase) + go_.y), (LAS unsigned*)(lds + (bufoff) + ldsw + 8192), 16, 0, 0); } \
      else { PG8_STAGE(bufoff, (const char*)(gbase) + (h_) * hstepA, voffA); } } while (0)
#define PG8_LDA(dst, b, h) do { _Pragma("unroll") for (int m = 0; m < 4; ++m) _Pragma("unroll") for (int k = 0; k < 2; ++k) dst[m][k] = *(const LAS bf16x8*)(lds + PG8_SA(b, h) + aoff + m * 2048 + k * 1024); } while (0)
#define PG8_LDB(dst, b, h) do { _Pragma("unroll") for (int n = 0; n < 2; ++n) _Pragma("unroll") for (int k = 0; k < 2; ++k) dst[n][k] = *(const LAS bf16x8*)(lds + PG8_SB(b, h) + boff + n * 2048 + k * 1024); } while (0)
#define PG8_MMA(ai, bj, At, Bt) do { __builtin_amdgcn_s_setprio(1); _Pragma("unroll") for (int m = 0; m < 4; ++m) _Pragma("unroll") for (int n = 0; n < 2; ++n) _Pragma("unroll") for (int k = 0; k < 2; ++k) \
        acc[ai][bj][m][n] = __builtin_amdgcn_mfma_f32_16x16x32_bf16(Bt[n][k], At[m][k], acc[ai][bj][m][n], 0, 0, 0); __builtin_amdgcn_s_setprio(0); } while (0)
#define PG8_WAIT_V(n) asm volatile("s_waitcnt vmcnt(" #n ")" ::: "memory")
#define PG8_WAIT_L(n) asm volatile("s_waitcnt lgkmcnt(" #n ")" ::: "memory")
#define PG8_BAR __builtin_amdgcn_s_barrier()
#define PG8_SCHED __builtin_amdgcn_sched_barrier(0)
    Unit cur, nxt; int ui = 0;
    if (!S.next(0, cur)) return;
    EpiCtx ctx; ctx.wr = wr; ctx.wc = wc; ctx.wid = wid; ctx.xl = xl;
    f32x4 acc[2][2][4][2];
#pragma unroll
    for (int a = 0; a < 2; ++a)
#pragma unroll
        for (int b = 0; b < 2; ++b)
#pragma unroll
            for (int m = 0; m < 4; ++m)
#pragma unroll
                for (int n = 0; n < 2; ++n) acc[a][b][m][n] = (f32x4){0.f, 0.f, 0.f, 0.f};
    bf16x8 At[4][2], B0[2][2], B1[2][2];
    const char* cA = cur.a; const char* cB = cur.b;
    PG8_GSETUP(0, cur.pm);
    if constexpr (SP2) {
        PG8_STAGE(PG8_SB(0, 0), cB, voffB); PG8_STAGE(PG8_SB(0, 1), cB + hstepB, voffB); { PG8_GOFF(0, 0); PG8_STAGE_A(PG8_SA(0, 0), cA, 0, 0); } { PG8_GOFF(1, 0); PG8_STAGE_A(PG8_SA(0, 1), cA, 1, 0); }
        if (wr == 1) PG8_BAR;
        PG8_WAIT_V(2); PG8_BAR;
        PG8_STAGE(PG8_SB(1, 0), cB + kstep, voffB); { PG8_GOFF(0, 0); PG8_STAGE_A(PG8_SA(1, 0), cA + kstep, 0, 0); } PG8_STAGE(PG8_SB(1, 1), cB + hstepB + kstep, voffB);
        PG8_WAIT_V(6); PG8_BAR;
    } else {
        PG8_STAGE(PG8_SB(0, 0), cB, voffB); PG8_STAGE(PG8_SA(0, 0), cA, voffA); PG8_STAGE(PG8_SB(0, 1), cB + hstepB, voffB); PG8_STAGE(PG8_SA(0, 1), cA + hstepA, voffA);
        if (wr == 1) PG8_BAR;
        PG8_WAIT_V(4); PG8_BAR;
        PG8_STAGE(PG8_SB(1, 0), cB + kstep, voffB); PG8_STAGE(PG8_SA(1, 0), cA + kstep, voffA); PG8_STAGE(PG8_SB(1, 1), cB + hstepB + kstep, voffB);
        PG8_WAIT_V(6); PG8_BAR;
    }
    for (;;) {
        const bool has_next = S.next(ui + 1, nxt);
        const char* nA = has_next ? nxt.a : cA; const char* nB = has_next ? nxt.b : cB;
        if (has_next) PG8_GSETUP(gset ^ 1, nxt.pm);
        for (int t = 0; t < nt; t += 2) {
            const bool last = (t == nt - 2);
            const char* a1 = cA + (size_t)(t + 1) * kstep;
            const char* a2 = last ? nA : cA + (size_t)(t + 2) * kstep; const char* b2 = last ? nB : cB + (size_t)(t + 2) * kstep;
            const char* a3 = a2 + kstep; const char* b3 = b2 + kstep;
            const int set2 = (last && has_next) ? (gset ^ 1) : gset;
            if constexpr (SP2) {
            { PG8_GOFF(1, gset); PG8_LDB(B0, 0, 0); PG8_LDB(B1, 0, 1); PG8_SCHED; PG8_LDA(At, 0, 0); PG8_STAGE_A(PG8_SA(1, 1), a1, 1, gset); }
            PG8_WAIT_V(8); PG8_WAIT_L(0); PG8_BAR; PG8_MMA(0, 0, At, B0); PG8_MMA(0, 1, At, B1); PG8_BAR; PG8_SCHED;
            { PG8_GOFF(0, set2); PG8_LDA(At, 0, 1); PG8_STAGE(PG8_SB(0, 0), b2, voffB); PG8_STAGE(PG8_SB(0, 1), b2 + hstepB, voffB); PG8_STAGE_A(PG8_SA(0, 0), a2, 0, set2); }
            PG8_WAIT_V(8); PG8_WAIT_L(0); PG8_BAR; PG8_MMA(1, 0, At, B0); PG8_MMA(1, 1, At, B1); PG8_BAR; PG8_SCHED;
            { PG8_GOFF(1, set2); PG8_LDB(B0, 1, 0); PG8_LDB(B1, 1, 1); PG8_SCHED; PG8_LDA(At, 1, 0); PG8_STAGE_A(PG8_SA(0, 1), a2, 1, set2); }
            PG8_WAIT_V(8); PG8_WAIT_L(0); PG8_BAR; PG8_MMA(0, 0, At, B0); PG8_MMA(0, 1, At, B1); PG8_BAR; PG8_SCHED;
            { PG8_GOFF(0, set2); PG8_LDA(At, 1, 1); PG8_STAGE(PG8_SB(1, 0), b3, voffB); PG8_STAGE(PG8_SB(1, 1), b3 + hstepB, voffB); PG8_STAGE_A(PG8_SA(1, 0), a3, 0, set2); }
            PG8_WAIT_V(8); PG8_WAIT_L(0); PG8_BAR; PG8_MMA(1, 0, At, B0); PG8_MMA(1, 1, At, B1); PG8_BAR; PG8_SCHED;
            } else {
            PG8_LDB(B0, 0, 0); PG8_SCHED; PG8_LDA(At, 0, 0); PG8_STAGE(PG8_SA(1, 1), a1 + hstepA, voffA);
            PG8_WAIT_L(8); PG8_BAR; PG8_WAIT_L(0); PG8_MMA(0, 0, At, B0); PG8_BAR; PG8_SCHED;
            PG8_LDB(B1, 0, 1); PG8_STAGE(PG8_SB(0, 0), b2, voffB);
            PG8_BAR; PG8_WAIT_L(0); PG8_MMA(0, 1, At, B1); PG8_BAR;
            PG8_LDA(At, 0, 1); PG8_STAGE(PG8_SA(0, 0), a2, voffA);
            PG8_BAR; PG8_WAIT_L(0); PG8_MMA(1, 0, At, B0); PG8_BAR; PG8_SCHED;
            PG8_STAGE(PG8_SB(0, 1), b2 + hstepB, voffB);
            PG8_WAIT_V(6); PG8_BAR; PG8_MMA(1, 1, At, B1); PG8_BAR;
            PG8_LDB(B0, 1, 0); PG8_SCHED; PG8_LDA(At, 1, 0); PG8_STAGE(PG8_SA(0, 1), a2 + hstepA, voffA);
            PG8_WAIT_L(8); PG8_BAR; PG8_WAIT_L(0); PG8_MMA(0, 0, At, B0); PG8_BAR; PG8_SCHED;
            PG8_LDB(B1, 1, 1); PG8_STAGE(PG8_SB(1, 0), b3, voffB);
            PG8_BAR; PG8_WAIT_L(0); PG8_MMA(0, 1, At, B1); PG8_BAR;
            PG8_LDA(At, 1, 1); PG8_STAGE(PG8_SA(1, 0), a3, voffA);
            PG8_BAR; PG8_WAIT_L(0); PG8_MMA(1, 0, At, B0); PG8_BAR; PG8_SCHED;
            PG8_STAGE(PG8_SB(1, 1), b3 + hstepB, voffB);
            PG8_WAIT_V(6); PG8_BAR; PG8_MMA(1, 1, At, B1); PG8_BAR;
            }
        }
        if constexpr (ALIGN_EPI) { if (wr == 0) PG8_BAR; }
        E(acc, cur, ctx);
        if (!has_next) break;
#pragma unroll
        for (int a = 0; a < 2; ++a)
#pragma unroll
            for (int b = 0; b < 2; ++b)
#pragma unroll
                for (int m = 0; m < 4; ++m)
#pragma unroll
                    for (int n = 0; n < 2; ++n) acc[a][b][m][n] = (f32x4){0.f, 0.f, 0.f, 0.f};
        cur = nxt; cA = nA; cB = nB; ++ui; gset ^= 1;
        if constexpr (ALIGN_EPI) { if (wr == 1) PG8_BAR; }
    }
    PG8_WAIT_V(0);
    if constexpr (!ALIGN_EPI) { if (wr == 0) PG8_BAR; }
    PG8_BAR;
#undef PG8_SA
#undef PG8_SB
#undef PG8_STAGE
#undef PG8_STAGE_A
#undef PG8_GOFF
#undef PG8_GSETUP
#undef PG8_LDA
#undef PG8_LDB
#undef PG8_MMA
#undef PG8_WAIT_V
#undef PG8_WAIT_L
#undef PG8_BAR
#undef PG8_SCHED
}
}

constexpr size_t MiB = 1u << 20;
constexpr size_t WS_CTL = 0, CTL_ZERO_BYTES = 1 * MiB;
constexpr size_t WS_WIN_T = 1 * MiB, WS_WF_T = 11 * MiB, WS_WOUT_T = 15 * MiB, WS_WCQ_T = 23 * MiB, WS_WCK_T = 39 * MiB, WS_WCV_T = 55 * MiB, WS_WCO_T = 71 * MiB;
constexpr size_t WS_WP_T = 87 * MiB, WS_DFT = 89 * MiB, WS_ROPE = 105 * MiB, WS_WGU_T = 106 * MiB, WS_WD_T = 234 * MiB;
constexpr size_t WS_HN = 298 * MiB, WS_XB = 330 * MiB, WS_QB = 362 * MiB, WS_KB = 386 * MiB, WS_VB = 394 * MiB, WS_FPQ = 402 * MiB, WS_MIXB = 418 * MiB, WS_QCB = 450 * MiB;
constexpr size_t WS_KCB = 482 * MiB, WS_VTB = 490 * MiB, WS_MEMNB = 498 * MiB, WS_PB = 506 * MiB, WS_XSB = 522 * MiB, WS_ACTB = 586 * MiB, WS_YB = 618 * MiB;
constexpr size_t WS_SSP = 682 * MiB, WS_AFF = 683 * MiB, WS_RANK = 684 * MiB, WS_GATE = 685 * MiB, WS_XALT = 686 * MiB, WS_WGU_T2 = 750 * MiB, WS_WD_T2 = 878 * MiB, WS_FAST_END = 942 * MiB;
constexpr int CW_TMO = 0, CW_CODE = 1, CW_BAR = 4096;
constexpr int RING_OFF = 0, RING_BYTES = 131072, XL_OFF = 131072, XL_BYTES = 16384, LDSCTL_OFF = XL_OFF + XL_BYTES, MISC_OFF = LDSCTL_OFF + 320, LDS_BYTES = 149504;
static_assert(MISC_OFF + 128 <= LDS_BYTES, "LDS map");
constexpr int NWAVES = 8;

typedef GAS unsigned gu32;
#define RLX_AGENT __ATOMIC_RELAXED, __HIP_MEMORY_SCOPE_AGENT

#define XB_TMO      128
#define XB_XCNT(j)  (256  + 64 * (j))
#define XB_XSUB(j)  (1280 + 64 * (j))
#define XB_XGEN(j)  (2304 + 64 * (j))
#define XB_TOP      3328
#define XB_TOPGEN   3392
#define XCD_BAR_WORDS 3456
#define XB_SPIN_CAP (1u << 18)
__device__ __forceinline__ unsigned xb_ld(unsigned* p)              { return __hip_atomic_load(p, __ATOMIC_RELAXED, __HIP_MEMORY_SCOPE_AGENT); }
__device__ __forceinline__ unsigned xb_add(unsigned* p, unsigned v) { return __hip_atomic_fetch_add(p, v, __ATOMIC_RELAXED, __HIP_MEMORY_SCOPE_AGENT); }
__device__ __forceinline__ unsigned xb_xcc_id() { return (unsigned)__builtin_amdgcn_s_getreg((3 << 11) | 20) & 0xFu; }
#define XB_SPIN(cond, bar) do { unsigned _sp = 0; while (cond) { __builtin_amdgcn_s_sleep(1); \
    if ((++_sp & 255u) == 0u) { if (xb_ld(&(bar)[XB_TMO])) break; if (_sp > XB_SPIN_CAP) { atomicAdd(&(bar)[XB_TMO], 1u); break; } } } } while (0)
struct XcdBarrier { unsigned* bar; unsigned x; volatile LAS unsigned* st; int wave; };
__device__ __forceinline__ XcdBarrier xcd_barrier_post(unsigned* bar, volatile LAS unsigned* st, int wave) {
    XcdBarrier b; b.bar = bar; b.x = xb_xcc_id(); b.st = st; b.wave = wave;
    if (wave == 0 && lane_id() == 0) (void)xb_add(&bar[XB_XCNT(b.x)], 1u);
    return b;
}
__device__ __forceinline__ void xcd_barrier_complete(unsigned* bar, unsigned x, unsigned& nloc, unsigned& nx) {
    const unsigned G = gridDim.x * gridDim.y * gridDim.z;
    unsigned sum, cnt, mine, sp = 0u;
    for (;;) {
        sum = 0u; cnt = 0u; mine = 0u;
#pragma unroll
        for (unsigned j = 0; j < 16; ++j) { const unsigned c = xb_ld(&bar[XB_XCNT(j)]); sum += c; cnt += (c > 0u) ? 1u : 0u; mine = (j == x) ? c : mine; }
        if (sum == G) break;
        __builtin_amdgcn_s_sleep(1);
        if ((++sp & 255u) == 0u) { if (xb_ld(&bar[XB_TMO])) break; if (sp > XB_SPIN_CAP) { atomicAdd(&bar[XB_TMO], 1u); break; } }
    }
    nloc = mine > 0u ? mine : 1u; nx = cnt > 0u ? cnt : 1u;
}
__device__ __forceinline__ void xcd_barrier(const XcdBarrier& b) {
    asm volatile("s_waitcnt vmcnt(0)" ::: "memory");
    __syncthreads();
    if (b.wave == 0 && lane_id() == 0) {
        unsigned* bar = b.bar;
        __builtin_amdgcn_s_waitcnt(0);
        unsigned nloc = b.st[0], nx = b.st[1];
        if (nloc == 0u) { xcd_barrier_complete(bar, b.x, nloc, nx); b.st[0] = nloc; b.st[1] = nx; }
        const unsigned old = xb_add(&bar[XB_XSUB(b.x)], 1u);
        const unsigned gen = old / nloc;
        if (old + 1u == (gen + 1u) * nloc) {
            __builtin_amdgcn_fence(__ATOMIC_RELEASE, "agent");
            asm volatile("s_waitcnt vmcnt(0)" ::: "memory");
            const unsigned og = xb_add(&bar[XB_TOP], 1u);
            const unsigned tg = og / nx;
            if (og + 1u == (tg + 1u) * nx) xb_add(&bar[XB_TOPGEN], 1u);
            else XB_SPIN(xb_ld(&bar[XB_TOPGEN]) == tg, bar);
            __builtin_amdgcn_fence(__ATOMIC_ACQUIRE, "agent");
            xb_add(&bar[XB_XGEN(b.x)], 1u);
            asm volatile("s_waitcnt vmcnt(0)" ::: "memory");
        } else {
            XB_SPIN(xb_ld(&bar[XB_XGEN(b.x)]) == gen, bar);
            __builtin_amdgcn_fence(__ATOMIC_ACQUIRE, "agent");
            asm volatile("s_waitcnt vmcnt(0)" ::: "memory");
        }
    }
    __syncthreads();
}

struct Args { const float* in[22]; float* out; unsigned char* ws; int ph_lo, ph_hi, li, pad; };
struct Frame {
    LAS unsigned char* lds; volatile LAS unsigned* MISC; gu32* ctl;
    int wave, vcu, G;
    unsigned char* ws;
};
__device__ __forceinline__ float wave_sum(float v) {
#pragma unroll
    for (int o = 1; o < 64; o <<= 1) v += __shfl_xor(v, o);
    return v;
}
struct TrDesc { const float* W; const float* gain; bf16_t* WT; int ldw, ldt, k0, n0; long drow0; };
__device__ __forceinline__ void tr_load(const TrDesc& d, f32x4 (&v)[16], int lane) {
    const int lr = lane >> 4, lc = (lane & 15) * 4;
#pragma unroll
    for (int i = 0; i < 16; ++i) v[i] = __builtin_nontemporal_load((const GAS f32x4*)(d.W + (size_t)(d.k0 + 4 * i + lr) * d.ldw + d.n0 + lc));
}
#ifndef TRV
#define TRV 0
#endif
template <int V> __device__ __forceinline__ void tr_finish(const TrDesc& d, const f32x4 (&v)[16], LAS float* scr, int lane) {
    const int lr = lane >> 4, lc = (lane & 15) * 4;
    if (V == 1) { f32x4 s = v[0]; for (int i = 1; i < 16; ++i) s = s + v[i]; if (s.x == 1.2345e30f) *(GAS f32x4*)(d.WT) = s; return; }
#pragma unroll
    for (int i = 0; i < 16; ++i) { const int kk = 4 * i + lr; f32x4 x = v[i]; if (d.gain) x = x * d.gain[d.k0 + kk];
        LAS float* s = scr + kk * 65 + lc; s[0] = x.x; s[1] = x.y; s[2] = x.z; s[3] = x.w; }
    LDS_WAIT(); asm volatile("" ::: "memory");
    const int c = lane & 7;
#pragma unroll
    for (int j = 0; j < 8; ++j) { const int n = (lane >> 3) + 8 * j; const LAS float* s = scr + (8 * c) * 65 + n;
        u32x4 o; o.x = cvtpk(s[0 * 65], s[1 * 65]); o.y = cvtpk(s[2 * 65], s[3 * 65]); o.z = cvtpk(s[4 * 65], s[5 * 65]); o.w = cvtpk(s[6 * 65], s[7 * 65]);
        if (V == 0 || o.x == 0x12345678u) *(GAS u32x4*)(d.WT + (size_t)(d.drow0 + n) * d.ldt + d.k0 + 8 * c) = o; }
    LDS_WAIT(); asm volatile("" ::: "memory");
}
#ifndef TR_PIPE
#define TR_PIPE 0
#endif
constexpr int TR_DENSE = 32 * 20 + 9 * 32 * 16 + 32 * 4, TR_EXPERT = NE * 768;
__device__ __forceinline__ TrDesc tr_desc(karg_t ka, unsigned char* ws, int it, int mode) {
    TrDesc d; d.gain = nullptr;
    constexpr int I_IN = 32 * 20, I_SQ = 32 * 16;
    if (mode == 0) {
        int r = it;
        if (r < I_IN) { d.W = KIN(ka, 3); d.ldw = INW; d.WT = (bf16_t*)(ws + WS_WIN_T); d.ldt = DM; d.k0 = (r / 20) * 64; d.n0 = (r % 20) * 128; d.drow0 = d.n0; return d; } r -= I_IN;
        if (r < I_SQ) { d.W = KIN(ka, 7); d.ldw = DM; d.WT = (bf16_t*)(ws + WS_WOUT_T); d.ldt = DM; d.k0 = (r / 16) * 64; d.n0 = (r % 16) * 128; d.drow0 = d.n0; return d; } r -= I_SQ;
        if (r < 8 * I_SQ) { const int j = r / I_SQ, q = r % I_SQ, wsel = j >> 1, layer = j & 1;
            d.W = KIN(ka, 12 + wsel) + (size_t)layer * DM * DM; d.ldw = DM; if (wsel == 0) d.gain = KIN(ka, 10) + layer * DM;
            d.WT = (bf16_t*)(ws + (wsel == 0 ? WS_WCQ_T : wsel == 1 ? WS_WCK_T : wsel == 2 ? WS_WCV_T : WS_WCO_T) + (size_t)layer * DM * DM * 2); d.ldt = DM;
            d.k0 = (q / 16) * 64; d.n0 = (q % 16) * 128; d.drow0 = d.n0; return d; } r -= 8 * I_SQ;
        d.W = KIN(ka, 8); d.ldw = 512; d.WT = (bf16_t*)(ws + WS_WP_T); d.ldt = DM; d.k0 = (r / 4) * 64; d.n0 = (r % 4) * 128; d.drow0 = d.n0; return d;
    }
    const int layer = mode - 1;
    const int e = it / 768, r = it % 768; const size_t eo = (size_t)(layer * NE + e);
    if (r < 512) { const int up = r >> 8, q = r & 255, kb = q >> 3, nb = q & 7, n0 = nb * 128;
        d.W = (up ? KIN(ka, 19) : KIN(ka, 18)) + eo * DM * EFF; d.ldw = EFF; d.gain = KIN(ka, 16) + layer * DM;   d.WT = (bf16_t*)(ws + (layer ? WS_WGU_T2 : WS_WGU_T)) + (size_t)e * 2048 * 2048; d.ldt = 2048;
        d.k0 = kb * 64; d.n0 = n0; d.drow0 = (long)(n0 >> 7) * 256 + up * 128;
    } else { const int q = r - 512, kb = q >> 4, nb = q & 15;
        d.W = KIN(ka, 20) + eo * EFF * DM; d.ldw = DM; d.WT = (bf16_t*)(ws + (layer ? WS_WD_T2 : WS_WD_T)) + (size_t)e * 2048 * 1024; d.ldt = 1024; d.k0 = kb * 64; d.n0 = nb * 128; d.drow0 = nb * 128; }
    return d;
}
template <int V = 0> __device__ __forceinline__ void tr_span(const Frame& F, karg_t ka, unsigned char* ws, int mode, int first, int stride, int cnt) {
    const int lane = lane_id(); LAS float* scr = (LAS float*)(F.lds + RING_OFF + F.wave * 16640);
    if (cnt <= 0) return;
    f32x4 va[16], vb[16];
    TrDesc da = tr_desc(ka, ws, first, mode), db = da; db.n0 += 64; db.drow0 += 64;
    tr_load(da, va, lane); tr_load(db, vb, lane);
    for (int j = 0; j < cnt; ++j) {
        const bool more = j + 1 < cnt; TrDesc na = da, nb = db;
        if (more) { na = tr_desc(ka, ws, first + stride * (j + 1), mode); nb = na; nb.n0 += 64; nb.drow0 += 64; }
        tr_finish<V>(da, va, scr, lane); if (more) tr_load(na, va, lane);
        tr_finish<V>(db, vb, scr, lane); if (more) tr_load(nb, vb, lane);
        da = na; db = nb;
    }
}
__device__ __forceinline__ void rms_row_to_bf16(const float* xrow, const float* __restrict__ gain, bf16_t* orow, int lane) {
    const GAS f32x4* xr = (const GAS f32x4*)xrow + lane; const f32x4* gr = (const f32x4*)gain + lane;
    f32x4 v[8]; float s = 0.f;
#pragma unroll
    for (int j = 0; j < 8; ++j) { v[j] = xr[64 * j]; s += (v[j].x * v[j].x + v[j].y * v[j].y) + (v[j].z * v[j].z + v[j].w * v[j].w); }
    const float r = rsqrtf(wave_sum(s) * (1.f / DM) + EPS);
    GAS u32x2* o8 = (GAS u32x2*)orow + lane;
#pragma unroll
    for (int j = 0; j < 8; ++j) { const f32x4 g = gr[64 * j]; u32x2 w; w.x = cvtpk(v[j].x * r * g.x, v[j].y * r * g.y); w.y = cvtpk(v[j].z * r * g.z, v[j].w * r * g.w); o8[64 * j] = w; }
}

__device__ __forceinline__ void p0_prologue(Frame& F, karg_t ka, unsigned char* ws) {
    const float* x = KIN(ka, 0); const float* mem = KIN(ka, 1); const float* mix_norm = KIN(ka, 2); const float* w_in = KIN(ka, 3);
    const float* w_four = KIN(ka, 6); const float* w_out = KIN(ka, 7); const float* pool_w = KIN(ka, 8); const float* cross_norm = KIN(ka, 10); const float* mem_norm = KIN(ka, 11);
    const int gw = F.vcu * NWAVES + F.wave, NGW = F.G * NWAVES;
    const int p_lane = lane_id(), p_tid = F.wave * 64 + p_lane;
    { LAS float* tab = (LAS float*)(F.lds + RING_OFF);
      for (int m = p_tid; m < 2048; m += 512) tab[m] = cosf(6.283185307179586f * (float)m * (1.0f / 2048.0f));
      __syncthreads();
      bf16_t* DFT = (bf16_t*)(ws + WS_DFT);
      for (int row = F.vcu * 8; row < 2048; row += F.G * 8)
          for (int rr = 0; rr < 8; ++rr) { const int k1 = row + rr; if (k1 >= 2048) break;
              { const int c0 = p_tid * 8; const int which = c0 >> 11, s0 = c0 & 2047; unsigned w[4];
#pragma unroll
                for (int j = 0; j < 4; ++j) { const int ma = (k1 * (s0 + 2 * j)) & 2047, mb = (k1 * (s0 + 2 * j + 1)) & 2047;
                    w[j] = cvtpk(tab[(ma - which * 512) & 2047], tab[(mb - which * 512) & 2047]); }
                *(GAS u32x4*)(DFT + (size_t)k1 * 4096 + c0) = (u32x4){w[0], w[1], w[2], w[3]}; } }
      __syncthreads(); }
    { float* RC = (float*)(ws + WS_ROPE); float* RS = RC + SEQ * 64;
      for (int i = F.vcu * 512 + p_tid; i < SEQ * 64; i += F.G * 512) { const int t = i >> 6, p = i & 63; const int pos = (p < 32) ? (t >> 6) : (t & 63); const int j = p & 31;
          const float inv = 1.0f / powf(10000.0f, (float)(2 * j) / 64.0f); const float ang = (float)pos * inv; RC[i] = cosf(ang); RS[i] = sinf(ang); } }
    { u32x4* RB = (u32x4*)(ws + WS_AFF + 512 * 1024);
      for (int i = F.vcu * 512 + p_tid; i < 2 * 64 * 64; i += F.G * 512) { const int layer = i >> 12, ks = (i >> 6) & 63, ln = i & 63, e = ln & 15, k0 = 32 * ks + 8 * (ln >> 4);
          const float* Wr = KIN(ka, 17) + (size_t)layer * DM * NE; const float* gn = KIN(ka, 16) + layer * DM; float w[8], lo[8];
#pragma unroll
          for (int j = 0; j < 8; ++j) { w[j] = gn[k0 + j] * Wr[(size_t)(k0 + j) * NE + e]; }
          u32x4 hi4 = {cvtpk(w[0], w[1]), cvtpk(w[2], w[3]), cvtpk(w[4], w[5]), cvtpk(w[6], w[7])};
          const unsigned hh[4] = {hi4.x, hi4.y, hi4.z, hi4.w};
#pragma unroll
          for (int j = 0; j < 4; ++j) { lo[2 * j] = w[2 * j] - __uint_as_float(hh[j] << 16); lo[2 * j + 1] = w[2 * j + 1] - __uint_as_float(hh[j] & 0xffff0000u); }
          RB[(size_t)(layer * 2 + 0) * 4096 + ks * 64 + ln] = hi4;
          RB[(size_t)(layer * 2 + 1) * 4096 + ks * 64 + ln] = (u32x4){cvtpk(lo[0], lo[1]), cvtpk(lo[2], lo[3]), cvtpk(lo[4], lo[5]), cvtpk(lo[6], lo[7])}; } }
    { LAS float* Mw = (LAS float*)(F.lds + RING_OFF); LAS float* t128 = Mw + 128 * 32;
      bf16_t* WF = (bf16_t*)(ws + WS_WF_T);
      for (int it = F.vcu; it < 256; it += F.G) {
          const int which = it >> 7, g = (it >> 5) & 3, d0 = ((it >> 3) & 3) * 32, k0 = (it & 7) * 256;
          if (p_tid < 128) t128[p_tid] = cosf(6.283185307179586f * (float)p_tid * (1.0f / 128.0f));
          __syncthreads();
          { const int c = p_tid >> 2, dd = (p_tid & 3) * 8; float o[8] = {0.f, 0.f, 0.f, 0.f, 0.f, 0.f, 0.f, 0.f};
#pragma unroll 16
            for (int k2 = 0; k2 < 128; ++k2) { const int m = (c * k2) & 127; const float tv = which ? -t128[(m - 32) & 127] : t128[m];
                const float* wr_ = w_four + ((size_t)g * 128 + k2) * 128 + d0 + dd; const f32x4 w0 = *(const f32x4*)wr_, w1 = *(const f32x4*)(wr_ + 4);
                o[0] += tv * w0.x; o[1] += tv * w0.y; o[2] += tv * w0.z; o[3] += tv * w0.w; o[4] += tv * w1.x; o[5] += tv * w1.y; o[6] += tv * w1.z; o[7] += tv * w1.w; }
#pragma unroll
            for (int j = 0; j < 8; ++j) Mw[c * 32 + dd + j] = o[j] * (1.0f / 512.0f); }
          __syncthreads();
          { const int kp = p_tid & 127, dq = p_tid >> 7, k = k0 + 2 * kp; float o0[8] = {0.f, 0.f, 0.f, 0.f, 0.f, 0.f, 0.f, 0.f}, o1[8] = {0.f, 0.f, 0.f, 0.f, 0.f, 0.f, 0.f, 0.f};
            const float* r0 = w_in + (size_t)k * INW + 2560 + g * 128; const float* r1 = r0 + INW;
#pragma unroll 8
            for (int c4 = 0; c4 < 32; ++c4) { const f32x4 a = *(const f32x4*)(r0 + 4 * c4), b = *(const f32x4*)(r1 + 4 * c4); const float av[4] = {a.x, a.y, a.z, a.w}, bv[4] = {b.x, b.y, b.z, b.w};
#pragma unroll
                for (int cc = 0; cc < 4; ++cc) { const LAS float* mr = Mw + (4 * c4 + cc) * 32 + dq * 8;
#pragma unroll
                    for (int j = 0; j < 8; ++j) { o0[j] += av[cc] * mr[j]; o1[j] += bv[cc] * mr[j]; } } }
#pragma unroll
            for (int j = 0; j < 8; ++j) *(GAS unsigned*)(WF + (size_t)(which * 512 + g * 128 + d0 + dq * 8 + j) * DM + k) = cvtpk(o0[j], o1[j]); }
          __syncthreads(); } }
    { const int n = (TR_DENSE - gw + NGW - 1) / NGW; tr_span(F, ka, ws, 0, gw, NGW, n > 0 ? n : 0); }
    __syncthreads();
    for (int m = gw; m < NTOK; m += NGW) rms_row_to_bf16(x + (size_t)m * DM, mix_norm, (bf16_t*)(ws + WS_HN) + (size_t)m * DM, p_lane);
    for (int m = gw; m < 2 * NB * MEML; m += NGW) { const int l = m / (NB * MEML), r = m % (NB * MEML);
        rms_row_to_bf16(mem + (size_t)r * DM, mem_norm + l * DM, (bf16_t*)(ws + WS_MEMNB) + (size_t)m * DM, p_lane); }
}

struct MapLin { const char* A; const char* B; size_t as, bs; __device__ __forceinline__ void operator()(pg8::Unit& u) const { u.a = A + (size_t)u.pm * as; u.b = B + (size_t)u.pn * bs; } };

struct EpiQKV {
    static constexpr bool PERM = true;
    bf16_t* Q; bf16_t* K; bf16_t* V; const float* qg; const float* kg; const float* RC; const float* RS;
    __device__ __forceinline__ void operator()(f32x4 (&acc)[2][2][4][2], const pg8::Unit& u, const pg8::EpiCtx& c) const { const int e_lane = lane_id(), e_fr = e_lane & 15, e_fq = e_lane >> 4;
        const int pn = u.pn, hc = c.wc * 32 + e_fq * 8, rl0 = c.wr * 64 + e_fr;
        if (pn >= 8) {
            bf16_t* base = V + (size_t)(u.pm * 256 + rl0) * KVW + (pn - 8) * 256 + hc;
#pragma unroll
            for (int ai = 0; ai < 2; ++ai)
#pragma unroll
                for (int m = 0; m < 4; ++m) { bf16_t* rowp = base + (size_t)(ai * 128 + m * 16) * KVW;
#pragma unroll
                    for (int bj = 0; bj < 2; ++bj) { const f32x4 v0 = acc[ai][bj][m][0], v1 = acc[ai][bj][m][1];
                        st16((rowp + bj * 128), (u32x4){cvtpk(v0.x, v0.y), cvtpk(v0.z, v0.w), cvtpk(v1.x, v1.y), cvtpk(v1.z, v1.w)}); } }
            return;
        }
        LAS float* part = (LAS float*)c.xl;
#pragma unroll
        for (int ai = 0; ai < 2; ++ai)
#pragma unroll
            for (int m = 0; m < 4; ++m)
#pragma unroll
                for (int bj = 0; bj < 2; ++bj) { const f32x4 v0 = acc[ai][bj][m][0], v1 = acc[ai][bj][m][1];
                    float s = (v0.x * v0.x + v0.y * v0.y) + (v0.z * v0.z + v0.w * v0.w) + (v1.x * v1.x + v1.y * v1.y) + (v1.z * v1.z + v1.w * v1.w);
                    s += __shfl_xor(s, 16); s += __shfl_xor(s, 32);
                    if (e_fq == 0) part[((ai * 128 + rl0 + m * 16) * 2 + bj) * 4 + c.wc] = s; }
        WG_BAR();
        const float* gain = pn < 6 ? qg : kg;
        const f32x4 g0 = *(const f32x4*)(gain + hc), g1 = *(const f32x4*)(gain + hc + 4);
        bf16_t* O = pn < 6 ? Q : K; const int ld = pn < 6 ? AW : KVW; const int colbase = (pn < 6 ? pn : pn - 6) * 256 + hc;
#pragma unroll
        for (int ai = 0; ai < 2; ++ai)
#pragma unroll
            for (int m = 0; m < 4; ++m) { const int rl = ai * 128 + rl0 + m * 16, row = u.pm * 256 + rl, sp = row & (SEQ - 1);
                const f32x4 cs = *(const f32x4*)(RC + sp * 64 + (hc >> 1)), sn = *(const f32x4*)(RS + sp * 64 + (hc >> 1));
#pragma unroll
                for (int bj = 0; bj < 2; ++bj) { const f32x4 p4 = *(const LAS f32x4*)(part + (rl * 2 + bj) * 4);
                    const float r = rsqrtf(((p4.x + p4.y) + (p4.z + p4.w)) * (1.0f / 128.0f) + EPS);
                    const f32x4 v0 = acc[ai][bj][m][0] * r * g0, v1 = acc[ai][bj][m][1] * r * g1;
                    u32x4 w; w.x = cvtpk(v0.x * cs.x - v0.y * sn.x, v0.x * sn.x + v0.y * cs.x); w.y = cvtpk(v0.z * cs.y - v0.w * sn.y, v0.z * sn.y + v0.w * cs.y);
                    w.z = cvtpk(v1.x * cs.z - v1.y * sn.z, v1.x * sn.z + v1.y * cs.z); w.w = cvtpk(v1.z * cs.w - v1.w * sn.w, v1.z * sn.w + v1.w * cs.w);
                    st16((O + (size_t)row * ld + colbase + bj * 128), w); } }
    }
};


template <class AddrF> struct EpiStore {
    static constexpr bool PERM = true; AddrF f;
    __device__ __forceinline__ void operator()(f32x4 (&acc)[2][2][4][2], const pg8::Unit& u, const pg8::EpiCtx& c) const { const int e_lane = lane_id(), e_fr = e_lane & 15, e_fq = e_lane >> 4;
        const int hc = c.wc * 32 + e_fq * 8, rl0 = c.wr * 64 + e_fr;
#pragma unroll
        for (int ai = 0; ai < 2; ++ai)
#pragma unroll
            for (int m = 0; m < 4; ++m)
#pragma unroll
                for (int bj = 0; bj < 2; ++bj) { const f32x4 v0 = acc[ai][bj][m][0], v1 = acc[ai][bj][m][1];
                    st16(f(u, ai * 128 + rl0 + m * 16, bj * 128 + hc), (u32x4){cvtpk(v0.x, v0.y), cvtpk(v0.z, v0.w), cvtpk(v1.x, v1.y), cvtpk(v1.z, v1.w)}); }
    }
};
struct AddrF1 { bf16_t* FPQ; __device__ __forceinline__ bf16_t* operator()(const pg8::Unit& u, int rl, int tc) const {
    const int r = u.pm * 256 + rl, which = r >> 9, n = r & 511, cidx = u.pn * 256 + tc, b = cidx >> 11, s = cidx & 2047; return FPQ + (((size_t)(b * 512 + n) * 2 + which) * 2048 + s); } };
struct AddrF2 { bf16_t* MIX; __device__ __forceinline__ bf16_t* operator()(const pg8::Unit& u, int rl, int tc) const {
    const int row = (u.pn >> 1) * 2048 + u.pm * 256 + rl, col = AW + (u.pn & 1) * 256 + tc; return MIX + (size_t)row * DM + col; } };

template <bool BF32> struct EpiResB {
    static constexpr bool PERM = true;
    const void* base; bf16_t* xo; float* ssp; const float* cscale;
    __device__ __forceinline__ void operator()(f32x4 (&acc)[2][2][4][2], const pg8::Unit& u, const pg8::EpiCtx& c) const { const int e_lane = lane_id(), e_fr = e_lane & 15, e_fq = e_lane >> 4;
        const int hc = c.wc * 32 + e_fq * 8, rl0 = c.wr * 64 + e_fr;
        LAS float* part = (LAS float*)c.xl;
#pragma unroll
        for (int ai = 0; ai < 2; ++ai) {
            f32x4 bf0[4][2], bf1[4][2]; u32x4 bb[4][2];
#pragma unroll
            for (int m = 0; m < 4; ++m)
#pragma unroll
                for (int bj = 0; bj < 2; ++bj) { const size_t off = (size_t)(u.pm * 256 + ai * 128 + rl0 + m * 16) * DM + u.pn * 256 + bj * 128 + hc;
                    if (BF32) { bf0[m][bj] = *(const f32x4*)((const float*)base + off); bf1[m][bj] = *(const f32x4*)((const float*)base + off + 4); }
                    else bb[m][bj] = *(const u32x4*)((const bf16_t*)base + off); }
#pragma unroll
            for (int m = 0; m < 4; ++m) { const int rl = ai * 128 + rl0 + m * 16; float s = 0.f;
#pragma unroll
                for (int bj = 0; bj < 2; ++bj) { const int col = u.pn * 256 + bj * 128 + hc; const size_t off = (size_t)(u.pm * 256 + rl) * DM + col;
                    f32x4 v0 = acc[ai][bj][m][0], v1 = acc[ai][bj][m][1];
                    if (cscale) { v0 = v0 * *(const f32x4*)(cscale + col); v1 = v1 * *(const f32x4*)(cscale + col + 4); }
                    if (BF32) { v0 = v0 + bf0[m][bj]; v1 = v1 + bf1[m][bj]; }
                    else { const u32x4 b = bb[m][bj];
                        v0.x += __uint_as_float(b.x << 16); v0.y += __uint_as_float(b.x & 0xffff0000u); v0.z += __uint_as_float(b.y << 16); v0.w += __uint_as_float(b.y & 0xffff0000u);
                        v1.x += __uint_as_float(b.z << 16); v1.y += __uint_as_float(b.z & 0xffff0000u); v1.z += __uint_as_float(b.w << 16); v1.w += __uint_as_float(b.w & 0xffff0000u); }
                    st16((xo + off), (u32x4){cvtpk(v0.x, v0.y), cvtpk(v0.z, v0.w), cvtpk(v1.x, v1.y), cvtpk(v1.z, v1.w)});
                    if (ssp) s += ((v0.x * v0.x + v0.y * v0.y) + (v0.z * v0.z + v0.w * v0.w)) + ((v1.x * v1.x + v1.y * v1.y) + (v1.z * v1.z + v1.w * v1.w)); }
                if (ssp) { s += __shfl_xor(s, 16); s += __shfl_xor(s, 32); if (e_fq == 0) part[rl * 4 + c.wc] = s; } }
            asm volatile("" ::: "memory"); }
        if (ssp) { WG_BAR();
            if (e_lane < 32) { const int row = c.wid * 32 + e_lane; const f32x4 p4 = *(const LAS f32x4*)(part + row * 4);
                ssp[(size_t)(u.pm * 256 + row) * 8 + u.pn] = (p4.x + p4.y) + (p4.z + p4.w); }
            WG_BAR(); }
    }
};

namespace attn {
using s16x4 = __attribute__((ext_vector_type(4))) short;
using f32x16 = __attribute__((ext_vector_type(16))) float;
constexpr int D = 128, NW = 8, QBLK = 32, KVBLK = 64;
constexpr float SCALE = 0.088388347648318440f;
constexpr float THR = 0.f;
#ifndef ATT_SDEPTH
#define ATT_SDEPTH 1
#endif
constexpr int LDQ = AW, LDK = KVW, LDO = DM;
constexpr size_t SHM_V = KVBLK * D * 2, SHM_K = KVBLK * D * 2, SHM_ATTN = 2 * SHM_V + 2 * SHM_K + NW * 64 * 4;
#define KSWZ(row, colB) ((row) * 256 + ((colB) ^ (((row) & 7) << 4)))
#define SBAR() __builtin_amdgcn_sched_barrier(0)
__device__ __forceinline__ int crow(int r, int hi) { return (r & 3) + 8 * (r >> 2) + 4 * hi; }
__device__ __forceinline__ unsigned cvtpk_a(float lo, float hi) { unsigned r; asm volatile("v_cvt_pk_bf16_f32 %0, %1, %2" : "=v"(r) : "v"(lo), "v"(hi)); return r; }
__device__ __forceinline__ void partialSM(f32x16& p0, f32x16& p1, float& m_reg, float& mn, float& alpha) {
  constexpr float C = SCALE * 1.4426950408889634f;
  float pmax = p0[0]; for (int r = 1; r < 16; ++r) pmax = fmaxf(pmax, p0[r]); for (int r = 0; r < 16; ++r) pmax = fmaxf(pmax, p1[r]);
  { auto rr = __builtin_amdgcn_permlane32_swap(__float_as_uint(pmax), __float_as_uint(pmax), false, false);
    pmax = fmaxf(__uint_as_float(rr[0]), __uint_as_float(rr[1])); }
  if (__builtin_expect(__all(pmax - m_reg <= THR / SCALE), 1)) { mn = m_reg; alpha = 1.f; }
  else { mn = fmaxf(m_reg, pmax); alpha = __builtin_amdgcn_exp2f((m_reg - mn) * C); m_reg = mn; }
  float mnC = -mn * C;
  for (int r = 0; r < 16; ++r) p0[r] = fmaf(p0[r], C, mnC); for (int r = 0; r < 16; ++r) p1[r] = fmaf(p1[r], C, mnC);
  for (int r = 0; r < 16; ++r) p0[r] = __builtin_amdgcn_exp2f(p0[r]);
}
__device__ __forceinline__ void finishSM(f32x16& p0, f32x16& p1, float alpha, float& l_reg, bf16x8& pa0, bf16x8& pa1, bf16x8& pa2, bf16x8& pa3) {
  for (int r = 0; r < 16; ++r) p1[r] = __builtin_amdgcn_exp2f(p1[r]);
  float ps = 0; for (int r = 0; r < 16; ++r) ps += p0[r]; for (int r = 0; r < 16; ++r) ps += p1[r];
  { auto rr = __builtin_amdgcn_permlane32_swap(__float_as_uint(ps), __float_as_uint(ps), false, false);
    ps = __uint_as_float(rr[0]) + __uint_as_float(rr[1]); }
  l_reg = l_reg * alpha + ps;
#define PK4(P, BASE, OUT) do { unsigned a0 = cvtpk_a(P[BASE + 0], P[BASE + 1]), a1 = cvtpk_a(P[BASE + 2], P[BASE + 3]);   \
    unsigned b0 = cvtpk_a(P[BASE + 4], P[BASE + 5]), b1 = cvtpk_a(P[BASE + 6], P[BASE + 7]);                              \
    auto r0 = __builtin_amdgcn_permlane32_swap(a0, b0, false, false); auto r1 = __builtin_amdgcn_permlane32_swap(a1, b1, false, false); \
    u32x4 w = {r0[0], r1[0], r0[1], r1[1]}; OUT = *reinterpret_cast<bf16x8*>(&w); } while (0)
  PK4(p0, 0, pa0); PK4(p0, 8, pa1); PK4(p1, 0, pa2); PK4(p1, 8, pa3);
#undef PK4
}
__device__ __forceinline__ void qkt(f32x16& p0, f32x16& p1, const bf16_t* Ks, const bf16x8* qr, int r32, int hi) {
  p0 = f32x16{}; p1 = f32x16{};
  for (int d0 = 0; d0 < 8; ++d0) { int cb = (d0 * 16 + hi * 8) * 2;
    bf16x8 b0 = *reinterpret_cast<const bf16x8*>((const char*)Ks + KSWZ(r32, cb));
    bf16x8 b1 = *reinterpret_cast<const bf16x8*>((const char*)Ks + KSWZ(32 + r32, cb));
    p0 = __builtin_amdgcn_mfma_f32_32x32x16_bf16(b0, qr[d0], p0, 0, 0, 0);
    p1 = __builtin_amdgcn_mfma_f32_32x32x16_bf16(b1, qr[d0], p1, 0, 0, 0); }
}
__device__ __forceinline__ int v_st(int k, int c) { const int kk = (k & ~0xC) | ((k & 4) << 1) | ((k & 8) >> 1); return ((kk >> 3) * 4 + (c >> 5)) * 512 + ((kk & 7) * 32 + (c & 31)) * 2; }
__device__ __forceinline__ int v_rd_base(int lane) { return ((lane & 3) << 3) | (((lane >> 2) & 3) << 6) | (((lane >> 4) & 1) << 5) | (((lane >> 5) & 1) << 8); }
constexpr int v_rd_off(int d0, int ks, int half) { return d0 * 512 + ks * 4096 + half * 2048; }
template <int OFF> __device__ __forceinline__ s16x4 tr_read(int vb) {
  s16x4 r; asm volatile("ds_read_b64_tr_b16 %0, %1 offset:%2" : "=&v"(r) : "v"(vb), "i"(OFF) : "memory"); return r;
}
template <int D0> __device__ __forceinline__ void pv_one(f32x16& od, int vb, bf16x8 pa0, bf16x8 pa1, bf16x8 pa2, bf16x8 pa3) {
  const s16x4 l0 = tr_read<v_rd_off(D0, 0, 0)>(vb), h0 = tr_read<v_rd_off(D0, 0, 1)>(vb), l1 = tr_read<v_rd_off(D0, 1, 0)>(vb), h1 = tr_read<v_rd_off(D0, 1, 1)>(vb);
  const s16x4 l2 = tr_read<v_rd_off(D0, 2, 0)>(vb), h2 = tr_read<v_rd_off(D0, 2, 1)>(vb), l3 = tr_read<v_rd_off(D0, 3, 0)>(vb), h3 = tr_read<v_rd_off(D0, 3, 1)>(vb);
  asm volatile("s_waitcnt lgkmcnt(0)" ::: "memory"); SBAR();
#define PK(L, H) (bf16x8){L[0], L[1], L[2], L[3], H[0], H[1], H[2], H[3]}
  od = __builtin_amdgcn_mfma_f32_32x32x16_bf16(pa0, PK(l0, h0), od, 0, 0, 0);
  od = __builtin_amdgcn_mfma_f32_32x32x16_bf16(pa1, PK(l1, h1), od, 0, 0, 0);
  od = __builtin_amdgcn_mfma_f32_32x32x16_bf16(pa2, PK(l2, h2), od, 0, 0, 0);
  od = __builtin_amdgcn_mfma_f32_32x32x16_bf16(pa3, PK(l3, h3), od, 0, 0, 0);
#undef PK
}
__device__ __forceinline__ void pv_d0(f32x16* o, int vb, bf16x8 pa0, bf16x8 pa1, bf16x8 pa2, bf16x8 pa3) {
  pv_one<0>(o[0], vb, pa0, pa1, pa2, pa3); pv_one<1>(o[1], vb, pa0, pa1, pa2, pa3); pv_one<2>(o[2], vb, pa0, pa1, pa2, pa3); pv_one<3>(o[3], vb, pa0, pa1, pa2, pa3);
}
__device__ __forceinline__ void attn_dense_body(const bf16_t* __restrict__ Qb, const bf16_t* __restrict__ Kh, const bf16_t* __restrict__ Vh,
                                                bf16_t* __restrict__ Ob, int seq, char* lds, const int wave_) {
  constexpr int SDEPTH = ATT_SDEPTH;
  const int lane = lane_id(), wid = wave_, tid = wid * 64 + lane, r32 = lane & 31, hi = lane >> 5;
  bf16_t* V_lds = (bf16_t*)lds; bf16_t* K_lds = (bf16_t*)(lds + 2 * SHM_V);
  float* ws = (float*)(lds + 2 * SHM_V + 2 * SHM_K) + wid * 64; float* li_l = ws; float* al_l = ws + 32;
  float m_reg = -1e30f, l_reg = 0; f32x16 o[4] = {}; bf16x8 qr[8];
  const bf16_t* Qw = Qb + (long)(wid * QBLK + r32) * LDQ + hi * 8;
#pragma unroll
  for (int d0 = 0; d0 < 8; ++d0) qr[d0] = *reinterpret_cast<const bf16x8*>(Qw + d0 * 16);
  const int sr = tid >> 4, sc = (tid & 15) * 8, vst0 = v_st(sr, sc), vst1 = v_st(32 + sr, sc);
  const int vb0 = (int)(uintptr_t)V_lds + v_rd_base(lane);
  struct { bf16x8 vs0, vs1, ks0, ks1; } sr_[SDEPTH];
#define SLOAD(i, k0) do { sr_[i].vs0 = *reinterpret_cast<const bf16x8*>(&Vh[(long)((k0) + sr) * LDK + sc]); sr_[i].vs1 = *reinterpret_cast<const bf16x8*>(&Vh[(long)((k0) + 32 + sr) * LDK + sc]); \
    sr_[i].ks0 = *reinterpret_cast<const bf16x8*>(&Kh[(long)((k0) + sr) * LDK + sc]); sr_[i].ks1 = *reinterpret_cast<const bf16x8*>(&Kh[(long)((k0) + 32 + sr) * LDK + sc]); } while (0)
#define SWRITE(b, i) do { *(bf16x8*)((char*)V_lds + (b) * SHM_V + vst0) = sr_[i].vs0;          \
    *(bf16x8*)((char*)V_lds + (b) * SHM_V + vst1) = sr_[i].vs1; int kc = sc * 2;               \
    *(bf16x8*)((char*)K_lds + (b) * SHM_K + KSWZ(sr, kc)) = sr_[i].ks0;                       \
    *(bf16x8*)((char*)K_lds + (b) * SHM_K + KSWZ(32 + sr, kc)) = sr_[i].ks1; } while (0)
#define SWAIT() do { if constexpr (SDEPTH == 2) asm volatile("s_waitcnt vmcnt(4)" ::: "memory"); else asm volatile("s_waitcnt vmcnt(0)" ::: "memory"); } while (0)
#define RESC(a) do { if (__any((a) < 1.f)) { if (hi == 0) al_l[r32] = (a); asm volatile("s_waitcnt lgkmcnt(0)" ::: "memory"); \
    for (int d = 0; d < 4; ++d) for (int r = 0; r < 16; ++r) o[d][r] *= al_l[crow(r, hi)]; } } while (0)
  f32x16 pA0, pA1, pB0, pB1; float mnA, mnB, alA, alB; bf16x8 pa0, pa1, pa2, pa3; const int NT = seq / KVBLK;
  constexpr int SE = 0, SO = SDEPTH - 1;
  SLOAD(SE, 0); asm volatile("s_waitcnt vmcnt(0)" ::: "memory"); SWRITE(0, SE); __syncthreads();
  qkt(pA0, pA1, K_lds, qr, r32, hi); partialSM(pA0, pA1, m_reg, mnA, alA);
  SLOAD(SO, KVBLK); if constexpr (SDEPTH == 2) { if (2 < NT) SLOAD(SE, 2 * KVBLK); }
  SWAIT(); SWRITE(1, SO); __syncthreads();
  for (int j = 1; j + 1 < NT; j += 2) {
    SBAR(); qkt(pB0, pB1, (bf16_t*)((char*)K_lds + SHM_K), qr, r32, hi);
    finishSM(pA0, pA1, alA, l_reg, pa0, pa1, pa2, pa3); SBAR();
    SLOAD(SO, (j + SDEPTH) * KVBLK); SBAR();
    pv_d0(o, vb0, pa0, pa1, pa2, pa3); partialSM(pB0, pB1, m_reg, mnB, alB);
    __syncthreads(); SWAIT(); SWRITE(0, SE);
    RESC(alB); __syncthreads();
    SBAR(); qkt(pA0, pA1, K_lds, qr, r32, hi);
    finishSM(pB0, pB1, alB, l_reg, pa0, pa1, pa2, pa3); SBAR();
    if (SDEPTH == 1 || j + 3 < NT) SLOAD(SE, (j + 1 + SDEPTH) * KVBLK); SBAR();
    pv_d0(o, vb0 + (int)SHM_V, pa0, pa1, pa2, pa3); partialSM(pA0, pA1, m_reg, mnA, alA);
    __syncthreads(); SWAIT(); SWRITE(1, SO);
    RESC(alA); __syncthreads();
  }
  SBAR(); qkt(pB0, pB1, (bf16_t*)((char*)K_lds + SHM_K), qr, r32, hi);
  finishSM(pA0, pA1, alA, l_reg, pa0, pa1, pa2, pa3); SBAR();
  pv_d0(o, vb0, pa0, pa1, pa2, pa3); partialSM(pB0, pB1, m_reg, mnB, alB);
  __syncthreads(); RESC(alB);
  finishSM(pB0, pB1, alB, l_reg, pa0, pa1, pa2, pa3); SBAR();
  pv_d0(o, vb0 + (int)SHM_V, pa0, pa1, pa2, pa3);
  if (hi == 0) li_l[r32] = l_reg; asm volatile("s_waitcnt lgkmcnt(0)" ::: "memory");
  float rli[16];
#pragma unroll
  for (int r = 0; r < 16; ++r) rli[r] = __builtin_amdgcn_rcpf(li_l[crow(r, hi)]);
  bf16_t* Ow = Ob + (long)(wid * QBLK) * LDO;
#pragma unroll
  for (int r = 0; r < 16; ++r) { int orow = crow(r, hi);
    for (int d0 = 0; d0 < 4; ++d0) Ow[(long)orow * LDO + d0 * 32 + r32] = (bf16_t)(cvtpk(o[d0][r] * rli[r], 0.f) & 0xffffu); }
#undef SLOAD
#undef SWRITE
#undef SWAIT
#undef RESC
  __syncthreads();
}
#undef KSWZ
#undef SBAR
}

struct AddrLin { bf16_t* O; int ld; __device__ __forceinline__ bf16_t* operator()(const pg8::Unit& u, int rl, int tc) const { return O + (size_t)(u.pm * 256 + rl) * ld + u.pn * 256 + tc; } };
struct EpiRowScale {
    static constexpr bool PERM = true; bf16_t* O; int ld; const float* ssp; float cscale;
    __device__ __forceinline__ void operator()(f32x4 (&acc)[2][2][4][2], const pg8::Unit& u, const pg8::EpiCtx& c) const { const int e_lane = lane_id(), e_fr = e_lane & 15, e_fq = e_lane >> 4;
        const int hc = c.wc * 32 + e_fq * 8, rl0 = c.wr * 64 + e_fr;
#pragma unroll
        for (int ai = 0; ai < 2; ++ai)
#pragma unroll
            for (int m = 0; m < 4; ++m) { const int row = u.pm * 256 + ai * 128 + rl0 + m * 16; const f32x4 p0 = *(const f32x4*)(ssp + (size_t)row * 8), p1 = *(const f32x4*)(ssp + (size_t)row * 8 + 4);
                const float r = rsqrtf((((p0.x + p0.y) + (p0.z + p0.w)) + ((p1.x + p1.y) + (p1.z + p1.w))) * (1.0f / DM) + EPS) * cscale;
#pragma unroll
                for (int bj = 0; bj < 2; ++bj) { const f32x4 v0 = acc[ai][bj][m][0] * r, v1 = acc[ai][bj][m][1] * r;
                    st16((O + (size_t)row * ld + u.pn * 256 + bj * 128 + hc), (u32x4){cvtpk(v0.x, v0.y), cvtpk(v0.z, v0.w), cvtpk(v1.x, v1.y), cvtpk(v1.z, v1.w)}); } }
    }
};
struct EpiSoftmax {
    static constexpr bool PERM = true; bf16_t* P; int ld;
    __device__ __forceinline__ void operator()(f32x4 (&acc)[2][2][4][2], const pg8::Unit& u, const pg8::EpiCtx& c) const { const int e_lane = lane_id(), e_fr = e_lane & 15, e_fq = e_lane >> 4;
        const int hc = c.wc * 32 + e_fq * 8, rl0 = c.wr * 64 + e_fr;
        LAS float* pmx = (LAS float*)c.xl; LAS float* psm = pmx + 1024;
#pragma unroll
        for (int ai = 0; ai < 2; ++ai)
#pragma unroll
            for (int m = 0; m < 4; ++m) { float mx = -3.0e38f;
#pragma unroll
                for (int bj = 0; bj < 2; ++bj)
#pragma unroll
                    for (int n = 0; n < 2; ++n) { const f32x4 v = acc[ai][bj][m][n]; mx = fmaxf(fmaxf(mx, fmaxf(v.x, v.y)), fmaxf(v.z, v.w)); }
                mx = fmaxf(mx, __shfl_xor(mx, 16)); mx = fmaxf(mx, __shfl_xor(mx, 32));
                if (e_fq == 0) pmx[(ai * 128 + rl0 + m * 16) * 4 + c.wc] = mx; }
        WG_BAR();
#pragma unroll
        for (int ai = 0; ai < 2; ++ai)
#pragma unroll
            for (int m = 0; m < 4; ++m) { const int rl = ai * 128 + rl0 + m * 16; const f32x4 p4 = *(const LAS f32x4*)(pmx + rl * 4);
                const float mx = fmaxf(fmaxf(p4.x, p4.y), fmaxf(p4.z, p4.w)) * 1.4426950408889634f; float s = 0.f;
#pragma unroll
                for (int bj = 0; bj < 2; ++bj)
#pragma unroll
                    for (int n = 0; n < 2; ++n) { f32x4 v = acc[ai][bj][m][n];
                        v.x = __builtin_amdgcn_exp2f(fmaf(v.x, 1.4426950408889634f, -mx)); v.y = __builtin_amdgcn_exp2f(fmaf(v.y, 1.4426950408889634f, -mx));
                        v.z = __builtin_amdgcn_exp2f(fmaf(v.z, 1.4426950408889634f, -mx)); v.w = __builtin_amdgcn_exp2f(fmaf(v.w, 1.4426950408889634f, -mx));
                        s += (v.x + v.y) + (v.z + v.w); acc[ai][bj][m][n] = v; }
                s += __shfl_xor(s, 16); s += __shfl_xor(s, 32);
                if (e_fq == 0) psm[rl * 4 + c.wc] = s; }
        WG_BAR();
#pragma unroll
        for (int ai = 0; ai < 2; ++ai)
#pragma unroll
            for (int m = 0; m < 4; ++m) { const int rl = ai * 128 + rl0 + m * 16; const f32x4 p4 = *(const LAS f32x4*)(psm + rl * 4);
                const float inv = 1.0f / ((p4.x + p4.y) + (p4.z + p4.w));
#pragma unroll
                for (int bj = 0; bj < 2; ++bj) { const f32x4 v0 = acc[ai][bj][m][0] * inv, v1 = acc[ai][bj][m][1] * inv;
                    st16((P + (size_t)(u.pm * 256 + rl) * ld + u.pn * 256 + bj * 128 + hc), (u32x4){cvtpk(v0.x, v0.y), cvtpk(v0.z, v0.w), cvtpk(v1.x, v1.y), cvtpk(v1.z, v1.w)}); } }
        WG_BAR();
    }
};
struct MapXS { const char* Q; const char* K; __device__ __forceinline__ void operator()(pg8::Unit& u) const {
    u.a = Q + ((size_t)u.pm * 256 * DM + (size_t)u.pn * MHD) * 2; u.b = K + ((size_t)(u.pm >> 3) * MEML * DM + (size_t)u.pn * MHD) * 2; } };
struct SchedPair { pg8::Unit ua, ub; __device__ __forceinline__ bool next(int i, pg8::Unit& o) const { if (i >= 2) return false; o.pm = i ? ub.pm : ua.pm; o.pn = i ? ub.pn : ua.pn; o.a = i ? ub.a : ua.a; o.b = i ? ub.b : ua.b; asm volatile("" : "+s"(o.a), "+s"(o.b));     return true; } };
struct MapXPV { const char* P; const char* VT; __device__ __forceinline__ void operator()(pg8::Unit& u) const {
    u.a = P + ((size_t)u.pm * 256 * 1024 + (size_t)(u.pn >> 1) * MEML) * 2; u.b = VT + ((size_t)u.pn * 256 * 1024 + (size_t)(u.pm >> 3) * MEML) * 2; } };

struct MapMoE { const char* A; const char* W; size_t as, es, ws_; __device__ __forceinline__ void operator()(pg8::Unit& u) const {
    u.a = A + (size_t)u.pm * as; u.b = W + (size_t)(u.pm >> 2) * es + (size_t)u.pn * ws_; } };
struct EpiSwiGLU {
    static constexpr bool PERM = true; bf16_t* ACT; const float* rs;
    __device__ __forceinline__ void operator()(f32x4 (&acc)[2][2][4][2], const pg8::Unit& u, const pg8::EpiCtx& c) const { const int e_lane = lane_id(), e_fr = e_lane & 15, e_fq = e_lane >> 4;
        const int hc = c.wc * 32 + e_fq * 8, rl0 = c.wr * 64 + e_fr;
#pragma unroll
        for (int ai = 0; ai < 2; ++ai)
#pragma unroll
            for (int m = 0; m < 4; ++m) { f32x4 o[2]; const float rf = rs[u.pm * 256 + ai * 128 + rl0 + m * 16];
#pragma unroll
                for (int n = 0; n < 2; ++n) { const f32x4 g = acc[ai][0][m][n] * rf, up = acc[ai][1][m][n] * rf; f32x4 r;
                    r.x = g.x * __builtin_amdgcn_rcpf(1.0f + __builtin_amdgcn_exp2f(-1.4426950408889634f * g.x)) * up.x; r.y = g.y * __builtin_amdgcn_rcpf(1.0f + __builtin_amdgcn_exp2f(-1.4426950408889634f * g.y)) * up.y;
                    r.z = g.z * __builtin_amdgcn_rcpf(1.0f + __builtin_amdgcn_exp2f(-1.4426950408889634f * g.z)) * up.z; r.w = g.w * __builtin_amdgcn_rcpf(1.0f + __builtin_amdgcn_exp2f(-1.4426950408889634f * g.w)) * up.w; o[n] = r; }
                st16((ACT + (size_t)(u.pm * 256 + ai * 128 + rl0 + m * 16) * EFF + u.pn * 128 + hc), (u32x4){cvtpk(o[0].x, o[0].y), cvtpk(o[0].z, o[0].w), cvtpk(o[1].x, o[1].y), cvtpk(o[1].z, o[1].w)}); }
    }
};
struct EpiRowGate {
    static constexpr bool PERM = true; bf16_t* Y; const float* gate;
    __device__ __forceinline__ void operator()(f32x4 (&acc)[2][2][4][2], const pg8::Unit& u, const pg8::EpiCtx& c) const { const int e_lane = lane_id(), e_fr = e_lane & 15, e_fq = e_lane >> 4;
        const int hc = c.wc * 32 + e_fq * 8, rl0 = c.wr * 64 + e_fr;
#pragma unroll
        for (int ai = 0; ai < 2; ++ai)
#pragma unroll
            for (int m = 0; m < 4; ++m) { const int row = u.pm * 256 + ai * 128 + rl0 + m * 16; const float gt = gate[row];
#pragma unroll
                for (int bj = 0; bj < 2; ++bj) { const f32x4 v0 = acc[ai][bj][m][0] * gt, v1 = acc[ai][bj][m][1] * gt;
                    st16((Y + (size_t)row * DM + u.pn * 256 + bj * 128 + hc), (u32x4){cvtpk(v0.x, v0.y), cvtpk(v0.z, v0.w), cvtpk(v1.x, v1.y), cvtpk(v1.z, v1.w)}); } }
    }
};
__device__ __forceinline__ float rms_row_to_bf16_r(const float* xrow, const float* __restrict__ gain, bf16_t* orow, int lane) {
    const GAS f32x4* xr = (const GAS f32x4*)xrow + lane; const f32x4* gr = (const f32x4*)gain + lane;
    f32x4 v[8]; float s = 0.f;
#pragma unroll
    for (int j = 0; j < 8; ++j) { v[j] = xr[64 * j]; s += (v[j].x * v[j].x + v[j].y * v[j].y) + (v[j].z * v[j].z + v[j].w * v[j].w); }
    const float r = rsqrtf(wave_sum(s) * (1.f / DM) + EPS);
    GAS u32x2* o8 = (GAS u32x2*)orow + lane;
#pragma unroll
    for (int j = 0; j < 8; ++j) { const f32x4 g = gr[64 * j]; u32x2 w; w.x = cvtpk(v[j].x * r * g.x, v[j].y * r * g.y); w.y = cvtpk(v[j].z * r * g.z, v[j].w * r * g.w); o8[64 * j] = w; }
    return r;
}
__device__ __forceinline__ void router_phase(const Frame& F, const bf16_t* x, const u32x4* RBl, float* rrow, float* aff, LAS unsigned char* xl) {
    const int lane = lane_id(), tid = F.wave * 64 + lane;
    LAS u32x4* Bl = (LAS u32x4*)(F.lds + RING_OFF);
    for (int i = tid; i < 2 * 4096; i += 512) Bl[i] = RBl[i];
    __syncthreads();
    LAS float* red = (LAS float*)xl;
    LAS float* ssq = (LAS float*)(xl + 8192);
    const int rg = F.wave >> 2, kq = F.wave & 3, r16 = lane & 15, kg = lane >> 4;
    for (int rb = (int)blockIdx.x * 32; rb < NTOK; rb += F.G * 32) {
        const bf16_t* xr = x + (size_t)(rb + rg * 16 + r16) * DM + kq * 512 + kg * 8;
        bf16x8 a[16];
#pragma unroll
        for (int s = 0; s < 16; ++s) a[s] = *(const GAS bf16x8*)(xr + 32 * s);
        f32x4 acc = {0.f, 0.f, 0.f, 0.f}; float sq = 0.f;
#pragma unroll
        for (int s = 0; s < 16; ++s) { const int ks = kq * 16 + s;
            const bf16x8 bh = __builtin_bit_cast(bf16x8, Bl[ks * 64 + lane]), bl = __builtin_bit_cast(bf16x8, Bl[4096 + ks * 64 + lane]);
            acc = __builtin_amdgcn_mfma_f32_16x16x32_bf16(a[s], bh, acc, 0, 0, 0);
            acc = __builtin_amdgcn_mfma_f32_16x16x32_bf16(a[s], bl, acc, 0, 0, 0);
            const u32x4 av = __builtin_bit_cast(u32x4, a[s]);
            const float f0 = __uint_as_float(av.x << 16), f1 = __uint_as_float(av.x & 0xffff0000u), f2 = __uint_as_float(av.y << 16), f3 = __uint_as_float(av.y & 0xffff0000u);
            const float f4 = __uint_as_float(av.z << 16), f5 = __uint_as_float(av.z & 0xffff0000u), f6 = __uint_as_float(av.w << 16), f7 = __uint_as_float(av.w & 0xffff0000u);
            sq += ((f0 * f0 + f1 * f1) + (f2 * f2 + f3 * f3)) + ((f4 * f4 + f5 * f5) + (f6 * f6 + f7 * f7)); }
        sq += __shfl_xor(sq, 16); sq += __shfl_xor(sq, 32);
        *(LAS f32x4*)(red + ((rg * 4 + kq) * 64 + lane) * 4) = acc;
        if (kg == 0) ssq[(rg * 4 + kq) * 16 + r16] = sq;
        __syncthreads();
        if (kq == 0) {
            f32x4 t = *(const LAS f32x4*)(red + ((rg * 4 + 0) * 64 + lane) * 4);
#pragma unroll
            for (int q = 1; q < 4; ++q) t = t + *(const LAS f32x4*)(red + ((rg * 4 + q) * 64 + lane) * 4);
            const float lg[4] = {t.x, t.y, t.z, t.w};
#pragma unroll
            for (int i = 0; i < 4; ++i) { const int rr = 4 * kg + i; const float ss = (ssq[(rg * 4 + 0) * 16 + rr] + ssq[(rg * 4 + 1) * 16 + rr]) + (ssq[(rg * 4 + 2) * 16 + rr] + ssq[(rg * 4 + 3) * 16 + rr]);
                const float r = rsqrtf(ss * (1.f / DM) + EPS); const int row = rb + rg * 16 + rr;
                const float v = lg[i] * r; float mx = v;
                mx = fmaxf(mx, __shfl_xor(mx, 8)); mx = fmaxf(mx, __shfl_xor(mx, 4)); mx = fmaxf(mx, __shfl_xor(mx, 2)); mx = fmaxf(mx, __shfl_xor(mx, 1));
                const float ex = expf(v - mx); float sm = ex;
                sm += __shfl_xor(sm, 8); sm += __shfl_xor(sm, 4); sm += __shfl_xor(sm, 2); sm += __shfl_xor(sm, 1);
                const int b = row / SEQ, tt = row % SEQ; aff[((size_t)b * NE + r16) * SEQ + tt] = ex / sm;
                if (r16 == 0) rrow[row] = r; }
        }
        __syncthreads();
    }
}
__device__ __forceinline__ void rank_phase(const Frame& F, const float* aff, int* rank, float* gate, const float* rrow, float* rs, int* gidx) {
    const int lane = lane_id(), tid = F.wave * 64 + lane;
    LAS unsigned* wc = (LAS unsigned*)(F.lds + RING_OFF);
    LAS unsigned* ck = (LAS unsigned*)(F.lds + RING_OFF + 256);
    LAS unsigned* ci = ck + SEQ + 4;
    LAS unsigned* ncp = ci + SEQ + 4;
    for (int be = (int)blockIdx.x; be < NB * NE; be += F.G) {
        const int b = be >> 4, e = be & 15;
        unsigned k[4];
#pragma unroll
        for (int j = 0; j < 4; ++j) k[j] = __float_as_uint(aff[(size_t)be * SEQ + tid + 512 * j]);
        unsigned lo = 0u, hi = 0x3F800001u;
        if (tid == 0) ncp[0] = 0u;
        for (int it = 0; it < 40; ++it) {
            const unsigned mid = lo + ((hi - lo) >> 1); if (mid == lo) break;
            const int ws_ = __popcll(__ballot(k[0] >= mid)) + __popcll(__ballot(k[1] >= mid)) + __popcll(__ballot(k[2] >= mid)) + __popcll(__ballot(k[3] >= mid));
            if (lane == 0) wc[(it & 1) * 8 + F.wave] = (unsigned)ws_;
            __syncthreads();
            const u32x4 c0 = *(const LAS u32x4*)(wc + (it & 1) * 8), c1 = *(const LAS u32x4*)(wc + (it & 1) * 8 + 4);
            const int c = (int)(((c0.x + c0.y) + (c0.z + c0.w)) + ((c1.x + c1.y) + (c1.z + c1.w)));
            if (c < CAP) hi = mid; else { lo = mid; if (c <= 448) break; }
        }
        const unsigned T = lo;
        __syncthreads();
#pragma unroll
        for (int j = 0; j < 4; ++j) { const bool pred = k[j] >= T; const unsigned long long bal = __ballot(pred);
            const int wcount = __popcll(bal), pre = __popcll(bal & ((1ull << lane) - 1ull));
            unsigned base = 0u; if (lane == 0 && wcount) base = __hip_atomic_fetch_add(ncp, (unsigned)wcount, __ATOMIC_RELAXED, __HIP_MEMORY_SCOPE_WORKGROUP);
            base = (unsigned)__builtin_amdgcn_readfirstlane((int)base);
            if (pred) { ck[base + pre] = k[j]; ci[base + pre] = (unsigned)(tid + 512 * j); } else rank[(size_t)be * SEQ + tid + 512 * j] = CAP; }
        __syncthreads();
        const int nc = (int)ncp[0];
        if (tid < 4) { ck[nc + tid] = 0u; ci[nc + tid] = 0x7fffffffu; }
        __syncthreads();
        const int nc4 = (nc + 3) >> 2;
        for (int i = tid; i < nc; i += 512) { const unsigned kk = ck[i]; const int tt = (int)ci[i]; int cnt = 0;
#pragma unroll 4
            for (int m = 0; m < nc4; ++m) { const u32x4 km = ((const LAS u32x4*)ck)[m]; const u32x4 tm = ((const LAS u32x4*)ci)[m];
                cnt += ((km.x > kk || (km.x == kk && (int)tm.x < tt)) ? 1 : 0) + ((km.y > kk || (km.y == kk && (int)tm.y < tt)) ? 1 : 0)
                     + ((km.z > kk || (km.z == kk && (int)tm.z < tt)) ? 1 : 0) + ((km.w > kk || (km.w == kk && (int)tm.w < tt)) ? 1 : 0); }
            const int r = cnt < CAP ? cnt : CAP; rank[(size_t)be * SEQ + tt] = r;
            if (r < CAP) { const int sl = (e * 4 + b) * CAP + r; gate[sl] = __uint_as_float(kk); gidx[sl] = b * SEQ + tt; rs[sl] = rrow[b * SEQ + tt]; } }
        __syncthreads();
    }
}
__device__ __forceinline__ void combine_phase(const Frame& F, const bf16_t* xin, bf16_t* xo, float* fout, const bf16_t* Y, const int* rank, const float* __restrict__ gain, bf16_t* HNo, bool final_) {
    const int lane = lane_id();
    const int gw = (int)blockIdx.x * NWAVES + F.wave, NGW = F.G * NWAVES;
    for (int row = gw; row < NTOK; row += NGW) {
        const int b = row / SEQ, t = row % SEQ;
        int rk = CAP; if (lane < NE) rk = rank[((size_t)b * NE + lane) * SEQ + t];
        const GAS u32x2* xi = (const GAS u32x2*)(xin + (size_t)row * DM) + lane; f32x4 v[8];
#pragma unroll
        for (int j = 0; j < 8; ++j) { const u32x2 p = xi[64 * j]; v[j] = (f32x4){__uint_as_float(p.x << 16), __uint_as_float(p.x & 0xffff0000u), __uint_as_float(p.y << 16), __uint_as_float(p.y & 0xffff0000u)}; }
#pragma unroll
        for (int e = 0; e < NE; ++e) { const int r = __builtin_amdgcn_readlane(rk, e);
            if (r < CAP) { const u32x2* yr = (const u32x2*)(Y + ((size_t)(e * 4 + b) * CAP + r) * DM) + lane;
#pragma unroll
                for (int j = 0; j < 8; ++j) { const u32x2 w = yr[64 * j]; v[j].x += __uint_as_float(w.x << 16); v[j].y += __uint_as_float(w.x & 0xffff0000u); v[j].z += __uint_as_float(w.y << 16); v[j].w += __uint_as_float(w.y & 0xffff0000u); } } }
        float s = 0.f;
#pragma unroll
        for (int j = 0; j < 8; ++j) s += (v[j].x * v[j].x + v[j].y * v[j].y) + (v[j].z * v[j].z + v[j].w * v[j].w);
        const float r = rsqrtf(wave_sum(s) * (1.f / DM) + EPS); const f32x4* gr = (const f32x4*)gain + lane;
        if (final_) { GAS f32x4* fo = (GAS f32x4*)(fout + (size_t)row * DM) + lane;
#pragma unroll
            for (int j = 0; j < 8; ++j) { const f32x4 g = gr[64 * j]; fo[64 * j] = (f32x4){v[j].x * r * g.x, v[j].y * r * g.y, v[j].z * r * g.z, v[j].w * r * g.w}; }
        } else { GAS u32x2* o8 = (GAS u32x2*)(HNo + (size_t)row * DM) + lane; GAS u32x2* x8 = (GAS u32x2*)(xo + (size_t)row * DM) + lane;
#pragma unroll
            for (int j = 0; j < 8; ++j) { const f32x4 g = gr[64 * j]; x8[64 * j] = (u32x2){cvtpk(v[j].x, v[j].y), cvtpk(v[j].z, v[j].w)}; o8[64 * j] = (u32x2){cvtpk(v[j].x * r * g.x, v[j].y * r * g.y), cvtpk(v[j].z * r * g.z, v[j].w * r * g.w)}; } }
    }
}
struct MapPool { const char* A; const char* W; __device__ __forceinline__ void operator()(pg8::Unit& u) const {
    u.a = A + ((size_t)u.pm * 256 * DM + (size_t)(u.pn >> 1) * 512) * 2; u.b = W + ((size_t)(u.pn & 1) * 256 * DM + (size_t)(u.pn >> 1) * 512) * 2; } };
template <int W> __device__ __forceinline__ void pool_item4(const bf16_t* H, bf16_t* P, int row0, int c8) {
    const int t0 = row0 & (SEQ - 1); const bf16_t* base = H + (size_t)(row0 - t0) * DM + c8 * 8;
    u32x4 v[W + 3];
#pragma unroll
    for (int i = 0; i < W + 3; ++i) { int j = t0 - W / 2 + i; j = j < 0 ? 0 : (j > SEQ - 1 ? SEQ - 1 : j); v[i] = *(const u32x4*)(base + (size_t)j * DM); }
    float f[W + 3][8];
#pragma unroll
    for (int i = 0; i < W + 3; ++i) { const int j = t0 - W / 2 + i; const float m = (j >= 0 && j < SEQ) ? 1.f : 0.f;
        f[i][0] = m * __uint_as_float(v[i].x << 16); f[i][1] = m * __uint_as_float(v[i].x & 0xffff0000u); f[i][2] = m * __uint_as_float(v[i].y << 16); f[i][3] = m * __uint_as_float(v[i].y & 0xffff0000u);
        f[i][4] = m * __uint_as_float(v[i].z << 16); f[i][5] = m * __uint_as_float(v[i].z & 0xffff0000u); f[i][6] = m * __uint_as_float(v[i].w << 16); f[i][7] = m * __uint_as_float(v[i].w & 0xffff0000u); }
    float s[8];
#pragma unroll
    for (int c = 0; c < 8; ++c) { s[c] = 0.f;
#pragma unroll
        for (int i = 0; i < W; ++i) s[c] += f[i][c]; }
#pragma unroll
    for (int q = 0; q < 4; ++q) { const int t = t0 + q; int lo = t - W / 2, hi = t + W / 2; if (lo < 0) lo = 0; if (hi > SEQ) hi = SEQ; const float inv = 1.0f / (float)(hi - lo);
        if (q > 0) {
#pragma unroll
            for (int c = 0; c < 8; ++c) s[c] += f[q + W - 1][c] - f[q - 1][c]; }
        const float* e = f[q + W / 2];
        *(u32x4*)(P + (size_t)(row0 + q) * DM + c8 * 8) = (u32x4){cvtpk(s[0] * inv - e[0], s[1] * inv - e[1]), cvtpk(s[2] * inv - e[2], s[3] * inv - e[3]), cvtpk(s[4] * inv - e[4], s[5] * inv - e[5]), cvtpk(s[6] * inv - e[6], s[7] * inv - e[7])}; }
}
__device__ __forceinline__ void pool_phase(const Frame& F, const bf16_t* H, bf16_t* P) {
    const int lane = lane_id(); const int gwv = (int)blockIdx.x * NWAVES + F.wave, NWV = F.G * NWAVES;
    for (int wi = gwv; wi < NTOK; wi += NWV) {
        const int row0 = (wi >> 2) * 4, g = wi & 3, c8 = g * 64 + lane;
        if (g == 0) pool_item4<2>(H, P, row0, c8); else if (g == 1) pool_item4<4>(H, P, row0, c8); else if (g == 2) pool_item4<8>(H, P, row0, c8); else pool_item4<16>(H, P, row0, c8);
    }
}

constexpr int N_PHASES = 24;
#ifndef MK_N_LAUNCHES
#define MK_N_LAUNCHES 1
#endif
#ifndef REP_MASK
#define REP_MASK 0
#endif
__global__ void __launch_bounds__(NWAVES * 64, 2) skel_fwd(Args args) {
    extern __shared__ __attribute__((aligned(16))) unsigned char lds_raw[];
    Frame F;
    F.lds = (LAS unsigned char*)lds_raw; F.MISC = (volatile LAS unsigned*)(F.lds + MISC_OFF);
    F.wave = __builtin_amdgcn_readfirstlane(threadIdx.x >> 6);
    F.G = gridDim.x; { const int bx = blockIdx.x; F.vcu = (F.G % 8 == 0) ? (bx % 8) * (F.G / 8) + bx / 8 : bx; }
    F.ws = nullptr; F.ctl = (gu32*)(uptr(args.ws) + WS_CTL);
    for (int u = threadIdx.x; u < (LDS_BYTES - LDSCTL_OFF) / 4; u += NWAVES * 64) ((LAS unsigned*)(F.lds + LDSCTL_OFF))[u] = 0u;
    __syncthreads();
    const bool multi = (MK_N_LAUNCHES == 1) || (args.ph_hi - args.ph_lo) > 1 || REP_MASK != 0;
    XcdBarrier bar; bar.bar = (unsigned*)(F.ctl + CW_BAR); bar.x = 0; bar.st = nullptr; bar.wave = F.wave;
    if (multi) bar = xcd_barrier_post((unsigned*)(F.ctl + CW_BAR), F.MISC + 8, F.wave);
    const int lo = args.ph_lo, hi = args.ph_hi;
#ifdef REP_RT
    const unsigned rep_mask_ = (unsigned)__builtin_amdgcn_readfirstlane(args.pad);
#endif
#define IN(k) ((MK_N_LAUNCHES == 1) ? ((k) < N_PHASES) : (lo <= (k) && (k) < hi))
#ifdef REP_RT
#define REPBIT(k) ((int)((rep_mask_ >> (k)) & 1u))
#else
#define REPBIT(k) ((int)((((unsigned)REP_MASK) >> (k)) & 1u))
#endif
#define PHASE(k) _Pragma("unroll") for (int rep_ = 0; rep_ < 1 + REPBIT(k); ++rep_)
#define SEAM(k) do { if ((IN(k) && IN((k) + 1)) || rep_ + 1 < 1 + REPBIT(k)) xcd_barrier(bar); } while (0)
    LAS unsigned char* ring = F.lds + RING_OFF; LAS unsigned char* xl = F.lds + XL_OFF;
    const int bx = (int)blockIdx.x, G = F.G;

#define KV_PROJ(l, rotK, rotV) do {   \
            { MapLin mp{(const char*)(ws + WS_MEMNB + (size_t)(l) * NB * MEML * DM * 2), (const char*)(ws + WS_WCK_T + (size_t)(l) * DM * DM * 2), (size_t)256 * DM * 2, (size_t)256 * DM * 2}; \
              pg8::Sched<MapLin> S; S.init(NB * MEML / 256, DM / 256, G, (bx + G - ((rotK) % G)) % G, mp); \
              EpiStore<AddrLin> E{AddrLin{(bf16_t*)(ws + WS_KCB + (size_t)(l) * NB * MEML * DM * 2), DM}}; \
              pg8::gemm_phase<EpiStore<AddrLin>, pg8::Sched<MapLin>, true>(F.wave, ring, xl, DM, DM * 2, DM * 2, S, E); } \
            { MapLin mp{(const char*)(ws + WS_WCV_T + (size_t)(l) * DM * DM * 2), (const char*)(ws + WS_MEMNB + (size_t)(l) * NB * MEML * DM * 2), (size_t)256 * DM * 2, (size_t)256 * DM * 2}; \
              pg8::Sched<MapLin> S; S.init(DM / 256, NB * MEML / 256, G, (bx + G - ((rotV) % G)) % G, mp); \
              EpiStore<AddrLin> E{AddrLin{(bf16_t*)(ws + WS_VTB + (size_t)(l) * NB * MEML * DM * 2), NB * MEML}}; \
              pg8::gemm_phase<EpiStore<AddrLin>, pg8::Sched<MapLin>, true>(F.wave, ring, xl, DM, DM * 2, DM * 2, S, E); } } while (0)
#ifdef EXTRA_BARS
    for (int eb = 0; eb < EXTRA_BARS; ++eb) xcd_barrier(bar);
#endif
    if (IN(0)) PHASE(0) { const karg_t ka = kargs(); unsigned char* const ws = uptr(KWS(ka)); p0_prologue(F, ka, ws); SEAM(0); }
    if (IN(1)) PHASE(1) { const karg_t ka = kargs(); unsigned char* const ws = uptr(KWS(ka));
        {
            MapLin mp{(const char*)(ws + WS_HN), (const char*)(ws + WS_WIN_T), (size_t)256 * DM * 2, (size_t)256 * DM * 2};
            pg8::Sched<MapLin> S; S.init(NTOK / 256, 2560 / 256, G, bx, mp);
            EpiQKV E{(bf16_t*)(ws + WS_QB), (bf16_t*)(ws + WS_KB), (bf16_t*)(ws + WS_VB), KIN(ka, 4), KIN(ka, 5), (const float*)(ws + WS_ROPE), (const float*)(ws + WS_ROPE) + SEQ * 64};
            pg8::gemm_phase<EpiQKV, pg8::Sched<MapLin>, true>(F.wave, ring, xl, DM, DM * 2, DM * 2, S, E); }
        {
            MapLin mp{(const char*)(ws + WS_WF_T), (const char*)(ws + WS_HN), (size_t)256 * DM * 2, (size_t)256 * DM * 2};
            pg8::Sched<MapLin> S; S.init(1024 / 256, NTOK / 256, G, (bx + G - (320 % G)) % G, mp);
            EpiStore<AddrF1> E{AddrF1{(bf16_t*)(ws + WS_FPQ)}};
            pg8::gemm_phase<EpiStore<AddrF1>, pg8::Sched<MapLin>, true>(F.wave, ring, xl, DM, DM * 2, DM * 2, S, E); }
        KV_PROJ(0, 448, 480);
        SEAM(1);
    }
    if (IN(2)) PHASE(2) { const karg_t ka = kargs(); unsigned char* const ws = uptr(KWS(ka));
        const int nF2 = (G > 64) ? 64 : 0;
        if (bx < nF2 || nF2 == 0) {
            MapLin mp{(const char*)(ws + WS_DFT), (const char*)(ws + WS_FPQ), (size_t)256 * 4096 * 2, (size_t)256 * 4096 * 2};
            pg8::Sched<MapLin> S; S.init(8, 8, nF2 ? nF2 : G, bx, mp);
            EpiStore<AddrF2> E{AddrF2{(bf16_t*)(ws + WS_MIXB)}};
            pg8::gemm_phase<EpiStore<AddrF2>, pg8::Sched<MapLin>, true>(F.wave, ring, xl, 4096, 4096 * 2, 4096 * 2, S, E);
        }
        if (bx < nF2) { __syncthreads(); tr_span(F, ka, ws, 1, 6144 + bx * 8 + F.wave, 512, 5); __syncthreads(); }
        if (bx >= nF2) {
            const int a = bx - nF2, cnt = G - nF2, per = (384 + cnt - 1) / cnt, slot = a % 3; int ui = 0;
            for (int uid = a * per; uid < (a + 1) * per && uid < 384; ++uid, ++ui) {
                if (ui == slot) { __syncthreads(); tr_span(F, ka, ws, 1, a * 8 + F.wave, 1536, 4); __syncthreads(); }
                const int qb = uid & 7, hq = (uid >> 3) % NQH, b = uid / (8 * NQH), kvh = hq / 3;
                const bf16_t* Qb = (const bf16_t*)(ws + WS_QB) + ((size_t)b * SEQ + qb * 256) * AW + hq * HD;
                const bf16_t* Kh = (const bf16_t*)(ws + WS_KB) + (size_t)b * SEQ * KVW + kvh * HD;
                const bf16_t* Vh = (const bf16_t*)(ws + WS_VB) + (size_t)b * SEQ * KVW + kvh * HD;
                bf16_t* Ob = (bf16_t*)(ws + WS_MIXB) + ((size_t)b * SEQ + qb * 256) * DM + hq * HD;
                attn::attn_dense_body(Qb, Kh, Vh, Ob, SEQ, (char*)lds_raw + RING_OFF, F.wave);
            }
            if (slot >= ui) { __syncthreads(); tr_span(F, ka, ws, 1, a * 8 + F.wave, 1536, 4); __syncthreads(); }
        }
        SEAM(2);
    }
    if (IN(3)) PHASE(3) { const karg_t ka = kargs(); unsigned char* const ws = uptr(KWS(ka));
        MapLin mp{(const char*)(ws + WS_MIXB), (const char*)(ws + WS_WOUT_T), (size_t)256 * DM * 2, (size_t)256 * DM * 2};
        pg8::Sched<MapLin> S; S.init(NTOK / 256, DM / 256, G, bx, mp);
        EpiResB<true> E{KIN(ka, 0), (bf16_t*)(ws + WS_XB), (float*)(ws + WS_SSP), nullptr};
        pg8::gemm_phase<EpiResB<true>, pg8::Sched<MapLin>, true>(F.wave, ring, xl, DM, DM * 2, DM * 2, S, E);
        SEAM(3);
    }
    {
        constexpr int l = 0; constexpr int pb = l ? 15 : 4;
        if (l == 1) {
            if (IN(13)) PHASE(13) { const karg_t ka = kargs(); unsigned char* const ws = uptr(KWS(ka));
                pool_phase(F, (const bf16_t*)(ws + WS_HN), (bf16_t*)(ws + WS_QCB));
#ifdef PROBE_CONV
                tr_span<TRV>(F, ka, ws, 1, bx * 8 + F.wave, 2048, 6);
#endif
                SEAM(13);
            }
            if (IN(14)) PHASE(14) { const karg_t ka = kargs(); unsigned char* const ws = uptr(KWS(ka));
                MapPool mp{(const char*)(ws + WS_QCB), (const char*)(ws + WS_WP_T)};
                pg8::Sched<MapPool> S; S.init(NTOK / 256, DM / 256, G, bx, mp);
                EpiResB<false> E{(const bf16_t*)(ws + WS_XB), (bf16_t*)(ws + WS_XALT), (float*)(ws + WS_SSP), KIN(ka, 9)};
                pg8::gemm_phase<EpiResB<false>, pg8::Sched<MapPool>, true>(F.wave, ring, xl, 512, DM * 2, DM * 2, S, E);
                SEAM(14);
            }
        }
        if (IN(pb + 0)) PHASE(pb + 0) { const karg_t ka = kargs(); unsigned char* const ws = uptr(KWS(ka));
            MapLin mp{(const char*)(ws + (l == 0 ? WS_XB : WS_XALT)), (const char*)(ws + WS_WCQ_T + (size_t)l * DM * DM * 2), (size_t)256 * DM * 2, (size_t)256 * DM * 2};
            pg8::Sched<MapLin> S; S.init(NTOK / 256, DM / 256, G, bx, mp);
            EpiRowScale E{(bf16_t*)(ws + WS_QCB), DM, (const float*)(ws + WS_SSP), 0.04419417382415922f};
            pg8::gemm_phase<EpiRowScale, pg8::Sched<MapLin>, true>(F.wave, ring, xl, DM, DM * 2, DM * 2, S, E);
            SEAM(pb + 0);
        }
        if (IN(pb + 1)) PHASE(pb + 1) { const karg_t ka = kargs(); unsigned char* const ws = uptr(KWS(ka));
            MapXS mp{(const char*)(ws + WS_QCB), (const char*)(ws + WS_KCB + (size_t)l * NB * MEML * DM * 2)};
            pg8::Sched<MapXS> S; S.init(NTOK / 256, NMH, G, bx, mp);
            EpiSoftmax E{(bf16_t*)(ws + WS_PB), NMH * MEML};
            pg8::gemm_phase<EpiSoftmax, pg8::Sched<MapXS>, true>(F.wave, ring, xl, MHD, DM * 2, DM * 2, S, E);
            { pg8::Unit su; if (S.next(0, su)) {
                VM_WAIT(); __syncthreads(); if (F.wave == 0 && lane_id() == 0) { __builtin_amdgcn_fence(__ATOMIC_ACQUIRE, "agent"); VM_WAIT(); } __syncthreads();
                MapXPV mp2{(const char*)(ws + WS_PB), (const char*)(ws + WS_VTB + (size_t)l * NB * MEML * DM * 2)};
                SchedPair S2; S2.ua.pm = su.pm; S2.ua.pn = 2 * su.pn; S2.ub.pm = su.pm; S2.ub.pn = 2 * su.pn + 1; mp2(S2.ua); mp2(S2.ub);
                EpiStore<AddrLin> E2{AddrLin{(bf16_t*)(ws + WS_MIXB), DM}};
                pg8::gemm_phase<EpiStore<AddrLin>, SchedPair, true>(F.wave, ring, xl, MEML, NMH * MEML * 2, NB * MEML * 2, S2, E2); } }
            if (l == 0) { KV_PROJ(1, 128, 160);
                if (bx < 128) { __syncthreads(); tr_span(F, ka, ws, 1, 8704 + bx * 8 + F.wave, 1024, 2); }
                else if (bx >= 192) { tr_span(F, ka, ws, 2, (bx - 192) * 8 + F.wave, 512, 3); } }
            if (l == 1 && bx >= 128) tr_span(F, ka, ws, 2, 9728 + (bx - 128) * 8 + F.wave, 1024, 1);
            SEAM(pb + 1);
        }
        if (IN(pb + 3)) PHASE(pb + 3) { const karg_t ka = kargs(); unsigned char* const ws = uptr(KWS(ka));
            MapLin mp{(const char*)(ws + WS_MIXB), (const char*)(ws + WS_WCO_T + (size_t)l * DM * DM * 2), (size_t)256 * DM * 2, (size_t)256 * DM * 2};
            pg8::Sched<MapLin> S; S.init(NTOK / 256, DM / 256, G, bx, mp);
            EpiResB<false> E{(const bf16_t*)(ws + (l == 0 ? WS_XB : WS_XALT)), (bf16_t*)(ws + (l == 0 ? WS_XALT : WS_XB)), nullptr, nullptr};
            pg8::gemm_phase<EpiResB<false>, pg8::Sched<MapLin>, true>(F.wave, ring, xl, DM, DM * 2, DM * 2, S, E);
            SEAM(pb + 3);
        }
        if (IN(pb + 4)) PHASE(pb + 4) { const karg_t ka = kargs(); unsigned char* const ws = uptr(KWS(ka));
            router_phase(F, (const bf16_t*)(ws + (l == 0 ? WS_XALT : WS_XB)), (const u32x4*)(ws + WS_AFF + 512 * 1024) + (size_t)l * 8192, (float*)(ws + WS_SSP + 512 * 1024), (float*)(ws + WS_AFF), xl);
            SEAM(pb + 4);
        }
        if (IN(pb + 5)) PHASE(pb + 5) { const karg_t ka = kargs(); unsigned char* const ws = uptr(KWS(ka));
            rank_phase(F, (const float*)(ws + WS_AFF), (int*)(ws + WS_RANK), (float*)(ws + WS_GATE), (const float*)(ws + WS_SSP + 512 * 1024), (float*)(ws + WS_SSP + 768 * 1024), (int*)(ws + WS_GATE + 512 * 1024));
            if (bx >= NB * NE) tr_span(F, ka, ws, l == 0 ? 1 : 2, 10752 + (bx - NB * NE) * 8 + F.wave, 1536, 1);
            SEAM(pb + 5);
        }
        if (IN(pb + 6)) PHASE(pb + 6) { const karg_t ka = kargs(); unsigned char* const ws = uptr(KWS(ka));
            MapMoE mp{(const char*)(ws + (l == 0 ? WS_XALT : WS_XB)), (const char*)(ws + (l ? WS_WGU_T2 : WS_WGU_T)), (size_t)0, (size_t)2048 * DM * 2, (size_t)256 * DM * 2};
            pg8::Sched<MapMoE> S; S.init(NB * NE, 8, G, bx, mp);
            EpiSwiGLU E{(bf16_t*)(ws + WS_ACTB), (const float*)(ws + WS_SSP + 768 * 1024)};
            const bool cfirst = ((bx >> 3) & 1) != 0;
            if (l == 0 && cfirst) { tr_span(F, ka, ws, 2, 1536 + bx * 8 + F.wave, 2048, 2); __syncthreads(); }
            pg8::gemm_phase<EpiSwiGLU, pg8::Sched<MapMoE>, true, true>(F.wave, ring, xl, DM, DM * 2, DM * 2, S, E, (const int*)(ws + WS_GATE + 512 * 1024));
            if (l == 0 && !cfirst) { __syncthreads(); tr_span(F, ka, ws, 2, 1536 + bx * 8 + F.wave, 2048, 2); }
            SEAM(pb + 6);
        }
        if (IN(pb + 7)) PHASE(pb + 7) { const karg_t ka = kargs(); unsigned char* const ws = uptr(KWS(ka));
            MapMoE mp{(const char*)(ws + WS_ACTB), (const char*)(ws + (l ? WS_WD_T2 : WS_WD_T)), (size_t)256 * EFF * 2, (size_t)2048 * EFF * 2, (size_t)256 * EFF * 2};
            pg8::Sched<MapMoE> S; S.init(NB * NE, 8, G, bx, mp);
            EpiRowGate E{(bf16_t*)(ws + WS_YB), (const float*)(ws + WS_GATE)};
            const bool cfirst = ((bx >> 3) & 1) == 0;
            if (l == 0 && cfirst) { tr_span(F, ka, ws, 2, 5632 + bx * 8 + F.wave, 2048, 2); __syncthreads(); }
            pg8::gemm_phase<EpiRowGate, pg8::Sched<MapMoE>, true>(F.wave, ring, xl, EFF, EFF * 2, EFF * 2, S, E);
            if (l == 0 && !cfirst) { __syncthreads(); tr_span(F, ka, ws, 2, 5632 + bx * 8 + F.wave, 2048, 2); }
            SEAM(pb + 7);
        }
        if (IN(pb + 8)) PHASE(pb + 8) { const karg_t ka = kargs(); unsigned char* const ws = uptr(KWS(ka));
            combine_phase(F, (const bf16_t*)(ws + (l == 0 ? WS_XALT : WS_XB)), (bf16_t*)(ws + WS_XB), KOUT(ka), (const bf16_t*)(ws + WS_YB), (const int*)(ws + WS_RANK), l == 0 ? KIN(ka, 2) + DM : KIN(ka, 21), (bf16_t*)(ws + WS_HN), l == 1);
            SEAM(pb + 8);
        }
    }
    {
        constexpr int l = 1; constexpr int pb = l ? 15 : 4;
        if (l == 1) {
            if (IN(13)) PHASE(13) { const karg_t ka = kargs(); unsigned char* const ws = uptr(KWS(ka));
                pool_phase(F, (const bf16_t*)(ws + WS_HN), (bf16_t*)(ws + WS_QCB));
#ifdef PROBE_CONV
                tr_span<TRV>(F, ka, ws, 1, bx * 8 + F.wave, 2048, 6);
#endif
                SEAM(13);
            }
            if (IN(14)) PHASE(14) { const karg_t ka = kargs(); unsigned char* const ws = uptr(KWS(ka));
                MapPool mp{(const char*)(ws + WS_QCB), (const char*)(ws + WS_WP_T)};
                pg8::Sched<MapPool> S; S.init(NTOK / 256, DM / 256, G, bx, mp);
                EpiResB<false> E{(const bf16_t*)(ws + WS_XB), (bf16_t*)(ws + WS_XALT), (float*)(ws + WS_SSP), KIN(ka, 9)};
                pg8::gemm_phase<EpiResB<false>, pg8::Sched<MapPool>, true>(F.wave, ring, xl, 512, DM * 2, DM * 2, S, E);
                SEAM(14);
            }
        }
        if (IN(pb + 0)) PHASE(pb + 0) { const karg_t ka = kargs(); unsigned char* const ws = uptr(KWS(ka));
            MapLin mp{(const char*)(ws + (l == 0 ? WS_XB : WS_XALT)), (const char*)(ws + WS_WCQ_T + (size_t)l * DM * DM * 2), (size_t)256 * DM * 2, (size_t)256 * DM * 2};
            pg8::Sched<MapLin> S; S.init(NTOK / 256, DM / 256, G, bx, mp);
            EpiRowScale E{(bf16_t*)(ws + WS_QCB), DM, (const float*)(ws + WS_SSP), 0.04419417382415922f};
            pg8::gemm_phase<EpiRowScale, pg8::Sched<MapLin>, true>(F.wave, ring, xl, DM, DM * 2, DM * 2, S, E);
            SEAM(pb + 0);
        }
        if (IN(pb + 1)) PHASE(pb + 1) { const karg_t ka = kargs(); unsigned char* const ws = uptr(KWS(ka));
            MapXS mp{(const char*)(ws + WS_QCB), (const char*)(ws + WS_KCB + (size_t)l * NB * MEML * DM * 2)};
            pg8::Sched<MapXS> S; S.init(NTOK / 256, NMH, G, bx, mp);
            EpiSoftmax E{(bf16_t*)(ws + WS_PB), NMH * MEML};
            pg8::gemm_phase<EpiSoftmax, pg8::Sched<MapXS>, true>(F.wave, ring, xl, MHD, DM * 2, DM * 2, S, E);
            { pg8::Unit su; if (S.next(0, su)) {
                VM_WAIT(); __syncthreads(); if (F.wave == 0 && lane_id() == 0) { __builtin_amdgcn_fence(__ATOMIC_ACQUIRE, "agent"); VM_WAIT(); } __syncthreads();
                MapXPV mp2{(const char*)(ws + WS_PB), (const char*)(ws + WS_VTB + (size_t)l * NB * MEML * DM * 2)};
                SchedPair S2; S2.ua.pm = su.pm; S2.ua.pn = 2 * su.pn; S2.ub.pm = su.pm; S2.ub.pn = 2 * su.pn + 1; mp2(S2.ua); mp2(S2.ub);
                EpiStore<AddrLin> E2{AddrLin{(bf16_t*)(ws + WS_MIXB), DM}};
                pg8::gemm_phase<EpiStore<AddrLin>, SchedPair, true>(F.wave, ring, xl, MEML, NMH * MEML * 2, NB * MEML * 2, S2, E2); } }
            if (l == 0) { KV_PROJ(1, 128, 160);
                if (bx < 128) { __syncthreads(); tr_span(F, ka, ws, 1, 8704 + bx * 8 + F.wave, 1024, 2); }
                else if (bx >= 192) { tr_span(F, ka, ws, 2, (bx - 192) * 8 + F.wave, 512, 3); } }
            if (l == 1 && bx >= 128) tr_span(F, ka, ws, 2, 9728 + (bx - 128) * 8 + F.wave, 1024, 1);
            SEAM(pb + 1);
        }
        if (IN(pb + 3)) PHASE(pb + 3) { const karg_t ka = kargs(); unsigned char* const ws = uptr(KWS(ka));
            MapLin mp{(const char*)(ws + WS_MIXB), (const char*)(ws + WS_WCO_T + (size_t)l * DM * DM * 2), (size_t)256 * DM * 2, (size_t)256 * DM * 2};
            pg8::Sched<MapLin> S; S.init(NTOK / 256, DM / 256, G, bx, mp);
            EpiResB<false> E{(const bf16_t*)(ws + (l == 0 ? WS_XB : WS_XALT)), (bf16_t*)(ws + (l == 0 ? WS_XALT : WS_XB)), nullptr, nullptr};
            pg8::gemm_phase<EpiResB<false>, pg8::Sched<MapLin>, true>(F.wave, ring, xl, DM, DM * 2, DM * 2, S, E);
            SEAM(pb + 3);
        }
        if (IN(pb + 4)) PHASE(pb + 4) { const karg_t ka = kargs(); unsigned char* const ws = uptr(KWS(ka));
            router_phase(F, (const bf16_t*)(ws + (l == 0 ? WS_XALT : WS_XB)), (const u32x4*)(ws + WS_AFF + 512 * 1024) + (size_t)l * 8192, (float*)(ws + WS_SSP + 512 * 1024), (float*)(ws + WS_AFF), xl);
            SEAM(pb + 4);
        }
        if (IN(pb + 5)) PHASE(pb + 5) { const karg_t ka = kargs(); unsigned char* const ws = uptr(KWS(ka));
            rank_phase(F, (const float*)(ws + WS_AFF), (int*)(ws + WS_RANK), (float*)(ws + WS_GATE), (const float*)(ws + WS_SSP + 512 * 1024), (float*)(ws + WS_SSP + 768 * 1024), (int*)(ws + WS_GATE + 512 * 1024));
            if (bx >= NB * NE) tr_span(F, ka, ws, l == 0 ? 1 : 2, 10752 + (bx - NB * NE) * 8 + F.wave, 1536, 1);
            SEAM(pb + 5);
        }
        if (IN(pb + 6)) PHASE(pb + 6) { const karg_t ka = kargs(); unsigned char* const ws = uptr(KWS(ka));
            MapMoE mp{(const char*)(ws + (l == 0 ? WS_XALT : WS_XB)), (const char*)(ws + (l ? WS_WGU_T2 : WS_WGU_T)), (size_t)0, (size_t)2048 * DM * 2, (size_t)256 * DM * 2};
            pg8::Sched<MapMoE> S; S.init(NB * NE, 8, G, bx, mp);
            EpiSwiGLU E{(bf16_t*)(ws + WS_ACTB), (const float*)(ws + WS_SSP + 768 * 1024)};
            const bool cfirst = ((bx >> 3) & 1) != 0;
            if (l == 0 && cfirst) { tr_span(F, ka, ws, 2, 1536 + bx * 8 + F.wave, 2048, 2); __syncthreads(); }
            pg8::gemm_phase<EpiSwiGLU, pg8::Sched<MapMoE>, true, true>(F.wave, ring, xl, DM, DM * 2, DM * 2, S, E, (const int*)(ws + WS_GATE + 512 * 1024));
            if (l == 0 && !cfirst) { __syncthreads(); tr_span(F, ka, ws, 2, 1536 + bx * 8 + F.wave, 2048, 2); }
            SEAM(pb + 6);
        }
        if (IN(pb + 7)) PHASE(pb + 7) { const karg_t ka = kargs(); unsigned char* const ws = uptr(KWS(ka));
            MapMoE mp{(const char*)(ws + WS_ACTB), (const char*)(ws + (l ? WS_WD_T2 : WS_WD_T)), (size_t)256 * EFF * 2, (size_t)2048 * EFF * 2, (size_t)256 * EFF * 2};
            pg8::Sched<MapMoE> S; S.init(NB * NE, 8, G, bx, mp);
            EpiRowGate E{(bf16_t*)(ws + WS_YB), (const float*)(ws + WS_GATE)};
            const bool cfirst = ((bx >> 3) & 1) == 0;
            if (l == 0 && cfirst) { tr_span(F, ka, ws, 2, 5632 + bx * 8 + F.wave, 2048, 2); __syncthreads(); }
            pg8::gemm_phase<EpiRowGate, pg8::Sched<MapMoE>, true>(F.wave, ring, xl, EFF, EFF * 2, EFF * 2, S, E);
            if (l == 0 && !cfirst) { __syncthreads(); tr_span(F, ka, ws, 2, 5632 + bx * 8 + F.wave, 2048, 2); }
            SEAM(pb + 7);
        }
        if (IN(pb + 8)) PHASE(pb + 8) { const karg_t ka = kargs(); unsigned char* const ws = uptr(KWS(ka));
            combine_phase(F, (const bf16_t*)(ws + (l == 0 ? WS_XALT : WS_XB)), (bf16_t*)(ws + WS_XB), KOUT(ka), (const bf16_t*)(ws + WS_YB), (const int*)(ws + WS_RANK), l == 0 ? KIN(ka, 2) + DM : KIN(ka, 21), (bf16_t*)(ws + WS_HN), l == 1);
            SEAM(pb + 8);
        }
    }
#undef IN
#undef SEAM
#undef PHASE
#undef KV_PROJ
}


extern "C" void kernel_launch(void* const* d_in, const int* in_sizes, int n_in, void* d_out, int out_size, void* d_ws, size_t ws_size, hipStream_t stream) {
    static int grid = 0;
    if (grid == 0) {
        int dev = 0, cus = 0;
        if (n_in != 22 || out_size != NTOK * DM || ws_size < WS_FAST_END) { fprintf(stderr, "kernel_launch: unexpected shapes (n_in %d out %d ws %zu)\n", n_in, out_size, ws_size); grid = -1; return; }
        if (hipGetDevice(&dev) != hipSuccess || hipDeviceGetAttribute(&cus, hipDeviceAttributeMultiprocessorCount, dev) != hipSuccess) { fprintf(stderr, "device query failed\n"); grid = -1; return; }
        if (hipFuncSetAttribute((const void*)skel_fwd, hipFuncAttributeMaxDynamicSharedMemorySize, LDS_BYTES) != hipSuccess) { fprintf(stderr, "hipFuncSetAttribute failed\n"); grid = -1; return; }
        (void)hipGetLastError();
        grid = cus;
        if (grid != 256) { fprintf(stderr, "kernel_launch: this kernel is laid out for 256 CUs (found %d)\n", cus); grid = -1; return; }
    }
    if (grid < 0) return;
    (void)hipMemsetAsync((char*)d_ws + WS_CTL, 0, 32768, stream);
    Args a{};
    for (int i = 0; i < 22; ++i) a.in[i] = (const float*)d_in[i];
    a.out = (float*)d_out; a.ws = (unsigned char*)d_ws;
#ifdef REP_RT
    a.pad = REP_RT;
#endif
    constexpr int NL = MK_N_LAUNCHES;
    for (int li = 0; li < NL; ++li) {
        a.ph_lo = (N_PHASES * li) / NL; a.ph_hi = (N_PHASES * (li + 1)) / NL; a.li = li;
        hipLaunchKernelGGL(skel_fwd, dim3(grid), dim3(NWAVES * 64), LDS_BYTES, stream, a);
    }
}
```

```cpp
#include <hip/hip_runtime.h>
#include <cstdio>
#include <cstdint>

constexpr int DM = 2048, NB = 4, SEQ = 2048, NTOK = NB * SEQ;
constexpr int HD = 128, NQH = 12, NKVH = 4, AW = NQH * HD, KVW = NKVH * HD, FW = 512, INW = 3072;
constexpr int MEML = 256, NMH = 4, MHD = 512;
constexpr int NE = 16, EFF = 1024, CAP = 256;
constexpr float EPS = 1e-6f;

#define LAS __attribute__((address_space(3)))
#define GAS __attribute__((address_space(1)))
typedef unsigned short bf16_t;
typedef short bf16x8 __attribute__((ext_vector_type(8)));
typedef float f32x4 __attribute__((ext_vector_type(4)));
typedef float f32x2 __attribute__((ext_vector_type(2)));
typedef unsigned u32x4 __attribute__((ext_vector_type(4)));
typedef unsigned u32x2 __attribute__((ext_vector_type(2)));
typedef __bf16 bf16x2_t __attribute__((ext_vector_type(2)));
__device__ __forceinline__ unsigned cvtpk(float lo, float hi) { f32x2 v = {lo, hi}; bf16x2_t b = __builtin_convertvector(v, bf16x2_t); return __builtin_bit_cast(unsigned, b); }
__device__ __forceinline__ float bf2f(unsigned short h) { return __uint_as_float(((unsigned)h) << 16); }
template <class T> __device__ __forceinline__ T* uptr(T* p) { const unsigned long long v = (unsigned long long)p; const unsigned lo = __builtin_amdgcn_readfirstlane((unsigned)v), hi = __builtin_amdgcn_readfirstlane((unsigned)(v >> 32)); return (T*)(((unsigned long long)hi << 32) | lo); }
__device__ __forceinline__ int lane_id() { int l = (int)__builtin_amdgcn_mbcnt_hi(~0u, __builtin_amdgcn_mbcnt_lo(~0u, 0u)); asm volatile("" : "+v"(l)); return l; }
typedef __attribute__((address_space(4))) const unsigned char* karg_t;
__device__ __forceinline__ karg_t kargs() { karg_t p = (karg_t)__builtin_amdgcn_kernarg_segment_ptr(); asm volatile("" : "+s"(p)); return p; }
#define KIN(ka, i) (*(const float* const __attribute__((address_space(4)))*)((ka) + 8 * (i)))
#define KOUT(ka) (*(float* const __attribute__((address_space(4)))*)((ka) + 176))
#define KWS(ka) (*(unsigned char* const __attribute__((address_space(4)))*)((ka) + 184))
#ifndef EPI_WT
#define EPI_WT 0
#endif
__device__ __forceinline__ void st16(void* p, u32x4 v) {
#if EPI_WT
    asm volatile("global_store_dwordx4 %0, %1, off sc1\n\ts_nop 1" :: "v"(p), "v"(v) : "memory");
#else
    *(u32x4*)p = v;
#endif
}
#define LDS_WAIT() asm volatile("s_waitcnt lgkmcnt(0)" ::: "memory")
#define VM_WAIT() asm volatile("s_waitcnt vmcnt(0)" ::: "memory")
#define WG_BAR() do { asm volatile("s_waitcnt lgkmcnt(0)" ::: "memory"); __builtin_amdgcn_s_barrier(); asm volatile("" ::: "memory"); } while (0)

namespace pg8 {
constexpr int BM = 256, BK = 64, HALF = 128, HTB = HALF * BK * 2, STAGE_BYTES = 8 * HTB, NXCD = 8, WGM = 8;
__host__ __device__ __forceinline__ int lds_byte(int r, int c) { const int st = (r >> 4) * 2 + (c >> 5), rr = r & 15, cc = c & 31, ob = rr * 64 + cc * 2; return st * 1024 + (ob ^ (((ob >> 9) & 1) << 5)); }
__host__ __device__ __forceinline__ void stage_rc(int b, int& R, int& C) { const int st = b / 1024, sb = b % 1024, swz = sb ^ (((sb >> 9) & 1) << 5); R = (st >> 1) * 16 + swz / 64; C = (st & 1) * 32 + (swz % 64) / 2; }
__host__ __device__ __forceinline__ int perm32(int rho) { const int n = rho >> 4, i = rho & 15; return 8 * (i >> 2) + 4 * n + (i & 3); }

struct Unit { int pm, pn; const char* a; const char* b; };
struct EpiCtx { int wr, wc, wid; LAS unsigned char* xl; };

template <class Map> struct Sched {
    int nM, nN, nwg, G, c, wgm; Map map;
    __device__ __forceinline__ void init(int nM_, int nN_, int G_, int c_, const Map& m, int wgm_ = WGM) { nM = nM_; nN = nN_; nwg = nM * nN; G = G_; c = c_; map = m; wgm = wgm_; }
    __device__ __forceinline__ bool next(int i, Unit& u) const {
        const long L = (long)i * G + c; if (L >= nwg) return false;
        int wgid = (int)L; { const int q = nwg / NXCD, r = nwg % NXCD, xcd = wgid % NXCD, off = wgid / NXCD; wgid = (xcd < r ? xcd * (q + 1) : r * (q + 1) + (xcd - r) * q) + off; }
        const int nig = wgm * nN, gid = wgid / nig, fm = gid * wgm, gsz = (nM - fm) < wgm ? (nM - fm) : wgm;
        u.pm = fm + ((wgid % nig) % gsz); u.pn = (wgid % nig) / gsz; map(u); return true;
    }
};

template <class Epi, class SchedT, bool SP2, bool GATHER = false>
__device__ __forceinline__ void gemm_phase(const int wave_, LAS unsigned char* lds, LAS unsigned char* xl, const int K, const int lda, const int ldb, const SchedT& S, const Epi& E, const int* gidx = nullptr) {
    constexpr bool ALIGN_EPI = true; static_assert(SP2 || !GATHER, "GATHER needs the SP2 loop");
    const int lane = lane_id(), wid = wave_, tid = wid * 64 + lane, wr = wid >> 2, wc = wid & 3, fr = lane & 15, fq = lane >> 4;
    const int nt = K / BK;
    unsigned voffA[2], voffB[2];
#pragma unroll
    for (int i = 0; i < 2; ++i) { int R, C; stage_rc(tid * 16 + i * 8192, R, C); const int Rb = Epi::PERM ? ((R & ~31) + perm32(R & 31)) : R;
        voffA[i] = (unsigned)(R * lda + C * 2); voffB[i] = (unsigned)(Rb * ldb + C * 2); }
    const size_t kstep = (size_t)(BK * 2);
    const size_t hstepA = (size_t)HALF * lda, hstepB = (size_t)HALF * ldb;
    const unsigned ldsw = (unsigned)wid * 1024u;
    const int aoff = lds_byte(wr * 64 + fr, fq * 8), boff = lds_byte(wc * 32 + fr, fq * 8);
    const unsigned xoffA = (unsigned)tid * 16u;
    int gset = 0;
#define PG8_GSETUP(set, pm_) do { if constexpr (GATHER) { int R0_, C0_, R1_, C1_; stage_rc(tid * 16, R0_, C0_); stage_rc(tid * 16 + 8192, R1_, C1_); \
        const GAS int* gi_ = (const GAS int*)gidx + (pm_) * 256; const int r00_ = gi_[R0_], r01_ = gi_[R1_], r10_ = gi_[128 + R0_], r11_ = gi_[128 + R1_];     \
        *(LAS u32x4*)(xl + (set) * 8192 + xoffA) = (u32x4){(unsigned)(r00_ * lda + C0_ * 2), (unsigned)(r01_ * lda + C1_ * 2), (unsigned)(r10_ * lda + C0_ * 2), (unsigned)(r11_ * lda + C1_ * 2)}; } } while (0)
#define PG8_SA(b, h) (((b) * 2 + (h)) * HTB)
#define PG8_SB(b, h) ((4 + (b) * 2 + (h)) * HTB)
#define PG8_STAGE(bufoff, gbase, voff) do { _Pragma("unroll") for (int _i = 0; _i < 2; ++_i) \
        __builtin_amdgcn_global_load_lds((const unsigned*)((const char*)(gbase) + (voff)[_i]), (LAS unsigned*)(lds + (bufoff) + ldsw + _i * 8192), 16, 0, 0); } while (0)
#define PG8_GOFF(h_, set_) u32x2 go_ = {0u, 0u}; if constexpr (GATHER) go_ = *(const LAS u32x2*)(xl + (set_) * 8192 + xoffA + (h_) * 8)
#define PG8_STAGE_A(bufoff, gbase, h_, set_) do { if constexpr (GATHER) { \
        __builtin_amdgcn_global_load_lds((const unsigned*)((const char*)(gbase) + go_.x), (LAS unsigned*)(lds + (bufoff) + ldsw), 16, 0, 0); \
        __builtin_amdgcn_global_load_lds((const unsigned*)((const char*)(gbase) + go_.y), (LAS unsigned*)(lds + (bufoff) + ldsw + 8192), 16, 0, 0); } \
      else { PG8_STAGE(bufoff, (const char*)(gbase) + (h_) * hstepA, voffA); } } while (0)
#define PG8_LDA(dst, b, h) do { _Pragma("unroll") for (int m = 0; m < 4; ++m) _Pragma("unroll") for (int k = 0; k < 2; ++k) dst[m][k] = *(const LAS bf16x8*)(lds + PG8_SA(b, h) + aoff + m * 2048 + k * 1024); } while (0)
#define PG8_LDB(dst, b, h) do { _Pragma("unroll") for (int n = 0; n < 2; ++n) _Pragma("unroll") for (int k = 0; k < 2; ++k) dst[n][k] = *(const LAS bf16x8*)(lds + PG8_SB(b, h) + boff + n * 2048 + k * 1024); } while (0)
#define PG8_MMA(ai, bj, At, Bt) do { __builtin_amdgcn_s_setprio(1); _Pragma("unroll") for (int m = 0; m < 4; ++m) _Pragma("unroll") for (int n = 0; n < 2; ++n) _Pragma("unroll") for (int k = 0; k < 2; ++k) \
        acc[ai][bj][m][n] = __builtin_amdgcn_mfma_f32_16x16x32_bf16(Bt[n][k], At[m][k], acc[ai][bj][m][n], 0, 0, 0); __builtin_amdgcn_s_setprio(0); } while (0)
#define PG8_WAIT_V(n) asm volatile("s_waitcnt vmcnt(" #n ")" ::: "memory")
#define PG8_WAIT_L(n) asm volatile("s_waitcnt lgkmcnt(" #n ")" ::: "memory")
#define PG8_BAR __builtin_amdgcn_s_barrier()
#define PG8_SCHED __builtin_amdgcn_sched_barrier(0)
    Unit cur, nxt; int ui = 0;
    if (!S.next(0, cur)) return;
    EpiCtx ctx; ctx.wr = wr; ctx.wc = wc; ctx.wid = wid; ctx.xl = xl;
    f32x4 acc[2][2][4][2];
#pragma unroll
    for (int a = 0; a < 2; ++a)
#pragma unroll
        for (int b = 0; b < 2; ++b)
#pragma unroll
            for (int m = 0; m < 4; ++m)
#pragma unroll
                for (int n = 0; n < 2; ++n) acc[a][b][m][n] = (f32x4){0.f, 0.f, 0.f, 0.f};
    bf16x8 At[4][2], B0[2][2], B1[2][2];
    const char* cA = cur.a; const char* cB = cur.b;
    PG8_GSETUP(0, cur.pm);
    if constexpr (SP2) {
        PG8_STAGE(PG8_SB(0, 0), cB, voffB); PG8_STAGE(PG8_SB(0, 1), cB + hstepB, voffB); { PG8_GOFF(0, 0); PG8_STAGE_A(PG8_SA(0, 0), cA, 0, 0); } { PG8_GOFF(1, 0); PG8_STAGE_A(PG8_SA(0, 1), cA, 1, 0); }
        if (wr == 1) PG8_BAR;
        PG8_WAIT_V(2); PG8_BAR;
        PG8_STAGE(PG8_SB(1, 0), cB + kstep, voffB); { PG8_GOFF(0, 0); PG8_STAGE_A(PG8_SA(1, 0), cA + kstep, 0, 0); } PG8_STAGE(PG8_SB(1, 1), cB + hstepB + kstep, voffB);
        PG8_WAIT_V(6); PG8_BAR;
    } else {
        PG8_STAGE(PG8_SB(0, 0), cB, voffB); PG8_STAGE(PG8_SA(0, 0), cA, voffA); PG8_STAGE(PG8_SB(0, 1), cB + hstepB, voffB); PG8_STAGE(PG8_SA(0, 1), cA + hstepA, voffA);
        if (wr == 1) PG8_BAR;
        PG8_WAIT_V(4); PG8_BAR;
        PG8_STAGE(PG8_SB(1, 0), cB + kstep, voffB); PG8_STAGE(PG8_SA(1, 0), cA + kstep, voffA); PG8_STAGE(PG8_SB(1, 1), cB + hstepB + kstep, voffB);
        PG8_WAIT_V(6); PG8_BAR;
    }
    for (;;) {
        const bool has_next = S.next(ui + 1, nxt);
        const char* nA = has_next ? nxt.a : cA; const char* nB = has_next ? nxt.b : cB;
        if (has_next) PG8_GSETUP(gset ^ 1, nxt.pm);
        for (int t = 0; t < nt; t += 2) {
            const bool last = (t == nt - 2);
            const char* a1 = cA + (size_t)(t + 1) * kstep;
            const char* a2 = last ? nA : cA + (size_t)(t + 2) * kstep; const char* b2 = last ? nB : cB + (size_t)(t + 2) * kstep;
            const char* a3 = a2 + kstep; const char* b3 = b2 + kstep;
            const int set2 = (last && has_next) ? (gset ^ 1) : gset;
            if constexpr (SP2) {
            { PG8_GOFF(1, gset); PG8_LDB(B0, 0, 0); PG8_LDB(B1, 0, 1); PG8_SCHED; PG8_LDA(At, 0, 0); PG8_STAGE_A(PG8_SA(1, 1), a1, 1, gset); }
            PG8_WAIT_V(8); PG8_WAIT_L(0); PG8_BAR; PG8_MMA(0, 0, At, B0); PG8_MMA(0, 1, At, B1); PG8_BAR; PG8_SCHED;
            { PG8_GOFF(0, set2); PG8_LDA(At, 0, 1); PG8_STAGE(PG8_SB(0, 0), b2, voffB); PG8_STAGE(PG8_SB(0, 1), b2 + hstepB, voffB); PG8_STAGE_A(PG8_SA(0, 0), a2, 0, set2); }
            PG8_WAIT_V(8); PG8_WAIT_L(0); PG8_BAR; PG8_MMA(1, 0, At, B0); PG8_MMA(1, 1, At, B1); PG8_BAR; PG8_SCHED;
            { PG8_GOFF(1, set2); PG8_LDB(B0, 1, 0); PG8_LDB(B1, 1, 1); PG8_SCHED; PG8_LDA(At, 1, 0); PG8_STAGE_A(PG8_SA(0, 1), a2, 1, set2); }
            PG8_WAIT_V(8); PG8_WAIT_L(0); PG8_BAR; PG8_MMA(0, 0, At, B0); PG8_MMA(0, 1, At, B1); PG8_BAR; PG8_SCHED;
            { PG8_GOFF(0, set2); PG8_LDA(At, 1, 1); PG8_STAGE(PG8_SB(1, 0), b3, voffB); PG8_STAGE(PG8_SB(1, 1), b3 + hstepB, voffB); PG8_STAGE_A(PG8_SA(1, 0), a3, 0, set2); }
            PG8_WAIT_V(8); PG8_WAIT_L(0); PG8_BAR; PG8_MMA(1, 0, At, B0); PG8_MMA(1, 1, At, B1); PG8_BAR; PG8_SCHED;
            } else {
            PG8_LDB(B0, 0, 0); PG8_SCHED; PG8_LDA(At, 0, 0); PG8_STAGE(PG8_SA(1, 1), a1 + hstepA, voffA);
            PG8_WAIT_L(8); PG8_BAR; PG8_WAIT_L(0); PG8_MMA(0, 0, At, B0); PG8_BAR; PG8_SCHED;
            PG8_LDB(B1, 0, 1); PG8_STAGE(PG8_SB(0, 0), b2, voffB);
            PG8_BAR; PG8_WAIT_L(0); PG8_MMA(0, 1, At, B1); PG8_BAR;
            PG8_LDA(At, 0, 1); PG8_STAGE(PG8_SA(0, 0), a2, voffA);
            PG8_BAR; PG8_WAIT_L(0); PG8_MMA(1, 0, At, B0); PG8_BAR; PG8_SCHED;
            PG8_STAGE(PG8_SB(0, 1), b2 + hstepB, voffB);
            PG8_WAIT_V(6); PG8_BAR; PG8_MMA(1, 1, At, B1); PG8_BAR;
            PG8_LDB(B0, 1, 0); PG8_SCHED; PG8_LDA(At, 1, 0); PG8_STAGE(PG8_SA(0, 1), a2 + hstepA, voffA);
            PG8_WAIT_L(8); PG8_BAR; PG8_WAIT_L(0); PG8_MMA(0, 0, At, B0); PG8_BAR; PG8_SCHED;
            PG8_LDB(B1, 1, 1); PG8_STAGE(PG8_SB(1, 0), b3, voffB);
            PG8_BAR; PG8_WAIT_L(0); PG8_MMA(0, 1, At, B1); PG8_BAR;
            PG8_LDA(At, 1, 1); PG8_STAGE(PG8_SA(1, 0), a3, voffA);
            PG8_BAR; PG8_WAIT_L(0); PG8_MMA(1, 0, At, B0); PG8_BAR; PG8_SCHED;
            PG8_STAGE(PG8_SB(1, 1), b3 + hstepB, voffB);
            PG8_WAIT_V(6); PG8_BAR; PG8_MMA(1, 1, At, B1); PG8_BAR;
            }
        }
        if constexpr (ALIGN_EPI) { if (wr == 0) PG8_BAR; }
        E(acc, cur, ctx);
        if (!has_next) break;
#pragma unroll
        for (int a = 0; a < 2; ++a)
#pragma unroll
            for (int b = 0; b < 2; ++b)
#pragma unroll
                for (int m = 0; m < 4; ++m)
#pragma unroll
                    for (int n = 0; n < 2; ++n) acc[a][b][m][n] = (f32x4){0.f, 0.f, 0.f, 0.f};
        cur = nxt; cA = nA; cB = nB; ++ui; gset ^= 1;
        if constexpr (ALIGN_EPI) { if (wr == 1) PG8_BAR; }
    }
    PG8_WAIT_V(0);
    if constexpr (!ALIGN_EPI) { if (wr == 0) PG8_BAR; }
    PG8_BAR;
#undef PG8_SA
#undef PG8_SB
#undef PG8_STAGE
#undef PG8_STAGE_A
#undef PG8_GOFF
#undef PG8_GSETUP
#undef PG8_LDA
#undef PG8_LDB
#undef PG8_MMA
#undef PG8_WAIT_V
#undef PG8_WAIT_L
#undef PG8_BAR
#undef PG8_SCHED
}
}

constexpr size_t MiB = 1u << 20;
constexpr size_t WS_CTL = 0, CTL_ZERO_BYTES = 1 * MiB;
constexpr size_t WS_WIN_T = 1 * MiB, WS_WF_T = 11 * MiB, WS_WOUT_T = 15 * MiB, WS_WCQ_T = 23 * MiB, WS_WCK_T = 39 * MiB, WS_WCV_T = 55 * MiB, WS_WCO_T = 71 * MiB;
constexpr size_t WS_WP_T = 87 * MiB, WS_DFT = 89 * MiB, WS_ROPE = 105 * MiB, WS_WGU_T = 106 * MiB, WS_WD_T = 234 * MiB;
constexpr size_t WS_HN = 298 * MiB, WS_XB = 330 * MiB, WS_QB = 362 * MiB, WS_KB = 386 * MiB, WS_VB = 394 * MiB, WS_FPQ = 402 * MiB, WS_MIXB = 418 * MiB, WS_QCB = 450 * MiB;
constexpr size_t WS_KCB = 482 * MiB, WS_VTB = 490 * MiB, WS_MEMNB = 498 * MiB, WS_PB = 506 * MiB, WS_XSB = 522 * MiB, WS_ACTB = 586 * MiB, WS_YB = 618 * MiB;
constexpr size_t WS_SSP = 682 * MiB, WS_AFF = 683 * MiB, WS_RANK = 684 * MiB, WS_GATE = 685 * MiB, WS_XALT = 686 * MiB, WS_WGU_T2 = 750 * MiB, WS_WD_T2 = 878 * MiB, WS_FAST_END = 942 * MiB;
constexpr int CW_TMO = 0, CW_CODE = 1, CW_BAR = 4096;
constexpr int RING_OFF = 0, RING_BYTES = 131072, XL_OFF = 131072, XL_BYTES = 16384, LDSCTL_OFF = XL_OFF + XL_BYTES, MISC_OFF = LDSCTL_OFF + 320, LDS_BYTES = 149504;
static_assert(MISC_OFF + 128 <= LDS_BYTES, "LDS map");
constexpr int NWAVES = 8;

typedef GAS unsigned gu32;
#define RLX_AGENT __ATOMIC_RELAXED, __HIP_MEMORY_SCOPE_AGENT

#define XB_TMO      128
#define XB_XCNT(j)  (256  + 64 * (j))
#define XB_XSUB(j)  (1280 + 64 * (j))
#define XB_XGEN(j)  (2304 + 64 * (j))
#define XB_TOP      3328
#define XB_TOPGEN   3392
#define XCD_BAR_WORDS 3456
#define XB_SPIN_CAP (1u << 18)
__device__ __forceinline__ unsigned xb_ld(unsigned* p)              { return __hip_atomic_load(p, __ATOMIC_RELAXED, __HIP_MEMORY_SCOPE_AGENT); }
__device__ __forceinline__ unsigned xb_add(unsigned* p, unsigned v) { return __hip_atomic_fetch_add(p, v, __ATOMIC_RELAXED, __HIP_MEMORY_SCOPE_AGENT); }
__device__ __forceinline__ unsigned xb_xcc_id() { return (unsigned)__builtin_amdgcn_s_getreg((3 << 11) | 20) & 0xFu; }
#define XB_SPIN(cond, bar) do { unsigned _sp = 0; while (cond) { __builtin_amdgcn_s_sleep(1); \
    if ((++_sp & 255u) == 0u) { if (xb_ld(&(bar)[XB_TMO])) break; if (_sp > XB_SPIN_CAP) { atomicAdd(&(bar)[XB_TMO], 1u); break; } } } } while (0)
struct XcdBarrier { unsigned* bar; unsigned x; volatile LAS unsigned* st; int wave; };
__device__ __forceinline__ XcdBarrier xcd_barrier_post(unsigned* bar, volatile LAS unsigned* st, int wave) {
    XcdBarrier b; b.bar = bar; b.x = xb_xcc_id(); b.st = st; b.wave = wave;
    if (wave == 0 && lane_id() == 0) (void)xb_add(&bar[XB_XCNT(b.x)], 1u);
    return b;
}
__device__ __forceinline__ void xcd_barrier_complete(unsigned* bar, unsigned x, unsigned& nloc, unsigned& nx) {
    const unsigned G = gridDim.x * gridDim.y * gridDim.z;
    unsigned sum, cnt, mine, sp = 0u;
    for (;;) {
        sum = 0u; cnt = 0u; mine = 0u;
#pragma unroll
        for (unsigned j = 0; j < 16; ++j) { const unsigned c = xb_ld(&bar[XB_XCNT(j)]); sum += c; cnt += (c > 0u) ? 1u : 0u; mine = (j == x) ? c : mine; }
        if (sum == G) break;
        __builtin_amdgcn_s_sleep(1);
        if ((++sp & 255u) == 0u) { if (xb_ld(&bar[XB_TMO])) break; if (sp > XB_SPIN_CAP) { atomicAdd(&bar[XB_TMO], 1u); break; } }
    }
    nloc = mine > 0u ? mine : 1u; nx = cnt > 0u ? cnt : 1u;
}
__device__ __forceinline__ void xcd_barrier(const XcdBarrier& b) {
    asm volatile("s_waitcnt vmcnt(0)" ::: "memory");
    __syncthreads();
    if (b.wave == 0 && lane_id() == 0) {
        unsigned* bar = b.bar;
        __builtin_amdgcn_s_waitcnt(0);
        unsigned nloc = b.st[0], nx = b.st[1];
        if (nloc == 0u) { xcd_barrier_complete(bar, b.x, nloc, nx); b.st[0] = nloc; b.st[1] = nx; }
        const unsigned old = xb_add(&bar[XB_XSUB(b.x)], 1u);
        const unsigned gen = old / nloc;
        if (old + 1u == (gen + 1u) * nloc) {
            __builtin_amdgcn_fence(__ATOMIC_RELEASE, "agent");
            asm volatile("s_waitcnt vmcnt(0)" ::: "memory");
            const unsigned og = xb_add(&bar[XB_TOP], 1u);
            const unsigned tg = og / nx;
            if (og + 1u == (tg + 1u) * nx) xb_add(&bar[XB_TOPGEN], 1u);
            else XB_SPIN(xb_ld(&bar[XB_TOPGEN]) == tg, bar);
            __builtin_amdgcn_fence(__ATOMIC_ACQUIRE, "agent");
            xb_add(&bar[XB_XGEN(b.x)], 1u);
            asm volatile("s_waitcnt vmcnt(0)" ::: "memory");
        } else {
            XB_SPIN(xb_ld(&bar[XB_XGEN(b.x)]) == gen, bar);
            __builtin_amdgcn_fence(__ATOMIC_ACQUIRE, "agent");
            asm volatile("s_waitcnt vmcnt(0)" ::: "memory");
        }
    }
    __syncthreads();
}

struct Args { const float* in[22]; float* out; unsigned char* ws; int ph_lo, ph_hi, li, pad; };
struct Frame {
    LAS unsigned char* lds; volatile LAS unsigned* MISC; gu32* ctl;
    int wave, vcu, G;
    unsigned char* ws;
};
__device__ __forceinline__ float wave_sum(float v) {
#pragma unroll
    for (int o = 1; o < 64; o <<= 1) v += __shfl_xor(v, o);
    return v;
}
struct TrDesc { const float* W; const float* gain; bf16_t* WT; int ldw, ldt, k0, n0; long drow0; };
__device__ __forceinline__ void tr_load(const TrDesc& d, f32x4 (&v)[16], int lane) {
    const int lr = lane >> 4, lc = (lane & 15) * 4;
#pragma unroll
    for (int i = 0; i < 16; ++i) v[i] = __builtin_nontemporal_load((const GAS f32x4*)(d.W + (size_t)(d.k0 + 4 * i + lr) * d.ldw + d.n0 + lc));
}
#ifndef TRV
#define TRV 0
#endif
template <int V> __device__ __forceinline__ void tr_finish(const TrDesc& d, const f32x4 (&v)[16], LAS float* scr, int lane) {
    const int lr = lane >> 4, lc = (lane & 15) * 4;
    if (V == 1) { f32x4 s = v[0]; for (int i = 1; i < 16; ++i) s = s + v[i]; if (s.x == 1.2345e30f) *(GAS f32x4*)(d.WT) = s; return; }
#pragma unroll
    for (int i = 0; i < 16; ++i) { const int kk = 4 * i + lr; f32x4 x = v[i]; if (d.gain) x = x * d.gain[d.k0 + kk];
        LAS float* s = scr + kk * 65 + lc; s[0] = x.x; s[1] = x.y; s[2] = x.z; s[3] = x.w; }
    LDS_WAIT(); asm volatile("" ::: "memory");
    const int c = lane & 7;
#pragma unroll
    for (int j = 0; j < 8; ++j) { const int n = (lane >> 3) + 8 * j; const LAS float* s = scr + (8 * c) * 65 + n;
        u32x4 o; o.x = cvtpk(s[0 * 65], s[1 * 65]); o.y = cvtpk(s[2 * 65], s[3 * 65]); o.z = cvtpk(s[4 * 65], s[5 * 65]); o.w = cvtpk(s[6 * 65], s[7 * 65]);
        if (V == 0 || o.x == 0x12345678u) *(GAS u32x4*)(d.WT + (size_t)(d.drow0 + n) * d.ldt + d.k0 + 8 * c) = o; }
    LDS_WAIT(); asm volatile("" ::: "memory");
}
#ifndef TR_PIPE
#define TR_PIPE 0
#endif
constexpr int TR_DENSE = 32 * 20 + 9 * 32 * 16 + 32 * 4, TR_EXPERT = NE * 768;
__device__ __forceinline__ TrDesc tr_desc(karg_t ka, unsigned char* ws, int it, int mode) {
    TrDesc d; d.gain = nullptr;
    constexpr int I_IN = 32 * 20, I_SQ = 32 * 16;
    if (mode == 0) {
        int r = it;
        if (r < I_IN) { d.W = KIN(ka, 3); d.ldw = INW; d.WT = (bf16_t*)(ws + WS_WIN_T); d.ldt = DM; d.k0 = (r / 20) * 64; d.n0 = (r % 20) * 128; d.drow0 = d.n0; return d; } r -= I_IN;
        if (r < I_SQ) { d.W = KIN(ka, 7); d.ldw = DM; d.WT = (bf16_t*)(ws + WS_WOUT_T); d.ldt = DM; d.k0 = (r / 16) * 64; d.n0 = (r % 16) * 128; d.drow0 = d.n0; return d; } r -= I_SQ;
        if (r < 8 * I_SQ) { const int j = r / I_SQ, q = r % I_SQ, wsel = j >> 1, layer = j & 1;
            d.W = KIN(ka, 12 + wsel) + (size_t)layer * DM * DM; d.ldw = DM; if (wsel == 0) d.gain = KIN(ka, 10) + layer * DM;
            d.WT = (bf16_t*)(ws + (wsel == 0 ? WS_WCQ_T : wsel == 1 ? WS_WCK_T : wsel == 2 ? WS_WCV_T : WS_WCO_T) + (size_t)layer * DM * DM * 2); d.ldt = DM;
            d.k0 = (q / 16) * 64; d.n0 = (q % 16) * 128; d.drow0 = d.n0; return d; } r -= 8 * I_SQ;
        d.W = KIN(ka, 8); d.ldw = 512; d.WT = (bf16_t*)(ws + WS_WP_T); d.ldt = DM; d.k0 = (r / 4) * 64; d.n0 = (r % 4) * 128; d.drow0 = d.n0; return d;
    }
    const int layer = mode - 1;
    const int e = it / 768, r = it % 768; const size_t eo = (size_t)(layer * NE + e);
    if (r < 512) { const int up = r >> 8, q = r & 255, kb = q >> 3, nb = q & 7, n0 = nb * 128;
        d.W = (up ? KIN(ka, 19) : KIN(ka, 18)) + eo * DM * EFF; d.ldw = EFF; d.gain = KIN(ka, 16) + layer * DM;   d.WT = (bf16_t*)(ws + (layer ? WS_WGU_T2 : WS_WGU_T)) + (size_t)e * 2048 * 2048; d.ldt = 2048;
        d.k0 = kb * 64; d.n0 = n0; d.drow0 = (long)(n0 >> 7) * 256 + up * 128;
    } else { const int q = r - 512, kb = q >> 4, nb = q & 15;
        d.W = KIN(ka, 20) + eo * EFF * DM; d.ldw = DM; d.WT = (bf16_t*)(ws + (layer ? WS_WD_T2 : WS_WD_T)) + (size_t)e * 2048 * 1024; d.ldt = 1024; d.k0 = kb * 64; d.n0 = nb * 128; d.drow0 = nb * 128; }
    return d;
}
template <int V = 0> __device__ __forceinline__ void tr_span(const Frame& F, karg_t ka, unsigned char* ws, int mode, int first, int stride, int cnt) {
    const int lane = lane_id(); LAS float* scr = (LAS float*)(F.lds + RING_OFF + F.wave * 16640);
    if (cnt <= 0) return;
    f32x4 va[16], vb[16];
    TrDesc da = tr_desc(ka, ws, first, mode), db = da; db.n0 += 64; db.drow0 += 64;
    tr_load(da, va, lane); tr_load(db, vb, lane);
    for (int j = 0; j < cnt; ++j) {
        const bool more = j + 1 < cnt; TrDesc na = da, nb = db;
        if (more) { na = tr_desc(ka, ws, first + stride * (j + 1), mode); nb = na; nb.n0 += 64; nb.drow0 += 64; }
        tr_finish<V>(da, va, scr, lane); if (more) tr_load(na, va, lane);
        tr_finish<V>(db, vb, scr, lane); if (more) tr_load(nb, vb, lane);
        da = na; db = nb;
    }
}
__device__ __forceinline__ void rms_row_to_bf16(const float* xrow, const float* __restrict__ gain, bf16_t* orow, int lane) {
    const GAS f32x4* xr = (const GAS f32x4*)xrow + lane; const f32x4* gr = (const f32x4*)gain + lane;
    f32x4 v[8]; float s = 0.f;
#pragma unroll
    for (int j = 0; j < 8; ++j) { v[j] = xr[64 * j]; s += (v[j].x * v[j].x + v[j].y * v[j].y) + (v[j].z * v[j].z + v[j].w * v[j].w); }
    const float r = rsqrtf(wave_sum(s) * (1.f / DM) + EPS);
    GAS u32x2* o8 = (GAS u32x2*)orow + lane;
#pragma unroll
    for (int j = 0; j < 8; ++j) { const f32x4 g = gr[64 * j]; u32x2 w; w.x = cvtpk(v[j].x * r * g.x, v[j].y * r * g.y); w.y = cvtpk(v[j].z * r * g.z, v[j].w * r * g.w); o8[64 * j] = w; }
}

__device__ __forceinline__ void p0_prologue(Frame& F, karg_t ka, unsigned char* ws) {
    const float* x = KIN(ka, 0); const float* mem = KIN(ka, 1); const float* mix_norm = KIN(ka, 2); const float* w_in = KIN(ka, 3);
    const float* w_four = KIN(ka, 6); const float* w_out = KIN(ka, 7); const float* pool_w = KIN(ka, 8); const float* cross_norm = KIN(ka, 10); const float* mem_norm = KIN(ka, 11);
    const int gw = F.vcu * NWAVES + F.wave, NGW = F.G * NWAVES;
    const int p_lane = lane_id(), p_tid = F.wave * 64 + p_lane;
    { LAS float* tab = (LAS float*)(F.lds + RING_OFF);
      for (int m = p_tid; m < 2048; m += 512) tab[m] = cosf(6.283185307179586f * (float)m * (1.0f / 2048.0f));
      __syncthreads();
      bf16_t* DFT = (bf16_t*)(ws + WS_DFT);
      for (int row = F.vcu * 8; row < 2048; row += F.G * 8)
          for (int rr = 0; rr < 8; ++rr) { const int k1 = row + rr; if (k1 >= 2048) break;
              { const int c0 = p_tid * 8; const int which = c0 >> 11, s0 = c0 & 2047; unsigned w[4];
#pragma unroll
                for (int j = 0; j < 4; ++j) { const int ma = (k1 * (s0 + 2 * j)) & 2047, mb = (k1 * (s0 + 2 * j + 1)) & 2047;
                    w[j] = cvtpk(tab[(ma - which * 512) & 2047], tab[(mb - which * 512) & 2047]); }
                *(GAS u32x4*)(DFT + (size_t)k1 * 4096 + c0) = (u32x4){w[0], w[1], w[2], w[3]}; } }
      __syncthreads(); }
    { float* RC = (float*)(ws + WS_ROPE); float* RS = RC + SEQ * 64;
      for (int i = F.vcu * 512 + p_tid; i < SEQ * 64; i += F.G * 512) { const int t = i >> 6, p = i & 63; const int pos = (p < 32) ? (t >> 6) : (t & 63); const int j = p & 31;
          const float inv = 1.0f / powf(10000.0f, (float)(2 * j) / 64.0f); const float ang = (float)pos * inv; RC[i] = cosf(ang); RS[i] = sinf(ang); } }
    { u32x4* RB = (u32x4*)(ws + WS_AFF + 512 * 1024);
      for (int i = F.vcu * 512 + p_tid; i < 2 * 64 * 64; i += F.G * 512) { const int layer = i >> 12, ks = (i >> 6) & 63, ln = i & 63, e = ln & 15, k0 = 32 * ks + 8 * (ln >> 4);
          const float* Wr = KIN(ka, 17) + (size_t)layer * DM * NE; const float* gn = KIN(ka, 16) + layer * DM; float w[8], lo[8];
#pragma unroll
          for (int j = 0; j < 8; ++j) { w[j] = gn[k0 + j] * Wr[(size_t)(k0 + j) * NE + e]; }
          u32x4 hi4 = {cvtpk(w[0], w[1]), cvtpk(w[2], w[3]), cvtpk(w[4], w[5]), cvtpk(w[6], w[7])};
          const unsigned hh[4] = {hi4.x, hi4.y, hi4.z, hi4.w};
#pragma unroll
          for (int j = 0; j < 4; ++j) { lo[2 * j] = w[2 * j] - __uint_as_float(hh[j] << 16); lo[2 * j + 1] = w[2 * j + 1] - __uint_as_float(hh[j] & 0xffff0000u); }
          RB[(size_t)(layer * 2 + 0) * 4096 + ks * 64 + ln] = hi4;
          RB[(size_t)(layer * 2 + 1) * 4096 + ks * 64 + ln] = (u32x4){cvtpk(lo[0], lo[1]), cvtpk(lo[2], lo[3]), cvtpk(lo[4], lo[5]), cvtpk(lo[6], lo[7])}; } }
    { LAS float* Mw = (LAS float*)(F.lds + RING_OFF); LAS float* t128 = Mw + 128 * 32;
      bf16_t* WF = (bf16_t*)(ws + WS_WF_T);
      for (int it = F.vcu; it < 256; it += F.G) {
          const int which = it >> 7, g = (it >> 5) & 3, d0 = ((it >> 3) & 3) * 32, k0 = (it & 7) * 256;
          if (p_tid < 128) t128[p_tid] = cosf(6.283185307179586f * (float)p_tid * (1.0f / 128.0f));
          __syncthreads();
          { const int c = p_tid >> 2, dd = (p_tid & 3) * 8; float o[8] = {0.f, 0.f, 0.f, 0.f, 0.f, 0.f, 0.f, 0.f};
#pragma unroll 16
            for (int k2 = 0; k2 < 128; ++k2) { const int m = (c * k2) & 127; const float tv = which ? -t128[(m - 32) & 127] : t128[m];
                const float* wr_ = w_four + ((size_t)g * 128 + k2) * 128 + d0 + dd; const f32x4 w0 = *(const f32x4*)wr_, w1 = *(const f32x4*)(wr_ + 4);
                o[0] += tv * w0.x; o[1] += tv * w0.y; o[2] += tv * w0.z; o[3] += tv * w0.w; o[4] += tv * w1.x; o[5] += tv * w1.y; o[6] += tv * w1.z; o[7] += tv * w1.w; }
#pragma unroll
            for (int j = 0; j < 8; ++j) Mw[c * 32 + dd + j] = o[j] * (1.0f / 512.0f); }
          __syncthreads();
          { const int kp = p_tid & 127, dq = p_tid >> 7, k = k0 + 2 * kp; float o0[8] = {0.f, 0.f, 0.f, 0.f, 0.f, 0.f, 0.f, 0.f}, o1[8] = {0.f, 0.f, 0.f, 0.f, 0.f, 0.f, 0.f, 0.f};
            const float* r0 = w_in + (size_t)k * INW + 2560 + g * 128; const float* r1 = r0 + INW;
#pragma unroll 8
            for (int c4 = 0; c4 < 32; ++c4) { const f32x4 a = *(const f32x4*)(r0 + 4 * c4), b = *(const f32x4*)(r1 + 4 * c4); const float av[4] = {a.x, a.y, a.z, a.w}, bv[4] = {b.x, b.y, b.z, b.w};
#pragma unroll
                for (int cc = 0; cc < 4; ++cc) { const LAS float* mr = Mw + (4 * c4 + cc) * 32 + dq * 8;
#pragma unroll
                    for (int j = 0; j < 8; ++j) { o0[j] += av[cc] * mr[j]; o1[j] += bv[cc] * mr[j]; } } }
#pragma unroll
            for (int j = 0; j < 8; ++j) *(GAS unsigned*)(WF + (size_t)(which * 512 + g * 128 + d0 + dq * 8 + j) * DM + k) = cvtpk(o0[j], o1[j]); }
          __syncthreads(); } }
    { const int n = (TR_DENSE - gw + NGW - 1) / NGW; tr_span(F, ka, ws, 0, gw, NGW, n > 0 ? n : 0); }
    __syncthreads();
    for (int m = gw; m < NTOK; m += NGW) rms_row_to_bf16(x + (size_t)m * DM, mix_norm, (bf16_t*)(ws + WS_HN) + (size_t)m * DM, p_lane);
    for (int m = gw; m < 2 * NB * MEML; m += NGW) { const int l = m / (NB * MEML), r = m % (NB * MEML);
        rms_row_to_bf16(mem + (size_t)r * DM, mem_norm + l * DM, (bf16_t*)(ws + WS_MEMNB) + (size_t)m * DM, p_lane); }
}

struct MapLin { const char* A; const char* B; size_t as, bs; __device__ __forceinline__ void operator()(pg8::Unit& u) const { u.a = A + (size_t)u.pm * as; u.b = B + (size_t)u.pn * bs; } };

struct EpiQKV {
    static constexpr bool PERM = true;
    bf16_t* Q; bf16_t* K; bf16_t* V; const float* qg; const float* kg; const float* RC; const float* RS;
    __device__ __forceinline__ void operator()(f32x4 (&acc)[2][2][4][2], const pg8::Unit& u, const pg8::EpiCtx& c) const { const int e_lane = lane_id(), e_fr = e_lane & 15, e_fq = e_lane >> 4;
        const int pn = u.pn, hc = c.wc * 32 + e_fq * 8, rl0 = c.wr * 64 + e_fr;
        if (pn >= 8) {
            bf16_t* base = V + (size_t)(u.pm * 256 + rl0) * KVW + (pn - 8) * 256 + hc;
#pragma unroll
            for (int ai = 0; ai < 2; ++ai)
#pragma unroll
                for (int m = 0; m < 4; ++m) { bf16_t* rowp = base + (size_t)(ai * 128 + m * 16) * KVW;
#pragma unroll
                    for (int bj = 0; bj < 2; ++bj) { const f32x4 v0 = acc[ai][bj][m][0], v1 = acc[ai][bj][m][1];
                        st16((rowp + bj * 128), (u32x4){cvtpk(v0.x, v0.y), cvtpk(v0.z, v0.w), cvtpk(v1.x, v1.y), cvtpk(v1.z, v1.w)}); } }
            return;
        }
        LAS float* part = (LAS float*)c.xl;
#pragma unroll
        for (int ai = 0; ai < 2; ++ai)
#pragma unroll
            for (int m = 0; m < 4; ++m)
#pragma unroll
                for (int bj = 0; bj < 2; ++bj) { const f32x4 v0 = acc[ai][bj][m][0], v1 = acc[ai][bj][m][1];
                    float s = (v0.x * v0.x + v0.y * v0.y) + (v0.z * v0.z + v0.w * v0.w) + (v1.x * v1.x + v1.y * v1.y) + (v1.z * v1.z + v1.w * v1.w);
                    s += __shfl_xor(s, 16); s += __shfl_xor(s, 32);
                    if (e_fq == 0) part[((ai * 128 + rl0 + m * 16) * 2 + bj) * 4 + c.wc] = s; }
        WG_BAR();
        const float* gain = pn < 6 ? qg : kg;
        const f32x4 g0 = *(const f32x4*)(gain + hc), g1 = *(const f32x4*)(gain + hc + 4);
        bf16_t* O = pn < 6 ? Q : K; const int ld = pn < 6 ? AW : KVW; const int colbase = (pn < 6 ? pn : pn - 6) * 256 + hc;
#pragma unroll
        for (int ai = 0; ai < 2; ++ai)
#pragma unroll
            for (int m = 0; m < 4; ++m) { const int rl = ai * 128 + rl0 + m * 16, row = u.pm * 256 + rl, sp = row & (SEQ - 1);
                const f32x4 cs = *(const f32x4*)(RC + sp * 64 + (hc >> 1)), sn = *(const f32x4*)(RS + sp * 64 + (hc >> 1));
#pragma unroll
                for (int bj = 0; bj < 2; ++bj) { const f32x4 p4 = *(const LAS f32x4*)(part + (rl * 2 + bj) * 4);
                    const float r = rsqrtf(((p4.x + p4.y) + (p4.z + p4.w)) * (1.0f / 128.0f) + EPS);
                    const f32x4 v0 = acc[ai][bj][m][0] * r * g0, v1 = acc[ai][bj][m][1] * r * g1;
                    u32x4 w; w.x = cvtpk(v0.x * cs.x - v0.y * sn.x, v0.x * sn.x + v0.y * cs.x); w.y = cvtpk(v0.z * cs.y - v0.w * sn.y, v0.z * sn.y + v0.w * cs.y);
                    w.z = cvtpk(v1.x * cs.z - v1.y * sn.z, v1.x * sn.z + v1.y * cs.z); w.w = cvtpk(v1.z * cs.w - v1.w * sn.w, v1.z * sn.w + v1.w * cs.w);
                    st16((O + (size_t)row * ld + colbase + bj * 128), w); } }
    }
};


template <class AddrF> struct EpiStore {
    static constexpr bool PERM = true; AddrF f;
    __device__ __forceinline__ void operator()(f32x4 (&acc)[2][2][4][2], const pg8::Unit& u, const pg8::EpiCtx& c) const { const int e_lane = lane_id(), e_fr = e_lane & 15, e_fq = e_lane >> 4;
        const int hc = c.wc * 32 + e_fq * 8, rl0 = c.wr * 64 + e_fr;
#pragma unroll
        for (int ai = 0; ai < 2; ++ai)
#pragma unroll
            for (int m = 0; m < 4; ++m)
#pragma unroll
                for (int bj = 0; bj < 2; ++bj) { const f32x4 v0 = acc[ai][bj][m][0], v1 = acc[ai][bj][m][1];
                    st16(f(u, ai * 128 + rl0 + m * 16, bj * 128 + hc), (u32x4){cvtpk(v0.x, v0.y), cvtpk(v0.z, v0.w), cvtpk(v1.x, v1.y), cvtpk(v1.z, v1.w)}); }
    }
};
struct AddrF1 { bf16_t* FPQ; __device__ __forceinline__ bf16_t* operator()(const pg8::Unit& u, int rl, int tc) const {
    const int r = u.pm * 256 + rl, which = r >> 9, n = r & 511, cidx = u.pn * 256 + tc, b = cidx >> 11, s = cidx & 2047; return FPQ + (((size_t)(b * 512 + n) * 2 + which) * 2048 + s); } };
struct AddrF2 { bf16_t* MIX; __device__ __forceinline__ bf16_t* operator()(const pg8::Unit& u, int rl, int tc) const {
    const int row = (u.pn >> 1) * 2048 + u.pm * 256 + rl, col = AW + (u.pn & 1) * 256 + tc; return MIX + (size_t)row * DM + col; } };

template <bool BF32> struct EpiResB {
    static constexpr bool PERM = true;
    const void* base; bf16_t* xo; float* ssp; const float* cscale;
    __device__ __forceinline__ void operator()(f32x4 (&acc)[2][2][4][2], const pg8::Unit& u, const pg8::EpiCtx& c) const { const int e_lane = lane_id(), e_fr = e_lane & 15, e_fq = e_lane >> 4;
        const int hc = c.wc * 32 + e_fq * 8, rl0 = c.wr * 64 + e_fr;
        LAS float* part = (LAS float*)c.xl;
#pragma unroll
        for (int ai = 0; ai < 2; ++ai) {
            f32x4 bf0[4][2], bf1[4][2]; u32x4 bb[4][2];
#pragma unroll
            for (int m = 0; m < 4; ++m)
#pragma unroll
                for (int bj = 0; bj < 2; ++bj) { const size_t off = (size_t)(u.pm * 256 + ai * 128 + rl0 + m * 16) * DM + u.pn * 256 + bj * 128 + hc;
                    if (BF32) { bf0[m][bj] = *(const f32x4*)((const float*)base + off); bf1[m][bj] = *(const f32x4*)((const float*)base + off + 4); }
                    else bb[m][bj] = *(const u32x4*)((const bf16_t*)base + off); }
#pragma unroll
            for (int m = 0; m < 4; ++m) { const int rl = ai * 128 + rl0 + m * 16; float s = 0.f;
#pragma unroll
                for (int bj = 0; bj < 2; ++bj) { const int col = u.pn * 256 + bj * 128 + hc; const size_t off = (size_t)(u.pm * 256 + rl) * DM + col;
                    f32x4 v0 = acc[ai][bj][m][0], v1 = acc[ai][bj][m][1];
                    if (cscale) { v0 = v0 * *(const f32x4*)(cscale + col); v1 = v1 * *(const f32x4*)(cscale + col + 4); }
                    if (BF32) { v0 = v0 + bf0[m][bj]; v1 = v1 + bf1[m][bj]; }
                    else { const u32x4 b = bb[m][bj];
                        v0.x += __uint_as_float(b.x << 16); v0.y += __uint_as_float(b.x & 0xffff0000u); v0.z += __uint_as_float(b.y << 16); v0.w += __uint_as_float(b.y & 0xffff0000u);
                        v1.x += __uint_as_float(b.z << 16); v1.y += __uint_as_float(b.z & 0xffff0000u); v1.z += __uint_as_float(b.w << 16); v1.w += __uint_as_float(b.w & 0xffff0000u); }
                    st16((xo + off), (u32x4){cvtpk(v0.x, v0.y), cvtpk(v0.z, v0.w), cvtpk(v1.x, v1.y), cvtpk(v1.z, v1.w)});
                    if (ssp) s += ((v0.x * v0.x + v0.y * v0.y) + (v0.z * v0.z + v0.w * v0.w)) + ((v1.x * v1.x + v1.y * v1.y) + (v1.z * v1.z + v1.w * v1.w)); }
                if (ssp) { s += __shfl_xor(s, 16); s += __shfl_xor(s, 32); if (e_fq == 0) part[rl * 4 + c.wc] = s; } }
            asm volatile("" ::: "memory"); }
        if (ssp) { WG_BAR();
            if (e_lane < 32) { const int row = c.wid * 32 + e_lane; const f32x4 p4 = *(const LAS f32x4*)(part + row * 4);
                ssp[(size_t)(u.pm * 256 + row) * 8 + u.pn] = (p4.x + p4.y) + (p4.z + p4.w); }
            WG_BAR(); }
    }
};

namespace attn {
using s16x4 = __attribute__((ext_vector_type(4))) short;
using f32x16 = __attribute__((ext_vector_type(16))) float;
constexpr int D = 128, NW = 8, QBLK = 32, KVBLK = 64;
constexpr float SCALE = 0.088388347648318440f;
constexpr float THR = 0.f;
#ifndef ATT_SDEPTH
#define ATT_SDEPTH 1
#endif
constexpr int LDQ = AW, LDK = KVW, LDO = DM;
constexpr size_t SHM_V = KVBLK * D * 2, SHM_K = KVBLK * D * 2, SHM_ATTN = 2 * SHM_V + 2 * SHM_K + NW * 64 * 4;
#define KSWZ(row, colB) ((row) * 256 + ((colB) ^ (((row) & 7) << 4)))
#define SBAR() __builtin_amdgcn_sched_barrier(0)
__device__ __forceinline__ int crow(int r, int hi) { return (r & 3) + 8 * (r >> 2) + 4 * hi; }
__device__ __forceinline__ unsigned cvtpk_a(float lo, float hi) { unsigned r; asm volatile("v_cvt_pk_bf16_f32 %0, %1, %2" : "=v"(r) : "v"(lo), "v"(hi)); return r; }
__device__ __forceinline__ void partialSM(f32x16& p0, f32x16& p1, float& m_reg, float& mn, float& alpha) {
  constexpr float C = SCALE * 1.4426950408889634f;
  float pmax = p0[0]; for (int r = 1; r < 16; ++r) pmax = fmaxf(pmax, p0[r]); for (int r = 0; r < 16; ++r) pmax = fmaxf(pmax, p1[r]);
  { auto rr = __builtin_amdgcn_permlane32_swap(__float_as_uint(pmax), __float_as_uint(pmax), false, false);
    pmax = fmaxf(__uint_as_float(rr[0]), __uint_as_float(rr[1])); }
  if (__builtin_expect(__all(pmax - m_reg <= THR / SCALE), 1)) { mn = m_reg; alpha = 1.f; }
  else { mn = fmaxf(m_reg, pmax); alpha = __builtin_amdgcn_exp2f((m_reg - mn) * C); m_reg = mn; }
  float mnC = -mn * C;
  for (int r = 0; r < 16; ++r) p0[r] = fmaf(p0[r], C, mnC); for (int r = 0; r < 16; ++r) p1[r] = fmaf(p1[r], C, mnC);
  for (int r = 0; r < 16; ++r) p0[r] = __builtin_amdgcn_exp2f(p0[r]);
}
__device__ __forceinline__ void finishSM(f32x16& p0, f32x16& p1, float alpha, float& l_reg, bf16x8& pa0, bf16x8& pa1, bf16x8& pa2, bf16x8& pa3) {
  for (int r = 0; r < 16; ++r) p1[r] = __builtin_amdgcn_exp2f(p1[r]);
  float ps = 0; for (int r = 0; r < 16; ++r) ps += p0[r]; for (int r = 0; r < 16; ++r) ps += p1[r];
  { auto rr = __builtin_amdgcn_permlane32_swap(__float_as_uint(ps), __float_as_uint(ps), false, false);
    ps = __uint_as_float(rr[0]) + __uint_as_float(rr[1]); }
  l_reg = l_reg * alpha + ps;
#define PK4(P, BASE, OUT) do { unsigned a0 = cvtpk_a(P[BASE + 0], P[BASE + 1]), a1 = cvtpk_a(P[BASE + 2], P[BASE + 3]);   \
    unsigned b0 = cvtpk_a(P[BASE + 4], P[BASE + 5]), b1 = cvtpk_a(P[BASE + 6], P[BASE + 7]);                              \
    auto r0 = __builtin_amdgcn_permlane32_swap(a0, b0, false, false); auto r1 = __builtin_amdgcn_permlane32_swap(a1, b1, false, false); \
    u32x4 w = {r0[0], r1[0], r0[1], r1[1]}; OUT = *reinterpret_cast<bf16x8*>(&w); } while (0)
  PK4(p0, 0, pa0); PK4(p0, 8, pa1); PK4(p1, 0, pa2); PK4(p1, 8, pa3);
#undef PK4
}
__device__ __forceinline__ void qkt(f32x16& p0, f32x16& p1, const bf16_t* Ks, const bf16x8* qr, int r32, int hi) {
  p0 = f32x16{}; p1 = f32x16{};
  for (int d0 = 0; d0 < 8; ++d0) { int cb = (d0 * 16 + hi * 8) * 2;
    bf16x8 b0 = *reinterpret_cast<const bf16x8*>((const char*)Ks + KSWZ(r32, cb));
    bf16x8 b1 = *reinterpret_cast<const bf16x8*>((const char*)Ks + KSWZ(32 + r32, cb));
    p0 = __builtin_amdgcn_mfma_f32_32x32x16_bf16(b0, qr[d0], p0, 0, 0, 0);
    p1 = __builtin_amdgcn_mfma_f32_32x32x16_bf16(b1, qr[d0], p1, 0, 0, 0); }
}
__device__ __forceinline__ int v_st(int k, int c) { const int kk = (k & ~0xC) | ((k & 4) << 1) | ((k & 8) >> 1); return ((kk >> 3) * 4 + (c >> 5)) * 512 + ((kk & 7) * 32 + (c & 31)) * 2; }
__device__ __forceinline__ int v_rd_base(int lane) { return ((lane & 3) << 3) | (((lane >> 2) & 3) << 6) | (((lane >> 4) & 1) << 5) | (((lane >> 5) & 1) << 8); }
constexpr int v_rd_off(int d0, int ks, int half) { return d0 * 512 + ks * 4096 + half * 2048; }
template <int OFF> __device__ __forceinline__ s16x4 tr_read(int vb) {
  s16x4 r; asm volatile("ds_read_b64_tr_b16 %0, %1 offset:%2" : "=&v"(r) : "v"(vb), "i"(OFF) : "memory"); return r;
}
template <int D0> __device__ __forceinline__ void pv_one(f32x16& od, int vb, bf16x8 pa0, bf16x8 pa1, bf16x8 pa2, bf16x8 pa3) {
  const s16x4 l0 = tr_read<v_rd_off(D0, 0, 0)>(vb), h0 = tr_read<v_rd_off(D0, 0, 1)>(vb), l1 = tr_read<v_rd_off(D0, 1, 0)>(vb), h1 = tr_read<v_rd_off(D0, 1, 1)>(vb);
  const s16x4 l2 = tr_read<v_rd_off(D0, 2, 0)>(vb), h2 = tr_read<v_rd_off(D0, 2, 1)>(vb), l3 = tr_read<v_rd_off(D0, 3, 0)>(vb), h3 = tr_read<v_rd_off(D0, 3, 1)>(vb);
  asm volatile("s_waitcnt lgkmcnt(0)" ::: "memory"); SBAR();
#define PK(L, H) (bf16x8){L[0], L[1], L[2], L[3], H[0], H[1], H[2], H[3]}
  od = __builtin_amdgcn_mfma_f32_32x32x16_bf16(pa0, PK(l0, h0), od, 0, 0, 0);
  od = __builtin_amdgcn_mfma_f32_32x32x16_bf16(pa1, PK(l1, h1), od, 0, 0, 0);
  od = __builtin_amdgcn_mfma_f32_32x32x16_bf16(pa2, PK(l2, h2), od, 0, 0, 0);
  od = __builtin_amdgcn_mfma_f32_32x32x16_bf16(pa3, PK(l3, h3), od, 0, 0, 0);
#undef PK
}
__device__ __forceinline__ void pv_d0(f32x16* o, int vb, bf16x8 pa0, bf16x8 pa1, bf16x8 pa2, bf16x8 pa3) {
  pv_one<0>(o[0], vb, pa0, pa1, pa2, pa3); pv_one<1>(o[1], vb, pa0, pa1, pa2, pa3); pv_one<2>(o[2], vb, pa0, pa1, pa2, pa3); pv_one<3>(o[3], vb, pa0, pa1, pa2, pa3);
}
__device__ __forceinline__ void attn_dense_body(const bf16_t* __restrict__ Qb, const bf16_t* __restrict__ Kh, const bf16_t* __restrict__ Vh,
                                                bf16_t* __restrict__ Ob, int seq, char* lds, const int wave_) {
  constexpr int SDEPTH = ATT_SDEPTH;
  const int lane = lane_id(), wid = wave_, tid = wid * 64 + lane, r32 = lane & 31, hi = lane >> 5;
  bf16_t* V_lds = (bf16_t*)lds; bf16_t* K_lds = (bf16_t*)(lds + 2 * SHM_V);
  float* ws = (float*)(lds + 2 * SHM_V + 2 * SHM_K) + wid * 64; float* li_l = ws; float* al_l = ws + 32;
  float m_reg = -1e30f, l_reg = 0; f32x16 o[4] = {}; bf16x8 qr[8];
  const bf16_t* Qw = Qb + (long)(wid * QBLK + r32) * LDQ + hi * 8;
#pragma unroll
  for (int d0 = 0; d0 < 8; ++d0) qr[d0] = *reinterpret_cast<const bf16x8*>(Qw + d0 * 16);
  const int sr = tid >> 4, sc = (tid & 15) * 8, vst0 = v_st(sr, sc), vst1 = v_st(32 + sr, sc);
  const int vb0 = (int)(uintptr_t)V_lds + v_rd_base(lane);
  struct { bf16x8 vs0, vs1, ks0, ks1; } sr_[SDEPTH];
#define SLOAD(i, k0) do { sr_[i].vs0 = *reinterpret_cast<const bf16x8*>(&Vh[(long)((k0) + sr) * LDK + sc]); sr_[i].vs1 = *reinterpret_cast<const bf16x8*>(&Vh[(long)((k0) + 32 + sr) * LDK + sc]); \
    sr_[i].ks0 = *reinterpret_cast<const bf16x8*>(&Kh[(long)((k0) + sr) * LDK + sc]); sr_[i].ks1 = *reinterpret_cast<const bf16x8*>(&Kh[(long)((k0) + 32 + sr) * LDK + sc]); } while (0)
#define SWRITE(b, i) do { *(bf16x8*)((char*)V_lds + (b) * SHM_V + vst0) = sr_[i].vs0;          \
    *(bf16x8*)((char*)V_lds + (b) * SHM_V + vst1) = sr_[i].vs1; int kc = sc * 2;               \
    *(bf16x8*)((char*)K_lds + (b) * SHM_K + KSWZ(sr, kc)) = sr_[i].ks0;                       \
    *(bf16x8*)((char*)K_lds + (b) * SHM_K + KSWZ(32 + sr, kc)) = sr_[i].ks1; } while (0)
#define SWAIT() do { if constexpr (SDEPTH == 2) asm volatile("s_waitcnt vmcnt(4)" ::: "memory"); else asm volatile("s_waitcnt vmcnt(0)" ::: "memory"); } while (0)
#define RESC(a) do { if (__any((a) < 1.f)) { if (hi == 0) al_l[r32] = (a); asm volatile("s_waitcnt lgkmcnt(0)" ::: "memory"); \
    for (int d = 0; d < 4; ++d) for (int r = 0; r < 16; ++r) o[d][r] *= al_l[crow(r, hi)]; } } while (0)
  f32x16 pA0, pA1, pB0, pB1; float mnA, mnB, alA, alB; bf16x8 pa0, pa1, pa2, pa3; const int NT = seq / KVBLK;
  constexpr int SE = 0, SO = SDEPTH - 1;
  SLOAD(SE, 0); asm volatile("s_waitcnt vmcnt(0)" ::: "memory"); SWRITE(0, SE); __syncthreads();
  qkt(pA0, pA1, K_lds, qr, r32, hi); partialSM(pA0, pA1, m_reg, mnA, alA);
  SLOAD(SO, KVBLK); if constexpr (SDEPTH == 2) { if (2 < NT) SLOAD(SE, 2 * KVBLK); }
  SWAIT(); SWRITE(1, SO); __syncthreads();
  for (int j = 1; j + 1 < NT; j += 2) {
    SBAR(); qkt(pB0, pB1, (bf16_t*)((char*)K_lds + SHM_K), qr, r32, hi);
    finishSM(pA0, pA1, alA, l_reg, pa0, pa1, pa2, pa3); SBAR();
    SLOAD(SO, (j + SDEPTH) * KVBLK); SBAR();
    pv_d0(o, vb0, pa0, pa1, pa2, pa3); partialSM(pB0, pB1, m_reg, mnB, alB);
    __syncthreads(); SWAIT(); SWRITE(0, SE);
    RESC(alB); __syncthreads();
    SBAR(); qkt(pA0, pA1, K_lds, qr, r32, hi);
    finishSM(pB0, pB1, alB, l_reg, pa0, pa1, pa2, pa3); SBAR();
    if (SDEPTH == 1 || j + 3 < NT) SLOAD(SE, (j + 1 + SDEPTH) * KVBLK); SBAR();
    pv_d0(o, vb0 + (int)SHM_V, pa0, pa1, pa2, pa3); partialSM(pA0, pA1, m_reg, mnA, alA);
    __syncthreads(); SWAIT(); SWRITE(1, SO);
    RESC(alA); __syncthreads();
  }
  SBAR(); qkt(pB0, pB1, (bf16_t*)((char*)K_lds + SHM_K), qr, r32, hi);
  finishSM(pA0, pA1, alA, l_reg, pa0, pa1, pa2, pa3); SBAR();
  pv_d0(o, vb0, pa0, pa1, pa2, pa3); partialSM(pB0, pB1, m_reg, mnB, alB);
  __syncthreads(); RESC(alB);
  finishSM(pB0, pB1, alB, l_reg, pa0, pa1, pa2, pa3); SBAR();
  pv_d0(o, vb0 + (int)SHM_V, pa0, pa1, pa2, pa3);
  if (hi == 0) li_l[r32] = l_reg; asm volatile("s_waitcnt lgkmcnt(0)" ::: "memory");
  float rli[16];
#pragma unroll
  for (int r = 0; r < 16; ++r) rli[r] = __builtin_amdgcn_rcpf(li_l[crow(r, hi)]);
  bf16_t* Ow = Ob + (long)(wid * QBLK) * LDO;
#pragma unroll
  for (int r = 0; r < 16; ++r) { int orow = crow(r, hi);
    for (int d0 = 0; d0 < 4; ++d0) Ow[(long)orow * LDO + d0 * 32 + r32] = (bf16_t)(cvtpk(o[d0][r] * rli[r], 0.f) & 0xffffu); }
#undef SLOAD
#undef SWRITE
#undef SWAIT
#undef RESC
  __syncthreads();
}
#undef KSWZ
#undef SBAR
}

struct AddrLin { bf16_t* O; int ld; __device__ __forceinline__ bf16_t* operator()(const pg8::Unit& u, int rl, int tc) const { return O + (size_t)(u.pm * 256 + rl) * ld + u.pn * 256 + tc; } };
struct EpiRowScale {
    static constexpr bool PERM = true; bf16_t* O; int ld; const float* ssp; float cscale;
    __device__ __forceinline__ void operator()(f32x4 (&acc)[2][2][4][2], const pg8::Unit& u, const pg8::EpiCtx& c) const { const int e_lane = lane_id(), e_fr = e_lane & 15, e_fq = e_lane >> 4;
        const int hc = c.wc * 32 + e_fq * 8, rl0 = c.wr * 64 + e_fr;
#pragma unroll
        for (int ai = 0; ai < 2; ++ai)
#pragma unroll
            for (int m = 0; m < 4; ++m) { const int row = u.pm * 256 + ai * 128 + rl0 + m * 16; const f32x4 p0 = *(const f32x4*)(ssp + (size_t)row * 8), p1 = *(const f32x4*)(ssp + (size_t)row * 8 + 4);
                const float r = rsqrtf((((p0.x + p0.y) + (p0.z + p0.w)) + ((p1.x + p1.y) + (p1.z + p1.w))) * (1.0f / DM) + EPS) * cscale;
#pragma unroll
                for (int bj = 0; bj < 2; ++bj) { const f32x4 v0 = acc[ai][bj][m][0] * r, v1 = acc[ai][bj][m][1] * r;
                    st16((O + (size_t)row * ld + u.pn * 256 + bj * 128 + hc), (u32x4){cvtpk(v0.x, v0.y), cvtpk(v0.z, v0.w), cvtpk(v1.x, v1.y), cvtpk(v1.z, v1.w)}); } }
    }
};
struct EpiSoftmax {
    static constexpr bool PERM = true; bf16_t* P; int ld;
    __device__ __forceinline__ void operator()(f32x4 (&acc)[2][2][4][2], const pg8::Unit& u, const pg8::EpiCtx& c) const { const int e_lane = lane_id(), e_fr = e_lane & 15, e_fq = e_lane >> 4;
        const int hc = c.wc * 32 + e_fq * 8, rl0 = c.wr * 64 + e_fr;
        LAS float* pmx = (LAS float*)c.xl; LAS float* psm = pmx + 1024;
#pragma unroll
        for (int ai = 0; ai < 2; ++ai)
#pragma unroll
            for (int m = 0; m < 4; ++m) { float mx = -3.0e38f;
#pragma unroll
                for (int bj = 0; bj < 2; ++bj)
#pragma unroll
                    for (int n = 0; n < 2; ++n) { const f32x4 v = acc[ai][bj][m][n]; mx = fmaxf(fmaxf(mx, fmaxf(v.x, v.y)), fmaxf(v.z, v.w)); }
                mx = fmaxf(mx, __shfl_xor(mx, 16)); mx = fmaxf(mx, __shfl_xor(mx, 32));
                if (e_fq == 0) pmx[(ai * 128 + rl0 + m * 16) * 4 + c.wc] = mx; }
        WG_BAR();
#pragma unroll
        for (int ai = 0; ai < 2; ++ai)
#pragma unroll
            for (int m = 0; m < 4; ++m) { const int rl = ai * 128 + rl0 + m * 16; const f32x4 p4 = *(const LAS f32x4*)(pmx + rl * 4);
                const float mx = fmaxf(fmaxf(p4.x, p4.y), fmaxf(p4.z, p4.w)) * 1.4426950408889634f; float s = 0.f;
#pragma unroll
                for (int bj = 0; bj < 2; ++bj)
#pragma unroll
                    for (int n = 0; n < 2; ++n) { f32x4 v = acc[ai][bj][m][n];
                        v.x = __builtin_amdgcn_exp2f(fmaf(v.x, 1.4426950408889634f, -mx)); v.y = __builtin_amdgcn_exp2f(fmaf(v.y, 1.4426950408889634f, -mx));
                        v.z = __builtin_amdgcn_exp2f(fmaf(v.z, 1.4426950408889634f, -mx)); v.w = __builtin_amdgcn_exp2f(fmaf(v.w, 1.4426950408889634f, -mx));
                        s += (v.x + v.y) + (v.z + v.w); acc[ai][bj][m][n] = v; }
                s += __shfl_xor(s, 16); s += __shfl_xor(s, 32);
                if (e_fq == 0) psm[rl * 4 + c.wc] = s; }
        WG_BAR();
#pragma unroll
        for (int ai = 0; ai < 2; ++ai)
#pragma unroll
            for (int m = 0; m < 4; ++m) { const int rl = ai * 128 + rl0 + m * 16; const f32x4 p4 = *(const LAS f32x4*)(psm + rl * 4);
                const float inv = 1.0f / ((p4.x + p4.y) + (p4.z + p4.w));
#pragma unroll
                for (int bj = 0; bj < 2; ++bj) { const f32x4 v0 = acc[ai][bj][m][0] * inv, v1 = acc[ai][bj][m][1] * inv;
                    st16((P + (size_t)(u.pm * 256 + rl) * ld + u.pn * 256 + bj * 128 + hc), (u32x4){cvtpk(v0.x, v0.y), cvtpk(v0.z, v0.w), cvtpk(v1.x, v1.y), cvtpk(v1.z, v1.w)}); } }
        WG_BAR();
    }
};
struct MapXS { const char* Q; const char* K; __device__ __forceinline__ void operator()(pg8::Unit& u) const {
    u.a = Q + ((size_t)u.pm * 256 * DM + (size_t)u.pn * MHD) * 2; u.b = K + ((size_t)(u.pm >> 3) * MEML * DM + (size_t)u.pn * MHD) * 2; } };
struct SchedPair { pg8::Unit ua, ub; __device__ __forceinline__ bool next(int i, pg8::Unit& o) const { if (i >= 2) return false; o.pm = i ? ub.pm : ua.pm; o.pn = i ? ub.pn : ua.pn; o.a = i ? ub.a : ua.a; o.b = i ? ub.b : ua.b; asm volatile("" : "+s"(o.a), "+s"(o.b));     return true; } };
struct MapXPV { const char* P; const char* VT; __device__ __forceinline__ void operator()(pg8::Unit& u) const {
    u.a = P + ((size_t)u.pm * 256 * 1024 + (size_t)(u.pn >> 1) * MEML) * 2; u.b = VT + ((size_t)u.pn * 256 * 1024 + (size_t)(u.pm >> 3) * MEML) * 2; } };

struct MapMoE { const char* A; const char* W; size_t as, es, ws_; __device__ __forceinline__ void operator()(pg8::Unit& u) const {
    u.a = A + (size_t)u.pm * as; u.b = W + (size_t)(u.pm >> 2) * es + (size_t)u.pn * ws_; } };
struct EpiSwiGLU {
    static constexpr bool PERM = true; bf16_t* ACT; const float* rs;
    __device__ __forceinline__ void operator()(f32x4 (&acc)[2][2][4][2], const pg8::Unit& u, const pg8::EpiCtx& c) const { const int e_lane = lane_id(), e_fr = e_lane & 15, e_fq = e_lane >> 4;
        const int hc = c.wc * 32 + e_fq * 8, rl0 = c.wr * 64 + e_fr;
#pragma unroll
        for (int ai = 0; ai < 2; ++ai)
#pragma unroll
            for (int m = 0; m < 4; ++m) { f32x4 o[2]; const float rf = rs[u.pm * 256 + ai * 128 + rl0 + m * 16];
#pragma unroll
                for (int n = 0; n < 2; ++n) { const f32x4 g = acc[ai][0][m][n] * rf, up = acc[ai][1][m][n] * rf; f32x4 r;
                    r.x = g.x * __builtin_amdgcn_rcpf(1.0f + __builtin_amdgcn_exp2f(-1.4426950408889634f * g.x)) * up.x; r.y = g.y * __builtin_amdgcn_rcpf(1.0f + __builtin_amdgcn_exp2f(-1.4426950408889634f * g.y)) * up.y;
                    r.z = g.z * __builtin_amdgcn_rcpf(1.0f + __builtin_amdgcn_exp2f(-1.4426950408889634f * g.z)) * up.z; r.w = g.w * __builtin_amdgcn_rcpf(1.0f + __builtin_amdgcn_exp2f(-1.4426950408889634f * g.w)) * up.w; o[n] = r; }
                st16((ACT + (size_t)(u.pm * 256 + ai * 128 + rl0 + m * 16) * EFF + u.pn * 128 + hc), (u32x4){cvtpk(o[0].x, o[0].y), cvtpk(o[0].z, o[0].w), cvtpk(o[1].x, o[1].y), cvtpk(o[1].z, o[1].w)}); }
    }
};
struct EpiRowGate {
    static constexpr bool PERM = true; bf16_t* Y; const float* gate;
    __device__ __forceinline__ void operator()(f32x4 (&acc)[2][2][4][2], const pg8::Unit& u, const pg8::EpiCtx& c) const { const int e_lane = lane_id(), e_fr = e_lane & 15, e_fq = e_lane >> 4;
        const int hc = c.wc * 32 + e_fq * 8, rl0 = c.wr * 64 + e_fr;
#pragma unroll
        for (int ai = 0; ai < 2; ++ai)
#pragma unroll
            for (int m = 0; m < 4; ++m) { const int row = u.pm * 256 + ai * 128 + rl0 + m * 16; const float gt = gate[row];
#pragma unroll
                for (int bj = 0; bj < 2; ++bj) { const f32x4 v0 = acc[ai][bj][m][0] * gt, v1 = acc[ai][bj][m][1] * gt;
                    st16((Y + (size_t)row * DM + u.pn * 256 + bj * 128 + hc), (u32x4){cvtpk(v0.x, v0.y), cvtpk(v0.z, v0.w), cvtpk(v1.x, v1.y), cvtpk(v1.z, v1.w)}); } }
    }
};
__device__ __forceinline__ float rms_row_to_bf16_r(const float* xrow, const float* __restrict__ gain, bf16_t* orow, int lane) {
    const GAS f32x4* xr = (const GAS f32x4*)xrow + lane; const f32x4* gr = (const f32x4*)gain + lane;
    f32x4 v[8]; float s = 0.f;
#pragma unroll
    for (int j = 0; j < 8; ++j) { v[j] = xr[64 * j]; s += (v[j].x * v[j].x + v[j].y * v[j].y) + (v[j].z * v[j].z + v[j].w * v[j].w); }
    const float r = rsqrtf(wave_sum(s) * (1.f / DM) + EPS);
    GAS u32x2* o8 = (GAS u32x2*)orow + lane;
#pragma unroll
    for (int j = 0; j < 8; ++j) { const f32x4 g = gr[64 * j]; u32x2 w; w.x = cvtpk(v[j].x * r * g.x, v[j].y * r * g.y); w.y = cvtpk(v[j].z * r * g.z, v[j].w * r * g.w); o8[64 * j] = w; }
    return r;
}
__device__ __forceinline__ void router_phase(const Frame& F, const bf16_t* x, const u32x4* RBl, float* rrow, float* aff, LAS unsigned char* xl) {
    const int lane = lane_id(), tid = F.wave * 64 + lane;
    LAS u32x4* Bl = (LAS u32x4*)(F.lds + RING_OFF);
    for (int i = tid; i < 2 * 4096; i += 512) Bl[i] = RBl[i];
    __syncthreads();
    LAS float* red = (LAS float*)xl;
    LAS float* ssq = (LAS float*)(xl + 8192);
    const int rg = F.wave >> 2, kq = F.wave & 3, r16 = lane & 15, kg = lane >> 4;
    for (int rb = (int)blockIdx.x * 32; rb < NTOK; rb += F.G * 32) {
        const bf16_t* xr = x + (size_t)(rb + rg * 16 + r16) * DM + kq * 512 + kg * 8;
        bf16x8 a[16];
#pragma unroll
        for (int s = 0; s < 16; ++s) a[s] = *(const GAS bf16x8*)(xr + 32 * s);
        f32x4 acc = {0.f, 0.f, 0.f, 0.f}; float sq = 0.f;
#pragma unroll
        for (int s = 0; s < 16; ++s) { const int ks = kq * 16 + s;
            const bf16x8 bh = __builtin_bit_cast(bf16x8, Bl[ks * 64 + lane]), bl = __builtin_bit_cast(bf16x8, Bl[4096 + ks * 64 + lane]);
            acc = __builtin_amdgcn_mfma_f32_16x16x32_bf16(a[s], bh, acc, 0, 0, 0);
            acc = __builtin_amdgcn_mfma_f32_16x16x32_bf16(a[s], bl, acc, 0, 0, 0);
            const u32x4 av = __builtin_bit_cast(u32x4, a[s]);
            const float f0 = __uint_as_float(av.x << 16), f1 = __uint_as_float(av.x & 0xffff0000u), f2 = __uint_as_float(av.y << 16), f3 = __uint_as_float(av.y & 0xffff0000u);
            const float f4 = __uint_as_float(av.z << 16), f5 = __uint_as_float(av.z & 0xffff0000u), f6 = __uint_as_float(av.w << 16), f7 = __uint_as_float(av.w & 0xffff0000u);
            sq += ((f0 * f0 + f1 * f1) + (f2 * f2 + f3 * f3)) + ((f4 * f4 + f5 * f5) + (f6 * f6 + f7 * f7)); }
        sq += __shfl_xor(sq, 16); sq += __shfl_xor(sq, 32);
        *(LAS f32x4*)(red + ((rg * 4 + kq) * 64 + lane) * 4) = acc;
        if (kg == 0) ssq[(rg * 4 + kq) * 16 + r16] = sq;
        __syncthreads();
        if (kq == 0) {
            f32x4 t = *(const LAS f32x4*)(red + ((rg * 4 + 0) * 64 + lane) * 4);
#pragma unroll
            for (int q = 1; q < 4; ++q) t = t + *(const LAS f32x4*)(red + ((rg * 4 + q) * 64 + lane) * 4);
            const float lg[4] = {t.x, t.y, t.z, t.w};
#pragma unroll
            for (int i = 0; i < 4; ++i) { const int rr = 4 * kg + i; const float ss = (ssq[(rg * 4 + 0) * 16 + rr] + ssq[(rg * 4 + 1) * 16 + rr]) + (ssq[(rg * 4 + 2) * 16 + rr] + ssq[(rg * 4 + 3) * 16 + rr]);
                const float r = rsqrtf(ss * (1.f / DM) + EPS); const int row = rb + rg * 16 + rr;
                const float v = lg[i] * r; float mx = v;
                mx = fmaxf(mx, __shfl_xor(mx, 8)); mx = fmaxf(mx, __shfl_xor(mx, 4)); mx = fmaxf(mx, __shfl_xor(mx, 2)); mx = fmaxf(mx, __shfl_xor(mx, 1));
                const float ex = expf(v - mx); float sm = ex;
                sm += __shfl_xor(sm, 8); sm += __shfl_xor(sm, 4); sm += __shfl_xor(sm, 2); sm += __shfl_xor(sm, 1);
                const int b = row / SEQ, tt = row % SEQ; aff[((size_t)b * NE + r16) * SEQ + tt] = ex / sm;
                if (r16 == 0) rrow[row] = r; }
        }
        __syncthreads();
    }
}
__device__ __forceinline__ void rank_phase(const Frame& F, const float* aff, int* rank, float* gate, const float* rrow, float* rs, int* gidx) {
    const int lane = lane_id(), tid = F.wave * 64 + lane;
    LAS unsigned* wc = (LAS unsigned*)(F.lds + RING_OFF);
    LAS unsigned* ck = (LAS unsigned*)(F.lds + RING_OFF + 256);
    LAS unsigned* ci = ck + SEQ + 4;
    LAS unsigned* ncp = ci + SEQ + 4;
    for (int be = (int)blockIdx.x; be < NB * NE; be += F.G) {
        const int b = be >> 4, e = be & 15;
        unsigned k[4];
#pragma unroll
        for (int j = 0; j < 4; ++j) k[j] = __float_as_uint(aff[(size_t)be * SEQ + tid + 512 * j]);
        unsigned lo = 0u, hi = 0x3F800001u;
        if (tid == 0) ncp[0] = 0u;
        for (int it = 0; it < 40; ++it) {
            const unsigned mid = lo + ((hi - lo) >> 1); if (mid == lo) break;
            const int ws_ = __popcll(__ballot(k[0] >= mid)) + __popcll(__ballot(k[1] >= mid)) + __popcll(__ballot(k[2] >= mid)) + __popcll(__ballot(k[3] >= mid));
            if (lane == 0) wc[(it & 1) * 8 + F.wave] = (unsigned)ws_;
            __syncthreads();
            const u32x4 c0 = *(const LAS u32x4*)(wc + (it & 1) * 8), c1 = *(const LAS u32x4*)(wc + (it & 1) * 8 + 4);
            const int c = (int)(((c0.x + c0.y) + (c0.z + c0.w)) + ((c1.x + c1.y) + (c1.z + c1.w)));
            if (c < CAP) hi = mid; else { lo = mid; if (c <= 448) break; }
        }
        const unsigned T = lo;
        __syncthreads();
#pragma unroll
        for (int j = 0; j < 4; ++j) { const bool pred = k[j] >= T; const unsigned long long bal = __ballot(pred);
            const int wcount = __popcll(bal), pre = __popcll(bal & ((1ull << lane) - 1ull));
            unsigned base = 0u; if (lane == 0 && wcount) base = __hip_atomic_fetch_add(ncp, (unsigned)wcount, __ATOMIC_RELAXED, __HIP_MEMORY_SCOPE_WORKGROUP);
            base = (unsigned)__builtin_amdgcn_readfirstlane((int)base);
            if (pred) { ck[base + pre] = k[j]; ci[base + pre] = (unsigned)(tid + 512 * j); } else rank[(size_t)be * SEQ + tid + 512 * j] = CAP; }
        __syncthreads();
        const int nc = (int)ncp[0];
        if (tid < 4) { ck[nc + tid] = 0u; ci[nc + tid] = 0x7fffffffu; }
        __syncthreads();
        const int nc4 = (nc + 3) >> 2;
        for (int i = tid; i < nc; i += 512) { const unsigned kk = ck[i]; const int tt = (int)ci[i]; int cnt = 0;
#pragma unroll 4
            for (int m = 0; m < nc4; ++m) { const u32x4 km = ((const LAS u32x4*)ck)[m]; const u32x4 tm = ((const LAS u32x4*)ci)[m];
                cnt += ((km.x > kk || (km.x == kk && (int)tm.x < tt)) ? 1 : 0) + ((km.y > kk || (km.y == kk && (int)tm.y < tt)) ? 1 : 0)
                     + ((km.z > kk || (km.z == kk && (int)tm.z < tt)) ? 1 : 0) + ((km.w > kk || (km.w == kk && (int)tm.w < tt)) ? 1 : 0); }
            const int r = cnt < CAP ? cnt : CAP; rank[(size_t)be * SEQ + tt] = r;
            if (r < CAP) { const int sl = (e * 4 + b) * CAP + r; gate[sl] = __uint_as_float(kk); gidx[sl] = b * SEQ + tt; rs[sl] = rrow[b * SEQ + tt]; } }
        __syncthreads();
    }
}
__device__ __forceinline__ void combine_phase(const Frame& F, const bf16_t* xin, bf16_t* xo, float* fout, const bf16_t* Y, const int* rank, const float* __restrict__ gain, bf16_t* HNo, bool final_) {
    const int lane = lane_id();
    const int gw = (int)blockIdx.x * NWAVES + F.wave, NGW = F.G * NWAVES;
    for (int row = gw; row < NTOK; row += NGW) {
        const int b = row / SEQ, t = row % SEQ;
        int rk = CAP; if (lane < NE) rk = rank[((size_t)b * NE + lane) * SEQ + t];
        const GAS u32x2* xi = (const GAS u32x2*)(xin + (size_t)row * DM) + lane; f32x4 v[8];
#pragma unroll
        for (int j = 0; j < 8; ++j) { const u32x2 p = xi[64 * j]; v[j] = (f32x4){__uint_as_float(p.x << 16), __uint_as_float(p.x & 0xffff0000u), __uint_as_float(p.y << 16), __uint_as_float(p.y & 0xffff0000u)}; }
#pragma unroll
        for (int e = 0; e < NE; ++e) { const int r = __builtin_amdgcn_readlane(rk, e);
            if (r < CAP) { const u32x2* yr = (const u32x2*)(Y + ((size_t)(e * 4 + b) * CAP + r) * DM) + lane;
#pragma unroll
                for (int j = 0; j < 8; ++j) { const u32x2 w = yr[64 * j]; v[j].x += __uint_as_float(w.x << 16); v[j].y += __uint_as_float(w.x & 0xffff0000u); v[j].z += __uint_as_float(w.y << 16); v[j].w += __uint_as_float(w.y & 0xffff0000u); } } }
        float s = 0.f;
#pragma unroll
        for (int j = 0; j < 8; ++j) s += (v[j].x * v[j].x + v[j].y * v[j].y) + (v[j].z * v[j].z + v[j].w * v[j].w);
        const float r = rsqrtf(wave_sum(s) * (1.f / DM) + EPS); const f32x4* gr = (const f32x4*)gain + lane;
        if (final_) { GAS f32x4* fo = (GAS f32x4*)(fout + (size_t)row * DM) + lane;
#pragma unroll
            for (int j = 0; j < 8; ++j) { const f32x4 g = gr[64 * j]; fo[64 * j] = (f32x4){v[j].x * r * g.x, v[j].y * r * g.y, v[j].z * r * g.z, v[j].w * r * g.w}; }
        } else { GAS u32x2* o8 = (GAS u32x2*)(HNo + (size_t)row * DM) + lane; GAS u32x2* x8 = (GAS u32x2*)(xo + (size_t)row * DM) + lane;
#pragma unroll
            for (int j = 0; j < 8; ++j) { const f32x4 g = gr[64 * j]; x8[64 * j] = (u32x2){cvtpk(v[j].x, v[j].y), cvtpk(v[j].z, v[j].w)}; o8[64 * j] = (u32x2){cvtpk(v[j].x * r * g.x, v[j].y * r * g.y), cvtpk(v[j].z * r * g.z, v[j].w * r * g.w)}; } }
    }
}
struct MapPool { const char* A; const char* W; __device__ __forceinline__ void operator()(pg8::Unit& u) const {
    u.a = A + ((size_t)u.pm * 256 * DM + (size_t)(u.pn >> 1) * 512) * 2; u.b = W + ((size_t)(u.pn & 1) * 256 * DM + (size_t)(u.pn >> 1) * 512) * 2; } };
template <int W> __device__ __forceinline__ void pool_item4(const bf16_t* H, bf16_t* P, int row0, int c8) {
    const int t0 = row0 & (SEQ - 1); const bf16_t* base = H + (size_t)(row0 - t0) * DM + c8 * 8;
    u32x4 v[W + 3];
#pragma unroll
    for (int i = 0; i < W + 3; ++i) { int j = t0 - W / 2 + i; j = j < 0 ? 0 : (j > SEQ - 1 ? SEQ - 1 : j); v[i] = *(const u32x4*)(base + (size_t)j * DM); }
    float f[W + 3][8];
#pragma unroll
    for (int i = 0; i < W + 3; ++i) { const int j = t0 - W / 2 + i; const float m = (j >= 0 && j < SEQ) ? 1.f : 0.f;
        f[i][0] = m * __uint_as_float(v[i].x << 16); f[i][1] = m * __uint_as_float(v[i].x & 0xffff0000u); f[i][2] = m * __uint_as_float(v[i].y << 16); f[i][3] = m * __uint_as_float(v[i].y & 0xffff0000u);
        f[i][4] = m * __uint_as_float(v[i].z << 16); f[i][5] = m * __uint_as_float(v[i].z & 0xffff0000u); f[i][6] = m * __uint_as_float(v[i].w << 16); f[i][7] = m * __uint_as_float(v[i].w & 0xffff0000u); }
    float s[8];
#pragma unroll
    for (int c = 0; c < 8; ++c) { s[c] = 0.f;
#pragma unroll
        for (int i = 0; i < W; ++i) s[c] += f[i][c]; }
#pragma unroll
    for (int q = 0; q < 4; ++q) { const int t = t0 + q; int lo = t - W / 2, hi = t + W / 2; if (lo < 0) lo = 0; if (hi > SEQ) hi = SEQ; const float inv = 1.0f / (float)(hi - lo);
        if (q > 0) {
#pragma unroll
            for (int c = 0; c < 8; ++c) s[c] += f[q + W - 1][c] - f[q - 1][c]; }
        const float* e = f[q + W / 2];
        *(u32x4*)(P + (size_t)(row0 + q) * DM + c8 * 8) = (u32x4){cvtpk(s[0] * inv - e[0], s[1] * inv - e[1]), cvtpk(s[2] * inv - e[2], s[3] * inv - e[3]), cvtpk(s[4] * inv - e[4], s[5] * inv - e[5]), cvtpk(s[6] * inv - e[6], s[7] * inv - e[7])}; }
}
__device__ __forceinline__ void pool_phase(const Frame& F, const bf16_t* H, bf16_t* P) {
    const int lane = lane_id(); const int gwv = (int)blockIdx.x * NWAVES + F.wave, NWV = F.G * NWAVES;
    for (int wi = gwv; wi < NTOK; wi += NWV) {
        const int row0 = (wi >> 2) * 4, g = wi & 3, c8 = g * 64 + lane;
        if (g == 0) pool_item4<2>(H, P, row0, c8); else if (g == 1) pool_item4<4>(H, P, row0, c8); else if (g == 2) pool_item4<8>(H, P, row0, c8); else pool_item4<16>(H, P, row0, c8);
    }
}

constexpr int N_PHASES = 24;
#ifndef MK_N_LAUNCHES
#define MK_N_LAUNCHES 1
#endif
#ifndef REP_MASK
#define REP_MASK 0
#endif
__global__ void __launch_bounds__(NWAVES * 64, 2) skel_fwd(Args args) {
    extern __shared__ __attribute__((aligned(16))) unsigned char lds_raw[];
    Frame F;
    F.lds = (LAS unsigned char*)lds_raw; F.MISC = (volatile LAS unsigned*)(F.lds + MISC_OFF);
    F.wave = __builtin_amdgcn_readfirstlane(threadIdx.x >> 6);
    F.G = gridDim.x; { const int bx = blockIdx.x; F.vcu = (F.G % 8 == 0) ? (bx % 8) * (F.G / 8) + bx / 8 : bx; }
    F.ws = nullptr; F.ctl = (gu32*)(uptr(args.ws) + WS_CTL);
    for (int u = threadIdx.x; u < (LDS_BYTES - LDSCTL_OFF) / 4; u += NWAVES * 64) ((LAS unsigned*)(F.lds + LDSCTL_OFF))[u] = 0u;
    __syncthreads();
    const bool multi = (MK_N_LAUNCHES == 1) || (args.ph_hi - args.ph_lo) > 1 || REP_MASK != 0;
    XcdBarrier bar; bar.bar = (unsigned*)(F.ctl + CW_BAR); bar.x = 0; bar.st = nullptr; bar.wave = F.wave;
    if (multi) bar = xcd_barrier_post((unsigned*)(F.ctl + CW_BAR), F.MISC + 8, F.wave);
    const int lo = args.ph_lo, hi = args.ph_hi;
#ifdef REP_RT
    const unsigned rep_mask_ = (unsigned)__builtin_amdgcn_readfirstlane(args.pad);
#endif
#define IN(k) ((MK_N_LAUNCHES == 1) ? ((k) < N_PHASES) : (lo <= (k) && (k) < hi))
#ifdef REP_RT
#define REPBIT(k) ((int)((rep_mask_ >> (k)) & 1u))
#else
#define REPBIT(k) ((int)((((unsigned)REP_MASK) >> (k)) & 1u))
#endif
#define PHASE(k) _Pragma("unroll") for (int rep_ = 0; rep_ < 1 + REPBIT(k); ++rep_)
#define SEAM(k) do { if ((IN(k) && IN((k) + 1)) || rep_ + 1 < 1 + REPBIT(k)) xcd_barrier(bar); } while (0)
    LAS unsigned char* ring = F.lds + RING_OFF; LAS unsigned char* xl = F.lds + XL_OFF;
    const int bx = (int)blockIdx.x, G = F.G;

#define KV_PROJ(l, rotK, rotV) do {   \
            { MapLin mp{(const char*)(ws + WS_MEMNB + (size_t)(l) * NB * MEML * DM * 2), (const char*)(ws + WS_WCK_T + (size_t)(l) * DM * DM * 2), (size_t)256 * DM * 2, (size_t)256 * DM * 2}; \
              pg8::Sched<MapLin> S; S.init(NB * MEML / 256, DM / 256, G, (bx + G - ((rotK) % G)) % G, mp); \
              EpiStore<AddrLin> E{AddrLin{(bf16_t*)(ws + WS_KCB + (size_t)(l) * NB * MEML * DM * 2), DM}}; \
              pg8::gemm_phase<EpiStore<AddrLin>, pg8::Sched<MapLin>, true>(F.wave, ring, xl, DM, DM * 2, DM * 2, S, E); } \
            { MapLin mp{(const char*)(ws + WS_WCV_T + (size_t)(l) * DM * DM * 2), (const char*)(ws + WS_MEMNB + (size_t)(l) * NB * MEML * DM * 2), (size_t)256 * DM * 2, (size_t)256 * DM * 2}; \
              pg8::Sched<MapLin> S; S.init(DM / 256, NB * MEML / 256, G, (bx + G - ((rotV) % G)) % G, mp); \
              EpiStore<AddrLin> E{AddrLin{(bf16_t*)(ws + WS_VTB + (size_t)(l) * NB * MEML * DM * 2), NB * MEML}}; \
              pg8::gemm_phase<EpiStore<AddrLin>, pg8::Sched<MapLin>, true>(F.wave, ring, xl, DM, DM * 2, DM * 2, S, E); } } while (0)
#ifdef EXTRA_BARS
    for (int eb = 0; eb < EXTRA_BARS; ++eb) xcd_barrier(bar);
#endif
    if (IN(0)) PHASE(0) { const karg_t ka = kargs(); unsigned char* const ws = uptr(KWS(ka)); p0_prologue(F, ka, ws); SEAM(0); }
    if (IN(1)) PHASE(1) { const karg_t ka = kargs(); unsigned char* const ws = uptr(KWS(ka));
        {
            MapLin mp{(const char*)(ws + WS_HN), (const char*)(ws + WS_WIN_T), (size_t)256 * DM * 2, (size_t)256 * DM * 2};
            pg8::Sched<MapLin> S; S.init(NTOK / 256, 2560 / 256, G, bx, mp);
            EpiQKV E{(bf16_t*)(ws + WS_QB), (bf16_t*)(ws + WS_KB), (bf16_t*)(ws + WS_VB), KIN(ka, 4), KIN(ka, 5), (const float*)(ws + WS_ROPE), (const float*)(ws + WS_ROPE) + SEQ * 64};
            pg8::gemm_phase<EpiQKV, pg8::Sched<MapLin>, true>(F.wave, ring, xl, DM, DM * 2, DM * 2, S, E); }
        {
            MapLin mp{(const char*)(ws + WS_WF_T), (const char*)(ws + WS_HN), (size_t)256 * DM * 2, (size_t)256 * DM * 2};
            pg8::Sched<MapLin> S; S.init(1024 / 256, NTOK / 256, G, (bx + G - (320 % G)) % G, mp);
            EpiStore<AddrF1> E{AddrF1{(bf16_t*)(ws + WS_FPQ)}};
            pg8::gemm_phase<EpiStore<AddrF1>, pg8::Sched<MapLin>, true>(F.wave, ring, xl, DM, DM * 2, DM * 2, S, E); }
        KV_PROJ(0, 448, 480);
        SEAM(1);
    }
    if (IN(2)) PHASE(2) { const karg_t ka = kargs(); unsigned char* const ws = uptr(KWS(ka));
        const int nF2 = (G > 64) ? 64 : 0;
        if (bx < nF2 || nF2 == 0) {
            MapLin mp{(const char*)(ws + WS_DFT), (const char*)(ws + WS_FPQ), (size_t)256 * 4096 * 2, (size_t)256 * 4096 * 2};
            pg8::Sched<MapLin> S; S.init(8, 8, nF2 ? nF2 : G, bx, mp);
            EpiStore<AddrF2> E{AddrF2{(bf16_t*)(ws + WS_MIXB)}};
            pg8::gemm_phase<EpiStore<AddrF2>, pg8::Sched<MapLin>, true>(F.wave, ring, xl, 4096, 4096 * 2, 4096 * 2, S, E);
        }
        if (bx < nF2) { __syncthreads(); tr_span(F, ka, ws, 1, 6144 + bx * 8 + F.wave, 512, 5); __syncthreads(); }
        if (bx >= nF2) {
            const int a = bx - nF2, cnt = G - nF2, per = (384 + cnt - 1) / cnt, slot = a % 3; int ui = 0;
            for (int uid = a * per; uid < (a + 1) * per && uid < 384; ++uid, ++ui) {
                if (ui == slot) { __syncthreads(); tr_span(F, ka, ws, 1, a * 8 + F.wave, 1536, 4); __syncthreads(); }
                const int set_ = 2 * (a & 7) + ui, jx = a >> 3, b = set_ >> 2, kvh = set_ & 3, qb = jx & 7, hq = kvh * 3 + (jx >> 3);
                const bf16_t* Qb = (const bf16_t*)(ws + WS_QB) + ((size_t)b * SEQ + qb * 256) * AW + hq * HD;
                const bf16_t* Kh = (const bf16_t*)(ws + WS_KB) + (size_t)b * SEQ * KVW + kvh * HD;
                const bf16_t* Vh = (const bf16_t*)(ws + WS_VB) + (size_t)b * SEQ * KVW + kvh * HD;
                bf16_t* Ob = (bf16_t*)(ws + WS_MIXB) + ((size_t)b * SEQ + qb * 256) * DM + hq * HD;
                attn::attn_dense_body(Qb, Kh, Vh, Ob, SEQ, (char*)lds_raw + RING_OFF, F.wave);
            }
            if (slot >= ui) { __syncthreads(); tr_span(F, ka, ws, 1, a * 8 + F.wave, 1536, 4); __syncthreads(); }
        }
        SEAM(2);
    }
    if (IN(3)) PHASE(3) { const karg_t ka = kargs(); unsigned char* const ws = uptr(KWS(ka));
        MapLin mp{(const char*)(ws + WS_MIXB), (const char*)(ws + WS_WOUT_T), (size_t)256 * DM * 2, (size_t)256 * DM * 2};
        pg8::Sched<MapLin> S; S.init(NTOK / 256, DM / 256, G, bx, mp);
        EpiResB<true> E{KIN(ka, 0), (bf16_t*)(ws + WS_XB), (float*)(ws + WS_SSP), nullptr};
        pg8::gemm_phase<EpiResB<true>, pg8::Sched<MapLin>, true>(F.wave, ring, xl, DM, DM * 2, DM * 2, S, E);
        SEAM(3);
    }
    {
        constexpr int l = 0; constexpr int pb = l ? 15 : 4;
        if (l == 1) {
            if (IN(13)) PHASE(13) { const karg_t ka = kargs(); unsigned char* const ws = uptr(KWS(ka));
                pool_phase(F, (const bf16_t*)(ws + WS_HN), (bf16_t*)(ws + WS_QCB));
#ifdef PROBE_CONV
                tr_span<TRV>(F, ka, ws, 1, bx * 8 + F.wave, 2048, 6);
#endif
                SEAM(13);
            }
            if (IN(14)) PHASE(14) { const karg_t ka = kargs(); unsigned char* const ws = uptr(KWS(ka));
                MapPool mp{(const char*)(ws + WS_QCB), (const char*)(ws + WS_WP_T)};
                pg8::Sched<MapPool> S; S.init(NTOK / 256, DM / 256, G, bx, mp);
                EpiResB<false> E{(const bf16_t*)(ws + WS_XB), (bf16_t*)(ws + WS_XALT), (float*)(ws + WS_SSP), KIN(ka, 9)};
                pg8::gemm_phase<EpiResB<false>, pg8::Sched<MapPool>, true>(F.wave, ring, xl, 512, DM * 2, DM * 2, S, E);
                SEAM(14);
            }
        }
        if (IN(pb + 0)) PHASE(pb + 0) { const karg_t ka = kargs(); unsigned char* const ws = uptr(KWS(ka));
            MapLin mp{(const char*)(ws + (l == 0 ? WS_XB : WS_XALT)), (const char*)(ws + WS_WCQ_T + (size_t)l * DM * DM * 2), (size_t)256 * DM * 2, (size_t)256 * DM * 2};
            pg8::Sched<MapLin> S; S.init(NTOK / 256, DM / 256, G, bx, mp);
            EpiRowScale E{(bf16_t*)(ws + WS_QCB), DM, (const float*)(ws + WS_SSP), 0.04419417382415922f};
            pg8::gemm_phase<EpiRowScale, pg8::Sched<MapLin>, true>(F.wave, ring, xl, DM, DM * 2, DM * 2, S, E);
            SEAM(pb + 0);
        }
        if (IN(pb + 1)) PHASE(pb + 1) { const karg_t ka = kargs(); unsigned char* const ws = uptr(KWS(ka));
            MapXS mp{(const char*)(ws + WS_QCB), (const char*)(ws + WS_KCB + (size_t)l * NB * MEML * DM * 2)};
            pg8::Sched<MapXS> S; S.init(NTOK / 256, NMH, G, bx, mp);
            EpiSoftmax E{(bf16_t*)(ws + WS_PB), NMH * MEML};
            pg8::gemm_phase<EpiSoftmax, pg8::Sched<MapXS>, true>(F.wave, ring, xl, MHD, DM * 2, DM * 2, S, E);
            { pg8::Unit su; if (S.next(0, su)) {
                VM_WAIT(); __syncthreads(); if (F.wave == 0 && lane_id() == 0) { __builtin_amdgcn_fence(__ATOMIC_ACQUIRE, "agent"); VM_WAIT(); } __syncthreads();
                MapXPV mp2{(const char*)(ws + WS_PB), (const char*)(ws + WS_VTB + (size_t)l * NB * MEML * DM * 2)};
                SchedPair S2; S2.ua.pm = su.pm; S2.ua.pn = 2 * su.pn; S2.ub.pm = su.pm; S2.ub.pn = 2 * su.pn + 1; mp2(S2.ua); mp2(S2.ub);
                EpiStore<AddrLin> E2{AddrLin{(bf16_t*)(ws + WS_MIXB), DM}};
                pg8::gemm_phase<EpiStore<AddrLin>, SchedPair, true>(F.wave, ring, xl, MEML, NMH * MEML * 2, NB * MEML * 2, S2, E2); } }
            if (l == 0) { KV_PROJ(1, 128, 160);
                if (bx < 128) { __syncthreads(); tr_span(F, ka, ws, 1, 8704 + bx * 8 + F.wave, 1024, 2); }
                else if (bx >= 192) { tr_span(F, ka, ws, 2, (bx - 192) * 8 + F.wave, 512, 3); } }
            if (l == 1 && bx >= 128) tr_span(F, ka, ws, 2, 9728 + (bx - 128) * 8 + F.wave, 1024, 1);
            SEAM(pb + 1);
        }
        if (IN(pb + 3)) PHASE(pb + 3) { const karg_t ka = kargs(); unsigned char* const ws = uptr(KWS(ka));
            MapLin mp{(const char*)(ws + WS_MIXB), (const char*)(ws + WS_WCO_T + (size_t)l * DM * DM * 2), (size_t)256 * DM * 2, (size_t)256 * DM * 2};
            pg8::Sched<MapLin> S; S.init(NTOK / 256, DM / 256, G, bx, mp);
            EpiResB<false> E{(const bf16_t*)(ws + (l == 0 ? WS_XB : WS_XALT)), (bf16_t*)(ws + (l == 0 ? WS_XALT : WS_XB)), nullptr, nullptr};
            pg8::gemm_phase<EpiResB<false>, pg8::Sched<MapLin>, true>(F.wave, ring, xl, DM, DM * 2, DM * 2, S, E);
            SEAM(pb + 3);
        }
        if (IN(pb + 4)) PHASE(pb + 4) { const karg_t ka = kargs(); unsigned char* const ws = uptr(KWS(ka));
            router_phase(F, (const bf16_t*)(ws + (l == 0 ? WS_XALT : WS_XB)), (const u32x4*)(ws + WS_AFF + 512 * 1024) + (size_t)l * 8192, (float*)(ws + WS_SSP + 512 * 1024), (float*)(ws + WS_AFF), xl);
            SEAM(pb + 4);
        }
        if (IN(pb + 5)) PHASE(pb + 5) { const karg_t ka = kargs(); unsigned char* const ws = uptr(KWS(ka));
            rank_phase(F, (const float*)(ws + WS_AFF), (int*)(ws + WS_RANK), (float*)(ws + WS_GATE), (const float*)(ws + WS_SSP + 512 * 1024), (float*)(ws + WS_SSP + 768 * 1024), (int*)(ws + WS_GATE + 512 * 1024));
            if (bx >= NB * NE) tr_span(F, ka, ws, l == 0 ? 1 : 2, 10752 + (bx - NB * NE) * 8 + F.wave, 1536, 1);
            SEAM(pb + 5);
        }
        if (IN(pb + 6)) PHASE(pb + 6) { const karg_t ka = kargs(); unsigned char* const ws = uptr(KWS(ka));
            MapMoE mp{(const char*)(ws + (l == 0 ? WS_XALT : WS_XB)), (const char*)(ws + (l ? WS_WGU_T2 : WS_WGU_T)), (size_t)0, (size_t)2048 * DM * 2, (size_t)256 * DM * 2};
            pg8::Sched<MapMoE> S; S.init(NB * NE, 8, G, bx, mp);
            EpiSwiGLU E{(bf16_t*)(ws + WS_ACTB), (const float*)(ws + WS_SSP + 768 * 1024)};
            const bool cfirst = ((bx >> 3) & 1) != 0;
            if (l == 0 && cfirst) { tr_span(F, ka, ws, 2, 1536 + bx * 8 + F.wave, 2048, 2); __syncthreads(); }
            pg8::gemm_phase<EpiSwiGLU, pg8::Sched<MapMoE>, true, true>(F.wave, ring, xl, DM, DM * 2, DM * 2, S, E, (const int*)(ws + WS_GATE + 512 * 1024));
            if (l == 0 && !cfirst) { __syncthreads(); tr_span(F, ka, ws, 2, 1536 + bx * 8 + F.wave, 2048, 2); }
            SEAM(pb + 6);
        }
        if (IN(pb + 7)) PHASE(pb + 7) { const karg_t ka = kargs(); unsigned char* const ws = uptr(KWS(ka));
            MapMoE mp{(const char*)(ws + WS_ACTB), (const char*)(ws + (l ? WS_WD_T2 : WS_WD_T)), (size_t)256 * EFF * 2, (size_t)2048 * EFF * 2, (size_t)256 * EFF * 2};
            pg8::Sched<MapMoE> S; S.init(NB * NE, 8, G, bx, mp);
            EpiRowGate E{(bf16_t*)(ws + WS_YB), (const float*)(ws + WS_GATE)};
            const bool cfirst = ((bx >> 3) & 1) == 0;
            if (l == 0 && cfirst) { tr_span(F, ka, ws, 2, 5632 + bx * 8 + F.wave, 2048, 2); __syncthreads(); }
            pg8::gemm_phase<EpiRowGate, pg8::Sched<MapMoE>, true>(F.wave, ring, xl, EFF, EFF * 2, EFF * 2, S, E);
            if (l == 0 && !cfirst) { __syncthreads(); tr_span(F, ka, ws, 2, 5632 + bx * 8 + F.wave, 2048, 2); }
            SEAM(pb + 7);
        }
        if (IN(pb + 8)) PHASE(pb + 8) { const karg_t ka = kargs(); unsigned char* const ws = uptr(KWS(ka));
            combine_phase(F, (const bf16_t*)(ws + (l == 0 ? WS_XALT : WS_XB)), (bf16_t*)(ws + WS_XB), KOUT(ka), (const bf16_t*)(ws + WS_YB), (const int*)(ws + WS_RANK), l == 0 ? KIN(ka, 2) + DM : KIN(ka, 21), (bf16_t*)(ws + WS_HN), l == 1);
            SEAM(pb + 8);
        }
    }
    {
        constexpr int l = 1; constexpr int pb = l ? 15 : 4;
        if (l == 1) {
            if (IN(13)) PHASE(13) { const karg_t ka = kargs(); unsigned char* const ws = uptr(KWS(ka));
                pool_phase(F, (const bf16_t*)(ws + WS_HN), (bf16_t*)(ws + WS_QCB));
#ifdef PROBE_CONV
                tr_span<TRV>(F, ka, ws, 1, bx * 8 + F.wave, 2048, 6);
#endif
                SEAM(13);
            }
            if (IN(14)) PHASE(14) { const karg_t ka = kargs(); unsigned char* const ws = uptr(KWS(ka));
                MapPool mp{(const char*)(ws + WS_QCB), (const char*)(ws + WS_WP_T)};
                pg8::Sched<MapPool> S; S.init(NTOK / 256, DM / 256, G, bx, mp);
                EpiResB<false> E{(const bf16_t*)(ws + WS_XB), (bf16_t*)(ws + WS_XALT), (float*)(ws + WS_SSP), KIN(ka, 9)};
                pg8::gemm_phase<EpiResB<false>, pg8::Sched<MapPool>, true>(F.wave, ring, xl, 512, DM * 2, DM * 2, S, E);
                SEAM(14);
            }
        }
        if (IN(pb + 0)) PHASE(pb + 0) { const karg_t ka = kargs(); unsigned char* const ws = uptr(KWS(ka));
            MapLin mp{(const char*)(ws + (l == 0 ? WS_XB : WS_XALT)), (const char*)(ws + WS_WCQ_T + (size_t)l * DM * DM * 2), (size_t)256 * DM * 2, (size_t)256 * DM * 2};
            pg8::Sched<MapLin> S; S.init(NTOK / 256, DM / 256, G, bx, mp);
            EpiRowScale E{(bf16_t*)(ws + WS_QCB), DM, (const float*)(ws + WS_SSP), 0.04419417382415922f};
            pg8::gemm_phase<EpiRowScale, pg8::Sched<MapLin>, true>(F.wave, ring, xl, DM, DM * 2, DM * 2, S, E);
            SEAM(pb + 0);
        }
        if (IN(pb + 1)) PHASE(pb + 1) { const karg_t ka = kargs(); unsigned char* const ws = uptr(KWS(ka));
            MapXS mp{(const char*)(ws + WS_QCB), (const char*)(ws + WS_KCB + (size_t)l * NB * MEML * DM * 2)};
            pg8::Sched<MapXS> S; S.init(NTOK / 256, NMH, G, bx, mp);
            EpiSoftmax E{(bf16_t*)(ws + WS_PB), NMH * MEML};
            pg8::gemm_phase<EpiSoftmax, pg8::Sched<MapXS>, true>(F.wave, ring, xl, MHD, DM * 2, DM * 2, S, E);
            { pg8::Unit su; if (S.next(0, su)) {
                VM_WAIT(); __syncthreads(); if (F.wave == 0 && lane_id() == 0) { __builtin_amdgcn_fence(__ATOMIC_ACQUIRE, "agent"); VM_WAIT(); } __syncthreads();
                MapXPV mp2{(const char*)(ws + WS_PB), (const char*)(ws + WS_VTB + (size_t)l * NB * MEML * DM * 2)};
                SchedPair S2; S2.ua.pm = su.pm; S2.ua.pn = 2 * su.pn; S2.ub.pm = su.pm; S2.ub.pn = 2 * su.pn + 1; mp2(S2.ua); mp2(S2.ub);
                EpiStore<AddrLin> E2{AddrLin{(bf16_t*)(ws + WS_MIXB), DM}};
                pg8::gemm_phase<EpiStore<AddrLin>, SchedPair, true>(F.wave, ring, xl, MEML, NMH * MEML * 2, NB * MEML * 2, S2, E2); } }
            if (l == 0) { KV_PROJ(1, 128, 160);
                if (bx < 128) { __syncthreads(); tr_span(F, ka, ws, 1, 8704 + bx * 8 + F.wave, 1024, 2); }
                else if (bx >= 192) { tr_span(F, ka, ws, 2, (bx - 192) * 8 + F.wave, 512, 3); } }
            if (l == 1 && bx >= 128) tr_span(F, ka, ws, 2, 9728 + (bx - 128) * 8 + F.wave, 1024, 1);
            SEAM(pb + 1);
        }
        if (IN(pb + 3)) PHASE(pb + 3) { const karg_t ka = kargs(); unsigned char* const ws = uptr(KWS(ka));
            MapLin mp{(const char*)(ws + WS_MIXB), (const char*)(ws + WS_WCO_T + (size_t)l * DM * DM * 2), (size_t)256 * DM * 2, (size_t)256 * DM * 2};
            pg8::Sched<MapLin> S; S.init(NTOK / 256, DM / 256, G, bx, mp);
            EpiResB<false> E{(const bf16_t*)(ws + (l == 0 ? WS_XB : WS_XALT)), (bf16_t*)(ws + (l == 0 ? WS_XALT : WS_XB)), nullptr, nullptr};
            pg8::gemm_phase<EpiResB<false>, pg8::Sched<MapLin>, true>(F.wave, ring, xl, DM, DM * 2, DM * 2, S, E);
            SEAM(pb + 3);
        }
        if (IN(pb + 4)) PHASE(pb + 4) { const karg_t ka = kargs(); unsigned char* const ws = uptr(KWS(ka));
            router_phase(F, (const bf16_t*)(ws + (l == 0 ? WS_XALT : WS_XB)), (const u32x4*)(ws + WS_AFF + 512 * 1024) + (size_t)l * 8192, (float*)(ws + WS_SSP + 512 * 1024), (float*)(ws + WS_AFF), xl);
            SEAM(pb + 4);
        }
        if (IN(pb + 5)) PHASE(pb + 5) { const karg_t ka = kargs(); unsigned char* const ws = uptr(KWS(ka));
            rank_phase(F, (const float*)(ws + WS_AFF), (int*)(ws + WS_RANK), (float*)(ws + WS_GATE), (const float*)(ws + WS_SSP + 512 * 1024), (float*)(ws + WS_SSP + 768 * 1024), (int*)(ws + WS_GATE + 512 * 1024));
            if (bx >= NB * NE) tr_span(F, ka, ws, l == 0 ? 1 : 2, 10752 + (bx - NB * NE) * 8 + F.wave, 1536, 1);
            SEAM(pb + 5);
        }
        if (IN(pb + 6)) PHASE(pb + 6) { const karg_t ka = kargs(); unsigned char* const ws = uptr(KWS(ka));
            MapMoE mp{(const char*)(ws + (l == 0 ? WS_XALT : WS_XB)), (const char*)(ws + (l ? WS_WGU_T2 : WS_WGU_T)), (size_t)0, (size_t)2048 * DM * 2, (size_t)256 * DM * 2};
            pg8::Sched<MapMoE> S; S.init(NB * NE, 8, G, bx, mp);
            EpiSwiGLU E{(bf16_t*)(ws + WS_ACTB), (const float*)(ws + WS_SSP + 768 * 1024)};
            const bool cfirst = ((bx >> 3) & 1) != 0;
            if (l == 0 && cfirst) { tr_span(F, ka, ws, 2, 1536 + bx * 8 + F.wave, 2048, 2); __syncthreads(); }
            pg8::gemm_phase<EpiSwiGLU, pg8::Sched<MapMoE>, true, true>(F.wave, ring, xl, DM, DM * 2, DM * 2, S, E, (const int*)(ws + WS_GATE + 512 * 1024));
            if (l == 0 && !cfirst) { __syncthreads(); tr_span(F, ka, ws, 2, 1536 + bx * 8 + F.wave, 2048, 2); }
            SEAM(pb + 6);
        }
        if (IN(pb + 7)) PHASE(pb + 7) { const karg_t ka = kargs(); unsigned char* const ws = uptr(KWS(ka));
            MapMoE mp{(const char*)(ws + WS_ACTB), (const char*)(ws + (l ? WS_WD_T2 : WS_WD_T)), (size_t)256 * EFF * 2, (size_t)2048 * EFF * 2, (size_t)256 * EFF * 2};
            pg8::Sched<MapMoE> S; S.init(NB * NE, 8, G, bx, mp);
            EpiRowGate E{(bf16_t*)(ws + WS_YB), (const float*)(ws + WS_GATE)};
            const bool cfirst = ((bx >> 3) & 1) == 0;
            if (l == 0 && cfirst) { tr_span(F, ka, ws, 2, 5632 + bx * 8 + F.wave, 2048, 2); __syncthreads(); }
            pg8::gemm_phase<EpiRowGate, pg8::Sched<MapMoE>, true>(F.wave, ring, xl, EFF, EFF * 2, EFF * 2, S, E);
            if (l == 0 && !cfirst) { __syncthreads(); tr_span(F, ka, ws, 2, 5632 + bx * 8 + F.wave, 2048, 2); }
            SEAM(pb + 7);
        }
        if (IN(pb + 8)) PHASE(pb + 8) { const karg_t ka = kargs(); unsigned char* const ws = uptr(KWS(ka));
            combine_phase(F, (const bf16_t*)(ws + (l == 0 ? WS_XALT : WS_XB)), (bf16_t*)(ws + WS_XB), KOUT(ka), (const bf16_t*)(ws + WS_YB), (const int*)(ws + WS_RANK), l == 0 ? KIN(ka, 2) + DM : KIN(ka, 21), (bf16_t*)(ws + WS_HN), l == 1);
            SEAM(pb + 8);
        }
    }
#undef IN
#undef SEAM
#undef PHASE
#undef KV_PROJ
}


extern "C" void kernel_launch(void* const* d_in, const int* in_sizes, int n_in, void* d_out, int out_size, void* d_ws, size_t ws_size, hipStream_t stream) {
    static int grid = 0;
    if (grid == 0) {
        int dev = 0, cus = 0;
        if (n_in != 22 || out_size != NTOK * DM || ws_size < WS_FAST_END) { fprintf(stderr, "kernel_launch: unexpected shapes (n_in %d out %d ws %zu)\n", n_in, out_size, ws_size); grid = -1; return; }
        if (hipGetDevice(&dev) != hipSuccess || hipDeviceGetAttribute(&cus, hipDeviceAttributeMultiprocessorCount, dev) != hipSuccess) { fprintf(stderr, "device query failed\n"); grid = -1; return; }
        if (hipFuncSetAttribute((const void*)skel_fwd, hipFuncAttributeMaxDynamicSharedMemorySize, LDS_BYTES) != hipSuccess) { fprintf(stderr, "hipFuncSetAttribute failed\n"); grid = -1; return; }
        (void)hipGetLastError();
        grid = cus;
        if (grid != 256) { fprintf(stderr, "kernel_launch: this kernel is laid out for 256 CUs (found %d)\n", cus); grid = -1; return; }
    }
    if (grid < 0) return;
    (void)hipMemsetAsync((char*)d_ws + WS_CTL, 0, 32768, stream);
    Args a{};
    for (int i = 0; i < 22; ++i) a.in[i] = (const float*)d_in[i];
    a.out = (float*)d_out; a.ws = (unsigned char*)d_ws;
#ifdef REP_RT
    a.pad = REP_RT;
#endif
    constexpr int NL = MK_N_LAUNCHES;
    for (int li = 0; li < NL; ++li) {
        a.ph_lo = (N_PHASES * li) / NL; a.ph_hi = (N_PHASES * (li + 1)) / NL; a.li = li;
        hipLaunchKernelGGL(skel_fwd, dim3(grid), dim3(NWAVES * 64), LDS_BYTES, stream, a);
    }
}
```

```cpp
#include <hip/hip_runtime.h>
#include <cstdio>
#include <cstdint>

constexpr int DM = 2048, NB = 4, SEQ = 2048, NTOK = NB * SEQ;
constexpr int HD = 128, NQH = 12, NKVH = 4, AW = NQH * HD, KVW = NKVH * HD, FW = 512, INW = 3072;
constexpr int MEML = 256, NMH = 4, MHD = 512;
constexpr int NE = 16, EFF = 1024, CAP = 256;
constexpr float EPS = 1e-6f;

#define LAS __attribute__((address_space(3)))
#define GAS __attribute__((address_space(1)))
typedef unsigned short bf16_t;
typedef short bf16x8 __attribute__((ext_vector_type(8)));
typedef float f32x4 __attribute__((ext_vector_type(4)));
typedef float f32x2 __attribute__((ext_vector_type(2)));
typedef unsigned u32x4 __attribute__((ext_vector_type(4)));
typedef unsigned u32x2 __attribute__((ext_vector_type(2)));
typedef __bf16 bf16x2_t __attribute__((ext_vector_type(2)));
__device__ __forceinline__ unsigned cvtpk(float lo, float hi) { f32x2 v = {lo, hi}; bf16x2_t b = __builtin_convertvector(v, bf16x2_t); return __builtin_bit_cast(unsigned, b); }
__device__ __forceinline__ float bf2f(unsigned short h) { return __uint_as_float(((unsigned)h) << 16); }
template <class T> __device__ __forceinline__ T* uptr(T* p) { const unsigned long long v = (unsigned long long)p; const unsigned lo = __builtin_amdgcn_readfirstlane((unsigned)v), hi = __builtin_amdgcn_readfirstlane((unsigned)(v >> 32)); return (T*)(((unsigned long long)hi << 32) | lo); }
__device__ __forceinline__ int lane_id() { int l = (int)__builtin_amdgcn_mbcnt_hi(~0u, __builtin_amdgcn_mbcnt_lo(~0u, 0u)); asm volatile("" : "+v"(l)); return l; }
typedef __attribute__((address_space(4))) const unsigned char* karg_t;
__device__ __forceinline__ karg_t kargs() { karg_t p = (karg_t)__builtin_amdgcn_kernarg_segment_ptr(); asm volatile("" : "+s"(p)); return p; }
#define KIN(ka, i) (*(const float* const __attribute__((address_space(4)))*)((ka) + 8 * (i)))
#define KOUT(ka) (*(float* const __attribute__((address_space(4)))*)((ka) + 176))
#define KWS(ka) (*(unsigned char* const __attribute__((address_space(4)))*)((ka) + 184))
#ifndef EPI_WT
#define EPI_WT 0
#endif
__device__ __forceinline__ void st16(void* p, u32x4 v) {
#if EPI_WT
    asm volatile("global_store_dwordx4 %0, %1, off sc1\n\ts_nop 1" :: "v"(p), "v"(v) : "memory");
#else
    *(u32x4*)p = v;
#endif
}
#define LDS_WAIT() asm volatile("s_waitcnt lgkmcnt(0)" ::: "memory")
#define VM_WAIT() asm volatile("s_waitcnt vmcnt(0)" ::: "memory")
#define WG_BAR() do { asm volatile("s_waitcnt lgkmcnt(0)" ::: "memory"); __builtin_amdgcn_s_barrier(); asm volatile("" ::: "memory"); } while (0)

namespace pg8 {
constexpr int BM = 256, BK = 64, HALF = 128, HTB = HALF * BK * 2, STAGE_BYTES = 8 * HTB, NXCD = 8, WGM = 8;
__host__ __device__ __forceinline__ int lds_byte(int r, int c) { const int st = (r >> 4) * 2 + (c >> 5), rr = r & 15, cc = c & 31, ob = rr * 64 + cc * 2; return st * 1024 + (ob ^ (((ob >> 9) & 1) << 5)); }
__host__ __device__ __forceinline__ void stage_rc(int b, int& R, int& C) { const int st = b / 1024, sb = b % 1024, swz = sb ^ (((sb >> 9) & 1) << 5); R = (st >> 1) * 16 + swz / 64; C = (st & 1) * 32 + (swz % 64) / 2; }
__host__ __device__ __forceinline__ int perm32(int rho) { const int n = rho >> 4, i = rho & 15; return 8 * (i >> 2) + 4 * n + (i & 3); }

struct Unit { int pm, pn; const char* a; const char* b; };
struct EpiCtx { int wr, wc, wid; LAS unsigned char* xl; };

template <class Map> struct Sched {
    int nM, nN, nwg, G, c, wgm; Map map;
    __device__ __forceinline__ void init(int nM_, int nN_, int G_, int c_, const Map& m, int wgm_ = WGM) { nM = nM_; nN = nN_; nwg = nM * nN; G = G_; c = c_; map = m; wgm = wgm_; }
    __device__ __forceinline__ bool next(int i, Unit& u) const {
        const long L = (long)i * G + c; if (L >= nwg) return false;
        int wgid = (int)L; { const int q = nwg / NXCD, r = nwg % NXCD, xcd = wgid % NXCD, off = wgid / NXCD; wgid = (xcd < r ? xcd * (q + 1) : r * (q + 1) + (xcd - r) * q) + off; }
        const int nig = wgm * nN, gid = wgid / nig, fm = gid * wgm, gsz = (nM - fm) < wgm ? (nM - fm) : wgm;
        u.pm = fm + ((wgid % nig) % gsz); u.pn = (wgid % nig) / gsz; map(u); return true;
    }
};

template <class Epi, class SchedT, bool SP2, bool GATHER = false, int BF = 0, bool BGAIN = false>
__device__ __forceinline__ void gemm_phase(const int wave_, LAS unsigned char* lds, LAS unsigned char* xl, const int K, const int lda, const int ldb, const SchedT& S, const Epi& E, const int* gidx = nullptr, const long bhoff = 0, const LAS float* bgl = nullptr) {
    constexpr bool ALIGN_EPI = true; static_assert(SP2 || !GATHER, "GATHER needs the SP2 loop"); static_assert(BF == 0 || (SP2 && Epi::PERM), "BF needs the SP2 loop and the PERM column order");
    const int lane = lane_id(), wid = wave_, tid = wid * 64 + lane, wr = wid >> 2, wc = wid & 3, fr = lane & 15, fq = lane >> 4;
    const int nt = K / BK;
    unsigned voffA[2], voffB[2];
#pragma unroll
    for (int i = 0; i < 2; ++i) { int R, C; stage_rc(tid * 16 + i * 8192, R, C); const int Rb = Epi::PERM ? ((R & ~31) + perm32(R & 31)) : R;
        voffA[i] = (unsigned)(R * lda + C * 2); voffB[i] = (unsigned)(Rb * ldb + C * 2); }
    const size_t kstep = (size_t)(BK * 2);
    const size_t hstepA = (size_t)HALF * lda, hstepB = (size_t)HALF * ldb;
    const unsigned ldsw = (unsigned)wid * 1024u;
    const int aoff = lds_byte(wr * 64 + fr, fq * 8), boff = lds_byte(wc * 32 + fr, fq * 8);
    const unsigned xoffA = (unsigned)tid * 16u;
    int gset = 0;
    const int bf_nb = lane & 15, bf_kq = lane >> 4, bf_m = (bf_nb >> 1) & 3, bf_kb = 32 * (wid >> 2) + 8 * bf_kq;
    const unsigned bf_src = (unsigned)(bf_kb * ldb + (64 * (wid & 1) + 4 * bf_nb) * 4);
    const long bf_h = ((wid & 3) >> 1) ? bhoff : 0;
    const unsigned bf_dst = (unsigned)(((wid & 3) >> 1) * HTB + (((64 * (wid & 1) + 32 * (bf_nb >> 3) + 16 * (bf_nb & 1)) >> 4) * 2 + (wid >> 2)) * 1024 + 256 * bf_m + ((16 * bf_kq) ^ ((bf_m >> 1) << 5)));
    f32x4 bq[8];
#define PG8_BISSUE(gbase) do { if constexpr (BF) { const char* gb_ = (const char*)(gbase) + bf_h; _Pragma("unroll") for (int i_ = 0; i_ < 8; ++i_) \
        asm volatile("global_load_dwordx4 %0, %1, %2" : "=v"(bq[i_]) : "v"(bf_src), "s"(gb_ + (size_t)i_ * ldb) : "memory"); } } while (0)
#define PG8_BWAIT(n) do { if constexpr (BF) asm volatile("s_waitcnt vmcnt(" #n ")" : "+v"(bq[0]), "+v"(bq[1]), "+v"(bq[2]), "+v"(bq[3]), "+v"(bq[4]), "+v"(bq[5]), "+v"(bq[6]), "+v"(bq[7]) :: "memory"); } while (0)
#define PG8_BCONS(b_, kt_) do { if constexpr (BF) { const unsigned ad_ = (unsigned)(size_t)lds + (unsigned)PG8_SB(b_, 0) + bf_dst; \
        if constexpr (BGAIN) { { const f32x4 g_ = *(const LAS f32x4*)(bgl + (kt_) * 64 + bf_kb); bq[0] = bq[0] * g_.x; bq[1] = bq[1] * g_.y; bq[2] = bq[2] * g_.z; bq[3] = bq[3] * g_.w; } \
                               { const f32x4 g_ = *(const LAS f32x4*)(bgl + (kt_) * 64 + bf_kb + 4); bq[4] = bq[4] * g_.x; bq[5] = bq[5] * g_.y; bq[6] = bq[6] * g_.z; bq[7] = bq[7] * g_.w; } } \
        _Pragma("unroll") for (int c_ = 0; c_ < 4; ++c_) { const u32x4 o_ = (u32x4){cvtpk(bq[0][c_], bq[1][c_]), cvtpk(bq[2][c_], bq[3][c_]), cvtpk(bq[4][c_], bq[5][c_]), cvtpk(bq[6][c_], bq[7][c_])}; \
            asm volatile("ds_write_b128 %0, %1 offset:%2" :: "v"(ad_), "v"(o_), "i"(c_ * 64) : "memory"); } } } while (0)
#define PG8_GSETUP(set, pm_) do { if constexpr (GATHER) { int R0_, C0_, R1_, C1_; stage_rc(tid * 16, R0_, C0_); stage_rc(tid * 16 + 8192, R1_, C1_); \
        const GAS int* gi_ = (const GAS int*)gidx + (pm_) * 256; const int r00_ = gi_[R0_], r01_ = gi_[R1_], r10_ = gi_[128 + R0_], r11_ = gi_[128 + R1_];     \
        *(LAS u32x4*)(xl + (set) * 8192 + xoffA) = (u32x4){(unsigned)(r00_ * lda + C0_ * 2), (unsigned)(r01_ * lda + C1_ * 2), (unsigned)(r10_ * lda + C0_ * 2), (unsigned)(r11_ * lda + C1_ * 2)}; } } while (0)
#define PG8_SA(b, h) (((b) * 2 + (h)) * HTB)
#define PG8_SB(b, h) ((4 + (b) * 2 + (h)) * HTB)
#define PG8_STAGE(bufoff, gbase, voff) do { _Pragma("unroll") for (int _i = 0; _i < 2; ++_i) \
        __builtin_amdgcn_global_load_lds((const unsigned*)((const char*)(gbase) + (voff)[_i]), (LAS unsigned*)(lds + (bufoff) + ldsw + _i * 8192), 16, 0, 0); } while (0)
#define PG8_GOFF(h_, set_) u32x2 go_ = {0u, 0u}; if constexpr (GATHER) go_ = *(const LAS u32x2*)(xl + (set_) * 8192 + xoffA + (h_) * 8)
#define PG8_STAGE_A(bufoff, gbase, h_, set_) do { if constexpr (GATHER) { \
        __builtin_amdgcn_global_load_lds((const unsigned*)((const char*)(gbase) + go_.x), (LAS unsigned*)(lds + (bufoff) + ldsw), 16, 0, 0); \
        __builtin_amdgcn_global_load_lds((const unsigned*)((const char*)(gbase) + go_.y), (LAS unsigned*)(lds + (bufoff) + ldsw + 8192), 16, 0, 0); } \
      else { PG8_STAGE(bufoff, (const char*)(gbase) + (h_) * hstepA, voffA); } } while (0)
#define PG8_LDA(dst, b, h) do { _Pragma("unroll") for (int m = 0; m < 4; ++m) _Pragma("unroll") for (int k = 0; k < 2; ++k) dst[m][k] = *(const LAS bf16x8*)(lds + PG8_SA(b, h) + aoff + m * 2048 + k * 1024); } while (0)
#define PG8_LDB(dst, b, h) do { _Pragma("unroll") for (int n = 0; n < 2; ++n) _Pragma("unroll") for (int k = 0; k < 2; ++k) dst[n][k] = *(const LAS bf16x8*)(lds + PG8_SB(b, h) + boff + n * 2048 + k * 1024); } while (0)
#define PG8_MMA(ai, bj, At, Bt) do { __builtin_amdgcn_s_setprio(1); _Pragma("unroll") for (int m = 0; m < 4; ++m) _Pragma("unroll") for (int n = 0; n < 2; ++n) _Pragma("unroll") for (int k = 0; k < 2; ++k) \
        acc[ai][bj][m][n] = __builtin_amdgcn_mfma_f32_16x16x32_bf16(Bt[n][k], At[m][k], acc[ai][bj][m][n], 0, 0, 0); __builtin_amdgcn_s_setprio(0); } while (0)
#define PG8_WAIT_V(n) asm volatile("s_waitcnt vmcnt(" #n ")" ::: "memory")
#define PG8_WAIT_L(n) asm volatile("s_waitcnt lgkmcnt(" #n ")" ::: "memory")
#define PG8_BAR __builtin_amdgcn_s_barrier()
#define PG8_SCHED __builtin_amdgcn_sched_barrier(0)
    Unit cur, nxt; int ui = 0;
    if (!S.next(0, cur)) return;
    EpiCtx ctx; ctx.wr = wr; ctx.wc = wc; ctx.wid = wid; ctx.xl = xl;
    f32x4 acc[2][2][4][2];
#pragma unroll
    for (int a = 0; a < 2; ++a)
#pragma unroll
        for (int b = 0; b < 2; ++b)
#pragma unroll
            for (int m = 0; m < 4; ++m)
#pragma unroll
                for (int n = 0; n < 2; ++n) acc[a][b][m][n] = (f32x4){0.f, 0.f, 0.f, 0.f};
    bf16x8 At[4][2], B0[2][2], B1[2][2];
    const char* cA = cur.a; const char* cB = cur.b;
    PG8_GSETUP(0, cur.pm);
    const size_t kstepB = BF ? (size_t)BK * ldb : kstep;
    if constexpr (BF) {
        PG8_BISSUE(cB); { PG8_GOFF(0, 0); PG8_STAGE_A(PG8_SA(0, 0), cA, 0, 0); } { PG8_GOFF(1, 0); PG8_STAGE_A(PG8_SA(0, 1), cA, 1, 0); }
        if (wr == 1) PG8_BAR;
        PG8_BWAIT(2); PG8_BCONS(0, 0); PG8_WAIT_L(0); PG8_BAR;
        { PG8_GOFF(0, 0); PG8_STAGE_A(PG8_SA(1, 0), cA + kstep, 0, 0); } PG8_BISSUE(cB + kstepB);
        PG8_WAIT_V(10); PG8_BAR;
    } else if constexpr (SP2) {
        PG8_STAGE(PG8_SB(0, 0), cB, voffB); PG8_STAGE(PG8_SB(0, 1), cB + hstepB, voffB); { PG8_GOFF(0, 0); PG8_STAGE_A(PG8_SA(0, 0), cA, 0, 0); } { PG8_GOFF(1, 0); PG8_STAGE_A(PG8_SA(0, 1), cA, 1, 0); }
        if (wr == 1) PG8_BAR;
        PG8_WAIT_V(2); PG8_BAR;
        PG8_STAGE(PG8_SB(1, 0), cB + kstep, voffB); { PG8_GOFF(0, 0); PG8_STAGE_A(PG8_SA(1, 0), cA + kstep, 0, 0); } PG8_STAGE(PG8_SB(1, 1), cB + hstepB + kstep, voffB);
        PG8_WAIT_V(6); PG8_BAR;
    } else {
        PG8_STAGE(PG8_SB(0, 0), cB, voffB); PG8_STAGE(PG8_SA(0, 0), cA, voffA); PG8_STAGE(PG8_SB(0, 1), cB + hstepB, voffB); PG8_STAGE(PG8_SA(0, 1), cA + hstepA, voffA);
        if (wr == 1) PG8_BAR;
        PG8_WAIT_V(4); PG8_BAR;
        PG8_STAGE(PG8_SB(1, 0), cB + kstep, voffB); PG8_STAGE(PG8_SA(1, 0), cA + kstep, voffA); PG8_STAGE(PG8_SB(1, 1), cB + hstepB + kstep, voffB);
        PG8_WAIT_V(6); PG8_BAR;
    }
    for (;;) {
        const bool has_next = S.next(ui + 1, nxt);
        const char* nA = has_next ? nxt.a : cA; const char* nB = has_next ? nxt.b : cB;
        if (has_next) PG8_GSETUP(gset ^ 1, nxt.pm);
        for (int t = 0; t < nt; t += 2) {
            const bool last = (t == nt - 2);
            const char* a1 = cA + (size_t)(t + 1) * kstep;
            const char* a2 = last ? nA : cA + (size_t)(t + 2) * kstep; const char* b2 = last ? nB : cB + (size_t)(t + 2) * kstepB;
            const char* a3 = a2 + kstep; const char* b3 = b2 + kstepB;
            const int set2 = (last && has_next) ? (gset ^ 1) : gset;
            if constexpr (BF) {
            const int kt2 = last ? 0 : t + 2;
            { PG8_GOFF(1, gset); PG8_LDB(B0, 0, 0); PG8_LDB(B1, 0, 1); PG8_SCHED; PG8_LDA(At, 0, 0); PG8_STAGE_A(PG8_SA(1, 1), a1, 1, gset); }
            PG8_WAIT_V(12); PG8_WAIT_L(0); PG8_BAR; PG8_MMA(0, 0, At, B0); PG8_MMA(0, 1, At, B1); PG8_BAR; PG8_SCHED;
            { PG8_GOFF(0, set2); PG8_LDA(At, 0, 1); PG8_STAGE_A(PG8_SA(0, 0), a2, 0, set2); PG8_SCHED; PG8_BWAIT(4); PG8_BCONS(1, t + 1); PG8_SCHED; PG8_BISSUE(b2); }
            PG8_WAIT_L(0); PG8_BAR; PG8_MMA(1, 0, At, B0); PG8_MMA(1, 1, At, B1); PG8_BAR; PG8_SCHED;
            { PG8_GOFF(1, set2); PG8_LDB(B0, 1, 0); PG8_LDB(B1, 1, 1); PG8_SCHED; PG8_LDA(At, 1, 0); PG8_STAGE_A(PG8_SA(0, 1), a2, 1, set2); }
            PG8_WAIT_V(12); PG8_WAIT_L(0); PG8_BAR; PG8_MMA(0, 0, At, B0); PG8_MMA(0, 1, At, B1); PG8_BAR; PG8_SCHED;
            { PG8_GOFF(0, set2); PG8_LDA(At, 1, 1); PG8_STAGE_A(PG8_SA(1, 0), a3, 0, set2); PG8_SCHED; PG8_BWAIT(4); PG8_BCONS(0, kt2); PG8_SCHED; PG8_BISSUE(b3); }
            PG8_WAIT_L(0); PG8_BAR; PG8_MMA(1, 0, At, B0); PG8_MMA(1, 1, At, B1); PG8_BAR; PG8_SCHED;
            } else if constexpr (SP2) {
            { PG8_GOFF(1, gset); PG8_LDB(B0, 0, 0); PG8_LDB(B1, 0, 1); PG8_SCHED; PG8_LDA(At, 0, 0); PG8_STAGE_A(PG8_SA(1, 1), a1, 1, gset); }
            PG8_WAIT_V(8); PG8_WAIT_L(0); PG8_BAR; PG8_MMA(0, 0, At, B0); PG8_MMA(0, 1, At, B1); PG8_BAR; PG8_SCHED;
            { PG8_GOFF(0, set2); PG8_LDA(At, 0, 1); PG8_STAGE(PG8_SB(0, 0), b2, voffB); PG8_STAGE(PG8_SB(0, 1), b2 + hstepB, voffB); PG8_STAGE_A(PG8_SA(0, 0), a2, 0, set2); }
            PG8_WAIT_V(8); PG8_WAIT_L(0); PG8_BAR; PG8_MMA(1, 0, At, B0); PG8_MMA(1, 1, At, B1); PG8_BAR; PG8_SCHED;
            { PG8_GOFF(1, set2); PG8_LDB(B0, 1, 0); PG8_LDB(B1, 1, 1); PG8_SCHED; PG8_LDA(At, 1, 0); PG8_STAGE_A(PG8_SA(0, 1), a2, 1, set2); }
            PG8_WAIT_V(8); PG8_WAIT_L(0); PG8_BAR; PG8_MMA(0, 0, At, B0); PG8_MMA(0, 1, At, B1); PG8_BAR; PG8_SCHED;
            { PG8_GOFF(0, set2); PG8_LDA(At, 1, 1); PG8_STAGE(PG8_SB(1, 0), b3, voffB); PG8_STAGE(PG8_SB(1, 1), b3 + hstepB, voffB); PG8_STAGE_A(PG8_SA(1, 0), a3, 0, set2); }
            PG8_WAIT_V(8); PG8_WAIT_L(0); PG8_BAR; PG8_MMA(1, 0, At, B0); PG8_MMA(1, 1, At, B1); PG8_BAR; PG8_SCHED;
            } else {
            PG8_LDB(B0, 0, 0); PG8_SCHED; PG8_LDA(At, 0, 0); PG8_STAGE(PG8_SA(1, 1), a1 + hstepA, voffA);
            PG8_WAIT_L(8); PG8_BAR; PG8_WAIT_L(0); PG8_MMA(0, 0, At, B0); PG8_BAR; PG8_SCHED;
            PG8_LDB(B1, 0, 1); PG8_STAGE(PG8_SB(0, 0), b2, voffB);
            PG8_BAR; PG8_WAIT_L(0); PG8_MMA(0, 1, At, B1); PG8_BAR;
            PG8_LDA(At, 0, 1); PG8_STAGE(PG8_SA(0, 0), a2, voffA);
            PG8_BAR; PG8_WAIT_L(0); PG8_MMA(1, 0, At, B0); PG8_BAR; PG8_SCHED;
            PG8_STAGE(PG8_SB(0, 1), b2 + hstepB, voffB);
            PG8_WAIT_V(6); PG8_BAR; PG8_MMA(1, 1, At, B1); PG8_BAR;
            PG8_LDB(B0, 1, 0); PG8_SCHED; PG8_LDA(At, 1, 0); PG8_STAGE(PG8_SA(0, 1), a2 + hstepA, voffA);
            PG8_WAIT_L(8); PG8_BAR; PG8_WAIT_L(0); PG8_MMA(0, 0, At, B0); PG8_BAR; PG8_SCHED;
            PG8_LDB(B1, 1, 1); PG8_STAGE(PG8_SB(1, 0), b3, voffB);
            PG8_BAR; PG8_WAIT_L(0); PG8_MMA(0, 1, At, B1); PG8_BAR;
            PG8_LDA(At, 1, 1); PG8_STAGE(PG8_SA(1, 0), a3, voffA);
            PG8_BAR; PG8_WAIT_L(0); PG8_MMA(1, 0, At, B0); PG8_BAR; PG8_SCHED;
            PG8_STAGE(PG8_SB(1, 1), b3 + hstepB, voffB);
            PG8_WAIT_V(6); PG8_BAR; PG8_MMA(1, 1, At, B1); PG8_BAR;
            }
        }
        PG8_BWAIT(0);
        if constexpr (ALIGN_EPI) { if (wr == 0) PG8_BAR; }
        E(acc, cur, ctx);
        if (!has_next) break;
#pragma unroll
        for (int a = 0; a < 2; ++a)
#pragma unroll
            for (int b = 0; b < 2; ++b)
#pragma unroll
                for (int m = 0; m < 4; ++m)
#pragma unroll
                    for (int n = 0; n < 2; ++n) acc[a][b][m][n] = (f32x4){0.f, 0.f, 0.f, 0.f};
        cur = nxt; cA = nA; cB = nB; ++ui; gset ^= 1;
        if constexpr (ALIGN_EPI) { if (wr == 1) PG8_BAR; }
    }
    PG8_WAIT_V(0);
    if constexpr (!ALIGN_EPI) { if (wr == 0) PG8_BAR; }
    PG8_BAR;
#undef PG8_SA
#undef PG8_SB
#undef PG8_STAGE
#undef PG8_STAGE_A
#undef PG8_GOFF
#undef PG8_GSETUP
#undef PG8_BISSUE
#undef PG8_BWAIT
#undef PG8_BCONS
#undef PG8_LDA
#undef PG8_LDB
#undef PG8_MMA
#undef PG8_WAIT_V
#undef PG8_WAIT_L
#undef PG8_BAR
#undef PG8_SCHED
}
}

constexpr size_t MiB = 1u << 20;
constexpr size_t WS_CTL = 0, CTL_ZERO_BYTES = 1 * MiB;
constexpr size_t WS_WIN_T = 1 * MiB, WS_WF_T = 11 * MiB, WS_WOUT_T = 15 * MiB, WS_WCQ_T = 23 * MiB, WS_WCK_T = 39 * MiB, WS_WCV_T = 55 * MiB, WS_WCO_T = 71 * MiB;
constexpr size_t WS_WP_T = 87 * MiB, WS_DFT = 89 * MiB, WS_ROPE = 105 * MiB, WS_WGU_T = 106 * MiB, WS_WD_T = 234 * MiB;
constexpr size_t WS_HN = 298 * MiB, WS_XB = 330 * MiB, WS_QB = 362 * MiB, WS_KB = 386 * MiB, WS_VB = 394 * MiB, WS_FPQ = 402 * MiB, WS_MIXB = 418 * MiB, WS_QCB = 450 * MiB;
constexpr size_t WS_KCB = 482 * MiB, WS_VTB = 490 * MiB, WS_MEMNB = 498 * MiB, WS_PB = 506 * MiB, WS_XSB = 522 * MiB, WS_ACTB = 586 * MiB, WS_YB = 618 * MiB;
constexpr size_t WS_SSP = 682 * MiB, WS_AFF = 683 * MiB, WS_RANK = 684 * MiB, WS_GATE = 685 * MiB, WS_XALT = 686 * MiB, WS_WGU_T2 = 750 * MiB, WS_WD_T2 = 878 * MiB, WS_FAST_END = 942 * MiB;
constexpr int CW_TMO = 0, CW_CODE = 1, CW_BAR = 4096;
constexpr int RING_OFF = 0, RING_BYTES = 131072, XL_OFF = 131072, XL_BYTES = 16384, LDSCTL_OFF = XL_OFF + XL_BYTES, MISC_OFF = LDSCTL_OFF + 320, LDS_BYTES = 149504;
static_assert(MISC_OFF + 128 <= LDS_BYTES, "LDS map");
constexpr int NWAVES = 8;

typedef GAS unsigned gu32;
#define RLX_AGENT __ATOMIC_RELAXED, __HIP_MEMORY_SCOPE_AGENT

#define XB_TMO      128
#define XB_XCNT(j)  (256  + 64 * (j))
#define XB_XSUB(j)  (1280 + 64 * (j))
#define XB_XGEN(j)  (2304 + 64 * (j))
#define XB_TOP      3328
#define XB_TOPGEN   3392
#define XCD_BAR_WORDS 3456
#define XB_SPIN_CAP (1u << 18)
__device__ __forceinline__ unsigned xb_ld(unsigned* p)              { return __hip_atomic_load(p, __ATOMIC_RELAXED, __HIP_MEMORY_SCOPE_AGENT); }
__device__ __forceinline__ unsigned xb_add(unsigned* p, unsigned v) { return __hip_atomic_fetch_add(p, v, __ATOMIC_RELAXED, __HIP_MEMORY_SCOPE_AGENT); }
__device__ __forceinline__ unsigned xb_xcc_id() { return (unsigned)__builtin_amdgcn_s_getreg((3 << 11) | 20) & 0xFu; }
#define XB_SPIN(cond, bar) do { unsigned _sp = 0; while (cond) { __builtin_amdgcn_s_sleep(1); \
    if ((++_sp & 255u) == 0u) { if (xb_ld(&(bar)[XB_TMO])) break; if (_sp > XB_SPIN_CAP) { atomicAdd(&(bar)[XB_TMO], 1u); break; } } } } while (0)
struct XcdBarrier { unsigned* bar; unsigned x; volatile LAS unsigned* st; int wave; };
__device__ __forceinline__ XcdBarrier xcd_barrier_post(unsigned* bar, volatile LAS unsigned* st, int wave) {
    XcdBarrier b; b.bar = bar; b.x = xb_xcc_id(); b.st = st; b.wave = wave;
    if (wave == 0 && lane_id() == 0) (void)xb_add(&bar[XB_XCNT(b.x)], 1u);
    return b;
}
__device__ __forceinline__ void xcd_barrier_complete(unsigned* bar, unsigned x, unsigned& nloc, unsigned& nx) {
    const unsigned G = gridDim.x * gridDim.y * gridDim.z;
    unsigned sum, cnt, mine, sp = 0u;
    for (;;) {
        sum = 0u; cnt = 0u; mine = 0u;
#pragma unroll
        for (unsigned j = 0; j < 16; ++j) { const unsigned c = xb_ld(&bar[XB_XCNT(j)]); sum += c; cnt += (c > 0u) ? 1u : 0u; mine = (j == x) ? c : mine; }
        if (sum == G) break;
        __builtin_amdgcn_s_sleep(1);
        if ((++sp & 255u) == 0u) { if (xb_ld(&bar[XB_TMO])) break; if (sp > XB_SPIN_CAP) { atomicAdd(&bar[XB_TMO], 1u); break; } }
    }
    nloc = mine > 0u ? mine : 1u; nx = cnt > 0u ? cnt : 1u;
}
__device__ __forceinline__ void xcd_barrier(const XcdBarrier& b) {
    asm volatile("s_waitcnt vmcnt(0)" ::: "memory");
    __syncthreads();
    if (b.wave == 0 && lane_id() == 0) {
        unsigned* bar = b.bar;
        __builtin_amdgcn_s_waitcnt(0);
        unsigned nloc = b.st[0], nx = b.st[1];
        if (nloc == 0u) { xcd_barrier_complete(bar, b.x, nloc, nx); b.st[0] = nloc; b.st[1] = nx; }
        const unsigned old = xb_add(&bar[XB_XSUB(b.x)], 1u);
        const unsigned gen = old / nloc;
        if (old + 1u == (gen + 1u) * nloc) {
            __builtin_amdgcn_fence(__ATOMIC_RELEASE, "agent");
            asm volatile("s_waitcnt vmcnt(0)" ::: "memory");
            const unsigned og = xb_add(&bar[XB_TOP], 1u);
            const unsigned tg = og / nx;
            if (og + 1u == (tg + 1u) * nx) xb_add(&bar[XB_TOPGEN], 1u);
            else XB_SPIN(xb_ld(&bar[XB_TOPGEN]) == tg, bar);
            __builtin_amdgcn_fence(__ATOMIC_ACQUIRE, "agent");
            xb_add(&bar[XB_XGEN(b.x)], 1u);
            asm volatile("s_waitcnt vmcnt(0)" ::: "memory");
        } else {
            XB_SPIN(xb_ld(&bar[XB_XGEN(b.x)]) == gen, bar);
            __builtin_amdgcn_fence(__ATOMIC_ACQUIRE, "agent");
            asm volatile("s_waitcnt vmcnt(0)" ::: "memory");
        }
    }
    __syncthreads();
}

struct Args { const float* in[22]; float* out; unsigned char* ws; int ph_lo, ph_hi, li, pad; };
struct Frame {
    LAS unsigned char* lds; volatile LAS unsigned* MISC; gu32* ctl;
    int wave, vcu, G;
    unsigned char* ws;
};
__device__ __forceinline__ float wave_sum(float v) {
#pragma unroll
    for (int o = 1; o < 64; o <<= 1) v += __shfl_xor(v, o);
    return v;
}
struct TrDesc { const float* W; const float* gain; bf16_t* WT; int ldw, ldt, k0, n0; long drow0; };
__device__ __forceinline__ void tr_load(const TrDesc& d, f32x4 (&v)[16], int lane) {
    const int lr = lane >> 4, lc = (lane & 15) * 4;
#pragma unroll
    for (int i = 0; i < 16; ++i) v[i] = __builtin_nontemporal_load((const GAS f32x4*)(d.W + (size_t)(d.k0 + 4 * i + lr) * d.ldw + d.n0 + lc));
}
#ifndef TRV
#define TRV 0
#endif
template <int V> __device__ __forceinline__ void tr_finish(const TrDesc& d, const f32x4 (&v)[16], LAS float* scr, int lane) {
    const int lr = lane >> 4, lc = (lane & 15) * 4;
    if (V == 1) { f32x4 s = v[0]; for (int i = 1; i < 16; ++i) s = s + v[i]; if (s.x == 1.2345e30f) *(GAS f32x4*)(d.WT) = s; return; }
#pragma unroll
    for (int i = 0; i < 16; ++i) { const int kk = 4 * i + lr; f32x4 x = v[i]; if (d.gain) x = x * d.gain[d.k0 + kk];
        LAS float* s = scr + kk * 65 + lc; s[0] = x.x; s[1] = x.y; s[2] = x.z; s[3] = x.w; }
    LDS_WAIT(); asm volatile("" ::: "memory");
    const int c = lane & 7;
#pragma unroll
    for (int j = 0; j < 8; ++j) { const int n = (lane >> 3) + 8 * j; const LAS float* s = scr + (8 * c) * 65 + n;
        u32x4 o; o.x = cvtpk(s[0 * 65], s[1 * 65]); o.y = cvtpk(s[2 * 65], s[3 * 65]); o.z = cvtpk(s[4 * 65], s[5 * 65]); o.w = cvtpk(s[6 * 65], s[7 * 65]);
        if (V == 0 || o.x == 0x12345678u) __builtin_nontemporal_store(o, (GAS u32x4*)(d.WT + (size_t)(d.drow0 + n) * d.ldt + d.k0 + 8 * c)); }
    LDS_WAIT(); asm volatile("" ::: "memory");
}
#ifndef TR_PIPE
#define TR_PIPE 0
#endif
constexpr int TR_DENSE = 32 * 20 + 5 * 32 * 16, TR_DEFER = 4 * 32 * 16 + 32 * 4, TR_EXPERT = NE * 512;
__device__ __forceinline__ TrDesc tr_desc(karg_t ka, unsigned char* ws, int it, int mode) {
    TrDesc d; d.gain = nullptr;
    constexpr int I_IN = 32 * 20, I_SQ = 32 * 16;
    if (mode == 0 || mode == 3) {
        int r = it;
        if (mode == 0) {
            if (r < I_IN) { d.W = KIN(ka, 3); d.ldw = INW; d.WT = (bf16_t*)(ws + WS_WIN_T); d.ldt = DM; d.k0 = (r / 20) * 64; d.n0 = (r % 20) * 128; d.drow0 = d.n0; return d; } r -= I_IN;
            if (r < I_SQ) { d.W = KIN(ka, 7); d.ldw = DM; d.WT = (bf16_t*)(ws + WS_WOUT_T); d.ldt = DM; d.k0 = (r / 16) * 64; d.n0 = (r % 16) * 128; d.drow0 = d.n0; return d; } r -= I_SQ;
        }
        if (r < 4 * I_SQ) { const int j = r / I_SQ, q = r % I_SQ, layer = mode == 0 ? 0 : 1, wsel = mode == 0 ? j : (j == 0 ? 1 : j == 1 ? 2 : j == 2 ? 0 : 3);
            d.W = KIN(ka, 12 + wsel) + (size_t)layer * DM * DM; d.ldw = DM; if (wsel == 0) d.gain = KIN(ka, 10) + layer * DM;
            d.WT = (bf16_t*)(ws + (wsel == 0 ? WS_WCQ_T : wsel == 1 ? WS_WCK_T : wsel == 2 ? WS_WCV_T : WS_WCO_T) + (size_t)layer * DM * DM * 2); d.ldt = DM;
            d.k0 = (q / 16) * 64; d.n0 = (q % 16) * 128; d.drow0 = d.n0; return d; } r -= 4 * I_SQ;
        d.W = KIN(ka, 8); d.ldw = 512; d.WT = (bf16_t*)(ws + WS_WP_T); d.ldt = DM; d.k0 = (r / 4) * 64; d.n0 = (r % 4) * 128; d.drow0 = d.n0; return d;
    }
    const int layer = mode - 1;
    const int e = it / 512, r = it % 512; const size_t eo = (size_t)(layer * NE + e);
    { const int up = r >> 8, q = r & 255, kb = q >> 3, nb = q & 7, n0 = nb * 128;
        d.W = (up ? KIN(ka, 19) : KIN(ka, 18)) + eo * DM * EFF; d.ldw = EFF; d.gain = KIN(ka, 16) + layer * DM;   d.WT = (bf16_t*)(ws + (layer ? WS_WGU_T2 : WS_WGU_T)) + (size_t)e * 2048 * 2048; d.ldt = 2048;
        d.k0 = kb * 64; d.n0 = n0; d.drow0 = (long)(n0 >> 7) * 256 + up * 128;
    }
    return d;
}
template <int V = 0> __device__ __forceinline__ void tr_span(const Frame& F, karg_t ka, unsigned char* ws, int mode, int first, int stride, int cnt) {
    const int lane = lane_id(); LAS float* scr = (LAS float*)(F.lds + RING_OFF + F.wave * 16640);
    if (cnt <= 0) return;
    f32x4 va[16], vb[16];
    TrDesc da = tr_desc(ka, ws, first, mode), db = da; db.n0 += 64; db.drow0 += 64;
    tr_load(da, va, lane); tr_load(db, vb, lane);
    for (int j = 0; j < cnt; ++j) {
        const bool more = j + 1 < cnt; TrDesc na = da, nb = db;
        if (more) { na = tr_desc(ka, ws, first + stride * (j + 1), mode); nb = na; nb.n0 += 64; nb.drow0 += 64; }
        tr_finish<V>(da, va, scr, lane); if (more) tr_load(na, va, lane);
        tr_finish<V>(db, vb, scr, lane); if (more) tr_load(nb, vb, lane);
        da = na; db = nb;
    }
}
__device__ __forceinline__ void rms_row_to_bf16(const float* xrow, const float* __restrict__ gain, bf16_t* orow, int lane) {
    const GAS f32x4* xr = (const GAS f32x4*)xrow + lane; const f32x4* gr = (const f32x4*)gain + lane;
    f32x4 v[8]; float s = 0.f;
#pragma unroll
    for (int j = 0; j < 8; ++j) { v[j] = xr[64 * j]; s += (v[j].x * v[j].x + v[j].y * v[j].y) + (v[j].z * v[j].z + v[j].w * v[j].w); }
    const float r = rsqrtf(wave_sum(s) * (1.f / DM) + EPS);
    GAS u32x2* o8 = (GAS u32x2*)orow + lane;
#pragma unroll
    for (int j = 0; j < 8; ++j) { const f32x4 g = gr[64 * j]; u32x2 w; w.x = cvtpk(v[j].x * r * g.x, v[j].y * r * g.y); w.y = cvtpk(v[j].z * r * g.z, v[j].w * r * g.w); o8[64 * j] = w; }
}

__device__ __forceinline__ void rms_rows2_to_bf16(const float* x0, const float* x1, const float* __restrict__ gain, bf16_t* o0, bf16_t* o1, int lane) {
    f32x4 a[4][2], b[4][2]; float sa = 0.f, sb = 0.f;
#pragma unroll
    for (int j = 0; j < 4; ++j) { const int c0 = 8 * (lane + 64 * j); a[j][0] = *(const GAS f32x4*)(x0 + c0); a[j][1] = *(const GAS f32x4*)(x0 + c0 + 4); b[j][0] = *(const GAS f32x4*)(x1 + c0); b[j][1] = *(const GAS f32x4*)(x1 + c0 + 4); }
#pragma unroll
    for (int j = 0; j < 4; ++j)
#pragma unroll
        for (int q = 0; q < 2; ++q) { sa += (a[j][q].x * a[j][q].x + a[j][q].y * a[j][q].y) + (a[j][q].z * a[j][q].z + a[j][q].w * a[j][q].w); sb += (b[j][q].x * b[j][q].x + b[j][q].y * b[j][q].y) + (b[j][q].z * b[j][q].z + b[j][q].w * b[j][q].w); }
    const float ra = rsqrtf(wave_sum(sa) * (1.f / DM) + EPS), rb = rsqrtf(wave_sum(sb) * (1.f / DM) + EPS);
#pragma unroll
    for (int j = 0; j < 4; ++j) { const int c0 = 8 * (lane + 64 * j); const f32x4 g0 = *(const f32x4*)(gain + c0), g1 = *(const f32x4*)(gain + c0 + 4);
        *(GAS u32x4*)(o0 + c0) = (u32x4){cvtpk(a[j][0].x * ra * g0.x, a[j][0].y * ra * g0.y), cvtpk(a[j][0].z * ra * g0.z, a[j][0].w * ra * g0.w), cvtpk(a[j][1].x * ra * g1.x, a[j][1].y * ra * g1.y), cvtpk(a[j][1].z * ra * g1.z, a[j][1].w * ra * g1.w)};
        *(GAS u32x4*)(o1 + c0) = (u32x4){cvtpk(b[j][0].x * rb * g0.x, b[j][0].y * rb * g0.y), cvtpk(b[j][0].z * rb * g0.z, b[j][0].w * rb * g0.w), cvtpk(b[j][1].x * rb * g1.x, b[j][1].y * rb * g1.y), cvtpk(b[j][1].z * rb * g1.z, b[j][1].w * rb * g1.w)}; }
}

__device__ __forceinline__ void p0_prologue(Frame& F, karg_t ka, unsigned char* ws) {
    const float* x = KIN(ka, 0); const float* mem = KIN(ka, 1); const float* mix_norm = KIN(ka, 2); const float* w_in = KIN(ka, 3);
    const float* w_four = KIN(ka, 6); const float* w_out = KIN(ka, 7); const float* pool_w = KIN(ka, 8); const float* cross_norm = KIN(ka, 10); const float* mem_norm = KIN(ka, 11);
    const int gw = F.vcu * NWAVES + F.wave, NGW = F.G * NWAVES;
    const int p_lane = lane_id(), p_tid = F.wave * 64 + p_lane;
    { LAS float* tab = (LAS float*)(F.lds + RING_OFF);
      for (int m = p_tid; m < 2048; m += 512) tab[m] = cosf(6.283185307179586f * (float)m * (1.0f / 2048.0f));
      __syncthreads();
      bf16_t* DFT = (bf16_t*)(ws + WS_DFT);
      for (int row = F.vcu * 8; row < 2048; row += F.G * 8)
          for (int rr = 0; rr < 8; ++rr) { const int k1 = row + rr; if (k1 >= 2048) break;
              { const int c0 = p_tid * 8; const int which = c0 >> 11, s0 = c0 & 2047; unsigned w[4];
#pragma unroll
                for (int j = 0; j < 4; ++j) { const int ma = (k1 * (s0 + 2 * j)) & 2047, mb = (k1 * (s0 + 2 * j + 1)) & 2047;
                    w[j] = cvtpk(tab[(ma - which * 512) & 2047], tab[(mb - which * 512) & 2047]); }
                *(GAS u32x4*)(DFT + (size_t)k1 * 4096 + c0) = (u32x4){w[0], w[1], w[2], w[3]}; } }
      __syncthreads(); }
    { float* RC = (float*)(ws + WS_ROPE); float* RS = RC + SEQ * 64;
      for (int i = F.vcu * 512 + p_tid; i < SEQ * 64; i += F.G * 512) { const int t = i >> 6, p = i & 63; const int pos = (p < 32) ? (t >> 6) : (t & 63); const int j = p & 31;
          const float inv = 1.0f / powf(10000.0f, (float)(2 * j) / 64.0f); const float ang = (float)pos * inv; RC[i] = cosf(ang); RS[i] = sinf(ang); } }
    { u32x4* RB = (u32x4*)(ws + WS_AFF + 512 * 1024);
      for (int i = F.vcu * 512 + p_tid; i < 2 * 64 * 64; i += F.G * 512) { const int layer = i >> 12, ks = (i >> 6) & 63, ln = i & 63, e = ln & 15, k0 = 32 * ks + 8 * (ln >> 4);
          const float* Wr = KIN(ka, 17) + (size_t)layer * DM * NE; const float* gn = KIN(ka, 16) + layer * DM; float w[8], lo[8];
#pragma unroll
          for (int j = 0; j < 8; ++j) { w[j] = gn[k0 + j] * Wr[(size_t)(k0 + j) * NE + e]; }
          u32x4 hi4 = {cvtpk(w[0], w[1]), cvtpk(w[2], w[3]), cvtpk(w[4], w[5]), cvtpk(w[6], w[7])};
          const unsigned hh[4] = {hi4.x, hi4.y, hi4.z, hi4.w};
#pragma unroll
          for (int j = 0; j < 4; ++j) { lo[2 * j] = w[2 * j] - __uint_as_float(hh[j] << 16); lo[2 * j + 1] = w[2 * j + 1] - __uint_as_float(hh[j] & 0xffff0000u); }
          RB[(size_t)(layer * 2 + 0) * 4096 + ks * 64 + ln] = hi4;
          RB[(size_t)(layer * 2 + 1) * 4096 + ks * 64 + ln] = (u32x4){cvtpk(lo[0], lo[1]), cvtpk(lo[2], lo[3]), cvtpk(lo[4], lo[5]), cvtpk(lo[6], lo[7])}; } }
    { LAS float* Mw = (LAS float*)(F.lds + RING_OFF); LAS float* t128 = Mw + 128 * 32;
      bf16_t* WF = (bf16_t*)(ws + WS_WF_T);
      for (int it = F.vcu; it < 256; it += F.G) {
          const int which = it >> 7, g = (it >> 5) & 3, d0 = ((it >> 3) & 3) * 32, k0 = (it & 7) * 256;
          if (p_tid < 128) t128[p_tid] = cosf(6.283185307179586f * (float)p_tid * (1.0f / 128.0f));
          __syncthreads();
          { const int c = p_tid >> 2, dd = (p_tid & 3) * 8; float o[8] = {0.f, 0.f, 0.f, 0.f, 0.f, 0.f, 0.f, 0.f};
#pragma unroll 16
            for (int k2 = 0; k2 < 128; ++k2) { const int m = (c * k2) & 127; const float tv = which ? -t128[(m - 32) & 127] : t128[m];
                const float* wr_ = w_four + ((size_t)g * 128 + k2) * 128 + d0 + dd; const f32x4 w0 = *(const f32x4*)wr_, w1 = *(const f32x4*)(wr_ + 4);
                o[0] += tv * w0.x; o[1] += tv * w0.y; o[2] += tv * w0.z; o[3] += tv * w0.w; o[4] += tv * w1.x; o[5] += tv * w1.y; o[6] += tv * w1.z; o[7] += tv * w1.w; }
#pragma unroll
            for (int j = 0; j < 8; ++j) Mw[c * 32 + dd + j] = o[j] * (1.0f / 512.0f); }
          __syncthreads();
          { const int kp = p_tid & 127, dq = p_tid >> 7, k = k0 + 2 * kp; float o0[8] = {0.f, 0.f, 0.f, 0.f, 0.f, 0.f, 0.f, 0.f}, o1[8] = {0.f, 0.f, 0.f, 0.f, 0.f, 0.f, 0.f, 0.f};
            const float* r0 = w_in + (size_t)k * INW + 2560 + g * 128; const float* r1 = r0 + INW;
#pragma unroll 8
            for (int c4 = 0; c4 < 32; ++c4) { const f32x4 a = *(const f32x4*)(r0 + 4 * c4), b = *(const f32x4*)(r1 + 4 * c4); const float av[4] = {a.x, a.y, a.z, a.w}, bv[4] = {b.x, b.y, b.z, b.w};
#pragma unroll
                for (int cc = 0; cc < 4; ++cc) { const LAS float* mr = Mw + (4 * c4 + cc) * 32 + dq * 8;
#pragma unroll
                    for (int j = 0; j < 8; ++j) { o0[j] += av[cc] * mr[j]; o1[j] += bv[cc] * mr[j]; } } }
#pragma unroll
            for (int j = 0; j < 8; ++j) *(GAS unsigned*)(WF + (size_t)(which * 512 + g * 128 + d0 + dq * 8 + j) * DM + k) = cvtpk(o0[j], o1[j]); }
          __syncthreads(); } }
    { const int n = (TR_DENSE - gw + NGW - 1) / NGW; tr_span(F, ka, ws, 0, gw, NGW, n > 0 ? n : 0); }
    __syncthreads();
    for (int m = 2 * gw; m < NTOK; m += 2 * NGW) rms_rows2_to_bf16(x + (size_t)m * DM, x + (size_t)(m + 1) * DM, mix_norm, (bf16_t*)(ws + WS_HN) + (size_t)m * DM, (bf16_t*)(ws + WS_HN) + (size_t)(m + 1) * DM, p_lane);
    for (int m = gw; m < 2 * NB * MEML; m += NGW) { const int l = m / (NB * MEML), r = m % (NB * MEML);
        rms_row_to_bf16(mem + (size_t)r * DM, mem_norm + l * DM, (bf16_t*)(ws + WS_MEMNB) + (size_t)m * DM, p_lane); }
}

struct MapLin { const char* A; const char* B; size_t as, bs; __device__ __forceinline__ void operator()(pg8::Unit& u) const { u.a = A + (size_t)u.pm * as; u.b = B + (size_t)u.pn * bs; } };

struct EpiQKV {
    static constexpr bool PERM = true;
    bf16_t* Q; bf16_t* K; bf16_t* V; const float* qg; const float* kg; const float* RC; const float* RS;
    __device__ __forceinline__ void operator()(f32x4 (&acc)[2][2][4][2], const pg8::Unit& u, const pg8::EpiCtx& c) const { const int e_lane = lane_id(), e_fr = e_lane & 15, e_fq = e_lane >> 4;
        const int pn = u.pn, hc = c.wc * 32 + e_fq * 8, rl0 = c.wr * 64 + e_fr;
        if (pn >= 8) {
            bf16_t* base = V + (size_t)(u.pm * 256 + rl0) * KVW + (pn - 8) * 256 + hc;
#pragma unroll
            for (int ai = 0; ai < 2; ++ai)
#pragma unroll
                for (int m = 0; m < 4; ++m) { bf16_t* rowp = base + (size_t)(ai * 128 + m * 16) * KVW;
#pragma unroll
                    for (int bj = 0; bj < 2; ++bj) { const f32x4 v0 = acc[ai][bj][m][0], v1 = acc[ai][bj][m][1];
                        st16((rowp + bj * 128), (u32x4){cvtpk(v0.x, v0.y), cvtpk(v0.z, v0.w), cvtpk(v1.x, v1.y), cvtpk(v1.z, v1.w)}); } }
            return;
        }
        LAS float* part = (LAS float*)c.xl;
#pragma unroll
        for (int ai = 0; ai < 2; ++ai)
#pragma unroll
            for (int m = 0; m < 4; ++m)
#pragma unroll
                for (int bj = 0; bj < 2; ++bj) { const f32x4 v0 = acc[ai][bj][m][0], v1 = acc[ai][bj][m][1];
                    float s = (v0.x * v0.x + v0.y * v0.y) + (v0.z * v0.z + v0.w * v0.w) + (v1.x * v1.x + v1.y * v1.y) + (v1.z * v1.z + v1.w * v1.w);
                    s += __shfl_xor(s, 16); s += __shfl_xor(s, 32);
                    if (e_fq == 0) part[((ai * 128 + rl0 + m * 16) * 2 + bj) * 4 + c.wc] = s; }
        WG_BAR();
        const float* gain = pn < 6 ? qg : kg;
        const f32x4 g0 = *(const f32x4*)(gain + hc), g1 = *(const f32x4*)(gain + hc + 4);
        bf16_t* O = pn < 6 ? Q : K; const int ld = pn < 6 ? AW : KVW; const int colbase = (pn < 6 ? pn : pn - 6) * 256 + hc;
#pragma unroll
        for (int ai = 0; ai < 2; ++ai)
#pragma unroll
            for (int m = 0; m < 4; ++m) { const int rl = ai * 128 + rl0 + m * 16, row = u.pm * 256 + rl, sp = row & (SEQ - 1);
                const f32x4 cs = *(const f32x4*)(RC + sp * 64 + (hc >> 1)), sn = *(const f32x4*)(RS + sp * 64 + (hc >> 1));
#pragma unroll
                for (int bj = 0; bj < 2; ++bj) { const f32x4 p4 = *(const LAS f32x4*)(part + (rl * 2 + bj) * 4);
                    const float r = rsqrtf(((p4.x + p4.y) + (p4.z + p4.w)) * (1.0f / 128.0f) + EPS);
                    const f32x4 v0 = acc[ai][bj][m][0] * r * g0, v1 = acc[ai][bj][m][1] * r * g1;
                    u32x4 w; w.x = cvtpk(v0.x * cs.x - v0.y * sn.x, v0.x * sn.x + v0.y * cs.x); w.y = cvtpk(v0.z * cs.y - v0.w * sn.y, v0.z * sn.y + v0.w * cs.y);
                    w.z = cvtpk(v1.x * cs.z - v1.y * sn.z, v1.x * sn.z + v1.y * cs.z); w.w = cvtpk(v1.z * cs.w - v1.w * sn.w, v1.z * sn.w + v1.w * cs.w);
                    st16((O + (size_t)row * ld + colbase + bj * 128), w); } }
    }
};


template <class AddrF> struct EpiStore {
    static constexpr bool PERM = true; AddrF f;
    __device__ __forceinline__ void operator()(f32x4 (&acc)[2][2][4][2], const pg8::Unit& u, const pg8::EpiCtx& c) const { const int e_lane = lane_id(), e_fr = e_lane & 15, e_fq = e_lane >> 4;
        const int hc = c.wc * 32 + e_fq * 8, rl0 = c.wr * 64 + e_fr;
#pragma unroll
        for (int ai = 0; ai < 2; ++ai)
#pragma unroll
            for (int m = 0; m < 4; ++m)
#pragma unroll
                for (int bj = 0; bj < 2; ++bj) { const f32x4 v0 = acc[ai][bj][m][0], v1 = acc[ai][bj][m][1];
                    st16(f(u, ai * 128 + rl0 + m * 16, bj * 128 + hc), (u32x4){cvtpk(v0.x, v0.y), cvtpk(v0.z, v0.w), cvtpk(v1.x, v1.y), cvtpk(v1.z, v1.w)}); }
    }
};
struct AddrF1 { bf16_t* FPQ; __device__ __forceinline__ bf16_t* operator()(const pg8::Unit& u, int rl, int tc) const {
    const int r = u.pm * 256 + rl, which = r >> 9, n = r & 511, cidx = u.pn * 256 + tc, b = cidx >> 11, s = cidx & 2047; return FPQ + (((size_t)(b * 512 + n) * 2 + which) * 2048 + s); } };
struct AddrF2 { bf16_t* MIX; __device__ __forceinline__ bf16_t* operator()(const pg8::Unit& u, int rl, int tc) const {
    const int row = (u.pn >> 1) * 2048 + u.pm * 256 + rl, col = AW + (u.pn & 1) * 256 + tc; return MIX + (size_t)row * DM + col; } };

template <bool BF32> struct EpiResB {
    static constexpr bool PERM = true;
    const void* base; bf16_t* xo; float* ssp; const float* cscale; bf16_t* xg; const float* gv;
    __device__ __forceinline__ void operator()(f32x4 (&acc)[2][2][4][2], const pg8::Unit& u, const pg8::EpiCtx& c) const { const int e_lane = lane_id(), e_fr = e_lane & 15, e_fq = e_lane >> 4;
        const int hc = c.wc * 32 + e_fq * 8, rl0 = c.wr * 64 + e_fr;
        LAS float* part = (LAS float*)c.xl;
#pragma unroll
        for (int ai = 0; ai < 2; ++ai) {
            f32x4 bf0[4][2], bf1[4][2]; u32x4 bb[4][2];
#pragma unroll
            for (int m = 0; m < 4; ++m)
#pragma unroll
                for (int bj = 0; bj < 2; ++bj) { const size_t off = (size_t)(u.pm * 256 + ai * 128 + rl0 + m * 16) * DM + u.pn * 256 + bj * 128 + hc;
                    if (BF32) { bf0[m][bj] = *(const f32x4*)((const float*)base + off); bf1[m][bj] = *(const f32x4*)((const float*)base + off + 4); }
                    else bb[m][bj] = *(const u32x4*)((const bf16_t*)base + off); }
#pragma unroll
            for (int m = 0; m < 4; ++m) { const int rl = ai * 128 + rl0 + m * 16; float s = 0.f;
#pragma unroll
                for (int bj = 0; bj < 2; ++bj) { const int col = u.pn * 256 + bj * 128 + hc; const size_t off = (size_t)(u.pm * 256 + rl) * DM + col;
                    f32x4 v0 = acc[ai][bj][m][0], v1 = acc[ai][bj][m][1];
                    if (cscale) { v0 = v0 * *(const f32x4*)(cscale + col); v1 = v1 * *(const f32x4*)(cscale + col + 4); }
                    if (BF32) { v0 = v0 + bf0[m][bj]; v1 = v1 + bf1[m][bj]; }
                    else { const u32x4 b = bb[m][bj];
                        v0.x += __uint_as_float(b.x << 16); v0.y += __uint_as_float(b.x & 0xffff0000u); v0.z += __uint_as_float(b.y << 16); v0.w += __uint_as_float(b.y & 0xffff0000u);
                        v1.x += __uint_as_float(b.z << 16); v1.y += __uint_as_float(b.z & 0xffff0000u); v1.z += __uint_as_float(b.w << 16); v1.w += __uint_as_float(b.w & 0xffff0000u); }
                    st16((xo + off), (u32x4){cvtpk(v0.x, v0.y), cvtpk(v0.z, v0.w), cvtpk(v1.x, v1.y), cvtpk(v1.z, v1.w)});
                    if (xg) { const f32x4 g0 = *(const f32x4*)(gv + col), g1 = *(const f32x4*)(gv + col + 4);
                        st16((xg + off), (u32x4){cvtpk(v0.x * g0.x, v0.y * g0.y), cvtpk(v0.z * g0.z, v0.w * g0.w), cvtpk(v1.x * g1.x, v1.y * g1.y), cvtpk(v1.z * g1.z, v1.w * g1.w)}); }
                    if (ssp) s += ((v0.x * v0.x + v0.y * v0.y) + (v0.z * v0.z + v0.w * v0.w)) + ((v1.x * v1.x + v1.y * v1.y) + (v1.z * v1.z + v1.w * v1.w)); }
                if (ssp) { s += __shfl_xor(s, 16); s += __shfl_xor(s, 32); if (e_fq == 0) part[rl * 4 + c.wc] = s; } }
            asm volatile("" ::: "memory"); }
        if (ssp) { WG_BAR();
            if (e_lane < 32) { const int row = c.wid * 32 + e_lane; const f32x4 p4 = *(const LAS f32x4*)(part + row * 4);
                ssp[(size_t)(u.pm * 256 + row) * 8 + u.pn] = (p4.x + p4.y) + (p4.z + p4.w); }
            WG_BAR(); }
    }
};

namespace attn {
using s16x4 = __attribute__((ext_vector_type(4))) short;
using f32x16 = __attribute__((ext_vector_type(16))) float;
constexpr int D = 128, NW = 8, QBLK = 32, KVBLK = 64;
constexpr float SCALE = 0.088388347648318440f;
constexpr float THR = 0.f;
#ifndef ATT_SDEPTH
#define ATT_SDEPTH 1
#endif
constexpr int LDQ = AW, LDK = KVW, LDO = DM;
constexpr size_t SHM_V = KVBLK * D * 2, SHM_K = KVBLK * D * 2, SHM_ATTN = 2 * SHM_V + 2 * SHM_K + NW * 64 * 4;
#define KSWZ(row, colB) ((row) * 256 + ((colB) ^ (((row) & 7) << 4)))
#define SBAR() __builtin_amdgcn_sched_barrier(0)
__device__ __forceinline__ int crow(int r, int hi) { return (r & 3) + 8 * (r >> 2) + 4 * hi; }
__device__ __forceinline__ unsigned cvtpk_a(float lo, float hi) { unsigned r; asm volatile("v_cvt_pk_bf16_f32 %0, %1, %2" : "=v"(r) : "v"(lo), "v"(hi)); return r; }
__device__ __forceinline__ void partialSM(f32x16& p0, f32x16& p1, float& m_reg, float& mn, float& alpha) {
  constexpr float C = SCALE * 1.4426950408889634f;
  float pmax = p0[0]; for (int r = 1; r < 16; ++r) pmax = fmaxf(pmax, p0[r]); for (int r = 0; r < 16; ++r) pmax = fmaxf(pmax, p1[r]);
  { auto rr = __builtin_amdgcn_permlane32_swap(__float_as_uint(pmax), __float_as_uint(pmax), false, false);
    pmax = fmaxf(__uint_as_float(rr[0]), __uint_as_float(rr[1])); }
  if (__builtin_expect(__all(pmax - m_reg <= THR / SCALE), 1)) { mn = m_reg; alpha = 1.f; }
  else { mn = fmaxf(m_reg, pmax); alpha = __builtin_amdgcn_exp2f((m_reg - mn) * C); m_reg = mn; }
  float mnC = -mn * C;
  for (int r = 0; r < 16; ++r) p0[r] = fmaf(p0[r], C, mnC); for (int r = 0; r < 16; ++r) p1[r] = fmaf(p1[r], C, mnC);
  for (int r = 0; r < 16; ++r) p0[r] = __builtin_amdgcn_exp2f(p0[r]);
}
__device__ __forceinline__ void finishSM(f32x16& p0, f32x16& p1, float alpha, float& l_reg, bf16x8& pa0, bf16x8& pa1, bf16x8& pa2, bf16x8& pa3) {
  for (int r = 0; r < 16; ++r) p1[r] = __builtin_amdgcn_exp2f(p1[r]);
  float ps = 0; for (int r = 0; r < 16; ++r) ps += p0[r]; for (int r = 0; r < 16; ++r) ps += p1[r];
  { auto rr = __builtin_amdgcn_permlane32_swap(__float_as_uint(ps), __float_as_uint(ps), false, false);
    ps = __uint_as_float(rr[0]) + __uint_as_float(rr[1]); }
  l_reg = l_reg * alpha + ps;
#define PK4(P, BASE, OUT) do { unsigned a0 = cvtpk_a(P[BASE + 0], P[BASE + 1]), a1 = cvtpk_a(P[BASE + 2], P[BASE + 3]);   \
    unsigned b0 = cvtpk_a(P[BASE + 4], P[BASE + 5]), b1 = cvtpk_a(P[BASE + 6], P[BASE + 7]);                              \
    auto r0 = __builtin_amdgcn_permlane32_swap(a0, b0, false, false); auto r1 = __builtin_amdgcn_permlane32_swap(a1, b1, false, false); \
    u32x4 w = {r0[0], r1[0], r0[1], r1[1]}; OUT = *reinterpret_cast<bf16x8*>(&w); } while (0)
  PK4(p0, 0, pa0); PK4(p0, 8, pa1); PK4(p1, 0, pa2); PK4(p1, 8, pa3);
#undef PK4
}
__device__ __forceinline__ void qkt(f32x16& p0, f32x16& p1, const bf16_t* Ks, const bf16x8* qr, int r32, int hi) {
  p0 = f32x16{}; p1 = f32x16{};
  for (int d0 = 0; d0 < 8; ++d0) { int cb = (d0 * 16 + hi * 8) * 2;
    bf16x8 b0 = *reinterpret_cast<const bf16x8*>((const char*)Ks + KSWZ(r32, cb));
    bf16x8 b1 = *reinterpret_cast<const bf16x8*>((const char*)Ks + KSWZ(32 + r32, cb));
    p0 = __builtin_amdgcn_mfma_f32_32x32x16_bf16(b0, qr[d0], p0, 0, 0, 0);
    p1 = __builtin_amdgcn_mfma_f32_32x32x16_bf16(b1, qr[d0], p1, 0, 0, 0); }
}
__device__ __forceinline__ int v_st(int k, int c) { const int kk = (k & ~0xC) | ((k & 4) << 1) | ((k & 8) >> 1); return ((kk >> 3) * 4 + (c >> 5)) * 512 + ((kk & 7) * 32 + (c & 31)) * 2; }
__device__ __forceinline__ int v_rd_base(int lane) { return ((lane & 3) << 3) | (((lane >> 2) & 3) << 6) | (((lane >> 4) & 1) << 5) | (((lane >> 5) & 1) << 8); }
constexpr int v_rd_off(int d0, int ks, int half) { return d0 * 512 + ks * 4096 + half * 2048; }
template <int OFF> __device__ __forceinline__ s16x4 tr_read(int vb) {
  s16x4 r; asm volatile("ds_read_b64_tr_b16 %0, %1 offset:%2" : "=&v"(r) : "v"(vb), "i"(OFF) : "memory"); return r;
}
template <int D0> __device__ __forceinline__ void pv_one(f32x16& od, int vb, bf16x8 pa0, bf16x8 pa1, bf16x8 pa2, bf16x8 pa3) {
  const s16x4 l0 = tr_read<v_rd_off(D0, 0, 0)>(vb), h0 = tr_read<v_rd_off(D0, 0, 1)>(vb), l1 = tr_read<v_rd_off(D0, 1, 0)>(vb), h1 = tr_read<v_rd_off(D0, 1, 1)>(vb);
  const s16x4 l2 = tr_read<v_rd_off(D0, 2, 0)>(vb), h2 = tr_read<v_rd_off(D0, 2, 1)>(vb), l3 = tr_read<v_rd_off(D0, 3, 0)>(vb), h3 = tr_read<v_rd_off(D0, 3, 1)>(vb);
  asm volatile("s_waitcnt lgkmcnt(0)" ::: "memory"); SBAR();
#define PK(L, H) (bf16x8){L[0], L[1], L[2], L[3], H[0], H[1], H[2], H[3]}
  od = __builtin_amdgcn_mfma_f32_32x32x16_bf16(pa0, PK(l0, h0), od, 0, 0, 0);
  od = __builtin_amdgcn_mfma_f32_32x32x16_bf16(pa1, PK(l1, h1), od, 0, 0, 0);
  od = __builtin_amdgcn_mfma_f32_32x32x16_bf16(pa2, PK(l2, h2), od, 0, 0, 0);
  od = __builtin_amdgcn_mfma_f32_32x32x16_bf16(pa3, PK(l3, h3), od, 0, 0, 0);
#undef PK
}
__device__ __forceinline__ void pv_d0(f32x16* o, int vb, bf16x8 pa0, bf16x8 pa1, bf16x8 pa2, bf16x8 pa3) {
  pv_one<0>(o[0], vb, pa0, pa1, pa2, pa3); pv_one<1>(o[1], vb, pa0, pa1, pa2, pa3); pv_one<2>(o[2], vb, pa0, pa1, pa2, pa3); pv_one<3>(o[3], vb, pa0, pa1, pa2, pa3);
}
__device__ __forceinline__ void attn_dense_body(const bf16_t* __restrict__ Qb, const bf16_t* __restrict__ Kh, const bf16_t* __restrict__ Vh,
                                                bf16_t* __restrict__ Ob, int seq, char* lds, const int wave_) {
  constexpr int SDEPTH = ATT_SDEPTH;
  const int lane = lane_id(), wid = wave_, tid = wid * 64 + lane, r32 = lane & 31, hi = lane >> 5;
  bf16_t* V_lds = (bf16_t*)lds; bf16_t* K_lds = (bf16_t*)(lds + 2 * SHM_V);
  float* ws = (float*)(lds + 2 * SHM_V + 2 * SHM_K) + wid * 64; float* li_l = ws; float* al_l = ws + 32;
  float m_reg = -1e30f, l_reg = 0; f32x16 o[4] = {}; bf16x8 qr[8];
  const bf16_t* Qw = Qb + (long)(wid * QBLK + r32) * LDQ + hi * 8;
#pragma unroll
  for (int d0 = 0; d0 < 8; ++d0) qr[d0] = *reinterpret_cast<const bf16x8*>(Qw + d0 * 16);
  const int sr = tid >> 4, sc = (tid & 15) * 8, vst0 = v_st(sr, sc), vst1 = v_st(32 + sr, sc);
  const int vb0 = (int)(uintptr_t)V_lds + v_rd_base(lane);
  struct { bf16x8 vs0, vs1, ks0, ks1; } sr_[SDEPTH];
#define SLOAD(i, k0) do { sr_[i].vs0 = *reinterpret_cast<const bf16x8*>(&Vh[(long)((k0) + sr) * LDK + sc]); sr_[i].vs1 = *reinterpret_cast<const bf16x8*>(&Vh[(long)((k0) + 32 + sr) * LDK + sc]); \
    sr_[i].ks0 = *reinterpret_cast<const bf16x8*>(&Kh[(long)((k0) + sr) * LDK + sc]); sr_[i].ks1 = *reinterpret_cast<const bf16x8*>(&Kh[(long)((k0) + 32 + sr) * LDK + sc]); } while (0)
#define SWRITE(b, i) do { *(bf16x8*)((char*)V_lds + (b) * SHM_V + vst0) = sr_[i].vs0;          \
    *(bf16x8*)((char*)V_lds + (b) * SHM_V + vst1) = sr_[i].vs1; int kc = sc * 2;               \
    *(bf16x8*)((char*)K_lds + (b) * SHM_K + KSWZ(sr, kc)) = sr_[i].ks0;                       \
    *(bf16x8*)((char*)K_lds + (b) * SHM_K + KSWZ(32 + sr, kc)) = sr_[i].ks1; } while (0)
#define SWAIT() do { if constexpr (SDEPTH == 2) asm volatile("s_waitcnt vmcnt(4)" ::: "memory"); else asm volatile("s_waitcnt vmcnt(0)" ::: "memory"); } while (0)
#define RESC(a) do { if (__any((a) < 1.f)) { if (hi == 0) al_l[r32] = (a); asm volatile("s_waitcnt lgkmcnt(0)" ::: "memory"); \
    for (int d = 0; d < 4; ++d) for (int r = 0; r < 16; ++r) o[d][r] *= al_l[crow(r, hi)]; } } while (0)
  f32x16 pA0, pA1, pB0, pB1; float mnA, mnB, alA, alB; bf16x8 pa0, pa1, pa2, pa3; const int NT = seq / KVBLK;
  constexpr int SE = 0, SO = SDEPTH - 1;
  SLOAD(SE, 0); asm volatile("s_waitcnt vmcnt(0)" ::: "memory"); SWRITE(0, SE); __syncthreads();
  qkt(pA0, pA1, K_lds, qr, r32, hi); partialSM(pA0, pA1, m_reg, mnA, alA);
  SLOAD(SO, KVBLK); if constexpr (SDEPTH == 2) { if (2 < NT) SLOAD(SE, 2 * KVBLK); }
  SWAIT(); SWRITE(1, SO); __syncthreads();
  for (int j = 1; j + 1 < NT; j += 2) {
    SBAR(); qkt(pB0, pB1, (bf16_t*)((char*)K_lds + SHM_K), qr, r32, hi);
    finishSM(pA0, pA1, alA, l_reg, pa0, pa1, pa2, pa3); SBAR();
    SLOAD(SO, (j + SDEPTH) * KVBLK); SBAR();
    pv_d0(o, vb0, pa0, pa1, pa2, pa3); partialSM(pB0, pB1, m_reg, mnB, alB);
    __syncthreads(); SWAIT(); SWRITE(0, SE);
    RESC(alB); __syncthreads();
    SBAR(); qkt(pA0, pA1, K_lds, qr, r32, hi);
    finishSM(pB0, pB1, alB, l_reg, pa0, pa1, pa2, pa3); SBAR();
    if (SDEPTH == 1 || j + 3 < NT) SLOAD(SE, (j + 1 + SDEPTH) * KVBLK); SBAR();
    pv_d0(o, vb0 + (int)SHM_V, pa0, pa1, pa2, pa3); partialSM(pA0, pA1, m_reg, mnA, alA);
    __syncthreads(); SWAIT(); SWRITE(1, SO);
    RESC(alA); __syncthreads();
  }
  SBAR(); qkt(pB0, pB1, (bf16_t*)((char*)K_lds + SHM_K), qr, r32, hi);
  finishSM(pA0, pA1, alA, l_reg, pa0, pa1, pa2, pa3); SBAR();
  pv_d0(o, vb0, pa0, pa1, pa2, pa3); partialSM(pB0, pB1, m_reg, mnB, alB);
  __syncthreads(); RESC(alB);
  finishSM(pB0, pB1, alB, l_reg, pa0, pa1, pa2, pa3); SBAR();
  pv_d0(o, vb0 + (int)SHM_V, pa0, pa1, pa2, pa3);
  if (hi == 0) li_l[r32] = l_reg; asm volatile("s_waitcnt lgkmcnt(0)" ::: "memory");
  float rli[16];
#pragma unroll
  for (int r = 0; r < 16; ++r) rli[r] = __builtin_amdgcn_rcpf(li_l[crow(r, hi)]);
  bf16_t* Ow = Ob + (long)(wid * QBLK) * LDO;
  char* stg = (char*)K_lds + wid * 4096;
#pragma unroll
  for (int p = 0; p < 2; ++p) {
#pragma unroll
    for (int rr = 0; rr < 8; ++rr) { const int r = 8 * p + rr, row16 = (r & 3) + 8 * ((r >> 2) & 1) + 4 * hi;
#pragma unroll
      for (int d0 = 0; d0 < 4; ++d0) *(bf16_t*)(stg + row16 * 256 + (d0 * 32 + r32) * 2) = (bf16_t)(cvtpk(o[d0][r] * rli[r], 0.f) & 0xffffu); }
    asm volatile("s_waitcnt lgkmcnt(0)" ::: "memory");
#pragma unroll
    for (int i = 0; i < 4; ++i) { const int idx = lane + 64 * i, row = idx >> 4, ch = idx & 15; const u32x4 v = *(const u32x4*)(stg + row * 256 + ch * 16);
      *(u32x4*)(Ow + (long)(16 * p + row) * LDO + ch * 8) = v; }
    asm volatile("s_waitcnt lgkmcnt(0)" ::: "memory");
  }
#undef SLOAD
#undef SWRITE
#undef SWAIT
#undef RESC
  __syncthreads();
}
#undef KSWZ
#undef SBAR
}

struct AddrLin { bf16_t* O; int ld; __device__ __forceinline__ bf16_t* operator()(const pg8::Unit& u, int rl, int tc) const { return O + (size_t)(u.pm * 256 + rl) * ld + u.pn * 256 + tc; } };
struct EpiRowScale {
    static constexpr bool PERM = true; bf16_t* O; int ld; const float* ssp; float cscale;
    __device__ __forceinline__ void operator()(f32x4 (&acc)[2][2][4][2], const pg8::Unit& u, const pg8::EpiCtx& c) const { const int e_lane = lane_id(), e_fr = e_lane & 15, e_fq = e_lane >> 4;
        const int hc = c.wc * 32 + e_fq * 8, rl0 = c.wr * 64 + e_fr;
#pragma unroll
        for (int ai = 0; ai < 2; ++ai)
#pragma unroll
            for (int m = 0; m < 4; ++m) { const int row = u.pm * 256 + ai * 128 + rl0 + m * 16; const f32x4 p0 = *(const f32x4*)(ssp + (size_t)row * 8), p1 = *(const f32x4*)(ssp + (size_t)row * 8 + 4);
                const float r = rsqrtf((((p0.x + p0.y) + (p0.z + p0.w)) + ((p1.x + p1.y) + (p1.z + p1.w))) * (1.0f / DM) + EPS) * cscale;
#pragma unroll
                for (int bj = 0; bj < 2; ++bj) { const f32x4 v0 = acc[ai][bj][m][0] * r, v1 = acc[ai][bj][m][1] * r;
                    st16((O + (size_t)row * ld + u.pn * 256 + bj * 128 + hc), (u32x4){cvtpk(v0.x, v0.y), cvtpk(v0.z, v0.w), cvtpk(v1.x, v1.y), cvtpk(v1.z, v1.w)}); } }
    }
};
struct EpiSoftmax {
    static constexpr bool PERM = true; bf16_t* P; int ld;
    __device__ __forceinline__ void operator()(f32x4 (&acc)[2][2][4][2], const pg8::Unit& u, const pg8::EpiCtx& c) const { const int e_lane = lane_id(), e_fr = e_lane & 15, e_fq = e_lane >> 4;
        const int hc = c.wc * 32 + e_fq * 8, rl0 = c.wr * 64 + e_fr;
        LAS float* pmx = (LAS float*)c.xl; LAS float* psm = pmx + 1024;
#pragma unroll
        for (int ai = 0; ai < 2; ++ai)
#pragma unroll
            for (int m = 0; m < 4; ++m) { float mx = -3.0e38f;
#pragma unroll
                for (int bj = 0; bj < 2; ++bj)
#pragma unroll
                    for (int n = 0; n < 2; ++n) { const f32x4 v = acc[ai][bj][m][n]; mx = fmaxf(fmaxf(mx, fmaxf(v.x, v.y)), fmaxf(v.z, v.w)); }
                mx = fmaxf(mx, __shfl_xor(mx, 16)); mx = fmaxf(mx, __shfl_xor(mx, 32));
                if (e_fq == 0) pmx[(ai * 128 + rl0 + m * 16) * 4 + c.wc] = mx; }
        WG_BAR();
#pragma unroll
        for (int ai = 0; ai < 2; ++ai)
#pragma unroll
            for (int m = 0; m < 4; ++m) { const int rl = ai * 128 + rl0 + m * 16; const f32x4 p4 = *(const LAS f32x4*)(pmx + rl * 4);
                const float mx = fmaxf(fmaxf(p4.x, p4.y), fmaxf(p4.z, p4.w)) * 1.4426950408889634f; float s = 0.f;
#pragma unroll
                for (int bj = 0; bj < 2; ++bj)
#pragma unroll
                    for (int n = 0; n < 2; ++n) { f32x4 v = acc[ai][bj][m][n];
                        v.x = __builtin_amdgcn_exp2f(fmaf(v.x, 1.4426950408889634f, -mx)); v.y = __builtin_amdgcn_exp2f(fmaf(v.y, 1.4426950408889634f, -mx));
                        v.z = __builtin_amdgcn_exp2f(fmaf(v.z, 1.4426950408889634f, -mx)); v.w = __builtin_amdgcn_exp2f(fmaf(v.w, 1.4426950408889634f, -mx));
                        s += (v.x + v.y) + (v.z + v.w); acc[ai][bj][m][n] = v; }
                s += __shfl_xor(s, 16); s += __shfl_xor(s, 32);
                if (e_fq == 0) psm[rl * 4 + c.wc] = s; }
        WG_BAR();
#pragma unroll
        for (int ai = 0; ai < 2; ++ai)
#pragma unroll
            for (int m = 0; m < 4; ++m) { const int rl = ai * 128 + rl0 + m * 16; const f32x4 p4 = *(const LAS f32x4*)(psm + rl * 4);
                const float inv = 1.0f / ((p4.x + p4.y) + (p4.z + p4.w));
#pragma unroll
                for (int bj = 0; bj < 2; ++bj) { const f32x4 v0 = acc[ai][bj][m][0] * inv, v1 = acc[ai][bj][m][1] * inv;
                    st16((P + (size_t)(u.pm * 256 + rl) * ld + u.pn * 256 + bj * 128 + hc), (u32x4){cvtpk(v0.x, v0.y), cvtpk(v0.z, v0.w), cvtpk(v1.x, v1.y), cvtpk(v1.z, v1.w)}); } }
        WG_BAR();
    }
};
struct MapXS { const char* Q; const char* K; __device__ __forceinline__ void operator()(pg8::Unit& u) const {
    u.a = Q + ((size_t)u.pm * 256 * DM + (size_t)u.pn * MHD) * 2; u.b = K + ((size_t)(u.pm >> 3) * MEML * DM + (size_t)u.pn * MHD) * 2; } };
struct SchedPair { pg8::Unit ua, ub; __device__ __forceinline__ bool next(int i, pg8::Unit& o) const { if (i >= 2) return false; o.pm = i ? ub.pm : ua.pm; o.pn = i ? ub.pn : ua.pn; o.a = i ? ub.a : ua.a; o.b = i ? ub.b : ua.b; asm volatile("" : "+s"(o.a), "+s"(o.b));     return true; } };
struct MapXPV { const char* P; const char* VT; __device__ __forceinline__ void operator()(pg8::Unit& u) const {
    u.a = P + ((size_t)u.pm * 256 * 1024 + (size_t)(u.pn >> 1) * MEML) * 2; u.b = VT + ((size_t)u.pn * 256 * 1024 + (size_t)(u.pm >> 3) * MEML) * 2; } };

struct MapMoE { const char* A; const char* W; size_t as, es, ws_; __device__ __forceinline__ void operator()(pg8::Unit& u) const {
    u.a = A + (size_t)u.pm * as; u.b = W + (size_t)(u.pm >> 2) * es + (size_t)u.pn * ws_; } };
struct EpiSwiGLU {
    static constexpr bool PERM = true; bf16_t* ACT; const float* rs;
    __device__ __forceinline__ void operator()(f32x4 (&acc)[2][2][4][2], const pg8::Unit& u, const pg8::EpiCtx& c) const { const int e_lane = lane_id(), e_fr = e_lane & 15, e_fq = e_lane >> 4;
        const int hc = c.wc * 32 + e_fq * 8, rl0 = c.wr * 64 + e_fr;
#pragma unroll
        for (int ai = 0; ai < 2; ++ai)
#pragma unroll
            for (int m = 0; m < 4; ++m) { f32x4 o[2]; const float rf = rs[u.pm * 256 + ai * 128 + rl0 + m * 16];
#pragma unroll
                for (int n = 0; n < 2; ++n) { const f32x4 g = acc[ai][0][m][n] * rf, up = acc[ai][1][m][n] * rf; f32x4 r;
                    r.x = g.x * __builtin_amdgcn_rcpf(1.0f + __builtin_amdgcn_exp2f(-1.4426950408889634f * g.x)) * up.x; r.y = g.y * __builtin_amdgcn_rcpf(1.0f + __builtin_amdgcn_exp2f(-1.4426950408889634f * g.y)) * up.y;
                    r.z = g.z * __builtin_amdgcn_rcpf(1.0f + __builtin_amdgcn_exp2f(-1.4426950408889634f * g.z)) * up.z; r.w = g.w * __builtin_amdgcn_rcpf(1.0f + __builtin_amdgcn_exp2f(-1.4426950408889634f * g.w)) * up.w; o[n] = r; }
                st16((ACT + (size_t)(u.pm * 256 + ai * 128 + rl0 + m * 16) * EFF + u.pn * 128 + hc), (u32x4){cvtpk(o[0].x, o[0].y), cvtpk(o[0].z, o[0].w), cvtpk(o[1].x, o[1].y), cvtpk(o[1].z, o[1].w)}); }
    }
};
struct EpiRowGate {
    static constexpr bool PERM = true; bf16_t* Y; const float* gate;
    __device__ __forceinline__ void operator()(f32x4 (&acc)[2][2][4][2], const pg8::Unit& u, const pg8::EpiCtx& c) const { const int e_lane = lane_id(), e_fr = e_lane & 15, e_fq = e_lane >> 4;
        const int hc = c.wc * 32 + e_fq * 8, rl0 = c.wr * 64 + e_fr;
#pragma unroll
        for (int ai = 0; ai < 2; ++ai)
#pragma unroll
            for (int m = 0; m < 4; ++m) { const int row = u.pm * 256 + ai * 128 + rl0 + m * 16; const float gt = gate[row];
#pragma unroll
                for (int bj = 0; bj < 2; ++bj) { const f32x4 v0 = acc[ai][bj][m][0] * gt, v1 = acc[ai][bj][m][1] * gt;
                    st16((Y + (size_t)row * DM + u.pn * 256 + bj * 128 + hc), (u32x4){cvtpk(v0.x, v0.y), cvtpk(v0.z, v0.w), cvtpk(v1.x, v1.y), cvtpk(v1.z, v1.w)}); } }
    }
};
__device__ __forceinline__ float rms_row_to_bf16_r(const float* xrow, const float* __restrict__ gain, bf16_t* orow, int lane) {
    const GAS f32x4* xr = (const GAS f32x4*)xrow + lane; const f32x4* gr = (const f32x4*)gain + lane;
    f32x4 v[8]; float s = 0.f;
#pragma unroll
    for (int j = 0; j < 8; ++j) { v[j] = xr[64 * j]; s += (v[j].x * v[j].x + v[j].y * v[j].y) + (v[j].z * v[j].z + v[j].w * v[j].w); }
    const float r = rsqrtf(wave_sum(s) * (1.f / DM) + EPS);
    GAS u32x2* o8 = (GAS u32x2*)orow + lane;
#pragma unroll
    for (int j = 0; j < 8; ++j) { const f32x4 g = gr[64 * j]; u32x2 w; w.x = cvtpk(v[j].x * r * g.x, v[j].y * r * g.y); w.y = cvtpk(v[j].z * r * g.z, v[j].w * r * g.w); o8[64 * j] = w; }
    return r;
}
__device__ __forceinline__ void router_phase(const Frame& F, const bf16_t* x, const u32x4* RBl, float* rrow, float* aff, LAS unsigned char* xl) {
    const int lane = lane_id(), tid = F.wave * 64 + lane;
    LAS u32x4* Bl = (LAS u32x4*)(F.lds + RING_OFF);
    for (int i = tid; i < 2 * 4096; i += 512) Bl[i] = RBl[i];
    __syncthreads();
    LAS float* red = (LAS float*)xl;
    LAS float* ssq = (LAS float*)(xl + 8192);
    const int rg = F.wave >> 2, kq = F.wave & 3, r16 = lane & 15, kg = lane >> 4;
    for (int rb = (int)blockIdx.x * 32; rb < NTOK; rb += F.G * 32) {
        const bf16_t* xr = x + (size_t)(rb + rg * 16 + r16) * DM + kq * 512 + kg * 8;
        bf16x8 a[16];
#pragma unroll
        for (int s = 0; s < 16; ++s) a[s] = *(const GAS bf16x8*)(xr + 32 * s);
        f32x4 acc = {0.f, 0.f, 0.f, 0.f}; float sq = 0.f;
#pragma unroll
        for (int s = 0; s < 16; ++s) { const int ks = kq * 16 + s;
            const bf16x8 bh = __builtin_bit_cast(bf16x8, Bl[ks * 64 + lane]), bl = __builtin_bit_cast(bf16x8, Bl[4096 + ks * 64 + lane]);
            acc = __builtin_amdgcn_mfma_f32_16x16x32_bf16(a[s], bh, acc, 0, 0, 0);
            acc = __builtin_amdgcn_mfma_f32_16x16x32_bf16(a[s], bl, acc, 0, 0, 0);
            const u32x4 av = __builtin_bit_cast(u32x4, a[s]);
            const float f0 = __uint_as_float(av.x << 16), f1 = __uint_as_float(av.x & 0xffff0000u), f2 = __uint_as_float(av.y << 16), f3 = __uint_as_float(av.y & 0xffff0000u);
            const float f4 = __uint_as_float(av.z << 16), f5 = __uint_as_float(av.z & 0xffff0000u), f6 = __uint_as_float(av.w << 16), f7 = __uint_as_float(av.w & 0xffff0000u);
            sq += ((f0 * f0 + f1 * f1) + (f2 * f2 + f3 * f3)) + ((f4 * f4 + f5 * f5) + (f6 * f6 + f7 * f7)); }
        sq += __shfl_xor(sq, 16); sq += __shfl_xor(sq, 32);
        *(LAS f32x4*)(red + ((rg * 4 + kq) * 64 + lane) * 4) = acc;
        if (kg == 0) ssq[(rg * 4 + kq) * 16 + r16] = sq;
        __syncthreads();
        if (kq == 0) {
            f32x4 t = *(const LAS f32x4*)(red + ((rg * 4 + 0) * 64 + lane) * 4);
#pragma unroll
            for (int q = 1; q < 4; ++q) t = t + *(const LAS f32x4*)(red + ((rg * 4 + q) * 64 + lane) * 4);
            const float lg[4] = {t.x, t.y, t.z, t.w};
#pragma unroll
            for (int i = 0; i < 4; ++i) { const int rr = 4 * kg + i; const float ss = (ssq[(rg * 4 + 0) * 16 + rr] + ssq[(rg * 4 + 1) * 16 + rr]) + (ssq[(rg * 4 + 2) * 16 + rr] + ssq[(rg * 4 + 3) * 16 + rr]);
                const float r = rsqrtf(ss * (1.f / DM) + EPS); const int row = rb + rg * 16 + rr;
                const float v = lg[i] * r; float mx = v;
                mx = fmaxf(mx, __shfl_xor(mx, 8)); mx = fmaxf(mx, __shfl_xor(mx, 4)); mx = fmaxf(mx, __shfl_xor(mx, 2)); mx = fmaxf(mx, __shfl_xor(mx, 1));
                const float ex = expf(v - mx); float sm = ex;
                sm += __shfl_xor(sm, 8); sm += __shfl_xor(sm, 4); sm += __shfl_xor(sm, 2); sm += __shfl_xor(sm, 1);
                const int b = row / SEQ, tt = row % SEQ; aff[((size_t)b * NE + r16) * SEQ + tt] = ex / sm;
                if (r16 == 0) rrow[row] = r; }
        }
        __syncthreads();
    }
}
__device__ __forceinline__ void rank_phase(const Frame& F, const float* aff, int* rank, float* gate, const float* rrow, float* rs, int* gidx) {
    const int lane = lane_id(), tid = F.wave * 64 + lane;
    LAS unsigned* wc = (LAS unsigned*)(F.lds + RING_OFF);
    LAS unsigned* ck = (LAS unsigned*)(F.lds + RING_OFF + 256);
    LAS unsigned* ci = ck + SEQ + 4;
    LAS unsigned* ncp = ci + SEQ + 4;
    for (int be = (int)blockIdx.x; be < NB * NE; be += F.G) {
        const int b = be >> 4, e = be & 15;
        unsigned k[4];
#pragma unroll
        for (int j = 0; j < 4; ++j) k[j] = __float_as_uint(aff[(size_t)be * SEQ + tid + 512 * j]);
        unsigned lo = 0u, hi = 0x3F800001u;
        if (tid == 0) ncp[0] = 0u;
        for (int it = 0; it < 40; ++it) {
            const unsigned mid = lo + ((hi - lo) >> 1); if (mid == lo) break;
            const int ws_ = __popcll(__ballot(k[0] >= mid)) + __popcll(__ballot(k[1] >= mid)) + __popcll(__ballot(k[2] >= mid)) + __popcll(__ballot(k[3] >= mid));
            if (lane == 0) wc[(it & 1) * 8 + F.wave] = (unsigned)ws_;
            __syncthreads();
            const u32x4 c0 = *(const LAS u32x4*)(wc + (it & 1) * 8), c1 = *(const LAS u32x4*)(wc + (it & 1) * 8 + 4);
            const int c = (int)(((c0.x + c0.y) + (c0.z + c0.w)) + ((c1.x + c1.y) + (c1.z + c1.w)));
            if (c < CAP) hi = mid; else { lo = mid; if (c <= 448) break; }
        }
        const unsigned T = lo;
        __syncthreads();
#pragma unroll
        for (int j = 0; j < 4; ++j) { const bool pred = k[j] >= T; const unsigned long long bal = __ballot(pred);
            const int wcount = __popcll(bal), pre = __popcll(bal & ((1ull << lane) - 1ull));
            unsigned base = 0u; if (lane == 0 && wcount) base = __hip_atomic_fetch_add(ncp, (unsigned)wcount, __ATOMIC_RELAXED, __HIP_MEMORY_SCOPE_WORKGROUP);
            base = (unsigned)__builtin_amdgcn_readfirstlane((int)base);
            if (pred) { ck[base + pre] = k[j]; ci[base + pre] = (unsigned)(tid + 512 * j); } else rank[(size_t)be * SEQ + tid + 512 * j] = CAP; }
        __syncthreads();
        const int nc = (int)ncp[0];
        if (tid < 4) { ck[nc + tid] = 0u; ci[nc + tid] = 0x7fffffffu; }
        __syncthreads();
        const int nc4 = (nc + 3) >> 2;
        for (int i = tid; i < nc; i += 512) { const unsigned kk = ck[i]; const int tt = (int)ci[i]; int cnt = 0;
#pragma unroll 4
            for (int m = 0; m < nc4; ++m) { const u32x4 km = ((const LAS u32x4*)ck)[m]; const u32x4 tm = ((const LAS u32x4*)ci)[m];
                cnt += ((km.x > kk || (km.x == kk && (int)tm.x < tt)) ? 1 : 0) + ((km.y > kk || (km.y == kk && (int)tm.y < tt)) ? 1 : 0)
                     + ((km.z > kk || (km.z == kk && (int)tm.z < tt)) ? 1 : 0) + ((km.w > kk || (km.w == kk && (int)tm.w < tt)) ? 1 : 0); }
            const int r = cnt < CAP ? cnt : CAP; rank[(size_t)be * SEQ + tt] = r;
            if (r < CAP) { const int sl = (e * 4 + b) * CAP + r; gate[sl] = __uint_as_float(kk); gidx[sl] = b * SEQ + tt; rs[sl] = rrow[b * SEQ + tt]; } }
        __syncthreads();
    }
}
__device__ __forceinline__ void combine_phase(const Frame& F, const bf16_t* xin, bf16_t* xo, float* fout, const bf16_t* Y, const int* rank, const float* __restrict__ gain, bf16_t* HNo, bool final_) {
    const int lane = lane_id();
    const int gw = (int)blockIdx.x * NWAVES + F.wave, NGW = F.G * NWAVES;
    for (int row = gw; row < NTOK; row += NGW) {
        const int b = row / SEQ, t = row % SEQ;
        int rk = CAP; if (lane < NE) rk = rank[((size_t)b * NE + lane) * SEQ + t];
        const GAS u32x4* xi = (const GAS u32x4*)(xin + (size_t)row * DM) + lane; float v[4][8];
#pragma unroll
        for (int j = 0; j < 4; ++j) { const u32x4 p = xi[64 * j];
            v[j][0] = __uint_as_float(p.x << 16); v[j][1] = __uint_as_float(p.x & 0xffff0000u); v[j][2] = __uint_as_float(p.y << 16); v[j][3] = __uint_as_float(p.y & 0xffff0000u);
            v[j][4] = __uint_as_float(p.z << 16); v[j][5] = __uint_as_float(p.z & 0xffff0000u); v[j][6] = __uint_as_float(p.w << 16); v[j][7] = __uint_as_float(p.w & 0xffff0000u); }
#pragma unroll
        for (int e = 0; e < NE; ++e) { const int r = __builtin_amdgcn_readlane(rk, e);
            if (r < CAP) { const u32x4* yr = (const u32x4*)(Y + ((size_t)(e * 4 + b) * CAP + r) * DM) + lane;
#pragma unroll
                for (int j = 0; j < 4; ++j) { const u32x4 w = yr[64 * j];
                    v[j][0] += __uint_as_float(w.x << 16); v[j][1] += __uint_as_float(w.x & 0xffff0000u); v[j][2] += __uint_as_float(w.y << 16); v[j][3] += __uint_as_float(w.y & 0xffff0000u);
                    v[j][4] += __uint_as_float(w.z << 16); v[j][5] += __uint_as_float(w.z & 0xffff0000u); v[j][6] += __uint_as_float(w.w << 16); v[j][7] += __uint_as_float(w.w & 0xffff0000u); } } }
        float s = 0.f;
#pragma unroll
        for (int j = 0; j < 4; ++j)
#pragma unroll
            for (int i = 0; i < 8; ++i) s += v[j][i] * v[j][i];
        const float r = rsqrtf(wave_sum(s) * (1.f / DM) + EPS);
        if (final_) { GAS f32x4* fo = (GAS f32x4*)(fout + (size_t)row * DM);
#pragma unroll
            for (int j = 0; j < 4; ++j) { const int c0 = 8 * (lane + 64 * j); const f32x4 g0 = *(const f32x4*)(gain + c0), g1 = *(const f32x4*)(gain + c0 + 4);
                fo[(c0 >> 2)] = (f32x4){v[j][0] * r * g0.x, v[j][1] * r * g0.y, v[j][2] * r * g0.z, v[j][3] * r * g0.w};
                fo[(c0 >> 2) + 1] = (f32x4){v[j][4] * r * g1.x, v[j][5] * r * g1.y, v[j][6] * r * g1.z, v[j][7] * r * g1.w}; }
        } else { GAS u32x4* o8 = (GAS u32x4*)(HNo + (size_t)row * DM) + lane; GAS u32x4* x8 = (GAS u32x4*)(xo + (size_t)row * DM) + lane;
#pragma unroll
            for (int j = 0; j < 4; ++j) { const int c0 = 8 * (lane + 64 * j); const f32x4 g0 = *(const f32x4*)(gain + c0), g1 = *(const f32x4*)(gain + c0 + 4);
                x8[64 * j] = (u32x4){cvtpk(v[j][0], v[j][1]), cvtpk(v[j][2], v[j][3]), cvtpk(v[j][4], v[j][5]), cvtpk(v[j][6], v[j][7])};
                o8[64 * j] = (u32x4){cvtpk(v[j][0] * r * g0.x, v[j][1] * r * g0.y), cvtpk(v[j][2] * r * g0.z, v[j][3] * r * g0.w), cvtpk(v[j][4] * r * g1.x, v[j][5] * r * g1.y), cvtpk(v[j][6] * r * g1.z, v[j][7] * r * g1.w)}; } }
    }
}
struct MapPool { const char* A; const char* W; __device__ __forceinline__ void operator()(pg8::Unit& u) const {
    u.a = A + ((size_t)u.pm * 256 * DM + (size_t)(u.pn >> 1) * 512) * 2; u.b = W + ((size_t)(u.pn & 1) * 256 * DM + (size_t)(u.pn >> 1) * 512) * 2; } };
template <int W> __device__ __forceinline__ void pool_item4(const bf16_t* H, bf16_t* P, int row0, int c8) {
    const int t0 = row0 & (SEQ - 1); const bf16_t* base = H + (size_t)(row0 - t0) * DM + c8 * 8;
    u32x4 v[W + 3];
#pragma unroll
    for (int i = 0; i < W + 3; ++i) { int j = t0 - W / 2 + i; j = j < 0 ? 0 : (j > SEQ - 1 ? SEQ - 1 : j); v[i] = *(const u32x4*)(base + (size_t)j * DM); }
    float f[W + 3][8];
#pragma unroll
    for (int i = 0; i < W + 3; ++i) { const int j = t0 - W / 2 + i; const float m = (j >= 0 && j < SEQ) ? 1.f : 0.f;
        f[i][0] = m * __uint_as_float(v[i].x << 16); f[i][1] = m * __uint_as_float(v[i].x & 0xffff0000u); f[i][2] = m * __uint_as_float(v[i].y << 16); f[i][3] = m * __uint_as_float(v[i].y & 0xffff0000u);
        f[i][4] = m * __uint_as_float(v[i].z << 16); f[i][5] = m * __uint_as_float(v[i].z & 0xffff0000u); f[i][6] = m * __uint_as_float(v[i].w << 16); f[i][7] = m * __uint_as_float(v[i].w & 0xffff0000u); }
    float s[8];
#pragma unroll
    for (int c = 0; c < 8; ++c) { s[c] = 0.f;
#pragma unroll
        for (int i = 0; i < W; ++i) s[c] += f[i][c]; }
#pragma unroll
    for (int q = 0; q < 4; ++q) { const int t = t0 + q; int lo = t - W / 2, hi = t + W / 2; if (lo < 0) lo = 0; if (hi > SEQ) hi = SEQ; const float inv = 1.0f / (float)(hi - lo);
        if (q > 0) {
#pragma unroll
            for (int c = 0; c < 8; ++c) s[c] += f[q + W - 1][c] - f[q - 1][c]; }
        const float* e = f[q + W / 2];
        *(u32x4*)(P + (size_t)(row0 + q) * DM + c8 * 8) = (u32x4){cvtpk(s[0] * inv - e[0], s[1] * inv - e[1]), cvtpk(s[2] * inv - e[2], s[3] * inv - e[3]), cvtpk(s[4] * inv - e[4], s[5] * inv - e[5]), cvtpk(s[6] * inv - e[6], s[7] * inv - e[7])}; }
}
__device__ __forceinline__ void pool_phase(const Frame& F, const bf16_t* H, bf16_t* P) {
    const int lane = lane_id(); const int gwv = (int)blockIdx.x * NWAVES + F.wave, NWV = F.G * NWAVES;
    for (int wi = gwv; wi < NTOK; wi += NWV) {
        const int row0 = (wi >> 2) * 4, g = wi & 3, c8 = g * 64 + lane;
        if (g == 0) pool_item4<2>(H, P, row0, c8); else if (g == 1) pool_item4<4>(H, P, row0, c8); else if (g == 2) pool_item4<8>(H, P, row0, c8); else pool_item4<16>(H, P, row0, c8);
    }
}

constexpr int N_PHASES = 24;
#ifndef MK_N_LAUNCHES
#define MK_N_LAUNCHES 1
#endif
#ifndef REP_MASK
#define REP_MASK 0
#endif
__global__ void __launch_bounds__(NWAVES * 64, 2) skel_fwd(Args args) {
    extern __shared__ __attribute__((aligned(16))) unsigned char lds_raw[];
    Frame F;
    F.lds = (LAS unsigned char*)lds_raw; F.MISC = (volatile LAS unsigned*)(F.lds + MISC_OFF);
    F.wave = __builtin_amdgcn_readfirstlane(threadIdx.x >> 6);
    F.G = gridDim.x; { const int bx = blockIdx.x; F.vcu = (F.G % 8 == 0) ? (bx % 8) * (F.G / 8) + bx / 8 : bx; }
    F.ws = nullptr; F.ctl = (gu32*)(uptr(args.ws) + WS_CTL);
    for (int u = threadIdx.x; u < (LDS_BYTES - LDSCTL_OFF) / 4; u += NWAVES * 64) ((LAS unsigned*)(F.lds + LDSCTL_OFF))[u] = 0u;
    __syncthreads();
    const bool multi = (MK_N_LAUNCHES == 1) || (args.ph_hi - args.ph_lo) > 1 || REP_MASK != 0;
    XcdBarrier bar; bar.bar = (unsigned*)(F.ctl + CW_BAR); bar.x = 0; bar.st = nullptr; bar.wave = F.wave;
    if (multi) bar = xcd_barrier_post((unsigned*)(F.ctl + CW_BAR), F.MISC + 8, F.wave);
    const int lo = args.ph_lo, hi = args.ph_hi;
#ifdef REP_RT
    const unsigned rep_mask_ = (unsigned)__builtin_amdgcn_readfirstlane(args.pad);
#endif
#define IN(k) ((MK_N_LAUNCHES == 1) ? ((k) < N_PHASES) : (lo <= (k) && (k) < hi))
#ifdef REP_RT
#define REPBIT(k) ((int)((rep_mask_ >> (k)) & 1u))
#else
#define REPBIT(k) ((int)((((unsigned)REP_MASK) >> (k)) & 1u))
#endif
#define PHASE(k) _Pragma("unroll") for (int rep_ = 0; rep_ < 1 + REPBIT(k); ++rep_)
#define SEAM(k) do { if ((IN(k) && IN((k) + 1)) || rep_ + 1 < 1 + REPBIT(k)) xcd_barrier(bar); } while (0)
    LAS unsigned char* ring = F.lds + RING_OFF; LAS unsigned char* xl = F.lds + XL_OFF;
    const int bx = (int)blockIdx.x, G = F.G;

#define KV_PROJ(l, rotK, rotV) do {   \
            { MapLin mp{(const char*)(ws + WS_MEMNB + (size_t)(l) * NB * MEML * DM * 2), (const char*)(ws + WS_WCK_T + (size_t)(l) * DM * DM * 2), (size_t)256 * DM * 2, (size_t)256 * DM * 2}; \
              pg8::Sched<MapLin> S; S.init(NB * MEML / 256, DM / 256, G, (bx + G - ((rotK) % G)) % G, mp); \
              EpiStore<AddrLin> E{AddrLin{(bf16_t*)(ws + WS_KCB + (size_t)(l) * NB * MEML * DM * 2), DM}}; \
              pg8::gemm_phase<EpiStore<AddrLin>, pg8::Sched<MapLin>, true>(F.wave, ring, xl, DM, DM * 2, DM * 2, S, E); } \
            { MapLin mp{(const char*)(ws + WS_WCV_T + (size_t)(l) * DM * DM * 2), (const char*)(ws + WS_MEMNB + (size_t)(l) * NB * MEML * DM * 2), (size_t)256 * DM * 2, (size_t)256 * DM * 2}; \
              pg8::Sched<MapLin> S; S.init(DM / 256, NB * MEML / 256, G, (bx + G - ((rotV) % G)) % G, mp); \
              EpiStore<AddrLin> E{AddrLin{(bf16_t*)(ws + WS_VTB + (size_t)(l) * NB * MEML * DM * 2), NB * MEML}}; \
              pg8::gemm_phase<EpiStore<AddrLin>, pg8::Sched<MapLin>, true>(F.wave, ring, xl, DM, DM * 2, DM * 2, S, E); } } while (0)
#ifdef EXTRA_BARS
    for (int eb = 0; eb < EXTRA_BARS; ++eb) xcd_barrier(bar);
#endif
    if (IN(0)) PHASE(0) { const karg_t ka = kargs(); unsigned char* const ws = uptr(KWS(ka)); p0_prologue(F, ka, ws); SEAM(0); }
    if (IN(1)) PHASE(1) { const karg_t ka = kargs(); unsigned char* const ws = uptr(KWS(ka));
        {
            MapLin mp{(const char*)(ws + WS_HN), (const char*)(ws + WS_WIN_T), (size_t)256 * DM * 2, (size_t)256 * DM * 2};
            pg8::Sched<MapLin> S; S.init(NTOK / 256, 2560 / 256, G, bx, mp);
            EpiQKV E{(bf16_t*)(ws + WS_QB), (bf16_t*)(ws + WS_KB), (bf16_t*)(ws + WS_VB), KIN(ka, 4), KIN(ka, 5), (const float*)(ws + WS_ROPE), (const float*)(ws + WS_ROPE) + SEQ * 64};
            pg8::gemm_phase<EpiQKV, pg8::Sched<MapLin>, true>(F.wave, ring, xl, DM, DM * 2, DM * 2, S, E); }
        {
            MapLin mp{(const char*)(ws + WS_WF_T), (const char*)(ws + WS_HN), (size_t)256 * DM * 2, (size_t)256 * DM * 2};
            pg8::Sched<MapLin> S; S.init(1024 / 256, NTOK / 256, G, (bx + G - (320 % G)) % G, mp);
            EpiStore<AddrF1> E{AddrF1{(bf16_t*)(ws + WS_FPQ)}};
            pg8::gemm_phase<EpiStore<AddrF1>, pg8::Sched<MapLin>, true>(F.wave, ring, xl, DM, DM * 2, DM * 2, S, E); }
        KV_PROJ(0, 448, 480);
        SEAM(1);
    }
    if (IN(2)) PHASE(2) { const karg_t ka = kargs(); unsigned char* const ws = uptr(KWS(ka));
        const int nF2 = (G > 64) ? 64 : 0;
        if (bx < nF2 || nF2 == 0) {
            MapLin mp{(const char*)(ws + WS_DFT), (const char*)(ws + WS_FPQ), (size_t)256 * 4096 * 2, (size_t)256 * 4096 * 2};
            pg8::Sched<MapLin> S; S.init(8, 8, nF2 ? nF2 : G, bx, mp);
            EpiStore<AddrF2> E{AddrF2{(bf16_t*)(ws + WS_MIXB)}};
            pg8::gemm_phase<EpiStore<AddrF2>, pg8::Sched<MapLin>, true>(F.wave, ring, xl, 4096, 4096 * 2, 4096 * 2, S, E);
        }
        if (bx < nF2) { __syncthreads(); tr_span(F, ka, ws, 3, bx * 8 + F.wave, 512, 2); __syncthreads(); }
        if (bx >= nF2) {
            const int a = bx - nF2, cnt = G - nF2, per = (384 + cnt - 1) / cnt; int ui = 0;
            for (int uid = a * per; uid < (a + 1) * per && uid < 384; ++uid, ++ui) {
                const int set_ = 2 * (a & 7) + ui, jx = a >> 3, b = set_ >> 2, kvh = set_ & 3, qb = jx & 7, hq = kvh * 3 + (jx >> 3);
                const bf16_t* Qb = (const bf16_t*)(ws + WS_QB) + ((size_t)b * SEQ + qb * 256) * AW + hq * HD;
                const bf16_t* Kh = (const bf16_t*)(ws + WS_KB) + (size_t)b * SEQ * KVW + kvh * HD;
                const bf16_t* Vh = (const bf16_t*)(ws + WS_VB) + (size_t)b * SEQ * KVW + kvh * HD;
                bf16_t* Ob = (bf16_t*)(ws + WS_MIXB) + ((size_t)b * SEQ + qb * 256) * DM + hq * HD;
                attn::attn_dense_body(Qb, Kh, Vh, Ob, SEQ, (char*)lds_raw + RING_OFF, F.wave);
            }
        }
        SEAM(2);
    }
    if (IN(3)) PHASE(3) { const karg_t ka = kargs(); unsigned char* const ws = uptr(KWS(ka));
        MapLin mp{(const char*)(ws + WS_MIXB), (const char*)(ws + WS_WOUT_T), (size_t)256 * DM * 2, (size_t)256 * DM * 2};
        pg8::Sched<MapLin> S; S.init(NTOK / 256, DM / 256, G, bx, mp);
        EpiResB<true> E{KIN(ka, 0), (bf16_t*)(ws + WS_XB), (float*)(ws + WS_SSP), nullptr};
        pg8::gemm_phase<EpiResB<true>, pg8::Sched<MapLin>, true>(F.wave, ring, xl, DM, DM * 2, DM * 2, S, E);
        SEAM(3);
    }
    {
        constexpr int l = 0; constexpr int pb = l ? 15 : 4;
        if (l == 1) {
            if (IN(13)) PHASE(13) { const karg_t ka = kargs(); unsigned char* const ws = uptr(KWS(ka));
                pool_phase(F, (const bf16_t*)(ws + WS_HN), (bf16_t*)(ws + WS_QCB));
#ifdef PROBE_CONV
                tr_span<TRV>(F, ka, ws, 1, bx * 8 + F.wave, 2048, 4);
#endif
                SEAM(13);
            }
            if (IN(14)) PHASE(14) { const karg_t ka = kargs(); unsigned char* const ws = uptr(KWS(ka));
                MapPool mp{(const char*)(ws + WS_QCB), (const char*)(ws + WS_WP_T)};
                pg8::Sched<MapPool> S; S.init(NTOK / 256, DM / 256, G, bx, mp);
                EpiResB<false> E{(const bf16_t*)(ws + WS_XB), (bf16_t*)(ws + WS_XALT), (float*)(ws + WS_SSP), KIN(ka, 9)};
                pg8::gemm_phase<EpiResB<false>, pg8::Sched<MapPool>, true>(F.wave, ring, xl, 512, DM * 2, DM * 2, S, E);
                SEAM(14);
            }
        }
        if (IN(pb + 0)) PHASE(pb + 0) { const karg_t ka = kargs(); unsigned char* const ws = uptr(KWS(ka));
            MapLin mp{(const char*)(ws + (l == 0 ? WS_XB : WS_XALT)), (const char*)(ws + WS_WCQ_T + (size_t)l * DM * DM * 2), (size_t)256 * DM * 2, (size_t)256 * DM * 2};
            pg8::Sched<MapLin> S; S.init(NTOK / 256, DM / 256, G, bx, mp);
            EpiRowScale E{(bf16_t*)(ws + WS_QCB), DM, (const float*)(ws + WS_SSP), 0.04419417382415922f};
            pg8::gemm_phase<EpiRowScale, pg8::Sched<MapLin>, true>(F.wave, ring, xl, DM, DM * 2, DM * 2, S, E);
            SEAM(pb + 0);
        }
        if (IN(pb + 1)) PHASE(pb + 1) { const karg_t ka = kargs(); unsigned char* const ws = uptr(KWS(ka));
            MapXS mp{(const char*)(ws + WS_QCB), (const char*)(ws + WS_KCB + (size_t)l * NB * MEML * DM * 2)};
            pg8::Sched<MapXS> S; S.init(NTOK / 256, NMH, G, bx, mp);
            EpiSoftmax E{(bf16_t*)(ws + WS_PB), NMH * MEML};
            pg8::gemm_phase<EpiSoftmax, pg8::Sched<MapXS>, true>(F.wave, ring, xl, MHD, DM * 2, DM * 2, S, E);
            { pg8::Unit su; if (S.next(0, su)) {
                VM_WAIT(); __syncthreads(); if (F.wave == 0 && lane_id() == 0) { __builtin_amdgcn_fence(__ATOMIC_ACQUIRE, "agent"); VM_WAIT(); } __syncthreads();
                MapXPV mp2{(const char*)(ws + WS_PB), (const char*)(ws + WS_VTB + (size_t)l * NB * MEML * DM * 2)};
                SchedPair S2; S2.ua.pm = su.pm; S2.ua.pn = 2 * su.pn; S2.ub.pm = su.pm; S2.ub.pn = 2 * su.pn + 1; mp2(S2.ua); mp2(S2.ub);
                EpiStore<AddrLin> E2{AddrLin{(bf16_t*)(ws + WS_MIXB), DM}};
                pg8::gemm_phase<EpiStore<AddrLin>, SchedPair, true>(F.wave, ring, xl, MEML, NMH * MEML * 2, NB * MEML * 2, S2, E2); } }
            if (l == 0) { KV_PROJ(1, 128, 160);
            }
            SEAM(pb + 1);
        }
        if (IN(pb + 3)) PHASE(pb + 3) { const karg_t ka = kargs(); unsigned char* const ws = uptr(KWS(ka));
            MapLin mp{(const char*)(ws + WS_MIXB), (const char*)(ws + WS_WCO_T + (size_t)l * DM * DM * 2), (size_t)256 * DM * 2, (size_t)256 * DM * 2};
            pg8::Sched<MapLin> S; S.init(NTOK / 256, DM / 256, G, bx, mp);
            EpiResB<false> E{(const bf16_t*)(ws + (l == 0 ? WS_XB : WS_XALT)), (bf16_t*)(ws + (l == 0 ? WS_XALT : WS_XB)), nullptr, nullptr, (bf16_t*)(ws + WS_XSB), KIN(ka, 16) + l * DM};
            pg8::gemm_phase<EpiResB<false>, pg8::Sched<MapLin>, true>(F.wave, ring, xl, DM, DM * 2, DM * 2, S, E);
            SEAM(pb + 3);
        }
        if (IN(pb + 4)) PHASE(pb + 4) { const karg_t ka = kargs(); unsigned char* const ws = uptr(KWS(ka));
            router_phase(F, (const bf16_t*)(ws + (l == 0 ? WS_XALT : WS_XB)), (const u32x4*)(ws + WS_AFF + 512 * 1024) + (size_t)l * 8192, (float*)(ws + WS_SSP + 512 * 1024), (float*)(ws + WS_AFF), xl);
            SEAM(pb + 4);
        }
        if (IN(pb + 5)) PHASE(pb + 5) { const karg_t ka = kargs(); unsigned char* const ws = uptr(KWS(ka));
            rank_phase(F, (const float*)(ws + WS_AFF), (int*)(ws + WS_RANK), (float*)(ws + WS_GATE), (const float*)(ws + WS_SSP + 512 * 1024), (float*)(ws + WS_SSP + 768 * 1024), (int*)(ws + WS_GATE + 512 * 1024));
            if (l == 0 && bx >= NB * NE && (bx - NB * NE) * 8 + F.wave < TR_DEFER - 1024) tr_span(F, ka, ws, 3, 1024 + (bx - NB * NE) * 8 + F.wave, 0, 1);
            SEAM(pb + 5);
        }
        if (IN(pb + 6)) PHASE(pb + 6) { const karg_t ka = kargs(); unsigned char* const ws = uptr(KWS(ka));
            MapMoE mp{(const char*)(ws + WS_XSB), (const char*)(KIN(ka, 18) + (size_t)l * NE * DM * EFF), (size_t)0, (size_t)DM * EFF * 4, (size_t)128 * 4};
            pg8::Sched<MapMoE> S; S.init(NB * NE, 8, G, bx, mp);
            EpiSwiGLU E{(bf16_t*)(ws + WS_ACTB), (const float*)(ws + WS_SSP + 768 * 1024)};
            pg8::gemm_phase<EpiSwiGLU, pg8::Sched<MapMoE>, true, true, 1, false>(F.wave, ring, xl, DM, DM * 2, EFF * 4, S, E, (const int*)(ws + WS_GATE + 512 * 1024), (long)((const char*)KIN(ka, 19) - (const char*)KIN(ka, 18)));
            SEAM(pb + 6);
        }
        if (IN(pb + 7)) PHASE(pb + 7) { const karg_t ka = kargs(); unsigned char* const ws = uptr(KWS(ka));
            MapMoE mp{(const char*)(ws + WS_ACTB), (const char*)(KIN(ka, 20) + (size_t)l * NE * EFF * DM), (size_t)256 * EFF * 2, (size_t)EFF * DM * 4, (size_t)256 * 4};
            pg8::Sched<MapMoE> S; S.init(NB * NE, 8, G, bx, mp);
            EpiRowGate E{(bf16_t*)(ws + WS_YB), (const float*)(ws + WS_GATE)};
            pg8::gemm_phase<EpiRowGate, pg8::Sched<MapMoE>, true, false, 1, false>(F.wave, ring, xl, EFF, EFF * 2, DM * 4, S, E, nullptr, 512);
            SEAM(pb + 7);
        }
        if (IN(pb + 8)) PHASE(pb + 8) { const karg_t ka = kargs(); unsigned char* const ws = uptr(KWS(ka));
            combine_phase(F, (const bf16_t*)(ws + (l == 0 ? WS_XALT : WS_XB)), (bf16_t*)(ws + WS_XB), KOUT(ka), (const bf16_t*)(ws + WS_YB), (const int*)(ws + WS_RANK), l == 0 ? KIN(ka, 2) + DM : KIN(ka, 21), (bf16_t*)(ws + WS_HN), l == 1);
            SEAM(pb + 8);
        }
    }
    {
        constexpr int l = 1; constexpr int pb = l ? 15 : 4;
        if (l == 1) {
            if (IN(13)) PHASE(13) { const karg_t ka = kargs(); unsigned char* const ws = uptr(KWS(ka));
                pool_phase(F, (const bf16_t*)(ws + WS_HN), (bf16_t*)(ws + WS_QCB));
#ifdef PROBE_CONV
                tr_span<TRV>(F, ka, ws, 1, bx * 8 + F.wave, 2048, 4);
#endif
                SEAM(13);
            }
            if (IN(14)) PHASE(14) { const karg_t ka = kargs(); unsigned char* const ws = uptr(KWS(ka));
                MapPool mp{(const char*)(ws + WS_QCB), (const char*)(ws + WS_WP_T)};
                pg8::Sched<MapPool> S; S.init(NTOK / 256, DM / 256, G, bx, mp);
                EpiResB<false> E{(const bf16_t*)(ws + WS_XB), (bf16_t*)(ws + WS_XALT), (float*)(ws + WS_SSP), KIN(ka, 9)};
                pg8::gemm_phase<EpiResB<false>, pg8::Sched<MapPool>, true>(F.wave, ring, xl, 512, DM * 2, DM * 2, S, E);
                SEAM(14);
            }
        }
        if (IN(pb + 0)) PHASE(pb + 0) { const karg_t ka = kargs(); unsigned char* const ws = uptr(KWS(ka));
            MapLin mp{(const char*)(ws + (l == 0 ? WS_XB : WS_XALT)), (const char*)(ws + WS_WCQ_T + (size_t)l * DM * DM * 2), (size_t)256 * DM * 2, (size_t)256 * DM * 2};
            pg8::Sched<MapLin> S; S.init(NTOK / 256, DM / 256, G, bx, mp);
            EpiRowScale E{(bf16_t*)(ws + WS_QCB), DM, (const float*)(ws + WS_SSP), 0.04419417382415922f};
            pg8::gemm_phase<EpiRowScale, pg8::Sched<MapLin>, true>(F.wave, ring, xl, DM, DM * 2, DM * 2, S, E);
            SEAM(pb + 0);
        }
        if (IN(pb + 1)) PHASE(pb + 1) { const karg_t ka = kargs(); unsigned char* const ws = uptr(KWS(ka));
            MapXS mp{(const char*)(ws + WS_QCB), (const char*)(ws + WS_KCB + (size_t)l * NB * MEML * DM * 2)};
            pg8::Sched<MapXS> S; S.init(NTOK / 256, NMH, G, bx, mp);
            EpiSoftmax E{(bf16_t*)(ws + WS_PB), NMH * MEML};
            pg8::gemm_phase<EpiSoftmax, pg8::Sched<MapXS>, true>(F.wave, ring, xl, MHD, DM * 2, DM * 2, S, E);
            { pg8::Unit su; if (S.next(0, su)) {
                VM_WAIT(); __syncthreads(); if (F.wave == 0 && lane_id() == 0) { __builtin_amdgcn_fence(__ATOMIC_ACQUIRE, "agent"); VM_WAIT(); } __syncthreads();
                MapXPV mp2{(const char*)(ws + WS_PB), (const char*)(ws + WS_VTB + (size_t)l * NB * MEML * DM * 2)};
                SchedPair S2; S2.ua.pm = su.pm; S2.ua.pn = 2 * su.pn; S2.ub.pm = su.pm; S2.ub.pn = 2 * su.pn + 1; mp2(S2.ua); mp2(S2.ub);
                EpiStore<AddrLin> E2{AddrLin{(bf16_t*)(ws + WS_MIXB), DM}};
                pg8::gemm_phase<EpiStore<AddrLin>, SchedPair, true>(F.wave, ring, xl, MEML, NMH * MEML * 2, NB * MEML * 2, S2, E2); } }
            if (l == 0) { KV_PROJ(1, 128, 160);
            }
            SEAM(pb + 1);
        }
        if (IN(pb + 3)) PHASE(pb + 3) { const karg_t ka = kargs(); unsigned char* const ws = uptr(KWS(ka));
            MapLin mp{(const char*)(ws + WS_MIXB), (const char*)(ws + WS_WCO_T + (size_t)l * DM * DM * 2), (size_t)256 * DM * 2, (size_t)256 * DM * 2};
            pg8::Sched<MapLin> S; S.init(NTOK / 256, DM / 256, G, bx, mp);
            EpiResB<false> E{(const bf16_t*)(ws + (l == 0 ? WS_XB : WS_XALT)), (bf16_t*)(ws + (l == 0 ? WS_XALT : WS_XB)), nullptr, nullptr, (bf16_t*)(ws + WS_XSB), KIN(ka, 16) + l * DM};
            pg8::gemm_phase<EpiResB<false>, pg8::Sched<MapLin>, true>(F.wave, ring, xl, DM, DM * 2, DM * 2, S, E);
            SEAM(pb + 3);
        }
        if (IN(pb + 4)) PHASE(pb + 4) { const karg_t ka = kargs(); unsigned char* const ws = uptr(KWS(ka));
            router_phase(F, (const bf16_t*)(ws + (l == 0 ? WS_XALT : WS_XB)), (const u32x4*)(ws + WS_AFF + 512 * 1024) + (size_t)l * 8192, (float*)(ws + WS_SSP + 512 * 1024), (float*)(ws + WS_AFF), xl);
            SEAM(pb + 4);
        }
        if (IN(pb + 5)) PHASE(pb + 5) { const karg_t ka = kargs(); unsigned char* const ws = uptr(KWS(ka));
            rank_phase(F, (const float*)(ws + WS_AFF), (int*)(ws + WS_RANK), (float*)(ws + WS_GATE), (const float*)(ws + WS_SSP + 512 * 1024), (float*)(ws + WS_SSP + 768 * 1024), (int*)(ws + WS_GATE + 512 * 1024));
            if (l == 0 && bx >= NB * NE && (bx - NB * NE) * 8 + F.wave < TR_DEFER - 1024) tr_span(F, ka, ws, 3, 1024 + (bx - NB * NE) * 8 + F.wave, 0, 1);
            SEAM(pb + 5);
        }
        if (IN(pb + 6)) PHASE(pb + 6) { const karg_t ka = kargs(); unsigned char* const ws = uptr(KWS(ka));
            MapMoE mp{(const char*)(ws + WS_XSB), (const char*)(KIN(ka, 18) + (size_t)l * NE * DM * EFF), (size_t)0, (size_t)DM * EFF * 4, (size_t)128 * 4};
            pg8::Sched<MapMoE> S; S.init(NB * NE, 8, G, bx, mp);
            EpiSwiGLU E{(bf16_t*)(ws + WS_ACTB), (const float*)(ws + WS_SSP + 768 * 1024)};
            pg8::gemm_phase<EpiSwiGLU, pg8::Sched<MapMoE>, true, true, 1, false>(F.wave, ring, xl, DM, DM * 2, EFF * 4, S, E, (const int*)(ws + WS_GATE + 512 * 1024), (long)((const char*)KIN(ka, 19) - (const char*)KIN(ka, 18)));
            SEAM(pb + 6);
        }
        if (IN(pb + 7)) PHASE(pb + 7) { const karg_t ka = kargs(); unsigned char* const ws = uptr(KWS(ka));
            MapMoE mp{(const char*)(ws + WS_ACTB), (const char*)(KIN(ka, 20) + (size_t)l * NE * EFF * DM), (size_t)256 * EFF * 2, (size_t)EFF * DM * 4, (size_t)256 * 4};
            pg8::Sched<MapMoE> S; S.init(NB * NE, 8, G, bx, mp);
            EpiRowGate E{(bf16_t*)(ws + WS_YB), (const float*)(ws + WS_GATE)};
            pg8::gemm_phase<EpiRowGate, pg8::Sched<MapMoE>, true, false, 1, false>(F.wave, ring, xl, EFF, EFF * 2, DM * 4, S, E, nullptr, 512);
            SEAM(pb + 7);
        }
        if (IN(pb + 8)) PHASE(pb + 8) { const karg_t ka = kargs(); unsigned char* const ws = uptr(KWS(ka));
            combine_phase(F, (const bf16_t*)(ws + (l == 0 ? WS_XALT : WS_XB)), (bf16_t*)(ws + WS_XB), KOUT(ka), (const bf16_t*)(ws + WS_YB), (const int*)(ws + WS_RANK), l == 0 ? KIN(ka, 2) + DM : KIN(ka, 21), (bf16_t*)(ws + WS_HN), l == 1);
            SEAM(pb + 8);
        }
    }
#undef IN
#undef SEAM
#undef PHASE
#undef KV_PROJ
}


extern "C" void kernel_launch(void* const* d_in, const int* in_sizes, int n_in, void* d_out, int out_size, void* d_ws, size_t ws_size, hipStream_t stream) {
    static int grid = 0;
    if (grid == 0) {
        int dev = 0, cus = 0;
        if (n_in != 22 || out_size != NTOK * DM || ws_size < WS_FAST_END) { fprintf(stderr, "kernel_launch: unexpected shapes (n_in %d out %d ws %zu)\n", n_in, out_size, ws_size); grid = -1; return; }
        if (hipGetDevice(&dev) != hipSuccess || hipDeviceGetAttribute(&cus, hipDeviceAttributeMultiprocessorCount, dev) != hipSuccess) { fprintf(stderr, "device query failed\n"); grid = -1; return; }
        if (hipFuncSetAttribute((const void*)skel_fwd, hipFuncAttributeMaxDynamicSharedMemorySize, LDS_BYTES) != hipSuccess) { fprintf(stderr, "hipFuncSetAttribute failed\n"); grid = -1; return; }
        (void)hipGetLastError();
        grid = cus;
        if (grid != 256) { fprintf(stderr, "kernel_launch: this kernel is laid out for 256 CUs (found %d)\n", cus); grid = -1; return; }
    }
    if (grid < 0) return;
    (void)hipMemsetAsync((char*)d_ws + WS_CTL, 0, 32768, stream);
    Args a{};
    for (int i = 0; i < 22; ++i) a.in[i] = (const float*)d_in[i];
    a.out = (float*)d_out; a.ws = (unsigned char*)d_ws;
#ifdef REP_RT
    a.pad = REP_RT;
#endif
    constexpr int NL = MK_N_LAUNCHES;
    for (int li = 0; li < NL; ++li) {
        a.ph_lo = (N_PHASES * li) / NL; a.ph_hi = (N_PHASES * (li + 1)) / NL; a.li = li;
        hipLaunchKernelGGL(skel_fwd, dim3(grid), dim3(NWAVES * 64), LDS_BYTES, stream, a);
    }
}
```

```cpp
#include <hip/hip_runtime.h>
#include <cstdio>
#include <cstdint>

constexpr int DM = 2048, NB = 4, SEQ = 2048, NTOK = NB * SEQ;
constexpr int HD = 128, NQH = 12, NKVH = 4, AW = NQH * HD, KVW = NKVH * HD, FW = 512, INW = 3072;
constexpr int MEML = 256, NMH = 4, MHD = 512;
constexpr int NE = 16, EFF = 1024, CAP = 256;
constexpr float EPS = 1e-6f;

#define LAS __attribute__((address_space(3)))
#define GAS __attribute__((address_space(1)))
typedef unsigned short bf16_t;
typedef short bf16x8 __attribute__((ext_vector_type(8)));
typedef float f32x4 __attribute__((ext_vector_type(4)));
typedef float f32x2 __attribute__((ext_vector_type(2)));
typedef unsigned u32x4 __attribute__((ext_vector_type(4)));
typedef unsigned u32x2 __attribute__((ext_vector_type(2)));
typedef __bf16 bf16x2_t __attribute__((ext_vector_type(2)));
__device__ __forceinline__ unsigned cvtpk(float lo, float hi) { f32x2 v = {lo, hi}; bf16x2_t b = __builtin_convertvector(v, bf16x2_t); return __builtin_bit_cast(unsigned, b); }
__device__ __forceinline__ float bf2f(unsigned short h) { return __uint_as_float(((unsigned)h) << 16); }
template <class T> __device__ __forceinline__ T* uptr(T* p) { const unsigned long long v = (unsigned long long)p; const unsigned lo = __builtin_amdgcn_readfirstlane((unsigned)v), hi = __builtin_amdgcn_readfirstlane((unsigned)(v >> 32)); return (T*)(((unsigned long long)hi << 32) | lo); }
__device__ __forceinline__ int lane_id() { int l = (int)__builtin_amdgcn_mbcnt_hi(~0u, __builtin_amdgcn_mbcnt_lo(~0u, 0u)); asm volatile("" : "+v"(l)); return l; }
typedef __attribute__((address_space(4))) const unsigned char* karg_t;
__device__ __forceinline__ karg_t kargs() { karg_t p = (karg_t)__builtin_amdgcn_kernarg_segment_ptr(); asm volatile("" : "+s"(p)); return p; }
#define KIN(ka, i) (*(const float* const __attribute__((address_space(4)))*)((ka) + 8 * (i)))
#define KOUT(ka) (*(float* const __attribute__((address_space(4)))*)((ka) + 176))
#define KWS(ka) (*(unsigned char* const __attribute__((address_space(4)))*)((ka) + 184))
#ifndef EPI_WT
#define EPI_WT 0
#endif
__device__ __forceinline__ void st16(void* p, u32x4 v) {
#if EPI_WT
    asm volatile("global_store_dwordx4 %0, %1, off sc1\n\ts_nop 1" :: "v"(p), "v"(v) : "memory");
#else
    *(u32x4*)p = v;
#endif
}
#define LDS_WAIT() asm volatile("s_waitcnt lgkmcnt(0)" ::: "memory")
#define VM_WAIT() asm volatile("s_waitcnt vmcnt(0)" ::: "memory")
#define WG_BAR() do { asm volatile("s_waitcnt lgkmcnt(0)" ::: "memory"); __builtin_amdgcn_s_barrier(); asm volatile("" ::: "memory"); } while (0)

namespace pg8 {
constexpr int BM = 256, BK = 64, HALF = 128, HTB = HALF * BK * 2, STAGE_BYTES = 8 * HTB, NXCD = 8, WGM = 8;
__host__ __device__ __forceinline__ int lds_byte(int r, int c) { const int st = (r >> 4) * 2 + (c >> 5), rr = r & 15, cc = c & 31, ob = rr * 64 + cc * 2; return st * 1024 + (ob ^ (((ob >> 9) & 1) << 5)); }
__host__ __device__ __forceinline__ void stage_rc(int b, int& R, int& C) { const int st = b / 1024, sb = b % 1024, swz = sb ^ (((sb >> 9) & 1) << 5); R = (st >> 1) * 16 + swz / 64; C = (st & 1) * 32 + (swz % 64) / 2; }
__host__ __device__ __forceinline__ int perm32(int rho) { const int n = rho >> 4, i = rho & 15; return 8 * (i >> 2) + 4 * n + (i & 3); }

struct Unit { int pm, pn; const char* a; const char* b; };
struct EpiCtx { int wr, wc, wid; LAS unsigned char* xl; };

template <class Map> struct Sched {
    int nM, nN, nwg, G, c, wgm; Map map;
    __device__ __forceinline__ void init(int nM_, int nN_, int G_, int c_, const Map& m, int wgm_ = WGM) { nM = nM_; nN = nN_; nwg = nM * nN; G = G_; c = c_; map = m; wgm = wgm_; }
    __device__ __forceinline__ bool next(int i, Unit& u) const {
        const long L = (long)i * G + c; if (L >= nwg) return false;
        int wgid = (int)L; { const int q = nwg / NXCD, r = nwg % NXCD, xcd = wgid % NXCD, off = wgid / NXCD; wgid = (xcd < r ? xcd * (q + 1) : r * (q + 1) + (xcd - r) * q) + off; }
        const int nig = wgm * nN, gid = wgid / nig, fm = gid * wgm, gsz = (nM - fm) < wgm ? (nM - fm) : wgm;
        u.pm = fm + ((wgid % nig) % gsz); u.pn = (wgid % nig) / gsz; map(u); return true;
    }
};

template <class Epi, class SchedT, bool SP2, bool GATHER = false, int BF = 0, bool BGAIN = false>
__device__ __forceinline__ void gemm_phase(const int wave_, LAS unsigned char* lds, LAS unsigned char* xl, const int K, const int lda, const int ldb, const SchedT& S, const Epi& E, const int* gidx = nullptr, const long bhoff = 0, const LAS float* bgl = nullptr) {
    constexpr bool ALIGN_EPI = true; static_assert(SP2 || !GATHER, "GATHER needs the SP2 loop"); static_assert(BF == 0 || (SP2 && Epi::PERM), "BF needs the SP2 loop and the PERM column order");
    const int lane = lane_id(), wid = wave_, tid = wid * 64 + lane, wr = wid >> 2, wc = wid & 3, fr = lane & 15, fq = lane >> 4;
    const int nt = K / BK;
    unsigned voffA[2], voffB[2];
#pragma unroll
    for (int i = 0; i < 2; ++i) { int R, C; stage_rc(tid * 16 + i * 8192, R, C); const int Rb = Epi::PERM ? ((R & ~31) + perm32(R & 31)) : R;
        voffA[i] = (unsigned)(R * lda + C * 2); voffB[i] = (unsigned)(Rb * ldb + C * 2); }
    const size_t kstep = (size_t)(BK * 2);
    const size_t hstepA = (size_t)HALF * lda, hstepB = (size_t)HALF * ldb;
    const unsigned ldsw = (unsigned)wid * 1024u;
    const int aoff = lds_byte(wr * 64 + fr, fq * 8), boff = lds_byte(wc * 32 + fr, fq * 8);
    const unsigned xoffA = (unsigned)tid * 16u;
    int gset = 0;
    const int bf_nb = lane & 15, bf_kq = lane >> 4, bf_m = (bf_nb >> 1) & 3, bf_kb = 32 * (wid >> 2) + 8 * bf_kq;
    const unsigned bf_src = (unsigned)(bf_kb * ldb + (64 * (wid & 1) + 4 * bf_nb) * 4);
    const long bf_h = ((wid & 3) >> 1) ? bhoff : 0;
    const unsigned bf_dst = (unsigned)(((wid & 3) >> 1) * HTB + (((64 * (wid & 1) + 32 * (bf_nb >> 3) + 16 * (bf_nb & 1)) >> 4) * 2 + (wid >> 2)) * 1024 + 256 * bf_m + ((16 * bf_kq) ^ ((bf_m >> 1) << 5)));
    f32x4 bq[8];
#define PG8_BISSUE(gbase) do { if constexpr (BF) { const char* gb_ = (const char*)(gbase) + bf_h; _Pragma("unroll") for (int i_ = 0; i_ < 8; ++i_) \
        asm volatile("global_load_dwordx4 %0, %1, %2" : "=v"(bq[i_]) : "v"(bf_src), "s"(gb_ + (size_t)i_ * ldb) : "memory"); } } while (0)
#define PG8_BWAIT(n) do { if constexpr (BF) asm volatile("s_waitcnt vmcnt(" #n ")" : "+v"(bq[0]), "+v"(bq[1]), "+v"(bq[2]), "+v"(bq[3]), "+v"(bq[4]), "+v"(bq[5]), "+v"(bq[6]), "+v"(bq[7]) :: "memory"); } while (0)
#define PG8_BCONS(b_, kt_) do { if constexpr (BF) { const unsigned ad_ = (unsigned)(size_t)lds + (unsigned)PG8_SB(b_, 0) + bf_dst; \
        if constexpr (BGAIN) { { const f32x4 g_ = *(const LAS f32x4*)(bgl + (kt_) * 64 + bf_kb); bq[0] = bq[0] * g_.x; bq[1] = bq[1] * g_.y; bq[2] = bq[2] * g_.z; bq[3] = bq[3] * g_.w; } \
                               { const f32x4 g_ = *(const LAS f32x4*)(bgl + (kt_) * 64 + bf_kb + 4); bq[4] = bq[4] * g_.x; bq[5] = bq[5] * g_.y; bq[6] = bq[6] * g_.z; bq[7] = bq[7] * g_.w; } } \
        _Pragma("unroll") for (int c_ = 0; c_ < 4; ++c_) { const u32x4 o_ = (u32x4){cvtpk(bq[0][c_], bq[1][c_]), cvtpk(bq[2][c_], bq[3][c_]), cvtpk(bq[4][c_], bq[5][c_]), cvtpk(bq[6][c_], bq[7][c_])}; \
            asm volatile("ds_write_b128 %0, %1 offset:%2" :: "v"(ad_), "v"(o_), "i"(c_ * 64) : "memory"); } } } while (0)
#define PG8_GSETUP(set, pm_) do { if constexpr (GATHER) { int R0_, C0_, R1_, C1_; stage_rc(tid * 16, R0_, C0_); stage_rc(tid * 16 + 8192, R1_, C1_); \
        const GAS int* gi_ = (const GAS int*)gidx + (pm_) * 256; const int r00_ = gi_[R0_], r01_ = gi_[R1_], r10_ = gi_[128 + R0_], r11_ = gi_[128 + R1_];     \
        *(LAS u32x4*)(xl + (set) * 8192 + xoffA) = (u32x4){(unsigned)(r00_ * lda + C0_ * 2), (unsigned)(r01_ * lda + C1_ * 2), (unsigned)(r10_ * lda + C0_ * 2), (unsigned)(r11_ * lda + C1_ * 2)}; } } while (0)
#define PG8_SA(b, h) (((b) * 2 + (h)) * HTB)
#define PG8_SB(b, h) ((4 + (b) * 2 + (h)) * HTB)
#define PG8_STAGE(bufoff, gbase, voff) do { _Pragma("unroll") for (int _i = 0; _i < 2; ++_i) \
        __builtin_amdgcn_global_load_lds((const unsigned*)((const char*)(gbase) + (voff)[_i]), (LAS unsigned*)(lds + (bufoff) + ldsw + _i * 8192), 16, 0, 0); } while (0)
#define PG8_GOFF(h_, set_) u32x2 go_ = {0u, 0u}; if constexpr (GATHER) go_ = *(const LAS u32x2*)(xl + (set_) * 8192 + xoffA + (h_) * 8)
#define PG8_STAGE_A(bufoff, gbase, h_, set_) do { if constexpr (GATHER) { \
        __builtin_amdgcn_global_load_lds((const unsigned*)((const char*)(gbase) + go_.x), (LAS unsigned*)(lds + (bufoff) + ldsw), 16, 0, 0); \
        __builtin_amdgcn_global_load_lds((const unsigned*)((const char*)(gbase) + go_.y), (LAS unsigned*)(lds + (bufoff) + ldsw + 8192), 16, 0, 0); } \
      else { PG8_STAGE(bufoff, (const char*)(gbase) + (h_) * hstepA, voffA); } } while (0)
#define PG8_LDA(dst, b, h) do { _Pragma("unroll") for (int m = 0; m < 4; ++m) _Pragma("unroll") for (int k = 0; k < 2; ++k) dst[m][k] = *(const LAS bf16x8*)(lds + PG8_SA(b, h) + aoff + m * 2048 + k * 1024); } while (0)
#define PG8_LDB(dst, b, h) do { _Pragma("unroll") for (int n = 0; n < 2; ++n) _Pragma("unroll") for (int k = 0; k < 2; ++k) dst[n][k] = *(const LAS bf16x8*)(lds + PG8_SB(b, h) + boff + n * 2048 + k * 1024); } while (0)
#define PG8_MMA(ai, bj, At, Bt) do { __builtin_amdgcn_s_setprio(1); _Pragma("unroll") for (int m = 0; m < 4; ++m) _Pragma("unroll") for (int n = 0; n < 2; ++n) _Pragma("unroll") for (int k = 0; k < 2; ++k) \
        acc[ai][bj][m][n] = __builtin_amdgcn_mfma_f32_16x16x32_bf16(Bt[n][k], At[m][k], acc[ai][bj][m][n], 0, 0, 0); __builtin_amdgcn_s_setprio(0); } while (0)
#define PG8_WAIT_V(n) asm volatile("s_waitcnt vmcnt(" #n ")" ::: "memory")
#define PG8_WAIT_L(n) asm volatile("s_waitcnt lgkmcnt(" #n ")" ::: "memory")
#define PG8_BAR __builtin_amdgcn_s_barrier()
#define PG8_SCHED __builtin_amdgcn_sched_barrier(0)
    Unit cur, nxt; int ui = 0;
    if (!S.next(0, cur)) return;
    EpiCtx ctx; ctx.wr = wr; ctx.wc = wc; ctx.wid = wid; ctx.xl = xl;
    f32x4 acc[2][2][4][2];
#pragma unroll
    for (int a = 0; a < 2; ++a)
#pragma unroll
        for (int b = 0; b < 2; ++b)
#pragma unroll
            for (int m = 0; m < 4; ++m)
#pragma unroll
                for (int n = 0; n < 2; ++n) acc[a][b][m][n] = (f32x4){0.f, 0.f, 0.f, 0.f};
    bf16x8 At[4][2], B0[2][2], B1[2][2];
    const char* cA = cur.a; const char* cB = cur.b;
    PG8_GSETUP(0, cur.pm);
    const size_t kstepB = BF ? (size_t)BK * ldb : kstep;
    if constexpr (BF) {
        PG8_BISSUE(cB); { PG8_GOFF(0, 0); PG8_STAGE_A(PG8_SA(0, 0), cA, 0, 0); } { PG8_GOFF(1, 0); PG8_STAGE_A(PG8_SA(0, 1), cA, 1, 0); }
        if (wr == 1) PG8_BAR;
        PG8_BWAIT(2); PG8_BCONS(0, 0); PG8_WAIT_L(0); PG8_BAR;
        { PG8_GOFF(0, 0); PG8_STAGE_A(PG8_SA(1, 0), cA + kstep, 0, 0); } PG8_BISSUE(cB + kstepB);
        PG8_WAIT_V(10); PG8_BAR;
    } else if constexpr (SP2) {
        PG8_STAGE(PG8_SB(0, 0), cB, voffB); PG8_STAGE(PG8_SB(0, 1), cB + hstepB, voffB); { PG8_GOFF(0, 0); PG8_STAGE_A(PG8_SA(0, 0), cA, 0, 0); } { PG8_GOFF(1, 0); PG8_STAGE_A(PG8_SA(0, 1), cA, 1, 0); }
        if (wr == 1) PG8_BAR;
        PG8_WAIT_V(2); PG8_BAR;
        PG8_STAGE(PG8_SB(1, 0), cB + kstep, voffB); { PG8_GOFF(0, 0); PG8_STAGE_A(PG8_SA(1, 0), cA + kstep, 0, 0); } PG8_STAGE(PG8_SB(1, 1), cB + hstepB + kstep, voffB);
        PG8_WAIT_V(6); PG8_BAR;
    } else {
        PG8_STAGE(PG8_SB(0, 0), cB, voffB); PG8_STAGE(PG8_SA(0, 0), cA, voffA); PG8_STAGE(PG8_SB(0, 1), cB + hstepB, voffB); PG8_STAGE(PG8_SA(0, 1), cA + hstepA, voffA);
        if (wr == 1) PG8_BAR;
        PG8_WAIT_V(4); PG8_BAR;
        PG8_STAGE(PG8_SB(1, 0), cB + kstep, voffB); PG8_STAGE(PG8_SA(1, 0), cA + kstep, voffA); PG8_STAGE(PG8_SB(1, 1), cB + hstepB + kstep, voffB);
        PG8_WAIT_V(6); PG8_BAR;
    }
    for (;;) {
        const bool has_next = S.next(ui + 1, nxt);
        const char* nA = has_next ? nxt.a : cA; const char* nB = has_next ? nxt.b : cB;
        if (has_next) PG8_GSETUP(gset ^ 1, nxt.pm);
        for (int t = 0; t < nt; t += 2) {
            const bool last = (t == nt - 2);
            const char* a1 = cA + (size_t)(t + 1) * kstep;
            const char* a2 = last ? nA : cA + (size_t)(t + 2) * kstep; const char* b2 = last ? nB : cB + (size_t)(t + 2) * kstepB;
            const char* a3 = a2 + kstep; const char* b3 = b2 + kstepB;
            const int set2 = (last && has_next) ? (gset ^ 1) : gset;
            if constexpr (BF) {
            const int kt2 = last ? 0 : t + 2;
            { PG8_GOFF(1, gset); PG8_LDB(B0, 0, 0); PG8_LDB(B1, 0, 1); PG8_SCHED; PG8_LDA(At, 0, 0); PG8_STAGE_A(PG8_SA(1, 1), a1, 1, gset); }
            PG8_WAIT_V(12); PG8_WAIT_L(0); PG8_BAR; PG8_MMA(0, 0, At, B0); PG8_MMA(0, 1, At, B1); PG8_BAR; PG8_SCHED;
            { PG8_GOFF(0, set2); PG8_LDA(At, 0, 1); PG8_STAGE_A(PG8_SA(0, 0), a2, 0, set2); PG8_SCHED; PG8_BWAIT(4); PG8_BCONS(1, t + 1); PG8_SCHED; PG8_BISSUE(b2); }
            PG8_WAIT_L(0); PG8_BAR; PG8_MMA(1, 0, At, B0); PG8_MMA(1, 1, At, B1); PG8_BAR; PG8_SCHED;
            { PG8_GOFF(1, set2); PG8_LDB(B0, 1, 0); PG8_LDB(B1, 1, 1); PG8_SCHED; PG8_LDA(At, 1, 0); PG8_STAGE_A(PG8_SA(0, 1), a2, 1, set2); }
            PG8_WAIT_V(12); PG8_WAIT_L(0); PG8_BAR; PG8_MMA(0, 0, At, B0); PG8_MMA(0, 1, At, B1); PG8_BAR; PG8_SCHED;
            { PG8_GOFF(0, set2); PG8_LDA(At, 1, 1); PG8_STAGE_A(PG8_SA(1, 0), a3, 0, set2); PG8_SCHED; PG8_BWAIT(4); PG8_BCONS(0, kt2); PG8_SCHED; PG8_BISSUE(b3); }
            PG8_WAIT_L(0); PG8_BAR; PG8_MMA(1, 0, At, B0); PG8_MMA(1, 1, At, B1); PG8_BAR; PG8_SCHED;
            } else if constexpr (SP2) {
            { PG8_GOFF(1, gset); PG8_LDB(B0, 0, 0); PG8_LDB(B1, 0, 1); PG8_SCHED; PG8_LDA(At, 0, 0); PG8_STAGE_A(PG8_SA(1, 1), a1, 1, gset); }
            PG8_WAIT_V(8); PG8_WAIT_L(0); PG8_BAR; PG8_MMA(0, 0, At, B0); PG8_MMA(0, 1, At, B1); PG8_BAR; PG8_SCHED;
            { PG8_GOFF(0, set2); PG8_LDA(At, 0, 1); PG8_STAGE(PG8_SB(0, 0), b2, voffB); PG8_STAGE(PG8_SB(0, 1), b2 + hstepB, voffB); PG8_STAGE_A(PG8_SA(0, 0), a2, 0, set2); }
            PG8_WAIT_V(8); PG8_WAIT_L(0); PG8_BAR; PG8_MMA(1, 0, At, B0); PG8_MMA(1, 1, At, B1); PG8_BAR; PG8_SCHED;
            { PG8_GOFF(1, set2); PG8_LDB(B0, 1, 0); PG8_LDB(B1, 1, 1); PG8_SCHED; PG8_LDA(At, 1, 0); PG8_STAGE_A(PG8_SA(0, 1), a2, 1, set2); }
            PG8_WAIT_V(8); PG8_WAIT_L(0); PG8_BAR; PG8_MMA(0, 0, At, B0); PG8_MMA(0, 1, At, B1); PG8_BAR; PG8_SCHED;
            { PG8_GOFF(0, set2); PG8_LDA(At, 1, 1); PG8_STAGE(PG8_SB(1, 0), b3, voffB); PG8_STAGE(PG8_SB(1, 1), b3 + hstepB, voffB); PG8_STAGE_A(PG8_SA(1, 0), a3, 0, set2); }
            PG8_WAIT_V(8); PG8_WAIT_L(0); PG8_BAR; PG8_MMA(1, 0, At, B0); PG8_MMA(1, 1, At, B1); PG8_BAR; PG8_SCHED;
            } else {
            PG8_LDB(B0, 0, 0); PG8_SCHED; PG8_LDA(At, 0, 0); PG8_STAGE(PG8_SA(1, 1), a1 + hstepA, voffA);
            PG8_WAIT_L(8); PG8_BAR; PG8_WAIT_L(0); PG8_MMA(0, 0, At, B0); PG8_BAR; PG8_SCHED;
            PG8_LDB(B1, 0, 1); PG8_STAGE(PG8_SB(0, 0), b2, voffB);
            PG8_BAR; PG8_WAIT_L(0); PG8_MMA(0, 1, At, B1); PG8_BAR;
            PG8_LDA(At, 0, 1); PG8_STAGE(PG8_SA(0, 0), a2, voffA);
            PG8_BAR; PG8_WAIT_L(0); PG8_MMA(1, 0, At, B0); PG8_BAR; PG8_SCHED;
            PG8_STAGE(PG8_SB(0, 1), b2 + hstepB, voffB);
            PG8_WAIT_V(6); PG8_BAR; PG8_MMA(1, 1, At, B1); PG8_BAR;
            PG8_LDB(B0, 1, 0); PG8_SCHED; PG8_LDA(At, 1, 0); PG8_STAGE(PG8_SA(0, 1), a2 + hstepA, voffA);
            PG8_WAIT_L(8); PG8_BAR; PG8_WAIT_L(0); PG8_MMA(0, 0, At, B0); PG8_BAR; PG8_SCHED;
            PG8_LDB(B1, 1, 1); PG8_STAGE(PG8_SB(1, 0), b3, voffB);
            PG8_BAR; PG8_WAIT_L(0); PG8_MMA(0, 1, At, B1); PG8_BAR;
            PG8_LDA(At, 1, 1); PG8_STAGE(PG8_SA(1, 0), a3, voffA);
            PG8_BAR; PG8_WAIT_L(0); PG8_MMA(1, 0, At, B0); PG8_BAR; PG8_SCHED;
            PG8_STAGE(PG8_SB(1, 1), b3 + hstepB, voffB);
            PG8_WAIT_V(6); PG8_BAR; PG8_MMA(1, 1, At, B1); PG8_BAR;
            }
        }
        PG8_BWAIT(0);
        if constexpr (ALIGN_EPI) { if (wr == 0) PG8_BAR; }
        E(acc, cur, ctx);
        if (!has_next) break;
#pragma unroll
        for (int a = 0; a < 2; ++a)
#pragma unroll
            for (int b = 0; b < 2; ++b)
#pragma unroll
                for (int m = 0; m < 4; ++m)
#pragma unroll
                    for (int n = 0; n < 2; ++n) acc[a][b][m][n] = (f32x4){0.f, 0.f, 0.f, 0.f};
        cur = nxt; cA = nA; cB = nB; ++ui; gset ^= 1;
        if constexpr (ALIGN_EPI) { if (wr == 1) PG8_BAR; }
    }
    PG8_WAIT_V(0);
    if constexpr (!ALIGN_EPI) { if (wr == 0) PG8_BAR; }
    PG8_BAR;
#undef PG8_SA
#undef PG8_SB
#undef PG8_STAGE
#undef PG8_STAGE_A
#undef PG8_GOFF
#undef PG8_GSETUP
#undef PG8_BISSUE
#undef PG8_BWAIT
#undef PG8_BCONS
#undef PG8_LDA
#undef PG8_LDB
#undef PG8_MMA
#undef PG8_WAIT_V
#undef PG8_WAIT_L
#undef PG8_BAR
#undef PG8_SCHED
}
}

constexpr size_t MiB = 1u << 20;
constexpr size_t WS_CTL = 0, CTL_ZERO_BYTES = 1 * MiB;
constexpr size_t WS_WIN_T = 1 * MiB, WS_WF_T = 11 * MiB, WS_WOUT_T = 15 * MiB, WS_WCQ_T = 23 * MiB, WS_WCK_T = 39 * MiB, WS_WCV_T = 55 * MiB, WS_WCO_T = 71 * MiB;
constexpr size_t WS_WP_T = 87 * MiB, WS_DFT = 89 * MiB, WS_ROPE = 105 * MiB, WS_WGU_T = 106 * MiB, WS_WD_T = 234 * MiB;
constexpr size_t WS_HN = 298 * MiB, WS_XB = 330 * MiB, WS_QB = 362 * MiB, WS_KB = 386 * MiB, WS_VB = 394 * MiB, WS_FPQ = 402 * MiB, WS_MIXB = 418 * MiB, WS_QCB = 450 * MiB;
constexpr size_t WS_KCB = 482 * MiB, WS_VTB = 490 * MiB, WS_MEMNB = 498 * MiB, WS_PB = 506 * MiB, WS_XSB = 522 * MiB, WS_ACTB = 586 * MiB, WS_YB = 618 * MiB;
constexpr size_t WS_SSP = 682 * MiB, WS_AFF = 683 * MiB, WS_RANK = 684 * MiB, WS_GATE = 685 * MiB, WS_XALT = 686 * MiB, WS_WGU_T2 = 750 * MiB, WS_WD_T2 = 878 * MiB, WS_FAST_END = 942 * MiB;
constexpr int CW_TMO = 0, CW_CODE = 1, CW_BAR = 4096;
constexpr int RING_OFF = 0, RING_BYTES = 131072, XL_OFF = 131072, XL_BYTES = 16384, LDSCTL_OFF = XL_OFF + XL_BYTES, MISC_OFF = LDSCTL_OFF + 320, LDS_BYTES = 149504;
static_assert(MISC_OFF + 128 <= LDS_BYTES, "LDS map");
constexpr int NWAVES = 8;

typedef GAS unsigned gu32;
#define RLX_AGENT __ATOMIC_RELAXED, __HIP_MEMORY_SCOPE_AGENT

#define XB_TMO      128
#define XB_XCNT(j)  (256  + 64 * (j))
#define XB_XSUB(j)  (1280 + 64 * (j))
#define XB_XGEN(j)  (2304 + 64 * (j))
#define XB_TOP      3328
#define XB_TOPGEN   3392
#define XCD_BAR_WORDS 3456
#define XB_SPIN_CAP (1u << 18)
__device__ __forceinline__ unsigned xb_ld(unsigned* p)              { return __hip_atomic_load(p, __ATOMIC_RELAXED, __HIP_MEMORY_SCOPE_AGENT); }
__device__ __forceinline__ unsigned xb_add(unsigned* p, unsigned v) { return __hip_atomic_fetch_add(p, v, __ATOMIC_RELAXED, __HIP_MEMORY_SCOPE_AGENT); }
__device__ __forceinline__ unsigned xb_xcc_id() { return (unsigned)__builtin_amdgcn_s_getreg((3 << 11) | 20) & 0xFu; }
#define XB_SPIN(cond, bar) do { unsigned _sp = 0; while (cond) { __builtin_amdgcn_s_sleep(1); \
    if ((++_sp & 255u) == 0u) { if (xb_ld(&(bar)[XB_TMO])) break; if (_sp > XB_SPIN_CAP) { atomicAdd(&(bar)[XB_TMO], 1u); break; } } } } while (0)
struct XcdBarrier { unsigned* bar; unsigned x; volatile LAS unsigned* st; int wave; };
__device__ __forceinline__ XcdBarrier xcd_barrier_post(unsigned* bar, volatile LAS unsigned* st, int wave) {
    XcdBarrier b; b.bar = bar; b.x = xb_xcc_id(); b.st = st; b.wave = wave;
    if (wave == 0 && lane_id() == 0) (void)xb_add(&bar[XB_XCNT(b.x)], 1u);
    return b;
}
__device__ __forceinline__ void xcd_barrier_complete(unsigned* bar, unsigned x, unsigned& nloc, unsigned& nx) {
    const unsigned G = gridDim.x * gridDim.y * gridDim.z;
    unsigned sum, cnt, mine, sp = 0u;
    for (;;) {
        sum = 0u; cnt = 0u; mine = 0u;
#pragma unroll
        for (unsigned j = 0; j < 16; ++j) { const unsigned c = xb_ld(&bar[XB_XCNT(j)]); sum += c; cnt += (c > 0u) ? 1u : 0u; mine = (j == x) ? c : mine; }
        if (sum == G) break;
        __builtin_amdgcn_s_sleep(1);
        if ((++sp & 255u) == 0u) { if (xb_ld(&bar[XB_TMO])) break; if (sp > XB_SPIN_CAP) { atomicAdd(&bar[XB_TMO], 1u); break; } }
    }
    nloc = mine > 0u ? mine : 1u; nx = cnt > 0u ? cnt : 1u;
}
__device__ __forceinline__ void xcd_barrier(const XcdBarrier& b) {
    asm volatile("s_waitcnt vmcnt(0)" ::: "memory");
    __syncthreads();
    if (b.wave == 0 && lane_id() == 0) {
        unsigned* bar = b.bar;
        __builtin_amdgcn_s_waitcnt(0);
        unsigned nloc = b.st[0], nx = b.st[1];
        if (nloc == 0u) { xcd_barrier_complete(bar, b.x, nloc, nx); b.st[0] = nloc; b.st[1] = nx; }
        const unsigned old = xb_add(&bar[XB_XSUB(b.x)], 1u);
        const unsigned gen = old / nloc;
        if (old + 1u == (gen + 1u) * nloc) {
            __builtin_amdgcn_fence(__ATOMIC_RELEASE, "agent");
            asm volatile("s_waitcnt vmcnt(0)" ::: "memory");
            const unsigned og = xb_add(&bar[XB_TOP], 1u);
            const unsigned tg = og / nx;
            if (og + 1u == (tg + 1u) * nx) xb_add(&bar[XB_TOPGEN], 1u);
            else XB_SPIN(xb_ld(&bar[XB_TOPGEN]) == tg, bar);
            __builtin_amdgcn_fence(__ATOMIC_ACQUIRE, "agent");
            xb_add(&bar[XB_XGEN(b.x)], 1u);
            asm volatile("s_waitcnt vmcnt(0)" ::: "memory");
        } else {
            XB_SPIN(xb_ld(&bar[XB_XGEN(b.x)]) == gen, bar);
            __builtin_amdgcn_fence(__ATOMIC_ACQUIRE, "agent");
            asm volatile("s_waitcnt vmcnt(0)" ::: "memory");
        }
    }
    __syncthreads();
}

struct Args { const float* in[22]; float* out; unsigned char* ws; int ph_lo, ph_hi, li, pad; };
struct Frame {
    LAS unsigned char* lds; volatile LAS unsigned* MISC; gu32* ctl;
    int wave, vcu, G;
    unsigned char* ws;
};
__device__ __forceinline__ float wave_sum(float v) {
#pragma unroll
    for (int o = 1; o < 64; o <<= 1) v += __shfl_xor(v, o);
    return v;
}
struct TrDesc { const float* W; const float* gain; bf16_t* WT; int ldw, ldt, k0, n0; long drow0; };
__device__ __forceinline__ void tr_load(const TrDesc& d, f32x4 (&v)[16], int lane) {
    const int lr = lane >> 4, lc = (lane & 15) * 4;
#pragma unroll
    for (int i = 0; i < 16; ++i) v[i] = __builtin_nontemporal_load((const GAS f32x4*)(d.W + (size_t)(d.k0 + 4 * i + lr) * d.ldw + d.n0 + lc));
}
#ifndef TRV
#define TRV 0
#endif
template <int V> __device__ __forceinline__ void tr_finish(const TrDesc& d, const f32x4 (&v)[16], LAS float* scr, int lane) {
    const int lr = lane >> 4, lc = (lane & 15) * 4;
    if (V == 1) { f32x4 s = v[0]; for (int i = 1; i < 16; ++i) s = s + v[i]; if (s.x == 1.2345e30f) *(GAS f32x4*)(d.WT) = s; return; }
#pragma unroll
    for (int i = 0; i < 16; ++i) { const int kk = 4 * i + lr; f32x4 x = v[i]; if (d.gain) x = x * d.gain[d.k0 + kk];
        LAS float* s = scr + kk * 65 + lc; s[0] = x.x; s[1] = x.y; s[2] = x.z; s[3] = x.w; }
    LDS_WAIT(); asm volatile("" ::: "memory");
    const int c = lane & 7;
#pragma unroll
    for (int j = 0; j < 8; ++j) { const int n = (lane >> 3) + 8 * j; const LAS float* s = scr + (8 * c) * 65 + n;
        u32x4 o; o.x = cvtpk(s[0 * 65], s[1 * 65]); o.y = cvtpk(s[2 * 65], s[3 * 65]); o.z = cvtpk(s[4 * 65], s[5 * 65]); o.w = cvtpk(s[6 * 65], s[7 * 65]);
        if (V == 0 || o.x == 0x12345678u) __builtin_nontemporal_store(o, (GAS u32x4*)(d.WT + (size_t)(d.drow0 + n) * d.ldt + d.k0 + 8 * c)); }
    LDS_WAIT(); asm volatile("" ::: "memory");
}
#ifndef TR_PIPE
#define TR_PIPE 0
#endif
constexpr int TR_DENSE = 32 * 20 + 5 * 32 * 16, TR_DEFER = 4 * 32 * 16 + 32 * 4, TR_EXPERT = NE * 512;
__device__ __forceinline__ TrDesc tr_desc(karg_t ka, unsigned char* ws, int it, int mode) {
    TrDesc d; d.gain = nullptr;
    constexpr int I_IN = 32 * 20, I_SQ = 32 * 16;
    if (mode == 0 || mode == 3) {
        int r = it;
        if (mode == 0) {
            if (r < I_IN) { d.W = KIN(ka, 3); d.ldw = INW; d.WT = (bf16_t*)(ws + WS_WIN_T); d.ldt = DM; d.k0 = (r / 20) * 64; d.n0 = (r % 20) * 128; d.drow0 = d.n0; return d; } r -= I_IN;
            if (r < I_SQ) { d.W = KIN(ka, 7); d.ldw = DM; d.WT = (bf16_t*)(ws + WS_WOUT_T); d.ldt = DM; d.k0 = (r / 16) * 64; d.n0 = (r % 16) * 128; d.drow0 = d.n0; return d; } r -= I_SQ;
        }
        if (r < 4 * I_SQ) { const int j = r / I_SQ, q = r % I_SQ, layer = mode == 0 ? 0 : 1, wsel = mode == 0 ? j : (j == 0 ? 1 : j == 1 ? 2 : j == 2 ? 0 : 3);
            d.W = KIN(ka, 12 + wsel) + (size_t)layer * DM * DM; d.ldw = DM; if (wsel == 0) d.gain = KIN(ka, 10) + layer * DM;
            d.WT = (bf16_t*)(ws + (wsel == 0 ? WS_WCQ_T : wsel == 1 ? WS_WCK_T : wsel == 2 ? WS_WCV_T : WS_WCO_T) + (size_t)layer * DM * DM * 2); d.ldt = DM;
            d.k0 = (q / 16) * 64; d.n0 = (q % 16) * 128; d.drow0 = d.n0; return d; } r -= 4 * I_SQ;
        d.W = KIN(ka, 8); d.ldw = 512; d.WT = (bf16_t*)(ws + WS_WP_T); d.ldt = DM; d.k0 = (r / 4) * 64; d.n0 = (r % 4) * 128; d.drow0 = d.n0; return d;
    }
    const int layer = mode - 1;
    const int e = it / 512, r = it % 512; const size_t eo = (size_t)(layer * NE + e);
    { const int up = r >> 8, q = r & 255, kb = q >> 3, nb = q & 7, n0 = nb * 128;
        d.W = (up ? KIN(ka, 19) : KIN(ka, 18)) + eo * DM * EFF; d.ldw = EFF; d.gain = KIN(ka, 16) + layer * DM;   d.WT = (bf16_t*)(ws + (layer ? WS_WGU_T2 : WS_WGU_T)) + (size_t)e * 2048 * 2048; d.ldt = 2048;
        d.k0 = kb * 64; d.n0 = n0; d.drow0 = (long)(n0 >> 7) * 256 + up * 128;
    }
    return d;
}
template <int V = 0> __device__ __forceinline__ void tr_span(const Frame& F, karg_t ka, unsigned char* ws, int mode, int first, int stride, int cnt) {
    const int lane = lane_id(); LAS float* scr = (LAS float*)(F.lds + RING_OFF + F.wave * 16640);
    if (cnt <= 0) return;
    f32x4 va[16], vb[16];
    TrDesc da = tr_desc(ka, ws, first, mode), db = da; db.n0 += 64; db.drow0 += 64;
    tr_load(da, va, lane); tr_load(db, vb, lane);
    for (int j = 0; j < cnt; ++j) {
        const bool more = j + 1 < cnt; TrDesc na = da, nb = db;
        if (more) { na = tr_desc(ka, ws, first + stride * (j + 1), mode); nb = na; nb.n0 += 64; nb.drow0 += 64; }
        tr_finish<V>(da, va, scr, lane); if (more) tr_load(na, va, lane);
        tr_finish<V>(db, vb, scr, lane); if (more) tr_load(nb, vb, lane);
        da = na; db = nb;
    }
}
__device__ __forceinline__ void rms_row_to_bf16(const float* xrow, const float* __restrict__ gain, bf16_t* orow, int lane) {
    const GAS f32x4* xr = (const GAS f32x4*)xrow + lane; const f32x4* gr = (const f32x4*)gain + lane;
    f32x4 v[8]; float s = 0.f;
#pragma unroll
    for (int j = 0; j < 8; ++j) { v[j] = xr[64 * j]; s += (v[j].x * v[j].x + v[j].y * v[j].y) + (v[j].z * v[j].z + v[j].w * v[j].w); }
    const float r = rsqrtf(wave_sum(s) * (1.f / DM) + EPS);
    GAS u32x2* o8 = (GAS u32x2*)orow + lane;
#pragma unroll
    for (int j = 0; j < 8; ++j) { const f32x4 g = gr[64 * j]; u32x2 w; w.x = cvtpk(v[j].x * r * g.x, v[j].y * r * g.y); w.y = cvtpk(v[j].z * r * g.z, v[j].w * r * g.w); o8[64 * j] = w; }
}

__device__ __forceinline__ void rms_rows2_to_bf16(const float* x0, const float* x1, const float* __restrict__ gain, bf16_t* o0, bf16_t* o1, int lane) {
    f32x4 a[4][2], b[4][2]; float sa = 0.f, sb = 0.f;
#pragma unroll
    for (int j = 0; j < 4; ++j) { const int c0 = 8 * (lane + 64 * j); a[j][0] = *(const GAS f32x4*)(x0 + c0); a[j][1] = *(const GAS f32x4*)(x0 + c0 + 4); b[j][0] = *(const GAS f32x4*)(x1 + c0); b[j][1] = *(const GAS f32x4*)(x1 + c0 + 4); }
#pragma unroll
    for (int j = 0; j < 4; ++j)
#pragma unroll
        for (int q = 0; q < 2; ++q) { sa += (a[j][q].x * a[j][q].x + a[j][q].y * a[j][q].y) + (a[j][q].z * a[j][q].z + a[j][q].w * a[j][q].w); sb += (b[j][q].x * b[j][q].x + b[j][q].y * b[j][q].y) + (b[j][q].z * b[j][q].z + b[j][q].w * b[j][q].w); }
    const float ra = rsqrtf(wave_sum(sa) * (1.f / DM) + EPS), rb = rsqrtf(wave_sum(sb) * (1.f / DM) + EPS);
#pragma unroll
    for (int j = 0; j < 4; ++j) { const int c0 = 8 * (lane + 64 * j); const f32x4 g0 = *(const f32x4*)(gain + c0), g1 = *(const f32x4*)(gain + c0 + 4);
        *(GAS u32x4*)(o0 + c0) = (u32x4){cvtpk(a[j][0].x * ra * g0.x, a[j][0].y * ra * g0.y), cvtpk(a[j][0].z * ra * g0.z, a[j][0].w * ra * g0.w), cvtpk(a[j][1].x * ra * g1.x, a[j][1].y * ra * g1.y), cvtpk(a[j][1].z * ra * g1.z, a[j][1].w * ra * g1.w)};
        *(GAS u32x4*)(o1 + c0) = (u32x4){cvtpk(b[j][0].x * rb * g0.x, b[j][0].y * rb * g0.y), cvtpk(b[j][0].z * rb * g0.z, b[j][0].w * rb * g0.w), cvtpk(b[j][1].x * rb * g1.x, b[j][1].y * rb * g1.y), cvtpk(b[j][1].z * rb * g1.z, b[j][1].w * rb * g1.w)}; }
}

__device__ __forceinline__ void p0_prologue(Frame& F, karg_t ka, unsigned char* ws) {
    const float* x = KIN(ka, 0); const float* mem = KIN(ka, 1); const float* mix_norm = KIN(ka, 2); const float* w_in = KIN(ka, 3);
    const float* w_four = KIN(ka, 6); const float* w_out = KIN(ka, 7); const float* pool_w = KIN(ka, 8); const float* cross_norm = KIN(ka, 10); const float* mem_norm = KIN(ka, 11);
    const int gw = F.vcu * NWAVES + F.wave, NGW = F.G * NWAVES;
    const int p_lane = lane_id(), p_tid = F.wave * 64 + p_lane;
    { LAS float* tab = (LAS float*)(F.lds + RING_OFF);
      for (int m = p_tid; m < 2048; m += 512) tab[m] = cosf(6.283185307179586f * (float)m * (1.0f / 2048.0f));
      __syncthreads();
      bf16_t* DFT = (bf16_t*)(ws + WS_DFT);
      for (int row = F.vcu * 8; row < 2048; row += F.G * 8)
          for (int rr = 0; rr < 8; ++rr) { const int k1 = row + rr; if (k1 >= 2048) break;
              { const int c0 = p_tid * 8; const int which = c0 >> 11, s0 = c0 & 2047; unsigned w[4];
#pragma unroll
                for (int j = 0; j < 4; ++j) { const int ma = (k1 * (s0 + 2 * j)) & 2047, mb = (k1 * (s0 + 2 * j + 1)) & 2047;
                    w[j] = cvtpk(tab[(ma - which * 512) & 2047], tab[(mb - which * 512) & 2047]); }
                *(GAS u32x4*)(DFT + (size_t)k1 * 4096 + c0) = (u32x4){w[0], w[1], w[2], w[3]}; } }
      __syncthreads(); }
    { float* RC = (float*)(ws + WS_ROPE); float* RS = RC + SEQ * 64;
      for (int i = F.vcu * 512 + p_tid; i < SEQ * 64; i += F.G * 512) { const int t = i >> 6, p = i & 63; const int pos = (p < 32) ? (t >> 6) : (t & 63); const int j = p & 31;
          const float inv = 1.0f / powf(10000.0f, (float)(2 * j) / 64.0f); const float ang = (float)pos * inv; RC[i] = cosf(ang); RS[i] = sinf(ang); } }
    { u32x4* RB = (u32x4*)(ws + WS_AFF + 512 * 1024);
      for (int i = F.vcu * 512 + p_tid; i < 2 * 64 * 64; i += F.G * 512) { const int layer = i >> 12, ks = (i >> 6) & 63, ln = i & 63, e = ln & 15, k0 = 32 * ks + 8 * (ln >> 4);
          const float* Wr = KIN(ka, 17) + (size_t)layer * DM * NE; const float* gn = KIN(ka, 16) + layer * DM; float w[8], lo[8];
#pragma unroll
          for (int j = 0; j < 8; ++j) { w[j] = gn[k0 + j] * Wr[(size_t)(k0 + j) * NE + e]; }
          u32x4 hi4 = {cvtpk(w[0], w[1]), cvtpk(w[2], w[3]), cvtpk(w[4], w[5]), cvtpk(w[6], w[7])};
          const unsigned hh[4] = {hi4.x, hi4.y, hi4.z, hi4.w};
#pragma unroll
          for (int j = 0; j < 4; ++j) { lo[2 * j] = w[2 * j] - __uint_as_float(hh[j] << 16); lo[2 * j + 1] = w[2 * j + 1] - __uint_as_float(hh[j] & 0xffff0000u); }
          RB[(size_t)(layer * 2 + 0) * 4096 + ks * 64 + ln] = hi4;
          RB[(size_t)(layer * 2 + 1) * 4096 + ks * 64 + ln] = (u32x4){cvtpk(lo[0], lo[1]), cvtpk(lo[2], lo[3]), cvtpk(lo[4], lo[5]), cvtpk(lo[6], lo[7])}; } }
    { LAS float* Mw = (LAS float*)(F.lds + RING_OFF); LAS float* t128 = Mw + 128 * 32;
      bf16_t* WF = (bf16_t*)(ws + WS_WF_T);
      for (int it = F.vcu; it < 256; it += F.G) {
          const int which = it >> 7, g = (it >> 5) & 3, d0 = ((it >> 3) & 3) * 32, k0 = (it & 7) * 256;
          if (p_tid < 128) t128[p_tid] = cosf(6.283185307179586f * (float)p_tid * (1.0f / 128.0f));
          __syncthreads();
          { const int c = p_tid >> 2, dd = (p_tid & 3) * 8; float o[8] = {0.f, 0.f, 0.f, 0.f, 0.f, 0.f, 0.f, 0.f};
#pragma unroll 16
            for (int k2 = 0; k2 < 128; ++k2) { const int m = (c * k2) & 127; const float tv = which ? -t128[(m - 32) & 127] : t128[m];
                const float* wr_ = w_four + ((size_t)g * 128 + k2) * 128 + d0 + dd; const f32x4 w0 = *(const f32x4*)wr_, w1 = *(const f32x4*)(wr_ + 4);
                o[0] += tv * w0.x; o[1] += tv * w0.y; o[2] += tv * w0.z; o[3] += tv * w0.w; o[4] += tv * w1.x; o[5] += tv * w1.y; o[6] += tv * w1.z; o[7] += tv * w1.w; }
#pragma unroll
            for (int j = 0; j < 8; ++j) Mw[c * 32 + dd + j] = o[j] * (1.0f / 512.0f); }
          __syncthreads();
          { const int kp = p_tid & 127, dq = p_tid >> 7, k = k0 + 2 * kp; float o0[8] = {0.f, 0.f, 0.f, 0.f, 0.f, 0.f, 0.f, 0.f}, o1[8] = {0.f, 0.f, 0.f, 0.f, 0.f, 0.f, 0.f, 0.f};
            const float* r0 = w_in + (size_t)k * INW + 2560 + g * 128; const float* r1 = r0 + INW;
#pragma unroll 8
            for (int c4 = 0; c4 < 32; ++c4) { const f32x4 a = *(const f32x4*)(r0 + 4 * c4), b = *(const f32x4*)(r1 + 4 * c4); const float av[4] = {a.x, a.y, a.z, a.w}, bv[4] = {b.x, b.y, b.z, b.w};
#pragma unroll
                for (int cc = 0; cc < 4; ++cc) { const LAS float* mr = Mw + (4 * c4 + cc) * 32 + dq * 8;
#pragma unroll
                    for (int j = 0; j < 8; ++j) { o0[j] += av[cc] * mr[j]; o1[j] += bv[cc] * mr[j]; } } }
#pragma unroll
            for (int j = 0; j < 8; ++j) *(GAS unsigned*)(WF + (size_t)(which * 512 + g * 128 + d0 + dq * 8 + j) * DM + k) = cvtpk(o0[j], o1[j]); }
          __syncthreads(); } }
    { const int n = (TR_DENSE - gw + NGW - 1) / NGW; tr_span(F, ka, ws, 0, gw, NGW, n > 0 ? n : 0); }
    __syncthreads();
    for (int m = 2 * gw; m < NTOK; m += 2 * NGW) rms_rows2_to_bf16(x + (size_t)m * DM, x + (size_t)(m + 1) * DM, mix_norm, (bf16_t*)(ws + WS_HN) + (size_t)m * DM, (bf16_t*)(ws + WS_HN) + (size_t)(m + 1) * DM, p_lane);
    for (int m = gw; m < 2 * NB * MEML; m += NGW) { const int l = m / (NB * MEML), r = m % (NB * MEML);
        rms_row_to_bf16(mem + (size_t)r * DM, mem_norm + l * DM, (bf16_t*)(ws + WS_MEMNB) + (size_t)m * DM, p_lane); }
}

struct MapLin { const char* A; const char* B; size_t as, bs; __device__ __forceinline__ void operator()(pg8::Unit& u) const { u.a = A + (size_t)u.pm * as; u.b = B + (size_t)u.pn * bs; } };

struct EpiQKV {
    static constexpr bool PERM = true;
    bf16_t* Q; bf16_t* K; bf16_t* V; const float* qg; const float* kg; const float* RC; const float* RS;
    __device__ __forceinline__ void operator()(f32x4 (&acc)[2][2][4][2], const pg8::Unit& u, const pg8::EpiCtx& c) const { const int e_lane = lane_id(), e_fr = e_lane & 15, e_fq = e_lane >> 4;
        const int pn = u.pn, hc = c.wc * 32 + e_fq * 8, rl0 = c.wr * 64 + e_fr;
        if (pn >= 8) {
            bf16_t* base = V + (size_t)(u.pm * 256 + rl0) * KVW + (pn - 8) * 256 + hc;
#pragma unroll
            for (int ai = 0; ai < 2; ++ai)
#pragma unroll
                for (int m = 0; m < 4; ++m) { bf16_t* rowp = base + (size_t)(ai * 128 + m * 16) * KVW;
#pragma unroll
                    for (int bj = 0; bj < 2; ++bj) { const f32x4 v0 = acc[ai][bj][m][0], v1 = acc[ai][bj][m][1];
                        st16((rowp + bj * 128), (u32x4){cvtpk(v0.x, v0.y), cvtpk(v0.z, v0.w), cvtpk(v1.x, v1.y), cvtpk(v1.z, v1.w)}); } }
            return;
        }
        LAS float* part = (LAS float*)c.xl;
#pragma unroll
        for (int ai = 0; ai < 2; ++ai)
#pragma unroll
            for (int m = 0; m < 4; ++m)
#pragma unroll
                for (int bj = 0; bj < 2; ++bj) { const f32x4 v0 = acc[ai][bj][m][0], v1 = acc[ai][bj][m][1];
                    float s = (v0.x * v0.x + v0.y * v0.y) + (v0.z * v0.z + v0.w * v0.w) + (v1.x * v1.x + v1.y * v1.y) + (v1.z * v1.z + v1.w * v1.w);
                    s += __shfl_xor(s, 16); s += __shfl_xor(s, 32);
                    if (e_fq == 0) part[((ai * 128 + rl0 + m * 16) * 2 + bj) * 4 + c.wc] = s; }
        WG_BAR();
        const float* gain = pn < 6 ? qg : kg;
        const f32x4 g0 = *(const f32x4*)(gain + hc), g1 = *(const f32x4*)(gain + hc + 4);
        bf16_t* O = pn < 6 ? Q : K; const int ld = pn < 6 ? AW : KVW; const int colbase = (pn < 6 ? pn : pn - 6) * 256 + hc;
#pragma unroll
        for (int ai = 0; ai < 2; ++ai)
#pragma unroll
            for (int m = 0; m < 4; ++m) { const int rl = ai * 128 + rl0 + m * 16, row = u.pm * 256 + rl, sp = row & (SEQ - 1);
                const f32x4 cs = *(const f32x4*)(RC + sp * 64 + (hc >> 1)), sn = *(const f32x4*)(RS + sp * 64 + (hc >> 1));
#pragma unroll
                for (int bj = 0; bj < 2; ++bj) { const f32x4 p4 = *(const LAS f32x4*)(part + (rl * 2 + bj) * 4);
                    const float r = rsqrtf(((p4.x + p4.y) + (p4.z + p4.w)) * (1.0f / 128.0f) + EPS);
                    const f32x4 v0 = acc[ai][bj][m][0] * r * g0, v1 = acc[ai][bj][m][1] * r * g1;
                    u32x4 w; w.x = cvtpk(v0.x * cs.x - v0.y * sn.x, v0.x * sn.x + v0.y * cs.x); w.y = cvtpk(v0.z * cs.y - v0.w * sn.y, v0.z * sn.y + v0.w * cs.y);
                    w.z = cvtpk(v1.x * cs.z - v1.y * sn.z, v1.x * sn.z + v1.y * cs.z); w.w = cvtpk(v1.z * cs.w - v1.w * sn.w, v1.z * sn.w + v1.w * cs.w);
                    st16((O + (size_t)row * ld + colbase + bj * 128), w); } }
    }
};


template <class AddrF> struct EpiStore {
    static constexpr bool PERM = true; AddrF f;
    __device__ __forceinline__ void operator()(f32x4 (&acc)[2][2][4][2], const pg8::Unit& u, const pg8::EpiCtx& c) const { const int e_lane = lane_id(), e_fr = e_lane & 15, e_fq = e_lane >> 4;
        const int hc = c.wc * 32 + e_fq * 8, rl0 = c.wr * 64 + e_fr;
#pragma unroll
        for (int ai = 0; ai < 2; ++ai)
#pragma unroll
            for (int m = 0; m < 4; ++m)
#pragma unroll
                for (int bj = 0; bj < 2; ++bj) { const f32x4 v0 = acc[ai][bj][m][0], v1 = acc[ai][bj][m][1];
                    st16(f(u, ai * 128 + rl0 + m * 16, bj * 128 + hc), (u32x4){cvtpk(v0.x, v0.y), cvtpk(v0.z, v0.w), cvtpk(v1.x, v1.y), cvtpk(v1.z, v1.w)}); }
    }
};
struct AddrF1 { bf16_t* FPQ; __device__ __forceinline__ bf16_t* operator()(const pg8::Unit& u, int rl, int tc) const {
    const int r = u.pm * 256 + rl, which = r >> 9, n = r & 511, cidx = u.pn * 256 + tc, b = cidx >> 11, s = cidx & 2047; return FPQ + (((size_t)(b * 512 + n) * 2 + which) * 2048 + s); } };
struct AddrF2 { bf16_t* MIX; __device__ __forceinline__ bf16_t* operator()(const pg8::Unit& u, int rl, int tc) const {
    const int row = (u.pn >> 1) * 2048 + u.pm * 256 + rl, col = AW + (u.pn & 1) * 256 + tc; return MIX + (size_t)row * DM + col; } };

template <bool BF32> struct EpiResB {
    static constexpr bool PERM = true;
    const void* base; bf16_t* xo; float* ssp; const float* cscale; bf16_t* xg; const float* gv;
    __device__ __forceinline__ void operator()(f32x4 (&acc)[2][2][4][2], const pg8::Unit& u, const pg8::EpiCtx& c) const { const int e_lane = lane_id(), e_fr = e_lane & 15, e_fq = e_lane >> 4;
        const int hc = c.wc * 32 + e_fq * 8, rl0 = c.wr * 64 + e_fr;
        LAS float* part = (LAS float*)c.xl;
#pragma unroll
        for (int ai = 0; ai < 2; ++ai) {
            f32x4 bf0[4][2], bf1[4][2]; u32x4 bb[4][2];
#pragma unroll
            for (int m = 0; m < 4; ++m)
#pragma unroll
                for (int bj = 0; bj < 2; ++bj) { const size_t off = (size_t)(u.pm * 256 + ai * 128 + rl0 + m * 16) * DM + u.pn * 256 + bj * 128 + hc;
                    if (BF32) { bf0[m][bj] = *(const f32x4*)((const float*)base + off); bf1[m][bj] = *(const f32x4*)((const float*)base + off + 4); }
                    else bb[m][bj] = *(const u32x4*)((const bf16_t*)base + off); }
#pragma unroll
            for (int m = 0; m < 4; ++m) { const int rl = ai * 128 + rl0 + m * 16; float s = 0.f;
#pragma unroll
                for (int bj = 0; bj < 2; ++bj) { const int col = u.pn * 256 + bj * 128 + hc; const size_t off = (size_t)(u.pm * 256 + rl) * DM + col;
                    f32x4 v0 = acc[ai][bj][m][0], v1 = acc[ai][bj][m][1];
                    if (cscale) { v0 = v0 * *(const f32x4*)(cscale + col); v1 = v1 * *(const f32x4*)(cscale + col + 4); }
                    if (BF32) { v0 = v0 + bf0[m][bj]; v1 = v1 + bf1[m][bj]; }
                    else { const u32x4 b = bb[m][bj];
                        v0.x += __uint_as_float(b.x << 16); v0.y += __uint_as_float(b.x & 0xffff0000u); v0.z += __uint_as_float(b.y << 16); v0.w += __uint_as_float(b.y & 0xffff0000u);
                        v1.x += __uint_as_float(b.z << 16); v1.y += __uint_as_float(b.z & 0xffff0000u); v1.z += __uint_as_float(b.w << 16); v1.w += __uint_as_float(b.w & 0xffff0000u); }
                    st16((xo + off), (u32x4){cvtpk(v0.x, v0.y), cvtpk(v0.z, v0.w), cvtpk(v1.x, v1.y), cvtpk(v1.z, v1.w)});
                    if (xg) { const f32x4 g0 = *(const f32x4*)(gv + col), g1 = *(const f32x4*)(gv + col + 4);
                        st16((xg + off), (u32x4){cvtpk(v0.x * g0.x, v0.y * g0.y), cvtpk(v0.z * g0.z, v0.w * g0.w), cvtpk(v1.x * g1.x, v1.y * g1.y), cvtpk(v1.z * g1.z, v1.w * g1.w)}); }
                    if (ssp) s += ((v0.x * v0.x + v0.y * v0.y) + (v0.z * v0.z + v0.w * v0.w)) + ((v1.x * v1.x + v1.y * v1.y) + (v1.z * v1.z + v1.w * v1.w)); }
                if (ssp) { s += __shfl_xor(s, 16); s += __shfl_xor(s, 32); if (e_fq == 0) part[rl * 4 + c.wc] = s; } }
            asm volatile("" ::: "memory"); }
        if (ssp) { WG_BAR();
            if (e_lane < 32) { const int row = c.wid * 32 + e_lane; const f32x4 p4 = *(const LAS f32x4*)(part + row * 4);
                ssp[(size_t)(u.pm * 256 + row) * 8 + u.pn] = (p4.x + p4.y) + (p4.z + p4.w); }
            WG_BAR(); }
    }
};

namespace attn {
using s16x4 = __attribute__((ext_vector_type(4))) short;
using f32x16 = __attribute__((ext_vector_type(16))) float;
constexpr int D = 128, NW = 8, QBLK = 32, KVBLK = 64;
constexpr float SCALE = 0.088388347648318440f;
constexpr float THR = 8.f;
#ifndef ATT_SDEPTH
#define ATT_SDEPTH 1
#endif
constexpr int LDQ = AW, LDK = KVW, LDO = DM;
constexpr size_t SHM_V = KVBLK * D * 2, SHM_K = KVBLK * D * 2, SHM_ATTN = 2 * SHM_V + 2 * SHM_K + NW * 64 * 4;
#define KSWZ(row, colB) ((row) * 256 + ((colB) ^ (((row) & 7) << 4)))
#define SBAR() __builtin_amdgcn_sched_barrier(0)
__device__ __forceinline__ int crow(int r, int hi) { return (r & 3) + 8 * (r >> 2) + 4 * hi; }
__device__ __forceinline__ unsigned cvtpk_a(float lo, float hi) { unsigned r; asm volatile("v_cvt_pk_bf16_f32 %0, %1, %2" : "=v"(r) : "v"(lo), "v"(hi)); return r; }
__device__ __forceinline__ void partialSM(f32x16& p0, f32x16& p1, float& m_reg, float& mn, float& alpha) {
  constexpr float C = SCALE * 1.4426950408889634f;
  float pmax = p0[0]; for (int r = 1; r < 16; ++r) pmax = fmaxf(pmax, p0[r]); for (int r = 0; r < 16; ++r) pmax = fmaxf(pmax, p1[r]);
  { auto rr = __builtin_amdgcn_permlane32_swap(__float_as_uint(pmax), __float_as_uint(pmax), false, false);
    pmax = fmaxf(__uint_as_float(rr[0]), __uint_as_float(rr[1])); }
  if (__builtin_expect(__all(pmax - m_reg <= THR / SCALE), 1)) { mn = m_reg; alpha = 1.f; }
  else { mn = fmaxf(m_reg, pmax); alpha = __builtin_amdgcn_exp2f((m_reg - mn) * C); m_reg = mn; }
  float mnC = -mn * C;
  for (int r = 0; r < 16; ++r) p0[r] = fmaf(p0[r], C, mnC); for (int r = 0; r < 16; ++r) p1[r] = fmaf(p1[r], C, mnC);
  for (int r = 0; r < 16; ++r) p0[r] = __builtin_amdgcn_exp2f(p0[r]);
}
__device__ __forceinline__ void finishSM(f32x16& p0, f32x16& p1, float alpha, float& l_reg, bf16x8& pa0, bf16x8& pa1, bf16x8& pa2, bf16x8& pa3) {
  for (int r = 0; r < 16; ++r) p1[r] = __builtin_amdgcn_exp2f(p1[r]);
  float ps = 0; for (int r = 0; r < 16; ++r) ps += p0[r]; for (int r = 0; r < 16; ++r) ps += p1[r];
  { auto rr = __builtin_amdgcn_permlane32_swap(__float_as_uint(ps), __float_as_uint(ps), false, false);
    ps = __uint_as_float(rr[0]) + __uint_as_float(rr[1]); }
  l_reg = l_reg * alpha + ps;
#define PK4(P, BASE, OUT) do { unsigned a0 = cvtpk_a(P[BASE + 0], P[BASE + 1]), a1 = cvtpk_a(P[BASE + 2], P[BASE + 3]);   \
    unsigned b0 = cvtpk_a(P[BASE + 4], P[BASE + 5]), b1 = cvtpk_a(P[BASE + 6], P[BASE + 7]);                              \
    auto r0 = __builtin_amdgcn_permlane32_swap(a0, b0, false, false); auto r1 = __builtin_amdgcn_permlane32_swap(a1, b1, false, false); \
    u32x4 w = {r0[0], r1[0], r0[1], r1[1]}; OUT = *reinterpret_cast<bf16x8*>(&w); } while (0)
  PK4(p0, 0, pa0); PK4(p0, 8, pa1); PK4(p1, 0, pa2); PK4(p1, 8, pa3);
#undef PK4
}
__device__ __forceinline__ void qkt(f32x16& p0, f32x16& p1, const bf16_t* Ks, const bf16x8* qr, int r32, int hi) {
  p0 = f32x16{}; p1 = f32x16{};
  for (int d0 = 0; d0 < 8; ++d0) { int cb = (d0 * 16 + hi * 8) * 2;
    bf16x8 b0 = *reinterpret_cast<const bf16x8*>((const char*)Ks + KSWZ(r32, cb));
    bf16x8 b1 = *reinterpret_cast<const bf16x8*>((const char*)Ks + KSWZ(32 + r32, cb));
    p0 = __builtin_amdgcn_mfma_f32_32x32x16_bf16(b0, qr[d0], p0, 0, 0, 0);
    p1 = __builtin_amdgcn_mfma_f32_32x32x16_bf16(b1, qr[d0], p1, 0, 0, 0); }
}
__device__ __forceinline__ int v_st(int k, int c) { const int kk = (k & ~0xC) | ((k & 4) << 1) | ((k & 8) >> 1); return ((kk >> 3) * 4 + (c >> 5)) * 512 + ((kk & 7) * 32 + (c & 31)) * 2; }
__device__ __forceinline__ int v_rd_base(int lane) { return ((lane & 3) << 3) | (((lane >> 2) & 3) << 6) | (((lane >> 4) & 1) << 5) | (((lane >> 5) & 1) << 8); }
constexpr int v_rd_off(int d0, int ks, int half) { return d0 * 512 + ks * 4096 + half * 2048; }
template <int OFF> __device__ __forceinline__ s16x4 tr_read(int vb) {
  s16x4 r; asm volatile("ds_read_b64_tr_b16 %0, %1 offset:%2" : "=&v"(r) : "v"(vb), "i"(OFF) : "memory"); return r;
}
template <int D0> __device__ __forceinline__ void pv_one(f32x16& od, int vb, bf16x8 pa0, bf16x8 pa1, bf16x8 pa2, bf16x8 pa3) {
  const s16x4 l0 = tr_read<v_rd_off(D0, 0, 0)>(vb), h0 = tr_read<v_rd_off(D0, 0, 1)>(vb), l1 = tr_read<v_rd_off(D0, 1, 0)>(vb), h1 = tr_read<v_rd_off(D0, 1, 1)>(vb);
  const s16x4 l2 = tr_read<v_rd_off(D0, 2, 0)>(vb), h2 = tr_read<v_rd_off(D0, 2, 1)>(vb), l3 = tr_read<v_rd_off(D0, 3, 0)>(vb), h3 = tr_read<v_rd_off(D0, 3, 1)>(vb);
  asm volatile("s_waitcnt lgkmcnt(0)" ::: "memory"); SBAR();
#define PK(L, H) (bf16x8){L[0], L[1], L[2], L[3], H[0], H[1], H[2], H[3]}
  od = __builtin_amdgcn_mfma_f32_32x32x16_bf16(pa0, PK(l0, h0), od, 0, 0, 0);
  od = __builtin_amdgcn_mfma_f32_32x32x16_bf16(pa1, PK(l1, h1), od, 0, 0, 0);
  od = __builtin_amdgcn_mfma_f32_32x32x16_bf16(pa2, PK(l2, h2), od, 0, 0, 0);
  od = __builtin_amdgcn_mfma_f32_32x32x16_bf16(pa3, PK(l3, h3), od, 0, 0, 0);
#undef PK
}
__device__ __forceinline__ void pv_d0(f32x16* o, int vb, bf16x8 pa0, bf16x8 pa1, bf16x8 pa2, bf16x8 pa3) {
  pv_one<0>(o[0], vb, pa0, pa1, pa2, pa3); pv_one<1>(o[1], vb, pa0, pa1, pa2, pa3); pv_one<2>(o[2], vb, pa0, pa1, pa2, pa3); pv_one<3>(o[3], vb, pa0, pa1, pa2, pa3);
}
__device__ __forceinline__ void attn_dense_body(const bf16_t* __restrict__ Qb, const bf16_t* __restrict__ Kh, const bf16_t* __restrict__ Vh,
                                                bf16_t* __restrict__ Ob, int seq, char* lds, const int wave_) {
  constexpr int SDEPTH = ATT_SDEPTH;
  const int lane = lane_id(), wid = wave_, tid = wid * 64 + lane, r32 = lane & 31, hi = lane >> 5;
  bf16_t* V_lds = (bf16_t*)lds; bf16_t* K_lds = (bf16_t*)(lds + 2 * SHM_V);
  float* ws = (float*)(lds + 2 * SHM_V + 2 * SHM_K) + wid * 64; float* li_l = ws; float* al_l = ws + 32;
  float m_reg = -1e30f, l_reg = 0; f32x16 o[4] = {}; bf16x8 qr[8];
  const bf16_t* Qw = Qb + (long)(wid * QBLK + r32) * LDQ + hi * 8;
#pragma unroll
  for (int d0 = 0; d0 < 8; ++d0) qr[d0] = *reinterpret_cast<const bf16x8*>(Qw + d0 * 16);
  const int sr = tid >> 4, sc = (tid & 15) * 8, vst0 = v_st(sr, sc), vst1 = v_st(32 + sr, sc);
  const int vb0 = (int)(uintptr_t)V_lds + v_rd_base(lane);
  struct { bf16x8 vs0, vs1, ks0, ks1; } sr_[SDEPTH];
#define SLOAD(i, k0) do { sr_[i].vs0 = *reinterpret_cast<const bf16x8*>(&Vh[(long)((k0) + sr) * LDK + sc]); sr_[i].vs1 = *reinterpret_cast<const bf16x8*>(&Vh[(long)((k0) + 32 + sr) * LDK + sc]); \
    sr_[i].ks0 = *reinterpret_cast<const bf16x8*>(&Kh[(long)((k0) + sr) * LDK + sc]); sr_[i].ks1 = *reinterpret_cast<const bf16x8*>(&Kh[(long)((k0) + 32 + sr) * LDK + sc]); } while (0)
#define SWRITE(b, i) do { *(bf16x8*)((char*)V_lds + (b) * SHM_V + vst0) = sr_[i].vs0;          \
    *(bf16x8*)((char*)V_lds + (b) * SHM_V + vst1) = sr_[i].vs1; int kc = sc * 2;               \
    *(bf16x8*)((char*)K_lds + (b) * SHM_K + KSWZ(sr, kc)) = sr_[i].ks0;                       \
    *(bf16x8*)((char*)K_lds + (b) * SHM_K + KSWZ(32 + sr, kc)) = sr_[i].ks1; } while (0)
#define SWAIT() do { if constexpr (SDEPTH == 2) asm volatile("s_waitcnt vmcnt(4)" ::: "memory"); else asm volatile("s_waitcnt vmcnt(0)" ::: "memory"); } while (0)
#define RESC(a) do { if (__any((a) < 1.f)) { if (hi == 0) al_l[r32] = (a); asm volatile("s_waitcnt lgkmcnt(0)" ::: "memory"); \
    for (int d = 0; d < 4; ++d) for (int r = 0; r < 16; ++r) o[d][r] *= al_l[crow(r, hi)]; } } while (0)
  f32x16 pA0, pA1, pB0, pB1; float mnA, mnB, alA, alB; bf16x8 pa0, pa1, pa2, pa3; const int NT = seq / KVBLK;
  constexpr int SE = 0, SO = SDEPTH - 1;
  SLOAD(SE, 0); asm volatile("s_waitcnt vmcnt(0)" ::: "memory"); SWRITE(0, SE); __syncthreads();
  qkt(pA0, pA1, K_lds, qr, r32, hi); partialSM(pA0, pA1, m_reg, mnA, alA);
  SLOAD(SO, KVBLK); if constexpr (SDEPTH == 2) { if (2 < NT) SLOAD(SE, 2 * KVBLK); }
  SWAIT(); SWRITE(1, SO); __syncthreads();
  for (int j = 1; j + 1 < NT; j += 2) {
    SBAR(); qkt(pB0, pB1, (bf16_t*)((char*)K_lds + SHM_K), qr, r32, hi);
    finishSM(pA0, pA1, alA, l_reg, pa0, pa1, pa2, pa3); SBAR();
    SLOAD(SO, (j + SDEPTH) * KVBLK); SBAR();
    pv_d0(o, vb0, pa0, pa1, pa2, pa3); partialSM(pB0, pB1, m_reg, mnB, alB);
    __syncthreads(); SWAIT(); SWRITE(0, SE);
    RESC(alB); __syncthreads();
    SBAR(); qkt(pA0, pA1, K_lds, qr, r32, hi);
    finishSM(pB0, pB1, alB, l_reg, pa0, pa1, pa2, pa3); SBAR();
    if (SDEPTH == 1 || j + 3 < NT) SLOAD(SE, (j + 1 + SDEPTH) * KVBLK); SBAR();
    pv_d0(o, vb0 + (int)SHM_V, pa0, pa1, pa2, pa3); partialSM(pA0, pA1, m_reg, mnA, alA);
    __syncthreads(); SWAIT(); SWRITE(1, SO);
    RESC(alA); __syncthreads();
  }
  SBAR(); qkt(pB0, pB1, (bf16_t*)((char*)K_lds + SHM_K), qr, r32, hi);
  finishSM(pA0, pA1, alA, l_reg, pa0, pa1, pa2, pa3); SBAR();
  pv_d0(o, vb0, pa0, pa1, pa2, pa3); partialSM(pB0, pB1, m_reg, mnB, alB);
  __syncthreads(); RESC(alB);
  finishSM(pB0, pB1, alB, l_reg, pa0, pa1, pa2, pa3); SBAR();
  pv_d0(o, vb0 + (int)SHM_V, pa0, pa1, pa2, pa3);
  if (hi == 0) li_l[r32] = l_reg; asm volatile("s_waitcnt lgkmcnt(0)" ::: "memory");
  float rli[16];
#pragma unroll
  for (int r = 0; r < 16; ++r) rli[r] = __builtin_amdgcn_rcpf(li_l[crow(r, hi)]);
  bf16_t* Ow = Ob + (long)(wid * QBLK) * LDO;
  char* stg = (char*)K_lds + wid * 4096;
#pragma unroll
  for (int p = 0; p < 2; ++p) {
#pragma unroll
    for (int rr = 0; rr < 8; ++rr) { const int r = 8 * p + rr, row16 = (r & 3) + 8 * ((r >> 2) & 1) + 4 * hi;
#pragma unroll
      for (int d0 = 0; d0 < 4; ++d0) *(bf16_t*)(stg + row16 * 256 + (d0 * 32 + r32) * 2) = (bf16_t)(cvtpk(o[d0][r] * rli[r], 0.f) & 0xffffu); }
    asm volatile("s_waitcnt lgkmcnt(0)" ::: "memory");
#pragma unroll
    for (int i = 0; i < 4; ++i) { const int idx = lane + 64 * i, row = idx >> 4, ch = idx & 15; const u32x4 v = *(const u32x4*)(stg + row * 256 + ch * 16);
      *(u32x4*)(Ow + (long)(16 * p + row) * LDO + ch * 8) = v; }
    asm volatile("s_waitcnt lgkmcnt(0)" ::: "memory");
  }
#undef SLOAD
#undef SWRITE
#undef SWAIT
#undef RESC
  __syncthreads();
}
#undef KSWZ
#undef SBAR
}

struct AddrLin { bf16_t* O; int ld; __device__ __forceinline__ bf16_t* operator()(const pg8::Unit& u, int rl, int tc) const { return O + (size_t)(u.pm * 256 + rl) * ld + u.pn * 256 + tc; } };
struct EpiRowScale {
    static constexpr bool PERM = true; bf16_t* O; int ld; const float* ssp; float cscale;
    __device__ __forceinline__ void operator()(f32x4 (&acc)[2][2][4][2], const pg8::Unit& u, const pg8::EpiCtx& c) const { const int e_lane = lane_id(), e_fr = e_lane & 15, e_fq = e_lane >> 4;
        const int hc = c.wc * 32 + e_fq * 8, rl0 = c.wr * 64 + e_fr;
#pragma unroll
        for (int ai = 0; ai < 2; ++ai)
#pragma unroll
            for (int m = 0; m < 4; ++m) { const int row = u.pm * 256 + ai * 128 + rl0 + m * 16; const f32x4 p0 = *(const f32x4*)(ssp + (size_t)row * 8), p1 = *(const f32x4*)(ssp + (size_t)row * 8 + 4);
                const float r = rsqrtf((((p0.x + p0.y) + (p0.z + p0.w)) + ((p1.x + p1.y) + (p1.z + p1.w))) * (1.0f / DM) + EPS) * cscale;
#pragma unroll
                for (int bj = 0; bj < 2; ++bj) { const f32x4 v0 = acc[ai][bj][m][0] * r, v1 = acc[ai][bj][m][1] * r;
                    st16((O + (size_t)row * ld + u.pn * 256 + bj * 128 + hc), (u32x4){cvtpk(v0.x, v0.y), cvtpk(v0.z, v0.w), cvtpk(v1.x, v1.y), cvtpk(v1.z, v1.w)}); } }
    }
};
struct EpiSoftmax {
    static constexpr bool PERM = true; bf16_t* P; int ld;
    __device__ __forceinline__ void operator()(f32x4 (&acc)[2][2][4][2], const pg8::Unit& u, const pg8::EpiCtx& c) const { const int e_lane = lane_id(), e_fr = e_lane & 15, e_fq = e_lane >> 4;
        const int hc = c.wc * 32 + e_fq * 8, rl0 = c.wr * 64 + e_fr;
        LAS float* pmx = (LAS float*)c.xl; LAS float* psm = pmx + 1024;
#pragma unroll
        for (int ai = 0; ai < 2; ++ai)
#pragma unroll
            for (int m = 0; m < 4; ++m) { float mx = -3.0e38f;
#pragma unroll
                for (int bj = 0; bj < 2; ++bj)
#pragma unroll
                    for (int n = 0; n < 2; ++n) { const f32x4 v = acc[ai][bj][m][n]; mx = fmaxf(fmaxf(mx, fmaxf(v.x, v.y)), fmaxf(v.z, v.w)); }
                mx = fmaxf(mx, __shfl_xor(mx, 16)); mx = fmaxf(mx, __shfl_xor(mx, 32));
                if (e_fq == 0) pmx[(ai * 128 + rl0 + m * 16) * 4 + c.wc] = mx; }
        WG_BAR();
#pragma unroll
        for (int ai = 0; ai < 2; ++ai)
#pragma unroll
            for (int m = 0; m < 4; ++m) { const int rl = ai * 128 + rl0 + m * 16; const f32x4 p4 = *(const LAS f32x4*)(pmx + rl * 4);
                const float mx = fmaxf(fmaxf(p4.x, p4.y), fmaxf(p4.z, p4.w)) * 1.4426950408889634f; float s = 0.f;
#pragma unroll
                for (int bj = 0; bj < 2; ++bj)
#pragma unroll
                    for (int n = 0; n < 2; ++n) { f32x4 v = acc[ai][bj][m][n];
                        v.x = __builtin_amdgcn_exp2f(fmaf(v.x, 1.4426950408889634f, -mx)); v.y = __builtin_amdgcn_exp2f(fmaf(v.y, 1.4426950408889634f, -mx));
                        v.z = __builtin_amdgcn_exp2f(fmaf(v.z, 1.4426950408889634f, -mx)); v.w = __builtin_amdgcn_exp2f(fmaf(v.w, 1.4426950408889634f, -mx));
                        s += (v.x + v.y) + (v.z + v.w); acc[ai][bj][m][n] = v; }
                s += __shfl_xor(s, 16); s += __shfl_xor(s, 32);
                if (e_fq == 0) psm[rl * 4 + c.wc] = s; }
        WG_BAR();
#pragma unroll
        for (int ai = 0; ai < 2; ++ai)
#pragma unroll
            for (int m = 0; m < 4; ++m) { const int rl = ai * 128 + rl0 + m * 16; const f32x4 p4 = *(const LAS f32x4*)(psm + rl * 4);
                const float inv = 1.0f / ((p4.x + p4.y) + (p4.z + p4.w));
#pragma unroll
                for (int bj = 0; bj < 2; ++bj) { const f32x4 v0 = acc[ai][bj][m][0] * inv, v1 = acc[ai][bj][m][1] * inv;
                    st16((P + (size_t)(u.pm * 256 + rl) * ld + u.pn * 256 + bj * 128 + hc), (u32x4){cvtpk(v0.x, v0.y), cvtpk(v0.z, v0.w), cvtpk(v1.x, v1.y), cvtpk(v1.z, v1.w)}); } }
        WG_BAR();
    }
};
struct MapXS { const char* Q; const char* K; __device__ __forceinline__ void operator()(pg8::Unit& u) const {
    u.a = Q + ((size_t)u.pm * 256 * DM + (size_t)u.pn * MHD) * 2; u.b = K + ((size_t)(u.pm >> 3) * MEML * DM + (size_t)u.pn * MHD) * 2; } };
struct SchedPair { pg8::Unit ua, ub; __device__ __forceinline__ bool next(int i, pg8::Unit& o) const { if (i >= 2) return false; o.pm = i ? ub.pm : ua.pm; o.pn = i ? ub.pn : ua.pn; o.a = i ? ub.a : ua.a; o.b = i ? ub.b : ua.b; asm volatile("" : "+s"(o.a), "+s"(o.b));     return true; } };
struct MapXPV { const char* P; const char* VT; __device__ __forceinline__ void operator()(pg8::Unit& u) const {
    u.a = P + ((size_t)u.pm * 256 * 1024 + (size_t)(u.pn >> 1) * MEML) * 2; u.b = VT + ((size_t)u.pn * 256 * 1024 + (size_t)(u.pm >> 3) * MEML) * 2; } };

struct MapMoE { const char* A; const char* W; size_t as, es, ws_; __device__ __forceinline__ void operator()(pg8::Unit& u) const {
    u.a = A + (size_t)u.pm * as; u.b = W + (size_t)(u.pm >> 2) * es + (size_t)u.pn * ws_; } };
struct EpiSwiGLU {
    static constexpr bool PERM = true; bf16_t* ACT; const float* rs;
    __device__ __forceinline__ void operator()(f32x4 (&acc)[2][2][4][2], const pg8::Unit& u, const pg8::EpiCtx& c) const { const int e_lane = lane_id(), e_fr = e_lane & 15, e_fq = e_lane >> 4;
        const int hc = c.wc * 32 + e_fq * 8, rl0 = c.wr * 64 + e_fr;
#pragma unroll
        for (int ai = 0; ai < 2; ++ai)
#pragma unroll
            for (int m = 0; m < 4; ++m) { f32x4 o[2]; const float rf = rs[u.pm * 256 + ai * 128 + rl0 + m * 16];
#pragma unroll
                for (int n = 0; n < 2; ++n) { const f32x4 g = acc[ai][0][m][n] * rf, up = acc[ai][1][m][n] * rf; f32x4 r;
                    r.x = g.x * __builtin_amdgcn_rcpf(1.0f + __builtin_amdgcn_exp2f(-1.4426950408889634f * g.x)) * up.x; r.y = g.y * __builtin_amdgcn_rcpf(1.0f + __builtin_amdgcn_exp2f(-1.4426950408889634f * g.y)) * up.y;
                    r.z = g.z * __builtin_amdgcn_rcpf(1.0f + __builtin_amdgcn_exp2f(-1.4426950408889634f * g.z)) * up.z; r.w = g.w * __builtin_amdgcn_rcpf(1.0f + __builtin_amdgcn_exp2f(-1.4426950408889634f * g.w)) * up.w; o[n] = r; }
                st16((ACT + (size_t)(u.pm * 256 + ai * 128 + rl0 + m * 16) * EFF + u.pn * 128 + hc), (u32x4){cvtpk(o[0].x, o[0].y), cvtpk(o[0].z, o[0].w), cvtpk(o[1].x, o[1].y), cvtpk(o[1].z, o[1].w)}); }
    }
};
struct EpiRowGate {
    static constexpr bool PERM = true; bf16_t* Y; const float* gate;
    __device__ __forceinline__ void operator()(f32x4 (&acc)[2][2][4][2], const pg8::Unit& u, const pg8::EpiCtx& c) const { const int e_lane = lane_id(), e_fr = e_lane & 15, e_fq = e_lane >> 4;
        const int hc = c.wc * 32 + e_fq * 8, rl0 = c.wr * 64 + e_fr;
#pragma unroll
        for (int ai = 0; ai < 2; ++ai)
#pragma unroll
            for (int m = 0; m < 4; ++m) { const int row = u.pm * 256 + ai * 128 + rl0 + m * 16; const float gt = gate[row];
#pragma unroll
                for (int bj = 0; bj < 2; ++bj) { const f32x4 v0 = acc[ai][bj][m][0] * gt, v1 = acc[ai][bj][m][1] * gt;
                    st16((Y + (size_t)row * DM + u.pn * 256 + bj * 128 + hc), (u32x4){cvtpk(v0.x, v0.y), cvtpk(v0.z, v0.w), cvtpk(v1.x, v1.y), cvtpk(v1.z, v1.w)}); } }
    }
};
__device__ __forceinline__ float rms_row_to_bf16_r(const float* xrow, const float* __restrict__ gain, bf16_t* orow, int lane) {
    const GAS f32x4* xr = (const GAS f32x4*)xrow + lane; const f32x4* gr = (const f32x4*)gain + lane;
    f32x4 v[8]; float s = 0.f;
#pragma unroll
    for (int j = 0; j < 8; ++j) { v[j] = xr[64 * j]; s += (v[j].x * v[j].x + v[j].y * v[j].y) + (v[j].z * v[j].z + v[j].w * v[j].w); }
    const float r = rsqrtf(wave_sum(s) * (1.f / DM) + EPS);
    GAS u32x2* o8 = (GAS u32x2*)orow + lane;
#pragma unroll
    for (int j = 0; j < 8; ++j) { const f32x4 g = gr[64 * j]; u32x2 w; w.x = cvtpk(v[j].x * r * g.x, v[j].y * r * g.y); w.y = cvtpk(v[j].z * r * g.z, v[j].w * r * g.w); o8[64 * j] = w; }
    return r;
}
__device__ __forceinline__ void router_phase(const Frame& F, const bf16_t* x, const u32x4* RBl, float* rrow, float* aff, LAS unsigned char* xl) {
    const int lane = lane_id(), tid = F.wave * 64 + lane;
    LAS u32x4* Bl = (LAS u32x4*)(F.lds + RING_OFF);
    for (int i = tid; i < 2 * 4096; i += 512) Bl[i] = RBl[i];
    __syncthreads();
    LAS float* red = (LAS float*)xl;
    LAS float* ssq = (LAS float*)(xl + 8192);
    const int rg = F.wave >> 2, kq = F.wave & 3, r16 = lane & 15, kg = lane >> 4;
    for (int rb = (int)blockIdx.x * 32; rb < NTOK; rb += F.G * 32) {
        const bf16_t* xr = x + (size_t)(rb + rg * 16 + r16) * DM + kq * 512 + kg * 8;
        bf16x8 a[16];
#pragma unroll
        for (int s = 0; s < 16; ++s) a[s] = *(const GAS bf16x8*)(xr + 32 * s);
        f32x4 acc = {0.f, 0.f, 0.f, 0.f}; float sq = 0.f;
#pragma unroll
        for (int s = 0; s < 16; ++s) { const int ks = kq * 16 + s;
            const bf16x8 bh = __builtin_bit_cast(bf16x8, Bl[ks * 64 + lane]), bl = __builtin_bit_cast(bf16x8, Bl[4096 + ks * 64 + lane]);
            acc = __builtin_amdgcn_mfma_f32_16x16x32_bf16(a[s], bh, acc, 0, 0, 0);
            acc = __builtin_amdgcn_mfma_f32_16x16x32_bf16(a[s], bl, acc, 0, 0, 0);
            const u32x4 av = __builtin_bit_cast(u32x4, a[s]);
            const float f0 = __uint_as_float(av.x << 16), f1 = __uint_as_float(av.x & 0xffff0000u), f2 = __uint_as_float(av.y << 16), f3 = __uint_as_float(av.y & 0xffff0000u);
            const float f4 = __uint_as_float(av.z << 16), f5 = __uint_as_float(av.z & 0xffff0000u), f6 = __uint_as_float(av.w << 16), f7 = __uint_as_float(av.w & 0xffff0000u);
            sq += ((f0 * f0 + f1 * f1) + (f2 * f2 + f3 * f3)) + ((f4 * f4 + f5 * f5) + (f6 * f6 + f7 * f7)); }
        sq += __shfl_xor(sq, 16); sq += __shfl_xor(sq, 32);
        *(LAS f32x4*)(red + ((rg * 4 + kq) * 64 + lane) * 4) = acc;
        if (kg == 0) ssq[(rg * 4 + kq) * 16 + r16] = sq;
        __syncthreads();
        if (kq == 0) {
            f32x4 t = *(const LAS f32x4*)(red + ((rg * 4 + 0) * 64 + lane) * 4);
#pragma unroll
            for (int q = 1; q < 4; ++q) t = t + *(const LAS f32x4*)(red + ((rg * 4 + q) * 64 + lane) * 4);
            const float lg[4] = {t.x, t.y, t.z, t.w};
#pragma unroll
            for (int i = 0; i < 4; ++i) { const int rr = 4 * kg + i; const float ss = (ssq[(rg * 4 + 0) * 16 + rr] + ssq[(rg * 4 + 1) * 16 + rr]) + (ssq[(rg * 4 + 2) * 16 + rr] + ssq[(rg * 4 + 3) * 16 + rr]);
                const float r = rsqrtf(ss * (1.f / DM) + EPS); const int row = rb + rg * 16 + rr;
                const float v = lg[i] * r; float mx = v;
                mx = fmaxf(mx, __shfl_xor(mx, 8)); mx = fmaxf(mx, __shfl_xor(mx, 4)); mx = fmaxf(mx, __shfl_xor(mx, 2)); mx = fmaxf(mx, __shfl_xor(mx, 1));
                const float ex = expf(v - mx); float sm = ex;
                sm += __shfl_xor(sm, 8); sm += __shfl_xor(sm, 4); sm += __shfl_xor(sm, 2); sm += __shfl_xor(sm, 1);
                const int b = row / SEQ, tt = row % SEQ; aff[((size_t)b * NE + r16) * SEQ + tt] = ex / sm;
                if (r16 == 0) rrow[row] = r; }
        }
        __syncthreads();
    }
}
__device__ __forceinline__ void rank_phase(const Frame& F, const float* aff, int* rank, float* gate, const float* rrow, float* rs, int* gidx) {
    const int lane = lane_id(), tid = F.wave * 64 + lane;
    LAS unsigned* wc = (LAS unsigned*)(F.lds + RING_OFF);
    LAS unsigned* ck = (LAS unsigned*)(F.lds + RING_OFF + 256);
    LAS unsigned* ci = ck + SEQ + 4;
    LAS unsigned* ncp = ci + SEQ + 4;
    for (int be = (int)blockIdx.x; be < NB * NE; be += F.G) {
        const int b = be >> 4, e = be & 15;
        unsigned k[4];
#pragma unroll
        for (int j = 0; j < 4; ++j) k[j] = __float_as_uint(aff[(size_t)be * SEQ + tid + 512 * j]);
        unsigned lo = 0u, hi = 0x3F800001u;
        if (tid == 0) ncp[0] = 0u;
        for (int it = 0; it < 40; ++it) {
            const unsigned mid = lo + ((hi - lo) >> 1); if (mid == lo) break;
            const int ws_ = __popcll(__ballot(k[0] >= mid)) + __popcll(__ballot(k[1] >= mid)) + __popcll(__ballot(k[2] >= mid)) + __popcll(__ballot(k[3] >= mid));
            if (lane == 0) wc[(it & 1) * 8 + F.wave] = (unsigned)ws_;
            __syncthreads();
            const u32x4 c0 = *(const LAS u32x4*)(wc + (it & 1) * 8), c1 = *(const LAS u32x4*)(wc + (it & 1) * 8 + 4);
            const int c = (int)(((c0.x + c0.y) + (c0.z + c0.w)) + ((c1.x + c1.y) + (c1.z + c1.w)));
            if (c < CAP) hi = mid; else { lo = mid; if (c <= 448) break; }
        }
        const unsigned T = lo;
        __syncthreads();
#pragma unroll
        for (int j = 0; j < 4; ++j) { const bool pred = k[j] >= T; const unsigned long long bal = __ballot(pred);
            const int wcount = __popcll(bal), pre = __popcll(bal & ((1ull << lane) - 1ull));
            unsigned base = 0u; if (lane == 0 && wcount) base = __hip_atomic_fetch_add(ncp, (unsigned)wcount, __ATOMIC_RELAXED, __HIP_MEMORY_SCOPE_WORKGROUP);
            base = (unsigned)__builtin_amdgcn_readfirstlane((int)base);
            if (pred) { ck[base + pre] = k[j]; ci[base + pre] = (unsigned)(tid + 512 * j); } else rank[(size_t)be * SEQ + tid + 512 * j] = CAP; }
        __syncthreads();
        const int nc = (int)ncp[0];
        if (tid < 4) { ck[nc + tid] = 0u; ci[nc + tid] = 0x7fffffffu; }
        __syncthreads();
        const int nc4 = (nc + 3) >> 2;
        for (int i = tid; i < nc; i += 512) { const unsigned kk = ck[i]; const int tt = (int)ci[i]; int cnt = 0;
#pragma unroll 4
            for (int m = 0; m < nc4; ++m) { const u32x4 km = ((const LAS u32x4*)ck)[m]; const u32x4 tm = ((const LAS u32x4*)ci)[m];
                cnt += ((km.x > kk || (km.x == kk && (int)tm.x < tt)) ? 1 : 0) + ((km.y > kk || (km.y == kk && (int)tm.y < tt)) ? 1 : 0)
                     + ((km.z > kk || (km.z == kk && (int)tm.z < tt)) ? 1 : 0) + ((km.w > kk || (km.w == kk && (int)tm.w < tt)) ? 1 : 0); }
            const int r = cnt < CAP ? cnt : CAP; rank[(size_t)be * SEQ + tt] = r;
            if (r < CAP) { const int sl = (e * 4 + b) * CAP + r; gate[sl] = __uint_as_float(kk); gidx[sl] = b * SEQ + tt; rs[sl] = rrow[b * SEQ + tt]; } }
        __syncthreads();
    }
}
__device__ __forceinline__ void combine_phase(const Frame& F, const bf16_t* xin, bf16_t* xo, float* fout, const bf16_t* Y, const int* rank, const float* __restrict__ gain, bf16_t* HNo, bool final_) {
    const int lane = lane_id();
    const int gw = (int)blockIdx.x * NWAVES + F.wave, NGW = F.G * NWAVES;
    for (int row = gw; row < NTOK; row += NGW) {
        const int b = row / SEQ, t = row % SEQ;
        int rk = CAP; if (lane < NE) rk = rank[((size_t)b * NE + lane) * SEQ + t];
        const GAS u32x4* xi = (const GAS u32x4*)(xin + (size_t)row * DM) + lane; float v[4][8];
#pragma unroll
        for (int j = 0; j < 4; ++j) { const u32x4 p = xi[64 * j];
            v[j][0] = __uint_as_float(p.x << 16); v[j][1] = __uint_as_float(p.x & 0xffff0000u); v[j][2] = __uint_as_float(p.y << 16); v[j][3] = __uint_as_float(p.y & 0xffff0000u);
            v[j][4] = __uint_as_float(p.z << 16); v[j][5] = __uint_as_float(p.z & 0xffff0000u); v[j][6] = __uint_as_float(p.w << 16); v[j][7] = __uint_as_float(p.w & 0xffff0000u); }
#pragma unroll
        for (int e = 0; e < NE; ++e) { const int r = __builtin_amdgcn_readlane(rk, e);
            if (r < CAP) { const u32x4* yr = (const u32x4*)(Y + ((size_t)(e * 4 + b) * CAP + r) * DM) + lane;
#pragma unroll
                for (int j = 0; j < 4; ++j) { const u32x4 w = yr[64 * j];
                    v[j][0] += __uint_as_float(w.x << 16); v[j][1] += __uint_as_float(w.x & 0xffff0000u); v[j][2] += __uint_as_float(w.y << 16); v[j][3] += __uint_as_float(w.y & 0xffff0000u);
                    v[j][4] += __uint_as_float(w.z << 16); v[j][5] += __uint_as_float(w.z & 0xffff0000u); v[j][6] += __uint_as_float(w.w << 16); v[j][7] += __uint_as_float(w.w & 0xffff0000u); } } }
        float s = 0.f;
#pragma unroll
        for (int j = 0; j < 4; ++j)
#pragma unroll
            for (int i = 0; i < 8; ++i) s += v[j][i] * v[j][i];
        const float r = rsqrtf(wave_sum(s) * (1.f / DM) + EPS);
        if (final_) { GAS f32x4* fo = (GAS f32x4*)(fout + (size_t)row * DM);
#pragma unroll
            for (int j = 0; j < 4; ++j) { const int c0 = 8 * (lane + 64 * j); const f32x4 g0 = *(const f32x4*)(gain + c0), g1 = *(const f32x4*)(gain + c0 + 4);
                fo[(c0 >> 2)] = (f32x4){v[j][0] * r * g0.x, v[j][1] * r * g0.y, v[j][2] * r * g0.z, v[j][3] * r * g0.w};
                fo[(c0 >> 2) + 1] = (f32x4){v[j][4] * r * g1.x, v[j][5] * r * g1.y, v[j][6] * r * g1.z, v[j][7] * r * g1.w}; }
        } else { GAS u32x4* o8 = (GAS u32x4*)(HNo + (size_t)row * DM) + lane; GAS u32x4* x8 = (GAS u32x4*)(xo + (size_t)row * DM) + lane;
#pragma unroll
            for (int j = 0; j < 4; ++j) { const int c0 = 8 * (lane + 64 * j); const f32x4 g0 = *(const f32x4*)(gain + c0), g1 = *(const f32x4*)(gain + c0 + 4);
                x8[64 * j] = (u32x4){cvtpk(v[j][0], v[j][1]), cvtpk(v[j][2], v[j][3]), cvtpk(v[j][4], v[j][5]), cvtpk(v[j][6], v[j][7])};
                o8[64 * j] = (u32x4){cvtpk(v[j][0] * r * g0.x, v[j][1] * r * g0.y), cvtpk(v[j][2] * r * g0.z, v[j][3] * r * g0.w), cvtpk(v[j][4] * r * g1.x, v[j][5] * r * g1.y), cvtpk(v[j][6] * r * g1.z, v[j][7] * r * g1.w)}; } }
    }
}
struct MapPool { const char* A; const char* W; __device__ __forceinline__ void operator()(pg8::Unit& u) const {
    u.a = A + ((size_t)u.pm * 256 * DM + (size_t)(u.pn >> 1) * 512) * 2; u.b = W + ((size_t)(u.pn & 1) * 256 * DM + (size_t)(u.pn >> 1) * 512) * 2; } };
template <int W> __device__ __forceinline__ void pool_item4(const bf16_t* H, bf16_t* P, int row0, int c8) {
    const int t0 = row0 & (SEQ - 1); const bf16_t* base = H + (size_t)(row0 - t0) * DM + c8 * 8;
    u32x4 v[W + 3];
#pragma unroll
    for (int i = 0; i < W + 3; ++i) { int j = t0 - W / 2 + i; j = j < 0 ? 0 : (j > SEQ - 1 ? SEQ - 1 : j); v[i] = *(const u32x4*)(base + (size_t)j * DM); }
    float f[W + 3][8];
#pragma unroll
    for (int i = 0; i < W + 3; ++i) { const int j = t0 - W / 2 + i; const float m = (j >= 0 && j < SEQ) ? 1.f : 0.f;
        f[i][0] = m * __uint_as_float(v[i].x << 16); f[i][1] = m * __uint_as_float(v[i].x & 0xffff0000u); f[i][2] = m * __uint_as_float(v[i].y << 16); f[i][3] = m * __uint_as_float(v[i].y & 0xffff0000u);
        f[i][4] = m * __uint_as_float(v[i].z << 16); f[i][5] = m * __uint_as_float(v[i].z & 0xffff0000u); f[i][6] = m * __uint_as_float(v[i].w << 16); f[i][7] = m * __uint_as_float(v[i].w & 0xffff0000u); }
    float s[8];
#pragma unroll
    for (int c = 0; c < 8; ++c) { s[c] = 0.f;
#pragma unroll
        for (int i = 0; i < W; ++i) s[c] += f[i][c]; }
#pragma unroll
    for (int q = 0; q < 4; ++q) { const int t = t0 + q; int lo = t - W / 2, hi = t + W / 2; if (lo < 0) lo = 0; if (hi > SEQ) hi = SEQ; const float inv = 1.0f / (float)(hi - lo);
        if (q > 0) {
#pragma unroll
            for (int c = 0; c < 8; ++c) s[c] += f[q + W - 1][c] - f[q - 1][c]; }
        const float* e = f[q + W / 2];
        *(u32x4*)(P + (size_t)(row0 + q) * DM + c8 * 8) = (u32x4){cvtpk(s[0] * inv - e[0], s[1] * inv - e[1]), cvtpk(s[2] * inv - e[2], s[3] * inv - e[3]), cvtpk(s[4] * inv - e[4], s[5] * inv - e[5]), cvtpk(s[6] * inv - e[6], s[7] * inv - e[7])}; }
}
__device__ __forceinline__ void pool_phase(const Frame& F, const bf16_t* H, bf16_t* P) {
    const int lane = lane_id(); const int gwv = (int)blockIdx.x * NWAVES + F.wave, NWV = F.G * NWAVES;
    for (int wi = gwv; wi < NTOK; wi += NWV) {
        const int row0 = (wi >> 2) * 4, g = wi & 3, c8 = g * 64 + lane;
        if (g == 0) pool_item4<2>(H, P, row0, c8); else if (g == 1) pool_item4<4>(H, P, row0, c8); else if (g == 2) pool_item4<8>(H, P, row0, c8); else pool_item4<16>(H, P, row0, c8);
    }
}

constexpr int N_PHASES = 24;
#ifndef MK_N_LAUNCHES
#define MK_N_LAUNCHES 1
#endif
#ifndef REP_MASK
#define REP_MASK 0
#endif
__global__ void __launch_bounds__(NWAVES * 64, 2) skel_fwd(Args args) {
    extern __shared__ __attribute__((aligned(16))) unsigned char lds_raw[];
    Frame F;
    F.lds = (LAS unsigned char*)lds_raw; F.MISC = (volatile LAS unsigned*)(F.lds + MISC_OFF);
    F.wave = __builtin_amdgcn_readfirstlane(threadIdx.x >> 6);
    F.G = gridDim.x; { const int bx = blockIdx.x; F.vcu = (F.G % 8 == 0) ? (bx % 8) * (F.G / 8) + bx / 8 : bx; }
    F.ws = nullptr; F.ctl = (gu32*)(uptr(args.ws) + WS_CTL);
    for (int u = threadIdx.x; u < (LDS_BYTES - LDSCTL_OFF) / 4; u += NWAVES * 64) ((LAS unsigned*)(F.lds + LDSCTL_OFF))[u] = 0u;
    __syncthreads();
    const bool multi = (MK_N_LAUNCHES == 1) || (args.ph_hi - args.ph_lo) > 1 || REP_MASK != 0;
    XcdBarrier bar; bar.bar = (unsigned*)(F.ctl + CW_BAR); bar.x = 0; bar.st = nullptr; bar.wave = F.wave;
    if (multi) bar = xcd_barrier_post((unsigned*)(F.ctl + CW_BAR), F.MISC + 8, F.wave);
    const int lo = args.ph_lo, hi = args.ph_hi;
#ifdef REP_RT
    const unsigned rep_mask_ = (unsigned)__builtin_amdgcn_readfirstlane(args.pad);
#endif
#define IN(k) ((MK_N_LAUNCHES == 1) ? ((k) < N_PHASES) : (lo <= (k) && (k) < hi))
#ifdef REP_RT
#define REPBIT(k) ((int)((rep_mask_ >> (k)) & 1u))
#else
#define REPBIT(k) ((int)((((unsigned)REP_MASK) >> (k)) & 1u))
#endif
#define PHASE(k) _Pragma("unroll") for (int rep_ = 0; rep_ < 1 + REPBIT(k); ++rep_)
#define SEAM(k) do { if ((IN(k) && IN((k) + 1)) || rep_ + 1 < 1 + REPBIT(k)) xcd_barrier(bar); } while (0)
    LAS unsigned char* ring = F.lds + RING_OFF; LAS unsigned char* xl = F.lds + XL_OFF;
    const int bx = (int)blockIdx.x, G = F.G;

#define KV_PROJ(l, rotK, rotV) do {   \
            { MapLin mp{(const char*)(ws + WS_MEMNB + (size_t)(l) * NB * MEML * DM * 2), (const char*)(ws + WS_WCK_T + (size_t)(l) * DM * DM * 2), (size_t)256 * DM * 2, (size_t)256 * DM * 2}; \
              pg8::Sched<MapLin> S; S.init(NB * MEML / 256, DM / 256, G, (bx + G - ((rotK) % G)) % G, mp); \
              EpiStore<AddrLin> E{AddrLin{(bf16_t*)(ws + WS_KCB + (size_t)(l) * NB * MEML * DM * 2), DM}}; \
              pg8::gemm_phase<EpiStore<AddrLin>, pg8::Sched<MapLin>, true>(F.wave, ring, xl, DM, DM * 2, DM * 2, S, E); } \
            { MapLin mp{(const char*)(ws + WS_WCV_T + (size_t)(l) * DM * DM * 2), (const char*)(ws + WS_MEMNB + (size_t)(l) * NB * MEML * DM * 2), (size_t)256 * DM * 2, (size_t)256 * DM * 2}; \
              pg8::Sched<MapLin> S; S.init(DM / 256, NB * MEML / 256, G, (bx + G - ((rotV) % G)) % G, mp); \
              EpiStore<AddrLin> E{AddrLin{(bf16_t*)(ws + WS_VTB + (size_t)(l) * NB * MEML * DM * 2), NB * MEML}}; \
              pg8::gemm_phase<EpiStore<AddrLin>, pg8::Sched<MapLin>, true>(F.wave, ring, xl, DM, DM * 2, DM * 2, S, E); } } while (0)
#ifdef EXTRA_BARS
    for (int eb = 0; eb < EXTRA_BARS; ++eb) xcd_barrier(bar);
#endif
    if (IN(0)) PHASE(0) { const karg_t ka = kargs(); unsigned char* const ws = uptr(KWS(ka)); p0_prologue(F, ka, ws); SEAM(0); }
    if (IN(1)) PHASE(1) { const karg_t ka = kargs(); unsigned char* const ws = uptr(KWS(ka));
        {
            MapLin mp{(const char*)(ws + WS_HN), (const char*)(ws + WS_WIN_T), (size_t)256 * DM * 2, (size_t)256 * DM * 2};
            pg8::Sched<MapLin> S; S.init(NTOK / 256, 2560 / 256, G, bx, mp);
            EpiQKV E{(bf16_t*)(ws + WS_QB), (bf16_t*)(ws + WS_KB), (bf16_t*)(ws + WS_VB), KIN(ka, 4), KIN(ka, 5), (const float*)(ws + WS_ROPE), (const float*)(ws + WS_ROPE) + SEQ * 64};
            pg8::gemm_phase<EpiQKV, pg8::Sched<MapLin>, true>(F.wave, ring, xl, DM, DM * 2, DM * 2, S, E); }
        {
            MapLin mp{(const char*)(ws + WS_WF_T), (const char*)(ws + WS_HN), (size_t)256 * DM * 2, (size_t)256 * DM * 2};
            pg8::Sched<MapLin> S; S.init(1024 / 256, NTOK / 256, G, (bx + G - (320 % G)) % G, mp);
            EpiStore<AddrF1> E{AddrF1{(bf16_t*)(ws + WS_FPQ)}};
            pg8::gemm_phase<EpiStore<AddrF1>, pg8::Sched<MapLin>, true>(F.wave, ring, xl, DM, DM * 2, DM * 2, S, E); }
        KV_PROJ(0, 448, 480);
        SEAM(1);
    }
    if (IN(2)) PHASE(2) { const karg_t ka = kargs(); unsigned char* const ws = uptr(KWS(ka));
        const int nF2 = (G > 64) ? 64 : 0;
        if (bx < nF2 || nF2 == 0) {
            MapLin mp{(const char*)(ws + WS_DFT), (const char*)(ws + WS_FPQ), (size_t)256 * 4096 * 2, (size_t)256 * 4096 * 2};
            pg8::Sched<MapLin> S; S.init(8, 8, nF2 ? nF2 : G, bx, mp);
            EpiStore<AddrF2> E{AddrF2{(bf16_t*)(ws + WS_MIXB)}};
            pg8::gemm_phase<EpiStore<AddrF2>, pg8::Sched<MapLin>, true>(F.wave, ring, xl, 4096, 4096 * 2, 4096 * 2, S, E);
        }
        if (bx < nF2) { __syncthreads(); tr_span(F, ka, ws, 3, bx * 8 + F.wave, 512, 2); __syncthreads(); }
        if (bx >= nF2) {
            const int a = bx - nF2, cnt = G - nF2, per = (384 + cnt - 1) / cnt; int ui = 0;
            for (int uid = a * per; uid < (a + 1) * per && uid < 384; ++uid, ++ui) {
                const int set_ = 2 * (a & 7) + ui, jx = a >> 3, b = set_ >> 2, kvh = set_ & 3, qb = jx & 7, hq = kvh * 3 + (jx >> 3);
                const bf16_t* Qb = (const bf16_t*)(ws + WS_QB) + ((size_t)b * SEQ + qb * 256) * AW + hq * HD;
                const bf16_t* Kh = (const bf16_t*)(ws + WS_KB) + (size_t)b * SEQ * KVW + kvh * HD;
                const bf16_t* Vh = (const bf16_t*)(ws + WS_VB) + (size_t)b * SEQ * KVW + kvh * HD;
                bf16_t* Ob = (bf16_t*)(ws + WS_MIXB) + ((size_t)b * SEQ + qb * 256) * DM + hq * HD;
                attn::attn_dense_body(Qb, Kh, Vh, Ob, SEQ, (char*)lds_raw + RING_OFF, F.wave);
            }
        }
        SEAM(2);
    }
    if (IN(3)) PHASE(3) { const karg_t ka = kargs(); unsigned char* const ws = uptr(KWS(ka));
        MapLin mp{(const char*)(ws + WS_MIXB), (const char*)(ws + WS_WOUT_T), (size_t)256 * DM * 2, (size_t)256 * DM * 2};
        pg8::Sched<MapLin> S; S.init(NTOK / 256, DM / 256, G, bx, mp);
        EpiResB<true> E{KIN(ka, 0), (bf16_t*)(ws + WS_XB), (float*)(ws + WS_SSP), nullptr};
        pg8::gemm_phase<EpiResB<true>, pg8::Sched<MapLin>, true>(F.wave, ring, xl, DM, DM * 2, DM * 2, S, E);
        SEAM(3);
    }
    {
        constexpr int l = 0; constexpr int pb = l ? 15 : 4;
        if (l == 1) {
            if (IN(13)) PHASE(13) { const karg_t ka = kargs(); unsigned char* const ws = uptr(KWS(ka));
                pool_phase(F, (const bf16_t*)(ws + WS_HN), (bf16_t*)(ws + WS_QCB));
#ifdef PROBE_CONV
                tr_span<TRV>(F, ka, ws, 1, bx * 8 + F.wave, 2048, 4);
#endif
                SEAM(13);
            }
            if (IN(14)) PHASE(14) { const karg_t ka = kargs(); unsigned char* const ws = uptr(KWS(ka));
                MapPool mp{(const char*)(ws + WS_QCB), (const char*)(ws + WS_WP_T)};
                pg8::Sched<MapPool> S; S.init(NTOK / 256, DM / 256, G, bx, mp);
                EpiResB<false> E{(const bf16_t*)(ws + WS_XB), (bf16_t*)(ws + WS_XALT), (float*)(ws + WS_SSP), KIN(ka, 9)};
                pg8::gemm_phase<EpiResB<false>, pg8::Sched<MapPool>, true>(F.wave, ring, xl, 512, DM * 2, DM * 2, S, E);
                SEAM(14);
            }
        }
        if (IN(pb + 0)) PHASE(pb + 0) { const karg_t ka = kargs(); unsigned char* const ws = uptr(KWS(ka));
            MapLin mp{(const char*)(ws + (l == 0 ? WS_XB : WS_XALT)), (const char*)(ws + WS_WCQ_T + (size_t)l * DM * DM * 2), (size_t)256 * DM * 2, (size_t)256 * DM * 2};
            pg8::Sched<MapLin> S; S.init(NTOK / 256, DM / 256, G, bx, mp);
            EpiRowScale E{(bf16_t*)(ws + WS_QCB), DM, (const float*)(ws + WS_SSP), 0.04419417382415922f};
            pg8::gemm_phase<EpiRowScale, pg8::Sched<MapLin>, true>(F.wave, ring, xl, DM, DM * 2, DM * 2, S, E);
            SEAM(pb + 0);
        }
        if (IN(pb + 1)) PHASE(pb + 1) { const karg_t ka = kargs(); unsigned char* const ws = uptr(KWS(ka));
            MapXS mp{(const char*)(ws + WS_QCB), (const char*)(ws + WS_KCB + (size_t)l * NB * MEML * DM * 2)};
            pg8::Sched<MapXS> S; S.init(NTOK / 256, NMH, G, bx, mp);
            EpiSoftmax E{(bf16_t*)(ws + WS_PB), NMH * MEML};
            pg8::gemm_phase<EpiSoftmax, pg8::Sched<MapXS>, true>(F.wave, ring, xl, MHD, DM * 2, DM * 2, S, E);
            { pg8::Unit su; if (S.next(0, su)) {
                VM_WAIT(); __syncthreads(); if (F.wave == 0 && lane_id() == 0) { __builtin_amdgcn_fence(__ATOMIC_ACQUIRE, "agent"); VM_WAIT(); } __syncthreads();
                MapXPV mp2{(const char*)(ws + WS_PB), (const char*)(ws + WS_VTB + (size_t)l * NB * MEML * DM * 2)};
                SchedPair S2; S2.ua.pm = su.pm; S2.ua.pn = 2 * su.pn; S2.ub.pm = su.pm; S2.ub.pn = 2 * su.pn + 1; mp2(S2.ua); mp2(S2.ub);
                EpiStore<AddrLin> E2{AddrLin{(bf16_t*)(ws + WS_MIXB), DM}};
                pg8::gemm_phase<EpiStore<AddrLin>, SchedPair, true>(F.wave, ring, xl, MEML, NMH * MEML * 2, NB * MEML * 2, S2, E2); } }
            if (l == 0) { KV_PROJ(1, 128, 160);
            }
            SEAM(pb + 1);
        }
        if (IN(pb + 3)) PHASE(pb + 3) { const karg_t ka = kargs(); unsigned char* const ws = uptr(KWS(ka));
            MapLin mp{(const char*)(ws + WS_MIXB), (const char*)(ws + WS_WCO_T + (size_t)l * DM * DM * 2), (size_t)256 * DM * 2, (size_t)256 * DM * 2};
            pg8::Sched<MapLin> S; S.init(NTOK / 256, DM / 256, G, bx, mp);
            EpiResB<false> E{(const bf16_t*)(ws + (l == 0 ? WS_XB : WS_XALT)), (bf16_t*)(ws + (l == 0 ? WS_XALT : WS_XB)), nullptr, nullptr, (bf16_t*)(ws + WS_XSB), KIN(ka, 16) + l * DM};
            pg8::gemm_phase<EpiResB<false>, pg8::Sched<MapLin>, true>(F.wave, ring, xl, DM, DM * 2, DM * 2, S, E);
            SEAM(pb + 3);
        }
        if (IN(pb + 4)) PHASE(pb + 4) { const karg_t ka = kargs(); unsigned char* const ws = uptr(KWS(ka));
            router_phase(F, (const bf16_t*)(ws + (l == 0 ? WS_XALT : WS_XB)), (const u32x4*)(ws + WS_AFF + 512 * 1024) + (size_t)l * 8192, (float*)(ws + WS_SSP + 512 * 1024), (float*)(ws + WS_AFF), xl);
            SEAM(pb + 4);
        }
        if (IN(pb + 5)) PHASE(pb + 5) { const karg_t ka = kargs(); unsigned char* const ws = uptr(KWS(ka));
            rank_phase(F, (const float*)(ws + WS_AFF), (int*)(ws + WS_RANK), (float*)(ws + WS_GATE), (const float*)(ws + WS_SSP + 512 * 1024), (float*)(ws + WS_SSP + 768 * 1024), (int*)(ws + WS_GATE + 512 * 1024));
            if (l == 0 && bx >= NB * NE && (bx - NB * NE) * 8 + F.wave < TR_DEFER - 1024) tr_span(F, ka, ws, 3, 1024 + (bx - NB * NE) * 8 + F.wave, 0, 1);
            SEAM(pb + 5);
        }
        if (IN(pb + 6)) PHASE(pb + 6) { const karg_t ka = kargs(); unsigned char* const ws = uptr(KWS(ka));
            MapMoE mp{(const char*)(ws + WS_XSB), (const char*)(KIN(ka, 18) + (size_t)l * NE * DM * EFF), (size_t)0, (size_t)DM * EFF * 4, (size_t)128 * 4};
            pg8::Sched<MapMoE> S; S.init(NB * NE, 8, G, bx, mp);
            EpiSwiGLU E{(bf16_t*)(ws + WS_ACTB), (const float*)(ws + WS_SSP + 768 * 1024)};
            pg8::gemm_phase<EpiSwiGLU, pg8::Sched<MapMoE>, true, true, 1, false>(F.wave, ring, xl, DM, DM * 2, EFF * 4, S, E, (const int*)(ws + WS_GATE + 512 * 1024), (long)((const char*)KIN(ka, 19) - (const char*)KIN(ka, 18)));
            SEAM(pb + 6);
        }
        if (IN(pb + 7)) PHASE(pb + 7) { const karg_t ka = kargs(); unsigned char* const ws = uptr(KWS(ka));
            MapMoE mp{(const char*)(ws + WS_ACTB), (const char*)(KIN(ka, 20) + (size_t)l * NE * EFF * DM), (size_t)256 * EFF * 2, (size_t)EFF * DM * 4, (size_t)256 * 4};
            pg8::Sched<MapMoE> S; S.init(NB * NE, 8, G, bx, mp);
            EpiRowGate E{(bf16_t*)(ws + WS_YB), (const float*)(ws + WS_GATE)};
            pg8::gemm_phase<EpiRowGate, pg8::Sched<MapMoE>, true, false, 1, false>(F.wave, ring, xl, EFF, EFF * 2, DM * 4, S, E, nullptr, 512);
            SEAM(pb + 7);
        }
        if (IN(pb + 8)) PHASE(pb + 8) { const karg_t ka = kargs(); unsigned char* const ws = uptr(KWS(ka));
            combine_phase(F, (const bf16_t*)(ws + (l == 0 ? WS_XALT : WS_XB)), (bf16_t*)(ws + WS_XB), KOUT(ka), (const bf16_t*)(ws + WS_YB), (const int*)(ws + WS_RANK), l == 0 ? KIN(ka, 2) + DM : KIN(ka, 21), (bf16_t*)(ws + WS_HN), l == 1);
            SEAM(pb + 8);
        }
    }
    {
        constexpr int l = 1; constexpr int pb = l ? 15 : 4;
        if (l == 1) {
            if (IN(13)) PHASE(13) { const karg_t ka = kargs(); unsigned char* const ws = uptr(KWS(ka));
                pool_phase(F, (const bf16_t*)(ws + WS_HN), (bf16_t*)(ws + WS_QCB));
#ifdef PROBE_CONV
                tr_span<TRV>(F, ka, ws, 1, bx * 8 + F.wave, 2048, 4);
#endif
                SEAM(13);
            }
            if (IN(14)) PHASE(14) { const karg_t ka = kargs(); unsigned char* const ws = uptr(KWS(ka));
                MapPool mp{(const char*)(ws + WS_QCB), (const char*)(ws + WS_WP_T)};
                pg8::Sched<MapPool> S; S.init(NTOK / 256, DM / 256, G, bx, mp);
                EpiResB<false> E{(const bf16_t*)(ws + WS_XB), (bf16_t*)(ws + WS_XALT), (float*)(ws + WS_SSP), KIN(ka, 9)};
                pg8::gemm_phase<EpiResB<false>, pg8::Sched<MapPool>, true>(F.wave, ring, xl, 512, DM * 2, DM * 2, S, E);
                SEAM(14);
            }
        }
        if (IN(pb + 0)) PHASE(pb + 0) { const karg_t ka = kargs(); unsigned char* const ws = uptr(KWS(ka));
            MapLin mp{(const char*)(ws + (l == 0 ? WS_XB : WS_XALT)), (const char*)(ws + WS_WCQ_T + (size_t)l * DM * DM * 2), (size_t)256 * DM * 2, (size_t)256 * DM * 2};
            pg8::Sched<MapLin> S; S.init(NTOK / 256, DM / 256, G, bx, mp);
            EpiRowScale E{(bf16_t*)(ws + WS_QCB), DM, (const float*)(ws + WS_SSP), 0.04419417382415922f};
            pg8::gemm_phase<EpiRowScale, pg8::Sched<MapLin>, true>(F.wave, ring, xl, DM, DM * 2, DM * 2, S, E);
            SEAM(pb + 0);
        }
        if (IN(pb + 1)) PHASE(pb + 1) { const karg_t ka = kargs(); unsigned char* const ws = uptr(KWS(ka));
            MapXS mp{(const char*)(ws + WS_QCB), (const char*)(ws + WS_KCB + (size_t)l * NB * MEML * DM * 2)};
            pg8::Sched<MapXS> S; S.init(NTOK / 256, NMH, G, bx, mp);
            EpiSoftmax E{(bf16_t*)(ws + WS_PB), NMH * MEML};
            pg8::gemm_phase<EpiSoftmax, pg8::Sched<MapXS>, true>(F.wave, ring, xl, MHD, DM * 2, DM * 2, S, E);
            { pg8::Unit su; if (S.next(0, su)) {
                VM_WAIT(); __syncthreads(); if (F.wave == 0 && lane_id() == 0) { __builtin_amdgcn_fence(__ATOMIC_ACQUIRE, "agent"); VM_WAIT(); } __syncthreads();
                MapXPV mp2{(const char*)(ws + WS_PB), (const char*)(ws + WS_VTB + (size_t)l * NB * MEML * DM * 2)};
                SchedPair S2; S2.ua.pm = su.pm; S2.ua.pn = 2 * su.pn; S2.ub.pm = su.pm; S2.ub.pn = 2 * su.pn + 1; mp2(S2.ua); mp2(S2.ub);
                EpiStore<AddrLin> E2{AddrLin{(bf16_t*)(ws + WS_MIXB), DM}};
                pg8::gemm_phase<EpiStore<AddrLin>, SchedPair, true>(F.wave, ring, xl, MEML, NMH * MEML * 2, NB * MEML * 2, S2, E2); } }
            if (l == 0) { KV_PROJ(1, 128, 160);
            }
            SEAM(pb + 1);
        }
        if (IN(pb + 3)) PHASE(pb + 3) { const karg_t ka = kargs(); unsigned char* const ws = uptr(KWS(ka));
            MapLin mp{(const char*)(ws + WS_MIXB), (const char*)(ws + WS_WCO_T + (size_t)l * DM * DM * 2), (size_t)256 * DM * 2, (size_t)256 * DM * 2};
            pg8::Sched<MapLin> S; S.init(NTOK / 256, DM / 256, G, bx, mp);
            EpiResB<false> E{(const bf16_t*)(ws + (l == 0 ? WS_XB : WS_XALT)), (bf16_t*)(ws + (l == 0 ? WS_XALT : WS_XB)), nullptr, nullptr, (bf16_t*)(ws + WS_XSB), KIN(ka, 16) + l * DM};
            pg8::gemm_phase<EpiResB<false>, pg8::Sched<MapLin>, true>(F.wave, ring, xl, DM, DM * 2, DM * 2, S, E);
            SEAM(pb + 3);
        }
        if (IN(pb + 4)) PHASE(pb + 4) { const karg_t ka = kargs(); unsigned char* const ws = uptr(KWS(ka));
            router_phase(F, (const bf16_t*)(ws + (l == 0 ? WS_XALT : WS_XB)), (const u32x4*)(ws + WS_AFF + 512 * 1024) + (size_t)l * 8192, (float*)(ws + WS_SSP + 512 * 1024), (float*)(ws + WS_AFF), xl);
            SEAM(pb + 4);
        }
        if (IN(pb + 5)) PHASE(pb + 5) { const karg_t ka = kargs(); unsigned char* const ws = uptr(KWS(ka));
            rank_phase(F, (const float*)(ws + WS_AFF), (int*)(ws + WS_RANK), (float*)(ws + WS_GATE), (const float*)(ws + WS_SSP + 512 * 1024), (float*)(ws + WS_SSP + 768 * 1024), (int*)(ws + WS_GATE + 512 * 1024));
            if (l == 0 && bx >= NB * NE && (bx - NB * NE) * 8 + F.wave < TR_DEFER - 1024) tr_span(F, ka, ws, 3, 1024 + (bx - NB * NE) * 8 + F.wave, 0, 1);
            SEAM(pb + 5);
        }
        if (IN(pb + 6)) PHASE(pb + 6) { const karg_t ka = kargs(); unsigned char* const ws = uptr(KWS(ka));
            MapMoE mp{(const char*)(ws + WS_XSB), (const char*)(KIN(ka, 18) + (size_t)l * NE * DM * EFF), (size_t)0, (size_t)DM * EFF * 4, (size_t)128 * 4};
            pg8::Sched<MapMoE> S; S.init(NB * NE, 8, G, bx, mp);
            EpiSwiGLU E{(bf16_t*)(ws + WS_ACTB), (const float*)(ws + WS_SSP + 768 * 1024)};
            pg8::gemm_phase<EpiSwiGLU, pg8::Sched<MapMoE>, true, true, 1, false>(F.wave, ring, xl, DM, DM * 2, EFF * 4, S, E, (const int*)(ws + WS_GATE + 512 * 1024), (long)((const char*)KIN(ka, 19) - (const char*)KIN(ka, 18)));
            SEAM(pb + 6);
        }
        if (IN(pb + 7)) PHASE(pb + 7) { const karg_t ka = kargs(); unsigned char* const ws = uptr(KWS(ka));
            MapMoE mp{(const char*)(ws + WS_ACTB), (const char*)(KIN(ka, 20) + (size_t)l * NE * EFF * DM), (size_t)256 * EFF * 2, (size_t)EFF * DM * 4, (size_t)256 * 4};
            pg8::Sched<MapMoE> S; S.init(NB * NE, 8, G, bx, mp);
            EpiRowGate E{(bf16_t*)(ws + WS_YB), (const float*)(ws + WS_GATE)};
            pg8::gemm_phase<EpiRowGate, pg8::Sched<MapMoE>, true, false, 1, false>(F.wave, ring, xl, EFF, EFF * 2, DM * 4, S, E, nullptr, 512);
            SEAM(pb + 7);
        }
        if (IN(pb + 8)) PHASE(pb + 8) { const karg_t ka = kargs(); unsigned char* const ws = uptr(KWS(ka));
            combine_phase(F, (const bf16_t*)(ws + (l == 0 ? WS_XALT : WS_XB)), (bf16_t*)(ws + WS_XB), KOUT(ka), (const bf16_t*)(ws + WS_YB), (const int*)(ws + WS_RANK), l == 0 ? KIN(ka, 2) + DM : KIN(ka, 21), (bf16_t*)(ws + WS_HN), l == 1);
            SEAM(pb + 8);
        }
    }
#undef IN
#undef SEAM
#undef PHASE
#undef KV_PROJ
}


extern "C" void kernel_launch(void* const* d_in, const int* in_sizes, int n_in, void* d_out, int out_size, void* d_ws, size_t ws_size, hipStream_t stream) {
    static int grid = 0;
    if (grid == 0) {
        int dev = 0, cus = 0;
        if (n_in != 22 || out_size != NTOK * DM || ws_size < WS_FAST_END) { fprintf(stderr, "kernel_launch: unexpected shapes (n_in %d out %d ws %zu)\n", n_in, out_size, ws_size); grid = -1; return; }
        if (hipGetDevice(&dev) != hipSuccess || hipDeviceGetAttribute(&cus, hipDeviceAttributeMultiprocessorCount, dev) != hipSuccess) { fprintf(stderr, "device query failed\n"); grid = -1; return; }
        if (hipFuncSetAttribute((const void*)skel_fwd, hipFuncAttributeMaxDynamicSharedMemorySize, LDS_BYTES) != hipSuccess) { fprintf(stderr, "hipFuncSetAttribute failed\n"); grid = -1; return; }
        (void)hipGetLastError();
        grid = cus;
        if (grid != 256) { fprintf(stderr, "kernel_launch: this kernel is laid out for 256 CUs (found %d)\n", cus); grid = -1; return; }
    }
    if (grid < 0) return;
    (void)hipMemsetAsync((char*)d_ws + WS_CTL, 0, 32768, stream);
    Args a{};
    for (int i = 0; i < 22; ++i) a.in[i] = (const float*)d_in[i];
    a.out = (float*)d_out; a.ws = (unsigned char*)d_ws;
#ifdef REP_RT
    a.pad = REP_RT;
#endif
    constexpr int NL = MK_N_LAUNCHES;
    for (int li = 0; li < NL; ++li) {
        a.ph_lo = (N_PHASES * li) / NL; a.ph_hi = (N_PHASES * (li + 1)) / NL; a.li = li;
        hipLaunchKernelGGL(skel_fwd, dim3(grid), dim3(NWAVES * 64), LDS_BYTES, stream, a);
    }
}
```

```cpp
#include <hip/hip_runtime.h>
#include <cstdio>
#include <cstdint>

constexpr int DM = 2048, NB = 4, SEQ = 2048, NTOK = NB * SEQ;
constexpr int HD = 128, NQH = 12, NKVH = 4, AW = NQH * HD, KVW = NKVH * HD, FW = 512, INW = 3072;
constexpr int MEML = 256, NMH = 4, MHD = 512;
constexpr int NE = 16, EFF = 1024, CAP = 256;
constexpr float EPS = 1e-6f;

#define LAS __attribute__((address_space(3)))
#define GAS __attribute__((address_space(1)))
typedef unsigned short bf16_t;
typedef short bf16x8 __attribute__((ext_vector_type(8)));
typedef float f32x4 __attribute__((ext_vector_type(4)));
typedef float f32x2 __attribute__((ext_vector_type(2)));
typedef unsigned u32x4 __attribute__((ext_vector_type(4)));
typedef unsigned u32x2 __attribute__((ext_vector_type(2)));
typedef __bf16 bf16x2_t __attribute__((ext_vector_type(2)));
__device__ __forceinline__ unsigned cvtpk(float lo, float hi) { f32x2 v = {lo, hi}; bf16x2_t b = __builtin_convertvector(v, bf16x2_t); return __builtin_bit_cast(unsigned, b); }
__device__ __forceinline__ float bf2f(unsigned short h) { return __uint_as_float(((unsigned)h) << 16); }
template <class T> __device__ __forceinline__ T* uptr(T* p) { const unsigned long long v = (unsigned long long)p; const unsigned lo = __builtin_amdgcn_readfirstlane((unsigned)v), hi = __builtin_amdgcn_readfirstlane((unsigned)(v >> 32)); return (T*)(((unsigned long long)hi << 32) | lo); }
__device__ __forceinline__ int lane_id() { int l = (int)__builtin_amdgcn_mbcnt_hi(~0u, __builtin_amdgcn_mbcnt_lo(~0u, 0u)); asm volatile("" : "+v"(l)); return l; }
typedef __attribute__((address_space(4))) const unsigned char* karg_t;
__device__ __forceinline__ karg_t kargs() { karg_t p = (karg_t)__builtin_amdgcn_kernarg_segment_ptr(); asm volatile("" : "+s"(p)); return p; }
#define KIN(ka, i) (*(const float* const __attribute__((address_space(4)))*)((ka) + 8 * (i)))
#define KOUT(ka) (*(float* const __attribute__((address_space(4)))*)((ka) + 176))
#define KWS(ka) (*(unsigned char* const __attribute__((address_space(4)))*)((ka) + 184))
#ifndef EPI_WT
#define EPI_WT 0
#endif
__device__ __forceinline__ void st16(void* p, u32x4 v) {
#if EPI_WT
    asm volatile("global_store_dwordx4 %0, %1, off sc1\n\ts_nop 1" :: "v"(p), "v"(v) : "memory");
#else
    *(u32x4*)p = v;
#endif
}
#define LDS_WAIT() asm volatile("s_waitcnt lgkmcnt(0)" ::: "memory")
#define VM_WAIT() asm volatile("s_waitcnt vmcnt(0)" ::: "memory")
#define WG_BAR() do { asm volatile("s_waitcnt lgkmcnt(0)" ::: "memory"); __builtin_amdgcn_s_barrier(); asm volatile("" ::: "memory"); } while (0)

namespace pg8 {
constexpr int BM = 256, BK = 64, HALF = 128, HTB = HALF * BK * 2, STAGE_BYTES = 8 * HTB, NXCD = 8, WGM = 8;
__host__ __device__ __forceinline__ int lds_byte(int r, int c) { const int st = (r >> 4) * 2 + (c >> 5), rr = r & 15, cc = c & 31, ob = rr * 64 + cc * 2; return st * 1024 + (ob ^ (((ob >> 9) & 1) << 5)); }
__host__ __device__ __forceinline__ void stage_rc(int b, int& R, int& C) { const int st = b / 1024, sb = b % 1024, swz = sb ^ (((sb >> 9) & 1) << 5); R = (st >> 1) * 16 + swz / 64; C = (st & 1) * 32 + (swz % 64) / 2; }
__host__ __device__ __forceinline__ int perm32(int rho) { const int n = rho >> 4, i = rho & 15; return 8 * (i >> 2) + 4 * n + (i & 3); }

struct Unit { int pm, pn; const char* a; const char* b; };
struct EpiCtx { int wr, wc, wid; LAS unsigned char* xl; };

template <class Map> struct Sched {
    int nM, nN, nwg, G, c, wgm; Map map;
    __device__ __forceinline__ void init(int nM_, int nN_, int G_, int c_, const Map& m, int wgm_ = WGM) { nM = nM_; nN = nN_; nwg = nM * nN; G = G_; c = c_; map = m; wgm = wgm_; }
    __device__ __forceinline__ bool next(int i, Unit& u) const {
        const long L = (long)i * G + c; if (L >= nwg) return false;
        int wgid = (int)L; { const int q = nwg / NXCD, r = nwg % NXCD, xcd = wgid % NXCD, off = wgid / NXCD; wgid = (xcd < r ? xcd * (q + 1) : r * (q + 1) + (xcd - r) * q) + off; }
        const int nig = wgm * nN, gid = wgid / nig, fm = gid * wgm, gsz = (nM - fm) < wgm ? (nM - fm) : wgm;
        u.pm = fm + ((wgid % nig) % gsz); u.pn = (wgid % nig) / gsz; map(u); return true;
    }
};

template <class Epi, class SchedT, bool SP2, bool GATHER = false, int BF = 0, bool BGAIN = false>
__device__ __forceinline__ void gemm_phase(const int wave_, LAS unsigned char* lds, LAS unsigned char* xl, const int K, const int lda, const int ldb, const SchedT& S, const Epi& E, const int* gidx = nullptr, const long bhoff = 0, const LAS float* bgl = nullptr) {
    constexpr bool ALIGN_EPI = true; static_assert(SP2 || !GATHER, "GATHER needs the SP2 loop"); static_assert(BF == 0 || (SP2 && Epi::PERM), "BF needs the SP2 loop and the PERM column order");
    const int lane = lane_id(), wid = wave_, tid = wid * 64 + lane, wr = wid >> 2, wc = wid & 3, fr = lane & 15, fq = lane >> 4;
    const int nt = K / BK;
    unsigned voffA[2], voffB[2];
#pragma unroll
    for (int i = 0; i < 2; ++i) { int R, C; stage_rc(tid * 16 + i * 8192, R, C); const int Rb = Epi::PERM ? ((R & ~31) + perm32(R & 31)) : R;
        voffA[i] = (unsigned)(R * lda + C * 2); voffB[i] = (unsigned)(Rb * ldb + C * 2); }
    const size_t kstep = (size_t)(BK * 2);
    const size_t hstepA = (size_t)HALF * lda, hstepB = (size_t)HALF * ldb;
    const unsigned ldsw = (unsigned)wid * 1024u;
    const int aoff = lds_byte(wr * 64 + fr, fq * 8), boff = lds_byte(wc * 32 + fr, fq * 8);
    const unsigned xoffA = (unsigned)tid * 16u;
    int gset = 0;
    const int bf_nb = lane & 15, bf_kq = lane >> 4, bf_m = (bf_nb >> 1) & 3, bf_kb = 32 * (wid >> 2) + 8 * bf_kq;
    const unsigned bf_src = (unsigned)(bf_kb * ldb + (64 * (wid & 1) + 4 * bf_nb) * 4);
    const long bf_h = ((wid & 3) >> 1) ? bhoff : 0;
    const unsigned bf_dst = (unsigned)(((wid & 3) >> 1) * HTB + (((64 * (wid & 1) + 32 * (bf_nb >> 3) + 16 * (bf_nb & 1)) >> 4) * 2 + (wid >> 2)) * 1024 + 256 * bf_m + ((16 * bf_kq) ^ ((bf_m >> 1) << 5)));
    f32x4 bq[8];
#define PG8_BISSUE(gbase) do { if constexpr (BF) { const char* gb_ = (const char*)(gbase) + bf_h; _Pragma("unroll") for (int i_ = 0; i_ < 8; ++i_) \
        asm volatile("global_load_dwordx4 %0, %1, %2" : "=v"(bq[i_]) : "v"(bf_src), "s"(gb_ + (size_t)i_ * ldb) : "memory"); } } while (0)
#define PG8_BWAIT(n) do { if constexpr (BF) asm volatile("s_waitcnt vmcnt(" #n ")" : "+v"(bq[0]), "+v"(bq[1]), "+v"(bq[2]), "+v"(bq[3]), "+v"(bq[4]), "+v"(bq[5]), "+v"(bq[6]), "+v"(bq[7]) :: "memory"); } while (0)
#define PG8_BCONS(b_, kt_) do { if constexpr (BF) { const unsigned ad_ = (unsigned)(size_t)lds + (unsigned)PG8_SB(b_, 0) + bf_dst; \
        if constexpr (BGAIN) { { const f32x4 g_ = *(const LAS f32x4*)(bgl + (kt_) * 64 + bf_kb); bq[0] = bq[0] * g_.x; bq[1] = bq[1] * g_.y; bq[2] = bq[2] * g_.z; bq[3] = bq[3] * g_.w; } \
                               { const f32x4 g_ = *(const LAS f32x4*)(bgl + (kt_) * 64 + bf_kb + 4); bq[4] = bq[4] * g_.x; bq[5] = bq[5] * g_.y; bq[6] = bq[6] * g_.z; bq[7] = bq[7] * g_.w; } } \
        _Pragma("unroll") for (int c_ = 0; c_ < 4; ++c_) { const u32x4 o_ = (u32x4){cvtpk(bq[0][c_], bq[1][c_]), cvtpk(bq[2][c_], bq[3][c_]), cvtpk(bq[4][c_], bq[5][c_]), cvtpk(bq[6][c_], bq[7][c_])}; \
            asm volatile("ds_write_b128 %0, %1 offset:%2" :: "v"(ad_), "v"(o_), "i"(c_ * 64) : "memory"); } } } while (0)
#define PG8_GSETUP(set, pm_) do { if constexpr (GATHER) { int R0_, C0_, R1_, C1_; stage_rc(tid * 16, R0_, C0_); stage_rc(tid * 16 + 8192, R1_, C1_); \
        const GAS int* gi_ = (const GAS int*)gidx + (pm_) * 256; const int r00_ = gi_[R0_], r01_ = gi_[R1_], r10_ = gi_[128 + R0_], r11_ = gi_[128 + R1_];     \
        *(LAS u32x4*)(xl + (set) * 8192 + xoffA) = (u32x4){(unsigned)(r00_ * lda + C0_ * 2), (unsigned)(r01_ * lda + C1_ * 2), (unsigned)(r10_ * lda + C0_ * 2), (unsigned)(r11_ * lda + C1_ * 2)}; } } while (0)
#define PG8_SA(b, h) (((b) * 2 + (h)) * HTB)
#define PG8_SB(b, h) ((4 + (b) * 2 + (h)) * HTB)
#define PG8_STAGE(bufoff, gbase, voff) do { _Pragma("unroll") for (int _i = 0; _i < 2; ++_i) \
        __builtin_amdgcn_global_load_lds((const unsigned*)((const char*)(gbase) + (voff)[_i]), (LAS unsigned*)(lds + (bufoff) + ldsw + _i * 8192), 16, 0, 0); } while (0)
#define PG8_GOFF(h_, set_) u32x2 go_ = {0u, 0u}; if constexpr (GATHER) go_ = *(const LAS u32x2*)(xl + (set_) * 8192 + xoffA + (h_) * 8)
#define PG8_STAGE_A(bufoff, gbase, h_, set_) do { if constexpr (GATHER) { \
        __builtin_amdgcn_global_load_lds((const unsigned*)((const char*)(gbase) + go_.x), (LAS unsigned*)(lds + (bufoff) + ldsw), 16, 0, 0); \
        __builtin_amdgcn_global_load_lds((const unsigned*)((const char*)(gbase) + go_.y), (LAS unsigned*)(lds + (bufoff) + ldsw + 8192), 16, 0, 0); } \
      else { PG8_STAGE(bufoff, (const char*)(gbase) + (h_) * hstepA, voffA); } } while (0)
#define PG8_LDA(dst, b, h) do { _Pragma("unroll") for (int m = 0; m < 4; ++m) _Pragma("unroll") for (int k = 0; k < 2; ++k) dst[m][k] = *(const LAS bf16x8*)(lds + PG8_SA(b, h) + aoff + m * 2048 + k * 1024); } while (0)
#define PG8_LDB(dst, b, h) do { _Pragma("unroll") for (int n = 0; n < 2; ++n) _Pragma("unroll") for (int k = 0; k < 2; ++k) dst[n][k] = *(const LAS bf16x8*)(lds + PG8_SB(b, h) + boff + n * 2048 + k * 1024); } while (0)
#define PG8_MMA(ai, bj, At, Bt) do { __builtin_amdgcn_s_setprio(1); _Pragma("unroll") for (int m = 0; m < 4; ++m) _Pragma("unroll") for (int n = 0; n < 2; ++n) _Pragma("unroll") for (int k = 0; k < 2; ++k) \
        acc[ai][bj][m][n] = __builtin_amdgcn_mfma_f32_16x16x32_bf16(Bt[n][k], At[m][k], acc[ai][bj][m][n], 0, 0, 0); __builtin_amdgcn_s_setprio(0); } while (0)
#define PG8_WAIT_V(n) asm volatile("s_waitcnt vmcnt(" #n ")" ::: "memory")
#define PG8_WAIT_L(n) asm volatile("s_waitcnt lgkmcnt(" #n ")" ::: "memory")
#define PG8_BAR __builtin_amdgcn_s_barrier()
#define PG8_SCHED __builtin_amdgcn_sched_barrier(0)
    Unit cur, nxt; int ui = 0;
    if (!S.next(0, cur)) return;
    EpiCtx ctx; ctx.wr = wr; ctx.wc = wc; ctx.wid = wid; ctx.xl = xl;
    f32x4 acc[2][2][4][2];
#pragma unroll
    for (int a = 0; a < 2; ++a)
#pragma unroll
        for (int b = 0; b < 2; ++b)
#pragma unroll
            for (int m = 0; m < 4; ++m)
#pragma unroll
                for (int n = 0; n < 2; ++n) acc[a][b][m][n] = (f32x4){0.f, 0.f, 0.f, 0.f};
    bf16x8 At[4][2], B0[2][2], B1[2][2];
    const char* cA = cur.a; const char* cB = cur.b;
    PG8_GSETUP(0, cur.pm);
    const size_t kstepB = BF ? (size_t)BK * ldb : kstep;
    if constexpr (BF) {
        PG8_BISSUE(cB); { PG8_GOFF(0, 0); PG8_STAGE_A(PG8_SA(0, 0), cA, 0, 0); } { PG8_GOFF(1, 0); PG8_STAGE_A(PG8_SA(0, 1), cA, 1, 0); }
        if (wr == 1) PG8_BAR;
        PG8_BWAIT(2); PG8_BCONS(0, 0); PG8_WAIT_L(0); PG8_BAR;
        { PG8_GOFF(0, 0); PG8_STAGE_A(PG8_SA(1, 0), cA + kstep, 0, 0); } PG8_BISSUE(cB + kstepB);
        PG8_WAIT_V(10); PG8_BAR;
    } else if constexpr (SP2) {
        PG8_STAGE(PG8_SB(0, 0), cB, voffB); PG8_STAGE(PG8_SB(0, 1), cB + hstepB, voffB); { PG8_GOFF(0, 0); PG8_STAGE_A(PG8_SA(0, 0), cA, 0, 0); } { PG8_GOFF(1, 0); PG8_STAGE_A(PG8_SA(0, 1), cA, 1, 0); }
        if (wr == 1) PG8_BAR;
        PG8_WAIT_V(2); PG8_BAR;
        PG8_STAGE(PG8_SB(1, 0), cB + kstep, voffB); { PG8_GOFF(0, 0); PG8_STAGE_A(PG8_SA(1, 0), cA + kstep, 0, 0); } PG8_STAGE(PG8_SB(1, 1), cB + hstepB + kstep, voffB);
        PG8_WAIT_V(6); PG8_BAR;
    } else {
        PG8_STAGE(PG8_SB(0, 0), cB, voffB); PG8_STAGE(PG8_SA(0, 0), cA, voffA); PG8_STAGE(PG8_SB(0, 1), cB + hstepB, voffB); PG8_STAGE(PG8_SA(0, 1), cA + hstepA, voffA);
        if (wr == 1) PG8_BAR;
        PG8_WAIT_V(4); PG8_BAR;
        PG8_STAGE(PG8_SB(1, 0), cB + kstep, voffB); PG8_STAGE(PG8_SA(1, 0), cA + kstep, voffA); PG8_STAGE(PG8_SB(1, 1), cB + hstepB + kstep, voffB);
        PG8_WAIT_V(6); PG8_BAR;
    }
    for (;;) {
        const bool has_next = S.next(ui + 1, nxt);
        const char* nA = has_next ? nxt.a : cA; const char* nB = has_next ? nxt.b : cB;
        if (has_next) PG8_GSETUP(gset ^ 1, nxt.pm);
        for (int t = 0; t < nt; t += 2) {
            const bool last = (t == nt - 2);
            const char* a1 = cA + (size_t)(t + 1) * kstep;
            const char* a2 = last ? nA : cA + (size_t)(t + 2) * kstep; const char* b2 = last ? nB : cB + (size_t)(t + 2) * kstepB;
            const char* a3 = a2 + kstep; const char* b3 = b2 + kstepB;
            const int set2 = (last && has_next) ? (gset ^ 1) : gset;
            if constexpr (BF) {
            const int kt2 = last ? 0 : t + 2;
            { PG8_GOFF(1, gset); PG8_LDB(B0, 0, 0); PG8_LDB(B1, 0, 1); PG8_SCHED; PG8_LDA(At, 0, 0); PG8_STAGE_A(PG8_SA(1, 1), a1, 1, gset); }
            PG8_WAIT_V(12); PG8_WAIT_L(0); PG8_BAR; PG8_MMA(0, 0, At, B0); PG8_MMA(0, 1, At, B1); PG8_BAR; PG8_SCHED;
            { PG8_GOFF(0, set2); PG8_LDA(At, 0, 1); PG8_STAGE_A(PG8_SA(0, 0), a2, 0, set2); PG8_SCHED; PG8_BWAIT(4); PG8_BCONS(1, t + 1); PG8_SCHED; PG8_BISSUE(b2); }
            PG8_WAIT_L(0); PG8_BAR; PG8_MMA(1, 0, At, B0); PG8_MMA(1, 1, At, B1); PG8_BAR; PG8_SCHED;
            { PG8_GOFF(1, set2); PG8_LDB(B0, 1, 0); PG8_LDB(B1, 1, 1); PG8_SCHED; PG8_LDA(At, 1, 0); PG8_STAGE_A(PG8_SA(0, 1), a2, 1, set2); }
            PG8_WAIT_V(12); PG8_WAIT_L(0); PG8_BAR; PG8_MMA(0, 0, At, B0); PG8_MMA(0, 1, At, B1); PG8_BAR; PG8_SCHED;
            { PG8_GOFF(0, set2); PG8_LDA(At, 1, 1); PG8_STAGE_A(PG8_SA(1, 0), a3, 0, set2); PG8_SCHED; PG8_BWAIT(4); PG8_BCONS(0, kt2); PG8_SCHED; PG8_BISSUE(b3); }
            PG8_WAIT_L(0); PG8_BAR; PG8_MMA(1, 0, At, B0); PG8_MMA(1, 1, At, B1); PG8_BAR; PG8_SCHED;
            } else if constexpr (SP2) {
            { PG8_GOFF(1, gset); PG8_LDB(B0, 0, 0); PG8_LDB(B1, 0, 1); PG8_SCHED; PG8_LDA(At, 0, 0); PG8_STAGE_A(PG8_SA(1, 1), a1, 1, gset); }
            PG8_WAIT_V(8); PG8_WAIT_L(0); PG8_BAR; PG8_MMA(0, 0, At, B0); PG8_MMA(0, 1, At, B1); PG8_BAR; PG8_SCHED;
            { PG8_GOFF(0, set2); PG8_LDA(At, 0, 1); PG8_STAGE(PG8_SB(0, 0), b2, voffB); PG8_STAGE(PG8_SB(0, 1), b2 + hstepB, voffB); PG8_STAGE_A(PG8_SA(0, 0), a2, 0, set2); }
            PG8_WAIT_V(8); PG8_WAIT_L(0); PG8_BAR; PG8_MMA(1, 0, At, B0); PG8_MMA(1, 1, At, B1); PG8_BAR; PG8_SCHED;
            { PG8_GOFF(1, set2); PG8_LDB(B0, 1, 0); PG8_LDB(B1, 1, 1); PG8_SCHED; PG8_LDA(At, 1, 0); PG8_STAGE_A(PG8_SA(0, 1), a2, 1, set2); }
            PG8_WAIT_V(8); PG8_WAIT_L(0); PG8_BAR; PG8_MMA(0, 0, At, B0); PG8_MMA(0, 1, At, B1); PG8_BAR; PG8_SCHED;
            { PG8_GOFF(0, set2); PG8_LDA(At, 1, 1); PG8_STAGE(PG8_SB(1, 0), b3, voffB); PG8_STAGE(PG8_SB(1, 1), b3 + hstepB, voffB); PG8_STAGE_A(PG8_SA(1, 0), a3, 0, set2); }
            PG8_WAIT_V(8); PG8_WAIT_L(0); PG8_BAR; PG8_MMA(1, 0, At, B0); PG8_MMA(1, 1, At, B1); PG8_BAR; PG8_SCHED;
            } else {
            PG8_LDB(B0, 0, 0); PG8_SCHED; PG8_LDA(At, 0, 0); PG8_STAGE(PG8_SA(1, 1), a1 + hstepA, voffA);
            PG8_WAIT_L(8); PG8_BAR; PG8_WAIT_L(0); PG8_MMA(0, 0, At, B0); PG8_BAR; PG8_SCHED;
            PG8_LDB(B1, 0, 1); PG8_STAGE(PG8_SB(0, 0), b2, voffB);
            PG8_BAR; PG8_WAIT_L(0); PG8_MMA(0, 1, At, B1); PG8_BAR;
            PG8_LDA(At, 0, 1); PG8_STAGE(PG8_SA(0, 0), a2, voffA);
            PG8_BAR; PG8_WAIT_L(0); PG8_MMA(1, 0, At, B0); PG8_BAR; PG8_SCHED;
            PG8_STAGE(PG8_SB(0, 1), b2 + hstepB, voffB);
            PG8_WAIT_V(6); PG8_BAR; PG8_MMA(1, 1, At, B1); PG8_BAR;
            PG8_LDB(B0, 1, 0); PG8_SCHED; PG8_LDA(At, 1, 0); PG8_STAGE(PG8_SA(0, 1), a2 + hstepA, voffA);
            PG8_WAIT_L(8); PG8_BAR; PG8_WAIT_L(0); PG8_MMA(0, 0, At, B0); PG8_BAR; PG8_SCHED;
            PG8_LDB(B1, 1, 1); PG8_STAGE(PG8_SB(1, 0), b3, voffB);
            PG8_BAR; PG8_WAIT_L(0); PG8_MMA(0, 1, At, B1); PG8_BAR;
            PG8_LDA(At, 1, 1); PG8_STAGE(PG8_SA(1, 0), a3, voffA);
            PG8_BAR; PG8_WAIT_L(0); PG8_MMA(1, 0, At, B0); PG8_BAR; PG8_SCHED;
            PG8_STAGE(PG8_SB(1, 1), b3 + hstepB, voffB);
            PG8_WAIT_V(6); PG8_BAR; PG8_MMA(1, 1, At, B1); PG8_BAR;
            }
        }
        PG8_BWAIT(0);
        if constexpr (ALIGN_EPI) { if (wr == 0) PG8_BAR; }
        E(acc, cur, ctx);
        if (!has_next) break;
#pragma unroll
        for (int a = 0; a < 2; ++a)
#pragma unroll
            for (int b = 0; b < 2; ++b)
#pragma unroll
                for (int m = 0; m < 4; ++m)
#pragma unroll
                    for (int n = 0; n < 2; ++n) acc[a][b][m][n] = (f32x4){0.f, 0.f, 0.f, 0.f};
        cur = nxt; cA = nA; cB = nB; ++ui; gset ^= 1;
        if constexpr (ALIGN_EPI) { if (wr == 1) PG8_BAR; }
    }
    PG8_WAIT_V(0);
    if constexpr (!ALIGN_EPI) { if (wr == 0) PG8_BAR; }
    PG8_BAR;
#undef PG8_SA
#undef PG8_SB
#undef PG8_STAGE
#undef PG8_STAGE_A
#undef PG8_GOFF
#undef PG8_GSETUP
#undef PG8_BISSUE
#undef PG8_BWAIT
#undef PG8_BCONS
#undef PG8_LDA
#undef PG8_LDB
#undef PG8_MMA
#undef PG8_WAIT_V
#undef PG8_WAIT_L
#undef PG8_BAR
#undef PG8_SCHED
}
}

constexpr size_t MiB = 1u << 20;
constexpr size_t WS_CTL = 0, CTL_ZERO_BYTES = 1 * MiB;
constexpr size_t WS_WIN_T = 1 * MiB, WS_WF_T = 11 * MiB, WS_WOUT_T = 15 * MiB, WS_WCQ_T = 23 * MiB, WS_WCK_T = 39 * MiB, WS_WCV_T = 55 * MiB, WS_WCO_T = 71 * MiB;
constexpr size_t WS_WP_T = 87 * MiB, WS_DFT = 89 * MiB, WS_ROPE = 105 * MiB, WS_WGU_T = 106 * MiB, WS_WD_T = 234 * MiB;
constexpr size_t WS_HN = 298 * MiB, WS_XB = 330 * MiB, WS_QB = 362 * MiB, WS_KB = 386 * MiB, WS_VB = 394 * MiB, WS_FPQ = 402 * MiB, WS_MIXB = 418 * MiB, WS_QCB = 450 * MiB;
constexpr size_t WS_KCB = 482 * MiB, WS_VTB = 490 * MiB, WS_MEMNB = 498 * MiB, WS_PB = 506 * MiB, WS_XSB = 522 * MiB, WS_ACTB = 586 * MiB, WS_YB = 618 * MiB;
constexpr size_t WS_SSP = 682 * MiB, WS_AFF = 683 * MiB, WS_RANK = 684 * MiB, WS_GATE = 685 * MiB, WS_XALT = 686 * MiB, WS_WGU_T2 = 750 * MiB, WS_WD_T2 = 878 * MiB, WS_FAST_END = 942 * MiB;
constexpr int CW_TMO = 0, CW_CODE = 1, CW_BAR = 4096;
constexpr int RING_OFF = 0, RING_BYTES = 131072, XL_OFF = 131072, XL_BYTES = 16384, LDSCTL_OFF = XL_OFF + XL_BYTES, MISC_OFF = LDSCTL_OFF + 320, LDS_BYTES = 149504;
static_assert(MISC_OFF + 128 <= LDS_BYTES, "LDS map");
constexpr int NWAVES = 8;

typedef GAS unsigned gu32;
#define RLX_AGENT __ATOMIC_RELAXED, __HIP_MEMORY_SCOPE_AGENT

#define XB_TMO      128
#define XB_XCNT(j)  (256  + 64 * (j))
#define XB_XSUB(j)  (1280 + 64 * (j))
#define XB_XGEN(j)  (2304 + 64 * (j))
#define XB_TOP      3328
#define XB_TOPGEN   3392
#define XCD_BAR_WORDS 3456
#define XB_SPIN_CAP (1u << 18)
__device__ __forceinline__ unsigned xb_ld(unsigned* p)              { return __hip_atomic_load(p, __ATOMIC_RELAXED, __HIP_MEMORY_SCOPE_AGENT); }
__device__ __forceinline__ unsigned xb_add(unsigned* p, unsigned v) { return __hip_atomic_fetch_add(p, v, __ATOMIC_RELAXED, __HIP_MEMORY_SCOPE_AGENT); }
__device__ __forceinline__ unsigned xb_xcc_id() { return (unsigned)__builtin_amdgcn_s_getreg((3 << 11) | 20) & 0xFu; }
#define XB_SPIN(cond, bar) do { unsigned _sp = 0; while (cond) { __builtin_amdgcn_s_sleep(1); \
    if ((++_sp & 255u) == 0u) { if (xb_ld(&(bar)[XB_TMO])) break; if (_sp > XB_SPIN_CAP) { atomicAdd(&(bar)[XB_TMO], 1u); break; } } } } while (0)
struct XcdBarrier { unsigned* bar; unsigned x; volatile LAS unsigned* st; int wave; };
__device__ __forceinline__ XcdBarrier xcd_barrier_post(unsigned* bar, volatile LAS unsigned* st, int wave) {
    XcdBarrier b; b.bar = bar; b.x = xb_xcc_id(); b.st = st; b.wave = wave;
    if (wave == 0 && lane_id() == 0) (void)xb_add(&bar[XB_XCNT(b.x)], 1u);
    return b;
}
__device__ __forceinline__ void xcd_barrier_complete(unsigned* bar, unsigned x, unsigned& nloc, unsigned& nx) {
    const unsigned G = gridDim.x * gridDim.y * gridDim.z;
    unsigned sum, cnt, mine, sp = 0u;
    for (;;) {
        sum = 0u; cnt = 0u; mine = 0u;
#pragma unroll
        for (unsigned j = 0; j < 16; ++j) { const unsigned c = xb_ld(&bar[XB_XCNT(j)]); sum += c; cnt += (c > 0u) ? 1u : 0u; mine = (j == x) ? c : mine; }
        if (sum == G) break;
        __builtin_amdgcn_s_sleep(1);
        if ((++sp & 255u) == 0u) { if (xb_ld(&bar[XB_TMO])) break; if (sp > XB_SPIN_CAP) { atomicAdd(&bar[XB_TMO], 1u); break; } }
    }
    nloc = mine > 0u ? mine : 1u; nx = cnt > 0u ? cnt : 1u;
}
__device__ __forceinline__ void xcd_barrier(const XcdBarrier& b) {
    asm volatile("s_waitcnt vmcnt(0)" ::: "memory");
    __syncthreads();
    if (b.wave == 0 && lane_id() == 0) {
        unsigned* bar = b.bar;
        __builtin_amdgcn_s_waitcnt(0);
        unsigned nloc = b.st[0], nx = b.st[1];
        if (nloc == 0u) { xcd_barrier_complete(bar, b.x, nloc, nx); b.st[0] = nloc; b.st[1] = nx; }
        const unsigned old = xb_add(&bar[XB_XSUB(b.x)], 1u);
        const unsigned gen = old / nloc;
        if (old + 1u == (gen + 1u) * nloc) {
            __builtin_amdgcn_fence(__ATOMIC_RELEASE, "agent");
            asm volatile("s_waitcnt vmcnt(0)" ::: "memory");
            const unsigned og = xb_add(&bar[XB_TOP], 1u);
            const unsigned tg = og / nx;
            if (og + 1u == (tg + 1u) * nx) xb_add(&bar[XB_TOPGEN], 1u);
            else XB_SPIN(xb_ld(&bar[XB_TOPGEN]) == tg, bar);
            __builtin_amdgcn_fence(__ATOMIC_ACQUIRE, "agent");
            xb_add(&bar[XB_XGEN(b.x)], 1u);
            asm volatile("s_waitcnt vmcnt(0)" ::: "memory");
        } else {
            XB_SPIN(xb_ld(&bar[XB_XGEN(b.x)]) == gen, bar);
            __builtin_amdgcn_fence(__ATOMIC_ACQUIRE, "agent");
            asm volatile("s_waitcnt vmcnt(0)" ::: "memory");
        }
    }
    __syncthreads();
}

struct Args { const float* in[22]; float* out; unsigned char* ws; int ph_lo, ph_hi, li, pad; };
struct Frame {
    LAS unsigned char* lds; volatile LAS unsigned* MISC; gu32* ctl;
    int wave, vcu, G;
    unsigned char* ws;
};
__device__ __forceinline__ float wave_sum(float v) {
#pragma unroll
    for (int o = 1; o < 64; o <<= 1) v += __shfl_xor(v, o);
    return v;
}
struct TrDesc { const float* W; const float* gain; bf16_t* WT; int ldw, ldt, k0, n0; long drow0; };
__device__ __forceinline__ void tr_load(const TrDesc& d, f32x4 (&v)[16], int lane) {
    const int lr = lane >> 4, lc = (lane & 15) * 4;
#pragma unroll
    for (int i = 0; i < 16; ++i) v[i] = __builtin_nontemporal_load((const GAS f32x4*)(d.W + (size_t)(d.k0 + 4 * i + lr) * d.ldw + d.n0 + lc));
}
#ifndef TRV
#define TRV 0
#endif
template <int V> __device__ __forceinline__ void tr_finish(const TrDesc& d, const f32x4 (&v)[16], LAS float* scr, int lane) {
    const int lr = lane >> 4, lc = (lane & 15) * 4;
    if (V == 1) { f32x4 s = v[0]; for (int i = 1; i < 16; ++i) s = s + v[i]; if (s.x == 1.2345e30f) *(GAS f32x4*)(d.WT) = s; return; }
#pragma unroll
    for (int i = 0; i < 16; ++i) { const int kk = 4 * i + lr; f32x4 x = v[i]; if (d.gain) x = x * d.gain[d.k0 + kk];
        LAS float* s = scr + kk * 65 + lc; s[0] = x.x; s[1] = x.y; s[2] = x.z; s[3] = x.w; }
    LDS_WAIT(); asm volatile("" ::: "memory");
    const int c = lane & 7;
#pragma unroll
    for (int j = 0; j < 8; ++j) { const int n = (lane >> 3) + 8 * j; const LAS float* s = scr + (8 * c) * 65 + n;
        u32x4 o; o.x = cvtpk(s[0 * 65], s[1 * 65]); o.y = cvtpk(s[2 * 65], s[3 * 65]); o.z = cvtpk(s[4 * 65], s[5 * 65]); o.w = cvtpk(s[6 * 65], s[7 * 65]);
        if (V == 0 || o.x == 0x12345678u) __builtin_nontemporal_store(o, (GAS u32x4*)(d.WT + (size_t)(d.drow0 + n) * d.ldt + d.k0 + 8 * c)); }
    LDS_WAIT(); asm volatile("" ::: "memory");
}
#ifndef TR_PIPE
#define TR_PIPE 0
#endif
constexpr int TR_DENSE = 32 * 20 + 5 * 32 * 16, TR_DEFER = 4 * 32 * 16 + 32 * 4, TR_EXPERT = NE * 512;
__device__ __forceinline__ TrDesc tr_desc(karg_t ka, unsigned char* ws, int it, int mode) {
    TrDesc d; d.gain = nullptr;
    constexpr int I_IN = 32 * 20, I_SQ = 32 * 16;
    if (mode == 0 || mode == 3) {
        int r = it;
        if (mode == 0) {
            if (r < I_IN) { d.W = KIN(ka, 3); d.ldw = INW; d.WT = (bf16_t*)(ws + WS_WIN_T); d.ldt = DM; d.k0 = (r / 20) * 64; d.n0 = (r % 20) * 128; d.drow0 = d.n0; return d; } r -= I_IN;
            if (r < I_SQ) { d.W = KIN(ka, 7); d.ldw = DM; d.WT = (bf16_t*)(ws + WS_WOUT_T); d.ldt = DM; d.k0 = (r / 16) * 64; d.n0 = (r % 16) * 128; d.drow0 = d.n0; return d; } r -= I_SQ;
        }
        if (r < 4 * I_SQ) { const int j = r / I_SQ, q = r % I_SQ, layer = mode == 0 ? 0 : 1, wsel = mode == 0 ? j : (j == 0 ? 1 : j == 1 ? 2 : j == 2 ? 0 : 3);
            d.W = KIN(ka, 12 + wsel) + (size_t)layer * DM * DM; d.ldw = DM; if (wsel == 0) d.gain = KIN(ka, 10) + layer * DM;
            d.WT = (bf16_t*)(ws + (wsel == 0 ? WS_WCQ_T : wsel == 1 ? WS_WCK_T : wsel == 2 ? WS_WCV_T : WS_WCO_T) + (size_t)layer * DM * DM * 2); d.ldt = DM;
            d.k0 = (q / 16) * 64; d.n0 = (q % 16) * 128; d.drow0 = d.n0; return d; } r -= 4 * I_SQ;
        d.W = KIN(ka, 8); d.ldw = 512; d.WT = (bf16_t*)(ws + WS_WP_T); d.ldt = DM; d.k0 = (r / 4) * 64; d.n0 = (r % 4) * 128; d.drow0 = d.n0; return d;
    }
    const int layer = mode - 1;
    const int e = it / 512, r = it % 512; const size_t eo = (size_t)(layer * NE + e);
    { const int up = r >> 8, q = r & 255, kb = q >> 3, nb = q & 7, n0 = nb * 128;
        d.W = (up ? KIN(ka, 19) : KIN(ka, 18)) + eo * DM * EFF; d.ldw = EFF; d.gain = KIN(ka, 16) + layer * DM;   d.WT = (bf16_t*)(ws + (layer ? WS_WGU_T2 : WS_WGU_T)) + (size_t)e * 2048 * 2048; d.ldt = 2048;
        d.k0 = kb * 64; d.n0 = n0; d.drow0 = (long)(n0 >> 7) * 256 + up * 128;
    }
    return d;
}
template <int V = 0> __device__ __forceinline__ void tr_span(const Frame& F, karg_t ka, unsigned char* ws, int mode, int first, int stride, int cnt) {
    const int lane = lane_id(); LAS float* scr = (LAS float*)(F.lds + RING_OFF + F.wave * 16640);
    if (cnt <= 0) return;
    f32x4 va[16], vb[16];
    TrDesc da = tr_desc(ka, ws, first, mode), db = da; db.n0 += 64; db.drow0 += 64;
    tr_load(da, va, lane); tr_load(db, vb, lane);
    for (int j = 0; j < cnt; ++j) {
        const bool more = j + 1 < cnt; TrDesc na = da, nb = db;
        if (more) { na = tr_desc(ka, ws, first + stride * (j + 1), mode); nb = na; nb.n0 += 64; nb.drow0 += 64; }
        tr_finish<V>(da, va, scr, lane); if (more) tr_load(na, va, lane);
        tr_finish<V>(db, vb, scr, lane); if (more) tr_load(nb, vb, lane);
        da = na; db = nb;
    }
}
__device__ __forceinline__ void rms_row_to_bf16(const float* xrow, const float* __restrict__ gain, bf16_t* orow, int lane) {
    const GAS f32x4* xr = (const GAS f32x4*)xrow + lane; const f32x4* gr = (const f32x4*)gain + lane;
    f32x4 v[8]; float s = 0.f;
#pragma unroll
    for (int j = 0; j < 8; ++j) { v[j] = xr[64 * j]; s += (v[j].x * v[j].x + v[j].y * v[j].y) + (v[j].z * v[j].z + v[j].w * v[j].w); }
    const float r = rsqrtf(wave_sum(s) * (1.f / DM) + EPS);
    GAS u32x2* o8 = (GAS u32x2*)orow + lane;
#pragma unroll
    for (int j = 0; j < 8; ++j) { const f32x4 g = gr[64 * j]; u32x2 w; w.x = cvtpk(v[j].x * r * g.x, v[j].y * r * g.y); w.y = cvtpk(v[j].z * r * g.z, v[j].w * r * g.w); o8[64 * j] = w; }
}

__device__ __forceinline__ void rms_rows2_to_bf16(const float* x0, const float* x1, const float* __restrict__ gain, bf16_t* o0, bf16_t* o1, int lane) {
    f32x4 a[4][2], b[4][2]; float sa = 0.f, sb = 0.f;
#pragma unroll
    for (int j = 0; j < 4; ++j) { const int c0 = 8 * (lane + 64 * j); a[j][0] = *(const GAS f32x4*)(x0 + c0); a[j][1] = *(const GAS f32x4*)(x0 + c0 + 4); b[j][0] = *(const GAS f32x4*)(x1 + c0); b[j][1] = *(const GAS f32x4*)(x1 + c0 + 4); }
#pragma unroll
    for (int j = 0; j < 4; ++j)
#pragma unroll
        for (int q = 0; q < 2; ++q) { sa += (a[j][q].x * a[j][q].x + a[j][q].y * a[j][q].y) + (a[j][q].z * a[j][q].z + a[j][q].w * a[j][q].w); sb += (b[j][q].x * b[j][q].x + b[j][q].y * b[j][q].y) + (b[j][q].z * b[j][q].z + b[j][q].w * b[j][q].w); }
    const float ra = rsqrtf(wave_sum(sa) * (1.f / DM) + EPS), rb = rsqrtf(wave_sum(sb) * (1.f / DM) + EPS);
#pragma unroll
    for (int j = 0; j < 4; ++j) { const int c0 = 8 * (lane + 64 * j); const f32x4 g0 = *(const f32x4*)(gain + c0), g1 = *(const f32x4*)(gain + c0 + 4);
        *(GAS u32x4*)(o0 + c0) = (u32x4){cvtpk(a[j][0].x * ra * g0.x, a[j][0].y * ra * g0.y), cvtpk(a[j][0].z * ra * g0.z, a[j][0].w * ra * g0.w), cvtpk(a[j][1].x * ra * g1.x, a[j][1].y * ra * g1.y), cvtpk(a[j][1].z * ra * g1.z, a[j][1].w * ra * g1.w)};
        *(GAS u32x4*)(o1 + c0) = (u32x4){cvtpk(b[j][0].x * rb * g0.x, b[j][0].y * rb * g0.y), cvtpk(b[j][0].z * rb * g0.z, b[j][0].w * rb * g0.w), cvtpk(b[j][1].x * rb * g1.x, b[j][1].y * rb * g1.y), cvtpk(b[j][1].z * rb * g1.z, b[j][1].w * rb * g1.w)}; }
}

__device__ __forceinline__ void p0_prologue(Frame& F, karg_t ka, unsigned char* ws) {
    const float* x = KIN(ka, 0); const float* mem = KIN(ka, 1); const float* mix_norm = KIN(ka, 2); const float* w_in = KIN(ka, 3);
    const float* w_four = KIN(ka, 6); const float* w_out = KIN(ka, 7); const float* pool_w = KIN(ka, 8); const float* cross_norm = KIN(ka, 10); const float* mem_norm = KIN(ka, 11);
    const int gw = F.vcu * NWAVES + F.wave, NGW = F.G * NWAVES;
    const int p_lane = lane_id(), p_tid = F.wave * 64 + p_lane;
    { LAS float* tab = (LAS float*)(F.lds + RING_OFF);
      for (int m = p_tid; m < 2048; m += 512) tab[m] = cosf(6.283185307179586f * (float)m * (1.0f / 2048.0f));
      __syncthreads();
      bf16_t* DFT = (bf16_t*)(ws + WS_DFT);
      for (int row = F.vcu * 8; row < 2048; row += F.G * 8)
          for (int rr = 0; rr < 8; ++rr) { const int k1 = row + rr; if (k1 >= 2048) break;
              { const int c0 = p_tid * 8; const int which = c0 >> 11, s0 = c0 & 2047; unsigned w[4];
#pragma unroll
                for (int j = 0; j < 4; ++j) { const int ma = (k1 * (s0 + 2 * j)) & 2047, mb = (k1 * (s0 + 2 * j + 1)) & 2047;
                    w[j] = cvtpk(tab[(ma - which * 512) & 2047], tab[(mb - which * 512) & 2047]); }
                *(GAS u32x4*)(DFT + (size_t)k1 * 4096 + c0) = (u32x4){w[0], w[1], w[2], w[3]}; } }
      __syncthreads(); }
    { float* RC = (float*)(ws + WS_ROPE); float* RS = RC + SEQ * 64;
      for (int i = F.vcu * 512 + p_tid; i < SEQ * 64; i += F.G * 512) { const int t = i >> 6, p = i & 63; const int pos = (p < 32) ? (t >> 6) : (t & 63); const int j = p & 31;
          const float inv = 1.0f / powf(10000.0f, (float)(2 * j) / 64.0f); const float ang = (float)pos * inv; RC[i] = cosf(ang); RS[i] = sinf(ang); } }
    { u32x4* RB = (u32x4*)(ws + WS_AFF + 512 * 1024);
      for (int i = F.vcu * 512 + p_tid; i < 2 * 64 * 64; i += F.G * 512) { const int layer = i >> 12, ks = (i >> 6) & 63, ln = i & 63, e = ln & 15, k0 = 32 * ks + 8 * (ln >> 4);
          const float* Wr = KIN(ka, 17) + (size_t)layer * DM * NE; const float* gn = KIN(ka, 16) + layer * DM; float w[8], lo[8];
#pragma unroll
          for (int j = 0; j < 8; ++j) { w[j] = gn[k0 + j] * Wr[(size_t)(k0 + j) * NE + e]; }
          u32x4 hi4 = {cvtpk(w[0], w[1]), cvtpk(w[2], w[3]), cvtpk(w[4], w[5]), cvtpk(w[6], w[7])};
          const unsigned hh[4] = {hi4.x, hi4.y, hi4.z, hi4.w};
#pragma unroll
          for (int j = 0; j < 4; ++j) { lo[2 * j] = w[2 * j] - __uint_as_float(hh[j] << 16); lo[2 * j + 1] = w[2 * j + 1] - __uint_as_float(hh[j] & 0xffff0000u); }
          RB[(size_t)(layer * 2 + 0) * 4096 + ks * 64 + ln] = hi4;
          RB[(size_t)(layer * 2 + 1) * 4096 + ks * 64 + ln] = (u32x4){cvtpk(lo[0], lo[1]), cvtpk(lo[2], lo[3]), cvtpk(lo[4], lo[5]), cvtpk(lo[6], lo[7])}; } }
    { LAS float* Mw = (LAS float*)(F.lds + RING_OFF); LAS float* t128 = Mw + 128 * 32;
      bf16_t* WF = (bf16_t*)(ws + WS_WF_T);
      for (int it = F.vcu; it < 256; it += F.G) {
          const int which = it >> 7, g = (it >> 5) & 3, d0 = ((it >> 3) & 3) * 32, k0 = (it & 7) * 256;
          if (p_tid < 128) t128[p_tid] = cosf(6.283185307179586f * (float)p_tid * (1.0f / 128.0f));
          __syncthreads();
          { const int c = p_tid >> 2, dd = (p_tid & 3) * 8; float o[8] = {0.f, 0.f, 0.f, 0.f, 0.f, 0.f, 0.f, 0.f};
#pragma unroll 16
            for (int k2 = 0; k2 < 128; ++k2) { const int m = (c * k2) & 127; const float tv = which ? -t128[(m - 32) & 127] : t128[m];
                const float* wr_ = w_four + ((size_t)g * 128 + k2) * 128 + d0 + dd; const f32x4 w0 = *(const f32x4*)wr_, w1 = *(const f32x4*)(wr_ + 4);
                o[0] += tv * w0.x; o[1] += tv * w0.y; o[2] += tv * w0.z; o[3] += tv * w0.w; o[4] += tv * w1.x; o[5] += tv * w1.y; o[6] += tv * w1.z; o[7] += tv * w1.w; }
#pragma unroll
            for (int j = 0; j < 8; ++j) Mw[c * 32 + dd + j] = o[j] * (1.0f / 512.0f); }
          __syncthreads();
          { const int kp = p_tid & 127, dq = p_tid >> 7, k = k0 + 2 * kp; float o0[8] = {0.f, 0.f, 0.f, 0.f, 0.f, 0.f, 0.f, 0.f}, o1[8] = {0.f, 0.f, 0.f, 0.f, 0.f, 0.f, 0.f, 0.f};
            const float* r0 = w_in + (size_t)k * INW + 2560 + g * 128; const float* r1 = r0 + INW;
#pragma unroll 8
            for (int c4 = 0; c4 < 32; ++c4) { const f32x4 a = *(const f32x4*)(r0 + 4 * c4), b = *(const f32x4*)(r1 + 4 * c4); const float av[4] = {a.x, a.y, a.z, a.w}, bv[4] = {b.x, b.y, b.z, b.w};
#pragma unroll
                for (int cc = 0; cc < 4; ++cc) { const LAS float* mr = Mw + (4 * c4 + cc) * 32 + dq * 8;
#pragma unroll
                    for (int j = 0; j < 8; ++j) { o0[j] += av[cc] * mr[j]; o1[j] += bv[cc] * mr[j]; } } }
#pragma unroll
            for (int j = 0; j < 8; ++j) *(GAS unsigned*)(WF + (size_t)(which * 512 + g * 128 + d0 + dq * 8 + j) * DM + k) = cvtpk(o0[j], o1[j]); }
          __syncthreads(); } }
    { const int n = (TR_DENSE - gw + NGW - 1) / NGW; tr_span(F, ka, ws, 0, gw, NGW, n > 0 ? n : 0); }
    __syncthreads();
    for (int m = 2 * gw; m < NTOK; m += 2 * NGW) rms_rows2_to_bf16(x + (size_t)m * DM, x + (size_t)(m + 1) * DM, mix_norm, (bf16_t*)(ws + WS_HN) + (size_t)m * DM, (bf16_t*)(ws + WS_HN) + (size_t)(m + 1) * DM, p_lane);
    for (int m = gw; m < 2 * NB * MEML; m += NGW) { const int l = m / (NB * MEML), r = m % (NB * MEML);
        rms_row_to_bf16(mem + (size_t)r * DM, mem_norm + l * DM, (bf16_t*)(ws + WS_MEMNB) + (size_t)m * DM, p_lane); }
}

struct MapLin { const char* A; const char* B; size_t as, bs; __device__ __forceinline__ void operator()(pg8::Unit& u) const { u.a = A + (size_t)u.pm * as; u.b = B + (size_t)u.pn * bs; } };

struct EpiQKV {
    static constexpr bool PERM = true;
    bf16_t* Q; bf16_t* K; bf16_t* V; const float* qg; const float* kg; const float* RC; const float* RS;
    __device__ __forceinline__ void operator()(f32x4 (&acc)[2][2][4][2], const pg8::Unit& u, const pg8::EpiCtx& c) const { const int e_lane = lane_id(), e_fr = e_lane & 15, e_fq = e_lane >> 4;
        const int pn = u.pn, hc = c.wc * 32 + e_fq * 8, rl0 = c.wr * 64 + e_fr;
        if (pn >= 8) {
            bf16_t* base = V + (size_t)(u.pm * 256 + rl0) * KVW + (pn - 8) * 256 + hc;
#pragma unroll
            for (int ai = 0; ai < 2; ++ai)
#pragma unroll
                for (int m = 0; m < 4; ++m) { bf16_t* rowp = base + (size_t)(ai * 128 + m * 16) * KVW;
#pragma unroll
                    for (int bj = 0; bj < 2; ++bj) { const f32x4 v0 = acc[ai][bj][m][0], v1 = acc[ai][bj][m][1];
                        st16((rowp + bj * 128), (u32x4){cvtpk(v0.x, v0.y), cvtpk(v0.z, v0.w), cvtpk(v1.x, v1.y), cvtpk(v1.z, v1.w)}); } }
            return;
        }
        LAS float* part = (LAS float*)c.xl;
#pragma unroll
        for (int ai = 0; ai < 2; ++ai)
#pragma unroll
            for (int m = 0; m < 4; ++m)
#pragma unroll
                for (int bj = 0; bj < 2; ++bj) { const f32x4 v0 = acc[ai][bj][m][0], v1 = acc[ai][bj][m][1];
                    float s = (v0.x * v0.x + v0.y * v0.y) + (v0.z * v0.z + v0.w * v0.w) + (v1.x * v1.x + v1.y * v1.y) + (v1.z * v1.z + v1.w * v1.w);
                    s += __shfl_xor(s, 16); s += __shfl_xor(s, 32);
                    if (e_fq == 0) part[((ai * 128 + rl0 + m * 16) * 2 + bj) * 4 + c.wc] = s; }
        WG_BAR();
        const float* gain = pn < 6 ? qg : kg;
        const f32x4 g0 = *(const f32x4*)(gain + hc), g1 = *(const f32x4*)(gain + hc + 4);
        bf16_t* O = pn < 6 ? Q : K; const int ld = pn < 6 ? AW : KVW; const int colbase = (pn < 6 ? pn : pn - 6) * 256 + hc;
#pragma unroll
        for (int ai = 0; ai < 2; ++ai)
#pragma unroll
            for (int m = 0; m < 4; ++m) { const int rl = ai * 128 + rl0 + m * 16, row = u.pm * 256 + rl, sp = row & (SEQ - 1);
                const f32x4 cs = *(const f32x4*)(RC + sp * 64 + (hc >> 1)), sn = *(const f32x4*)(RS + sp * 64 + (hc >> 1));
#pragma unroll
                for (int bj = 0; bj < 2; ++bj) { const f32x4 p4 = *(const LAS f32x4*)(part + (rl * 2 + bj) * 4);
                    const float r = rsqrtf(((p4.x + p4.y) + (p4.z + p4.w)) * (1.0f / 128.0f) + EPS);
                    const f32x4 v0 = acc[ai][bj][m][0] * r * g0, v1 = acc[ai][bj][m][1] * r * g1;
                    u32x4 w; w.x = cvtpk(v0.x * cs.x - v0.y * sn.x, v0.x * sn.x + v0.y * cs.x); w.y = cvtpk(v0.z * cs.y - v0.w * sn.y, v0.z * sn.y + v0.w * cs.y);
                    w.z = cvtpk(v1.x * cs.z - v1.y * sn.z, v1.x * sn.z + v1.y * cs.z); w.w = cvtpk(v1.z * cs.w - v1.w * sn.w, v1.z * sn.w + v1.w * cs.w);
                    st16((O + (size_t)row * ld + colbase + bj * 128), w); } }
    }
};


template <class AddrF> struct EpiStore {
    static constexpr bool PERM = true; AddrF f;
    __device__ __forceinline__ void operator()(f32x4 (&acc)[2][2][4][2], const pg8::Unit& u, const pg8::EpiCtx& c) const { const int e_lane = lane_id(), e_fr = e_lane & 15, e_fq = e_lane >> 4;
        const int hc = c.wc * 32 + e_fq * 8, rl0 = c.wr * 64 + e_fr;
#pragma unroll
        for (int ai = 0; ai < 2; ++ai)
#pragma unroll
            for (int m = 0; m < 4; ++m)
#pragma unroll
                for (int bj = 0; bj < 2; ++bj) { const f32x4 v0 = acc[ai][bj][m][0], v1 = acc[ai][bj][m][1];
                    st16(f(u, ai * 128 + rl0 + m * 16, bj * 128 + hc), (u32x4){cvtpk(v0.x, v0.y), cvtpk(v0.z, v0.w), cvtpk(v1.x, v1.y), cvtpk(v1.z, v1.w)}); }
    }
};
struct AddrF1 { bf16_t* FPQ; __device__ __forceinline__ bf16_t* operator()(const pg8::Unit& u, int rl, int tc) const {
    const int r = u.pm * 256 + rl, which = r >> 9, n = r & 511, cidx = u.pn * 256 + tc, b = cidx >> 11, s = cidx & 2047; return FPQ + (((size_t)(b * 512 + n) * 2 + which) * 2048 + s); } };
struct AddrF2 { bf16_t* MIX; __device__ __forceinline__ bf16_t* operator()(const pg8::Unit& u, int rl, int tc) const {
    const int row = (u.pn >> 1) * 2048 + u.pm * 256 + rl, col = AW + (u.pn & 1) * 256 + tc; return MIX + (size_t)row * DM + col; } };

template <bool BF32> struct EpiResB {
    static constexpr bool PERM = true;
    const void* base; bf16_t* xo; float* ssp; const float* cscale; bf16_t* xg; const float* gv;
    __device__ __forceinline__ void operator()(f32x4 (&acc)[2][2][4][2], const pg8::Unit& u, const pg8::EpiCtx& c) const { const int e_lane = lane_id(), e_fr = e_lane & 15, e_fq = e_lane >> 4;
        const int hc = c.wc * 32 + e_fq * 8, rl0 = c.wr * 64 + e_fr;
        LAS float* part = (LAS float*)c.xl;
#pragma unroll
        for (int ai = 0; ai < 2; ++ai) {
            f32x4 bf0[4][2], bf1[4][2]; u32x4 bb[4][2];
#pragma unroll
            for (int m = 0; m < 4; ++m)
#pragma unroll
                for (int bj = 0; bj < 2; ++bj) { const size_t off = (size_t)(u.pm * 256 + ai * 128 + rl0 + m * 16) * DM + u.pn * 256 + bj * 128 + hc;
                    if (BF32) { bf0[m][bj] = *(const f32x4*)((const float*)base + off); bf1[m][bj] = *(const f32x4*)((const float*)base + off + 4); }
                    else bb[m][bj] = *(const u32x4*)((const bf16_t*)base + off); }
#pragma unroll
            for (int m = 0; m < 4; ++m) { const int rl = ai * 128 + rl0 + m * 16; float s = 0.f;
#pragma unroll
                for (int bj = 0; bj < 2; ++bj) { const int col = u.pn * 256 + bj * 128 + hc; const size_t off = (size_t)(u.pm * 256 + rl) * DM + col;
                    f32x4 v0 = acc[ai][bj][m][0], v1 = acc[ai][bj][m][1];
                    if (cscale) { v0 = v0 * *(const f32x4*)(cscale + col); v1 = v1 * *(const f32x4*)(cscale + col + 4); }
                    if (BF32) { v0 = v0 + bf0[m][bj]; v1 = v1 + bf1[m][bj]; }
                    else { const u32x4 b = bb[m][bj];
                        v0.x += __uint_as_float(b.x << 16); v0.y += __uint_as_float(b.x & 0xffff0000u); v0.z += __uint_as_float(b.y << 16); v0.w += __uint_as_float(b.y & 0xffff0000u);
                        v1.x += __uint_as_float(b.z << 16); v1.y += __uint_as_float(b.z & 0xffff0000u); v1.z += __uint_as_float(b.w << 16); v1.w += __uint_as_float(b.w & 0xffff0000u); }
                    st16((xo + off), (u32x4){cvtpk(v0.x, v0.y), cvtpk(v0.z, v0.w), cvtpk(v1.x, v1.y), cvtpk(v1.z, v1.w)});
                    if (xg) { const f32x4 g0 = *(const f32x4*)(gv + col), g1 = *(const f32x4*)(gv + col + 4);
                        st16((xg + off), (u32x4){cvtpk(v0.x * g0.x, v0.y * g0.y), cvtpk(v0.z * g0.z, v0.w * g0.w), cvtpk(v1.x * g1.x, v1.y * g1.y), cvtpk(v1.z * g1.z, v1.w * g1.w)}); }
                    if (ssp) s += ((v0.x * v0.x + v0.y * v0.y) + (v0.z * v0.z + v0.w * v0.w)) + ((v1.x * v1.x + v1.y * v1.y) + (v1.z * v1.z + v1.w * v1.w)); }
                if (ssp) { s += __shfl_xor(s, 16); s += __shfl_xor(s, 32); if (e_fq == 0) part[rl * 4 + c.wc] = s; } }
            asm volatile("" ::: "memory"); }
        if (ssp) { WG_BAR();
            if (e_lane < 32) { const int row = c.wid * 32 + e_lane; const f32x4 p4 = *(const LAS f32x4*)(part + row * 4);
                ssp[(size_t)(u.pm * 256 + row) * 8 + u.pn] = (p4.x + p4.y) + (p4.z + p4.w); }
            WG_BAR(); }
    }
};

namespace attn {
using s16x4 = __attribute__((ext_vector_type(4))) short;
using f32x16 = __attribute__((ext_vector_type(16))) float;
constexpr int D = 128, NW = 8, QBLK = 32, KVBLK = 64;
constexpr float SCALE = 0.088388347648318440f;
constexpr float THR = 8.f;
#ifndef ATT_SDEPTH
#define ATT_SDEPTH 1
#endif
constexpr int LDQ = AW, LDK = KVW, LDO = DM;
constexpr size_t SHM_V = KVBLK * D * 2, SHM_K = KVBLK * D * 2, SHM_ATTN = 2 * SHM_V + 2 * SHM_K + NW * 64 * 4;
#define KSWZ(row, colB) ((row) * 256 + ((colB) ^ (((row) & 7) << 4)))
#define SBAR() __builtin_amdgcn_sched_barrier(0)
__device__ __forceinline__ int crow(int r, int hi) { return (r & 3) + 8 * (r >> 2) + 4 * hi; }
__device__ __forceinline__ unsigned cvtpk_a(float lo, float hi) { unsigned r; asm volatile("v_cvt_pk_bf16_f32 %0, %1, %2" : "=v"(r) : "v"(lo), "v"(hi)); return r; }
template <bool FM> __device__ __forceinline__ void partialSM(f32x16& p0, f32x16& p1, float& m_reg, float& mn, float& alpha) {
  constexpr float C = SCALE * 1.4426950408889634f;
  if constexpr (FM) { mn = m_reg; alpha = 1.f; const float mnC_ = -mn * C;
    for (int r = 0; r < 16; ++r) p0[r] = fmaf(p0[r], C, mnC_); for (int r = 0; r < 16; ++r) p1[r] = fmaf(p1[r], C, mnC_);
    for (int r = 0; r < 16; ++r) p0[r] = __builtin_amdgcn_exp2f(p0[r]); return; }
  float pmax = p0[0]; for (int r = 1; r < 16; ++r) pmax = fmaxf(pmax, p0[r]); for (int r = 0; r < 16; ++r) pmax = fmaxf(pmax, p1[r]);
  { auto rr = __builtin_amdgcn_permlane32_swap(__float_as_uint(pmax), __float_as_uint(pmax), false, false);
    pmax = fmaxf(__uint_as_float(rr[0]), __uint_as_float(rr[1])); }
  if (__builtin_expect(__all(pmax - m_reg <= THR / SCALE), 1)) { mn = m_reg; alpha = 1.f; }
  else { mn = fmaxf(m_reg, pmax); alpha = __builtin_amdgcn_exp2f((m_reg - mn) * C); m_reg = mn; }
  float mnC = -mn * C;
  for (int r = 0; r < 16; ++r) p0[r] = fmaf(p0[r], C, mnC); for (int r = 0; r < 16; ++r) p1[r] = fmaf(p1[r], C, mnC);
  for (int r = 0; r < 16; ++r) p0[r] = __builtin_amdgcn_exp2f(p0[r]);
}
__device__ __forceinline__ void finishSM(f32x16& p0, f32x16& p1, float alpha, float& l_reg, bf16x8& pa0, bf16x8& pa1, bf16x8& pa2, bf16x8& pa3) {
  for (int r = 0; r < 16; ++r) p1[r] = __builtin_amdgcn_exp2f(p1[r]);
  float ps = 0; for (int r = 0; r < 16; ++r) ps += p0[r]; for (int r = 0; r < 16; ++r) ps += p1[r];
  { auto rr = __builtin_amdgcn_permlane32_swap(__float_as_uint(ps), __float_as_uint(ps), false, false);
    ps = __uint_as_float(rr[0]) + __uint_as_float(rr[1]); }
  l_reg = l_reg * alpha + ps;
#define PK4(P, BASE, OUT) do { unsigned a0 = cvtpk_a(P[BASE + 0], P[BASE + 1]), a1 = cvtpk_a(P[BASE + 2], P[BASE + 3]);   \
    unsigned b0 = cvtpk_a(P[BASE + 4], P[BASE + 5]), b1 = cvtpk_a(P[BASE + 6], P[BASE + 7]);                              \
    auto r0 = __builtin_amdgcn_permlane32_swap(a0, b0, false, false); auto r1 = __builtin_amdgcn_permlane32_swap(a1, b1, false, false); \
    u32x4 w = {r0[0], r1[0], r0[1], r1[1]}; OUT = *reinterpret_cast<bf16x8*>(&w); } while (0)
  PK4(p0, 0, pa0); PK4(p0, 8, pa1); PK4(p1, 0, pa2); PK4(p1, 8, pa3);
#undef PK4
}
__device__ __forceinline__ void qkt(f32x16& p0, f32x16& p1, const bf16_t* Ks, const bf16x8* qr, int r32, int hi) {
  p0 = f32x16{}; p1 = f32x16{};
  for (int d0 = 0; d0 < 8; ++d0) { int cb = (d0 * 16 + hi * 8) * 2;
    bf16x8 b0 = *reinterpret_cast<const bf16x8*>((const char*)Ks + KSWZ(r32, cb));
    bf16x8 b1 = *reinterpret_cast<const bf16x8*>((const char*)Ks + KSWZ(32 + r32, cb));
    p0 = __builtin_amdgcn_mfma_f32_32x32x16_bf16(b0, qr[d0], p0, 0, 0, 0);
    p1 = __builtin_amdgcn_mfma_f32_32x32x16_bf16(b1, qr[d0], p1, 0, 0, 0); }
}
__device__ __forceinline__ int v_st(int k, int c) { const int kk = (k & ~0xC) | ((k & 4) << 1) | ((k & 8) >> 1); return ((kk >> 3) * 4 + (c >> 5)) * 512 + ((kk & 7) * 32 + (c & 31)) * 2; }
__device__ __forceinline__ int v_rd_base(int lane) { return ((lane & 3) << 3) | (((lane >> 2) & 3) << 6) | (((lane >> 4) & 1) << 5) | (((lane >> 5) & 1) << 8); }
constexpr int v_rd_off(int d0, int ks, int half) { return d0 * 512 + ks * 4096 + half * 2048; }
template <int OFF> __device__ __forceinline__ s16x4 tr_read(int vb) {
  s16x4 r; asm volatile("ds_read_b64_tr_b16 %0, %1 offset:%2" : "=&v"(r) : "v"(vb), "i"(OFF) : "memory"); return r;
}
template <int D0> __device__ __forceinline__ void pv_one(f32x16& od, int vb, bf16x8 pa0, bf16x8 pa1, bf16x8 pa2, bf16x8 pa3) {
  const s16x4 l0 = tr_read<v_rd_off(D0, 0, 0)>(vb), h0 = tr_read<v_rd_off(D0, 0, 1)>(vb), l1 = tr_read<v_rd_off(D0, 1, 0)>(vb), h1 = tr_read<v_rd_off(D0, 1, 1)>(vb);
  const s16x4 l2 = tr_read<v_rd_off(D0, 2, 0)>(vb), h2 = tr_read<v_rd_off(D0, 2, 1)>(vb), l3 = tr_read<v_rd_off(D0, 3, 0)>(vb), h3 = tr_read<v_rd_off(D0, 3, 1)>(vb);
  asm volatile("s_waitcnt lgkmcnt(0)" ::: "memory"); SBAR();
#define PK(L, H) (bf16x8){L[0], L[1], L[2], L[3], H[0], H[1], H[2], H[3]}
  od = __builtin_amdgcn_mfma_f32_32x32x16_bf16(pa0, PK(l0, h0), od, 0, 0, 0);
  od = __builtin_amdgcn_mfma_f32_32x32x16_bf16(pa1, PK(l1, h1), od, 0, 0, 0);
  od = __builtin_amdgcn_mfma_f32_32x32x16_bf16(pa2, PK(l2, h2), od, 0, 0, 0);
  od = __builtin_amdgcn_mfma_f32_32x32x16_bf16(pa3, PK(l3, h3), od, 0, 0, 0);
#undef PK
}
__device__ __forceinline__ void pv_d0(f32x16* o, int vb, bf16x8 pa0, bf16x8 pa1, bf16x8 pa2, bf16x8 pa3) {
  pv_one<0>(o[0], vb, pa0, pa1, pa2, pa3); pv_one<1>(o[1], vb, pa0, pa1, pa2, pa3); pv_one<2>(o[2], vb, pa0, pa1, pa2, pa3); pv_one<3>(o[3], vb, pa0, pa1, pa2, pa3);
}
template <bool FM> __device__ __forceinline__ void attn_dense_body(const bf16_t* __restrict__ Qb, const bf16_t* __restrict__ Kh, const bf16_t* __restrict__ Vh,
                                                bf16_t* __restrict__ Ob, int seq, char* lds, const int wave_, const float mfix = 0.f) {
  constexpr int SDEPTH = ATT_SDEPTH;
  const int lane = lane_id(), wid = wave_, tid = wid * 64 + lane, r32 = lane & 31, hi = lane >> 5;
  bf16_t* V_lds = (bf16_t*)lds; bf16_t* K_lds = (bf16_t*)(lds + 2 * SHM_V);
  float* ws = (float*)(lds + 2 * SHM_V + 2 * SHM_K) + wid * 64; float* li_l = ws; float* al_l = ws + 32;
  float m_reg = FM ? mfix / SCALE : -1e30f, l_reg = 0; f32x16 o[4] = {}; bf16x8 qr[8];
  const bf16_t* Qw = Qb + (long)(wid * QBLK + r32) * LDQ + hi * 8;
#pragma unroll
  for (int d0 = 0; d0 < 8; ++d0) qr[d0] = *reinterpret_cast<const bf16x8*>(Qw + d0 * 16);
  const int sr = tid >> 4, sc = (tid & 15) * 8, vst0 = v_st(sr, sc), vst1 = v_st(32 + sr, sc);
  const int vb0 = (int)(uintptr_t)V_lds + v_rd_base(lane);
  struct { bf16x8 vs0, vs1, ks0, ks1; } sr_[SDEPTH];
#define SLOAD(i, k0) do { sr_[i].vs0 = *reinterpret_cast<const bf16x8*>(&Vh[(long)((k0) + sr) * LDK + sc]); sr_[i].vs1 = *reinterpret_cast<const bf16x8*>(&Vh[(long)((k0) + 32 + sr) * LDK + sc]); \
    sr_[i].ks0 = *reinterpret_cast<const bf16x8*>(&Kh[(long)((k0) + sr) * LDK + sc]); sr_[i].ks1 = *reinterpret_cast<const bf16x8*>(&Kh[(long)((k0) + 32 + sr) * LDK + sc]); } while (0)
#define SWRITE(b, i) do { *(bf16x8*)((char*)V_lds + (b) * SHM_V + vst0) = sr_[i].vs0;          \
    *(bf16x8*)((char*)V_lds + (b) * SHM_V + vst1) = sr_[i].vs1; int kc = sc * 2;               \
    *(bf16x8*)((char*)K_lds + (b) * SHM_K + KSWZ(sr, kc)) = sr_[i].ks0;                       \
    *(bf16x8*)((char*)K_lds + (b) * SHM_K + KSWZ(32 + sr, kc)) = sr_[i].ks1; } while (0)
#define SWAIT() do { if constexpr (SDEPTH == 2) asm volatile("s_waitcnt vmcnt(4)" ::: "memory"); else asm volatile("s_waitcnt vmcnt(0)" ::: "memory"); } while (0)
#define RESC(a) do { if (!FM && __any((a) < 1.f)) { if (hi == 0) al_l[r32] = (a); asm volatile("s_waitcnt lgkmcnt(0)" ::: "memory"); \
    for (int d = 0; d < 4; ++d) for (int r = 0; r < 16; ++r) o[d][r] *= al_l[crow(r, hi)]; } } while (0)
  f32x16 pA0, pA1, pB0, pB1; float mnA, mnB, alA, alB; bf16x8 pa0, pa1, pa2, pa3; const int NT = seq / KVBLK;
  constexpr int SE = 0, SO = SDEPTH - 1;
  SLOAD(SE, 0); asm volatile("s_waitcnt vmcnt(0)" ::: "memory"); SWRITE(0, SE); __syncthreads();
  qkt(pA0, pA1, K_lds, qr, r32, hi); partialSM<FM>(pA0, pA1, m_reg, mnA, alA);
  SLOAD(SO, KVBLK); if constexpr (SDEPTH == 2) { if (2 < NT) SLOAD(SE, 2 * KVBLK); }
  SWAIT(); SWRITE(1, SO); __syncthreads();
  for (int j = 1; j + 1 < NT; j += 2) {
    SBAR(); qkt(pB0, pB1, (bf16_t*)((char*)K_lds + SHM_K), qr, r32, hi);
    finishSM(pA0, pA1, alA, l_reg, pa0, pa1, pa2, pa3); SBAR();
    SLOAD(SO, (j + SDEPTH) * KVBLK); SBAR();
    pv_d0(o, vb0, pa0, pa1, pa2, pa3); partialSM<FM>(pB0, pB1, m_reg, mnB, alB);
    __syncthreads(); SWAIT(); SWRITE(0, SE);
    RESC(alB); __syncthreads();
    SBAR(); qkt(pA0, pA1, K_lds, qr, r32, hi);
    finishSM(pB0, pB1, alB, l_reg, pa0, pa1, pa2, pa3); SBAR();
    if (SDEPTH == 1 || j + 3 < NT) SLOAD(SE, (j + 1 + SDEPTH) * KVBLK); SBAR();
    pv_d0(o, vb0 + (int)SHM_V, pa0, pa1, pa2, pa3); partialSM<FM>(pA0, pA1, m_reg, mnA, alA);
    __syncthreads(); SWAIT(); SWRITE(1, SO);
    RESC(alA); __syncthreads();
  }
  SBAR(); qkt(pB0, pB1, (bf16_t*)((char*)K_lds + SHM_K), qr, r32, hi);
  finishSM(pA0, pA1, alA, l_reg, pa0, pa1, pa2, pa3); SBAR();
  pv_d0(o, vb0, pa0, pa1, pa2, pa3); partialSM<FM>(pB0, pB1, m_reg, mnB, alB);
  __syncthreads(); RESC(alB);
  finishSM(pB0, pB1, alB, l_reg, pa0, pa1, pa2, pa3); SBAR();
  pv_d0(o, vb0 + (int)SHM_V, pa0, pa1, pa2, pa3);
  if (hi == 0) li_l[r32] = l_reg; asm volatile("s_waitcnt lgkmcnt(0)" ::: "memory");
  float rli[16];
#pragma unroll
  for (int r = 0; r < 16; ++r) rli[r] = __builtin_amdgcn_rcpf(li_l[crow(r, hi)]);
  bf16_t* Ow = Ob + (long)(wid * QBLK) * LDO;
  char* stg = (char*)K_lds + wid * 4096;
#pragma unroll
  for (int p = 0; p < 2; ++p) {
#pragma unroll
    for (int rr = 0; rr < 8; ++rr) { const int r = 8 * p + rr, row16 = (r & 3) + 8 * ((r >> 2) & 1) + 4 * hi;
#pragma unroll
      for (int d0 = 0; d0 < 4; ++d0) *(bf16_t*)(stg + row16 * 256 + (d0 * 32 + r32) * 2) = (bf16_t)(cvtpk(o[d0][r] * rli[r], 0.f) & 0xffffu); }
    asm volatile("s_waitcnt lgkmcnt(0)" ::: "memory");
#pragma unroll
    for (int i = 0; i < 4; ++i) { const int idx = lane + 64 * i, row = idx >> 4, ch = idx & 15; const u32x4 v = *(const u32x4*)(stg + row * 256 + ch * 16);
      *(u32x4*)(Ow + (long)(16 * p + row) * LDO + ch * 8) = v; }
    asm volatile("s_waitcnt lgkmcnt(0)" ::: "memory");
  }
#undef SLOAD
#undef SWRITE
#undef SWAIT
#undef RESC
  __syncthreads();
}
#undef KSWZ
#undef SBAR
}

struct AddrLin { bf16_t* O; int ld; __device__ __forceinline__ bf16_t* operator()(const pg8::Unit& u, int rl, int tc) const { return O + (size_t)(u.pm * 256 + rl) * ld + u.pn * 256 + tc; } };
struct EpiRowScale {
    static constexpr bool PERM = true; bf16_t* O; int ld; const float* ssp; float cscale;
    __device__ __forceinline__ void operator()(f32x4 (&acc)[2][2][4][2], const pg8::Unit& u, const pg8::EpiCtx& c) const { const int e_lane = lane_id(), e_fr = e_lane & 15, e_fq = e_lane >> 4;
        const int hc = c.wc * 32 + e_fq * 8, rl0 = c.wr * 64 + e_fr;
#pragma unroll
        for (int ai = 0; ai < 2; ++ai)
#pragma unroll
            for (int m = 0; m < 4; ++m) { const int row = u.pm * 256 + ai * 128 + rl0 + m * 16; const f32x4 p0 = *(const f32x4*)(ssp + (size_t)row * 8), p1 = *(const f32x4*)(ssp + (size_t)row * 8 + 4);
                const float r = rsqrtf((((p0.x + p0.y) + (p0.z + p0.w)) + ((p1.x + p1.y) + (p1.z + p1.w))) * (1.0f / DM) + EPS) * cscale;
#pragma unroll
                for (int bj = 0; bj < 2; ++bj) { const f32x4 v0 = acc[ai][bj][m][0] * r, v1 = acc[ai][bj][m][1] * r;
                    st16((O + (size_t)row * ld + u.pn * 256 + bj * 128 + hc), (u32x4){cvtpk(v0.x, v0.y), cvtpk(v0.z, v0.w), cvtpk(v1.x, v1.y), cvtpk(v1.z, v1.w)}); } }
    }
};
struct EpiSoftmax {
    static constexpr bool PERM = true; bf16_t* P; int ld;
    __device__ __forceinline__ void operator()(f32x4 (&acc)[2][2][4][2], const pg8::Unit& u, const pg8::EpiCtx& c) const { const int e_lane = lane_id(), e_fr = e_lane & 15, e_fq = e_lane >> 4;
        const int hc = c.wc * 32 + e_fq * 8, rl0 = c.wr * 64 + e_fr;
        LAS float* pmx = (LAS float*)c.xl; LAS float* psm = pmx + 1024;
#pragma unroll
        for (int ai = 0; ai < 2; ++ai)
#pragma unroll
            for (int m = 0; m < 4; ++m) { float mx = -3.0e38f;
#pragma unroll
                for (int bj = 0; bj < 2; ++bj)
#pragma unroll
                    for (int n = 0; n < 2; ++n) { const f32x4 v = acc[ai][bj][m][n]; mx = fmaxf(fmaxf(mx, fmaxf(v.x, v.y)), fmaxf(v.z, v.w)); }
                mx = fmaxf(mx, __shfl_xor(mx, 16)); mx = fmaxf(mx, __shfl_xor(mx, 32));
                if (e_fq == 0) pmx[(ai * 128 + rl0 + m * 16) * 4 + c.wc] = mx; }
        WG_BAR();
#pragma unroll
        for (int ai = 0; ai < 2; ++ai)
#pragma unroll
            for (int m = 0; m < 4; ++m) { const int rl = ai * 128 + rl0 + m * 16; const f32x4 p4 = *(const LAS f32x4*)(pmx + rl * 4);
                const float mx = fmaxf(fmaxf(p4.x, p4.y), fmaxf(p4.z, p4.w)) * 1.4426950408889634f; float s = 0.f;
#pragma unroll
                for (int bj = 0; bj < 2; ++bj)
#pragma unroll
                    for (int n = 0; n < 2; ++n) { f32x4 v = acc[ai][bj][m][n];
                        v.x = __builtin_amdgcn_exp2f(fmaf(v.x, 1.4426950408889634f, -mx)); v.y = __builtin_amdgcn_exp2f(fmaf(v.y, 1.4426950408889634f, -mx));
                        v.z = __builtin_amdgcn_exp2f(fmaf(v.z, 1.4426950408889634f, -mx)); v.w = __builtin_amdgcn_exp2f(fmaf(v.w, 1.4426950408889634f, -mx));
                        s += (v.x + v.y) + (v.z + v.w); acc[ai][bj][m][n] = v; }
                s += __shfl_xor(s, 16); s += __shfl_xor(s, 32);
                if (e_fq == 0) psm[rl * 4 + c.wc] = s; }
        WG_BAR();
#pragma unroll
        for (int ai = 0; ai < 2; ++ai)
#pragma unroll
            for (int m = 0; m < 4; ++m) { const int rl = ai * 128 + rl0 + m * 16; const f32x4 p4 = *(const LAS f32x4*)(psm + rl * 4);
                const float inv = 1.0f / ((p4.x + p4.y) + (p4.z + p4.w));
#pragma unroll
                for (int bj = 0; bj < 2; ++bj) { const f32x4 v0 = acc[ai][bj][m][0] * inv, v1 = acc[ai][bj][m][1] * inv;
                    st16((P + (size_t)(u.pm * 256 + rl) * ld + u.pn * 256 + bj * 128 + hc), (u32x4){cvtpk(v0.x, v0.y), cvtpk(v0.z, v0.w), cvtpk(v1.x, v1.y), cvtpk(v1.z, v1.w)}); } }
        WG_BAR();
    }
};
struct MapXS { const char* Q; const char* K; __device__ __forceinline__ void operator()(pg8::Unit& u) const {
    u.a = Q + ((size_t)u.pm * 256 * DM + (size_t)u.pn * MHD) * 2; u.b = K + ((size_t)(u.pm >> 3) * MEML * DM + (size_t)u.pn * MHD) * 2; } };
struct SchedPair { pg8::Unit ua, ub; __device__ __forceinline__ bool next(int i, pg8::Unit& o) const { if (i >= 2) return false; o.pm = i ? ub.pm : ua.pm; o.pn = i ? ub.pn : ua.pn; o.a = i ? ub.a : ua.a; o.b = i ? ub.b : ua.b; asm volatile("" : "+s"(o.a), "+s"(o.b));     return true; } };
struct MapXPV { const char* P; const char* VT; __device__ __forceinline__ void operator()(pg8::Unit& u) const {
    u.a = P + ((size_t)u.pm * 256 * 1024 + (size_t)(u.pn >> 1) * MEML) * 2; u.b = VT + ((size_t)u.pn * 256 * 1024 + (size_t)(u.pm >> 3) * MEML) * 2; } };

struct MapMoE { const char* A; const char* W; size_t as, es, ws_; __device__ __forceinline__ void operator()(pg8::Unit& u) const {
    u.a = A + (size_t)u.pm * as; u.b = W + (size_t)(u.pm >> 2) * es + (size_t)u.pn * ws_; } };
struct EpiSwiGLU {
    static constexpr bool PERM = true; bf16_t* ACT; const float* rs;
    __device__ __forceinline__ void operator()(f32x4 (&acc)[2][2][4][2], const pg8::Unit& u, const pg8::EpiCtx& c) const { const int e_lane = lane_id(), e_fr = e_lane & 15, e_fq = e_lane >> 4;
        const int hc = c.wc * 32 + e_fq * 8, rl0 = c.wr * 64 + e_fr;
#pragma unroll
        for (int ai = 0; ai < 2; ++ai)
#pragma unroll
            for (int m = 0; m < 4; ++m) { f32x4 o[2]; const float rf = rs[u.pm * 256 + ai * 128 + rl0 + m * 16];
#pragma unroll
                for (int n = 0; n < 2; ++n) { const f32x4 g = acc[ai][0][m][n] * rf, up = acc[ai][1][m][n] * rf; f32x4 r;
                    r.x = g.x * __builtin_amdgcn_rcpf(1.0f + __builtin_amdgcn_exp2f(-1.4426950408889634f * g.x)) * up.x; r.y = g.y * __builtin_amdgcn_rcpf(1.0f + __builtin_amdgcn_exp2f(-1.4426950408889634f * g.y)) * up.y;
                    r.z = g.z * __builtin_amdgcn_rcpf(1.0f + __builtin_amdgcn_exp2f(-1.4426950408889634f * g.z)) * up.z; r.w = g.w * __builtin_amdgcn_rcpf(1.0f + __builtin_amdgcn_exp2f(-1.4426950408889634f * g.w)) * up.w; o[n] = r; }
                st16((ACT + (size_t)(u.pm * 256 + ai * 128 + rl0 + m * 16) * EFF + u.pn * 128 + hc), (u32x4){cvtpk(o[0].x, o[0].y), cvtpk(o[0].z, o[0].w), cvtpk(o[1].x, o[1].y), cvtpk(o[1].z, o[1].w)}); }
    }
};
struct EpiRowGate {
    static constexpr bool PERM = true; bf16_t* Y; const float* gate;
    __device__ __forceinline__ void operator()(f32x4 (&acc)[2][2][4][2], const pg8::Unit& u, const pg8::EpiCtx& c) const { const int e_lane = lane_id(), e_fr = e_lane & 15, e_fq = e_lane >> 4;
        const int hc = c.wc * 32 + e_fq * 8, rl0 = c.wr * 64 + e_fr;
#pragma unroll
        for (int ai = 0; ai < 2; ++ai)
#pragma unroll
            for (int m = 0; m < 4; ++m) { const int row = u.pm * 256 + ai * 128 + rl0 + m * 16; const float gt = gate[row];
#pragma unroll
                for (int bj = 0; bj < 2; ++bj) { const f32x4 v0 = acc[ai][bj][m][0] * gt, v1 = acc[ai][bj][m][1] * gt;
                    st16((Y + (size_t)row * DM + u.pn * 256 + bj * 128 + hc), (u32x4){cvtpk(v0.x, v0.y), cvtpk(v0.z, v0.w), cvtpk(v1.x, v1.y), cvtpk(v1.z, v1.w)}); } }
    }
};
__device__ __forceinline__ float rms_row_to_bf16_r(const float* xrow, const float* __restrict__ gain, bf16_t* orow, int lane) {
    const GAS f32x4* xr = (const GAS f32x4*)xrow + lane; const f32x4* gr = (const f32x4*)gain + lane;
    f32x4 v[8]; float s = 0.f;
#pragma unroll
    for (int j = 0; j < 8; ++j) { v[j] = xr[64 * j]; s += (v[j].x * v[j].x + v[j].y * v[j].y) + (v[j].z * v[j].z + v[j].w * v[j].w); }
    const float r = rsqrtf(wave_sum(s) * (1.f / DM) + EPS);
    GAS u32x2* o8 = (GAS u32x2*)orow + lane;
#pragma unroll
    for (int j = 0; j < 8; ++j) { const f32x4 g = gr[64 * j]; u32x2 w; w.x = cvtpk(v[j].x * r * g.x, v[j].y * r * g.y); w.y = cvtpk(v[j].z * r * g.z, v[j].w * r * g.w); o8[64 * j] = w; }
    return r;
}
__device__ __forceinline__ void router_phase(const Frame& F, const bf16_t* x, const u32x4* RBl, float* rrow, float* aff, LAS unsigned char* xl) {
    const int lane = lane_id(), tid = F.wave * 64 + lane;
    LAS u32x4* Bl = (LAS u32x4*)(F.lds + RING_OFF);
    for (int i = tid; i < 2 * 4096; i += 512) Bl[i] = RBl[i];
    __syncthreads();
    LAS float* red = (LAS float*)xl;
    LAS float* ssq = (LAS float*)(xl + 8192);
    const int rg = F.wave >> 2, kq = F.wave & 3, r16 = lane & 15, kg = lane >> 4;
    for (int rb = (int)blockIdx.x * 32; rb < NTOK; rb += F.G * 32) {
        const bf16_t* xr = x + (size_t)(rb + rg * 16 + r16) * DM + kq * 512 + kg * 8;
        bf16x8 a[16];
#pragma unroll
        for (int s = 0; s < 16; ++s) a[s] = *(const GAS bf16x8*)(xr + 32 * s);
        f32x4 acc = {0.f, 0.f, 0.f, 0.f}; float sq = 0.f;
#pragma unroll
        for (int s = 0; s < 16; ++s) { const int ks = kq * 16 + s;
            const bf16x8 bh = __builtin_bit_cast(bf16x8, Bl[ks * 64 + lane]), bl = __builtin_bit_cast(bf16x8, Bl[4096 + ks * 64 + lane]);
            acc = __builtin_amdgcn_mfma_f32_16x16x32_bf16(a[s], bh, acc, 0, 0, 0);
            acc = __builtin_amdgcn_mfma_f32_16x16x32_bf16(a[s], bl, acc, 0, 0, 0);
            const u32x4 av = __builtin_bit_cast(u32x4, a[s]);
            const float f0 = __uint_as_float(av.x << 16), f1 = __uint_as_float(av.x & 0xffff0000u), f2 = __uint_as_float(av.y << 16), f3 = __uint_as_float(av.y & 0xffff0000u);
            const float f4 = __uint_as_float(av.z << 16), f5 = __uint_as_float(av.z & 0xffff0000u), f6 = __uint_as_float(av.w << 16), f7 = __uint_as_float(av.w & 0xffff0000u);
            sq += ((f0 * f0 + f1 * f1) + (f2 * f2 + f3 * f3)) + ((f4 * f4 + f5 * f5) + (f6 * f6 + f7 * f7)); }
        sq += __shfl_xor(sq, 16); sq += __shfl_xor(sq, 32);
        *(LAS f32x4*)(red + ((rg * 4 + kq) * 64 + lane) * 4) = acc;
        if (kg == 0) ssq[(rg * 4 + kq) * 16 + r16] = sq;
        __syncthreads();
        if (kq == 0) {
            f32x4 t = *(const LAS f32x4*)(red + ((rg * 4 + 0) * 64 + lane) * 4);
#pragma unroll
            for (int q = 1; q < 4; ++q) t = t + *(const LAS f32x4*)(red + ((rg * 4 + q) * 64 + lane) * 4);
            const float lg[4] = {t.x, t.y, t.z, t.w};
#pragma unroll
            for (int i = 0; i < 4; ++i) { const int rr = 4 * kg + i; const float ss = (ssq[(rg * 4 + 0) * 16 + rr] + ssq[(rg * 4 + 1) * 16 + rr]) + (ssq[(rg * 4 + 2) * 16 + rr] + ssq[(rg * 4 + 3) * 16 + rr]);
                const float r = rsqrtf(ss * (1.f / DM) + EPS); const int row = rb + rg * 16 + rr;
                const float v = lg[i] * r; float mx = v;
                mx = fmaxf(mx, __shfl_xor(mx, 8)); mx = fmaxf(mx, __shfl_xor(mx, 4)); mx = fmaxf(mx, __shfl_xor(mx, 2)); mx = fmaxf(mx, __shfl_xor(mx, 1));
                const float ex = expf(v - mx); float sm = ex;
                sm += __shfl_xor(sm, 8); sm += __shfl_xor(sm, 4); sm += __shfl_xor(sm, 2); sm += __shfl_xor(sm, 1);
                const int b = row / SEQ, tt = row % SEQ; aff[((size_t)b * NE + r16) * SEQ + tt] = ex / sm;
                if (r16 == 0) rrow[row] = r; }
        }
        __syncthreads();
    }
}
__device__ __forceinline__ void rank_phase(const Frame& F, const float* aff, int* rank, float* gate, const float* rrow, float* rs, int* gidx) {
    const int lane = lane_id(), tid = F.wave * 64 + lane;
    LAS unsigned* wc = (LAS unsigned*)(F.lds + RING_OFF);
    LAS unsigned* ck = (LAS unsigned*)(F.lds + RING_OFF + 256);
    LAS unsigned* ci = ck + SEQ + 4;
    LAS unsigned* ncp = ci + SEQ + 4;
    for (int be = (int)blockIdx.x; be < NB * NE; be += F.G) {
        const int b = be >> 4, e = be & 15;
        unsigned k[4];
#pragma unroll
        for (int j = 0; j < 4; ++j) k[j] = __float_as_uint(aff[(size_t)be * SEQ + tid + 512 * j]);
        unsigned lo = 0u, hi = 0x3F800001u;
        if (tid == 0) ncp[0] = 0u;
        for (int it = 0; it < 40; ++it) {
            const unsigned mid = lo + ((hi - lo) >> 1); if (mid == lo) break;
            const int ws_ = __popcll(__ballot(k[0] >= mid)) + __popcll(__ballot(k[1] >= mid)) + __popcll(__ballot(k[2] >= mid)) + __popcll(__ballot(k[3] >= mid));
            if (lane == 0) wc[(it & 1) * 8 + F.wave] = (unsigned)ws_;
            __syncthreads();
            const u32x4 c0 = *(const LAS u32x4*)(wc + (it & 1) * 8), c1 = *(const LAS u32x4*)(wc + (it & 1) * 8 + 4);
            const int c = (int)(((c0.x + c0.y) + (c0.z + c0.w)) + ((c1.x + c1.y) + (c1.z + c1.w)));
            if (c < CAP) hi = mid; else { lo = mid; if (c <= 448) break; }
        }
        const unsigned T = lo;
        __syncthreads();
#pragma unroll
        for (int j = 0; j < 4; ++j) { const bool pred = k[j] >= T; const unsigned long long bal = __ballot(pred);
            const int wcount = __popcll(bal), pre = __popcll(bal & ((1ull << lane) - 1ull));
            unsigned base = 0u; if (lane == 0 && wcount) base = __hip_atomic_fetch_add(ncp, (unsigned)wcount, __ATOMIC_RELAXED, __HIP_MEMORY_SCOPE_WORKGROUP);
            base = (unsigned)__builtin_amdgcn_readfirstlane((int)base);
            if (pred) { ck[base + pre] = k[j]; ci[base + pre] = (unsigned)(tid + 512 * j); } else rank[(size_t)be * SEQ + tid + 512 * j] = CAP; }
        __syncthreads();
        const int nc = (int)ncp[0];
        if (tid < 4) { ck[nc + tid] = 0u; ci[nc + tid] = 0x7fffffffu; }
        __syncthreads();
        const int nc4 = (nc + 3) >> 2;
        for (int i = tid; i < nc; i += 512) { const unsigned kk = ck[i]; const int tt = (int)ci[i]; int cnt = 0;
#pragma unroll 4
            for (int m = 0; m < nc4; ++m) { const u32x4 km = ((const LAS u32x4*)ck)[m]; const u32x4 tm = ((const LAS u32x4*)ci)[m];
                cnt += ((km.x > kk || (km.x == kk && (int)tm.x < tt)) ? 1 : 0) + ((km.y > kk || (km.y == kk && (int)tm.y < tt)) ? 1 : 0)
                     + ((km.z > kk || (km.z == kk && (int)tm.z < tt)) ? 1 : 0) + ((km.w > kk || (km.w == kk && (int)tm.w < tt)) ? 1 : 0); }
            const int r = cnt < CAP ? cnt : CAP; rank[(size_t)be * SEQ + tt] = r;
            if (r < CAP) { const int sl = (e * 4 + b) * CAP + r; gate[sl] = __uint_as_float(kk); gidx[sl] = b * SEQ + tt; rs[sl] = rrow[b * SEQ + tt]; } }
        __syncthreads();
    }
}
__device__ __forceinline__ void combine_phase(const Frame& F, const bf16_t* xin, bf16_t* xo, float* fout, const bf16_t* Y, const int* rank, const float* __restrict__ gain, bf16_t* HNo, bool final_) {
    const int lane = lane_id();
    const int gw = (int)blockIdx.x * NWAVES + F.wave, NGW = F.G * NWAVES;
    for (int row = gw; row < NTOK; row += NGW) {
        const int b = row / SEQ, t = row % SEQ;
        int rk = CAP; if (lane < NE) rk = rank[((size_t)b * NE + lane) * SEQ + t];
        const GAS u32x4* xi = (const GAS u32x4*)(xin + (size_t)row * DM) + lane; float v[4][8];
#pragma unroll
        for (int j = 0; j < 4; ++j) { const u32x4 p = xi[64 * j];
            v[j][0] = __uint_as_float(p.x << 16); v[j][1] = __uint_as_float(p.x & 0xffff0000u); v[j][2] = __uint_as_float(p.y << 16); v[j][3] = __uint_as_float(p.y & 0xffff0000u);
            v[j][4] = __uint_as_float(p.z << 16); v[j][5] = __uint_as_float(p.z & 0xffff0000u); v[j][6] = __uint_as_float(p.w << 16); v[j][7] = __uint_as_float(p.w & 0xffff0000u); }
#pragma unroll
        for (int e = 0; e < NE; ++e) { const int r = __builtin_amdgcn_readlane(rk, e);
            if (r < CAP) { const u32x4* yr = (const u32x4*)(Y + ((size_t)(e * 4 + b) * CAP + r) * DM) + lane;
#pragma unroll
                for (int j = 0; j < 4; ++j) { const u32x4 w = yr[64 * j];
                    v[j][0] += __uint_as_float(w.x << 16); v[j][1] += __uint_as_float(w.x & 0xffff0000u); v[j][2] += __uint_as_float(w.y << 16); v[j][3] += __uint_as_float(w.y & 0xffff0000u);
                    v[j][4] += __uint_as_float(w.z << 16); v[j][5] += __uint_as_float(w.z & 0xffff0000u); v[j][6] += __uint_as_float(w.w << 16); v[j][7] += __uint_as_float(w.w & 0xffff0000u); } } }
        float s = 0.f;
#pragma unroll
        for (int j = 0; j < 4; ++j)
#pragma unroll
            for (int i = 0; i < 8; ++i) s += v[j][i] * v[j][i];
        const float r = rsqrtf(wave_sum(s) * (1.f / DM) + EPS);
        if (final_) { GAS f32x4* fo = (GAS f32x4*)(fout + (size_t)row * DM);
#pragma unroll
            for (int j = 0; j < 4; ++j) { const int c0 = 8 * (lane + 64 * j); const f32x4 g0 = *(const f32x4*)(gain + c0), g1 = *(const f32x4*)(gain + c0 + 4);
                fo[(c0 >> 2)] = (f32x4){v[j][0] * r * g0.x, v[j][1] * r * g0.y, v[j][2] * r * g0.z, v[j][3] * r * g0.w};
                fo[(c0 >> 2) + 1] = (f32x4){v[j][4] * r * g1.x, v[j][5] * r * g1.y, v[j][6] * r * g1.z, v[j][7] * r * g1.w}; }
        } else { GAS u32x4* o8 = (GAS u32x4*)(HNo + (size_t)row * DM) + lane; GAS u32x4* x8 = (GAS u32x4*)(xo + (size_t)row * DM) + lane;
#pragma unroll
            for (int j = 0; j < 4; ++j) { const int c0 = 8 * (lane + 64 * j); const f32x4 g0 = *(const f32x4*)(gain + c0), g1 = *(const f32x4*)(gain + c0 + 4);
                x8[64 * j] = (u32x4){cvtpk(v[j][0], v[j][1]), cvtpk(v[j][2], v[j][3]), cvtpk(v[j][4], v[j][5]), cvtpk(v[j][6], v[j][7])};
                o8[64 * j] = (u32x4){cvtpk(v[j][0] * r * g0.x, v[j][1] * r * g0.y), cvtpk(v[j][2] * r * g0.z, v[j][3] * r * g0.w), cvtpk(v[j][4] * r * g1.x, v[j][5] * r * g1.y), cvtpk(v[j][6] * r * g1.z, v[j][7] * r * g1.w)}; } }
    }
}
struct MapPool { const char* A; const char* W; __device__ __forceinline__ void operator()(pg8::Unit& u) const {
    u.a = A + ((size_t)u.pm * 256 * DM + (size_t)(u.pn >> 1) * 512) * 2; u.b = W + ((size_t)(u.pn & 1) * 256 * DM + (size_t)(u.pn >> 1) * 512) * 2; } };
template <int W> __device__ __forceinline__ void pool_item4(const bf16_t* H, bf16_t* P, int row0, int c8) {
    const int t0 = row0 & (SEQ - 1); const bf16_t* base = H + (size_t)(row0 - t0) * DM + c8 * 8;
    u32x4 v[W + 3];
#pragma unroll
    for (int i = 0; i < W + 3; ++i) { int j = t0 - W / 2 + i; j = j < 0 ? 0 : (j > SEQ - 1 ? SEQ - 1 : j); v[i] = *(const u32x4*)(base + (size_t)j * DM); }
    float f[W + 3][8];
#pragma unroll
    for (int i = 0; i < W + 3; ++i) { const int j = t0 - W / 2 + i; const float m = (j >= 0 && j < SEQ) ? 1.f : 0.f;
        f[i][0] = m * __uint_as_float(v[i].x << 16); f[i][1] = m * __uint_as_float(v[i].x & 0xffff0000u); f[i][2] = m * __uint_as_float(v[i].y << 16); f[i][3] = m * __uint_as_float(v[i].y & 0xffff0000u);
        f[i][4] = m * __uint_as_float(v[i].z << 16); f[i][5] = m * __uint_as_float(v[i].z & 0xffff0000u); f[i][6] = m * __uint_as_float(v[i].w << 16); f[i][7] = m * __uint_as_float(v[i].w & 0xffff0000u); }
    float s[8];
#pragma unroll
    for (int c = 0; c < 8; ++c) { s[c] = 0.f;
#pragma unroll
        for (int i = 0; i < W; ++i) s[c] += f[i][c]; }
#pragma unroll
    for (int q = 0; q < 4; ++q) { const int t = t0 + q; int lo = t - W / 2, hi = t + W / 2; if (lo < 0) lo = 0; if (hi > SEQ) hi = SEQ; const float inv = 1.0f / (float)(hi - lo);
        if (q > 0) {
#pragma unroll
            for (int c = 0; c < 8; ++c) s[c] += f[q + W - 1][c] - f[q - 1][c]; }
        const float* e = f[q + W / 2];
        *(u32x4*)(P + (size_t)(row0 + q) * DM + c8 * 8) = (u32x4){cvtpk(s[0] * inv - e[0], s[1] * inv - e[1]), cvtpk(s[2] * inv - e[2], s[3] * inv - e[3]), cvtpk(s[4] * inv - e[4], s[5] * inv - e[5]), cvtpk(s[6] * inv - e[6], s[7] * inv - e[7])}; }
}
__device__ __forceinline__ void pool_phase(const Frame& F, const bf16_t* H, bf16_t* P) {
    const int lane = lane_id(); const int gwv = (int)blockIdx.x * NWAVES + F.wave, NWV = F.G * NWAVES;
    for (int wi = gwv; wi < NTOK; wi += NWV) {
        const int row0 = (wi >> 2) * 4, g = wi & 3, c8 = g * 64 + lane;
        if (g == 0) pool_item4<2>(H, P, row0, c8); else if (g == 1) pool_item4<4>(H, P, row0, c8); else if (g == 2) pool_item4<8>(H, P, row0, c8); else pool_item4<16>(H, P, row0, c8);
    }
}

constexpr int N_PHASES = 24;
#ifndef MK_N_LAUNCHES
#define MK_N_LAUNCHES 1
#endif
#ifndef REP_MASK
#define REP_MASK 0
#endif
__global__ void __launch_bounds__(NWAVES * 64, 2) skel_fwd(Args args) {
    extern __shared__ __attribute__((aligned(16))) unsigned char lds_raw[];
    Frame F;
    F.lds = (LAS unsigned char*)lds_raw; F.MISC = (volatile LAS unsigned*)(F.lds + MISC_OFF);
    F.wave = __builtin_amdgcn_readfirstlane(threadIdx.x >> 6);
    F.G = gridDim.x; { const int bx = blockIdx.x; F.vcu = (F.G % 8 == 0) ? (bx % 8) * (F.G / 8) + bx / 8 : bx; }
    F.ws = nullptr; F.ctl = (gu32*)(uptr(args.ws) + WS_CTL);
    for (int u = threadIdx.x; u < (LDS_BYTES - LDSCTL_OFF) / 4; u += NWAVES * 64) ((LAS unsigned*)(F.lds + LDSCTL_OFF))[u] = 0u;
    __syncthreads();
    const bool multi = (MK_N_LAUNCHES == 1) || (args.ph_hi - args.ph_lo) > 1 || REP_MASK != 0;
    XcdBarrier bar; bar.bar = (unsigned*)(F.ctl + CW_BAR); bar.x = 0; bar.st = nullptr; bar.wave = F.wave;
    if (multi) bar = xcd_barrier_post((unsigned*)(F.ctl + CW_BAR), F.MISC + 8, F.wave);
    const int lo = args.ph_lo, hi = args.ph_hi;
#ifdef REP_RT
    const unsigned rep_mask_ = (unsigned)__builtin_amdgcn_readfirstlane(args.pad);
#endif
#define IN(k) ((MK_N_LAUNCHES == 1) ? ((k) < N_PHASES) : (lo <= (k) && (k) < hi))
#ifdef REP_RT
#define REPBIT(k) ((int)((rep_mask_ >> (k)) & 1u))
#else
#define REPBIT(k) ((int)((((unsigned)REP_MASK) >> (k)) & 1u))
#endif
#define PHASE(k) _Pragma("unroll") for (int rep_ = 0; rep_ < 1 + REPBIT(k); ++rep_)
#define SEAM(k) do { if ((IN(k) && IN((k) + 1)) || rep_ + 1 < 1 + REPBIT(k)) xcd_barrier(bar); } while (0)
    LAS unsigned char* ring = F.lds + RING_OFF; LAS unsigned char* xl = F.lds + XL_OFF;
    const int bx = (int)blockIdx.x, G = F.G;

#define KV_PROJ(l, rotK, rotV) do {   \
            { MapLin mp{(const char*)(ws + WS_MEMNB + (size_t)(l) * NB * MEML * DM * 2), (const char*)(ws + WS_WCK_T + (size_t)(l) * DM * DM * 2), (size_t)256 * DM * 2, (size_t)256 * DM * 2}; \
              pg8::Sched<MapLin> S; S.init(NB * MEML / 256, DM / 256, G, (bx + G - ((rotK) % G)) % G, mp); \
              EpiStore<AddrLin> E{AddrLin{(bf16_t*)(ws + WS_KCB + (size_t)(l) * NB * MEML * DM * 2), DM}}; \
              pg8::gemm_phase<EpiStore<AddrLin>, pg8::Sched<MapLin>, true>(F.wave, ring, xl, DM, DM * 2, DM * 2, S, E); } \
            { MapLin mp{(const char*)(ws + WS_WCV_T + (size_t)(l) * DM * DM * 2), (const char*)(ws + WS_MEMNB + (size_t)(l) * NB * MEML * DM * 2), (size_t)256 * DM * 2, (size_t)256 * DM * 2}; \
              pg8::Sched<MapLin> S; S.init(DM / 256, NB * MEML / 256, G, (bx + G - ((rotV) % G)) % G, mp); \
              EpiStore<AddrLin> E{AddrLin{(bf16_t*)(ws + WS_VTB + (size_t)(l) * NB * MEML * DM * 2), NB * MEML}}; \
              pg8::gemm_phase<EpiStore<AddrLin>, pg8::Sched<MapLin>, true>(F.wave, ring, xl, DM, DM * 2, DM * 2, S, E); } } while (0)
#ifdef EXTRA_BARS
    for (int eb = 0; eb < EXTRA_BARS; ++eb) xcd_barrier(bar);
#endif
    if (IN(0)) PHASE(0) { const karg_t ka = kargs(); unsigned char* const ws = uptr(KWS(ka)); p0_prologue(F, ka, ws); SEAM(0); }
    if (IN(1)) PHASE(1) { const karg_t ka = kargs(); unsigned char* const ws = uptr(KWS(ka));
        {
            MapLin mp{(const char*)(ws + WS_HN), (const char*)(ws + WS_WIN_T), (size_t)256 * DM * 2, (size_t)256 * DM * 2};
            pg8::Sched<MapLin> S; S.init(NTOK / 256, 2560 / 256, G, bx, mp);
            EpiQKV E{(bf16_t*)(ws + WS_QB), (bf16_t*)(ws + WS_KB), (bf16_t*)(ws + WS_VB), KIN(ka, 4), KIN(ka, 5), (const float*)(ws + WS_ROPE), (const float*)(ws + WS_ROPE) + SEQ * 64};
            pg8::gemm_phase<EpiQKV, pg8::Sched<MapLin>, true>(F.wave, ring, xl, DM, DM * 2, DM * 2, S, E); }
        {
            MapLin mp{(const char*)(ws + WS_WF_T), (const char*)(ws + WS_HN), (size_t)256 * DM * 2, (size_t)256 * DM * 2};
            pg8::Sched<MapLin> S; S.init(1024 / 256, NTOK / 256, G, (bx + G - (320 % G)) % G, mp);
            EpiStore<AddrF1> E{AddrF1{(bf16_t*)(ws + WS_FPQ)}};
            pg8::gemm_phase<EpiStore<AddrF1>, pg8::Sched<MapLin>, true>(F.wave, ring, xl, DM, DM * 2, DM * 2, S, E); }
        KV_PROJ(0, 448, 480);
        SEAM(1);
    }
    if (IN(2)) PHASE(2) { const karg_t ka = kargs(); unsigned char* const ws = uptr(KWS(ka));
        const int nF2 = (G > 64) ? 64 : 0;
        if (bx < nF2 || nF2 == 0) {
            MapLin mp{(const char*)(ws + WS_DFT), (const char*)(ws + WS_FPQ), (size_t)256 * 4096 * 2, (size_t)256 * 4096 * 2};
            pg8::Sched<MapLin> S; S.init(8, 8, nF2 ? nF2 : G, bx, mp);
            EpiStore<AddrF2> E{AddrF2{(bf16_t*)(ws + WS_MIXB)}};
            pg8::gemm_phase<EpiStore<AddrF2>, pg8::Sched<MapLin>, true>(F.wave, ring, xl, 4096, 4096 * 2, 4096 * 2, S, E);
        }
        if (bx < nF2) { __syncthreads(); tr_span(F, ka, ws, 3, bx * 8 + F.wave, 512, 2); __syncthreads(); }
        if (bx >= nF2) {
            const int a = bx - nF2, cnt = G - nF2, per = (384 + cnt - 1) / cnt; int ui = 0;
            float mfix; bool fm_ok; { const int ln = lane_id(); const float* gq = KIN(ka, 4); const float* gk = KIN(ka, 5);
                float mq = fmaxf(fabsf(gq[ln]), fabsf(gq[ln + 64])), mk = fmaxf(fabsf(gk[ln]), fabsf(gk[ln + 64]));
#pragma unroll
                for (int o_ = 1; o_ < 64; o_ <<= 1) { mq = fmaxf(mq, __shfl_xor(mq, o_)); mk = fmaxf(mk, __shfl_xor(mk, o_)); }
                mfix = 11.313708499f * 1.02f * mq * mk; fm_ok = __builtin_amdgcn_readfirstlane((int)(mfix <= 40.f)) != 0; mfix = __uint_as_float((unsigned)__builtin_amdgcn_readfirstlane((int)__float_as_uint(mfix))); }
            for (int uid = a * per; uid < (a + 1) * per && uid < 384; ++uid, ++ui) {
                const int set_ = 2 * (a & 7) + ui, jx = a >> 3, b = set_ >> 2, kvh = set_ & 3, qb = jx & 7, hq = kvh * 3 + (jx >> 3);
                const bf16_t* Qb = (const bf16_t*)(ws + WS_QB) + ((size_t)b * SEQ + qb * 256) * AW + hq * HD;
                const bf16_t* Kh = (const bf16_t*)(ws + WS_KB) + (size_t)b * SEQ * KVW + kvh * HD;
                const bf16_t* Vh = (const bf16_t*)(ws + WS_VB) + (size_t)b * SEQ * KVW + kvh * HD;
                bf16_t* Ob = (bf16_t*)(ws + WS_MIXB) + ((size_t)b * SEQ + qb * 256) * DM + hq * HD;
                if (fm_ok) attn::attn_dense_body<true>(Qb, Kh, Vh, Ob, SEQ, (char*)lds_raw + RING_OFF, F.wave, mfix);
                else attn::attn_dense_body<false>(Qb, Kh, Vh, Ob, SEQ, (char*)lds_raw + RING_OFF, F.wave);
            }
        }
        SEAM(2);
    }
    if (IN(3)) PHASE(3) { const karg_t ka = kargs(); unsigned char* const ws = uptr(KWS(ka));
        MapLin mp{(const char*)(ws + WS_MIXB), (const char*)(ws + WS_WOUT_T), (size_t)256 * DM * 2, (size_t)256 * DM * 2};
        pg8::Sched<MapLin> S; S.init(NTOK / 256, DM / 256, G, bx, mp);
        EpiResB<true> E{KIN(ka, 0), (bf16_t*)(ws + WS_XB), (float*)(ws + WS_SSP), nullptr};
        pg8::gemm_phase<EpiResB<true>, pg8::Sched<MapLin>, true>(F.wave, ring, xl, DM, DM * 2, DM * 2, S, E);
        SEAM(3);
    }
    {
        constexpr int l = 0; constexpr int pb = l ? 15 : 4;
        if (l == 1) {
            if (IN(13)) PHASE(13) { const karg_t ka = kargs(); unsigned char* const ws = uptr(KWS(ka));
                pool_phase(F, (const bf16_t*)(ws + WS_HN), (bf16_t*)(ws + WS_QCB));
#ifdef PROBE_CONV
                tr_span<TRV>(F, ka, ws, 1, bx * 8 + F.wave, 2048, 4);
#endif
                SEAM(13);
            }
            if (IN(14)) PHASE(14) { const karg_t ka = kargs(); unsigned char* const ws = uptr(KWS(ka));
                MapPool mp{(const char*)(ws + WS_QCB), (const char*)(ws + WS_WP_T)};
                pg8::Sched<MapPool> S; S.init(NTOK / 256, DM / 256, G, bx, mp);
                EpiResB<false> E{(const bf16_t*)(ws + WS_XB), (bf16_t*)(ws + WS_XALT), (float*)(ws + WS_SSP), KIN(ka, 9)};
                pg8::gemm_phase<EpiResB<false>, pg8::Sched<MapPool>, true>(F.wave, ring, xl, 512, DM * 2, DM * 2, S, E);
                SEAM(14);
            }
        }
        if (IN(pb + 0)) PHASE(pb + 0) { const karg_t ka = kargs(); unsigned char* const ws = uptr(KWS(ka));
            MapLin mp{(const char*)(ws + (l == 0 ? WS_XB : WS_XALT)), (const char*)(ws + WS_WCQ_T + (size_t)l * DM * DM * 2), (size_t)256 * DM * 2, (size_t)256 * DM * 2};
            pg8::Sched<MapLin> S; S.init(NTOK / 256, DM / 256, G, bx, mp);
            EpiRowScale E{(bf16_t*)(ws + WS_QCB), DM, (const float*)(ws + WS_SSP), 0.04419417382415922f};
            pg8::gemm_phase<EpiRowScale, pg8::Sched<MapLin>, true>(F.wave, ring, xl, DM, DM * 2, DM * 2, S, E);
            SEAM(pb + 0);
        }
        if (IN(pb + 1)) PHASE(pb + 1) { const karg_t ka = kargs(); unsigned char* const ws = uptr(KWS(ka));
            MapXS mp{(const char*)(ws + WS_QCB), (const char*)(ws + WS_KCB + (size_t)l * NB * MEML * DM * 2)};
            pg8::Sched<MapXS> S; S.init(NTOK / 256, NMH, G, bx, mp);
            EpiSoftmax E{(bf16_t*)(ws + WS_PB), NMH * MEML};
            pg8::gemm_phase<EpiSoftmax, pg8::Sched<MapXS>, true>(F.wave, ring, xl, MHD, DM * 2, DM * 2, S, E);
            { pg8::Unit su; if (S.next(0, su)) {
                VM_WAIT(); __syncthreads(); if (F.wave == 0 && lane_id() == 0) { __builtin_amdgcn_fence(__ATOMIC_ACQUIRE, "agent"); VM_WAIT(); } __syncthreads();
                MapXPV mp2{(const char*)(ws + WS_PB), (const char*)(ws + WS_VTB + (size_t)l * NB * MEML * DM * 2)};
                SchedPair S2; S2.ua.pm = su.pm; S2.ua.pn = 2 * su.pn; S2.ub.pm = su.pm; S2.ub.pn = 2 * su.pn + 1; mp2(S2.ua); mp2(S2.ub);
                EpiStore<AddrLin> E2{AddrLin{(bf16_t*)(ws + WS_MIXB), DM}};
                pg8::gemm_phase<EpiStore<AddrLin>, SchedPair, true>(F.wave, ring, xl, MEML, NMH * MEML * 2, NB * MEML * 2, S2, E2); } }
            if (l == 0) { KV_PROJ(1, 128, 160);
            }
            SEAM(pb + 1);
        }
        if (IN(pb + 3)) PHASE(pb + 3) { const karg_t ka = kargs(); unsigned char* const ws = uptr(KWS(ka));
            MapLin mp{(const char*)(ws + WS_MIXB), (const char*)(ws + WS_WCO_T + (size_t)l * DM * DM * 2), (size_t)256 * DM * 2, (size_t)256 * DM * 2};
            pg8::Sched<MapLin> S; S.init(NTOK / 256, DM / 256, G, bx, mp);
            EpiResB<false> E{(const bf16_t*)(ws + (l == 0 ? WS_XB : WS_XALT)), (bf16_t*)(ws + (l == 0 ? WS_XALT : WS_XB)), nullptr, nullptr, (bf16_t*)(ws + WS_XSB), KIN(ka, 16) + l * DM};
            pg8::gemm_phase<EpiResB<false>, pg8::Sched<MapLin>, true>(F.wave, ring, xl, DM, DM * 2, DM * 2, S, E);
            SEAM(pb + 3);
        }
        if (IN(pb + 4)) PHASE(pb + 4) { const karg_t ka = kargs(); unsigned char* const ws = uptr(KWS(ka));
            router_phase(F, (const bf16_t*)(ws + (l == 0 ? WS_XALT : WS_XB)), (const u32x4*)(ws + WS_AFF + 512 * 1024) + (size_t)l * 8192, (float*)(ws + WS_SSP + 512 * 1024), (float*)(ws + WS_AFF), xl);
            SEAM(pb + 4);
        }
        if (IN(pb + 5)) PHASE(pb + 5) { const karg_t ka = kargs(); unsigned char* const ws = uptr(KWS(ka));
            rank_phase(F, (const float*)(ws + WS_AFF), (int*)(ws + WS_RANK), (float*)(ws + WS_GATE), (const float*)(ws + WS_SSP + 512 * 1024), (float*)(ws + WS_SSP + 768 * 1024), (int*)(ws + WS_GATE + 512 * 1024));
            if (l == 0 && bx >= NB * NE && (bx - NB * NE) * 8 + F.wave < TR_DEFER - 1024) tr_span(F, ka, ws, 3, 1024 + (bx - NB * NE) * 8 + F.wave, 0, 1);
            SEAM(pb + 5);
        }
        if (IN(pb + 6)) PHASE(pb + 6) { const karg_t ka = kargs(); unsigned char* const ws = uptr(KWS(ka));
            MapMoE mp{(const char*)(ws + WS_XSB), (const char*)(KIN(ka, 18) + (size_t)l * NE * DM * EFF), (size_t)0, (size_t)DM * EFF * 4, (size_t)128 * 4};
            pg8::Sched<MapMoE> S; S.init(NB * NE, 8, G, bx, mp);
            EpiSwiGLU E{(bf16_t*)(ws + WS_ACTB), (const float*)(ws + WS_SSP + 768 * 1024)};
            pg8::gemm_phase<EpiSwiGLU, pg8::Sched<MapMoE>, true, true, 1, false>(F.wave, ring, xl, DM, DM * 2, EFF * 4, S, E, (const int*)(ws + WS_GATE + 512 * 1024), (long)((const char*)KIN(ka, 19) - (const char*)KIN(ka, 18)));
            SEAM(pb + 6);
        }
        if (IN(pb + 7)) PHASE(pb + 7) { const karg_t ka = kargs(); unsigned char* const ws = uptr(KWS(ka));
            MapMoE mp{(const char*)(ws + WS_ACTB), (const char*)(KIN(ka, 20) + (size_t)l * NE * EFF * DM), (size_t)256 * EFF * 2, (size_t)EFF * DM * 4, (size_t)256 * 4};
            pg8::Sched<MapMoE> S; S.init(NB * NE, 8, G, bx, mp);
            EpiRowGate E{(bf16_t*)(ws + WS_YB), (const float*)(ws + WS_GATE)};
            pg8::gemm_phase<EpiRowGate, pg8::Sched<MapMoE>, true, false, 1, false>(F.wave, ring, xl, EFF, EFF * 2, DM * 4, S, E, nullptr, 512);
            SEAM(pb + 7);
        }
        if (IN(pb + 8)) PHASE(pb + 8) { const karg_t ka = kargs(); unsigned char* const ws = uptr(KWS(ka));
            combine_phase(F, (const bf16_t*)(ws + (l == 0 ? WS_XALT : WS_XB)), (bf16_t*)(ws + WS_XB), KOUT(ka), (const bf16_t*)(ws + WS_YB), (const int*)(ws + WS_RANK), l == 0 ? KIN(ka, 2) + DM : KIN(ka, 21), (bf16_t*)(ws + WS_HN), l == 1);
            SEAM(pb + 8);
        }
    }
    {
        constexpr int l = 1; constexpr int pb = l ? 15 : 4;
        if (l == 1) {
            if (IN(13)) PHASE(13) { const karg_t ka = kargs(); unsigned char* const ws = uptr(KWS(ka));
                pool_phase(F, (const bf16_t*)(ws + WS_HN), (bf16_t*)(ws + WS_QCB));
#ifdef PROBE_CONV
                tr_span<TRV>(F, ka, ws, 1, bx * 8 + F.wave, 2048, 4);
#endif
                SEAM(13);
            }
            if (IN(14)) PHASE(14) { const karg_t ka = kargs(); unsigned char* const ws = uptr(KWS(ka));
                MapPool mp{(const char*)(ws + WS_QCB), (const char*)(ws + WS_WP_T)};
                pg8::Sched<MapPool> S; S.init(NTOK / 256, DM / 256, G, bx, mp);
                EpiResB<false> E{(const bf16_t*)(ws + WS_XB), (bf16_t*)(ws + WS_XALT), (float*)(ws + WS_SSP), KIN(ka, 9)};
                pg8::gemm_phase<EpiResB<false>, pg8::Sched<MapPool>, true>(F.wave, ring, xl, 512, DM * 2, DM * 2, S, E);
                SEAM(14);
            }
        }
        if (IN(pb + 0)) PHASE(pb + 0) { const karg_t ka = kargs(); unsigned char* const ws = uptr(KWS(ka));
            MapLin mp{(const char*)(ws + (l == 0 ? WS_XB : WS_XALT)), (const char*)(ws + WS_WCQ_T + (size_t)l * DM * DM * 2), (size_t)256 * DM * 2, (size_t)256 * DM * 2};
            pg8::Sched<MapLin> S; S.init(NTOK / 256, DM / 256, G, bx, mp);
            EpiRowScale E{(bf16_t*)(ws + WS_QCB), DM, (const float*)(ws + WS_SSP), 0.04419417382415922f};
            pg8::gemm_phase<EpiRowScale, pg8::Sched<MapLin>, true>(F.wave, ring, xl, DM, DM * 2, DM * 2, S, E);
            SEAM(pb + 0);
        }
        if (IN(pb + 1)) PHASE(pb + 1) { const karg_t ka = kargs(); unsigned char* const ws = uptr(KWS(ka));
            MapXS mp{(const char*)(ws + WS_QCB), (const char*)(ws + WS_KCB + (size_t)l * NB * MEML * DM * 2)};
            pg8::Sched<MapXS> S; S.init(NTOK / 256, NMH, G, bx, mp);
            EpiSoftmax E{(bf16_t*)(ws + WS_PB), NMH * MEML};
            pg8::gemm_phase<EpiSoftmax, pg8::Sched<MapXS>, true>(F.wave, ring, xl, MHD, DM * 2, DM * 2, S, E);
            { pg8::Unit su; if (S.next(0, su)) {
                VM_WAIT(); __syncthreads(); if (F.wave == 0 && lane_id() == 0) { __builtin_amdgcn_fence(__ATOMIC_ACQUIRE, "agent"); VM_WAIT(); } __syncthreads();
                MapXPV mp2{(const char*)(ws + WS_PB), (const char*)(ws + WS_VTB + (size_t)l * NB * MEML * DM * 2)};
                SchedPair S2; S2.ua.pm = su.pm; S2.ua.pn = 2 * su.pn; S2.ub.pm = su.pm; S2.ub.pn = 2 * su.pn + 1; mp2(S2.ua); mp2(S2.ub);
                EpiStore<AddrLin> E2{AddrLin{(bf16_t*)(ws + WS_MIXB), DM}};
                pg8::gemm_phase<EpiStore<AddrLin>, SchedPair, true>(F.wave, ring, xl, MEML, NMH * MEML * 2, NB * MEML * 2, S2, E2); } }
            if (l == 0) { KV_PROJ(1, 128, 160);
            }
            SEAM(pb + 1);
        }
        if (IN(pb + 3)) PHASE(pb + 3) { const karg_t ka = kargs(); unsigned char* const ws = uptr(KWS(ka));
            MapLin mp{(const char*)(ws + WS_MIXB), (const char*)(ws + WS_WCO_T + (size_t)l * DM * DM * 2), (size_t)256 * DM * 2, (size_t)256 * DM * 2};
            pg8::Sched<MapLin> S; S.init(NTOK / 256, DM / 256, G, bx, mp);
            EpiResB<false> E{(const bf16_t*)(ws + (l == 0 ? WS_XB : WS_XALT)), (bf16_t*)(ws + (l == 0 ? WS_XALT : WS_XB)), nullptr, nullptr, (bf16_t*)(ws + WS_XSB), KIN(ka, 16) + l * DM};
            pg8::gemm_phase<EpiResB<false>, pg8::Sched<MapLin>, true>(F.wave, ring, xl, DM, DM * 2, DM * 2, S, E);
            SEAM(pb + 3);
        }
        if (IN(pb + 4)) PHASE(pb + 4) { const karg_t ka = kargs(); unsigned char* const ws = uptr(KWS(ka));
            router_phase(F, (const bf16_t*)(ws + (l == 0 ? WS_XALT : WS_XB)), (const u32x4*)(ws + WS_AFF + 512 * 1024) + (size_t)l * 8192, (float*)(ws + WS_SSP + 512 * 1024), (float*)(ws + WS_AFF), xl);
            SEAM(pb + 4);
        }
        if (IN(pb + 5)) PHASE(pb + 5) { const karg_t ka = kargs(); unsigned char* const ws = uptr(KWS(ka));
            rank_phase(F, (const float*)(ws + WS_AFF), (int*)(ws + WS_RANK), (float*)(ws + WS_GATE), (const float*)(ws + WS_SSP + 512 * 1024), (float*)(ws + WS_SSP + 768 * 1024), (int*)(ws + WS_GATE + 512 * 1024));
            if (l == 0 && bx >= NB * NE && (bx - NB * NE) * 8 + F.wave < TR_DEFER - 1024) tr_span(F, ka, ws, 3, 1024 + (bx - NB * NE) * 8 + F.wave, 0, 1);
            SEAM(pb + 5);
        }
        if (IN(pb + 6)) PHASE(pb + 6) { const karg_t ka = kargs(); unsigned char* const ws = uptr(KWS(ka));
            MapMoE mp{(const char*)(ws + WS_XSB), (const char*)(KIN(ka, 18) + (size_t)l * NE * DM * EFF), (size_t)0, (size_t)DM * EFF * 4, (size_t)128 * 4};
            pg8::Sched<MapMoE> S; S.init(NB * NE, 8, G, bx, mp);
            EpiSwiGLU E{(bf16_t*)(ws + WS_ACTB), (const float*)(ws + WS_SSP + 768 * 1024)};
            pg8::gemm_phase<EpiSwiGLU, pg8::Sched<MapMoE>, true, true, 1, false>(F.wave, ring, xl, DM, DM * 2, EFF * 4, S, E, (const int*)(ws + WS_GATE + 512 * 1024), (long)((const char*)KIN(ka, 19) - (const char*)KIN(ka, 18)));
            SEAM(pb + 6);
        }
        if (IN(pb + 7)) PHASE(pb + 7) { const karg_t ka = kargs(); unsigned char* const ws = uptr(KWS(ka));
            MapMoE mp{(const char*)(ws + WS_ACTB), (const char*)(KIN(ka, 20) + (size_t)l * NE * EFF * DM), (size_t)256 * EFF * 2, (size_t)EFF * DM * 4, (size_t)256 * 4};
            pg8::Sched<MapMoE> S; S.init(NB * NE, 8, G, bx, mp);
            EpiRowGate E{(bf16_t*)(ws + WS_YB), (const float*)(ws + WS_GATE)};
            pg8::gemm_phase<EpiRowGate, pg8::Sched<MapMoE>, true, false, 1, false>(F.wave, ring, xl, EFF, EFF * 2, DM * 4, S, E, nullptr, 512);
            SEAM(pb + 7);
        }
        if (IN(pb + 8)) PHASE(pb + 8) { const karg_t ka = kargs(); unsigned char* const ws = uptr(KWS(ka));
            combine_phase(F, (const bf16_t*)(ws + (l == 0 ? WS_XALT : WS_XB)), (bf16_t*)(ws + WS_XB), KOUT(ka), (const bf16_t*)(ws + WS_YB), (const int*)(ws + WS_RANK), l == 0 ? KIN(ka, 2) + DM : KIN(ka, 21), (bf16_t*)(ws + WS_HN), l == 1);
            SEAM(pb + 8);
        }
    }
#undef IN
#undef SEAM
#undef PHASE
#undef KV_PROJ
}


extern "C" void kernel_launch(void* const* d_in, const int* in_sizes, int n_in, void* d_out, int out_size, void* d_ws, size_t ws_size, hipStream_t stream) {
    static int grid = 0;
    if (grid == 0) {
        int dev = 0, cus = 0;
        if (n_in != 22 || out_size != NTOK * DM || ws_size < WS_FAST_END) { fprintf(stderr, "kernel_launch: unexpected shapes (n_in %d out %d ws %zu)\n", n_in, out_size, ws_size); grid = -1; return; }
        if (hipGetDevice(&dev) != hipSuccess || hipDeviceGetAttribute(&cus, hipDeviceAttributeMultiprocessorCount, dev) != hipSuccess) { fprintf(stderr, "device query failed\n"); grid = -1; return; }
        if (hipFuncSetAttribute((const void*)skel_fwd, hipFuncAttributeMaxDynamicSharedMemorySize, LDS_BYTES) != hipSuccess) { fprintf(stderr, "hipFuncSetAttribute failed\n"); grid = -1; return; }
        (void)hipGetLastError();
        grid = cus;
        if (grid != 256) { fprintf(stderr, "kernel_launch: this kernel is laid out for 256 CUs (found %d)\n", cus); grid = -1; return; }
    }
    if (grid < 0) return;
    (void)hipMemsetAsync((char*)d_ws + WS_CTL, 0, 32768, stream);
    Args a{};
    for (int i = 0; i < 22; ++i) a.in[i] = (const float*)d_in[i];
    a.out = (float*)d_out; a.ws = (unsigned char*)d_ws;
#ifdef REP_RT
    a.pad = REP_RT;
#endif
    constexpr int NL = MK_N_LAUNCHES;
    for (int li = 0; li < NL; ++li) {
        a.ph_lo = (N_PHASES * li) / NL; a.ph_hi = (N_PHASES * (li + 1)) / NL; a.li = li;
        hipLaunchKernelGGL(skel_fwd, dim3(grid), dim3(NWAVES * 64), LDS_BYTES, stream, a);
    }
}
```

```cpp
#include <hip/hip_runtime.h>
#include <cstdio>
#include <cstdint>

constexpr int DM = 2048, NB = 4, SEQ = 2048, NTOK = NB * SEQ;
constexpr int HD = 128, NQH = 12, NKVH = 4, AW = NQH * HD, KVW = NKVH * HD, FW = 512, INW = 3072;
constexpr int MEML = 256, NMH = 4, MHD = 512;
constexpr int NE = 16, EFF = 1024, CAP = 256;
constexpr float EPS = 1e-6f;

#define LAS __attribute__((address_space(3)))
#define GAS __attribute__((address_space(1)))
typedef unsigned short bf16_t;
typedef short bf16x8 __attribute__((ext_vector_type(8)));
typedef float f32x4 __attribute__((ext_vector_type(4)));
typedef float f32x2 __attribute__((ext_vector_type(2)));
typedef unsigned u32x4 __attribute__((ext_vector_type(4)));
typedef unsigned u32x2 __attribute__((ext_vector_type(2)));
typedef __bf16 bf16x2_t __attribute__((ext_vector_type(2)));
__device__ __forceinline__ unsigned cvtpk(float lo, float hi) { f32x2 v = {lo, hi}; bf16x2_t b = __builtin_convertvector(v, bf16x2_t); return __builtin_bit_cast(unsigned, b); }
__device__ __forceinline__ float bf2f(unsigned short h) { return __uint_as_float(((unsigned)h) << 16); }
template <class T> __device__ __forceinline__ T* uptr(T* p) { const unsigned long long v = (unsigned long long)p; const unsigned lo = __builtin_amdgcn_readfirstlane((unsigned)v), hi = __builtin_amdgcn_readfirstlane((unsigned)(v >> 32)); return (T*)(((unsigned long long)hi << 32) | lo); }
__device__ __forceinline__ int lane_id() { int l = (int)__builtin_amdgcn_mbcnt_hi(~0u, __builtin_amdgcn_mbcnt_lo(~0u, 0u)); asm volatile("" : "+v"(l)); return l; }
typedef __attribute__((address_space(4))) const unsigned char* karg_t;
__device__ __forceinline__ karg_t kargs() { karg_t p = (karg_t)__builtin_amdgcn_kernarg_segment_ptr(); asm volatile("" : "+s"(p)); return p; }
#define KIN(ka, i) (*(const float* const __attribute__((address_space(4)))*)((ka) + 8 * (i)))
#define KOUT(ka) (*(float* const __attribute__((address_space(4)))*)((ka) + 176))
#define KWS(ka) (*(unsigned char* const __attribute__((address_space(4)))*)((ka) + 184))
#ifndef EPI_WT
#define EPI_WT 0
#endif
__device__ __forceinline__ void st16(void* p, u32x4 v) {
#if EPI_WT
    asm volatile("global_store_dwordx4 %0, %1, off sc1\n\ts_nop 1" :: "v"(p), "v"(v) : "memory");
#else
    *(u32x4*)p = v;
#endif
}
#define LDS_WAIT() asm volatile("s_waitcnt lgkmcnt(0)" ::: "memory")
#define VM_WAIT() asm volatile("s_waitcnt vmcnt(0)" ::: "memory")
#define WG_BAR() do { asm volatile("s_waitcnt lgkmcnt(0)" ::: "memory"); __builtin_amdgcn_s_barrier(); asm volatile("" ::: "memory"); } while (0)

namespace pg8 {
constexpr int BM = 256, BK = 64, HALF = 128, HTB = HALF * BK * 2, STAGE_BYTES = 8 * HTB, NXCD = 8, WGM = 8;
__host__ __device__ __forceinline__ int lds_byte(int r, int c) { const int st = (r >> 4) * 2 + (c >> 5), rr = r & 15, cc = c & 31, ob = rr * 64 + cc * 2; return st * 1024 + (ob ^ (((ob >> 9) & 1) << 5)); }
__host__ __device__ __forceinline__ void stage_rc(int b, int& R, int& C) { const int st = b / 1024, sb = b % 1024, swz = sb ^ (((sb >> 9) & 1) << 5); R = (st >> 1) * 16 + swz / 64; C = (st & 1) * 32 + (swz % 64) / 2; }
__host__ __device__ __forceinline__ int perm32(int rho) { const int n = rho >> 4, i = rho & 15; return 8 * (i >> 2) + 4 * n + (i & 3); }

struct Unit { int pm, pn; const char* a; const char* b; };
struct EpiCtx { int wr, wc, wid; LAS unsigned char* xl; };

template <class Map> struct Sched {
    int nM, nN, nwg, G, c, wgm; Map map;
    __device__ __forceinline__ void init(int nM_, int nN_, int G_, int c_, const Map& m, int wgm_ = WGM) { nM = nM_; nN = nN_; nwg = nM * nN; G = G_; c = c_; map = m; wgm = wgm_; }
    __device__ __forceinline__ bool next(int i, Unit& u) const {
        const long L = (long)i * G + c; if (L >= nwg) return false;
        int wgid = (int)L; { const int q = nwg / NXCD, r = nwg % NXCD, xcd = wgid % NXCD, off = wgid / NXCD; wgid = (xcd < r ? xcd * (q + 1) : r * (q + 1) + (xcd - r) * q) + off; }
        const int nig = wgm * nN, gid = wgid / nig, fm = gid * wgm, gsz = (nM - fm) < wgm ? (nM - fm) : wgm;
        u.pm = fm + ((wgid % nig) % gsz); u.pn = (wgid % nig) / gsz; map(u); return true;
    }
};

template <class Epi, class SchedT, bool SP2, bool GATHER = false, int BF = 0, bool BGAIN = false>
__device__ __forceinline__ void gemm_phase(const int wave_, LAS unsigned char* lds, LAS unsigned char* xl, const int K, const int lda, const int ldb, const SchedT& S, const Epi& E, const int* gidx = nullptr, const long bhoff = 0, const LAS float* bgl = nullptr) {
    constexpr bool ALIGN_EPI = true; static_assert(SP2 || !GATHER, "GATHER needs the SP2 loop"); static_assert(BF == 0 || (SP2 && Epi::PERM), "BF needs the SP2 loop and the PERM column order");
    const int lane = lane_id(), wid = wave_, tid = wid * 64 + lane, wr = wid >> 2, wc = wid & 3, fr = lane & 15, fq = lane >> 4;
    const int nt = K / BK;
    unsigned voffA[2], voffB[2];
#pragma unroll
    for (int i = 0; i < 2; ++i) { int R, C; stage_rc(tid * 16 + i * 8192, R, C); const int Rb = Epi::PERM ? ((R & ~31) + perm32(R & 31)) : R;
        voffA[i] = (unsigned)(R * lda + C * 2); voffB[i] = (unsigned)(Rb * ldb + C * 2); }
    const size_t kstep = (size_t)(BK * 2);
    const size_t hstepA = (size_t)HALF * lda, hstepB = (size_t)HALF * ldb;
    const unsigned ldsw = (unsigned)wid * 1024u;
    const int aoff = lds_byte(wr * 64 + fr, fq * 8), boff = lds_byte(wc * 32 + fr, fq * 8);
    const unsigned xoffA = (unsigned)tid * 16u;
    int gset = 0;
    const int bf_nb = lane & 15, bf_kq = lane >> 4, bf_m = (bf_nb >> 1) & 3, bf_kb = 32 * (wid >> 2) + 8 * bf_kq;
    const unsigned bf_src = (unsigned)(bf_kb * ldb + (64 * (wid & 1) + 4 * bf_nb) * 4);
    const long bf_h = ((wid & 3) >> 1) ? bhoff : 0;
    const unsigned bf_dst = (unsigned)(((wid & 3) >> 1) * HTB + (((64 * (wid & 1) + 32 * (bf_nb >> 3) + 16 * (bf_nb & 1)) >> 4) * 2 + (wid >> 2)) * 1024 + 256 * bf_m + ((16 * bf_kq) ^ ((bf_m >> 1) << 5)));
    f32x4 bq[8];
#define PG8_BISSUE(gbase) do { if constexpr (BF) { const char* gb_ = (const char*)(gbase) + bf_h; _Pragma("unroll") for (int i_ = 0; i_ < 8; ++i_) \
        asm volatile("global_load_dwordx4 %0, %1, %2" : "=v"(bq[i_]) : "v"(bf_src), "s"(gb_ + (size_t)i_ * ldb) : "memory"); } } while (0)
#define PG8_BWAIT(n) do { if constexpr (BF) asm volatile("s_waitcnt vmcnt(" #n ")" : "+v"(bq[0]), "+v"(bq[1]), "+v"(bq[2]), "+v"(bq[3]), "+v"(bq[4]), "+v"(bq[5]), "+v"(bq[6]), "+v"(bq[7]) :: "memory"); } while (0)
#define PG8_BCONS(b_, kt_) do { if constexpr (BF) { const unsigned ad_ = (unsigned)(size_t)lds + (unsigned)PG8_SB(b_, 0) + bf_dst; \
        if constexpr (BGAIN) { { const f32x4 g_ = *(const LAS f32x4*)(bgl + (kt_) * 64 + bf_kb); bq[0] = bq[0] * g_.x; bq[1] = bq[1] * g_.y; bq[2] = bq[2] * g_.z; bq[3] = bq[3] * g_.w; } \
                               { const f32x4 g_ = *(const LAS f32x4*)(bgl + (kt_) * 64 + bf_kb + 4); bq[4] = bq[4] * g_.x; bq[5] = bq[5] * g_.y; bq[6] = bq[6] * g_.z; bq[7] = bq[7] * g_.w; } } \
        _Pragma("unroll") for (int c_ = 0; c_ < 4; ++c_) { const u32x4 o_ = (u32x4){cvtpk(bq[0][c_], bq[1][c_]), cvtpk(bq[2][c_], bq[3][c_]), cvtpk(bq[4][c_], bq[5][c_]), cvtpk(bq[6][c_], bq[7][c_])}; \
            asm volatile("ds_write_b128 %0, %1 offset:%2" :: "v"(ad_), "v"(o_), "i"(c_ * 64) : "memory"); } } } while (0)
#define PG8_GSETUP(set, pm_) do { if constexpr (GATHER) { int R0_, C0_, R1_, C1_; stage_rc(tid * 16, R0_, C0_); stage_rc(tid * 16 + 8192, R1_, C1_); \
        const GAS int* gi_ = (const GAS int*)gidx + (pm_) * 256; const int r00_ = gi_[R0_], r01_ = gi_[R1_], r10_ = gi_[128 + R0_], r11_ = gi_[128 + R1_];     \
        *(LAS u32x4*)(xl + (set) * 8192 + xoffA) = (u32x4){(unsigned)(r00_ * lda + C0_ * 2), (unsigned)(r01_ * lda + C1_ * 2), (unsigned)(r10_ * lda + C0_ * 2), (unsigned)(r11_ * lda + C1_ * 2)}; } } while (0)
#define PG8_SA(b, h) (((b) * 2 + (h)) * HTB)
#define PG8_SB(b, h) ((4 + (b) * 2 + (h)) * HTB)
#define PG8_STAGE(bufoff, gbase, voff) do { _Pragma("unroll") for (int _i = 0; _i < 2; ++_i) \
        __builtin_amdgcn_global_load_lds((const unsigned*)((const char*)(gbase) + (voff)[_i]), (LAS unsigned*)(lds + (bufoff) + ldsw + _i * 8192), 16, 0, 0); } while (0)
#define PG8_GOFF(h_, set_) u32x2 go_ = {0u, 0u}; if constexpr (GATHER) go_ = *(const LAS u32x2*)(xl + (set_) * 8192 + xoffA + (h_) * 8)
#define PG8_STAGE_A(bufoff, gbase, h_, set_) do { if constexpr (GATHER) { \
        __builtin_amdgcn_global_load_lds((const unsigned*)((const char*)(gbase) + go_.x), (LAS unsigned*)(lds + (bufoff) + ldsw), 16, 0, 0); \
        __builtin_amdgcn_global_load_lds((const unsigned*)((const char*)(gbase) + go_.y), (LAS unsigned*)(lds + (bufoff) + ldsw + 8192), 16, 0, 0); } \
      else { PG8_STAGE(bufoff, (const char*)(gbase) + (h_) * hstepA, voffA); } } while (0)
#define PG8_LDA(dst, b, h) do { _Pragma("unroll") for (int m = 0; m < 4; ++m) _Pragma("unroll") for (int k = 0; k < 2; ++k) dst[m][k] = *(const LAS bf16x8*)(lds + PG8_SA(b, h) + aoff + m * 2048 + k * 1024); } while (0)
#define PG8_LDB(dst, b, h) do { _Pragma("unroll") for (int n = 0; n < 2; ++n) _Pragma("unroll") for (int k = 0; k < 2; ++k) dst[n][k] = *(const LAS bf16x8*)(lds + PG8_SB(b, h) + boff + n * 2048 + k * 1024); } while (0)
#define PG8_MMA(ai, bj, At, Bt) do { __builtin_amdgcn_s_setprio(1); _Pragma("unroll") for (int m = 0; m < 4; ++m) _Pragma("unroll") for (int n = 0; n < 2; ++n) _Pragma("unroll") for (int k = 0; k < 2; ++k) \
        acc[ai][bj][m][n] = __builtin_amdgcn_mfma_f32_16x16x32_bf16(Bt[n][k], At[m][k], acc[ai][bj][m][n], 0, 0, 0); __builtin_amdgcn_s_setprio(0); } while (0)
#define PG8_MMAX(ai, bj, At, Bt) do { _Pragma("unroll") for (int m = 0; m < 4; ++m) _Pragma("unroll") for (int n = 0; n < 2; ++n) _Pragma("unroll") for (int k = 0; k < 2; ++k) \
        acc[ai][bj][m][n] = __builtin_amdgcn_mfma_f32_16x16x32_bf16(Bt[n][k], At[m][k], acc[ai][bj][m][n], 0, 0, 0); } while (0)

#define PG8_WAIT_V(n) asm volatile("s_waitcnt vmcnt(" #n ")" ::: "memory")
#define PG8_WAIT_L(n) asm volatile("s_waitcnt lgkmcnt(" #n ")" ::: "memory")
#define PG8_BAR __builtin_amdgcn_s_barrier()
#define PG8_SCHED __builtin_amdgcn_sched_barrier(0)
    Unit cur, nxt; int ui = 0;
    if (!S.next(0, cur)) return;
    EpiCtx ctx; ctx.wr = wr; ctx.wc = wc; ctx.wid = wid; ctx.xl = xl;
    f32x4 acc[2][2][4][2];
#pragma unroll
    for (int a = 0; a < 2; ++a)
#pragma unroll
        for (int b = 0; b < 2; ++b)
#pragma unroll
            for (int m = 0; m < 4; ++m)
#pragma unroll
                for (int n = 0; n < 2; ++n) acc[a][b][m][n] = (f32x4){0.f, 0.f, 0.f, 0.f};
    bf16x8 At[4][2], B0[2][2], B1[2][2];
    const char* cA = cur.a; const char* cB = cur.b;
    PG8_GSETUP(0, cur.pm);
    const size_t kstepB = BF ? (size_t)BK * ldb : kstep;
    if constexpr (BF) {
        PG8_BISSUE(cB); { PG8_GOFF(0, 0); PG8_STAGE_A(PG8_SA(0, 0), cA, 0, 0); } { PG8_GOFF(1, 0); PG8_STAGE_A(PG8_SA(0, 1), cA, 1, 0); }
        if (wr == 1) PG8_BAR;
        PG8_BWAIT(2); PG8_BCONS(0, 0); PG8_WAIT_L(0); PG8_BAR;
        { PG8_GOFF(0, 0); PG8_STAGE_A(PG8_SA(1, 0), cA + kstep, 0, 0); } PG8_BISSUE(cB + kstepB);
        PG8_WAIT_V(10); PG8_BAR;
    } else if constexpr (SP2) {
        PG8_STAGE(PG8_SB(0, 0), cB, voffB); PG8_STAGE(PG8_SB(0, 1), cB + hstepB, voffB); { PG8_GOFF(0, 0); PG8_STAGE_A(PG8_SA(0, 0), cA, 0, 0); } { PG8_GOFF(1, 0); PG8_STAGE_A(PG8_SA(0, 1), cA, 1, 0); }
        if (wr == 1) PG8_BAR;
        PG8_WAIT_V(2); PG8_BAR;
        PG8_STAGE(PG8_SB(1, 0), cB + kstep, voffB); { PG8_GOFF(0, 0); PG8_STAGE_A(PG8_SA(1, 0), cA + kstep, 0, 0); } PG8_STAGE(PG8_SB(1, 1), cB + hstepB + kstep, voffB);
        PG8_WAIT_V(6); PG8_BAR;
    } else {
        PG8_STAGE(PG8_SB(0, 0), cB, voffB); PG8_STAGE(PG8_SA(0, 0), cA, voffA); PG8_STAGE(PG8_SB(0, 1), cB + hstepB, voffB); PG8_STAGE(PG8_SA(0, 1), cA + hstepA, voffA);
        if (wr == 1) PG8_BAR;
        PG8_WAIT_V(4); PG8_BAR;
        PG8_STAGE(PG8_SB(1, 0), cB + kstep, voffB); PG8_STAGE(PG8_SA(1, 0), cA + kstep, voffA); PG8_STAGE(PG8_SB(1, 1), cB + hstepB + kstep, voffB);
        PG8_WAIT_V(6); PG8_BAR;
    }
    for (;;) {
        const bool has_next = S.next(ui + 1, nxt);
        const char* nA = has_next ? nxt.a : cA; const char* nB = has_next ? nxt.b : cB;
        if (has_next) PG8_GSETUP(gset ^ 1, nxt.pm);
        for (int t = 0; t < nt; t += 2) {
            const bool last = (t == nt - 2);
            const char* a1 = cA + (size_t)(t + 1) * kstep;
            const char* a2 = last ? nA : cA + (size_t)(t + 2) * kstep; const char* b2 = last ? nB : cB + (size_t)(t + 2) * kstepB;
            const char* a3 = a2 + kstep; const char* b3 = b2 + kstepB;
            const int set2 = (last && has_next) ? (gset ^ 1) : gset;
            if constexpr (BF) {
            const int kt2 = last ? 0 : t + 2;
            { PG8_GOFF(1, gset); PG8_LDB(B0, 0, 0); PG8_LDB(B1, 0, 1); PG8_SCHED; PG8_LDA(At, 0, 0); PG8_STAGE_A(PG8_SA(1, 1), a1, 1, gset); }
            PG8_WAIT_V(12); PG8_WAIT_L(0); PG8_BAR; __builtin_amdgcn_s_setprio(1); PG8_MMAX(0, 0, At, B0); PG8_MMAX(0, 1, At, B1); __builtin_amdgcn_s_setprio(0); PG8_BAR; PG8_SCHED;
            { PG8_GOFF(0, set2); PG8_LDA(At, 0, 1); PG8_STAGE_A(PG8_SA(0, 0), a2, 0, set2); PG8_SCHED; PG8_BWAIT(4); PG8_BCONS(1, t + 1); PG8_SCHED; PG8_BISSUE(b2); }
            PG8_WAIT_L(0); PG8_BAR; __builtin_amdgcn_s_setprio(1); PG8_MMAX(1, 0, At, B0); PG8_MMAX(1, 1, At, B1); __builtin_amdgcn_s_setprio(0); PG8_BAR; PG8_SCHED;
            { PG8_GOFF(1, set2); PG8_LDB(B0, 1, 0); PG8_LDB(B1, 1, 1); PG8_SCHED; PG8_LDA(At, 1, 0); PG8_STAGE_A(PG8_SA(0, 1), a2, 1, set2); }
            PG8_WAIT_V(12); PG8_WAIT_L(0); PG8_BAR; __builtin_amdgcn_s_setprio(1); PG8_MMAX(0, 0, At, B0); PG8_MMAX(0, 1, At, B1); __builtin_amdgcn_s_setprio(0); PG8_BAR; PG8_SCHED;
            { PG8_GOFF(0, set2); PG8_LDA(At, 1, 1); PG8_STAGE_A(PG8_SA(1, 0), a3, 0, set2); PG8_SCHED; PG8_BWAIT(4); PG8_BCONS(0, kt2); PG8_SCHED; PG8_BISSUE(b3); }
            PG8_WAIT_L(0); PG8_BAR; __builtin_amdgcn_s_setprio(1); PG8_MMAX(1, 0, At, B0); PG8_MMAX(1, 1, At, B1); __builtin_amdgcn_s_setprio(0); PG8_BAR; PG8_SCHED;
            } else if constexpr (SP2) {
            { PG8_GOFF(1, gset); PG8_LDB(B0, 0, 0); PG8_LDB(B1, 0, 1); PG8_SCHED; PG8_LDA(At, 0, 0); PG8_STAGE_A(PG8_SA(1, 1), a1, 1, gset); }
            PG8_WAIT_V(8); PG8_WAIT_L(0); PG8_BAR; __builtin_amdgcn_s_setprio(1); PG8_MMAX(0, 0, At, B0); PG8_MMAX(0, 1, At, B1); __builtin_amdgcn_s_setprio(0); PG8_BAR; PG8_SCHED;
            { PG8_GOFF(0, set2); PG8_LDA(At, 0, 1); PG8_STAGE(PG8_SB(0, 0), b2, voffB); PG8_STAGE(PG8_SB(0, 1), b2 + hstepB, voffB); PG8_STAGE_A(PG8_SA(0, 0), a2, 0, set2); }
            PG8_WAIT_V(8); PG8_WAIT_L(0); PG8_BAR; __builtin_amdgcn_s_setprio(1); PG8_MMAX(1, 0, At, B0); PG8_MMAX(1, 1, At, B1); __builtin_amdgcn_s_setprio(0); PG8_BAR; PG8_SCHED;
            { PG8_GOFF(1, set2); PG8_LDB(B0, 1, 0); PG8_LDB(B1, 1, 1); PG8_SCHED; PG8_LDA(At, 1, 0); PG8_STAGE_A(PG8_SA(0, 1), a2, 1, set2); }
            PG8_WAIT_V(8); PG8_WAIT_L(0); PG8_BAR; __builtin_amdgcn_s_setprio(1); PG8_MMAX(0, 0, At, B0); PG8_MMAX(0, 1, At, B1); __builtin_amdgcn_s_setprio(0); PG8_BAR; PG8_SCHED;
            { PG8_GOFF(0, set2); PG8_LDA(At, 1, 1); PG8_STAGE(PG8_SB(1, 0), b3, voffB); PG8_STAGE(PG8_SB(1, 1), b3 + hstepB, voffB); PG8_STAGE_A(PG8_SA(1, 0), a3, 0, set2); }
            PG8_WAIT_V(8); PG8_WAIT_L(0); PG8_BAR; __builtin_amdgcn_s_setprio(1); PG8_MMAX(1, 0, At, B0); PG8_MMAX(1, 1, At, B1); __builtin_amdgcn_s_setprio(0); PG8_BAR; PG8_SCHED;
            } else {
            PG8_LDB(B0, 0, 0); PG8_SCHED; PG8_LDA(At, 0, 0); PG8_STAGE(PG8_SA(1, 1), a1 + hstepA, voffA);
            PG8_WAIT_L(8); PG8_BAR; PG8_WAIT_L(0); PG8_MMA(0, 0, At, B0); PG8_BAR; PG8_SCHED;
            PG8_LDB(B1, 0, 1); PG8_STAGE(PG8_SB(0, 0), b2, voffB);
            PG8_BAR; PG8_WAIT_L(0); PG8_MMA(0, 1, At, B1); PG8_BAR;
            PG8_LDA(At, 0, 1); PG8_STAGE(PG8_SA(0, 0), a2, voffA);
            PG8_BAR; PG8_WAIT_L(0); PG8_MMA(1, 0, At, B0); PG8_BAR; PG8_SCHED;
            PG8_STAGE(PG8_SB(0, 1), b2 + hstepB, voffB);
            PG8_WAIT_V(6); PG8_BAR; PG8_MMA(1, 1, At, B1); PG8_BAR;
            PG8_LDB(B0, 1, 0); PG8_SCHED; PG8_LDA(At, 1, 0); PG8_STAGE(PG8_SA(0, 1), a2 + hstepA, voffA);
            PG8_WAIT_L(8); PG8_BAR; PG8_WAIT_L(0); PG8_MMA(0, 0, At, B0); PG8_BAR; PG8_SCHED;
            PG8_LDB(B1, 1, 1); PG8_STAGE(PG8_SB(1, 0), b3, voffB);
            PG8_BAR; PG8_WAIT_L(0); PG8_MMA(0, 1, At, B1); PG8_BAR;
            PG8_LDA(At, 1, 1); PG8_STAGE(PG8_SA(1, 0), a3, voffA);
            PG8_BAR; PG8_WAIT_L(0); PG8_MMA(1, 0, At, B0); PG8_BAR; PG8_SCHED;
            PG8_STAGE(PG8_SB(1, 1), b3 + hstepB, voffB);
            PG8_WAIT_V(6); PG8_BAR; PG8_MMA(1, 1, At, B1); PG8_BAR;
            }
        }
        PG8_BWAIT(0);
        if constexpr (ALIGN_EPI) { if (wr == 0) PG8_BAR; }
        E(acc, cur, ctx);
        if (!has_next) break;
#pragma unroll
        for (int a = 0; a < 2; ++a)
#pragma unroll
            for (int b = 0; b < 2; ++b)
#pragma unroll
                for (int m = 0; m < 4; ++m)
#pragma unroll
                    for (int n = 0; n < 2; ++n) acc[a][b][m][n] = (f32x4){0.f, 0.f, 0.f, 0.f};
        cur = nxt; cA = nA; cB = nB; ++ui; gset ^= 1;
        if constexpr (ALIGN_EPI) { if (wr == 1) PG8_BAR; }
    }
    PG8_WAIT_V(0);
    if constexpr (!ALIGN_EPI) { if (wr == 0) PG8_BAR; }
    PG8_BAR;
#undef PG8_SA
#undef PG8_SB
#undef PG8_STAGE
#undef PG8_STAGE_A
#undef PG8_GOFF
#undef PG8_GSETUP
#undef PG8_BISSUE
#undef PG8_BWAIT
#undef PG8_BCONS
#undef PG8_LDA
#undef PG8_LDB
#undef PG8_MMA
#undef PG8_MMAX
#undef PG8_WAIT_V
#undef PG8_WAIT_L
#undef PG8_BAR
#undef PG8_SCHED
}
}

constexpr size_t MiB = 1u << 20;
constexpr size_t WS_CTL = 0, CTL_ZERO_BYTES = 1 * MiB;
constexpr size_t WS_WIN_T = 1 * MiB, WS_WF_T = 11 * MiB, WS_WOUT_T = 15 * MiB, WS_WCQ_T = 23 * MiB, WS_WCK_T = 39 * MiB, WS_WCV_T = 55 * MiB, WS_WCO_T = 71 * MiB;
constexpr size_t WS_WP_T = 87 * MiB, WS_DFT = 89 * MiB, WS_ROPE = 105 * MiB, WS_WGU_T = 106 * MiB, WS_WD_T = 234 * MiB;
constexpr size_t WS_HN = 298 * MiB, WS_XB = 330 * MiB, WS_QB = 362 * MiB, WS_KB = 386 * MiB, WS_VB = 394 * MiB, WS_FPQ = 402 * MiB, WS_MIXB = 418 * MiB, WS_QCB = 450 * MiB;
constexpr size_t WS_KCB = 482 * MiB, WS_VTB = 490 * MiB, WS_MEMNB = 498 * MiB, WS_PB = 506 * MiB, WS_XSB = 522 * MiB, WS_ACTB = 586 * MiB, WS_YB = 618 * MiB;
constexpr size_t WS_SSP = 682 * MiB, WS_AFF = 683 * MiB, WS_RANK = 684 * MiB, WS_GATE = 685 * MiB, WS_XALT = 686 * MiB, WS_WGU_T2 = 750 * MiB, WS_WD_T2 = 878 * MiB, WS_FAST_END = 942 * MiB;
constexpr int CW_TMO = 0, CW_CODE = 1, CW_BAR = 4096;
constexpr int RING_OFF = 0, RING_BYTES = 131072, XL_OFF = 131072, XL_BYTES = 16384, LDSCTL_OFF = XL_OFF + XL_BYTES, MISC_OFF = LDSCTL_OFF + 320, LDS_BYTES = 149504;
static_assert(MISC_OFF + 128 <= LDS_BYTES, "LDS map");
constexpr int NWAVES = 8;

typedef GAS unsigned gu32;
#define RLX_AGENT __ATOMIC_RELAXED, __HIP_MEMORY_SCOPE_AGENT

#define XB_TMO      128
#define XB_XCNT(j)  (256  + 64 * (j))
#define XB_XSUB(j)  (1280 + 64 * (j))
#define XB_XGEN(j)  (2304 + 64 * (j))
#define XB_TOP      3328
#define XB_TOPGEN   3392
#define XCD_BAR_WORDS 3456
#define XB_SPIN_CAP (1u << 18)
__device__ __forceinline__ unsigned xb_ld(unsigned* p)              { return __hip_atomic_load(p, __ATOMIC_RELAXED, __HIP_MEMORY_SCOPE_AGENT); }
__device__ __forceinline__ unsigned xb_add(unsigned* p, unsigned v) { return __hip_atomic_fetch_add(p, v, __ATOMIC_RELAXED, __HIP_MEMORY_SCOPE_AGENT); }
__device__ __forceinline__ unsigned xb_xcc_id() { return (unsigned)__builtin_amdgcn_s_getreg((3 << 11) | 20) & 0xFu; }
#define XB_SPIN(cond, bar) do { unsigned _sp = 0; while (cond) { __builtin_amdgcn_s_sleep(1); \
    if ((++_sp & 255u) == 0u) { if (xb_ld(&(bar)[XB_TMO])) break; if (_sp > XB_SPIN_CAP) { atomicAdd(&(bar)[XB_TMO], 1u); break; } } } } while (0)
struct XcdBarrier { unsigned* bar; unsigned x; volatile LAS unsigned* st; int wave; };
__device__ __forceinline__ XcdBarrier xcd_barrier_post(unsigned* bar, volatile LAS unsigned* st, int wave) {
    XcdBarrier b; b.bar = bar; b.x = xb_xcc_id(); b.st = st; b.wave = wave;
    if (wave == 0 && lane_id() == 0) (void)xb_add(&bar[XB_XCNT(b.x)], 1u);
    return b;
}
__device__ __forceinline__ void xcd_barrier_complete(unsigned* bar, unsigned x, unsigned& nloc, unsigned& nx) {
    const unsigned G = gridDim.x * gridDim.y * gridDim.z;
    unsigned sum, cnt, mine, sp = 0u;
    for (;;) {
        sum = 0u; cnt = 0u; mine = 0u;
#pragma unroll
        for (unsigned j = 0; j < 16; ++j) { const unsigned c = xb_ld(&bar[XB_XCNT(j)]); sum += c; cnt += (c > 0u) ? 1u : 0u; mine = (j == x) ? c : mine; }
        if (sum == G) break;
        __builtin_amdgcn_s_sleep(1);
        if ((++sp & 255u) == 0u) { if (xb_ld(&bar[XB_TMO])) break; if (sp > XB_SPIN_CAP) { atomicAdd(&bar[XB_TMO], 1u); break; } }
    }
    nloc = mine > 0u ? mine : 1u; nx = cnt > 0u ? cnt : 1u;
}
__device__ __forceinline__ void xcd_barrier(const XcdBarrier& b) {
    asm volatile("s_waitcnt vmcnt(0)" ::: "memory");
    __syncthreads();
    if (b.wave == 0 && lane_id() == 0) {
        unsigned* bar = b.bar;
        __builtin_amdgcn_s_waitcnt(0);
        unsigned nloc = b.st[0], nx = b.st[1];
        if (nloc == 0u) { xcd_barrier_complete(bar, b.x, nloc, nx); b.st[0] = nloc; b.st[1] = nx; }
        const unsigned old = xb_add(&bar[XB_XSUB(b.x)], 1u);
        const unsigned gen = old / nloc;
        if (old + 1u == (gen + 1u) * nloc) {
            __builtin_amdgcn_fence(__ATOMIC_RELEASE, "agent");
            asm volatile("s_waitcnt vmcnt(0)" ::: "memory");
            const unsigned og = xb_add(&bar[XB_TOP], 1u);
            const unsigned tg = og / nx;
            if (og + 1u == (tg + 1u) * nx) xb_add(&bar[XB_TOPGEN], 1u);
            else XB_SPIN(xb_ld(&bar[XB_TOPGEN]) == tg, bar);
            __builtin_amdgcn_fence(__ATOMIC_ACQUIRE, "agent");
            xb_add(&bar[XB_XGEN(b.x)], 1u);
            asm volatile("s_waitcnt vmcnt(0)" ::: "memory");
        } else {
            XB_SPIN(xb_ld(&bar[XB_XGEN(b.x)]) == gen, bar);
            __builtin_amdgcn_fence(__ATOMIC_ACQUIRE, "agent");
            asm volatile("s_waitcnt vmcnt(0)" ::: "memory");
        }
    }
    __syncthreads();
}

struct Args { const float* in[22]; float* out; unsigned char* ws; int ph_lo, ph_hi, li, pad; };
struct Frame {
    LAS unsigned char* lds; volatile LAS unsigned* MISC; gu32* ctl;
    int wave, vcu, G;
    unsigned char* ws;
};
__device__ __forceinline__ float wave_sum(float v) {
#pragma unroll
    for (int o = 1; o < 64; o <<= 1) v += __shfl_xor(v, o);
    return v;
}
struct TrDesc { const float* W; const float* gain; bf16_t* WT; int ldw, ldt, k0, n0; long drow0; };
__device__ __forceinline__ void tr_load(const TrDesc& d, f32x4 (&v)[16], int lane) {
    const int lr = lane >> 4, lc = (lane & 15) * 4;
#pragma unroll
    for (int i = 0; i < 16; ++i) v[i] = __builtin_nontemporal_load((const GAS f32x4*)(d.W + (size_t)(d.k0 + 4 * i + lr) * d.ldw + d.n0 + lc));
}
#ifndef TRV
#define TRV 0
#endif
template <int V> __device__ __forceinline__ void tr_finish(const TrDesc& d, const f32x4 (&v)[16], LAS float* scr, int lane) {
    const int lr = lane >> 4, lc = (lane & 15) * 4;
    if (V == 1) { f32x4 s = v[0]; for (int i = 1; i < 16; ++i) s = s + v[i]; if (s.x == 1.2345e30f) *(GAS f32x4*)(d.WT) = s; return; }
#pragma unroll
    for (int i = 0; i < 16; ++i) { const int kk = 4 * i + lr; f32x4 x = v[i]; if (d.gain) x = x * d.gain[d.k0 + kk];
        LAS float* s = scr + kk * 65 + lc; s[0] = x.x; s[1] = x.y; s[2] = x.z; s[3] = x.w; }
    LDS_WAIT(); asm volatile("" ::: "memory");
    const int c = lane & 7;
#pragma unroll
    for (int j = 0; j < 8; ++j) { const int n = (lane >> 3) + 8 * j; const LAS float* s = scr + (8 * c) * 65 + n;
        u32x4 o; o.x = cvtpk(s[0 * 65], s[1 * 65]); o.y = cvtpk(s[2 * 65], s[3 * 65]); o.z = cvtpk(s[4 * 65], s[5 * 65]); o.w = cvtpk(s[6 * 65], s[7 * 65]);
        if (V == 0 || o.x == 0x12345678u) __builtin_nontemporal_store(o, (GAS u32x4*)(d.WT + (size_t)(d.drow0 + n) * d.ldt + d.k0 + 8 * c)); }
    LDS_WAIT(); asm volatile("" ::: "memory");
}
#ifndef TR_PIPE
#define TR_PIPE 0
#endif
constexpr int TR_DENSE = 32 * 20 + 5 * 32 * 16, TR_DEFER = 4 * 32 * 16 + 32 * 4, TR_EXPERT = NE * 512;
__device__ __forceinline__ TrDesc tr_desc(karg_t ka, unsigned char* ws, int it, int mode) {
    TrDesc d; d.gain = nullptr;
    constexpr int I_IN = 32 * 20, I_SQ = 32 * 16;
    if (mode == 0 || mode == 3) {
        int r = it;
        if (mode == 0) {
            if (r < I_IN) { d.W = KIN(ka, 3); d.ldw = INW; d.WT = (bf16_t*)(ws + WS_WIN_T); d.ldt = DM; d.k0 = (r / 20) * 64; d.n0 = (r % 20) * 128; d.drow0 = d.n0; return d; } r -= I_IN;
            if (r < I_SQ) { d.W = KIN(ka, 7); d.ldw = DM; d.WT = (bf16_t*)(ws + WS_WOUT_T); d.ldt = DM; d.k0 = (r / 16) * 64; d.n0 = (r % 16) * 128; d.drow0 = d.n0; return d; } r -= I_SQ;
        }
        if (r < 4 * I_SQ) { const int j = r / I_SQ, q = r % I_SQ, layer = mode == 0 ? 0 : 1, wsel = mode == 0 ? j : (j == 0 ? 1 : j == 1 ? 2 : j == 2 ? 0 : 3);
            d.W = KIN(ka, 12 + wsel) + (size_t)layer * DM * DM; d.ldw = DM; if (wsel == 0) d.gain = KIN(ka, 10) + layer * DM;
            d.WT = (bf16_t*)(ws + (wsel == 0 ? WS_WCQ_T : wsel == 1 ? WS_WCK_T : wsel == 2 ? WS_WCV_T : WS_WCO_T) + (size_t)layer * DM * DM * 2); d.ldt = DM;
            d.k0 = (q / 16) * 64; d.n0 = (q % 16) * 128; d.drow0 = d.n0; return d; } r -= 4 * I_SQ;
        d.W = KIN(ka, 8); d.ldw = 512; d.WT = (bf16_t*)(ws + WS_WP_T); d.ldt = DM; d.k0 = (r / 4) * 64; d.n0 = (r % 4) * 128; d.drow0 = d.n0; return d;
    }
    const int layer = mode - 1;
    const int e = it / 512, r = it % 512; const size_t eo = (size_t)(layer * NE + e);
    { const int up = r >> 8, q = r & 255, kb = q >> 3, nb = q & 7, n0 = nb * 128;
        d.W = (up ? KIN(ka, 19) : KIN(ka, 18)) + eo * DM * EFF; d.ldw = EFF; d.gain = KIN(ka, 16) + layer * DM;   d.WT = (bf16_t*)(ws + (layer ? WS_WGU_T2 : WS_WGU_T)) + (size_t)e * 2048 * 2048; d.ldt = 2048;
        d.k0 = kb * 64; d.n0 = n0; d.drow0 = (long)(n0 >> 7) * 256 + up * 128;
    }
    return d;
}
template <int V = 0> __device__ __forceinline__ void tr_span(const Frame& F, karg_t ka, unsigned char* ws, int mode, int first, int stride, int cnt) {
    const int lane = lane_id(); LAS float* scr = (LAS float*)(F.lds + RING_OFF + F.wave * 16640);
    if (cnt <= 0) return;
    f32x4 va[16], vb[16];
    TrDesc da = tr_desc(ka, ws, first, mode), db = da; db.n0 += 64; db.drow0 += 64;
    tr_load(da, va, lane); tr_load(db, vb, lane);
    for (int j = 0; j < cnt; ++j) {
        const bool more = j + 1 < cnt; TrDesc na = da, nb = db;
        if (more) { na = tr_desc(ka, ws, first + stride * (j + 1), mode); nb = na; nb.n0 += 64; nb.drow0 += 64; }
        tr_finish<V>(da, va, scr, lane); if (more) tr_load(na, va, lane);
        tr_finish<V>(db, vb, scr, lane); if (more) tr_load(nb, vb, lane);
        da = na; db = nb;
    }
}
__device__ __forceinline__ void rms_row_to_bf16(const float* xrow, const float* __restrict__ gain, bf16_t* orow, int lane) {
    const GAS f32x4* xr = (const GAS f32x4*)xrow + lane; const f32x4* gr = (const f32x4*)gain + lane;
    f32x4 v[8]; float s = 0.f;
#pragma unroll
    for (int j = 0; j < 8; ++j) { v[j] = xr[64 * j]; s += (v[j].x * v[j].x + v[j].y * v[j].y) + (v[j].z * v[j].z + v[j].w * v[j].w); }
    const float r = rsqrtf(wave_sum(s) * (1.f / DM) + EPS);
    GAS u32x2* o8 = (GAS u32x2*)orow + lane;
#pragma unroll
    for (int j = 0; j < 8; ++j) { const f32x4 g = gr[64 * j]; u32x2 w; w.x = cvtpk(v[j].x * r * g.x, v[j].y * r * g.y); w.y = cvtpk(v[j].z * r * g.z, v[j].w * r * g.w); o8[64 * j] = w; }
}

__device__ __forceinline__ void rms_rows2_to_bf16(const float* x0, const float* x1, const float* __restrict__ gain, bf16_t* o0, bf16_t* o1, int lane) {
    f32x4 a[4][2], b[4][2]; float sa = 0.f, sb = 0.f;
#pragma unroll
    for (int j = 0; j < 4; ++j) { const int c0 = 8 * (lane + 64 * j); a[j][0] = *(const GAS f32x4*)(x0 + c0); a[j][1] = *(const GAS f32x4*)(x0 + c0 + 4); b[j][0] = *(const GAS f32x4*)(x1 + c0); b[j][1] = *(const GAS f32x4*)(x1 + c0 + 4); }
#pragma unroll
    for (int j = 0; j < 4; ++j)
#pragma unroll
        for (int q = 0; q < 2; ++q) { sa += (a[j][q].x * a[j][q].x + a[j][q].y * a[j][q].y) + (a[j][q].z * a[j][q].z + a[j][q].w * a[j][q].w); sb += (b[j][q].x * b[j][q].x + b[j][q].y * b[j][q].y) + (b[j][q].z * b[j][q].z + b[j][q].w * b[j][q].w); }
    const float ra = rsqrtf(wave_sum(sa) * (1.f / DM) + EPS), rb = rsqrtf(wave_sum(sb) * (1.f / DM) + EPS);
#pragma unroll
    for (int j = 0; j < 4; ++j) { const int c0 = 8 * (lane + 64 * j); const f32x4 g0 = *(const f32x4*)(gain + c0), g1 = *(const f32x4*)(gain + c0 + 4);
        *(GAS u32x4*)(o0 + c0) = (u32x4){cvtpk(a[j][0].x * ra * g0.x, a[j][0].y * ra * g0.y), cvtpk(a[j][0].z * ra * g0.z, a[j][0].w * ra * g0.w), cvtpk(a[j][1].x * ra * g1.x, a[j][1].y * ra * g1.y), cvtpk(a[j][1].z * ra * g1.z, a[j][1].w * ra * g1.w)};
        *(GAS u32x4*)(o1 + c0) = (u32x4){cvtpk(b[j][0].x * rb * g0.x, b[j][0].y * rb * g0.y), cvtpk(b[j][0].z * rb * g0.z, b[j][0].w * rb * g0.w), cvtpk(b[j][1].x * rb * g1.x, b[j][1].y * rb * g1.y), cvtpk(b[j][1].z * rb * g1.z, b[j][1].w * rb * g1.w)}; }
}

__device__ __forceinline__ void p0_prologue(Frame& F, karg_t ka, unsigned char* ws) {
    const float* x = KIN(ka, 0); const float* mem = KIN(ka, 1); const float* mix_norm = KIN(ka, 2); const float* w_in = KIN(ka, 3);
    const float* w_four = KIN(ka, 6); const float* w_out = KIN(ka, 7); const float* pool_w = KIN(ka, 8); const float* cross_norm = KIN(ka, 10); const float* mem_norm = KIN(ka, 11);
    const int gw = F.vcu * NWAVES + F.wave, NGW = F.G * NWAVES;
    const int p_lane = lane_id(), p_tid = F.wave * 64 + p_lane;
    { LAS float* tab = (LAS float*)(F.lds + RING_OFF);
      for (int m = p_tid; m < 2048; m += 512) tab[m] = cosf(6.283185307179586f * (float)m * (1.0f / 2048.0f));
      __syncthreads();
      bf16_t* DFT = (bf16_t*)(ws + WS_DFT);
      for (int row = F.vcu * 8; row < 2048; row += F.G * 8)
          for (int rr = 0; rr < 8; ++rr) { const int k1 = row + rr; if (k1 >= 2048) break;
              { const int c0 = p_tid * 8; const int which = c0 >> 11, s0 = c0 & 2047; unsigned w[4];
#pragma unroll
                for (int j = 0; j < 4; ++j) { const int ma = (k1 * (s0 + 2 * j)) & 2047, mb = (k1 * (s0 + 2 * j + 1)) & 2047;
                    w[j] = cvtpk(tab[(ma - which * 512) & 2047], tab[(mb - which * 512) & 2047]); }
                *(GAS u32x4*)(DFT + (size_t)k1 * 4096 + c0) = (u32x4){w[0], w[1], w[2], w[3]}; } }
      __syncthreads(); }
    { float* RC = (float*)(ws + WS_ROPE); float* RS = RC + SEQ * 64;
      for (int i = F.vcu * 512 + p_tid; i < SEQ * 64; i += F.G * 512) { const int t = i >> 6, p = i & 63; const int pos = (p < 32) ? (t >> 6) : (t & 63); const int j = p & 31;
          const float inv = 1.0f / powf(10000.0f, (float)(2 * j) / 64.0f); const float ang = (float)pos * inv; RC[i] = cosf(ang); RS[i] = sinf(ang); } }
    { u32x4* RB = (u32x4*)(ws + WS_AFF + 512 * 1024);
      for (int i = F.vcu * 512 + p_tid; i < 2 * 64 * 64; i += F.G * 512) { const int layer = i >> 12, ks = (i >> 6) & 63, ln = i & 63, e = ln & 15, k0 = 32 * ks + 8 * (ln >> 4);
          const float* Wr = KIN(ka, 17) + (size_t)layer * DM * NE; const float* gn = KIN(ka, 16) + layer * DM; float w[8], lo[8];
#pragma unroll
          for (int j = 0; j < 8; ++j) { w[j] = gn[k0 + j] * Wr[(size_t)(k0 + j) * NE + e]; }
          u32x4 hi4 = {cvtpk(w[0], w[1]), cvtpk(w[2], w[3]), cvtpk(w[4], w[5]), cvtpk(w[6], w[7])};
          const unsigned hh[4] = {hi4.x, hi4.y, hi4.z, hi4.w};
#pragma unroll
          for (int j = 0; j < 4; ++j) { lo[2 * j] = w[2 * j] - __uint_as_float(hh[j] << 16); lo[2 * j + 1] = w[2 * j + 1] - __uint_as_float(hh[j] & 0xffff0000u); }
          RB[(size_t)(layer * 2 + 0) * 4096 + ks * 64 + ln] = hi4;
          RB[(size_t)(layer * 2 + 1) * 4096 + ks * 64 + ln] = (u32x4){cvtpk(lo[0], lo[1]), cvtpk(lo[2], lo[3]), cvtpk(lo[4], lo[5]), cvtpk(lo[6], lo[7])}; } }
    { LAS float* Mw = (LAS float*)(F.lds + RING_OFF); LAS float* t128 = Mw + 128 * 32;
      bf16_t* WF = (bf16_t*)(ws + WS_WF_T);
      for (int it = F.vcu; it < 256; it += F.G) {
          const int which = it >> 7, g = (it >> 5) & 3, d0 = ((it >> 3) & 3) * 32, k0 = (it & 7) * 256;
          if (p_tid < 128) t128[p_tid] = cosf(6.283185307179586f * (float)p_tid * (1.0f / 128.0f));
          __syncthreads();
          { const int c = p_tid >> 2, dd = (p_tid & 3) * 8; float o[8] = {0.f, 0.f, 0.f, 0.f, 0.f, 0.f, 0.f, 0.f};
#pragma unroll 16
            for (int k2 = 0; k2 < 128; ++k2) { const int m = (c * k2) & 127; const float tv = which ? -t128[(m - 32) & 127] : t128[m];
                const float* wr_ = w_four + ((size_t)g * 128 + k2) * 128 + d0 + dd; const f32x4 w0 = *(const f32x4*)wr_, w1 = *(const f32x4*)(wr_ + 4);
                o[0] += tv * w0.x; o[1] += tv * w0.y; o[2] += tv * w0.z; o[3] += tv * w0.w; o[4] += tv * w1.x; o[5] += tv * w1.y; o[6] += tv * w1.z; o[7] += tv * w1.w; }
#pragma unroll
            for (int j = 0; j < 8; ++j) Mw[c * 32 + dd + j] = o[j] * (1.0f / 512.0f); }
          __syncthreads();
          { const int kp = p_tid & 127, dq = p_tid >> 7, k = k0 + 2 * kp; float o0[8] = {0.f, 0.f, 0.f, 0.f, 0.f, 0.f, 0.f, 0.f}, o1[8] = {0.f, 0.f, 0.f, 0.f, 0.f, 0.f, 0.f, 0.f};
            const float* r0 = w_in + (size_t)k * INW + 2560 + g * 128; const float* r1 = r0 + INW;
#pragma unroll 8
            for (int c4 = 0; c4 < 32; ++c4) { const f32x4 a = *(const f32x4*)(r0 + 4 * c4), b = *(const f32x4*)(r1 + 4 * c4); const float av[4] = {a.x, a.y, a.z, a.w}, bv[4] = {b.x, b.y, b.z, b.w};
#pragma unroll
                for (int cc = 0; cc < 4; ++cc) { const LAS float* mr = Mw + (4 * c4 + cc) * 32 + dq * 8;
#pragma unroll
                    for (int j = 0; j < 8; ++j) { o0[j] += av[cc] * mr[j]; o1[j] += bv[cc] * mr[j]; } } }
#pragma unroll
            for (int j = 0; j < 8; ++j) *(GAS unsigned*)(WF + (size_t)(which * 512 + g * 128 + d0 + dq * 8 + j) * DM + k) = cvtpk(o0[j], o1[j]); }
          __syncthreads(); } }
    { const int n = (TR_DENSE - gw + NGW - 1) / NGW; tr_span(F, ka, ws, 0, gw, NGW, n > 0 ? n : 0); }
    __syncthreads();
    for (int m = 2 * gw; m < NTOK; m += 2 * NGW) rms_rows2_to_bf16(x + (size_t)m * DM, x + (size_t)(m + 1) * DM, mix_norm, (bf16_t*)(ws + WS_HN) + (size_t)m * DM, (bf16_t*)(ws + WS_HN) + (size_t)(m + 1) * DM, p_lane);
    for (int m = gw; m < 2 * NB * MEML; m += NGW) { const int l = m / (NB * MEML), r = m % (NB * MEML);
        rms_row_to_bf16(mem + (size_t)r * DM, mem_norm + l * DM, (bf16_t*)(ws + WS_MEMNB) + (size_t)m * DM, p_lane); }
}

struct MapLin { const char* A; const char* B; size_t as, bs; __device__ __forceinline__ void operator()(pg8::Unit& u) const { u.a = A + (size_t)u.pm * as; u.b = B + (size_t)u.pn * bs; } };

struct EpiQKV {
    static constexpr bool PERM = true;
    bf16_t* Q; bf16_t* K; bf16_t* V; const float* qg; const float* kg; const float* RC; const float* RS;
    __device__ __forceinline__ void operator()(f32x4 (&acc)[2][2][4][2], const pg8::Unit& u, const pg8::EpiCtx& c) const { const int e_lane = lane_id(), e_fr = e_lane & 15, e_fq = e_lane >> 4;
        const int pn = u.pn, hc = c.wc * 32 + e_fq * 8, rl0 = c.wr * 64 + e_fr;
        if (pn >= 8) {
            bf16_t* base = V + (size_t)(u.pm * 256 + rl0) * KVW + (pn - 8) * 256 + hc;
#pragma unroll
            for (int ai = 0; ai < 2; ++ai)
#pragma unroll
                for (int m = 0; m < 4; ++m) { bf16_t* rowp = base + (size_t)(ai * 128 + m * 16) * KVW;
#pragma unroll
                    for (int bj = 0; bj < 2; ++bj) { const f32x4 v0 = acc[ai][bj][m][0], v1 = acc[ai][bj][m][1];
                        st16((rowp + bj * 128), (u32x4){cvtpk(v0.x, v0.y), cvtpk(v0.z, v0.w), cvtpk(v1.x, v1.y), cvtpk(v1.z, v1.w)}); } }
            return;
        }
        LAS float* part = (LAS float*)c.xl;
#pragma unroll
        for (int ai = 0; ai < 2; ++ai)
#pragma unroll
            for (int m = 0; m < 4; ++m)
#pragma unroll
                for (int bj = 0; bj < 2; ++bj) { const f32x4 v0 = acc[ai][bj][m][0], v1 = acc[ai][bj][m][1];
                    float s = (v0.x * v0.x + v0.y * v0.y) + (v0.z * v0.z + v0.w * v0.w) + (v1.x * v1.x + v1.y * v1.y) + (v1.z * v1.z + v1.w * v1.w);
                    s += __shfl_xor(s, 16); s += __shfl_xor(s, 32);
                    if (e_fq == 0) part[((ai * 128 + rl0 + m * 16) * 2 + bj) * 4 + c.wc] = s; }
        WG_BAR();
        const float* gain = pn < 6 ? qg : kg;
        const f32x4 g0 = *(const f32x4*)(gain + hc), g1 = *(const f32x4*)(gain + hc + 4);
        bf16_t* O = pn < 6 ? Q : K; const int ld = pn < 6 ? AW : KVW; const int colbase = (pn < 6 ? pn : pn - 6) * 256 + hc;
#pragma unroll
        for (int ai = 0; ai < 2; ++ai)
#pragma unroll
            for (int m = 0; m < 4; ++m) { const int rl = ai * 128 + rl0 + m * 16, row = u.pm * 256 + rl, sp = row & (SEQ - 1);
                const f32x4 cs = *(const f32x4*)(RC + sp * 64 + (hc >> 1)), sn = *(const f32x4*)(RS + sp * 64 + (hc >> 1));
#pragma unroll
                for (int bj = 0; bj < 2; ++bj) { const f32x4 p4 = *(const LAS f32x4*)(part + (rl * 2 + bj) * 4);
                    const float r = rsqrtf(((p4.x + p4.y) + (p4.z + p4.w)) * (1.0f / 128.0f) + EPS);
                    const f32x4 v0 = acc[ai][bj][m][0] * r * g0, v1 = acc[ai][bj][m][1] * r * g1;
                    u32x4 w; w.x = cvtpk(v0.x * cs.x - v0.y * sn.x, v0.x * sn.x + v0.y * cs.x); w.y = cvtpk(v0.z * cs.y - v0.w * sn.y, v0.z * sn.y + v0.w * cs.y);
                    w.z = cvtpk(v1.x * cs.z - v1.y * sn.z, v1.x * sn.z + v1.y * cs.z); w.w = cvtpk(v1.z * cs.w - v1.w * sn.w, v1.z * sn.w + v1.w * cs.w);
                    st16((O + (size_t)row * ld + colbase + bj * 128), w); } }
    }
};


template <class AddrF> struct EpiStore {
    static constexpr bool PERM = true; AddrF f;
    __device__ __forceinline__ void operator()(f32x4 (&acc)[2][2][4][2], const pg8::Unit& u, const pg8::EpiCtx& c) const { const int e_lane = lane_id(), e_fr = e_lane & 15, e_fq = e_lane >> 4;
        const int hc = c.wc * 32 + e_fq * 8, rl0 = c.wr * 64 + e_fr;
#pragma unroll
        for (int ai = 0; ai < 2; ++ai)
#pragma unroll
            for (int m = 0; m < 4; ++m)
#pragma unroll
                for (int bj = 0; bj < 2; ++bj) { const f32x4 v0 = acc[ai][bj][m][0], v1 = acc[ai][bj][m][1];
                    st16(f(u, ai * 128 + rl0 + m * 16, bj * 128 + hc), (u32x4){cvtpk(v0.x, v0.y), cvtpk(v0.z, v0.w), cvtpk(v1.x, v1.y), cvtpk(v1.z, v1.w)}); }
    }
};
struct AddrF1 { bf16_t* FPQ; __device__ __forceinline__ bf16_t* operator()(const pg8::Unit& u, int rl, int tc) const {
    const int r = u.pm * 256 + rl, which = r >> 9, n = r & 511, cidx = u.pn * 256 + tc, b = cidx >> 11, s = cidx & 2047; return FPQ + (((size_t)(b * 512 + n) * 2 + which) * 2048 + s); } };
struct AddrF2 { bf16_t* MIX; __device__ __forceinline__ bf16_t* operator()(const pg8::Unit& u, int rl, int tc) const {
    const int row = (u.pn >> 1) * 2048 + u.pm * 256 + rl, col = AW + (u.pn & 1) * 256 + tc; return MIX + (size_t)row * DM + col; } };

template <bool BF32> struct EpiResB {
    static constexpr bool PERM = true;
    const void* base; bf16_t* xo; float* ssp; const float* cscale; bf16_t* xg; const float* gv;
    __device__ __forceinline__ void operator()(f32x4 (&acc)[2][2][4][2], const pg8::Unit& u, const pg8::EpiCtx& c) const { const int e_lane = lane_id(), e_fr = e_lane & 15, e_fq = e_lane >> 4;
        const int hc = c.wc * 32 + e_fq * 8, rl0 = c.wr * 64 + e_fr;
        LAS float* part = (LAS float*)c.xl;
#pragma unroll
        for (int ai = 0; ai < 2; ++ai) {
            f32x4 bf0[4][2], bf1[4][2]; u32x4 bb[4][2];
#pragma unroll
            for (int m = 0; m < 4; ++m)
#pragma unroll
                for (int bj = 0; bj < 2; ++bj) { const size_t off = (size_t)(u.pm * 256 + ai * 128 + rl0 + m * 16) * DM + u.pn * 256 + bj * 128 + hc;
                    if (BF32) { bf0[m][bj] = *(const f32x4*)((const float*)base + off); bf1[m][bj] = *(const f32x4*)((const float*)base + off + 4); }
                    else bb[m][bj] = *(const u32x4*)((const bf16_t*)base + off); }
#pragma unroll
            for (int m = 0; m < 4; ++m) { const int rl = ai * 128 + rl0 + m * 16; float s = 0.f;
#pragma unroll
                for (int bj = 0; bj < 2; ++bj) { const int col = u.pn * 256 + bj * 128 + hc; const size_t off = (size_t)(u.pm * 256 + rl) * DM + col;
                    f32x4 v0 = acc[ai][bj][m][0], v1 = acc[ai][bj][m][1];
                    if (cscale) { v0 = v0 * *(const f32x4*)(cscale + col); v1 = v1 * *(const f32x4*)(cscale + col + 4); }
                    if (BF32) { v0 = v0 + bf0[m][bj]; v1 = v1 + bf1[m][bj]; }
                    else { const u32x4 b = bb[m][bj];
                        v0.x += __uint_as_float(b.x << 16); v0.y += __uint_as_float(b.x & 0xffff0000u); v0.z += __uint_as_float(b.y << 16); v0.w += __uint_as_float(b.y & 0xffff0000u);
                        v1.x += __uint_as_float(b.z << 16); v1.y += __uint_as_float(b.z & 0xffff0000u); v1.z += __uint_as_float(b.w << 16); v1.w += __uint_as_float(b.w & 0xffff0000u); }
                    st16((xo + off), (u32x4){cvtpk(v0.x, v0.y), cvtpk(v0.z, v0.w), cvtpk(v1.x, v1.y), cvtpk(v1.z, v1.w)});
                    if (xg) { const f32x4 g0 = *(const f32x4*)(gv + col), g1 = *(const f32x4*)(gv + col + 4);
                        st16((xg + off), (u32x4){cvtpk(v0.x * g0.x, v0.y * g0.y), cvtpk(v0.z * g0.z, v0.w * g0.w), cvtpk(v1.x * g1.x, v1.y * g1.y), cvtpk(v1.z * g1.z, v1.w * g1.w)}); }
                    if (ssp) s += ((v0.x * v0.x + v0.y * v0.y) + (v0.z * v0.z + v0.w * v0.w)) + ((v1.x * v1.x + v1.y * v1.y) + (v1.z * v1.z + v1.w * v1.w)); }
                if (ssp) { s += __shfl_xor(s, 16); s += __shfl_xor(s, 32); if (e_fq == 0) part[rl * 4 + c.wc] = s; } }
            asm volatile("" ::: "memory"); }
        if (ssp) { WG_BAR();
            if (e_lane < 32) { const int row = c.wid * 32 + e_lane; const f32x4 p4 = *(const LAS f32x4*)(part + row * 4);
                ssp[(size_t)(u.pm * 256 + row) * 8 + u.pn] = (p4.x + p4.y) + (p4.z + p4.w); }
            WG_BAR(); }
    }
};

namespace attn {
using s16x4 = __attribute__((ext_vector_type(4))) short;
using f32x16 = __attribute__((ext_vector_type(16))) float;
constexpr int D = 128, NW = 8, QBLK = 32, KVBLK = 64;
constexpr float SCALE = 0.088388347648318440f;
constexpr float THR = 8.f;
#ifndef ATT_SDEPTH
#define ATT_SDEPTH 2
#endif
constexpr int LDQ = AW, LDK = KVW, LDO = DM;
constexpr size_t SHM_V = KVBLK * D * 2, SHM_K = KVBLK * D * 2, SHM_ATTN = 3 * SHM_V + 3 * SHM_K + NW * 64 * 4;
#define KSWZ(row, colB) ((row) * 256 + ((colB) ^ (((row) & 7) << 4)))
#define SBAR() __builtin_amdgcn_sched_barrier(0)
__device__ __forceinline__ int crow(int r, int hi) { return (r & 3) + 8 * (r >> 2) + 4 * hi; }
__device__ __forceinline__ unsigned cvtpk_a(float lo, float hi) { unsigned r; asm volatile("v_cvt_pk_bf16_f32 %0, %1, %2" : "=v"(r) : "v"(lo), "v"(hi)); return r; }
template <bool FM> __device__ __forceinline__ void partialSM(f32x16& p0, f32x16& p1, float& m_reg, float& mn, float& alpha) {
  constexpr float C = SCALE * 1.4426950408889634f;
  if constexpr (FM) { mn = m_reg; alpha = 1.f;
    for (int r = 0; r < 16; ++r) p0[r] = __builtin_amdgcn_exp2f(p0[r]); return; }
  float pmax = p0[0]; for (int r = 1; r < 16; ++r) pmax = fmaxf(pmax, p0[r]); for (int r = 0; r < 16; ++r) pmax = fmaxf(pmax, p1[r]);
  { auto rr = __builtin_amdgcn_permlane32_swap(__float_as_uint(pmax), __float_as_uint(pmax), false, false);
    pmax = fmaxf(__uint_as_float(rr[0]), __uint_as_float(rr[1])); }
  if (__builtin_expect(__all(pmax - m_reg <= THR / SCALE), 1)) { mn = m_reg; alpha = 1.f; }
  else { mn = fmaxf(m_reg, pmax); alpha = __builtin_amdgcn_exp2f((m_reg - mn) * C); m_reg = mn; }
  float mnC = -mn * C;
  for (int r = 0; r < 16; ++r) p0[r] = fmaf(p0[r], C, mnC); for (int r = 0; r < 16; ++r) p1[r] = fmaf(p1[r], C, mnC);
  for (int r = 0; r < 16; ++r) p0[r] = __builtin_amdgcn_exp2f(p0[r]);
}
__device__ __forceinline__ void finishSM(f32x16& p0, f32x16& p1, float alpha, float& l_reg, bf16x8& pa0, bf16x8& pa1, bf16x8& pa2, bf16x8& pa3) {
  for (int r = 0; r < 16; ++r) p1[r] = __builtin_amdgcn_exp2f(p1[r]);
  float ps = 0; for (int r = 0; r < 16; ++r) ps += p0[r]; for (int r = 0; r < 16; ++r) ps += p1[r];
  { auto rr = __builtin_amdgcn_permlane32_swap(__float_as_uint(ps), __float_as_uint(ps), false, false);
    ps = __uint_as_float(rr[0]) + __uint_as_float(rr[1]); }
  l_reg = l_reg * alpha + ps;
#define PK4(P, BASE, OUT) do { u32x4 w = {cvtpk_a(P[BASE + 0], P[BASE + 1]), cvtpk_a(P[BASE + 2], P[BASE + 3]), cvtpk_a(P[BASE + 4], P[BASE + 5]), cvtpk_a(P[BASE + 6], P[BASE + 7])}; \
    OUT = *reinterpret_cast<bf16x8*>(&w); } while (0)
  PK4(p0, 0, pa0); PK4(p0, 8, pa1); PK4(p1, 0, pa2); PK4(p1, 8, pa3);
#undef PK4
}
__device__ __forceinline__ void qkt(f32x16& p0, f32x16& p1, const bf16_t* Ks, const bf16x8* qr, int r32, int hi) {
  p0 = f32x16{}; p1 = f32x16{};
  for (int d0 = 0; d0 < 8; ++d0) { int cb = (d0 * 16 + hi * 8) * 2;
    bf16x8 b0 = *reinterpret_cast<const bf16x8*>((const char*)Ks + KSWZ(r32, cb));
    bf16x8 b1 = *reinterpret_cast<const bf16x8*>((const char*)Ks + KSWZ(32 + r32, cb));
    p0 = __builtin_amdgcn_mfma_f32_32x32x16_bf16(b0, qr[d0], p0, 0, 0, 0);
    p1 = __builtin_amdgcn_mfma_f32_32x32x16_bf16(b1, qr[d0], p1, 0, 0, 0); }
}
__device__ __forceinline__ int v_st(int k, int c) { const int kk = k;     return ((kk >> 3) * 4 + (c >> 5)) * 512 + ((kk & 7) * 32 + (c & 31)) * 2; }
__device__ __forceinline__ int v_rd_base(int lane) { return ((lane & 3) << 3) | (((lane >> 2) & 3) << 6) | (((lane >> 4) & 1) << 5) | (((lane >> 5) & 1) << 8); }
constexpr int v_rd_off(int d0, int ks, int half) { return d0 * 512 + ks * 4096 + half * 2048; }
template <int OFF> __device__ __forceinline__ s16x4 tr_read(int vb) {
  s16x4 r; asm volatile("ds_read_b64_tr_b16 %0, %1 offset:%2" : "=&v"(r) : "v"(vb), "i"(OFF) : "memory"); return r;
}
template <int D0> __device__ __forceinline__ void pv_one(f32x16& od, int vb, bf16x8 pa0, bf16x8 pa1, bf16x8 pa2, bf16x8 pa3) {
  const s16x4 l0 = tr_read<v_rd_off(D0, 0, 0)>(vb), h0 = tr_read<v_rd_off(D0, 0, 1)>(vb), l1 = tr_read<v_rd_off(D0, 1, 0)>(vb), h1 = tr_read<v_rd_off(D0, 1, 1)>(vb);
  const s16x4 l2 = tr_read<v_rd_off(D0, 2, 0)>(vb), h2 = tr_read<v_rd_off(D0, 2, 1)>(vb), l3 = tr_read<v_rd_off(D0, 3, 0)>(vb), h3 = tr_read<v_rd_off(D0, 3, 1)>(vb);
  asm volatile("s_waitcnt lgkmcnt(0)" ::: "memory"); SBAR();
#define PK(L, H) (bf16x8){L[0], L[1], L[2], L[3], H[0], H[1], H[2], H[3]}
  od = __builtin_amdgcn_mfma_f32_32x32x16_bf16(pa0, PK(l0, h0), od, 0, 0, 0);
  od = __builtin_amdgcn_mfma_f32_32x32x16_bf16(pa1, PK(l1, h1), od, 0, 0, 0);
  od = __builtin_amdgcn_mfma_f32_32x32x16_bf16(pa2, PK(l2, h2), od, 0, 0, 0);
  od = __builtin_amdgcn_mfma_f32_32x32x16_bf16(pa3, PK(l3, h3), od, 0, 0, 0);
#undef PK
}
__device__ __forceinline__ void pv_d0(f32x16* o, int vb, bf16x8 pa0, bf16x8 pa1, bf16x8 pa2, bf16x8 pa3) {
  pv_one<0>(o[0], vb, pa0, pa1, pa2, pa3); pv_one<1>(o[1], vb, pa0, pa1, pa2, pa3); pv_one<2>(o[2], vb, pa0, pa1, pa2, pa3); pv_one<3>(o[3], vb, pa0, pa1, pa2, pa3);
}
template <bool FM> __device__ __forceinline__ void attn_dense_body(const bf16_t* __restrict__ Qb, const bf16_t* __restrict__ Kh, const bf16_t* __restrict__ Vh,
                                                bf16_t* __restrict__ Ob, int seq, char* lds, const int wave_, const float mfix = 0.f) {
  constexpr int SDEPTH = ATT_SDEPTH;
  const int lane = lane_id(), wid = wave_, tid = wid * 64 + lane, r32 = lane & 31, hi = lane >> 5;
  bf16_t* V_lds = (bf16_t*)lds; bf16_t* K_lds = (bf16_t*)(lds + 3 * SHM_V);
  float* ws = (float*)(lds + 3 * SHM_V + 3 * SHM_K) + wid * 64; float* li_l = ws; float* al_l = ws + 32;
  float m_reg = FM ? mfix / SCALE : -1e30f, l_reg = 0; f32x16 o[4] = {}; bf16x8 qr[8];
  const bf16_t* Qw = Qb + (long)(wid * QBLK + r32) * LDQ + hi * 8;
#pragma unroll
  for (int d0 = 0; d0 < 8; ++d0) qr[d0] = *reinterpret_cast<const bf16x8*>(Qw + d0 * 16);
  if constexpr (FM) {
    constexpr float C = SCALE * 1.4426950408889634f;
#pragma unroll
    for (int d0 = 0; d0 < 8; ++d0) { const u32x4 w = __builtin_bit_cast(u32x4, qr[d0]);
      const u32x4 o = {cvtpk(__uint_as_float(w.x << 16) * C, __uint_as_float(w.x & 0xffff0000u) * C), cvtpk(__uint_as_float(w.y << 16) * C, __uint_as_float(w.y & 0xffff0000u) * C),
                       cvtpk(__uint_as_float(w.z << 16) * C, __uint_as_float(w.z & 0xffff0000u) * C), cvtpk(__uint_as_float(w.w << 16) * C, __uint_as_float(w.w & 0xffff0000u) * C)};
      qr[d0] = __builtin_bit_cast(bf16x8, o); } }
  const int sr = tid >> 4, sc = (tid & 15) * 8, vst0 = v_st(sr, sc), vst1 = v_st(32 + sr, sc);
  const int vb0 = (int)(uintptr_t)V_lds + v_rd_base(lane);
  struct { bf16x8 vs0, vs1, ks0, ks1; } sr_[SDEPTH];
#define SLOAD(i, k0) do { sr_[i].vs0 = *reinterpret_cast<const bf16x8*>(&Vh[(long)((k0) + sr) * LDK + sc]); sr_[i].vs1 = *reinterpret_cast<const bf16x8*>(&Vh[(long)((k0) + 32 + sr) * LDK + sc]); \
    sr_[i].ks0 = *reinterpret_cast<const bf16x8*>(&Kh[(long)((k0) + sr) * LDK + sc]); sr_[i].ks1 = *reinterpret_cast<const bf16x8*>(&Kh[(long)((k0) + 32 + sr) * LDK + sc]); } while (0)
#define SWRITE(bo, i) do { *(bf16x8*)((char*)V_lds + (bo) + vst0) = sr_[i].vs0;          \
    *(bf16x8*)((char*)V_lds + (bo) + vst1) = sr_[i].vs1; int kc = sc * 2;               \
    *(bf16x8*)((char*)K_lds + (bo) + KSWZ(sr, kc)) = sr_[i].ks0;                       \
    *(bf16x8*)((char*)K_lds + (bo) + KSWZ(32 + sr, kc)) = sr_[i].ks1; } while (0)
#define SWAIT() do { if constexpr (SDEPTH == 2) asm volatile("s_waitcnt vmcnt(4)" ::: "memory"); else asm volatile("s_waitcnt vmcnt(0)" ::: "memory"); } while (0)
#define RESC(a) do { if (!FM && __any((a) < 1.f)) { if (hi == 0) al_l[r32] = (a); asm volatile("s_waitcnt lgkmcnt(0)" ::: "memory"); \
    for (int d = 0; d < 4; ++d) for (int r = 0; r < 16; ++r) o[d][r] *= al_l[crow(r, hi)]; } } while (0)
  f32x16 pA0, pA1, pB0, pB1; float mnA, mnB, alA, alB; bf16x8 pa0, pa1, pa2, pa3; const int NT = seq / KVBLK;
  constexpr int SE = 0, SO = SDEPTH - 1;
  static_assert(SHM_V == SHM_K, "one buffer offset for K and V");
  int bprev = 0, bcur = (int)SHM_V, bfree = 2 * (int)SHM_V;
  SLOAD(SE, 0); asm volatile("s_waitcnt vmcnt(0)" ::: "memory"); SWRITE(0, SE); __syncthreads();
  qkt(pA0, pA1, K_lds, qr, r32, hi); partialSM<FM>(pA0, pA1, m_reg, mnA, alA);
  SLOAD(SO, KVBLK); if constexpr (SDEPTH == 2) { if (2 < NT) SLOAD(SE, 2 * KVBLK); }
  SWAIT(); SWRITE((int)SHM_V, SO); __syncthreads();
#define ROT3() do { const int t_ = bprev; bprev = bcur; bcur = bfree; bfree = t_; } while (0)
  for (int j = 1; j + 1 < NT; j += 2) {
    SBAR(); qkt(pB0, pB1, (bf16_t*)((char*)K_lds + bcur), qr, r32, hi);
    finishSM(pA0, pA1, alA, l_reg, pa0, pa1, pa2, pa3); SBAR();
    SLOAD(SO, (j + SDEPTH) * KVBLK); SBAR();
    pv_d0(o, vb0 + bprev, pa0, pa1, pa2, pa3); partialSM<FM>(pB0, pB1, m_reg, mnB, alB);
    SWAIT(); SWRITE(bfree, SE);
    RESC(alB); __syncthreads(); ROT3();
    SBAR(); qkt(pA0, pA1, (bf16_t*)((char*)K_lds + bcur), qr, r32, hi);
    finishSM(pB0, pB1, alB, l_reg, pa0, pa1, pa2, pa3); SBAR();
    if (SDEPTH == 1 || j + 3 < NT) SLOAD(SE, (j + 1 + SDEPTH) * KVBLK); SBAR();
    pv_d0(o, vb0 + bprev, pa0, pa1, pa2, pa3); partialSM<FM>(pA0, pA1, m_reg, mnA, alA);
    SWAIT(); SWRITE(bfree, SO);
    RESC(alA); __syncthreads(); ROT3();
  }
  SBAR(); qkt(pB0, pB1, (bf16_t*)((char*)K_lds + bcur), qr, r32, hi);
  finishSM(pA0, pA1, alA, l_reg, pa0, pa1, pa2, pa3); SBAR();
  pv_d0(o, vb0 + bprev, pa0, pa1, pa2, pa3); partialSM<FM>(pB0, pB1, m_reg, mnB, alB);
  __syncthreads(); RESC(alB);
  finishSM(pB0, pB1, alB, l_reg, pa0, pa1, pa2, pa3); SBAR();
  pv_d0(o, vb0 + bcur, pa0, pa1, pa2, pa3);
#undef ROT3
  if (hi == 0) li_l[r32] = l_reg; asm volatile("s_waitcnt lgkmcnt(0)" ::: "memory");
  float rli[16];
#pragma unroll
  for (int r = 0; r < 16; ++r) rli[r] = __builtin_amdgcn_rcpf(li_l[crow(r, hi)]);
  bf16_t* Ow = Ob + (long)(wid * QBLK) * LDO;
  char* stg = (char*)K_lds + wid * 4096;
#pragma unroll
  for (int p = 0; p < 2; ++p) {
#pragma unroll
    for (int rr = 0; rr < 8; ++rr) { const int r = 8 * p + rr, row16 = (r & 3) + 8 * ((r >> 2) & 1) + 4 * hi;
#pragma unroll
      for (int d0 = 0; d0 < 4; ++d0) *(bf16_t*)(stg + row16 * 256 + (d0 * 32 + r32) * 2) = (bf16_t)(cvtpk(o[d0][r] * rli[r], 0.f) & 0xffffu); }
    asm volatile("s_waitcnt lgkmcnt(0)" ::: "memory");
#pragma unroll
    for (int i = 0; i < 4; ++i) { const int idx = lane + 64 * i, row = idx >> 4, ch = idx & 15; const u32x4 v = *(const u32x4*)(stg + row * 256 + ch * 16);
      *(u32x4*)(Ow + (long)(16 * p + row) * LDO + ch * 8) = v; }
    asm volatile("s_waitcnt lgkmcnt(0)" ::: "memory");
  }
#undef SLOAD
#undef SWRITE
#undef SWAIT
#undef RESC
  __syncthreads();
}
#undef KSWZ
#undef SBAR
}

struct AddrLin { bf16_t* O; int ld; __device__ __forceinline__ bf16_t* operator()(const pg8::Unit& u, int rl, int tc) const { return O + (size_t)(u.pm * 256 + rl) * ld + u.pn * 256 + tc; } };
struct EpiRowScale {
    static constexpr bool PERM = true; bf16_t* O; int ld; const float* ssp; float cscale;
    __device__ __forceinline__ void operator()(f32x4 (&acc)[2][2][4][2], const pg8::Unit& u, const pg8::EpiCtx& c) const { const int e_lane = lane_id(), e_fr = e_lane & 15, e_fq = e_lane >> 4;
        const int hc = c.wc * 32 + e_fq * 8, rl0 = c.wr * 64 + e_fr;
#pragma unroll
        for (int ai = 0; ai < 2; ++ai)
#pragma unroll
            for (int m = 0; m < 4; ++m) { const int row = u.pm * 256 + ai * 128 + rl0 + m * 16; const f32x4 p0 = *(const f32x4*)(ssp + (size_t)row * 8), p1 = *(const f32x4*)(ssp + (size_t)row * 8 + 4);
                const float r = rsqrtf((((p0.x + p0.y) + (p0.z + p0.w)) + ((p1.x + p1.y) + (p1.z + p1.w))) * (1.0f / DM) + EPS) * cscale;
#pragma unroll
                for (int bj = 0; bj < 2; ++bj) { const f32x4 v0 = acc[ai][bj][m][0] * r, v1 = acc[ai][bj][m][1] * r;
                    st16((O + (size_t)row * ld + u.pn * 256 + bj * 128 + hc), (u32x4){cvtpk(v0.x, v0.y), cvtpk(v0.z, v0.w), cvtpk(v1.x, v1.y), cvtpk(v1.z, v1.w)}); } }
    }
};
struct EpiSoftmax {
    static constexpr bool PERM = true; bf16_t* P; int ld;
    __device__ __forceinline__ void operator()(f32x4 (&acc)[2][2][4][2], const pg8::Unit& u, const pg8::EpiCtx& c) const { const int e_lane = lane_id(), e_fr = e_lane & 15, e_fq = e_lane >> 4;
        const int hc = c.wc * 32 + e_fq * 8, rl0 = c.wr * 64 + e_fr;
        LAS float* pmx = (LAS float*)c.xl; LAS float* psm = pmx + 1024;
#pragma unroll
        for (int ai = 0; ai < 2; ++ai)
#pragma unroll
            for (int m = 0; m < 4; ++m) { float mx = -3.0e38f;
#pragma unroll
                for (int bj = 0; bj < 2; ++bj)
#pragma unroll
                    for (int n = 0; n < 2; ++n) { const f32x4 v = acc[ai][bj][m][n]; mx = fmaxf(fmaxf(mx, fmaxf(v.x, v.y)), fmaxf(v.z, v.w)); }
                mx = fmaxf(mx, __shfl_xor(mx, 16)); mx = fmaxf(mx, __shfl_xor(mx, 32));
                if (e_fq == 0) pmx[(ai * 128 + rl0 + m * 16) * 4 + c.wc] = mx; }
        WG_BAR();
#pragma unroll
        for (int ai = 0; ai < 2; ++ai)
#pragma unroll
            for (int m = 0; m < 4; ++m) { const int rl = ai * 128 + rl0 + m * 16; const f32x4 p4 = *(const LAS f32x4*)(pmx + rl * 4);
                const float mx = fmaxf(fmaxf(p4.x, p4.y), fmaxf(p4.z, p4.w)) * 1.4426950408889634f; float s = 0.f;
#pragma unroll
                for (int bj = 0; bj < 2; ++bj)
#pragma unroll
                    for (int n = 0; n < 2; ++n) { f32x4 v = acc[ai][bj][m][n];
                        v.x = __builtin_amdgcn_exp2f(fmaf(v.x, 1.4426950408889634f, -mx)); v.y = __builtin_amdgcn_exp2f(fmaf(v.y, 1.4426950408889634f, -mx));
                        v.z = __builtin_amdgcn_exp2f(fmaf(v.z, 1.4426950408889634f, -mx)); v.w = __builtin_amdgcn_exp2f(fmaf(v.w, 1.4426950408889634f, -mx));
                        s += (v.x + v.y) + (v.z + v.w); acc[ai][bj][m][n] = v; }
                s += __shfl_xor(s, 16); s += __shfl_xor(s, 32);
                if (e_fq == 0) psm[rl * 4 + c.wc] = s; }
        WG_BAR();
#pragma unroll
        for (int ai = 0; ai < 2; ++ai)
#pragma unroll
            for (int m = 0; m < 4; ++m) { const int rl = ai * 128 + rl0 + m * 16; const f32x4 p4 = *(const LAS f32x4*)(psm + rl * 4);
                const float inv = 1.0f / ((p4.x + p4.y) + (p4.z + p4.w));
#pragma unroll
                for (int bj = 0; bj < 2; ++bj) { const f32x4 v0 = acc[ai][bj][m][0] * inv, v1 = acc[ai][bj][m][1] * inv;
                    st16((P + (size_t)(u.pm * 256 + rl) * ld + u.pn * 256 + bj * 128 + hc), (u32x4){cvtpk(v0.x, v0.y), cvtpk(v0.z, v0.w), cvtpk(v1.x, v1.y), cvtpk(v1.z, v1.w)}); } }
        WG_BAR();
    }
};
struct MapXS { const char* Q; const char* K; __device__ __forceinline__ void operator()(pg8::Unit& u) const {
    u.a = Q + ((size_t)u.pm * 256 * DM + (size_t)u.pn * MHD) * 2; u.b = K + ((size_t)(u.pm >> 3) * MEML * DM + (size_t)u.pn * MHD) * 2; } };
struct SchedPair { pg8::Unit ua, ub; __device__ __forceinline__ bool next(int i, pg8::Unit& o) const { if (i >= 2) return false; o.pm = i ? ub.pm : ua.pm; o.pn = i ? ub.pn : ua.pn; o.a = i ? ub.a : ua.a; o.b = i ? ub.b : ua.b; asm volatile("" : "+s"(o.a), "+s"(o.b));     return true; } };
struct MapXPV { const char* P; const char* VT; __device__ __forceinline__ void operator()(pg8::Unit& u) const {
    u.a = P + ((size_t)u.pm * 256 * 1024 + (size_t)(u.pn >> 1) * MEML) * 2; u.b = VT + ((size_t)u.pn * 256 * 1024 + (size_t)(u.pm >> 3) * MEML) * 2; } };

struct MapMoE { const char* A; const char* W; size_t as, es, ws_; __device__ __forceinline__ void operator()(pg8::Unit& u) const {
    u.a = A + (size_t)u.pm * as; u.b = W + (size_t)(u.pm >> 2) * es + (size_t)u.pn * ws_; } };
struct EpiSwiGLU {
    static constexpr bool PERM = true; bf16_t* ACT; const float* rs;
    __device__ __forceinline__ void operator()(f32x4 (&acc)[2][2][4][2], const pg8::Unit& u, const pg8::EpiCtx& c) const { const int e_lane = lane_id(), e_fr = e_lane & 15, e_fq = e_lane >> 4;
        const int hc = c.wc * 32 + e_fq * 8, rl0 = c.wr * 64 + e_fr;
#pragma unroll
        for (int ai = 0; ai < 2; ++ai)
#pragma unroll
            for (int m = 0; m < 4; ++m) { f32x4 o[2]; const float rf = rs[u.pm * 256 + ai * 128 + rl0 + m * 16];
#pragma unroll
                for (int n = 0; n < 2; ++n) { const f32x4 g = acc[ai][0][m][n] * rf, up = acc[ai][1][m][n] * rf; f32x4 r;
                    r.x = g.x * __builtin_amdgcn_rcpf(1.0f + __builtin_amdgcn_exp2f(-1.4426950408889634f * g.x)) * up.x; r.y = g.y * __builtin_amdgcn_rcpf(1.0f + __builtin_amdgcn_exp2f(-1.4426950408889634f * g.y)) * up.y;
                    r.z = g.z * __builtin_amdgcn_rcpf(1.0f + __builtin_amdgcn_exp2f(-1.4426950408889634f * g.z)) * up.z; r.w = g.w * __builtin_amdgcn_rcpf(1.0f + __builtin_amdgcn_exp2f(-1.4426950408889634f * g.w)) * up.w; o[n] = r; }
                st16((ACT + (size_t)(u.pm * 256 + ai * 128 + rl0 + m * 16) * EFF + u.pn * 128 + hc), (u32x4){cvtpk(o[0].x, o[0].y), cvtpk(o[0].z, o[0].w), cvtpk(o[1].x, o[1].y), cvtpk(o[1].z, o[1].w)}); }
    }
};
struct EpiRowGate {
    static constexpr bool PERM = true; bf16_t* Y; const float* gate;
    __device__ __forceinline__ void operator()(f32x4 (&acc)[2][2][4][2], const pg8::Unit& u, const pg8::EpiCtx& c) const { const int e_lane = lane_id(), e_fr = e_lane & 15, e_fq = e_lane >> 4;
        const int hc = c.wc * 32 + e_fq * 8, rl0 = c.wr * 64 + e_fr;
#pragma unroll
        for (int ai = 0; ai < 2; ++ai)
#pragma unroll
            for (int m = 0; m < 4; ++m) { const int row = u.pm * 256 + ai * 128 + rl0 + m * 16; const float gt = gate[row];
#pragma unroll
                for (int bj = 0; bj < 2; ++bj) { const f32x4 v0 = acc[ai][bj][m][0] * gt, v1 = acc[ai][bj][m][1] * gt;
                    st16((Y + (size_t)row * DM + u.pn * 256 + bj * 128 + hc), (u32x4){cvtpk(v0.x, v0.y), cvtpk(v0.z, v0.w), cvtpk(v1.x, v1.y), cvtpk(v1.z, v1.w)}); } }
    }
};
__device__ __forceinline__ float rms_row_to_bf16_r(const float* xrow, const float* __restrict__ gain, bf16_t* orow, int lane) {
    const GAS f32x4* xr = (const GAS f32x4*)xrow + lane; const f32x4* gr = (const f32x4*)gain + lane;
    f32x4 v[8]; float s = 0.f;
#pragma unroll
    for (int j = 0; j < 8; ++j) { v[j] = xr[64 * j]; s += (v[j].x * v[j].x + v[j].y * v[j].y) + (v[j].z * v[j].z + v[j].w * v[j].w); }
    const float r = rsqrtf(wave_sum(s) * (1.f / DM) + EPS);
    GAS u32x2* o8 = (GAS u32x2*)orow + lane;
#pragma unroll
    for (int j = 0; j < 8; ++j) { const f32x4 g = gr[64 * j]; u32x2 w; w.x = cvtpk(v[j].x * r * g.x, v[j].y * r * g.y); w.y = cvtpk(v[j].z * r * g.z, v[j].w * r * g.w); o8[64 * j] = w; }
    return r;
}
__device__ __forceinline__ void router_phase(const Frame& F, const bf16_t* x, const u32x4* RBl, float* rrow, float* aff, LAS unsigned char* xl) {
    const int lane = lane_id(), tid = F.wave * 64 + lane;
    LAS u32x4* Bl = (LAS u32x4*)(F.lds + RING_OFF);
    for (int i = tid; i < 2 * 4096; i += 512) Bl[i] = RBl[i];
    __syncthreads();
    LAS float* red = (LAS float*)xl;
    LAS float* ssq = (LAS float*)(xl + 8192);
    const int rg = F.wave >> 2, kq = F.wave & 3, r16 = lane & 15, kg = lane >> 4;
    for (int rb = (int)blockIdx.x * 32; rb < NTOK; rb += F.G * 32) {
        const bf16_t* xr = x + (size_t)(rb + rg * 16 + r16) * DM + kq * 512 + kg * 8;
        bf16x8 a[16];
#pragma unroll
        for (int s = 0; s < 16; ++s) a[s] = *(const GAS bf16x8*)(xr + 32 * s);
        f32x4 acc = {0.f, 0.f, 0.f, 0.f}; float sq = 0.f;
#pragma unroll
        for (int s = 0; s < 16; ++s) { const int ks = kq * 16 + s;
            const bf16x8 bh = __builtin_bit_cast(bf16x8, Bl[ks * 64 + lane]), bl = __builtin_bit_cast(bf16x8, Bl[4096 + ks * 64 + lane]);
            acc = __builtin_amdgcn_mfma_f32_16x16x32_bf16(a[s], bh, acc, 0, 0, 0);
            acc = __builtin_amdgcn_mfma_f32_16x16x32_bf16(a[s], bl, acc, 0, 0, 0);
            const u32x4 av = __builtin_bit_cast(u32x4, a[s]);
            const float f0 = __uint_as_float(av.x << 16), f1 = __uint_as_float(av.x & 0xffff0000u), f2 = __uint_as_float(av.y << 16), f3 = __uint_as_float(av.y & 0xffff0000u);
            const float f4 = __uint_as_float(av.z << 16), f5 = __uint_as_float(av.z & 0xffff0000u), f6 = __uint_as_float(av.w << 16), f7 = __uint_as_float(av.w & 0xffff0000u);
            sq += ((f0 * f0 + f1 * f1) + (f2 * f2 + f3 * f3)) + ((f4 * f4 + f5 * f5) + (f6 * f6 + f7 * f7)); }
        sq += __shfl_xor(sq, 16); sq += __shfl_xor(sq, 32);
        *(LAS f32x4*)(red + ((rg * 4 + kq) * 64 + lane) * 4) = acc;
        if (kg == 0) ssq[(rg * 4 + kq) * 16 + r16] = sq;
        __syncthreads();
        if (kq == 0) {
            f32x4 t = *(const LAS f32x4*)(red + ((rg * 4 + 0) * 64 + lane) * 4);
#pragma unroll
            for (int q = 1; q < 4; ++q) t = t + *(const LAS f32x4*)(red + ((rg * 4 + q) * 64 + lane) * 4);
            const float lg[4] = {t.x, t.y, t.z, t.w};
#pragma unroll
            for (int i = 0; i < 4; ++i) { const int rr = 4 * kg + i; const float ss = (ssq[(rg * 4 + 0) * 16 + rr] + ssq[(rg * 4 + 1) * 16 + rr]) + (ssq[(rg * 4 + 2) * 16 + rr] + ssq[(rg * 4 + 3) * 16 + rr]);
                const float r = rsqrtf(ss * (1.f / DM) + EPS); const int row = rb + rg * 16 + rr;
                const float v = lg[i] * r; float mx = v;
                mx = fmaxf(mx, __shfl_xor(mx, 8)); mx = fmaxf(mx, __shfl_xor(mx, 4)); mx = fmaxf(mx, __shfl_xor(mx, 2)); mx = fmaxf(mx, __shfl_xor(mx, 1));
                const float ex = expf(v - mx); float sm = ex;
                sm += __shfl_xor(sm, 8); sm += __shfl_xor(sm, 4); sm += __shfl_xor(sm, 2); sm += __shfl_xor(sm, 1);
                const int b = row / SEQ, tt = row % SEQ; aff[((size_t)b * NE + r16) * SEQ + tt] = ex / sm;
                if (r16 == 0) rrow[row] = r; }
        }
        __syncthreads();
    }
}
__device__ __forceinline__ void rank_phase(const Frame& F, const float* aff, int* rank, float* gate, const float* rrow, float* rs, int* gidx) {
    const int lane = lane_id(), tid = F.wave * 64 + lane;
    LAS unsigned* wc = (LAS unsigned*)(F.lds + RING_OFF);
    LAS unsigned* ck = (LAS unsigned*)(F.lds + RING_OFF + 256);
    LAS unsigned* ci = ck + SEQ + 4;
    LAS unsigned* ncp = ci + SEQ + 4;
    for (int be = (int)blockIdx.x; be < NB * NE; be += F.G) {
        const int b = be >> 4, e = be & 15;
        unsigned k[4];
#pragma unroll
        for (int j = 0; j < 4; ++j) k[j] = __float_as_uint(aff[(size_t)be * SEQ + tid + 512 * j]);
        unsigned lo = 0u, hi = 0x3F800001u;
        if (tid == 0) ncp[0] = 0u;
        for (int it = 0; it < 40; ++it) {
            const unsigned mid = lo + ((hi - lo) >> 1); if (mid == lo) break;
            const int ws_ = __popcll(__ballot(k[0] >= mid)) + __popcll(__ballot(k[1] >= mid)) + __popcll(__ballot(k[2] >= mid)) + __popcll(__ballot(k[3] >= mid));
            if (lane == 0) wc[(it & 1) * 8 + F.wave] = (unsigned)ws_;
            __syncthreads();
            const u32x4 c0 = *(const LAS u32x4*)(wc + (it & 1) * 8), c1 = *(const LAS u32x4*)(wc + (it & 1) * 8 + 4);
            const int c = (int)(((c0.x + c0.y) + (c0.z + c0.w)) + ((c1.x + c1.y) + (c1.z + c1.w)));
            if (c < CAP) hi = mid; else { lo = mid; if (c <= 448) break; }
        }
        const unsigned T = lo;
        __syncthreads();
#pragma unroll
        for (int j = 0; j < 4; ++j) { const bool pred = k[j] >= T; const unsigned long long bal = __ballot(pred);
            const int wcount = __popcll(bal), pre = __popcll(bal & ((1ull << lane) - 1ull));
            unsigned base = 0u; if (lane == 0 && wcount) base = __hip_atomic_fetch_add(ncp, (unsigned)wcount, __ATOMIC_RELAXED, __HIP_MEMORY_SCOPE_WORKGROUP);
            base = (unsigned)__builtin_amdgcn_readfirstlane((int)base);
            if (pred) { ck[base + pre] = k[j]; ci[base + pre] = (unsigned)(tid + 512 * j); } else rank[(size_t)be * SEQ + tid + 512 * j] = CAP; }
        __syncthreads();
        const int nc = (int)ncp[0];
        if (tid < 4) { ck[nc + tid] = 0u; ci[nc + tid] = 0x7fffffffu; }
        __syncthreads();
        const int nc4 = (nc + 3) >> 2;
        for (int i = tid; i < nc; i += 512) { const unsigned kk = ck[i]; const int tt = (int)ci[i]; int cnt = 0;
#pragma unroll 4
            for (int m = 0; m < nc4; ++m) { const u32x4 km = ((const LAS u32x4*)ck)[m]; const u32x4 tm = ((const LAS u32x4*)ci)[m];
                cnt += ((km.x > kk || (km.x == kk && (int)tm.x < tt)) ? 1 : 0) + ((km.y > kk || (km.y == kk && (int)tm.y < tt)) ? 1 : 0)
                     + ((km.z > kk || (km.z == kk && (int)tm.z < tt)) ? 1 : 0) + ((km.w > kk || (km.w == kk && (int)tm.w < tt)) ? 1 : 0); }
            const int r = cnt < CAP ? cnt : CAP; rank[(size_t)be * SEQ + tt] = r;
            if (r < CAP) { const int sl = (e * 4 + b) * CAP + r; gate[sl] = __uint_as_float(kk); gidx[sl] = b * SEQ + tt; rs[sl] = rrow[b * SEQ + tt]; } }
        __syncthreads();
    }
}
__device__ __forceinline__ void combine_phase(const Frame& F, const bf16_t* xin, bf16_t* xo, float* fout, const bf16_t* Y, const int* rank, const float* __restrict__ gain, bf16_t* HNo, bool final_) {
    const int lane = lane_id();
    const int gw = (int)blockIdx.x * NWAVES + F.wave, NGW = F.G * NWAVES;
    for (int row = gw; row < NTOK; row += NGW) {
        const int b = row / SEQ, t = row % SEQ;
        int rk = CAP; if (lane < NE) rk = rank[((size_t)b * NE + lane) * SEQ + t];
        const GAS u32x4* xi = (const GAS u32x4*)(xin + (size_t)row * DM) + lane; float v[4][8];
#pragma unroll
        for (int j = 0; j < 4; ++j) { const u32x4 p = xi[64 * j];
            v[j][0] = __uint_as_float(p.x << 16); v[j][1] = __uint_as_float(p.x & 0xffff0000u); v[j][2] = __uint_as_float(p.y << 16); v[j][3] = __uint_as_float(p.y & 0xffff0000u);
            v[j][4] = __uint_as_float(p.z << 16); v[j][5] = __uint_as_float(p.z & 0xffff0000u); v[j][6] = __uint_as_float(p.w << 16); v[j][7] = __uint_as_float(p.w & 0xffff0000u); }
#pragma unroll
        for (int e = 0; e < NE; ++e) { const int r = __builtin_amdgcn_readlane(rk, e);
            if (r < CAP) { const u32x4* yr = (const u32x4*)(Y + ((size_t)(e * 4 + b) * CAP + r) * DM) + lane;
#pragma unroll
                for (int j = 0; j < 4; ++j) { const u32x4 w = yr[64 * j];
                    v[j][0] += __uint_as_float(w.x << 16); v[j][1] += __uint_as_float(w.x & 0xffff0000u); v[j][2] += __uint_as_float(w.y << 16); v[j][3] += __uint_as_float(w.y & 0xffff0000u);
                    v[j][4] += __uint_as_float(w.z << 16); v[j][5] += __uint_as_float(w.z & 0xffff0000u); v[j][6] += __uint_as_float(w.w << 16); v[j][7] += __uint_as_float(w.w & 0xffff0000u); } } }
        float s = 0.f;
#pragma unroll
        for (int j = 0; j < 4; ++j)
#pragma unroll
            for (int i = 0; i < 8; ++i) s += v[j][i] * v[j][i];
        const float r = rsqrtf(wave_sum(s) * (1.f / DM) + EPS);
        if (final_) { GAS f32x4* fo = (GAS f32x4*)(fout + (size_t)row * DM);
#pragma unroll
            for (int j = 0; j < 4; ++j) { const int c0 = 8 * (lane + 64 * j); const f32x4 g0 = *(const f32x4*)(gain + c0), g1 = *(const f32x4*)(gain + c0 + 4);
                fo[(c0 >> 2)] = (f32x4){v[j][0] * r * g0.x, v[j][1] * r * g0.y, v[j][2] * r * g0.z, v[j][3] * r * g0.w};
                fo[(c0 >> 2) + 1] = (f32x4){v[j][4] * r * g1.x, v[j][5] * r * g1.y, v[j][6] * r * g1.z, v[j][7] * r * g1.w}; }
        } else { GAS u32x4* o8 = (GAS u32x4*)(HNo + (size_t)row * DM) + lane; GAS u32x4* x8 = (GAS u32x4*)(xo + (size_t)row * DM) + lane;
#pragma unroll
            for (int j = 0; j < 4; ++j) { const int c0 = 8 * (lane + 64 * j); const f32x4 g0 = *(const f32x4*)(gain + c0), g1 = *(const f32x4*)(gain + c0 + 4);
                x8[64 * j] = (u32x4){cvtpk(v[j][0], v[j][1]), cvtpk(v[j][2], v[j][3]), cvtpk(v[j][4], v[j][5]), cvtpk(v[j][6], v[j][7])};
                o8[64 * j] = (u32x4){cvtpk(v[j][0] * r * g0.x, v[j][1] * r * g0.y), cvtpk(v[j][2] * r * g0.z, v[j][3] * r * g0.w), cvtpk(v[j][4] * r * g1.x, v[j][5] * r * g1.y), cvtpk(v[j][6] * r * g1.z, v[j][7] * r * g1.w)}; } }
    }
}
struct MapPool { const char* A; const char* W; __device__ __forceinline__ void operator()(pg8::Unit& u) const {
    u.a = A + ((size_t)u.pm * 256 * DM + (size_t)(u.pn >> 1) * 512) * 2; u.b = W + ((size_t)(u.pn & 1) * 256 * DM + (size_t)(u.pn >> 1) * 512) * 2; } };
template <int W, int R> __device__ __forceinline__ void pool_item(const bf16_t* H, bf16_t* P, int row0, int c8) {
    const int t0 = row0 & (SEQ - 1); const bf16_t* base = H + (size_t)(row0 - t0) * DM + c8 * 8;
    u32x4 v[W + R - 1];
#pragma unroll
    for (int i = 0; i < W + R - 1; ++i) { int j = t0 - W / 2 + i; j = j < 0 ? 0 : (j > SEQ - 1 ? SEQ - 1 : j); v[i] = *(const u32x4*)(base + (size_t)j * DM); }
    float f[W + R - 1][8];
#pragma unroll
    for (int i = 0; i < W + R - 1; ++i) { const int j = t0 - W / 2 + i; const float m = (j >= 0 && j < SEQ) ? 1.f : 0.f;
        f[i][0] = m * __uint_as_float(v[i].x << 16); f[i][1] = m * __uint_as_float(v[i].x & 0xffff0000u); f[i][2] = m * __uint_as_float(v[i].y << 16); f[i][3] = m * __uint_as_float(v[i].y & 0xffff0000u);
        f[i][4] = m * __uint_as_float(v[i].z << 16); f[i][5] = m * __uint_as_float(v[i].z & 0xffff0000u); f[i][6] = m * __uint_as_float(v[i].w << 16); f[i][7] = m * __uint_as_float(v[i].w & 0xffff0000u); }
    float s[8];
#pragma unroll
    for (int c = 0; c < 8; ++c) { s[c] = 0.f;
#pragma unroll
        for (int i = 0; i < W; ++i) s[c] += f[i][c]; }
#pragma unroll
    for (int q = 0; q < R; ++q) { const int t = t0 + q; int lo = t - W / 2, hi = t + W / 2; if (lo < 0) lo = 0; if (hi > SEQ) hi = SEQ; const float inv = 1.0f / (float)(hi - lo);
        if (q > 0) {
#pragma unroll
            for (int c = 0; c < 8; ++c) s[c] += f[q + W - 1][c] - f[q - 1][c]; }
        const float* e = f[q + W / 2];
        *(u32x4*)(P + (size_t)(row0 + q) * DM + c8 * 8) = (u32x4){cvtpk(s[0] * inv - e[0], s[1] * inv - e[1]), cvtpk(s[2] * inv - e[2], s[3] * inv - e[3]), cvtpk(s[4] * inv - e[4], s[5] * inv - e[5]), cvtpk(s[6] * inv - e[6], s[7] * inv - e[7])}; }
}
__device__ __forceinline__ void pool_phase(const Frame& F, const bf16_t* H, bf16_t* P) {
    const int lane = lane_id(); const int gwv = (int)blockIdx.x * NWAVES + F.wave, NWV = F.G * NWAVES;
    for (int wi = gwv; wi < NTOK / 2; wi += NWV) {
        const int row0 = (wi >> 2) * 8, g = wi & 3, c8 = g * 64 + lane;
        if (g == 0) pool_item<2, 8>(H, P, row0, c8); else if (g == 1) pool_item<4, 8>(H, P, row0, c8); else if (g == 2) pool_item<8, 8>(H, P, row0, c8); else pool_item<16, 8>(H, P, row0, c8);
    }
}

constexpr int N_PHASES = 24;
#ifndef MK_N_LAUNCHES
#define MK_N_LAUNCHES 1
#endif
#ifndef REP_MASK
#define REP_MASK 0
#endif
__global__ void __launch_bounds__(NWAVES * 64, 2) skel_fwd(Args args) {
    extern __shared__ __attribute__((aligned(16))) unsigned char lds_raw[];
    Frame F;
    F.lds = (LAS unsigned char*)lds_raw; F.MISC = (volatile LAS unsigned*)(F.lds + MISC_OFF);
    F.wave = __builtin_amdgcn_readfirstlane(threadIdx.x >> 6);
    F.G = gridDim.x; { const int bx = blockIdx.x; F.vcu = (F.G % 8 == 0) ? (bx % 8) * (F.G / 8) + bx / 8 : bx; }
    F.ws = nullptr; F.ctl = (gu32*)(uptr(args.ws) + WS_CTL);
    for (int u = threadIdx.x; u < (LDS_BYTES - LDSCTL_OFF) / 4; u += NWAVES * 64) ((LAS unsigned*)(F.lds + LDSCTL_OFF))[u] = 0u;
    __syncthreads();
    const bool multi = (MK_N_LAUNCHES == 1) || (args.ph_hi - args.ph_lo) > 1 || REP_MASK != 0;
    XcdBarrier bar; bar.bar = (unsigned*)(F.ctl + CW_BAR); bar.x = 0; bar.st = nullptr; bar.wave = F.wave;
    if (multi) bar = xcd_barrier_post((unsigned*)(F.ctl + CW_BAR), F.MISC + 8, F.wave);
    const int lo = args.ph_lo, hi = args.ph_hi;
#ifdef REP_RT
    const unsigned rep_mask_ = (unsigned)__builtin_amdgcn_readfirstlane(args.pad);
#endif
#define IN(k) ((MK_N_LAUNCHES == 1) ? ((k) < N_PHASES) : (lo <= (k) && (k) < hi))
#ifdef REP_RT
#define REPBIT(k) ((int)((rep_mask_ >> (k)) & 1u))
#else
#define REPBIT(k) ((int)((((unsigned)REP_MASK) >> (k)) & 1u))
#endif
#define PHASE(k) _Pragma("unroll") for (int rep_ = 0; rep_ < 1 + REPBIT(k); ++rep_)
#define SEAM(k) do { if ((IN(k) && IN((k) + 1)) || rep_ + 1 < 1 + REPBIT(k)) xcd_barrier(bar); } while (0)
    LAS unsigned char* ring = F.lds + RING_OFF; LAS unsigned char* xl = F.lds + XL_OFF;
    const int bx = (int)blockIdx.x, G = F.G;

#define KV_PROJ(l, rotK, rotV) do {   \
            { MapLin mp{(const char*)(ws + WS_MEMNB + (size_t)(l) * NB * MEML * DM * 2), (const char*)(ws + WS_WCK_T + (size_t)(l) * DM * DM * 2), (size_t)256 * DM * 2, (size_t)256 * DM * 2}; \
              pg8::Sched<MapLin> S; S.init(NB * MEML / 256, DM / 256, G, (bx + G - ((rotK) % G)) % G, mp); \
              EpiStore<AddrLin> E{AddrLin{(bf16_t*)(ws + WS_KCB + (size_t)(l) * NB * MEML * DM * 2), DM}}; \
              pg8::gemm_phase<EpiStore<AddrLin>, pg8::Sched<MapLin>, true>(F.wave, ring, xl, DM, DM * 2, DM * 2, S, E); } \
            { MapLin mp{(const char*)(ws + WS_WCV_T + (size_t)(l) * DM * DM * 2), (const char*)(ws + WS_MEMNB + (size_t)(l) * NB * MEML * DM * 2), (size_t)256 * DM * 2, (size_t)256 * DM * 2}; \
              pg8::Sched<MapLin> S; S.init(DM / 256, NB * MEML / 256, G, (bx + G - ((rotV) % G)) % G, mp); \
              EpiStore<AddrLin> E{AddrLin{(bf16_t*)(ws + WS_VTB + (size_t)(l) * NB * MEML * DM * 2), NB * MEML}}; \
              pg8::gemm_phase<EpiStore<AddrLin>, pg8::Sched<MapLin>, true>(F.wave, ring, xl, DM, DM * 2, DM * 2, S, E); } } while (0)
#ifdef EXTRA_BARS
    for (int eb = 0; eb < EXTRA_BARS; ++eb) xcd_barrier(bar);
#endif
    if (IN(0)) PHASE(0) { const karg_t ka = kargs(); unsigned char* const ws = uptr(KWS(ka)); p0_prologue(F, ka, ws); SEAM(0); }
    if (IN(1)) PHASE(1) { const karg_t ka = kargs(); unsigned char* const ws = uptr(KWS(ka));
        {
            MapLin mp{(const char*)(ws + WS_HN), (const char*)(ws + WS_WIN_T), (size_t)256 * DM * 2, (size_t)256 * DM * 2};
            pg8::Sched<MapLin> S; S.init(NTOK / 256, 2560 / 256, G, bx, mp);
            EpiQKV E{(bf16_t*)(ws + WS_QB), (bf16_t*)(ws + WS_KB), (bf16_t*)(ws + WS_VB), KIN(ka, 4), KIN(ka, 5), (const float*)(ws + WS_ROPE), (const float*)(ws + WS_ROPE) + SEQ * 64};
            pg8::gemm_phase<EpiQKV, pg8::Sched<MapLin>, true>(F.wave, ring, xl, DM, DM * 2, DM * 2, S, E); }
        {
            MapLin mp{(const char*)(ws + WS_WF_T), (const char*)(ws + WS_HN), (size_t)256 * DM * 2, (size_t)256 * DM * 2};
            pg8::Sched<MapLin> S; S.init(1024 / 256, NTOK / 256, G, (bx + G - (320 % G)) % G, mp);
            EpiStore<AddrF1> E{AddrF1{(bf16_t*)(ws + WS_FPQ)}};
            pg8::gemm_phase<EpiStore<AddrF1>, pg8::Sched<MapLin>, true>(F.wave, ring, xl, DM, DM * 2, DM * 2, S, E); }
        KV_PROJ(0, 448, 480);
        SEAM(1);
    }
    if (IN(2)) PHASE(2) { const karg_t ka = kargs(); unsigned char* const ws = uptr(KWS(ka));
        const int nF2 = (G > 64) ? 64 : 0;
        if (bx < nF2 || nF2 == 0) {
            MapLin mp{(const char*)(ws + WS_DFT), (const char*)(ws + WS_FPQ), (size_t)256 * 4096 * 2, (size_t)256 * 4096 * 2};
            pg8::Sched<MapLin> S; S.init(8, 8, nF2 ? nF2 : G, bx, mp);
            EpiStore<AddrF2> E{AddrF2{(bf16_t*)(ws + WS_MIXB)}};
            pg8::gemm_phase<EpiStore<AddrF2>, pg8::Sched<MapLin>, true>(F.wave, ring, xl, 4096, 4096 * 2, 4096 * 2, S, E);
        }
        if (bx < nF2) { __syncthreads(); tr_span(F, ka, ws, 3, bx * 8 + F.wave, 512, 2); __syncthreads(); }
        if (bx >= nF2) {
            const int a = bx - nF2, cnt = G - nF2, per = (384 + cnt - 1) / cnt; int ui = 0;
            float mfix; bool fm_ok; { const int ln = lane_id(); const float* gq = KIN(ka, 4); const float* gk = KIN(ka, 5);
                float mq = fmaxf(fabsf(gq[ln]), fabsf(gq[ln + 64])), mk = fmaxf(fabsf(gk[ln]), fabsf(gk[ln + 64]));
#pragma unroll
                for (int o_ = 1; o_ < 64; o_ <<= 1) { mq = fmaxf(mq, __shfl_xor(mq, o_)); mk = fmaxf(mk, __shfl_xor(mk, o_)); }
                mfix = 11.313708499f * 1.02f * mq * mk; fm_ok = __builtin_amdgcn_readfirstlane((int)(mfix <= 40.f)) != 0; mfix = __uint_as_float((unsigned)__builtin_amdgcn_readfirstlane((int)__float_as_uint(mfix))); }
            for (int uid = a * per; uid < (a + 1) * per && uid < 384; ++uid, ++ui) {
                const int set_ = 2 * (a & 7) + ui, jx = a >> 3, b = set_ >> 2, kvh = set_ & 3, qb = jx & 7, hq = kvh * 3 + (jx >> 3);
                const bf16_t* Qb = (const bf16_t*)(ws + WS_QB) + ((size_t)b * SEQ + qb * 256) * AW + hq * HD;
                const bf16_t* Kh = (const bf16_t*)(ws + WS_KB) + (size_t)b * SEQ * KVW + kvh * HD;
                const bf16_t* Vh = (const bf16_t*)(ws + WS_VB) + (size_t)b * SEQ * KVW + kvh * HD;
                bf16_t* Ob = (bf16_t*)(ws + WS_MIXB) + ((size_t)b * SEQ + qb * 256) * DM + hq * HD;
                if (fm_ok) attn::attn_dense_body<true>(Qb, Kh, Vh, Ob, SEQ, (char*)lds_raw + RING_OFF, F.wave, mfix);
                else attn::attn_dense_body<false>(Qb, Kh, Vh, Ob, SEQ, (char*)lds_raw + RING_OFF, F.wave);
            }
        }
        SEAM(2);
    }
    if (IN(3)) PHASE(3) { const karg_t ka = kargs(); unsigned char* const ws = uptr(KWS(ka));
        MapLin mp{(const char*)(ws + WS_MIXB), (const char*)(ws + WS_WOUT_T), (size_t)256 * DM * 2, (size_t)256 * DM * 2};
        pg8::Sched<MapLin> S; S.init(NTOK / 256, DM / 256, G, bx, mp);
        EpiResB<true> E{KIN(ka, 0), (bf16_t*)(ws + WS_XB), (float*)(ws + WS_SSP), nullptr};
        pg8::gemm_phase<EpiResB<true>, pg8::Sched<MapLin>, true>(F.wave, ring, xl, DM, DM * 2, DM * 2, S, E);
        SEAM(3);
    }
    {
        constexpr int l = 0; constexpr int pb = l ? 15 : 4;
        if (l == 1) {
            if (IN(13)) PHASE(13) { const karg_t ka = kargs(); unsigned char* const ws = uptr(KWS(ka));
                pool_phase(F, (const bf16_t*)(ws + WS_HN), (bf16_t*)(ws + WS_QCB));
#ifdef PROBE_CONV
                tr_span<TRV>(F, ka, ws, 1, bx * 8 + F.wave, 2048, 4);
#endif
                SEAM(13);
            }
            if (IN(14)) PHASE(14) { const karg_t ka = kargs(); unsigned char* const ws = uptr(KWS(ka));
                MapPool mp{(const char*)(ws + WS_QCB), (const char*)(ws + WS_WP_T)};
                pg8::Sched<MapPool> S; S.init(NTOK / 256, DM / 256, G, bx, mp);
                EpiResB<false> E{(const bf16_t*)(ws + WS_XB), (bf16_t*)(ws + WS_XALT), (float*)(ws + WS_SSP), KIN(ka, 9)};
                pg8::gemm_phase<EpiResB<false>, pg8::Sched<MapPool>, true>(F.wave, ring, xl, 512, DM * 2, DM * 2, S, E);
                SEAM(14);
            }
        }
        if (IN(pb + 0)) PHASE(pb + 0) { const karg_t ka = kargs(); unsigned char* const ws = uptr(KWS(ka));
            MapLin mp{(const char*)(ws + (l == 0 ? WS_XB : WS_XALT)), (const char*)(ws + WS_WCQ_T + (size_t)l * DM * DM * 2), (size_t)256 * DM * 2, (size_t)256 * DM * 2};
            pg8::Sched<MapLin> S; S.init(NTOK / 256, DM / 256, G, bx, mp);
            EpiRowScale E{(bf16_t*)(ws + WS_QCB), DM, (const float*)(ws + WS_SSP), 0.04419417382415922f};
            pg8::gemm_phase<EpiRowScale, pg8::Sched<MapLin>, true>(F.wave, ring, xl, DM, DM * 2, DM * 2, S, E);
            SEAM(pb + 0);
        }
        if (IN(pb + 1)) PHASE(pb + 1) { const karg_t ka = kargs(); unsigned char* const ws = uptr(KWS(ka));
            MapXS mp{(const char*)(ws + WS_QCB), (const char*)(ws + WS_KCB + (size_t)l * NB * MEML * DM * 2)};
            pg8::Sched<MapXS> S; S.init(NTOK / 256, NMH, G, bx, mp);
            EpiSoftmax E{(bf16_t*)(ws + WS_PB), NMH * MEML};
            pg8::gemm_phase<EpiSoftmax, pg8::Sched<MapXS>, true>(F.wave, ring, xl, MHD, DM * 2, DM * 2, S, E);
            { pg8::Unit su; if (S.next(0, su)) {
                VM_WAIT(); __syncthreads(); if (F.wave == 0 && lane_id() == 0) { __builtin_amdgcn_fence(__ATOMIC_ACQUIRE, "agent"); VM_WAIT(); } __syncthreads();
                MapXPV mp2{(const char*)(ws + WS_PB), (const char*)(ws + WS_VTB + (size_t)l * NB * MEML * DM * 2)};
                SchedPair S2; S2.ua.pm = su.pm; S2.ua.pn = 2 * su.pn; S2.ub.pm = su.pm; S2.ub.pn = 2 * su.pn + 1; mp2(S2.ua); mp2(S2.ub);
                EpiStore<AddrLin> E2{AddrLin{(bf16_t*)(ws + WS_MIXB), DM}};
                pg8::gemm_phase<EpiStore<AddrLin>, SchedPair, true>(F.wave, ring, xl, MEML, NMH * MEML * 2, NB * MEML * 2, S2, E2); } }
            if (l == 0) { KV_PROJ(1, 128, 160);
            }
            SEAM(pb + 1);
        }
        if (IN(pb + 3)) PHASE(pb + 3) { const karg_t ka = kargs(); unsigned char* const ws = uptr(KWS(ka));
            MapLin mp{(const char*)(ws + WS_MIXB), (const char*)(ws + WS_WCO_T + (size_t)l * DM * DM * 2), (size_t)256 * DM * 2, (size_t)256 * DM * 2};
            pg8::Sched<MapLin> S; S.init(NTOK / 256, DM / 256, G, bx, mp);
            EpiResB<false> E{(const bf16_t*)(ws + (l == 0 ? WS_XB : WS_XALT)), (bf16_t*)(ws + (l == 0 ? WS_XALT : WS_XB)), nullptr, nullptr, (bf16_t*)(ws + WS_XSB), KIN(ka, 16) + l * DM};
            pg8::gemm_phase<EpiResB<false>, pg8::Sched<MapLin>, true>(F.wave, ring, xl, DM, DM * 2, DM * 2, S, E);
            SEAM(pb + 3);
        }
        if (IN(pb + 4)) PHASE(pb + 4) { const karg_t ka = kargs(); unsigned char* const ws = uptr(KWS(ka));
            router_phase(F, (const bf16_t*)(ws + (l == 0 ? WS_XALT : WS_XB)), (const u32x4*)(ws + WS_AFF + 512 * 1024) + (size_t)l * 8192, (float*)(ws + WS_SSP + 512 * 1024), (float*)(ws + WS_AFF), xl);
            SEAM(pb + 4);
        }
        if (IN(pb + 5)) PHASE(pb + 5) { const karg_t ka = kargs(); unsigned char* const ws = uptr(KWS(ka));
            rank_phase(F, (const float*)(ws + WS_AFF), (int*)(ws + WS_RANK), (float*)(ws + WS_GATE), (const float*)(ws + WS_SSP + 512 * 1024), (float*)(ws + WS_SSP + 768 * 1024), (int*)(ws + WS_GATE + 512 * 1024));
            if (l == 0 && bx >= NB * NE && (bx - NB * NE) * 8 + F.wave < TR_DEFER - 1024) tr_span(F, ka, ws, 3, 1024 + (bx - NB * NE) * 8 + F.wave, 0, 1);
            SEAM(pb + 5);
        }
        if (IN(pb + 6)) PHASE(pb + 6) { const karg_t ka = kargs(); unsigned char* const ws = uptr(KWS(ka));
            MapMoE mp{(const char*)(ws + WS_XSB), (const char*)(KIN(ka, 18) + (size_t)l * NE * DM * EFF), (size_t)0, (size_t)DM * EFF * 4, (size_t)128 * 4};
            pg8::Sched<MapMoE> S; S.init(NB * NE, 8, G, bx, mp);
            EpiSwiGLU E{(bf16_t*)(ws + WS_ACTB), (const float*)(ws + WS_SSP + 768 * 1024)};
            pg8::gemm_phase<EpiSwiGLU, pg8::Sched<MapMoE>, true, true, 1, false>(F.wave, ring, xl, DM, DM * 2, EFF * 4, S, E, (const int*)(ws + WS_GATE + 512 * 1024), (long)((const char*)KIN(ka, 19) - (const char*)KIN(ka, 18)));
            SEAM(pb + 6);
        }
        if (IN(pb + 7)) PHASE(pb + 7) { const karg_t ka = kargs(); unsigned char* const ws = uptr(KWS(ka));
            MapMoE mp{(const char*)(ws + WS_ACTB), (const char*)(KIN(ka, 20) + (size_t)l * NE * EFF * DM), (size_t)256 * EFF * 2, (size_t)EFF * DM * 4, (size_t)256 * 4};
            pg8::Sched<MapMoE> S; S.init(NB * NE, 8, G, bx, mp);
            EpiRowGate E{(bf16_t*)(ws + WS_YB), (const float*)(ws + WS_GATE)};
            pg8::gemm_phase<EpiRowGate, pg8::Sched<MapMoE>, true, false, 1, false>(F.wave, ring, xl, EFF, EFF * 2, DM * 4, S, E, nullptr, 512);
            SEAM(pb + 7);
        }
        if (IN(pb + 8)) PHASE(pb + 8) { const karg_t ka = kargs(); unsigned char* const ws = uptr(KWS(ka));
            combine_phase(F, (const bf16_t*)(ws + (l == 0 ? WS_XALT : WS_XB)), (bf16_t*)(ws + WS_XB), KOUT(ka), (const bf16_t*)(ws + WS_YB), (const int*)(ws + WS_RANK), l == 0 ? KIN(ka, 2) + DM : KIN(ka, 21), (bf16_t*)(ws + WS_HN), l == 1);
            SEAM(pb + 8);
        }
    }
    {
        constexpr int l = 1; constexpr int pb = l ? 15 : 4;
        if (l == 1) {
            if (IN(13)) PHASE(13) { const karg_t ka = kargs(); unsigned char* const ws = uptr(KWS(ka));
                pool_phase(F, (const bf16_t*)(ws + WS_HN), (bf16_t*)(ws + WS_QCB));
#ifdef PROBE_CONV
                tr_span<TRV>(F, ka, ws, 1, bx * 8 + F.wave, 2048, 4);
#endif
                SEAM(13);
            }
            if (IN(14)) PHASE(14) { const karg_t ka = kargs(); unsigned char* const ws = uptr(KWS(ka));
                MapPool mp{(const char*)(ws + WS_QCB), (const char*)(ws + WS_WP_T)};
                pg8::Sched<MapPool> S; S.init(NTOK / 256, DM / 256, G, bx, mp);
                EpiResB<false> E{(const bf16_t*)(ws + WS_XB), (bf16_t*)(ws + WS_XALT), (float*)(ws + WS_SSP), KIN(ka, 9)};
                pg8::gemm_phase<EpiResB<false>, pg8::Sched<MapPool>, true>(F.wave, ring, xl, 512, DM * 2, DM * 2, S, E);
                SEAM(14);
            }
        }
        if (IN(pb + 0)) PHASE(pb + 0) { const karg_t ka = kargs(); unsigned char* const ws = uptr(KWS(ka));
            MapLin mp{(const char*)(ws + (l == 0 ? WS_XB : WS_XALT)), (const char*)(ws + WS_WCQ_T + (size_t)l * DM * DM * 2), (size_t)256 * DM * 2, (size_t)256 * DM * 2};
            pg8::Sched<MapLin> S; S.init(NTOK / 256, DM / 256, G, bx, mp);
            EpiRowScale E{(bf16_t*)(ws + WS_QCB), DM, (const float*)(ws + WS_SSP), 0.04419417382415922f};
            pg8::gemm_phase<EpiRowScale, pg8::Sched<MapLin>, true>(F.wave, ring, xl, DM, DM * 2, DM * 2, S, E);
            SEAM(pb + 0);
        }
        if (IN(pb + 1)) PHASE(pb + 1) { const karg_t ka = kargs(); unsigned char* const ws = uptr(KWS(ka));
            MapXS mp{(const char*)(ws + WS_QCB), (const char*)(ws + WS_KCB + (size_t)l * NB * MEML * DM * 2)};
            pg8::Sched<MapXS> S; S.init(NTOK / 256, NMH, G, bx, mp);
            EpiSoftmax E{(bf16_t*)(ws + WS_PB), NMH * MEML};
            pg8::gemm_phase<EpiSoftmax, pg8::Sched<MapXS>, true>(F.wave, ring, xl, MHD, DM * 2, DM * 2, S, E);
            { pg8::Unit su; if (S.next(0, su)) {
                VM_WAIT(); __syncthreads(); if (F.wave == 0 && lane_id() == 0) { __builtin_amdgcn_fence(__ATOMIC_ACQUIRE, "agent"); VM_WAIT(); } __syncthreads();
                MapXPV mp2{(const char*)(ws + WS_PB), (const char*)(ws + WS_VTB + (size_t)l * NB * MEML * DM * 2)};
                SchedPair S2; S2.ua.pm = su.pm; S2.ua.pn = 2 * su.pn; S2.ub.pm = su.pm; S2.ub.pn = 2 * su.pn + 1; mp2(S2.ua); mp2(S2.ub);
                EpiStore<AddrLin> E2{AddrLin{(bf16_t*)(ws + WS_MIXB), DM}};
                pg8::gemm_phase<EpiStore<AddrLin>, SchedPair, true>(F.wave, ring, xl, MEML, NMH * MEML * 2, NB * MEML * 2, S2, E2); } }
            if (l == 0) { KV_PROJ(1, 128, 160);
            }
            SEAM(pb + 1);
        }
        if (IN(pb + 3)) PHASE(pb + 3) { const karg_t ka = kargs(); unsigned char* const ws = uptr(KWS(ka));
            MapLin mp{(const char*)(ws + WS_MIXB), (const char*)(ws + WS_WCO_T + (size_t)l * DM * DM * 2), (size_t)256 * DM * 2, (size_t)256 * DM * 2};
            pg8::Sched<MapLin> S; S.init(NTOK / 256, DM / 256, G, bx, mp);
            EpiResB<false> E{(const bf16_t*)(ws + (l == 0 ? WS_XB : WS_XALT)), (bf16_t*)(ws + (l == 0 ? WS_XALT : WS_XB)), nullptr, nullptr, (bf16_t*)(ws + WS_XSB), KIN(ka, 16) + l * DM};
            pg8::gemm_phase<EpiResB<false>, pg8::Sched<MapLin>, true>(F.wave, ring, xl, DM, DM * 2, DM * 2, S, E);
            SEAM(pb + 3);
        }
        if (IN(pb + 4)) PHASE(pb + 4) { const karg_t ka = kargs(); unsigned char* const ws = uptr(KWS(ka));
            router_phase(F, (const bf16_t*)(ws + (l == 0 ? WS_XALT : WS_XB)), (const u32x4*)(ws + WS_AFF + 512 * 1024) + (size_t)l * 8192, (float*)(ws + WS_SSP + 512 * 1024), (float*)(ws + WS_AFF), xl);
            SEAM(pb + 4);
        }
        if (IN(pb + 5)) PHASE(pb + 5) { const karg_t ka = kargs(); unsigned char* const ws = uptr(KWS(ka));
            rank_phase(F, (const float*)(ws + WS_AFF), (int*)(ws + WS_RANK), (float*)(ws + WS_GATE), (const float*)(ws + WS_SSP + 512 * 1024), (float*)(ws + WS_SSP + 768 * 1024), (int*)(ws + WS_GATE + 512 * 1024));
            if (l == 0 && bx >= NB * NE && (bx - NB * NE) * 8 + F.wave < TR_DEFER - 1024) tr_span(F, ka, ws, 3, 1024 + (bx - NB * NE) * 8 + F.wave, 0, 1);
            SEAM(pb + 5);
        }
        if (IN(pb + 6)) PHASE(pb + 6) { const karg_t ka = kargs(); unsigned char* const ws = uptr(KWS(ka));
            MapMoE mp{(const char*)(ws + WS_XSB), (const char*)(KIN(ka, 18) + (size_t)l * NE * DM * EFF), (size_t)0, (size_t)DM * EFF * 4, (size_t)128 * 4};
            pg8::Sched<MapMoE> S; S.init(NB * NE, 8, G, bx, mp);
            EpiSwiGLU E{(bf16_t*)(ws + WS_ACTB), (const float*)(ws + WS_SSP + 768 * 1024)};
            pg8::gemm_phase<EpiSwiGLU, pg8::Sched<MapMoE>, true, true, 1, false>(F.wave, ring, xl, DM, DM * 2, EFF * 4, S, E, (const int*)(ws + WS_GATE + 512 * 1024), (long)((const char*)KIN(ka, 19) - (const char*)KIN(ka, 18)));
            SEAM(pb + 6);
        }
        if (IN(pb + 7)) PHASE(pb + 7) { const karg_t ka = kargs(); unsigned char* const ws = uptr(KWS(ka));
            MapMoE mp{(const char*)(ws + WS_ACTB), (const char*)(KIN(ka, 20) + (size_t)l * NE * EFF * DM), (size_t)256 * EFF * 2, (size_t)EFF * DM * 4, (size_t)256 * 4};
            pg8::Sched<MapMoE> S; S.init(NB * NE, 8, G, bx, mp);
            EpiRowGate E{(bf16_t*)(ws + WS_YB), (const float*)(ws + WS_GATE)};
            pg8::gemm_phase<EpiRowGate, pg8::Sched<MapMoE>, true, false, 1, false>(F.wave, ring, xl, EFF, EFF * 2, DM * 4, S, E, nullptr, 512);
            SEAM(pb + 7);
        }
        if (IN(pb + 8)) PHASE(pb + 8) { const karg_t ka = kargs(); unsigned char* const ws = uptr(KWS(ka));
            combine_phase(F, (const bf16_t*)(ws + (l == 0 ? WS_XALT : WS_XB)), (bf16_t*)(ws + WS_XB), KOUT(ka), (const bf16_t*)(ws + WS_YB), (const int*)(ws + WS_RANK), l == 0 ? KIN(ka, 2) + DM : KIN(ka, 21), (bf16_t*)(ws + WS_HN), l == 1);
            SEAM(pb + 8);
        }
    }
#undef IN
#undef SEAM
#undef PHASE
#undef KV_PROJ
}


extern "C" void kernel_launch(void* const* d_in, const int* in_sizes, int n_in, void* d_out, int out_size, void* d_ws, size_t ws_size, hipStream_t stream) {
    static int grid = 0;
    if (grid == 0) {
        int dev = 0, cus = 0;
        if (n_in != 22 || out_size != NTOK * DM || ws_size < WS_FAST_END) { fprintf(stderr, "kernel_launch: unexpected shapes (n_in %d out %d ws %zu)\n", n_in, out_size, ws_size); grid = -1; return; }
        if (hipGetDevice(&dev) != hipSuccess || hipDeviceGetAttribute(&cus, hipDeviceAttributeMultiprocessorCount, dev) != hipSuccess) { fprintf(stderr, "device query failed\n"); grid = -1; return; }
        if (hipFuncSetAttribute((const void*)skel_fwd, hipFuncAttributeMaxDynamicSharedMemorySize, LDS_BYTES) != hipSuccess) { fprintf(stderr, "hipFuncSetAttribute failed\n"); grid = -1; return; }
        (void)hipGetLastError();
        grid = cus;
        if (grid != 256) { fprintf(stderr, "kernel_launch: this kernel is laid out for 256 CUs (found %d)\n", cus); grid = -1; return; }
    }
    if (grid < 0) return;
    (void)hipMemsetAsync((char*)d_ws + WS_CTL, 0, 32768, stream);
    Args a{};
    for (int i = 0; i < 22; ++i) a.in[i] = (const float*)d_in[i];
    a.out = (float*)d_out; a.ws = (unsigned char*)d_ws;
#ifdef REP_RT
    a.pad = REP_RT;
#endif
    constexpr int NL = MK_N_LAUNCHES;
    for (int li = 0; li < NL; ++li) {
        a.ph_lo = (N_PHASES * li) / NL; a.ph_hi = (N_PHASES * (li + 1)) / NL; a.li = li;
        hipLaunchKernelGGL(skel_fwd, dim3(grid), dim3(NWAVES * 64), LDS_BYTES, stream, a);
    }
}
```
